# Optimizing an MI355X kernel written in HIP

```python
import numpy as np
import jax
import jax.numpy as jnp
from jax import lax

D_MODEL = 1024
BATCH = 2
SEQ = 8192
DEPTH = 2

HEAD_DIM = 64
NSA_HEADS = D_MODEL // (2 * HEAD_DIM)
NSA_KV_GROUPS = max(1, NSA_HEADS // 4)
NSA_HPG = NSA_HEADS // NSA_KV_GROUPS
NSA_CMP_LEN = 32
NSA_CMP_STRIDE = 16
NSA_CMP_HID = 128
NSA_SEL_BLOCK = 64
NSA_SEL_TOP = 16
NSA_WINDOW = 512
NSA_Q_CHUNK = 64
MOBA_HEADS = D_MODEL // (2 * HEAD_DIM)
MOBA_BLOCK = 256
MOBA_TOP = 3
MOBA_Q_CHUNK = 32
N_EXPERTS = 32
TOP_K = 4
D_FF = 1024
SWIGLU_LIMIT = 7.0
SWIGLU_ALPHA = 1.702
MOE_BLOCK = 128
EPS = 1e-6
NEG = -1e30
FORCE_SCORE = 1e4

NSA_W = NSA_HEADS * HEAD_DIM
NSA_KV_W = NSA_KV_GROUPS * HEAD_DIM
MOBA_W = MOBA_HEADS * HEAD_DIM
MIX_W = NSA_W + MOBA_W
IN_WIDTHS = (NSA_W, NSA_KV_W, NSA_KV_W, NSA_KV_W, NSA_KV_W, NSA_KV_W, NSA_KV_W,
             3 * NSA_HEADS, MOBA_W, MOBA_W, MOBA_W)
IN_W = sum(IN_WIDTHS)

kernel_name = 'hybrid_nsa_moba_moe_block'


def rms_norm(x, g):
    xf = x.astype(jnp.float32)
    y = xf * lax.rsqrt(jnp.mean(xf * xf, axis=-1, keepdims=True) + EPS)
    return (y * g.astype(jnp.float32)).astype(x.dtype)


def alibi_slopes(n):
    return jnp.asarray(2.0 ** (-8.0 * np.arange(1, n + 1) / n), dtype=jnp.float32)


def masked_softmax(s, mask):
    s = jnp.where(mask, s.astype(jnp.float32), NEG)
    p = jax.nn.softmax(s, axis=-1)
    return jnp.where(mask, p, 0.0)


def _heads(t, n_heads):
    b, s, _ = t.shape
    return t.reshape(b, s, n_heads, HEAD_DIM).transpose(0, 2, 1, 3)


_gather_blocks = jax.vmap(jax.vmap(lambda blocks, idx: blocks[idx]))


def _compress(kv, pos, w1, w2):
    s = kv.shape[2]
    n_cmp = (s - NSA_CMP_LEN) // NSA_CMP_STRIDE + 1
    idx = NSA_CMP_STRIDE * np.arange(n_cmp)[:, None] + np.arange(NSA_CMP_LEN)[None, :]
    blocks = kv[:, :, idx] + pos
    flat = blocks.reshape(kv.shape[0], kv.shape[1], n_cmp, NSA_CMP_LEN * HEAD_DIM)
    return jax.nn.gelu(flat @ w1) @ w2


def nsa_mixer(q, k_cmp, v_cmp, k_slc, v_slc, k_win, v_win, gates, k_gain, cmp_pos, cmp_w1, cmp_w2):
    B, G, Hg, S, dh = q.shape
    scale = dh ** -0.5
    sl = alibi_slopes(G * Hg).reshape(1, G, Hg, 1, 1)
    kc = rms_norm(_compress(k_cmp, cmp_pos[0], cmp_w1[0], cmp_w2[0]), k_gain)
    vc = _compress(v_cmp, cmp_pos[1], cmp_w1[1], cmp_w2[1])
    n_cmp = kc.shape[2]
    cmp_start = NSA_CMP_STRIDE * np.arange(n_cmp)
    cmp_end = jnp.asarray(cmp_start + NSA_CMP_LEN - 1, dtype=jnp.int32)
    cmp_center = jnp.asarray(cmp_start + 0.5 * (NSA_CMP_LEN - 1), dtype=jnp.float32)
    n_sel = S // NSA_SEL_BLOCK
    sel_start = NSA_SEL_BLOCK * np.arange(n_sel)
    incid = jnp.asarray((cmp_start[:, None] <= sel_start[None, :] + NSA_SEL_BLOCK - 1)
                        & (cmp_start[:, None] + NSA_CMP_LEN - 1 >= sel_start[None, :]), dtype=jnp.float32)
    n_top = min(NSA_SEL_TOP, n_sel)
    ks = rms_norm(k_slc, k_gain).reshape(B, G, n_sel, NSA_SEL_BLOCK, dh)
    vs = v_slc.reshape(B, G, n_sel, NSA_SEL_BLOCK, dh)
    pad = ((0, 0), (0, 0), (NSA_WINDOW, 0), (0, 0))
    kw = jnp.pad(rms_norm(k_win, k_gain), pad)
    vw = jnp.pad(v_win, pad)
    blk_ids = jnp.arange(n_sel)[None, :]
    in_blk = jnp.arange(NSA_SEL_BLOCK)
    win_off = jnp.arange(NSA_WINDOW + NSA_Q_CHUNK)
    C = NSA_Q_CHUNK
    m_sel = n_top * NSA_SEL_BLOCK

    def chunk(q0):
        qc = lax.dynamic_slice_in_dim(q, q0, C, axis=3)
        gc = lax.dynamic_slice_in_dim(gates, q0, C, axis=3)
        t = q0 + jnp.arange(C)
        tf = t.astype(jnp.float32)
        s = jnp.einsum('bghcd,bgnd->bghcn', qc, kc, preferred_element_type=jnp.float32) * scale
        s = s - sl * (tf[:, None] - cmp_center[None, :])
        p_cmp = masked_softmax(s, cmp_end[None, :] <= t[:, None])
        o_cmp = jnp.einsum('bghcn,bgnd->bghcd', p_cmp.astype(vc.dtype), vc)
        imp = jnp.einsum('bghcn,nj->bgcj', p_cmp, incid)
        cur = (t // NSA_SEL_BLOCK)[:, None]
        forced = (blk_ids == 0) | (blk_ids == cur) | (blk_ids == cur - 1)
        imp = jnp.where(forced, FORCE_SCORE, imp)
        imp = jnp.where(blk_ids <= cur, imp, NEG)
        _, sel = lax.top_k(imp, n_top)
        ksel = _gather_blocks(ks, sel).reshape(B, G, C, m_sel, dh)
        vsel = _gather_blocks(vs, sel).reshape(B, G, C, m_sel, dh)
        pos = (sel[..., None] * NSA_SEL_BLOCK + in_blk).reshape(B, G, C, m_sel)
        dist = (t[None, None, :, None] - pos)[:, :, None]
        s = jnp.einsum('bghcd,bgcmd->bghcm', qc, ksel, preferred_element_type=jnp.float32) * scale
        s = s - sl * dist.astype(jnp.float32)
        p = masked_softmax(s, dist >= 0)
        o_sel = jnp.einsum('bghcm,bgcmd->bghcd', p.astype(vsel.dtype), vsel)
        kwc = lax.dynamic_slice_in_dim(kw, q0, NSA_WINDOW + C, axis=2)
        vwc = lax.dynamic_slice_in_dim(vw, q0, NSA_WINDOW + C, axis=2)
        pos_w = q0 - NSA_WINDOW + win_off
        dist_w = t[:, None] - pos_w[None, :]
        mask_w = (dist_w >= 0) & (dist_w < NSA_WINDOW) & (pos_w >= 0)[None, :]
        s = jnp.einsum('bghcd,bgkd->bghck', qc, kwc, preferred_element_type=jnp.float32) * scale
        s = s - sl * dist_w.astype(jnp.float32)
        p = masked_softmax(s, mask_w)
        o_win = jnp.einsum('bghck,bgkd->bghcd', p.astype(vwc.dtype), vwc)
        return gc[..., 0:1] * o_cmp + gc[..., 1:2] * o_sel + gc[..., 2:3] * o_win

    out = lax.map(chunk, jnp.arange(0, S, C))
    return out.transpose(1, 0, 4, 2, 3, 5).reshape(B, S, G * Hg * dh)


def moba_mixer(q, k, v):
    B, H, S, dh = q.shape
    scale = dh ** -0.5
    sl = alibi_slopes(H).reshape(1, H, 1, 1)
    n_blk = -(-S // MOBA_BLOCK)
    pad = ((0, 0), (0, 0), (0, n_blk * MOBA_BLOCK - S), (0, 0))
    kp = jnp.pad(k, pad)
    vp = jnp.pad(v, pad)
    kb = kp.reshape(B, H, n_blk, MOBA_BLOCK, dh)
    vb = vp.reshape(B, H, n_blk, MOBA_BLOCK, dh)
    kmean = jnp.mean(kb.astype(jnp.float32), axis=3)
    n_top = min(MOBA_TOP, n_blk - 1)
    in_blk = jnp.arange(MOBA_BLOCK)
    blk_ids = jnp.arange(n_blk)
    C = MOBA_Q_CHUNK
    m_g = n_top * MOBA_BLOCK

    def chunk(q0):
        qc = lax.dynamic_slice_in_dim(q, q0, C, axis=2)
        t = q0 + jnp.arange(C)
        cb = q0 // MOBA_BLOCK
        kcur = lax.dynamic_slice_in_dim(kp, cb * MOBA_BLOCK, MOBA_BLOCK, axis=2)
        vcur = lax.dynamic_slice_in_dim(vp, cb * MOBA_BLOCK, MOBA_BLOCK, axis=2)
        dist_c = t[:, None] - (cb * MOBA_BLOCK + in_blk)[None, :]
        s_c = jnp.einsum('bhcd,bhkd->bhck', qc, kcur, preferred_element_type=jnp.float32) * scale
        s_c = s_c - sl * dist_c.astype(jnp.float32)
        mask_c = jnp.broadcast_to(dist_c >= 0, s_c.shape)
        if n_top > 0:
            gate = jnp.einsum('bhcd,bhnd->bhcn', qc, kmean, preferred_element_type=jnp.float32)
            gate = jnp.where(blk_ids < cb, gate, NEG)
            _, sel = lax.top_k(gate, n_top)
            kg = _gather_blocks(kb, sel).reshape(B, H, C, m_g, dh)
            vg = _gather_blocks(vb, sel).reshape(B, H, C, m_g, dh)
            pos_g = (sel[..., None] * MOBA_BLOCK + in_blk).reshape(B, H, C, m_g)
            dist_g = t[None, None, :, None] - pos_g
            s_g = jnp.einsum('bhcd,bhcmd->bhcm', qc, kg, preferred_element_type=jnp.float32) * scale
            s_g = s_g - sl * dist_g.astype(jnp.float32)
            mask_g = jnp.repeat(sel < cb, MOBA_BLOCK, axis=-1)
            p = masked_softmax(jnp.concatenate([s_g, s_c], axis=-1),
                               jnp.concatenate([mask_g, mask_c], axis=-1))
            o = (jnp.einsum('bhcm,bhcmd->bhcd', p[..., :m_g].astype(vg.dtype), vg)
                 + jnp.einsum('bhck,bhkd->bhcd', p[..., m_g:].astype(vcur.dtype), vcur))
        else:
            p = masked_softmax(s_c, mask_c)
            o = jnp.einsum('bhck,bhkd->bhcd', p.astype(vcur.dtype), vcur)
        return o

    out = lax.map(chunk, jnp.arange(0, S, C))
    return out.transpose(1, 0, 3, 2, 4).reshape(B, S, H * dh)


def hybrid_mixer(h, w_in, w_out, nsa_q_gain, nsa_k_gain, cmp_pos, cmp_w1, cmp_w2, moba_q_gain, moba_k_gain):
    B, S, _ = h.shape
    z = h @ w_in
    points = [int(v) for v in np.cumsum(IN_WIDTHS)[:-1]]
    q_n, kc, vc, ks, vs, kw, vw, g_n, q_m, k_m, v_m = jnp.split(z, points, axis=-1)
    qn = rms_norm(_heads(q_n, NSA_HEADS), nsa_q_gain).reshape(B, NSA_KV_GROUPS, NSA_HPG, S, HEAD_DIM)
    gates = jax.nn.sigmoid(g_n.reshape(B, S, NSA_KV_GROUPS, NSA_HPG, 3)).transpose(0, 2, 3, 1, 4)
    o_nsa = nsa_mixer(qn, _heads(kc, NSA_KV_GROUPS), _heads(vc, NSA_KV_GROUPS),
                      _heads(ks, NSA_KV_GROUPS), _heads(vs, NSA_KV_GROUPS),
                      _heads(kw, NSA_KV_GROUPS), _heads(vw, NSA_KV_GROUPS),
                      gates, nsa_k_gain, cmp_pos, cmp_w1, cmp_w2)
    o_moba = moba_mixer(rms_norm(_heads(q_m, MOBA_HEADS), moba_q_gain),
                        rms_norm(_heads(k_m, MOBA_HEADS), moba_k_gain),
                        _heads(v_m, MOBA_HEADS))
    return jnp.concatenate([o_nsa, o_moba], axis=-1) @ w_out


def sparse_moe(h, router_w, router_b, w1, b1, w2, b2):
    B, S, D = h.shape
    T = B * S
    hf = h.reshape(T, D)
    logits = (hf @ router_w + router_b).astype(jnp.float32)
    top_val, top_idx = lax.top_k(logits, TOP_K)
    gate = jax.nn.softmax(top_val, axis=-1)
    A = T * TOP_K
    e_flat = top_idx.reshape(A)
    tok_flat = jnp.arange(A, dtype=jnp.int32) // TOP_K
    w_flat = gate.reshape(A).astype(h.dtype)
    order = jnp.argsort(e_flat)
    e_s, tok_s, w_s = e_flat[order], tok_flat[order], w_flat[order]
    counts = jnp.bincount(e_flat, length=N_EXPERTS)
    padded = (counts + MOE_BLOCK - 1) // MOE_BLOCK * MOE_BLOCK
    start = jnp.cumsum(counts) - counts
    pend = jnp.cumsum(padded)
    pstart = pend - padded
    dest = pstart[e_s] + jnp.arange(A) - start[e_s]
    R = A + N_EXPERTS * MOE_BLOCK
    n_blocks = R // MOE_BLOCK
    row_tok = jnp.zeros((R,), jnp.int32).at[dest].set(tok_s)
    row_w = jnp.zeros((R,), h.dtype).at[dest].set(w_s)
    blk_e = jnp.minimum(jnp.searchsorted(pend, jnp.arange(n_blocks) * MOE_BLOCK, side='right'), N_EXPERTS - 1)

    def expert_block(args):
        e, toks, wts = args
        u = hf[toks] @ w1[e] + b1[e]
        g_, lin = u[:, :D_FF], u[:, D_FF:]
        g_ = jnp.minimum(g_, SWIGLU_LIMIT)
        lin = jnp.clip(lin, -SWIGLU_LIMIT, SWIGLU_LIMIT)
        y = ((lin + 1.0) * g_ * jax.nn.sigmoid(SWIGLU_ALPHA * g_)) @ w2[e] + b2[e]
        return y * wts[:, None]

    y = lax.map(expert_block, (blk_e, row_tok.reshape(n_blocks, MOE_BLOCK), row_w.reshape(n_blocks, MOE_BLOCK)))
    out = jax.ops.segment_sum(y.reshape(R, D), row_tok, num_segments=T)
    return out.reshape(B, S, D)


def setup_inputs(seed: int = 0) -> dict:
    key = jax.random.key(seed)
    ks = jax.random.split(key, 21)
    n = jax.random.normal
    f32 = jnp.float32
    D = D_MODEL
    return {
        'x': n(ks[0], (BATCH, SEQ, D), f32),
        'c': n(ks[1], (BATCH, D), f32),
        'ada_w': n(ks[2], (DEPTH, D, 6 * D), f32) * (0.5 * D ** -0.5),
        'ada_b': n(ks[3], (DEPTH, 6 * D), f32) * 0.01,
        'ln1_g': 1.0 + 0.01 * n(ks[4], (DEPTH, D), f32),
        'ln2_g': 1.0 + 0.01 * n(ks[5], (DEPTH, D), f32),
        'w_in': n(ks[6], (DEPTH, D, IN_W), f32) * D ** -0.5,
        'nsa_q_gain': 1.0 + 0.01 * n(ks[7], (DEPTH, HEAD_DIM), f32),
        'nsa_k_gain': 1.0 + 0.01 * n(ks[8], (DEPTH, HEAD_DIM), f32),
        'nsa_cmp_pos': 0.1 * n(ks[9], (DEPTH, 2, NSA_CMP_LEN, HEAD_DIM), f32),
        'nsa_cmp_w1': n(ks[10], (DEPTH, 2, NSA_CMP_LEN * HEAD_DIM, NSA_CMP_HID), f32) * (NSA_CMP_LEN * HEAD_DIM) ** -0.5,
        'nsa_cmp_w2': n(ks[11], (DEPTH, 2, NSA_CMP_HID, HEAD_DIM), f32) * NSA_CMP_HID ** -0.5,
        'moba_q_gain': 1.0 + 0.01 * n(ks[12], (DEPTH, HEAD_DIM), f32),
        'moba_k_gain': 1.0 + 0.01 * n(ks[13], (DEPTH, HEAD_DIM), f32),
        'w_out': n(ks[14], (DEPTH, MIX_W, D), f32) * MIX_W ** -0.5,
        'router_w': n(ks[15], (DEPTH, D, N_EXPERTS), f32) * D ** -0.5,
        'router_b': 0.01 * n(ks[16], (DEPTH, N_EXPERTS), f32),
        'exp_w1': n(ks[17], (DEPTH, N_EXPERTS, D, 2 * D_FF), f32) * D ** -0.5,
        'exp_b1': 0.01 * n(ks[18], (DEPTH, N_EXPERTS, 2 * D_FF), f32),
        'exp_w2': n(ks[19], (DEPTH, N_EXPERTS, D_FF, D), f32) * D_FF ** -0.5,
        'exp_b2': 0.01 * n(ks[20], (DEPTH, N_EXPERTS, D), f32),
    }


def reference(x, c, ada_w, ada_b, ln1_g, ln2_g, w_in, nsa_q_gain, nsa_k_gain, nsa_cmp_pos, nsa_cmp_w1,
              nsa_cmp_w2, moba_q_gain, moba_k_gain, w_out, router_w, router_b, exp_w1, exp_b1, exp_w2, exp_b2):
    cond = jax.nn.silu(c)
    for l in range(DEPTH):
        mod = (cond @ ada_w[l] + ada_b[l])[:, None, :]
        sh1, sc1, g1, sh2, sc2, g2 = jnp.split(mod, 6, axis=-1)
        h = rms_norm(x, ln1_g[l]) * (1.0 + sc1) + sh1
        x = x + g1 * hybrid_mixer(h, w_in[l], w_out[l], nsa_q_gain[l], nsa_k_gain[l], nsa_cmp_pos[l],
                                  nsa_cmp_w1[l], nsa_cmp_w2[l], moba_q_gain[l], moba_k_gain[l])
        h = rms_norm(x, ln2_g[l]) * (1.0 + sc2) + sh2
        x = x + g2 * sparse_moe(h, router_w[l], router_b[l], exp_w1[l], exp_b1[l], exp_w2[l], exp_b2[l])
    return x
```

```cpp
#include <hip/hip_runtime.h>
#include <hip/hip_cooperative_groups.h>
#include <cstdio>
#include <cstdint>
namespace cg = cooperative_groups;

constexpr int Bn = 2, S = 8192, D = 1024, L = 2, T = Bn * S;
constexpr int INW = 2840;
constexpr int NE = 32, TOPK = 4, DFF = 1024;
constexpr int A_TOT = T * TOPK;
constexpr int RMAX = A_TOT + NE * 256;
constexpr int NCMP = 511;
constexpr int NT = 512;
constexpr int NW = NT / 64;
constexpr int LDS_BYTES = 147456;
constexpr float EPS = 1e-6f;
constexpr float NEGF = -1e30f;

constexpr int ZC_Q = 0, ZC_KC = 512, ZC_VC = 640, ZC_KS = 768, ZC_VS = 896, ZC_KW = 1024, ZC_VW = 1152, ZC_G = 1280, ZC_MQ = 1304, ZC_MK = 1816, ZC_MV = 2328;

constexpr size_t al256(size_t x) { return (x + 255) & ~(size_t)255; }
constexpr size_t WS_MODP = 0;
constexpr size_t WS_MOD = al256(WS_MODP + (size_t)8 * L * Bn * 6144 * 4);
constexpr size_t WS_CNT = al256(WS_MOD + (size_t)L * Bn * 6144 * 4);
constexpr size_t WS_FILL = al256(WS_CNT + L * 32 * 4);
constexpr size_t WS_ROWTOK = al256(WS_FILL + L * 32 * 4);
constexpr size_t WS_ROWW = al256(WS_ROWTOK + (size_t)L * RMAX * 4);
constexpr size_t WS_TOKE = al256(WS_ROWW + (size_t)L * RMAX * 4);
constexpr size_t WS_TOKW = al256(WS_TOKE + (size_t)T * 4 * 4);
constexpr size_t WS_POS = al256(WS_TOKW + (size_t)T * 4 * 4);
constexpr size_t WS_HID = al256(WS_POS + (size_t)T * 4 * 4);
constexpr size_t WS_KC = al256(WS_HID + (size_t)2 * 2044 * 128 * 4);
constexpr size_t WS_VC = al256(WS_KC + (size_t)2044 * 64 * 4);
constexpr size_t WS_KM = al256(WS_VC + (size_t)2044 * 64 * 4);
constexpr size_t WS_H = al256(WS_KM + (size_t)Bn * 8 * 32 * 64 * 4);
constexpr size_t WS_Z = al256(WS_H + (size_t)T * D * 4);
constexpr size_t WS_ATT = al256(WS_Z + (size_t)T * INW * 4);
constexpr size_t WS_U = al256(WS_ATT + (size_t)T * D * 4);
constexpr size_t WS_Y = al256(WS_U + (size_t)RMAX * 2048 * 4);
constexpr size_t WS_END = al256(WS_Y + (size_t)RMAX * 1024 * 4);

struct Params {
    const float* in[21];
    float* out;
    unsigned char* ws;
};

__device__ __forceinline__ int otid() { int t = threadIdx.x; asm volatile("" : "+v"(t)); return t; }
__device__ __forceinline__ float wave_sum(float v) {
#pragma unroll
    for (int o = 1; o < 64; o <<= 1) v += __shfl_xor(v, o);
    return v;
}
__device__ __forceinline__ float sigmoidf_(float x) { return 1.f / (1.f + __expf(-x)); }
__device__ __forceinline__ float gelu_tanh(float x) {
    const float u = 0.7978845608028654f * (x + 0.044715f * x * x * x);
    return 0.5f * x * (1.f + tanhf(u));
}

template <class AL, class BL, class EP>
__device__ __forceinline__ void gemm_tile(float* lds, int m0, int n0, int K, const AL& al, const BL& bl, const EP& ep) {
    float* As = lds;
    float* Bs = lds + 16 * 132;
    const int tid = otid(), tx = tid & 15, ty = tid >> 4;
    const int ar = tid >> 2, ak = (tid & 3) * 4;
    const int bk = tid >> 5, bn = (tid & 31) * 2;
    float acc[4][4];
#pragma unroll
    for (int i = 0; i < 4; ++i)
#pragma unroll
        for (int j = 0; j < 4; ++j) acc[i][j] = 0.f;
    float4 av = al(m0 + ar, ak);
    float2 bv = bl(bk, n0 + bn);
    for (int k0 = 0; k0 < K; k0 += 16) {
        As[(ak + 0) * 132 + ar] = av.x; As[(ak + 1) * 132 + ar] = av.y; As[(ak + 2) * 132 + ar] = av.z; As[(ak + 3) * 132 + ar] = av.w;
        *(float2*)&Bs[bk * 68 + bn] = bv;
        __syncthreads();
        if (k0 + 16 < K) { av = al(m0 + ar, k0 + 16 + ak); bv = bl(k0 + 16 + bk, n0 + bn); }
#pragma unroll
        for (int kk = 0; kk < 16; ++kk) {
            const float4 a = *(const float4*)&As[kk * 132 + ty * 4];
            const float4 b = *(const float4*)&Bs[kk * 68 + tx * 4];
            const float a_[4] = {a.x, a.y, a.z, a.w}, b_[4] = {b.x, b.y, b.z, b.w};
#pragma unroll
            for (int i = 0; i < 4; ++i)
#pragma unroll
                for (int j = 0; j < 4; ++j) acc[i][j] += a_[i] * b_[j];
        }
        __syncthreads();
    }
#pragma unroll
    for (int i = 0; i < 4; ++i)
#pragma unroll
        for (int j = 0; j < 4; ++j) ep(m0 + ty * 4 + i, n0 + tx * 4 + j, acc[i][j]);
}

__device__ __forceinline__ void phase_p0a(const Params& p, float* lds) {
    const int tid = otid(), gtid = blockIdx.x * NT + tid, gsz = gridDim.x * NT;
    int* cnt = (int*)(p.ws + WS_CNT); int* fill = (int*)(p.ws + WS_FILL); int* rowtok = (int*)(p.ws + WS_ROWTOK);
    for (int i = gtid; i < L * 32; i += gsz) { cnt[i] = 0; fill[i] = 0; }
    for (int i = gtid; i < L * RMAX; i += gsz) rowtok[i] = -1;
    const float* c = p.in[1];
    for (int i = tid; i < Bn * D; i += NT) { const float v = c[i]; lds[i] = v / (1.f + __expf(-v)); }
    __syncthreads();
    const float* ada_w = p.in[2];
    float* modp = (float*)(p.ws + WS_MODP);
    for (int idx = gtid; idx < 8 * L * 6144; idx += gsz) {
        const int col = idx % 6144, l = (idx / 6144) % L, kc = idx / (6144 * L);
        const float* w = ada_w + ((size_t)l * D + kc * 128) * 6144 + col;
        float a0 = 0.f, a1 = 0.f;
#pragma unroll 8
        for (int k = 0; k < 128; ++k) { const float wv = w[(size_t)k * 6144]; a0 += lds[kc * 128 + k] * wv; a1 += lds[D + kc * 128 + k] * wv; }
        modp[((size_t)(kc * L + l) * Bn + 0) * 6144 + col] = a0;
        modp[((size_t)(kc * L + l) * Bn + 1) * 6144 + col] = a1;
    }
}
__device__ __forceinline__ void phase_p0b(const Params& p) {
    const int gtid = blockIdx.x * NT + otid(), gsz = gridDim.x * NT;
    const float* modp = (const float*)(p.ws + WS_MODP); float* mod = (float*)(p.ws + WS_MOD); const float* ada_b = p.in[3];
    for (int idx = gtid; idx < L * Bn * 6144; idx += gsz) {
        const int col = idx % 6144, l = idx / (Bn * 6144);
        float s = ada_b[l * 6144 + col];
#pragma unroll
        for (int kc = 0; kc < 8; ++kc) s += modp[(size_t)kc * L * Bn * 6144 + idx];
        mod[idx] = s;
    }
}

__device__ __forceinline__ void phase_r1(const Params& p, int l, bool do_h) {
    const int lane = otid() & 63, wave = otid() >> 6;
    const int gw = blockIdx.x * NW + wave, ngw = gridDim.x * NW;
    const float* mod = (const float*)(p.ws + WS_MOD);
    const float* xin = p.in[0]; float* XA = p.out; float* H = (float*)(p.ws + WS_H);
    const float* Y = (const float*)(p.ws + WS_Y); const int* pos = (const int*)(p.ws + WS_POS);
    const float* lng = p.in[4] + (size_t)(do_h ? l : 0) * D;
    for (int t = gw; t < T; t += ngw) {
        const int b = t / S;
        float4 v[4];
        if (l == 0) {
#pragma unroll
            for (int j = 0; j < 4; ++j) v[j] = *(const float4*)(xin + (size_t)t * D + 4 * lane + 256 * j);
        } else {
            const float* g2 = mod + ((size_t)(l - 1) * Bn + b) * 6144 + 5 * D;
            const int p0 = pos[t * 4 + 0], p1 = pos[t * 4 + 1], p2 = pos[t * 4 + 2], p3 = pos[t * 4 + 3];
#pragma unroll
            for (int j = 0; j < 4; ++j) {
                const int col = 4 * lane + 256 * j;
                const float4 x = *(const float4*)(XA + (size_t)t * D + col);
                const float4 y0 = *(const float4*)(Y + (size_t)p0 * D + col), y1 = *(const float4*)(Y + (size_t)p1 * D + col);
                const float4 y2 = *(const float4*)(Y + (size_t)p2 * D + col), y3 = *(const float4*)(Y + (size_t)p3 * D + col);
                const float4 g = *(const float4*)(g2 + col);
                float4 r;
                r.x = x.x + g.x * (((y0.x + y1.x) + y2.x) + y3.x); r.y = x.y + g.y * (((y0.y + y1.y) + y2.y) + y3.y);
                r.z = x.z + g.z * (((y0.z + y1.z) + y2.z) + y3.z); r.w = x.w + g.w * (((y0.w + y1.w) + y2.w) + y3.w);
                v[j] = r;
                *(float4*)(XA + (size_t)t * D + col) = r;
            }
        }
        if (do_h) {
            float ss = 0.f;
#pragma unroll
            for (int j = 0; j < 4; ++j) ss += (v[j].x * v[j].x + v[j].y * v[j].y) + (v[j].z * v[j].z + v[j].w * v[j].w);
            ss = wave_sum(ss);
            const float r = rsqrtf(ss * (1.f / D) + EPS);
            const float* sh = mod + ((size_t)l * Bn + b) * 6144 + 0 * D; const float* sc = mod + ((size_t)l * Bn + b) * 6144 + 1 * D;
#pragma unroll
            for (int j = 0; j < 4; ++j) {
                const int col = 4 * lane + 256 * j;
                const float4 g = *(const float4*)(lng + col), s1 = *(const float4*)(sc + col), s0 = *(const float4*)(sh + col);
                float4 o;
                o.x = v[j].x * r * g.x * (1.f + s1.x) + s0.x; o.y = v[j].y * r * g.y * (1.f + s1.y) + s0.y;
                o.z = v[j].z * r * g.z * (1.f + s1.z) + s0.z; o.w = v[j].w * r * g.w * (1.f + s1.w) + s0.w;
                *(float4*)(H + (size_t)t * D + col) = o;
            }
        }
    }
}

__device__ __forceinline__ void phase_g1(const Params& p, int l, float* lds) {
    const float* H = (const float*)(p.ws + WS_H); const float* W = p.in[6] + (size_t)l * D * INW; float* Z = (float*)(p.ws + WS_Z);
    constexpr int NTN = (INW + 63) / 64, NTM = T / 128;
    auto al = [=](int r, int k) -> float4 { return *(const float4*)(H + (size_t)r * D + k); };
    auto bl = [=](int k, int n) -> float2 { return n < INW ? *(const float2*)(W + (size_t)k * INW + n) : make_float2(0.f, 0.f); };
    auto ep = [=](int r, int c, float v) { if (c < INW) Z[(size_t)r * INW + c] = v; };
    for (int tile = blockIdx.x; tile < NTM * NTN; tile += gridDim.x) {
        const int tm = tile / NTN, tn = tile % NTN;
        gemm_tile(lds, tm * 128, tn * 64, D, al, bl, ep);
    }
}

__device__ __forceinline__ void phase_zp(const Params& p, int l) {
    const int lane = otid() & 63, wave = otid() >> 6;
    const int gw = blockIdx.x * NW + wave, ngw = gridDim.x * NW;
    float* Z = (float*)(p.ws + WS_Z);
    const float gq = p.in[7][l * 64 + lane], gk = p.in[8][l * 64 + lane], gmq = p.in[12][l * 64 + lane], gmk = p.in[13][l * 64 + lane];
    for (int t = gw; t < T; t += ngw) {
        float* z = Z + (size_t)t * INW;
        for (int seg = 0; seg < 28; ++seg) {
            int col; float g;
            if (seg < 8) { col = ZC_Q + seg * 64; g = gq; }
            else if (seg < 10) { col = ZC_KS + (seg - 8) * 64; g = gk; }
            else if (seg < 12) { col = ZC_KW + (seg - 10) * 64; g = gk; }
            else if (seg < 20) { col = ZC_MQ + (seg - 12) * 64; g = gmq; }
            else { col = ZC_MK + (seg - 20) * 64; g = gmk; }
            const float v = z[col + lane];
            const float ss = wave_sum(v * v);
            z[col + lane] = v * rsqrtf(ss * (1.f / 64.f) + EPS) * g;
        }
        if (lane < 24) z[ZC_G + lane] = sigmoidf_(z[ZC_G + lane]);
    }
}

__device__ __forceinline__ void phase_ck(const Params& p, int l, float* lds) {
    const float* Z = (const float*)(p.ws + WS_Z);
    float* HID = (float*)(p.ws + WS_HID);
    const float* posw = p.in[9] + (size_t)l * 2 * 32 * 64; const float* w1 = p.in[10] + (size_t)l * 2 * 2048 * 128;
    for (int tile = blockIdx.x; tile < 64; tile += gridDim.x) {
        const int idx = tile / 32, tm = (tile % 32) / 2, tn = tile % 2;
        const float* W = w1 + (size_t)idx * 2048 * 128; const float* PW = posw + (size_t)idx * 32 * 64; float* HO = HID + (size_t)idx * 2044 * 128;
        auto al = [=](int r, int k) -> float4 {
            if (r >= 2044) return make_float4(0.f, 0.f, 0.f, 0.f);
            const int b = r / 1022, g = (r / 511) & 1, n = r % 511, li = k >> 6, d = k & 63;
            const float4 a = *(const float4*)(Z + (size_t)(b * S + 16 * n + li) * INW + ZC_KC + idx * 128 + g * 64 + d);
            const float4 q = *(const float4*)(PW + li * 64 + d);
            return make_float4(a.x + q.x, a.y + q.y, a.z + q.z, a.w + q.w);
        };
        auto bl = [=](int k, int n) -> float2 { return *(const float2*)(W + (size_t)k * 128 + n); };
        auto ep = [=](int r, int c, float v) { if (r < 2044) HO[(size_t)r * 128 + c] = gelu_tanh(v); };
        gemm_tile(lds, tm * 128, tn * 64, 2048, al, bl, ep);
    }
    const int lane = otid() & 63, wave = otid() >> 6;
    float* KM = (float*)(p.ws + WS_KM);
    for (int it = blockIdx.x * NW + wave; it < Bn * 8 * 32; it += gridDim.x * NW) {
        const int b = it / 256, h = (it / 32) & 7, blk = it & 31;
        const float* base = Z + (size_t)(b * S + blk * 256) * INW + ZC_MK + h * 64 + lane;
        float s = 0.f;
        for (int i = 0; i < 256; ++i) s += base[(size_t)i * INW];
        KM[(size_t)it * 64 + lane] = s * (1.f / 256.f);
    }
}
__device__ __forceinline__ void phase_c2(const Params& p, int l) {
    const int lane = otid() & 63, wave = otid() >> 6;
    const float* HID = (const float*)(p.ws + WS_HID); const float* w2 = p.in[11] + (size_t)l * 2 * 128 * 64;
    float* KC = (float*)(p.ws + WS_KC); float* VC = (float*)(p.ws + WS_VC);
    const float gk = p.in[8][l * 64 + lane];
    for (int r = blockIdx.x * NW + wave; r < 2 * 2044; r += gridDim.x * NW) {
        const int idx = r / 2044, rr = r % 2044;
        const float* hrow = HID + (size_t)r * 128; const float* W = w2 + (size_t)idx * 128 * 64;
        float s = 0.f;
        for (int j = 0; j < 128; ++j) s += hrow[j] * W[j * 64 + lane];
        if (idx == 0) { const float ss = wave_sum(s * s); KC[(size_t)rr * 64 + lane] = s * rsqrtf(ss * (1.f / 64.f) + EPS) * gk; }
        else VC[(size_t)rr * 64 + lane] = s;
    }
}

#define ATT_KEY(valid, kp, vp, bias)                                                              \
    {                                                                                             \
        float s_ = 0.f;                                                                           \
        _Pragma("unroll") for (int d = 0; d < 32; ++d) s_ += qv[d] * (kp)[d];                     \
        s_ += __shfl_xor(s_, 1);                                                                  \
        s_ = s_ * 0.125f - (bias);                                                                \
        if (valid) {                                                                              \
            if (s_ > m) { const float cf = __expf(m - s_); lsum *= cf; _Pragma("unroll") for (int d = 0; d < 32; ++d) o[d] *= cf; m = s_; } \
            const float p_ = __expf(s_ - m); lsum += p_;                                          \
            _Pragma("unroll") for (int d = 0; d < 32; ++d) o[d] += p_ * (vp)[d];                  \
        }                                                                                         \
    }

__device__ __forceinline__ void nsa_item(const Params& p, int item, float* lds) {
    const int tid = otid(), q = (tid & 63) >> 1, half = tid & 1, h = __builtin_amdgcn_readfirstlane(tid >> 6), g = h >> 2, hg = h & 3;
    const int b = item >> 8, ci = item & 255, t0 = ci * 32, t = t0 + q, cur = t0 >> 6; const size_t tt = (size_t)b * S + t;
    const float* Z = (const float*)(p.ws + WS_Z); float* ATT = (float*)(p.ws + WS_ATT);
    const float* KC = (const float*)(p.ws + WS_KC) + (size_t)(b * 2 + g) * NCMP * 64 + half * 32; const float* VC = (const float*)(p.ws + WS_VC) + (size_t)(b * 2 + g) * NCMP * 64 + half * 32;
    float* imp = lds;
    unsigned* selm = (unsigned*)(lds + 2 * 32 * 129);
    const float slope = exp2f(-(float)(h + 1));
    float qv[32], o[32];
#pragma unroll
    for (int d = 0; d < 32; d += 4) { const float4 v = *(const float4*)(Z + tt * INW + ZC_Q + h * 64 + half * 32 + d); qv[d] = v.x; qv[d + 1] = v.y; qv[d + 2] = v.z; qv[d + 3] = v.w; }
    const float g0 = Z[tt * INW + ZC_G + h * 3 + 0], g1 = Z[tt * INW + ZC_G + h * 3 + 1], g2 = Z[tt * INW + ZC_G + h * 3 + 2];
    for (int i = tid; i < 2 * 32 * 129; i += NT) imp[i] = 0.f;
    const int cnt_t = t >= 31 ? (t - 31) / 16 + 1 : 0;
    const int cnt_max = (t0 + 31 - 31) / 16 + 1;
    float m = NEGF, lsum = 0.f;
    _Pragma("unroll 1") for (int n = 0; n < cnt_max; ++n) {
        const float* kp = KC + (size_t)n * 64;
        float s_ = 0.f;
#pragma unroll
        for (int d = 0; d < 32; ++d) s_ += qv[d] * kp[d];
        s_ += __shfl_xor(s_, 1);
        s_ = s_ * 0.125f - slope * ((float)t - (16.f * n + 15.5f));
        if (n < cnt_t) { if (s_ > m) { lsum *= __expf(m - s_); m = s_; } lsum += __expf(s_ - m); }
    }
    const float linv = lsum > 0.f ? 1.f / lsum : 0.f;
#pragma unroll
    for (int d = 0; d < 32; ++d) o[d] = 0.f;
    __syncthreads();
    _Pragma("unroll 1") for (int r = 0; r < 4; ++r) {
        if (hg == r) {
            float* myimp = imp + (size_t)(g * 32 + q) * 129;
            _Pragma("unroll 1") for (int n = 0; n < cnt_max; ++n) {
                const float* kp = KC + (size_t)n * 64; const float* vp = VC + (size_t)n * 64;
                float s_ = 0.f;
#pragma unroll
                for (int d = 0; d < 32; ++d) s_ += qv[d] * kp[d];
                s_ += __shfl_xor(s_, 1);
                s_ = s_ * 0.125f - slope * ((float)t - (16.f * n + 15.5f));
                if (n < cnt_t) {
                    const float p_ = __expf(s_ - m) * linv;
#pragma unroll
                    for (int d = 0; d < 32; ++d) o[d] += p_ * vp[d];
                    if (half == 0) {
                        myimp[n >> 2] += p_;
                        if ((n & 3) == 3) myimp[(n + 1) >> 2] += p_;
                    }
                }
            }
        }
        __syncthreads();
    }
    {
        float* ao = ATT + tt * D + h * 64 + half * 32;
#pragma unroll
        for (int d = 0; d < 32; d += 4) *(float4*)(ao + d) = make_float4(g0 * o[d], g0 * o[d + 1], g0 * o[d + 2], g0 * o[d + 3]);
    }
    if (hg == 0 && half == 0) {
        float* myimp = imp + (size_t)(g * 32 + q) * 129;
        _Pragma("unroll 1") for (int j = 0; j < 128; ++j) {
            float v = myimp[j];
            if (j == 0 || j == cur || j == cur - 1) v = 1e4f;
            if (j > cur) v = NEGF;
            myimp[j] = v;
        }
        unsigned mk0 = 0u, mk1 = 0u, mk2 = 0u, mk3 = 0u;
        _Pragma("unroll 1") for (int it = 0; it < 16; ++it) {
            float best = -3e38f; int bi = -1;
            _Pragma("unroll 4") for (int j = 0; j < 128; ++j) { const float v = myimp[j]; if (v > best) { best = v; bi = j; } }
            if (best <= NEGF) break;
            myimp[bi] = -3.4e38f;
            const unsigned bit = 1u << (bi & 31);
            if ((bi >> 5) == 0) mk0 |= bit; else if ((bi >> 5) == 1) mk1 |= bit; else if ((bi >> 5) == 2) mk2 |= bit; else mk3 |= bit;
        }
        unsigned* sm = selm + (g * 32 + q) * 4;
        sm[0] = mk0; sm[1] = mk1; sm[2] = mk2; sm[3] = mk3;
    }
    __syncthreads();
    {
        const unsigned* sm = selm + (g * 32 + q) * 4;
        const unsigned m0 = sm[0], m1 = sm[1], m2 = sm[2], m3 = sm[3];
        m = NEGF; lsum = 0.f;
#pragma unroll
        for (int d = 0; d < 32; ++d) o[d] = 0.f;
        _Pragma("unroll 1") for (int j = 0; j <= cur; ++j) {
            const unsigned w = (j >> 5) == 0 ? m0 : (j >> 5) == 1 ? m1 : (j >> 5) == 2 ? m2 : m3;
            const bool sel = (w >> (j & 31)) & 1u;
            if (__ballot(sel) == 0ull) continue;
            _Pragma("unroll 1") for (int kk = 0; kk < 64; ++kk) {
                const int ps = j * 64 + kk;
                const float* kp = Z + (size_t)(b * S + ps) * INW + ZC_KS + g * 64 + half * 32; const float* vp = Z + (size_t)(b * S + ps) * INW + ZC_VS + g * 64 + half * 32;
                const bool valid = sel && ps <= t;
                ATT_KEY(valid, kp, vp, slope * (float)(t - ps));
            }
        }
        const float li = lsum > 0.f ? g1 / lsum : 0.f;
        float* ao = ATT + tt * D + h * 64 + half * 32;
#pragma unroll
        for (int d = 0; d < 32; d += 4) { float4 a = *(float4*)(ao + d); a.x += li * o[d]; a.y += li * o[d + 1]; a.z += li * o[d + 2]; a.w += li * o[d + 3]; *(float4*)(ao + d) = a; }
    }
    {
        m = NEGF; lsum = 0.f;
#pragma unroll
        for (int d = 0; d < 32; ++d) o[d] = 0.f;
        const int lo = t0 - 511 > 0 ? t0 - 511 : 0;
        _Pragma("unroll 1") for (int ps = lo; ps <= t0 + 31; ++ps) {
            const float* kp = Z + (size_t)(b * S + ps) * INW + ZC_KW + g * 64 + half * 32; const float* vp = Z + (size_t)(b * S + ps) * INW + ZC_VW + g * 64 + half * 32;
            const bool valid = ps <= t && ps > t - 512;
            ATT_KEY(valid, kp, vp, slope * (float)(t - ps));
        }
        const float li = lsum > 0.f ? g2 / lsum : 0.f;
        float* ao = ATT + tt * D + h * 64 + half * 32;
#pragma unroll
        for (int d = 0; d < 32; d += 4) { float4 a = *(float4*)(ao + d); a.x += li * o[d]; a.y += li * o[d + 1]; a.z += li * o[d + 2]; a.w += li * o[d + 3]; *(float4*)(ao + d) = a; }
    }
    __syncthreads();
}

__device__ __forceinline__ void moba_item(const Params& p, int item) {
    const int tid = otid(), q = (tid & 63) >> 1, half = tid & 1, h = __builtin_amdgcn_readfirstlane(tid >> 6);
    const int b = item >> 8, ci = item & 255, t0 = ci * 32, t = t0 + q, cb = t0 >> 8; const size_t tt = (size_t)b * S + t;
    const float* Z = (const float*)(p.ws + WS_Z); float* ATT = (float*)(p.ws + WS_ATT);
    const float* KM = (const float*)(p.ws + WS_KM) + (size_t)(b * 8 + h) * 32 * 64 + half * 32;
    const float slope = exp2f(-(float)(h + 1));
    float qv[32], o[32];
#pragma unroll
    for (int d = 0; d < 32; d += 4) { const float4 v = *(const float4*)(Z + tt * INW + ZC_MQ + h * 64 + half * 32 + d); qv[d] = v.x; qv[d + 1] = v.y; qv[d + 2] = v.z; qv[d + 3] = v.w; }
    float v1 = NEGF, v2 = NEGF, v3 = NEGF; int i1 = -1, i2 = -1, i3 = -1;
    _Pragma("unroll 1") for (int n = 0; n < cb; ++n) {
        const float* kp = KM + n * 64;
        float s_ = 0.f;
#pragma unroll
        for (int d = 0; d < 32; ++d) s_ += qv[d] * kp[d];
        s_ += __shfl_xor(s_, 1);
        if (s_ > v1) { v3 = v2; i3 = i2; v2 = v1; i2 = i1; v1 = s_; i1 = n; }
        else if (s_ > v2) { v3 = v2; i3 = i2; v2 = s_; i2 = n; }
        else if (s_ > v3) { v3 = s_; i3 = n; }
    }
    float m = NEGF, lsum = 0.f;
#pragma unroll
    for (int d = 0; d < 32; ++d) o[d] = 0.f;
    _Pragma("unroll 1") for (int n = 0; n < cb; ++n) {
        const bool sel = (n == i1) || (n == i2) || (n == i3);
        if (__ballot(sel) == 0ull) continue;
        _Pragma("unroll 1") for (int kk = 0; kk < 256; ++kk) {
            const int ps = n * 256 + kk;
            const float* kp = Z + (size_t)(b * S + ps) * INW + ZC_MK + h * 64 + half * 32; const float* vp = Z + (size_t)(b * S + ps) * INW + ZC_MV + h * 64 + half * 32;
            ATT_KEY(sel, kp, vp, slope * (float)(t - ps));
        }
    }
    _Pragma("unroll 1") for (int ps = cb * 256; ps <= t0 + 31; ++ps) {
        const float* kp = Z + (size_t)(b * S + ps) * INW + ZC_MK + h * 64 + half * 32; const float* vp = Z + (size_t)(b * S + ps) * INW + ZC_MV + h * 64 + half * 32;
        const bool valid = ps <= t;
        ATT_KEY(valid, kp, vp, slope * (float)(t - ps));
    }
    const float li = lsum > 0.f ? 1.f / lsum : 0.f;
    float* ao = ATT + tt * D + 512 + h * 64 + half * 32;
#pragma unroll
    for (int d = 0; d < 32; d += 4) *(float4*)(ao + d) = make_float4(li * o[d], li * o[d + 1], li * o[d + 2], li * o[d + 3]);
}

__device__ __forceinline__ void phase_att(const Params& p, float* lds) {
    for (int pi = blockIdx.x; pi < 512; pi += gridDim.x) {
        nsa_item(p, pi, lds);
        moba_item(p, (pi & 256) | (255 - (pi & 255)));
    }
}

__device__ __forceinline__ void phase_g2(const Params& p, int l, float* lds) {
    const float* A = (const float*)(p.ws + WS_ATT); const float* W = p.in[14] + (size_t)l * D * D;
    const float* xin = l == 0 ? p.in[0] : p.out; float* XA = p.out;
    const float* mod = (const float*)(p.ws + WS_MOD) + (size_t)l * Bn * 6144 + 2 * D;
    auto al = [=](int r, int k) -> float4 { return *(const float4*)(A + (size_t)r * D + k); };
    auto bl = [=](int k, int n) -> float2 { return *(const float2*)(W + (size_t)k * D + n); };
    auto ep = [=](int r, int c, float v) { const int b = r / S; XA[(size_t)r * D + c] = xin[(size_t)r * D + c] + mod[(size_t)b * 6144 + c] * v; };
    for (int tile = blockIdx.x; tile < (T / 128) * (D / 64); tile += gridDim.x) {
        const int tm = tile / (D / 64), tn = tile % (D / 64);
        gemm_tile(lds, tm * 128, tn * 64, D, al, bl, ep);
    }
}

__device__ __forceinline__ void phase_r2(const Params& p, int l, float* lds) {
    const int tid = otid(), lane = tid & 63, wave = tid >> 6;
    const int gw = blockIdx.x * NW + wave, ngw = gridDim.x * NW;
    const float* mod = (const float*)(p.ws + WS_MOD);
    const float* XA = p.out; float* H = (float*)(p.ws + WS_H);
    const float* lng = p.in[5] + (size_t)l * D; const float* rw = p.in[15] + (size_t)l * D * NE; const float* rb = p.in[16] + l * NE;
    int* toke = (int*)(p.ws + WS_TOKE); float* tokw = (float*)(p.ws + WS_TOKW); int* cnt = (int*)(p.ws + WS_CNT) + l * 32;
    float* hrow = lds + wave * D;
    int* hist = (int*)(lds + NW * D);
    if (tid < 32) hist[tid] = 0;
    __syncthreads();
    for (int t = gw; t < T; t += ngw) {
        const int b = t / S;
        float4 v[4]; float ss = 0.f;
#pragma unroll
        for (int j = 0; j < 4; ++j) { v[j] = *(const float4*)(XA + (size_t)t * D + 4 * lane + 256 * j); ss += (v[j].x * v[j].x + v[j].y * v[j].y) + (v[j].z * v[j].z + v[j].w * v[j].w); }
        ss = wave_sum(ss);
        const float r = rsqrtf(ss * (1.f / D) + EPS);
        const float* sh = mod + ((size_t)l * Bn + b) * 6144 + 3 * D; const float* sc = mod + ((size_t)l * Bn + b) * 6144 + 4 * D;
#pragma unroll
        for (int j = 0; j < 4; ++j) {
            const int col = 4 * lane + 256 * j;
            const float4 g = *(const float4*)(lng + col), s1 = *(const float4*)(sc + col), s0 = *(const float4*)(sh + col);
            float4 o;
            o.x = v[j].x * r * g.x * (1.f + s1.x) + s0.x; o.y = v[j].y * r * g.y * (1.f + s1.y) + s0.y;
            o.z = v[j].z * r * g.z * (1.f + s1.z) + s0.z; o.w = v[j].w * r * g.w * (1.f + s1.w) + s0.w;
            *(float4*)(H + (size_t)t * D + col) = o;
            *(float4*)(hrow + col) = o;
        }
        asm volatile("s_waitcnt lgkmcnt(0)" ::: "memory");
        __builtin_amdgcn_wave_barrier();
        const int e = lane & 31, half = lane >> 5;
        float acc = 0.f;
        for (int k = half * 512; k < half * 512 + 512; ++k) acc += hrow[k] * rw[(size_t)k * NE + e];
        acc += __shfl_xor(acc, 32);
        const float logit = acc + rb[e];
        float lg[32];
#pragma unroll
        for (int i = 0; i < 32; ++i) lg[i] = __shfl(logit, i);
        int s0i = 0, s1i = 0, s2i = 0, s3i = 0; float a0 = -3e38f, a1 = -3e38f, a2 = -3e38f, a3 = -3e38f;
#pragma unroll
        for (int i = 0; i < 32; ++i) if (lg[i] > a0) { a0 = lg[i]; s0i = i; }
#pragma unroll
        for (int i = 0; i < 32; ++i) if (i != s0i && lg[i] > a1) { a1 = lg[i]; s1i = i; }
#pragma unroll
        for (int i = 0; i < 32; ++i) if (i != s0i && i != s1i && lg[i] > a2) { a2 = lg[i]; s2i = i; }
#pragma unroll
        for (int i = 0; i < 32; ++i) if (i != s0i && i != s1i && i != s2i && lg[i] > a3) { a3 = lg[i]; s3i = i; }
        const float e0 = 1.f, e1 = __expf(a1 - a0), e2 = __expf(a2 - a0), e3 = __expf(a3 - a0);
        const float inv = 1.f / (((e0 + e1) + e2) + e3);
        if (lane == 0) {
            toke[t * 4 + 0] = s0i; toke[t * 4 + 1] = s1i; toke[t * 4 + 2] = s2i; toke[t * 4 + 3] = s3i;
            tokw[t * 4 + 0] = e0 * inv; tokw[t * 4 + 1] = e1 * inv; tokw[t * 4 + 2] = e2 * inv; tokw[t * 4 + 3] = e3 * inv;
            atomicAdd(&hist[s0i], 1); atomicAdd(&hist[s1i], 1); atomicAdd(&hist[s2i], 1); atomicAdd(&hist[s3i], 1);
        }
        __builtin_amdgcn_wave_barrier();
    }
    __syncthreads();
    if (tid < 32 && hist[tid] != 0) atomicAdd(&cnt[tid], hist[tid]);
}

__device__ __forceinline__ void load_pstart(const Params& p, int l, int* ps) {
    const int* cnt = (const int*)(p.ws + WS_CNT) + l * 32;
    if (otid() == 0) { int s = 0; for (int e = 0; e < 32; ++e) { ps[e] = s; s += (cnt[e] + 255) & ~255; } ps[32] = s; }
    __syncthreads();
}

__device__ __forceinline__ void phase_sc(const Params& p, int l, float* lds) {
    int* ps = (int*)lds;
    load_pstart(p, l, ps);
    const int gtid = blockIdx.x * NT + otid(), gsz = gridDim.x * NT;
    const int* toke = (const int*)(p.ws + WS_TOKE); const float* tokw = (const float*)(p.ws + WS_TOKW);
    int* fill = (int*)(p.ws + WS_FILL) + l * 32; int* rowtok = (int*)(p.ws + WS_ROWTOK) + (size_t)l * RMAX; float* roww = (float*)(p.ws + WS_ROWW) + (size_t)l * RMAX;
    int* pos = (int*)(p.ws + WS_POS);
    for (int i = gtid; i < A_TOT; i += gsz) {
        const int e = toke[i];
        const int slot = ps[e] + atomicAdd(&fill[e], 1);
        rowtok[slot] = i >> 2; roww[slot] = tokw[i]; pos[i] = slot;
    }
    __syncthreads();
}

__device__ __forceinline__ void phase_m1(const Params& p, int l, float* lds) {
    int* ps = (int*)(lds + 16 * 132 + 16 * 68);
    load_pstart(p, l, ps);
    const int rused = ps[32];
    const float* H = (const float*)(p.ws + WS_H); float* U = (float*)(p.ws + WS_U);
    const int* rowtok = (const int*)(p.ws + WS_ROWTOK) + (size_t)l * RMAX;
    const int ntm = rused / 128, ntn = 2048 / 64;
    for (int tile = blockIdx.x; tile < ntm * ntn; tile += gridDim.x) {
        const int tm = tile / ntn, tn = tile % ntn;
        int e = 0; for (int i = 1; i < 32; ++i) if (ps[i] <= tm * 128) e = i;
        const float* W = p.in[17] + ((size_t)l * NE + e) * D * 2048; const float* b1 = p.in[18] + ((size_t)l * NE + e) * 2048;
        auto al = [=](int r, int k) -> float4 { const int tk = rowtok[r]; return tk >= 0 ? *(const float4*)(H + (size_t)tk * D + k) : make_float4(0.f, 0.f, 0.f, 0.f); };
        auto bl = [=](int k, int n) -> float2 { return *(const float2*)(W + (size_t)k * 2048 + n); };
        auto ep = [=](int r, int c, float v) { U[(size_t)r * 2048 + c] = v + b1[c]; };
        gemm_tile(lds, tm * 128, tn * 64, D, al, bl, ep);
    }
    __syncthreads();
}
__device__ __forceinline__ void phase_m2(const Params& p, int l, float* lds) {
    int* ps = (int*)(lds + 16 * 132 + 16 * 68);
    load_pstart(p, l, ps);
    const int rused = ps[32];
    const float* U = (const float*)(p.ws + WS_U); float* Y = (float*)(p.ws + WS_Y);
    const float* roww = (const float*)(p.ws + WS_ROWW) + (size_t)l * RMAX;
    const int ntm = rused / 128, ntn = D / 64;
    for (int tile = blockIdx.x; tile < ntm * ntn; tile += gridDim.x) {
        const int tm = tile / ntn, tn = tile % ntn;
        int e = 0; for (int i = 1; i < 32; ++i) if (ps[i] <= tm * 128) e = i;
        const float* W = p.in[19] + ((size_t)l * NE + e) * DFF * D; const float* b2 = p.in[20] + ((size_t)l * NE + e) * D;
        auto al = [=](int r, int k) -> float4 {
            const float4 gg = *(const float4*)(U + (size_t)r * 2048 + k), ll = *(const float4*)(U + (size_t)r * 2048 + 1024 + k);
            const float g_[4] = {gg.x, gg.y, gg.z, gg.w}, l_[4] = {ll.x, ll.y, ll.z, ll.w}; float o_[4];
#pragma unroll
            for (int i = 0; i < 4; ++i) { const float gc = fminf(g_[i], 7.f), lc = fminf(fmaxf(l_[i], -7.f), 7.f); o_[i] = (lc + 1.f) * gc * sigmoidf_(1.702f * gc); }
            return make_float4(o_[0], o_[1], o_[2], o_[3]);
        };
        auto bl = [=](int k, int n) -> float2 { return *(const float2*)(W + (size_t)k * D + n); };
        auto ep = [=](int r, int c, float v) { Y[(size_t)r * D + c] = (v + b2[c]) * roww[r]; };
        gemm_tile(lds, tm * 128, tn * 64, DFF, al, bl, ep);
    }
    __syncthreads();
}

__global__ void __launch_bounds__(NT) mega_fwd(Params p) {
    extern __shared__ __attribute__((aligned(16))) unsigned char lds_raw[];
    float* lds = (float*)lds_raw;
    cg::grid_group grid = cg::this_grid();
    phase_p0a(p, lds);
    grid.sync();
    phase_p0b(p);
    grid.sync();
    _Pragma("unroll 1") for (int l = 0; l < L; ++l) {
        phase_r1(p, l, true);
        grid.sync();
        phase_g1(p, l, lds);
        grid.sync();
        phase_zp(p, l);
        grid.sync();
        phase_ck(p, l, lds);
        grid.sync();
        phase_c2(p, l);
        grid.sync();
        phase_att(p, lds);
        grid.sync();
        phase_g2(p, l, lds);
        grid.sync();
        phase_r2(p, l, lds);
        grid.sync();
        phase_sc(p, l, lds);
        grid.sync();
        phase_m1(p, l, lds);
        grid.sync();
        phase_m2(p, l, lds);
        grid.sync();
    }
    phase_r1(p, L, false);
}

extern "C" void kernel_launch(void* const* d_in, const int* in_sizes, int n_in, void* d_out, int out_size, void* d_ws, size_t ws_size, hipStream_t stream) {
    static int grid_blocks = 0;
    if (grid_blocks == 0) {
        if (n_in != 21 || out_size != T * D || ws_size < WS_END) { fprintf(stderr, "kernel_launch: unexpected shapes (n_in %d out %d ws %zu need %zu)\n", n_in, out_size, ws_size, (size_t)WS_END); grid_blocks = -1; return; }
        int dev = 0, cus = 0, per_cu = 0;
        hipGetDevice(&dev);
        hipDeviceGetAttribute(&cus, hipDeviceAttributeMultiprocessorCount, dev);
        hipFuncSetAttribute((const void*)mega_fwd, hipFuncAttributeMaxDynamicSharedMemorySize, LDS_BYTES);
        hipOccupancyMaxActiveBlocksPerMultiprocessor(&per_cu, (const void*)mega_fwd, NT, LDS_BYTES);
        if (per_cu < 1) { fprintf(stderr, "kernel_launch: occupancy query says %d blocks per CU\n", per_cu); per_cu = 1; }
        (void)hipGetLastError();
        grid_blocks = cus * 1;
    }
    if (grid_blocks < 0) return;
    Params p{};
    for (int i = 0; i < 21; ++i) p.in[i] = (const float*)d_in[i];
    p.out = (float*)d_out; p.ws = (unsigned char*)d_ws;
    void* args[] = {&p};
    hipError_t e = hipLaunchCooperativeKernel((const void*)mega_fwd, dim3(grid_blocks), dim3(NT), args, LDS_BYTES, stream);
    if (e != hipSuccess) fprintf(stderr, "cooperative launch failed: %s (grid %d)\n", hipGetErrorString(e), grid_blocks);
}
```

```cpp
#include <hip/hip_runtime.h>
#include <hip/hip_cooperative_groups.h>
#include <cstdio>
#include <cstdint>
namespace cg = cooperative_groups;

constexpr int Bn = 2, S = 8192, D = 1024, L = 2, T = Bn * S;
constexpr int INW = 2840;
constexpr int NE = 32, TOPK = 4, DFF = 1024;
constexpr int A_TOT = T * TOPK;
constexpr int RMAX = A_TOT + NE * 256;
constexpr int NCMP = 511;
constexpr int NT = 512;
constexpr int NW = NT / 64;
constexpr int LDS_BYTES = 147456;
constexpr float EPS = 1e-6f;
constexpr float NEGF = -1e30f;

#ifndef FAST_G1
#define FAST_G1 1
#endif
#ifndef FAST_G2
#define FAST_G2 1
#endif
#ifndef FAST_MOE
#define FAST_MOE 1
#endif
constexpr int ZBW = 3072;
constexpr int ZC_Q = 0, ZC_KC = 512, ZC_VC = 640, ZC_KS = 768, ZC_VS = 896, ZC_KW = 1024, ZC_VW = 1152, ZC_G = 1280, ZC_MQ = 1304, ZC_MK = 1816, ZC_MV = 2328;

constexpr size_t al256(size_t x) { return (x + 255) & ~(size_t)255; }
constexpr size_t WS_MODP = 0;
constexpr size_t WS_MOD = al256(WS_MODP + (size_t)8 * L * Bn * 6144 * 4);
constexpr size_t WS_CNT = al256(WS_MOD + (size_t)L * Bn * 6144 * 4);
constexpr size_t WS_FILL = al256(WS_CNT + L * 32 * 4);
constexpr size_t WS_ROWTOK = al256(WS_FILL + L * 32 * 4);
constexpr size_t WS_ROWW = al256(WS_ROWTOK + (size_t)L * RMAX * 4);
constexpr size_t WS_TOKE = al256(WS_ROWW + (size_t)L * RMAX * 4);
constexpr size_t WS_TOKW = al256(WS_TOKE + (size_t)T * 4 * 4);
constexpr size_t WS_POS = al256(WS_TOKW + (size_t)T * 4 * 4);
constexpr size_t WS_HID = al256(WS_POS + (size_t)T * 4 * 4);
constexpr size_t WS_KC = al256(WS_HID + (size_t)2 * 2044 * 128 * 4);
constexpr size_t WS_VC = al256(WS_KC + (size_t)2044 * 64 * 4);
constexpr size_t WS_KM = al256(WS_VC + (size_t)2044 * 64 * 4);
constexpr size_t WS_H = al256(WS_KM + (size_t)Bn * 8 * 32 * 64 * 4);
constexpr size_t WS_Z = al256(WS_H + (size_t)T * D * 4);
constexpr size_t WS_ATT = al256(WS_Z + (size_t)T * INW * 4);
constexpr size_t WS_U = al256(WS_ATT + (size_t)T * D * 4);
constexpr size_t WS_Y = al256(WS_U + (FAST_MOE ? (size_t)0 : (size_t)RMAX * 2048 * 4));
constexpr size_t WS_WINT = al256(WS_Y + (size_t)RMAX * 1024 * 4);
constexpr size_t WS_WOT = al256(WS_WINT + (size_t)L * 3072 * 1024 * 2);
constexpr size_t WS_W1T = al256(WS_WOT + (size_t)L * 1024 * 1024 * 2);
constexpr size_t WS_W2T = al256(WS_W1T + (size_t)L * NE * 2048 * 1024 * 2);
constexpr size_t WS_XN = al256(WS_W2T + (size_t)L * NE * 1024 * 1024 * 2);
constexpr size_t WS_ATTB = al256(WS_XN + (size_t)(T + 1) * D * 2);
constexpr size_t WS_ACT = al256(WS_ATTB + (size_t)T * D * 2);
constexpr size_t WS_END = al256(WS_ACT + (size_t)RMAX * DFF * 2);

struct Params {
    const float* in[21];
    float* out;
    unsigned char* ws;
};

__device__ __forceinline__ int otid() { int t = threadIdx.x; asm volatile("" : "+v"(t)); return t; }
typedef unsigned short bf16_t;
__device__ __forceinline__ unsigned f2bf(float f) { unsigned u = __builtin_bit_cast(unsigned, f); return (u + 0x7fffu + ((u >> 16) & 1u)) >> 16; }
__device__ __forceinline__ unsigned pk2(float lo, float hi) { return f2bf(lo) | (f2bf(hi) << 16); }
__device__ __forceinline__ float wave_sum(float v) {
#pragma unroll
    for (int o = 1; o < 64; o <<= 1) v += __shfl_xor(v, o);
    return v;
}
__device__ __forceinline__ float sigmoidf_(float x) { return 1.f / (1.f + __expf(-x)); }
__device__ __forceinline__ float gelu_tanh(float x) {
    const float u = 0.7978845608028654f * (x + 0.044715f * x * x * x);
    return 0.5f * x * (1.f + tanhf(u));
}

template <class AL, class BL, class EP>
__device__ __forceinline__ void gemm_tile(float* lds, int m0, int n0, int K, const AL& al, const BL& bl, const EP& ep) {
    float* As = lds;
    float* Bs = lds + 16 * 132;
    const int tid = otid(), tx = tid & 15, ty = tid >> 4;
    const int ar = tid >> 2, ak = (tid & 3) * 4;
    const int bk = tid >> 5, bn = (tid & 31) * 2;
    float acc[4][4];
#pragma unroll
    for (int i = 0; i < 4; ++i)
#pragma unroll
        for (int j = 0; j < 4; ++j) acc[i][j] = 0.f;
    float4 av = al(m0 + ar, ak);
    float2 bv = bl(bk, n0 + bn);
    for (int k0 = 0; k0 < K; k0 += 16) {
        As[(ak + 0) * 132 + ar] = av.x; As[(ak + 1) * 132 + ar] = av.y; As[(ak + 2) * 132 + ar] = av.z; As[(ak + 3) * 132 + ar] = av.w;
        *(float2*)&Bs[bk * 68 + bn] = bv;
        __syncthreads();
        if (k0 + 16 < K) { av = al(m0 + ar, k0 + 16 + ak); bv = bl(k0 + 16 + bk, n0 + bn); }
#pragma unroll
        for (int kk = 0; kk < 16; ++kk) {
            const float4 a = *(const float4*)&As[kk * 132 + ty * 4];
            const float4 b = *(const float4*)&Bs[kk * 68 + tx * 4];
            const float a_[4] = {a.x, a.y, a.z, a.w}, b_[4] = {b.x, b.y, b.z, b.w};
#pragma unroll
            for (int i = 0; i < 4; ++i)
#pragma unroll
                for (int j = 0; j < 4; ++j) acc[i][j] += a_[i] * b_[j];
        }
        __syncthreads();
    }
#pragma unroll
    for (int i = 0; i < 4; ++i)
#pragma unroll
        for (int j = 0; j < 4; ++j) ep(m0 + ty * 4 + i, n0 + tx * 4 + j, acc[i][j]);
}

__device__ __forceinline__ void phase_p0a(const Params& p, float* lds) {
    const int tid = otid(), gtid = blockIdx.x * NT + tid, gsz = gridDim.x * NT;
    int* cnt = (int*)(p.ws + WS_CNT); int* fill = (int*)(p.ws + WS_FILL); int* rowtok = (int*)(p.ws + WS_ROWTOK);
    for (int i = gtid; i < L * 32; i += gsz) { cnt[i] = 0; fill[i] = 0; }
    for (int i = gtid; i < L * RMAX; i += gsz) rowtok[i] = -1;
    const float* c = p.in[1];
    for (int i = tid; i < Bn * D; i += NT) { const float v = c[i]; lds[i] = v / (1.f + __expf(-v)); }
    __syncthreads();
    const float* ada_w = p.in[2];
    float* modp = (float*)(p.ws + WS_MODP);
    for (int idx = gtid; idx < 8 * L * 6144; idx += gsz) {
        const int col = idx % 6144, l = (idx / 6144) % L, kc = idx / (6144 * L);
        const float* w = ada_w + ((size_t)l * D + kc * 128) * 6144 + col;
        float a0 = 0.f, a1 = 0.f;
#pragma unroll 8
        for (int k = 0; k < 128; ++k) { const float wv = w[(size_t)k * 6144]; a0 += lds[kc * 128 + k] * wv; a1 += lds[D + kc * 128 + k] * wv; }
        modp[((size_t)(kc * L + l) * Bn + 0) * 6144 + col] = a0;
        modp[((size_t)(kc * L + l) * Bn + 1) * 6144 + col] = a1;
    }
}
__device__ __forceinline__ void phase_p0b(const Params& p) {
    const int gtid = blockIdx.x * NT + otid(), gsz = gridDim.x * NT;
    const float* modp = (const float*)(p.ws + WS_MODP); float* mod = (float*)(p.ws + WS_MOD); const float* ada_b = p.in[3];
    for (int idx = gtid; idx < L * Bn * 6144; idx += gsz) {
        const int col = idx % 6144, l = idx / (Bn * 6144);
        float s = ada_b[l * 6144 + col];
#pragma unroll
        for (int kc = 0; kc < 8; ++kc) s += modp[(size_t)kc * L * Bn * 6144 + idx];
        mod[idx] = s;
    }
}

__device__ __forceinline__ void phase_r1(const Params& p, int l, bool do_h) {
    const int lane = otid() & 63, wave = otid() >> 6;
    const int gw = blockIdx.x * NW + wave, ngw = gridDim.x * NW;
    const float* mod = (const float*)(p.ws + WS_MOD);
    const float* xin = p.in[0]; float* XA = p.out; float* H = (float*)(p.ws + WS_H);
    const float* Y = (const float*)(p.ws + WS_Y); const int* pos = (const int*)(p.ws + WS_POS);
    const float* lng = p.in[4] + (size_t)(do_h ? l : 0) * D;
    bf16_t* XN = (bf16_t*)(p.ws + WS_XN);
    for (int t = gw; t < T; t += ngw) {
        const int b = t / S;
        float4 v[4];
        if (l == 0) {
#pragma unroll
            for (int j = 0; j < 4; ++j) v[j] = *(const float4*)(xin + (size_t)t * D + 4 * lane + 256 * j);
        } else {
            const float* g2 = mod + ((size_t)(l - 1) * Bn + b) * 6144 + 5 * D;
            const int p0 = pos[t * 4 + 0], p1 = pos[t * 4 + 1], p2 = pos[t * 4 + 2], p3 = pos[t * 4 + 3];
#pragma unroll
            for (int j = 0; j < 4; ++j) {
                const int col = 4 * lane + 256 * j;
                const float4 x = *(const float4*)(XA + (size_t)t * D + col);
                const float4 y0 = *(const float4*)(Y + (size_t)p0 * D + col), y1 = *(const float4*)(Y + (size_t)p1 * D + col);
                const float4 y2 = *(const float4*)(Y + (size_t)p2 * D + col), y3 = *(const float4*)(Y + (size_t)p3 * D + col);
                const float4 g = *(const float4*)(g2 + col);
                float4 r;
                r.x = x.x + g.x * (((y0.x + y1.x) + y2.x) + y3.x); r.y = x.y + g.y * (((y0.y + y1.y) + y2.y) + y3.y);
                r.z = x.z + g.z * (((y0.z + y1.z) + y2.z) + y3.z); r.w = x.w + g.w * (((y0.w + y1.w) + y2.w) + y3.w);
                v[j] = r;
                *(float4*)(XA + (size_t)t * D + col) = r;
            }
        }
        if (do_h) {
            float ss = 0.f;
#pragma unroll
            for (int j = 0; j < 4; ++j) ss += (v[j].x * v[j].x + v[j].y * v[j].y) + (v[j].z * v[j].z + v[j].w * v[j].w);
            ss = wave_sum(ss);
            const float r = rsqrtf(ss * (1.f / D) + EPS);
            const float* sh = mod + ((size_t)l * Bn + b) * 6144 + 0 * D; const float* sc = mod + ((size_t)l * Bn + b) * 6144 + 1 * D;
#pragma unroll
            for (int j = 0; j < 4; ++j) {
                const int col = 4 * lane + 256 * j;
                const float4 g = *(const float4*)(lng + col), s1 = *(const float4*)(sc + col), s0 = *(const float4*)(sh + col);
                float4 o;
                o.x = v[j].x * r * g.x * (1.f + s1.x) + s0.x; o.y = v[j].y * r * g.y * (1.f + s1.y) + s0.y;
                o.z = v[j].z * r * g.z * (1.f + s1.z) + s0.z; o.w = v[j].w * r * g.w * (1.f + s1.w) + s0.w;
                *(float4*)(H + (size_t)t * D + col) = o;
                *(uint2*)(XN + (size_t)t * D + col) = make_uint2(pk2(o.x, o.y), pk2(o.z, o.w));
            }
        }
    }
}

__device__ __forceinline__ void phase_g1(const Params& p, int l, float* lds) {
    const float* H = (const float*)(p.ws + WS_H); const float* W = p.in[6] + (size_t)l * D * INW; float* Z = (float*)(p.ws + WS_Z);
    constexpr int NTN = (INW + 63) / 64, NTM = T / 128;
    auto al = [=](int r, int k) -> float4 { return *(const float4*)(H + (size_t)r * D + k); };
    auto bl = [=](int k, int n) -> float2 { return n < INW ? *(const float2*)(W + (size_t)k * INW + n) : make_float2(0.f, 0.f); };
    auto ep = [=](int r, int c, float v) { if (c < INW) Z[(size_t)r * INW + c] = v; };
    for (int tile = blockIdx.x; tile < NTM * NTN; tile += gridDim.x) {
        const int tm = tile / NTN, tn = tile % NTN;
        gemm_tile(lds, tm * 128, tn * 64, D, al, bl, ep);
    }
}

__device__ __forceinline__ void phase_zp(const Params& p, int l) {
    const int lane = otid() & 63, wave = otid() >> 6;
    const int gw = blockIdx.x * NW + wave, ngw = gridDim.x * NW;
    float* Z = (float*)(p.ws + WS_Z);
    const float gq = p.in[7][l * 64 + lane], gk = p.in[8][l * 64 + lane], gmq = p.in[12][l * 64 + lane], gmk = p.in[13][l * 64 + lane];
    for (int t = gw; t < T; t += ngw) {
        float* z = Z + (size_t)t * INW;
        for (int seg = 0; seg < 28; ++seg) {
            int col; float g;
            if (seg < 8) { col = ZC_Q + seg * 64; g = gq; }
            else if (seg < 10) { col = ZC_KS + (seg - 8) * 64; g = gk; }
            else if (seg < 12) { col = ZC_KW + (seg - 10) * 64; g = gk; }
            else if (seg < 20) { col = ZC_MQ + (seg - 12) * 64; g = gmq; }
            else { col = ZC_MK + (seg - 20) * 64; g = gmk; }
            const float v = z[col + lane];
            const float ss = wave_sum(v * v);
            z[col + lane] = v * rsqrtf(ss * (1.f / 64.f) + EPS) * g;
        }
        if (lane < 24) z[ZC_G + lane] = sigmoidf_(z[ZC_G + lane]);
    }
}

__device__ __forceinline__ void phase_ck(const Params& p, int l, float* lds) {
    const float* Z = (const float*)(p.ws + WS_Z);
    float* HID = (float*)(p.ws + WS_HID);
    const float* posw = p.in[9] + (size_t)l * 2 * 32 * 64; const float* w1 = p.in[10] + (size_t)l * 2 * 2048 * 128;
    for (int tile = blockIdx.x; tile < 64; tile += gridDim.x) {
        const int idx = tile / 32, tm = (tile % 32) / 2, tn = tile % 2;
        const float* W = w1 + (size_t)idx * 2048 * 128; const float* PW = posw + (size_t)idx * 32 * 64; float* HO = HID + (size_t)idx * 2044 * 128;
        auto al = [=](int r, int k) -> float4 {
            if (r >= 2044) return make_float4(0.f, 0.f, 0.f, 0.f);
            const int b = r / 1022, g = (r / 511) & 1, n = r % 511, li = k >> 6, d = k & 63;
            const float4 a = *(const float4*)(Z + (size_t)(b * S + 16 * n + li) * INW + ZC_KC + idx * 128 + g * 64 + d);
            const float4 q = *(const float4*)(PW + li * 64 + d);
            return make_float4(a.x + q.x, a.y + q.y, a.z + q.z, a.w + q.w);
        };
        auto bl = [=](int k, int n) -> float2 { return *(const float2*)(W + (size_t)k * 128 + n); };
        auto ep = [=](int r, int c, float v) { if (r < 2044) HO[(size_t)r * 128 + c] = gelu_tanh(v); };
        gemm_tile(lds, tm * 128, tn * 64, 2048, al, bl, ep);
    }
    const int lane = otid() & 63, wave = otid() >> 6;
    float* KM = (float*)(p.ws + WS_KM);
    for (int it = blockIdx.x * NW + wave; it < Bn * 8 * 32; it += gridDim.x * NW) {
        const int b = it / 256, h = (it / 32) & 7, blk = it & 31;
        const float* base = Z + (size_t)(b * S + blk * 256) * INW + ZC_MK + h * 64 + lane;
        float s = 0.f;
        for (int i = 0; i < 256; ++i) s += base[(size_t)i * INW];
        KM[(size_t)it * 64 + lane] = s * (1.f / 256.f);
    }
}
__device__ __forceinline__ void phase_c2(const Params& p, int l) {
    const int lane = otid() & 63, wave = otid() >> 6;
    const float* HID = (const float*)(p.ws + WS_HID); const float* w2 = p.in[11] + (size_t)l * 2 * 128 * 64;
    float* KC = (float*)(p.ws + WS_KC); float* VC = (float*)(p.ws + WS_VC);
    const float gk = p.in[8][l * 64 + lane];
    for (int r = blockIdx.x * NW + wave; r < 2 * 2044; r += gridDim.x * NW) {
        const int idx = r / 2044, rr = r % 2044;
        const float* hrow = HID + (size_t)r * 128; const float* W = w2 + (size_t)idx * 128 * 64;
        float s = 0.f;
        for (int j = 0; j < 128; ++j) s += hrow[j] * W[j * 64 + lane];
        if (idx == 0) { const float ss = wave_sum(s * s); KC[(size_t)rr * 64 + lane] = s * rsqrtf(ss * (1.f / 64.f) + EPS) * gk; }
        else VC[(size_t)rr * 64 + lane] = s;
    }
}

#define ATT_KEY(valid, kp, vp, bias)                                                              \
    {                                                                                             \
        float s_ = 0.f;                                                                           \
        _Pragma("unroll") for (int d = 0; d < 32; ++d) s_ += qv[d] * (kp)[d];                     \
        s_ += __shfl_xor(s_, 1);                                                                  \
        s_ = s_ * 0.125f - (bias);                                                                \
        if (valid) {                                                                              \
            if (s_ > m) { const float cf = __expf(m - s_); lsum *= cf; _Pragma("unroll") for (int d = 0; d < 32; ++d) o[d] *= cf; m = s_; } \
            const float p_ = __expf(s_ - m); lsum += p_;                                          \
            _Pragma("unroll") for (int d = 0; d < 32; ++d) o[d] += p_ * (vp)[d];                  \
        }                                                                                         \
    }

__device__ __forceinline__ void nsa_item(const Params& p, int item, float* lds) {
    const int tid = otid(), q = (tid & 63) >> 1, half = tid & 1, h = __builtin_amdgcn_readfirstlane(tid >> 6), g = h >> 2, hg = h & 3;
    const int b = item >> 8, ci = item & 255, t0 = ci * 32, t = t0 + q, cur = t0 >> 6; const size_t tt = (size_t)b * S + t;
    const float* Z = (const float*)(p.ws + WS_Z); float* ATT = (float*)(p.ws + WS_ATT);
    const float* KC = (const float*)(p.ws + WS_KC) + (size_t)(b * 2 + g) * NCMP * 64 + half * 32; const float* VC = (const float*)(p.ws + WS_VC) + (size_t)(b * 2 + g) * NCMP * 64 + half * 32;
    float* imp = lds;
    unsigned* selm = (unsigned*)(lds + 2 * 32 * 129);
    const float slope = exp2f(-(float)(h + 1));
    float qv[32], o[32];
#pragma unroll
    for (int d = 0; d < 32; d += 4) { const float4 v = *(const float4*)(Z + tt * INW + ZC_Q + h * 64 + half * 32 + d); qv[d] = v.x; qv[d + 1] = v.y; qv[d + 2] = v.z; qv[d + 3] = v.w; }
    const float g0 = Z[tt * INW + ZC_G + h * 3 + 0], g1 = Z[tt * INW + ZC_G + h * 3 + 1], g2 = Z[tt * INW + ZC_G + h * 3 + 2];
    for (int i = tid; i < 2 * 32 * 129; i += NT) imp[i] = 0.f;
    const int cnt_t = t >= 31 ? (t - 31) / 16 + 1 : 0;
    const int cnt_max = (t0 + 31 - 31) / 16 + 1;
    float m = NEGF, lsum = 0.f;
    _Pragma("unroll 1") for (int n = 0; n < cnt_max; ++n) {
        const float* kp = KC + (size_t)n * 64;
        float s_ = 0.f;
#pragma unroll
        for (int d = 0; d < 32; ++d) s_ += qv[d] * kp[d];
        s_ += __shfl_xor(s_, 1);
        s_ = s_ * 0.125f - slope * ((float)t - (16.f * n + 15.5f));
        if (n < cnt_t) { if (s_ > m) { lsum *= __expf(m - s_); m = s_; } lsum += __expf(s_ - m); }
    }
    const float linv = lsum > 0.f ? 1.f / lsum : 0.f;
#pragma unroll
    for (int d = 0; d < 32; ++d) o[d] = 0.f;
    __syncthreads();
    _Pragma("unroll 1") for (int r = 0; r < 4; ++r) {
        if (hg == r) {
            float* myimp = imp + (size_t)(g * 32 + q) * 129;
            _Pragma("unroll 1") for (int n = 0; n < cnt_max; ++n) {
                const float* kp = KC + (size_t)n * 64; const float* vp = VC + (size_t)n * 64;
                float s_ = 0.f;
#pragma unroll
                for (int d = 0; d < 32; ++d) s_ += qv[d] * kp[d];
                s_ += __shfl_xor(s_, 1);
                s_ = s_ * 0.125f - slope * ((float)t - (16.f * n + 15.5f));
                if (n < cnt_t) {
                    const float p_ = __expf(s_ - m) * linv;
#pragma unroll
                    for (int d = 0; d < 32; ++d) o[d] += p_ * vp[d];
                    if (half == 0) {
                        myimp[n >> 2] += p_;
                        if ((n & 3) == 3) myimp[(n + 1) >> 2] += p_;
                    }
                }
            }
        }
        __syncthreads();
    }
    {
        float* ao = ATT + tt * D + h * 64 + half * 32;
#pragma unroll
        for (int d = 0; d < 32; d += 4) *(float4*)(ao + d) = make_float4(g0 * o[d], g0 * o[d + 1], g0 * o[d + 2], g0 * o[d + 3]);
    }
    if (hg == 0 && half == 0) {
        float* myimp = imp + (size_t)(g * 32 + q) * 129;
        _Pragma("unroll 1") for (int j = 0; j < 128; ++j) {
            float v = myimp[j];
            if (j == 0 || j == cur || j == cur - 1) v = 1e4f;
            if (j > cur) v = NEGF;
            myimp[j] = v;
        }
        unsigned mk0 = 0u, mk1 = 0u, mk2 = 0u, mk3 = 0u;
        _Pragma("unroll 1") for (int it = 0; it < 16; ++it) {
            float best = -3e38f; int bi = -1;
            _Pragma("unroll 4") for (int j = 0; j < 128; ++j) { const float v = myimp[j]; if (v > best) { best = v; bi = j; } }
            if (best <= NEGF) break;
            myimp[bi] = -3.4e38f;
            const unsigned bit = 1u << (bi & 31);
            if ((bi >> 5) == 0) mk0 |= bit; else if ((bi >> 5) == 1) mk1 |= bit; else if ((bi >> 5) == 2) mk2 |= bit; else mk3 |= bit;
        }
        unsigned* sm = selm + (g * 32 + q) * 4;
        sm[0] = mk0; sm[1] = mk1; sm[2] = mk2; sm[3] = mk3;
    }
    __syncthreads();
    {
        const unsigned* sm = selm + (g * 32 + q) * 4;
        const unsigned m0 = sm[0], m1 = sm[1], m2 = sm[2], m3 = sm[3];
        m = NEGF; lsum = 0.f;
#pragma unroll
        for (int d = 0; d < 32; ++d) o[d] = 0.f;
        _Pragma("unroll 1") for (int j = 0; j <= cur; ++j) {
            const unsigned w = (j >> 5) == 0 ? m0 : (j >> 5) == 1 ? m1 : (j >> 5) == 2 ? m2 : m3;
            const bool sel = (w >> (j & 31)) & 1u;
            if (__ballot(sel) == 0ull) continue;
            _Pragma("unroll 1") for (int kk = 0; kk < 64; ++kk) {
                const int ps = j * 64 + kk;
                const float* kp = Z + (size_t)(b * S + ps) * INW + ZC_KS + g * 64 + half * 32; const float* vp = Z + (size_t)(b * S + ps) * INW + ZC_VS + g * 64 + half * 32;
                const bool valid = sel && ps <= t;
                ATT_KEY(valid, kp, vp, slope * (float)(t - ps));
            }
        }
        const float li = lsum > 0.f ? g1 / lsum : 0.f;
        float* ao = ATT + tt * D + h * 64 + half * 32;
#pragma unroll
        for (int d = 0; d < 32; d += 4) { float4 a = *(float4*)(ao + d); a.x += li * o[d]; a.y += li * o[d + 1]; a.z += li * o[d + 2]; a.w += li * o[d + 3]; *(float4*)(ao + d) = a; }
    }
    {
        m = NEGF; lsum = 0.f;
#pragma unroll
        for (int d = 0; d < 32; ++d) o[d] = 0.f;
        const int lo = t0 - 511 > 0 ? t0 - 511 : 0;
        _Pragma("unroll 1") for (int ps = lo; ps <= t0 + 31; ++ps) {
            const float* kp = Z + (size_t)(b * S + ps) * INW + ZC_KW + g * 64 + half * 32; const float* vp = Z + (size_t)(b * S + ps) * INW + ZC_VW + g * 64 + half * 32;
            const bool valid = ps <= t && ps > t - 512;
            ATT_KEY(valid, kp, vp, slope * (float)(t - ps));
        }
        const float li = lsum > 0.f ? g2 / lsum : 0.f;
        float* ao = ATT + tt * D + h * 64 + half * 32;
        bf16_t* ab = (bf16_t*)(p.ws + WS_ATTB) + tt * D + h * 64 + half * 32;
#pragma unroll
        for (int d = 0; d < 32; d += 4) { float4 a = *(float4*)(ao + d); a.x += li * o[d]; a.y += li * o[d + 1]; a.z += li * o[d + 2]; a.w += li * o[d + 3]; *(float4*)(ao + d) = a;
            *(uint2*)(ab + d) = make_uint2(pk2(a.x, a.y), pk2(a.z, a.w)); }
    }
    __syncthreads();
}

__device__ __forceinline__ void moba_item(const Params& p, int item) {
    const int tid = otid(), q = (tid & 63) >> 1, half = tid & 1, h = __builtin_amdgcn_readfirstlane(tid >> 6);
    const int b = item >> 8, ci = item & 255, t0 = ci * 32, t = t0 + q, cb = t0 >> 8; const size_t tt = (size_t)b * S + t;
    const float* Z = (const float*)(p.ws + WS_Z); float* ATT = (float*)(p.ws + WS_ATT);
    const float* KM = (const float*)(p.ws + WS_KM) + (size_t)(b * 8 + h) * 32 * 64 + half * 32;
    const float slope = exp2f(-(float)(h + 1));
    float qv[32], o[32];
#pragma unroll
    for (int d = 0; d < 32; d += 4) { const float4 v = *(const float4*)(Z + tt * INW + ZC_MQ + h * 64 + half * 32 + d); qv[d] = v.x; qv[d + 1] = v.y; qv[d + 2] = v.z; qv[d + 3] = v.w; }
    float v1 = NEGF, v2 = NEGF, v3 = NEGF; int i1 = -1, i2 = -1, i3 = -1;
    _Pragma("unroll 1") for (int n = 0; n < cb; ++n) {
        const float* kp = KM + n * 64;
        float s_ = 0.f;
#pragma unroll
        for (int d = 0; d < 32; ++d) s_ += qv[d] * kp[d];
        s_ += __shfl_xor(s_, 1);
        if (s_ > v1) { v3 = v2; i3 = i2; v2 = v1; i2 = i1; v1 = s_; i1 = n; }
        else if (s_ > v2) { v3 = v2; i3 = i2; v2 = s_; i2 = n; }
        else if (s_ > v3) { v3 = s_; i3 = n; }
    }
    float m = NEGF, lsum = 0.f;
#pragma unroll
    for (int d = 0; d < 32; ++d) o[d] = 0.f;
    _Pragma("unroll 1") for (int n = 0; n < cb; ++n) {
        const bool sel = (n == i1) || (n == i2) || (n == i3);
        if (__ballot(sel) == 0ull) continue;
        _Pragma("unroll 1") for (int kk = 0; kk < 256; ++kk) {
            const int ps = n * 256 + kk;
            const float* kp = Z + (size_t)(b * S + ps) * INW + ZC_MK + h * 64 + half * 32; const float* vp = Z + (size_t)(b * S + ps) * INW + ZC_MV + h * 64 + half * 32;
            ATT_KEY(sel, kp, vp, slope * (float)(t - ps));
        }
    }
    _Pragma("unroll 1") for (int ps = cb * 256; ps <= t0 + 31; ++ps) {
        const float* kp = Z + (size_t)(b * S + ps) * INW + ZC_MK + h * 64 + half * 32; const float* vp = Z + (size_t)(b * S + ps) * INW + ZC_MV + h * 64 + half * 32;
        const bool valid = ps <= t;
        ATT_KEY(valid, kp, vp, slope * (float)(t - ps));
    }
    const float li = lsum > 0.f ? 1.f / lsum : 0.f;
    float* ao = ATT + tt * D + 512 + h * 64 + half * 32;
#pragma unroll
    for (int d = 0; d < 32; d += 4) *(float4*)(ao + d) = make_float4(li * o[d], li * o[d + 1], li * o[d + 2], li * o[d + 3]);
    bf16_t* ab = (bf16_t*)(p.ws + WS_ATTB) + tt * D + 512 + h * 64 + half * 32;
#pragma unroll
    for (int d = 0; d < 32; d += 4) *(uint2*)(ab + d) = make_uint2(pk2(li * o[d], li * o[d + 1]), pk2(li * o[d + 2], li * o[d + 3]));
}

__device__ __forceinline__ void phase_att(const Params& p, float* lds) {
    for (int pi = blockIdx.x; pi < 512; pi += gridDim.x) {
        nsa_item(p, pi, lds);
        moba_item(p, (pi & 256) | (255 - (pi & 255)));
    }
}

__device__ __forceinline__ void phase_g2(const Params& p, int l, float* lds) {
    const float* A = (const float*)(p.ws + WS_ATT); const float* W = p.in[14] + (size_t)l * D * D;
    const float* xin = l == 0 ? p.in[0] : p.out; float* XA = p.out;
    const float* mod = (const float*)(p.ws + WS_MOD) + (size_t)l * Bn * 6144 + 2 * D;
    auto al = [=](int r, int k) -> float4 { return *(const float4*)(A + (size_t)r * D + k); };
    auto bl = [=](int k, int n) -> float2 { return *(const float2*)(W + (size_t)k * D + n); };
    auto ep = [=](int r, int c, float v) { const int b = r / S; XA[(size_t)r * D + c] = xin[(size_t)r * D + c] + mod[(size_t)b * 6144 + c] * v; };
    for (int tile = blockIdx.x; tile < (T / 128) * (D / 64); tile += gridDim.x) {
        const int tm = tile / (D / 64), tn = tile % (D / 64);
        gemm_tile(lds, tm * 128, tn * 64, D, al, bl, ep);
    }
}

__device__ __forceinline__ void phase_r2(const Params& p, int l, float* lds) {
    const int tid = otid(), lane = tid & 63, wave = tid >> 6;
    const int gw = blockIdx.x * NW + wave, ngw = gridDim.x * NW;
    const float* mod = (const float*)(p.ws + WS_MOD);
    const float* XA = p.out; float* H = (float*)(p.ws + WS_H);
    const float* lng = p.in[5] + (size_t)l * D; const float* rw = p.in[15] + (size_t)l * D * NE; const float* rb = p.in[16] + l * NE;
    int* toke = (int*)(p.ws + WS_TOKE); float* tokw = (float*)(p.ws + WS_TOKW); int* cnt = (int*)(p.ws + WS_CNT) + l * 32;
    bf16_t* XN = (bf16_t*)(p.ws + WS_XN);
    float* hrow = lds + wave * D;
    int* hist = (int*)(lds + NW * D);
    if (tid < 32) hist[tid] = 0;
    __syncthreads();
    for (int t = gw; t < T; t += ngw) {
        const int b = t / S;
        float4 v[4]; float ss = 0.f;
#pragma unroll
        for (int j = 0; j < 4; ++j) { v[j] = *(const float4*)(XA + (size_t)t * D + 4 * lane + 256 * j); ss += (v[j].x * v[j].x + v[j].y * v[j].y) + (v[j].z * v[j].z + v[j].w * v[j].w); }
        ss = wave_sum(ss);
        const float r = rsqrtf(ss * (1.f / D) + EPS);
        const float* sh = mod + ((size_t)l * Bn + b) * 6144 + 3 * D; const float* sc = mod + ((size_t)l * Bn + b) * 6144 + 4 * D;
#pragma unroll
        for (int j = 0; j < 4; ++j) {
            const int col = 4 * lane + 256 * j;
            const float4 g = *(const float4*)(lng + col), s1 = *(const float4*)(sc + col), s0 = *(const float4*)(sh + col);
            float4 o;
            o.x = v[j].x * r * g.x * (1.f + s1.x) + s0.x; o.y = v[j].y * r * g.y * (1.f + s1.y) + s0.y;
            o.z = v[j].z * r * g.z * (1.f + s1.z) + s0.z; o.w = v[j].w * r * g.w * (1.f + s1.w) + s0.w;
            *(float4*)(H + (size_t)t * D + col) = o;
            *(uint2*)(XN + (size_t)t * D + col) = make_uint2(pk2(o.x, o.y), pk2(o.z, o.w));
            *(float4*)(hrow + col) = o;
        }
        asm volatile("s_waitcnt lgkmcnt(0)" ::: "memory");
        __builtin_amdgcn_wave_barrier();
        const int e = lane & 31, half = lane >> 5;
        float acc = 0.f;
        for (int k = half * 512; k < half * 512 + 512; ++k) acc += hrow[k] * rw[(size_t)k * NE + e];
        acc += __shfl_xor(acc, 32);
        const float logit = acc + rb[e];
        float lg[32];
#pragma unroll
        for (int i = 0; i < 32; ++i) lg[i] = __shfl(logit, i);
        int s0i = 0, s1i = 0, s2i = 0, s3i = 0; float a0 = -3e38f, a1 = -3e38f, a2 = -3e38f, a3 = -3e38f;
#pragma unroll
        for (int i = 0; i < 32; ++i) if (lg[i] > a0) { a0 = lg[i]; s0i = i; }
#pragma unroll
        for (int i = 0; i < 32; ++i) if (i != s0i && lg[i] > a1) { a1 = lg[i]; s1i = i; }
#pragma unroll
        for (int i = 0; i < 32; ++i) if (i != s0i && i != s1i && lg[i] > a2) { a2 = lg[i]; s2i = i; }
#pragma unroll
        for (int i = 0; i < 32; ++i) if (i != s0i && i != s1i && i != s2i && lg[i] > a3) { a3 = lg[i]; s3i = i; }
        const float e0 = 1.f, e1 = __expf(a1 - a0), e2 = __expf(a2 - a0), e3 = __expf(a3 - a0);
        const float inv = 1.f / (((e0 + e1) + e2) + e3);
        if (lane == 0) {
            toke[t * 4 + 0] = s0i; toke[t * 4 + 1] = s1i; toke[t * 4 + 2] = s2i; toke[t * 4 + 3] = s3i;
            tokw[t * 4 + 0] = e0 * inv; tokw[t * 4 + 1] = e1 * inv; tokw[t * 4 + 2] = e2 * inv; tokw[t * 4 + 3] = e3 * inv;
            atomicAdd(&hist[s0i], 1); atomicAdd(&hist[s1i], 1); atomicAdd(&hist[s2i], 1); atomicAdd(&hist[s3i], 1);
        }
        __builtin_amdgcn_wave_barrier();
    }
    __syncthreads();
    if (tid < 32 && hist[tid] != 0) atomicAdd(&cnt[tid], hist[tid]);
}

__device__ __forceinline__ void load_pstart(const Params& p, int l, int* ps) {
    const int* cnt = (const int*)(p.ws + WS_CNT) + l * 32;
    if (otid() == 0) { int s = 0; for (int e = 0; e < 32; ++e) { ps[e] = s; s += (cnt[e] + 255) & ~255; } ps[32] = s; }
    __syncthreads();
}

__device__ __forceinline__ void phase_sc(const Params& p, int l, float* lds) {
    int* ps = (int*)lds;
    load_pstart(p, l, ps);
    const int gtid = blockIdx.x * NT + otid(), gsz = gridDim.x * NT;
    const int* toke = (const int*)(p.ws + WS_TOKE); const float* tokw = (const float*)(p.ws + WS_TOKW);
    int* fill = (int*)(p.ws + WS_FILL) + l * 32; int* rowtok = (int*)(p.ws + WS_ROWTOK) + (size_t)l * RMAX; float* roww = (float*)(p.ws + WS_ROWW) + (size_t)l * RMAX;
    int* pos = (int*)(p.ws + WS_POS);
    for (int i = gtid; i < A_TOT; i += gsz) {
        const int e = toke[i];
        const int slot = ps[e] + atomicAdd(&fill[e], 1);
        rowtok[slot] = i >> 2; roww[slot] = tokw[i]; pos[i] = slot;
    }
    __syncthreads();
}

__device__ __forceinline__ void phase_m1(const Params& p, int l, float* lds) {
    int* ps = (int*)(lds + 16 * 132 + 16 * 68);
    load_pstart(p, l, ps);
    const int rused = ps[32];
    const float* H = (const float*)(p.ws + WS_H); float* U = (float*)(p.ws + WS_U);
    const int* rowtok = (const int*)(p.ws + WS_ROWTOK) + (size_t)l * RMAX;
    const int ntm = rused / 128, ntn = 2048 / 64;
    for (int tile = blockIdx.x; tile < ntm * ntn; tile += gridDim.x) {
        const int tm = tile / ntn, tn = tile % ntn;
        int e = 0; for (int i = 1; i < 32; ++i) if (ps[i] <= tm * 128) e = i;
        const float* W = p.in[17] + ((size_t)l * NE + e) * D * 2048; const float* b1 = p.in[18] + ((size_t)l * NE + e) * 2048;
        auto al = [=](int r, int k) -> float4 { const int tk = rowtok[r]; return tk >= 0 ? *(const float4*)(H + (size_t)tk * D + k) : make_float4(0.f, 0.f, 0.f, 0.f); };
        auto bl = [=](int k, int n) -> float2 { return *(const float2*)(W + (size_t)k * 2048 + n); };
        auto ep = [=](int r, int c, float v) { U[(size_t)r * 2048 + c] = v + b1[c]; };
        gemm_tile(lds, tm * 128, tn * 64, D, al, bl, ep);
    }
    __syncthreads();
}
__device__ __forceinline__ void phase_m2(const Params& p, int l, float* lds) {
    int* ps = (int*)(lds + 16 * 132 + 16 * 68);
    load_pstart(p, l, ps);
    const int rused = ps[32];
    const float* U = (const float*)(p.ws + WS_U); float* Y = (float*)(p.ws + WS_Y);
    const float* roww = (const float*)(p.ws + WS_ROWW) + (size_t)l * RMAX;
    const int ntm = rused / 128, ntn = D / 64;
    for (int tile = blockIdx.x; tile < ntm * ntn; tile += gridDim.x) {
        const int tm = tile / ntn, tn = tile % ntn;
        int e = 0; for (int i = 1; i < 32; ++i) if (ps[i] <= tm * 128) e = i;
        const float* W = p.in[19] + ((size_t)l * NE + e) * DFF * D; const float* b2 = p.in[20] + ((size_t)l * NE + e) * D;
        auto al = [=](int r, int k) -> float4 {
            const float4 gg = *(const float4*)(U + (size_t)r * 2048 + k), ll = *(const float4*)(U + (size_t)r * 2048 + 1024 + k);
            const float g_[4] = {gg.x, gg.y, gg.z, gg.w}, l_[4] = {ll.x, ll.y, ll.z, ll.w}; float o_[4];
#pragma unroll
            for (int i = 0; i < 4; ++i) { const float gc = fminf(g_[i], 7.f), lc = fminf(fmaxf(l_[i], -7.f), 7.f); o_[i] = (lc + 1.f) * gc * sigmoidf_(1.702f * gc); }
            return make_float4(o_[0], o_[1], o_[2], o_[3]);
        };
        auto bl = [=](int k, int n) -> float2 { return *(const float2*)(W + (size_t)k * D + n); };
        auto ep = [=](int r, int c, float v) { Y[(size_t)r * D + c] = (v + b2[c]) * roww[r]; };
        gemm_tile(lds, tm * 128, tn * 64, DFF, al, bl, ep);
    }
    __syncthreads();
}


template <int MAP>
__device__ __forceinline__ void tr_tile(const float* W, int Nsrc, bf16_t* WT, int K, int k0, int n0, float* scr, int lane) {
    const int nl = (lane & 15) * 4, kr = lane >> 4;
    int sc = n0 + nl;
    if (MAP == 1) { sc = sc < 1280 ? sc : (sc < 2816 ? sc + 24 : (sc < 2840 ? sc - 2816 + 1280 : -1)); }
    float4 v[16];
#pragma unroll
    for (int it = 0; it < 16; ++it) v[it] = sc >= 0 ? *(const float4*)(W + (size_t)(k0 + it * 4 + kr) * Nsrc + sc) : make_float4(0.f, 0.f, 0.f, 0.f);
#pragma unroll
    for (int it = 0; it < 16; ++it) { float* s = scr + (it * 4 + kr) * 65 + nl; s[0] = v[it].x; s[1] = v[it].y; s[2] = v[it].z; s[3] = v[it].w; }
    asm volatile("s_waitcnt lgkmcnt(0)" ::: "memory"); __builtin_amdgcn_wave_barrier();
    const int c = lane & 7, nr = lane >> 3;
#pragma unroll
    for (int it = 0; it < 8; ++it) {
        const int n = it * 8 + nr; const float* s = scr + (8 * c) * 65 + n;
        uint4 o; o.x = pk2(s[0], s[65]); o.y = pk2(s[2 * 65], s[3 * 65]); o.z = pk2(s[4 * 65], s[5 * 65]); o.w = pk2(s[6 * 65], s[7 * 65]);
        *(uint4*)(WT + (size_t)(n0 + n) * K + k0 + 8 * c) = o;
    }
    asm volatile("s_waitcnt lgkmcnt(0)" ::: "memory"); __builtin_amdgcn_wave_barrier();
}
__device__ __forceinline__ void phase_convert(const Params& p, float* lds) {
    const int tid = otid(), lane = tid & 63, wave = tid >> 6;
    float* scr = lds + wave * (64 * 65);
    const int gw = blockIdx.x * NW + wave, ngw = gridDim.x * NW;
    bf16_t* WinT = (bf16_t*)(p.ws + WS_WINT); bf16_t* WoT = (bf16_t*)(p.ws + WS_WOT); bf16_t* W1T = (bf16_t*)(p.ws + WS_W1T); bf16_t* W2T = (bf16_t*)(p.ws + WS_W2T);
    constexpr int I_IN = L * 16 * (ZBW / 64), I_O = L * 16 * 16, I_1 = L * NE * 16 * 32, I_2 = L * NE * 16 * 16;
    for (int it = gw; it < I_IN + I_O + I_1 + I_2; it += ngw) {
        int r = it;
        if (r < I_IN) { const int l = r / (16 * 48), q = r % (16 * 48), kb = q / 48, nb = q % 48;
            tr_tile<1>(p.in[6] + (size_t)l * D * INW, INW, WinT + (size_t)l * ZBW * D, D, kb * 64, nb * 64, scr, lane); continue; }
        r -= I_IN;
        if (r < I_O) { const int l = r / 256, q = r % 256, kb = q / 16, nb = q % 16;
            tr_tile<0>(p.in[14] + (size_t)l * D * D, D, WoT + (size_t)l * D * D, D, kb * 64, nb * 64, scr, lane); continue; }
        r -= I_O;
        if (r < I_1) { const int le = r / 512, q = r % 512, kb = q / 32, nb = q % 32;
            tr_tile<0>(p.in[17] + (size_t)le * D * 2048, 2048, W1T + (size_t)le * 2048 * D, D, kb * 64, nb * 64, scr, lane); continue; }
        r -= I_1;
        { const int le = r / 256, q = r % 256, kb = q / 16, nb = q % 16;
            tr_tile<0>(p.in[19] + (size_t)le * DFF * D, D, W2T + (size_t)le * D * DFF, DFF, kb * 64, nb * 64, scr, lane); }
    }
    if (blockIdx.x == 0) { bf16_t* XN = (bf16_t*)(p.ws + WS_XN); for (int i = tid; i < D / 2; i += NT) ((unsigned*)(XN + (size_t)T * D))[i] = 0u; }
}

namespace pg8 {
#define PG8_LAS __attribute__((address_space(3)))
typedef short bf16x8 __attribute__((ext_vector_type(8)));
typedef float f32x4 __attribute__((ext_vector_type(4)));
typedef unsigned u32x4 __attribute__((ext_vector_type(4)));
constexpr int BM = 256, BK = 64, HALF = 128, HTB = HALF * BK * 2, STAGE_BYTES = 8 * HTB, NXCD = 8, WGM = 8;
__device__ __forceinline__ int lds_byte(int r, int c) { const int st = (r >> 4) * 2 + (c >> 5), rr = r & 15, cc = c & 31, ob = rr * 64 + cc * 2; return st * 1024 + (ob ^ (((ob >> 9) & 1) << 5)); }
__device__ __forceinline__ void stage_rc(int b, int& R, int& C) { const int st = b / 1024, sb = b % 1024, swz = sb ^ (((sb >> 9) & 1) << 5); R = (st >> 1) * 16 + swz / 64; C = (st & 1) * 32 + (swz % 64) / 2; }
__device__ __forceinline__ int perm32(int rho) { const int n = rho >> 4, i = rho & 15; return 8 * (i >> 2) + 4 * n + (i & 3); }
struct Unit { int pm, pn; };
__device__ __forceinline__ unsigned cvt_pk_bf16(float lo, float hi) { unsigned r; asm volatile("v_cvt_pk_bf16_f32 %0, %1, %2" : "=v"(r) : "v"(lo), "v"(hi)); return r; }

__device__ __forceinline__ bool static_next(int nM, int nN, int G, int c, int i, Unit& u) {
    const int nwg = nM * nN; const long Lq = (long)i * G + c; if (Lq >= nwg) return false;
    int wgid = (int)Lq; { const int q = nwg / NXCD, r = nwg % NXCD, xcd = wgid % NXCD, off = wgid / NXCD; wgid = (xcd < r ? xcd * (q + 1) : r * (q + 1) + (xcd - r) * q) + off; }
    const int nig = WGM * nN, gid = wgid / nig, fm = gid * WGM, gsz = (nM - fm) < WGM ? (nM - fm) : WGM;
    u.pm = fm + ((wgid % nig) % gsz); u.pn = (wgid % nig) / gsz; return true;
}

template <class Prob, class Epi, bool ALIGN_EPI, bool SP2>
__device__ __forceinline__ void gemm_phase(PG8_LAS unsigned char* lds, const Prob& P, const Epi& E) {
    const int tid = otid(), wid = __builtin_amdgcn_readfirstlane(tid >> 6), lane = tid & 63, wr = wid >> 2, wc = wid & 3, fr = lane & 15, fq = lane >> 4;
    const int K = P.K, nt = K / BK;
    int sR[2], sC[2]; unsigned voffB[2];
#pragma unroll
    for (int i = 0; i < 2; ++i) { stage_rc(tid * 16 + i * 8192, sR[i], sC[i]); voffB[i] = (unsigned)(P.b_row(sR[i]) * K + sC[i]) * 2u; }
    const size_t kstep = (size_t)(BK * 2);
    const size_t hstepB = P.b_hstep();
    const unsigned ldsw = (unsigned)wid * 1024u;
    const int aoff = lds_byte(wr * 64 + fr, fq * 8), boff = lds_byte(wc * 32 + fr, fq * 8);
#define PG8_SA(b, h) (((b) * 2 + (h)) * HTB)
#define PG8_SB(b, h) ((4 + (b) * 2 + (h)) * HTB)
#define PG8_STAGE(bufoff, gbase, voff) do { _Pragma("unroll") for (int _i = 0; _i < 2; ++_i) \
        __builtin_amdgcn_global_load_lds((const unsigned*)((const char*)(gbase) + (voff)[_i]), (PG8_LAS unsigned*)(lds + (bufoff) + ldsw + _i * 8192), 16, 0, 0); } while (0)
#define PG8_LDA(dst, b, h) do { _Pragma("unroll") for (int m = 0; m < 4; ++m) _Pragma("unroll") for (int k = 0; k < 2; ++k) dst[m][k] = *(const PG8_LAS bf16x8*)(lds + PG8_SA(b, h) + aoff + m * 2048 + k * 1024); } while (0)
#define PG8_LDB(dst, b, h) do { _Pragma("unroll") for (int n = 0; n < 2; ++n) _Pragma("unroll") for (int k = 0; k < 2; ++k) dst[n][k] = *(const PG8_LAS bf16x8*)(lds + PG8_SB(b, h) + boff + n * 2048 + k * 1024); } while (0)
#define PG8_MMA(ai, bj, At, Bt) do { __builtin_amdgcn_s_setprio(1); _Pragma("unroll") for (int m = 0; m < 4; ++m) _Pragma("unroll") for (int n = 0; n < 2; ++n) _Pragma("unroll") for (int k = 0; k < 2; ++k) \
        acc[ai][bj][m][n] = __builtin_amdgcn_mfma_f32_16x16x32_bf16(Bt[n][k], At[m][k], acc[ai][bj][m][n], 0, 0, 0); __builtin_amdgcn_s_setprio(0); } while (0)
#define PG8_WAIT_V(n) asm volatile("s_waitcnt vmcnt(" #n ")" ::: "memory")
#define PG8_WAIT_L(n) asm volatile("s_waitcnt lgkmcnt(" #n ")" ::: "memory")
#define PG8_BAR __builtin_amdgcn_s_barrier()
#define PG8_SCHED __builtin_amdgcn_sched_barrier(0)
    Unit cur, nxt; int ui = 0;
    if (!P.next(0, cur)) return;
    f32x4 acc[2][2][4][2];
#pragma unroll
    for (int a = 0; a < 2; ++a)
#pragma unroll
        for (int b = 0; b < 2; ++b)
#pragma unroll
            for (int m = 0; m < 4; ++m)
#pragma unroll
                for (int n = 0; n < 2; ++n) acc[a][b][m][n] = (f32x4){0.f, 0.f, 0.f, 0.f};
    bf16x8 At[4][2], B0[2][2], B1[2][2];
    unsigned vAc[2][2], vAn[2][2];
    const char* cA = P.a_base(cur); const char* cB = P.b_base(cur);
    P.a_voff(cur, sR, sC, vAc);
#pragma unroll
    for (int h = 0; h < 2; ++h)
#pragma unroll
        for (int i = 0; i < 2; ++i) vAn[h][i] = vAc[h][i];
    if constexpr (SP2) {
        PG8_STAGE(PG8_SB(0, 0), cB, voffB); PG8_STAGE(PG8_SB(0, 1), cB + hstepB, voffB); PG8_STAGE(PG8_SA(0, 0), cA, vAc[0]); PG8_STAGE(PG8_SA(0, 1), cA, vAc[1]);
        if (wr == 1) PG8_BAR;
        PG8_WAIT_V(2); PG8_BAR;
        PG8_STAGE(PG8_SB(1, 0), cB + kstep, voffB); PG8_STAGE(PG8_SA(1, 0), cA + kstep, vAc[0]); PG8_STAGE(PG8_SB(1, 1), cB + hstepB + kstep, voffB);
        PG8_WAIT_V(6); PG8_BAR;
    } else {
        PG8_STAGE(PG8_SB(0, 0), cB, voffB); PG8_STAGE(PG8_SA(0, 0), cA, vAc[0]); PG8_STAGE(PG8_SB(0, 1), cB + hstepB, voffB); PG8_STAGE(PG8_SA(0, 1), cA, vAc[1]);
        if (wr == 1) PG8_BAR;
        PG8_WAIT_V(4); PG8_BAR;
        PG8_STAGE(PG8_SB(1, 0), cB + kstep, voffB); PG8_STAGE(PG8_SA(1, 0), cA + kstep, vAc[0]); PG8_STAGE(PG8_SB(1, 1), cB + hstepB + kstep, voffB);
        PG8_WAIT_V(6); PG8_BAR;
    }
    for (;;) {
        const bool has_next = P.next(ui + 1, nxt);
        const char* nA = cA; const char* nB = cB;
        if (has_next) { nA = P.a_base(nxt); nB = P.b_base(nxt); P.a_voff(nxt, sR, sC, vAn); }
        for (int t = 0; t < nt; t += 2) {
            const bool last = (t == nt - 2);
            const char* a1 = cA + (size_t)(t + 1) * kstep;
            const char* a2 = last ? nA : cA + (size_t)(t + 2) * kstep; const char* b2 = last ? nB : cB + (size_t)(t + 2) * kstep;
            const char* a3 = a2 + kstep; const char* b3 = b2 + kstep;
            unsigned v2[2][2];
#pragma unroll
            for (int h = 0; h < 2; ++h)
#pragma unroll
                for (int i = 0; i < 2; ++i) v2[h][i] = last ? vAn[h][i] : vAc[h][i];
            if constexpr (SP2) {
            PG8_LDB(B0, 0, 0); PG8_LDB(B1, 0, 1); PG8_SCHED; PG8_LDA(At, 0, 0); PG8_STAGE(PG8_SA(1, 1), a1, vAc[1]);
            PG8_WAIT_V(8); PG8_WAIT_L(0); PG8_BAR; PG8_MMA(0, 0, At, B0); PG8_MMA(0, 1, At, B1); PG8_BAR; PG8_SCHED;
            PG8_LDA(At, 0, 1); PG8_STAGE(PG8_SB(0, 0), b2, voffB); PG8_STAGE(PG8_SB(0, 1), b2 + hstepB, voffB); PG8_STAGE(PG8_SA(0, 0), a2, v2[0]);
            PG8_WAIT_V(8); PG8_WAIT_L(0); PG8_BAR; PG8_MMA(1, 0, At, B0); PG8_MMA(1, 1, At, B1); PG8_BAR; PG8_SCHED;
            PG8_LDB(B0, 1, 0); PG8_LDB(B1, 1, 1); PG8_SCHED; PG8_LDA(At, 1, 0); PG8_STAGE(PG8_SA(0, 1), a2, v2[1]);
            PG8_WAIT_V(8); PG8_WAIT_L(0); PG8_BAR; PG8_MMA(0, 0, At, B0); PG8_MMA(0, 1, At, B1); PG8_BAR; PG8_SCHED;
            PG8_LDA(At, 1, 1); PG8_STAGE(PG8_SB(1, 0), b3, voffB); PG8_STAGE(PG8_SB(1, 1), b3 + hstepB, voffB); PG8_STAGE(PG8_SA(1, 0), a3, v2[0]);
            PG8_WAIT_V(8); PG8_WAIT_L(0); PG8_BAR; PG8_MMA(1, 0, At, B0); PG8_MMA(1, 1, At, B1); PG8_BAR; PG8_SCHED;
            } else {
            PG8_LDB(B0, 0, 0); PG8_SCHED; PG8_LDA(At, 0, 0); PG8_STAGE(PG8_SA(1, 1), a1, vAc[1]);
            PG8_WAIT_L(8); PG8_BAR; PG8_WAIT_L(0); PG8_MMA(0, 0, At, B0); PG8_BAR; PG8_SCHED;
            PG8_LDB(B1, 0, 1); PG8_STAGE(PG8_SB(0, 0), b2, voffB);
            PG8_BAR; PG8_WAIT_L(0); PG8_MMA(0, 1, At, B1); PG8_BAR;
            PG8_LDA(At, 0, 1); PG8_STAGE(PG8_SA(0, 0), a2, v2[0]);
            PG8_BAR; PG8_WAIT_L(0); PG8_MMA(1, 0, At, B0); PG8_BAR; PG8_SCHED;
            PG8_STAGE(PG8_SB(0, 1), b2 + hstepB, voffB);
            PG8_WAIT_V(6); PG8_BAR; PG8_MMA(1, 1, At, B1); PG8_BAR;
            PG8_LDB(B0, 1, 0); PG8_SCHED; PG8_LDA(At, 1, 0); PG8_STAGE(PG8_SA(0, 1), a2, v2[1]);
            PG8_WAIT_L(8); PG8_BAR; PG8_WAIT_L(0); PG8_MMA(0, 0, At, B0); PG8_BAR; PG8_SCHED;
            PG8_LDB(B1, 1, 1); PG8_STAGE(PG8_SB(1, 0), b3, voffB);
            PG8_BAR; PG8_WAIT_L(0); PG8_MMA(0, 1, At, B1); PG8_BAR;
            PG8_LDA(At, 1, 1); PG8_STAGE(PG8_SA(1, 0), a3, v2[0]);
            PG8_BAR; PG8_WAIT_L(0); PG8_MMA(1, 0, At, B0); PG8_BAR; PG8_SCHED;
            PG8_STAGE(PG8_SB(1, 1), b3 + hstepB, voffB);
            PG8_WAIT_V(6); PG8_BAR; PG8_MMA(1, 1, At, B1); PG8_BAR;
            }
        }
        if constexpr (ALIGN_EPI) { if (wr == 0) PG8_BAR; }
        E(acc, cur, wr, wc, fr, fq);
        if (!has_next) break;
#pragma unroll
        for (int a = 0; a < 2; ++a)
#pragma unroll
            for (int b = 0; b < 2; ++b)
#pragma unroll
                for (int m = 0; m < 4; ++m)
#pragma unroll
                    for (int n = 0; n < 2; ++n) acc[a][b][m][n] = (f32x4){0.f, 0.f, 0.f, 0.f};
        cur = nxt; cA = nA; cB = nB; ++ui;
#pragma unroll
        for (int h = 0; h < 2; ++h)
#pragma unroll
            for (int i = 0; i < 2; ++i) vAc[h][i] = vAn[h][i];
        if constexpr (ALIGN_EPI) { if (wr == 1) PG8_BAR; }
    }
    PG8_WAIT_V(0);
    if constexpr (!ALIGN_EPI) { if (wr == 0) PG8_BAR; }
    PG8_BAR;
#undef PG8_SA
#undef PG8_SB
#undef PG8_STAGE
#undef PG8_LDA
#undef PG8_LDB
#undef PG8_MMA
#undef PG8_WAIT_V
#undef PG8_WAIT_L
#undef PG8_BAR
#undef PG8_SCHED
}

struct ProbDense {
    const bf16_t* A; const bf16_t* Bt; int K, nM, nN, G, c; bool headperm;
    __device__ __forceinline__ bool next(int i, Unit& u) const { return static_next(nM, nN, G, c, i, u); }
    __device__ __forceinline__ const char* a_base(const Unit& u) const { return (const char*)(A + (size_t)u.pm * BM * K); }
    __device__ __forceinline__ void a_voff(const Unit&, const int (&R)[2], const int (&C)[2], unsigned (&v)[2][2]) const {
#pragma unroll
        for (int h = 0; h < 2; ++h)
#pragma unroll
            for (int i = 0; i < 2; ++i) v[h][i] = (unsigned)((h * HALF + R[i]) * K + C[i]) * 2u;
    }
    __device__ __forceinline__ const char* b_base(const Unit& u) const { return (const char*)(Bt + (size_t)u.pn * BM * K); }
    __device__ __forceinline__ size_t b_hstep() const { return headperm ? (size_t)32 * K * 2 : (size_t)HALF * K * 2; }
    __device__ __forceinline__ int b_row(int R) const { return headperm ? ((R >> 5) * 64 + perm32(R & 31)) : ((R & ~31) + perm32(R & 31)); }
};
__device__ __forceinline__ int expert_of(const int* ps, int pm) { int e = 0; for (int i = 1; i < 32; ++i) if (ps[i] <= pm * 256) e = i; return e; }
struct ProbMoe1 {
    const bf16_t* XN; const bf16_t* W1T; const int* rowtok; const int* ps; int K, ntm, G, c;
    __device__ __forceinline__ bool next(int i, Unit& u) const { const int q = i * G + c; if (q >= ntm * 8) return false; u.pm = q >> 3; u.pn = q & 7; return true; }
    __device__ __forceinline__ const char* a_base(const Unit&) const { return (const char*)XN; }
    __device__ __forceinline__ void a_voff(const Unit& u, const int (&R)[2], const int (&C)[2], unsigned (&v)[2][2]) const {
#pragma unroll
        for (int h = 0; h < 2; ++h)
#pragma unroll
            for (int i = 0; i < 2; ++i) { int tk = rowtok[u.pm * BM + h * HALF + R[i]]; if (tk < 0) tk = T; v[h][i] = (unsigned)(tk * K + C[i]) * 2u; }
    }
    __device__ __forceinline__ const char* b_base(const Unit& u) const { const int e = expert_of(ps, u.pm); return (const char*)(W1T + ((size_t)e * 2048 + u.pn * 128) * K); }
    __device__ __forceinline__ size_t b_hstep() const { return (size_t)1024 * K * 2; }
    __device__ __forceinline__ int b_row(int R) const { return (R & ~31) + perm32(R & 31); }
};
struct ProbMoe2 {
    const bf16_t* ACT; const bf16_t* W2T; const int* ps; int K, ntm, G, c;
    __device__ __forceinline__ bool next(int i, Unit& u) const { const int q = i * G + c; if (q >= ntm * 4) return false; u.pm = q >> 2; u.pn = q & 3; return true; }
    __device__ __forceinline__ const char* a_base(const Unit& u) const { return (const char*)(ACT + (size_t)u.pm * BM * K); }
    __device__ __forceinline__ void a_voff(const Unit&, const int (&R)[2], const int (&C)[2], unsigned (&v)[2][2]) const {
#pragma unroll
        for (int h = 0; h < 2; ++h)
#pragma unroll
            for (int i = 0; i < 2; ++i) v[h][i] = (unsigned)((h * HALF + R[i]) * K + C[i]) * 2u;
    }
    __device__ __forceinline__ const char* b_base(const Unit& u) const { const int e = expert_of(ps, u.pm); return (const char*)(W2T + ((size_t)e * 1024 + u.pn * BM) * K); }
    __device__ __forceinline__ size_t b_hstep() const { return (size_t)HALF * K * 2; }
    __device__ __forceinline__ int b_row(int R) const { return (R & ~31) + perm32(R & 31); }
};

struct EpiG1Z {
    float* Z;
    __device__ __forceinline__ void operator()(const f32x4 (&acc)[2][2][4][2], const Unit& u, int wr, int wc, int fr, int fq) const {
#pragma unroll
        for (int ai = 0; ai < 2; ++ai)
#pragma unroll
            for (int m = 0; m < 4; ++m) { const size_t r = (size_t)u.pm * BM + ai * HALF + wr * 64 + m * 16 + fr;
#pragma unroll
                for (int bj = 0; bj < 2; ++bj)
#pragma unroll
                    for (int n = 0; n < 2; ++n) { const int zc = u.pn * BM + 64 * wc + 32 * bj + 8 * fq + 4 * n;
                        const int col = zc < 1280 ? zc : (zc < 2816 ? zc + 24 : (zc < 2840 ? zc - 2816 + 1280 : -1));
                        if (col >= 0) *(f32x4*)(Z + r * INW + col) = acc[ai][bj][m][n]; } }
    }
};
struct EpiG2 {
    const float* xin; float* XA; const float* g1;
    __device__ __forceinline__ void operator()(const f32x4 (&acc)[2][2][4][2], const Unit& u, int wr, int wc, int fr, int fq) const {
#pragma unroll
        for (int ai = 0; ai < 2; ++ai)
#pragma unroll
            for (int m = 0; m < 4; ++m) { const size_t r = (size_t)u.pm * BM + ai * HALF + wr * 64 + m * 16 + fr; const int b = (int)(r / S);
#pragma unroll
                for (int bj = 0; bj < 2; ++bj)
#pragma unroll
                    for (int n = 0; n < 2; ++n) { const int c = u.pn * BM + 128 * bj + 32 * wc + 8 * fq + 4 * n;
                        const f32x4 x = *(const f32x4*)(xin + r * D + c), g = *(const f32x4*)(g1 + (size_t)b * 6144 + c);
                        *(f32x4*)(XA + r * D + c) = x + g * acc[ai][bj][m][n]; } }
    }
};
struct EpiM1 {
    bf16_t* ACT; const float* b1l; const int* ps;
    __device__ __forceinline__ void operator()(const f32x4 (&acc)[2][2][4][2], const Unit& u, int wr, int wc, int fr, int fq) const {
        const int e = expert_of(ps, u.pm); const float* b1 = b1l + (size_t)e * 2048;
        const int c0 = u.pn * 128 + 32 * wc + 8 * fq;
        f32x4 bg[2], bl[2];
#pragma unroll
        for (int n = 0; n < 2; ++n) { bg[n] = *(const f32x4*)(b1 + c0 + 4 * n); bl[n] = *(const f32x4*)(b1 + 1024 + c0 + 4 * n); }
#pragma unroll
        for (int ai = 0; ai < 2; ++ai)
#pragma unroll
            for (int m = 0; m < 4; ++m) { const size_t r = (size_t)u.pm * BM + ai * HALF + wr * 64 + m * 16 + fr;
                float o[8];
#pragma unroll
                for (int n = 0; n < 2; ++n) { const f32x4 g = acc[ai][0][m][n] + bg[n], li = acc[ai][1][m][n] + bl[n];
#pragma unroll
                    for (int i = 0; i < 4; ++i) { const float gc = fminf(g[i], 7.f), lc = fminf(fmaxf(li[i], -7.f), 7.f); o[4 * n + i] = (lc + 1.f) * gc * (1.f / (1.f + __expf(-1.702f * gc))); } }
                u32x4 w; w.x = cvt_pk_bf16(o[0], o[1]); w.y = cvt_pk_bf16(o[2], o[3]); w.z = cvt_pk_bf16(o[4], o[5]); w.w = cvt_pk_bf16(o[6], o[7]);
                *(u32x4*)(ACT + r * DFF + c0) = w; }
    }
};
struct EpiM2 {
    float* Y; const float* b2l; const float* roww; const int* ps;
    __device__ __forceinline__ void operator()(const f32x4 (&acc)[2][2][4][2], const Unit& u, int wr, int wc, int fr, int fq) const {
        const int e = expert_of(ps, u.pm); const float* b2 = b2l + (size_t)e * D;
#pragma unroll
        for (int ai = 0; ai < 2; ++ai)
#pragma unroll
            for (int m = 0; m < 4; ++m) { const size_t r = (size_t)u.pm * BM + ai * HALF + wr * 64 + m * 16 + fr; const float w = roww[r];
#pragma unroll
                for (int bj = 0; bj < 2; ++bj)
#pragma unroll
                    for (int n = 0; n < 2; ++n) { const int c = u.pn * BM + 128 * bj + 32 * wc + 8 * fq + 4 * n;
                        const f32x4 bb = *(const f32x4*)(b2 + c);
                        *(f32x4*)(Y + r * D + c) = (acc[ai][bj][m][n] + bb) * w; } }
    }
};
}

__device__ __forceinline__ void phase_g1_fast(const Params& p, int l, unsigned char* lds_raw) {
    pg8::ProbDense P{(const bf16_t*)(p.ws + WS_XN), (const bf16_t*)(p.ws + WS_WINT) + (size_t)l * ZBW * D, D, T / 256, ZBW / 256, (int)gridDim.x, (int)blockIdx.x, true};
    pg8::EpiG1Z E{(float*)(p.ws + WS_Z)};
    pg8::gemm_phase<pg8::ProbDense, pg8::EpiG1Z, true, true>((PG8_LAS unsigned char*)lds_raw, P, E);
}
__device__ __forceinline__ void phase_g2_fast(const Params& p, int l, unsigned char* lds_raw) {
    pg8::ProbDense P{(const bf16_t*)(p.ws + WS_ATTB), (const bf16_t*)(p.ws + WS_WOT) + (size_t)l * D * D, D, T / 256, D / 256, (int)gridDim.x, (int)blockIdx.x, false};
    pg8::EpiG2 E{l == 0 ? p.in[0] : p.out, p.out, (const float*)(p.ws + WS_MOD) + (size_t)l * Bn * 6144 + 2 * D};
    pg8::gemm_phase<pg8::ProbDense, pg8::EpiG2, true, true>((PG8_LAS unsigned char*)lds_raw, P, E);
}
constexpr int LDS_PS_OFF = 131072;
__device__ __forceinline__ void phase_m1_fast(const Params& p, int l, unsigned char* lds_raw) {
    int* ps = (int*)(lds_raw + LDS_PS_OFF);
    load_pstart(p, l, ps);
    pg8::ProbMoe1 P{(const bf16_t*)(p.ws + WS_XN), (const bf16_t*)(p.ws + WS_W1T) + (size_t)l * NE * 2048 * D, (const int*)(p.ws + WS_ROWTOK) + (size_t)l * RMAX, ps, D, ps[32] / 256, (int)gridDim.x, (int)blockIdx.x};
    pg8::EpiM1 E{(bf16_t*)(p.ws + WS_ACT), p.in[18] + (size_t)l * NE * 2048, ps};
    pg8::gemm_phase<pg8::ProbMoe1, pg8::EpiM1, true, true>((PG8_LAS unsigned char*)lds_raw, P, E);
    __syncthreads();
}
__device__ __forceinline__ void phase_m2_fast(const Params& p, int l, unsigned char* lds_raw) {
    int* ps = (int*)(lds_raw + LDS_PS_OFF);
    load_pstart(p, l, ps);
    pg8::ProbMoe2 P{(const bf16_t*)(p.ws + WS_ACT), (const bf16_t*)(p.ws + WS_W2T) + (size_t)l * NE * D * DFF, ps, DFF, ps[32] / 256, (int)gridDim.x, (int)blockIdx.x};
    pg8::EpiM2 E{(float*)(p.ws + WS_Y), p.in[20] + (size_t)l * NE * D, (const float*)(p.ws + WS_ROWW) + (size_t)l * RMAX, ps};
    pg8::gemm_phase<pg8::ProbMoe2, pg8::EpiM2, true, true>((PG8_LAS unsigned char*)lds_raw, P, E);
    __syncthreads();
}

__global__ void __launch_bounds__(NT, 2) mega_fwd(Params p) {
    extern __shared__ __attribute__((aligned(16))) unsigned char lds_raw[];
    float* lds = (float*)lds_raw;
    cg::grid_group grid = cg::this_grid();
    phase_p0a(p, lds);
#if FAST_G1 || FAST_G2 || FAST_MOE
    __syncthreads();
    phase_convert(p, lds);
#endif
    grid.sync();
    phase_p0b(p);
    grid.sync();
    _Pragma("unroll 1") for (int l = 0; l < L; ++l) {
        phase_r1(p, l, true);
        grid.sync();
#if FAST_G1
        phase_g1_fast(p, l, lds_raw);
#else
        phase_g1(p, l, lds);
#endif
        grid.sync();
        phase_zp(p, l);
        grid.sync();
        phase_ck(p, l, lds);
        grid.sync();
        phase_c2(p, l);
        grid.sync();
        phase_att(p, lds);
        grid.sync();
#if FAST_G2
        phase_g2_fast(p, l, lds_raw);
#else
        phase_g2(p, l, lds);
#endif
        grid.sync();
        phase_r2(p, l, lds);
        grid.sync();
        phase_sc(p, l, lds);
        grid.sync();
#if FAST_MOE
        phase_m1_fast(p, l, lds_raw);
#else
        phase_m1(p, l, lds);
#endif
        grid.sync();
#if FAST_MOE
        phase_m2_fast(p, l, lds_raw);
#else
        phase_m2(p, l, lds);
#endif
        grid.sync();
    }
    phase_r1(p, L, false);
}

extern "C" void kernel_launch(void* const* d_in, const int* in_sizes, int n_in, void* d_out, int out_size, void* d_ws, size_t ws_size, hipStream_t stream) {
    static int grid_blocks = 0;
    if (grid_blocks == 0) {
        if (n_in != 21 || out_size != T * D || ws_size < WS_END) { fprintf(stderr, "kernel_launch: unexpected shapes (n_in %d out %d ws %zu need %zu)\n", n_in, out_size, ws_size, (size_t)WS_END); grid_blocks = -1; return; }
        int dev = 0, cus = 0, per_cu = 0;
        hipGetDevice(&dev);
        hipDeviceGetAttribute(&cus, hipDeviceAttributeMultiprocessorCount, dev);
        hipFuncSetAttribute((const void*)mega_fwd, hipFuncAttributeMaxDynamicSharedMemorySize, LDS_BYTES);
        hipOccupancyMaxActiveBlocksPerMultiprocessor(&per_cu, (const void*)mega_fwd, NT, LDS_BYTES);
        if (per_cu < 1) { fprintf(stderr, "kernel_launch: occupancy query says %d blocks per CU\n", per_cu); per_cu = 1; }
        (void)hipGetLastError();
        grid_blocks = cus * 1;
    }
    if (grid_blocks < 0) return;
    Params p{};
    for (int i = 0; i < 21; ++i) p.in[i] = (const float*)d_in[i];
    p.out = (float*)d_out; p.ws = (unsigned char*)d_ws;
    void* args[] = {&p};
    hipError_t e = hipLaunchCooperativeKernel((const void*)mega_fwd, dim3(grid_blocks), dim3(NT), args, LDS_BYTES, stream);
    if (e != hipSuccess) fprintf(stderr, "cooperative launch failed: %s (grid %d)\n", hipGetErrorString(e), grid_blocks);
}
```

```cpp
#include <hip/hip_runtime.h>
#include <hip/hip_cooperative_groups.h>
#include <cstdio>
#include <cstdint>
namespace cg = cooperative_groups;

constexpr int Bn = 2, S = 8192, D = 1024, L = 2, T = Bn * S;
constexpr int INW = 2840;
constexpr int NE = 32, TOPK = 4, DFF = 1024;
constexpr int A_TOT = T * TOPK;
constexpr int RMAX = A_TOT + NE * 256;
constexpr int NCMP = 511;
constexpr int NT = 512;
constexpr int NW = NT / 64;
constexpr int LDS_BYTES = 147456;
constexpr float EPS = 1e-6f;
constexpr float NEGF = -1e30f;

#ifndef FAST_G1
#define FAST_G1 1
#endif
#ifndef FAST_G2
#define FAST_G2 1
#endif
#ifndef FAST_ATT
#define FAST_ATT 1
#endif
#ifndef FAST_MOE
#define FAST_MOE 1
#endif
constexpr int ZBW = 3072;
constexpr int ZB_Q = 0, ZB_KC = 512, ZB_VC = 640, ZB_KS = 768, ZB_VS = 896, ZB_KW = 1024, ZB_VW = 1152, ZB_MQ = 1280, ZB_MK = 1792, ZB_MV = 2304, ZB_G = 2816;
constexpr float QSCALE = 0.125f * 1.4426950408889634f;
constexpr float LOG2E = 1.4426950408889634f;
constexpr int ZC_Q = 0, ZC_KC = 512, ZC_VC = 640, ZC_KS = 768, ZC_VS = 896, ZC_KW = 1024, ZC_VW = 1152, ZC_G = 1280, ZC_MQ = 1304, ZC_MK = 1816, ZC_MV = 2328;

constexpr size_t al256(size_t x) { return (x + 255) & ~(size_t)255; }
constexpr size_t WS_MODP = 0;
constexpr size_t WS_MOD = al256(WS_MODP + (size_t)8 * L * Bn * 6144 * 4);
constexpr size_t WS_CNT = al256(WS_MOD + (size_t)L * Bn * 6144 * 4);
constexpr size_t WS_FILL = al256(WS_CNT + L * 32 * 4);
constexpr size_t WS_ROWTOK = al256(WS_FILL + L * 32 * 4);
constexpr size_t WS_ROWW = al256(WS_ROWTOK + (size_t)L * RMAX * 4);
constexpr size_t WS_TOKE = al256(WS_ROWW + (size_t)L * RMAX * 4);
constexpr size_t WS_TOKW = al256(WS_TOKE + (size_t)T * 4 * 4);
constexpr size_t WS_POS = al256(WS_TOKW + (size_t)T * 4 * 4);
constexpr size_t WS_HID = al256(WS_POS + (size_t)T * 4 * 4);
constexpr size_t WS_KC = al256(WS_HID + (size_t)2 * 2044 * 128 * 4);
constexpr size_t WS_VC = al256(WS_KC + (size_t)2044 * 64 * 4);
constexpr size_t WS_KM = al256(WS_VC + (size_t)2044 * 64 * 4);
constexpr size_t WS_H = al256(WS_KM + (size_t)Bn * 8 * 32 * 64 * 4);
constexpr size_t WS_Z = al256(WS_H + (size_t)T * D * 4);
constexpr size_t WS_ATT = al256(WS_Z + (size_t)T * INW * 4);
constexpr size_t WS_U = al256(WS_ATT + (size_t)T * D * 4);
constexpr size_t WS_Y = al256(WS_U + (FAST_MOE ? (size_t)0 : (size_t)RMAX * 2048 * 4));
constexpr size_t WS_WINT = al256(WS_Y + (size_t)RMAX * 1024 * 4);
constexpr size_t WS_WOT = al256(WS_WINT + (size_t)L * 3072 * 1024 * 2);
constexpr size_t WS_W1T = al256(WS_WOT + (size_t)L * 1024 * 1024 * 2);
constexpr size_t WS_W2T = al256(WS_W1T + (size_t)L * NE * 2048 * 1024 * 2);
constexpr size_t WS_XN = al256(WS_W2T + (size_t)L * NE * 1024 * 1024 * 2);
constexpr size_t WS_ATTB = al256(WS_XN + (size_t)(T + 1) * D * 2);
constexpr size_t WS_ACT = al256(WS_ATTB + (size_t)T * D * 2);
constexpr size_t WS_ZB = al256(WS_ACT + (size_t)RMAX * DFF * 2);
constexpr size_t WS_GATE = al256(WS_ZB + (size_t)T * ZBW * 2);
constexpr size_t WS_KCB = al256(WS_GATE + (size_t)T * 32 * 4);
constexpr size_t WS_VCB = al256(WS_KCB + (size_t)Bn * 2 * 512 * 64 * 2);
constexpr size_t WS_KMB = al256(WS_VCB + (size_t)Bn * 2 * 512 * 64 * 2);
constexpr size_t WS_END = al256(WS_KMB + (size_t)Bn * 8 * 32 * 64 * 2);

struct Params {
    const float* in[21];
    float* out;
    unsigned char* ws;
};

__device__ __forceinline__ int otid() { int t = threadIdx.x; asm volatile("" : "+v"(t)); return t; }
typedef unsigned short bf16_t;
__device__ __forceinline__ unsigned f2bf(float f) { unsigned u = __builtin_bit_cast(unsigned, f); return (u + 0x7fffu + ((u >> 16) & 1u)) >> 16; }
__device__ __forceinline__ unsigned pk2(float lo, float hi) { return f2bf(lo) | (f2bf(hi) << 16); }
__device__ __forceinline__ float bf2f(bf16_t v) { return __builtin_bit_cast(float, (unsigned)v << 16); }
__device__ __forceinline__ float wave_sum(float v) {
#pragma unroll
    for (int o = 1; o < 64; o <<= 1) v += __shfl_xor(v, o);
    return v;
}
__device__ __forceinline__ float sigmoidf_(float x) { return 1.f / (1.f + __expf(-x)); }
__device__ __forceinline__ float gelu_tanh(float x) {
    const float u = 0.7978845608028654f * (x + 0.044715f * x * x * x);
    return 0.5f * x * (1.f + tanhf(u));
}

template <class AL, class BL, class EP>
__device__ __forceinline__ void gemm_tile(float* lds, int m0, int n0, int K, const AL& al, const BL& bl, const EP& ep) {
    float* As = lds;
    float* Bs = lds + 16 * 132;
    const int tid = otid(), tx = tid & 15, ty = tid >> 4;
    const int ar = tid >> 2, ak = (tid & 3) * 4;
    const int bk = tid >> 5, bn = (tid & 31) * 2;
    float acc[4][4];
#pragma unroll
    for (int i = 0; i < 4; ++i)
#pragma unroll
        for (int j = 0; j < 4; ++j) acc[i][j] = 0.f;
    float4 av = al(m0 + ar, ak);
    float2 bv = bl(bk, n0 + bn);
    for (int k0 = 0; k0 < K; k0 += 16) {
        As[(ak + 0) * 132 + ar] = av.x; As[(ak + 1) * 132 + ar] = av.y; As[(ak + 2) * 132 + ar] = av.z; As[(ak + 3) * 132 + ar] = av.w;
        *(float2*)&Bs[bk * 68 + bn] = bv;
        __syncthreads();
        if (k0 + 16 < K) { av = al(m0 + ar, k0 + 16 + ak); bv = bl(k0 + 16 + bk, n0 + bn); }
#pragma unroll
        for (int kk = 0; kk < 16; ++kk) {
            const float4 a = *(const float4*)&As[kk * 132 + ty * 4];
            const float4 b = *(const float4*)&Bs[kk * 68 + tx * 4];
            const float a_[4] = {a.x, a.y, a.z, a.w}, b_[4] = {b.x, b.y, b.z, b.w};
#pragma unroll
            for (int i = 0; i < 4; ++i)
#pragma unroll
                for (int j = 0; j < 4; ++j) acc[i][j] += a_[i] * b_[j];
        }
        __syncthreads();
    }
#pragma unroll
    for (int i = 0; i < 4; ++i)
#pragma unroll
        for (int j = 0; j < 4; ++j) ep(m0 + ty * 4 + i, n0 + tx * 4 + j, acc[i][j]);
}

__device__ __forceinline__ void phase_p0a(const Params& p, float* lds) {
    const int tid = otid(), gtid = blockIdx.x * NT + tid, gsz = gridDim.x * NT;
    int* cnt = (int*)(p.ws + WS_CNT); int* fill = (int*)(p.ws + WS_FILL); int* rowtok = (int*)(p.ws + WS_ROWTOK);
    for (int i = gtid; i < L * 32; i += gsz) { cnt[i] = 0; fill[i] = 0; }
    for (int i = gtid; i < L * RMAX; i += gsz) rowtok[i] = -1;
    const float* c = p.in[1];
    for (int i = tid; i < Bn * D; i += NT) { const float v = c[i]; lds[i] = v / (1.f + __expf(-v)); }
    __syncthreads();
    const float* ada_w = p.in[2];
    float* modp = (float*)(p.ws + WS_MODP);
    for (int idx = gtid; idx < 8 * L * 6144; idx += gsz) {
        const int col = idx % 6144, l = (idx / 6144) % L, kc = idx / (6144 * L);
        const float* w = ada_w + ((size_t)l * D + kc * 128) * 6144 + col;
        float a0 = 0.f, a1 = 0.f;
#pragma unroll 8
        for (int k = 0; k < 128; ++k) { const float wv = w[(size_t)k * 6144]; a0 += lds[kc * 128 + k] * wv; a1 += lds[D + kc * 128 + k] * wv; }
        modp[((size_t)(kc * L + l) * Bn + 0) * 6144 + col] = a0;
        modp[((size_t)(kc * L + l) * Bn + 1) * 6144 + col] = a1;
    }
}
__device__ __forceinline__ void phase_p0b(const Params& p) {
    const int gtid = blockIdx.x * NT + otid(), gsz = gridDim.x * NT;
    const float* modp = (const float*)(p.ws + WS_MODP); float* mod = (float*)(p.ws + WS_MOD); const float* ada_b = p.in[3];
    for (int idx = gtid; idx < L * Bn * 6144; idx += gsz) {
        const int col = idx % 6144, l = idx / (Bn * 6144);
        float s = ada_b[l * 6144 + col];
#pragma unroll
        for (int kc = 0; kc < 8; ++kc) s += modp[(size_t)kc * L * Bn * 6144 + idx];
        mod[idx] = s;
    }
}

__device__ __forceinline__ void phase_r1(const Params& p, int l, bool do_h) {
    const int lane = otid() & 63, wave = otid() >> 6;
    const int gw = blockIdx.x * NW + wave, ngw = gridDim.x * NW;
    const float* mod = (const float*)(p.ws + WS_MOD);
    const float* xin = p.in[0]; float* XA = p.out; float* H = (float*)(p.ws + WS_H);
    const float* Y = (const float*)(p.ws + WS_Y); const int* pos = (const int*)(p.ws + WS_POS);
    const float* lng = p.in[4] + (size_t)(do_h ? l : 0) * D;
    bf16_t* XN = (bf16_t*)(p.ws + WS_XN);
    for (int t = gw; t < T; t += ngw) {
        const int b = t / S;
        float4 v[4];
        if (l == 0) {
#pragma unroll
            for (int j = 0; j < 4; ++j) v[j] = *(const float4*)(xin + (size_t)t * D + 4 * lane + 256 * j);
        } else {
            const float* g2 = mod + ((size_t)(l - 1) * Bn + b) * 6144 + 5 * D;
            const int p0 = pos[t * 4 + 0], p1 = pos[t * 4 + 1], p2 = pos[t * 4 + 2], p3 = pos[t * 4 + 3];
#pragma unroll
            for (int j = 0; j < 4; ++j) {
                const int col = 4 * lane + 256 * j;
                const float4 x = *(const float4*)(XA + (size_t)t * D + col);
                const float4 y0 = *(const float4*)(Y + (size_t)p0 * D + col), y1 = *(const float4*)(Y + (size_t)p1 * D + col);
                const float4 y2 = *(const float4*)(Y + (size_t)p2 * D + col), y3 = *(const float4*)(Y + (size_t)p3 * D + col);
                const float4 g = *(const float4*)(g2 + col);
                float4 r;
                r.x = x.x + g.x * (((y0.x + y1.x) + y2.x) + y3.x); r.y = x.y + g.y * (((y0.y + y1.y) + y2.y) + y3.y);
                r.z = x.z + g.z * (((y0.z + y1.z) + y2.z) + y3.z); r.w = x.w + g.w * (((y0.w + y1.w) + y2.w) + y3.w);
                v[j] = r;
                *(float4*)(XA + (size_t)t * D + col) = r;
            }
        }
        if (do_h) {
            float ss = 0.f;
#pragma unroll
            for (int j = 0; j < 4; ++j) ss += (v[j].x * v[j].x + v[j].y * v[j].y) + (v[j].z * v[j].z + v[j].w * v[j].w);
            ss = wave_sum(ss);
            const float r = rsqrtf(ss * (1.f / D) + EPS);
            const float* sh = mod + ((size_t)l * Bn + b) * 6144 + 0 * D; const float* sc = mod + ((size_t)l * Bn + b) * 6144 + 1 * D;
#pragma unroll
            for (int j = 0; j < 4; ++j) {
                const int col = 4 * lane + 256 * j;
                const float4 g = *(const float4*)(lng + col), s1 = *(const float4*)(sc + col), s0 = *(const float4*)(sh + col);
                float4 o;
                o.x = v[j].x * r * g.x * (1.f + s1.x) + s0.x; o.y = v[j].y * r * g.y * (1.f + s1.y) + s0.y;
                o.z = v[j].z * r * g.z * (1.f + s1.z) + s0.z; o.w = v[j].w * r * g.w * (1.f + s1.w) + s0.w;
                *(float4*)(H + (size_t)t * D + col) = o;
                *(uint2*)(XN + (size_t)t * D + col) = make_uint2(pk2(o.x, o.y), pk2(o.z, o.w));
            }
        }
    }
}

__device__ __forceinline__ void phase_g1(const Params& p, int l, float* lds) {
    const float* H = (const float*)(p.ws + WS_H); const float* W = p.in[6] + (size_t)l * D * INW; float* Z = (float*)(p.ws + WS_Z);
    constexpr int NTN = (INW + 63) / 64, NTM = T / 128;
    auto al = [=](int r, int k) -> float4 { return *(const float4*)(H + (size_t)r * D + k); };
    auto bl = [=](int k, int n) -> float2 { return n < INW ? *(const float2*)(W + (size_t)k * INW + n) : make_float2(0.f, 0.f); };
    auto ep = [=](int r, int c, float v) { if (c < INW) Z[(size_t)r * INW + c] = v; };
    for (int tile = blockIdx.x; tile < NTM * NTN; tile += gridDim.x) {
        const int tm = tile / NTN, tn = tile % NTN;
        gemm_tile(lds, tm * 128, tn * 64, D, al, bl, ep);
    }
}

__device__ __forceinline__ void phase_zp(const Params& p, int l) {
    const int lane = otid() & 63, wave = otid() >> 6;
    const int gw = blockIdx.x * NW + wave, ngw = gridDim.x * NW;
    float* Z = (float*)(p.ws + WS_Z);
    const float gq = p.in[7][l * 64 + lane], gk = p.in[8][l * 64 + lane], gmq = p.in[12][l * 64 + lane], gmk = p.in[13][l * 64 + lane];
    for (int t = gw; t < T; t += ngw) {
        float* z = Z + (size_t)t * INW;
        for (int seg = 0; seg < 28; ++seg) {
            int col; float g;
            if (seg < 8) { col = ZC_Q + seg * 64; g = gq; }
            else if (seg < 10) { col = ZC_KS + (seg - 8) * 64; g = gk; }
            else if (seg < 12) { col = ZC_KW + (seg - 10) * 64; g = gk; }
            else if (seg < 20) { col = ZC_MQ + (seg - 12) * 64; g = gmq; }
            else { col = ZC_MK + (seg - 20) * 64; g = gmk; }
            const float v = z[col + lane];
            const float ss = wave_sum(v * v);
            z[col + lane] = v * rsqrtf(ss * (1.f / 64.f) + EPS) * g;
        }
        if (lane < 24) z[ZC_G + lane] = sigmoidf_(z[ZC_G + lane]);
    }
}

__device__ __forceinline__ void phase_ck(const Params& p, int l, float* lds) {
    const bf16_t* Z = (const bf16_t*)(p.ws + WS_ZB);
    float* HID = (float*)(p.ws + WS_HID);
    const float* posw = p.in[9] + (size_t)l * 2 * 32 * 64; const float* w1 = p.in[10] + (size_t)l * 2 * 2048 * 128;
    for (int tile = blockIdx.x; tile < 64; tile += gridDim.x) {
        const int idx = tile / 32, tm = (tile % 32) / 2, tn = tile % 2;
        const float* W = w1 + (size_t)idx * 2048 * 128; const float* PW = posw + (size_t)idx * 32 * 64; float* HO = HID + (size_t)idx * 2044 * 128;
        auto al = [=](int r, int k) -> float4 {
            if (r >= 2044) return make_float4(0.f, 0.f, 0.f, 0.f);
            const int b = r / 1022, g = (r / 511) & 1, n = r % 511, li = k >> 6, d = k & 63;
            const uint2 ab = *(const uint2*)(Z + (size_t)(b * S + 16 * n + li) * ZBW + ZB_KC + idx * 128 + g * 64 + d);
            const float4 a = make_float4(__builtin_bit_cast(float, ab.x << 16), __builtin_bit_cast(float, ab.x & 0xffff0000u), __builtin_bit_cast(float, ab.y << 16), __builtin_bit_cast(float, ab.y & 0xffff0000u));
            const float4 q = *(const float4*)(PW + li * 64 + d);
            return make_float4(a.x + q.x, a.y + q.y, a.z + q.z, a.w + q.w);
        };
        auto bl = [=](int k, int n) -> float2 { return *(const float2*)(W + (size_t)k * 128 + n); };
        auto ep = [=](int r, int c, float v) { if (r < 2044) HO[(size_t)r * 128 + c] = gelu_tanh(v); };
        gemm_tile(lds, tm * 128, tn * 64, 2048, al, bl, ep);
    }
    const int lane = otid() & 63, wave = otid() >> 6;
    float* KM = (float*)(p.ws + WS_KM);
    for (int it = blockIdx.x * NW + wave; it < Bn * 8 * 32; it += gridDim.x * NW) {
        const int b = it / 256, h = (it / 32) & 7, blk = it & 31;
        const bf16_t* base = Z + (size_t)(b * S + blk * 256) * ZBW + ZB_MK + h * 64 + lane;
        float s = 0.f;
        for (int i = 0; i < 256; ++i) s += bf2f(base[(size_t)i * ZBW]);
        KM[(size_t)it * 64 + lane] = s * (1.f / 256.f);
        ((bf16_t*)(p.ws + WS_KMB))[(size_t)it * 64 + lane] = (bf16_t)f2bf(s * (1.f / 256.f));
    }
}
__device__ __forceinline__ void phase_c2(const Params& p, int l) {
    const int lane = otid() & 63, wave = otid() >> 6;
    const float* HID = (const float*)(p.ws + WS_HID); const float* w2 = p.in[11] + (size_t)l * 2 * 128 * 64;
    float* KC = (float*)(p.ws + WS_KC); float* VC = (float*)(p.ws + WS_VC);
    const float gk = p.in[8][l * 64 + lane];
    for (int r = blockIdx.x * NW + wave; r < 2 * 2044; r += gridDim.x * NW) {
        const int idx = r / 2044, rr = r % 2044;
        const float* hrow = HID + (size_t)r * 128; const float* W = w2 + (size_t)idx * 128 * 64;
        float s = 0.f;
        for (int j = 0; j < 128; ++j) s += hrow[j] * W[j * 64 + lane];
        const int bgi = rr / 511, n = rr % 511;
        if (idx == 0) { const float ss = wave_sum(s * s); const float kv = s * rsqrtf(ss * (1.f / 64.f) + EPS) * gk; KC[(size_t)rr * 64 + lane] = kv; ((bf16_t*)(p.ws + WS_KCB))[((size_t)bgi * 512 + n) * 64 + lane] = (bf16_t)f2bf(kv); }
        else { VC[(size_t)rr * 64 + lane] = s; ((bf16_t*)(p.ws + WS_VCB))[((size_t)bgi * 512 + n) * 64 + lane] = (bf16_t)f2bf(s); }
    }
    if (blockIdx.x == 0 && otid() < 2 * 4 * 64) { const int i = otid(); bf16_t* dst = (bf16_t*)(p.ws + (i < 256 ? WS_KCB : WS_VCB)); dst[((size_t)((i & 255) >> 6) * 512 + 511) * 64 + (i & 63)] = 0; }
}

__device__ __forceinline__ void ld32bf(const bf16_t* p, float (&out)[32]) {
#pragma unroll
    for (int c = 0; c < 4; ++c) { const uint4 v = *(const uint4*)(p + 8 * c); const unsigned w[4] = {v.x, v.y, v.z, v.w};
#pragma unroll
        for (int i = 0; i < 4; ++i) { out[8 * c + 2 * i] = __builtin_bit_cast(float, w[i] << 16); out[8 * c + 2 * i + 1] = __builtin_bit_cast(float, w[i] & 0xffff0000u); } }
}
#define ATT_KEY(valid, kp, vp, bias)                                                              \
    {                                                                                             \
        float kk_[32]; ld32bf(kp, kk_);                                                           \
        float s_ = 0.f;                                                                           \
        _Pragma("unroll") for (int d = 0; d < 32; ++d) s_ += qv[d] * kk_[d];                      \
        s_ += __shfl_xor(s_, 1);                                                                  \
        s_ = s_ - (bias);                                                                         \
        if (valid) {                                                                              \
            float vv_[32]; ld32bf(vp, vv_);                                                       \
            if (s_ > m) { const float cf = exp2f(m - s_); lsum *= cf; _Pragma("unroll") for (int d = 0; d < 32; ++d) o[d] *= cf; m = s_; } \
            const float p_ = exp2f(s_ - m); lsum += p_;                                           \
            _Pragma("unroll") for (int d = 0; d < 32; ++d) o[d] += p_ * vv_[d];                   \
        }                                                                                         \
    }

__device__ __forceinline__ void nsa_item(const Params& p, int item, float* lds) {
    const int tid = otid(), q = (tid & 63) >> 1, half = tid & 1, h = __builtin_amdgcn_readfirstlane(tid >> 6), g = h >> 2, hg = h & 3;
    const int b = item >> 8, ci = item & 255, t0 = ci * 32, t = t0 + q, cur = t0 >> 6; const size_t tt = (size_t)b * S + t;
    const bf16_t* Z = (const bf16_t*)(p.ws + WS_ZB); const float* GT = (const float*)(p.ws + WS_GATE); float* ATT = (float*)(p.ws + WS_ATT);
    const float* KC = (const float*)(p.ws + WS_KC) + (size_t)(b * 2 + g) * NCMP * 64 + half * 32; const float* VC = (const float*)(p.ws + WS_VC) + (size_t)(b * 2 + g) * NCMP * 64 + half * 32;
    float* imp = lds;
    unsigned* selm = (unsigned*)(lds + 2 * 32 * 129);
    const float slope = exp2f(-(float)(h + 1)) * LOG2E;
    float qv[32], o[32];
    ld32bf(Z + tt * ZBW + ZB_Q + h * 64 + half * 32, qv);
    const float g0 = GT[tt * 32 + h * 3 + 0], g1 = GT[tt * 32 + h * 3 + 1], g2 = GT[tt * 32 + h * 3 + 2];
    for (int i = tid; i < 2 * 32 * 129; i += NT) imp[i] = 0.f;
    const int cnt_t = t >= 31 ? (t - 31) / 16 + 1 : 0;
    const int cnt_max = (t0 + 31 - 31) / 16 + 1;
    float m = NEGF, lsum = 0.f;
    _Pragma("unroll 1") for (int n = 0; n < cnt_max; ++n) {
        const float* kp = KC + (size_t)n * 64;
        float s_ = 0.f;
#pragma unroll
        for (int d = 0; d < 32; ++d) s_ += qv[d] * kp[d];
        s_ += __shfl_xor(s_, 1);
        s_ = s_ - slope * ((float)t - (16.f * n + 15.5f));
        if (n < cnt_t) { if (s_ > m) { lsum *= exp2f(m - s_); m = s_; } lsum += exp2f(s_ - m); }
    }
    const float linv = lsum > 0.f ? 1.f / lsum : 0.f;
#pragma unroll
    for (int d = 0; d < 32; ++d) o[d] = 0.f;
    __syncthreads();
    _Pragma("unroll 1") for (int r = 0; r < 4; ++r) {
        if (hg == r) {
            float* myimp = imp + (size_t)(g * 32 + q) * 129;
            _Pragma("unroll 1") for (int n = 0; n < cnt_max; ++n) {
                const float* kp = KC + (size_t)n * 64; const float* vp = VC + (size_t)n * 64;
                float s_ = 0.f;
#pragma unroll
                for (int d = 0; d < 32; ++d) s_ += qv[d] * kp[d];
                s_ += __shfl_xor(s_, 1);
                s_ = s_ - slope * ((float)t - (16.f * n + 15.5f));
                if (n < cnt_t) {
                    const float p_ = exp2f(s_ - m) * linv;
#pragma unroll
                    for (int d = 0; d < 32; ++d) o[d] += p_ * vp[d];
                    if (half == 0) {
                        myimp[n >> 2] += p_;
                        if ((n & 3) == 3) myimp[(n + 1) >> 2] += p_;
                    }
                }
            }
        }
        __syncthreads();
    }
    {
        float* ao = ATT + tt * D + h * 64 + half * 32;
#pragma unroll
        for (int d = 0; d < 32; d += 4) *(float4*)(ao + d) = make_float4(g0 * o[d], g0 * o[d + 1], g0 * o[d + 2], g0 * o[d + 3]);
    }
    if (hg == 0 && half == 0) {
        float* myimp = imp + (size_t)(g * 32 + q) * 129;
        _Pragma("unroll 1") for (int j = 0; j < 128; ++j) {
            float v = myimp[j];
            if (j == 0 || j == cur || j == cur - 1) v = 1e4f;
            if (j > cur) v = NEGF;
            myimp[j] = v;
        }
        unsigned mk0 = 0u, mk1 = 0u, mk2 = 0u, mk3 = 0u;
        _Pragma("unroll 1") for (int it = 0; it < 16; ++it) {
            float best = -3e38f; int bi = -1;
            _Pragma("unroll 4") for (int j = 0; j < 128; ++j) { const float v = myimp[j]; if (v > best) { best = v; bi = j; } }
            if (best <= NEGF) break;
            myimp[bi] = -3.4e38f;
            const unsigned bit = 1u << (bi & 31);
            if ((bi >> 5) == 0) mk0 |= bit; else if ((bi >> 5) == 1) mk1 |= bit; else if ((bi >> 5) == 2) mk2 |= bit; else mk3 |= bit;
        }
        unsigned* sm = selm + (g * 32 + q) * 4;
        sm[0] = mk0; sm[1] = mk1; sm[2] = mk2; sm[3] = mk3;
    }
    __syncthreads();
    {
        const unsigned* sm = selm + (g * 32 + q) * 4;
        const unsigned m0 = sm[0], m1 = sm[1], m2 = sm[2], m3 = sm[3];
        m = NEGF; lsum = 0.f;
#pragma unroll
        for (int d = 0; d < 32; ++d) o[d] = 0.f;
        _Pragma("unroll 1") for (int j = 0; j <= cur; ++j) {
            const unsigned w = (j >> 5) == 0 ? m0 : (j >> 5) == 1 ? m1 : (j >> 5) == 2 ? m2 : m3;
            const bool sel = (w >> (j & 31)) & 1u;
            if (__ballot(sel) == 0ull) continue;
            _Pragma("unroll 1") for (int kk = 0; kk < 64; ++kk) {
                const int ps = j * 64 + kk;
                const bf16_t* kp = Z + (size_t)(b * S + ps) * ZBW + ZB_KS + g * 64 + half * 32; const bf16_t* vp = Z + (size_t)(b * S + ps) * ZBW + ZB_VS + g * 64 + half * 32;
                const bool valid = sel && ps <= t;
                ATT_KEY(valid, kp, vp, slope * (float)(t - ps));
            }
        }
        const float li = lsum > 0.f ? g1 / lsum : 0.f;
        float* ao = ATT + tt * D + h * 64 + half * 32;
#pragma unroll
        for (int d = 0; d < 32; d += 4) { float4 a = *(float4*)(ao + d); a.x += li * o[d]; a.y += li * o[d + 1]; a.z += li * o[d + 2]; a.w += li * o[d + 3]; *(float4*)(ao + d) = a; }
    }
    {
        m = NEGF; lsum = 0.f;
#pragma unroll
        for (int d = 0; d < 32; ++d) o[d] = 0.f;
        const int lo = t0 - 511 > 0 ? t0 - 511 : 0;
        _Pragma("unroll 1") for (int ps = lo; ps <= t0 + 31; ++ps) {
            const bf16_t* kp = Z + (size_t)(b * S + ps) * ZBW + ZB_KW + g * 64 + half * 32; const bf16_t* vp = Z + (size_t)(b * S + ps) * ZBW + ZB_VW + g * 64 + half * 32;
            const bool valid = ps <= t && ps > t - 512;
            ATT_KEY(valid, kp, vp, slope * (float)(t - ps));
        }
        const float li = lsum > 0.f ? g2 / lsum : 0.f;
        float* ao = ATT + tt * D + h * 64 + half * 32;
        bf16_t* ab = (bf16_t*)(p.ws + WS_ATTB) + tt * D + h * 64 + half * 32;
#pragma unroll
        for (int d = 0; d < 32; d += 4) { float4 a = *(float4*)(ao + d); a.x += li * o[d]; a.y += li * o[d + 1]; a.z += li * o[d + 2]; a.w += li * o[d + 3]; *(float4*)(ao + d) = a;
            *(uint2*)(ab + d) = make_uint2(pk2(a.x, a.y), pk2(a.z, a.w)); }
    }
    __syncthreads();
}

__device__ __forceinline__ void moba_item(const Params& p, int item) {
    const int tid = otid(), q = (tid & 63) >> 1, half = tid & 1, h = __builtin_amdgcn_readfirstlane(tid >> 6);
    const int b = item >> 8, ci = item & 255, t0 = ci * 32, t = t0 + q, cb = t0 >> 8; const size_t tt = (size_t)b * S + t;
    const bf16_t* Z = (const bf16_t*)(p.ws + WS_ZB); const float* GT = (const float*)(p.ws + WS_GATE); float* ATT = (float*)(p.ws + WS_ATT);
    const float* KM = (const float*)(p.ws + WS_KM) + (size_t)(b * 8 + h) * 32 * 64 + half * 32;
    const float slope = exp2f(-(float)(h + 1)) * LOG2E;
    float qv[32], o[32];
    ld32bf(Z + tt * ZBW + ZB_MQ + h * 64 + half * 32, qv);
    float v1 = NEGF, v2 = NEGF, v3 = NEGF; int i1 = -1, i2 = -1, i3 = -1;
    _Pragma("unroll 1") for (int n = 0; n < cb; ++n) {
        const float* kp = KM + n * 64;
        float s_ = 0.f;
#pragma unroll
        for (int d = 0; d < 32; ++d) s_ += qv[d] * kp[d];
        s_ += __shfl_xor(s_, 1);
        if (s_ > v1) { v3 = v2; i3 = i2; v2 = v1; i2 = i1; v1 = s_; i1 = n; }
        else if (s_ > v2) { v3 = v2; i3 = i2; v2 = s_; i2 = n; }
        else if (s_ > v3) { v3 = s_; i3 = n; }
    }
    float m = NEGF, lsum = 0.f;
#pragma unroll
    for (int d = 0; d < 32; ++d) o[d] = 0.f;
    _Pragma("unroll 1") for (int n = 0; n < cb; ++n) {
        const bool sel = (n == i1) || (n == i2) || (n == i3);
        if (__ballot(sel) == 0ull) continue;
        _Pragma("unroll 1") for (int kk = 0; kk < 256; ++kk) {
            const int ps = n * 256 + kk;
            const bf16_t* kp = Z + (size_t)(b * S + ps) * ZBW + ZB_MK + h * 64 + half * 32; const bf16_t* vp = Z + (size_t)(b * S + ps) * ZBW + ZB_MV + h * 64 + half * 32;
            ATT_KEY(sel, kp, vp, slope * (float)(t - ps));
        }
    }
    _Pragma("unroll 1") for (int ps = cb * 256; ps <= t0 + 31; ++ps) {
        const bf16_t* kp = Z + (size_t)(b * S + ps) * ZBW + ZB_MK + h * 64 + half * 32; const bf16_t* vp = Z + (size_t)(b * S + ps) * ZBW + ZB_MV + h * 64 + half * 32;
        const bool valid = ps <= t;
        ATT_KEY(valid, kp, vp, slope * (float)(t - ps));
    }
    const float li = lsum > 0.f ? 1.f / lsum : 0.f;
    float* ao = ATT + tt * D + 512 + h * 64 + half * 32;
#pragma unroll
    for (int d = 0; d < 32; d += 4) *(float4*)(ao + d) = make_float4(li * o[d], li * o[d + 1], li * o[d + 2], li * o[d + 3]);
    bf16_t* ab = (bf16_t*)(p.ws + WS_ATTB) + tt * D + 512 + h * 64 + half * 32;
#pragma unroll
    for (int d = 0; d < 32; d += 4) *(uint2*)(ab + d) = make_uint2(pk2(li * o[d], li * o[d + 1]), pk2(li * o[d + 2], li * o[d + 3]));
}

__device__ __forceinline__ void phase_att(const Params& p, float* lds) {
    for (int pi = blockIdx.x; pi < 512; pi += gridDim.x) {
        nsa_item(p, pi, lds);
        moba_item(p, (pi & 256) | (255 - (pi & 255)));
    }
}

__device__ __forceinline__ void phase_g2(const Params& p, int l, float* lds) {
    const float* A = (const float*)(p.ws + WS_ATT); const float* W = p.in[14] + (size_t)l * D * D;
    const float* xin = l == 0 ? p.in[0] : p.out; float* XA = p.out;
    const float* mod = (const float*)(p.ws + WS_MOD) + (size_t)l * Bn * 6144 + 2 * D;
    auto al = [=](int r, int k) -> float4 { return *(const float4*)(A + (size_t)r * D + k); };
    auto bl = [=](int k, int n) -> float2 { return *(const float2*)(W + (size_t)k * D + n); };
    auto ep = [=](int r, int c, float v) { const int b = r / S; XA[(size_t)r * D + c] = xin[(size_t)r * D + c] + mod[(size_t)b * 6144 + c] * v; };
    for (int tile = blockIdx.x; tile < (T / 128) * (D / 64); tile += gridDim.x) {
        const int tm = tile / (D / 64), tn = tile % (D / 64);
        gemm_tile(lds, tm * 128, tn * 64, D, al, bl, ep);
    }
}

__device__ __forceinline__ void phase_r2(const Params& p, int l, float* lds) {
    const int tid = otid(), lane = tid & 63, wave = tid >> 6;
    const int gw = blockIdx.x * NW + wave, ngw = gridDim.x * NW;
    const float* mod = (const float*)(p.ws + WS_MOD);
    const float* XA = p.out; float* H = (float*)(p.ws + WS_H);
    const float* lng = p.in[5] + (size_t)l * D; const float* rw = p.in[15] + (size_t)l * D * NE; const float* rb = p.in[16] + l * NE;
    int* toke = (int*)(p.ws + WS_TOKE); float* tokw = (float*)(p.ws + WS_TOKW); int* cnt = (int*)(p.ws + WS_CNT) + l * 32;
    bf16_t* XN = (bf16_t*)(p.ws + WS_XN);
    float* hrow = lds + wave * D;
    int* hist = (int*)(lds + NW * D);
    if (tid < 32) hist[tid] = 0;
    __syncthreads();
    for (int t = gw; t < T; t += ngw) {
        const int b = t / S;
        float4 v[4]; float ss = 0.f;
#pragma unroll
        for (int j = 0; j < 4; ++j) { v[j] = *(const float4*)(XA + (size_t)t * D + 4 * lane + 256 * j); ss += (v[j].x * v[j].x + v[j].y * v[j].y) + (v[j].z * v[j].z + v[j].w * v[j].w); }
        ss = wave_sum(ss);
        const float r = rsqrtf(ss * (1.f / D) + EPS);
        const float* sh = mod + ((size_t)l * Bn + b) * 6144 + 3 * D; const float* sc = mod + ((size_t)l * Bn + b) * 6144 + 4 * D;
#pragma unroll
        for (int j = 0; j < 4; ++j) {
            const int col = 4 * lane + 256 * j;
            const float4 g = *(const float4*)(lng + col), s1 = *(const float4*)(sc + col), s0 = *(const float4*)(sh + col);
            float4 o;
            o.x = v[j].x * r * g.x * (1.f + s1.x) + s0.x; o.y = v[j].y * r * g.y * (1.f + s1.y) + s0.y;
            o.z = v[j].z * r * g.z * (1.f + s1.z) + s0.z; o.w = v[j].w * r * g.w * (1.f + s1.w) + s0.w;
            *(float4*)(H + (size_t)t * D + col) = o;
            *(uint2*)(XN + (size_t)t * D + col) = make_uint2(pk2(o.x, o.y), pk2(o.z, o.w));
            *(float4*)(hrow + col) = o;
        }
        asm volatile("s_waitcnt lgkmcnt(0)" ::: "memory");
        __builtin_amdgcn_wave_barrier();
        const int e = lane & 31, half = lane >> 5;
        float acc = 0.f;
        for (int k = half * 512; k < half * 512 + 512; ++k) acc += hrow[k] * rw[(size_t)k * NE + e];
        acc += __shfl_xor(acc, 32);
        const float logit = acc + rb[e];
        float lg[32];
#pragma unroll
        for (int i = 0; i < 32; ++i) lg[i] = __shfl(logit, i);
        int s0i = 0, s1i = 0, s2i = 0, s3i = 0; float a0 = -3e38f, a1 = -3e38f, a2 = -3e38f, a3 = -3e38f;
#pragma unroll
        for (int i = 0; i < 32; ++i) if (lg[i] > a0) { a0 = lg[i]; s0i = i; }
#pragma unroll
        for (int i = 0; i < 32; ++i) if (i != s0i && lg[i] > a1) { a1 = lg[i]; s1i = i; }
#pragma unroll
        for (int i = 0; i < 32; ++i) if (i != s0i && i != s1i && lg[i] > a2) { a2 = lg[i]; s2i = i; }
#pragma unroll
        for (int i = 0; i < 32; ++i) if (i != s0i && i != s1i && i != s2i && lg[i] > a3) { a3 = lg[i]; s3i = i; }
        const float e0 = 1.f, e1 = __expf(a1 - a0), e2 = __expf(a2 - a0), e3 = __expf(a3 - a0);
        const float inv = 1.f / (((e0 + e1) + e2) + e3);
        if (lane == 0) {
            toke[t * 4 + 0] = s0i; toke[t * 4 + 1] = s1i; toke[t * 4 + 2] = s2i; toke[t * 4 + 3] = s3i;
            tokw[t * 4 + 0] = e0 * inv; tokw[t * 4 + 1] = e1 * inv; tokw[t * 4 + 2] = e2 * inv; tokw[t * 4 + 3] = e3 * inv;
            atomicAdd(&hist[s0i], 1); atomicAdd(&hist[s1i], 1); atomicAdd(&hist[s2i], 1); atomicAdd(&hist[s3i], 1);
        }
        __builtin_amdgcn_wave_barrier();
    }
    __syncthreads();
    if (tid < 32 && hist[tid] != 0) atomicAdd(&cnt[tid], hist[tid]);
}

__device__ __forceinline__ void load_pstart(const Params& p, int l, int* ps) {
    const int* cnt = (const int*)(p.ws + WS_CNT) + l * 32;
    if (otid() == 0) { int s = 0; for (int e = 0; e < 32; ++e) { ps[e] = s; s += (cnt[e] + 255) & ~255; } ps[32] = s; }
    __syncthreads();
}

__device__ __forceinline__ void phase_sc(const Params& p, int l, float* lds) {
    int* ps = (int*)lds;
    load_pstart(p, l, ps);
    const int gtid = blockIdx.x * NT + otid(), gsz = gridDim.x * NT;
    const int* toke = (const int*)(p.ws + WS_TOKE); const float* tokw = (const float*)(p.ws + WS_TOKW);
    int* fill = (int*)(p.ws + WS_FILL) + l * 32; int* rowtok = (int*)(p.ws + WS_ROWTOK) + (size_t)l * RMAX; float* roww = (float*)(p.ws + WS_ROWW) + (size_t)l * RMAX;
    int* pos = (int*)(p.ws + WS_POS);
    for (int i = gtid; i < A_TOT; i += gsz) {
        const int e = toke[i];
        const int slot = ps[e] + atomicAdd(&fill[e], 1);
        rowtok[slot] = i >> 2; roww[slot] = tokw[i]; pos[i] = slot;
    }
    __syncthreads();
}

__device__ __forceinline__ void phase_m1(const Params& p, int l, float* lds) {
    int* ps = (int*)(lds + 16 * 132 + 16 * 68);
    load_pstart(p, l, ps);
    const int rused = ps[32];
    const float* H = (const float*)(p.ws + WS_H); float* U = (float*)(p.ws + WS_U);
    const int* rowtok = (const int*)(p.ws + WS_ROWTOK) + (size_t)l * RMAX;
    const int ntm = rused / 128, ntn = 2048 / 64;
    for (int tile = blockIdx.x; tile < ntm * ntn; tile += gridDim.x) {
        const int tm = tile / ntn, tn = tile % ntn;
        int e = 0; for (int i = 1; i < 32; ++i) if (ps[i] <= tm * 128) e = i;
        const float* W = p.in[17] + ((size_t)l * NE + e) * D * 2048; const float* b1 = p.in[18] + ((size_t)l * NE + e) * 2048;
        auto al = [=](int r, int k) -> float4 { const int tk = rowtok[r]; return tk >= 0 ? *(const float4*)(H + (size_t)tk * D + k) : make_float4(0.f, 0.f, 0.f, 0.f); };
        auto bl = [=](int k, int n) -> float2 { return *(const float2*)(W + (size_t)k * 2048 + n); };
        auto ep = [=](int r, int c, float v) { U[(size_t)r * 2048 + c] = v + b1[c]; };
        gemm_tile(lds, tm * 128, tn * 64, D, al, bl, ep);
    }
    __syncthreads();
}
__device__ __forceinline__ void phase_m2(const Params& p, int l, float* lds) {
    int* ps = (int*)(lds + 16 * 132 + 16 * 68);
    load_pstart(p, l, ps);
    const int rused = ps[32];
    const float* U = (const float*)(p.ws + WS_U); float* Y = (float*)(p.ws + WS_Y);
    const float* roww = (const float*)(p.ws + WS_ROWW) + (size_t)l * RMAX;
    const int ntm = rused / 128, ntn = D / 64;
    for (int tile = blockIdx.x; tile < ntm * ntn; tile += gridDim.x) {
        const int tm = tile / ntn, tn = tile % ntn;
        int e = 0; for (int i = 1; i < 32; ++i) if (ps[i] <= tm * 128) e = i;
        const float* W = p.in[19] + ((size_t)l * NE + e) * DFF * D; const float* b2 = p.in[20] + ((size_t)l * NE + e) * D;
        auto al = [=](int r, int k) -> float4 {
            const float4 gg = *(const float4*)(U + (size_t)r * 2048 + k), ll = *(const float4*)(U + (size_t)r * 2048 + 1024 + k);
            const float g_[4] = {gg.x, gg.y, gg.z, gg.w}, l_[4] = {ll.x, ll.y, ll.z, ll.w}; float o_[4];
#pragma unroll
            for (int i = 0; i < 4; ++i) { const float gc = fminf(g_[i], 7.f), lc = fminf(fmaxf(l_[i], -7.f), 7.f); o_[i] = (lc + 1.f) * gc * sigmoidf_(1.702f * gc); }
            return make_float4(o_[0], o_[1], o_[2], o_[3]);
        };
        auto bl = [=](int k, int n) -> float2 { return *(const float2*)(W + (size_t)k * D + n); };
        auto ep = [=](int r, int c, float v) { Y[(size_t)r * D + c] = (v + b2[c]) * roww[r]; };
        gemm_tile(lds, tm * 128, tn * 64, DFF, al, bl, ep);
    }
    __syncthreads();
}


template <int MAP>
__device__ __forceinline__ void tr_tile(const float* W, int Nsrc, bf16_t* WT, int K, int k0, int n0, float* scr, int lane) {
    const int nl = (lane & 15) * 4, kr = lane >> 4;
    int sc = n0 + nl;
    if (MAP == 1) { sc = sc < 1280 ? sc : (sc < 2816 ? sc + 24 : (sc < 2840 ? sc - 2816 + 1280 : -1)); }
    float4 v[16];
#pragma unroll
    for (int it = 0; it < 16; ++it) v[it] = sc >= 0 ? *(const float4*)(W + (size_t)(k0 + it * 4 + kr) * Nsrc + sc) : make_float4(0.f, 0.f, 0.f, 0.f);
#pragma unroll
    for (int it = 0; it < 16; ++it) { float* s = scr + (it * 4 + kr) * 65 + nl; s[0] = v[it].x; s[1] = v[it].y; s[2] = v[it].z; s[3] = v[it].w; }
    asm volatile("s_waitcnt lgkmcnt(0)" ::: "memory"); __builtin_amdgcn_wave_barrier();
    const int c = lane & 7, nr = lane >> 3;
#pragma unroll
    for (int it = 0; it < 8; ++it) {
        const int n = it * 8 + nr; const float* s = scr + (8 * c) * 65 + n;
        uint4 o; o.x = pk2(s[0], s[65]); o.y = pk2(s[2 * 65], s[3 * 65]); o.z = pk2(s[4 * 65], s[5 * 65]); o.w = pk2(s[6 * 65], s[7 * 65]);
        *(uint4*)(WT + (size_t)(n0 + n) * K + k0 + 8 * c) = o;
    }
    asm volatile("s_waitcnt lgkmcnt(0)" ::: "memory"); __builtin_amdgcn_wave_barrier();
}
__device__ __forceinline__ void phase_convert(const Params& p, float* lds) {
    const int tid = otid(), lane = tid & 63, wave = tid >> 6;
    float* scr = lds + wave * (64 * 65);
    const int gw = blockIdx.x * NW + wave, ngw = gridDim.x * NW;
    bf16_t* WinT = (bf16_t*)(p.ws + WS_WINT); bf16_t* WoT = (bf16_t*)(p.ws + WS_WOT); bf16_t* W1T = (bf16_t*)(p.ws + WS_W1T); bf16_t* W2T = (bf16_t*)(p.ws + WS_W2T);
    constexpr int I_IN = L * 16 * (ZBW / 64), I_O = L * 16 * 16, I_1 = L * NE * 16 * 32, I_2 = L * NE * 16 * 16;
    for (int it = gw; it < I_IN + I_O + I_1 + I_2; it += ngw) {
        int r = it;
        if (r < I_IN) { const int l = r / (16 * 48), q = r % (16 * 48), kb = q / 48, nb = q % 48;
            tr_tile<1>(p.in[6] + (size_t)l * D * INW, INW, WinT + (size_t)l * ZBW * D, D, kb * 64, nb * 64, scr, lane); continue; }
        r -= I_IN;
        if (r < I_O) { const int l = r / 256, q = r % 256, kb = q / 16, nb = q % 16;
            tr_tile<0>(p.in[14] + (size_t)l * D * D, D, WoT + (size_t)l * D * D, D, kb * 64, nb * 64, scr, lane); continue; }
        r -= I_O;
        if (r < I_1) { const int le = r / 512, q = r % 512, kb = q / 32, nb = q % 32;
            tr_tile<0>(p.in[17] + (size_t)le * D * 2048, 2048, W1T + (size_t)le * 2048 * D, D, kb * 64, nb * 64, scr, lane); continue; }
        r -= I_1;
        { const int le = r / 256, q = r % 256, kb = q / 16, nb = q % 16;
            tr_tile<0>(p.in[19] + (size_t)le * DFF * D, D, W2T + (size_t)le * D * DFF, DFF, kb * 64, nb * 64, scr, lane); }
    }
    if (blockIdx.x == 0) { bf16_t* XN = (bf16_t*)(p.ws + WS_XN); for (int i = tid; i < D / 2; i += NT) ((unsigned*)(XN + (size_t)T * D))[i] = 0u; }
}

namespace pg8 {
#define PG8_LAS __attribute__((address_space(3)))
typedef short bf16x8 __attribute__((ext_vector_type(8)));
typedef float f32x4 __attribute__((ext_vector_type(4)));
typedef unsigned u32x4 __attribute__((ext_vector_type(4)));
constexpr int BM = 256, BK = 64, HALF = 128, HTB = HALF * BK * 2, STAGE_BYTES = 8 * HTB, NXCD = 8, WGM = 8;
__device__ __forceinline__ int lds_byte(int r, int c) { const int st = (r >> 4) * 2 + (c >> 5), rr = r & 15, cc = c & 31, ob = rr * 64 + cc * 2; return st * 1024 + (ob ^ (((ob >> 9) & 1) << 5)); }
__device__ __forceinline__ void stage_rc(int b, int& R, int& C) { const int st = b / 1024, sb = b % 1024, swz = sb ^ (((sb >> 9) & 1) << 5); R = (st >> 1) * 16 + swz / 64; C = (st & 1) * 32 + (swz % 64) / 2; }
__device__ __forceinline__ int perm32(int rho) { const int n = rho >> 4, i = rho & 15; return 8 * (i >> 2) + 4 * n + (i & 3); }
struct Unit { int pm, pn, e; };
__device__ __forceinline__ unsigned cvt_pk_bf16(float lo, float hi) { unsigned r; asm volatile("v_cvt_pk_bf16_f32 %0, %1, %2" : "=v"(r) : "v"(lo), "v"(hi)); return r; }

__device__ __forceinline__ bool static_next(int nM, int nN, int G, int c, int i, Unit& u) {
    const int nwg = nM * nN; const long Lq = (long)i * G + c; if (Lq >= nwg) return false;
    int wgid = (int)Lq; { const int q = nwg / NXCD, r = nwg % NXCD, xcd = wgid % NXCD, off = wgid / NXCD; wgid = (xcd < r ? xcd * (q + 1) : r * (q + 1) + (xcd - r) * q) + off; }
    const int nig = WGM * nN, gid = wgid / nig, fm = gid * WGM, gsz = (nM - fm) < WGM ? (nM - fm) : WGM;
    u.pm = fm + ((wgid % nig) % gsz); u.pn = (wgid % nig) / gsz; u.e = 0; return true;
}

template <class Prob, class Epi, bool ALIGN_EPI, bool SP2>
__device__ __forceinline__ void gemm_phase(PG8_LAS unsigned char* lds, const Prob& P, const Epi& E) {
    const int tid = otid(), wid = __builtin_amdgcn_readfirstlane(tid >> 6), lane = tid & 63, wr = wid >> 2, wc = wid & 3, fr = lane & 15, fq = lane >> 4;
    const int K = P.K, nt = K / BK;
    int sR[2], sC[2]; unsigned voffB[2];
#pragma unroll
    for (int i = 0; i < 2; ++i) { stage_rc(tid * 16 + i * 8192, sR[i], sC[i]); voffB[i] = (unsigned)(P.b_row(sR[i]) * K + sC[i]) * 2u; }
    const size_t kstep = (size_t)(BK * 2);
    const size_t hstepB = P.b_hstep();
    const unsigned ldsw = (unsigned)wid * 1024u;
    const int aoff = lds_byte(wr * 64 + fr, fq * 8), boff = lds_byte(wc * 32 + fr, fq * 8);
#define PG8_SA(b, h) (((b) * 2 + (h)) * HTB)
#define PG8_SB(b, h) ((4 + (b) * 2 + (h)) * HTB)
#define PG8_STAGE(bufoff, gbase, voff) do { _Pragma("unroll") for (int _i = 0; _i < 2; ++_i) \
        __builtin_amdgcn_global_load_lds((const unsigned*)((const char*)(gbase) + (voff)[_i]), (PG8_LAS unsigned*)(lds + (bufoff) + ldsw + _i * 8192), 16, 0, 0); } while (0)
#define PG8_STAGE_SEL(bufoff, gbase, h) do { _Pragma("unroll") for (int _i = 0; _i < 2; ++_i) { unsigned _vo = vAc[h][_i]; if constexpr (Prob::GATHER) _vo = last ? vAn[h][_i] : _vo; \
        __builtin_amdgcn_global_load_lds((const unsigned*)((const char*)(gbase) + _vo), (PG8_LAS unsigned*)(lds + (bufoff) + ldsw + _i * 8192), 16, 0, 0); } } while (0)
#define PG8_LDA(dst, b, h) do { _Pragma("unroll") for (int m = 0; m < 4; ++m) _Pragma("unroll") for (int k = 0; k < 2; ++k) dst[m][k] = *(const PG8_LAS bf16x8*)(lds + PG8_SA(b, h) + aoff + m * 2048 + k * 1024); } while (0)
#define PG8_LDB(dst, b, h) do { _Pragma("unroll") for (int n = 0; n < 2; ++n) _Pragma("unroll") for (int k = 0; k < 2; ++k) dst[n][k] = *(const PG8_LAS bf16x8*)(lds + PG8_SB(b, h) + boff + n * 2048 + k * 1024); } while (0)
#define PG8_MMA(ai, bj, At, Bt) do { __builtin_amdgcn_s_setprio(1); _Pragma("unroll") for (int m = 0; m < 4; ++m) _Pragma("unroll") for (int n = 0; n < 2; ++n) _Pragma("unroll") for (int k = 0; k < 2; ++k) \
        acc[ai][bj][m][n] = __builtin_amdgcn_mfma_f32_16x16x32_bf16(Bt[n][k], At[m][k], acc[ai][bj][m][n], 0, 0, 0); __builtin_amdgcn_s_setprio(0); } while (0)
#define PG8_WAIT_V(n) asm volatile("s_waitcnt vmcnt(" #n ")" ::: "memory")
#define PG8_WAIT_L(n) asm volatile("s_waitcnt lgkmcnt(" #n ")" ::: "memory")
#define PG8_BAR __builtin_amdgcn_s_barrier()
#define PG8_SCHED __builtin_amdgcn_sched_barrier(0)
    Unit cur, nxt; int ui = 0;
    if (!P.next(0, cur)) return;
    f32x4 acc[2][2][4][2];
#pragma unroll
    for (int a = 0; a < 2; ++a)
#pragma unroll
        for (int b = 0; b < 2; ++b)
#pragma unroll
            for (int m = 0; m < 4; ++m)
#pragma unroll
                for (int n = 0; n < 2; ++n) acc[a][b][m][n] = (f32x4){0.f, 0.f, 0.f, 0.f};
    bf16x8 At[4][2], B0[2][2], B1[2][2];
    unsigned vAc[2][2], vAn[2][2];
    const char* cA = P.a_base(cur); const char* cB = P.b_base(cur);
    P.a_voff(cur, sR, sC, vAc);
#pragma unroll
    for (int h = 0; h < 2; ++h)
#pragma unroll
        for (int i = 0; i < 2; ++i) vAn[h][i] = vAc[h][i];
    if constexpr (SP2) {
        PG8_STAGE(PG8_SB(0, 0), cB, voffB); PG8_STAGE(PG8_SB(0, 1), cB + hstepB, voffB); PG8_STAGE(PG8_SA(0, 0), cA, vAc[0]); PG8_STAGE(PG8_SA(0, 1), cA, vAc[1]);
        if (wr == 1) PG8_BAR;
        PG8_WAIT_V(2); PG8_BAR;
        PG8_STAGE(PG8_SB(1, 0), cB + kstep, voffB); PG8_STAGE(PG8_SA(1, 0), cA + kstep, vAc[0]); PG8_STAGE(PG8_SB(1, 1), cB + hstepB + kstep, voffB);
        PG8_WAIT_V(6); PG8_BAR;
    } else {
        PG8_STAGE(PG8_SB(0, 0), cB, voffB); PG8_STAGE(PG8_SA(0, 0), cA, vAc[0]); PG8_STAGE(PG8_SB(0, 1), cB + hstepB, voffB); PG8_STAGE(PG8_SA(0, 1), cA, vAc[1]);
        if (wr == 1) PG8_BAR;
        PG8_WAIT_V(4); PG8_BAR;
        PG8_STAGE(PG8_SB(1, 0), cB + kstep, voffB); PG8_STAGE(PG8_SA(1, 0), cA + kstep, vAc[0]); PG8_STAGE(PG8_SB(1, 1), cB + hstepB + kstep, voffB);
        PG8_WAIT_V(6); PG8_BAR;
    }
    for (;;) {
        const bool has_next = P.next(ui + 1, nxt);
        const char* nA = cA; const char* nB = cB;
        if (has_next) { nA = P.a_base(nxt); nB = P.b_base(nxt); if constexpr (Prob::GATHER) P.a_voff(nxt, sR, sC, vAn); }
        for (int t = 0; t < nt; t += 2) {
            const bool last = (t == nt - 2);
            const char* a1 = cA + (size_t)(t + 1) * kstep;
            const char* a2 = last ? nA : cA + (size_t)(t + 2) * kstep; const char* b2 = last ? nB : cB + (size_t)(t + 2) * kstep;
            const char* a3 = a2 + kstep; const char* b3 = b2 + kstep;
            if constexpr (SP2) {
            PG8_LDB(B0, 0, 0); PG8_LDB(B1, 0, 1); PG8_SCHED; PG8_LDA(At, 0, 0); PG8_STAGE(PG8_SA(1, 1), a1, vAc[1]);
            PG8_WAIT_V(8); PG8_WAIT_L(0); PG8_BAR; PG8_MMA(0, 0, At, B0); PG8_MMA(0, 1, At, B1); PG8_BAR; PG8_SCHED;
            PG8_LDA(At, 0, 1); PG8_STAGE(PG8_SB(0, 0), b2, voffB); PG8_STAGE(PG8_SB(0, 1), b2 + hstepB, voffB); PG8_STAGE_SEL(PG8_SA(0, 0), a2, 0);
            PG8_WAIT_V(8); PG8_WAIT_L(0); PG8_BAR; PG8_MMA(1, 0, At, B0); PG8_MMA(1, 1, At, B1); PG8_BAR; PG8_SCHED;
            PG8_LDB(B0, 1, 0); PG8_LDB(B1, 1, 1); PG8_SCHED; PG8_LDA(At, 1, 0); PG8_STAGE_SEL(PG8_SA(0, 1), a2, 1);
            PG8_WAIT_V(8); PG8_WAIT_L(0); PG8_BAR; PG8_MMA(0, 0, At, B0); PG8_MMA(0, 1, At, B1); PG8_BAR; PG8_SCHED;
            PG8_LDA(At, 1, 1); PG8_STAGE(PG8_SB(1, 0), b3, voffB); PG8_STAGE(PG8_SB(1, 1), b3 + hstepB, voffB); PG8_STAGE_SEL(PG8_SA(1, 0), a3, 0);
            PG8_WAIT_V(8); PG8_WAIT_L(0); PG8_BAR; PG8_MMA(1, 0, At, B0); PG8_MMA(1, 1, At, B1); PG8_BAR; PG8_SCHED;
            } else {
            PG8_LDB(B0, 0, 0); PG8_SCHED; PG8_LDA(At, 0, 0); PG8_STAGE(PG8_SA(1, 1), a1, vAc[1]);
            PG8_WAIT_L(8); PG8_BAR; PG8_WAIT_L(0); PG8_MMA(0, 0, At, B0); PG8_BAR; PG8_SCHED;
            PG8_LDB(B1, 0, 1); PG8_STAGE(PG8_SB(0, 0), b2, voffB);
            PG8_BAR; PG8_WAIT_L(0); PG8_MMA(0, 1, At, B1); PG8_BAR;
            PG8_LDA(At, 0, 1); PG8_STAGE_SEL(PG8_SA(0, 0), a2, 0);
            PG8_BAR; PG8_WAIT_L(0); PG8_MMA(1, 0, At, B0); PG8_BAR; PG8_SCHED;
            PG8_STAGE(PG8_SB(0, 1), b2 + hstepB, voffB);
            PG8_WAIT_V(6); PG8_BAR; PG8_MMA(1, 1, At, B1); PG8_BAR;
            PG8_LDB(B0, 1, 0); PG8_SCHED; PG8_LDA(At, 1, 0); PG8_STAGE_SEL(PG8_SA(0, 1), a2, 1);
            PG8_WAIT_L(8); PG8_BAR; PG8_WAIT_L(0); PG8_MMA(0, 0, At, B0); PG8_BAR; PG8_SCHED;
            PG8_LDB(B1, 1, 1); PG8_STAGE(PG8_SB(1, 0), b3, voffB);
            PG8_BAR; PG8_WAIT_L(0); PG8_MMA(0, 1, At, B1); PG8_BAR;
            PG8_LDA(At, 1, 1); PG8_STAGE_SEL(PG8_SA(1, 0), a3, 0);
            PG8_BAR; PG8_WAIT_L(0); PG8_MMA(1, 0, At, B0); PG8_BAR; PG8_SCHED;
            PG8_STAGE(PG8_SB(1, 1), b3 + hstepB, voffB);
            PG8_WAIT_V(6); PG8_BAR; PG8_MMA(1, 1, At, B1); PG8_BAR;
            }
        }
        if constexpr (ALIGN_EPI) { if (wr == 0) PG8_BAR; }
        E(acc, cur, wr, wc, fr, fq);
        if (!has_next) break;
#pragma unroll
        for (int a = 0; a < 2; ++a)
#pragma unroll
            for (int b = 0; b < 2; ++b)
#pragma unroll
                for (int m = 0; m < 4; ++m)
#pragma unroll
                    for (int n = 0; n < 2; ++n) acc[a][b][m][n] = (f32x4){0.f, 0.f, 0.f, 0.f};
        cur = nxt; cA = nA; cB = nB; ++ui;
        if constexpr (Prob::GATHER) {
#pragma unroll
            for (int h = 0; h < 2; ++h)
#pragma unroll
                for (int i = 0; i < 2; ++i) vAc[h][i] = vAn[h][i];
        }
        if constexpr (ALIGN_EPI) { if (wr == 1) PG8_BAR; }
    }
    PG8_WAIT_V(0);
    if constexpr (!ALIGN_EPI) { if (wr == 0) PG8_BAR; }
    PG8_BAR;
#undef PG8_SA
#undef PG8_SB
#undef PG8_STAGE
#undef PG8_STAGE_SEL
#undef PG8_LDA
#undef PG8_LDB
#undef PG8_MMA
#undef PG8_WAIT_V
#undef PG8_WAIT_L
#undef PG8_BAR
#undef PG8_SCHED
}

struct ProbDense { static constexpr bool GATHER = false;
    const bf16_t* A; const bf16_t* Bt; int K, nM, nN, G, c; bool headperm;
    __device__ __forceinline__ bool next(int i, Unit& u) const { return static_next(nM, nN, G, c, i, u); }
    __device__ __forceinline__ const char* a_base(const Unit& u) const { return (const char*)(A + (size_t)u.pm * BM * K); }
    __device__ __forceinline__ void a_voff(const Unit&, const int (&R)[2], const int (&C)[2], unsigned (&v)[2][2]) const {
#pragma unroll
        for (int h = 0; h < 2; ++h)
#pragma unroll
            for (int i = 0; i < 2; ++i) v[h][i] = (unsigned)((h * HALF + R[i]) * K + C[i]) * 2u;
    }
    __device__ __forceinline__ const char* b_base(const Unit& u) const { return (const char*)(Bt + (size_t)u.pn * BM * K); }
    __device__ __forceinline__ size_t b_hstep() const { return headperm ? (size_t)32 * K * 2 : (size_t)HALF * K * 2; }
    __device__ __forceinline__ int b_row(int R) const { return headperm ? ((R >> 5) * 64 + perm32(R & 31)) : ((R & ~31) + perm32(R & 31)); }
};
typedef const PG8_LAS int* lds_ints;
__device__ __forceinline__ int expert_of(lds_ints ps, int pm) { int e = 0;
#pragma unroll
    for (int i = 1; i < 32; ++i) if (ps[i] <= pm * 256) e = i;
    return __builtin_amdgcn_readfirstlane(e); }
struct ProbMoe1 { static constexpr bool GATHER = true;
    const bf16_t* XN; const bf16_t* W1T; const int* rowtok; lds_ints ps; int K, ntm, G, c;
    __device__ __forceinline__ bool next(int i, Unit& u) const { const int q = i * G + c; if (q >= ntm * 8) return false; u.pm = q >> 3; u.pn = q & 7; u.e = expert_of(ps, u.pm); return true; }
    __device__ __forceinline__ const char* a_base(const Unit&) const { return (const char*)XN; }
    __device__ __forceinline__ void a_voff(const Unit& u, const int (&R)[2], const int (&C)[2], unsigned (&v)[2][2]) const {
#pragma unroll
        for (int h = 0; h < 2; ++h)
#pragma unroll
            for (int i = 0; i < 2; ++i) { int tk = rowtok[u.pm * BM + h * HALF + R[i]]; if (tk < 0) tk = T; v[h][i] = (unsigned)(tk * K + C[i]) * 2u; }
    }
    __device__ __forceinline__ const char* b_base(const Unit& u) const { return (const char*)(W1T + ((size_t)u.e * 2048 + u.pn * 128) * K); }
    __device__ __forceinline__ size_t b_hstep() const { return (size_t)1024 * K * 2; }
    __device__ __forceinline__ int b_row(int R) const { return (R & ~31) + perm32(R & 31); }
};
struct ProbMoe2 { static constexpr bool GATHER = false;
    const bf16_t* ACT; const bf16_t* W2T; lds_ints ps; int K, ntm, G, c;
    __device__ __forceinline__ bool next(int i, Unit& u) const { const int q = i * G + c; if (q >= ntm * 4) return false; u.pm = q >> 2; u.pn = q & 3; u.e = expert_of(ps, u.pm); return true; }
    __device__ __forceinline__ const char* a_base(const Unit& u) const { return (const char*)(ACT + (size_t)u.pm * BM * K); }
    __device__ __forceinline__ void a_voff(const Unit&, const int (&R)[2], const int (&C)[2], unsigned (&v)[2][2]) const {
#pragma unroll
        for (int h = 0; h < 2; ++h)
#pragma unroll
            for (int i = 0; i < 2; ++i) v[h][i] = (unsigned)((h * HALF + R[i]) * K + C[i]) * 2u;
    }
    __device__ __forceinline__ const char* b_base(const Unit& u) const { return (const char*)(W2T + ((size_t)u.e * 1024 + u.pn * BM) * K); }
    __device__ __forceinline__ size_t b_hstep() const { return (size_t)HALF * K * 2; }
    __device__ __forceinline__ int b_row(int R) const { return (R & ~31) + perm32(R & 31); }
};

struct EpiG1Z {
    float* Z;
    __device__ __forceinline__ void operator()(const f32x4 (&acc)[2][2][4][2], const Unit& u, int wr, int wc, int fr, int fq) const {
#pragma unroll
        for (int ai = 0; ai < 2; ++ai)
#pragma unroll
            for (int m = 0; m < 4; ++m) { const size_t r = (size_t)u.pm * BM + ai * HALF + wr * 64 + m * 16 + fr;
#pragma unroll
                for (int bj = 0; bj < 2; ++bj)
#pragma unroll
                    for (int n = 0; n < 2; ++n) { const int zc = u.pn * BM + 64 * wc + 32 * bj + 8 * fq + 4 * n;
                        const int col = zc < 1280 ? zc : (zc < 2816 ? zc + 24 : (zc < 2840 ? zc - 2816 + 1280 : -1));
                        if (col >= 0) *(f32x4*)(Z + r * INW + col) = acc[ai][bj][m][n]; } }
    }
};
struct EpiG1F {
    bf16_t* ZB; float* GATE; const float* gq; const float* gk; const float* gmq; const float* gmk;
    __device__ __forceinline__ void operator()(const f32x4 (&acc)[2][2][4][2], const Unit& u, int wr, int wc, int fr, int fq) const {
        const int pn = u.pn;
        const float* gain = nullptr; float sc = 1.f;
        if (pn < 2) { gain = gq; sc = QSCALE; }
        else if (pn == 3 || pn == 4) { if (wc < 2) gain = gk; }
        else if (pn == 5 || pn == 6) { gain = gmq; sc = QSCALE; }
        else if (pn == 7 || pn == 8) { gain = gmk; }
        if (pn == 11) {
            if (wc == 0 && fq < 3) {
#pragma unroll
                for (int ai = 0; ai < 2; ++ai)
#pragma unroll
                    for (int m = 0; m < 4; ++m) { const size_t r = (size_t)u.pm * BM + ai * HALF + wr * 64 + m * 16 + fr;
#pragma unroll
                        for (int n = 0; n < 2; ++n) { const f32x4 v = acc[ai][0][m][n]; f32x4 o;
#pragma unroll
                            for (int i = 0; i < 4; ++i) o[i] = 1.f / (1.f + __expf(-v[i]));
                            *(f32x4*)(GATE + r * 32 + 8 * fq + 4 * n) = o; } }
            }
            return;
        }
        f32x4 gv[2][2];
#pragma unroll
        for (int bj = 0; bj < 2; ++bj)
#pragma unroll
            for (int n = 0; n < 2; ++n) gv[bj][n] = gain ? *(const f32x4*)(gain + 32 * bj + 8 * fq + 4 * n) * sc : (f32x4){1.f, 1.f, 1.f, 1.f};
#pragma unroll
        for (int ai = 0; ai < 2; ++ai)
#pragma unroll
            for (int m = 0; m < 4; ++m) { const size_t r = (size_t)u.pm * BM + ai * HALF + wr * 64 + m * 16 + fr;
                float rs = 1.f;
                if (gain) { float ss = 0.f;
#pragma unroll
                    for (int bj = 0; bj < 2; ++bj)
#pragma unroll
                        for (int n = 0; n < 2; ++n) { const f32x4 v = acc[ai][bj][m][n]; ss += (v[0] * v[0] + v[1] * v[1]) + (v[2] * v[2] + v[3] * v[3]); }
                    ss += __shfl_xor(ss, 16); ss += __shfl_xor(ss, 32);
                    rs = rsqrtf(ss * (1.f / 64.f) + EPS); }
#pragma unroll
                for (int bj = 0; bj < 2; ++bj) { const f32x4 a = acc[ai][bj][m][0] * gv[bj][0] * rs, b = acc[ai][bj][m][1] * gv[bj][1] * rs;
                    u32x4 w; w.x = cvt_pk_bf16(a[0], a[1]); w.y = cvt_pk_bf16(a[2], a[3]); w.z = cvt_pk_bf16(b[0], b[1]); w.w = cvt_pk_bf16(b[2], b[3]);
                    *(u32x4*)(ZB + r * ZBW + pn * BM + 64 * wc + 32 * bj + 8 * fq) = w; } }
    }
};
struct EpiG2 {
    const float* xin; float* XA; const float* g1;
    __device__ __forceinline__ void operator()(const f32x4 (&acc)[2][2][4][2], const Unit& u, int wr, int wc, int fr, int fq) const {
#pragma unroll
        for (int ai = 0; ai < 2; ++ai)
#pragma unroll
            for (int m = 0; m < 4; ++m) { const size_t r = (size_t)u.pm * BM + ai * HALF + wr * 64 + m * 16 + fr; const int b = (int)(r / S);
#pragma unroll
                for (int bj = 0; bj < 2; ++bj)
#pragma unroll
                    for (int n = 0; n < 2; ++n) { const int c = u.pn * BM + 128 * bj + 32 * wc + 8 * fq + 4 * n;
                        const f32x4 x = *(const f32x4*)(xin + r * D + c), g = *(const f32x4*)(g1 + (size_t)b * 6144 + c);
                        *(f32x4*)(XA + r * D + c) = x + g * acc[ai][bj][m][n]; } }
    }
};
struct EpiM1 {
    bf16_t* ACT; const float* b1l;
    __device__ __forceinline__ void operator()(const f32x4 (&acc)[2][2][4][2], const Unit& u, int wr, int wc, int fr, int fq) const {
        const float* b1 = b1l + (size_t)u.e * 2048;
        const int c0 = u.pn * 128 + 32 * wc + 8 * fq;
        f32x4 bg[2], bl[2];
#pragma unroll
        for (int n = 0; n < 2; ++n) { bg[n] = *(const f32x4*)(b1 + c0 + 4 * n); bl[n] = *(const f32x4*)(b1 + 1024 + c0 + 4 * n); }
#pragma unroll
        for (int ai = 0; ai < 2; ++ai)
#pragma unroll
            for (int m = 0; m < 4; ++m) { const size_t r = (size_t)u.pm * BM + ai * HALF + wr * 64 + m * 16 + fr;
                float o[8];
#pragma unroll
                for (int n = 0; n < 2; ++n) { const f32x4 g = acc[ai][0][m][n] + bg[n], li = acc[ai][1][m][n] + bl[n];
#pragma unroll
                    for (int i = 0; i < 4; ++i) { const float gc = fminf(g[i], 7.f), lc = fminf(fmaxf(li[i], -7.f), 7.f); o[4 * n + i] = (lc + 1.f) * gc * (1.f / (1.f + __expf(-1.702f * gc))); } }
                u32x4 w; w.x = cvt_pk_bf16(o[0], o[1]); w.y = cvt_pk_bf16(o[2], o[3]); w.z = cvt_pk_bf16(o[4], o[5]); w.w = cvt_pk_bf16(o[6], o[7]);
                *(u32x4*)(ACT + r * DFF + c0) = w; }
    }
};
struct EpiM2 {
    float* Y; const float* b2l; const float* roww;
    __device__ __forceinline__ void operator()(const f32x4 (&acc)[2][2][4][2], const Unit& u, int wr, int wc, int fr, int fq) const {
        const float* b2 = b2l + (size_t)u.e * D;
#pragma unroll
        for (int ai = 0; ai < 2; ++ai)
#pragma unroll
            for (int m = 0; m < 4; ++m) { const size_t r = (size_t)u.pm * BM + ai * HALF + wr * 64 + m * 16 + fr; const float w = roww[r];
#pragma unroll
                for (int bj = 0; bj < 2; ++bj)
#pragma unroll
                    for (int n = 0; n < 2; ++n) { const int c = u.pn * BM + 128 * bj + 32 * wc + 8 * fq + 4 * n;
                        const f32x4 bb = *(const f32x4*)(b2 + c);
                        *(f32x4*)(Y + r * D + c) = (acc[ai][bj][m][n] + bb) * w; } }
    }
};
}

__device__ __forceinline__ void phase_g1_fast(const Params& p, int l, unsigned char* lds_raw) {
    pg8::ProbDense P{(const bf16_t*)(p.ws + WS_XN), (const bf16_t*)(p.ws + WS_WINT) + (size_t)l * ZBW * D, D, T / 256, ZBW / 256, (int)gridDim.x, (int)blockIdx.x, true};
    pg8::EpiG1F E{(bf16_t*)(p.ws + WS_ZB), (float*)(p.ws + WS_GATE), p.in[7] + l * 64, p.in[8] + l * 64, p.in[12] + l * 64, p.in[13] + l * 64};
    pg8::gemm_phase<pg8::ProbDense, pg8::EpiG1F, true, true>((PG8_LAS unsigned char*)lds_raw, P, E);
}
__device__ __forceinline__ void phase_g2_fast(const Params& p, int l, unsigned char* lds_raw) {
    pg8::ProbDense P{(const bf16_t*)(p.ws + WS_ATTB), (const bf16_t*)(p.ws + WS_WOT) + (size_t)l * D * D, D, T / 256, D / 256, (int)gridDim.x, (int)blockIdx.x, false};
    pg8::EpiG2 E{l == 0 ? p.in[0] : p.out, p.out, (const float*)(p.ws + WS_MOD) + (size_t)l * Bn * 6144 + 2 * D};
    pg8::gemm_phase<pg8::ProbDense, pg8::EpiG2, true, true>((PG8_LAS unsigned char*)lds_raw, P, E);
}
constexpr int LDS_PS_OFF = 131072;
__device__ __forceinline__ void phase_m1_fast(const Params& p, int l, unsigned char* lds_raw) {
    int* ps = (int*)(lds_raw + LDS_PS_OFF);
    load_pstart(p, l, ps);
    pg8::ProbMoe1 P{(const bf16_t*)(p.ws + WS_XN), (const bf16_t*)(p.ws + WS_W1T) + (size_t)l * NE * 2048 * D, (const int*)(p.ws + WS_ROWTOK) + (size_t)l * RMAX, (pg8::lds_ints)ps, D, ps[32] / 256, (int)gridDim.x, (int)blockIdx.x};
    pg8::EpiM1 E{(bf16_t*)(p.ws + WS_ACT), p.in[18] + (size_t)l * NE * 2048};
    pg8::gemm_phase<pg8::ProbMoe1, pg8::EpiM1, true, true>((PG8_LAS unsigned char*)lds_raw, P, E);
    __syncthreads();
}
__device__ __forceinline__ void phase_m2_fast(const Params& p, int l, unsigned char* lds_raw) {
    int* ps = (int*)(lds_raw + LDS_PS_OFF);
    load_pstart(p, l, ps);
    pg8::ProbMoe2 P{(const bf16_t*)(p.ws + WS_ACT), (const bf16_t*)(p.ws + WS_W2T) + (size_t)l * NE * D * DFF, (pg8::lds_ints)ps, DFF, ps[32] / 256, (int)gridDim.x, (int)blockIdx.x};
    pg8::EpiM2 E{(float*)(p.ws + WS_Y), p.in[20] + (size_t)l * NE * D, (const float*)(p.ws + WS_ROWW) + (size_t)l * RMAX};
    pg8::gemm_phase<pg8::ProbMoe2, pg8::EpiM2, true, true>((PG8_LAS unsigned char*)lds_raw, P, E);
    __syncthreads();
}

namespace at {
#define AT_LAS __attribute__((address_space(3)))
typedef short bf16x8 __attribute__((ext_vector_type(8)));
typedef short s16x4 __attribute__((ext_vector_type(4)));
typedef short v4i16_t __attribute__((ext_vector_type(4)));
typedef float f32x16 __attribute__((ext_vector_type(16)));
typedef unsigned u32x4 __attribute__((ext_vector_type(4)));
typedef float f32x2_t __attribute__((ext_vector_type(2))); typedef __bf16 bf16x2_t __attribute__((ext_vector_type(2)));
typedef AT_LAS unsigned char* lp;
constexpr int L_K = 0, L_V = 16384, L_WSF = 32768, L_OST = 34816  , L_IMP = 100352, L_SELM = 133376, L_UNI = 134400, L_KMT = 134656, L_END = 142848;
constexpr float NEGS = -1e30f;
__device__ __forceinline__ int crow(int r, int hi) { return (r & 3) + 8 * (r >> 2) + 4 * hi; }
__device__ __forceinline__ unsigned cvtpk(float lo, float hi) { f32x2_t v = {lo, hi}; bf16x2_t b = __builtin_convertvector(v, bf16x2_t); return __builtin_bit_cast(unsigned, b); }
__device__ __forceinline__ float mx3(float a, float b, float c) { return __builtin_fmaxf(__builtin_fmaxf(a, b), c); }
__device__ __forceinline__ void wsync() { asm volatile("s_waitcnt lgkmcnt(0)" ::: "memory"); __builtin_amdgcn_wave_barrier(); }
__device__ __forceinline__ void bar() { __builtin_amdgcn_s_barrier(); }
#define AT_WAITV(n) asm volatile("s_waitcnt vmcnt(" #n ")" ::: "memory")
#define AT_WAITL() asm volatile("s_waitcnt lgkmcnt(0)" ::: "memory")
__device__ __forceinline__ void glds(const void* g, lp dst) { __builtin_amdgcn_global_load_lds((const unsigned*)g, (AT_LAS unsigned*)dst, 16, 0, 0); }
__device__ __forceinline__ s16x4 vtr(const AT_LAS unsigned char* p) { return __builtin_bit_cast(s16x4, __builtin_amdgcn_ds_read_tr16_b64_v4i16((AT_LAS v4i16_t*)p)); }

__device__ __forceinline__ void dma_k(lp slot, const bf16_t* kbase, int pitch, int key0, int wid, int lane) { glds(kbase + (size_t)(key0 + lane) * pitch + wid * 8, slot + wid * 1024); }
__device__ __forceinline__ void dma_v(lp slot, const bf16_t* vbase, int pitch, int key0, int wid, int lane) {
    glds(vbase + (size_t)(key0 + 16 * (wid & 3) + (lane >> 2)) * pitch + (wid >> 2) * 32 + (lane & 3) * 8, slot + wid * 1024); }

__device__ __forceinline__ void qk_tile(f32x16& p0, f32x16& p1, lp kslot, const bf16x8 (&qr)[4], int r32, int hi) {
    const AT_LAS unsigned char* kb = kslot + hi * 1024 + r32 * 16;
#pragma unroll
    for (int d0 = 0; d0 < 4; ++d0) {
        const bf16x8 b0 = *(const AT_LAS bf16x8*)(kb + d0 * 2048), b1 = *(const AT_LAS bf16x8*)(kb + d0 * 2048 + 512);
        p0 = __builtin_amdgcn_mfma_f32_32x32x16_bf16(b0, qr[d0], p0, 0, 0, 0);
        p1 = __builtin_amdgcn_mfma_f32_32x32x16_bf16(b1, qr[d0], p1, 0, 0, 0);
    }
}
__device__ __forceinline__ void pv_tile(f32x16 (&o)[2], lp vslot, int lane, int hi, u32x4 pw0, u32x4 pw1, u32x4 pw2, u32x4 pw3) {
    const AT_LAS unsigned char* vp = vslot + ((lane >> 4) & 1) * 32 + (lane & 3) * 8 + (4 * hi + ((lane & 15) >> 2)) * 64;
    const bf16x8 pa[4] = {__builtin_bit_cast(bf16x8, pw0), __builtin_bit_cast(bf16x8, pw1), __builtin_bit_cast(bf16x8, pw2), __builtin_bit_cast(bf16x8, pw3)};
#pragma unroll
    for (int d0 = 0; d0 < 2; ++d0)
#pragma unroll
        for (int ks = 0; ks < 4; ++ks) {
            const s16x4 lo = vtr(vp + d0 * 4096 + ks * 1024), hh = vtr(vp + d0 * 4096 + ks * 1024 + 512);
            const bf16x8 vf = (bf16x8){lo[0], lo[1], lo[2], lo[3], hh[0], hh[1], hh[2], hh[3]};
            o[d0] = __builtin_amdgcn_mfma_f32_32x32x16_bf16(pa[ks], vf, o[d0], 0, 0, 0);
        }
}
__device__ __forceinline__ float rowmax(const f32x16& p0, const f32x16& p1) {
    float a = mx3(p0[0], p0[1], p1[0]), b = mx3(p0[2], p0[3], p1[1]); a = mx3(a, p1[2], p1[3]);
#pragma unroll
    for (int r = 4; r < 16; r += 4) { a = mx3(a, p0[r], p0[r + 1]); b = mx3(b, p0[r + 2], p0[r + 3]); a = mx3(a, p1[r], p1[r + 1]); b = mx3(b, p1[r + 2], p1[r + 3]); }
    const float m = __builtin_fmaxf(a, b);
    auto rr = __builtin_amdgcn_permlane32_swap(__float_as_uint(m), __float_as_uint(m), false, false);
    return __builtin_fmaxf(__uint_as_float(rr[0]), __uint_as_float(rr[1]));
}
__device__ __forceinline__ float halfsum(float v) {
    auto rr = __builtin_amdgcn_permlane32_swap(__float_as_uint(v), __float_as_uint(v), false, false);
    return __uint_as_float(rr[0]) + __uint_as_float(rr[1]);
}
__device__ __forceinline__ void mask_tile(f32x16& p0, f32x16& p1, int lo, int hi_, int hi) {
    const int kb = 4 * hi;
#pragma unroll
    for (int r = 0; r < 16; ++r) { const int kv = kb + (r & 3) + 8 * (r >> 2); if (kv > hi_ || kv < lo) p0[r] = NEGS; if (kv + 32 > hi_ || kv + 32 < lo) p1[r] = NEGS; }
}

__device__ __forceinline__ int next_bit128(unsigned u0, unsigned u1, unsigned u2, unsigned u3, int below) {
    if (below > 96) { unsigned x = u3; if (below < 128) x &= (1u << (below - 96)) - 1u; if (x) return 96 + 31 - __builtin_clz(x); }
    if (below > 64) { unsigned x = u2; if (below < 96) x &= (1u << (below - 64)) - 1u; if (x) return 64 + 31 - __builtin_clz(x); }
    if (below > 32) { unsigned x = u1; if (below < 64) x &= (1u << (below - 32)) - 1u; if (x) return 32 + 31 - __builtin_clz(x); }
    if (below > 0) { unsigned x = u0; if (below < 32) x &= (1u << below) - 1u; if (x) return 31 - __builtin_clz(x); }
    return -1;
}
struct Soft { float m, l; };

template <bool HAS_O>
__device__ __forceinline__ void softmax_step(f32x16& p0, f32x16& p1, Soft& st, f32x16 (&o)[2], float* wsf, int r32, int hi) {
    const float rm = rowmax(p0, p1);
    if (__any(rm > 0.f)) {
        const float dl = __builtin_fmaxf(rm, 0.f); st.m += dl;
#pragma unroll
        for (int r = 0; r < 16; ++r) { p0[r] -= dl; p1[r] -= dl; }
        const float al = __builtin_amdgcn_exp2f(-dl); st.l *= al;
        if (HAS_O) {
            if (hi == 0) wsf[r32] = al;
            wsync();
#pragma unroll
            for (int r = 0; r < 16; ++r) { const float f = wsf[crow(r, hi)]; o[0][r] *= f; o[1][r] *= f; }
            wsync();
        }
    }
    float s = 0.f;
#pragma unroll
    for (int r = 0; r < 16; ++r) { p0[r] = __builtin_amdgcn_exp2f(p0[r]); p1[r] = __builtin_amdgcn_exp2f(p1[r]); s += p0[r] + p1[r]; }
    st.l += s;
}
#define AT_PACK(P0, P1) \
    const u32x4 pw0 = {cvtpk(P0[0], P0[1]), cvtpk(P0[2], P0[3]), cvtpk(P0[4], P0[5]), cvtpk(P0[6], P0[7])}, pw1 = {cvtpk(P0[8], P0[9]), cvtpk(P0[10], P0[11]), cvtpk(P0[12], P0[13]), cvtpk(P0[14], P0[15])}, \
                pw2 = {cvtpk(P1[0], P1[1]), cvtpk(P1[2], P1[3]), cvtpk(P1[4], P1[5]), cvtpk(P1[6], P1[7])}, pw3 = {cvtpk(P1[8], P1[9]), cvtpk(P1[10], P1[11]), cvtpk(P1[12], P1[13]), cvtpk(P1[14], P1[15])}
__device__ __forceinline__ f32x16 cinit(float c2k, int hi, float x) { f32x16 c; const float xb = __builtin_fmaf(c2k, (float)(4 * hi), x);
#pragma unroll
    for (int r = 0; r < 16; ++r) c[r] = __builtin_fmaf(c2k, (float)((r & 3) + 8 * (r >> 2)), xb);
    return c; }
template <bool FIRST>
__device__ __forceinline__ void acc_scaled(float* stage, const f32x16 (&o)[2], float f, float* wsf, int r32, int hi) {
    if (hi == 0) wsf[r32] = f;
    wsync();
#pragma unroll
    for (int r = 0; r < 16; ++r) { const int orow = crow(r, hi); const float g = wsf[orow]; float* s0 = stage + orow * 64 + r32;
        if (FIRST) { s0[0] = o[0][r] * g; s0[32] = o[1][r] * g; } else { s0[0] += o[0][r] * g; s0[32] += o[1][r] * g; } }
    wsync();
}

__device__ __forceinline__ void nsa_unit(const Params& p, int b, int g, int c, unsigned char* lds_raw) {
    const int tid = otid(), lane = tid & 63, r32 = lane & 31, hi = lane >> 5, wid = __builtin_amdgcn_readfirstlane(tid >> 6);
    lp lds = (lp)lds_raw;
    const bf16_t* ZB = (const bf16_t*)(p.ws + WS_ZB); const float* GT = (const float*)(p.ws + WS_GATE);
    const bf16_t* KCB = (const bf16_t*)(p.ws + WS_KCB) + (size_t)(b * 2 + g) * 512 * 64; const bf16_t* VCB = (const bf16_t*)(p.ws + WS_VCB) + (size_t)(b * 2 + g) * 512 * 64;
    const int t0 = c * 64, hg = r32 >> 3, qq = r32 & 7, qi = 8 * wid + qq, t = t0 + qi, h = 4 * g + hg; const size_t tt = (size_t)b * S + t;
    float* wsf = (float*)(lds_raw + L_WSF) + wid * 64;
    float* imp = (float*)(lds_raw + L_IMP);
    unsigned* selm = (unsigned*)(lds_raw + L_SELM);
    unsigned* uni = (unsigned*)(lds_raw + L_UNI);
    const float c2 = exp2f(-(float)(h + 1)) * LOG2E;
    bf16x8 qr[4];
#pragma unroll
    for (int d0 = 0; d0 < 4; ++d0) qr[d0] = *(const bf16x8*)(ZB + tt * ZBW + ZB_Q + h * 64 + d0 * 16 + hi * 8);
    const float gt0 = GT[tt * 32 + h * 3 + 0], gt1 = GT[tt * 32 + h * 3 + 1], gt2 = GT[tt * 32 + h * 3 + 2];
    float* ostage = (float*)(lds_raw + L_OST) + wid * 2048;
    f32x16 o[2];
    const lp sK0 = lds + L_K, sV0 = lds + L_V;
    const int nmax = t >= 31 ? (t - 31) >> 4 : -1;
    const int ntc = ((4 * c + 2) >> 6) + 1;
    for (int i = lane; i < 8 * 129; i += 64) imp[(8 * wid) * 129 + i] = 0.f;
    Soft sc; sc.m = 0.f; sc.l = 0.f;
    dma_k(sK0, KCB, 64, 0, wid, lane);
    for (int k = 0; k < ntc; ++k) {
        const lp sK = sK0 + (k & 1) * 8192;
        if (k + 1 < ntc) { dma_k(sK0 + ((k + 1) & 1) * 8192, KCB, 64, 64 * (k + 1), wid, lane); AT_WAITV(1); } else { AT_WAITV(0); }
        bar();
        const float x0 = c2 * (16.f * (64 * k) + 15.5f - (float)t0) - sc.m;
        f32x16 p0 = cinit(16.f * c2, hi, x0), p1 = cinit(16.f * c2, hi, x0 + c2 * 512.f);
        qk_tile(p0, p1, sK, qr, r32, hi);
        mask_tile(p0, p1, 0, nmax - 64 * k, hi);
        softmax_step<false>(p0, p1, sc, o, wsf, r32, hi);
        AT_WAITL(); bar();
    }
    const float lc = halfsum(sc.l), linv = lc > 0.f ? 1.f / lc : 0.f;
    o[0] = f32x16{}; o[1] = f32x16{};
    dma_k(sK0, KCB, 64, 0, wid, lane); dma_v(sV0, VCB, 64, 0, wid, lane);
    for (int k = 0; k < ntc; ++k) {
        const lp sK = sK0 + (k & 1) * 8192, sV = sV0 + (k & 1) * 8192;
        if (k + 1 < ntc) { dma_k(sK0 + ((k + 1) & 1) * 8192, KCB, 64, 64 * (k + 1), wid, lane); dma_v(sV0 + ((k + 1) & 1) * 8192, VCB, 64, 64 * (k + 1), wid, lane); AT_WAITV(2); } else { AT_WAITV(0); }
        bar();
        const float x0 = c2 * (16.f * (64 * k) + 15.5f - (float)t0) - sc.m;
        f32x16 p0 = cinit(16.f * c2, hi, x0), p1 = cinit(16.f * c2, hi, x0 + c2 * 512.f);
        qk_tile(p0, p1, sK, qr, r32, hi);
        mask_tile(p0, p1, 0, nmax - 64 * k, hi);
#pragma unroll
        for (int r = 0; r < 16; ++r) { p0[r] = __builtin_amdgcn_exp2f(p0[r]); p1[r] = __builtin_amdgcn_exp2f(p1[r]); }
        { AT_PACK(p0, p1); pv_tile(o, sV, lane, hi, pw0, pw1, pw2, pw3); }
        float gs[8], ls[8];
#pragma unroll
        for (int q4 = 0; q4 < 4; ++q4) { gs[q4] = ((p0[4 * q4] + p0[4 * q4 + 1]) + (p0[4 * q4 + 2] + p0[4 * q4 + 3])) * linv; ls[q4] = p0[4 * q4 + 3] * linv;
                                         gs[4 + q4] = ((p1[4 * q4] + p1[4 * q4 + 1]) + (p1[4 * q4 + 2] + p1[4 * q4 + 3])) * linv; ls[4 + q4] = p1[4 * q4 + 3] * linv; }
#pragma unroll
        for (int q4 = 0; q4 < 8; ++q4) { gs[q4] += __shfl_xor(gs[q4], 8); gs[q4] += __shfl_xor(gs[q4], 16); ls[q4] += __shfl_xor(ls[q4], 8); ls[q4] += __shfl_xor(ls[q4], 16); }
        if (r32 < 8) {
            float* row = imp + (size_t)(8 * wid + qq) * 129 + 16 * k + hi;
#pragma unroll
            for (int q4 = 0; q4 < 8; ++q4) row[2 * q4] += gs[q4];
        }
        wsync();
        if (r32 < 8) {
            float* row = imp + (size_t)(8 * wid + qq) * 129 + 16 * k + hi + 1;
#pragma unroll
            for (int q4 = 0; q4 < 8; ++q4) row[2 * q4] += ls[q4];
        }
        AT_WAITL(); bar();
    }
    acc_scaled<true>(ostage, o, gt0 * linv, wsf, r32, hi);
    unsigned mk0 = 0u, mk1 = 0u, mk2 = 0u, mk3 = 0u;
    {
        const int qs = lane >> 3, part = lane & 7;
        float v[16];
#pragma unroll
        for (int i = 0; i < 16; ++i) { const int j = part * 16 + i; float x = imp[(size_t)(8 * wid + qs) * 129 + j]; if (j == 0 || j == c || j == c - 1) x = 1e4f; if (j > c) x = NEGS; v[i] = x; }
#pragma unroll 1
        for (int it = 0; it < 16; ++it) {
            float bv = -3e38f; int bi = 0;
#pragma unroll
            for (int i = 0; i < 16; ++i) if (v[i] > bv) { bv = v[i]; bi = part * 16 + i; }
#pragma unroll
            for (int sft = 1; sft < 8; sft <<= 1) { const float ov = __shfl_xor(bv, sft); const int oi = __shfl_xor(bi, sft); if (ov > bv || (ov == bv && oi < bi)) { bv = ov; bi = oi; } }
            if (bv > NEGS) { const unsigned bit = 1u << (bi & 31); const int wq = bi >> 5; if (wq == 0) mk0 |= bit; else if (wq == 1) mk1 |= bit; else if (wq == 2) mk2 |= bit; else mk3 |= bit; }
#pragma unroll
            for (int i = 0; i < 16; ++i) if (part * 16 + i == bi) v[i] = -3.4e38f;
        }
        if (part == 0) { unsigned* sm = selm + (8 * wid + qs) * 4; sm[0] = mk0; sm[1] = mk1; sm[2] = mk2; sm[3] = mk3; }
        unsigned u0 = mk0, u1 = mk1, u2 = mk2, u3 = mk3;
#pragma unroll
        for (int sft = 8; sft < 64; sft <<= 1) { u0 |= __shfl_xor(u0, sft); u1 |= __shfl_xor(u1, sft); u2 |= __shfl_xor(u2, sft); u3 |= __shfl_xor(u3, sft); }
        if (lane == 0) { uni[wid * 4 + 0] = u0; uni[wid * 4 + 1] = u1; uni[wid * 4 + 2] = u2; uni[wid * 4 + 3] = u3; }
    }
    AT_WAITL(); bar();
    unsigned un0 = 0u, un1 = 0u, un2 = 0u, un3 = 0u;
#pragma unroll
    for (int w = 0; w < 8; ++w) { un0 |= uni[w * 4 + 0]; un1 |= uni[w * 4 + 1]; un2 |= uni[w * 4 + 2]; un3 |= uni[w * 4 + 3]; }
    un0 = __builtin_amdgcn_readfirstlane(un0); un1 = __builtin_amdgcn_readfirstlane(un1); un2 = __builtin_amdgcn_readfirstlane(un2); un3 = __builtin_amdgcn_readfirstlane(un3);
    const unsigned my0 = selm[(8 * wid + qq) * 4 + 0], my1 = selm[(8 * wid + qq) * 4 + 1], my2 = selm[(8 * wid + qq) * 4 + 2], my3 = selm[(8 * wid + qq) * 4 + 3];
    {
        const bf16_t* KS = ZB + (size_t)b * S * ZBW + ZB_KS + g * 64; const bf16_t* VS = ZB + (size_t)b * S * ZBW + ZB_VS + g * 64;
        Soft ss; ss.m = 0.f; ss.l = 0.f; o[0] = f32x16{}; o[1] = f32x16{};
        int j = next_bit128(un0, un1, un2, un3, 128), slot = 0;
        if (j >= 0) { dma_k(sK0, KS, ZBW, 64 * j, wid, lane); dma_v(sV0, VS, ZBW, 64 * j, wid, lane); }
        while (j >= 0) {
            const int jn = next_bit128(un0, un1, un2, un3, j);
            const lp sK = sK0 + slot * 8192, sV = sV0 + slot * 8192;
            if (jn >= 0) { dma_k(sK0 + (slot ^ 1) * 8192, KS, ZBW, 64 * jn, wid, lane); dma_v(sV0 + (slot ^ 1) * 8192, VS, ZBW, 64 * jn, wid, lane); AT_WAITV(2); } else { AT_WAITV(0); }
            bar();
            const unsigned mw = (j >> 5) == 0 ? my0 : (j >> 5) == 1 ? my1 : (j >> 5) == 2 ? my2 : my3;
            const bool sel = (mw >> (j & 31)) & 1u;
            const float x0 = sel ? c2 * (float)(64 * j - t0) - ss.m : NEGS;
            f32x16 p0 = cinit(c2, hi, x0), p1 = cinit(c2, hi, sel ? x0 + c2 * 32.f : NEGS);
            qk_tile(p0, p1, sK, qr, r32, hi);
            if (j == c) mask_tile(p0, p1, 0, qi, hi);
            softmax_step<true>(p0, p1, ss, o, wsf, r32, hi);
            { AT_PACK(p0, p1); pv_tile(o, sV, lane, hi, pw0, pw1, pw2, pw3); }
            AT_WAITL(); bar();
            j = jn; slot ^= 1;
        }
        const float ls_ = halfsum(ss.l);
        acc_scaled<false>(ostage, o, ls_ > 0.f ? gt1 / ls_ : 0.f, wsf, r32, hi);
    }
    {
        const bf16_t* KW = ZB + (size_t)b * S * ZBW + ZB_KW + g * 64; const bf16_t* VW = ZB + (size_t)b * S * ZBW + ZB_VW + g * 64;
        Soft sw; sw.m = 0.f; sw.l = 0.f; o[0] = f32x16{}; o[1] = f32x16{};
        const int k0 = c >= 8 ? 0 : 8 - c;
        dma_k(sK0, KW, ZBW, t0 - 512 + 64 * k0, wid, lane); dma_v(sV0, VW, ZBW, t0 - 512 + 64 * k0, wid, lane);
        int slot = 0;
        for (int k = k0; k < 9; ++k) {
            const lp sK = sK0 + slot * 8192, sV = sV0 + slot * 8192;
            if (k + 1 < 9) { dma_k(sK0 + (slot ^ 1) * 8192, KW, ZBW, t0 - 512 + 64 * (k + 1), wid, lane); dma_v(sV0 + (slot ^ 1) * 8192, VW, ZBW, t0 - 512 + 64 * (k + 1), wid, lane); AT_WAITV(2); } else { AT_WAITV(0); }
            bar();
            const float x0 = c2 * (float)(64 * k - 512) - sw.m;
            f32x16 p0 = cinit(c2, hi, x0), p1 = cinit(c2, hi, x0 + c2 * 32.f);
            qk_tile(p0, p1, sK, qr, r32, hi);
            if (k == 0) mask_tile(p0, p1, qi + 1, 63, hi);
            if (k == 8) mask_tile(p0, p1, 0, qi, hi);
            softmax_step<true>(p0, p1, sw, o, wsf, r32, hi);
            { AT_PACK(p0, p1); pv_tile(o, sV, lane, hi, pw0, pw1, pw2, pw3); }
            AT_WAITL(); bar();
            slot ^= 1;
        }
        const float lw = halfsum(sw.l);
        acc_scaled<false>(ostage, o, lw > 0.f ? gt2 / lw : 0.f, wsf, r32, hi);
    }
    {
        bf16_t* AB = (bf16_t*)(p.ws + WS_ATTB);
#pragma unroll
        for (int i = 0; i < 4; ++i) { const int row = i * 8 + (lane >> 3), ch = lane & 7; const float4 a = *(const float4*)(ostage + row * 64 + ch * 8), c4 = *(const float4*)(ostage + row * 64 + ch * 8 + 4);
            const uint4 v = make_uint4(pk2(a.x, a.y), pk2(a.z, a.w), pk2(c4.x, c4.y), pk2(c4.z, c4.w));
            *(uint4*)(AB + ((size_t)b * S + t0 + 8 * wid + (row & 7)) * D + (4 * g + (row >> 3)) * 64 + ch * 8) = v; }
        wsync();
    }
    AT_WAITL(); bar();
}

__device__ __forceinline__ void moba_unit(const Params& p, int b, int h, int blk, unsigned char* lds_raw) {
    const int tid = otid(), lane = tid & 63, r32 = lane & 31, hi = lane >> 5, wid = __builtin_amdgcn_readfirstlane(tid >> 6);
    lp lds = (lp)lds_raw;
    const bf16_t* ZB = (const bf16_t*)(p.ws + WS_ZB);
    const bf16_t* KMB = (const bf16_t*)(p.ws + WS_KMB) + (size_t)(b * 8 + h) * 32 * 64;
    const int qi = 32 * wid + r32, t = blk * 256 + qi; const size_t tt = (size_t)b * S + t;
    float* wsf = (float*)(lds_raw + L_WSF) + wid * 64;
    unsigned* uni = (unsigned*)(lds_raw + L_UNI);
    const float c2 = exp2f(-(float)(h + 1)) * LOG2E;
    bf16x8 qr[4];
#pragma unroll
    for (int d0 = 0; d0 < 4; ++d0) qr[d0] = *(const bf16x8*)(ZB + tt * ZBW + ZB_MQ + h * 64 + d0 * 16 + hi * 8);
    const lp sK0 = lds + L_K, sV0 = lds + L_V;
    unsigned mymask = 0u;
    {
        const lp sKM = lds + L_KMT;
        glds(KMB + (size_t)(lane & 31) * 64 + wid * 8, sKM + wid * 1024);
        AT_WAITV(0); bar();
        f32x16 g0 = f32x16{}, g1 = f32x16{};
        qk_tile(g0, g1, sKM, qr, r32, hi);
        float v1 = NEGS, v2 = NEGS, v3 = NEGS; int i1 = 64, i2 = 64, i3 = 64;
#pragma unroll
        for (int r = 0; r < 16; ++r) { const int n = crow(r, hi); const float s_ = n < blk ? g0[r] : NEGS;
            if (s_ > v1) { v3 = v2; i3 = i2; v2 = v1; i2 = i1; v1 = s_; i1 = n; } else if (s_ > v2) { v3 = v2; i3 = i2; v2 = s_; i2 = n; } else if (s_ > v3) { v3 = s_; i3 = n; } }
        float ov[3]; int oi[3];
        { auto a = __builtin_amdgcn_permlane32_swap(__float_as_uint(v1), __float_as_uint(v1), false, false); ov[0] = __uint_as_float(hi ? a[0] : a[1]); }
        { auto a = __builtin_amdgcn_permlane32_swap(__float_as_uint(v2), __float_as_uint(v2), false, false); ov[1] = __uint_as_float(hi ? a[0] : a[1]); }
        { auto a = __builtin_amdgcn_permlane32_swap(__float_as_uint(v3), __float_as_uint(v3), false, false); ov[2] = __uint_as_float(hi ? a[0] : a[1]); }
        { auto a = __builtin_amdgcn_permlane32_swap((unsigned)i1, (unsigned)i1, false, false); oi[0] = (int)(hi ? a[0] : a[1]); }
        { auto a = __builtin_amdgcn_permlane32_swap((unsigned)i2, (unsigned)i2, false, false); oi[1] = (int)(hi ? a[0] : a[1]); }
        { auto a = __builtin_amdgcn_permlane32_swap((unsigned)i3, (unsigned)i3, false, false); oi[2] = (int)(hi ? a[0] : a[1]); }
#pragma unroll
        for (int k = 0; k < 3; ++k) { const float s_ = ov[k]; const int n = oi[k];
            if (s_ > v1 || (s_ == v1 && n < i1)) { v3 = v2; i3 = i2; v2 = v1; i2 = i1; v1 = s_; i1 = n; }
            else if (s_ > v2 || (s_ == v2 && n < i2)) { v3 = v2; i3 = i2; v2 = s_; i2 = n; }
            else if (s_ > v3 || (s_ == v3 && n < i3)) { v3 = s_; i3 = n; } }
        if (v1 > NEGS) mymask |= 1u << i1; if (v2 > NEGS) mymask |= 1u << i2; if (v3 > NEGS) mymask |= 1u << i3;
        unsigned u = mymask;
#pragma unroll
        for (int sft = 1; sft < 64; sft <<= 1) u |= __shfl_xor(u, sft);
        if (lane == 0) uni[wid] = u;
        AT_WAITL(); bar();
    }
    unsigned un = 0u;
#pragma unroll
    for (int w = 0; w < 8; ++w) un |= uni[w];
    un = __builtin_amdgcn_readfirstlane(un);
    const bf16_t* KM_ = ZB + (size_t)b * S * ZBW + ZB_MK + h * 64; const bf16_t* VM_ = ZB + (size_t)b * S * ZBW + ZB_MV + h * 64;
    const int nub = __builtin_popcount(un), ntile = 4 * nub + 4;
    Soft sm; sm.m = 0.f; sm.l = 0.f; f32x16 o[2]; o[0] = f32x16{}; o[1] = f32x16{};
    unsigned rem = un; int curblk = nub > 0 ? __builtin_ctz(rem) : blk;
    unsigned prem = un; int pblk = nub > 0 ? __builtin_ctz(prem) : blk, psub = 0;
    dma_k(sK0, KM_, ZBW, (pblk * 256), wid, lane); dma_v(sV0, VM_, ZBW, (pblk * 256), wid, lane);
    psub = 1;
    int sub = 0, slot = 0;
    for (int i = 0; i < ntile; ++i) {
        const lp sK = sK0 + slot * 8192, sV = sV0 + slot * 8192;
        if (i + 1 < ntile) {
            if (psub == 4) { psub = 0; if (pblk != blk) { prem &= prem - 1; pblk = prem ? __builtin_ctz(prem) : blk; } }
            dma_k(sK0 + (slot ^ 1) * 8192, KM_, ZBW, (pblk * 256 + psub * 64), wid, lane); dma_v(sV0 + (slot ^ 1) * 8192, VM_, ZBW, (pblk * 256 + psub * 64), wid, lane); ++psub;
            AT_WAITV(2);
        } else { AT_WAITV(0); }
        bar();
        const bool own = (i >= 4 * nub);
        const int rel = own ? qi - 64 * sub : 63;
        const bool skip = own && (32 * wid + 31 < 64 * sub);
        if (!skip) {
            const bool sel = own ? true : ((mymask >> curblk) & 1u);
            const float x0 = sel ? c2 * (float)(curblk * 256 + sub * 64 - blk * 256) - sm.m : NEGS;
            f32x16 p0 = cinit(c2, hi, x0), p1 = cinit(c2, hi, sel ? x0 + c2 * 32.f : NEGS);
            qk_tile(p0, p1, sK, qr, r32, hi);
            if (own && (64 * sub + 63 > 32 * wid)) mask_tile(p0, p1, 0, rel, hi);
            softmax_step<true>(p0, p1, sm, o, wsf, r32, hi);
            { AT_PACK(p0, p1); pv_tile(o, sV, lane, hi, pw0, pw1, pw2, pw3); }
        }
        AT_WAITL(); bar();
        slot ^= 1;
        if (++sub == 4) { sub = 0; if (!own) { rem &= rem - 1; curblk = rem ? __builtin_ctz(rem) : blk; } }
    }
    {
        const float lt = halfsum(sm.l); const float f = lt > 0.f ? 1.f / lt : 0.f;
        if (hi == 0) wsf[r32] = f;
        wsync();
        bf16_t* stg = (bf16_t*)(lds_raw + L_OST) + wid * 4096;
#pragma unroll
        for (int r = 0; r < 16; ++r) { const int orow = crow(r, hi); const float g = wsf[orow]; stg[orow * 64 + r32] = (bf16_t)f2bf(o[0][r] * g); stg[orow * 64 + 32 + r32] = (bf16_t)f2bf(o[1][r] * g); }
        wsync();
        bf16_t* AB = (bf16_t*)(p.ws + WS_ATTB);
#pragma unroll
        for (int i = 0; i < 4; ++i) { const int row = i * 8 + (lane >> 3), ch = lane & 7; const uint4 v = *(const uint4*)(stg + row * 64 + ch * 8);
            *(uint4*)(AB + ((size_t)b * S + blk * 256 + 32 * wid + row) * D + 512 + h * 64 + ch * 8) = v; }
        wsync();
    }
    AT_WAITL(); bar();
}
}

__device__ __forceinline__ void phase_att_fast(const Params& p, unsigned char* lds_raw) {
    for (int pi = blockIdx.x; pi < 512; pi += gridDim.x) {
        const int rnd = pi >> 8, id = pi & 255;
        { const int bg = 2 * rnd + (id >> 7), c = rnd ? 127 - (id & 127) : (id & 127); at::nsa_unit(p, bg >> 1, bg & 1, c, lds_raw); }
        { const int bh = 8 * rnd + (id >> 5), blk = rnd ? 31 - (id & 31) : (id & 31); at::moba_unit(p, bh >> 3, bh & 7, blk, lds_raw); }
    }
}

__global__ void __launch_bounds__(NT, 2) mega_fwd(Params p) {
    extern __shared__ __attribute__((aligned(16))) unsigned char lds_raw[];
    float* lds = (float*)lds_raw;
    cg::grid_group grid = cg::this_grid();
    phase_p0a(p, lds);
#if FAST_G1 || FAST_G2 || FAST_MOE
    __syncthreads();
    phase_convert(p, lds);
#endif
    grid.sync();
    phase_p0b(p);
    grid.sync();
    _Pragma("unroll 1") for (int l = 0; l < L; ++l) {
        phase_r1(p, l, true);
        grid.sync();
#if FAST_G1
        phase_g1_fast(p, l, lds_raw);
#else
        phase_g1(p, l, lds);
#endif
        grid.sync();
#if !FAST_G1
        phase_zp(p, l);
        grid.sync();
#endif
        phase_ck(p, l, lds);
        grid.sync();
        phase_c2(p, l);
        grid.sync();
#if FAST_ATT
        phase_att_fast(p, lds_raw);
#else
        phase_att(p, lds);
#endif
        grid.sync();
#if FAST_G2
        phase_g2_fast(p, l, lds_raw);
#else
        phase_g2(p, l, lds);
#endif
        grid.sync();
        phase_r2(p, l, lds);
        grid.sync();
        phase_sc(p, l, lds);
        grid.sync();
#if FAST_MOE
        phase_m1_fast(p, l, lds_raw);
#else
        phase_m1(p, l, lds);
#endif
        grid.sync();
#if FAST_MOE
        phase_m2_fast(p, l, lds_raw);
#else
        phase_m2(p, l, lds);
#endif
        grid.sync();
    }
    phase_r1(p, L, false);
}

extern "C" void kernel_launch(void* const* d_in, const int* in_sizes, int n_in, void* d_out, int out_size, void* d_ws, size_t ws_size, hipStream_t stream) {
    static int grid_blocks = 0;
    if (grid_blocks == 0) {
        if (n_in != 21 || out_size != T * D || ws_size < WS_END) { fprintf(stderr, "kernel_launch: unexpected shapes (n_in %d out %d ws %zu need %zu)\n", n_in, out_size, ws_size, (size_t)WS_END); grid_blocks = -1; return; }
        int dev = 0, cus = 0, per_cu = 0;
        hipGetDevice(&dev);
        hipDeviceGetAttribute(&cus, hipDeviceAttributeMultiprocessorCount, dev);
        hipFuncSetAttribute((const void*)mega_fwd, hipFuncAttributeMaxDynamicSharedMemorySize, LDS_BYTES);
        hipOccupancyMaxActiveBlocksPerMultiprocessor(&per_cu, (const void*)mega_fwd, NT, LDS_BYTES);
        if (per_cu < 1) { fprintf(stderr, "kernel_launch: occupancy query says %d blocks per CU\n", per_cu); per_cu = 1; }
        (void)hipGetLastError();
        grid_blocks = cus * 1;
    }
    if (grid_blocks < 0) return;
    Params p{};
    for (int i = 0; i < 21; ++i) p.in[i] = (const float*)d_in[i];
    p.out = (float*)d_out; p.ws = (unsigned char*)d_ws;
    void* args[] = {&p};
    hipError_t e = hipLaunchCooperativeKernel((const void*)mega_fwd, dim3(grid_blocks), dim3(NT), args, LDS_BYTES, stream);
    if (e != hipSuccess) fprintf(stderr, "cooperative launch failed: %s (grid %d)\n", hipGetErrorString(e), grid_blocks);
}
```

```cpp
#include <hip/hip_runtime.h>
#include <hip/hip_cooperative_groups.h>
#include <cstdio>
#include <cstdint>
namespace cg = cooperative_groups;

constexpr int Bn = 2, S = 8192, D = 1024, L = 2, T = Bn * S;
constexpr int INW = 2840;
constexpr int NE = 32, TOPK = 4, DFF = 1024;
constexpr int A_TOT = T * TOPK;
constexpr int RMAX = A_TOT + NE * 256;
constexpr int NCMP = 511;
constexpr int NT = 512;
constexpr int NW = NT / 64;
constexpr int LDS_BYTES = 147456;
constexpr float EPS = 1e-6f;
constexpr float NEGF = -1e30f;

#ifndef FAST_G1
#define FAST_G1 1
#endif
#ifndef FAST_G2
#define FAST_G2 1
#endif
#ifndef DUP
#define DUP 0
#endif
#ifndef USE_CG_SYNC
#define USE_CG_SYNC 0
#endif
#ifndef FAST_ATT
#define FAST_ATT 1
#endif
#ifndef FAST_MOE
#define FAST_MOE 1
#endif
constexpr int ZBW = 3072;
constexpr int ZB_Q = 0, ZB_KC = 512, ZB_VC = 640, ZB_KS = 768, ZB_VS = 896, ZB_KW = 1024, ZB_VW = 1152, ZB_MQ = 1280, ZB_MK = 1792, ZB_MV = 2304, ZB_G = 2816;
constexpr float QSCALE = 0.125f * 1.4426950408889634f;
constexpr float LOG2E = 1.4426950408889634f;
constexpr int ZC_Q = 0, ZC_KC = 512, ZC_VC = 640, ZC_KS = 768, ZC_VS = 896, ZC_KW = 1024, ZC_VW = 1152, ZC_G = 1280, ZC_MQ = 1304, ZC_MK = 1816, ZC_MV = 2328;

constexpr size_t al256(size_t x) { return (x + 255) & ~(size_t)255; }
constexpr size_t WS_BAR = 0;
constexpr size_t WS_MODP = 16384;
constexpr size_t WS_MOD = al256(WS_MODP + (size_t)8 * L * Bn * 6144 * 4);
constexpr size_t WS_CNT = al256(WS_MOD + (size_t)L * Bn * 6144 * 4);
constexpr size_t WS_FILL = al256(WS_CNT + L * 32 * 4);
constexpr size_t WS_ROWTOK = al256(WS_FILL + L * 32 * 4);
constexpr size_t WS_ROWW = al256(WS_ROWTOK + (size_t)L * RMAX * 4);
constexpr size_t WS_TOKE = al256(WS_ROWW + (size_t)L * RMAX * 4);
constexpr size_t WS_TOKW = al256(WS_TOKE + (size_t)T * 4 * 4);
constexpr size_t WS_POS = al256(WS_TOKW + (size_t)T * 4 * 4);
constexpr size_t WS_HID = al256(WS_POS + (size_t)T * 4 * 4);
constexpr size_t WS_KC = al256(WS_HID + (size_t)2 * 2044 * 128 * 4);
constexpr size_t WS_VC = al256(WS_KC + (size_t)2044 * 64 * 4);
constexpr size_t WS_KM = al256(WS_VC + (size_t)2044 * 64 * 4);
constexpr size_t WS_H = al256(WS_KM + (size_t)Bn * 8 * 32 * 64 * 4);
constexpr size_t WS_Z = al256(WS_H + (size_t)T * D * 4);
constexpr size_t WS_ATT = al256(WS_Z + (size_t)T * INW * 4);
constexpr size_t WS_U = al256(WS_ATT + (size_t)T * D * 4);
constexpr size_t WS_Y = al256(WS_U + (FAST_MOE ? (size_t)0 : (size_t)RMAX * 2048 * 4));
constexpr size_t WS_WINT = al256(WS_Y + (size_t)RMAX * 1024 * 4);
constexpr size_t WS_WOT = al256(WS_WINT + (size_t)L * 3072 * 1024 * 2);
constexpr size_t WS_W1T = al256(WS_WOT + (size_t)L * 1024 * 1024 * 2);
constexpr size_t WS_W2T = al256(WS_W1T + (size_t)L * NE * 2048 * 1024 * 2);
constexpr size_t WS_XN = al256(WS_W2T + (size_t)L * NE * 1024 * 1024 * 2);
constexpr size_t WS_ATTB = al256(WS_XN + (size_t)(T + 1) * D * 2);
constexpr size_t WS_ACT = al256(WS_ATTB + (size_t)T * D * 2);
constexpr size_t WS_ZB = al256(WS_ACT + (size_t)RMAX * DFF * 2);
constexpr size_t WS_GATE = al256(WS_ZB + (size_t)T * ZBW * 2);
constexpr size_t WS_KCB = al256(WS_GATE + (size_t)T * 32 * 4);
constexpr size_t WS_VCB = al256(WS_KCB + (size_t)Bn * 2 * 512 * 64 * 2);
constexpr size_t WS_KMB = al256(WS_VCB + (size_t)Bn * 2 * 512 * 64 * 2);
constexpr size_t WS_XNLO = al256(WS_KMB + (size_t)Bn * 8 * 32 * 64 * 2);
constexpr size_t WS_BC = al256(WS_XNLO + (size_t)T * D * 2);
constexpr size_t WS_WCT = al256(WS_BC + (size_t)(T / 64) * 32 * 4);
constexpr size_t WS_CBP = al256(WS_WCT + (size_t)L * 2 * 128 * 2048 * 2);
constexpr size_t WS_CB = al256(WS_CBP + (size_t)16 * L * 2 * 128 * 4);
constexpr size_t WS_END = al256(WS_CB + (size_t)L * 2 * 128 * 4);

struct Params {
    const float* in[21];
    float* out;
    unsigned char* ws;
};

__device__ __forceinline__ int otid() { int t = threadIdx.x; asm volatile("" : "+v"(t)); return t; }
typedef unsigned short bf16_t;
__device__ __forceinline__ unsigned f2bf(float f) { unsigned u = __builtin_bit_cast(unsigned, f); return (u + 0x7fffu + ((u >> 16) & 1u)) >> 16; }
__device__ __forceinline__ unsigned pk2(float lo, float hi) { return f2bf(lo) | (f2bf(hi) << 16); }
__device__ __forceinline__ float bf2f(bf16_t v) { return __builtin_bit_cast(float, (unsigned)v << 16); }
__device__ __forceinline__ float wave_sum(float v) {
#pragma unroll
    for (int o = 1; o < 64; o <<= 1) v += __shfl_xor(v, o);
    return v;
}
__device__ __forceinline__ float sigmoidf_(float x) { return 1.f / (1.f + __expf(-x)); }
__device__ __forceinline__ float gelu_tanh(float x) {
    const float u = 0.7978845608028654f * (x + 0.044715f * x * x * x);
    return 0.5f * x * (1.f + tanhf(u));
}

template <class AL, class BL, class EP>
__device__ __forceinline__ void gemm_tile(float* lds, int m0, int n0, int K, const AL& al, const BL& bl, const EP& ep) {
    float* As = lds;
    float* Bs = lds + 16 * 132;
    const int tid = otid(), tx = tid & 15, ty = tid >> 4;
    const int ar = tid >> 2, ak = (tid & 3) * 4;
    const int bk = tid >> 5, bn = (tid & 31) * 2;
    float acc[4][4];
#pragma unroll
    for (int i = 0; i < 4; ++i)
#pragma unroll
        for (int j = 0; j < 4; ++j) acc[i][j] = 0.f;
    float4 av = al(m0 + ar, ak);
    float2 bv = bl(bk, n0 + bn);
    for (int k0 = 0; k0 < K; k0 += 16) {
        As[(ak + 0) * 132 + ar] = av.x; As[(ak + 1) * 132 + ar] = av.y; As[(ak + 2) * 132 + ar] = av.z; As[(ak + 3) * 132 + ar] = av.w;
        *(float2*)&Bs[bk * 68 + bn] = bv;
        __syncthreads();
        if (k0 + 16 < K) { av = al(m0 + ar, k0 + 16 + ak); bv = bl(k0 + 16 + bk, n0 + bn); }
#pragma unroll
        for (int kk = 0; kk < 16; ++kk) {
            const float4 a = *(const float4*)&As[kk * 132 + ty * 4];
            const float4 b = *(const float4*)&Bs[kk * 68 + tx * 4];
            const float a_[4] = {a.x, a.y, a.z, a.w}, b_[4] = {b.x, b.y, b.z, b.w};
#pragma unroll
            for (int i = 0; i < 4; ++i)
#pragma unroll
                for (int j = 0; j < 4; ++j) acc[i][j] += a_[i] * b_[j];
        }
        __syncthreads();
    }
#pragma unroll
    for (int i = 0; i < 4; ++i)
#pragma unroll
        for (int j = 0; j < 4; ++j) ep(m0 + ty * 4 + i, n0 + tx * 4 + j, acc[i][j]);
}

__device__ __forceinline__ void phase_p0a(const Params& p, float* lds) {
    const int tid = otid(), gtid = blockIdx.x * NT + tid, gsz = gridDim.x * NT;
    int* cnt = (int*)(p.ws + WS_CNT); int* fill = (int*)(p.ws + WS_FILL); int* rowtok = (int*)(p.ws + WS_ROWTOK);
    for (int i = gtid; i < L * 32; i += gsz) { cnt[i] = 0; fill[i] = 0; }
    for (int i = gtid; i < L * RMAX; i += gsz) rowtok[i] = -1;
    const float* c = p.in[1];
    for (int i = tid; i < Bn * D; i += NT) { const float v = c[i]; lds[i] = v / (1.f + __expf(-v)); }
    __syncthreads();
    const float* ada_w = p.in[2];
    float* modp = (float*)(p.ws + WS_MODP);
    for (int idx = gtid; idx < 8 * L * 6144; idx += gsz) {
        const int col = idx % 6144, l = (idx / 6144) % L, kc = idx / (6144 * L);
        const float* w = ada_w + ((size_t)l * D + kc * 128) * 6144 + col;
        float a0 = 0.f, a1 = 0.f;
#pragma unroll 8
        for (int k = 0; k < 128; ++k) { const float wv = w[(size_t)k * 6144]; a0 += lds[kc * 128 + k] * wv; a1 += lds[D + kc * 128 + k] * wv; }
        modp[((size_t)(kc * L + l) * Bn + 0) * 6144 + col] = a0;
        modp[((size_t)(kc * L + l) * Bn + 1) * 6144 + col] = a1;
    }
    { const float* posw = p.in[9]; const float* w1c = p.in[10]; float* cbp = (float*)(p.ws + WS_CBP);
      for (int idx = gtid; idx < 16 * L * 2 * 128; idx += gsz) {
          const int j = idx & 127, li = (idx >> 7) % (L * 2), kc = idx / (L * 2 * 128);
          const float* w = w1c + ((size_t)li * 2048 + kc * 128) * 128 + j; const float* pp = posw + (size_t)li * 2048 + kc * 128;
          float a = 0.f;
#pragma unroll 8
          for (int k = 0; k < 128; ++k) a += pp[k] * w[(size_t)k * 128];
          cbp[idx] = a; } }
}
__device__ __forceinline__ void phase_p0b(const Params& p) {
    const int gtid = blockIdx.x * NT + otid(), gsz = gridDim.x * NT;
    { const float* cbp = (const float*)(p.ws + WS_CBP); float* cb = (float*)(p.ws + WS_CB);
      for (int idx = gtid; idx < L * 2 * 128; idx += gsz) { float s = 0.f;
#pragma unroll
          for (int kc = 0; kc < 16; ++kc) s += cbp[kc * (L * 2 * 128) + idx];
          cb[idx] = s; } }
    const float* modp = (const float*)(p.ws + WS_MODP); float* mod = (float*)(p.ws + WS_MOD); const float* ada_b = p.in[3];
    for (int idx = gtid; idx < L * Bn * 6144; idx += gsz) {
        const int col = idx % 6144, l = idx / (Bn * 6144);
        float s = ada_b[l * 6144 + col];
#pragma unroll
        for (int kc = 0; kc < 8; ++kc) s += modp[(size_t)kc * L * Bn * 6144 + idx];
        mod[idx] = s;
    }
}

__device__ __forceinline__ void phase_r1(const Params& p, int l, bool do_h) {
    const int lane = otid() & 63, wave = otid() >> 6;
    const int gw = blockIdx.x * NW + wave, ngw = gridDim.x * NW;
    const float* mod = (const float*)(p.ws + WS_MOD);
    const float* xin = p.in[0]; float* XA = p.out; float* H = (float*)(p.ws + WS_H);
    const bf16_t* Y = (const bf16_t*)(p.ws + WS_Y); const int* pos = (const int*)(p.ws + WS_POS);
    const float* lng = p.in[4] + (size_t)(do_h ? l : 0) * D;
    bf16_t* XN = (bf16_t*)(p.ws + WS_XN);
    for (int t = gw; t < T; t += ngw) {
        const int b = t / S;
        float4 v[4];
        if (l == 0) {
#pragma unroll
            for (int j = 0; j < 4; ++j) v[j] = *(const float4*)(xin + (size_t)t * D + 4 * lane + 256 * j);
        } else {
            const float* g2 = mod + ((size_t)(l - 1) * Bn + b) * 6144 + 5 * D;
            const int p0 = pos[t * 4 + 0], p1 = pos[t * 4 + 1], p2 = pos[t * 4 + 2], p3 = pos[t * 4 + 3];
#pragma unroll
            for (int j = 0; j < 4; ++j) {
                const int col = 4 * lane + 256 * j;
                const float4 x = *(const float4*)(XA + (size_t)t * D + col);
                const uint2 q0 = *(const uint2*)(Y + (size_t)p0 * D + col), q1 = *(const uint2*)(Y + (size_t)p1 * D + col), q2 = *(const uint2*)(Y + (size_t)p2 * D + col), q3 = *(const uint2*)(Y + (size_t)p3 * D + col);
#define BF4(q) make_float4(__builtin_bit_cast(float, (q).x << 16), __builtin_bit_cast(float, (q).x & 0xffff0000u), __builtin_bit_cast(float, (q).y << 16), __builtin_bit_cast(float, (q).y & 0xffff0000u))
                const float4 y0 = BF4(q0), y1 = BF4(q1), y2 = BF4(q2), y3 = BF4(q3);
#undef BF4
                const float4 g = *(const float4*)(g2 + col);
                float4 r;
                r.x = x.x + g.x * (((y0.x + y1.x) + y2.x) + y3.x); r.y = x.y + g.y * (((y0.y + y1.y) + y2.y) + y3.y);
                r.z = x.z + g.z * (((y0.z + y1.z) + y2.z) + y3.z); r.w = x.w + g.w * (((y0.w + y1.w) + y2.w) + y3.w);
                v[j] = r;
                *(float4*)(XA + (size_t)t * D + col) = r;
            }
        }
        if (do_h) {
            float ss = 0.f;
#pragma unroll
            for (int j = 0; j < 4; ++j) ss += (v[j].x * v[j].x + v[j].y * v[j].y) + (v[j].z * v[j].z + v[j].w * v[j].w);
            ss = wave_sum(ss);
            const float r = rsqrtf(ss * (1.f / D) + EPS);
            const float* sh = mod + ((size_t)l * Bn + b) * 6144 + 0 * D; const float* sc = mod + ((size_t)l * Bn + b) * 6144 + 1 * D;
#pragma unroll
            for (int j = 0; j < 4; ++j) {
                const int col = 4 * lane + 256 * j;
                const float4 g = *(const float4*)(lng + col), s1 = *(const float4*)(sc + col), s0 = *(const float4*)(sh + col);
                float4 o;
                o.x = v[j].x * r * g.x * (1.f + s1.x) + s0.x; o.y = v[j].y * r * g.y * (1.f + s1.y) + s0.y;
                o.z = v[j].z * r * g.z * (1.f + s1.z) + s0.z; o.w = v[j].w * r * g.w * (1.f + s1.w) + s0.w;
                *(float4*)(H + (size_t)t * D + col) = o;
                *(uint2*)(XN + (size_t)t * D + col) = make_uint2(pk2(o.x, o.y), pk2(o.z, o.w));
            }
        }
    }
}

__device__ __forceinline__ void phase_g1(const Params& p, int l, float* lds) {
    const float* H = (const float*)(p.ws + WS_H); const float* W = p.in[6] + (size_t)l * D * INW; float* Z = (float*)(p.ws + WS_Z);
    constexpr int NTN = (INW + 63) / 64, NTM = T / 128;
    auto al = [=](int r, int k) -> float4 { return *(const float4*)(H + (size_t)r * D + k); };
    auto bl = [=](int k, int n) -> float2 { return n < INW ? *(const float2*)(W + (size_t)k * INW + n) : make_float2(0.f, 0.f); };
    auto ep = [=](int r, int c, float v) { if (c < INW) Z[(size_t)r * INW + c] = v; };
    for (int tile = blockIdx.x; tile < NTM * NTN; tile += gridDim.x) {
        const int tm = tile / NTN, tn = tile % NTN;
        gemm_tile(lds, tm * 128, tn * 64, D, al, bl, ep);
    }
}

__device__ __forceinline__ void phase_zp(const Params& p, int l) {
    const int lane = otid() & 63, wave = otid() >> 6;
    const int gw = blockIdx.x * NW + wave, ngw = gridDim.x * NW;
    float* Z = (float*)(p.ws + WS_Z);
    const float gq = p.in[7][l * 64 + lane], gk = p.in[8][l * 64 + lane], gmq = p.in[12][l * 64 + lane], gmk = p.in[13][l * 64 + lane];
    for (int t = gw; t < T; t += ngw) {
        float* z = Z + (size_t)t * INW;
        for (int seg = 0; seg < 28; ++seg) {
            int col; float g;
            if (seg < 8) { col = ZC_Q + seg * 64; g = gq; }
            else if (seg < 10) { col = ZC_KS + (seg - 8) * 64; g = gk; }
            else if (seg < 12) { col = ZC_KW + (seg - 10) * 64; g = gk; }
            else if (seg < 20) { col = ZC_MQ + (seg - 12) * 64; g = gmq; }
            else { col = ZC_MK + (seg - 20) * 64; g = gmk; }
            const float v = z[col + lane];
            const float ss = wave_sum(v * v);
            z[col + lane] = v * rsqrtf(ss * (1.f / 64.f) + EPS) * g;
        }
        if (lane < 24) z[ZC_G + lane] = sigmoidf_(z[ZC_G + lane]);
    }
}

__device__ __forceinline__ void phase_ck(const Params& p, int l, float* lds) {
    const bf16_t* Z = (const bf16_t*)(p.ws + WS_ZB);
    float* HID = (float*)(p.ws + WS_HID);
    const float* posw = p.in[9] + (size_t)l * 2 * 32 * 64; const float* w1 = p.in[10] + (size_t)l * 2 * 2048 * 128;
    for (int tile = blockIdx.x; tile < 64; tile += gridDim.x) {
        const int idx = tile / 32, tm = (tile % 32) / 2, tn = tile % 2;
        const float* W = w1 + (size_t)idx * 2048 * 128; const float* PW = posw + (size_t)idx * 32 * 64; float* HO = HID + (size_t)idx * 2044 * 128;
        auto al = [=](int r, int k) -> float4 {
            if (r >= 2044) return make_float4(0.f, 0.f, 0.f, 0.f);
            const int b = r / 1022, g = (r / 511) & 1, n = r % 511, li = k >> 6, d = k & 63;
            const uint2 ab = *(const uint2*)(Z + (size_t)(b * S + 16 * n + li) * ZBW + ZB_KC + idx * 128 + g * 64 + d);
            const float4 a = make_float4(__builtin_bit_cast(float, ab.x << 16), __builtin_bit_cast(float, ab.x & 0xffff0000u), __builtin_bit_cast(float, ab.y << 16), __builtin_bit_cast(float, ab.y & 0xffff0000u));
            const float4 q = *(const float4*)(PW + li * 64 + d);
            return make_float4(a.x + q.x, a.y + q.y, a.z + q.z, a.w + q.w);
        };
        auto bl = [=](int k, int n) -> float2 { return *(const float2*)(W + (size_t)k * 128 + n); };
        auto ep = [=](int r, int c, float v) { if (r < 2044) HO[(size_t)r * 128 + c] = gelu_tanh(v); };
        gemm_tile(lds, tm * 128, tn * 64, 2048, al, bl, ep);
    }
    const int lane = otid() & 63, wave = otid() >> 6;
    float* KM = (float*)(p.ws + WS_KM);
    for (int it = blockIdx.x * NW + wave; it < Bn * 8 * 32; it += gridDim.x * NW) {
        const int b = it / 256, h = (it / 32) & 7, blk = it & 31;
        const bf16_t* base = Z + (size_t)(b * S + blk * 256) * ZBW + ZB_MK + h * 64 + lane;
        float s = 0.f;
        for (int i = 0; i < 256; ++i) s += bf2f(base[(size_t)i * ZBW]);
        KM[(size_t)it * 64 + lane] = s * (1.f / 256.f);
        ((bf16_t*)(p.ws + WS_KMB))[(size_t)it * 64 + lane] = (bf16_t)f2bf(s * (1.f / 256.f));
    }
}
__device__ __forceinline__ void phase_c2(const Params& p, int l) {
    const int lane = otid() & 63, wave = otid() >> 6;
    const float* HID = (const float*)(p.ws + WS_HID); const float* w2 = p.in[11] + (size_t)l * 2 * 128 * 64;
    float* KC = (float*)(p.ws + WS_KC); float* VC = (float*)(p.ws + WS_VC);
    const float gk = p.in[8][l * 64 + lane];
    for (int r = blockIdx.x * NW + wave; r < 2 * 2044; r += gridDim.x * NW) {
        const int idx = r / 2044, rr = r % 2044;
        const float* hrow = HID + (size_t)r * 128; const float* W = w2 + (size_t)idx * 128 * 64;
        float s = 0.f;
        for (int j = 0; j < 128; ++j) s += hrow[j] * W[j * 64 + lane];
        const int bgi = rr / 511, n = rr % 511;
        if (idx == 0) { const float ss = wave_sum(s * s); const float kv = s * rsqrtf(ss * (1.f / 64.f) + EPS) * gk; KC[(size_t)rr * 64 + lane] = kv; ((bf16_t*)(p.ws + WS_KCB))[((size_t)bgi * 512 + n) * 64 + lane] = (bf16_t)f2bf(kv); }
        else { VC[(size_t)rr * 64 + lane] = s; ((bf16_t*)(p.ws + WS_VCB))[((size_t)bgi * 512 + n) * 64 + lane] = (bf16_t)f2bf(s); }
    }
    if (blockIdx.x == 0 && otid() < 2 * 4 * 64) { const int i = otid(); bf16_t* dst = (bf16_t*)(p.ws + (i < 256 ? WS_KCB : WS_VCB)); dst[((size_t)((i & 255) >> 6) * 512 + 511) * 64 + (i & 63)] = 0; }
}

__device__ __forceinline__ void ld32bf(const bf16_t* p, float (&out)[32]) {
#pragma unroll
    for (int c = 0; c < 4; ++c) { const uint4 v = *(const uint4*)(p + 8 * c); const unsigned w[4] = {v.x, v.y, v.z, v.w};
#pragma unroll
        for (int i = 0; i < 4; ++i) { out[8 * c + 2 * i] = __builtin_bit_cast(float, w[i] << 16); out[8 * c + 2 * i + 1] = __builtin_bit_cast(float, w[i] & 0xffff0000u); } }
}
#define ATT_KEY(valid, kp, vp, bias)                                                              \
    {                                                                                             \
        float kk_[32]; ld32bf(kp, kk_);                                                           \
        float s_ = 0.f;                                                                           \
        _Pragma("unroll") for (int d = 0; d < 32; ++d) s_ += qv[d] * kk_[d];                      \
        s_ += __shfl_xor(s_, 1);                                                                  \
        s_ = s_ - (bias);                                                                         \
        if (valid) {                                                                              \
            float vv_[32]; ld32bf(vp, vv_);                                                       \
            if (s_ > m) { const float cf = exp2f(m - s_); lsum *= cf; _Pragma("unroll") for (int d = 0; d < 32; ++d) o[d] *= cf; m = s_; } \
            const float p_ = exp2f(s_ - m); lsum += p_;                                           \
            _Pragma("unroll") for (int d = 0; d < 32; ++d) o[d] += p_ * vv_[d];                   \
        }                                                                                         \
    }

__device__ __forceinline__ void nsa_item(const Params& p, int item, float* lds) {
    const int tid = otid(), q = (tid & 63) >> 1, half = tid & 1, h = __builtin_amdgcn_readfirstlane(tid >> 6), g = h >> 2, hg = h & 3;
    const int b = item >> 8, ci = item & 255, t0 = ci * 32, t = t0 + q, cur = t0 >> 6; const size_t tt = (size_t)b * S + t;
    const bf16_t* Z = (const bf16_t*)(p.ws + WS_ZB); const float* GT = (const float*)(p.ws + WS_GATE); float* ATT = (float*)(p.ws + WS_ATT);
    const float* KC = (const float*)(p.ws + WS_KC) + (size_t)(b * 2 + g) * NCMP * 64 + half * 32; const float* VC = (const float*)(p.ws + WS_VC) + (size_t)(b * 2 + g) * NCMP * 64 + half * 32;
    float* imp = lds;
    unsigned* selm = (unsigned*)(lds + 2 * 32 * 129);
    const float slope = exp2f(-(float)(h + 1)) * LOG2E;
    float qv[32], o[32];
    ld32bf(Z + tt * ZBW + ZB_Q + h * 64 + half * 32, qv);
    const float g0 = GT[tt * 32 + h * 3 + 0], g1 = GT[tt * 32 + h * 3 + 1], g2 = GT[tt * 32 + h * 3 + 2];
    for (int i = tid; i < 2 * 32 * 129; i += NT) imp[i] = 0.f;
    const int cnt_t = t >= 31 ? (t - 31) / 16 + 1 : 0;
    const int cnt_max = (t0 + 31 - 31) / 16 + 1;
    float m = NEGF, lsum = 0.f;
    _Pragma("unroll 1") for (int n = 0; n < cnt_max; ++n) {
        const float* kp = KC + (size_t)n * 64;
        float s_ = 0.f;
#pragma unroll
        for (int d = 0; d < 32; ++d) s_ += qv[d] * kp[d];
        s_ += __shfl_xor(s_, 1);
        s_ = s_ - slope * ((float)t - (16.f * n + 15.5f));
        if (n < cnt_t) { if (s_ > m) { lsum *= exp2f(m - s_); m = s_; } lsum += exp2f(s_ - m); }
    }
    const float linv = lsum > 0.f ? 1.f / lsum : 0.f;
#pragma unroll
    for (int d = 0; d < 32; ++d) o[d] = 0.f;
    __syncthreads();
    _Pragma("unroll 1") for (int r = 0; r < 4; ++r) {
        if (hg == r) {
            float* myimp = imp + (size_t)(g * 32 + q) * 129;
            _Pragma("unroll 1") for (int n = 0; n < cnt_max; ++n) {
                const float* kp = KC + (size_t)n * 64; const float* vp = VC + (size_t)n * 64;
                float s_ = 0.f;
#pragma unroll
                for (int d = 0; d < 32; ++d) s_ += qv[d] * kp[d];
                s_ += __shfl_xor(s_, 1);
                s_ = s_ - slope * ((float)t - (16.f * n + 15.5f));
                if (n < cnt_t) {
                    const float p_ = exp2f(s_ - m) * linv;
#pragma unroll
                    for (int d = 0; d < 32; ++d) o[d] += p_ * vp[d];
                    if (half == 0) {
                        myimp[n >> 2] += p_;
                        if ((n & 3) == 3) myimp[(n + 1) >> 2] += p_;
                    }
                }
            }
        }
        __syncthreads();
    }
    {
        float* ao = ATT + tt * D + h * 64 + half * 32;
#pragma unroll
        for (int d = 0; d < 32; d += 4) *(float4*)(ao + d) = make_float4(g0 * o[d], g0 * o[d + 1], g0 * o[d + 2], g0 * o[d + 3]);
    }
    if (hg == 0 && half == 0) {
        float* myimp = imp + (size_t)(g * 32 + q) * 129;
        _Pragma("unroll 1") for (int j = 0; j < 128; ++j) {
            float v = myimp[j];
            if (j == 0 || j == cur || j == cur - 1) v = 1e4f;
            if (j > cur) v = NEGF;
            myimp[j] = v;
        }
        unsigned mk0 = 0u, mk1 = 0u, mk2 = 0u, mk3 = 0u;
        _Pragma("unroll 1") for (int it = 0; it < 16; ++it) {
            float best = -3e38f; int bi = -1;
            _Pragma("unroll 4") for (int j = 0; j < 128; ++j) { const float v = myimp[j]; if (v > best) { best = v; bi = j; } }
            if (best <= NEGF) break;
            myimp[bi] = -3.4e38f;
            const unsigned bit = 1u << (bi & 31);
            if ((bi >> 5) == 0) mk0 |= bit; else if ((bi >> 5) == 1) mk1 |= bit; else if ((bi >> 5) == 2) mk2 |= bit; else mk3 |= bit;
        }
        unsigned* sm = selm + (g * 32 + q) * 4;
        sm[0] = mk0; sm[1] = mk1; sm[2] = mk2; sm[3] = mk3;
    }
    __syncthreads();
    {
        const unsigned* sm = selm + (g * 32 + q) * 4;
        const unsigned m0 = sm[0], m1 = sm[1], m2 = sm[2], m3 = sm[3];
        m = NEGF; lsum = 0.f;
#pragma unroll
        for (int d = 0; d < 32; ++d) o[d] = 0.f;
        _Pragma("unroll 1") for (int j = 0; j <= cur; ++j) {
            const unsigned w = (j >> 5) == 0 ? m0 : (j >> 5) == 1 ? m1 : (j >> 5) == 2 ? m2 : m3;
            const bool sel = (w >> (j & 31)) & 1u;
            if (__ballot(sel) == 0ull) continue;
            _Pragma("unroll 1") for (int kk = 0; kk < 64; ++kk) {
                const int ps = j * 64 + kk;
                const bf16_t* kp = Z + (size_t)(b * S + ps) * ZBW + ZB_KS + g * 64 + half * 32; const bf16_t* vp = Z + (size_t)(b * S + ps) * ZBW + ZB_VS + g * 64 + half * 32;
                const bool valid = sel && ps <= t;
                ATT_KEY(valid, kp, vp, slope * (float)(t - ps));
            }
        }
        const float li = lsum > 0.f ? g1 / lsum : 0.f;
        float* ao = ATT + tt * D + h * 64 + half * 32;
#pragma unroll
        for (int d = 0; d < 32; d += 4) { float4 a = *(float4*)(ao + d); a.x += li * o[d]; a.y += li * o[d + 1]; a.z += li * o[d + 2]; a.w += li * o[d + 3]; *(float4*)(ao + d) = a; }
    }
    {
        m = NEGF; lsum = 0.f;
#pragma unroll
        for (int d = 0; d < 32; ++d) o[d] = 0.f;
        const int lo = t0 - 511 > 0 ? t0 - 511 : 0;
        _Pragma("unroll 1") for (int ps = lo; ps <= t0 + 31; ++ps) {
            const bf16_t* kp = Z + (size_t)(b * S + ps) * ZBW + ZB_KW + g * 64 + half * 32; const bf16_t* vp = Z + (size_t)(b * S + ps) * ZBW + ZB_VW + g * 64 + half * 32;
            const bool valid = ps <= t && ps > t - 512;
            ATT_KEY(valid, kp, vp, slope * (float)(t - ps));
        }
        const float li = lsum > 0.f ? g2 / lsum : 0.f;
        float* ao = ATT + tt * D + h * 64 + half * 32;
        bf16_t* ab = (bf16_t*)(p.ws + WS_ATTB) + tt * D + h * 64 + half * 32;
#pragma unroll
        for (int d = 0; d < 32; d += 4) { float4 a = *(float4*)(ao + d); a.x += li * o[d]; a.y += li * o[d + 1]; a.z += li * o[d + 2]; a.w += li * o[d + 3]; *(float4*)(ao + d) = a;
            *(uint2*)(ab + d) = make_uint2(pk2(a.x, a.y), pk2(a.z, a.w)); }
    }
    __syncthreads();
}

__device__ __forceinline__ void moba_item(const Params& p, int item) {
    const int tid = otid(), q = (tid & 63) >> 1, half = tid & 1, h = __builtin_amdgcn_readfirstlane(tid >> 6);
    const int b = item >> 8, ci = item & 255, t0 = ci * 32, t = t0 + q, cb = t0 >> 8; const size_t tt = (size_t)b * S + t;
    const bf16_t* Z = (const bf16_t*)(p.ws + WS_ZB); const float* GT = (const float*)(p.ws + WS_GATE); float* ATT = (float*)(p.ws + WS_ATT);
    const float* KM = (const float*)(p.ws + WS_KM) + (size_t)(b * 8 + h) * 32 * 64 + half * 32;
    const float slope = exp2f(-(float)(h + 1)) * LOG2E;
    float qv[32], o[32];
    ld32bf(Z + tt * ZBW + ZB_MQ + h * 64 + half * 32, qv);
    float v1 = NEGF, v2 = NEGF, v3 = NEGF; int i1 = -1, i2 = -1, i3 = -1;
    _Pragma("unroll 1") for (int n = 0; n < cb; ++n) {
        const float* kp = KM + n * 64;
        float s_ = 0.f;
#pragma unroll
        for (int d = 0; d < 32; ++d) s_ += qv[d] * kp[d];
        s_ += __shfl_xor(s_, 1);
        if (s_ > v1) { v3 = v2; i3 = i2; v2 = v1; i2 = i1; v1 = s_; i1 = n; }
        else if (s_ > v2) { v3 = v2; i3 = i2; v2 = s_; i2 = n; }
        else if (s_ > v3) { v3 = s_; i3 = n; }
    }
    float m = NEGF, lsum = 0.f;
#pragma unroll
    for (int d = 0; d < 32; ++d) o[d] = 0.f;
    _Pragma("unroll 1") for (int n = 0; n < cb; ++n) {
        const bool sel = (n == i1) || (n == i2) || (n == i3);
        if (__ballot(sel) == 0ull) continue;
        _Pragma("unroll 1") for (int kk = 0; kk < 256; ++kk) {
            const int ps = n * 256 + kk;
            const bf16_t* kp = Z + (size_t)(b * S + ps) * ZBW + ZB_MK + h * 64 + half * 32; const bf16_t* vp = Z + (size_t)(b * S + ps) * ZBW + ZB_MV + h * 64 + half * 32;
            ATT_KEY(sel, kp, vp, slope * (float)(t - ps));
        }
    }
    _Pragma("unroll 1") for (int ps = cb * 256; ps <= t0 + 31; ++ps) {
        const bf16_t* kp = Z + (size_t)(b * S + ps) * ZBW + ZB_MK + h * 64 + half * 32; const bf16_t* vp = Z + (size_t)(b * S + ps) * ZBW + ZB_MV + h * 64 + half * 32;
        const bool valid = ps <= t;
        ATT_KEY(valid, kp, vp, slope * (float)(t - ps));
    }
    const float li = lsum > 0.f ? 1.f / lsum : 0.f;
    float* ao = ATT + tt * D + 512 + h * 64 + half * 32;
#pragma unroll
    for (int d = 0; d < 32; d += 4) *(float4*)(ao + d) = make_float4(li * o[d], li * o[d + 1], li * o[d + 2], li * o[d + 3]);
    bf16_t* ab = (bf16_t*)(p.ws + WS_ATTB) + tt * D + 512 + h * 64 + half * 32;
#pragma unroll
    for (int d = 0; d < 32; d += 4) *(uint2*)(ab + d) = make_uint2(pk2(li * o[d], li * o[d + 1]), pk2(li * o[d + 2], li * o[d + 3]));
}

__device__ __forceinline__ void phase_att(const Params& p, float* lds) {
    for (int pi = blockIdx.x; pi < 512; pi += gridDim.x) {
        nsa_item(p, pi, lds);
        moba_item(p, (pi & 256) | (255 - (pi & 255)));
    }
}

__device__ __forceinline__ void phase_g2(const Params& p, int l, float* lds) {
    const float* A = (const float*)(p.ws + WS_ATT); const float* W = p.in[14] + (size_t)l * D * D;
    const float* xin = l == 0 ? p.in[0] : p.out; float* XA = p.out;
    const float* mod = (const float*)(p.ws + WS_MOD) + (size_t)l * Bn * 6144 + 2 * D;
    auto al = [=](int r, int k) -> float4 { return *(const float4*)(A + (size_t)r * D + k); };
    auto bl = [=](int k, int n) -> float2 { return *(const float2*)(W + (size_t)k * D + n); };
    auto ep = [=](int r, int c, float v) { const int b = r / S; XA[(size_t)r * D + c] = xin[(size_t)r * D + c] + mod[(size_t)b * 6144 + c] * v; };
    for (int tile = blockIdx.x; tile < (T / 128) * (D / 64); tile += gridDim.x) {
        const int tm = tile / (D / 64), tn = tile % (D / 64);
        gemm_tile(lds, tm * 128, tn * 64, D, al, bl, ep);
    }
}

__device__ __forceinline__ void phase_r2(const Params& p, int l, float* lds, bool commit = true) {
    const int tid = otid(), lane = tid & 63, wave = tid >> 6;
    const int gw = blockIdx.x * NW + wave, ngw = gridDim.x * NW;
    const float* mod = (const float*)(p.ws + WS_MOD);
    const float* XA = p.out; float* H = (float*)(p.ws + WS_H);
    const float* lng = p.in[5] + (size_t)l * D; const float* rw = p.in[15] + (size_t)l * D * NE; const float* rb = p.in[16] + l * NE;
    int* toke = (int*)(p.ws + WS_TOKE); float* tokw = (float*)(p.ws + WS_TOKW); int* cnt = (int*)(p.ws + WS_CNT) + l * 32;
    bf16_t* XN = (bf16_t*)(p.ws + WS_XN);
    float* hrow = lds + wave * D;
    int* hist = (int*)(lds + NW * D);
    if (tid < 32) hist[tid] = 0;
    __syncthreads();
    for (int t = gw; t < T; t += ngw) {
        const int b = t / S;
        float4 v[4]; float ss = 0.f;
#pragma unroll
        for (int j = 0; j < 4; ++j) { v[j] = *(const float4*)(XA + (size_t)t * D + 4 * lane + 256 * j); ss += (v[j].x * v[j].x + v[j].y * v[j].y) + (v[j].z * v[j].z + v[j].w * v[j].w); }
        ss = wave_sum(ss);
        const float r = rsqrtf(ss * (1.f / D) + EPS);
        const float* sh = mod + ((size_t)l * Bn + b) * 6144 + 3 * D; const float* sc = mod + ((size_t)l * Bn + b) * 6144 + 4 * D;
#pragma unroll
        for (int j = 0; j < 4; ++j) {
            const int col = 4 * lane + 256 * j;
            const float4 g = *(const float4*)(lng + col), s1 = *(const float4*)(sc + col), s0 = *(const float4*)(sh + col);
            float4 o;
            o.x = v[j].x * r * g.x * (1.f + s1.x) + s0.x; o.y = v[j].y * r * g.y * (1.f + s1.y) + s0.y;
            o.z = v[j].z * r * g.z * (1.f + s1.z) + s0.z; o.w = v[j].w * r * g.w * (1.f + s1.w) + s0.w;
            *(float4*)(H + (size_t)t * D + col) = o;
            *(uint2*)(XN + (size_t)t * D + col) = make_uint2(pk2(o.x, o.y), pk2(o.z, o.w));
            *(float4*)(hrow + col) = o;
        }
        asm volatile("s_waitcnt lgkmcnt(0)" ::: "memory");
        __builtin_amdgcn_wave_barrier();
        const int e = lane & 31, half = lane >> 5;
        float acc = 0.f;
        for (int k = half * 512; k < half * 512 + 512; ++k) acc += hrow[k] * rw[(size_t)k * NE + e];
        acc += __shfl_xor(acc, 32);
        const float logit = acc + rb[e];
        float lg[32];
#pragma unroll
        for (int i = 0; i < 32; ++i) lg[i] = __shfl(logit, i);
        int s0i = 0, s1i = 0, s2i = 0, s3i = 0; float a0 = -3e38f, a1 = -3e38f, a2 = -3e38f, a3 = -3e38f;
#pragma unroll
        for (int i = 0; i < 32; ++i) if (lg[i] > a0) { a0 = lg[i]; s0i = i; }
#pragma unroll
        for (int i = 0; i < 32; ++i) if (i != s0i && lg[i] > a1) { a1 = lg[i]; s1i = i; }
#pragma unroll
        for (int i = 0; i < 32; ++i) if (i != s0i && i != s1i && lg[i] > a2) { a2 = lg[i]; s2i = i; }
#pragma unroll
        for (int i = 0; i < 32; ++i) if (i != s0i && i != s1i && i != s2i && lg[i] > a3) { a3 = lg[i]; s3i = i; }
        const float e0 = 1.f, e1 = __expf(a1 - a0), e2 = __expf(a2 - a0), e3 = __expf(a3 - a0);
        const float inv = 1.f / (((e0 + e1) + e2) + e3);
        if (lane == 0) {
            toke[t * 4 + 0] = s0i; toke[t * 4 + 1] = s1i; toke[t * 4 + 2] = s2i; toke[t * 4 + 3] = s3i;
            tokw[t * 4 + 0] = e0 * inv; tokw[t * 4 + 1] = e1 * inv; tokw[t * 4 + 2] = e2 * inv; tokw[t * 4 + 3] = e3 * inv;
            if (commit) { atomicAdd(&hist[s0i], 1); atomicAdd(&hist[s1i], 1); atomicAdd(&hist[s2i], 1); atomicAdd(&hist[s3i], 1); }
        }
        __builtin_amdgcn_wave_barrier();
    }
    __syncthreads();
    if (tid < 32 && hist[tid] != 0) atomicAdd(&cnt[tid], hist[tid]);
}

__device__ __forceinline__ void load_pstart(const Params& p, int l, int* ps) {
    const int* cnt = (const int*)(p.ws + WS_CNT) + l * 32;
    if (otid() == 0) { int s = 0; for (int e = 0; e < 32; ++e) { ps[e] = s; s += (cnt[e] + 255) & ~255; } ps[32] = s; }
    __syncthreads();
}

__device__ __forceinline__ void phase_sc(const Params& p, int l, float* lds) {
    int* ps = (int*)lds;
    load_pstart(p, l, ps);
    const int gtid = blockIdx.x * NT + otid(), gsz = gridDim.x * NT;
    const int* toke = (const int*)(p.ws + WS_TOKE); const float* tokw = (const float*)(p.ws + WS_TOKW);
    int* fill = (int*)(p.ws + WS_FILL) + l * 32; int* rowtok = (int*)(p.ws + WS_ROWTOK) + (size_t)l * RMAX; float* roww = (float*)(p.ws + WS_ROWW) + (size_t)l * RMAX;
    int* pos = (int*)(p.ws + WS_POS);
    for (int i = gtid; i < A_TOT; i += gsz) {
        const int e = toke[i];
        const int slot = ps[e] + atomicAdd(&fill[e], 1);
        rowtok[slot] = i >> 2; roww[slot] = tokw[i]; pos[i] = slot;
    }
    __syncthreads();
}

__device__ __forceinline__ void phase_m1(const Params& p, int l, float* lds) {
    int* ps = (int*)(lds + 16 * 132 + 16 * 68);
    load_pstart(p, l, ps);
    const int rused = ps[32];
    const float* H = (const float*)(p.ws + WS_H); float* U = (float*)(p.ws + WS_U);
    const int* rowtok = (const int*)(p.ws + WS_ROWTOK) + (size_t)l * RMAX;
    const int ntm = rused / 128, ntn = 2048 / 64;
    for (int tile = blockIdx.x; tile < ntm * ntn; tile += gridDim.x) {
        const int tm = tile / ntn, tn = tile % ntn;
        int e = 0; for (int i = 1; i < 32; ++i) if (ps[i] <= tm * 128) e = i;
        const float* W = p.in[17] + ((size_t)l * NE + e) * D * 2048; const float* b1 = p.in[18] + ((size_t)l * NE + e) * 2048;
        auto al = [=](int r, int k) -> float4 { const int tk = rowtok[r]; return tk >= 0 ? *(const float4*)(H + (size_t)tk * D + k) : make_float4(0.f, 0.f, 0.f, 0.f); };
        auto bl = [=](int k, int n) -> float2 { return *(const float2*)(W + (size_t)k * 2048 + n); };
        auto ep = [=](int r, int c, float v) { U[(size_t)r * 2048 + c] = v + b1[c]; };
        gemm_tile(lds, tm * 128, tn * 64, D, al, bl, ep);
    }
    __syncthreads();
}
__device__ __forceinline__ void phase_m2(const Params& p, int l, float* lds) {
    int* ps = (int*)(lds + 16 * 132 + 16 * 68);
    load_pstart(p, l, ps);
    const int rused = ps[32];
    const float* U = (const float*)(p.ws + WS_U); float* Y = (float*)(p.ws + WS_Y);
    const float* roww = (const float*)(p.ws + WS_ROWW) + (size_t)l * RMAX;
    const int ntm = rused / 128, ntn = D / 64;
    for (int tile = blockIdx.x; tile < ntm * ntn; tile += gridDim.x) {
        const int tm = tile / ntn, tn = tile % ntn;
        int e = 0; for (int i = 1; i < 32; ++i) if (ps[i] <= tm * 128) e = i;
        const float* W = p.in[19] + ((size_t)l * NE + e) * DFF * D; const float* b2 = p.in[20] + ((size_t)l * NE + e) * D;
        auto al = [=](int r, int k) -> float4 {
            const float4 gg = *(const float4*)(U + (size_t)r * 2048 + k), ll = *(const float4*)(U + (size_t)r * 2048 + 1024 + k);
            const float g_[4] = {gg.x, gg.y, gg.z, gg.w}, l_[4] = {ll.x, ll.y, ll.z, ll.w}; float o_[4];
#pragma unroll
            for (int i = 0; i < 4; ++i) { const float gc = fminf(g_[i], 7.f), lc = fminf(fmaxf(l_[i], -7.f), 7.f); o_[i] = (lc + 1.f) * gc * sigmoidf_(1.702f * gc); }
            return make_float4(o_[0], o_[1], o_[2], o_[3]);
        };
        auto bl = [=](int k, int n) -> float2 { return *(const float2*)(W + (size_t)k * D + n); };
        auto ep = [=](int r, int c, float v) { Y[(size_t)r * D + c] = (v + b2[c]) * roww[r]; };
        gemm_tile(lds, tm * 128, tn * 64, DFF, al, bl, ep);
    }
    __syncthreads();
}


template <int MAP>
__device__ __forceinline__ void tr_tile(const float* W, int Nsrc, bf16_t* WT, int K, int k0, int n0, float* scr, int lane) {
    const int nl = (lane & 15) * 4, kr = lane >> 4;
    int sc = n0 + nl;
    if (MAP == 1) { sc = sc < 1280 ? sc : (sc < 2816 ? sc + 24 : (sc < 2840 ? sc - 2816 + 1280 : -1)); }
    float4 v[16];
#pragma unroll
    for (int it = 0; it < 16; ++it) v[it] = sc >= 0 ? *(const float4*)(W + (size_t)(k0 + it * 4 + kr) * Nsrc + sc) : make_float4(0.f, 0.f, 0.f, 0.f);
#pragma unroll
    for (int it = 0; it < 16; ++it) { float* s = scr + (it * 4 + kr) * 65 + nl; s[0] = v[it].x; s[1] = v[it].y; s[2] = v[it].z; s[3] = v[it].w; }
    asm volatile("s_waitcnt lgkmcnt(0)" ::: "memory"); __builtin_amdgcn_wave_barrier();
    const int c = lane & 7, nr = lane >> 3;
#pragma unroll
    for (int it = 0; it < 8; ++it) {
        const int n = it * 8 + nr; const float* s = scr + (8 * c) * 65 + n;
        uint4 o; o.x = pk2(s[0], s[65]); o.y = pk2(s[2 * 65], s[3 * 65]); o.z = pk2(s[4 * 65], s[5 * 65]); o.w = pk2(s[6 * 65], s[7 * 65]);
        *(uint4*)(WT + (size_t)(n0 + n) * K + k0 + 8 * c) = o;
    }
    asm volatile("s_waitcnt lgkmcnt(0)" ::: "memory"); __builtin_amdgcn_wave_barrier();
}
__device__ __forceinline__ void phase_convert(const Params& p, float* lds) {
    const int tid = otid(), lane = tid & 63, wave = tid >> 6;
    float* scr = lds + wave * (64 * 65);
    const int gw = blockIdx.x * NW + wave, ngw = gridDim.x * NW;
    bf16_t* WinT = (bf16_t*)(p.ws + WS_WINT); bf16_t* WoT = (bf16_t*)(p.ws + WS_WOT); bf16_t* W1T = (bf16_t*)(p.ws + WS_W1T); bf16_t* W2T = (bf16_t*)(p.ws + WS_W2T);
    constexpr int I_IN = L * 16 * (ZBW / 64), I_O = L * 16 * 16, I_1 = L * NE * 16 * 32, I_2 = L * NE * 16 * 16, I_C = L * 2 * 32 * 2;
    for (int it = gw; it < I_C + I_IN + I_O + I_1 + I_2; it += ngw) {
        int r = it;
        if (r < I_C) { const int li = r / 64, q = r % 64, kb = q / 2, nb = q % 2;
            tr_tile<0>(p.in[10] + (size_t)li * 2048 * 128, 128, (bf16_t*)(p.ws + WS_WCT) + (size_t)li * 128 * 2048, 2048, kb * 64, nb * 64, scr, lane); continue; }
        r -= I_C;
        if (r < I_IN) { const int l = r / (16 * 48), q = r % (16 * 48), kb = q / 48, nb = q % 48;
            tr_tile<1>(p.in[6] + (size_t)l * D * INW, INW, WinT + (size_t)l * ZBW * D, D, kb * 64, nb * 64, scr, lane); continue; }
        r -= I_IN;
        if (r < I_O) { const int l = r / 256, q = r % 256, kb = q / 16, nb = q % 16;
            tr_tile<0>(p.in[14] + (size_t)l * D * D, D, WoT + (size_t)l * D * D, D, kb * 64, nb * 64, scr, lane); continue; }
        r -= I_O;
        if (r < I_1) { const int le = r / 512, q = r % 512, kb = q / 32, nb = q % 32;
            tr_tile<0>(p.in[17] + (size_t)le * D * 2048, 2048, W1T + (size_t)le * 2048 * D, D, kb * 64, nb * 64, scr, lane); continue; }
        r -= I_1;
        { const int le = r / 256, q = r % 256, kb = q / 16, nb = q % 16;
            tr_tile<0>(p.in[19] + (size_t)le * DFF * D, D, W2T + (size_t)le * D * DFF, DFF, kb * 64, nb * 64, scr, lane); }
    }
    if (blockIdx.x == 0) { bf16_t* XN = (bf16_t*)(p.ws + WS_XN); for (int i = tid; i < D / 2; i += NT) ((unsigned*)(XN + (size_t)T * D))[i] = 0u; }
}

namespace pg8 {
#define PG8_LAS __attribute__((address_space(3)))
typedef short bf16x8 __attribute__((ext_vector_type(8)));
typedef float f32x4 __attribute__((ext_vector_type(4)));
typedef unsigned u32x4 __attribute__((ext_vector_type(4)));
constexpr int BM = 256, BK = 64, HALF = 128, HTB = HALF * BK * 2, STAGE_BYTES = 8 * HTB, NXCD = 8, WGM = 8;
__device__ __forceinline__ int lds_byte(int r, int c) { const int st = (r >> 4) * 2 + (c >> 5), rr = r & 15, cc = c & 31, ob = rr * 64 + cc * 2; return st * 1024 + (ob ^ (((ob >> 9) & 1) << 5)); }
__device__ __forceinline__ void stage_rc(int b, int& R, int& C) { const int st = b / 1024, sb = b % 1024, swz = sb ^ (((sb >> 9) & 1) << 5); R = (st >> 1) * 16 + swz / 64; C = (st & 1) * 32 + (swz % 64) / 2; }
__device__ __forceinline__ int perm32(int rho) { const int n = rho >> 4, i = rho & 15; return 8 * (i >> 2) + 4 * n + (i & 3); }
struct Unit { int pm, pn, e; };
__device__ __forceinline__ unsigned cvt_pk_bf16(float lo, float hi) { unsigned r; asm volatile("v_cvt_pk_bf16_f32 %0, %1, %2" : "=v"(r) : "v"(lo), "v"(hi)); return r; }

__device__ __forceinline__ bool static_next(int nM, int nN, int G, int c, int i, Unit& u) {
    const int nwg = nM * nN; const long Lq = (long)i * G + c; if (Lq >= nwg) return false;
    int wgid = (int)Lq; { const int q = nwg / NXCD, r = nwg % NXCD, xcd = wgid % NXCD, off = wgid / NXCD; wgid = (xcd < r ? xcd * (q + 1) : r * (q + 1) + (xcd - r) * q) + off; }
    const int nig = WGM * nN, gid = wgid / nig, fm = gid * WGM, gsz = (nM - fm) < WGM ? (nM - fm) : WGM;
    u.pm = fm + ((wgid % nig) % gsz); u.pn = (wgid % nig) / gsz; u.e = 0; return true;
}

template <class Prob, class Epi, bool ALIGN_EPI, bool SP2>
__device__ __forceinline__ void gemm_phase(PG8_LAS unsigned char* lds, const Prob& P, const Epi& E) {
    const int tid = otid(), wid = __builtin_amdgcn_readfirstlane(tid >> 6), lane = tid & 63, wr = wid >> 2, wc = wid & 3, fr = lane & 15, fq = lane >> 4;
    const int K = P.K, nt = K / BK;
    int sR[2], sC[2]; unsigned voffB[2];
#pragma unroll
    for (int i = 0; i < 2; ++i) { stage_rc(tid * 16 + i * 8192, sR[i], sC[i]); voffB[i] = (unsigned)(P.b_row(sR[i]) * K + sC[i]) * 2u; }
    const size_t kstep = (size_t)(BK * 2);
    const size_t kstepA = P.a_kstep();
    const size_t hstepB = P.b_hstep();
    const unsigned ldsw = (unsigned)wid * 1024u;
    const int aoff = lds_byte(wr * 64 + fr, fq * 8), boff = lds_byte(wc * 32 + fr, fq * 8);
#define PG8_SA(b, h) (((b) * 2 + (h)) * HTB)
#define PG8_SB(b, h) ((4 + (b) * 2 + (h)) * HTB)
#define PG8_STAGE(bufoff, gbase, voff) do { _Pragma("unroll") for (int _i = 0; _i < 2; ++_i) \
        __builtin_amdgcn_global_load_lds((const unsigned*)((const char*)(gbase) + (voff)[_i]), (PG8_LAS unsigned*)(lds + (bufoff) + ldsw + _i * 8192), 16, 0, 0); } while (0)
#define PG8_STAGE_SEL(bufoff, gbase, h) do { _Pragma("unroll") for (int _i = 0; _i < 2; ++_i) { unsigned _vo = vAc[h][_i]; if constexpr (Prob::GATHER) _vo = last ? vAn[h][_i] : _vo; \
        __builtin_amdgcn_global_load_lds((const unsigned*)((const char*)(gbase) + _vo), (PG8_LAS unsigned*)(lds + (bufoff) + ldsw + _i * 8192), 16, 0, 0); } } while (0)
#define PG8_LDA(dst, b, h) do { _Pragma("unroll") for (int m = 0; m < 4; ++m) _Pragma("unroll") for (int k = 0; k < 2; ++k) dst[m][k] = *(const PG8_LAS bf16x8*)(lds + PG8_SA(b, h) + aoff + m * 2048 + k * 1024); } while (0)
#define PG8_LDB(dst, b, h) do { _Pragma("unroll") for (int n = 0; n < 2; ++n) _Pragma("unroll") for (int k = 0; k < 2; ++k) dst[n][k] = *(const PG8_LAS bf16x8*)(lds + PG8_SB(b, h) + boff + n * 2048 + k * 1024); } while (0)
#define PG8_MMA(ai, bj, At, Bt) do { __builtin_amdgcn_s_setprio(1); _Pragma("unroll") for (int m = 0; m < 4; ++m) _Pragma("unroll") for (int n = 0; n < 2; ++n) _Pragma("unroll") for (int k = 0; k < 2; ++k) \
        acc[ai][bj][m][n] = __builtin_amdgcn_mfma_f32_16x16x32_bf16(Bt[n][k], At[m][k], acc[ai][bj][m][n], 0, 0, 0); __builtin_amdgcn_s_setprio(0); } while (0)
#define PG8_WAIT_V(n) asm volatile("s_waitcnt vmcnt(" #n ")" ::: "memory")
#define PG8_WAIT_L(n) asm volatile("s_waitcnt lgkmcnt(" #n ")" ::: "memory")
#define PG8_BAR __builtin_amdgcn_s_barrier()
#define PG8_SCHED __builtin_amdgcn_sched_barrier(0)
    Unit cur, nxt; int ui = 0;
    if (!P.next(0, cur)) return;
    f32x4 acc[2][2][4][2];
#pragma unroll
    for (int a = 0; a < 2; ++a)
#pragma unroll
        for (int b = 0; b < 2; ++b)
#pragma unroll
            for (int m = 0; m < 4; ++m)
#pragma unroll
                for (int n = 0; n < 2; ++n) acc[a][b][m][n] = (f32x4){0.f, 0.f, 0.f, 0.f};
    bf16x8 At[4][2], B0[2][2], B1[2][2];
    unsigned vAc[2][2], vAn[2][2];
    const char* cA = P.a_base(cur); const char* cB = P.b_base(cur);
    P.a_voff(cur, sR, sC, vAc);
#pragma unroll
    for (int h = 0; h < 2; ++h)
#pragma unroll
        for (int i = 0; i < 2; ++i) vAn[h][i] = vAc[h][i];
    if constexpr (SP2) {
        PG8_STAGE(PG8_SB(0, 0), cB, voffB); PG8_STAGE(PG8_SB(0, 1), cB + hstepB, voffB); PG8_STAGE(PG8_SA(0, 0), cA, vAc[0]); PG8_STAGE(PG8_SA(0, 1), cA, vAc[1]);
        if (wr == 1) PG8_BAR;
        PG8_WAIT_V(2); PG8_BAR;
        PG8_STAGE(PG8_SB(1, 0), cB + kstep, voffB); PG8_STAGE(PG8_SA(1, 0), cA + kstepA, vAc[0]); PG8_STAGE(PG8_SB(1, 1), cB + hstepB + kstep, voffB);
        PG8_WAIT_V(6); PG8_BAR;
    } else {
        PG8_STAGE(PG8_SB(0, 0), cB, voffB); PG8_STAGE(PG8_SA(0, 0), cA, vAc[0]); PG8_STAGE(PG8_SB(0, 1), cB + hstepB, voffB); PG8_STAGE(PG8_SA(0, 1), cA, vAc[1]);
        if (wr == 1) PG8_BAR;
        PG8_WAIT_V(4); PG8_BAR;
        PG8_STAGE(PG8_SB(1, 0), cB + kstep, voffB); PG8_STAGE(PG8_SA(1, 0), cA + kstepA, vAc[0]); PG8_STAGE(PG8_SB(1, 1), cB + hstepB + kstep, voffB);
        PG8_WAIT_V(6); PG8_BAR;
    }
    for (;;) {
        const bool has_next = P.next(ui + 1, nxt);
        const char* nA = cA; const char* nB = cB;
        if (has_next) { nA = P.a_base(nxt); nB = P.b_base(nxt); if constexpr (Prob::GATHER) P.a_voff(nxt, sR, sC, vAn); }
        for (int t = 0; t < nt; t += 2) {
            const bool last = (t == nt - 2);
            const char* a1 = cA + (size_t)(t + 1) * kstepA;
            const char* a2 = last ? nA : cA + (size_t)(t + 2) * kstepA; const char* b2 = last ? nB : cB + (size_t)(t + 2) * kstep;
            const char* a3 = a2 + kstepA; const char* b3 = b2 + kstep;
            if constexpr (SP2) {
            PG8_LDB(B0, 0, 0); PG8_LDB(B1, 0, 1); PG8_SCHED; PG8_LDA(At, 0, 0); PG8_STAGE(PG8_SA(1, 1), a1, vAc[1]);
            PG8_WAIT_V(8); PG8_WAIT_L(0); PG8_BAR; PG8_MMA(0, 0, At, B0); PG8_MMA(0, 1, At, B1); PG8_BAR; PG8_SCHED;
            PG8_LDA(At, 0, 1); PG8_STAGE(PG8_SB(0, 0), b2, voffB); PG8_STAGE(PG8_SB(0, 1), b2 + hstepB, voffB); PG8_STAGE_SEL(PG8_SA(0, 0), a2, 0);
            PG8_WAIT_V(8); PG8_WAIT_L(0); PG8_BAR; PG8_MMA(1, 0, At, B0); PG8_MMA(1, 1, At, B1); PG8_BAR; PG8_SCHED;
            PG8_LDB(B0, 1, 0); PG8_LDB(B1, 1, 1); PG8_SCHED; PG8_LDA(At, 1, 0); PG8_STAGE_SEL(PG8_SA(0, 1), a2, 1);
            PG8_WAIT_V(8); PG8_WAIT_L(0); PG8_BAR; PG8_MMA(0, 0, At, B0); PG8_MMA(0, 1, At, B1); PG8_BAR; PG8_SCHED;
            PG8_LDA(At, 1, 1); PG8_STAGE(PG8_SB(1, 0), b3, voffB); PG8_STAGE(PG8_SB(1, 1), b3 + hstepB, voffB); PG8_STAGE_SEL(PG8_SA(1, 0), a3, 0);
            PG8_WAIT_V(8); PG8_WAIT_L(0); PG8_BAR; PG8_MMA(1, 0, At, B0); PG8_MMA(1, 1, At, B1); PG8_BAR; PG8_SCHED;
            } else {
            PG8_LDB(B0, 0, 0); PG8_SCHED; PG8_LDA(At, 0, 0); PG8_STAGE(PG8_SA(1, 1), a1, vAc[1]);
            PG8_WAIT_L(8); PG8_BAR; PG8_WAIT_L(0); PG8_MMA(0, 0, At, B0); PG8_BAR; PG8_SCHED;
            PG8_LDB(B1, 0, 1); PG8_STAGE(PG8_SB(0, 0), b2, voffB);
            PG8_BAR; PG8_WAIT_L(0); PG8_MMA(0, 1, At, B1); PG8_BAR;
            PG8_LDA(At, 0, 1); PG8_STAGE_SEL(PG8_SA(0, 0), a2, 0);
            PG8_BAR; PG8_WAIT_L(0); PG8_MMA(1, 0, At, B0); PG8_BAR; PG8_SCHED;
            PG8_STAGE(PG8_SB(0, 1), b2 + hstepB, voffB);
            PG8_WAIT_V(6); PG8_BAR; PG8_MMA(1, 1, At, B1); PG8_BAR;
            PG8_LDB(B0, 1, 0); PG8_SCHED; PG8_LDA(At, 1, 0); PG8_STAGE_SEL(PG8_SA(0, 1), a2, 1);
            PG8_WAIT_L(8); PG8_BAR; PG8_WAIT_L(0); PG8_MMA(0, 0, At, B0); PG8_BAR; PG8_SCHED;
            PG8_LDB(B1, 1, 1); PG8_STAGE(PG8_SB(1, 0), b3, voffB);
            PG8_BAR; PG8_WAIT_L(0); PG8_MMA(0, 1, At, B1); PG8_BAR;
            PG8_LDA(At, 1, 1); PG8_STAGE_SEL(PG8_SA(1, 0), a3, 0);
            PG8_BAR; PG8_WAIT_L(0); PG8_MMA(1, 0, At, B0); PG8_BAR; PG8_SCHED;
            PG8_STAGE(PG8_SB(1, 1), b3 + hstepB, voffB);
            PG8_WAIT_V(6); PG8_BAR; PG8_MMA(1, 1, At, B1); PG8_BAR;
            }
        }
        if constexpr (ALIGN_EPI) { if (wr == 0) PG8_BAR; }
        E(acc, cur, wr, wc, fr, fq);
        if (!has_next) break;
#pragma unroll
        for (int a = 0; a < 2; ++a)
#pragma unroll
            for (int b = 0; b < 2; ++b)
#pragma unroll
                for (int m = 0; m < 4; ++m)
#pragma unroll
                    for (int n = 0; n < 2; ++n) acc[a][b][m][n] = (f32x4){0.f, 0.f, 0.f, 0.f};
        cur = nxt; cA = nA; cB = nB; ++ui;
        if constexpr (Prob::GATHER) {
#pragma unroll
            for (int h = 0; h < 2; ++h)
#pragma unroll
                for (int i = 0; i < 2; ++i) vAc[h][i] = vAn[h][i];
        }
        if constexpr (ALIGN_EPI) { if (wr == 1) PG8_BAR; }
    }
    PG8_WAIT_V(0);
    if constexpr (!ALIGN_EPI) { if (wr == 0) PG8_BAR; }
    PG8_BAR;
#undef PG8_SA
#undef PG8_SB
#undef PG8_STAGE
#undef PG8_STAGE_SEL
#undef PG8_LDA
#undef PG8_LDB
#undef PG8_MMA
#undef PG8_WAIT_V
#undef PG8_WAIT_L
#undef PG8_BAR
#undef PG8_SCHED
}

struct ProbDense { static constexpr bool GATHER = false;
    const bf16_t* A; const bf16_t* Bt; int K, nM, nN, G, c; bool headperm;
    __device__ __forceinline__ bool next(int i, Unit& u) const { return static_next(nM, nN, G, c, i, u); }
    __device__ __forceinline__ const char* a_base(const Unit& u) const { return (const char*)(A + (size_t)u.pm * BM * K); }
    __device__ __forceinline__ void a_voff(const Unit&, const int (&R)[2], const int (&C)[2], unsigned (&v)[2][2]) const {
#pragma unroll
        for (int h = 0; h < 2; ++h)
#pragma unroll
            for (int i = 0; i < 2; ++i) v[h][i] = (unsigned)((h * HALF + R[i]) * K + C[i]) * 2u;
    }
    __device__ __forceinline__ const char* b_base(const Unit& u) const { return (const char*)(Bt + (size_t)u.pn * BM * K); }
    __device__ __forceinline__ size_t a_kstep() const { return (size_t)BK * 2; }
    __device__ __forceinline__ size_t b_hstep() const { return headperm ? (size_t)32 * K * 2 : (size_t)HALF * K * 2; }
    __device__ __forceinline__ int b_row(int R) const { return headperm ? ((R >> 5) * 64 + perm32(R & 31)) : ((R & ~31) + perm32(R & 31)); }
};
typedef const PG8_LAS int* lds_ints;
__device__ __forceinline__ int expert_of(lds_ints ps, int pm) { int e = 0;
#pragma unroll
    for (int i = 1; i < 32; ++i) if (ps[i] <= pm * 256) e = i;
    return __builtin_amdgcn_readfirstlane(e); }
struct ProbMoe1 { static constexpr bool GATHER = true;
    const bf16_t* XN; const bf16_t* W1T; const int* rowtok; lds_ints ps; int K, ntm, G, c;
    __device__ __forceinline__ bool next(int i, Unit& u) const { const int q = i * G + c; if (q >= ntm * 8) return false; u.pm = q >> 3; u.pn = q & 7; u.e = expert_of(ps, u.pm); return true; }
    __device__ __forceinline__ const char* a_base(const Unit&) const { return (const char*)XN; }
    __device__ __forceinline__ void a_voff(const Unit& u, const int (&R)[2], const int (&C)[2], unsigned (&v)[2][2]) const {
#pragma unroll
        for (int h = 0; h < 2; ++h)
#pragma unroll
            for (int i = 0; i < 2; ++i) { int tk = rowtok[u.pm * BM + h * HALF + R[i]]; if (tk < 0) tk = T; v[h][i] = (unsigned)(tk * K + C[i]) * 2u; }
    }
    __device__ __forceinline__ const char* b_base(const Unit& u) const { return (const char*)(W1T + ((size_t)u.e * 2048 + u.pn * 128) * K); }
    __device__ __forceinline__ size_t a_kstep() const { return (size_t)BK * 2; }
    __device__ __forceinline__ size_t b_hstep() const { return (size_t)1024 * K * 2; }
    __device__ __forceinline__ int b_row(int R) const { return (R & ~31) + perm32(R & 31); }
};
struct ProbMoe2 { static constexpr bool GATHER = false;
    const bf16_t* ACT; const bf16_t* W2T; lds_ints ps; int K, ntm, G, c;
    __device__ __forceinline__ bool next(int i, Unit& u) const { const int q = i * G + c; if (q >= ntm * 4) return false; u.pm = q >> 2; u.pn = q & 3; u.e = expert_of(ps, u.pm); return true; }
    __device__ __forceinline__ const char* a_base(const Unit& u) const { return (const char*)(ACT + (size_t)u.pm * BM * K); }
    __device__ __forceinline__ void a_voff(const Unit&, const int (&R)[2], const int (&C)[2], unsigned (&v)[2][2]) const {
#pragma unroll
        for (int h = 0; h < 2; ++h)
#pragma unroll
            for (int i = 0; i < 2; ++i) v[h][i] = (unsigned)((h * HALF + R[i]) * K + C[i]) * 2u;
    }
    __device__ __forceinline__ const char* b_base(const Unit& u) const { return (const char*)(W2T + ((size_t)u.e * 1024 + u.pn * BM) * K); }
    __device__ __forceinline__ size_t a_kstep() const { return (size_t)BK * 2; }
    __device__ __forceinline__ size_t b_hstep() const { return (size_t)HALF * K * 2; }
    __device__ __forceinline__ int b_row(int R) const { return (R & ~31) + perm32(R & 31); }
};

struct ProbCmp { static constexpr bool GATHER = false;
    const bf16_t* ZB; const bf16_t* W1T; int K, G, c;
    __device__ __forceinline__ bool next(int i, Unit& u) const { const int q = i * G + c; if (q >= 16) return false; u.pm = q; u.pn = 0; u.e = 0; return true; }
    __device__ __forceinline__ const char* a_base(const Unit& u) const { const int idx = u.pm >> 3, bg = (u.pm >> 1) & 3, half = u.pm & 1;
        return (const char*)(ZB + ((size_t)(bg >> 1) * S + 16 * 256 * half) * ZBW + ZB_KC + idx * 128 + (bg & 1) * 64); }
    __device__ __forceinline__ void a_voff(const Unit&, const int (&R)[2], const int (&C)[2], unsigned (&v)[2][2]) const {
#pragma unroll
        for (int h = 0; h < 2; ++h)
#pragma unroll
            for (int i = 0; i < 2; ++i) v[h][i] = (unsigned)(16 * (h * HALF + R[i]) * ZBW + C[i]) * 2u;
    }
    __device__ __forceinline__ size_t a_kstep() const { return (size_t)ZBW * 2; }
    __device__ __forceinline__ const char* b_base(const Unit& u) const { return (const char*)(W1T + (size_t)(u.pm >> 3) * 128 * K); }
    __device__ __forceinline__ size_t b_hstep() const { return 0; }
    __device__ __forceinline__ int b_row(int R) const { return (R & ~31) + perm32(R & 31); }
};
struct EpiCmp {
    float* HID; const float* cb;
    __device__ __forceinline__ void operator()(const f32x4 (&acc)[2][2][4][2], const Unit& u, int wr, int wc, int fr, int fq) const {
        const int idx = u.pm >> 3, bg = (u.pm >> 1) & 3, half = u.pm & 1;
        const int c0 = 32 * wc + 8 * fq;
        const f32x4 b0 = *(const f32x4*)(cb + idx * 128 + c0), b1 = *(const f32x4*)(cb + idx * 128 + c0 + 4);
#pragma unroll
        for (int ai = 0; ai < 2; ++ai)
#pragma unroll
            for (int m = 0; m < 4; ++m) { const int n = 256 * half + ai * HALF + wr * 64 + m * 16 + fr;
                if (n < 511) { float* dst = HID + ((size_t)idx * 2044 + bg * 511 + n) * 128 + c0;
                    const f32x4 x0 = acc[ai][0][m][0] + b0, x1 = acc[ai][0][m][1] + b1; f32x4 o0, o1;
#pragma unroll
                    for (int i = 0; i < 4; ++i) { o0[i] = gelu_tanh(x0[i]); o1[i] = gelu_tanh(x1[i]); }
                    *(f32x4*)dst = o0; *(f32x4*)(dst + 4) = o1; } }
    }
};
struct EpiG1Z {
    float* Z;
    __device__ __forceinline__ void operator()(const f32x4 (&acc)[2][2][4][2], const Unit& u, int wr, int wc, int fr, int fq) const {
#pragma unroll
        for (int ai = 0; ai < 2; ++ai)
#pragma unroll
            for (int m = 0; m < 4; ++m) { const size_t r = (size_t)u.pm * BM + ai * HALF + wr * 64 + m * 16 + fr;
#pragma unroll
                for (int bj = 0; bj < 2; ++bj)
#pragma unroll
                    for (int n = 0; n < 2; ++n) { const int zc = u.pn * BM + 64 * wc + 32 * bj + 8 * fq + 4 * n;
                        const int col = zc < 1280 ? zc : (zc < 2816 ? zc + 24 : (zc < 2840 ? zc - 2816 + 1280 : -1));
                        if (col >= 0) *(f32x4*)(Z + r * INW + col) = acc[ai][bj][m][n]; } }
    }
};
struct EpiG1F {
    bf16_t* ZB; float* GATE; const float* gq; const float* gk; const float* gmq; const float* gmk;
    __device__ __forceinline__ void operator()(const f32x4 (&acc)[2][2][4][2], const Unit& u, int wr, int wc, int fr, int fq) const {
        const int pn = u.pn;
        const float* gain = nullptr; float sc = 1.f;
        if (pn < 2) { gain = gq; sc = QSCALE; }
        else if (pn == 3 || pn == 4) { if (wc < 2) gain = gk; }
        else if (pn == 5 || pn == 6) { gain = gmq; sc = QSCALE; }
        else if (pn == 7 || pn == 8) { gain = gmk; }
        if (pn == 11) {
            if (wc == 0 && fq < 3) {
#pragma unroll
                for (int ai = 0; ai < 2; ++ai)
#pragma unroll
                    for (int m = 0; m < 4; ++m) { const size_t r = (size_t)u.pm * BM + ai * HALF + wr * 64 + m * 16 + fr;
#pragma unroll
                        for (int n = 0; n < 2; ++n) { const f32x4 v = acc[ai][0][m][n]; f32x4 o;
#pragma unroll
                            for (int i = 0; i < 4; ++i) o[i] = 1.f / (1.f + __expf(-v[i]));
                            *(f32x4*)(GATE + r * 32 + 8 * fq + 4 * n) = o; } }
            }
            return;
        }
        f32x4 gv[2][2];
#pragma unroll
        for (int bj = 0; bj < 2; ++bj)
#pragma unroll
            for (int n = 0; n < 2; ++n) gv[bj][n] = gain ? *(const f32x4*)(gain + 32 * bj + 8 * fq + 4 * n) * sc : (f32x4){1.f, 1.f, 1.f, 1.f};
#pragma unroll
        for (int ai = 0; ai < 2; ++ai)
#pragma unroll
            for (int m = 0; m < 4; ++m) { const size_t r = (size_t)u.pm * BM + ai * HALF + wr * 64 + m * 16 + fr;
                float rs = 1.f;
                if (gain) { float ss = 0.f;
#pragma unroll
                    for (int bj = 0; bj < 2; ++bj)
#pragma unroll
                        for (int n = 0; n < 2; ++n) { const f32x4 v = acc[ai][bj][m][n]; ss += (v[0] * v[0] + v[1] * v[1]) + (v[2] * v[2] + v[3] * v[3]); }
                    ss += __shfl_xor(ss, 16); ss += __shfl_xor(ss, 32);
                    rs = rsqrtf(ss * (1.f / 64.f) + EPS); }
#pragma unroll
                for (int bj = 0; bj < 2; ++bj) { const f32x4 a = acc[ai][bj][m][0] * gv[bj][0] * rs, b = acc[ai][bj][m][1] * gv[bj][1] * rs;
                    u32x4 w; w.x = cvt_pk_bf16(a[0], a[1]); w.y = cvt_pk_bf16(a[2], a[3]); w.z = cvt_pk_bf16(b[0], b[1]); w.w = cvt_pk_bf16(b[2], b[3]);
                    *(u32x4*)(ZB + r * ZBW + pn * BM + 64 * wc + 32 * bj + 8 * fq) = w; } }
    }
};
struct EpiG2 {
    const float* xin; float* XA; const float* g1;
    __device__ __forceinline__ void operator()(const f32x4 (&acc)[2][2][4][2], const Unit& u, int wr, int wc, int fr, int fq) const {
#pragma unroll
        for (int ai = 0; ai < 2; ++ai)
#pragma unroll
            for (int m = 0; m < 4; ++m) { const size_t r = (size_t)u.pm * BM + ai * HALF + wr * 64 + m * 16 + fr; const int b = (int)(r / S);
#pragma unroll
                for (int bj = 0; bj < 2; ++bj)
#pragma unroll
                    for (int n = 0; n < 2; ++n) { const int c = u.pn * BM + 128 * bj + 32 * wc + 8 * fq + 4 * n;
                        const f32x4 x = *(const f32x4*)(xin + r * D + c), g = *(const f32x4*)(g1 + (size_t)b * 6144 + c);
                        *(f32x4*)(XA + r * D + c) = x + g * acc[ai][bj][m][n]; } }
    }
};
struct EpiM1 {
    bf16_t* ACT; const float* b1l;
    __device__ __forceinline__ void operator()(const f32x4 (&acc)[2][2][4][2], const Unit& u, int wr, int wc, int fr, int fq) const {
        const float* b1 = b1l + (size_t)u.e * 2048;
        const int c0 = u.pn * 128 + 32 * wc + 8 * fq;
        f32x4 bg[2], bl[2];
#pragma unroll
        for (int n = 0; n < 2; ++n) { bg[n] = *(const f32x4*)(b1 + c0 + 4 * n); bl[n] = *(const f32x4*)(b1 + 1024 + c0 + 4 * n); }
#pragma unroll
        for (int ai = 0; ai < 2; ++ai)
#pragma unroll
            for (int m = 0; m < 4; ++m) { const size_t r = (size_t)u.pm * BM + ai * HALF + wr * 64 + m * 16 + fr;
                float o[8];
#pragma unroll
                for (int n = 0; n < 2; ++n) { const f32x4 g = acc[ai][0][m][n] + bg[n], li = acc[ai][1][m][n] + bl[n];
#pragma unroll
                    for (int i = 0; i < 4; ++i) { const float gc = fminf(g[i], 7.f), lc = fminf(fmaxf(li[i], -7.f), 7.f); o[4 * n + i] = (lc + 1.f) * gc * (1.f / (1.f + __expf(-1.702f * gc))); } }
                u32x4 w; w.x = cvt_pk_bf16(o[0], o[1]); w.y = cvt_pk_bf16(o[2], o[3]); w.z = cvt_pk_bf16(o[4], o[5]); w.w = cvt_pk_bf16(o[6], o[7]);
                *(u32x4*)(ACT + r * DFF + c0) = w; }
    }
};
struct EpiM2 {
    bf16_t* Y; const float* b2l; const float* roww;
    __device__ __forceinline__ void operator()(const f32x4 (&acc)[2][2][4][2], const Unit& u, int wr, int wc, int fr, int fq) const {
        const float* b2 = b2l + (size_t)u.e * D;
#pragma unroll
        for (int ai = 0; ai < 2; ++ai)
#pragma unroll
            for (int m = 0; m < 4; ++m) { const size_t r = (size_t)u.pm * BM + ai * HALF + wr * 64 + m * 16 + fr; const float w = roww[r];
#pragma unroll
                for (int bj = 0; bj < 2; ++bj) { const int c = u.pn * BM + 128 * bj + 32 * wc + 8 * fq;
                    const f32x4 v0 = (acc[ai][bj][m][0] + *(const f32x4*)(b2 + c)) * w, v1 = (acc[ai][bj][m][1] + *(const f32x4*)(b2 + c + 4)) * w;
                    u32x4 o; o.x = cvt_pk_bf16(v0[0], v0[1]); o.y = cvt_pk_bf16(v0[2], v0[3]); o.z = cvt_pk_bf16(v1[0], v1[1]); o.w = cvt_pk_bf16(v1[2], v1[3]);
                    *(u32x4*)(Y + r * D + c) = o; } }
    }
};
}

__device__ __forceinline__ void phase_g1_fast(const Params& p, int l, unsigned char* lds_raw) {
    pg8::ProbDense P{(const bf16_t*)(p.ws + WS_XN), (const bf16_t*)(p.ws + WS_WINT) + (size_t)l * ZBW * D, D, T / 256, ZBW / 256, (int)gridDim.x, (int)blockIdx.x, true};
    pg8::EpiG1F E{(bf16_t*)(p.ws + WS_ZB), (float*)(p.ws + WS_GATE), p.in[7] + l * 64, p.in[8] + l * 64, p.in[12] + l * 64, p.in[13] + l * 64};
    pg8::gemm_phase<pg8::ProbDense, pg8::EpiG1F, true, true>((PG8_LAS unsigned char*)lds_raw, P, E);
}
__device__ __forceinline__ void phase_g2_fast(const Params& p, int l, unsigned char* lds_raw) {
    pg8::ProbDense P{(const bf16_t*)(p.ws + WS_ATTB), (const bf16_t*)(p.ws + WS_WOT) + (size_t)l * D * D, D, T / 256, D / 256, (int)gridDim.x, (int)blockIdx.x, false};
    pg8::EpiG2 E{l == 0 ? p.in[0] : p.out, p.out, (const float*)(p.ws + WS_MOD) + (size_t)l * Bn * 6144 + 2 * D};
    pg8::gemm_phase<pg8::ProbDense, pg8::EpiG2, true, true>((PG8_LAS unsigned char*)lds_raw, P, E);
}
constexpr int LDS_PS_OFF = 131072;
__device__ __forceinline__ void phase_ck_fast(const Params& p, int l, unsigned char* lds_raw) {
    pg8::ProbCmp P{(const bf16_t*)(p.ws + WS_ZB), (const bf16_t*)(p.ws + WS_WCT) + (size_t)l * 2 * 128 * 2048, 2048, (int)gridDim.x, (int)blockIdx.x};
    pg8::EpiCmp E{(float*)(p.ws + WS_HID), (const float*)(p.ws + WS_CB) + l * 2 * 128};
    pg8::gemm_phase<pg8::ProbCmp, pg8::EpiCmp, true, true>((PG8_LAS unsigned char*)lds_raw, P, E);
    const int lane = otid() & 63, wave = otid() >> 6;
    const bf16_t* Z = (const bf16_t*)(p.ws + WS_ZB); bf16_t* KMB = (bf16_t*)(p.ws + WS_KMB);
    for (int it = blockIdx.x * NW + wave; it < Bn * 8 * 32; it += gridDim.x * NW) {
        const int b = it / 256, h = (it / 32) & 7, blk = it & 31;
        const bf16_t* base = Z + (size_t)(b * S + blk * 256) * ZBW + ZB_MK + h * 64 + lane;
        float s0 = 0.f, s1 = 0.f, s2 = 0.f, s3 = 0.f;
        for (int i = 0; i < 256; i += 4) { s0 += bf2f(base[(size_t)i * ZBW]); s1 += bf2f(base[(size_t)(i + 1) * ZBW]); s2 += bf2f(base[(size_t)(i + 2) * ZBW]); s3 += bf2f(base[(size_t)(i + 3) * ZBW]); }
        KMB[(size_t)it * 64 + lane] = (bf16_t)f2bf(((s0 + s1) + (s2 + s3)) * (1.f / 256.f));
    }
}
__device__ __forceinline__ void phase_m1_fast(const Params& p, int l, unsigned char* lds_raw) {
    int* ps = (int*)(lds_raw + LDS_PS_OFF);
    load_pstart(p, l, ps);
    pg8::ProbMoe1 P{(const bf16_t*)(p.ws + WS_XN), (const bf16_t*)(p.ws + WS_W1T) + (size_t)l * NE * 2048 * D, (const int*)(p.ws + WS_ROWTOK) + (size_t)l * RMAX, (pg8::lds_ints)ps, D, ps[32] / 256, (int)gridDim.x, (int)blockIdx.x};
    pg8::EpiM1 E{(bf16_t*)(p.ws + WS_ACT), p.in[18] + (size_t)l * NE * 2048};
    pg8::gemm_phase<pg8::ProbMoe1, pg8::EpiM1, true, true>((PG8_LAS unsigned char*)lds_raw, P, E);
    __syncthreads();
}
__device__ __forceinline__ void phase_m2_fast(const Params& p, int l, unsigned char* lds_raw) {
    int* ps = (int*)(lds_raw + LDS_PS_OFF);
    load_pstart(p, l, ps);
    pg8::ProbMoe2 P{(const bf16_t*)(p.ws + WS_ACT), (const bf16_t*)(p.ws + WS_W2T) + (size_t)l * NE * D * DFF, (pg8::lds_ints)ps, DFF, ps[32] / 256, (int)gridDim.x, (int)blockIdx.x};
    pg8::EpiM2 E{(bf16_t*)(p.ws + WS_Y), p.in[20] + (size_t)l * NE * D, (const float*)(p.ws + WS_ROWW) + (size_t)l * RMAX};
    pg8::gemm_phase<pg8::ProbMoe2, pg8::EpiM2, true, true>((PG8_LAS unsigned char*)lds_raw, P, E);
    __syncthreads();
}

namespace at {
#define AT_LAS __attribute__((address_space(3)))
typedef short bf16x8 __attribute__((ext_vector_type(8)));
typedef short s16x4 __attribute__((ext_vector_type(4)));
typedef short v4i16_t __attribute__((ext_vector_type(4)));
typedef float f32x16 __attribute__((ext_vector_type(16)));
typedef unsigned u32x4 __attribute__((ext_vector_type(4)));
typedef float f32x2_t __attribute__((ext_vector_type(2))); typedef __bf16 bf16x2_t __attribute__((ext_vector_type(2)));
typedef AT_LAS unsigned char* lp;
constexpr int L_K = 0, L_V = 16384, L_WSF = 32768, L_OST = 34816  , L_IMP = 100352, L_SELM = 133376, L_UNI = 134400, L_KMT = 134656, L_END = 142848;
constexpr float NEGS = -1e30f;
__device__ __forceinline__ int crow(int r, int hi) { return (r & 3) + 8 * (r >> 2) + 4 * hi; }
__device__ __forceinline__ unsigned cvtpk(float lo, float hi) { f32x2_t v = {lo, hi}; bf16x2_t b = __builtin_convertvector(v, bf16x2_t); return __builtin_bit_cast(unsigned, b); }
__device__ __forceinline__ float mx3(float a, float b, float c) { return __builtin_fmaxf(__builtin_fmaxf(a, b), c); }
__device__ __forceinline__ void wsync() { asm volatile("s_waitcnt lgkmcnt(0)" ::: "memory"); __builtin_amdgcn_wave_barrier(); }
__device__ __forceinline__ void bar() { __builtin_amdgcn_s_barrier(); }
#define AT_WAITV(n) asm volatile("s_waitcnt vmcnt(" #n ")" ::: "memory")
#define AT_WAITL() asm volatile("s_waitcnt lgkmcnt(0)" ::: "memory")
__device__ __forceinline__ void glds(const void* g, lp dst) { __builtin_amdgcn_global_load_lds((const unsigned*)g, (AT_LAS unsigned*)dst, 16, 0, 0); }
__device__ __forceinline__ s16x4 vtr(const AT_LAS unsigned char* p) { return __builtin_bit_cast(s16x4, __builtin_amdgcn_ds_read_tr16_b64_v4i16((AT_LAS v4i16_t*)p)); }

__device__ __forceinline__ void dma_k(lp slot, const bf16_t* kbase, int pitch, int key0, int wid, int lane) { glds(kbase + (size_t)(key0 + lane) * pitch + wid * 8, slot + wid * 1024); }
__device__ __forceinline__ void dma_v(lp slot, const bf16_t* vbase, int pitch, int key0, int wid, int lane) {
    glds(vbase + (size_t)(key0 + 16 * (wid & 3) + (lane >> 2)) * pitch + (wid >> 2) * 32 + (lane & 3) * 8, slot + wid * 1024); }

__device__ __forceinline__ void qk_tile(f32x16& p0, f32x16& p1, lp kslot, const bf16x8 (&qr)[4], int r32, int hi) {
    const AT_LAS unsigned char* kb = kslot + hi * 1024 + r32 * 16;
#pragma unroll
    for (int d0 = 0; d0 < 4; ++d0) {
        const bf16x8 b0 = *(const AT_LAS bf16x8*)(kb + d0 * 2048), b1 = *(const AT_LAS bf16x8*)(kb + d0 * 2048 + 512);
        p0 = __builtin_amdgcn_mfma_f32_32x32x16_bf16(b0, qr[d0], p0, 0, 0, 0);
        p1 = __builtin_amdgcn_mfma_f32_32x32x16_bf16(b1, qr[d0], p1, 0, 0, 0);
    }
}
__device__ __forceinline__ void pv_tile(f32x16 (&o)[2], lp vslot, int lane, int hi, u32x4 pw0, u32x4 pw1, u32x4 pw2, u32x4 pw3) {
    const AT_LAS unsigned char* vp = vslot + ((lane >> 4) & 1) * 32 + (lane & 3) * 8 + (4 * hi + ((lane & 15) >> 2)) * 64;
    const bf16x8 pa[4] = {__builtin_bit_cast(bf16x8, pw0), __builtin_bit_cast(bf16x8, pw1), __builtin_bit_cast(bf16x8, pw2), __builtin_bit_cast(bf16x8, pw3)};
#pragma unroll
    for (int d0 = 0; d0 < 2; ++d0)
#pragma unroll
        for (int ks = 0; ks < 4; ++ks) {
            const s16x4 lo = vtr(vp + d0 * 4096 + ks * 1024), hh = vtr(vp + d0 * 4096 + ks * 1024 + 512);
            const bf16x8 vf = (bf16x8){lo[0], lo[1], lo[2], lo[3], hh[0], hh[1], hh[2], hh[3]};
            o[d0] = __builtin_amdgcn_mfma_f32_32x32x16_bf16(pa[ks], vf, o[d0], 0, 0, 0);
        }
}
__device__ __forceinline__ float rowmax(const f32x16& p0, const f32x16& p1) {
    float a = mx3(p0[0], p0[1], p1[0]), b = mx3(p0[2], p0[3], p1[1]); a = mx3(a, p1[2], p1[3]);
#pragma unroll
    for (int r = 4; r < 16; r += 4) { a = mx3(a, p0[r], p0[r + 1]); b = mx3(b, p0[r + 2], p0[r + 3]); a = mx3(a, p1[r], p1[r + 1]); b = mx3(b, p1[r + 2], p1[r + 3]); }
    const float m = __builtin_fmaxf(a, b);
    auto rr = __builtin_amdgcn_permlane32_swap(__float_as_uint(m), __float_as_uint(m), false, false);
    return __builtin_fmaxf(__uint_as_float(rr[0]), __uint_as_float(rr[1]));
}
__device__ __forceinline__ float halfsum(float v) {
    auto rr = __builtin_amdgcn_permlane32_swap(__float_as_uint(v), __float_as_uint(v), false, false);
    return __uint_as_float(rr[0]) + __uint_as_float(rr[1]);
}
__device__ __forceinline__ void mask_tile(f32x16& p0, f32x16& p1, int lo, int hi_, int hi) {
    const int kb = 4 * hi;
#pragma unroll
    for (int r = 0; r < 16; ++r) { const int kv = kb + (r & 3) + 8 * (r >> 2); if (kv > hi_ || kv < lo) p0[r] = NEGS; if (kv + 32 > hi_ || kv + 32 < lo) p1[r] = NEGS; }
}

__device__ __forceinline__ int next_bit128(unsigned u0, unsigned u1, unsigned u2, unsigned u3, int below) {
    if (below > 96) { unsigned x = u3; if (below < 128) x &= (1u << (below - 96)) - 1u; if (x) return 96 + 31 - __builtin_clz(x); }
    if (below > 64) { unsigned x = u2; if (below < 96) x &= (1u << (below - 64)) - 1u; if (x) return 64 + 31 - __builtin_clz(x); }
    if (below > 32) { unsigned x = u1; if (below < 64) x &= (1u << (below - 32)) - 1u; if (x) return 32 + 31 - __builtin_clz(x); }
    if (below > 0) { unsigned x = u0; if (below < 32) x &= (1u << below) - 1u; if (x) return 31 - __builtin_clz(x); }
    return -1;
}
struct Soft { float m, l; };

template <bool HAS_O>
__device__ __forceinline__ void softmax_step(f32x16& p0, f32x16& p1, Soft& st, f32x16 (&o)[2], float* wsf, int r32, int hi) {
    const float rm = rowmax(p0, p1);
    if (__any(rm > 0.f)) {
        const float dl = __builtin_fmaxf(rm, 0.f); st.m += dl;
#pragma unroll
        for (int r = 0; r < 16; ++r) { p0[r] -= dl; p1[r] -= dl; }
        const float al = __builtin_amdgcn_exp2f(-dl); st.l *= al;
        if (HAS_O) {
            if (hi == 0) wsf[r32] = al;
            wsync();
#pragma unroll
            for (int r = 0; r < 16; ++r) { const float f = wsf[crow(r, hi)]; o[0][r] *= f; o[1][r] *= f; }
            wsync();
        }
    }
    float s = 0.f;
#pragma unroll
    for (int r = 0; r < 16; ++r) { p0[r] = __builtin_amdgcn_exp2f(p0[r]); p1[r] = __builtin_amdgcn_exp2f(p1[r]); s += p0[r] + p1[r]; }
    st.l += s;
}
#define AT_PACK(P0, P1) \
    const u32x4 pw0 = {cvtpk(P0[0], P0[1]), cvtpk(P0[2], P0[3]), cvtpk(P0[4], P0[5]), cvtpk(P0[6], P0[7])}, pw1 = {cvtpk(P0[8], P0[9]), cvtpk(P0[10], P0[11]), cvtpk(P0[12], P0[13]), cvtpk(P0[14], P0[15])}, \
                pw2 = {cvtpk(P1[0], P1[1]), cvtpk(P1[2], P1[3]), cvtpk(P1[4], P1[5]), cvtpk(P1[6], P1[7])}, pw3 = {cvtpk(P1[8], P1[9]), cvtpk(P1[10], P1[11]), cvtpk(P1[12], P1[13]), cvtpk(P1[14], P1[15])}
__device__ __forceinline__ f32x16 cinit(float c2k, int hi, float x) { f32x16 c; const float xb = __builtin_fmaf(c2k, (float)(4 * hi), x);
#pragma unroll
    for (int r = 0; r < 16; ++r) c[r] = __builtin_fmaf(c2k, (float)((r & 3) + 8 * (r >> 2)), xb);
    return c; }
template <bool FIRST>
__device__ __forceinline__ void acc_scaled(float* stage, const f32x16 (&o)[2], float f, float* wsf, int r32, int hi) {
    if (hi == 0) wsf[r32] = f;
    wsync();
#pragma unroll
    for (int r = 0; r < 16; ++r) { const int orow = crow(r, hi); const float g = wsf[orow]; float* s0 = stage + orow * 64 + r32;
        if (FIRST) { s0[0] = o[0][r] * g; s0[32] = o[1][r] * g; } else { s0[0] += o[0][r] * g; s0[32] += o[1][r] * g; } }
    wsync();
}

__device__ __forceinline__ void nsa_unit(const Params& p, int b, int g, int c, unsigned char* lds_raw) {
    const int tid = otid(), lane = tid & 63, r32 = lane & 31, hi = lane >> 5, wid = __builtin_amdgcn_readfirstlane(tid >> 6);
    lp lds = (lp)lds_raw;
    const bf16_t* ZB = (const bf16_t*)(p.ws + WS_ZB); const float* GT = (const float*)(p.ws + WS_GATE);
    const bf16_t* KCB = (const bf16_t*)(p.ws + WS_KCB) + (size_t)(b * 2 + g) * 512 * 64; const bf16_t* VCB = (const bf16_t*)(p.ws + WS_VCB) + (size_t)(b * 2 + g) * 512 * 64;
    const int t0 = c * 64, hg = r32 >> 3, qq = r32 & 7, qi = 8 * wid + qq, t = t0 + qi, h = 4 * g + hg; const size_t tt = (size_t)b * S + t;
    float* wsf = (float*)(lds_raw + L_WSF) + wid * 64;
    float* imp = (float*)(lds_raw + L_IMP);
    unsigned* selm = (unsigned*)(lds_raw + L_SELM);
    unsigned* uni = (unsigned*)(lds_raw + L_UNI);
    const float c2 = exp2f(-(float)(h + 1)) * LOG2E;
    bf16x8 qr[4];
#pragma unroll
    for (int d0 = 0; d0 < 4; ++d0) qr[d0] = *(const bf16x8*)(ZB + tt * ZBW + ZB_Q + h * 64 + d0 * 16 + hi * 8);
    const float gt0 = GT[tt * 32 + h * 3 + 0], gt1 = GT[tt * 32 + h * 3 + 1], gt2 = GT[tt * 32 + h * 3 + 2];
    float* ostage = (float*)(lds_raw + L_OST) + wid * 2048;
    f32x16 o[2];
    const lp sK0 = lds + L_K, sV0 = lds + L_V;
    const int nmax = t >= 31 ? (t - 31) >> 4 : -1;
    const int ntc = ((4 * c + 2) >> 6) + 1;
    for (int i = lane; i < 8 * 129; i += 64) imp[(8 * wid) * 129 + i] = 0.f;
    Soft sc; sc.m = 0.f; sc.l = 0.f;
    dma_k(sK0, KCB, 64, 0, wid, lane);
    for (int k = 0; k < ntc; ++k) {
        const lp sK = sK0 + (k & 1) * 8192;
        if (k + 1 < ntc) { dma_k(sK0 + ((k + 1) & 1) * 8192, KCB, 64, 64 * (k + 1), wid, lane); AT_WAITV(1); } else { AT_WAITV(0); }
        bar();
        const float x0 = c2 * (16.f * (64 * k) + 15.5f - (float)t0) - sc.m;
        f32x16 p0 = cinit(16.f * c2, hi, x0), p1 = cinit(16.f * c2, hi, x0 + c2 * 512.f);
        qk_tile(p0, p1, sK, qr, r32, hi);
        mask_tile(p0, p1, 0, nmax - 64 * k, hi);
        softmax_step<false>(p0, p1, sc, o, wsf, r32, hi);
        AT_WAITL(); bar();
    }
    const float lc = halfsum(sc.l), linv = lc > 0.f ? 1.f / lc : 0.f;
    o[0] = f32x16{}; o[1] = f32x16{};
    dma_k(sK0, KCB, 64, 0, wid, lane); dma_v(sV0, VCB, 64, 0, wid, lane);
    for (int k = 0; k < ntc; ++k) {
        const lp sK = sK0 + (k & 1) * 8192, sV = sV0 + (k & 1) * 8192;
        if (k + 1 < ntc) { dma_k(sK0 + ((k + 1) & 1) * 8192, KCB, 64, 64 * (k + 1), wid, lane); dma_v(sV0 + ((k + 1) & 1) * 8192, VCB, 64, 64 * (k + 1), wid, lane); AT_WAITV(2); } else { AT_WAITV(0); }
        bar();
        const float x0 = c2 * (16.f * (64 * k) + 15.5f - (float)t0) - sc.m;
        f32x16 p0 = cinit(16.f * c2, hi, x0), p1 = cinit(16.f * c2, hi, x0 + c2 * 512.f);
        qk_tile(p0, p1, sK, qr, r32, hi);
        mask_tile(p0, p1, 0, nmax - 64 * k, hi);
#pragma unroll
        for (int r = 0; r < 16; ++r) { p0[r] = __builtin_amdgcn_exp2f(p0[r]); p1[r] = __builtin_amdgcn_exp2f(p1[r]); }
        { AT_PACK(p0, p1); pv_tile(o, sV, lane, hi, pw0, pw1, pw2, pw3); }
        float gs[8], ls[8];
#pragma unroll
        for (int q4 = 0; q4 < 4; ++q4) { gs[q4] = ((p0[4 * q4] + p0[4 * q4 + 1]) + (p0[4 * q4 + 2] + p0[4 * q4 + 3])) * linv; ls[q4] = p0[4 * q4 + 3] * linv;
                                         gs[4 + q4] = ((p1[4 * q4] + p1[4 * q4 + 1]) + (p1[4 * q4 + 2] + p1[4 * q4 + 3])) * linv; ls[4 + q4] = p1[4 * q4 + 3] * linv; }
#pragma unroll
        for (int q4 = 0; q4 < 8; ++q4) { gs[q4] += __shfl_xor(gs[q4], 8); gs[q4] += __shfl_xor(gs[q4], 16); ls[q4] += __shfl_xor(ls[q4], 8); ls[q4] += __shfl_xor(ls[q4], 16); }
        if (r32 < 8) {
            float* row = imp + (size_t)(8 * wid + qq) * 129 + 16 * k + hi;
#pragma unroll
            for (int q4 = 0; q4 < 8; ++q4) row[2 * q4] += gs[q4];
        }
        wsync();
        if (r32 < 8) {
            float* row = imp + (size_t)(8 * wid + qq) * 129 + 16 * k + hi + 1;
#pragma unroll
            for (int q4 = 0; q4 < 8; ++q4) row[2 * q4] += ls[q4];
        }
        AT_WAITL(); bar();
    }
    acc_scaled<true>(ostage, o, gt0 * linv, wsf, r32, hi);
    unsigned mk0 = 0u, mk1 = 0u, mk2 = 0u, mk3 = 0u;
    {
        const int qs = lane >> 3, part = lane & 7;
        float v[16];
#pragma unroll
        for (int i = 0; i < 16; ++i) { const int j = part * 16 + i; float x = imp[(size_t)(8 * wid + qs) * 129 + j]; if (j == 0 || j == c || j == c - 1) x = 1e4f; if (j > c) x = NEGS; v[i] = x; }
#pragma unroll 1
        for (int it = 0; it < 16; ++it) {
            float bv = -3e38f; int bi = 0;
#pragma unroll
            for (int i = 0; i < 16; ++i) if (v[i] > bv) { bv = v[i]; bi = part * 16 + i; }
#pragma unroll
            for (int sft = 1; sft < 8; sft <<= 1) { const float ov = __shfl_xor(bv, sft); const int oi = __shfl_xor(bi, sft); if (ov > bv || (ov == bv && oi < bi)) { bv = ov; bi = oi; } }
            if (bv > NEGS) { const unsigned bit = 1u << (bi & 31); const int wq = bi >> 5; if (wq == 0) mk0 |= bit; else if (wq == 1) mk1 |= bit; else if (wq == 2) mk2 |= bit; else mk3 |= bit; }
#pragma unroll
            for (int i = 0; i < 16; ++i) if (part * 16 + i == bi) v[i] = -3.4e38f;
        }
        if (part == 0) { unsigned* sm = selm + (8 * wid + qs) * 4; sm[0] = mk0; sm[1] = mk1; sm[2] = mk2; sm[3] = mk3; }
        unsigned u0 = mk0, u1 = mk1, u2 = mk2, u3 = mk3;
#pragma unroll
        for (int sft = 8; sft < 64; sft <<= 1) { u0 |= __shfl_xor(u0, sft); u1 |= __shfl_xor(u1, sft); u2 |= __shfl_xor(u2, sft); u3 |= __shfl_xor(u3, sft); }
        if (lane == 0) { uni[wid * 4 + 0] = u0; uni[wid * 4 + 1] = u1; uni[wid * 4 + 2] = u2; uni[wid * 4 + 3] = u3; }
    }
    AT_WAITL(); bar();
    unsigned un0 = 0u, un1 = 0u, un2 = 0u, un3 = 0u;
#pragma unroll
    for (int w = 0; w < 8; ++w) { un0 |= uni[w * 4 + 0]; un1 |= uni[w * 4 + 1]; un2 |= uni[w * 4 + 2]; un3 |= uni[w * 4 + 3]; }
    un0 = __builtin_amdgcn_readfirstlane(un0); un1 = __builtin_amdgcn_readfirstlane(un1); un2 = __builtin_amdgcn_readfirstlane(un2); un3 = __builtin_amdgcn_readfirstlane(un3);
    const unsigned my0 = selm[(8 * wid + qq) * 4 + 0], my1 = selm[(8 * wid + qq) * 4 + 1], my2 = selm[(8 * wid + qq) * 4 + 2], my3 = selm[(8 * wid + qq) * 4 + 3];
    {
        const bf16_t* KS = ZB + (size_t)b * S * ZBW + ZB_KS + g * 64; const bf16_t* VS = ZB + (size_t)b * S * ZBW + ZB_VS + g * 64;
        Soft ss; ss.m = 0.f; ss.l = 0.f; o[0] = f32x16{}; o[1] = f32x16{};
        int j = next_bit128(un0, un1, un2, un3, 128), slot = 0;
        if (j >= 0) { dma_k(sK0, KS, ZBW, 64 * j, wid, lane); dma_v(sV0, VS, ZBW, 64 * j, wid, lane); }
        while (j >= 0) {
            const int jn = next_bit128(un0, un1, un2, un3, j);
            const lp sK = sK0 + slot * 8192, sV = sV0 + slot * 8192;
            if (jn >= 0) { dma_k(sK0 + (slot ^ 1) * 8192, KS, ZBW, 64 * jn, wid, lane); dma_v(sV0 + (slot ^ 1) * 8192, VS, ZBW, 64 * jn, wid, lane); AT_WAITV(2); } else { AT_WAITV(0); }
            bar();
            const unsigned mw = (j >> 5) == 0 ? my0 : (j >> 5) == 1 ? my1 : (j >> 5) == 2 ? my2 : my3;
            const bool sel = (mw >> (j & 31)) & 1u;
            const float x0 = sel ? c2 * (float)(64 * j - t0) - ss.m : NEGS;
            f32x16 p0 = cinit(c2, hi, x0), p1 = cinit(c2, hi, sel ? x0 + c2 * 32.f : NEGS);
            qk_tile(p0, p1, sK, qr, r32, hi);
            if (j == c) mask_tile(p0, p1, 0, qi, hi);
            softmax_step<true>(p0, p1, ss, o, wsf, r32, hi);
            { AT_PACK(p0, p1); pv_tile(o, sV, lane, hi, pw0, pw1, pw2, pw3); }
            AT_WAITL(); bar();
            j = jn; slot ^= 1;
        }
        const float ls_ = halfsum(ss.l);
        acc_scaled<false>(ostage, o, ls_ > 0.f ? gt1 / ls_ : 0.f, wsf, r32, hi);
    }
    {
        const bf16_t* KW = ZB + (size_t)b * S * ZBW + ZB_KW + g * 64; const bf16_t* VW = ZB + (size_t)b * S * ZBW + ZB_VW + g * 64;
        Soft sw; sw.m = 0.f; sw.l = 0.f; o[0] = f32x16{}; o[1] = f32x16{};
        const int k0 = c >= 8 ? 0 : 8 - c;
        dma_k(sK0, KW, ZBW, t0 - 512 + 64 * k0, wid, lane); dma_v(sV0, VW, ZBW, t0 - 512 + 64 * k0, wid, lane);
        int slot = 0;
        for (int k = k0; k < 9; ++k) {
            const lp sK = sK0 + slot * 8192, sV = sV0 + slot * 8192;
            if (k + 1 < 9) { dma_k(sK0 + (slot ^ 1) * 8192, KW, ZBW, t0 - 512 + 64 * (k + 1), wid, lane); dma_v(sV0 + (slot ^ 1) * 8192, VW, ZBW, t0 - 512 + 64 * (k + 1), wid, lane); AT_WAITV(2); } else { AT_WAITV(0); }
            bar();
            const float x0 = c2 * (float)(64 * k - 512) - sw.m;
            f32x16 p0 = cinit(c2, hi, x0), p1 = cinit(c2, hi, x0 + c2 * 32.f);
            qk_tile(p0, p1, sK, qr, r32, hi);
            if (k == 0) mask_tile(p0, p1, qi + 1, 63, hi);
            if (k == 8) mask_tile(p0, p1, 0, qi, hi);
            softmax_step<true>(p0, p1, sw, o, wsf, r32, hi);
            { AT_PACK(p0, p1); pv_tile(o, sV, lane, hi, pw0, pw1, pw2, pw3); }
            AT_WAITL(); bar();
            slot ^= 1;
        }
        const float lw = halfsum(sw.l);
        acc_scaled<false>(ostage, o, lw > 0.f ? gt2 / lw : 0.f, wsf, r32, hi);
    }
    {
        bf16_t* AB = (bf16_t*)(p.ws + WS_ATTB);
#pragma unroll
        for (int i = 0; i < 4; ++i) { const int row = i * 8 + (lane >> 3), ch = lane & 7; const float4 a = *(const float4*)(ostage + row * 64 + ch * 8), c4 = *(const float4*)(ostage + row * 64 + ch * 8 + 4);
            const uint4 v = make_uint4(pk2(a.x, a.y), pk2(a.z, a.w), pk2(c4.x, c4.y), pk2(c4.z, c4.w));
            *(uint4*)(AB + ((size_t)b * S + t0 + 8 * wid + (row & 7)) * D + (4 * g + (row >> 3)) * 64 + ch * 8) = v; }
        wsync();
    }
    AT_WAITL(); bar();
}

__device__ __forceinline__ void moba_unit(const Params& p, int b, int h, int blk, unsigned char* lds_raw) {
    const int tid = otid(), lane = tid & 63, r32 = lane & 31, hi = lane >> 5, wid = __builtin_amdgcn_readfirstlane(tid >> 6);
    lp lds = (lp)lds_raw;
    const bf16_t* ZB = (const bf16_t*)(p.ws + WS_ZB);
    const bf16_t* KMB = (const bf16_t*)(p.ws + WS_KMB) + (size_t)(b * 8 + h) * 32 * 64;
    const int qi = 32 * wid + r32, t = blk * 256 + qi; const size_t tt = (size_t)b * S + t;
    float* wsf = (float*)(lds_raw + L_WSF) + wid * 64;
    unsigned* uni = (unsigned*)(lds_raw + L_UNI);
    const float c2 = exp2f(-(float)(h + 1)) * LOG2E;
    bf16x8 qr[4];
#pragma unroll
    for (int d0 = 0; d0 < 4; ++d0) qr[d0] = *(const bf16x8*)(ZB + tt * ZBW + ZB_MQ + h * 64 + d0 * 16 + hi * 8);
    const lp sK0 = lds + L_K, sV0 = lds + L_V;
    unsigned mymask = 0u;
    {
        const lp sKM = lds + L_KMT;
        glds(KMB + (size_t)(lane & 31) * 64 + wid * 8, sKM + wid * 1024);
        AT_WAITV(0); bar();
        f32x16 g0 = f32x16{}, g1 = f32x16{};
        qk_tile(g0, g1, sKM, qr, r32, hi);
        float v1 = NEGS, v2 = NEGS, v3 = NEGS; int i1 = 64, i2 = 64, i3 = 64;
#pragma unroll
        for (int r = 0; r < 16; ++r) { const int n = crow(r, hi); const float s_ = n < blk ? g0[r] : NEGS;
            if (s_ > v1) { v3 = v2; i3 = i2; v2 = v1; i2 = i1; v1 = s_; i1 = n; } else if (s_ > v2) { v3 = v2; i3 = i2; v2 = s_; i2 = n; } else if (s_ > v3) { v3 = s_; i3 = n; } }
        float ov[3]; int oi[3];
        { auto a = __builtin_amdgcn_permlane32_swap(__float_as_uint(v1), __float_as_uint(v1), false, false); ov[0] = __uint_as_float(hi ? a[0] : a[1]); }
        { auto a = __builtin_amdgcn_permlane32_swap(__float_as_uint(v2), __float_as_uint(v2), false, false); ov[1] = __uint_as_float(hi ? a[0] : a[1]); }
        { auto a = __builtin_amdgcn_permlane32_swap(__float_as_uint(v3), __float_as_uint(v3), false, false); ov[2] = __uint_as_float(hi ? a[0] : a[1]); }
        { auto a = __builtin_amdgcn_permlane32_swap((unsigned)i1, (unsigned)i1, false, false); oi[0] = (int)(hi ? a[0] : a[1]); }
        { auto a = __builtin_amdgcn_permlane32_swap((unsigned)i2, (unsigned)i2, false, false); oi[1] = (int)(hi ? a[0] : a[1]); }
        { auto a = __builtin_amdgcn_permlane32_swap((unsigned)i3, (unsigned)i3, false, false); oi[2] = (int)(hi ? a[0] : a[1]); }
#pragma unroll
        for (int k = 0; k < 3; ++k) { const float s_ = ov[k]; const int n = oi[k];
            if (s_ > v1 || (s_ == v1 && n < i1)) { v3 = v2; i3 = i2; v2 = v1; i2 = i1; v1 = s_; i1 = n; }
            else if (s_ > v2 || (s_ == v2 && n < i2)) { v3 = v2; i3 = i2; v2 = s_; i2 = n; }
            else if (s_ > v3 || (s_ == v3 && n < i3)) { v3 = s_; i3 = n; } }
        if (v1 > NEGS) mymask |= 1u << i1; if (v2 > NEGS) mymask |= 1u << i2; if (v3 > NEGS) mymask |= 1u << i3;
        unsigned u = mymask;
#pragma unroll
        for (int sft = 1; sft < 64; sft <<= 1) u |= __shfl_xor(u, sft);
        if (lane == 0) uni[wid] = u;
        AT_WAITL(); bar();
    }
    unsigned un = 0u;
#pragma unroll
    for (int w = 0; w < 8; ++w) un |= uni[w];
    un = __builtin_amdgcn_readfirstlane(un);
    const bf16_t* KM_ = ZB + (size_t)b * S * ZBW + ZB_MK + h * 64; const bf16_t* VM_ = ZB + (size_t)b * S * ZBW + ZB_MV + h * 64;
    const int nub = __builtin_popcount(un), ntile = 4 * nub + 4;
    Soft sm; sm.m = 0.f; sm.l = 0.f; f32x16 o[2]; o[0] = f32x16{}; o[1] = f32x16{};
    unsigned rem = un; int curblk = nub > 0 ? __builtin_ctz(rem) : blk;
    unsigned prem = un; int pblk = nub > 0 ? __builtin_ctz(prem) : blk, psub = 0;
    dma_k(sK0, KM_, ZBW, (pblk * 256), wid, lane); dma_v(sV0, VM_, ZBW, (pblk * 256), wid, lane);
    psub = 1;
    int sub = 0, slot = 0;
    for (int i = 0; i < ntile; ++i) {
        const lp sK = sK0 + slot * 8192, sV = sV0 + slot * 8192;
        if (i + 1 < ntile) {
            if (psub == 4) { psub = 0; if (pblk != blk) { prem &= prem - 1; pblk = prem ? __builtin_ctz(prem) : blk; } }
            dma_k(sK0 + (slot ^ 1) * 8192, KM_, ZBW, (pblk * 256 + psub * 64), wid, lane); dma_v(sV0 + (slot ^ 1) * 8192, VM_, ZBW, (pblk * 256 + psub * 64), wid, lane); ++psub;
            AT_WAITV(2);
        } else { AT_WAITV(0); }
        bar();
        const bool own = (i >= 4 * nub);
        const int rel = own ? qi - 64 * sub : 63;
        const bool skip = own && (32 * wid + 31 < 64 * sub);
        if (!skip) {
            const bool sel = own ? true : ((mymask >> curblk) & 1u);
            const float x0 = sel ? c2 * (float)(curblk * 256 + sub * 64 - blk * 256) - sm.m : NEGS;
            f32x16 p0 = cinit(c2, hi, x0), p1 = cinit(c2, hi, sel ? x0 + c2 * 32.f : NEGS);
            qk_tile(p0, p1, sK, qr, r32, hi);
            if (own && (64 * sub + 63 > 32 * wid)) mask_tile(p0, p1, 0, rel, hi);
            softmax_step<true>(p0, p1, sm, o, wsf, r32, hi);
            { AT_PACK(p0, p1); pv_tile(o, sV, lane, hi, pw0, pw1, pw2, pw3); }
        }
        AT_WAITL(); bar();
        slot ^= 1;
        if (++sub == 4) { sub = 0; if (!own) { rem &= rem - 1; curblk = rem ? __builtin_ctz(rem) : blk; } }
    }
    {
        const float lt = halfsum(sm.l); const float f = lt > 0.f ? 1.f / lt : 0.f;
        if (hi == 0) wsf[r32] = f;
        wsync();
        bf16_t* stg = (bf16_t*)(lds_raw + L_OST) + wid * 4096;
#pragma unroll
        for (int r = 0; r < 16; ++r) { const int orow = crow(r, hi); const float g = wsf[orow]; stg[orow * 64 + r32] = (bf16_t)f2bf(o[0][r] * g); stg[orow * 64 + 32 + r32] = (bf16_t)f2bf(o[1][r] * g); }
        wsync();
        bf16_t* AB = (bf16_t*)(p.ws + WS_ATTB);
#pragma unroll
        for (int i = 0; i < 4; ++i) { const int row = i * 8 + (lane >> 3), ch = lane & 7; const uint4 v = *(const uint4*)(stg + row * 64 + ch * 8);
            *(uint4*)(AB + ((size_t)b * S + blk * 256 + 32 * wid + row) * D + 512 + h * 64 + ch * 8) = v; }
        wsync();
    }
    AT_WAITL(); bar();
}
}

__device__ __forceinline__ void phase_att_fast(const Params& p, unsigned char* lds_raw) {
    for (int pi = blockIdx.x; pi < 512; pi += gridDim.x) {
        const int rnd = pi >> 8, id = pi & 255;
        { const int bg = 2 * rnd + (id >> 7), c = rnd ? 127 - (id & 127) : (id & 127); at::nsa_unit(p, bg >> 1, bg & 1, c, lds_raw); }
        { const int bh = 8 * rnd + (id >> 5), blk = rnd ? 31 - (id & 31) : (id & 31); at::moba_unit(p, bh >> 3, bh & 7, blk, lds_raw); }
    }
}


__device__ __forceinline__ void phase_r2_fast(const Params& p, int l, unsigned char* lds_raw) {
    using namespace at;
    const int tid = otid(), lane = tid & 63, wave = __builtin_amdgcn_readfirstlane(tid >> 6), r32 = lane & 31, hi = lane >> 5;
    const float* mod = (const float*)(p.ws + WS_MOD);
    const float* XA = p.out; bf16_t* XN = (bf16_t*)(p.ws + WS_XN); bf16_t* XL = (bf16_t*)(p.ws + WS_XNLO);
    const float* lng = p.in[5] + (size_t)l * D; const float* rw = p.in[15] + (size_t)l * D * NE; const float* rb = p.in[16] + l * NE;
    int* toke = (int*)(p.ws + WS_TOKE); float* tokw = (float*)(p.ws + WS_TOKW); int* BC = (int*)(p.ws + WS_BC);
    lp lds = (lp)lds_raw;
    int* hist = (int*)(lds_raw + 131072);
    for (int idx = tid; idx < 128 * 32; idx += NT) {
        const int kc = idx >> 5, e = idx & 31; float v[8];
#pragma unroll
        for (int j = 0; j < 8; ++j) v[j] = rw[(size_t)(8 * kc + j) * NE + e];
        unsigned hh[8], ll[8];
#pragma unroll
        for (int j = 0; j < 8; ++j) { hh[j] = f2bf(v[j]); ll[j] = f2bf(v[j] - __builtin_bit_cast(float, hh[j] << 16)); }
        *(uint4*)(lds_raw + (size_t)idx * 16) = make_uint4(hh[0] | (hh[1] << 16), hh[2] | (hh[3] << 16), hh[4] | (hh[5] << 16), hh[6] | (hh[7] << 16));
        *(uint4*)(lds_raw + 65536 + (size_t)idx * 16) = make_uint4(ll[0] | (ll[1] << 16), ll[2] | (ll[3] << 16), ll[4] | (ll[5] << 16), ll[6] | (ll[7] << 16));
    }
    for (int blk = blockIdx.x; blk < T / 64; blk += gridDim.x) {
        if (tid < 32) hist[tid] = 0;
        for (int i = 0; i < 8; ++i) {
            const int t = blk * 64 + wave * 8 + i, b = t / S;
            float4 v[4]; float ss = 0.f;
#pragma unroll
            for (int j = 0; j < 4; ++j) { v[j] = *(const float4*)(XA + (size_t)t * D + 4 * lane + 256 * j); ss += (v[j].x * v[j].x + v[j].y * v[j].y) + (v[j].z * v[j].z + v[j].w * v[j].w); }
            ss = wave_sum(ss);
            const float r = rsqrtf(ss * (1.f / D) + EPS);
            const float* sh = mod + ((size_t)l * Bn + b) * 6144 + 3 * D; const float* sc = mod + ((size_t)l * Bn + b) * 6144 + 4 * D;
#pragma unroll
            for (int j = 0; j < 4; ++j) {
                const int col = 4 * lane + 256 * j;
                const float4 g = *(const float4*)(lng + col), s1 = *(const float4*)(sc + col), s0 = *(const float4*)(sh + col);
                const float o[4] = {v[j].x * r * g.x * (1.f + s1.x) + s0.x, v[j].y * r * g.y * (1.f + s1.y) + s0.y, v[j].z * r * g.z * (1.f + s1.z) + s0.z, v[j].w * r * g.w * (1.f + s1.w) + s0.w};
                unsigned hh[4], ll[4];
#pragma unroll
                for (int q = 0; q < 4; ++q) { hh[q] = f2bf(o[q]); ll[q] = f2bf(o[q] - __builtin_bit_cast(float, hh[q] << 16)); }
                *(uint2*)(XN + (size_t)t * D + col) = make_uint2(hh[0] | (hh[1] << 16), hh[2] | (hh[3] << 16));
                *(uint2*)(XL + (size_t)t * D + col) = make_uint2(ll[0] | (ll[1] << 16), ll[2] | (ll[3] << 16));
            }
        }
        asm volatile("s_waitcnt vmcnt(0)" ::: "memory");
        __syncthreads();
        if (wave < 2) {
            const int t = blk * 64 + wave * 32 + r32;
            const bf16_t* xh = XN + (size_t)t * D + 8 * hi; const bf16_t* xl = XL + (size_t)t * D + 8 * hi;
            const AT_LAS unsigned char* wh = lds + (size_t)(hi * 32 + r32) * 16; const AT_LAS unsigned char* wl = wh + 65536;
            f32x16 acc = f32x16{};
#pragma unroll 4
            for (int ks = 0; ks < 64; ++ks) {
                const bf16x8 bh = *(const bf16x8*)(xh + 16 * ks), bl = *(const bf16x8*)(xl + 16 * ks);
                const bf16x8 ah = *(const AT_LAS bf16x8*)(wh + ks * 1024), al = *(const AT_LAS bf16x8*)(wl + ks * 1024);
                acc = __builtin_amdgcn_mfma_f32_32x32x16_bf16(ah, bh, acc, 0, 0, 0);
                acc = __builtin_amdgcn_mfma_f32_32x32x16_bf16(al, bh, acc, 0, 0, 0);
                acc = __builtin_amdgcn_mfma_f32_32x32x16_bf16(ah, bl, acc, 0, 0, 0);
            }
            float a0 = -3e38f, a1 = -3e38f, a2 = -3e38f, a3 = -3e38f; int i0 = 99, i1 = 99, i2 = 99, i3 = 99;
#pragma unroll
            for (int r = 0; r < 16; ++r) { const int e = crow(r, hi); const float s_ = acc[r] + rb[e];
                if (s_ > a0) { a3 = a2; i3 = i2; a2 = a1; i2 = i1; a1 = a0; i1 = i0; a0 = s_; i0 = e; }
                else if (s_ > a1) { a3 = a2; i3 = i2; a2 = a1; i2 = i1; a1 = s_; i1 = e; }
                else if (s_ > a2) { a3 = a2; i3 = i2; a2 = s_; i2 = e; }
                else if (s_ > a3) { a3 = s_; i3 = e; } }
            float ov[4]; int oi[4];
            { const float sv[4] = {a0, a1, a2, a3}; const int si[4] = {i0, i1, i2, i3};
#pragma unroll
              for (int k = 0; k < 4; ++k) { auto a = __builtin_amdgcn_permlane32_swap(__float_as_uint(sv[k]), __float_as_uint(sv[k]), false, false); ov[k] = __uint_as_float(hi ? a[0] : a[1]);
                                            auto c = __builtin_amdgcn_permlane32_swap((unsigned)si[k], (unsigned)si[k], false, false); oi[k] = (int)(hi ? c[0] : c[1]); } }
#pragma unroll
            for (int k = 0; k < 4; ++k) { const float s_ = ov[k]; const int e = oi[k];
                if (s_ > a0 || (s_ == a0 && e < i0)) { a3 = a2; i3 = i2; a2 = a1; i2 = i1; a1 = a0; i1 = i0; a0 = s_; i0 = e; }
                else if (s_ > a1 || (s_ == a1 && e < i1)) { a3 = a2; i3 = i2; a2 = a1; i2 = i1; a1 = s_; i1 = e; }
                else if (s_ > a2 || (s_ == a2 && e < i2)) { a3 = a2; i3 = i2; a2 = s_; i2 = e; }
                else if (s_ > a3 || (s_ == a3 && e < i3)) { a3 = s_; i3 = e; } }
            const float e1 = __expf(a1 - a0), e2 = __expf(a2 - a0), e3 = __expf(a3 - a0), inv = 1.f / (((1.f + e1) + e2) + e3);
            if (hi == 0) {
                *(int4*)(toke + (size_t)t * 4) = make_int4(i0, i1, i2, i3);
                *(float4*)(tokw + (size_t)t * 4) = make_float4(inv, e1 * inv, e2 * inv, e3 * inv);
                atomicAdd(&hist[i0], 1); atomicAdd(&hist[i1], 1); atomicAdd(&hist[i2], 1); atomicAdd(&hist[i3], 1);
            }
        }
        __syncthreads();
        if (tid < 32) BC[blk * 32 + tid] = hist[tid];
        __syncthreads();
    }
}
__device__ __forceinline__ void phase_sc_fast(const Params& p, int l, unsigned char* lds_raw) {
    const int tid = otid();
    const int* BC = (const int*)(p.ws + WS_BC);
    int* cnt = (int*)(p.ws + WS_CNT) + l * 32;
    int* tot = (int*)lds_raw; int* base = tot + 32; int* fillc = tot + 64; int* before = tot + 96;
    const int* toke = (const int*)(p.ws + WS_TOKE); const float* tokw = (const float*)(p.ws + WS_TOKW);
    int* rowtok = (int*)(p.ws + WS_ROWTOK) + (size_t)l * RMAX; float* roww = (float*)(p.ws + WS_ROWW) + (size_t)l * RMAX; int* pos = (int*)(p.ws + WS_POS);
    for (int blk = blockIdx.x; blk < T / 64; blk += gridDim.x) {
        if (tid < 32) { int s = 0, bf = 0; for (int i = 0; i < T / 64; ++i) { const int c = BC[i * 32 + tid]; s += c; if (i < blk) bf += c; } tot[tid] = s; before[tid] = bf; fillc[tid] = 0; if (blk == 0) cnt[tid] = s; }
        __syncthreads();
        if (tid == 0) { int s = 0; for (int e = 0; e < 32; ++e) { base[e] = s + before[e]; s += (tot[e] + 255) & ~255; } }
        __syncthreads();
        if (tid < 256) {
            const int i = blk * 256 + tid, e = toke[i];
            const int slot = base[e] + atomicAdd(&fillc[e], 1);
            rowtok[slot] = i >> 2; roww[slot] = tokw[i]; pos[i] = slot;
        }
        __syncthreads();
    }
}

#define XB_TMO      128
#define XB_XCNT(j)  (256  + 64 * (j))
#define XB_XSUB(j)  (1280 + 64 * (j))
#define XB_XGEN(j)  (2304 + 64 * (j))
#define XB_TOP      3328
#define XB_TOPGEN   3392
#define XCD_BAR_WORDS 3456
#define XB_SPIN_CAP (1u << 18)
#define XLAS __attribute__((address_space(3)))
__device__ __forceinline__ unsigned xb_ld(unsigned* p)              { return __hip_atomic_load(p, __ATOMIC_RELAXED, __HIP_MEMORY_SCOPE_AGENT); }
__device__ __forceinline__ unsigned xb_add(unsigned* p, unsigned v) { return __hip_atomic_fetch_add(p, v, __ATOMIC_RELAXED, __HIP_MEMORY_SCOPE_AGENT); }
__device__ __forceinline__ unsigned xb_xcc_id() { return (unsigned)__builtin_amdgcn_s_getreg((3 << 11) | 20) & 0xFu; }
#define XB_SPIN(cond, bar) do { unsigned _sp = 0; while (cond) { __builtin_amdgcn_s_sleep(1); \
    if ((++_sp & 255u) == 0u) { if (xb_ld(&(bar)[XB_TMO])) break; if (_sp > XB_SPIN_CAP) { atomicAdd(&(bar)[XB_TMO], 1u); break; } } } } while (0)
constexpr int LDS_BARST_OFF = 147200;
struct XcdBarrier { unsigned* bar; unsigned x; volatile XLAS unsigned* st; };
__device__ __forceinline__ XcdBarrier xcd_barrier_post(unsigned* bar, volatile XLAS unsigned* st) {
    XcdBarrier b; b.bar = bar; b.x = xb_xcc_id(); b.st = st;
    if (threadIdx.x == 0) (void)xb_add(&bar[XB_XCNT(b.x)], 1u);
    return b;
}
__device__ __forceinline__ void xcd_barrier_complete(unsigned* bar, unsigned x, unsigned& nloc, unsigned& nx) {
    const unsigned G = gridDim.x * gridDim.y * gridDim.z;
    unsigned sum, cnt, mine, sp = 0u;
    for (;;) {
        sum = 0u; cnt = 0u; mine = 0u;
#pragma unroll
        for (unsigned j = 0; j < 16; ++j) { const unsigned c = xb_ld(&bar[XB_XCNT(j)]); sum += c; cnt += (c > 0u) ? 1u : 0u; mine = (j == x) ? c : mine; }
        if (sum == G) break;
        __builtin_amdgcn_s_sleep(1);
        if ((++sp & 255u) == 0u) { if (xb_ld(&bar[XB_TMO])) break; if (sp > XB_SPIN_CAP) { atomicAdd(&bar[XB_TMO], 1u); break; } }
    }
    nloc = mine > 0u ? mine : 1u; nx = cnt > 0u ? cnt : 1u;
}
__device__ __forceinline__ void xcd_barrier(unsigned char* ws, unsigned char* lds_raw_) {
    XcdBarrier b; b.bar = (unsigned*)(ws + WS_BAR); b.x = xb_xcc_id(); b.st = (volatile XLAS unsigned*)((XLAS unsigned char*)lds_raw_ + LDS_BARST_OFF);
    asm volatile("s_waitcnt vmcnt(0)" ::: "memory");
    __syncthreads();
    if (threadIdx.x == 0) {
        unsigned* bar = b.bar;
        __builtin_amdgcn_s_waitcnt(0);
        unsigned nloc = b.st[0], nx = b.st[1];
        if (nloc == 0u) { xcd_barrier_complete(bar, b.x, nloc, nx); b.st[0] = nloc; b.st[1] = nx; }
        const unsigned old = xb_add(&bar[XB_XSUB(b.x)], 1u);
        const unsigned gen = old / nloc;
        if (old + 1u == (gen + 1u) * nloc) {
            __builtin_amdgcn_fence(__ATOMIC_RELEASE, "agent");
            asm volatile("s_waitcnt vmcnt(0)" ::: "memory");
            const unsigned og = xb_add(&bar[XB_TOP], 1u);
            const unsigned tg = og / nx;
            if (og + 1u == (tg + 1u) * nx) xb_add(&bar[XB_TOPGEN], 1u);
            else XB_SPIN(xb_ld(&bar[XB_TOPGEN]) == tg, bar);
            __builtin_amdgcn_fence(__ATOMIC_ACQUIRE, "agent");
            xb_add(&bar[XB_XGEN(b.x)], 1u);
            asm volatile("s_waitcnt vmcnt(0)" ::: "memory");
        } else {
            XB_SPIN(xb_ld(&bar[XB_XGEN(b.x)]) == gen, bar);
            __builtin_amdgcn_fence(__ATOMIC_ACQUIRE, "agent");
            asm volatile("s_waitcnt vmcnt(0)" ::: "memory");
        }
    }
    __syncthreads();
}

__global__ void __launch_bounds__(NT, 2) mega_fwd(Params p) {
    extern __shared__ __attribute__((aligned(16))) unsigned char lds_raw[];
    float* lds = (float*)lds_raw;
    cg::grid_group grid = cg::this_grid();
    volatile XLAS unsigned* bst = (volatile XLAS unsigned*)((XLAS unsigned char*)lds_raw + LDS_BARST_OFF);
    if (threadIdx.x < 2) bst[threadIdx.x] = 0u;
    __syncthreads();
    (void)xcd_barrier_post((unsigned*)(p.ws + WS_BAR), bst);
#if USE_CG_SYNC
#define GSYNC() grid.sync()
#else
#define GSYNC() xcd_barrier(p.ws, lds_raw)
#endif
    phase_p0a(p, lds);
#if FAST_G1 || FAST_G2 || FAST_MOE
    __syncthreads();
    phase_convert(p, lds);
#if DUP == 1
    __syncthreads(); phase_convert(p, lds);
#endif
#endif
    grid.sync();
    phase_p0b(p);
#if DUP == 10
    GSYNC(); __syncthreads(); phase_p0a(p, lds); GSYNC(); phase_p0b(p);
#endif
    GSYNC();
    _Pragma("unroll 1") for (int l = 0; l < L; ++l) {
        phase_r1(p, l, true);
#if DUP == 11
        if (l == 0) phase_r1(p, l, true);
#endif
        GSYNC();
#if FAST_G1
        phase_g1_fast(p, l, lds_raw);
#if DUP == 2
        phase_g1_fast(p, l, lds_raw);
#endif
#else
        phase_g1(p, l, lds);
#endif
        GSYNC();
#if !FAST_G1
        phase_zp(p, l);
        GSYNC();
#endif
        phase_ck_fast(p, l, lds_raw);
        GSYNC();
        phase_c2(p, l);
#if DUP == 4
        phase_c2(p, l);
#endif
        GSYNC();
#if FAST_ATT
        phase_att_fast(p, lds_raw);
#if DUP == 5
        phase_att_fast(p, lds_raw);
#endif
#else
        phase_att(p, lds);
#endif
        GSYNC();
#if FAST_G2
        phase_g2_fast(p, l, lds_raw);
#if DUP == 8
        if (l == 0) phase_g2_fast(p, l, lds_raw);
#endif
#else
        phase_g2(p, l, lds);
#endif
        GSYNC();
        phase_r2_fast(p, l, lds_raw);
        GSYNC();
        phase_sc_fast(p, l, lds_raw);
        GSYNC();
#if FAST_MOE
        phase_m1_fast(p, l, lds_raw);
#if DUP == 6
        phase_m1_fast(p, l, lds_raw);
#endif
#else
        phase_m1(p, l, lds);
#endif
        GSYNC();
#if FAST_MOE
        phase_m2_fast(p, l, lds_raw);
#if DUP == 7
        phase_m2_fast(p, l, lds_raw);
#endif
#else
        phase_m2(p, l, lds);
#endif
        GSYNC();
    }
    phase_r1(p, L, false);
}

extern "C" void kernel_launch(void* const* d_in, const int* in_sizes, int n_in, void* d_out, int out_size, void* d_ws, size_t ws_size, hipStream_t stream) {
    static int grid_blocks = 0;
    if (grid_blocks == 0) {
        if (n_in != 21 || out_size != T * D || ws_size < WS_END) { fprintf(stderr, "kernel_launch: unexpected shapes (n_in %d out %d ws %zu need %zu)\n", n_in, out_size, ws_size, (size_t)WS_END); grid_blocks = -1; return; }
        int dev = 0, cus = 0, per_cu = 0;
        hipGetDevice(&dev);
        hipDeviceGetAttribute(&cus, hipDeviceAttributeMultiprocessorCount, dev);
        hipFuncSetAttribute((const void*)mega_fwd, hipFuncAttributeMaxDynamicSharedMemorySize, LDS_BYTES);
        hipOccupancyMaxActiveBlocksPerMultiprocessor(&per_cu, (const void*)mega_fwd, NT, LDS_BYTES);
        if (per_cu < 1) { fprintf(stderr, "kernel_launch: occupancy query says %d blocks per CU\n", per_cu); per_cu = 1; }
        (void)hipGetLastError();
        grid_blocks = cus * 1;
    }
    if (grid_blocks < 0) return;
    if (hipMemsetAsync((char*)d_ws + WS_BAR, 0, 16384, stream) != hipSuccess) { fprintf(stderr, "kernel_launch: memset failed\n"); return; }
    Params p{};
    for (int i = 0; i < 21; ++i) p.in[i] = (const float*)d_in[i];
    p.out = (float*)d_out; p.ws = (unsigned char*)d_ws;
    void* args[] = {&p};
    hipError_t e = hipLaunchCooperativeKernel((const void*)mega_fwd, dim3(grid_blocks), dim3(NT), args, LDS_BYTES, stream);
    if (e != hipSuccess) fprintf(stderr, "cooperative launch failed: %s (grid %d)\n", hipGetErrorString(e), grid_blocks);
}
```

```cpp
#include <hip/hip_runtime.h>
#include <hip/hip_cooperative_groups.h>
#include <cstdio>
#include <cstdint>
namespace cg = cooperative_groups;

constexpr int Bn = 2, S = 8192, D = 1024, L = 2, T = Bn * S;
constexpr int INW = 2840;
constexpr int NE = 32, TOPK = 4, DFF = 1024;
constexpr int A_TOT = T * TOPK;
constexpr int RMAX = A_TOT + NE * 256;
constexpr int NCMP = 511;
constexpr int NT = 512;
constexpr int NW = NT / 64;
constexpr int LDS_BYTES = 147456;
constexpr float EPS = 1e-6f;
constexpr float NEGF = -1e30f;

#ifndef FAST_G1
#define FAST_G1 1
#endif
#ifndef FAST_G2
#define FAST_G2 1
#endif
#ifndef DUP
#define DUP 0
#endif
#ifndef USE_CG_SYNC
#define USE_CG_SYNC 0
#endif
#ifndef FAST_ATT
#define FAST_ATT 1
#endif
#ifndef FAST_MOE
#define FAST_MOE 1
#endif
constexpr int ZBW = 3072;
constexpr int ZB_Q = 0, ZB_KC = 512, ZB_VC = 640, ZB_KS = 768, ZB_VS = 896, ZB_KW = 1024, ZB_VW = 1152, ZB_MQ = 1280, ZB_MK = 1792, ZB_MV = 2304, ZB_G = 2816;
constexpr float QSCALE = 0.125f * 1.4426950408889634f;
constexpr float LOG2E = 1.4426950408889634f;
constexpr int ZC_Q = 0, ZC_KC = 512, ZC_VC = 640, ZC_KS = 768, ZC_VS = 896, ZC_KW = 1024, ZC_VW = 1152, ZC_G = 1280, ZC_MQ = 1304, ZC_MK = 1816, ZC_MV = 2328;

constexpr size_t al256(size_t x) { return (x + 255) & ~(size_t)255; }
constexpr size_t WS_BAR = 0;
constexpr size_t WS_MODP = 16384;
constexpr size_t WS_MOD = al256(WS_MODP + (size_t)8 * L * Bn * 6144 * 4);
constexpr size_t WS_CNT = al256(WS_MOD + (size_t)L * Bn * 6144 * 4);
constexpr size_t WS_FILL = al256(WS_CNT + L * 32 * 4);
constexpr size_t WS_ROWTOK = al256(WS_FILL + L * 32 * 4);
constexpr size_t WS_ROWW = al256(WS_ROWTOK + (size_t)L * RMAX * 4);
constexpr size_t WS_TOKE = al256(WS_ROWW + (size_t)L * RMAX * 4);
constexpr size_t WS_TOKW = al256(WS_TOKE + (size_t)T * 4 * 4);
constexpr size_t WS_POS = al256(WS_TOKW + (size_t)T * 4 * 4);
constexpr size_t WS_HID = al256(WS_POS + (size_t)T * 4 * 4);
constexpr size_t WS_KC = al256(WS_HID + (size_t)2 * 2044 * 128 * 4);
constexpr size_t WS_VC = al256(WS_KC + (size_t)2044 * 64 * 4);
constexpr size_t WS_KM = al256(WS_VC + (size_t)2044 * 64 * 4);
constexpr size_t WS_H = al256(WS_KM + (size_t)Bn * 8 * 32 * 64 * 4);
constexpr size_t WS_Z = al256(WS_H + (size_t)T * D * 4);
constexpr size_t WS_ATT = al256(WS_Z + (size_t)T * INW * 4);
constexpr size_t WS_U = al256(WS_ATT + (size_t)T * D * 4);
constexpr size_t WS_Y = al256(WS_U + (FAST_MOE ? (size_t)0 : (size_t)RMAX * 2048 * 4));
constexpr size_t WS_WINT = al256(WS_Y + (size_t)RMAX * 1024 * 4);
constexpr size_t WS_WOT = al256(WS_WINT + (size_t)L * 3072 * 1024 * 2);
constexpr size_t WS_W1T = al256(WS_WOT + (size_t)L * 1024 * 1024 * 2);
constexpr size_t WS_W2T = al256(WS_W1T + (size_t)L * NE * 2048 * 1024 * 2);
constexpr size_t WS_XN = al256(WS_W2T + (size_t)L * NE * 1024 * 1024 * 2);
constexpr size_t WS_ATTB = al256(WS_XN + (size_t)(T + 1) * D * 2);
constexpr size_t WS_ACT = al256(WS_ATTB + (size_t)T * D * 2);
constexpr size_t WS_ZB = al256(WS_ACT + (size_t)RMAX * DFF * 2);
constexpr size_t WS_GATE = al256(WS_ZB + (size_t)T * ZBW * 2);
constexpr size_t WS_KCB = al256(WS_GATE + (size_t)T * 32 * 4);
constexpr size_t WS_VCB = al256(WS_KCB + (size_t)Bn * 2 * 512 * 64 * 2);
constexpr size_t WS_KMB = al256(WS_VCB + (size_t)Bn * 2 * 512 * 64 * 2);
constexpr size_t WS_XNLO = al256(WS_KMB + (size_t)Bn * 8 * 32 * 64 * 2);
constexpr size_t WS_BC = al256(WS_XNLO + (size_t)T * D * 2);
constexpr size_t WS_WCT = al256(WS_BC + (size_t)(T / 64) * 32 * 4);
constexpr size_t WS_CBP = al256(WS_WCT + (size_t)L * 2 * 128 * 2048 * 2);
constexpr size_t WS_CB = al256(WS_CBP + (size_t)16 * L * 2 * 128 * 4);
constexpr size_t WS_HIDP = al256(WS_CB + (size_t)L * 2 * 128 * 4);
constexpr size_t WS_SEL3 = al256(WS_HIDP + (size_t)4 * 2 * 2044 * 128 * 4);
constexpr size_t WS_LRK = al256(WS_SEL3 + (size_t)T * 8 * 4);
constexpr size_t WS_ILIST = al256(WS_LRK + (size_t)T * 8 * 4);
constexpr size_t WS_BCM = al256(WS_ILIST + (size_t)16 * 32 * 32 * 256);
constexpr size_t WS_PM = al256(WS_BCM + (size_t)16 * 32 * 32 * 4);
constexpr size_t WS_PL = al256(WS_PM + (size_t)16 * 25600 * 4);
constexpr size_t WS_PO = al256(WS_PL + (size_t)16 * 25600 * 4);
constexpr size_t WS_END = al256(WS_PO + (size_t)16 * 25600 * 64 * 2);

struct Params {
    const float* in[21];
    float* out;
    unsigned char* ws;
};

__device__ __forceinline__ int otid() { int t = threadIdx.x; asm volatile("" : "+v"(t)); return t; }
typedef unsigned short bf16_t;
__device__ __forceinline__ unsigned f2bf(float f) { unsigned u = __builtin_bit_cast(unsigned, f); return (u + 0x7fffu + ((u >> 16) & 1u)) >> 16; }
__device__ __forceinline__ unsigned pk2(float lo, float hi) { return f2bf(lo) | (f2bf(hi) << 16); }
__device__ __forceinline__ float bf2f(bf16_t v) { return __builtin_bit_cast(float, (unsigned)v << 16); }
__device__ __forceinline__ float wave_sum(float v) {
#pragma unroll
    for (int o = 1; o < 64; o <<= 1) v += __shfl_xor(v, o);
    return v;
}
__device__ __forceinline__ float sigmoidf_(float x) { return 1.f / (1.f + __expf(-x)); }
__device__ __forceinline__ float gelu_tanh(float x) {
    const float u = 0.7978845608028654f * (x + 0.044715f * x * x * x);
    return 0.5f * x * (1.f + tanhf(u));
}

template <class AL, class BL, class EP>
__device__ __forceinline__ void gemm_tile(float* lds, int m0, int n0, int K, const AL& al, const BL& bl, const EP& ep) {
    float* As = lds;
    float* Bs = lds + 16 * 132;
    const int tid = otid(), tx = tid & 15, ty = tid >> 4;
    const int ar = tid >> 2, ak = (tid & 3) * 4;
    const int bk = tid >> 5, bn = (tid & 31) * 2;
    float acc[4][4];
#pragma unroll
    for (int i = 0; i < 4; ++i)
#pragma unroll
        for (int j = 0; j < 4; ++j) acc[i][j] = 0.f;
    float4 av = al(m0 + ar, ak);
    float2 bv = bl(bk, n0 + bn);
    for (int k0 = 0; k0 < K; k0 += 16) {
        As[(ak + 0) * 132 + ar] = av.x; As[(ak + 1) * 132 + ar] = av.y; As[(ak + 2) * 132 + ar] = av.z; As[(ak + 3) * 132 + ar] = av.w;
        *(float2*)&Bs[bk * 68 + bn] = bv;
        __syncthreads();
        if (k0 + 16 < K) { av = al(m0 + ar, k0 + 16 + ak); bv = bl(k0 + 16 + bk, n0 + bn); }
#pragma unroll
        for (int kk = 0; kk < 16; ++kk) {
            const float4 a = *(const float4*)&As[kk * 132 + ty * 4];
            const float4 b = *(const float4*)&Bs[kk * 68 + tx * 4];
            const float a_[4] = {a.x, a.y, a.z, a.w}, b_[4] = {b.x, b.y, b.z, b.w};
#pragma unroll
            for (int i = 0; i < 4; ++i)
#pragma unroll
                for (int j = 0; j < 4; ++j) acc[i][j] += a_[i] * b_[j];
        }
        __syncthreads();
    }
#pragma unroll
    for (int i = 0; i < 4; ++i)
#pragma unroll
        for (int j = 0; j < 4; ++j) ep(m0 + ty * 4 + i, n0 + tx * 4 + j, acc[i][j]);
}

__device__ __forceinline__ void phase_p0a(const Params& p, float* lds) {
    const int tid = otid(), gtid = blockIdx.x * NT + tid, gsz = gridDim.x * NT;
    int* cnt = (int*)(p.ws + WS_CNT); int* fill = (int*)(p.ws + WS_FILL); int* rowtok = (int*)(p.ws + WS_ROWTOK);
    for (int i = gtid; i < L * 32; i += gsz) { cnt[i] = 0; fill[i] = 0; }
    for (int i = gtid; i < L * RMAX; i += gsz) rowtok[i] = -1;
    const float* c = p.in[1];
    for (int i = tid; i < Bn * D; i += NT) { const float v = c[i]; lds[i] = v / (1.f + __expf(-v)); }
    __syncthreads();
    const float* ada_w = p.in[2];
    float* modp = (float*)(p.ws + WS_MODP);
    for (int idx = gtid; idx < 8 * L * 6144; idx += gsz) {
        const int col = idx % 6144, l = (idx / 6144) % L, kc = idx / (6144 * L);
        const float* w = ada_w + ((size_t)l * D + kc * 128) * 6144 + col;
        float a0 = 0.f, a1 = 0.f;
#pragma unroll 8
        for (int k = 0; k < 128; ++k) { const float wv = w[(size_t)k * 6144]; a0 += lds[kc * 128 + k] * wv; a1 += lds[D + kc * 128 + k] * wv; }
        modp[((size_t)(kc * L + l) * Bn + 0) * 6144 + col] = a0;
        modp[((size_t)(kc * L + l) * Bn + 1) * 6144 + col] = a1;
    }
    { const float* posw = p.in[9]; const float* w1c = p.in[10]; float* cbp = (float*)(p.ws + WS_CBP);
      for (int idx = gtid; idx < 16 * L * 2 * 128; idx += gsz) {
          const int j = idx & 127, li = (idx >> 7) % (L * 2), kc = idx / (L * 2 * 128);
          const float* w = w1c + ((size_t)li * 2048 + kc * 128) * 128 + j; const float* pp = posw + (size_t)li * 2048 + kc * 128;
          float a = 0.f;
#pragma unroll 8
          for (int k = 0; k < 128; ++k) a += pp[k] * w[(size_t)k * 128];
          cbp[idx] = a; } }
}
__device__ __forceinline__ void phase_p0b(const Params& p) {
    const int gtid = blockIdx.x * NT + otid(), gsz = gridDim.x * NT;
    { const float* cbp = (const float*)(p.ws + WS_CBP); float* cb = (float*)(p.ws + WS_CB);
      for (int idx = gtid; idx < L * 2 * 128; idx += gsz) { float s = 0.f;
#pragma unroll
          for (int kc = 0; kc < 16; ++kc) s += cbp[kc * (L * 2 * 128) + idx];
          cb[idx] = s; } }
    const float* modp = (const float*)(p.ws + WS_MODP); float* mod = (float*)(p.ws + WS_MOD); const float* ada_b = p.in[3];
    for (int idx = gtid; idx < L * Bn * 6144; idx += gsz) {
        const int col = idx % 6144, l = idx / (Bn * 6144);
        float s = ada_b[l * 6144 + col];
#pragma unroll
        for (int kc = 0; kc < 8; ++kc) s += modp[(size_t)kc * L * Bn * 6144 + idx];
        mod[idx] = s;
    }
}

__device__ __forceinline__ void phase_r1(const Params& p, int l, bool do_h) {
    const int lane = otid() & 63, wave = otid() >> 6;
    const int gw = blockIdx.x * NW + wave, ngw = gridDim.x * NW;
    const float* mod = (const float*)(p.ws + WS_MOD);
    const float* xin = p.in[0]; float* XA = p.out; float* H = (float*)(p.ws + WS_H);
    const bf16_t* Y = (const bf16_t*)(p.ws + WS_Y); const int* pos = (const int*)(p.ws + WS_POS);
    const float* lng = p.in[4] + (size_t)(do_h ? l : 0) * D;
    bf16_t* XN = (bf16_t*)(p.ws + WS_XN);
    for (int t = gw; t < T; t += ngw) {
        const int b = t / S;
        float4 v[4];
        if (l == 0) {
#pragma unroll
            for (int j = 0; j < 4; ++j) v[j] = *(const float4*)(xin + (size_t)t * D + 4 * lane + 256 * j);
        } else {
            const float* g2 = mod + ((size_t)(l - 1) * Bn + b) * 6144 + 5 * D;
            const int p0 = pos[t * 4 + 0], p1 = pos[t * 4 + 1], p2 = pos[t * 4 + 2], p3 = pos[t * 4 + 3];
#pragma unroll
            for (int j = 0; j < 4; ++j) {
                const int col = 4 * lane + 256 * j;
                const float4 x = *(const float4*)(XA + (size_t)t * D + col);
                const uint2 q0 = *(const uint2*)(Y + (size_t)p0 * D + col), q1 = *(const uint2*)(Y + (size_t)p1 * D + col), q2 = *(const uint2*)(Y + (size_t)p2 * D + col), q3 = *(const uint2*)(Y + (size_t)p3 * D + col);
#define BF4(q) make_float4(__builtin_bit_cast(float, (q).x << 16), __builtin_bit_cast(float, (q).x & 0xffff0000u), __builtin_bit_cast(float, (q).y << 16), __builtin_bit_cast(float, (q).y & 0xffff0000u))
                const float4 y0 = BF4(q0), y1 = BF4(q1), y2 = BF4(q2), y3 = BF4(q3);
#undef BF4
                const float4 g = *(const float4*)(g2 + col);
                float4 r;
                r.x = x.x + g.x * (((y0.x + y1.x) + y2.x) + y3.x); r.y = x.y + g.y * (((y0.y + y1.y) + y2.y) + y3.y);
                r.z = x.z + g.z * (((y0.z + y1.z) + y2.z) + y3.z); r.w = x.w + g.w * (((y0.w + y1.w) + y2.w) + y3.w);
                v[j] = r;
                *(float4*)(XA + (size_t)t * D + col) = r;
            }
        }
        if (do_h) {
            float ss = 0.f;
#pragma unroll
            for (int j = 0; j < 4; ++j) ss += (v[j].x * v[j].x + v[j].y * v[j].y) + (v[j].z * v[j].z + v[j].w * v[j].w);
            ss = wave_sum(ss);
            const float r = rsqrtf(ss * (1.f / D) + EPS);
            const float* sh = mod + ((size_t)l * Bn + b) * 6144 + 0 * D; const float* sc = mod + ((size_t)l * Bn + b) * 6144 + 1 * D;
#pragma unroll
            for (int j = 0; j < 4; ++j) {
                const int col = 4 * lane + 256 * j;
                const float4 g = *(const float4*)(lng + col), s1 = *(const float4*)(sc + col), s0 = *(const float4*)(sh + col);
                float4 o;
                o.x = v[j].x * r * g.x * (1.f + s1.x) + s0.x; o.y = v[j].y * r * g.y * (1.f + s1.y) + s0.y;
                o.z = v[j].z * r * g.z * (1.f + s1.z) + s0.z; o.w = v[j].w * r * g.w * (1.f + s1.w) + s0.w;
                *(float4*)(H + (size_t)t * D + col) = o;
                *(uint2*)(XN + (size_t)t * D + col) = make_uint2(pk2(o.x, o.y), pk2(o.z, o.w));
            }
        }
    }
}

__device__ __forceinline__ void phase_g1(const Params& p, int l, float* lds) {
    const float* H = (const float*)(p.ws + WS_H); const float* W = p.in[6] + (size_t)l * D * INW; float* Z = (float*)(p.ws + WS_Z);
    constexpr int NTN = (INW + 63) / 64, NTM = T / 128;
    auto al = [=](int r, int k) -> float4 { return *(const float4*)(H + (size_t)r * D + k); };
    auto bl = [=](int k, int n) -> float2 { return n < INW ? *(const float2*)(W + (size_t)k * INW + n) : make_float2(0.f, 0.f); };
    auto ep = [=](int r, int c, float v) { if (c < INW) Z[(size_t)r * INW + c] = v; };
    for (int tile = blockIdx.x; tile < NTM * NTN; tile += gridDim.x) {
        const int tm = tile / NTN, tn = tile % NTN;
        gemm_tile(lds, tm * 128, tn * 64, D, al, bl, ep);
    }
}

__device__ __forceinline__ void phase_zp(const Params& p, int l) {
    const int lane = otid() & 63, wave = otid() >> 6;
    const int gw = blockIdx.x * NW + wave, ngw = gridDim.x * NW;
    float* Z = (float*)(p.ws + WS_Z);
    const float gq = p.in[7][l * 64 + lane], gk = p.in[8][l * 64 + lane], gmq = p.in[12][l * 64 + lane], gmk = p.in[13][l * 64 + lane];
    for (int t = gw; t < T; t += ngw) {
        float* z = Z + (size_t)t * INW;
        for (int seg = 0; seg < 28; ++seg) {
            int col; float g;
            if (seg < 8) { col = ZC_Q + seg * 64; g = gq; }
            else if (seg < 10) { col = ZC_KS + (seg - 8) * 64; g = gk; }
            else if (seg < 12) { col = ZC_KW + (seg - 10) * 64; g = gk; }
            else if (seg < 20) { col = ZC_MQ + (seg - 12) * 64; g = gmq; }
            else { col = ZC_MK + (seg - 20) * 64; g = gmk; }
            const float v = z[col + lane];
            const float ss = wave_sum(v * v);
            z[col + lane] = v * rsqrtf(ss * (1.f / 64.f) + EPS) * g;
        }
        if (lane < 24) z[ZC_G + lane] = sigmoidf_(z[ZC_G + lane]);
    }
}

__device__ __forceinline__ void phase_ck(const Params& p, int l, float* lds) {
    const bf16_t* Z = (const bf16_t*)(p.ws + WS_ZB);
    float* HID = (float*)(p.ws + WS_HID);
    const float* posw = p.in[9] + (size_t)l * 2 * 32 * 64; const float* w1 = p.in[10] + (size_t)l * 2 * 2048 * 128;
    for (int tile = blockIdx.x; tile < 64; tile += gridDim.x) {
        const int idx = tile / 32, tm = (tile % 32) / 2, tn = tile % 2;
        const float* W = w1 + (size_t)idx * 2048 * 128; const float* PW = posw + (size_t)idx * 32 * 64; float* HO = HID + (size_t)idx * 2044 * 128;
        auto al = [=](int r, int k) -> float4 {
            if (r >= 2044) return make_float4(0.f, 0.f, 0.f, 0.f);
            const int b = r / 1022, g = (r / 511) & 1, n = r % 511, li = k >> 6, d = k & 63;
            const uint2 ab = *(const uint2*)(Z + (size_t)(b * S + 16 * n + li) * ZBW + ZB_KC + idx * 128 + g * 64 + d);
            const float4 a = make_float4(__builtin_bit_cast(float, ab.x << 16), __builtin_bit_cast(float, ab.x & 0xffff0000u), __builtin_bit_cast(float, ab.y << 16), __builtin_bit_cast(float, ab.y & 0xffff0000u));
            const float4 q = *(const float4*)(PW + li * 64 + d);
            return make_float4(a.x + q.x, a.y + q.y, a.z + q.z, a.w + q.w);
        };
        auto bl = [=](int k, int n) -> float2 { return *(const float2*)(W + (size_t)k * 128 + n); };
        auto ep = [=](int r, int c, float v) { if (r < 2044) HO[(size_t)r * 128 + c] = gelu_tanh(v); };
        gemm_tile(lds, tm * 128, tn * 64, 2048, al, bl, ep);
    }
    const int lane = otid() & 63, wave = otid() >> 6;
    float* KM = (float*)(p.ws + WS_KM);
    for (int it = blockIdx.x * NW + wave; it < Bn * 8 * 32; it += gridDim.x * NW) {
        const int b = it / 256, h = (it / 32) & 7, blk = it & 31;
        const bf16_t* base = Z + (size_t)(b * S + blk * 256) * ZBW + ZB_MK + h * 64 + lane;
        float s = 0.f;
        for (int i = 0; i < 256; ++i) s += bf2f(base[(size_t)i * ZBW]);
        KM[(size_t)it * 64 + lane] = s * (1.f / 256.f);
        ((bf16_t*)(p.ws + WS_KMB))[(size_t)it * 64 + lane] = (bf16_t)f2bf(s * (1.f / 256.f));
    }
}
__device__ __forceinline__ void phase_c2(const Params& p, int l, float* lds) {
    const int lane = otid() & 63, wave = otid() >> 6;
    const float* HIDP = (const float*)(p.ws + WS_HIDP); const float* cb = (const float*)(p.ws + WS_CB) + l * 2 * 128; const float* w2 = p.in[11] + (size_t)l * 2 * 128 * 64;
    const float gk = p.in[8][l * 64 + lane];
    float* hl = lds + wave * 128;
    for (int r = blockIdx.x * NW + wave; r < 2 * 2044; r += gridDim.x * NW) {
        const int idx = r / 2044, rr = r % 2044;
#pragma unroll
        for (int q = 0; q < 2; ++q) { const int j = lane + 64 * q; float s = cb[idx * 128 + j];
#pragma unroll
            for (int kq = 0; kq < 1; ++kq) s += HIDP[((size_t)(kq * 2 + idx) * 2044 + rr) * 128 + j];
            hl[j] = gelu_tanh(s); }
        asm volatile("s_waitcnt lgkmcnt(0)" ::: "memory"); __builtin_amdgcn_wave_barrier();
        const float* W = w2 + (size_t)idx * 128 * 64;
        float s = 0.f;
#pragma unroll 8
        for (int j = 0; j < 128; ++j) s += hl[j] * W[j * 64 + lane];
        asm volatile("s_waitcnt lgkmcnt(0)" ::: "memory"); __builtin_amdgcn_wave_barrier();
        const int bgi = rr / 511, n = rr % 511;
        if (idx == 0) { const float ss = wave_sum(s * s); const float kv = s * rsqrtf(ss * (1.f / 64.f) + EPS) * gk; ((bf16_t*)(p.ws + WS_KCB))[((size_t)bgi * 512 + n) * 64 + lane] = (bf16_t)f2bf(kv); }
        else { ((bf16_t*)(p.ws + WS_VCB))[((size_t)bgi * 512 + n) * 64 + lane] = (bf16_t)f2bf(s); }
    }
    if (blockIdx.x == 0 && otid() < 2 * 4 * 64) { const int i = otid(); bf16_t* dst = (bf16_t*)(p.ws + (i < 256 ? WS_KCB : WS_VCB)); dst[((size_t)((i & 255) >> 6) * 512 + 511) * 64 + (i & 63)] = 0; }
}

__device__ __forceinline__ void ld32bf(const bf16_t* p, float (&out)[32]) {
#pragma unroll
    for (int c = 0; c < 4; ++c) { const uint4 v = *(const uint4*)(p + 8 * c); const unsigned w[4] = {v.x, v.y, v.z, v.w};
#pragma unroll
        for (int i = 0; i < 4; ++i) { out[8 * c + 2 * i] = __builtin_bit_cast(float, w[i] << 16); out[8 * c + 2 * i + 1] = __builtin_bit_cast(float, w[i] & 0xffff0000u); } }
}
#define ATT_KEY(valid, kp, vp, bias)                                                              \
    {                                                                                             \
        float kk_[32]; ld32bf(kp, kk_);                                                           \
        float s_ = 0.f;                                                                           \
        _Pragma("unroll") for (int d = 0; d < 32; ++d) s_ += qv[d] * kk_[d];                      \
        s_ += __shfl_xor(s_, 1);                                                                  \
        s_ = s_ - (bias);                                                                         \
        if (valid) {                                                                              \
            float vv_[32]; ld32bf(vp, vv_);                                                       \
            if (s_ > m) { const float cf = exp2f(m - s_); lsum *= cf; _Pragma("unroll") for (int d = 0; d < 32; ++d) o[d] *= cf; m = s_; } \
            const float p_ = exp2f(s_ - m); lsum += p_;                                           \
            _Pragma("unroll") for (int d = 0; d < 32; ++d) o[d] += p_ * vv_[d];                   \
        }                                                                                         \
    }

__device__ __forceinline__ void nsa_item(const Params& p, int item, float* lds) {
    const int tid = otid(), q = (tid & 63) >> 1, half = tid & 1, h = __builtin_amdgcn_readfirstlane(tid >> 6), g = h >> 2, hg = h & 3;
    const int b = item >> 8, ci = item & 255, t0 = ci * 32, t = t0 + q, cur = t0 >> 6; const size_t tt = (size_t)b * S + t;
    const bf16_t* Z = (const bf16_t*)(p.ws + WS_ZB); const float* GT = (const float*)(p.ws + WS_GATE); float* ATT = (float*)(p.ws + WS_ATT);
    const float* KC = (const float*)(p.ws + WS_KC) + (size_t)(b * 2 + g) * NCMP * 64 + half * 32; const float* VC = (const float*)(p.ws + WS_VC) + (size_t)(b * 2 + g) * NCMP * 64 + half * 32;
    float* imp = lds;
    unsigned* selm = (unsigned*)(lds + 2 * 32 * 129);
    const float slope = exp2f(-(float)(h + 1)) * LOG2E;
    float qv[32], o[32];
    ld32bf(Z + tt * ZBW + ZB_Q + h * 64 + half * 32, qv);
    const float g0 = GT[tt * 32 + h * 3 + 0], g1 = GT[tt * 32 + h * 3 + 1], g2 = GT[tt * 32 + h * 3 + 2];
    for (int i = tid; i < 2 * 32 * 129; i += NT) imp[i] = 0.f;
    const int cnt_t = t >= 31 ? (t - 31) / 16 + 1 : 0;
    const int cnt_max = (t0 + 31 - 31) / 16 + 1;
    float m = NEGF, lsum = 0.f;
    _Pragma("unroll 1") for (int n = 0; n < cnt_max; ++n) {
        const float* kp = KC + (size_t)n * 64;
        float s_ = 0.f;
#pragma unroll
        for (int d = 0; d < 32; ++d) s_ += qv[d] * kp[d];
        s_ += __shfl_xor(s_, 1);
        s_ = s_ - slope * ((float)t - (16.f * n + 15.5f));
        if (n < cnt_t) { if (s_ > m) { lsum *= exp2f(m - s_); m = s_; } lsum += exp2f(s_ - m); }
    }
    const float linv = lsum > 0.f ? 1.f / lsum : 0.f;
#pragma unroll
    for (int d = 0; d < 32; ++d) o[d] = 0.f;
    __syncthreads();
    _Pragma("unroll 1") for (int r = 0; r < 4; ++r) {
        if (hg == r) {
            float* myimp = imp + (size_t)(g * 32 + q) * 129;
            _Pragma("unroll 1") for (int n = 0; n < cnt_max; ++n) {
                const float* kp = KC + (size_t)n * 64; const float* vp = VC + (size_t)n * 64;
                float s_ = 0.f;
#pragma unroll
                for (int d = 0; d < 32; ++d) s_ += qv[d] * kp[d];
                s_ += __shfl_xor(s_, 1);
                s_ = s_ - slope * ((float)t - (16.f * n + 15.5f));
                if (n < cnt_t) {
                    const float p_ = exp2f(s_ - m) * linv;
#pragma unroll
                    for (int d = 0; d < 32; ++d) o[d] += p_ * vp[d];
                    if (half == 0) {
                        myimp[n >> 2] += p_;
                        if ((n & 3) == 3) myimp[(n + 1) >> 2] += p_;
                    }
                }
            }
        }
        __syncthreads();
    }
    {
        float* ao = ATT + tt * D + h * 64 + half * 32;
#pragma unroll
        for (int d = 0; d < 32; d += 4) *(float4*)(ao + d) = make_float4(g0 * o[d], g0 * o[d + 1], g0 * o[d + 2], g0 * o[d + 3]);
    }
    if (hg == 0 && half == 0) {
        float* myimp = imp + (size_t)(g * 32 + q) * 129;
        _Pragma("unroll 1") for (int j = 0; j < 128; ++j) {
            float v = myimp[j];
            if (j == 0 || j == cur || j == cur - 1) v = 1e4f;
            if (j > cur) v = NEGF;
            myimp[j] = v;
        }
        unsigned mk0 = 0u, mk1 = 0u, mk2 = 0u, mk3 = 0u;
        _Pragma("unroll 1") for (int it = 0; it < 16; ++it) {
            float best = -3e38f; int bi = -1;
            _Pragma("unroll 4") for (int j = 0; j < 128; ++j) { const float v = myimp[j]; if (v > best) { best = v; bi = j; } }
            if (best <= NEGF) break;
            myimp[bi] = -3.4e38f;
            const unsigned bit = 1u << (bi & 31);
            if ((bi >> 5) == 0) mk0 |= bit; else if ((bi >> 5) == 1) mk1 |= bit; else if ((bi >> 5) == 2) mk2 |= bit; else mk3 |= bit;
        }
        unsigned* sm = selm + (g * 32 + q) * 4;
        sm[0] = mk0; sm[1] = mk1; sm[2] = mk2; sm[3] = mk3;
    }
    __syncthreads();
    {
        const unsigned* sm = selm + (g * 32 + q) * 4;
        const unsigned m0 = sm[0], m1 = sm[1], m2 = sm[2], m3 = sm[3];
        m = NEGF; lsum = 0.f;
#pragma unroll
        for (int d = 0; d < 32; ++d) o[d] = 0.f;
        _Pragma("unroll 1") for (int j = 0; j <= cur; ++j) {
            const unsigned w = (j >> 5) == 0 ? m0 : (j >> 5) == 1 ? m1 : (j >> 5) == 2 ? m2 : m3;
            const bool sel = (w >> (j & 31)) & 1u;
            if (__ballot(sel) == 0ull) continue;
            _Pragma("unroll 1") for (int kk = 0; kk < 64; ++kk) {
                const int ps = j * 64 + kk;
                const bf16_t* kp = Z + (size_t)(b * S + ps) * ZBW + ZB_KS + g * 64 + half * 32; const bf16_t* vp = Z + (size_t)(b * S + ps) * ZBW + ZB_VS + g * 64 + half * 32;
                const bool valid = sel && ps <= t;
                ATT_KEY(valid, kp, vp, slope * (float)(t - ps));
            }
        }
        const float li = lsum > 0.f ? g1 / lsum : 0.f;
        float* ao = ATT + tt * D + h * 64 + half * 32;
#pragma unroll
        for (int d = 0; d < 32; d += 4) { float4 a = *(float4*)(ao + d); a.x += li * o[d]; a.y += li * o[d + 1]; a.z += li * o[d + 2]; a.w += li * o[d + 3]; *(float4*)(ao + d) = a; }
    }
    {
        m = NEGF; lsum = 0.f;
#pragma unroll
        for (int d = 0; d < 32; ++d) o[d] = 0.f;
        const int lo = t0 - 511 > 0 ? t0 - 511 : 0;
        _Pragma("unroll 1") for (int ps = lo; ps <= t0 + 31; ++ps) {
            const bf16_t* kp = Z + (size_t)(b * S + ps) * ZBW + ZB_KW + g * 64 + half * 32; const bf16_t* vp = Z + (size_t)(b * S + ps) * ZBW + ZB_VW + g * 64 + half * 32;
            const bool valid = ps <= t && ps > t - 512;
            ATT_KEY(valid, kp, vp, slope * (float)(t - ps));
        }
        const float li = lsum > 0.f ? g2 / lsum : 0.f;
        float* ao = ATT + tt * D + h * 64 + half * 32;
        bf16_t* ab = (bf16_t*)(p.ws + WS_ATTB) + tt * D + h * 64 + half * 32;
#pragma unroll
        for (int d = 0; d < 32; d += 4) { float4 a = *(float4*)(ao + d); a.x += li * o[d]; a.y += li * o[d + 1]; a.z += li * o[d + 2]; a.w += li * o[d + 3]; *(float4*)(ao + d) = a;
            *(uint2*)(ab + d) = make_uint2(pk2(a.x, a.y), pk2(a.z, a.w)); }
    }
    __syncthreads();
}

__device__ __forceinline__ void moba_item(const Params& p, int item) {
    const int tid = otid(), q = (tid & 63) >> 1, half = tid & 1, h = __builtin_amdgcn_readfirstlane(tid >> 6);
    const int b = item >> 8, ci = item & 255, t0 = ci * 32, t = t0 + q, cb = t0 >> 8; const size_t tt = (size_t)b * S + t;
    const bf16_t* Z = (const bf16_t*)(p.ws + WS_ZB); const float* GT = (const float*)(p.ws + WS_GATE); float* ATT = (float*)(p.ws + WS_ATT);
    const float* KM = (const float*)(p.ws + WS_KM) + (size_t)(b * 8 + h) * 32 * 64 + half * 32;
    const float slope = exp2f(-(float)(h + 1)) * LOG2E;
    float qv[32], o[32];
    ld32bf(Z + tt * ZBW + ZB_MQ + h * 64 + half * 32, qv);
    float v1 = NEGF, v2 = NEGF, v3 = NEGF; int i1 = -1, i2 = -1, i3 = -1;
    _Pragma("unroll 1") for (int n = 0; n < cb; ++n) {
        const float* kp = KM + n * 64;
        float s_ = 0.f;
#pragma unroll
        for (int d = 0; d < 32; ++d) s_ += qv[d] * kp[d];
        s_ += __shfl_xor(s_, 1);
        if (s_ > v1) { v3 = v2; i3 = i2; v2 = v1; i2 = i1; v1 = s_; i1 = n; }
        else if (s_ > v2) { v3 = v2; i3 = i2; v2 = s_; i2 = n; }
        else if (s_ > v3) { v3 = s_; i3 = n; }
    }
    float m = NEGF, lsum = 0.f;
#pragma unroll
    for (int d = 0; d < 32; ++d) o[d] = 0.f;
    _Pragma("unroll 1") for (int n = 0; n < cb; ++n) {
        const bool sel = (n == i1) || (n == i2) || (n == i3);
        if (__ballot(sel) == 0ull) continue;
        _Pragma("unroll 1") for (int kk = 0; kk < 256; ++kk) {
            const int ps = n * 256 + kk;
            const bf16_t* kp = Z + (size_t)(b * S + ps) * ZBW + ZB_MK + h * 64 + half * 32; const bf16_t* vp = Z + (size_t)(b * S + ps) * ZBW + ZB_MV + h * 64 + half * 32;
            ATT_KEY(sel, kp, vp, slope * (float)(t - ps));
        }
    }
    _Pragma("unroll 1") for (int ps = cb * 256; ps <= t0 + 31; ++ps) {
        const bf16_t* kp = Z + (size_t)(b * S + ps) * ZBW + ZB_MK + h * 64 + half * 32; const bf16_t* vp = Z + (size_t)(b * S + ps) * ZBW + ZB_MV + h * 64 + half * 32;
        const bool valid = ps <= t;
        ATT_KEY(valid, kp, vp, slope * (float)(t - ps));
    }
    const float li = lsum > 0.f ? 1.f / lsum : 0.f;
    float* ao = ATT + tt * D + 512 + h * 64 + half * 32;
#pragma unroll
    for (int d = 0; d < 32; d += 4) *(float4*)(ao + d) = make_float4(li * o[d], li * o[d + 1], li * o[d + 2], li * o[d + 3]);
    bf16_t* ab = (bf16_t*)(p.ws + WS_ATTB) + tt * D + 512 + h * 64 + half * 32;
#pragma unroll
    for (int d = 0; d < 32; d += 4) *(uint2*)(ab + d) = make_uint2(pk2(li * o[d], li * o[d + 1]), pk2(li * o[d + 2], li * o[d + 3]));
}

__device__ __forceinline__ void phase_att(const Params& p, float* lds) {
    for (int pi = blockIdx.x; pi < 512; pi += gridDim.x) {
        nsa_item(p, pi, lds);
        moba_item(p, (pi & 256) | (255 - (pi & 255)));
    }
}

__device__ __forceinline__ void phase_g2(const Params& p, int l, float* lds) {
    const float* A = (const float*)(p.ws + WS_ATT); const float* W = p.in[14] + (size_t)l * D * D;
    const float* xin = l == 0 ? p.in[0] : p.out; float* XA = p.out;
    const float* mod = (const float*)(p.ws + WS_MOD) + (size_t)l * Bn * 6144 + 2 * D;
    auto al = [=](int r, int k) -> float4 { return *(const float4*)(A + (size_t)r * D + k); };
    auto bl = [=](int k, int n) -> float2 { return *(const float2*)(W + (size_t)k * D + n); };
    auto ep = [=](int r, int c, float v) { const int b = r / S; XA[(size_t)r * D + c] = xin[(size_t)r * D + c] + mod[(size_t)b * 6144 + c] * v; };
    for (int tile = blockIdx.x; tile < (T / 128) * (D / 64); tile += gridDim.x) {
        const int tm = tile / (D / 64), tn = tile % (D / 64);
        gemm_tile(lds, tm * 128, tn * 64, D, al, bl, ep);
    }
}

__device__ __forceinline__ void phase_r2(const Params& p, int l, float* lds, bool commit = true) {
    const int tid = otid(), lane = tid & 63, wave = tid >> 6;
    const int gw = blockIdx.x * NW + wave, ngw = gridDim.x * NW;
    const float* mod = (const float*)(p.ws + WS_MOD);
    const float* XA = p.out; float* H = (float*)(p.ws + WS_H);
    const float* lng = p.in[5] + (size_t)l * D; const float* rw = p.in[15] + (size_t)l * D * NE; const float* rb = p.in[16] + l * NE;
    int* toke = (int*)(p.ws + WS_TOKE); float* tokw = (float*)(p.ws + WS_TOKW); int* cnt = (int*)(p.ws + WS_CNT) + l * 32;
    bf16_t* XN = (bf16_t*)(p.ws + WS_XN);
    float* hrow = lds + wave * D;
    int* hist = (int*)(lds + NW * D);
    if (tid < 32) hist[tid] = 0;
    __syncthreads();
    for (int t = gw; t < T; t += ngw) {
        const int b = t / S;
        float4 v[4]; float ss = 0.f;
#pragma unroll
        for (int j = 0; j < 4; ++j) { v[j] = *(const float4*)(XA + (size_t)t * D + 4 * lane + 256 * j); ss += (v[j].x * v[j].x + v[j].y * v[j].y) + (v[j].z * v[j].z + v[j].w * v[j].w); }
        ss = wave_sum(ss);
        const float r = rsqrtf(ss * (1.f / D) + EPS);
        const float* sh = mod + ((size_t)l * Bn + b) * 6144 + 3 * D; const float* sc = mod + ((size_t)l * Bn + b) * 6144 + 4 * D;
#pragma unroll
        for (int j = 0; j < 4; ++j) {
            const int col = 4 * lane + 256 * j;
            const float4 g = *(const float4*)(lng + col), s1 = *(const float4*)(sc + col), s0 = *(const float4*)(sh + col);
            float4 o;
            o.x = v[j].x * r * g.x * (1.f + s1.x) + s0.x; o.y = v[j].y * r * g.y * (1.f + s1.y) + s0.y;
            o.z = v[j].z * r * g.z * (1.f + s1.z) + s0.z; o.w = v[j].w * r * g.w * (1.f + s1.w) + s0.w;
            *(float4*)(H + (size_t)t * D + col) = o;
            *(uint2*)(XN + (size_t)t * D + col) = make_uint2(pk2(o.x, o.y), pk2(o.z, o.w));
            *(float4*)(hrow + col) = o;
        }
        asm volatile("s_waitcnt lgkmcnt(0)" ::: "memory");
        __builtin_amdgcn_wave_barrier();
        const int e = lane & 31, half = lane >> 5;
        float acc = 0.f;
        for (int k = half * 512; k < half * 512 + 512; ++k) acc += hrow[k] * rw[(size_t)k * NE + e];
        acc += __shfl_xor(acc, 32);
        const float logit = acc + rb[e];
        float lg[32];
#pragma unroll
        for (int i = 0; i < 32; ++i) lg[i] = __shfl(logit, i);
        int s0i = 0, s1i = 0, s2i = 0, s3i = 0; float a0 = -3e38f, a1 = -3e38f, a2 = -3e38f, a3 = -3e38f;
#pragma unroll
        for (int i = 0; i < 32; ++i) if (lg[i] > a0) { a0 = lg[i]; s0i = i; }
#pragma unroll
        for (int i = 0; i < 32; ++i) if (i != s0i && lg[i] > a1) { a1 = lg[i]; s1i = i; }
#pragma unroll
        for (int i = 0; i < 32; ++i) if (i != s0i && i != s1i && lg[i] > a2) { a2 = lg[i]; s2i = i; }
#pragma unroll
        for (int i = 0; i < 32; ++i) if (i != s0i && i != s1i && i != s2i && lg[i] > a3) { a3 = lg[i]; s3i = i; }
        const float e0 = 1.f, e1 = __expf(a1 - a0), e2 = __expf(a2 - a0), e3 = __expf(a3 - a0);
        const float inv = 1.f / (((e0 + e1) + e2) + e3);
        if (lane == 0) {
            toke[t * 4 + 0] = s0i; toke[t * 4 + 1] = s1i; toke[t * 4 + 2] = s2i; toke[t * 4 + 3] = s3i;
            tokw[t * 4 + 0] = e0 * inv; tokw[t * 4 + 1] = e1 * inv; tokw[t * 4 + 2] = e2 * inv; tokw[t * 4 + 3] = e3 * inv;
            if (commit) { atomicAdd(&hist[s0i], 1); atomicAdd(&hist[s1i], 1); atomicAdd(&hist[s2i], 1); atomicAdd(&hist[s3i], 1); }
        }
        __builtin_amdgcn_wave_barrier();
    }
    __syncthreads();
    if (tid < 32 && hist[tid] != 0) atomicAdd(&cnt[tid], hist[tid]);
}

__device__ __forceinline__ void load_pstart(const Params& p, int l, int* ps) {
    const int* cnt = (const int*)(p.ws + WS_CNT) + l * 32;
    if (otid() == 0) { int s = 0; for (int e = 0; e < 32; ++e) { ps[e] = s; s += (cnt[e] + 255) & ~255; } ps[32] = s; }
    __syncthreads();
}

__device__ __forceinline__ void phase_sc(const Params& p, int l, float* lds) {
    int* ps = (int*)lds;
    load_pstart(p, l, ps);
    const int gtid = blockIdx.x * NT + otid(), gsz = gridDim.x * NT;
    const int* toke = (const int*)(p.ws + WS_TOKE); const float* tokw = (const float*)(p.ws + WS_TOKW);
    int* fill = (int*)(p.ws + WS_FILL) + l * 32; int* rowtok = (int*)(p.ws + WS_ROWTOK) + (size_t)l * RMAX; float* roww = (float*)(p.ws + WS_ROWW) + (size_t)l * RMAX;
    int* pos = (int*)(p.ws + WS_POS);
    for (int i = gtid; i < A_TOT; i += gsz) {
        const int e = toke[i];
        const int slot = ps[e] + atomicAdd(&fill[e], 1);
        rowtok[slot] = i >> 2; roww[slot] = tokw[i]; pos[i] = slot;
    }
    __syncthreads();
}

__device__ __forceinline__ void phase_m1(const Params& p, int l, float* lds) {
    int* ps = (int*)(lds + 16 * 132 + 16 * 68);
    load_pstart(p, l, ps);
    const int rused = ps[32];
    const float* H = (const float*)(p.ws + WS_H); float* U = (float*)(p.ws + WS_U);
    const int* rowtok = (const int*)(p.ws + WS_ROWTOK) + (size_t)l * RMAX;
    const int ntm = rused / 128, ntn = 2048 / 64;
    for (int tile = blockIdx.x; tile < ntm * ntn; tile += gridDim.x) {
        const int tm = tile / ntn, tn = tile % ntn;
        int e = 0; for (int i = 1; i < 32; ++i) if (ps[i] <= tm * 128) e = i;
        const float* W = p.in[17] + ((size_t)l * NE + e) * D * 2048; const float* b1 = p.in[18] + ((size_t)l * NE + e) * 2048;
        auto al = [=](int r, int k) -> float4 { const int tk = rowtok[r]; return tk >= 0 ? *(const float4*)(H + (size_t)tk * D + k) : make_float4(0.f, 0.f, 0.f, 0.f); };
        auto bl = [=](int k, int n) -> float2 { return *(const float2*)(W + (size_t)k * 2048 + n); };
        auto ep = [=](int r, int c, float v) { U[(size_t)r * 2048 + c] = v + b1[c]; };
        gemm_tile(lds, tm * 128, tn * 64, D, al, bl, ep);
    }
    __syncthreads();
}
__device__ __forceinline__ void phase_m2(const Params& p, int l, float* lds) {
    int* ps = (int*)(lds + 16 * 132 + 16 * 68);
    load_pstart(p, l, ps);
    const int rused = ps[32];
    const float* U = (const float*)(p.ws + WS_U); float* Y = (float*)(p.ws + WS_Y);
    const float* roww = (const float*)(p.ws + WS_ROWW) + (size_t)l * RMAX;
    const int ntm = rused / 128, ntn = D / 64;
    for (int tile = blockIdx.x; tile < ntm * ntn; tile += gridDim.x) {
        const int tm = tile / ntn, tn = tile % ntn;
        int e = 0; for (int i = 1; i < 32; ++i) if (ps[i] <= tm * 128) e = i;
        const float* W = p.in[19] + ((size_t)l * NE + e) * DFF * D; const float* b2 = p.in[20] + ((size_t)l * NE + e) * D;
        auto al = [=](int r, int k) -> float4 {
            const float4 gg = *(const float4*)(U + (size_t)r * 2048 + k), ll = *(const float4*)(U + (size_t)r * 2048 + 1024 + k);
            const float g_[4] = {gg.x, gg.y, gg.z, gg.w}, l_[4] = {ll.x, ll.y, ll.z, ll.w}; float o_[4];
#pragma unroll
            for (int i = 0; i < 4; ++i) { const float gc = fminf(g_[i], 7.f), lc = fminf(fmaxf(l_[i], -7.f), 7.f); o_[i] = (lc + 1.f) * gc * sigmoidf_(1.702f * gc); }
            return make_float4(o_[0], o_[1], o_[2], o_[3]);
        };
        auto bl = [=](int k, int n) -> float2 { return *(const float2*)(W + (size_t)k * D + n); };
        auto ep = [=](int r, int c, float v) { Y[(size_t)r * D + c] = (v + b2[c]) * roww[r]; };
        gemm_tile(lds, tm * 128, tn * 64, DFF, al, bl, ep);
    }
    __syncthreads();
}


template <int MAP>
__device__ __forceinline__ void tr_tile(const float* W, int Nsrc, bf16_t* WT, int K, int k0, int n0, float* scr, int lane) {
    const int nl = (lane & 15) * 4, kr = lane >> 4;
    int sc = n0 + nl;
    if (MAP == 1) { sc = sc < 1280 ? sc : (sc < 2816 ? sc + 24 : (sc < 2840 ? sc - 2816 + 1280 : -1)); }
    float4 v[16];
#pragma unroll
    for (int it = 0; it < 16; ++it) v[it] = sc >= 0 ? *(const float4*)(W + (size_t)(k0 + it * 4 + kr) * Nsrc + sc) : make_float4(0.f, 0.f, 0.f, 0.f);
#pragma unroll
    for (int it = 0; it < 16; ++it) { float* s = scr + (it * 4 + kr) * 65 + nl; s[0] = v[it].x; s[1] = v[it].y; s[2] = v[it].z; s[3] = v[it].w; }
    asm volatile("s_waitcnt lgkmcnt(0)" ::: "memory"); __builtin_amdgcn_wave_barrier();
    const int c = lane & 7, nr = lane >> 3;
#pragma unroll
    for (int it = 0; it < 8; ++it) {
        const int n = it * 8 + nr; const float* s = scr + (8 * c) * 65 + n;
        uint4 o; o.x = pk2(s[0], s[65]); o.y = pk2(s[2 * 65], s[3 * 65]); o.z = pk2(s[4 * 65], s[5 * 65]); o.w = pk2(s[6 * 65], s[7 * 65]);
        *(uint4*)(WT + (size_t)(n0 + n) * K + k0 + 8 * c) = o;
    }
    asm volatile("s_waitcnt lgkmcnt(0)" ::: "memory"); __builtin_amdgcn_wave_barrier();
}
__device__ __forceinline__ void phase_convert(const Params& p, float* lds) {
    const int tid = otid(), lane = tid & 63, wave = tid >> 6;
    float* scr = lds + wave * (64 * 65);
    const int gw = blockIdx.x * NW + wave, ngw = gridDim.x * NW;
    bf16_t* WinT = (bf16_t*)(p.ws + WS_WINT); bf16_t* WoT = (bf16_t*)(p.ws + WS_WOT); bf16_t* W1T = (bf16_t*)(p.ws + WS_W1T); bf16_t* W2T = (bf16_t*)(p.ws + WS_W2T);
    constexpr int I_IN = L * 16 * (ZBW / 64), I_O = L * 16 * 16, I_1 = L * NE * 16 * 32, I_2 = L * NE * 16 * 16, I_C = L * 2 * 32 * 2;
    for (int it = gw; it < I_C + I_IN + I_O + I_1 + I_2; it += ngw) {
        int r = it;
        if (r < I_C) { const int li = r / 64, q = r % 64, kb = q / 2, nb = q % 2;
            tr_tile<0>(p.in[10] + (size_t)li * 2048 * 128, 128, (bf16_t*)(p.ws + WS_WCT) + (size_t)li * 128 * 2048, 2048, kb * 64, nb * 64, scr, lane); continue; }
        r -= I_C;
        if (r < I_IN) { const int l = r / (16 * 48), q = r % (16 * 48), kb = q / 48, nb = q % 48;
            tr_tile<1>(p.in[6] + (size_t)l * D * INW, INW, WinT + (size_t)l * ZBW * D, D, kb * 64, nb * 64, scr, lane); continue; }
        r -= I_IN;
        if (r < I_O) { const int l = r / 256, q = r % 256, kb = q / 16, nb = q % 16;
            tr_tile<0>(p.in[14] + (size_t)l * D * D, D, WoT + (size_t)l * D * D, D, kb * 64, nb * 64, scr, lane); continue; }
        r -= I_O;
        if (r < I_1) { const int le = r / 512, q = r % 512, kb = q / 32, nb = q % 32;
            tr_tile<0>(p.in[17] + (size_t)le * D * 2048, 2048, W1T + (size_t)le * 2048 * D, D, kb * 64, nb * 64, scr, lane); continue; }
        r -= I_1;
        { const int le = r / 256, q = r % 256, kb = q / 16, nb = q % 16;
            tr_tile<0>(p.in[19] + (size_t)le * DFF * D, D, W2T + (size_t)le * D * DFF, DFF, kb * 64, nb * 64, scr, lane); }
    }
    if (blockIdx.x == 0) { bf16_t* XN = (bf16_t*)(p.ws + WS_XN); for (int i = tid; i < D / 2; i += NT) ((unsigned*)(XN + (size_t)T * D))[i] = 0u; }
}

namespace pg8 {
#define PG8_LAS __attribute__((address_space(3)))
typedef short bf16x8 __attribute__((ext_vector_type(8)));
typedef float f32x4 __attribute__((ext_vector_type(4)));
typedef unsigned u32x4 __attribute__((ext_vector_type(4)));
constexpr int BM = 256, BK = 64, HALF = 128, HTB = HALF * BK * 2, STAGE_BYTES = 8 * HTB, NXCD = 8, WGM = 8;
__device__ __forceinline__ int lds_byte(int r, int c) { const int st = (r >> 4) * 2 + (c >> 5), rr = r & 15, cc = c & 31, ob = rr * 64 + cc * 2; return st * 1024 + (ob ^ (((ob >> 9) & 1) << 5)); }
__device__ __forceinline__ void stage_rc(int b, int& R, int& C) { const int st = b / 1024, sb = b % 1024, swz = sb ^ (((sb >> 9) & 1) << 5); R = (st >> 1) * 16 + swz / 64; C = (st & 1) * 32 + (swz % 64) / 2; }
__device__ __forceinline__ int perm32(int rho) { const int n = rho >> 4, i = rho & 15; return 8 * (i >> 2) + 4 * n + (i & 3); }
struct Unit { int pm, pn, e; };
__device__ __forceinline__ unsigned cvt_pk_bf16(float lo, float hi) { unsigned r; asm volatile("v_cvt_pk_bf16_f32 %0, %1, %2" : "=v"(r) : "v"(lo), "v"(hi)); return r; }

__device__ __forceinline__ bool static_next(int nM, int nN, int G, int c, int i, Unit& u) {
    const int nwg = nM * nN; const long Lq = (long)i * G + c; if (Lq >= nwg) return false;
    int wgid = (int)Lq; { const int q = nwg / NXCD, r = nwg % NXCD, xcd = wgid % NXCD, off = wgid / NXCD; wgid = (xcd < r ? xcd * (q + 1) : r * (q + 1) + (xcd - r) * q) + off; }
    const int nig = WGM * nN, gid = wgid / nig, fm = gid * WGM, gsz = (nM - fm) < WGM ? (nM - fm) : WGM;
    u.pm = fm + ((wgid % nig) % gsz); u.pn = (wgid % nig) / gsz; u.e = 0; return true;
}

template <class Prob, class Epi, bool ALIGN_EPI, bool SP2>
__device__ __forceinline__ void gemm_phase(PG8_LAS unsigned char* lds, const Prob& P, const Epi& E) {
    const int tid = otid(), wid = __builtin_amdgcn_readfirstlane(tid >> 6), lane = tid & 63, wr = wid >> 2, wc = wid & 3, fr = lane & 15, fq = lane >> 4;
    const int K = P.K, nt = K / BK;
    int sR[2], sC[2]; unsigned voffB[2];
#pragma unroll
    for (int i = 0; i < 2; ++i) { stage_rc(tid * 16 + i * 8192, sR[i], sC[i]); voffB[i] = (unsigned)(P.b_row(sR[i]) * K + sC[i]) * 2u; }
    const size_t kstep = (size_t)(BK * 2);
    const size_t kstepA = P.a_kstep();
    const size_t hstepB = P.b_hstep();
    const unsigned ldsw = (unsigned)wid * 1024u;
    const int aoff = lds_byte(wr * 64 + fr, fq * 8), boff = lds_byte(wc * 32 + fr, fq * 8);
#define PG8_SA(b, h) (((b) * 2 + (h)) * HTB)
#define PG8_SB(b, h) ((4 + (b) * 2 + (h)) * HTB)
#define PG8_STAGE(bufoff, gbase, voff) do { _Pragma("unroll") for (int _i = 0; _i < 2; ++_i) \
        __builtin_amdgcn_global_load_lds((const unsigned*)((const char*)(gbase) + (voff)[_i]), (PG8_LAS unsigned*)(lds + (bufoff) + ldsw + _i * 8192), 16, 0, 0); } while (0)
#define PG8_STAGE_SEL(bufoff, gbase, h) do { _Pragma("unroll") for (int _i = 0; _i < 2; ++_i) { unsigned _vo = vAc[h][_i]; if constexpr (Prob::GATHER) _vo = last ? vAn[h][_i] : _vo; \
        __builtin_amdgcn_global_load_lds((const unsigned*)((const char*)(gbase) + _vo), (PG8_LAS unsigned*)(lds + (bufoff) + ldsw + _i * 8192), 16, 0, 0); } } while (0)
#define PG8_LDA(dst, b, h) do { _Pragma("unroll") for (int m = 0; m < 4; ++m) _Pragma("unroll") for (int k = 0; k < 2; ++k) dst[m][k] = *(const PG8_LAS bf16x8*)(lds + PG8_SA(b, h) + aoff + m * 2048 + k * 1024); } while (0)
#define PG8_LDB(dst, b, h) do { _Pragma("unroll") for (int n = 0; n < 2; ++n) _Pragma("unroll") for (int k = 0; k < 2; ++k) dst[n][k] = *(const PG8_LAS bf16x8*)(lds + PG8_SB(b, h) + boff + n * 2048 + k * 1024); } while (0)
#define PG8_MMA(ai, bj, At, Bt) do { __builtin_amdgcn_s_setprio(1); _Pragma("unroll") for (int m = 0; m < 4; ++m) _Pragma("unroll") for (int n = 0; n < 2; ++n) _Pragma("unroll") for (int k = 0; k < 2; ++k) \
        acc[ai][bj][m][n] = __builtin_amdgcn_mfma_f32_16x16x32_bf16(Bt[n][k], At[m][k], acc[ai][bj][m][n], 0, 0, 0); __builtin_amdgcn_s_setprio(0); } while (0)
#define PG8_WAIT_V(n) asm volatile("s_waitcnt vmcnt(" #n ")" ::: "memory")
#define PG8_WAIT_L(n) asm volatile("s_waitcnt lgkmcnt(" #n ")" ::: "memory")
#define PG8_BAR __builtin_amdgcn_s_barrier()
#define PG8_SCHED __builtin_amdgcn_sched_barrier(0)
    Unit cur, nxt; int ui = 0;
    if (!P.next(0, cur)) return;
    f32x4 acc[2][2][4][2];
#pragma unroll
    for (int a = 0; a < 2; ++a)
#pragma unroll
        for (int b = 0; b < 2; ++b)
#pragma unroll
            for (int m = 0; m < 4; ++m)
#pragma unroll
                for (int n = 0; n < 2; ++n) acc[a][b][m][n] = (f32x4){0.f, 0.f, 0.f, 0.f};
    bf16x8 At[4][2], B0[2][2], B1[2][2];
    unsigned vAc[2][2], vAn[2][2];
    const char* cA = P.a_base(cur); const char* cB = P.b_base(cur);
    P.a_voff(cur, sR, sC, vAc);
#pragma unroll
    for (int h = 0; h < 2; ++h)
#pragma unroll
        for (int i = 0; i < 2; ++i) vAn[h][i] = vAc[h][i];
    if constexpr (SP2) {
        PG8_STAGE(PG8_SB(0, 0), cB, voffB); PG8_STAGE(PG8_SB(0, 1), cB + hstepB, voffB); PG8_STAGE(PG8_SA(0, 0), cA, vAc[0]); PG8_STAGE(PG8_SA(0, 1), cA, vAc[1]);
        if (wr == 1) PG8_BAR;
        PG8_WAIT_V(2); PG8_BAR;
        PG8_STAGE(PG8_SB(1, 0), cB + kstep, voffB); PG8_STAGE(PG8_SA(1, 0), cA + kstepA, vAc[0]); PG8_STAGE(PG8_SB(1, 1), cB + hstepB + kstep, voffB);
        PG8_WAIT_V(6); PG8_BAR;
    } else {
        PG8_STAGE(PG8_SB(0, 0), cB, voffB); PG8_STAGE(PG8_SA(0, 0), cA, vAc[0]); PG8_STAGE(PG8_SB(0, 1), cB + hstepB, voffB); PG8_STAGE(PG8_SA(0, 1), cA, vAc[1]);
        if (wr == 1) PG8_BAR;
        PG8_WAIT_V(4); PG8_BAR;
        PG8_STAGE(PG8_SB(1, 0), cB + kstep, voffB); PG8_STAGE(PG8_SA(1, 0), cA + kstepA, vAc[0]); PG8_STAGE(PG8_SB(1, 1), cB + hstepB + kstep, voffB);
        PG8_WAIT_V(6); PG8_BAR;
    }
    for (;;) {
        const bool has_next = P.next(ui + 1, nxt);
        const char* nA = cA; const char* nB = cB;
        if (has_next) { nA = P.a_base(nxt); nB = P.b_base(nxt); if constexpr (Prob::GATHER) P.a_voff(nxt, sR, sC, vAn); }
        for (int t = 0; t < nt; t += 2) {
            const bool last = (t == nt - 2);
            const char* a1 = cA + (size_t)(t + 1) * kstepA;
            const char* a2 = last ? nA : cA + (size_t)(t + 2) * kstepA; const char* b2 = last ? nB : cB + (size_t)(t + 2) * kstep;
            const char* a3 = a2 + kstepA; const char* b3 = b2 + kstep;
            if constexpr (SP2) {
            PG8_LDB(B0, 0, 0); PG8_LDB(B1, 0, 1); PG8_SCHED; PG8_LDA(At, 0, 0); PG8_STAGE(PG8_SA(1, 1), a1, vAc[1]);
            PG8_WAIT_V(8); PG8_WAIT_L(0); PG8_BAR; PG8_MMA(0, 0, At, B0); PG8_MMA(0, 1, At, B1); PG8_BAR; PG8_SCHED;
            PG8_LDA(At, 0, 1); PG8_STAGE(PG8_SB(0, 0), b2, voffB); PG8_STAGE(PG8_SB(0, 1), b2 + hstepB, voffB); PG8_STAGE_SEL(PG8_SA(0, 0), a2, 0);
            PG8_WAIT_V(8); PG8_WAIT_L(0); PG8_BAR; PG8_MMA(1, 0, At, B0); PG8_MMA(1, 1, At, B1); PG8_BAR; PG8_SCHED;
            PG8_LDB(B0, 1, 0); PG8_LDB(B1, 1, 1); PG8_SCHED; PG8_LDA(At, 1, 0); PG8_STAGE_SEL(PG8_SA(0, 1), a2, 1);
            PG8_WAIT_V(8); PG8_WAIT_L(0); PG8_BAR; PG8_MMA(0, 0, At, B0); PG8_MMA(0, 1, At, B1); PG8_BAR; PG8_SCHED;
            PG8_LDA(At, 1, 1); PG8_STAGE(PG8_SB(1, 0), b3, voffB); PG8_STAGE(PG8_SB(1, 1), b3 + hstepB, voffB); PG8_STAGE_SEL(PG8_SA(1, 0), a3, 0);
            PG8_WAIT_V(8); PG8_WAIT_L(0); PG8_BAR; PG8_MMA(1, 0, At, B0); PG8_MMA(1, 1, At, B1); PG8_BAR; PG8_SCHED;
            } else {
            PG8_LDB(B0, 0, 0); PG8_SCHED; PG8_LDA(At, 0, 0); PG8_STAGE(PG8_SA(1, 1), a1, vAc[1]);
            PG8_WAIT_L(8); PG8_BAR; PG8_WAIT_L(0); PG8_MMA(0, 0, At, B0); PG8_BAR; PG8_SCHED;
            PG8_LDB(B1, 0, 1); PG8_STAGE(PG8_SB(0, 0), b2, voffB);
            PG8_BAR; PG8_WAIT_L(0); PG8_MMA(0, 1, At, B1); PG8_BAR;
            PG8_LDA(At, 0, 1); PG8_STAGE_SEL(PG8_SA(0, 0), a2, 0);
            PG8_BAR; PG8_WAIT_L(0); PG8_MMA(1, 0, At, B0); PG8_BAR; PG8_SCHED;
            PG8_STAGE(PG8_SB(0, 1), b2 + hstepB, voffB);
            PG8_WAIT_V(6); PG8_BAR; PG8_MMA(1, 1, At, B1); PG8_BAR;
            PG8_LDB(B0, 1, 0); PG8_SCHED; PG8_LDA(At, 1, 0); PG8_STAGE_SEL(PG8_SA(0, 1), a2, 1);
            PG8_WAIT_L(8); PG8_BAR; PG8_WAIT_L(0); PG8_MMA(0, 0, At, B0); PG8_BAR; PG8_SCHED;
            PG8_LDB(B1, 1, 1); PG8_STAGE(PG8_SB(1, 0), b3, voffB);
            PG8_BAR; PG8_WAIT_L(0); PG8_MMA(0, 1, At, B1); PG8_BAR;
            PG8_LDA(At, 1, 1); PG8_STAGE_SEL(PG8_SA(1, 0), a3, 0);
            PG8_BAR; PG8_WAIT_L(0); PG8_MMA(1, 0, At, B0); PG8_BAR; PG8_SCHED;
            PG8_STAGE(PG8_SB(1, 1), b3 + hstepB, voffB);
            PG8_WAIT_V(6); PG8_BAR; PG8_MMA(1, 1, At, B1); PG8_BAR;
            }
        }
        if constexpr (ALIGN_EPI) { if (wr == 0) PG8_BAR; }
        E(acc, cur, wr, wc, fr, fq);
        if (!has_next) break;
#pragma unroll
        for (int a = 0; a < 2; ++a)
#pragma unroll
            for (int b = 0; b < 2; ++b)
#pragma unroll
                for (int m = 0; m < 4; ++m)
#pragma unroll
                    for (int n = 0; n < 2; ++n) acc[a][b][m][n] = (f32x4){0.f, 0.f, 0.f, 0.f};
        cur = nxt; cA = nA; cB = nB; ++ui;
        if constexpr (Prob::GATHER) {
#pragma unroll
            for (int h = 0; h < 2; ++h)
#pragma unroll
                for (int i = 0; i < 2; ++i) vAc[h][i] = vAn[h][i];
        }
        if constexpr (ALIGN_EPI) { if (wr == 1) PG8_BAR; }
    }
    PG8_WAIT_V(0);
    if constexpr (!ALIGN_EPI) { if (wr == 0) PG8_BAR; }
    PG8_BAR;
#undef PG8_SA
#undef PG8_SB
#undef PG8_STAGE
#undef PG8_STAGE_SEL
#undef PG8_LDA
#undef PG8_LDB
#undef PG8_MMA
#undef PG8_WAIT_V
#undef PG8_WAIT_L
#undef PG8_BAR
#undef PG8_SCHED
}

struct ProbDense { static constexpr bool GATHER = false; static constexpr int KT = 0;
    const bf16_t* A; const bf16_t* Bt; int K, nM, nN, G, c; bool headperm;
    __device__ __forceinline__ bool next(int i, Unit& u) const { return static_next(nM, nN, G, c, i, u); }
    __device__ __forceinline__ const char* a_base(const Unit& u) const { return (const char*)(A + (size_t)u.pm * BM * K); }
    __device__ __forceinline__ void a_voff(const Unit&, const int (&R)[2], const int (&C)[2], unsigned (&v)[2][2]) const {
#pragma unroll
        for (int h = 0; h < 2; ++h)
#pragma unroll
            for (int i = 0; i < 2; ++i) v[h][i] = (unsigned)((h * HALF + R[i]) * K + C[i]) * 2u;
    }
    __device__ __forceinline__ const char* b_base(const Unit& u) const { return (const char*)(Bt + (size_t)u.pn * BM * K); }
    __device__ __forceinline__ size_t a_kstep() const { return (size_t)BK * 2; }
    __device__ __forceinline__ size_t b_hstep() const { return headperm ? (size_t)32 * K * 2 : (size_t)HALF * K * 2; }
    __device__ __forceinline__ int b_row(int R) const { return headperm ? ((R >> 5) * 64 + perm32(R & 31)) : ((R & ~31) + perm32(R & 31)); }
};
typedef const PG8_LAS int* lds_ints;
__device__ __forceinline__ int expert_of(lds_ints ps, int pm) { int e = 0;
#pragma unroll
    for (int i = 1; i < 32; ++i) if (ps[i] <= pm * 256) e = i;
    return __builtin_amdgcn_readfirstlane(e); }
struct ProbMoe1 { static constexpr bool GATHER = true; static constexpr int KT = 0;
    const bf16_t* XN; const bf16_t* W1T; const int* rowtok; lds_ints ps; int K, ntm, G, c;
    __device__ __forceinline__ bool next(int i, Unit& u) const { const int q = i * G + c; if (q >= ntm * 8) return false; u.pm = q >> 3; u.pn = q & 7; u.e = expert_of(ps, u.pm); return true; }
    __device__ __forceinline__ const char* a_base(const Unit&) const { return (const char*)XN; }
    __device__ __forceinline__ void a_voff(const Unit& u, const int (&R)[2], const int (&C)[2], unsigned (&v)[2][2]) const {
#pragma unroll
        for (int h = 0; h < 2; ++h)
#pragma unroll
            for (int i = 0; i < 2; ++i) { int tk = rowtok[u.pm * BM + h * HALF + R[i]]; if (tk < 0) tk = T; v[h][i] = (unsigned)(tk * K + C[i]) * 2u; }
    }
    __device__ __forceinline__ const char* b_base(const Unit& u) const { return (const char*)(W1T + ((size_t)u.e * 2048 + u.pn * 128) * K); }
    __device__ __forceinline__ size_t a_kstep() const { return (size_t)BK * 2; }
    __device__ __forceinline__ size_t b_hstep() const { return (size_t)1024 * K * 2; }
    __device__ __forceinline__ int b_row(int R) const { return (R & ~31) + perm32(R & 31); }
};
struct ProbMoe2 { static constexpr bool GATHER = false; static constexpr int KT = 0;
    const bf16_t* ACT; const bf16_t* W2T; lds_ints ps; int K, ntm, G, c;
    __device__ __forceinline__ bool next(int i, Unit& u) const { const int q = i * G + c; if (q >= ntm * 4) return false; u.pm = q >> 2; u.pn = q & 3; u.e = expert_of(ps, u.pm); return true; }
    __device__ __forceinline__ const char* a_base(const Unit& u) const { return (const char*)(ACT + (size_t)u.pm * BM * K); }
    __device__ __forceinline__ void a_voff(const Unit&, const int (&R)[2], const int (&C)[2], unsigned (&v)[2][2]) const {
#pragma unroll
        for (int h = 0; h < 2; ++h)
#pragma unroll
            for (int i = 0; i < 2; ++i) v[h][i] = (unsigned)((h * HALF + R[i]) * K + C[i]) * 2u;
    }
    __device__ __forceinline__ const char* b_base(const Unit& u) const { return (const char*)(W2T + ((size_t)u.e * 1024 + u.pn * BM) * K); }
    __device__ __forceinline__ size_t a_kstep() const { return (size_t)BK * 2; }
    __device__ __forceinline__ size_t b_hstep() const { return (size_t)HALF * K * 2; }
    __device__ __forceinline__ int b_row(int R) const { return (R & ~31) + perm32(R & 31); }
};

struct ProbCmp { static constexpr bool GATHER = false; static constexpr int KT = 32;
    const bf16_t* ZB; const bf16_t* W1T; int K, G, c;
    __device__ __forceinline__ bool next(int i, Unit& u) const { const int q = i * G + c; if (q >= 16) return false; u.pm = q & 15; u.pn = 0; u.e = q >> 4; return true; }
    __device__ __forceinline__ const char* a_base(const Unit& u) const { const int idx = u.pm >> 3, bg = (u.pm >> 1) & 3, half = u.pm & 1;
        return (const char*)(ZB + ((size_t)(bg >> 1) * S + 16 * 256 * half + 8 * u.e) * ZBW + ZB_KC + idx * 128 + (bg & 1) * 64); }
    __device__ __forceinline__ void a_voff(const Unit&, const int (&R)[2], const int (&C)[2], unsigned (&v)[2][2]) const {
#pragma unroll
        for (int h = 0; h < 2; ++h)
#pragma unroll
            for (int i = 0; i < 2; ++i) v[h][i] = (unsigned)(16 * (h * HALF + R[i]) * ZBW + C[i]) * 2u;
    }
    __device__ __forceinline__ size_t a_kstep() const { return (size_t)ZBW * 2; }
    __device__ __forceinline__ const char* b_base(const Unit& u) const { return (const char*)(W1T + (size_t)(u.pm >> 3) * 128 * K + 8 * 64 * u.e); }
    __device__ __forceinline__ size_t b_hstep() const { return 0; }
    __device__ __forceinline__ int b_row(int R) const { return (R & ~31) + perm32(R & 31); }
};
struct EpiCmp {
    float* HIDP;
    __device__ __forceinline__ void operator()(const f32x4 (&acc)[2][2][4][2], const Unit& u, int wr, int wc, int fr, int fq) const {
        const int idx = u.pm >> 3, bg = (u.pm >> 1) & 3, half = u.pm & 1;
        const int c0 = 32 * wc + 8 * fq;
#pragma unroll
        for (int ai = 0; ai < 2; ++ai)
#pragma unroll
            for (int m = 0; m < 4; ++m) { const int n = 256 * half + ai * HALF + wr * 64 + m * 16 + fr;
                if (n < 511) { float* dst = HIDP + (((size_t)u.e * 2 + idx) * 2044 + bg * 511 + n) * 128 + c0;
                    *(f32x4*)dst = acc[ai][0][m][0]; *(f32x4*)(dst + 4) = acc[ai][0][m][1]; } }
    }
};
struct EpiG1Z {
    float* Z;
    __device__ __forceinline__ void operator()(const f32x4 (&acc)[2][2][4][2], const Unit& u, int wr, int wc, int fr, int fq) const {
#pragma unroll
        for (int ai = 0; ai < 2; ++ai)
#pragma unroll
            for (int m = 0; m < 4; ++m) { const size_t r = (size_t)u.pm * BM + ai * HALF + wr * 64 + m * 16 + fr;
#pragma unroll
                for (int bj = 0; bj < 2; ++bj)
#pragma unroll
                    for (int n = 0; n < 2; ++n) { const int zc = u.pn * BM + 64 * wc + 32 * bj + 8 * fq + 4 * n;
                        const int col = zc < 1280 ? zc : (zc < 2816 ? zc + 24 : (zc < 2840 ? zc - 2816 + 1280 : -1));
                        if (col >= 0) *(f32x4*)(Z + r * INW + col) = acc[ai][bj][m][n]; } }
    }
};
struct EpiG1F {
    bf16_t* ZB; float* GATE; const float* gq; const float* gk; const float* gmq; const float* gmk;
    __device__ __forceinline__ void operator()(const f32x4 (&acc)[2][2][4][2], const Unit& u, int wr, int wc, int fr, int fq) const {
        const int pn = u.pn;
        const float* gain = nullptr; float sc = 1.f;
        if (pn < 2) { gain = gq; sc = QSCALE; }
        else if (pn == 3 || pn == 4) { if (wc < 2) gain = gk; }
        else if (pn == 5 || pn == 6) { gain = gmq; sc = QSCALE; }
        else if (pn == 7 || pn == 8) { gain = gmk; }
        if (pn == 11) {
            if (wc == 0 && fq < 3) {
#pragma unroll
                for (int ai = 0; ai < 2; ++ai)
#pragma unroll
                    for (int m = 0; m < 4; ++m) { const size_t r = (size_t)u.pm * BM + ai * HALF + wr * 64 + m * 16 + fr;
#pragma unroll
                        for (int n = 0; n < 2; ++n) { const f32x4 v = acc[ai][0][m][n]; f32x4 o;
#pragma unroll
                            for (int i = 0; i < 4; ++i) o[i] = 1.f / (1.f + __expf(-v[i]));
                            *(f32x4*)(GATE + r * 32 + 8 * fq + 4 * n) = o; } }
            }
            return;
        }
        f32x4 gv[2][2];
#pragma unroll
        for (int bj = 0; bj < 2; ++bj)
#pragma unroll
            for (int n = 0; n < 2; ++n) gv[bj][n] = gain ? *(const f32x4*)(gain + 32 * bj + 8 * fq + 4 * n) * sc : (f32x4){1.f, 1.f, 1.f, 1.f};
#pragma unroll
        for (int ai = 0; ai < 2; ++ai)
#pragma unroll
            for (int m = 0; m < 4; ++m) { const size_t r = (size_t)u.pm * BM + ai * HALF + wr * 64 + m * 16 + fr;
                float rs = 1.f;
                if (gain) { float ss = 0.f;
#pragma unroll
                    for (int bj = 0; bj < 2; ++bj)
#pragma unroll
                        for (int n = 0; n < 2; ++n) { const f32x4 v = acc[ai][bj][m][n]; ss += (v[0] * v[0] + v[1] * v[1]) + (v[2] * v[2] + v[3] * v[3]); }
                    ss += __shfl_xor(ss, 16); ss += __shfl_xor(ss, 32);
                    rs = rsqrtf(ss * (1.f / 64.f) + EPS); }
#pragma unroll
                for (int bj = 0; bj < 2; ++bj) { const f32x4 a = acc[ai][bj][m][0] * gv[bj][0] * rs, b = acc[ai][bj][m][1] * gv[bj][1] * rs;
                    u32x4 w; w.x = cvt_pk_bf16(a[0], a[1]); w.y = cvt_pk_bf16(a[2], a[3]); w.z = cvt_pk_bf16(b[0], b[1]); w.w = cvt_pk_bf16(b[2], b[3]);
                    *(u32x4*)(ZB + r * ZBW + pn * BM + 64 * wc + 32 * bj + 8 * fq) = w; } }
    }
};
struct EpiG2 {
    const float* xin; float* XA; const float* g1;
    __device__ __forceinline__ void operator()(const f32x4 (&acc)[2][2][4][2], const Unit& u, int wr, int wc, int fr, int fq) const {
#pragma unroll
        for (int ai = 0; ai < 2; ++ai)
#pragma unroll
            for (int m = 0; m < 4; ++m) { const size_t r = (size_t)u.pm * BM + ai * HALF + wr * 64 + m * 16 + fr; const int b = (int)(r / S);
#pragma unroll
                for (int bj = 0; bj < 2; ++bj)
#pragma unroll
                    for (int n = 0; n < 2; ++n) { const int c = u.pn * BM + 128 * bj + 32 * wc + 8 * fq + 4 * n;
                        const f32x4 x = *(const f32x4*)(xin + r * D + c), g = *(const f32x4*)(g1 + (size_t)b * 6144 + c);
                        *(f32x4*)(XA + r * D + c) = x + g * acc[ai][bj][m][n]; } }
    }
};
struct EpiM1 {
    bf16_t* ACT; const float* b1l;
    __device__ __forceinline__ void operator()(const f32x4 (&acc)[2][2][4][2], const Unit& u, int wr, int wc, int fr, int fq) const {
        const float* b1 = b1l + (size_t)u.e * 2048;
        const int c0 = u.pn * 128 + 32 * wc + 8 * fq;
        f32x4 bg[2], bl[2];
#pragma unroll
        for (int n = 0; n < 2; ++n) { bg[n] = *(const f32x4*)(b1 + c0 + 4 * n); bl[n] = *(const f32x4*)(b1 + 1024 + c0 + 4 * n); }
#pragma unroll
        for (int ai = 0; ai < 2; ++ai)
#pragma unroll
            for (int m = 0; m < 4; ++m) { const size_t r = (size_t)u.pm * BM + ai * HALF + wr * 64 + m * 16 + fr;
                float o[8];
#pragma unroll
                for (int n = 0; n < 2; ++n) { const f32x4 g = acc[ai][0][m][n] + bg[n], li = acc[ai][1][m][n] + bl[n];
#pragma unroll
                    for (int i = 0; i < 4; ++i) { const float gc = fminf(g[i], 7.f), lc = fminf(fmaxf(li[i], -7.f), 7.f); o[4 * n + i] = (lc + 1.f) * gc * (1.f / (1.f + __expf(-1.702f * gc))); } }
                u32x4 w; w.x = cvt_pk_bf16(o[0], o[1]); w.y = cvt_pk_bf16(o[2], o[3]); w.z = cvt_pk_bf16(o[4], o[5]); w.w = cvt_pk_bf16(o[6], o[7]);
                *(u32x4*)(ACT + r * DFF + c0) = w; }
    }
};
struct EpiM2 {
    bf16_t* Y; const float* b2l; const float* roww;
    __device__ __forceinline__ void operator()(const f32x4 (&acc)[2][2][4][2], const Unit& u, int wr, int wc, int fr, int fq) const {
        const float* b2 = b2l + (size_t)u.e * D;
#pragma unroll
        for (int ai = 0; ai < 2; ++ai)
#pragma unroll
            for (int m = 0; m < 4; ++m) { const size_t r = (size_t)u.pm * BM + ai * HALF + wr * 64 + m * 16 + fr; const float w = roww[r];
#pragma unroll
                for (int bj = 0; bj < 2; ++bj) { const int c = u.pn * BM + 128 * bj + 32 * wc + 8 * fq;
                    const f32x4 v0 = (acc[ai][bj][m][0] + *(const f32x4*)(b2 + c)) * w, v1 = (acc[ai][bj][m][1] + *(const f32x4*)(b2 + c + 4)) * w;
                    u32x4 o; o.x = cvt_pk_bf16(v0[0], v0[1]); o.y = cvt_pk_bf16(v0[2], v0[3]); o.z = cvt_pk_bf16(v1[0], v1[1]); o.w = cvt_pk_bf16(v1[2], v1[3]);
                    *(u32x4*)(Y + r * D + c) = o; } }
    }
};
}

__device__ __forceinline__ void phase_g1_fast(const Params& p, int l, unsigned char* lds_raw) {
    pg8::ProbDense P{(const bf16_t*)(p.ws + WS_XN), (const bf16_t*)(p.ws + WS_WINT) + (size_t)l * ZBW * D, D, T / 256, ZBW / 256, (int)gridDim.x, (int)blockIdx.x, true};
    pg8::EpiG1F E{(bf16_t*)(p.ws + WS_ZB), (float*)(p.ws + WS_GATE), p.in[7] + l * 64, p.in[8] + l * 64, p.in[12] + l * 64, p.in[13] + l * 64};
    pg8::gemm_phase<pg8::ProbDense, pg8::EpiG1F, true, true>((PG8_LAS unsigned char*)lds_raw, P, E);
}
__device__ __forceinline__ void phase_g2_fast(const Params& p, int l, unsigned char* lds_raw) {
    pg8::ProbDense P{(const bf16_t*)(p.ws + WS_ATTB), (const bf16_t*)(p.ws + WS_WOT) + (size_t)l * D * D, D, T / 256, D / 256, (int)gridDim.x, (int)blockIdx.x, false};
    pg8::EpiG2 E{l == 0 ? p.in[0] : p.out, p.out, (const float*)(p.ws + WS_MOD) + (size_t)l * Bn * 6144 + 2 * D};
    pg8::gemm_phase<pg8::ProbDense, pg8::EpiG2, true, true>((PG8_LAS unsigned char*)lds_raw, P, E);
}
constexpr int LDS_PS_OFF = 131072;
__device__ __forceinline__ void phase_ck_fast(const Params& p, int l, unsigned char* lds_raw) {
    pg8::ProbCmp P{(const bf16_t*)(p.ws + WS_ZB), (const bf16_t*)(p.ws + WS_WCT) + (size_t)l * 2 * 128 * 2048, 2048, (int)gridDim.x, (int)blockIdx.x};
    pg8::EpiCmp E{(float*)(p.ws + WS_HIDP)};
    pg8::gemm_phase<pg8::ProbCmp, pg8::EpiCmp, true, true>((PG8_LAS unsigned char*)lds_raw, P, E);
    const int lane = otid() & 63, wave = otid() >> 6;
    const bf16_t* Z = (const bf16_t*)(p.ws + WS_ZB); bf16_t* KMB = (bf16_t*)(p.ws + WS_KMB);
    for (int it = blockIdx.x * NW + wave; it < Bn * 8 * 32; it += gridDim.x * NW) {
        const int b = it / 256, h = (it / 32) & 7, blk = it & 31;
        const bf16_t* base = Z + (size_t)(b * S + blk * 256) * ZBW + ZB_MK + h * 64 + lane;
        float s0 = 0.f, s1 = 0.f, s2 = 0.f, s3 = 0.f;
        for (int i = 0; i < 256; i += 4) { s0 += bf2f(base[(size_t)i * ZBW]); s1 += bf2f(base[(size_t)(i + 1) * ZBW]); s2 += bf2f(base[(size_t)(i + 2) * ZBW]); s3 += bf2f(base[(size_t)(i + 3) * ZBW]); }
        KMB[(size_t)it * 64 + lane] = (bf16_t)f2bf(((s0 + s1) + (s2 + s3)) * (1.f / 256.f));
    }
}
__device__ __forceinline__ void phase_m1_fast(const Params& p, int l, unsigned char* lds_raw) {
    int* ps = (int*)(lds_raw + LDS_PS_OFF);
    load_pstart(p, l, ps);
    pg8::ProbMoe1 P{(const bf16_t*)(p.ws + WS_XN), (const bf16_t*)(p.ws + WS_W1T) + (size_t)l * NE * 2048 * D, (const int*)(p.ws + WS_ROWTOK) + (size_t)l * RMAX, (pg8::lds_ints)ps, D, ps[32] / 256, (int)gridDim.x, (int)blockIdx.x};
    pg8::EpiM1 E{(bf16_t*)(p.ws + WS_ACT), p.in[18] + (size_t)l * NE * 2048};
    pg8::gemm_phase<pg8::ProbMoe1, pg8::EpiM1, true, true>((PG8_LAS unsigned char*)lds_raw, P, E);
    __syncthreads();
}
__device__ __forceinline__ void phase_m2_fast(const Params& p, int l, unsigned char* lds_raw) {
    int* ps = (int*)(lds_raw + LDS_PS_OFF);
    load_pstart(p, l, ps);
    pg8::ProbMoe2 P{(const bf16_t*)(p.ws + WS_ACT), (const bf16_t*)(p.ws + WS_W2T) + (size_t)l * NE * D * DFF, (pg8::lds_ints)ps, DFF, ps[32] / 256, (int)gridDim.x, (int)blockIdx.x};
    pg8::EpiM2 E{(bf16_t*)(p.ws + WS_Y), p.in[20] + (size_t)l * NE * D, (const float*)(p.ws + WS_ROWW) + (size_t)l * RMAX};
    pg8::gemm_phase<pg8::ProbMoe2, pg8::EpiM2, true, true>((PG8_LAS unsigned char*)lds_raw, P, E);
    __syncthreads();
}

namespace at {
#define AT_LAS __attribute__((address_space(3)))
typedef short bf16x8 __attribute__((ext_vector_type(8)));
typedef short s16x4 __attribute__((ext_vector_type(4)));
typedef short v4i16_t __attribute__((ext_vector_type(4)));
typedef float f32x16 __attribute__((ext_vector_type(16)));
typedef unsigned u32x4 __attribute__((ext_vector_type(4)));
typedef float f32x2_t __attribute__((ext_vector_type(2))); typedef __bf16 bf16x2_t __attribute__((ext_vector_type(2)));
typedef AT_LAS unsigned char* lp;
constexpr int L_K = 0  , L_V = 32768  , L_WSF = 65536, L_OST = 67584  , L_SELM = 133120, L_UNI = 134144, L_KMT = 134400, L_END = 142592;
constexpr float NEGS = -1e30f;
__device__ __forceinline__ int crow(int r, int hi) { return (r & 3) + 8 * (r >> 2) + 4 * hi; }
__device__ __forceinline__ unsigned cvtpk(float lo, float hi) { f32x2_t v = {lo, hi}; bf16x2_t b = __builtin_convertvector(v, bf16x2_t); return __builtin_bit_cast(unsigned, b); }
__device__ __forceinline__ float mx3(float a, float b, float c) { return __builtin_fmaxf(__builtin_fmaxf(a, b), c); }
__device__ __forceinline__ void wsync() { asm volatile("s_waitcnt lgkmcnt(0)" ::: "memory"); __builtin_amdgcn_wave_barrier(); }
__device__ __forceinline__ void bar() { __builtin_amdgcn_s_barrier(); }
#define AT_WAITV(n) asm volatile("s_waitcnt vmcnt(" #n ")" ::: "memory")
#define AT_WAITL() asm volatile("s_waitcnt lgkmcnt(0)" ::: "memory")
__device__ __forceinline__ void glds(const void* g, lp dst) { __builtin_amdgcn_global_load_lds((const unsigned*)g, (AT_LAS unsigned*)dst, 16, 0, 0); }
__device__ __forceinline__ s16x4 vtr(const AT_LAS unsigned char* p) { return __builtin_bit_cast(s16x4, __builtin_amdgcn_ds_read_tr16_b64_v4i16((AT_LAS v4i16_t*)p)); }

__device__ __forceinline__ void dma_k(lp slot, const bf16_t* kbase, int pitch, int key0, int wid, int lane) { glds(kbase + (size_t)(key0 + lane) * pitch + wid * 8, slot + wid * 1024); }
__device__ __forceinline__ void dma_v(lp slot, const bf16_t* vbase, int pitch, int key0, int wid, int lane) {
    glds(vbase + (size_t)(key0 + 16 * (wid & 3) + (lane >> 2)) * pitch + (wid >> 2) * 32 + (lane & 3) * 8, slot + wid * 1024); }

__device__ __forceinline__ void qk_tile(f32x16& p0, f32x16& p1, lp kslot, const bf16x8 (&qr)[4], int r32, int hi) {
    const AT_LAS unsigned char* kb = kslot + hi * 1024 + r32 * 16;
#pragma unroll
    for (int d0 = 0; d0 < 4; ++d0) {
        const bf16x8 b0 = *(const AT_LAS bf16x8*)(kb + d0 * 2048), b1 = *(const AT_LAS bf16x8*)(kb + d0 * 2048 + 512);
        p0 = __builtin_amdgcn_mfma_f32_32x32x16_bf16(b0, qr[d0], p0, 0, 0, 0);
        p1 = __builtin_amdgcn_mfma_f32_32x32x16_bf16(b1, qr[d0], p1, 0, 0, 0);
    }
}
__device__ __forceinline__ void pv_tile(f32x16 (&o)[2], lp vslot, int lane, int hi, u32x4 pw0, u32x4 pw1, u32x4 pw2, u32x4 pw3) {
    const AT_LAS unsigned char* vp = vslot + ((lane >> 4) & 1) * 32 + (lane & 3) * 8 + (4 * hi + ((lane & 15) >> 2)) * 64;
    const bf16x8 pa[4] = {__builtin_bit_cast(bf16x8, pw0), __builtin_bit_cast(bf16x8, pw1), __builtin_bit_cast(bf16x8, pw2), __builtin_bit_cast(bf16x8, pw3)};
#pragma unroll
    for (int d0 = 0; d0 < 2; ++d0)
#pragma unroll
        for (int ks = 0; ks < 4; ++ks) {
            const s16x4 lo = vtr(vp + d0 * 4096 + ks * 1024), hh = vtr(vp + d0 * 4096 + ks * 1024 + 512);
            const bf16x8 vf = (bf16x8){lo[0], lo[1], lo[2], lo[3], hh[0], hh[1], hh[2], hh[3]};
            o[d0] = __builtin_amdgcn_mfma_f32_32x32x16_bf16(pa[ks], vf, o[d0], 0, 0, 0);
        }
}
__device__ __forceinline__ float rowmax(const f32x16& p0, const f32x16& p1) {
    float a = mx3(p0[0], p0[1], p1[0]), b = mx3(p0[2], p0[3], p1[1]); a = mx3(a, p1[2], p1[3]);
#pragma unroll
    for (int r = 4; r < 16; r += 4) { a = mx3(a, p0[r], p0[r + 1]); b = mx3(b, p0[r + 2], p0[r + 3]); a = mx3(a, p1[r], p1[r + 1]); b = mx3(b, p1[r + 2], p1[r + 3]); }
    const float m = __builtin_fmaxf(a, b);
    auto rr = __builtin_amdgcn_permlane32_swap(__float_as_uint(m), __float_as_uint(m), false, false);
    return __builtin_fmaxf(__uint_as_float(rr[0]), __uint_as_float(rr[1]));
}
__device__ __forceinline__ float halfsum(float v) {
    auto rr = __builtin_amdgcn_permlane32_swap(__float_as_uint(v), __float_as_uint(v), false, false);
    return __uint_as_float(rr[0]) + __uint_as_float(rr[1]);
}
__device__ __forceinline__ void mask_tile(f32x16& p0, f32x16& p1, int lo, int hi_, int hi) {
    const int kb = 4 * hi;
#pragma unroll
    for (int r = 0; r < 16; ++r) { const int kv = kb + (r & 3) + 8 * (r >> 2); if (kv > hi_ || kv < lo) p0[r] = NEGS; if (kv + 32 > hi_ || kv + 32 < lo) p1[r] = NEGS; }
}

__device__ __forceinline__ int next_bit128(unsigned u0, unsigned u1, unsigned u2, unsigned u3, int below) {
    if (below > 96) { unsigned x = u3; if (below < 128) x &= (1u << (below - 96)) - 1u; if (x) return 96 + 31 - __builtin_clz(x); }
    if (below > 64) { unsigned x = u2; if (below < 96) x &= (1u << (below - 64)) - 1u; if (x) return 64 + 31 - __builtin_clz(x); }
    if (below > 32) { unsigned x = u1; if (below < 64) x &= (1u << (below - 32)) - 1u; if (x) return 32 + 31 - __builtin_clz(x); }
    if (below > 0) { unsigned x = u0; if (below < 32) x &= (1u << below) - 1u; if (x) return 31 - __builtin_clz(x); }
    return -1;
}
struct Soft { float m, l; };

template <bool HAS_O>
__device__ __forceinline__ void softmax_step(f32x16& p0, f32x16& p1, Soft& st, f32x16 (&o)[2], float* wsf, int r32, int hi) {
    const float rm = rowmax(p0, p1);
    if (__any(rm > 0.f)) {
        const float dl = __builtin_fmaxf(rm, 0.f); st.m += dl;
#pragma unroll
        for (int r = 0; r < 16; ++r) { p0[r] -= dl; p1[r] -= dl; }
        const float al = __builtin_amdgcn_exp2f(-dl); st.l *= al;
        if (HAS_O) {
            if (hi == 0) wsf[r32] = al;
            wsync();
#pragma unroll
            for (int r = 0; r < 16; ++r) { const float f = wsf[crow(r, hi)]; o[0][r] *= f; o[1][r] *= f; }
            wsync();
        }
    }
    float s = 0.f;
#pragma unroll
    for (int r = 0; r < 16; ++r) { p0[r] = __builtin_amdgcn_exp2f(p0[r]); p1[r] = __builtin_amdgcn_exp2f(p1[r]); s += p0[r] + p1[r]; }
    st.l += s;
}
#define AT_PACK(P0, P1) \
    const u32x4 pw0 = {cvtpk(P0[0], P0[1]), cvtpk(P0[2], P0[3]), cvtpk(P0[4], P0[5]), cvtpk(P0[6], P0[7])}, pw1 = {cvtpk(P0[8], P0[9]), cvtpk(P0[10], P0[11]), cvtpk(P0[12], P0[13]), cvtpk(P0[14], P0[15])}, \
                pw2 = {cvtpk(P1[0], P1[1]), cvtpk(P1[2], P1[3]), cvtpk(P1[4], P1[5]), cvtpk(P1[6], P1[7])}, pw3 = {cvtpk(P1[8], P1[9]), cvtpk(P1[10], P1[11]), cvtpk(P1[12], P1[13]), cvtpk(P1[14], P1[15])}
__device__ __forceinline__ f32x16 cinit(float c2k, int hi, float x) { f32x16 c; const float xb = __builtin_fmaf(c2k, (float)(4 * hi), x);
#pragma unroll
    for (int r = 0; r < 16; ++r) c[r] = __builtin_fmaf(c2k, (float)((r & 3) + 8 * (r >> 2)), xb);
    return c; }
template <bool FIRST>
__device__ __forceinline__ void acc_scaled(float* stage, const f32x16 (&o)[2], float f, float* wsf, int r32, int hi) {
    if (hi == 0) wsf[r32] = f;
    wsync();
#pragma unroll
    for (int r = 0; r < 16; ++r) { const int orow = crow(r, hi); const float g = wsf[orow]; float* s0 = stage + orow * 64 + r32;
        if (FIRST) { s0[0] = o[0][r] * g; s0[32] = o[1][r] * g; } else { s0[0] += o[0][r] * g; s0[32] += o[1][r] * g; } }
    wsync();
}

#define AT_WAIT_NEWER(newer, per) do { if ((newer) >= 2) { if ((per) == 2) AT_WAITV(4); else AT_WAITV(2); } else if ((newer) == 1) { if ((per) == 2) AT_WAITV(2); else AT_WAITV(1); } else AT_WAITV(0); } while (0)

__device__ __forceinline__ void nsa_unit(const Params& p, int b, int g, int c, unsigned char* lds_raw) {
    const int tid = otid(), lane = tid & 63, r32 = lane & 31, hi = lane >> 5, wid = __builtin_amdgcn_readfirstlane(tid >> 6);
    lp lds = (lp)lds_raw;
    const bf16_t* ZB = (const bf16_t*)(p.ws + WS_ZB); const float* GT = (const float*)(p.ws + WS_GATE);
    const bf16_t* KCB = (const bf16_t*)(p.ws + WS_KCB) + (size_t)(b * 2 + g) * 512 * 64; const bf16_t* VCB = (const bf16_t*)(p.ws + WS_VCB) + (size_t)(b * 2 + g) * 512 * 64;
    const int t0 = c * 64, hg = r32 >> 3, qq = r32 & 7, qi = 8 * wid + qq, t = t0 + qi, h = 4 * g + hg; const size_t tt = (size_t)b * S + t;
    float* wsf = (float*)(lds_raw + L_WSF) + wid * 64;
    float* ostage = (float*)(lds_raw + L_OST) + wid * 2048;
    float* imp = ostage;
    unsigned* selm = (unsigned*)(lds_raw + L_SELM);
    unsigned* uni = (unsigned*)(lds_raw + L_UNI);
    const float c2 = exp2f(-(float)(h + 1)) * LOG2E;
    bf16x8 qr[4];
#pragma unroll
    for (int d0 = 0; d0 < 4; ++d0) qr[d0] = *(const bf16x8*)(ZB + tt * ZBW + ZB_Q + h * 64 + d0 * 16 + hi * 8);
    const float gt0 = GT[tt * 32 + h * 3 + 0], gt1 = GT[tt * 32 + h * 3 + 1], gt2 = GT[tt * 32 + h * 3 + 2];
    f32x16 o[2];
    const lp sK0 = lds + L_K, sV0 = lds + L_V;
    const int nmax = t >= 31 ? (t - 31) >> 4 : -1;
    const int ntc = ((4 * c + 2) >> 6) + 1;
    for (int i = lane; i < 8 * 129; i += 64) imp[i] = 0.f;
    Soft sc; sc.m = 0.f; sc.l = 0.f;
#pragma unroll
    for (int k = 0; k < 3; ++k) if (k < ntc) dma_k(sK0 + k * 8192, KCB, 64, 64 * k, wid, lane);
    for (int k = 0; k < ntc; ++k) {
        const int newer = ntc - 1 - k; AT_WAIT_NEWER(newer, 1);
        AT_WAITL(); bar();
        if (k + 3 < ntc) dma_k(sK0 + ((k + 3) & 3) * 8192, KCB, 64, 64 * (k + 3), wid, lane);
        const lp sK = sK0 + (k & 3) * 8192;
        const float x0 = c2 * (16.f * (64 * k) + 15.5f - (float)t0) - sc.m;
        f32x16 p0 = cinit(16.f * c2, hi, x0), p1 = cinit(16.f * c2, hi, x0 + c2 * 512.f);
        qk_tile(p0, p1, sK, qr, r32, hi);
        if (__any(nmax - 64 * k < 63)) mask_tile(p0, p1, 0, nmax - 64 * k, hi);
        softmax_step<false>(p0, p1, sc, o, wsf, r32, hi);
    }
    const float lc = halfsum(sc.l), linv = lc > 0.f ? 1.f / lc : 0.f;
    o[0] = f32x16{}; o[1] = f32x16{};
    AT_WAITL(); bar();
#pragma unroll
    for (int k = 0; k < 3; ++k) if (k < ntc) { dma_k(sK0 + k * 8192, KCB, 64, 64 * k, wid, lane); dma_v(sV0 + k * 8192, VCB, 64, 64 * k, wid, lane); }
    for (int k = 0; k < ntc; ++k) {
        const int newer = ntc - 1 - k; AT_WAIT_NEWER(newer, 2);
        AT_WAITL(); bar();
        if (k + 3 < ntc) { dma_k(sK0 + ((k + 3) & 3) * 8192, KCB, 64, 64 * (k + 3), wid, lane); dma_v(sV0 + ((k + 3) & 3) * 8192, VCB, 64, 64 * (k + 3), wid, lane); }
        const lp sK = sK0 + (k & 3) * 8192, sV = sV0 + (k & 3) * 8192;
        const float x0 = c2 * (16.f * (64 * k) + 15.5f - (float)t0) - sc.m;
        f32x16 p0 = cinit(16.f * c2, hi, x0), p1 = cinit(16.f * c2, hi, x0 + c2 * 512.f);
        qk_tile(p0, p1, sK, qr, r32, hi);
        if (__any(nmax - 64 * k < 63)) mask_tile(p0, p1, 0, nmax - 64 * k, hi);
#pragma unroll
        for (int r = 0; r < 16; ++r) { p0[r] = __builtin_amdgcn_exp2f(p0[r]); p1[r] = __builtin_amdgcn_exp2f(p1[r]); }
        { AT_PACK(p0, p1); pv_tile(o, sV, lane, hi, pw0, pw1, pw2, pw3); }
        float gs[8], ls[8];
#pragma unroll
        for (int q4 = 0; q4 < 4; ++q4) { gs[q4] = ((p0[4 * q4] + p0[4 * q4 + 1]) + (p0[4 * q4 + 2] + p0[4 * q4 + 3])) * linv; ls[q4] = p0[4 * q4 + 3] * linv;
                                         gs[4 + q4] = ((p1[4 * q4] + p1[4 * q4 + 1]) + (p1[4 * q4 + 2] + p1[4 * q4 + 3])) * linv; ls[4 + q4] = p1[4 * q4 + 3] * linv; }
#pragma unroll
        for (int q4 = 0; q4 < 8; ++q4) { gs[q4] += __shfl_xor(gs[q4], 8); gs[q4] += __shfl_xor(gs[q4], 16); ls[q4] += __shfl_xor(ls[q4], 8); ls[q4] += __shfl_xor(ls[q4], 16); }
        if (r32 < 8) {
            float* row = imp + qq * 129 + 16 * k + hi;
#pragma unroll
            for (int q4 = 0; q4 < 8; ++q4) row[2 * q4] += gs[q4];
        }
        wsync();
        if (r32 < 8) {
            float* row = imp + qq * 129 + 16 * k + hi + 1;
#pragma unroll
            for (int q4 = 0; q4 < 8; ++q4) row[2 * q4] += ls[q4];
        }
        wsync();
    }
    unsigned mk0 = 0u, mk1 = 0u, mk2 = 0u, mk3 = 0u;
    {
        const int qs = lane >> 3, part = lane & 7;
        float v[16];
#pragma unroll
        for (int i = 0; i < 16; ++i) { const int j = part * 16 + i; float x = imp[qs * 129 + j]; if (j == 0 || j == c || j == c - 1) x = 1e4f; if (j > c) x = NEGS; v[i] = x; }
#pragma unroll 1
        for (int it = 0; it < 16; ++it) {
            float bv = -3e38f; int bi = 0;
#pragma unroll
            for (int i = 0; i < 16; ++i) if (v[i] > bv) { bv = v[i]; bi = part * 16 + i; }
#pragma unroll
            for (int sft = 1; sft < 8; sft <<= 1) { const float ov = __shfl_xor(bv, sft); const int oi = __shfl_xor(bi, sft); if (ov > bv || (ov == bv && oi < bi)) { bv = ov; bi = oi; } }
            if (bv > NEGS) { const unsigned bit = 1u << (bi & 31); const int wq = bi >> 5; if (wq == 0) mk0 |= bit; else if (wq == 1) mk1 |= bit; else if (wq == 2) mk2 |= bit; else mk3 |= bit; }
#pragma unroll
            for (int i = 0; i < 16; ++i) if (part * 16 + i == bi) v[i] = -3.4e38f;
        }
        if (part == 0) { unsigned* sm = selm + (8 * wid + qs) * 4; sm[0] = mk0; sm[1] = mk1; sm[2] = mk2; sm[3] = mk3; }
        unsigned u0 = mk0, u1 = mk1, u2 = mk2, u3 = mk3;
#pragma unroll
        for (int sft = 8; sft < 64; sft <<= 1) { u0 |= __shfl_xor(u0, sft); u1 |= __shfl_xor(u1, sft); u2 |= __shfl_xor(u2, sft); u3 |= __shfl_xor(u3, sft); }
        if (lane == 0) { uni[wid * 4 + 0] = u0; uni[wid * 4 + 1] = u1; uni[wid * 4 + 2] = u2; uni[wid * 4 + 3] = u3; }
    }
    wsync();
    acc_scaled<true>(ostage, o, gt0 * linv, wsf, r32, hi);
    AT_WAITL(); bar();
    unsigned un0 = 0u, un1 = 0u, un2 = 0u, un3 = 0u;
#pragma unroll
    for (int w = 0; w < 8; ++w) { un0 |= uni[w * 4 + 0]; un1 |= uni[w * 4 + 1]; un2 |= uni[w * 4 + 2]; un3 |= uni[w * 4 + 3]; }
    un0 = __builtin_amdgcn_readfirstlane(un0); un1 = __builtin_amdgcn_readfirstlane(un1); un2 = __builtin_amdgcn_readfirstlane(un2); un3 = __builtin_amdgcn_readfirstlane(un3);
    const unsigned my0 = selm[(8 * wid + qq) * 4 + 0], my1 = selm[(8 * wid + qq) * 4 + 1], my2 = selm[(8 * wid + qq) * 4 + 2], my3 = selm[(8 * wid + qq) * 4 + 3];
    {
        const bf16_t* KS = ZB + (size_t)b * S * ZBW + ZB_KS + g * 64; const bf16_t* VS = ZB + (size_t)b * S * ZBW + ZB_VS + g * 64;
        Soft ss; ss.m = 0.f; ss.l = 0.f; o[0] = f32x16{}; o[1] = f32x16{};
        const int nsel = __builtin_popcount(un0) + __builtin_popcount(un1) + __builtin_popcount(un2) + __builtin_popcount(un3);
        int ji = 128;
#pragma unroll
        for (int k = 0; k < 3; ++k) if (k < nsel) { ji = next_bit128(un0, un1, un2, un3, ji); dma_k(sK0 + k * 8192, KS, ZBW, 64 * ji, wid, lane); dma_v(sV0 + k * 8192, VS, ZBW, 64 * ji, wid, lane); }
        int j = 128;
        for (int i = 0; i < nsel; ++i) {
            j = next_bit128(un0, un1, un2, un3, j);
            const int newer = nsel - 1 - i; AT_WAIT_NEWER(newer, 2);
            AT_WAITL(); bar();
            if (i + 3 < nsel) { ji = next_bit128(un0, un1, un2, un3, ji); dma_k(sK0 + ((i + 3) & 3) * 8192, KS, ZBW, 64 * ji, wid, lane); dma_v(sV0 + ((i + 3) & 3) * 8192, VS, ZBW, 64 * ji, wid, lane); }
            const lp sK = sK0 + (i & 3) * 8192, sV = sV0 + (i & 3) * 8192;
            const unsigned mw = (j >> 5) == 0 ? my0 : (j >> 5) == 1 ? my1 : (j >> 5) == 2 ? my2 : my3;
            const bool sel = (mw >> (j & 31)) & 1u;
            const float x0 = sel ? c2 * (float)(64 * j - t0) - ss.m : NEGS;
            f32x16 p0 = cinit(c2, hi, x0), p1 = cinit(c2, hi, sel ? x0 + c2 * 32.f : NEGS);
            qk_tile(p0, p1, sK, qr, r32, hi);
            if (j == c) mask_tile(p0, p1, 0, qi, hi);
            softmax_step<true>(p0, p1, ss, o, wsf, r32, hi);
            { AT_PACK(p0, p1); pv_tile(o, sV, lane, hi, pw0, pw1, pw2, pw3); }
        }
        const float ls_ = halfsum(ss.l);
        acc_scaled<false>(ostage, o, ls_ > 0.f ? gt1 / ls_ : 0.f, wsf, r32, hi);
    }
    {
        const bf16_t* KW = ZB + (size_t)b * S * ZBW + ZB_KW + g * 64; const bf16_t* VW = ZB + (size_t)b * S * ZBW + ZB_VW + g * 64;
        Soft sw; sw.m = 0.f; sw.l = 0.f; o[0] = f32x16{}; o[1] = f32x16{};
        const int k0 = c >= 8 ? 0 : 8 - c, nw = 9 - k0;
        AT_WAITL(); bar();
#pragma unroll
        for (int k = 0; k < 3; ++k) if (k < nw) { dma_k(sK0 + k * 8192, KW, ZBW, t0 - 512 + 64 * (k0 + k), wid, lane); dma_v(sV0 + k * 8192, VW, ZBW, t0 - 512 + 64 * (k0 + k), wid, lane); }
        for (int i = 0; i < nw; ++i) {
            const int k = k0 + i;
            const int newer = nw - 1 - i; AT_WAIT_NEWER(newer, 2);
            AT_WAITL(); bar();
            if (i + 3 < nw) { dma_k(sK0 + ((i + 3) & 3) * 8192, KW, ZBW, t0 - 512 + 64 * (k + 3), wid, lane); dma_v(sV0 + ((i + 3) & 3) * 8192, VW, ZBW, t0 - 512 + 64 * (k + 3), wid, lane); }
            const lp sK = sK0 + (i & 3) * 8192, sV = sV0 + (i & 3) * 8192;
            const float x0 = c2 * (float)(64 * k - 512) - sw.m;
            f32x16 p0 = cinit(c2, hi, x0), p1 = cinit(c2, hi, x0 + c2 * 32.f);
            qk_tile(p0, p1, sK, qr, r32, hi);
            if (k == 0) mask_tile(p0, p1, qi + 1, 63, hi);
            if (k == 8) mask_tile(p0, p1, 0, qi, hi);
            softmax_step<true>(p0, p1, sw, o, wsf, r32, hi);
            { AT_PACK(p0, p1); pv_tile(o, sV, lane, hi, pw0, pw1, pw2, pw3); }
        }
        const float lw = halfsum(sw.l);
        acc_scaled<false>(ostage, o, lw > 0.f ? gt2 / lw : 0.f, wsf, r32, hi);
    }
    {
        bf16_t* AB = (bf16_t*)(p.ws + WS_ATTB);
#pragma unroll
        for (int i = 0; i < 4; ++i) { const int row = i * 8 + (lane >> 3), ch = lane & 7; const float4 a = *(const float4*)(ostage + row * 64 + ch * 8), c4 = *(const float4*)(ostage + row * 64 + ch * 8 + 4);
            const uint4 v = make_uint4(pk2(a.x, a.y), pk2(a.z, a.w), pk2(c4.x, c4.y), pk2(c4.z, c4.w));
            *(uint4*)(AB + ((size_t)b * S + t0 + 8 * wid + (row & 7)) * D + (4 * g + (row >> 3)) * 64 + ch * 8) = v; }
        wsync();
    }
    AT_WAITL(); bar();
}

__device__ __forceinline__ void moba_unit(const Params& p, int b, int h, int blk, unsigned char* lds_raw) {
    const int tid = otid(), lane = tid & 63, r32 = lane & 31, hi = lane >> 5, wid = __builtin_amdgcn_readfirstlane(tid >> 6);
    lp lds = (lp)lds_raw;
    const bf16_t* ZB = (const bf16_t*)(p.ws + WS_ZB);
    const bf16_t* KMB = (const bf16_t*)(p.ws + WS_KMB) + (size_t)(b * 8 + h) * 32 * 64;
    const int qi = 32 * wid + r32, t = blk * 256 + qi; const size_t tt = (size_t)b * S + t;
    float* wsf = (float*)(lds_raw + L_WSF) + wid * 64;
    unsigned* uni = (unsigned*)(lds_raw + L_UNI);
    const float c2 = exp2f(-(float)(h + 1)) * LOG2E;
    bf16x8 qr[4];
#pragma unroll
    for (int d0 = 0; d0 < 4; ++d0) qr[d0] = *(const bf16x8*)(ZB + tt * ZBW + ZB_MQ + h * 64 + d0 * 16 + hi * 8);
    const lp sK0 = lds + L_K, sV0 = lds + L_V;
    unsigned mymask = 0u;
    {
        const lp sKM = lds + L_KMT;
        glds(KMB + (size_t)(lane & 31) * 64 + wid * 8, sKM + wid * 1024);
        AT_WAITV(0); bar();
        f32x16 g0 = f32x16{}, g1 = f32x16{};
        qk_tile(g0, g1, sKM, qr, r32, hi);
        float v1 = NEGS, v2 = NEGS, v3 = NEGS; int i1 = 64, i2 = 64, i3 = 64;
#pragma unroll
        for (int r = 0; r < 16; ++r) { const int n = crow(r, hi); const float s_ = n < blk ? g0[r] : NEGS;
            if (s_ > v1) { v3 = v2; i3 = i2; v2 = v1; i2 = i1; v1 = s_; i1 = n; } else if (s_ > v2) { v3 = v2; i3 = i2; v2 = s_; i2 = n; } else if (s_ > v3) { v3 = s_; i3 = n; } }
        float ov[3]; int oi[3];
        { auto a = __builtin_amdgcn_permlane32_swap(__float_as_uint(v1), __float_as_uint(v1), false, false); ov[0] = __uint_as_float(hi ? a[0] : a[1]); }
        { auto a = __builtin_amdgcn_permlane32_swap(__float_as_uint(v2), __float_as_uint(v2), false, false); ov[1] = __uint_as_float(hi ? a[0] : a[1]); }
        { auto a = __builtin_amdgcn_permlane32_swap(__float_as_uint(v3), __float_as_uint(v3), false, false); ov[2] = __uint_as_float(hi ? a[0] : a[1]); }
        { auto a = __builtin_amdgcn_permlane32_swap((unsigned)i1, (unsigned)i1, false, false); oi[0] = (int)(hi ? a[0] : a[1]); }
        { auto a = __builtin_amdgcn_permlane32_swap((unsigned)i2, (unsigned)i2, false, false); oi[1] = (int)(hi ? a[0] : a[1]); }
        { auto a = __builtin_amdgcn_permlane32_swap((unsigned)i3, (unsigned)i3, false, false); oi[2] = (int)(hi ? a[0] : a[1]); }
#pragma unroll
        for (int k = 0; k < 3; ++k) { const float s_ = ov[k]; const int n = oi[k];
            if (s_ > v1 || (s_ == v1 && n < i1)) { v3 = v2; i3 = i2; v2 = v1; i2 = i1; v1 = s_; i1 = n; }
            else if (s_ > v2 || (s_ == v2 && n < i2)) { v3 = v2; i3 = i2; v2 = s_; i2 = n; }
            else if (s_ > v3 || (s_ == v3 && n < i3)) { v3 = s_; i3 = n; } }
        if (v1 > NEGS) mymask |= 1u << i1; if (v2 > NEGS) mymask |= 1u << i2; if (v3 > NEGS) mymask |= 1u << i3;
        unsigned u = mymask;
#pragma unroll
        for (int sft = 1; sft < 64; sft <<= 1) u |= __shfl_xor(u, sft);
        if (lane == 0) uni[wid] = u;
        AT_WAITL(); bar();
    }
    unsigned un = 0u;
#pragma unroll
    for (int w = 0; w < 8; ++w) un |= uni[w];
    un = __builtin_amdgcn_readfirstlane(un);
    const bf16_t* KM_ = ZB + (size_t)b * S * ZBW + ZB_MK + h * 64; const bf16_t* VM_ = ZB + (size_t)b * S * ZBW + ZB_MV + h * 64;
    const int nub = __builtin_popcount(un), ntile = 4 * nub + 4;
    Soft sm; sm.m = 0.f; sm.l = 0.f; f32x16 o[2]; o[0] = f32x16{}; o[1] = f32x16{};
    unsigned rem = un; int curblk = nub > 0 ? __builtin_ctz(rem) : blk;
    unsigned prem = un; int pblk = nub > 0 ? __builtin_ctz(prem) : blk, psub = 0;
#define MOBA_ISSUE(slot_) do { if (psub == 4) { psub = 0; if (pblk != blk) { prem &= prem - 1; pblk = prem ? __builtin_ctz(prem) : blk; } } \
        dma_k(sK0 + (slot_) * 8192, KM_, ZBW, pblk * 256 + psub * 64, wid, lane); dma_v(sV0 + (slot_) * 8192, VM_, ZBW, pblk * 256 + psub * 64, wid, lane); ++psub; } while (0)
    MOBA_ISSUE(0); MOBA_ISSUE(1); MOBA_ISSUE(2);
    int sub = 0;
    for (int i = 0; i < ntile; ++i) {
        const int newer = ntile - 1 - i; AT_WAIT_NEWER(newer, 2);
        AT_WAITL(); bar();
        if (i + 3 < ntile) MOBA_ISSUE((i + 3) & 3);
        const lp sK = sK0 + (i & 3) * 8192, sV = sV0 + (i & 3) * 8192;
        const bool own = (i >= 4 * nub);
        const int rel = own ? qi - 64 * sub : 63;
        const bool skip = own && (32 * wid + 31 < 64 * sub);
        if (!skip) {
            const bool sel = own ? true : ((mymask >> curblk) & 1u);
            const float x0 = sel ? c2 * (float)(curblk * 256 + sub * 64 - blk * 256) - sm.m : NEGS;
            f32x16 p0 = cinit(c2, hi, x0), p1 = cinit(c2, hi, sel ? x0 + c2 * 32.f : NEGS);
            qk_tile(p0, p1, sK, qr, r32, hi);
            if (own && (64 * sub + 63 > 32 * wid)) mask_tile(p0, p1, 0, rel, hi);
            softmax_step<true>(p0, p1, sm, o, wsf, r32, hi);
            { AT_PACK(p0, p1); pv_tile(o, sV, lane, hi, pw0, pw1, pw2, pw3); }
        }
        if (++sub == 4) { sub = 0; if (!own) { rem &= rem - 1; curblk = rem ? __builtin_ctz(rem) : blk; } }
    }
#undef MOBA_ISSUE
    {
        const float lt = halfsum(sm.l); const float f = lt > 0.f ? 1.f / lt : 0.f;
        if (hi == 0) wsf[r32] = f;
        wsync();
        bf16_t* stg = (bf16_t*)(lds_raw + L_OST) + wid * 4096;
#pragma unroll
        for (int r = 0; r < 16; ++r) { const int orow = crow(r, hi); const float g = wsf[orow]; stg[orow * 64 + r32] = (bf16_t)f2bf(o[0][r] * g); stg[orow * 64 + 32 + r32] = (bf16_t)f2bf(o[1][r] * g); }
        wsync();
        bf16_t* AB = (bf16_t*)(p.ws + WS_ATTB);
#pragma unroll
        for (int i = 0; i < 4; ++i) { const int row = i * 8 + (lane >> 3), ch = lane & 7; const uint4 v = *(const uint4*)(stg + row * 64 + ch * 8);
            *(uint4*)(AB + ((size_t)b * S + blk * 256 + 32 * wid + row) * D + 512 + h * 64 + ch * 8) = v; }
        wsync();
    }
    AT_WAITL(); bar();
}
}

constexpr int MB_CAP = 25600;
namespace at {
__device__ __forceinline__ void moba_route_unit(const Params& p, int b, int h, int qb, unsigned char* lds_raw) {
    const int tid = otid(), lane = tid & 63, r32 = lane & 31, hi = lane >> 5, wid = __builtin_amdgcn_readfirstlane(tid >> 6);
    lp lds = (lp)lds_raw;
    const bf16_t* ZB = (const bf16_t*)(p.ws + WS_ZB);
    const int bh = b * 8 + h;
    const bf16_t* KMB = (const bf16_t*)(p.ws + WS_KMB) + (size_t)bh * 32 * 64;
    const int qi = 32 * wid + r32, t = qb * 256 + qi; const size_t tt = (size_t)b * S + t;
    int* hist = (int*)(lds_raw + L_UNI);
    unsigned* SEL3 = (unsigned*)(p.ws + WS_SEL3); unsigned* LRK = (unsigned*)(p.ws + WS_LRK);
    unsigned char* IL = (unsigned char*)(p.ws + WS_ILIST) + ((size_t)(bh * 32 + qb) * 32) * 256;
    int* BCm = (int*)(p.ws + WS_BCM) + (size_t)(bh * 32 + qb) * 32;
    if (tid < 32) hist[tid] = 0;
    bf16x8 qr[4];
#pragma unroll
    for (int d0 = 0; d0 < 4; ++d0) qr[d0] = *(const bf16x8*)(ZB + tt * ZBW + ZB_MQ + h * 64 + d0 * 16 + hi * 8);
    const lp sKM = lds + L_KMT;
    glds(KMB + (size_t)(lane & 31) * 64 + wid * 8, sKM + wid * 1024);
    AT_WAITV(0); AT_WAITL(); bar();
    f32x16 g0 = f32x16{}, g1 = f32x16{};
    qk_tile(g0, g1, sKM, qr, r32, hi);
    float v1 = NEGS, v2 = NEGS, v3 = NEGS; int i1 = 64, i2 = 64, i3 = 64;
#pragma unroll
    for (int r = 0; r < 16; ++r) { const int n = crow(r, hi); const float s_ = n < qb ? g0[r] : NEGS;
        if (s_ > v1) { v3 = v2; i3 = i2; v2 = v1; i2 = i1; v1 = s_; i1 = n; } else if (s_ > v2) { v3 = v2; i3 = i2; v2 = s_; i2 = n; } else if (s_ > v3) { v3 = s_; i3 = n; } }
    float ov[3]; int oi[3];
    { auto a = __builtin_amdgcn_permlane32_swap(__float_as_uint(v1), __float_as_uint(v1), false, false); ov[0] = __uint_as_float(hi ? a[0] : a[1]); }
    { auto a = __builtin_amdgcn_permlane32_swap(__float_as_uint(v2), __float_as_uint(v2), false, false); ov[1] = __uint_as_float(hi ? a[0] : a[1]); }
    { auto a = __builtin_amdgcn_permlane32_swap(__float_as_uint(v3), __float_as_uint(v3), false, false); ov[2] = __uint_as_float(hi ? a[0] : a[1]); }
    { auto a = __builtin_amdgcn_permlane32_swap((unsigned)i1, (unsigned)i1, false, false); oi[0] = (int)(hi ? a[0] : a[1]); }
    { auto a = __builtin_amdgcn_permlane32_swap((unsigned)i2, (unsigned)i2, false, false); oi[1] = (int)(hi ? a[0] : a[1]); }
    { auto a = __builtin_amdgcn_permlane32_swap((unsigned)i3, (unsigned)i3, false, false); oi[2] = (int)(hi ? a[0] : a[1]); }
#pragma unroll
    for (int k = 0; k < 3; ++k) { const float s_ = ov[k]; const int n = oi[k];
        if (s_ > v1 || (s_ == v1 && n < i1)) { v3 = v2; i3 = i2; v2 = v1; i2 = i1; v1 = s_; i1 = n; }
        else if (s_ > v2 || (s_ == v2 && n < i2)) { v3 = v2; i3 = i2; v2 = s_; i2 = n; }
        else if (s_ > v3 || (s_ == v3 && n < i3)) { v3 = s_; i3 = n; } }
    if (hi == 0) {
        const int j1 = v1 > NEGS ? i1 : 255, j2 = v2 > NEGS ? i2 : 255, j3 = v3 > NEGS ? i3 : 255;
        int l1 = 0, l2 = 0, l3 = 0;
        if (j1 < 32) { l1 = atomicAdd(&hist[j1], 1); IL[j1 * 256 + l1] = (unsigned char)qi; }
        if (j2 < 32) { l2 = atomicAdd(&hist[j2], 1); IL[j2 * 256 + l2] = (unsigned char)qi; }
        if (j3 < 32) { l3 = atomicAdd(&hist[j3], 1); IL[j3 * 256 + l3] = (unsigned char)qi; }
        SEL3[tt * 8 + h] = (unsigned)j1 | ((unsigned)j2 << 8) | ((unsigned)j3 << 16);
        LRK[tt * 8 + h] = (unsigned)l1 | ((unsigned)l2 << 8) | ((unsigned)l3 << 16);
    }
    AT_WAITL(); bar();
    if (tid < 32) BCm[tid] = hist[tid];
    AT_WAITL(); bar();
}
__device__ __forceinline__ void moba_tables(const int* BCmbh, int lane, int& tot, int& seg) {
    int s = 0;
    if (lane < 32) { for (int q = 0; q < 32; ++q) s += BCmbh[q * 32 + lane]; }
    tot = s;
    int pad = (s + 31) & ~31, inc = pad;
#pragma unroll
    for (int sft = 1; sft < 32; sft <<= 1) { const int o_ = __shfl_up(inc, sft); if ((lane & 31) >= sft) inc += o_; }
    seg = inc - pad;
}
__device__ __forceinline__ void moba_gather_unit(const Params& p, int bh, int j, int ch, int segj, bool reload, unsigned char* lds_raw) {
    const int tid = otid(), lane = tid & 63, r32 = lane & 31, hi = lane >> 5, wid = __builtin_amdgcn_readfirstlane(tid >> 6);
    lp lds = (lp)lds_raw;
    const int b = bh >> 3, h = bh & 7;
    const bf16_t* ZB = (const bf16_t*)(p.ws + WS_ZB);
    const int* BCmbh = (const int*)(p.ws + WS_BCM) + (size_t)bh * 32 * 32;
    float* wsf = (float*)(lds_raw + L_WSF) + wid * 64;
    const lp sK0 = lds + L_K, sV0 = lds + L_V;
    const bf16_t* KM_ = ZB + (size_t)b * S * ZBW + ZB_MK + h * 64; const bf16_t* VM_ = ZB + (size_t)b * S * ZBW + ZB_MV + h * 64;
    if (reload) {
#pragma unroll
        for (int k = 0; k < 4; ++k) { dma_k(sK0 + k * 8192, KM_, ZBW, j * 256 + 64 * k, wid, lane); dma_v(sV0 + k * 8192, VM_, ZBW, j * 256 + 64 * k, wid, lane); }
    }
    const int gr = 256 * ch + 32 * wid + r32;
    const int cq = lane < 32 ? BCmbh[lane * 32 + j] : 0;
    int run = 0, qbs = j + 1, lr = 0;
#pragma unroll 4
    for (int q = 0; q < 32; ++q) { const int c_ = __builtin_amdgcn_readlane(cq, q); if (gr >= run && gr < run + c_) { qbs = q; lr = gr - run; } run += c_; }
    const int totj = run;
    const bool valid = gr < totj;
    const unsigned char* IL = (const unsigned char*)(p.ws + WS_ILIST);
    const int qidx = valid ? (int)IL[((size_t)(bh * 32 + qbs) * 32 + j) * 256 + lr] : 0;
    const int t = valid ? qbs * 256 + qidx : (j + 1) * 256; const size_t tt = (size_t)b * S + t;
    const float c2 = exp2f(-(float)(h + 1)) * LOG2E;
    bf16x8 qr[4];
#pragma unroll
    for (int d0 = 0; d0 < 4; ++d0) qr[d0] = *(const bf16x8*)(ZB + tt * ZBW + ZB_MQ + h * 64 + d0 * 16 + hi * 8);
    Soft sm; sm.m = 0.f; sm.l = 0.f; f32x16 o[2]; o[0] = f32x16{}; o[1] = f32x16{};
#pragma unroll 1
    for (int i = 0; i < 4; ++i) {
        if (reload) { const int newer = 3 - i; if (newer >= 3) AT_WAITV(6); else AT_WAIT_NEWER(newer, 2); AT_WAITL(); bar(); }
        const lp sK = sK0 + i * 8192, sV = sV0 + i * 8192;
        const float x0 = c2 * (float)(64 * i) - sm.m;
        f32x16 p0 = cinit(c2, hi, x0), p1 = cinit(c2, hi, x0 + c2 * 32.f);
        qk_tile(p0, p1, sK, qr, r32, hi);
        softmax_step<true>(p0, p1, sm, o, wsf, r32, hi);
        { AT_PACK(p0, p1); pv_tile(o, sV, lane, hi, pw0, pw1, pw2, pw3); }
    }
    {
        const float lt = halfsum(sm.l);
        float* PM = (float*)(p.ws + WS_PM) + (size_t)bh * MB_CAP; float* PL = (float*)(p.ws + WS_PL) + (size_t)bh * MB_CAP;
        if (hi == 0 && valid) { PM[segj + gr] = sm.m; PL[segj + gr] = lt; }
        bf16_t* stg = (bf16_t*)(lds_raw + L_OST) + wid * 4096;
#pragma unroll
        for (int r = 0; r < 16; ++r) { const int orow = crow(r, hi); stg[orow * 64 + r32] = (bf16_t)f2bf(o[0][r]); stg[orow * 64 + 32 + r32] = (bf16_t)f2bf(o[1][r]); }
        wsync();
        bf16_t* PO = (bf16_t*)(p.ws + WS_PO) + ((size_t)bh * MB_CAP + segj + 256 * ch + 32 * wid) * 64;
        const int nrow = totj - (256 * ch + 32 * wid);
#pragma unroll
        for (int i = 0; i < 4; ++i) { const int row = i * 8 + (lane >> 3), c8 = lane & 7; if (row < nrow) *(uint4*)(PO + (size_t)row * 64 + c8 * 8) = *(const uint4*)(stg + row * 64 + c8 * 8); }
        wsync();
    }
    AT_WAITL(); bar();
}
__device__ __forceinline__ void moba_self_unit(const Params& p, int b, int h, int qb, unsigned char* lds_raw) {
    const int tid = otid(), lane = tid & 63, r32 = lane & 31, hi = lane >> 5, wid = __builtin_amdgcn_readfirstlane(tid >> 6);
    lp lds = (lp)lds_raw;
    const int bh = b * 8 + h;
    const bf16_t* ZB = (const bf16_t*)(p.ws + WS_ZB);
    const int* BCmbh = (const int*)(p.ws + WS_BCM) + (size_t)bh * 32 * 32;
    const int qi = 32 * wid + r32, t = qb * 256 + qi; const size_t tt = (size_t)b * S + t;
    float* wsf = (float*)(lds_raw + L_WSF) + wid * 64;
    float* ostage = (float*)(lds_raw + L_OST) + wid * 2048;
    const float c2 = exp2f(-(float)(h + 1)) * LOG2E;
    bf16x8 qr[4];
#pragma unroll
    for (int d0 = 0; d0 < 4; ++d0) qr[d0] = *(const bf16x8*)(ZB + tt * ZBW + ZB_MQ + h * 64 + d0 * 16 + hi * 8);
    const lp sK0 = lds + L_K, sV0 = lds + L_V;
    const bf16_t* KM_ = ZB + (size_t)b * S * ZBW + ZB_MK + h * 64; const bf16_t* VM_ = ZB + (size_t)b * S * ZBW + ZB_MV + h * 64;
    Soft sm; sm.m = 0.f; sm.l = 0.f; f32x16 o[2]; o[0] = f32x16{}; o[1] = f32x16{};
#pragma unroll
    for (int k = 0; k < 3; ++k) { dma_k(sK0 + k * 8192, KM_, ZBW, qb * 256 + 64 * k, wid, lane); dma_v(sV0 + k * 8192, VM_, ZBW, qb * 256 + 64 * k, wid, lane); }
    int tot, seg; moba_tables(BCmbh, lane, tot, seg);
    int before = 0; if (lane < 32) { for (int q = 0; q < qb; ++q) before += BCmbh[q * 32 + lane]; }
    const int base = seg + before;
#pragma unroll 1
    for (int i = 0; i < 4; ++i) {
        const int newer = 3 - i; AT_WAIT_NEWER(newer, 2);
        AT_WAITL(); bar();
        if (i == 0) { dma_k(sK0 + 3 * 8192, KM_, ZBW, qb * 256 + 192, wid, lane); dma_v(sV0 + 3 * 8192, VM_, ZBW, qb * 256 + 192, wid, lane); }
        const lp sK = sK0 + i * 8192, sV = sV0 + i * 8192;
        const bool skip = (32 * wid + 31 < 64 * i);
        if (!skip) {
            const float x0 = c2 * (float)(64 * i) - sm.m;
            f32x16 p0 = cinit(c2, hi, x0), p1 = cinit(c2, hi, x0 + c2 * 32.f);
            qk_tile(p0, p1, sK, qr, r32, hi);
            if (64 * i + 63 > 32 * wid) mask_tile(p0, p1, 0, qi - 64 * i, hi);
            softmax_step<true>(p0, p1, sm, o, wsf, r32, hi);
            { AT_PACK(p0, p1); pv_tile(o, sV, lane, hi, pw0, pw1, pw2, pw3); }
        }
    }
    {
        const float lself = halfsum(sm.l);
        const unsigned s3 = ((const unsigned*)(p.ws + WS_SEL3))[tt * 8 + h], l3 = ((const unsigned*)(p.ws + WS_LRK))[tt * 8 + h];
        const float* PM = (const float*)(p.ws + WS_PM) + (size_t)bh * MB_CAP; const float* PL = (const float*)(p.ws + WS_PL) + (size_t)bh * MB_CAP;
        float mk[3], lk[3]; int pidx[3];
        float M = sm.m + c2 * 256.f * (float)qb;
        const float mself = M;
#pragma unroll
        for (int k = 0; k < 3; ++k) { const int jk = (s3 >> (8 * k)) & 255, lrk = (l3 >> (8 * k)) & 255;
            const int pb = __shfl(base, jk & 31);
            if (jk < 32) { pidx[k] = pb + lrk; mk[k] = PM[pidx[k]] + c2 * 256.f * (float)jk; lk[k] = PL[pidx[k]]; M = __builtin_fmaxf(M, mk[k]); }
            else { pidx[k] = -1; mk[k] = NEGS; lk[k] = 0.f; } }
        const float ws_ = __builtin_amdgcn_exp2f(mself - M);
        float wk[3]; float Lt = lself * ws_;
#pragma unroll
        for (int k = 0; k < 3; ++k) { wk[k] = pidx[k] >= 0 ? __builtin_amdgcn_exp2f(mk[k] - M) : 0.f; Lt += lk[k] * wk[k]; }
        const float inv = Lt > 0.f ? 1.f / Lt : 0.f;
        float* rws = wsf;
        float* rwk = (float*)(lds_raw + L_KMT) + wid * 256;
        int* rpi = (int*)(rwk + 96);
        if (hi == 0) { rws[r32] = ws_ * inv;
#pragma unroll
            for (int k = 0; k < 3; ++k) { rwk[k * 32 + r32] = wk[k] * inv; rpi[k * 32 + r32] = pidx[k]; } }
#pragma unroll
        for (int r = 0; r < 16; ++r) { const int orow = crow(r, hi); ostage[orow * 64 + r32] = o[0][r]; ostage[orow * 64 + 32 + r32] = o[1][r]; }
        wsync();
        const bf16_t* PO = (const bf16_t*)(p.ws + WS_PO) + (size_t)bh * MB_CAP * 64;
        bf16_t* AB = (bf16_t*)(p.ws + WS_ATTB);
#pragma unroll
        for (int i = 0; i < 4; ++i) { const int row = i * 8 + (lane >> 3), c8 = lane & 7;
            const float4 a = *(const float4*)(ostage + row * 64 + c8 * 8), c4 = *(const float4*)(ostage + row * 64 + c8 * 8 + 4);
            const float w0 = rws[row];
            float acc8[8] = {a.x * w0, a.y * w0, a.z * w0, a.w * w0, c4.x * w0, c4.y * w0, c4.z * w0, c4.w * w0};
#pragma unroll
            for (int k = 0; k < 3; ++k) { const int pi = rpi[k * 32 + row]; if (pi >= 0) { const float w = rwk[k * 32 + row]; const uint4 q = *(const uint4*)(PO + (size_t)pi * 64 + c8 * 8);
                const unsigned qq_[4] = {q.x, q.y, q.z, q.w};
#pragma unroll
                for (int e = 0; e < 4; ++e) { acc8[2 * e] += __builtin_bit_cast(float, qq_[e] << 16) * w; acc8[2 * e + 1] += __builtin_bit_cast(float, qq_[e] & 0xffff0000u) * w; } } }
            *(uint4*)(AB + ((size_t)b * S + qb * 256 + 32 * wid + row) * D + 512 + h * 64 + c8 * 8) = make_uint4(pk2(acc8[0], acc8[1]), pk2(acc8[2], acc8[3]), pk2(acc8[4], acc8[5]), pk2(acc8[6], acc8[7])); }
        wsync();
    }
    AT_WAITL(); bar();
}
}

__device__ __forceinline__ void phase_att1(const Params& p, unsigned char* lds_raw, bool do_nsa = true, bool do_gather = true) {
    const int tid = otid();
    int* pre = (int*)(lds_raw + at::L_END);
    int* segt = pre + 514;
    { const int* BCm = (const int*)(p.ws + WS_BCM); const int bh = tid >> 5, j = tid & 31; int s = 0;
      for (int q = 0; q < 32; ++q) s += BCm[(size_t)(bh * 32 + q) * 32 + j];
      pre[tid + 1] = (s + 255) >> 8; if (tid == 0) pre[0] = 0;
      segt[tid] = (s + 31) & ~31; }
    __syncthreads();
    for (int sft = 1; sft < 512; sft <<= 1) { int v = 0, w = 0; if (tid >= sft) v = pre[tid + 1 - sft]; if ((tid & 31) >= sft) w = segt[tid - sft]; __syncthreads(); pre[tid + 1] += v; if (sft < 32) segt[tid] += w; __syncthreads(); }
    { const int* BCm = (const int*)(p.ws + WS_BCM); const int bh = tid >> 5, j = tid & 31; int s = 0;
      for (int q = 0; q < 32; ++q) s += BCm[(size_t)(bh * 32 + q) * 32 + j];
      const int excl = segt[tid] - ((s + 31) & ~31); __syncthreads(); segt[tid] = excl; }
    __syncthreads();
    const int nun = pre[512];
    if (do_nsa) for (int pi = blockIdx.x; pi < 512; pi += gridDim.x) {
        const int rnd = pi >> 8, id = pi & 255;
        const int bg = 2 * rnd + (id >> 7), c = rnd ? 127 - (id & 127) : (id & 127); at::nsa_unit(p, bg >> 1, bg & 1, c, lds_raw);
    }
    if (do_gather) {
        const int u0 = (int)(((long)blockIdx.x * nun) / gridDim.x), u1 = (int)(((long)(blockIdx.x + 1) * nun) / gridDim.x);
        int prev = -1;
        for (int u = u0; u < u1; ++u) {
            int lo = 0, hi_ = 511;
            while (lo < hi_) { const int mid = (lo + hi_ + 1) >> 1; if (pre[mid] <= u) lo = mid; else hi_ = mid - 1; }
            at::moba_gather_unit(p, lo >> 5, lo & 31, u - pre[lo], segt[lo], lo != prev, lds_raw);
            prev = lo;
        }
    }
}
__device__ __forceinline__ void phase_att2(const Params& p, unsigned char* lds_raw) {
    for (int pi = blockIdx.x; pi < 512; pi += gridDim.x) {
        const int rnd = pi >> 8, id = pi & 255;
        const int bh = 8 * rnd + (id >> 5), qb = rnd ? 31 - (id & 31) : (id & 31); at::moba_self_unit(p, bh >> 3, bh & 7, qb, lds_raw);
    }
}
__device__ __forceinline__ void phase_route(const Params& p, unsigned char* lds_raw) {
    for (int pi = blockIdx.x; pi < 512; pi += gridDim.x) at::moba_route_unit(p, pi >> 8, (pi >> 5) & 7, pi & 31, lds_raw);
}

__device__ __forceinline__ void phase_att_fast(const Params& p, unsigned char* lds_raw) {
    for (int pi = blockIdx.x; pi < 512; pi += gridDim.x) {
        const int rnd = pi >> 8, id = pi & 255;
        { const int bg = 2 * rnd + (id >> 7), c = rnd ? 127 - (id & 127) : (id & 127); at::nsa_unit(p, bg >> 1, bg & 1, c, lds_raw); }
        { const int bh = 8 * rnd + (id >> 5), blk = rnd ? 31 - (id & 31) : (id & 31); at::moba_unit(p, bh >> 3, bh & 7, blk, lds_raw); }
    }
}


__device__ __forceinline__ void phase_r2_fast(const Params& p, int l, unsigned char* lds_raw) {
    using namespace at;
    const int tid = otid(), lane = tid & 63, wave = __builtin_amdgcn_readfirstlane(tid >> 6), r32 = lane & 31, hi = lane >> 5;
    const float* mod = (const float*)(p.ws + WS_MOD);
    const float* XA = p.out; bf16_t* XN = (bf16_t*)(p.ws + WS_XN); bf16_t* XL = (bf16_t*)(p.ws + WS_XNLO);
    const float* lng = p.in[5] + (size_t)l * D; const float* rw = p.in[15] + (size_t)l * D * NE; const float* rb = p.in[16] + l * NE;
    int* toke = (int*)(p.ws + WS_TOKE); float* tokw = (float*)(p.ws + WS_TOKW); int* BC = (int*)(p.ws + WS_BC);
    lp lds = (lp)lds_raw;
    int* hist = (int*)(lds_raw + 131072);
    for (int idx = tid; idx < 128 * 32; idx += NT) {
        const int kc = idx >> 5, e = idx & 31; float v[8];
#pragma unroll
        for (int j = 0; j < 8; ++j) v[j] = rw[(size_t)(8 * kc + j) * NE + e];
        unsigned hh[8], ll[8];
#pragma unroll
        for (int j = 0; j < 8; ++j) { hh[j] = f2bf(v[j]); ll[j] = f2bf(v[j] - __builtin_bit_cast(float, hh[j] << 16)); }
        *(uint4*)(lds_raw + (size_t)idx * 16) = make_uint4(hh[0] | (hh[1] << 16), hh[2] | (hh[3] << 16), hh[4] | (hh[5] << 16), hh[6] | (hh[7] << 16));
        *(uint4*)(lds_raw + 65536 + (size_t)idx * 16) = make_uint4(ll[0] | (ll[1] << 16), ll[2] | (ll[3] << 16), ll[4] | (ll[5] << 16), ll[6] | (ll[7] << 16));
    }
    for (int blk = blockIdx.x; blk < T / 64; blk += gridDim.x) {
        if (tid < 32) hist[tid] = 0;
        for (int i = 0; i < 8; ++i) {
            const int t = blk * 64 + wave * 8 + i, b = t / S;
            float4 v[4]; float ss = 0.f;
#pragma unroll
            for (int j = 0; j < 4; ++j) { v[j] = *(const float4*)(XA + (size_t)t * D + 4 * lane + 256 * j); ss += (v[j].x * v[j].x + v[j].y * v[j].y) + (v[j].z * v[j].z + v[j].w * v[j].w); }
            ss = wave_sum(ss);
            const float r = rsqrtf(ss * (1.f / D) + EPS);
            const float* sh = mod + ((size_t)l * Bn + b) * 6144 + 3 * D; const float* sc = mod + ((size_t)l * Bn + b) * 6144 + 4 * D;
#pragma unroll
            for (int j = 0; j < 4; ++j) {
                const int col = 4 * lane + 256 * j;
                const float4 g = *(const float4*)(lng + col), s1 = *(const float4*)(sc + col), s0 = *(const float4*)(sh + col);
                const float o[4] = {v[j].x * r * g.x * (1.f + s1.x) + s0.x, v[j].y * r * g.y * (1.f + s1.y) + s0.y, v[j].z * r * g.z * (1.f + s1.z) + s0.z, v[j].w * r * g.w * (1.f + s1.w) + s0.w};
                unsigned hh[4], ll[4];
#pragma unroll
                for (int q = 0; q < 4; ++q) { hh[q] = f2bf(o[q]); ll[q] = f2bf(o[q] - __builtin_bit_cast(float, hh[q] << 16)); }
                *(uint2*)(XN + (size_t)t * D + col) = make_uint2(hh[0] | (hh[1] << 16), hh[2] | (hh[3] << 16));
                *(uint2*)(XL + (size_t)t * D + col) = make_uint2(ll[0] | (ll[1] << 16), ll[2] | (ll[3] << 16));
            }
        }
        asm volatile("s_waitcnt vmcnt(0)" ::: "memory");
        __syncthreads();
        if (wave < 2) {
            const int t = blk * 64 + wave * 32 + r32;
            const bf16_t* xh = XN + (size_t)t * D + 8 * hi; const bf16_t* xl = XL + (size_t)t * D + 8 * hi;
            const AT_LAS unsigned char* wh = lds + (size_t)(hi * 32 + r32) * 16; const AT_LAS unsigned char* wl = wh + 65536;
            f32x16 acc = f32x16{};
#pragma unroll 4
            for (int ks = 0; ks < 64; ++ks) {
                const bf16x8 bh = *(const bf16x8*)(xh + 16 * ks), bl = *(const bf16x8*)(xl + 16 * ks);
                const bf16x8 ah = *(const AT_LAS bf16x8*)(wh + ks * 1024), al = *(const AT_LAS bf16x8*)(wl + ks * 1024);
                acc = __builtin_amdgcn_mfma_f32_32x32x16_bf16(ah, bh, acc, 0, 0, 0);
                acc = __builtin_amdgcn_mfma_f32_32x32x16_bf16(al, bh, acc, 0, 0, 0);
                acc = __builtin_amdgcn_mfma_f32_32x32x16_bf16(ah, bl, acc, 0, 0, 0);
            }
            float a0 = -3e38f, a1 = -3e38f, a2 = -3e38f, a3 = -3e38f; int i0 = 99, i1 = 99, i2 = 99, i3 = 99;
#pragma unroll
            for (int r = 0; r < 16; ++r) { const int e = crow(r, hi); const float s_ = acc[r] + rb[e];
                if (s_ > a0) { a3 = a2; i3 = i2; a2 = a1; i2 = i1; a1 = a0; i1 = i0; a0 = s_; i0 = e; }
                else if (s_ > a1) { a3 = a2; i3 = i2; a2 = a1; i2 = i1; a1 = s_; i1 = e; }
                else if (s_ > a2) { a3 = a2; i3 = i2; a2 = s_; i2 = e; }
                else if (s_ > a3) { a3 = s_; i3 = e; } }
            float ov[4]; int oi[4];
            { const float sv[4] = {a0, a1, a2, a3}; const int si[4] = {i0, i1, i2, i3};
#pragma unroll
              for (int k = 0; k < 4; ++k) { auto a = __builtin_amdgcn_permlane32_swap(__float_as_uint(sv[k]), __float_as_uint(sv[k]), false, false); ov[k] = __uint_as_float(hi ? a[0] : a[1]);
                                            auto c = __builtin_amdgcn_permlane32_swap((unsigned)si[k], (unsigned)si[k], false, false); oi[k] = (int)(hi ? c[0] : c[1]); } }
#pragma unroll
            for (int k = 0; k < 4; ++k) { const float s_ = ov[k]; const int e = oi[k];
                if (s_ > a0 || (s_ == a0 && e < i0)) { a3 = a2; i3 = i2; a2 = a1; i2 = i1; a1 = a0; i1 = i0; a0 = s_; i0 = e; }
                else if (s_ > a1 || (s_ == a1 && e < i1)) { a3 = a2; i3 = i2; a2 = a1; i2 = i1; a1 = s_; i1 = e; }
                else if (s_ > a2 || (s_ == a2 && e < i2)) { a3 = a2; i3 = i2; a2 = s_; i2 = e; }
                else if (s_ > a3 || (s_ == a3 && e < i3)) { a3 = s_; i3 = e; } }
            const float e1 = __expf(a1 - a0), e2 = __expf(a2 - a0), e3 = __expf(a3 - a0), inv = 1.f / (((1.f + e1) + e2) + e3);
            if (hi == 0) {
                *(int4*)(toke + (size_t)t * 4) = make_int4(i0, i1, i2, i3);
                *(float4*)(tokw + (size_t)t * 4) = make_float4(inv, e1 * inv, e2 * inv, e3 * inv);
                atomicAdd(&hist[i0], 1); atomicAdd(&hist[i1], 1); atomicAdd(&hist[i2], 1); atomicAdd(&hist[i3], 1);
            }
        }
        __syncthreads();
        if (tid < 32) BC[blk * 32 + tid] = hist[tid];
        __syncthreads();
    }
}
__device__ __forceinline__ void phase_sc_fast(const Params& p, int l, unsigned char* lds_raw) {
    const int tid = otid();
    const int* BC = (const int*)(p.ws + WS_BC);
    int* cnt = (int*)(p.ws + WS_CNT) + l * 32;
    int* tot = (int*)lds_raw; int* base = tot + 32; int* fillc = tot + 64; int* before = tot + 96;
    const int* toke = (const int*)(p.ws + WS_TOKE); const float* tokw = (const float*)(p.ws + WS_TOKW);
    int* rowtok = (int*)(p.ws + WS_ROWTOK) + (size_t)l * RMAX; float* roww = (float*)(p.ws + WS_ROWW) + (size_t)l * RMAX; int* pos = (int*)(p.ws + WS_POS);
    for (int blk = blockIdx.x; blk < T / 64; blk += gridDim.x) {
        { const int e = tid & 31, part = tid >> 5; int s = 0, bf = 0;
#pragma unroll 4
          for (int i = part * 16; i < part * 16 + 16; ++i) { const int c = BC[i * 32 + e]; s += c; if (i < blk) bf += c; }
          int* ptot = tot + 128; int* pbef = ptot + 512;
          ptot[tid] = s; pbef[tid] = bf; }
        __syncthreads();
        if (tid < 32) { const int* ptot = tot + 128; const int* pbef = ptot + 512; int s = 0, bf = 0;
#pragma unroll
            for (int q = 0; q < 16; ++q) { s += ptot[q * 32 + tid]; bf += pbef[q * 32 + tid]; }
            tot[tid] = s; before[tid] = bf; fillc[tid] = 0; if (blk == 0) cnt[tid] = s; }
        __syncthreads();
        if (tid == 0) { int s = 0; for (int e = 0; e < 32; ++e) { base[e] = s + before[e]; s += (tot[e] + 255) & ~255; } }
        __syncthreads();
        if (tid < 256) {
            const int i = blk * 256 + tid, e = toke[i];
            const int slot = base[e] + atomicAdd(&fillc[e], 1);
            rowtok[slot] = i >> 2; roww[slot] = tokw[i]; pos[i] = slot;
        }
        __syncthreads();
    }
}

#define XB_TMO      128
#define XB_XCNT(j)  (256  + 64 * (j))
#define XB_XSUB(j)  (1280 + 64 * (j))
#define XB_XGEN(j)  (2304 + 64 * (j))
#define XB_TOP      3328
#define XB_TOPGEN   3392
#define XCD_BAR_WORDS 3456
#define XB_SPIN_CAP (1u << 18)
#define XLAS __attribute__((address_space(3)))
__device__ __forceinline__ unsigned xb_ld(unsigned* p)              { return __hip_atomic_load(p, __ATOMIC_RELAXED, __HIP_MEMORY_SCOPE_AGENT); }
__device__ __forceinline__ unsigned xb_add(unsigned* p, unsigned v) { return __hip_atomic_fetch_add(p, v, __ATOMIC_RELAXED, __HIP_MEMORY_SCOPE_AGENT); }
__device__ __forceinline__ unsigned xb_xcc_id() { return (unsigned)__builtin_amdgcn_s_getreg((3 << 11) | 20) & 0xFu; }
#define XB_SPIN(cond, bar) do { unsigned _sp = 0; while (cond) { __builtin_amdgcn_s_sleep(1); \
    if ((++_sp & 255u) == 0u) { if (xb_ld(&(bar)[XB_TMO])) break; if (_sp > XB_SPIN_CAP) { atomicAdd(&(bar)[XB_TMO], 1u); break; } } } } while (0)
constexpr int LDS_BARST_OFF = 147200;
struct XcdBarrier { unsigned* bar; unsigned x; volatile XLAS unsigned* st; };
__device__ __forceinline__ XcdBarrier xcd_barrier_post(unsigned* bar, volatile XLAS unsigned* st) {
    XcdBarrier b; b.bar = bar; b.x = xb_xcc_id(); b.st = st;
    if (threadIdx.x == 0) (void)xb_add(&bar[XB_XCNT(b.x)], 1u);
    return b;
}
__device__ __forceinline__ void xcd_barrier_complete(unsigned* bar, unsigned x, unsigned& nloc, unsigned& nx) {
    const unsigned G = gridDim.x * gridDim.y * gridDim.z;
    unsigned sum, cnt, mine, sp = 0u;
    for (;;) {
        sum = 0u; cnt = 0u; mine = 0u;
#pragma unroll
        for (unsigned j = 0; j < 16; ++j) { const unsigned c = xb_ld(&bar[XB_XCNT(j)]); sum += c; cnt += (c > 0u) ? 1u : 0u; mine = (j == x) ? c : mine; }
        if (sum == G) break;
        __builtin_amdgcn_s_sleep(1);
        if ((++sp & 255u) == 0u) { if (xb_ld(&bar[XB_TMO])) break; if (sp > XB_SPIN_CAP) { atomicAdd(&bar[XB_TMO], 1u); break; } }
    }
    nloc = mine > 0u ? mine : 1u; nx = cnt > 0u ? cnt : 1u;
}
__device__ __forceinline__ void xcd_barrier(unsigned char* ws, unsigned char* lds_raw_) {
    XcdBarrier b; b.bar = (unsigned*)(ws + WS_BAR); b.x = xb_xcc_id(); b.st = (volatile XLAS unsigned*)((XLAS unsigned char*)lds_raw_ + LDS_BARST_OFF);
    asm volatile("s_waitcnt vmcnt(0)" ::: "memory");
    __syncthreads();
    if (threadIdx.x == 0) {
        unsigned* bar = b.bar;
        __builtin_amdgcn_s_waitcnt(0);
        unsigned nloc = b.st[0], nx = b.st[1];
        if (nloc == 0u) { xcd_barrier_complete(bar, b.x, nloc, nx); b.st[0] = nloc; b.st[1] = nx; }
        const unsigned old = xb_add(&bar[XB_XSUB(b.x)], 1u);
        const unsigned gen = old / nloc;
        if (old + 1u == (gen + 1u) * nloc) {
            __builtin_amdgcn_fence(__ATOMIC_RELEASE, "agent");
            asm volatile("s_waitcnt vmcnt(0)" ::: "memory");
            const unsigned og = xb_add(&bar[XB_TOP], 1u);
            const unsigned tg = og / nx;
            if (og + 1u == (tg + 1u) * nx) xb_add(&bar[XB_TOPGEN], 1u);
            else XB_SPIN(xb_ld(&bar[XB_TOPGEN]) == tg, bar);
            __builtin_amdgcn_fence(__ATOMIC_ACQUIRE, "agent");
            xb_add(&bar[XB_XGEN(b.x)], 1u);
            asm volatile("s_waitcnt vmcnt(0)" ::: "memory");
        } else {
            XB_SPIN(xb_ld(&bar[XB_XGEN(b.x)]) == gen, bar);
            __builtin_amdgcn_fence(__ATOMIC_ACQUIRE, "agent");
            asm volatile("s_waitcnt vmcnt(0)" ::: "memory");
        }
    }
    __syncthreads();
}

__global__ void __launch_bounds__(NT, 2) mega_fwd(Params p) {
    extern __shared__ __attribute__((aligned(16))) unsigned char lds_raw[];
    float* lds = (float*)lds_raw;
    volatile XLAS unsigned* bst = (volatile XLAS unsigned*)((XLAS unsigned char*)lds_raw + LDS_BARST_OFF);
    if (threadIdx.x < 2) bst[threadIdx.x] = 0u;
    __syncthreads();
    (void)xcd_barrier_post((unsigned*)(p.ws + WS_BAR), bst);
#define GSYNC() xcd_barrier(p.ws, lds_raw)
    phase_p0a(p, lds);
#if FAST_G1 || FAST_G2 || FAST_MOE
    __syncthreads();
    phase_convert(p, lds);
#if DUP == 1
    __syncthreads(); phase_convert(p, lds);
#endif
#endif
    GSYNC();
    phase_p0b(p);
#if DUP == 10
    GSYNC(); __syncthreads(); phase_p0a(p, lds); GSYNC(); phase_p0b(p);
#endif
    GSYNC();
    _Pragma("unroll 1") for (int l = 0; l < L; ++l) {
        phase_r1(p, l, true);
#if DUP == 11
        if (l == 0) phase_r1(p, l, true);
#endif
        GSYNC();
#if FAST_G1
        phase_g1_fast(p, l, lds_raw);
#if DUP == 2
        phase_g1_fast(p, l, lds_raw);
#endif
#else
        phase_g1(p, l, lds);
#endif
        GSYNC();
#if !FAST_G1
        phase_zp(p, l);
        GSYNC();
#endif
        phase_ck_fast(p, l, lds_raw);
#if DUP == 3
        __syncthreads(); phase_ck_fast(p, l, lds_raw);
#endif
        GSYNC();
        phase_c2(p, l, lds);
        __syncthreads();
        phase_route(p, lds_raw);
#if DUP == 14
        __syncthreads(); phase_route(p, lds_raw);
#endif
        GSYNC();
#if FAST_ATT
        phase_att1(p, lds_raw);
#if DUP == 5
        __syncthreads(); phase_att1(p, lds_raw);
#endif
#if DUP == 15
        __syncthreads(); phase_att1(p, lds_raw, false, true);
#endif
        GSYNC();
        phase_att2(p, lds_raw);
#if DUP == 13
        __syncthreads(); phase_att2(p, lds_raw);
#endif
#else
        phase_att(p, lds);
#endif
        GSYNC();
#if FAST_G2
        phase_g2_fast(p, l, lds_raw);
#if DUP == 8
        if (l == 0) phase_g2_fast(p, l, lds_raw);
#endif
#else
        phase_g2(p, l, lds);
#endif
        GSYNC();
        phase_r2_fast(p, l, lds_raw);
#if DUP == 9
        __syncthreads(); phase_r2_fast(p, l, lds_raw);
#endif
        GSYNC();
        phase_sc_fast(p, l, lds_raw);
#if DUP == 12
        __syncthreads(); phase_sc_fast(p, l, lds_raw);
#endif
        GSYNC();
#if FAST_MOE
        phase_m1_fast(p, l, lds_raw);
#if DUP == 6
        phase_m1_fast(p, l, lds_raw);
#endif
#else
        phase_m1(p, l, lds);
#endif
        GSYNC();
#if FAST_MOE
        phase_m2_fast(p, l, lds_raw);
#if DUP == 7
        phase_m2_fast(p, l, lds_raw);
#endif
#else
        phase_m2(p, l, lds);
#endif
        GSYNC();
    }
    phase_r1(p, L, false);
}

extern "C" void kernel_launch(void* const* d_in, const int* in_sizes, int n_in, void* d_out, int out_size, void* d_ws, size_t ws_size, hipStream_t stream) {
    static int grid_blocks = 0;
    if (grid_blocks == 0) {
        if (n_in != 21 || out_size != T * D || ws_size < WS_END) { fprintf(stderr, "kernel_launch: unexpected shapes (n_in %d out %d ws %zu need %zu)\n", n_in, out_size, ws_size, (size_t)WS_END); grid_blocks = -1; return; }
        int dev = 0, cus = 0, per_cu = 0;
        hipGetDevice(&dev);
        hipDeviceGetAttribute(&cus, hipDeviceAttributeMultiprocessorCount, dev);
        hipFuncSetAttribute((const void*)mega_fwd, hipFuncAttributeMaxDynamicSharedMemorySize, LDS_BYTES);
        hipOccupancyMaxActiveBlocksPerMultiprocessor(&per_cu, (const void*)mega_fwd, NT, LDS_BYTES);
        if (per_cu < 1) { fprintf(stderr, "kernel_launch: occupancy query says %d blocks per CU\n", per_cu); per_cu = 1; }
        (void)hipGetLastError();
        grid_blocks = cus * 1;
    }
    if (grid_blocks < 0) return;
    if (hipMemsetAsync((char*)d_ws + WS_BAR, 0, 16384, stream) != hipSuccess) { fprintf(stderr, "kernel_launch: memset failed\n"); return; }
    Params p{};
    for (int i = 0; i < 21; ++i) p.in[i] = (const float*)d_in[i];
    p.out = (float*)d_out; p.ws = (unsigned char*)d_ws;
    hipLaunchKernelGGL(mega_fwd, dim3(grid_blocks), dim3(NT), LDS_BYTES, stream, p);
    hipError_t e = hipPeekAtLastError();
    if (e != hipSuccess) fprintf(stderr, "launch failed: %s (grid %d)\n", hipGetErrorString(e), grid_blocks);
}
```

```cpp
#include <hip/hip_runtime.h>
#include <hip/hip_cooperative_groups.h>
#include <cstdio>
#include <cstdint>
namespace cg = cooperative_groups;

constexpr int Bn = 2, S = 8192, D = 1024, L = 2, T = Bn * S;
constexpr int INW = 2840;
constexpr int NE = 32, TOPK = 4, DFF = 1024;
constexpr int A_TOT = T * TOPK;
constexpr int RMAX = A_TOT + NE * 256;
constexpr int NCMP = 511;
constexpr int NT = 512;
constexpr int NW = NT / 64;
constexpr int LDS_BYTES = 147456;
constexpr float EPS = 1e-6f;
constexpr float NEGF = -1e30f;

#ifndef FAST_G1
#define FAST_G1 1
#endif
#ifndef FAST_G2
#define FAST_G2 1
#endif
#ifndef DUP
#define DUP 0
#endif
#ifndef USE_CG_SYNC
#define USE_CG_SYNC 0
#endif
#ifndef FAST_ATT
#define FAST_ATT 1
#endif
#ifndef FAST_MOE
#define FAST_MOE 1
#endif
constexpr int ZBW = 3072;
constexpr int ZB_Q = 0, ZB_KC = 512, ZB_VC = 640, ZB_KS = 768, ZB_VS = 896, ZB_KW = 1024, ZB_VW = 1152, ZB_MQ = 1280, ZB_MK = 1792, ZB_MV = 2304, ZB_G = 2816;
constexpr float QSCALE = 0.125f * 1.4426950408889634f;
constexpr float LOG2E = 1.4426950408889634f;
constexpr int ZC_Q = 0, ZC_KC = 512, ZC_VC = 640, ZC_KS = 768, ZC_VS = 896, ZC_KW = 1024, ZC_VW = 1152, ZC_G = 1280, ZC_MQ = 1304, ZC_MK = 1816, ZC_MV = 2328;

constexpr size_t al256(size_t x) { return (x + 255) & ~(size_t)255; }
constexpr size_t WS_BAR = 0;
constexpr size_t WS_MODP = 16384;
constexpr size_t WS_MOD = al256(WS_MODP + (size_t)8 * L * Bn * 6144 * 4);
constexpr size_t WS_CNT = al256(WS_MOD + (size_t)L * Bn * 6144 * 4);
constexpr size_t WS_FILL = al256(WS_CNT + L * 32 * 4);
constexpr size_t WS_ROWTOK = al256(WS_FILL + L * 32 * 4);
constexpr size_t WS_ROWW = al256(WS_ROWTOK + (size_t)L * RMAX * 4);
constexpr size_t WS_TOKE = al256(WS_ROWW + (size_t)L * RMAX * 4);
constexpr size_t WS_TOKW = al256(WS_TOKE + (size_t)T * 4 * 4);
constexpr size_t WS_POS = al256(WS_TOKW + (size_t)T * 4 * 4);
constexpr size_t WS_HID = al256(WS_POS + (size_t)T * 4 * 4);
constexpr size_t WS_KC = al256(WS_HID + (size_t)2 * 2044 * 128 * 4);
constexpr size_t WS_VC = al256(WS_KC + (size_t)2044 * 64 * 4);
constexpr size_t WS_KM = al256(WS_VC + (size_t)2044 * 64 * 4);
constexpr size_t WS_H = al256(WS_KM + (size_t)Bn * 8 * 32 * 64 * 4);
constexpr size_t WS_Z = al256(WS_H + (size_t)T * D * 4);
constexpr size_t WS_ATT = al256(WS_Z + (size_t)T * INW * 4);
constexpr size_t WS_U = al256(WS_ATT + (size_t)T * D * 4);
constexpr size_t WS_Y = al256(WS_U + (FAST_MOE ? (size_t)0 : (size_t)RMAX * 2048 * 4));
constexpr size_t WS_WINT = al256(WS_Y + (size_t)RMAX * 1024 * 4);
constexpr size_t WS_WOT = al256(WS_WINT + (size_t)L * 3072 * 1024 * 2);
constexpr size_t WS_W1T = al256(WS_WOT + (size_t)L * 1024 * 1024 * 2);
constexpr size_t WS_W2T = al256(WS_W1T + (size_t)L * NE * 2048 * 1024 * 2);
constexpr size_t WS_XN = al256(WS_W2T + (size_t)L * NE * 1024 * 1024 * 2);
constexpr size_t WS_ATTB = al256(WS_XN + (size_t)(T + 1) * D * 2);
constexpr size_t WS_ACT = al256(WS_ATTB + (size_t)T * D * 2);
constexpr size_t WS_ZB = al256(WS_ACT + (size_t)RMAX * DFF * 2);
constexpr size_t WS_GATE = al256(WS_ZB + (size_t)T * ZBW * 2);
constexpr size_t WS_KCB = al256(WS_GATE + (size_t)T * 32 * 4);
constexpr size_t WS_VCB = al256(WS_KCB + (size_t)Bn * 2 * 512 * 64 * 2);
constexpr size_t WS_KMB = al256(WS_VCB + (size_t)Bn * 2 * 512 * 64 * 2);
constexpr size_t WS_XNLO = al256(WS_KMB + (size_t)Bn * 8 * 32 * 64 * 2);
constexpr size_t WS_BC = al256(WS_XNLO + (size_t)T * D * 2);
constexpr size_t WS_WCT = al256(WS_BC + (size_t)(T / 64) * 32 * 4);
constexpr size_t WS_CBP = al256(WS_WCT + (size_t)L * 2 * 128 * 2048 * 2);
constexpr size_t WS_CB = al256(WS_CBP + (size_t)16 * L * 2 * 128 * 4);
constexpr size_t WS_HIDP = al256(WS_CB + (size_t)L * 2 * 128 * 4);
constexpr size_t WS_SEL3 = al256(WS_HIDP + (size_t)4 * 2 * 2044 * 128 * 4);
constexpr size_t WS_LRK = al256(WS_SEL3 + (size_t)T * 8 * 4);
constexpr size_t WS_ILIST = al256(WS_LRK + (size_t)T * 8 * 4);
constexpr size_t WS_BCM = al256(WS_ILIST + (size_t)16 * 32 * 32 * 256);
constexpr size_t WS_PM = al256(WS_BCM + (size_t)16 * 32 * 32 * 4);
constexpr size_t WS_PL = al256(WS_PM + (size_t)16 * 25600 * 4);
constexpr size_t WS_PO = al256(WS_PL + (size_t)16 * 25600 * 4);
constexpr size_t WS_END = al256(WS_PO + (size_t)16 * 25600 * 64 * 2);

struct Params {
    const float* in[21];
    float* out;
    unsigned char* ws;
};

__device__ __forceinline__ int otid() { int t = threadIdx.x; asm volatile("" : "+v"(t)); return t; }
typedef unsigned short bf16_t;
__device__ __forceinline__ unsigned f2bf(float f) { unsigned u = __builtin_bit_cast(unsigned, f); return (u + 0x7fffu + ((u >> 16) & 1u)) >> 16; }
__device__ __forceinline__ unsigned pk2(float lo, float hi) { return f2bf(lo) | (f2bf(hi) << 16); }
__device__ __forceinline__ float bf2f(bf16_t v) { return __builtin_bit_cast(float, (unsigned)v << 16); }
__device__ __forceinline__ float wave_sum(float v) {
#pragma unroll
    for (int o = 1; o < 64; o <<= 1) v += __shfl_xor(v, o);
    return v;
}
__device__ __forceinline__ float sigmoidf_(float x) { return 1.f / (1.f + __expf(-x)); }
__device__ __forceinline__ float gelu_tanh(float x) {
    const float u = 0.7978845608028654f * (x + 0.044715f * x * x * x);
    return 0.5f * x * (1.f + tanhf(u));
}

template <class AL, class BL, class EP>
__device__ __forceinline__ void gemm_tile(float* lds, int m0, int n0, int K, const AL& al, const BL& bl, const EP& ep) {
    float* As = lds;
    float* Bs = lds + 16 * 132;
    const int tid = otid(), tx = tid & 15, ty = tid >> 4;
    const int ar = tid >> 2, ak = (tid & 3) * 4;
    const int bk = tid >> 5, bn = (tid & 31) * 2;
    float acc[4][4];
#pragma unroll
    for (int i = 0; i < 4; ++i)
#pragma unroll
        for (int j = 0; j < 4; ++j) acc[i][j] = 0.f;
    float4 av = al(m0 + ar, ak);
    float2 bv = bl(bk, n0 + bn);
    for (int k0 = 0; k0 < K; k0 += 16) {
        As[(ak + 0) * 132 + ar] = av.x; As[(ak + 1) * 132 + ar] = av.y; As[(ak + 2) * 132 + ar] = av.z; As[(ak + 3) * 132 + ar] = av.w;
        *(float2*)&Bs[bk * 68 + bn] = bv;
        __syncthreads();
        if (k0 + 16 < K) { av = al(m0 + ar, k0 + 16 + ak); bv = bl(k0 + 16 + bk, n0 + bn); }
#pragma unroll
        for (int kk = 0; kk < 16; ++kk) {
            const float4 a = *(const float4*)&As[kk * 132 + ty * 4];
            const float4 b = *(const float4*)&Bs[kk * 68 + tx * 4];
            const float a_[4] = {a.x, a.y, a.z, a.w}, b_[4] = {b.x, b.y, b.z, b.w};
#pragma unroll
            for (int i = 0; i < 4; ++i)
#pragma unroll
                for (int j = 0; j < 4; ++j) acc[i][j] += a_[i] * b_[j];
        }
        __syncthreads();
    }
#pragma unroll
    for (int i = 0; i < 4; ++i)
#pragma unroll
        for (int j = 0; j < 4; ++j) ep(m0 + ty * 4 + i, n0 + tx * 4 + j, acc[i][j]);
}

__device__ __forceinline__ void phase_p0a(const Params& p, float* lds) {
    const int tid = otid(), gtid = blockIdx.x * NT + tid, gsz = gridDim.x * NT;
    int* cnt = (int*)(p.ws + WS_CNT); int* fill = (int*)(p.ws + WS_FILL); int* rowtok = (int*)(p.ws + WS_ROWTOK);
    for (int i = gtid; i < L * 32; i += gsz) { cnt[i] = 0; fill[i] = 0; }
    for (int i = gtid; i < L * RMAX; i += gsz) rowtok[i] = -1;
    const float* c = p.in[1];
    for (int i = tid; i < Bn * D; i += NT) { const float v = c[i]; lds[i] = v / (1.f + __expf(-v)); }
    __syncthreads();
    const float* ada_w = p.in[2];
    float* modp = (float*)(p.ws + WS_MODP);
    for (int idx = gtid; idx < 8 * L * 6144; idx += gsz) {
        const int col = idx % 6144, l = (idx / 6144) % L, kc = idx / (6144 * L);
        const float* w = ada_w + ((size_t)l * D + kc * 128) * 6144 + col;
        float a0 = 0.f, a1 = 0.f;
#pragma unroll 8
        for (int k = 0; k < 128; ++k) { const float wv = w[(size_t)k * 6144]; a0 += lds[kc * 128 + k] * wv; a1 += lds[D + kc * 128 + k] * wv; }
        modp[((size_t)(kc * L + l) * Bn + 0) * 6144 + col] = a0;
        modp[((size_t)(kc * L + l) * Bn + 1) * 6144 + col] = a1;
    }
    { const float* posw = p.in[9]; const float* w1c = p.in[10]; float* cbp = (float*)(p.ws + WS_CBP);
      for (int idx = gtid; idx < 16 * L * 2 * 128; idx += gsz) {
          const int j = idx & 127, li = (idx >> 7) % (L * 2), kc = idx / (L * 2 * 128);
          const float* w = w1c + ((size_t)li * 2048 + kc * 128) * 128 + j; const float* pp = posw + (size_t)li * 2048 + kc * 128;
          float a = 0.f;
#pragma unroll 8
          for (int k = 0; k < 128; ++k) a += pp[k] * w[(size_t)k * 128];
          cbp[idx] = a; } }
}
__device__ __forceinline__ void phase_p0b(const Params& p) {
    const int gtid = blockIdx.x * NT + otid(), gsz = gridDim.x * NT;
    { const float* cbp = (const float*)(p.ws + WS_CBP); float* cb = (float*)(p.ws + WS_CB);
      for (int idx = gtid; idx < L * 2 * 128; idx += gsz) { float s = 0.f;
#pragma unroll
          for (int kc = 0; kc < 16; ++kc) s += cbp[kc * (L * 2 * 128) + idx];
          cb[idx] = s; } }
    const float* modp = (const float*)(p.ws + WS_MODP); float* mod = (float*)(p.ws + WS_MOD); const float* ada_b = p.in[3];
    for (int idx = gtid; idx < L * Bn * 6144; idx += gsz) {
        const int col = idx % 6144, l = idx / (Bn * 6144);
        float s = ada_b[l * 6144 + col];
#pragma unroll
        for (int kc = 0; kc < 8; ++kc) s += modp[(size_t)kc * L * Bn * 6144 + idx];
        mod[idx] = s;
    }
}

__device__ __forceinline__ void phase_r1(const Params& p, int l, bool do_h) {
    const int lane = otid() & 63, wave = otid() >> 6;
    const int gw = blockIdx.x * NW + wave, ngw = gridDim.x * NW;
    const float* mod = (const float*)(p.ws + WS_MOD);
    const float* xin = p.in[0]; float* XA = p.out; float* H = (float*)(p.ws + WS_H);
    const bf16_t* Y = (const bf16_t*)(p.ws + WS_Y); const int* pos = (const int*)(p.ws + WS_POS);
    const float* lng = p.in[4] + (size_t)(do_h ? l : 0) * D;
    bf16_t* XN = (bf16_t*)(p.ws + WS_XN);
    for (int t = gw; t < T; t += ngw) {
        const int b = t / S;
        float4 v[4];
        if (l == 0) {
#pragma unroll
            for (int j = 0; j < 4; ++j) v[j] = *(const float4*)(xin + (size_t)t * D + 4 * lane + 256 * j);
        } else {
            const float* g2 = mod + ((size_t)(l - 1) * Bn + b) * 6144 + 5 * D;
            const int p0 = pos[t * 4 + 0], p1 = pos[t * 4 + 1], p2 = pos[t * 4 + 2], p3 = pos[t * 4 + 3];
#pragma unroll
            for (int j = 0; j < 4; ++j) {
                const int col = 4 * lane + 256 * j;
                const float4 x = *(const float4*)(XA + (size_t)t * D + col);
                const uint2 q0 = *(const uint2*)(Y + (size_t)p0 * D + col), q1 = *(const uint2*)(Y + (size_t)p1 * D + col), q2 = *(const uint2*)(Y + (size_t)p2 * D + col), q3 = *(const uint2*)(Y + (size_t)p3 * D + col);
#define BF4(q) make_float4(__builtin_bit_cast(float, (q).x << 16), __builtin_bit_cast(float, (q).x & 0xffff0000u), __builtin_bit_cast(float, (q).y << 16), __builtin_bit_cast(float, (q).y & 0xffff0000u))
                const float4 y0 = BF4(q0), y1 = BF4(q1), y2 = BF4(q2), y3 = BF4(q3);
#undef BF4
                const float4 g = *(const float4*)(g2 + col);
                float4 r;
                r.x = x.x + g.x * (((y0.x + y1.x) + y2.x) + y3.x); r.y = x.y + g.y * (((y0.y + y1.y) + y2.y) + y3.y);
                r.z = x.z + g.z * (((y0.z + y1.z) + y2.z) + y3.z); r.w = x.w + g.w * (((y0.w + y1.w) + y2.w) + y3.w);
                v[j] = r;
                *(float4*)(XA + (size_t)t * D + col) = r;
            }
        }
        if (do_h) {
            float ss = 0.f;
#pragma unroll
            for (int j = 0; j < 4; ++j) ss += (v[j].x * v[j].x + v[j].y * v[j].y) + (v[j].z * v[j].z + v[j].w * v[j].w);
            ss = wave_sum(ss);
            const float r = rsqrtf(ss * (1.f / D) + EPS);
            const float* sh = mod + ((size_t)l * Bn + b) * 6144 + 0 * D; const float* sc = mod + ((size_t)l * Bn + b) * 6144 + 1 * D;
#pragma unroll
            for (int j = 0; j < 4; ++j) {
                const int col = 4 * lane + 256 * j;
                const float4 g = *(const float4*)(lng + col), s1 = *(const float4*)(sc + col), s0 = *(const float4*)(sh + col);
                float4 o;
                o.x = v[j].x * r * g.x * (1.f + s1.x) + s0.x; o.y = v[j].y * r * g.y * (1.f + s1.y) + s0.y;
                o.z = v[j].z * r * g.z * (1.f + s1.z) + s0.z; o.w = v[j].w * r * g.w * (1.f + s1.w) + s0.w;
                *(float4*)(H + (size_t)t * D + col) = o;
                *(uint2*)(XN + (size_t)t * D + col) = make_uint2(pk2(o.x, o.y), pk2(o.z, o.w));
            }
        }
    }
}

__device__ __forceinline__ void phase_g1(const Params& p, int l, float* lds) {
    const float* H = (const float*)(p.ws + WS_H); const float* W = p.in[6] + (size_t)l * D * INW; float* Z = (float*)(p.ws + WS_Z);
    constexpr int NTN = (INW + 63) / 64, NTM = T / 128;
    auto al = [=](int r, int k) -> float4 { return *(const float4*)(H + (size_t)r * D + k); };
    auto bl = [=](int k, int n) -> float2 { return n < INW ? *(const float2*)(W + (size_t)k * INW + n) : make_float2(0.f, 0.f); };
    auto ep = [=](int r, int c, float v) { if (c < INW) Z[(size_t)r * INW + c] = v; };
    for (int tile = blockIdx.x; tile < NTM * NTN; tile += gridDim.x) {
        const int tm = tile / NTN, tn = tile % NTN;
        gemm_tile(lds, tm * 128, tn * 64, D, al, bl, ep);
    }
}

__device__ __forceinline__ void phase_zp(const Params& p, int l) {
    const int lane = otid() & 63, wave = otid() >> 6;
    const int gw = blockIdx.x * NW + wave, ngw = gridDim.x * NW;
    float* Z = (float*)(p.ws + WS_Z);
    const float gq = p.in[7][l * 64 + lane], gk = p.in[8][l * 64 + lane], gmq = p.in[12][l * 64 + lane], gmk = p.in[13][l * 64 + lane];
    for (int t = gw; t < T; t += ngw) {
        float* z = Z + (size_t)t * INW;
        for (int seg = 0; seg < 28; ++seg) {
            int col; float g;
            if (seg < 8) { col = ZC_Q + seg * 64; g = gq; }
            else if (seg < 10) { col = ZC_KS + (seg - 8) * 64; g = gk; }
            else if (seg < 12) { col = ZC_KW + (seg - 10) * 64; g = gk; }
            else if (seg < 20) { col = ZC_MQ + (seg - 12) * 64; g = gmq; }
            else { col = ZC_MK + (seg - 20) * 64; g = gmk; }
            const float v = z[col + lane];
            const float ss = wave_sum(v * v);
            z[col + lane] = v * rsqrtf(ss * (1.f / 64.f) + EPS) * g;
        }
        if (lane < 24) z[ZC_G + lane] = sigmoidf_(z[ZC_G + lane]);
    }
}

__device__ __forceinline__ void phase_ck(const Params& p, int l, float* lds) {
    const bf16_t* Z = (const bf16_t*)(p.ws + WS_ZB);
    float* HID = (float*)(p.ws + WS_HID);
    const float* posw = p.in[9] + (size_t)l * 2 * 32 * 64; const float* w1 = p.in[10] + (size_t)l * 2 * 2048 * 128;
    for (int tile = blockIdx.x; tile < 64; tile += gridDim.x) {
        const int idx = tile / 32, tm = (tile % 32) / 2, tn = tile % 2;
        const float* W = w1 + (size_t)idx * 2048 * 128; const float* PW = posw + (size_t)idx * 32 * 64; float* HO = HID + (size_t)idx * 2044 * 128;
        auto al = [=](int r, int k) -> float4 {
            if (r >= 2044) return make_float4(0.f, 0.f, 0.f, 0.f);
            const int b = r / 1022, g = (r / 511) & 1, n = r % 511, li = k >> 6, d = k & 63;
            const uint2 ab = *(const uint2*)(Z + (size_t)(b * S + 16 * n + li) * ZBW + ZB_KC + idx * 128 + g * 64 + d);
            const float4 a = make_float4(__builtin_bit_cast(float, ab.x << 16), __builtin_bit_cast(float, ab.x & 0xffff0000u), __builtin_bit_cast(float, ab.y << 16), __builtin_bit_cast(float, ab.y & 0xffff0000u));
            const float4 q = *(const float4*)(PW + li * 64 + d);
            return make_float4(a.x + q.x, a.y + q.y, a.z + q.z, a.w + q.w);
        };
        auto bl = [=](int k, int n) -> float2 { return *(const float2*)(W + (size_t)k * 128 + n); };
        auto ep = [=](int r, int c, float v) { if (r < 2044) HO[(size_t)r * 128 + c] = gelu_tanh(v); };
        gemm_tile(lds, tm * 128, tn * 64, 2048, al, bl, ep);
    }
    const int lane = otid() & 63, wave = otid() >> 6;
    float* KM = (float*)(p.ws + WS_KM);
    for (int it = blockIdx.x * NW + wave; it < Bn * 8 * 32; it += gridDim.x * NW) {
        const int b = it / 256, h = (it / 32) & 7, blk = it & 31;
        const bf16_t* base = Z + (size_t)(b * S + blk * 256) * ZBW + ZB_MK + h * 64 + lane;
        float s = 0.f;
        for (int i = 0; i < 256; ++i) s += bf2f(base[(size_t)i * ZBW]);
        KM[(size_t)it * 64 + lane] = s * (1.f / 256.f);
        ((bf16_t*)(p.ws + WS_KMB))[(size_t)it * 64 + lane] = (bf16_t)f2bf(s * (1.f / 256.f));
    }
}
__device__ __forceinline__ void phase_c2(const Params& p, int l, float* lds) {
    const int lane = otid() & 63, wave = otid() >> 6;
    const float* HIDP = (const float*)(p.ws + WS_HIDP); const float* cb = (const float*)(p.ws + WS_CB) + l * 2 * 128; const float* w2 = p.in[11] + (size_t)l * 2 * 128 * 64;
    const float gk = p.in[8][l * 64 + lane];
    float* hl = lds + wave * 128;
    for (int r = blockIdx.x * NW + wave; r < 2 * 2044; r += gridDim.x * NW) {
        const int idx = r / 2044, rr = r % 2044;
#pragma unroll
        for (int q = 0; q < 2; ++q) { const int j = lane + 64 * q; float s = cb[idx * 128 + j];
#pragma unroll
            for (int kq = 0; kq < 4; ++kq) s += HIDP[((size_t)(kq * 2 + idx) * 2044 + rr) * 128 + j];
            hl[j] = gelu_tanh(s); }
        asm volatile("s_waitcnt lgkmcnt(0)" ::: "memory"); __builtin_amdgcn_wave_barrier();
        const float* W = w2 + (size_t)idx * 128 * 64;
        float s = 0.f;
#pragma unroll 8
        for (int j = 0; j < 128; ++j) s += hl[j] * W[j * 64 + lane];
        asm volatile("s_waitcnt lgkmcnt(0)" ::: "memory"); __builtin_amdgcn_wave_barrier();
        const int bgi = rr / 511, n = rr % 511;
        if (idx == 0) { const float ss = wave_sum(s * s); const float kv = s * rsqrtf(ss * (1.f / 64.f) + EPS) * gk; ((bf16_t*)(p.ws + WS_KCB))[((size_t)bgi * 512 + n) * 64 + lane] = (bf16_t)f2bf(kv); }
        else { ((bf16_t*)(p.ws + WS_VCB))[((size_t)bgi * 512 + n) * 64 + lane] = (bf16_t)f2bf(s); }
    }
    if (blockIdx.x == 0 && otid() < 2 * 4 * 64) { const int i = otid(); bf16_t* dst = (bf16_t*)(p.ws + (i < 256 ? WS_KCB : WS_VCB)); dst[((size_t)((i & 255) >> 6) * 512 + 511) * 64 + (i & 63)] = 0; }
}

__device__ __forceinline__ void ld32bf(const bf16_t* p, float (&out)[32]) {
#pragma unroll
    for (int c = 0; c < 4; ++c) { const uint4 v = *(const uint4*)(p + 8 * c); const unsigned w[4] = {v.x, v.y, v.z, v.w};
#pragma unroll
        for (int i = 0; i < 4; ++i) { out[8 * c + 2 * i] = __builtin_bit_cast(float, w[i] << 16); out[8 * c + 2 * i + 1] = __builtin_bit_cast(float, w[i] & 0xffff0000u); } }
}
#define ATT_KEY(valid, kp, vp, bias)                                                              \
    {                                                                                             \
        float kk_[32]; ld32bf(kp, kk_);                                                           \
        float s_ = 0.f;                                                                           \
        _Pragma("unroll") for (int d = 0; d < 32; ++d) s_ += qv[d] * kk_[d];                      \
        s_ += __shfl_xor(s_, 1);                                                                  \
        s_ = s_ - (bias);                                                                         \
        if (valid) {                                                                              \
            float vv_[32]; ld32bf(vp, vv_);                                                       \
            if (s_ > m) { const float cf = exp2f(m - s_); lsum *= cf; _Pragma("unroll") for (int d = 0; d < 32; ++d) o[d] *= cf; m = s_; } \
            const float p_ = exp2f(s_ - m); lsum += p_;                                           \
            _Pragma("unroll") for (int d = 0; d < 32; ++d) o[d] += p_ * vv_[d];                   \
        }                                                                                         \
    }

__device__ __forceinline__ void nsa_item(const Params& p, int item, float* lds) {
    const int tid = otid(), q = (tid & 63) >> 1, half = tid & 1, h = __builtin_amdgcn_readfirstlane(tid >> 6), g = h >> 2, hg = h & 3;
    const int b = item >> 8, ci = item & 255, t0 = ci * 32, t = t0 + q, cur = t0 >> 6; const size_t tt = (size_t)b * S + t;
    const bf16_t* Z = (const bf16_t*)(p.ws + WS_ZB); const float* GT = (const float*)(p.ws + WS_GATE); float* ATT = (float*)(p.ws + WS_ATT);
    const float* KC = (const float*)(p.ws + WS_KC) + (size_t)(b * 2 + g) * NCMP * 64 + half * 32; const float* VC = (const float*)(p.ws + WS_VC) + (size_t)(b * 2 + g) * NCMP * 64 + half * 32;
    float* imp = lds;
    unsigned* selm = (unsigned*)(lds + 2 * 32 * 129);
    const float slope = exp2f(-(float)(h + 1)) * LOG2E;
    float qv[32], o[32];
    ld32bf(Z + tt * ZBW + ZB_Q + h * 64 + half * 32, qv);
    const float g0 = GT[tt * 32 + h * 3 + 0], g1 = GT[tt * 32 + h * 3 + 1], g2 = GT[tt * 32 + h * 3 + 2];
    for (int i = tid; i < 2 * 32 * 129; i += NT) imp[i] = 0.f;
    const int cnt_t = t >= 31 ? (t - 31) / 16 + 1 : 0;
    const int cnt_max = (t0 + 31 - 31) / 16 + 1;
    float m = NEGF, lsum = 0.f;
    _Pragma("unroll 1") for (int n = 0; n < cnt_max; ++n) {
        const float* kp = KC + (size_t)n * 64;
        float s_ = 0.f;
#pragma unroll
        for (int d = 0; d < 32; ++d) s_ += qv[d] * kp[d];
        s_ += __shfl_xor(s_, 1);
        s_ = s_ - slope * ((float)t - (16.f * n + 15.5f));
        if (n < cnt_t) { if (s_ > m) { lsum *= exp2f(m - s_); m = s_; } lsum += exp2f(s_ - m); }
    }
    const float linv = lsum > 0.f ? 1.f / lsum : 0.f;
#pragma unroll
    for (int d = 0; d < 32; ++d) o[d] = 0.f;
    __syncthreads();
    _Pragma("unroll 1") for (int r = 0; r < 4; ++r) {
        if (hg == r) {
            float* myimp = imp + (size_t)(g * 32 + q) * 129;
            _Pragma("unroll 1") for (int n = 0; n < cnt_max; ++n) {
                const float* kp = KC + (size_t)n * 64; const float* vp = VC + (size_t)n * 64;
                float s_ = 0.f;
#pragma unroll
                for (int d = 0; d < 32; ++d) s_ += qv[d] * kp[d];
                s_ += __shfl_xor(s_, 1);
                s_ = s_ - slope * ((float)t - (16.f * n + 15.5f));
                if (n < cnt_t) {
                    const float p_ = exp2f(s_ - m) * linv;
#pragma unroll
                    for (int d = 0; d < 32; ++d) o[d] += p_ * vp[d];
                    if (half == 0) {
                        myimp[n >> 2] += p_;
                        if ((n & 3) == 3) myimp[(n + 1) >> 2] += p_;
                    }
                }
            }
        }
        __syncthreads();
    }
    {
        float* ao = ATT + tt * D + h * 64 + half * 32;
#pragma unroll
        for (int d = 0; d < 32; d += 4) *(float4*)(ao + d) = make_float4(g0 * o[d], g0 * o[d + 1], g0 * o[d + 2], g0 * o[d + 3]);
    }
    if (hg == 0 && half == 0) {
        float* myimp = imp + (size_t)(g * 32 + q) * 129;
        _Pragma("unroll 1") for (int j = 0; j < 128; ++j) {
            float v = myimp[j];
            if (j == 0 || j == cur || j == cur - 1) v = 1e4f;
            if (j > cur) v = NEGF;
            myimp[j] = v;
        }
        unsigned mk0 = 0u, mk1 = 0u, mk2 = 0u, mk3 = 0u;
        _Pragma("unroll 1") for (int it = 0; it < 16; ++it) {
            float best = -3e38f; int bi = -1;
            _Pragma("unroll 4") for (int j = 0; j < 128; ++j) { const float v = myimp[j]; if (v > best) { best = v; bi = j; } }
            if (best <= NEGF) break;
            myimp[bi] = -3.4e38f;
            const unsigned bit = 1u << (bi & 31);
            if ((bi >> 5) == 0) mk0 |= bit; else if ((bi >> 5) == 1) mk1 |= bit; else if ((bi >> 5) == 2) mk2 |= bit; else mk3 |= bit;
        }
        unsigned* sm = selm + (g * 32 + q) * 4;
        sm[0] = mk0; sm[1] = mk1; sm[2] = mk2; sm[3] = mk3;
    }
    __syncthreads();
    {
        const unsigned* sm = selm + (g * 32 + q) * 4;
        const unsigned m0 = sm[0], m1 = sm[1], m2 = sm[2], m3 = sm[3];
        m = NEGF; lsum = 0.f;
#pragma unroll
        for (int d = 0; d < 32; ++d) o[d] = 0.f;
        _Pragma("unroll 1") for (int j = 0; j <= cur; ++j) {
            const unsigned w = (j >> 5) == 0 ? m0 : (j >> 5) == 1 ? m1 : (j >> 5) == 2 ? m2 : m3;
            const bool sel = (w >> (j & 31)) & 1u;
            if (__ballot(sel) == 0ull) continue;
            _Pragma("unroll 1") for (int kk = 0; kk < 64; ++kk) {
                const int ps = j * 64 + kk;
                const bf16_t* kp = Z + (size_t)(b * S + ps) * ZBW + ZB_KS + g * 64 + half * 32; const bf16_t* vp = Z + (size_t)(b * S + ps) * ZBW + ZB_VS + g * 64 + half * 32;
                const bool valid = sel && ps <= t;
                ATT_KEY(valid, kp, vp, slope * (float)(t - ps));
            }
        }
        const float li = lsum > 0.f ? g1 / lsum : 0.f;
        float* ao = ATT + tt * D + h * 64 + half * 32;
#pragma unroll
        for (int d = 0; d < 32; d += 4) { float4 a = *(float4*)(ao + d); a.x += li * o[d]; a.y += li * o[d + 1]; a.z += li * o[d + 2]; a.w += li * o[d + 3]; *(float4*)(ao + d) = a; }
    }
    {
        m = NEGF; lsum = 0.f;
#pragma unroll
        for (int d = 0; d < 32; ++d) o[d] = 0.f;
        const int lo = t0 - 511 > 0 ? t0 - 511 : 0;
        _Pragma("unroll 1") for (int ps = lo; ps <= t0 + 31; ++ps) {
            const bf16_t* kp = Z + (size_t)(b * S + ps) * ZBW + ZB_KW + g * 64 + half * 32; const bf16_t* vp = Z + (size_t)(b * S + ps) * ZBW + ZB_VW + g * 64 + half * 32;
            const bool valid = ps <= t && ps > t - 512;
            ATT_KEY(valid, kp, vp, slope * (float)(t - ps));
        }
        const float li = lsum > 0.f ? g2 / lsum : 0.f;
        float* ao = ATT + tt * D + h * 64 + half * 32;
        bf16_t* ab = (bf16_t*)(p.ws + WS_ATTB) + tt * D + h * 64 + half * 32;
#pragma unroll
        for (int d = 0; d < 32; d += 4) { float4 a = *(float4*)(ao + d); a.x += li * o[d]; a.y += li * o[d + 1]; a.z += li * o[d + 2]; a.w += li * o[d + 3]; *(float4*)(ao + d) = a;
            *(uint2*)(ab + d) = make_uint2(pk2(a.x, a.y), pk2(a.z, a.w)); }
    }
    __syncthreads();
}

__device__ __forceinline__ void moba_item(const Params& p, int item) {
    const int tid = otid(), q = (tid & 63) >> 1, half = tid & 1, h = __builtin_amdgcn_readfirstlane(tid >> 6);
    const int b = item >> 8, ci = item & 255, t0 = ci * 32, t = t0 + q, cb = t0 >> 8; const size_t tt = (size_t)b * S + t;
    const bf16_t* Z = (const bf16_t*)(p.ws + WS_ZB); const float* GT = (const float*)(p.ws + WS_GATE); float* ATT = (float*)(p.ws + WS_ATT);
    const float* KM = (const float*)(p.ws + WS_KM) + (size_t)(b * 8 + h) * 32 * 64 + half * 32;
    const float slope = exp2f(-(float)(h + 1)) * LOG2E;
    float qv[32], o[32];
    ld32bf(Z + tt * ZBW + ZB_MQ + h * 64 + half * 32, qv);
    float v1 = NEGF, v2 = NEGF, v3 = NEGF; int i1 = -1, i2 = -1, i3 = -1;
    _Pragma("unroll 1") for (int n = 0; n < cb; ++n) {
        const float* kp = KM + n * 64;
        float s_ = 0.f;
#pragma unroll
        for (int d = 0; d < 32; ++d) s_ += qv[d] * kp[d];
        s_ += __shfl_xor(s_, 1);
        if (s_ > v1) { v3 = v2; i3 = i2; v2 = v1; i2 = i1; v1 = s_; i1 = n; }
        else if (s_ > v2) { v3 = v2; i3 = i2; v2 = s_; i2 = n; }
        else if (s_ > v3) { v3 = s_; i3 = n; }
    }
    float m = NEGF, lsum = 0.f;
#pragma unroll
    for (int d = 0; d < 32; ++d) o[d] = 0.f;
    _Pragma("unroll 1") for (int n = 0; n < cb; ++n) {
        const bool sel = (n == i1) || (n == i2) || (n == i3);
        if (__ballot(sel) == 0ull) continue;
        _Pragma("unroll 1") for (int kk = 0; kk < 256; ++kk) {
            const int ps = n * 256 + kk;
            const bf16_t* kp = Z + (size_t)(b * S + ps) * ZBW + ZB_MK + h * 64 + half * 32; const bf16_t* vp = Z + (size_t)(b * S + ps) * ZBW + ZB_MV + h * 64 + half * 32;
            ATT_KEY(sel, kp, vp, slope * (float)(t - ps));
        }
    }
    _Pragma("unroll 1") for (int ps = cb * 256; ps <= t0 + 31; ++ps) {
        const bf16_t* kp = Z + (size_t)(b * S + ps) * ZBW + ZB_MK + h * 64 + half * 32; const bf16_t* vp = Z + (size_t)(b * S + ps) * ZBW + ZB_MV + h * 64 + half * 32;
        const bool valid = ps <= t;
        ATT_KEY(valid, kp, vp, slope * (float)(t - ps));
    }
    const float li = lsum > 0.f ? 1.f / lsum : 0.f;
    float* ao = ATT + tt * D + 512 + h * 64 + half * 32;
#pragma unroll
    for (int d = 0; d < 32; d += 4) *(float4*)(ao + d) = make_float4(li * o[d], li * o[d + 1], li * o[d + 2], li * o[d + 3]);
    bf16_t* ab = (bf16_t*)(p.ws + WS_ATTB) + tt * D + 512 + h * 64 + half * 32;
#pragma unroll
    for (int d = 0; d < 32; d += 4) *(uint2*)(ab + d) = make_uint2(pk2(li * o[d], li * o[d + 1]), pk2(li * o[d + 2], li * o[d + 3]));
}

__device__ __forceinline__ void phase_att(const Params& p, float* lds) {
    for (int pi = blockIdx.x; pi < 512; pi += gridDim.x) {
        nsa_item(p, pi, lds);
        moba_item(p, (pi & 256) | (255 - (pi & 255)));
    }
}

__device__ __forceinline__ void phase_g2(const Params& p, int l, float* lds) {
    const float* A = (const float*)(p.ws + WS_ATT); const float* W = p.in[14] + (size_t)l * D * D;
    const float* xin = l == 0 ? p.in[0] : p.out; float* XA = p.out;
    const float* mod = (const float*)(p.ws + WS_MOD) + (size_t)l * Bn * 6144 + 2 * D;
    auto al = [=](int r, int k) -> float4 { return *(const float4*)(A + (size_t)r * D + k); };
    auto bl = [=](int k, int n) -> float2 { return *(const float2*)(W + (size_t)k * D + n); };
    auto ep = [=](int r, int c, float v) { const int b = r / S; XA[(size_t)r * D + c] = xin[(size_t)r * D + c] + mod[(size_t)b * 6144 + c] * v; };
    for (int tile = blockIdx.x; tile < (T / 128) * (D / 64); tile += gridDim.x) {
        const int tm = tile / (D / 64), tn = tile % (D / 64);
        gemm_tile(lds, tm * 128, tn * 64, D, al, bl, ep);
    }
}

__device__ __forceinline__ void phase_r2(const Params& p, int l, float* lds, bool commit = true) {
    const int tid = otid(), lane = tid & 63, wave = tid >> 6;
    const int gw = blockIdx.x * NW + wave, ngw = gridDim.x * NW;
    const float* mod = (const float*)(p.ws + WS_MOD);
    const float* XA = p.out; float* H = (float*)(p.ws + WS_H);
    const float* lng = p.in[5] + (size_t)l * D; const float* rw = p.in[15] + (size_t)l * D * NE; const float* rb = p.in[16] + l * NE;
    int* toke = (int*)(p.ws + WS_TOKE); float* tokw = (float*)(p.ws + WS_TOKW); int* cnt = (int*)(p.ws + WS_CNT) + l * 32;
    bf16_t* XN = (bf16_t*)(p.ws + WS_XN);
    float* hrow = lds + wave * D;
    int* hist = (int*)(lds + NW * D);
    if (tid < 32) hist[tid] = 0;
    __syncthreads();
    for (int t = gw; t < T; t += ngw) {
        const int b = t / S;
        float4 v[4]; float ss = 0.f;
#pragma unroll
        for (int j = 0; j < 4; ++j) { v[j] = *(const float4*)(XA + (size_t)t * D + 4 * lane + 256 * j); ss += (v[j].x * v[j].x + v[j].y * v[j].y) + (v[j].z * v[j].z + v[j].w * v[j].w); }
        ss = wave_sum(ss);
        const float r = rsqrtf(ss * (1.f / D) + EPS);
        const float* sh = mod + ((size_t)l * Bn + b) * 6144 + 3 * D; const float* sc = mod + ((size_t)l * Bn + b) * 6144 + 4 * D;
#pragma unroll
        for (int j = 0; j < 4; ++j) {
            const int col = 4 * lane + 256 * j;
            const float4 g = *(const float4*)(lng + col), s1 = *(const float4*)(sc + col), s0 = *(const float4*)(sh + col);
            float4 o;
            o.x = v[j].x * r * g.x * (1.f + s1.x) + s0.x; o.y = v[j].y * r * g.y * (1.f + s1.y) + s0.y;
            o.z = v[j].z * r * g.z * (1.f + s1.z) + s0.z; o.w = v[j].w * r * g.w * (1.f + s1.w) + s0.w;
            *(float4*)(H + (size_t)t * D + col) = o;
            *(uint2*)(XN + (size_t)t * D + col) = make_uint2(pk2(o.x, o.y), pk2(o.z, o.w));
            *(float4*)(hrow + col) = o;
        }
        asm volatile("s_waitcnt lgkmcnt(0)" ::: "memory");
        __builtin_amdgcn_wave_barrier();
        const int e = lane & 31, half = lane >> 5;
        float acc = 0.f;
        for (int k = half * 512; k < half * 512 + 512; ++k) acc += hrow[k] * rw[(size_t)k * NE + e];
        acc += __shfl_xor(acc, 32);
        const float logit = acc + rb[e];
        float lg[32];
#pragma unroll
        for (int i = 0; i < 32; ++i) lg[i] = __shfl(logit, i);
        int s0i = 0, s1i = 0, s2i = 0, s3i = 0; float a0 = -3e38f, a1 = -3e38f, a2 = -3e38f, a3 = -3e38f;
#pragma unroll
        for (int i = 0; i < 32; ++i) if (lg[i] > a0) { a0 = lg[i]; s0i = i; }
#pragma unroll
        for (int i = 0; i < 32; ++i) if (i != s0i && lg[i] > a1) { a1 = lg[i]; s1i = i; }
#pragma unroll
        for (int i = 0; i < 32; ++i) if (i != s0i && i != s1i && lg[i] > a2) { a2 = lg[i]; s2i = i; }
#pragma unroll
        for (int i = 0; i < 32; ++i) if (i != s0i && i != s1i && i != s2i && lg[i] > a3) { a3 = lg[i]; s3i = i; }
        const float e0 = 1.f, e1 = __expf(a1 - a0), e2 = __expf(a2 - a0), e3 = __expf(a3 - a0);
        const float inv = 1.f / (((e0 + e1) + e2) + e3);
        if (lane == 0) {
            toke[t * 4 + 0] = s0i; toke[t * 4 + 1] = s1i; toke[t * 4 + 2] = s2i; toke[t * 4 + 3] = s3i;
            tokw[t * 4 + 0] = e0 * inv; tokw[t * 4 + 1] = e1 * inv; tokw[t * 4 + 2] = e2 * inv; tokw[t * 4 + 3] = e3 * inv;
            if (commit) { atomicAdd(&hist[s0i], 1); atomicAdd(&hist[s1i], 1); atomicAdd(&hist[s2i], 1); atomicAdd(&hist[s3i], 1); }
        }
        __builtin_amdgcn_wave_barrier();
    }
    __syncthreads();
    if (tid < 32 && hist[tid] != 0) atomicAdd(&cnt[tid], hist[tid]);
}

__device__ __forceinline__ void load_pstart(const Params& p, int l, int* ps) {
    const int* cnt = (const int*)(p.ws + WS_CNT) + l * 32;
    if (otid() == 0) { int s = 0; for (int e = 0; e < 32; ++e) { ps[e] = s; s += (cnt[e] + 255) & ~255; } ps[32] = s; }
    __syncthreads();
}

__device__ __forceinline__ void phase_sc(const Params& p, int l, float* lds) {
    int* ps = (int*)lds;
    load_pstart(p, l, ps);
    const int gtid = blockIdx.x * NT + otid(), gsz = gridDim.x * NT;
    const int* toke = (const int*)(p.ws + WS_TOKE); const float* tokw = (const float*)(p.ws + WS_TOKW);
    int* fill = (int*)(p.ws + WS_FILL) + l * 32; int* rowtok = (int*)(p.ws + WS_ROWTOK) + (size_t)l * RMAX; float* roww = (float*)(p.ws + WS_ROWW) + (size_t)l * RMAX;
    int* pos = (int*)(p.ws + WS_POS);
    for (int i = gtid; i < A_TOT; i += gsz) {
        const int e = toke[i];
        const int slot = ps[e] + atomicAdd(&fill[e], 1);
        rowtok[slot] = i >> 2; roww[slot] = tokw[i]; pos[i] = slot;
    }
    __syncthreads();
}

__device__ __forceinline__ void phase_m1(const Params& p, int l, float* lds) {
    int* ps = (int*)(lds + 16 * 132 + 16 * 68);
    load_pstart(p, l, ps);
    const int rused = ps[32];
    const float* H = (const float*)(p.ws + WS_H); float* U = (float*)(p.ws + WS_U);
    const int* rowtok = (const int*)(p.ws + WS_ROWTOK) + (size_t)l * RMAX;
    const int ntm = rused / 128, ntn = 2048 / 64;
    for (int tile = blockIdx.x; tile < ntm * ntn; tile += gridDim.x) {
        const int tm = tile / ntn, tn = tile % ntn;
        int e = 0; for (int i = 1; i < 32; ++i) if (ps[i] <= tm * 128) e = i;
        const float* W = p.in[17] + ((size_t)l * NE + e) * D * 2048; const float* b1 = p.in[18] + ((size_t)l * NE + e) * 2048;
        auto al = [=](int r, int k) -> float4 { const int tk = rowtok[r]; return tk >= 0 ? *(const float4*)(H + (size_t)tk * D + k) : make_float4(0.f, 0.f, 0.f, 0.f); };
        auto bl = [=](int k, int n) -> float2 { return *(const float2*)(W + (size_t)k * 2048 + n); };
        auto ep = [=](int r, int c, float v) { U[(size_t)r * 2048 + c] = v + b1[c]; };
        gemm_tile(lds, tm * 128, tn * 64, D, al, bl, ep);
    }
    __syncthreads();
}
__device__ __forceinline__ void phase_m2(const Params& p, int l, float* lds) {
    int* ps = (int*)(lds + 16 * 132 + 16 * 68);
    load_pstart(p, l, ps);
    const int rused = ps[32];
    const float* U = (const float*)(p.ws + WS_U); float* Y = (float*)(p.ws + WS_Y);
    const float* roww = (const float*)(p.ws + WS_ROWW) + (size_t)l * RMAX;
    const int ntm = rused / 128, ntn = D / 64;
    for (int tile = blockIdx.x; tile < ntm * ntn; tile += gridDim.x) {
        const int tm = tile / ntn, tn = tile % ntn;
        int e = 0; for (int i = 1; i < 32; ++i) if (ps[i] <= tm * 128) e = i;
        const float* W = p.in[19] + ((size_t)l * NE + e) * DFF * D; const float* b2 = p.in[20] + ((size_t)l * NE + e) * D;
        auto al = [=](int r, int k) -> float4 {
            const float4 gg = *(const float4*)(U + (size_t)r * 2048 + k), ll = *(const float4*)(U + (size_t)r * 2048 + 1024 + k);
            const float g_[4] = {gg.x, gg.y, gg.z, gg.w}, l_[4] = {ll.x, ll.y, ll.z, ll.w}; float o_[4];
#pragma unroll
            for (int i = 0; i < 4; ++i) { const float gc = fminf(g_[i], 7.f), lc = fminf(fmaxf(l_[i], -7.f), 7.f); o_[i] = (lc + 1.f) * gc * sigmoidf_(1.702f * gc); }
            return make_float4(o_[0], o_[1], o_[2], o_[3]);
        };
        auto bl = [=](int k, int n) -> float2 { return *(const float2*)(W + (size_t)k * D + n); };
        auto ep = [=](int r, int c, float v) { Y[(size_t)r * D + c] = (v + b2[c]) * roww[r]; };
        gemm_tile(lds, tm * 128, tn * 64, DFF, al, bl, ep);
    }
    __syncthreads();
}


template <int MAP>
__device__ __forceinline__ void tr_tile(const float* W, int Nsrc, bf16_t* WT, int K, int k0, int n0, float* scr, int lane) {
    const int nl = (lane & 15) * 4, kr = lane >> 4;
    int sc = n0 + nl;
    if (MAP == 1) { sc = sc < 1280 ? sc : (sc < 2816 ? sc + 24 : (sc < 2840 ? sc - 2816 + 1280 : -1)); }
    float4 v[16];
#pragma unroll
    for (int it = 0; it < 16; ++it) { if (sc >= 0) { const float* src_ = W + (size_t)(k0 + it * 4 + kr) * Nsrc + sc; typedef float f4v __attribute__((ext_vector_type(4))); const f4v t_ = __builtin_nontemporal_load((const f4v*)src_); v[it] = make_float4(t_[0], t_[1], t_[2], t_[3]); } else v[it] = make_float4(0.f, 0.f, 0.f, 0.f); }
#pragma unroll
    for (int it = 0; it < 16; ++it) { float* s = scr + (it * 4 + kr) * 65 + nl; s[0] = v[it].x; s[1] = v[it].y; s[2] = v[it].z; s[3] = v[it].w; }
    asm volatile("s_waitcnt lgkmcnt(0)" ::: "memory"); __builtin_amdgcn_wave_barrier();
    const int c = lane & 7, nr = lane >> 3;
#pragma unroll
    for (int it = 0; it < 8; ++it) {
        const int n = it * 8 + nr; const float* s = scr + (8 * c) * 65 + n;
        uint4 o; o.x = pk2(s[0], s[65]); o.y = pk2(s[2 * 65], s[3 * 65]); o.z = pk2(s[4 * 65], s[5 * 65]); o.w = pk2(s[6 * 65], s[7 * 65]);
        *(uint4*)(WT + (size_t)(n0 + n) * K + k0 + 8 * c) = o;
    }
    asm volatile("s_waitcnt lgkmcnt(0)" ::: "memory"); __builtin_amdgcn_wave_barrier();
}
__device__ __forceinline__ void phase_convert(const Params& p, float* lds) {
    const int tid = otid(), lane = tid & 63, wave = tid >> 6;
    float* scr = lds + wave * (64 * 65);
    const int gw = blockIdx.x * NW + wave, ngw = gridDim.x * NW;
    bf16_t* WinT = (bf16_t*)(p.ws + WS_WINT); bf16_t* WoT = (bf16_t*)(p.ws + WS_WOT); bf16_t* W1T = (bf16_t*)(p.ws + WS_W1T); bf16_t* W2T = (bf16_t*)(p.ws + WS_W2T);
    constexpr int I_IN = L * 16 * (ZBW / 64), I_O = L * 16 * 16, I_1 = L * NE * 16 * 32, I_2 = L * NE * 16 * 16, I_C = L * 2 * 32 * 2;
    for (int it = gw; it < I_C + I_IN + I_O + I_1 + I_2; it += ngw) {
        int r = it;
        if (r < I_C) { const int li = r / 64, q = r % 64, kb = q / 2, nb = q % 2;
            tr_tile<0>(p.in[10] + (size_t)li * 2048 * 128, 128, (bf16_t*)(p.ws + WS_WCT) + (size_t)li * 128 * 2048, 2048, kb * 64, nb * 64, scr, lane); continue; }
        r -= I_C;
        if (r < I_IN) { const int l = r / (16 * 48), q = r % (16 * 48), kb = q / 48, nb = q % 48;
            tr_tile<1>(p.in[6] + (size_t)l * D * INW, INW, WinT + (size_t)l * ZBW * D, D, kb * 64, nb * 64, scr, lane); continue; }
        r -= I_IN;
        if (r < I_O) { const int l = r / 256, q = r % 256, kb = q / 16, nb = q % 16;
            tr_tile<0>(p.in[14] + (size_t)l * D * D, D, WoT + (size_t)l * D * D, D, kb * 64, nb * 64, scr, lane); continue; }
        r -= I_O;
        if (r < I_1) { const int le = r / 512, q = r % 512, kb = q / 32, nb = q % 32;
            tr_tile<0>(p.in[17] + (size_t)le * D * 2048, 2048, W1T + (size_t)le * 2048 * D, D, kb * 64, nb * 64, scr, lane); continue; }
        r -= I_1;
        { const int le = r / 256, q = r % 256, kb = q / 16, nb = q % 16;
            tr_tile<0>(p.in[19] + (size_t)le * DFF * D, D, W2T + (size_t)le * D * DFF, DFF, kb * 64, nb * 64, scr, lane); }
    }
    if (blockIdx.x == 0) { bf16_t* XN = (bf16_t*)(p.ws + WS_XN); for (int i = tid; i < D / 2; i += NT) ((unsigned*)(XN + (size_t)T * D))[i] = 0u; }
}

namespace pg8 {
#define PG8_LAS __attribute__((address_space(3)))
typedef short bf16x8 __attribute__((ext_vector_type(8)));
typedef float f32x4 __attribute__((ext_vector_type(4)));
typedef unsigned u32x4 __attribute__((ext_vector_type(4)));
constexpr int BM = 256, BK = 64, HALF = 128, HTB = HALF * BK * 2, STAGE_BYTES = 8 * HTB, NXCD = 8, WGM = 8;
__device__ __forceinline__ int lds_byte(int r, int c) { const int st = (r >> 4) * 2 + (c >> 5), rr = r & 15, cc = c & 31, ob = rr * 64 + cc * 2; return st * 1024 + (ob ^ (((ob >> 9) & 1) << 5)); }
__device__ __forceinline__ void stage_rc(int b, int& R, int& C) { const int st = b / 1024, sb = b % 1024, swz = sb ^ (((sb >> 9) & 1) << 5); R = (st >> 1) * 16 + swz / 64; C = (st & 1) * 32 + (swz % 64) / 2; }
__device__ __forceinline__ int perm32(int rho) { const int n = rho >> 4, i = rho & 15; return 8 * (i >> 2) + 4 * n + (i & 3); }
struct Unit { int pm, pn, e; };
__device__ __forceinline__ unsigned cvt_pk_bf16(float lo, float hi) { unsigned r; asm volatile("v_cvt_pk_bf16_f32 %0, %1, %2" : "=v"(r) : "v"(lo), "v"(hi)); return r; }

__device__ __forceinline__ bool static_next(int nM, int nN, int G, int c, int i, Unit& u) {
    const int nwg = nM * nN; const long Lq = (long)i * G + c; if (Lq >= nwg) return false;
    int wgid = (int)Lq; { const int q = nwg / NXCD, r = nwg % NXCD, xcd = wgid % NXCD, off = wgid / NXCD; wgid = (xcd < r ? xcd * (q + 1) : r * (q + 1) + (xcd - r) * q) + off; }
    const int nig = WGM * nN, gid = wgid / nig, fm = gid * WGM, gsz = (nM - fm) < WGM ? (nM - fm) : WGM;
    u.pm = fm + ((wgid % nig) % gsz); u.pn = (wgid % nig) / gsz; u.e = 0; return true;
}

template <class Prob, class Epi, bool ALIGN_EPI, bool SP2>
__device__ __forceinline__ void gemm_phase(PG8_LAS unsigned char* lds, const Prob& P, const Epi& E) {
    const int tid = otid(), wid = __builtin_amdgcn_readfirstlane(tid >> 6), lane = tid & 63, wr = wid >> 2, wc = wid & 3, fr = lane & 15, fq = lane >> 4;
    const int K = P.K, nt = Prob::KT > 0 ? Prob::KT : K / BK;
    int sR[2], sC[2]; unsigned voffB[2];
#pragma unroll
    for (int i = 0; i < 2; ++i) { stage_rc(tid * 16 + i * 8192, sR[i], sC[i]); voffB[i] = (unsigned)(P.b_row(sR[i]) * K + sC[i]) * 2u; }
    const size_t kstep = (size_t)(BK * 2);
    const size_t kstepA = P.a_kstep();
    const size_t hstepB = P.b_hstep();
    const unsigned ldsw = (unsigned)wid * 1024u;
    const int aoff = lds_byte(wr * 64 + fr, fq * 8), boff = lds_byte(wc * 32 + fr, fq * 8);
#define PG8_SA(b, h) (((b) * 2 + (h)) * HTB)
#define PG8_SB(b, h) ((4 + (b) * 2 + (h)) * HTB)
#define PG8_STAGE(bufoff, gbase, voff) do { _Pragma("unroll") for (int _i = 0; _i < 2; ++_i) \
        __builtin_amdgcn_global_load_lds((const unsigned*)((const char*)(gbase) + (voff)[_i]), (PG8_LAS unsigned*)(lds + (bufoff) + ldsw + _i * 8192), 16, 0, 0); } while (0)
#define PG8_STAGE_SEL(bufoff, gbase, h) do { _Pragma("unroll") for (int _i = 0; _i < 2; ++_i) { unsigned _vo = vAc[h][_i]; if constexpr (Prob::GATHER) _vo = last ? vAn[h][_i] : _vo; \
        __builtin_amdgcn_global_load_lds((const unsigned*)((const char*)(gbase) + _vo), (PG8_LAS unsigned*)(lds + (bufoff) + ldsw + _i * 8192), 16, 0, 0); } } while (0)
#define PG8_LDA(dst, b, h) do { _Pragma("unroll") for (int m = 0; m < 4; ++m) _Pragma("unroll") for (int k = 0; k < 2; ++k) dst[m][k] = *(const PG8_LAS bf16x8*)(lds + PG8_SA(b, h) + aoff + m * 2048 + k * 1024); } while (0)
#define PG8_LDB(dst, b, h) do { _Pragma("unroll") for (int n = 0; n < 2; ++n) _Pragma("unroll") for (int k = 0; k < 2; ++k) dst[n][k] = *(const PG8_LAS bf16x8*)(lds + PG8_SB(b, h) + boff + n * 2048 + k * 1024); } while (0)
#define PG8_MMA(ai, bj, At, Bt) do { __builtin_amdgcn_s_setprio(1); _Pragma("unroll") for (int m = 0; m < 4; ++m) _Pragma("unroll") for (int n = 0; n < 2; ++n) _Pragma("unroll") for (int k = 0; k < 2; ++k) \
        acc[ai][bj][m][n] = __builtin_amdgcn_mfma_f32_16x16x32_bf16(Bt[n][k], At[m][k], acc[ai][bj][m][n], 0, 0, 0); __builtin_amdgcn_s_setprio(0); } while (0)
#define PG8_WAIT_V(n) asm volatile("s_waitcnt vmcnt(" #n ")" ::: "memory")
#define PG8_WAIT_L(n) asm volatile("s_waitcnt lgkmcnt(" #n ")" ::: "memory")
#define PG8_BAR __builtin_amdgcn_s_barrier()
#define PG8_SCHED __builtin_amdgcn_sched_barrier(0)
    Unit cur, nxt; int ui = 0;
    if (!P.next(0, cur)) return;
    f32x4 acc[2][2][4][2];
#pragma unroll
    for (int a = 0; a < 2; ++a)
#pragma unroll
        for (int b = 0; b < 2; ++b)
#pragma unroll
            for (int m = 0; m < 4; ++m)
#pragma unroll
                for (int n = 0; n < 2; ++n) acc[a][b][m][n] = (f32x4){0.f, 0.f, 0.f, 0.f};
    bf16x8 At[4][2], B0[2][2], B1[2][2];
    unsigned vAc[2][2], vAn[2][2];
    const char* cA = P.a_base(cur); const char* cB = P.b_base(cur);
    P.a_voff(cur, sR, sC, vAc);
#pragma unroll
    for (int h = 0; h < 2; ++h)
#pragma unroll
        for (int i = 0; i < 2; ++i) vAn[h][i] = vAc[h][i];
    if constexpr (SP2) {
        PG8_STAGE(PG8_SB(0, 0), cB, voffB); PG8_STAGE(PG8_SB(0, 1), cB + hstepB, voffB); PG8_STAGE(PG8_SA(0, 0), cA, vAc[0]); PG8_STAGE(PG8_SA(0, 1), cA, vAc[1]);
        if (wr == 1) PG8_BAR;
        PG8_WAIT_V(2); PG8_BAR;
        PG8_STAGE(PG8_SB(1, 0), cB + kstep, voffB); PG8_STAGE(PG8_SA(1, 0), cA + kstepA, vAc[0]); PG8_STAGE(PG8_SB(1, 1), cB + hstepB + kstep, voffB);
        PG8_WAIT_V(6); PG8_BAR;
    } else {
        PG8_STAGE(PG8_SB(0, 0), cB, voffB); PG8_STAGE(PG8_SA(0, 0), cA, vAc[0]); PG8_STAGE(PG8_SB(0, 1), cB + hstepB, voffB); PG8_STAGE(PG8_SA(0, 1), cA, vAc[1]);
        if (wr == 1) PG8_BAR;
        PG8_WAIT_V(4); PG8_BAR;
        PG8_STAGE(PG8_SB(1, 0), cB + kstep, voffB); PG8_STAGE(PG8_SA(1, 0), cA + kstepA, vAc[0]); PG8_STAGE(PG8_SB(1, 1), cB + hstepB + kstep, voffB);
        PG8_WAIT_V(6); PG8_BAR;
    }
    for (;;) {
        const bool has_next = P.next(ui + 1, nxt);
        const char* nA = cA; const char* nB = cB;
        if (has_next) { nA = P.a_base(nxt); nB = P.b_base(nxt); if constexpr (Prob::GATHER) P.a_voff(nxt, sR, sC, vAn); }
        for (int t = 0; t < nt; t += 2) {
            const bool last = (t == nt - 2);
            const char* a1 = cA + (size_t)(t + 1) * kstepA;
            const char* a2 = last ? nA : cA + (size_t)(t + 2) * kstepA; const char* b2 = last ? nB : cB + (size_t)(t + 2) * kstep;
            const char* a3 = a2 + kstepA; const char* b3 = b2 + kstep;
            if constexpr (SP2) {
            PG8_LDB(B0, 0, 0); PG8_LDB(B1, 0, 1); PG8_SCHED; PG8_LDA(At, 0, 0); PG8_STAGE(PG8_SA(1, 1), a1, vAc[1]);
            PG8_WAIT_V(8); PG8_WAIT_L(0); PG8_BAR; PG8_MMA(0, 0, At, B0); PG8_MMA(0, 1, At, B1); PG8_BAR; PG8_SCHED;
            PG8_LDA(At, 0, 1); PG8_STAGE(PG8_SB(0, 0), b2, voffB); PG8_STAGE(PG8_SB(0, 1), b2 + hstepB, voffB); PG8_STAGE_SEL(PG8_SA(0, 0), a2, 0);
            PG8_WAIT_V(8); PG8_WAIT_L(0); PG8_BAR; PG8_MMA(1, 0, At, B0); PG8_MMA(1, 1, At, B1); PG8_BAR; PG8_SCHED;
            PG8_LDB(B0, 1, 0); PG8_LDB(B1, 1, 1); PG8_SCHED; PG8_LDA(At, 1, 0); PG8_STAGE_SEL(PG8_SA(0, 1), a2, 1);
            PG8_WAIT_V(8); PG8_WAIT_L(0); PG8_BAR; PG8_MMA(0, 0, At, B0); PG8_MMA(0, 1, At, B1); PG8_BAR; PG8_SCHED;
            PG8_LDA(At, 1, 1); PG8_STAGE(PG8_SB(1, 0), b3, voffB); PG8_STAGE(PG8_SB(1, 1), b3 + hstepB, voffB); PG8_STAGE_SEL(PG8_SA(1, 0), a3, 0);
            PG8_WAIT_V(8); PG8_WAIT_L(0); PG8_BAR; PG8_MMA(1, 0, At, B0); PG8_MMA(1, 1, At, B1); PG8_BAR; PG8_SCHED;
            } else {
            PG8_LDB(B0, 0, 0); PG8_SCHED; PG8_LDA(At, 0, 0); PG8_STAGE(PG8_SA(1, 1), a1, vAc[1]);
            PG8_WAIT_L(8); PG8_BAR; PG8_WAIT_L(0); PG8_MMA(0, 0, At, B0); PG8_BAR; PG8_SCHED;
            PG8_LDB(B1, 0, 1); PG8_STAGE(PG8_SB(0, 0), b2, voffB);
            PG8_BAR; PG8_WAIT_L(0); PG8_MMA(0, 1, At, B1); PG8_BAR;
            PG8_LDA(At, 0, 1); PG8_STAGE_SEL(PG8_SA(0, 0), a2, 0);
            PG8_BAR; PG8_WAIT_L(0); PG8_MMA(1, 0, At, B0); PG8_BAR; PG8_SCHED;
            PG8_STAGE(PG8_SB(0, 1), b2 + hstepB, voffB);
            PG8_WAIT_V(6); PG8_BAR; PG8_MMA(1, 1, At, B1); PG8_BAR;
            PG8_LDB(B0, 1, 0); PG8_SCHED; PG8_LDA(At, 1, 0); PG8_STAGE_SEL(PG8_SA(0, 1), a2, 1);
            PG8_WAIT_L(8); PG8_BAR; PG8_WAIT_L(0); PG8_MMA(0, 0, At, B0); PG8_BAR; PG8_SCHED;
            PG8_LDB(B1, 1, 1); PG8_STAGE(PG8_SB(1, 0), b3, voffB);
            PG8_BAR; PG8_WAIT_L(0); PG8_MMA(0, 1, At, B1); PG8_BAR;
            PG8_LDA(At, 1, 1); PG8_STAGE_SEL(PG8_SA(1, 0), a3, 0);
            PG8_BAR; PG8_WAIT_L(0); PG8_MMA(1, 0, At, B0); PG8_BAR; PG8_SCHED;
            PG8_STAGE(PG8_SB(1, 1), b3 + hstepB, voffB);
            PG8_WAIT_V(6); PG8_BAR; PG8_MMA(1, 1, At, B1); PG8_BAR;
            }
        }
        if constexpr (ALIGN_EPI) { if (wr == 0) PG8_BAR; }
        E(acc, cur, wr, wc, fr, fq);
        if (!has_next) break;
#pragma unroll
        for (int a = 0; a < 2; ++a)
#pragma unroll
            for (int b = 0; b < 2; ++b)
#pragma unroll
                for (int m = 0; m < 4; ++m)
#pragma unroll
                    for (int n = 0; n < 2; ++n) acc[a][b][m][n] = (f32x4){0.f, 0.f, 0.f, 0.f};
        cur = nxt; cA = nA; cB = nB; ++ui;
        if constexpr (Prob::GATHER) {
#pragma unroll
            for (int h = 0; h < 2; ++h)
#pragma unroll
                for (int i = 0; i < 2; ++i) vAc[h][i] = vAn[h][i];
        }
        if constexpr (ALIGN_EPI) { if (wr == 1) PG8_BAR; }
    }
    PG8_WAIT_V(0);
    if constexpr (!ALIGN_EPI) { if (wr == 0) PG8_BAR; }
    PG8_BAR;
#undef PG8_SA
#undef PG8_SB
#undef PG8_STAGE
#undef PG8_STAGE_SEL
#undef PG8_LDA
#undef PG8_LDB
#undef PG8_MMA
#undef PG8_WAIT_V
#undef PG8_WAIT_L
#undef PG8_BAR
#undef PG8_SCHED
}

struct ProbDense { static constexpr bool GATHER = false; static constexpr int KT = 0;
    const bf16_t* A; const bf16_t* Bt; int K, nM, nN, G, c; bool headperm;
    __device__ __forceinline__ bool next(int i, Unit& u) const { return static_next(nM, nN, G, c, i, u); }
    __device__ __forceinline__ const char* a_base(const Unit& u) const { return (const char*)(A + (size_t)u.pm * BM * K); }
    __device__ __forceinline__ void a_voff(const Unit&, const int (&R)[2], const int (&C)[2], unsigned (&v)[2][2]) const {
#pragma unroll
        for (int h = 0; h < 2; ++h)
#pragma unroll
            for (int i = 0; i < 2; ++i) v[h][i] = (unsigned)((h * HALF + R[i]) * K + C[i]) * 2u;
    }
    __device__ __forceinline__ const char* b_base(const Unit& u) const { return (const char*)(Bt + (size_t)u.pn * BM * K); }
    __device__ __forceinline__ size_t a_kstep() const { return (size_t)BK * 2; }
    __device__ __forceinline__ size_t b_hstep() const { return headperm ? (size_t)32 * K * 2 : (size_t)HALF * K * 2; }
    __device__ __forceinline__ int b_row(int R) const { return headperm ? ((R >> 5) * 64 + perm32(R & 31)) : ((R & ~31) + perm32(R & 31)); }
};
typedef const PG8_LAS int* lds_ints;
__device__ __forceinline__ int expert_of(lds_ints ps, int pm) { int e = 0;
#pragma unroll
    for (int i = 1; i < 32; ++i) if (ps[i] <= pm * 256) e = i;
    return __builtin_amdgcn_readfirstlane(e); }
struct ProbMoe1 { static constexpr bool GATHER = true; static constexpr int KT = 0;
    const bf16_t* XN; const bf16_t* W1T; const int* rowtok; lds_ints ps; int K, ntm, G, c;
    __device__ __forceinline__ bool next(int i, Unit& u) const { const int q = i * G + c; if (q >= ntm * 8) return false; u.pm = q >> 3; u.pn = q & 7; u.e = expert_of(ps, u.pm); return true; }
    __device__ __forceinline__ const char* a_base(const Unit&) const { return (const char*)XN; }
    __device__ __forceinline__ void a_voff(const Unit& u, const int (&R)[2], const int (&C)[2], unsigned (&v)[2][2]) const {
#pragma unroll
        for (int h = 0; h < 2; ++h)
#pragma unroll
            for (int i = 0; i < 2; ++i) { int tk = rowtok[u.pm * BM + h * HALF + R[i]]; if (tk < 0) tk = T; v[h][i] = (unsigned)(tk * K + C[i]) * 2u; }
    }
    __device__ __forceinline__ const char* b_base(const Unit& u) const { return (const char*)(W1T + ((size_t)u.e * 2048 + u.pn * 128) * K); }
    __device__ __forceinline__ size_t a_kstep() const { return (size_t)BK * 2; }
    __device__ __forceinline__ size_t b_hstep() const { return (size_t)1024 * K * 2; }
    __device__ __forceinline__ int b_row(int R) const { return (R & ~31) + perm32(R & 31); }
};
struct ProbMoe2 { static constexpr bool GATHER = false; static constexpr int KT = 0;
    const bf16_t* ACT; const bf16_t* W2T; lds_ints ps; int K, ntm, G, c;
    __device__ __forceinline__ bool next(int i, Unit& u) const { const int q = i * G + c; if (q >= ntm * 4) return false; u.pm = q >> 2; u.pn = q & 3; u.e = expert_of(ps, u.pm); return true; }
    __device__ __forceinline__ const char* a_base(const Unit& u) const { return (const char*)(ACT + (size_t)u.pm * BM * K); }
    __device__ __forceinline__ void a_voff(const Unit&, const int (&R)[2], const int (&C)[2], unsigned (&v)[2][2]) const {
#pragma unroll
        for (int h = 0; h < 2; ++h)
#pragma unroll
            for (int i = 0; i < 2; ++i) v[h][i] = (unsigned)((h * HALF + R[i]) * K + C[i]) * 2u;
    }
    __device__ __forceinline__ const char* b_base(const Unit& u) const { return (const char*)(W2T + ((size_t)u.e * 1024 + u.pn * BM) * K); }
    __device__ __forceinline__ size_t a_kstep() const { return (size_t)BK * 2; }
    __device__ __forceinline__ size_t b_hstep() const { return (size_t)HALF * K * 2; }
    __device__ __forceinline__ int b_row(int R) const { return (R & ~31) + perm32(R & 31); }
};

struct ProbCmp { static constexpr bool GATHER = false; static constexpr int KT = 8;
    const bf16_t* ZB; const bf16_t* W1T; int K, G, c;
    __device__ __forceinline__ bool next(int i, Unit& u) const { const int q = i * G + c; if (q >= 64) return false; u.pm = q & 15; u.pn = 0; u.e = q >> 4; return true; }
    __device__ __forceinline__ const char* a_base(const Unit& u) const { const int idx = u.pm >> 3, bg = (u.pm >> 1) & 3, half = u.pm & 1;
        return (const char*)(ZB + ((size_t)(bg >> 1) * S + 16 * 256 * half + 8 * u.e) * ZBW + ZB_KC + idx * 128 + (bg & 1) * 64); }
    __device__ __forceinline__ void a_voff(const Unit&, const int (&R)[2], const int (&C)[2], unsigned (&v)[2][2]) const {
#pragma unroll
        for (int h = 0; h < 2; ++h)
#pragma unroll
            for (int i = 0; i < 2; ++i) v[h][i] = (unsigned)(16 * (h * HALF + R[i]) * ZBW + C[i]) * 2u;
    }
    __device__ __forceinline__ size_t a_kstep() const { return (size_t)ZBW * 2; }
    __device__ __forceinline__ const char* b_base(const Unit& u) const { return (const char*)(W1T + (size_t)(u.pm >> 3) * 128 * K + 8 * 64 * u.e); }
    __device__ __forceinline__ size_t b_hstep() const { return 0; }
    __device__ __forceinline__ int b_row(int R) const { return (R & ~31) + perm32(R & 31); }
};
struct EpiCmp {
    float* HIDP;
    __device__ __forceinline__ void operator()(const f32x4 (&acc)[2][2][4][2], const Unit& u, int wr, int wc, int fr, int fq) const {
        const int idx = u.pm >> 3, bg = (u.pm >> 1) & 3, half = u.pm & 1;
        const int c0 = 32 * wc + 8 * fq;
#pragma unroll
        for (int ai = 0; ai < 2; ++ai)
#pragma unroll
            for (int m = 0; m < 4; ++m) { const int n = 256 * half + ai * HALF + wr * 64 + m * 16 + fr;
                if (n < 511) { float* dst = HIDP + (((size_t)u.e * 2 + idx) * 2044 + bg * 511 + n) * 128 + c0;
                    *(f32x4*)dst = acc[ai][0][m][0]; *(f32x4*)(dst + 4) = acc[ai][0][m][1]; } }
    }
};
struct EpiG1Z {
    float* Z;
    __device__ __forceinline__ void operator()(const f32x4 (&acc)[2][2][4][2], const Unit& u, int wr, int wc, int fr, int fq) const {
#pragma unroll
        for (int ai = 0; ai < 2; ++ai)
#pragma unroll
            for (int m = 0; m < 4; ++m) { const size_t r = (size_t)u.pm * BM + ai * HALF + wr * 64 + m * 16 + fr;
#pragma unroll
                for (int bj = 0; bj < 2; ++bj)
#pragma unroll
                    for (int n = 0; n < 2; ++n) { const int zc = u.pn * BM + 64 * wc + 32 * bj + 8 * fq + 4 * n;
                        const int col = zc < 1280 ? zc : (zc < 2816 ? zc + 24 : (zc < 2840 ? zc - 2816 + 1280 : -1));
                        if (col >= 0) *(f32x4*)(Z + r * INW + col) = acc[ai][bj][m][n]; } }
    }
};
struct EpiG1F {
    bf16_t* ZB; float* GATE; const float* gq; const float* gk; const float* gmq; const float* gmk;
    __device__ __forceinline__ void operator()(const f32x4 (&acc)[2][2][4][2], const Unit& u, int wr, int wc, int fr, int fq) const {
        const int pn = u.pn;
        const float* gain = nullptr; float sc = 1.f;
        if (pn < 2) { gain = gq; sc = QSCALE; }
        else if (pn == 3 || pn == 4) { if (wc < 2) gain = gk; }
        else if (pn == 5 || pn == 6) { gain = gmq; sc = QSCALE; }
        else if (pn == 7 || pn == 8) { gain = gmk; }
        if (pn == 11) {
            if (wc == 0 && fq < 3) {
#pragma unroll
                for (int ai = 0; ai < 2; ++ai)
#pragma unroll
                    for (int m = 0; m < 4; ++m) { const size_t r = (size_t)u.pm * BM + ai * HALF + wr * 64 + m * 16 + fr;
#pragma unroll
                        for (int n = 0; n < 2; ++n) { const f32x4 v = acc[ai][0][m][n]; f32x4 o;
#pragma unroll
                            for (int i = 0; i < 4; ++i) o[i] = 1.f / (1.f + __expf(-v[i]));
                            *(f32x4*)(GATE + r * 32 + 8 * fq + 4 * n) = o; } }
            }
            return;
        }
        f32x4 gv[2][2];
#pragma unroll
        for (int bj = 0; bj < 2; ++bj)
#pragma unroll
            for (int n = 0; n < 2; ++n) gv[bj][n] = gain ? *(const f32x4*)(gain + 32 * bj + 8 * fq + 4 * n) * sc : (f32x4){1.f, 1.f, 1.f, 1.f};
#pragma unroll
        for (int ai = 0; ai < 2; ++ai)
#pragma unroll
            for (int m = 0; m < 4; ++m) { const size_t r = (size_t)u.pm * BM + ai * HALF + wr * 64 + m * 16 + fr;
                float rs = 1.f;
                if (gain) { float ss = 0.f;
#pragma unroll
                    for (int bj = 0; bj < 2; ++bj)
#pragma unroll
                        for (int n = 0; n < 2; ++n) { const f32x4 v = acc[ai][bj][m][n]; ss += (v[0] * v[0] + v[1] * v[1]) + (v[2] * v[2] + v[3] * v[3]); }
                    ss += __shfl_xor(ss, 16); ss += __shfl_xor(ss, 32);
                    rs = rsqrtf(ss * (1.f / 64.f) + EPS); }
#pragma unroll
                for (int bj = 0; bj < 2; ++bj) { const f32x4 a = acc[ai][bj][m][0] * gv[bj][0] * rs, b = acc[ai][bj][m][1] * gv[bj][1] * rs;
                    u32x4 w; w.x = cvt_pk_bf16(a[0], a[1]); w.y = cvt_pk_bf16(a[2], a[3]); w.z = cvt_pk_bf16(b[0], b[1]); w.w = cvt_pk_bf16(b[2], b[3]);
                    *(u32x4*)(ZB + r * ZBW + pn * BM + 64 * wc + 32 * bj + 8 * fq) = w; } }
    }
};
struct EpiG2 {
    const float* xin; float* XA; const float* g1;
    __device__ __forceinline__ void operator()(const f32x4 (&acc)[2][2][4][2], const Unit& u, int wr, int wc, int fr, int fq) const {
#pragma unroll
        for (int ai = 0; ai < 2; ++ai)
#pragma unroll
            for (int m = 0; m < 4; ++m) { const size_t r = (size_t)u.pm * BM + ai * HALF + wr * 64 + m * 16 + fr; const int b = (int)(r / S);
#pragma unroll
                for (int bj = 0; bj < 2; ++bj)
#pragma unroll
                    for (int n = 0; n < 2; ++n) { const int c = u.pn * BM + 128 * bj + 32 * wc + 8 * fq + 4 * n;
                        const f32x4 x = *(const f32x4*)(xin + r * D + c), g = *(const f32x4*)(g1 + (size_t)b * 6144 + c);
                        *(f32x4*)(XA + r * D + c) = x + g * acc[ai][bj][m][n]; } }
    }
};
struct EpiM1 {
    bf16_t* ACT; const float* b1l;
    __device__ __forceinline__ void operator()(const f32x4 (&acc)[2][2][4][2], const Unit& u, int wr, int wc, int fr, int fq) const {
        const float* b1 = b1l + (size_t)u.e * 2048;
        const int c0 = u.pn * 128 + 32 * wc + 8 * fq;
        f32x4 bg[2], bl[2];
#pragma unroll
        for (int n = 0; n < 2; ++n) { bg[n] = *(const f32x4*)(b1 + c0 + 4 * n); bl[n] = *(const f32x4*)(b1 + 1024 + c0 + 4 * n); }
#pragma unroll
        for (int ai = 0; ai < 2; ++ai)
#pragma unroll
            for (int m = 0; m < 4; ++m) { const size_t r = (size_t)u.pm * BM + ai * HALF + wr * 64 + m * 16 + fr;
                float o[8];
#pragma unroll
                for (int n = 0; n < 2; ++n) { const f32x4 g = acc[ai][0][m][n] + bg[n], li = acc[ai][1][m][n] + bl[n];
#pragma unroll
                    for (int i = 0; i < 4; ++i) { const float gc = fminf(g[i], 7.f), lc = fminf(fmaxf(li[i], -7.f), 7.f); o[4 * n + i] = (lc + 1.f) * gc * (1.f / (1.f + __expf(-1.702f * gc))); } }
                u32x4 w; w.x = cvt_pk_bf16(o[0], o[1]); w.y = cvt_pk_bf16(o[2], o[3]); w.z = cvt_pk_bf16(o[4], o[5]); w.w = cvt_pk_bf16(o[6], o[7]);
                *(u32x4*)(ACT + r * DFF + c0) = w; }
    }
};
struct EpiM2 {
    bf16_t* Y; const float* b2l; const float* roww;
    __device__ __forceinline__ void operator()(const f32x4 (&acc)[2][2][4][2], const Unit& u, int wr, int wc, int fr, int fq) const {
        const float* b2 = b2l + (size_t)u.e * D;
#pragma unroll
        for (int ai = 0; ai < 2; ++ai)
#pragma unroll
            for (int m = 0; m < 4; ++m) { const size_t r = (size_t)u.pm * BM + ai * HALF + wr * 64 + m * 16 + fr; const float w = roww[r];
#pragma unroll
                for (int bj = 0; bj < 2; ++bj) { const int c = u.pn * BM + 128 * bj + 32 * wc + 8 * fq;
                    const f32x4 v0 = (acc[ai][bj][m][0] + *(const f32x4*)(b2 + c)) * w, v1 = (acc[ai][bj][m][1] + *(const f32x4*)(b2 + c + 4)) * w;
                    u32x4 o; o.x = cvt_pk_bf16(v0[0], v0[1]); o.y = cvt_pk_bf16(v0[2], v0[3]); o.z = cvt_pk_bf16(v1[0], v1[1]); o.w = cvt_pk_bf16(v1[2], v1[3]);
                    *(u32x4*)(Y + r * D + c) = o; } }
    }
};
}

__device__ __forceinline__ void phase_g1_fast(const Params& p, int l, unsigned char* lds_raw) {
    pg8::ProbDense P{(const bf16_t*)(p.ws + WS_XN), (const bf16_t*)(p.ws + WS_WINT) + (size_t)l * ZBW * D, D, T / 256, ZBW / 256, (int)gridDim.x, (int)blockIdx.x, true};
    pg8::EpiG1F E{(bf16_t*)(p.ws + WS_ZB), (float*)(p.ws + WS_GATE), p.in[7] + l * 64, p.in[8] + l * 64, p.in[12] + l * 64, p.in[13] + l * 64};
    pg8::gemm_phase<pg8::ProbDense, pg8::EpiG1F, true, true>((PG8_LAS unsigned char*)lds_raw, P, E);
}
__device__ __forceinline__ void phase_g2_fast(const Params& p, int l, unsigned char* lds_raw) {
    pg8::ProbDense P{(const bf16_t*)(p.ws + WS_ATTB), (const bf16_t*)(p.ws + WS_WOT) + (size_t)l * D * D, D, T / 256, D / 256, (int)gridDim.x, (int)blockIdx.x, false};
    pg8::EpiG2 E{l == 0 ? p.in[0] : p.out, p.out, (const float*)(p.ws + WS_MOD) + (size_t)l * Bn * 6144 + 2 * D};
    pg8::gemm_phase<pg8::ProbDense, pg8::EpiG2, true, true>((PG8_LAS unsigned char*)lds_raw, P, E);
}
constexpr int LDS_PS_OFF = 131072;
__device__ __forceinline__ void phase_ck_fast(const Params& p, int l, unsigned char* lds_raw) {
    pg8::ProbCmp P{(const bf16_t*)(p.ws + WS_ZB), (const bf16_t*)(p.ws + WS_WCT) + (size_t)l * 2 * 128 * 2048, 2048, (int)gridDim.x, (int)blockIdx.x};
    pg8::EpiCmp E{(float*)(p.ws + WS_HIDP)};
    pg8::gemm_phase<pg8::ProbCmp, pg8::EpiCmp, true, true>((PG8_LAS unsigned char*)lds_raw, P, E);
    { const int tid = otid(), lane = tid & 63, wave = tid >> 6, r8 = lane >> 3, c8 = lane & 7;
      const bf16_t* Z = (const bf16_t*)(p.ws + WS_ZB); bf16_t* KMB = (bf16_t*)(p.ws + WS_KMB);
      float* part = (float*)(lds_raw + 131072 + 512);
      for (int it0 = blockIdx.x * 2; it0 < Bn * 8 * 32; it0 += gridDim.x * 2) {
          const int it = it0 + (wave >> 2), q = wave & 3;
          const int b = it / 256, h = (it / 32) & 7, blk = it & 31;
          const bf16_t* base = Z + (size_t)(b * S + blk * 256 + q * 64 + r8) * ZBW + ZB_MK + h * 64 + c8 * 8;
          float s[8] = {0.f, 0.f, 0.f, 0.f, 0.f, 0.f, 0.f, 0.f};
          uint4 v[8];
#pragma unroll
          for (int i = 0; i < 8; ++i) v[i] = *(const uint4*)(base + (size_t)(8 * i) * ZBW);
#pragma unroll
          for (int i = 0; i < 8; ++i) { const unsigned w[4] = {v[i].x, v[i].y, v[i].z, v[i].w};
#pragma unroll
              for (int e = 0; e < 4; ++e) { s[2 * e] += __builtin_bit_cast(float, w[e] << 16); s[2 * e + 1] += __builtin_bit_cast(float, w[e] & 0xffff0000u); } }
#pragma unroll
          for (int e = 0; e < 8; ++e) { s[e] += __shfl_xor(s[e], 8); s[e] += __shfl_xor(s[e], 16); s[e] += __shfl_xor(s[e], 32); }
          if (r8 == 0) {
#pragma unroll
              for (int e = 0; e < 8; ++e) part[wave * 64 + c8 * 8 + e] = s[e]; }
          __syncthreads();
          if (tid < 128) { const int item = tid >> 6, d = tid & 63; const float* pp = part + item * 256 + d;
              KMB[(size_t)(it0 + item) * 64 + d] = (bf16_t)f2bf((((pp[0] + pp[64]) + pp[128]) + pp[192]) * (1.f / 256.f)); }
          __syncthreads();
      } }
}
__device__ __forceinline__ void phase_m1_fast(const Params& p, int l, unsigned char* lds_raw) {
    int* ps = (int*)(lds_raw + LDS_PS_OFF);
    load_pstart(p, l, ps);
    pg8::ProbMoe1 P{(const bf16_t*)(p.ws + WS_XN), (const bf16_t*)(p.ws + WS_W1T) + (size_t)l * NE * 2048 * D, (const int*)(p.ws + WS_ROWTOK) + (size_t)l * RMAX, (pg8::lds_ints)ps, D, ps[32] / 256, (int)gridDim.x, (int)blockIdx.x};
    pg8::EpiM1 E{(bf16_t*)(p.ws + WS_ACT), p.in[18] + (size_t)l * NE * 2048};
    pg8::gemm_phase<pg8::ProbMoe1, pg8::EpiM1, true, true>((PG8_LAS unsigned char*)lds_raw, P, E);
    __syncthreads();
}
__device__ __forceinline__ void phase_m2_fast(const Params& p, int l, unsigned char* lds_raw) {
    int* ps = (int*)(lds_raw + LDS_PS_OFF);
    load_pstart(p, l, ps);
    pg8::ProbMoe2 P{(const bf16_t*)(p.ws + WS_ACT), (const bf16_t*)(p.ws + WS_W2T) + (size_t)l * NE * D * DFF, (pg8::lds_ints)ps, DFF, ps[32] / 256, (int)gridDim.x, (int)blockIdx.x};
    pg8::EpiM2 E{(bf16_t*)(p.ws + WS_Y), p.in[20] + (size_t)l * NE * D, (const float*)(p.ws + WS_ROWW) + (size_t)l * RMAX};
    pg8::gemm_phase<pg8::ProbMoe2, pg8::EpiM2, true, true>((PG8_LAS unsigned char*)lds_raw, P, E);
    __syncthreads();
}

namespace at {
#define AT_LAS __attribute__((address_space(3)))
typedef short bf16x8 __attribute__((ext_vector_type(8)));
typedef short s16x4 __attribute__((ext_vector_type(4)));
typedef short v4i16_t __attribute__((ext_vector_type(4)));
typedef float f32x16 __attribute__((ext_vector_type(16)));
typedef unsigned u32x4 __attribute__((ext_vector_type(4)));
typedef float f32x2_t __attribute__((ext_vector_type(2))); typedef __bf16 bf16x2_t __attribute__((ext_vector_type(2)));
typedef AT_LAS unsigned char* lp;
constexpr int L_K = 0  , L_V = 32768  , L_WSF = 65536, L_OST = 67584  , L_SELM = 133120, L_UNI = 134144, L_KMT = 134400, L_END = 142592;
constexpr float NEGS = -1e30f;
__device__ __forceinline__ int crow(int r, int hi) { return (r & 3) + 8 * (r >> 2) + 4 * hi; }
__device__ __forceinline__ unsigned cvtpk(float lo, float hi) { f32x2_t v = {lo, hi}; bf16x2_t b = __builtin_convertvector(v, bf16x2_t); return __builtin_bit_cast(unsigned, b); }
__device__ __forceinline__ float mx3(float a, float b, float c) { return __builtin_fmaxf(__builtin_fmaxf(a, b), c); }
__device__ __forceinline__ void wsync() { asm volatile("s_waitcnt lgkmcnt(0)" ::: "memory"); __builtin_amdgcn_wave_barrier(); }
__device__ __forceinline__ void bar() { __builtin_amdgcn_s_barrier(); }
#define AT_WAITV(n) asm volatile("s_waitcnt vmcnt(" #n ")" ::: "memory")
#define AT_WAITL() asm volatile("s_waitcnt lgkmcnt(0)" ::: "memory")
__device__ __forceinline__ void glds(const void* g, lp dst) { __builtin_amdgcn_global_load_lds((const unsigned*)g, (AT_LAS unsigned*)dst, 16, 0, 0); }
__device__ __forceinline__ s16x4 vtr(const AT_LAS unsigned char* p) { return __builtin_bit_cast(s16x4, __builtin_amdgcn_ds_read_tr16_b64_v4i16((AT_LAS v4i16_t*)p)); }

__device__ __forceinline__ void dma_k(lp slot, const bf16_t* kbase, int pitch, int key0, int wid, int lane) { glds(kbase + (size_t)(key0 + lane) * pitch + wid * 8, slot + wid * 1024); }
__device__ __forceinline__ void dma_v(lp slot, const bf16_t* vbase, int pitch, int key0, int wid, int lane) {
    glds(vbase + (size_t)(key0 + 16 * (wid & 3) + (lane >> 2)) * pitch + (wid >> 2) * 32 + (lane & 3) * 8, slot + wid * 1024); }

__device__ __forceinline__ void qk_tile(f32x16& p0, f32x16& p1, lp kslot, const bf16x8 (&qr)[4], int r32, int hi) {
    const AT_LAS unsigned char* kb = kslot + hi * 1024 + r32 * 16;
#pragma unroll
    for (int d0 = 0; d0 < 4; ++d0) {
        const bf16x8 b0 = *(const AT_LAS bf16x8*)(kb + d0 * 2048), b1 = *(const AT_LAS bf16x8*)(kb + d0 * 2048 + 512);
        p0 = __builtin_amdgcn_mfma_f32_32x32x16_bf16(b0, qr[d0], p0, 0, 0, 0);
        p1 = __builtin_amdgcn_mfma_f32_32x32x16_bf16(b1, qr[d0], p1, 0, 0, 0);
    }
}
__device__ __forceinline__ void pv_tile(f32x16 (&o)[2], lp vslot, int lane, int hi, u32x4 pw0, u32x4 pw1, u32x4 pw2, u32x4 pw3) {
    const AT_LAS unsigned char* vp = vslot + ((lane >> 4) & 1) * 32 + (lane & 3) * 8 + (4 * hi + ((lane & 15) >> 2)) * 64;
    const bf16x8 pa[4] = {__builtin_bit_cast(bf16x8, pw0), __builtin_bit_cast(bf16x8, pw1), __builtin_bit_cast(bf16x8, pw2), __builtin_bit_cast(bf16x8, pw3)};
#pragma unroll
    for (int d0 = 0; d0 < 2; ++d0)
#pragma unroll
        for (int ks = 0; ks < 4; ++ks) {
            const s16x4 lo = vtr(vp + d0 * 4096 + ks * 1024), hh = vtr(vp + d0 * 4096 + ks * 1024 + 512);
            const bf16x8 vf = (bf16x8){lo[0], lo[1], lo[2], lo[3], hh[0], hh[1], hh[2], hh[3]};
            o[d0] = __builtin_amdgcn_mfma_f32_32x32x16_bf16(pa[ks], vf, o[d0], 0, 0, 0);
        }
}
__device__ __forceinline__ float rowmax(const f32x16& p0, const f32x16& p1) {
    float a = mx3(p0[0], p0[1], p1[0]), b = mx3(p0[2], p0[3], p1[1]); a = mx3(a, p1[2], p1[3]);
#pragma unroll
    for (int r = 4; r < 16; r += 4) { a = mx3(a, p0[r], p0[r + 1]); b = mx3(b, p0[r + 2], p0[r + 3]); a = mx3(a, p1[r], p1[r + 1]); b = mx3(b, p1[r + 2], p1[r + 3]); }
    const float m = __builtin_fmaxf(a, b);
    auto rr = __builtin_amdgcn_permlane32_swap(__float_as_uint(m), __float_as_uint(m), false, false);
    return __builtin_fmaxf(__uint_as_float(rr[0]), __uint_as_float(rr[1]));
}
__device__ __forceinline__ float halfsum(float v) {
    auto rr = __builtin_amdgcn_permlane32_swap(__float_as_uint(v), __float_as_uint(v), false, false);
    return __uint_as_float(rr[0]) + __uint_as_float(rr[1]);
}
__device__ __forceinline__ void mask_tile(f32x16& p0, f32x16& p1, int lo, int hi_, int hi) {
    const int kb = 4 * hi;
#pragma unroll
    for (int r = 0; r < 16; ++r) { const int kv = kb + (r & 3) + 8 * (r >> 2); if (kv > hi_ || kv < lo) p0[r] = NEGS; if (kv + 32 > hi_ || kv + 32 < lo) p1[r] = NEGS; }
}

__device__ __forceinline__ int next_bit128(unsigned u0, unsigned u1, unsigned u2, unsigned u3, int below) {
    if (below > 96) { unsigned x = u3; if (below < 128) x &= (1u << (below - 96)) - 1u; if (x) return 96 + 31 - __builtin_clz(x); }
    if (below > 64) { unsigned x = u2; if (below < 96) x &= (1u << (below - 64)) - 1u; if (x) return 64 + 31 - __builtin_clz(x); }
    if (below > 32) { unsigned x = u1; if (below < 64) x &= (1u << (below - 32)) - 1u; if (x) return 32 + 31 - __builtin_clz(x); }
    if (below > 0) { unsigned x = u0; if (below < 32) x &= (1u << below) - 1u; if (x) return 31 - __builtin_clz(x); }
    return -1;
}
struct Soft { float m, l; };

template <bool HAS_O>
__device__ __forceinline__ void softmax_step(f32x16& p0, f32x16& p1, Soft& st, f32x16 (&o)[2], float* wsf, int r32, int hi) {
    const float rm = rowmax(p0, p1);
    if (__any(rm > 0.f)) {
        const float dl = __builtin_fmaxf(rm, 0.f); st.m += dl;
#pragma unroll
        for (int r = 0; r < 16; ++r) { p0[r] -= dl; p1[r] -= dl; }
        const float al = __builtin_amdgcn_exp2f(-dl); st.l *= al;
        if (HAS_O) {
            if (hi == 0) wsf[r32] = al;
            wsync();
#pragma unroll
            for (int r = 0; r < 16; ++r) { const float f = wsf[crow(r, hi)]; o[0][r] *= f; o[1][r] *= f; }
            wsync();
        }
    }
    float s = 0.f;
#pragma unroll
    for (int r = 0; r < 16; ++r) { p0[r] = __builtin_amdgcn_exp2f(p0[r]); p1[r] = __builtin_amdgcn_exp2f(p1[r]); s += p0[r] + p1[r]; }
    st.l += s;
}
#define AT_PACK(P0, P1) \
    const u32x4 pw0 = {cvtpk(P0[0], P0[1]), cvtpk(P0[2], P0[3]), cvtpk(P0[4], P0[5]), cvtpk(P0[6], P0[7])}, pw1 = {cvtpk(P0[8], P0[9]), cvtpk(P0[10], P0[11]), cvtpk(P0[12], P0[13]), cvtpk(P0[14], P0[15])}, \
                pw2 = {cvtpk(P1[0], P1[1]), cvtpk(P1[2], P1[3]), cvtpk(P1[4], P1[5]), cvtpk(P1[6], P1[7])}, pw3 = {cvtpk(P1[8], P1[9]), cvtpk(P1[10], P1[11]), cvtpk(P1[12], P1[13]), cvtpk(P1[14], P1[15])}
__device__ __forceinline__ f32x16 cinit(float c2k, int hi, float x) { f32x16 c; const float xb = __builtin_fmaf(c2k, (float)(4 * hi), x);
#pragma unroll
    for (int r = 0; r < 16; ++r) c[r] = __builtin_fmaf(c2k, (float)((r & 3) + 8 * (r >> 2)), xb);
    return c; }
template <bool FIRST>
__device__ __forceinline__ void acc_scaled(float* stage, const f32x16 (&o)[2], float f, float* wsf, int r32, int hi) {
    if (hi == 0) wsf[r32] = f;
    wsync();
#pragma unroll
    for (int r = 0; r < 16; ++r) { const int orow = crow(r, hi); const float g = wsf[orow]; float* s0 = stage + orow * 64 + r32;
        if (FIRST) { s0[0] = o[0][r] * g; s0[32] = o[1][r] * g; } else { s0[0] += o[0][r] * g; s0[32] += o[1][r] * g; } }
    wsync();
}

#define AT_WAIT_NEWER(newer, per) do { if ((newer) >= 2) { if ((per) == 2) AT_WAITV(4); else AT_WAITV(2); } else if ((newer) == 1) { if ((per) == 2) AT_WAITV(2); else AT_WAITV(1); } else AT_WAITV(0); } while (0)

__device__ __forceinline__ void nsa_unit(const Params& p, int b, int g, int c, unsigned char* lds_raw) {
    const int tid = otid(), lane = tid & 63, r32 = lane & 31, hi = lane >> 5, wid = __builtin_amdgcn_readfirstlane(tid >> 6);
    lp lds = (lp)lds_raw;
    const bf16_t* ZB = (const bf16_t*)(p.ws + WS_ZB); const float* GT = (const float*)(p.ws + WS_GATE);
    const bf16_t* KCB = (const bf16_t*)(p.ws + WS_KCB) + (size_t)(b * 2 + g) * 512 * 64; const bf16_t* VCB = (const bf16_t*)(p.ws + WS_VCB) + (size_t)(b * 2 + g) * 512 * 64;
    const int t0 = c * 64, hg = r32 >> 3, qq = r32 & 7, qi = 8 * wid + qq, t = t0 + qi, h = 4 * g + hg; const size_t tt = (size_t)b * S + t;
    float* wsf = (float*)(lds_raw + L_WSF) + wid * 64;
    float* ostage = (float*)(lds_raw + L_OST) + wid * 2048;
    float* imp = ostage;
    unsigned* selm = (unsigned*)(lds_raw + L_SELM);
    unsigned* uni = (unsigned*)(lds_raw + L_UNI);
    const float c2 = exp2f(-(float)(h + 1)) * LOG2E;
    bf16x8 qr[4];
#pragma unroll
    for (int d0 = 0; d0 < 4; ++d0) qr[d0] = *(const bf16x8*)(ZB + tt * ZBW + ZB_Q + h * 64 + d0 * 16 + hi * 8);
    const float gt0 = GT[tt * 32 + h * 3 + 0], gt1 = GT[tt * 32 + h * 3 + 1], gt2 = GT[tt * 32 + h * 3 + 2];
    f32x16 o[2];
    const lp sK0 = lds + L_K, sV0 = lds + L_V;
    const int nmax = t >= 31 ? (t - 31) >> 4 : -1;
    const int ntc = ((4 * c + 2) >> 6) + 1;
    for (int i = lane; i < 8 * 129; i += 64) imp[i] = 0.f;
    Soft sc; sc.m = 0.f; sc.l = 0.f;
#pragma unroll
    for (int k = 0; k < 3; ++k) if (k < ntc) dma_k(sK0 + k * 8192, KCB, 64, 64 * k, wid, lane);
    for (int k = 0; k < ntc; ++k) {
        const int newer = ntc - 1 - k; AT_WAIT_NEWER(newer, 1);
        AT_WAITL(); bar();
        if (k + 3 < ntc) dma_k(sK0 + ((k + 3) & 3) * 8192, KCB, 64, 64 * (k + 3), wid, lane);
        const lp sK = sK0 + (k & 3) * 8192;
        const float x0 = c2 * (16.f * (64 * k) + 15.5f - (float)t0) - sc.m;
        f32x16 p0 = cinit(16.f * c2, hi, x0), p1 = cinit(16.f * c2, hi, x0 + c2 * 512.f);
        qk_tile(p0, p1, sK, qr, r32, hi);
        if (__any(nmax - 64 * k < 63)) mask_tile(p0, p1, 0, nmax - 64 * k, hi);
        softmax_step<false>(p0, p1, sc, o, wsf, r32, hi);
    }
    const float lc = halfsum(sc.l), linv = lc > 0.f ? 1.f / lc : 0.f;
    o[0] = f32x16{}; o[1] = f32x16{};
    AT_WAITL(); bar();
#pragma unroll
    for (int k = 0; k < 3; ++k) if (k < ntc) { dma_k(sK0 + k * 8192, KCB, 64, 64 * k, wid, lane); dma_v(sV0 + k * 8192, VCB, 64, 64 * k, wid, lane); }
    for (int k = 0; k < ntc; ++k) {
        const int newer = ntc - 1 - k; AT_WAIT_NEWER(newer, 2);
        AT_WAITL(); bar();
        if (k + 3 < ntc) { dma_k(sK0 + ((k + 3) & 3) * 8192, KCB, 64, 64 * (k + 3), wid, lane); dma_v(sV0 + ((k + 3) & 3) * 8192, VCB, 64, 64 * (k + 3), wid, lane); }
        const lp sK = sK0 + (k & 3) * 8192, sV = sV0 + (k & 3) * 8192;
        const float x0 = c2 * (16.f * (64 * k) + 15.5f - (float)t0) - sc.m;
        f32x16 p0 = cinit(16.f * c2, hi, x0), p1 = cinit(16.f * c2, hi, x0 + c2 * 512.f);
        qk_tile(p0, p1, sK, qr, r32, hi);
        if (__any(nmax - 64 * k < 63)) mask_tile(p0, p1, 0, nmax - 64 * k, hi);
#pragma unroll
        for (int r = 0; r < 16; ++r) { p0[r] = __builtin_amdgcn_exp2f(p0[r]); p1[r] = __builtin_amdgcn_exp2f(p1[r]); }
        { AT_PACK(p0, p1); pv_tile(o, sV, lane, hi, pw0, pw1, pw2, pw3); }
        float gs[8], ls[8];
#pragma unroll
        for (int q4 = 0; q4 < 4; ++q4) { gs[q4] = ((p0[4 * q4] + p0[4 * q4 + 1]) + (p0[4 * q4 + 2] + p0[4 * q4 + 3])) * linv; ls[q4] = p0[4 * q4 + 3] * linv;
                                         gs[4 + q4] = ((p1[4 * q4] + p1[4 * q4 + 1]) + (p1[4 * q4 + 2] + p1[4 * q4 + 3])) * linv; ls[4 + q4] = p1[4 * q4 + 3] * linv; }
#pragma unroll
        for (int q4 = 0; q4 < 8; ++q4) { gs[q4] += __shfl_xor(gs[q4], 8); gs[q4] += __shfl_xor(gs[q4], 16); ls[q4] += __shfl_xor(ls[q4], 8); ls[q4] += __shfl_xor(ls[q4], 16); }
        if (r32 < 8) {
            float* row = imp + qq * 129 + 16 * k + hi;
#pragma unroll
            for (int q4 = 0; q4 < 8; ++q4) row[2 * q4] += gs[q4];
        }
        wsync();
        if (r32 < 8) {
            float* row = imp + qq * 129 + 16 * k + hi + 1;
#pragma unroll
            for (int q4 = 0; q4 < 8; ++q4) row[2 * q4] += ls[q4];
        }
        wsync();
    }
    unsigned mk0 = 0u, mk1 = 0u, mk2 = 0u, mk3 = 0u;
    {
        const int qs = lane >> 3, part = lane & 7;
        float v[16];
#pragma unroll
        for (int i = 0; i < 16; ++i) { const int j = part * 16 + i; float x = imp[qs * 129 + j]; if (j == 0 || j == c || j == c - 1) x = 1e4f; if (j > c) x = NEGS; v[i] = x; }
#pragma unroll 1
        for (int it = 0; it < 16; ++it) {
            float bv = -3e38f; int bi = 0;
#pragma unroll
            for (int i = 0; i < 16; ++i) if (v[i] > bv) { bv = v[i]; bi = part * 16 + i; }
#pragma unroll
            for (int sft = 1; sft < 8; sft <<= 1) { const float ov = __shfl_xor(bv, sft); const int oi = __shfl_xor(bi, sft); if (ov > bv || (ov == bv && oi < bi)) { bv = ov; bi = oi; } }
            if (bv > NEGS) { const unsigned bit = 1u << (bi & 31); const int wq = bi >> 5; if (wq == 0) mk0 |= bit; else if (wq == 1) mk1 |= bit; else if (wq == 2) mk2 |= bit; else mk3 |= bit; }
#pragma unroll
            for (int i = 0; i < 16; ++i) if (part * 16 + i == bi) v[i] = -3.4e38f;
        }
        if (part == 0) { unsigned* sm = selm + (8 * wid + qs) * 4; sm[0] = mk0; sm[1] = mk1; sm[2] = mk2; sm[3] = mk3; }
        unsigned u0 = mk0, u1 = mk1, u2 = mk2, u3 = mk3;
#pragma unroll
        for (int sft = 8; sft < 64; sft <<= 1) { u0 |= __shfl_xor(u0, sft); u1 |= __shfl_xor(u1, sft); u2 |= __shfl_xor(u2, sft); u3 |= __shfl_xor(u3, sft); }
        if (lane == 0) { uni[wid * 4 + 0] = u0; uni[wid * 4 + 1] = u1; uni[wid * 4 + 2] = u2; uni[wid * 4 + 3] = u3; }
    }
    wsync();
    acc_scaled<true>(ostage, o, gt0 * linv, wsf, r32, hi);
    AT_WAITL(); bar();
    unsigned un0 = 0u, un1 = 0u, un2 = 0u, un3 = 0u;
#pragma unroll
    for (int w = 0; w < 8; ++w) { un0 |= uni[w * 4 + 0]; un1 |= uni[w * 4 + 1]; un2 |= uni[w * 4 + 2]; un3 |= uni[w * 4 + 3]; }
    un0 = __builtin_amdgcn_readfirstlane(un0); un1 = __builtin_amdgcn_readfirstlane(un1); un2 = __builtin_amdgcn_readfirstlane(un2); un3 = __builtin_amdgcn_readfirstlane(un3);
    const unsigned my0 = selm[(8 * wid + qq) * 4 + 0], my1 = selm[(8 * wid + qq) * 4 + 1], my2 = selm[(8 * wid + qq) * 4 + 2], my3 = selm[(8 * wid + qq) * 4 + 3];
    {
        const bf16_t* KS = ZB + (size_t)b * S * ZBW + ZB_KS + g * 64; const bf16_t* VS = ZB + (size_t)b * S * ZBW + ZB_VS + g * 64;
        Soft ss; ss.m = 0.f; ss.l = 0.f; o[0] = f32x16{}; o[1] = f32x16{};
        const int nsel = __builtin_popcount(un0) + __builtin_popcount(un1) + __builtin_popcount(un2) + __builtin_popcount(un3);
        int ji = 128;
#pragma unroll
        for (int k = 0; k < 3; ++k) if (k < nsel) { ji = next_bit128(un0, un1, un2, un3, ji); dma_k(sK0 + k * 8192, KS, ZBW, 64 * ji, wid, lane); dma_v(sV0 + k * 8192, VS, ZBW, 64 * ji, wid, lane); }
        int j = 128;
        for (int i = 0; i < nsel; ++i) {
            j = next_bit128(un0, un1, un2, un3, j);
            const int newer = nsel - 1 - i; AT_WAIT_NEWER(newer, 2);
            AT_WAITL(); bar();
            if (i + 3 < nsel) { ji = next_bit128(un0, un1, un2, un3, ji); dma_k(sK0 + ((i + 3) & 3) * 8192, KS, ZBW, 64 * ji, wid, lane); dma_v(sV0 + ((i + 3) & 3) * 8192, VS, ZBW, 64 * ji, wid, lane); }
            const lp sK = sK0 + (i & 3) * 8192, sV = sV0 + (i & 3) * 8192;
            const unsigned mw = (j >> 5) == 0 ? my0 : (j >> 5) == 1 ? my1 : (j >> 5) == 2 ? my2 : my3;
            const bool sel = (mw >> (j & 31)) & 1u;
            const float x0 = sel ? c2 * (float)(64 * j - t0) - ss.m : NEGS;
            f32x16 p0 = cinit(c2, hi, x0), p1 = cinit(c2, hi, sel ? x0 + c2 * 32.f : NEGS);
            qk_tile(p0, p1, sK, qr, r32, hi);
            if (j == c) mask_tile(p0, p1, 0, qi, hi);
            softmax_step<true>(p0, p1, ss, o, wsf, r32, hi);
            { AT_PACK(p0, p1); pv_tile(o, sV, lane, hi, pw0, pw1, pw2, pw3); }
        }
        const float ls_ = halfsum(ss.l);
        acc_scaled<false>(ostage, o, ls_ > 0.f ? gt1 / ls_ : 0.f, wsf, r32, hi);
    }
    {
        const bf16_t* KW = ZB + (size_t)b * S * ZBW + ZB_KW + g * 64; const bf16_t* VW = ZB + (size_t)b * S * ZBW + ZB_VW + g * 64;
        Soft sw; sw.m = 0.f; sw.l = 0.f; o[0] = f32x16{}; o[1] = f32x16{};
        const int k0 = c >= 8 ? 0 : 8 - c, nw = 9 - k0;
        AT_WAITL(); bar();
#pragma unroll
        for (int k = 0; k < 3; ++k) if (k < nw) { dma_k(sK0 + k * 8192, KW, ZBW, t0 - 512 + 64 * (k0 + k), wid, lane); dma_v(sV0 + k * 8192, VW, ZBW, t0 - 512 + 64 * (k0 + k), wid, lane); }
        for (int i = 0; i < nw; ++i) {
            const int k = k0 + i;
            const int newer = nw - 1 - i; AT_WAIT_NEWER(newer, 2);
            AT_WAITL(); bar();
            if (i + 3 < nw) { dma_k(sK0 + ((i + 3) & 3) * 8192, KW, ZBW, t0 - 512 + 64 * (k + 3), wid, lane); dma_v(sV0 + ((i + 3) & 3) * 8192, VW, ZBW, t0 - 512 + 64 * (k + 3), wid, lane); }
            const lp sK = sK0 + (i & 3) * 8192, sV = sV0 + (i & 3) * 8192;
            const float x0 = c2 * (float)(64 * k - 512) - sw.m;
            f32x16 p0 = cinit(c2, hi, x0), p1 = cinit(c2, hi, x0 + c2 * 32.f);
            qk_tile(p0, p1, sK, qr, r32, hi);
            if (k == 0) mask_tile(p0, p1, qi + 1, 63, hi);
            if (k == 8) mask_tile(p0, p1, 0, qi, hi);
            softmax_step<true>(p0, p1, sw, o, wsf, r32, hi);
            { AT_PACK(p0, p1); pv_tile(o, sV, lane, hi, pw0, pw1, pw2, pw3); }
        }
        const float lw = halfsum(sw.l);
        acc_scaled<false>(ostage, o, lw > 0.f ? gt2 / lw : 0.f, wsf, r32, hi);
    }
    {
        bf16_t* AB = (bf16_t*)(p.ws + WS_ATTB);
#pragma unroll
        for (int i = 0; i < 4; ++i) { const int row = i * 8 + (lane >> 3), ch = lane & 7; const float4 a = *(const float4*)(ostage + row * 64 + ch * 8), c4 = *(const float4*)(ostage + row * 64 + ch * 8 + 4);
            const uint4 v = make_uint4(pk2(a.x, a.y), pk2(a.z, a.w), pk2(c4.x, c4.y), pk2(c4.z, c4.w));
            *(uint4*)(AB + ((size_t)b * S + t0 + 8 * wid + (row & 7)) * D + (4 * g + (row >> 3)) * 64 + ch * 8) = v; }
        wsync();
    }
    AT_WAITL(); bar();
}

__device__ __forceinline__ void moba_unit(const Params& p, int b, int h, int blk, unsigned char* lds_raw) {
    const int tid = otid(), lane = tid & 63, r32 = lane & 31, hi = lane >> 5, wid = __builtin_amdgcn_readfirstlane(tid >> 6);
    lp lds = (lp)lds_raw;
    const bf16_t* ZB = (const bf16_t*)(p.ws + WS_ZB);
    const bf16_t* KMB = (const bf16_t*)(p.ws + WS_KMB) + (size_t)(b * 8 + h) * 32 * 64;
    const int qi = 32 * wid + r32, t = blk * 256 + qi; const size_t tt = (size_t)b * S + t;
    float* wsf = (float*)(lds_raw + L_WSF) + wid * 64;
    unsigned* uni = (unsigned*)(lds_raw + L_UNI);
    const float c2 = exp2f(-(float)(h + 1)) * LOG2E;
    bf16x8 qr[4];
#pragma unroll
    for (int d0 = 0; d0 < 4; ++d0) qr[d0] = *(const bf16x8*)(ZB + tt * ZBW + ZB_MQ + h * 64 + d0 * 16 + hi * 8);
    const lp sK0 = lds + L_K, sV0 = lds + L_V;
    unsigned mymask = 0u;
    {
        const lp sKM = lds + L_KMT;
        glds(KMB + (size_t)(lane & 31) * 64 + wid * 8, sKM + wid * 1024);
        AT_WAITV(0); bar();
        f32x16 g0 = f32x16{}, g1 = f32x16{};
        qk_tile(g0, g1, sKM, qr, r32, hi);
        float v1 = NEGS, v2 = NEGS, v3 = NEGS; int i1 = 64, i2 = 64, i3 = 64;
#pragma unroll
        for (int r = 0; r < 16; ++r) { const int n = crow(r, hi); const float s_ = n < blk ? g0[r] : NEGS;
            if (s_ > v1) { v3 = v2; i3 = i2; v2 = v1; i2 = i1; v1 = s_; i1 = n; } else if (s_ > v2) { v3 = v2; i3 = i2; v2 = s_; i2 = n; } else if (s_ > v3) { v3 = s_; i3 = n; } }
        float ov[3]; int oi[3];
        { auto a = __builtin_amdgcn_permlane32_swap(__float_as_uint(v1), __float_as_uint(v1), false, false); ov[0] = __uint_as_float(hi ? a[0] : a[1]); }
        { auto a = __builtin_amdgcn_permlane32_swap(__float_as_uint(v2), __float_as_uint(v2), false, false); ov[1] = __uint_as_float(hi ? a[0] : a[1]); }
        { auto a = __builtin_amdgcn_permlane32_swap(__float_as_uint(v3), __float_as_uint(v3), false, false); ov[2] = __uint_as_float(hi ? a[0] : a[1]); }
        { auto a = __builtin_amdgcn_permlane32_swap((unsigned)i1, (unsigned)i1, false, false); oi[0] = (int)(hi ? a[0] : a[1]); }
        { auto a = __builtin_amdgcn_permlane32_swap((unsigned)i2, (unsigned)i2, false, false); oi[1] = (int)(hi ? a[0] : a[1]); }
        { auto a = __builtin_amdgcn_permlane32_swap((unsigned)i3, (unsigned)i3, false, false); oi[2] = (int)(hi ? a[0] : a[1]); }
#pragma unroll
        for (int k = 0; k < 3; ++k) { const float s_ = ov[k]; const int n = oi[k];
            if (s_ > v1 || (s_ == v1 && n < i1)) { v3 = v2; i3 = i2; v2 = v1; i2 = i1; v1 = s_; i1 = n; }
            else if (s_ > v2 || (s_ == v2 && n < i2)) { v3 = v2; i3 = i2; v2 = s_; i2 = n; }
            else if (s_ > v3 || (s_ == v3 && n < i3)) { v3 = s_; i3 = n; } }
        if (v1 > NEGS) mymask |= 1u << i1; if (v2 > NEGS) mymask |= 1u << i2; if (v3 > NEGS) mymask |= 1u << i3;
        unsigned u = mymask;
#pragma unroll
        for (int sft = 1; sft < 64; sft <<= 1) u |= __shfl_xor(u, sft);
        if (lane == 0) uni[wid] = u;
        AT_WAITL(); bar();
    }
    unsigned un = 0u;
#pragma unroll
    for (int w = 0; w < 8; ++w) un |= uni[w];
    un = __builtin_amdgcn_readfirstlane(un);
    const bf16_t* KM_ = ZB + (size_t)b * S * ZBW + ZB_MK + h * 64; const bf16_t* VM_ = ZB + (size_t)b * S * ZBW + ZB_MV + h * 64;
    const int nub = __builtin_popcount(un), ntile = 4 * nub + 4;
    Soft sm; sm.m = 0.f; sm.l = 0.f; f32x16 o[2]; o[0] = f32x16{}; o[1] = f32x16{};
    unsigned rem = un; int curblk = nub > 0 ? __builtin_ctz(rem) : blk;
    unsigned prem = un; int pblk = nub > 0 ? __builtin_ctz(prem) : blk, psub = 0;
#define MOBA_ISSUE(slot_) do { if (psub == 4) { psub = 0; if (pblk != blk) { prem &= prem - 1; pblk = prem ? __builtin_ctz(prem) : blk; } } \
        dma_k(sK0 + (slot_) * 8192, KM_, ZBW, pblk * 256 + psub * 64, wid, lane); dma_v(sV0 + (slot_) * 8192, VM_, ZBW, pblk * 256 + psub * 64, wid, lane); ++psub; } while (0)
    MOBA_ISSUE(0); MOBA_ISSUE(1); MOBA_ISSUE(2);
    int sub = 0;
    for (int i = 0; i < ntile; ++i) {
        const int newer = ntile - 1 - i; AT_WAIT_NEWER(newer, 2);
        AT_WAITL(); bar();
        if (i + 3 < ntile) MOBA_ISSUE((i + 3) & 3);
        const lp sK = sK0 + (i & 3) * 8192, sV = sV0 + (i & 3) * 8192;
        const bool own = (i >= 4 * nub);
        const int rel = own ? qi - 64 * sub : 63;
        const bool skip = own && (32 * wid + 31 < 64 * sub);
        if (!skip) {
            const bool sel = own ? true : ((mymask >> curblk) & 1u);
            const float x0 = sel ? c2 * (float)(curblk * 256 + sub * 64 - blk * 256) - sm.m : NEGS;
            f32x16 p0 = cinit(c2, hi, x0), p1 = cinit(c2, hi, sel ? x0 + c2 * 32.f : NEGS);
            qk_tile(p0, p1, sK, qr, r32, hi);
            if (own && (64 * sub + 63 > 32 * wid)) mask_tile(p0, p1, 0, rel, hi);
            softmax_step<true>(p0, p1, sm, o, wsf, r32, hi);
            { AT_PACK(p0, p1); pv_tile(o, sV, lane, hi, pw0, pw1, pw2, pw3); }
        }
        if (++sub == 4) { sub = 0; if (!own) { rem &= rem - 1; curblk = rem ? __builtin_ctz(rem) : blk; } }
    }
#undef MOBA_ISSUE
    {
        const float lt = halfsum(sm.l); const float f = lt > 0.f ? 1.f / lt : 0.f;
        if (hi == 0) wsf[r32] = f;
        wsync();
        bf16_t* stg = (bf16_t*)(lds_raw + L_OST) + wid * 4096;
#pragma unroll
        for (int r = 0; r < 16; ++r) { const int orow = crow(r, hi); const float g = wsf[orow]; stg[orow * 64 + r32] = (bf16_t)f2bf(o[0][r] * g); stg[orow * 64 + 32 + r32] = (bf16_t)f2bf(o[1][r] * g); }
        wsync();
        bf16_t* AB = (bf16_t*)(p.ws + WS_ATTB);
#pragma unroll
        for (int i = 0; i < 4; ++i) { const int row = i * 8 + (lane >> 3), ch = lane & 7; const uint4 v = *(const uint4*)(stg + row * 64 + ch * 8);
            *(uint4*)(AB + ((size_t)b * S + blk * 256 + 32 * wid + row) * D + 512 + h * 64 + ch * 8) = v; }
        wsync();
    }
    AT_WAITL(); bar();
}
}

constexpr int MB_CAP = 25600;
namespace at {
__device__ __forceinline__ void moba_route_unit(const Params& p, int b, int h, int qb, unsigned char* lds_raw) {
    const int tid = otid(), lane = tid & 63, r32 = lane & 31, hi = lane >> 5, wid = __builtin_amdgcn_readfirstlane(tid >> 6);
    lp lds = (lp)lds_raw;
    const bf16_t* ZB = (const bf16_t*)(p.ws + WS_ZB);
    const int bh = b * 8 + h;
    const bf16_t* KMB = (const bf16_t*)(p.ws + WS_KMB) + (size_t)bh * 32 * 64;
    const int qi = 32 * wid + r32, t = qb * 256 + qi; const size_t tt = (size_t)b * S + t;
    int* hist = (int*)(lds_raw + L_UNI);
    unsigned* SEL3 = (unsigned*)(p.ws + WS_SEL3); unsigned* LRK = (unsigned*)(p.ws + WS_LRK);
    unsigned char* IL = (unsigned char*)(p.ws + WS_ILIST) + ((size_t)(bh * 32 + qb) * 32) * 256;
    int* BCm = (int*)(p.ws + WS_BCM) + (size_t)(bh * 32 + qb) * 32;
    if (tid < 32) hist[tid] = 0;
    bf16x8 qr[4];
#pragma unroll
    for (int d0 = 0; d0 < 4; ++d0) qr[d0] = *(const bf16x8*)(ZB + tt * ZBW + ZB_MQ + h * 64 + d0 * 16 + hi * 8);
    const lp sKM = lds + L_KMT;
    glds(KMB + (size_t)(lane & 31) * 64 + wid * 8, sKM + wid * 1024);
    AT_WAITV(0); AT_WAITL(); bar();
    f32x16 g0 = f32x16{}, g1 = f32x16{};
    qk_tile(g0, g1, sKM, qr, r32, hi);
    float v1 = NEGS, v2 = NEGS, v3 = NEGS; int i1 = 64, i2 = 64, i3 = 64;
#pragma unroll
    for (int r = 0; r < 16; ++r) { const int n = crow(r, hi); const float s_ = n < qb ? g0[r] : NEGS;
        if (s_ > v1) { v3 = v2; i3 = i2; v2 = v1; i2 = i1; v1 = s_; i1 = n; } else if (s_ > v2) { v3 = v2; i3 = i2; v2 = s_; i2 = n; } else if (s_ > v3) { v3 = s_; i3 = n; } }
    float ov[3]; int oi[3];
    { auto a = __builtin_amdgcn_permlane32_swap(__float_as_uint(v1), __float_as_uint(v1), false, false); ov[0] = __uint_as_float(hi ? a[0] : a[1]); }
    { auto a = __builtin_amdgcn_permlane32_swap(__float_as_uint(v2), __float_as_uint(v2), false, false); ov[1] = __uint_as_float(hi ? a[0] : a[1]); }
    { auto a = __builtin_amdgcn_permlane32_swap(__float_as_uint(v3), __float_as_uint(v3), false, false); ov[2] = __uint_as_float(hi ? a[0] : a[1]); }
    { auto a = __builtin_amdgcn_permlane32_swap((unsigned)i1, (unsigned)i1, false, false); oi[0] = (int)(hi ? a[0] : a[1]); }
    { auto a = __builtin_amdgcn_permlane32_swap((unsigned)i2, (unsigned)i2, false, false); oi[1] = (int)(hi ? a[0] : a[1]); }
    { auto a = __builtin_amdgcn_permlane32_swap((unsigned)i3, (unsigned)i3, false, false); oi[2] = (int)(hi ? a[0] : a[1]); }
#pragma unroll
    for (int k = 0; k < 3; ++k) { const float s_ = ov[k]; const int n = oi[k];
        if (s_ > v1 || (s_ == v1 && n < i1)) { v3 = v2; i3 = i2; v2 = v1; i2 = i1; v1 = s_; i1 = n; }
        else if (s_ > v2 || (s_ == v2 && n < i2)) { v3 = v2; i3 = i2; v2 = s_; i2 = n; }
        else if (s_ > v3 || (s_ == v3 && n < i3)) { v3 = s_; i3 = n; } }
    if (hi == 0) {
        const int j1 = v1 > NEGS ? i1 : 255, j2 = v2 > NEGS ? i2 : 255, j3 = v3 > NEGS ? i3 : 255;
        int l1 = 0, l2 = 0, l3 = 0;
        if (j1 < 32) { l1 = atomicAdd(&hist[j1], 1); IL[j1 * 256 + l1] = (unsigned char)qi; }
        if (j2 < 32) { l2 = atomicAdd(&hist[j2], 1); IL[j2 * 256 + l2] = (unsigned char)qi; }
        if (j3 < 32) { l3 = atomicAdd(&hist[j3], 1); IL[j3 * 256 + l3] = (unsigned char)qi; }
        SEL3[tt * 8 + h] = (unsigned)j1 | ((unsigned)j2 << 8) | ((unsigned)j3 << 16);
        LRK[tt * 8 + h] = (unsigned)l1 | ((unsigned)l2 << 8) | ((unsigned)l3 << 16);
    }
    AT_WAITL(); bar();
    if (tid < 32) BCm[tid] = hist[tid];
    AT_WAITL(); bar();
}
__device__ __forceinline__ void moba_tables(const int* BCmbh, int lane, int& tot, int& seg) {
    int s = 0;
    if (lane < 32) { for (int q = 0; q < 32; ++q) s += BCmbh[q * 32 + lane]; }
    tot = s;
    int pad = (s + 31) & ~31, inc = pad;
#pragma unroll
    for (int sft = 1; sft < 32; sft <<= 1) { const int o_ = __shfl_up(inc, sft); if ((lane & 31) >= sft) inc += o_; }
    seg = inc - pad;
}
__device__ __forceinline__ void moba_gather_unit(const Params& p, int bh, int j, int ch, int segj, bool reload, unsigned char* lds_raw) {
    const int tid = otid(), lane = tid & 63, r32 = lane & 31, hi = lane >> 5, wid = __builtin_amdgcn_readfirstlane(tid >> 6);
    lp lds = (lp)lds_raw;
    const int b = bh >> 3, h = bh & 7;
    const bf16_t* ZB = (const bf16_t*)(p.ws + WS_ZB);
    const int* BCmbh = (const int*)(p.ws + WS_BCM) + (size_t)bh * 32 * 32;
    float* wsf = (float*)(lds_raw + L_WSF) + wid * 64;
    const lp sK0 = lds + L_K, sV0 = lds + L_V;
    const bf16_t* KM_ = ZB + (size_t)b * S * ZBW + ZB_MK + h * 64; const bf16_t* VM_ = ZB + (size_t)b * S * ZBW + ZB_MV + h * 64;
    if (reload) {
#pragma unroll
        for (int k = 0; k < 4; ++k) { dma_k(sK0 + k * 8192, KM_, ZBW, j * 256 + 64 * k, wid, lane); dma_v(sV0 + k * 8192, VM_, ZBW, j * 256 + 64 * k, wid, lane); }
    }
    const int gr = 256 * ch + 32 * wid + r32;
    const int cq = lane < 32 ? BCmbh[lane * 32 + j] : 0;
    int run = 0, qbs = j + 1, lr = 0;
#pragma unroll 4
    for (int q = 0; q < 32; ++q) { const int c_ = __builtin_amdgcn_readlane(cq, q); if (gr >= run && gr < run + c_) { qbs = q; lr = gr - run; } run += c_; }
    const int totj = run;
    const bool valid = gr < totj;
    const unsigned char* IL = (const unsigned char*)(p.ws + WS_ILIST);
    const int qidx = valid ? (int)IL[((size_t)(bh * 32 + qbs) * 32 + j) * 256 + lr] : 0;
    const int t = valid ? qbs * 256 + qidx : (j + 1) * 256; const size_t tt = (size_t)b * S + t;
    const float c2 = exp2f(-(float)(h + 1)) * LOG2E;
    bf16x8 qr[4];
#pragma unroll
    for (int d0 = 0; d0 < 4; ++d0) qr[d0] = *(const bf16x8*)(ZB + tt * ZBW + ZB_MQ + h * 64 + d0 * 16 + hi * 8);
    Soft sm; sm.m = 0.f; sm.l = 0.f; f32x16 o[2]; o[0] = f32x16{}; o[1] = f32x16{};
#pragma unroll 1
    for (int i = 0; i < 4; ++i) {
        if (reload) { const int newer = 3 - i; if (newer >= 3) AT_WAITV(6); else AT_WAIT_NEWER(newer, 2); AT_WAITL(); bar(); }
        const lp sK = sK0 + i * 8192, sV = sV0 + i * 8192;
        const float x0 = c2 * (float)(64 * i) - sm.m;
        f32x16 p0 = cinit(c2, hi, x0), p1 = cinit(c2, hi, x0 + c2 * 32.f);
        qk_tile(p0, p1, sK, qr, r32, hi);
        softmax_step<true>(p0, p1, sm, o, wsf, r32, hi);
        { AT_PACK(p0, p1); pv_tile(o, sV, lane, hi, pw0, pw1, pw2, pw3); }
    }
    {
        const float lt = halfsum(sm.l);
        float* PM = (float*)(p.ws + WS_PM) + (size_t)bh * MB_CAP; float* PL = (float*)(p.ws + WS_PL) + (size_t)bh * MB_CAP;
        if (hi == 0 && valid) { PM[segj + gr] = sm.m; PL[segj + gr] = lt; }
        bf16_t* stg = (bf16_t*)(lds_raw + L_OST) + wid * 4096;
#pragma unroll
        for (int r = 0; r < 16; ++r) { const int orow = crow(r, hi); stg[orow * 64 + r32] = (bf16_t)f2bf(o[0][r]); stg[orow * 64 + 32 + r32] = (bf16_t)f2bf(o[1][r]); }
        wsync();
        bf16_t* PO = (bf16_t*)(p.ws + WS_PO) + ((size_t)bh * MB_CAP + segj + 256 * ch + 32 * wid) * 64;
        const int nrow = totj - (256 * ch + 32 * wid);
#pragma unroll
        for (int i = 0; i < 4; ++i) { const int row = i * 8 + (lane >> 3), c8 = lane & 7; if (row < nrow) *(uint4*)(PO + (size_t)row * 64 + c8 * 8) = *(const uint4*)(stg + row * 64 + c8 * 8); }
        wsync();
    }
    AT_WAITL(); bar();
}
__device__ __forceinline__ void moba_self_unit(const Params& p, int b, int h, int qb, unsigned char* lds_raw) {
    const int tid = otid(), lane = tid & 63, r32 = lane & 31, hi = lane >> 5, wid = __builtin_amdgcn_readfirstlane(tid >> 6);
    lp lds = (lp)lds_raw;
    const int bh = b * 8 + h;
    const bf16_t* ZB = (const bf16_t*)(p.ws + WS_ZB);
    const int* BCmbh = (const int*)(p.ws + WS_BCM) + (size_t)bh * 32 * 32;
    const int qi = 32 * wid + r32, t = qb * 256 + qi; const size_t tt = (size_t)b * S + t;
    float* wsf = (float*)(lds_raw + L_WSF) + wid * 64;
    float* ostage = (float*)(lds_raw + L_OST) + wid * 2048;
    const float c2 = exp2f(-(float)(h + 1)) * LOG2E;
    bf16x8 qr[4];
#pragma unroll
    for (int d0 = 0; d0 < 4; ++d0) qr[d0] = *(const bf16x8*)(ZB + tt * ZBW + ZB_MQ + h * 64 + d0 * 16 + hi * 8);
    const lp sK0 = lds + L_K, sV0 = lds + L_V;
    const bf16_t* KM_ = ZB + (size_t)b * S * ZBW + ZB_MK + h * 64; const bf16_t* VM_ = ZB + (size_t)b * S * ZBW + ZB_MV + h * 64;
    Soft sm; sm.m = 0.f; sm.l = 0.f; f32x16 o[2]; o[0] = f32x16{}; o[1] = f32x16{};
#pragma unroll
    for (int k = 0; k < 3; ++k) { dma_k(sK0 + k * 8192, KM_, ZBW, qb * 256 + 64 * k, wid, lane); dma_v(sV0 + k * 8192, VM_, ZBW, qb * 256 + 64 * k, wid, lane); }
    int tot, seg; moba_tables(BCmbh, lane, tot, seg);
    int before = 0; if (lane < 32) { for (int q = 0; q < qb; ++q) before += BCmbh[q * 32 + lane]; }
    const int base = seg + before;
#pragma unroll 1
    for (int i = 0; i < 4; ++i) {
        const int newer = 3 - i; AT_WAIT_NEWER(newer, 2);
        AT_WAITL(); bar();
        if (i == 0) { dma_k(sK0 + 3 * 8192, KM_, ZBW, qb * 256 + 192, wid, lane); dma_v(sV0 + 3 * 8192, VM_, ZBW, qb * 256 + 192, wid, lane); }
        const lp sK = sK0 + i * 8192, sV = sV0 + i * 8192;
        const bool skip = (32 * wid + 31 < 64 * i);
        if (!skip) {
            const float x0 = c2 * (float)(64 * i) - sm.m;
            f32x16 p0 = cinit(c2, hi, x0), p1 = cinit(c2, hi, x0 + c2 * 32.f);
            qk_tile(p0, p1, sK, qr, r32, hi);
            if (64 * i + 63 > 32 * wid) mask_tile(p0, p1, 0, qi - 64 * i, hi);
            softmax_step<true>(p0, p1, sm, o, wsf, r32, hi);
            { AT_PACK(p0, p1); pv_tile(o, sV, lane, hi, pw0, pw1, pw2, pw3); }
        }
    }
    {
        const float lself = halfsum(sm.l);
        const unsigned s3 = ((const unsigned*)(p.ws + WS_SEL3))[tt * 8 + h], l3 = ((const unsigned*)(p.ws + WS_LRK))[tt * 8 + h];
        const float* PM = (const float*)(p.ws + WS_PM) + (size_t)bh * MB_CAP; const float* PL = (const float*)(p.ws + WS_PL) + (size_t)bh * MB_CAP;
        float mk[3], lk[3]; int pidx[3];
        float M = sm.m + c2 * 256.f * (float)qb;
        const float mself = M;
#pragma unroll
        for (int k = 0; k < 3; ++k) { const int jk = (s3 >> (8 * k)) & 255, lrk = (l3 >> (8 * k)) & 255;
            const int pb = __shfl(base, jk & 31);
            if (jk < 32) { pidx[k] = pb + lrk; mk[k] = PM[pidx[k]] + c2 * 256.f * (float)jk; lk[k] = PL[pidx[k]]; M = __builtin_fmaxf(M, mk[k]); }
            else { pidx[k] = -1; mk[k] = NEGS; lk[k] = 0.f; } }
        const float ws_ = __builtin_amdgcn_exp2f(mself - M);
        float wk[3]; float Lt = lself * ws_;
#pragma unroll
        for (int k = 0; k < 3; ++k) { wk[k] = pidx[k] >= 0 ? __builtin_amdgcn_exp2f(mk[k] - M) : 0.f; Lt += lk[k] * wk[k]; }
        const float inv = Lt > 0.f ? 1.f / Lt : 0.f;
        float* rws = wsf;
        float* rwk = (float*)(lds_raw + L_KMT) + wid * 256;
        int* rpi = (int*)(rwk + 96);
        if (hi == 0) { rws[r32] = ws_ * inv;
#pragma unroll
            for (int k = 0; k < 3; ++k) { rwk[k * 32 + r32] = wk[k] * inv; rpi[k * 32 + r32] = pidx[k]; } }
#pragma unroll
        for (int r = 0; r < 16; ++r) { const int orow = crow(r, hi); ostage[orow * 64 + r32] = o[0][r]; ostage[orow * 64 + 32 + r32] = o[1][r]; }
        wsync();
        const bf16_t* PO = (const bf16_t*)(p.ws + WS_PO) + (size_t)bh * MB_CAP * 64;
        bf16_t* AB = (bf16_t*)(p.ws + WS_ATTB);
#pragma unroll
        for (int i = 0; i < 4; ++i) { const int row = i * 8 + (lane >> 3), c8 = lane & 7;
            const float4 a = *(const float4*)(ostage + row * 64 + c8 * 8), c4 = *(const float4*)(ostage + row * 64 + c8 * 8 + 4);
            const float w0 = rws[row];
            float acc8[8] = {a.x * w0, a.y * w0, a.z * w0, a.w * w0, c4.x * w0, c4.y * w0, c4.z * w0, c4.w * w0};
#pragma unroll
            for (int k = 0; k < 3; ++k) { const int pi = rpi[k * 32 + row]; if (pi >= 0) { const float w = rwk[k * 32 + row]; const uint4 q = *(const uint4*)(PO + (size_t)pi * 64 + c8 * 8);
                const unsigned qq_[4] = {q.x, q.y, q.z, q.w};
#pragma unroll
                for (int e = 0; e < 4; ++e) { acc8[2 * e] += __builtin_bit_cast(float, qq_[e] << 16) * w; acc8[2 * e + 1] += __builtin_bit_cast(float, qq_[e] & 0xffff0000u) * w; } } }
            *(uint4*)(AB + ((size_t)b * S + qb * 256 + 32 * wid + row) * D + 512 + h * 64 + c8 * 8) = make_uint4(pk2(acc8[0], acc8[1]), pk2(acc8[2], acc8[3]), pk2(acc8[4], acc8[5]), pk2(acc8[6], acc8[7])); }
        wsync();
    }
    AT_WAITL(); bar();
}
}

__device__ __forceinline__ void phase_att1(const Params& p, unsigned char* lds_raw, bool do_nsa = true, bool do_gather = true) {
    const int tid = otid();
    int* pre = (int*)(lds_raw + at::L_END);
    int* segt = pre + 514;
    { const int* BCm = (const int*)(p.ws + WS_BCM); const int bh = tid >> 5, j = tid & 31; int s = 0;
      for (int q = 0; q < 32; ++q) s += BCm[(size_t)(bh * 32 + q) * 32 + j];
      pre[tid + 1] = (s + 255) >> 8; if (tid == 0) pre[0] = 0;
      segt[tid] = (s + 31) & ~31; }
    __syncthreads();
    for (int sft = 1; sft < 512; sft <<= 1) { int v = 0, w = 0; if (tid >= sft) v = pre[tid + 1 - sft]; if ((tid & 31) >= sft) w = segt[tid - sft]; __syncthreads(); pre[tid + 1] += v; if (sft < 32) segt[tid] += w; __syncthreads(); }
    { const int* BCm = (const int*)(p.ws + WS_BCM); const int bh = tid >> 5, j = tid & 31; int s = 0;
      for (int q = 0; q < 32; ++q) s += BCm[(size_t)(bh * 32 + q) * 32 + j];
      const int excl = segt[tid] - ((s + 31) & ~31); __syncthreads(); segt[tid] = excl; }
    __syncthreads();
    const int nun = pre[512];
    if (do_nsa) for (int pi = blockIdx.x; pi < 512; pi += gridDim.x) {
        const int rnd = pi >> 8, id = pi & 255;
        const int bg = 2 * rnd + (id >> 7), c = rnd ? 127 - (id & 127) : (id & 127); at::nsa_unit(p, bg >> 1, bg & 1, c, lds_raw);
    }
    if (do_gather) {
        const int u0 = (int)(((long)blockIdx.x * nun) / gridDim.x), u1 = (int)(((long)(blockIdx.x + 1) * nun) / gridDim.x);
        int prev = -1;
        for (int u = u0; u < u1; ++u) {
            int lo = 0, hi_ = 511;
            while (lo < hi_) { const int mid = (lo + hi_ + 1) >> 1; if (pre[mid] <= u) lo = mid; else hi_ = mid - 1; }
            at::moba_gather_unit(p, lo >> 5, lo & 31, u - pre[lo], segt[lo], lo != prev, lds_raw);
            prev = lo;
        }
    }
}
__device__ __forceinline__ void phase_att2(const Params& p, unsigned char* lds_raw) {
    for (int pi = blockIdx.x; pi < 512; pi += gridDim.x) {
        const int rnd = pi >> 8, id = pi & 255;
        const int bh = 8 * rnd + (id >> 5), qb = rnd ? 31 - (id & 31) : (id & 31); at::moba_self_unit(p, bh >> 3, bh & 7, qb, lds_raw);
    }
}
__device__ __forceinline__ void phase_route(const Params& p, unsigned char* lds_raw) {
    for (int pi = blockIdx.x; pi < 512; pi += gridDim.x) at::moba_route_unit(p, pi >> 8, (pi >> 5) & 7, pi & 31, lds_raw);
}

__device__ __forceinline__ void phase_att_fast(const Params& p, unsigned char* lds_raw) {
    for (int pi = blockIdx.x; pi < 512; pi += gridDim.x) {
        const int rnd = pi >> 8, id = pi & 255;
        { const int bg = 2 * rnd + (id >> 7), c = rnd ? 127 - (id & 127) : (id & 127); at::nsa_unit(p, bg >> 1, bg & 1, c, lds_raw); }
        { const int bh = 8 * rnd + (id >> 5), blk = rnd ? 31 - (id & 31) : (id & 31); at::moba_unit(p, bh >> 3, bh & 7, blk, lds_raw); }
    }
}


__device__ __forceinline__ void phase_r2_fast(const Params& p, int l, unsigned char* lds_raw) {
    using namespace at;
    const int tid = otid(), lane = tid & 63, wave = __builtin_amdgcn_readfirstlane(tid >> 6), r32 = lane & 31, hi = lane >> 5;
    const float* mod = (const float*)(p.ws + WS_MOD);
    const float* XA = p.out; bf16_t* XN = (bf16_t*)(p.ws + WS_XN); bf16_t* XL = (bf16_t*)(p.ws + WS_XNLO);
    const float* lng = p.in[5] + (size_t)l * D; const float* rw = p.in[15] + (size_t)l * D * NE; const float* rb = p.in[16] + l * NE;
    int* toke = (int*)(p.ws + WS_TOKE); float* tokw = (float*)(p.ws + WS_TOKW); int* BC = (int*)(p.ws + WS_BC);
    lp lds = (lp)lds_raw;
    int* hist = (int*)(lds_raw + 131072);
    for (int idx = tid; idx < 128 * 32; idx += NT) {
        const int kc = idx >> 5, e = idx & 31; float v[8];
#pragma unroll
        for (int j = 0; j < 8; ++j) v[j] = rw[(size_t)(8 * kc + j) * NE + e];
        unsigned hh[8], ll[8];
#pragma unroll
        for (int j = 0; j < 8; ++j) { hh[j] = f2bf(v[j]); ll[j] = f2bf(v[j] - __builtin_bit_cast(float, hh[j] << 16)); }
        *(uint4*)(lds_raw + (size_t)idx * 16) = make_uint4(hh[0] | (hh[1] << 16), hh[2] | (hh[3] << 16), hh[4] | (hh[5] << 16), hh[6] | (hh[7] << 16));
        *(uint4*)(lds_raw + 65536 + (size_t)idx * 16) = make_uint4(ll[0] | (ll[1] << 16), ll[2] | (ll[3] << 16), ll[4] | (ll[5] << 16), ll[6] | (ll[7] << 16));
    }
    for (int blk = blockIdx.x; blk < T / 64; blk += gridDim.x) {
        if (tid < 32) hist[tid] = 0;
        for (int i = 0; i < 8; ++i) {
            const int t = blk * 64 + wave * 8 + i, b = t / S;
            float4 v[4]; float ss = 0.f;
#pragma unroll
            for (int j = 0; j < 4; ++j) { v[j] = *(const float4*)(XA + (size_t)t * D + 4 * lane + 256 * j); ss += (v[j].x * v[j].x + v[j].y * v[j].y) + (v[j].z * v[j].z + v[j].w * v[j].w); }
            ss = wave_sum(ss);
            const float r = rsqrtf(ss * (1.f / D) + EPS);
            const float* sh = mod + ((size_t)l * Bn + b) * 6144 + 3 * D; const float* sc = mod + ((size_t)l * Bn + b) * 6144 + 4 * D;
#pragma unroll
            for (int j = 0; j < 4; ++j) {
                const int col = 4 * lane + 256 * j;
                const float4 g = *(const float4*)(lng + col), s1 = *(const float4*)(sc + col), s0 = *(const float4*)(sh + col);
                const float o[4] = {v[j].x * r * g.x * (1.f + s1.x) + s0.x, v[j].y * r * g.y * (1.f + s1.y) + s0.y, v[j].z * r * g.z * (1.f + s1.z) + s0.z, v[j].w * r * g.w * (1.f + s1.w) + s0.w};
                unsigned hh[4], ll[4];
#pragma unroll
                for (int q = 0; q < 4; ++q) { hh[q] = f2bf(o[q]); ll[q] = f2bf(o[q] - __builtin_bit_cast(float, hh[q] << 16)); }
                *(uint2*)(XN + (size_t)t * D + col) = make_uint2(hh[0] | (hh[1] << 16), hh[2] | (hh[3] << 16));
                *(uint2*)(XL + (size_t)t * D + col) = make_uint2(ll[0] | (ll[1] << 16), ll[2] | (ll[3] << 16));
            }
        }
        asm volatile("s_waitcnt vmcnt(0)" ::: "memory");
        __syncthreads();
        if (wave < 2) {
            const int t = blk * 64 + wave * 32 + r32;
            const bf16_t* xh = XN + (size_t)t * D + 8 * hi; const bf16_t* xl = XL + (size_t)t * D + 8 * hi;
            const AT_LAS unsigned char* wh = lds + (size_t)(hi * 32 + r32) * 16; const AT_LAS unsigned char* wl = wh + 65536;
            f32x16 acc = f32x16{};
#pragma unroll 4
            for (int ks = 0; ks < 64; ++ks) {
                const bf16x8 bh = *(const bf16x8*)(xh + 16 * ks), bl = *(const bf16x8*)(xl + 16 * ks);
                const bf16x8 ah = *(const AT_LAS bf16x8*)(wh + ks * 1024), al = *(const AT_LAS bf16x8*)(wl + ks * 1024);
                acc = __builtin_amdgcn_mfma_f32_32x32x16_bf16(ah, bh, acc, 0, 0, 0);
                acc = __builtin_amdgcn_mfma_f32_32x32x16_bf16(al, bh, acc, 0, 0, 0);
                acc = __builtin_amdgcn_mfma_f32_32x32x16_bf16(ah, bl, acc, 0, 0, 0);
            }
            float a0 = -3e38f, a1 = -3e38f, a2 = -3e38f, a3 = -3e38f; int i0 = 99, i1 = 99, i2 = 99, i3 = 99;
#pragma unroll
            for (int r = 0; r < 16; ++r) { const int e = crow(r, hi); const float s_ = acc[r] + rb[e];
                if (s_ > a0) { a3 = a2; i3 = i2; a2 = a1; i2 = i1; a1 = a0; i1 = i0; a0 = s_; i0 = e; }
                else if (s_ > a1) { a3 = a2; i3 = i2; a2 = a1; i2 = i1; a1 = s_; i1 = e; }
                else if (s_ > a2) { a3 = a2; i3 = i2; a2 = s_; i2 = e; }
                else if (s_ > a3) { a3 = s_; i3 = e; } }
            float ov[4]; int oi[4];
            { const float sv[4] = {a0, a1, a2, a3}; const int si[4] = {i0, i1, i2, i3};
#pragma unroll
              for (int k = 0; k < 4; ++k) { auto a = __builtin_amdgcn_permlane32_swap(__float_as_uint(sv[k]), __float_as_uint(sv[k]), false, false); ov[k] = __uint_as_float(hi ? a[0] : a[1]);
                                            auto c = __builtin_amdgcn_permlane32_swap((unsigned)si[k], (unsigned)si[k], false, false); oi[k] = (int)(hi ? c[0] : c[1]); } }
#pragma unroll
            for (int k = 0; k < 4; ++k) { const float s_ = ov[k]; const int e = oi[k];
                if (s_ > a0 || (s_ == a0 && e < i0)) { a3 = a2; i3 = i2; a2 = a1; i2 = i1; a1 = a0; i1 = i0; a0 = s_; i0 = e; }
                else if (s_ > a1 || (s_ == a1 && e < i1)) { a3 = a2; i3 = i2; a2 = a1; i2 = i1; a1 = s_; i1 = e; }
                else if (s_ > a2 || (s_ == a2 && e < i2)) { a3 = a2; i3 = i2; a2 = s_; i2 = e; }
                else if (s_ > a3 || (s_ == a3 && e < i3)) { a3 = s_; i3 = e; } }
            const float e1 = __expf(a1 - a0), e2 = __expf(a2 - a0), e3 = __expf(a3 - a0), inv = 1.f / (((1.f + e1) + e2) + e3);
            if (hi == 0) {
                *(int4*)(toke + (size_t)t * 4) = make_int4(i0, i1, i2, i3);
                *(float4*)(tokw + (size_t)t * 4) = make_float4(inv, e1 * inv, e2 * inv, e3 * inv);
                atomicAdd(&hist[i0], 1); atomicAdd(&hist[i1], 1); atomicAdd(&hist[i2], 1); atomicAdd(&hist[i3], 1);
            }
        }
        __syncthreads();
        if (tid < 32) BC[blk * 32 + tid] = hist[tid];
        __syncthreads();
    }
}
__device__ __forceinline__ void phase_sc_fast(const Params& p, int l, unsigned char* lds_raw) {
    const int tid = otid();
    const int* BC = (const int*)(p.ws + WS_BC);
    int* cnt = (int*)(p.ws + WS_CNT) + l * 32;
    int* tot = (int*)lds_raw; int* base = tot + 32; int* fillc = tot + 64; int* before = tot + 96;
    const int* toke = (const int*)(p.ws + WS_TOKE); const float* tokw = (const float*)(p.ws + WS_TOKW);
    int* rowtok = (int*)(p.ws + WS_ROWTOK) + (size_t)l * RMAX; float* roww = (float*)(p.ws + WS_ROWW) + (size_t)l * RMAX; int* pos = (int*)(p.ws + WS_POS);
    for (int blk = blockIdx.x; blk < T / 64; blk += gridDim.x) {
        { const int e = tid & 31, part = tid >> 5; int s = 0, bf = 0;
#pragma unroll 4
          for (int i = part * 16; i < part * 16 + 16; ++i) { const int c = BC[i * 32 + e]; s += c; if (i < blk) bf += c; }
          int* ptot = tot + 128; int* pbef = ptot + 512;
          ptot[tid] = s; pbef[tid] = bf; }
        __syncthreads();
        if (tid < 32) { const int* ptot = tot + 128; const int* pbef = ptot + 512; int s = 0, bf = 0;
#pragma unroll
            for (int q = 0; q < 16; ++q) { s += ptot[q * 32 + tid]; bf += pbef[q * 32 + tid]; }
            tot[tid] = s; before[tid] = bf; fillc[tid] = 0; if (blk == 0) cnt[tid] = s; }
        __syncthreads();
        if (tid == 0) { int s = 0; for (int e = 0; e < 32; ++e) { base[e] = s + before[e]; s += (tot[e] + 255) & ~255; } }
        __syncthreads();
        if (tid < 256) {
            const int i = blk * 256 + tid, e = toke[i];
            const int slot = base[e] + atomicAdd(&fillc[e], 1);
            rowtok[slot] = i >> 2; roww[slot] = tokw[i]; pos[i] = slot;
        }
        __syncthreads();
    }
}

#define XB_TMO      128
#define XB_XCNT(j)  (256  + 64 * (j))
#define XB_XSUB(j)  (1280 + 64 * (j))
#define XB_XGEN(j)  (2304 + 64 * (j))
#define XB_TOP      3328
#define XB_TOPGEN   3392
#define XCD_BAR_WORDS 3456
#define XB_SPIN_CAP (1u << 18)
#define XLAS __attribute__((address_space(3)))
__device__ __forceinline__ unsigned xb_ld(unsigned* p)              { return __hip_atomic_load(p, __ATOMIC_RELAXED, __HIP_MEMORY_SCOPE_AGENT); }
__device__ __forceinline__ unsigned xb_add(unsigned* p, unsigned v) { return __hip_atomic_fetch_add(p, v, __ATOMIC_RELAXED, __HIP_MEMORY_SCOPE_AGENT); }
__device__ __forceinline__ unsigned xb_xcc_id() { return (unsigned)__builtin_amdgcn_s_getreg((3 << 11) | 20) & 0xFu; }
#define XB_SPIN(cond, bar) do { unsigned _sp = 0; while (cond) { __builtin_amdgcn_s_sleep(1); \
    if ((++_sp & 255u) == 0u) { if (xb_ld(&(bar)[XB_TMO])) break; if (_sp > XB_SPIN_CAP) { atomicAdd(&(bar)[XB_TMO], 1u); break; } } } } while (0)
constexpr int LDS_BARST_OFF = 147200;
struct XcdBarrier { unsigned* bar; unsigned x; volatile XLAS unsigned* st; };
__device__ __forceinline__ XcdBarrier xcd_barrier_post(unsigned* bar, volatile XLAS unsigned* st) {
    XcdBarrier b; b.bar = bar; b.x = xb_xcc_id(); b.st = st;
    if (threadIdx.x == 0) (void)xb_add(&bar[XB_XCNT(b.x)], 1u);
    return b;
}
__device__ __forceinline__ void xcd_barrier_complete(unsigned* bar, unsigned x, unsigned& nloc, unsigned& nx) {
    const unsigned G = gridDim.x * gridDim.y * gridDim.z;
    unsigned sum, cnt, mine, sp = 0u;
    for (;;) {
        sum = 0u; cnt = 0u; mine = 0u;
#pragma unroll
        for (unsigned j = 0; j < 16; ++j) { const unsigned c = xb_ld(&bar[XB_XCNT(j)]); sum += c; cnt += (c > 0u) ? 1u : 0u; mine = (j == x) ? c : mine; }
        if (sum == G) break;
        __builtin_amdgcn_s_sleep(1);
        if ((++sp & 255u) == 0u) { if (xb_ld(&bar[XB_TMO])) break; if (sp > XB_SPIN_CAP) { atomicAdd(&bar[XB_TMO], 1u); break; } }
    }
    nloc = mine > 0u ? mine : 1u; nx = cnt > 0u ? cnt : 1u;
}
__device__ __forceinline__ void xcd_barrier(unsigned char* ws, unsigned char* lds_raw_) {
    XcdBarrier b; b.bar = (unsigned*)(ws + WS_BAR); b.x = xb_xcc_id(); b.st = (volatile XLAS unsigned*)((XLAS unsigned char*)lds_raw_ + LDS_BARST_OFF);
    asm volatile("s_waitcnt vmcnt(0)" ::: "memory");
    __syncthreads();
    if (threadIdx.x == 0) {
        unsigned* bar = b.bar;
        __builtin_amdgcn_s_waitcnt(0);
        unsigned nloc = b.st[0], nx = b.st[1];
        if (nloc == 0u) { xcd_barrier_complete(bar, b.x, nloc, nx); b.st[0] = nloc; b.st[1] = nx; }
        const unsigned old = xb_add(&bar[XB_XSUB(b.x)], 1u);
        const unsigned gen = old / nloc;
        if (old + 1u == (gen + 1u) * nloc) {
            __builtin_amdgcn_fence(__ATOMIC_RELEASE, "agent");
            asm volatile("s_waitcnt vmcnt(0)" ::: "memory");
            const unsigned og = xb_add(&bar[XB_TOP], 1u);
            const unsigned tg = og / nx;
            if (og + 1u == (tg + 1u) * nx) xb_add(&bar[XB_TOPGEN], 1u);
            else XB_SPIN(xb_ld(&bar[XB_TOPGEN]) == tg, bar);
            __builtin_amdgcn_fence(__ATOMIC_ACQUIRE, "agent");
            xb_add(&bar[XB_XGEN(b.x)], 1u);
            asm volatile("s_waitcnt vmcnt(0)" ::: "memory");
        } else {
            XB_SPIN(xb_ld(&bar[XB_XGEN(b.x)]) == gen, bar);
            __builtin_amdgcn_fence(__ATOMIC_ACQUIRE, "agent");
            asm volatile("s_waitcnt vmcnt(0)" ::: "memory");
        }
    }
    __syncthreads();
}

__global__ void __launch_bounds__(NT, 2) mega_fwd(Params p) {
    extern __shared__ __attribute__((aligned(16))) unsigned char lds_raw[];
    float* lds = (float*)lds_raw;
    volatile XLAS unsigned* bst = (volatile XLAS unsigned*)((XLAS unsigned char*)lds_raw + LDS_BARST_OFF);
    if (threadIdx.x < 2) bst[threadIdx.x] = 0u;
    __syncthreads();
    (void)xcd_barrier_post((unsigned*)(p.ws + WS_BAR), bst);
#define GSYNC() xcd_barrier(p.ws, lds_raw)
    phase_p0a(p, lds);
#if FAST_G1 || FAST_G2 || FAST_MOE
    __syncthreads();
    phase_convert(p, lds);
#if DUP == 1
    __syncthreads(); phase_convert(p, lds);
#endif
#endif
    GSYNC();
    phase_p0b(p);
#if DUP == 10
    GSYNC(); __syncthreads(); phase_p0a(p, lds); GSYNC(); phase_p0b(p);
#endif
    GSYNC();
    _Pragma("unroll 1") for (int l = 0; l < L; ++l) {
        phase_r1(p, l, true);
#if DUP == 11
        if (l == 0) phase_r1(p, l, true);
#endif
        GSYNC();
#if FAST_G1
        phase_g1_fast(p, l, lds_raw);
#if DUP == 2
        phase_g1_fast(p, l, lds_raw);
#endif
#else
        phase_g1(p, l, lds);
#endif
        GSYNC();
#if !FAST_G1
        phase_zp(p, l);
        GSYNC();
#endif
        phase_ck_fast(p, l, lds_raw);
#if DUP == 3
        __syncthreads(); phase_ck_fast(p, l, lds_raw);
#endif
        GSYNC();
        phase_c2(p, l, lds);
        __syncthreads();
        phase_route(p, lds_raw);
#if DUP == 14
        __syncthreads(); phase_route(p, lds_raw);
#endif
        GSYNC();
#if FAST_ATT
        phase_att1(p, lds_raw);
#if DUP == 5
        __syncthreads(); phase_att1(p, lds_raw);
#endif
#if DUP == 15
        __syncthreads(); phase_att1(p, lds_raw, false, true);
#endif
        GSYNC();
        phase_att2(p, lds_raw);
#if DUP == 13
        __syncthreads(); phase_att2(p, lds_raw);
#endif
#else
        phase_att(p, lds);
#endif
        GSYNC();
#if FAST_G2
        phase_g2_fast(p, l, lds_raw);
#if DUP == 8
        if (l == 0) phase_g2_fast(p, l, lds_raw);
#endif
#else
        phase_g2(p, l, lds);
#endif
        GSYNC();
        phase_r2_fast(p, l, lds_raw);
#if DUP == 9
        __syncthreads(); phase_r2_fast(p, l, lds_raw);
#endif
        GSYNC();
        phase_sc_fast(p, l, lds_raw);
#if DUP == 12
        __syncthreads(); phase_sc_fast(p, l, lds_raw);
#endif
        GSYNC();
#if FAST_MOE
        phase_m1_fast(p, l, lds_raw);
#if DUP == 6
        phase_m1_fast(p, l, lds_raw);
#endif
#else
        phase_m1(p, l, lds);
#endif
        GSYNC();
#if FAST_MOE
        phase_m2_fast(p, l, lds_raw);
#if DUP == 7
        phase_m2_fast(p, l, lds_raw);
#endif
#else
        phase_m2(p, l, lds);
#endif
        GSYNC();
    }
    phase_r1(p, L, false);
}

extern "C" void kernel_launch(void* const* d_in, const int* in_sizes, int n_in, void* d_out, int out_size, void* d_ws, size_t ws_size, hipStream_t stream) {
    static int grid_blocks = 0;
    if (grid_blocks == 0) {
        if (n_in != 21 || out_size != T * D || ws_size < WS_END) { fprintf(stderr, "kernel_launch: unexpected shapes (n_in %d out %d ws %zu need %zu)\n", n_in, out_size, ws_size, (size_t)WS_END); grid_blocks = -1; return; }
        int dev = 0, cus = 0, per_cu = 0;
        hipGetDevice(&dev);
        hipDeviceGetAttribute(&cus, hipDeviceAttributeMultiprocessorCount, dev);
        hipFuncSetAttribute((const void*)mega_fwd, hipFuncAttributeMaxDynamicSharedMemorySize, LDS_BYTES);
        hipOccupancyMaxActiveBlocksPerMultiprocessor(&per_cu, (const void*)mega_fwd, NT, LDS_BYTES);
        if (per_cu < 1) { fprintf(stderr, "kernel_launch: occupancy query says %d blocks per CU\n", per_cu); per_cu = 1; }
        (void)hipGetLastError();
        grid_blocks = cus * 1;
    }
    if (grid_blocks < 0) return;
    if (hipMemsetAsync((char*)d_ws + WS_BAR, 0, 16384, stream) != hipSuccess) { fprintf(stderr, "kernel_launch: memset failed\n"); return; }
    Params p{};
    for (int i = 0; i < 21; ++i) p.in[i] = (const float*)d_in[i];
    p.out = (float*)d_out; p.ws = (unsigned char*)d_ws;
    hipLaunchKernelGGL(mega_fwd, dim3(grid_blocks), dim3(NT), LDS_BYTES, stream, p);
    hipError_t e = hipPeekAtLastError();
    if (e != hipSuccess) fprintf(stderr, "launch failed: %s (grid %d)\n", hipGetErrorString(e), grid_blocks);
}
```

```cpp
#include <hip/hip_runtime.h>
#include <cstdio>
#include <cstdint>

constexpr int Bn = 2, S = 8192, D = 1024, L = 2, T = Bn * S;
constexpr int INW = 2840;
constexpr int NE = 32, TOPK = 4, DFF = 1024;
constexpr int A_TOT = T * TOPK;
constexpr int RMAX = A_TOT + NE * 256;
constexpr int NCMP = 511;
constexpr int NT = 512;
constexpr int NW = NT / 64;
constexpr int LDS_BYTES = 147456;
constexpr float EPS = 1e-6f;
constexpr float NEGF = -1e30f;

constexpr int ZBW = 3072;
constexpr int ZB_Q = 0, ZB_KC = 512, ZB_VC = 640, ZB_KS = 768, ZB_VS = 896, ZB_KW = 1024, ZB_VW = 1152, ZB_MQ = 1280, ZB_MK = 1792, ZB_MV = 2304, ZB_G = 2816;
constexpr float QSCALE = 0.125f * 1.4426950408889634f;
constexpr float LOG2E = 1.4426950408889634f;

constexpr size_t al256(size_t x) { return (x + 255) & ~(size_t)255; }
constexpr size_t WS_BAR = 0;
constexpr size_t WS_MODP = 16384;
constexpr size_t WS_MOD = al256(WS_MODP + (size_t)8 * L * Bn * 6144 * 4);
constexpr size_t WS_CNT = al256(WS_MOD + (size_t)L * Bn * 6144 * 4);
constexpr size_t WS_ROWTOK = al256(WS_CNT + L * 32 * 4);
constexpr size_t WS_ROWW = al256(WS_ROWTOK + (size_t)L * RMAX * 4);
constexpr size_t WS_TOKE = al256(WS_ROWW + (size_t)L * RMAX * 4);
constexpr size_t WS_TOKW = al256(WS_TOKE + (size_t)T * 4 * 4);
constexpr size_t WS_POS = al256(WS_TOKW + (size_t)T * 4 * 4);
constexpr size_t WS_Y = al256(WS_POS + (size_t)T * 4 * 4);
constexpr size_t WS_WINT = al256(WS_Y + (size_t)RMAX * 1024 * 4);
constexpr size_t WS_WOT = al256(WS_WINT + (size_t)L * 3072 * 1024 * 2);
constexpr size_t WS_W1T = al256(WS_WOT + (size_t)L * 1024 * 1024 * 2);
constexpr size_t WS_W2T = al256(WS_W1T + (size_t)L * NE * 2048 * 1024 * 2);
constexpr size_t WS_XN = al256(WS_W2T + (size_t)L * NE * 1024 * 1024 * 2);
constexpr size_t WS_ATTB = al256(WS_XN + (size_t)(T + 1) * D * 2);
constexpr size_t WS_ACT = al256(WS_ATTB + (size_t)T * D * 2);
constexpr size_t WS_ZB = al256(WS_ACT + (size_t)RMAX * DFF * 2);
constexpr size_t WS_GATE = al256(WS_ZB + (size_t)T * ZBW * 2);
constexpr size_t WS_KCB = al256(WS_GATE + (size_t)T * 32 * 4);
constexpr size_t WS_VCB = al256(WS_KCB + (size_t)Bn * 2 * 512 * 64 * 2);
constexpr size_t WS_KMB = al256(WS_VCB + (size_t)Bn * 2 * 512 * 64 * 2);
constexpr size_t WS_XNLO = al256(WS_KMB + (size_t)Bn * 8 * 32 * 64 * 2);
constexpr size_t WS_BC = al256(WS_XNLO + (size_t)T * D * 2);
constexpr size_t WS_WCT = al256(WS_BC + (size_t)(T / 64) * 32 * 4);
constexpr size_t WS_CBP = al256(WS_WCT + (size_t)L * 2 * 128 * 2048 * 2);
constexpr size_t WS_CB = al256(WS_CBP + (size_t)16 * L * 2 * 128 * 4);
constexpr size_t WS_HIDP = al256(WS_CB + (size_t)L * 2 * 128 * 4);
constexpr size_t WS_XAB = al256(WS_HIDP + (size_t)4 * 2 * 2044 * 128 * 4);
constexpr size_t WS_SEL3 = al256(WS_XAB + (size_t)T * D * 2);
constexpr size_t WS_LRK = al256(WS_SEL3 + (size_t)T * 8 * 4);
constexpr size_t WS_ILIST = al256(WS_LRK + (size_t)T * 8 * 4);
constexpr size_t WS_BCM = al256(WS_ILIST + (size_t)16 * 32 * 32 * 256);
constexpr size_t WS_PM = al256(WS_BCM + (size_t)16 * 32 * 32 * 4);
constexpr size_t WS_PL = al256(WS_PM + (size_t)16 * 25600 * 4);
constexpr size_t WS_PO = al256(WS_PL + (size_t)16 * 25600 * 4);
constexpr size_t WS_END = al256(WS_PO + (size_t)16 * 25600 * 64 * 2);

struct Params {
    const float* in[21];
    float* out;
    unsigned char* ws;
};

__device__ __forceinline__ int otid() { int t = threadIdx.x; asm volatile("" : "+v"(t)); return t; }
typedef unsigned short bf16_t;
__device__ __forceinline__ unsigned f2bf(float f) { unsigned u = __builtin_bit_cast(unsigned, f); return (u + 0x7fffu + ((u >> 16) & 1u)) >> 16; }
__device__ __forceinline__ unsigned pk2(float lo, float hi) { return f2bf(lo) | (f2bf(hi) << 16); }
__device__ __forceinline__ float bf2f(bf16_t v) { return __builtin_bit_cast(float, (unsigned)v << 16); }
__device__ __forceinline__ float wave_sum(float v) {
#pragma unroll
    for (int o = 1; o < 64; o <<= 1) v += __shfl_xor(v, o);
    return v;
}
__device__ __forceinline__ float sigmoidf_(float x) { return 1.f / (1.f + __expf(-x)); }
__device__ __forceinline__ float gelu_tanh(float x) {
    const float u = 0.7978845608028654f * (x + 0.044715f * x * x * x);
    return 0.5f * x * (1.f + tanhf(u));
}

__device__ __forceinline__ void phase_p0a(const Params& p, float* lds) {
    const int tid = otid(), gtid = blockIdx.x * NT + tid, gsz = gridDim.x * NT;
    int* cnt = (int*)(p.ws + WS_CNT); int* rowtok = (int*)(p.ws + WS_ROWTOK);
    for (int i = gtid; i < L * 32; i += gsz) cnt[i] = 0;
    for (int i = gtid; i < L * RMAX; i += gsz) rowtok[i] = -1;
    const float* c = p.in[1];
    for (int i = tid; i < Bn * D; i += NT) { const float v = c[i]; lds[i] = v / (1.f + __expf(-v)); }
    __syncthreads();
    const float* ada_w = p.in[2];
    float* modp = (float*)(p.ws + WS_MODP);
    for (int idx = gtid; idx < 8 * L * 6144; idx += gsz) {
        const int col = idx % 6144, l = (idx / 6144) % L, kc = idx / (6144 * L);
        const float* w = ada_w + ((size_t)l * D + kc * 128) * 6144 + col;
        float a0 = 0.f, a1 = 0.f;
#pragma unroll 8
        for (int k = 0; k < 128; ++k) { const float wv = w[(size_t)k * 6144]; a0 += lds[kc * 128 + k] * wv; a1 += lds[D + kc * 128 + k] * wv; }
        modp[((size_t)(kc * L + l) * Bn + 0) * 6144 + col] = a0;
        modp[((size_t)(kc * L + l) * Bn + 1) * 6144 + col] = a1;
    }
    { const float* posw = p.in[9]; const float* w1c = p.in[10]; float* cbp = (float*)(p.ws + WS_CBP);
      for (int idx = gtid; idx < 16 * L * 2 * 128; idx += gsz) {
          const int j = idx & 127, li = (idx >> 7) % (L * 2), kc = idx / (L * 2 * 128);
          const float* w = w1c + ((size_t)li * 2048 + kc * 128) * 128 + j; const float* pp = posw + (size_t)li * 2048 + kc * 128;
          float a = 0.f;
#pragma unroll 8
          for (int k = 0; k < 128; ++k) a += pp[k] * w[(size_t)k * 128];
          cbp[idx] = a; } }
}
__device__ __forceinline__ void phase_p0b(const Params& p) {
    const int gtid = blockIdx.x * NT + otid(), gsz = gridDim.x * NT;
    { const float* cbp = (const float*)(p.ws + WS_CBP); float* cb = (float*)(p.ws + WS_CB);
      for (int idx = gtid; idx < L * 2 * 128; idx += gsz) { float s = 0.f;
#pragma unroll
          for (int kc = 0; kc < 16; ++kc) s += cbp[kc * (L * 2 * 128) + idx];
          cb[idx] = s; } }
    const float* modp = (const float*)(p.ws + WS_MODP); float* mod = (float*)(p.ws + WS_MOD); const float* ada_b = p.in[3];
    for (int idx = gtid; idx < L * Bn * 6144; idx += gsz) {
        const int col = idx % 6144, l = idx / (Bn * 6144);
        float s = ada_b[l * 6144 + col];
#pragma unroll
        for (int kc = 0; kc < 8; ++kc) s += modp[(size_t)kc * L * Bn * 6144 + idx];
        mod[idx] = s;
    }
}

__device__ __forceinline__ void phase_r1(const Params& p, int l, bool do_h) {
    const int lane = otid() & 63, wave = otid() >> 6;
    const int gw = blockIdx.x * NW + wave, ngw = gridDim.x * NW;
    const float* mod = (const float*)(p.ws + WS_MOD);
    const float* xin = p.in[0]; float* XA = p.out;
    const bf16_t* Y = (const bf16_t*)(p.ws + WS_Y); const int* pos = (const int*)(p.ws + WS_POS);
    const float* lng = p.in[4] + (size_t)(do_h ? l : 0) * D;
    bf16_t* XN = (bf16_t*)(p.ws + WS_XN);
    for (int t = gw; t < T; t += ngw) {
        const int b = t / S;
        float4 v[4];
        if (l == 0) {
#pragma unroll
            for (int j = 0; j < 4; ++j) v[j] = *(const float4*)(xin + (size_t)t * D + 4 * lane + 256 * j);
        } else {
            const float* g2 = mod + ((size_t)(l - 1) * Bn + b) * 6144 + 5 * D;
            const int p0 = pos[t * 4 + 0], p1 = pos[t * 4 + 1], p2 = pos[t * 4 + 2], p3 = pos[t * 4 + 3];
            bf16_t* XAB = (bf16_t*)(p.ws + WS_XAB);
#pragma unroll
            for (int j = 0; j < 4; ++j) {
                const int col = 4 * lane + 256 * j;
#define BF4(q) make_float4(__builtin_bit_cast(float, (q).x << 16), __builtin_bit_cast(float, (q).x & 0xffff0000u), __builtin_bit_cast(float, (q).y << 16), __builtin_bit_cast(float, (q).y & 0xffff0000u))
                const uint2 xq = *(const uint2*)(XAB + (size_t)t * D + col);
                const float4 x = BF4(xq);
                const uint2 q0 = *(const uint2*)(Y + (size_t)p0 * D + col), q1 = *(const uint2*)(Y + (size_t)p1 * D + col), q2 = *(const uint2*)(Y + (size_t)p2 * D + col), q3 = *(const uint2*)(Y + (size_t)p3 * D + col);
                const float4 y0 = BF4(q0), y1 = BF4(q1), y2 = BF4(q2), y3 = BF4(q3);
#undef BF4
                const float4 g = *(const float4*)(g2 + col);
                float4 r;
                r.x = x.x + g.x * (((y0.x + y1.x) + y2.x) + y3.x); r.y = x.y + g.y * (((y0.y + y1.y) + y2.y) + y3.y);
                r.z = x.z + g.z * (((y0.z + y1.z) + y2.z) + y3.z); r.w = x.w + g.w * (((y0.w + y1.w) + y2.w) + y3.w);
                v[j] = r;
                if (do_h) *(uint2*)(XAB + (size_t)t * D + col) = make_uint2(pk2(r.x, r.y), pk2(r.z, r.w));
                else *(float4*)(XA + (size_t)t * D + col) = r;
            }
        }
        if (do_h) {
            float ss = 0.f;
#pragma unroll
            for (int j = 0; j < 4; ++j) ss += (v[j].x * v[j].x + v[j].y * v[j].y) + (v[j].z * v[j].z + v[j].w * v[j].w);
            ss = wave_sum(ss);
            const float r = rsqrtf(ss * (1.f / D) + EPS);
            const float* sh = mod + ((size_t)l * Bn + b) * 6144 + 0 * D; const float* sc = mod + ((size_t)l * Bn + b) * 6144 + 1 * D;
#pragma unroll
            for (int j = 0; j < 4; ++j) {
                const int col = 4 * lane + 256 * j;
                const float4 g = *(const float4*)(lng + col), s1 = *(const float4*)(sc + col), s0 = *(const float4*)(sh + col);
                float4 o;
                o.x = v[j].x * r * g.x * (1.f + s1.x) + s0.x; o.y = v[j].y * r * g.y * (1.f + s1.y) + s0.y;
                o.z = v[j].z * r * g.z * (1.f + s1.z) + s0.z; o.w = v[j].w * r * g.w * (1.f + s1.w) + s0.w;
                *(uint2*)(XN + (size_t)t * D + col) = make_uint2(pk2(o.x, o.y), pk2(o.z, o.w));
            }
        }
    }
}


__device__ __forceinline__ void phase_c2(const Params& p, int l, float* lds) {
    const int lane = otid() & 63, wave = otid() >> 6;
    const float* HIDP = (const float*)(p.ws + WS_HIDP); const float* cb = (const float*)(p.ws + WS_CB) + l * 2 * 128; const float* w2 = p.in[11] + (size_t)l * 2 * 128 * 64;
    const float gk = p.in[8][l * 64 + lane];
    float* hl = lds + wave * 128;
    for (int r = blockIdx.x * NW + wave; r < 2 * 2044; r += gridDim.x * NW) {
        const int idx = r / 2044, rr = r % 2044;
#pragma unroll
        for (int q = 0; q < 2; ++q) { const int j = lane + 64 * q; float s = cb[idx * 128 + j];
#pragma unroll
            for (int kq = 0; kq < 4; ++kq) s += HIDP[((size_t)(kq * 2 + idx) * 2044 + rr) * 128 + j];
            hl[j] = gelu_tanh(s); }
        asm volatile("s_waitcnt lgkmcnt(0)" ::: "memory"); __builtin_amdgcn_wave_barrier();
        const float* W = w2 + (size_t)idx * 128 * 64;
        float s = 0.f;
#pragma unroll 8
        for (int j = 0; j < 128; ++j) s += hl[j] * W[j * 64 + lane];
        asm volatile("s_waitcnt lgkmcnt(0)" ::: "memory"); __builtin_amdgcn_wave_barrier();
        const int bgi = rr / 511, n = rr % 511;
        if (idx == 0) { const float ss = wave_sum(s * s); const float kv = s * rsqrtf(ss * (1.f / 64.f) + EPS) * gk; ((bf16_t*)(p.ws + WS_KCB))[((size_t)bgi * 512 + n) * 64 + lane] = (bf16_t)f2bf(kv); }
        else { ((bf16_t*)(p.ws + WS_VCB))[((size_t)bgi * 512 + n) * 64 + lane] = (bf16_t)f2bf(s); }
    }
    if (blockIdx.x == 0 && otid() < 2 * 4 * 64) { const int i = otid(); bf16_t* dst = (bf16_t*)(p.ws + (i < 256 ? WS_KCB : WS_VCB)); dst[((size_t)((i & 255) >> 6) * 512 + 511) * 64 + (i & 63)] = 0; }
}

__device__ __forceinline__ void load_pstart(const Params& p, int l, int* ps) {
    const int* cnt = (const int*)(p.ws + WS_CNT) + l * 32;
    if (otid() == 0) { int s = 0; for (int e = 0; e < 32; ++e) { ps[e] = s; s += (cnt[e] + 255) & ~255; } ps[32] = s; }
    __syncthreads();
}


template <int MAP>
__device__ __forceinline__ void tr_tile(const float* W, int Nsrc, bf16_t* WT, int K, int k0, int n0, float* scr, int lane) {
    const int nl = (lane & 15) * 4, kr = lane >> 4;
    int sc = n0 + nl;
    if (MAP == 1) { sc = sc < 1280 ? sc : (sc < 2816 ? sc + 24 : (sc < 2840 ? sc - 2816 + 1280 : -1)); }
    float4 v[16];
#pragma unroll
    for (int it = 0; it < 16; ++it) { if (sc >= 0) { const float* src_ = W + (size_t)(k0 + it * 4 + kr) * Nsrc + sc; typedef float f4v __attribute__((ext_vector_type(4))); const f4v t_ = __builtin_nontemporal_load((const f4v*)src_); v[it] = make_float4(t_[0], t_[1], t_[2], t_[3]); } else v[it] = make_float4(0.f, 0.f, 0.f, 0.f); }
#pragma unroll
    for (int it = 0; it < 16; ++it) { float* s = scr + (it * 4 + kr) * 65 + nl; s[0] = v[it].x; s[1] = v[it].y; s[2] = v[it].z; s[3] = v[it].w; }
    asm volatile("s_waitcnt lgkmcnt(0)" ::: "memory"); __builtin_amdgcn_wave_barrier();
    const int c = lane & 7, nr = lane >> 3;
#pragma unroll
    for (int it = 0; it < 8; ++it) {
        const int n = it * 8 + nr; const float* s = scr + (8 * c) * 65 + n;
        uint4 o; o.x = pk2(s[0], s[65]); o.y = pk2(s[2 * 65], s[3 * 65]); o.z = pk2(s[4 * 65], s[5 * 65]); o.w = pk2(s[6 * 65], s[7 * 65]);
        *(uint4*)(WT + (size_t)(n0 + n) * K + k0 + 8 * c) = o;
    }
    asm volatile("s_waitcnt lgkmcnt(0)" ::: "memory"); __builtin_amdgcn_wave_barrier();
}
__device__ __forceinline__ void phase_convert(const Params& p, float* lds) {
    const int tid = otid(), lane = tid & 63, wave = tid >> 6;
    float* scr = lds + wave * (64 * 65);
    const int gw = blockIdx.x * NW + wave, ngw = gridDim.x * NW;
    bf16_t* WinT = (bf16_t*)(p.ws + WS_WINT); bf16_t* WoT = (bf16_t*)(p.ws + WS_WOT); bf16_t* W1T = (bf16_t*)(p.ws + WS_W1T); bf16_t* W2T = (bf16_t*)(p.ws + WS_W2T);
    constexpr int I_IN = L * 16 * (ZBW / 64), I_O = L * 16 * 16, I_1 = L * NE * 16 * 32, I_2 = L * NE * 16 * 16, I_C = L * 2 * 32 * 2;
    for (int it = gw; it < I_C + I_IN + I_O + I_1 + I_2; it += ngw) {
        int r = it;
        if (r < I_C) { const int li = r / 64, q = r % 64, kb = q / 2, nb = q % 2;
            tr_tile<0>(p.in[10] + (size_t)li * 2048 * 128, 128, (bf16_t*)(p.ws + WS_WCT) + (size_t)li * 128 * 2048, 2048, kb * 64, nb * 64, scr, lane); continue; }
        r -= I_C;
        if (r < I_IN) { const int l = r / (16 * 48), q = r % (16 * 48), kb = q / 48, nb = q % 48;
            tr_tile<1>(p.in[6] + (size_t)l * D * INW, INW, WinT + (size_t)l * ZBW * D, D, kb * 64, nb * 64, scr, lane); continue; }
        r -= I_IN;
        if (r < I_O) { const int l = r / 256, q = r % 256, kb = q / 16, nb = q % 16;
            tr_tile<0>(p.in[14] + (size_t)l * D * D, D, WoT + (size_t)l * D * D, D, kb * 64, nb * 64, scr, lane); continue; }
        r -= I_O;
        if (r < I_1) { const int le = r / 512, q = r % 512, kb = q / 32, nb = q % 32;
            tr_tile<0>(p.in[17] + (size_t)le * D * 2048, 2048, W1T + (size_t)le * 2048 * D, D, kb * 64, nb * 64, scr, lane); continue; }
        r -= I_1;
        { const int le = r / 256, q = r % 256, kb = q / 16, nb = q % 16;
            tr_tile<0>(p.in[19] + (size_t)le * DFF * D, D, W2T + (size_t)le * D * DFF, DFF, kb * 64, nb * 64, scr, lane); }
    }
    if (blockIdx.x == 0) { bf16_t* XN = (bf16_t*)(p.ws + WS_XN); for (int i = tid; i < D / 2; i += NT) ((unsigned*)(XN + (size_t)T * D))[i] = 0u; }
}

namespace pg8 {
#define PG8_LAS __attribute__((address_space(3)))
typedef short bf16x8 __attribute__((ext_vector_type(8)));
typedef float f32x4 __attribute__((ext_vector_type(4)));
typedef unsigned u32x4 __attribute__((ext_vector_type(4)));
constexpr int BM = 256, BK = 64, HALF = 128, HTB = HALF * BK * 2, STAGE_BYTES = 8 * HTB, NXCD = 8, WGM = 8;
__device__ __forceinline__ int lds_byte(int r, int c) { const int st = (r >> 4) * 2 + (c >> 5), rr = r & 15, cc = c & 31, ob = rr * 64 + cc * 2; return st * 1024 + (ob ^ (((ob >> 9) & 1) << 5)); }
__device__ __forceinline__ void stage_rc(int b, int& R, int& C) { const int st = b / 1024, sb = b % 1024, swz = sb ^ (((sb >> 9) & 1) << 5); R = (st >> 1) * 16 + swz / 64; C = (st & 1) * 32 + (swz % 64) / 2; }
__device__ __forceinline__ int perm32(int rho) { const int n = rho >> 4, i = rho & 15; return 8 * (i >> 2) + 4 * n + (i & 3); }
struct Unit { int pm, pn, e; };
__device__ __forceinline__ unsigned cvt_pk_bf16(float lo, float hi) { unsigned r; asm volatile("v_cvt_pk_bf16_f32 %0, %1, %2" : "=v"(r) : "v"(lo), "v"(hi)); return r; }

__device__ __forceinline__ bool static_next(int nM, int nN, int G, int c, int i, Unit& u) {
    const int nwg = nM * nN; const long Lq = (long)i * G + c; if (Lq >= nwg) return false;
    int wgid = (int)Lq; { const int q = nwg / NXCD, r = nwg % NXCD, xcd = wgid % NXCD, off = wgid / NXCD; wgid = (xcd < r ? xcd * (q + 1) : r * (q + 1) + (xcd - r) * q) + off; }
    const int nig = WGM * nN, gid = wgid / nig, fm = gid * WGM, gsz = (nM - fm) < WGM ? (nM - fm) : WGM;
    u.pm = fm + ((wgid % nig) % gsz); u.pn = (wgid % nig) / gsz; u.e = 0; return true;
}

template <class Prob, class Epi, bool ALIGN_EPI, bool SP2>
__device__ __forceinline__ void gemm_phase(PG8_LAS unsigned char* lds, const Prob& P, const Epi& E) {
    const int tid = otid(), wid = __builtin_amdgcn_readfirstlane(tid >> 6), lane = tid & 63, wr = wid >> 2, wc = wid & 3, fr = lane & 15, fq = lane >> 4;
    const int K = P.K, nt = Prob::KT > 0 ? Prob::KT : K / BK;
    int sR[2], sC[2]; unsigned voffB[2];
#pragma unroll
    for (int i = 0; i < 2; ++i) { stage_rc(tid * 16 + i * 8192, sR[i], sC[i]); voffB[i] = (unsigned)(P.b_row(sR[i]) * K + sC[i]) * 2u; }
    const size_t kstep = (size_t)(BK * 2);
    const size_t kstepA = P.a_kstep();
    const size_t hstepB = P.b_hstep();
    const unsigned ldsw = (unsigned)wid * 1024u;
    const int aoff = lds_byte(wr * 64 + fr, fq * 8), boff = lds_byte(wc * 32 + fr, fq * 8);
#define PG8_SA(b, h) (((b) * 2 + (h)) * HTB)
#define PG8_SB(b, h) ((4 + (b) * 2 + (h)) * HTB)
#define PG8_STAGE(bufoff, gbase, voff) do { _Pragma("unroll") for (int _i = 0; _i < 2; ++_i) \
        __builtin_amdgcn_global_load_lds((const unsigned*)((const char*)(gbase) + (voff)[_i]), (PG8_LAS unsigned*)(lds + (bufoff) + ldsw + _i * 8192), 16, 0, 0); } while (0)
#define PG8_STAGE_SEL(bufoff, gbase, h) do { _Pragma("unroll") for (int _i = 0; _i < 2; ++_i) { unsigned _vo = vAc[h][_i]; if constexpr (Prob::GATHER) _vo = last ? vAn[h][_i] : _vo; \
        __builtin_amdgcn_global_load_lds((const unsigned*)((const char*)(gbase) + _vo), (PG8_LAS unsigned*)(lds + (bufoff) + ldsw + _i * 8192), 16, 0, 0); } } while (0)
#define PG8_LDA(dst, b, h) do { _Pragma("unroll") for (int m = 0; m < 4; ++m) _Pragma("unroll") for (int k = 0; k < 2; ++k) dst[m][k] = *(const PG8_LAS bf16x8*)(lds + PG8_SA(b, h) + aoff + m * 2048 + k * 1024); } while (0)
#define PG8_LDB(dst, b, h) do { _Pragma("unroll") for (int n = 0; n < 2; ++n) _Pragma("unroll") for (int k = 0; k < 2; ++k) dst[n][k] = *(const PG8_LAS bf16x8*)(lds + PG8_SB(b, h) + boff + n * 2048 + k * 1024); } while (0)
#define PG8_MMA(ai, bj, At, Bt) do { __builtin_amdgcn_s_setprio(1); _Pragma("unroll") for (int m = 0; m < 4; ++m) _Pragma("unroll") for (int n = 0; n < 2; ++n) _Pragma("unroll") for (int k = 0; k < 2; ++k) \
        acc[ai][bj][m][n] = __builtin_amdgcn_mfma_f32_16x16x32_bf16(Bt[n][k], At[m][k], acc[ai][bj][m][n], 0, 0, 0); __builtin_amdgcn_s_setprio(0); } while (0)
#define PG8_WAIT_V(n) asm volatile("s_waitcnt vmcnt(" #n ")" ::: "memory")
#define PG8_WAIT_L(n) asm volatile("s_waitcnt lgkmcnt(" #n ")" ::: "memory")
#define PG8_BAR __builtin_amdgcn_s_barrier()
#define PG8_SCHED __builtin_amdgcn_sched_barrier(0)
    Unit cur, nxt; int ui = 0;
    if (!P.next(0, cur)) return;
    f32x4 acc[2][2][4][2];
#pragma unroll
    for (int a = 0; a < 2; ++a)
#pragma unroll
        for (int b = 0; b < 2; ++b)
#pragma unroll
            for (int m = 0; m < 4; ++m)
#pragma unroll
                for (int n = 0; n < 2; ++n) acc[a][b][m][n] = (f32x4){0.f, 0.f, 0.f, 0.f};
    bf16x8 At[4][2], B0[2][2], B1[2][2];
    unsigned vAc[2][2], vAn[2][2];
    const char* cA = P.a_base(cur); const char* cB = P.b_base(cur);
    P.a_voff(cur, sR, sC, vAc);
#pragma unroll
    for (int h = 0; h < 2; ++h)
#pragma unroll
        for (int i = 0; i < 2; ++i) vAn[h][i] = vAc[h][i];
    if constexpr (SP2) {
        PG8_STAGE(PG8_SB(0, 0), cB, voffB); PG8_STAGE(PG8_SB(0, 1), cB + hstepB, voffB); PG8_STAGE(PG8_SA(0, 0), cA, vAc[0]); PG8_STAGE(PG8_SA(0, 1), cA, vAc[1]);
        if (wr == 1) PG8_BAR;
        PG8_WAIT_V(2); PG8_BAR;
        PG8_STAGE(PG8_SB(1, 0), cB + kstep, voffB); PG8_STAGE(PG8_SA(1, 0), cA + kstepA, vAc[0]); PG8_STAGE(PG8_SB(1, 1), cB + hstepB + kstep, voffB);
        PG8_WAIT_V(6); PG8_BAR;
    } else {
        PG8_STAGE(PG8_SB(0, 0), cB, voffB); PG8_STAGE(PG8_SA(0, 0), cA, vAc[0]); PG8_STAGE(PG8_SB(0, 1), cB + hstepB, voffB); PG8_STAGE(PG8_SA(0, 1), cA, vAc[1]);
        if (wr == 1) PG8_BAR;
        PG8_WAIT_V(4); PG8_BAR;
        PG8_STAGE(PG8_SB(1, 0), cB + kstep, voffB); PG8_STAGE(PG8_SA(1, 0), cA + kstepA, vAc[0]); PG8_STAGE(PG8_SB(1, 1), cB + hstepB + kstep, voffB);
        PG8_WAIT_V(6); PG8_BAR;
    }
    for (;;) {
        const bool has_next = P.next(ui + 1, nxt);
        const char* nA = cA; const char* nB = cB;
        if (has_next) { nA = P.a_base(nxt); nB = P.b_base(nxt); if constexpr (Prob::GATHER) P.a_voff(nxt, sR, sC, vAn); }
        for (int t = 0; t < nt; t += 2) {
            const bool last = (t == nt - 2);
            const char* a1 = cA + (size_t)(t + 1) * kstepA;
            const char* a2 = last ? nA : cA + (size_t)(t + 2) * kstepA; const char* b2 = last ? nB : cB + (size_t)(t + 2) * kstep;
            const char* a3 = a2 + kstepA; const char* b3 = b2 + kstep;
            if constexpr (SP2) {
            PG8_LDB(B0, 0, 0); PG8_LDB(B1, 0, 1); PG8_SCHED; PG8_LDA(At, 0, 0); PG8_STAGE(PG8_SA(1, 1), a1, vAc[1]);
            PG8_WAIT_V(8); PG8_WAIT_L(0); PG8_BAR; PG8_MMA(0, 0, At, B0); PG8_MMA(0, 1, At, B1); PG8_BAR; PG8_SCHED;
            PG8_LDA(At, 0, 1); PG8_STAGE(PG8_SB(0, 0), b2, voffB); PG8_STAGE(PG8_SB(0, 1), b2 + hstepB, voffB); PG8_STAGE_SEL(PG8_SA(0, 0), a2, 0);
            PG8_WAIT_V(8); PG8_WAIT_L(0); PG8_BAR; PG8_MMA(1, 0, At, B0); PG8_MMA(1, 1, At, B1); PG8_BAR; PG8_SCHED;
            PG8_LDB(B0, 1, 0); PG8_LDB(B1, 1, 1); PG8_SCHED; PG8_LDA(At, 1, 0); PG8_STAGE_SEL(PG8_SA(0, 1), a2, 1);
            PG8_WAIT_V(8); PG8_WAIT_L(0); PG8_BAR; PG8_MMA(0, 0, At, B0); PG8_MMA(0, 1, At, B1); PG8_BAR; PG8_SCHED;
            PG8_LDA(At, 1, 1); PG8_STAGE(PG8_SB(1, 0), b3, voffB); PG8_STAGE(PG8_SB(1, 1), b3 + hstepB, voffB); PG8_STAGE_SEL(PG8_SA(1, 0), a3, 0);
            PG8_WAIT_V(8); PG8_WAIT_L(0); PG8_BAR; PG8_MMA(1, 0, At, B0); PG8_MMA(1, 1, At, B1); PG8_BAR; PG8_SCHED;
            } else {
            PG8_LDB(B0, 0, 0); PG8_SCHED; PG8_LDA(At, 0, 0); PG8_STAGE(PG8_SA(1, 1), a1, vAc[1]);
            PG8_WAIT_L(8); PG8_BAR; PG8_WAIT_L(0); PG8_MMA(0, 0, At, B0); PG8_BAR; PG8_SCHED;
            PG8_LDB(B1, 0, 1); PG8_STAGE(PG8_SB(0, 0), b2, voffB);
            PG8_BAR; PG8_WAIT_L(0); PG8_MMA(0, 1, At, B1); PG8_BAR;
            PG8_LDA(At, 0, 1); PG8_STAGE_SEL(PG8_SA(0, 0), a2, 0);
            PG8_BAR; PG8_WAIT_L(0); PG8_MMA(1, 0, At, B0); PG8_BAR; PG8_SCHED;
            PG8_STAGE(PG8_SB(0, 1), b2 + hstepB, voffB);
            PG8_WAIT_V(6); PG8_BAR; PG8_MMA(1, 1, At, B1); PG8_BAR;
            PG8_LDB(B0, 1, 0); PG8_SCHED; PG8_LDA(At, 1, 0); PG8_STAGE_SEL(PG8_SA(0, 1), a2, 1);
            PG8_WAIT_L(8); PG8_BAR; PG8_WAIT_L(0); PG8_MMA(0, 0, At, B0); PG8_BAR; PG8_SCHED;
            PG8_LDB(B1, 1, 1); PG8_STAGE(PG8_SB(1, 0), b3, voffB);
            PG8_BAR; PG8_WAIT_L(0); PG8_MMA(0, 1, At, B1); PG8_BAR;
            PG8_LDA(At, 1, 1); PG8_STAGE_SEL(PG8_SA(1, 0), a3, 0);
            PG8_BAR; PG8_WAIT_L(0); PG8_MMA(1, 0, At, B0); PG8_BAR; PG8_SCHED;
            PG8_STAGE(PG8_SB(1, 1), b3 + hstepB, voffB);
            PG8_WAIT_V(6); PG8_BAR; PG8_MMA(1, 1, At, B1); PG8_BAR;
            }
        }
        if constexpr (ALIGN_EPI) { if (wr == 0) PG8_BAR; }
        E(acc, cur, wr, wc, fr, fq);
        if (!has_next) break;
#pragma unroll
        for (int a = 0; a < 2; ++a)
#pragma unroll
            for (int b = 0; b < 2; ++b)
#pragma unroll
                for (int m = 0; m < 4; ++m)
#pragma unroll
                    for (int n = 0; n < 2; ++n) acc[a][b][m][n] = (f32x4){0.f, 0.f, 0.f, 0.f};
        cur = nxt; cA = nA; cB = nB; ++ui;
        if constexpr (Prob::GATHER) {
#pragma unroll
            for (int h = 0; h < 2; ++h)
#pragma unroll
                for (int i = 0; i < 2; ++i) vAc[h][i] = vAn[h][i];
        }
        if constexpr (ALIGN_EPI) { if (wr == 1) PG8_BAR; }
    }
    PG8_WAIT_V(0);
    if constexpr (!ALIGN_EPI) { if (wr == 0) PG8_BAR; }
    PG8_BAR;
#undef PG8_SA
#undef PG8_SB
#undef PG8_STAGE
#undef PG8_STAGE_SEL
#undef PG8_LDA
#undef PG8_LDB
#undef PG8_MMA
#undef PG8_WAIT_V
#undef PG8_WAIT_L
#undef PG8_BAR
#undef PG8_SCHED
}

struct ProbDense { static constexpr bool GATHER = false; static constexpr int KT = 0;
    const bf16_t* A; const bf16_t* Bt; int K, nM, nN, G, c; bool headperm;
    __device__ __forceinline__ bool next(int i, Unit& u) const { return static_next(nM, nN, G, c, i, u); }
    __device__ __forceinline__ const char* a_base(const Unit& u) const { return (const char*)(A + (size_t)u.pm * BM * K); }
    __device__ __forceinline__ void a_voff(const Unit&, const int (&R)[2], const int (&C)[2], unsigned (&v)[2][2]) const {
#pragma unroll
        for (int h = 0; h < 2; ++h)
#pragma unroll
            for (int i = 0; i < 2; ++i) v[h][i] = (unsigned)((h * HALF + R[i]) * K + C[i]) * 2u;
    }
    __device__ __forceinline__ const char* b_base(const Unit& u) const { return (const char*)(Bt + (size_t)u.pn * BM * K); }
    __device__ __forceinline__ size_t a_kstep() const { return (size_t)BK * 2; }
    __device__ __forceinline__ size_t b_hstep() const { return headperm ? (size_t)32 * K * 2 : (size_t)HALF * K * 2; }
    __device__ __forceinline__ int b_row(int R) const { return headperm ? ((R >> 5) * 64 + perm32(R & 31)) : ((R & ~31) + perm32(R & 31)); }
};
typedef const PG8_LAS int* lds_ints;
__device__ __forceinline__ int expert_of(lds_ints ps, int pm) { int e = 0;
#pragma unroll
    for (int i = 1; i < 32; ++i) if (ps[i] <= pm * 256) e = i;
    return __builtin_amdgcn_readfirstlane(e); }
struct ProbMoe1 { static constexpr bool GATHER = true; static constexpr int KT = 0;
    const bf16_t* XN; const bf16_t* W1T; const int* rowtok; lds_ints ps; int K, ntm, G, c;
    __device__ __forceinline__ bool next(int i, Unit& u) const { const int q = i * G + c; if (q >= ntm * 8) return false; u.pm = q >> 3; u.pn = q & 7; u.e = expert_of(ps, u.pm); return true; }
    __device__ __forceinline__ const char* a_base(const Unit&) const { return (const char*)XN; }
    __device__ __forceinline__ void a_voff(const Unit& u, const int (&R)[2], const int (&C)[2], unsigned (&v)[2][2]) const {
#pragma unroll
        for (int h = 0; h < 2; ++h)
#pragma unroll
            for (int i = 0; i < 2; ++i) { int tk = rowtok[u.pm * BM + h * HALF + R[i]]; if (tk < 0) tk = T; v[h][i] = (unsigned)(tk * K + C[i]) * 2u; }
    }
    __device__ __forceinline__ const char* b_base(const Unit& u) const { return (const char*)(W1T + ((size_t)u.e * 2048 + u.pn * 128) * K); }
    __device__ __forceinline__ size_t a_kstep() const { return (size_t)BK * 2; }
    __device__ __forceinline__ size_t b_hstep() const { return (size_t)1024 * K * 2; }
    __device__ __forceinline__ int b_row(int R) const { return (R & ~31) + perm32(R & 31); }
};
struct ProbMoe2 { static constexpr bool GATHER = false; static constexpr int KT = 0;
    const bf16_t* ACT; const bf16_t* W2T; lds_ints ps; int K, ntm, G, c;
    __device__ __forceinline__ bool next(int i, Unit& u) const { const int q = i * G + c; if (q >= ntm * 4) return false; u.pm = q >> 2; u.pn = q & 3; u.e = expert_of(ps, u.pm); return true; }
    __device__ __forceinline__ const char* a_base(const Unit& u) const { return (const char*)(ACT + (size_t)u.pm * BM * K); }
    __device__ __forceinline__ void a_voff(const Unit&, const int (&R)[2], const int (&C)[2], unsigned (&v)[2][2]) const {
#pragma unroll
        for (int h = 0; h < 2; ++h)
#pragma unroll
            for (int i = 0; i < 2; ++i) v[h][i] = (unsigned)((h * HALF + R[i]) * K + C[i]) * 2u;
    }
    __device__ __forceinline__ const char* b_base(const Unit& u) const { return (const char*)(W2T + ((size_t)u.e * 1024 + u.pn * BM) * K); }
    __device__ __forceinline__ size_t a_kstep() const { return (size_t)BK * 2; }
    __device__ __forceinline__ size_t b_hstep() const { return (size_t)HALF * K * 2; }
    __device__ __forceinline__ int b_row(int R) const { return (R & ~31) + perm32(R & 31); }
};

struct ProbCmp { static constexpr bool GATHER = false; static constexpr int KT = 8;
    const bf16_t* ZB; const bf16_t* W1T; int K, G, c;
    __device__ __forceinline__ bool next(int i, Unit& u) const { const int q = i * G + c; if (q >= 64) return false; u.pm = q & 15; u.pn = 0; u.e = q >> 4; return true; }
    __device__ __forceinline__ const char* a_base(const Unit& u) const { const int idx = u.pm >> 3, bg = (u.pm >> 1) & 3, half = u.pm & 1;
        return (const char*)(ZB + ((size_t)(bg >> 1) * S + 16 * 256 * half + 8 * u.e) * ZBW + ZB_KC + idx * 128 + (bg & 1) * 64); }
    __device__ __forceinline__ void a_voff(const Unit&, const int (&R)[2], const int (&C)[2], unsigned (&v)[2][2]) const {
#pragma unroll
        for (int h = 0; h < 2; ++h)
#pragma unroll
            for (int i = 0; i < 2; ++i) v[h][i] = (unsigned)(16 * (h * HALF + R[i]) * ZBW + C[i]) * 2u;
    }
    __device__ __forceinline__ size_t a_kstep() const { return (size_t)ZBW * 2; }
    __device__ __forceinline__ const char* b_base(const Unit& u) const { return (const char*)(W1T + (size_t)(u.pm >> 3) * 128 * K + 8 * 64 * u.e); }
    __device__ __forceinline__ size_t b_hstep() const { return 0; }
    __device__ __forceinline__ int b_row(int R) const { return (R & ~31) + perm32(R & 31); }
};
struct EpiCmp {
    float* HIDP;
    __device__ __forceinline__ void operator()(const f32x4 (&acc)[2][2][4][2], const Unit& u, int wr, int wc, int fr, int fq) const {
        const int idx = u.pm >> 3, bg = (u.pm >> 1) & 3, half = u.pm & 1;
        const int c0 = 32 * wc + 8 * fq;
#pragma unroll
        for (int ai = 0; ai < 2; ++ai)
#pragma unroll
            for (int m = 0; m < 4; ++m) { const int n = 256 * half + ai * HALF + wr * 64 + m * 16 + fr;
                if (n < 511) { float* dst = HIDP + (((size_t)u.e * 2 + idx) * 2044 + bg * 511 + n) * 128 + c0;
                    *(f32x4*)dst = acc[ai][0][m][0]; *(f32x4*)(dst + 4) = acc[ai][0][m][1]; } }
    }
};
struct EpiG1F {
    bf16_t* ZB; float* GATE; const float* gq; const float* gk; const float* gmq; const float* gmk;
    __device__ __forceinline__ void operator()(const f32x4 (&acc)[2][2][4][2], const Unit& u, int wr, int wc, int fr, int fq) const {
        const int pn = u.pn;
        const float* gain = nullptr; float sc = 1.f;
        if (pn < 2) { gain = gq; sc = QSCALE; }
        else if (pn == 3 || pn == 4) { if (wc < 2) gain = gk; }
        else if (pn == 5 || pn == 6) { gain = gmq; sc = QSCALE; }
        else if (pn == 7 || pn == 8) { gain = gmk; }
        if (pn == 11) {
            if (wc == 0 && fq < 3) {
#pragma unroll
                for (int ai = 0; ai < 2; ++ai)
#pragma unroll
                    for (int m = 0; m < 4; ++m) { const size_t r = (size_t)u.pm * BM + ai * HALF + wr * 64 + m * 16 + fr;
#pragma unroll
                        for (int n = 0; n < 2; ++n) { const f32x4 v = acc[ai][0][m][n]; f32x4 o;
#pragma unroll
                            for (int i = 0; i < 4; ++i) o[i] = 1.f / (1.f + __expf(-v[i]));
                            *(f32x4*)(GATE + r * 32 + 8 * fq + 4 * n) = o; } }
            }
            return;
        }
        f32x4 gv[2][2];
#pragma unroll
        for (int bj = 0; bj < 2; ++bj)
#pragma unroll
            for (int n = 0; n < 2; ++n) gv[bj][n] = gain ? *(const f32x4*)(gain + 32 * bj + 8 * fq + 4 * n) * sc : (f32x4){1.f, 1.f, 1.f, 1.f};
#pragma unroll
        for (int ai = 0; ai < 2; ++ai)
#pragma unroll
            for (int m = 0; m < 4; ++m) { const size_t r = (size_t)u.pm * BM + ai * HALF + wr * 64 + m * 16 + fr;
                float rs = 1.f;
                if (gain) { float ss = 0.f;
#pragma unroll
                    for (int bj = 0; bj < 2; ++bj)
#pragma unroll
                        for (int n = 0; n < 2; ++n) { const f32x4 v = acc[ai][bj][m][n]; ss += (v[0] * v[0] + v[1] * v[1]) + (v[2] * v[2] + v[3] * v[3]); }
                    ss += __shfl_xor(ss, 16); ss += __shfl_xor(ss, 32);
                    rs = rsqrtf(ss * (1.f / 64.f) + EPS); }
#pragma unroll
                for (int bj = 0; bj < 2; ++bj) { const f32x4 a = acc[ai][bj][m][0] * gv[bj][0] * rs, b = acc[ai][bj][m][1] * gv[bj][1] * rs;
                    u32x4 w; w.x = cvt_pk_bf16(a[0], a[1]); w.y = cvt_pk_bf16(a[2], a[3]); w.z = cvt_pk_bf16(b[0], b[1]); w.w = cvt_pk_bf16(b[2], b[3]);
                    *(u32x4*)(ZB + r * ZBW + pn * BM + 64 * wc + 32 * bj + 8 * fq) = w; } }
    }
};
struct EpiG2 {
    const float* xin32; bf16_t* XAB; const float* g1;
    __device__ __forceinline__ void operator()(const f32x4 (&acc)[2][2][4][2], const Unit& u, int wr, int wc, int fr, int fq) const {
#pragma unroll
        for (int ai = 0; ai < 2; ++ai)
#pragma unroll
            for (int m = 0; m < 4; ++m) { const size_t r = (size_t)u.pm * BM + ai * HALF + wr * 64 + m * 16 + fr; const int b = (int)(r / S);
#pragma unroll
                for (int bj = 0; bj < 2; ++bj) { const int c = u.pn * BM + 128 * bj + 32 * wc + 8 * fq;
                    f32x4 x0, x1;
                    if (xin32) { x0 = *(const f32x4*)(xin32 + r * D + c); x1 = *(const f32x4*)(xin32 + r * D + c + 4); }
                    else { const u32x4 q = *(const u32x4*)(XAB + r * D + c);
                        x0 = (f32x4){__builtin_bit_cast(float, q.x << 16), __builtin_bit_cast(float, q.x & 0xffff0000u), __builtin_bit_cast(float, q.y << 16), __builtin_bit_cast(float, q.y & 0xffff0000u)};
                        x1 = (f32x4){__builtin_bit_cast(float, q.z << 16), __builtin_bit_cast(float, q.z & 0xffff0000u), __builtin_bit_cast(float, q.w << 16), __builtin_bit_cast(float, q.w & 0xffff0000u)}; }
                    const f32x4 g0 = *(const f32x4*)(g1 + (size_t)b * 6144 + c), g1v = *(const f32x4*)(g1 + (size_t)b * 6144 + c + 4);
                    const f32x4 y0 = x0 + g0 * acc[ai][bj][m][0], y1 = x1 + g1v * acc[ai][bj][m][1];
                    u32x4 o; o.x = cvt_pk_bf16(y0[0], y0[1]); o.y = cvt_pk_bf16(y0[2], y0[3]); o.z = cvt_pk_bf16(y1[0], y1[1]); o.w = cvt_pk_bf16(y1[2], y1[3]);
                    *(u32x4*)(XAB + r * D + c) = o; } }
    }
};
struct EpiM1 {
    bf16_t* ACT; const float* b1l;
    __device__ __forceinline__ void operator()(const f32x4 (&acc)[2][2][4][2], const Unit& u, int wr, int wc, int fr, int fq) const {
        const float* b1 = b1l + (size_t)u.e * 2048;
        const int c0 = u.pn * 128 + 32 * wc + 8 * fq;
        f32x4 bg[2], bl[2];
#pragma unroll
        for (int n = 0; n < 2; ++n) { bg[n] = *(const f32x4*)(b1 + c0 + 4 * n); bl[n] = *(const f32x4*)(b1 + 1024 + c0 + 4 * n); }
#pragma unroll
        for (int ai = 0; ai < 2; ++ai)
#pragma unroll
            for (int m = 0; m < 4; ++m) { const size_t r = (size_t)u.pm * BM + ai * HALF + wr * 64 + m * 16 + fr;
                float o[8];
#pragma unroll
                for (int n = 0; n < 2; ++n) { const f32x4 g = acc[ai][0][m][n] + bg[n], li = acc[ai][1][m][n] + bl[n];
#pragma unroll
                    for (int i = 0; i < 4; ++i) { const float gc = fminf(g[i], 7.f), lc = fminf(fmaxf(li[i], -7.f), 7.f); o[4 * n + i] = (lc + 1.f) * gc * (1.f / (1.f + __expf(-1.702f * gc))); } }
                u32x4 w; w.x = cvt_pk_bf16(o[0], o[1]); w.y = cvt_pk_bf16(o[2], o[3]); w.z = cvt_pk_bf16(o[4], o[5]); w.w = cvt_pk_bf16(o[6], o[7]);
                *(u32x4*)(ACT + r * DFF + c0) = w; }
    }
};
struct EpiM2 {
    bf16_t* Y; const float* b2l; const float* roww;
    __device__ __forceinline__ void operator()(const f32x4 (&acc)[2][2][4][2], const Unit& u, int wr, int wc, int fr, int fq) const {
        const float* b2 = b2l + (size_t)u.e * D;
#pragma unroll
        for (int ai = 0; ai < 2; ++ai)
#pragma unroll
            for (int m = 0; m < 4; ++m) { const size_t r = (size_t)u.pm * BM + ai * HALF + wr * 64 + m * 16 + fr; const float w = roww[r];
#pragma unroll
                for (int bj = 0; bj < 2; ++bj) { const int c = u.pn * BM + 128 * bj + 32 * wc + 8 * fq;
                    const f32x4 v0 = (acc[ai][bj][m][0] + *(const f32x4*)(b2 + c)) * w, v1 = (acc[ai][bj][m][1] + *(const f32x4*)(b2 + c + 4)) * w;
                    u32x4 o; o.x = cvt_pk_bf16(v0[0], v0[1]); o.y = cvt_pk_bf16(v0[2], v0[3]); o.z = cvt_pk_bf16(v1[0], v1[1]); o.w = cvt_pk_bf16(v1[2], v1[3]);
                    *(u32x4*)(Y + r * D + c) = o; } }
    }
};
}

__device__ __forceinline__ void phase_g1_fast(const Params& p, int l, unsigned char* lds_raw) {
    pg8::ProbDense P{(const bf16_t*)(p.ws + WS_XN), (const bf16_t*)(p.ws + WS_WINT) + (size_t)l * ZBW * D, D, T / 256, ZBW / 256, (int)gridDim.x, (int)blockIdx.x, true};
    pg8::EpiG1F E{(bf16_t*)(p.ws + WS_ZB), (float*)(p.ws + WS_GATE), p.in[7] + l * 64, p.in[8] + l * 64, p.in[12] + l * 64, p.in[13] + l * 64};
    pg8::gemm_phase<pg8::ProbDense, pg8::EpiG1F, true, true>((PG8_LAS unsigned char*)lds_raw, P, E);
}
__device__ __forceinline__ void phase_g2_fast(const Params& p, int l, unsigned char* lds_raw) {
    pg8::ProbDense P{(const bf16_t*)(p.ws + WS_ATTB), (const bf16_t*)(p.ws + WS_WOT) + (size_t)l * D * D, D, T / 256, D / 256, (int)gridDim.x, (int)blockIdx.x, false};
    pg8::EpiG2 E{l == 0 ? p.in[0] : (const float*)nullptr, (bf16_t*)(p.ws + WS_XAB), (const float*)(p.ws + WS_MOD) + (size_t)l * Bn * 6144 + 2 * D};
    pg8::gemm_phase<pg8::ProbDense, pg8::EpiG2, true, true>((PG8_LAS unsigned char*)lds_raw, P, E);
}
constexpr int LDS_PS_OFF = 131072;
__device__ __forceinline__ void phase_ck_fast(const Params& p, int l, unsigned char* lds_raw) {
    pg8::ProbCmp P{(const bf16_t*)(p.ws + WS_ZB), (const bf16_t*)(p.ws + WS_WCT) + (size_t)l * 2 * 128 * 2048, 2048, (int)gridDim.x, (int)blockIdx.x};
    pg8::EpiCmp E{(float*)(p.ws + WS_HIDP)};
    pg8::gemm_phase<pg8::ProbCmp, pg8::EpiCmp, true, true>((PG8_LAS unsigned char*)lds_raw, P, E);
    { const int tid = otid(), lane = tid & 63, wave = tid >> 6, r8 = lane >> 3, c8 = lane & 7;
      const bf16_t* Z = (const bf16_t*)(p.ws + WS_ZB); bf16_t* KMB = (bf16_t*)(p.ws + WS_KMB);
      float* part = (float*)(lds_raw + 131072 + 512);
      for (int it0 = blockIdx.x * 2; it0 < Bn * 8 * 32; it0 += gridDim.x * 2) {
          const int it = it0 + (wave >> 2), q = wave & 3;
          const int b = it / 256, h = (it / 32) & 7, blk = it & 31;
          const bf16_t* base = Z + (size_t)(b * S + blk * 256 + q * 64 + r8) * ZBW + ZB_MK + h * 64 + c8 * 8;
          float s[8] = {0.f, 0.f, 0.f, 0.f, 0.f, 0.f, 0.f, 0.f};
          uint4 v[8];
#pragma unroll
          for (int i = 0; i < 8; ++i) v[i] = *(const uint4*)(base + (size_t)(8 * i) * ZBW);
#pragma unroll
          for (int i = 0; i < 8; ++i) { const unsigned w[4] = {v[i].x, v[i].y, v[i].z, v[i].w};
#pragma unroll
              for (int e = 0; e < 4; ++e) { s[2 * e] += __builtin_bit_cast(float, w[e] << 16); s[2 * e + 1] += __builtin_bit_cast(float, w[e] & 0xffff0000u); } }
#pragma unroll
          for (int e = 0; e < 8; ++e) { s[e] += __shfl_xor(s[e], 8); s[e] += __shfl_xor(s[e], 16); s[e] += __shfl_xor(s[e], 32); }
          if (r8 == 0) {
#pragma unroll
              for (int e = 0; e < 8; ++e) part[wave * 64 + c8 * 8 + e] = s[e]; }
          __syncthreads();
          if (tid < 128) { const int item = tid >> 6, d = tid & 63; const float* pp = part + item * 256 + d;
              KMB[(size_t)(it0 + item) * 64 + d] = (bf16_t)f2bf((((pp[0] + pp[64]) + pp[128]) + pp[192]) * (1.f / 256.f)); }
          __syncthreads();
      } }
}
__device__ __forceinline__ void phase_m1_fast(const Params& p, int l, unsigned char* lds_raw) {
    int* ps = (int*)(lds_raw + LDS_PS_OFF);
    load_pstart(p, l, ps);
    pg8::ProbMoe1 P{(const bf16_t*)(p.ws + WS_XN), (const bf16_t*)(p.ws + WS_W1T) + (size_t)l * NE * 2048 * D, (const int*)(p.ws + WS_ROWTOK) + (size_t)l * RMAX, (pg8::lds_ints)ps, D, ps[32] / 256, (int)gridDim.x, (int)blockIdx.x};
    pg8::EpiM1 E{(bf16_t*)(p.ws + WS_ACT), p.in[18] + (size_t)l * NE * 2048};
    pg8::gemm_phase<pg8::ProbMoe1, pg8::EpiM1, true, true>((PG8_LAS unsigned char*)lds_raw, P, E);
    __syncthreads();
}
__device__ __forceinline__ void phase_m2_fast(const Params& p, int l, unsigned char* lds_raw) {
    int* ps = (int*)(lds_raw + LDS_PS_OFF);
    load_pstart(p, l, ps);
    pg8::ProbMoe2 P{(const bf16_t*)(p.ws + WS_ACT), (const bf16_t*)(p.ws + WS_W2T) + (size_t)l * NE * D * DFF, (pg8::lds_ints)ps, DFF, ps[32] / 256, (int)gridDim.x, (int)blockIdx.x};
    pg8::EpiM2 E{(bf16_t*)(p.ws + WS_Y), p.in[20] + (size_t)l * NE * D, (const float*)(p.ws + WS_ROWW) + (size_t)l * RMAX};
    pg8::gemm_phase<pg8::ProbMoe2, pg8::EpiM2, true, true>((PG8_LAS unsigned char*)lds_raw, P, E);
    __syncthreads();
}

namespace at {
#define AT_LAS __attribute__((address_space(3)))
typedef short bf16x8 __attribute__((ext_vector_type(8)));
typedef short s16x4 __attribute__((ext_vector_type(4)));
typedef short v4i16_t __attribute__((ext_vector_type(4)));
typedef float f32x16 __attribute__((ext_vector_type(16)));
typedef unsigned u32x4 __attribute__((ext_vector_type(4)));
typedef float f32x2_t __attribute__((ext_vector_type(2))); typedef __bf16 bf16x2_t __attribute__((ext_vector_type(2)));
typedef AT_LAS unsigned char* lp;
constexpr int L_K = 0  , L_V = 32768  , L_WSF = 65536, L_OST = 67584  , L_SELM = 133120, L_UNI = 134144, L_KMT = 134400, L_END = 142592;
constexpr float NEGS = -1e30f;
__device__ __forceinline__ int crow(int r, int hi) { return (r & 3) + 8 * (r >> 2) + 4 * hi; }
__device__ __forceinline__ unsigned cvtpk(float lo, float hi) { f32x2_t v = {lo, hi}; bf16x2_t b = __builtin_convertvector(v, bf16x2_t); return __builtin_bit_cast(unsigned, b); }
__device__ __forceinline__ float mx3(float a, float b, float c) { return __builtin_fmaxf(__builtin_fmaxf(a, b), c); }
__device__ __forceinline__ void wsync() { asm volatile("s_waitcnt lgkmcnt(0)" ::: "memory"); __builtin_amdgcn_wave_barrier(); }
__device__ __forceinline__ void bar() { __builtin_amdgcn_s_barrier(); }
#define AT_WAITV(n) asm volatile("s_waitcnt vmcnt(" #n ")" ::: "memory")
#define AT_WAITL() asm volatile("s_waitcnt lgkmcnt(0)" ::: "memory")
__device__ __forceinline__ void glds(const void* g, lp dst) { __builtin_amdgcn_global_load_lds((const unsigned*)g, (AT_LAS unsigned*)dst, 16, 0, 0); }
__device__ __forceinline__ s16x4 vtr(const AT_LAS unsigned char* p) { return __builtin_bit_cast(s16x4, __builtin_amdgcn_ds_read_tr16_b64_v4i16((AT_LAS v4i16_t*)p)); }

__device__ __forceinline__ void dma_k(lp slot, const bf16_t* kbase, int pitch, int key0, int wid, int lane) { glds(kbase + (size_t)(key0 + lane) * pitch + wid * 8, slot + wid * 1024); }
__device__ __forceinline__ void dma_v(lp slot, const bf16_t* vbase, int pitch, int key0, int wid, int lane) {
    glds(vbase + (size_t)(key0 + 16 * (wid & 3) + (lane >> 2)) * pitch + (wid >> 2) * 32 + (lane & 3) * 8, slot + wid * 1024); }

__device__ __forceinline__ void qk_tile(f32x16& p0, f32x16& p1, lp kslot, const bf16x8 (&qr)[4], int r32, int hi) {
    const AT_LAS unsigned char* kb = kslot + hi * 1024 + r32 * 16;
#pragma unroll
    for (int d0 = 0; d0 < 4; ++d0) {
        const bf16x8 b0 = *(const AT_LAS bf16x8*)(kb + d0 * 2048), b1 = *(const AT_LAS bf16x8*)(kb + d0 * 2048 + 512);
        p0 = __builtin_amdgcn_mfma_f32_32x32x16_bf16(b0, qr[d0], p0, 0, 0, 0);
        p1 = __builtin_amdgcn_mfma_f32_32x32x16_bf16(b1, qr[d0], p1, 0, 0, 0);
    }
}
__device__ __forceinline__ void pv_tile(f32x16 (&o)[2], lp vslot, int lane, int hi, u32x4 pw0, u32x4 pw1, u32x4 pw2, u32x4 pw3) {
    const AT_LAS unsigned char* vp = vslot + ((lane >> 4) & 1) * 32 + (lane & 3) * 8 + (4 * hi + ((lane & 15) >> 2)) * 64;
    const bf16x8 pa[4] = {__builtin_bit_cast(bf16x8, pw0), __builtin_bit_cast(bf16x8, pw1), __builtin_bit_cast(bf16x8, pw2), __builtin_bit_cast(bf16x8, pw3)};
#pragma unroll
    for (int d0 = 0; d0 < 2; ++d0)
#pragma unroll
        for (int ks = 0; ks < 4; ++ks) {
            const s16x4 lo = vtr(vp + d0 * 4096 + ks * 1024), hh = vtr(vp + d0 * 4096 + ks * 1024 + 512);
            const bf16x8 vf = (bf16x8){lo[0], lo[1], lo[2], lo[3], hh[0], hh[1], hh[2], hh[3]};
            o[d0] = __builtin_amdgcn_mfma_f32_32x32x16_bf16(pa[ks], vf, o[d0], 0, 0, 0);
        }
}
__device__ __forceinline__ float rowmax(const f32x16& p0, const f32x16& p1) {
    float a = mx3(p0[0], p0[1], p1[0]), b = mx3(p0[2], p0[3], p1[1]); a = mx3(a, p1[2], p1[3]);
#pragma unroll
    for (int r = 4; r < 16; r += 4) { a = mx3(a, p0[r], p0[r + 1]); b = mx3(b, p0[r + 2], p0[r + 3]); a = mx3(a, p1[r], p1[r + 1]); b = mx3(b, p1[r + 2], p1[r + 3]); }
    const float m = __builtin_fmaxf(a, b);
    auto rr = __builtin_amdgcn_permlane32_swap(__float_as_uint(m), __float_as_uint(m), false, false);
    return __builtin_fmaxf(__uint_as_float(rr[0]), __uint_as_float(rr[1]));
}
__device__ __forceinline__ float halfsum(float v) {
    auto rr = __builtin_amdgcn_permlane32_swap(__float_as_uint(v), __float_as_uint(v), false, false);
    return __uint_as_float(rr[0]) + __uint_as_float(rr[1]);
}
__device__ __forceinline__ void mask_tile(f32x16& p0, f32x16& p1, int lo, int hi_, int hi) {
    const int kb = 4 * hi;
#pragma unroll
    for (int r = 0; r < 16; ++r) { const int kv = kb + (r & 3) + 8 * (r >> 2); if (kv > hi_ || kv < lo) p0[r] = NEGS; if (kv + 32 > hi_ || kv + 32 < lo) p1[r] = NEGS; }
}

__device__ __forceinline__ int next_bit128(unsigned u0, unsigned u1, unsigned u2, unsigned u3, int below) {
    if (below > 96) { unsigned x = u3; if (below < 128) x &= (1u << (below - 96)) - 1u; if (x) return 96 + 31 - __builtin_clz(x); }
    if (below > 64) { unsigned x = u2; if (below < 96) x &= (1u << (below - 64)) - 1u; if (x) return 64 + 31 - __builtin_clz(x); }
    if (below > 32) { unsigned x = u1; if (below < 64) x &= (1u << (below - 32)) - 1u; if (x) return 32 + 31 - __builtin_clz(x); }
    if (below > 0) { unsigned x = u0; if (below < 32) x &= (1u << below) - 1u; if (x) return 31 - __builtin_clz(x); }
    return -1;
}
struct Soft { float m, l; };

template <bool HAS_O>
__device__ __forceinline__ void softmax_step(f32x16& p0, f32x16& p1, Soft& st, f32x16 (&o)[2], float* wsf, int r32, int hi) {
    const float rm = rowmax(p0, p1);
    if (__any(rm > 0.f)) {
        const float dl = __builtin_fmaxf(rm, 0.f); st.m += dl;
#pragma unroll
        for (int r = 0; r < 16; ++r) { p0[r] -= dl; p1[r] -= dl; }
        const float al = __builtin_amdgcn_exp2f(-dl); st.l *= al;
        if (HAS_O) {
            if (hi == 0) wsf[r32] = al;
            wsync();
#pragma unroll
            for (int r = 0; r < 16; ++r) { const float f = wsf[crow(r, hi)]; o[0][r] *= f; o[1][r] *= f; }
            wsync();
        }
    }
    float s = 0.f;
#pragma unroll
    for (int r = 0; r < 16; ++r) { p0[r] = __builtin_amdgcn_exp2f(p0[r]); p1[r] = __builtin_amdgcn_exp2f(p1[r]); s += p0[r] + p1[r]; }
    st.l += s;
}
#define AT_PACK(P0, P1) \
    const u32x4 pw0 = {cvtpk(P0[0], P0[1]), cvtpk(P0[2], P0[3]), cvtpk(P0[4], P0[5]), cvtpk(P0[6], P0[7])}, pw1 = {cvtpk(P0[8], P0[9]), cvtpk(P0[10], P0[11]), cvtpk(P0[12], P0[13]), cvtpk(P0[14], P0[15])}, \
                pw2 = {cvtpk(P1[0], P1[1]), cvtpk(P1[2], P1[3]), cvtpk(P1[4], P1[5]), cvtpk(P1[6], P1[7])}, pw3 = {cvtpk(P1[8], P1[9]), cvtpk(P1[10], P1[11]), cvtpk(P1[12], P1[13]), cvtpk(P1[14], P1[15])}
__device__ __forceinline__ f32x16 cinit(float c2k, int hi, float x) { f32x16 c; const float xb = __builtin_fmaf(c2k, (float)(4 * hi), x);
#pragma unroll
    for (int r = 0; r < 16; ++r) c[r] = __builtin_fmaf(c2k, (float)((r & 3) + 8 * (r >> 2)), xb);
    return c; }
template <bool FIRST>
__device__ __forceinline__ void acc_scaled(float* stage, const f32x16 (&o)[2], float f, float* wsf, int r32, int hi) {
    if (hi == 0) wsf[r32] = f;
    wsync();
#pragma unroll
    for (int r = 0; r < 16; ++r) { const int orow = crow(r, hi); const float g = wsf[orow]; float* s0 = stage + orow * 64 + r32;
        if (FIRST) { s0[0] = o[0][r] * g; s0[32] = o[1][r] * g; } else { s0[0] += o[0][r] * g; s0[32] += o[1][r] * g; } }
    wsync();
}

#define AT_WAIT_NEWER(newer, per) do { if ((newer) >= 2) { if ((per) == 2) AT_WAITV(4); else AT_WAITV(2); } else if ((newer) == 1) { if ((per) == 2) AT_WAITV(2); else AT_WAITV(1); } else AT_WAITV(0); } while (0)

__device__ __forceinline__ void nsa_unit(const Params& p, int b, int g, int c, unsigned char* lds_raw) {
    const int tid = otid(), lane = tid & 63, r32 = lane & 31, hi = lane >> 5, wid = __builtin_amdgcn_readfirstlane(tid >> 6);
    lp lds = (lp)lds_raw;
    const bf16_t* ZB = (const bf16_t*)(p.ws + WS_ZB); const float* GT = (const float*)(p.ws + WS_GATE);
    const bf16_t* KCB = (const bf16_t*)(p.ws + WS_KCB) + (size_t)(b * 2 + g) * 512 * 64; const bf16_t* VCB = (const bf16_t*)(p.ws + WS_VCB) + (size_t)(b * 2 + g) * 512 * 64;
    const int t0 = c * 64, hg = r32 >> 3, qq = r32 & 7, qi = 8 * wid + qq, t = t0 + qi, h = 4 * g + hg; const size_t tt = (size_t)b * S + t;
    float* wsf = (float*)(lds_raw + L_WSF) + wid * 64;
    float* ostage = (float*)(lds_raw + L_OST) + wid * 2048;
    float* imp = ostage;
    unsigned* selm = (unsigned*)(lds_raw + L_SELM);
    unsigned* uni = (unsigned*)(lds_raw + L_UNI);
    const float c2 = exp2f(-(float)(h + 1)) * LOG2E;
    bf16x8 qr[4];
#pragma unroll
    for (int d0 = 0; d0 < 4; ++d0) qr[d0] = *(const bf16x8*)(ZB + tt * ZBW + ZB_Q + h * 64 + d0 * 16 + hi * 8);
    const float gt0 = GT[tt * 32 + h * 3 + 0], gt1 = GT[tt * 32 + h * 3 + 1], gt2 = GT[tt * 32 + h * 3 + 2];
    f32x16 o[2];
    const lp sK0 = lds + L_K, sV0 = lds + L_V;
    const int nmax = t >= 31 ? (t - 31) >> 4 : -1;
    const int ntc = ((4 * c + 2) >> 6) + 1;
    for (int i = lane; i < 8 * 129; i += 64) imp[i] = 0.f;
    Soft sc; sc.m = 0.f; sc.l = 0.f;
#pragma unroll
    for (int k = 0; k < 3; ++k) if (k < ntc) dma_k(sK0 + k * 8192, KCB, 64, 64 * k, wid, lane);
    for (int k = 0; k < ntc; ++k) {
        const int newer = ntc - 1 - k; AT_WAIT_NEWER(newer, 1);
        AT_WAITL(); bar();
        if (k + 3 < ntc) dma_k(sK0 + ((k + 3) & 3) * 8192, KCB, 64, 64 * (k + 3), wid, lane);
        const lp sK = sK0 + (k & 3) * 8192;
        const float x0 = c2 * (16.f * (64 * k) + 15.5f - (float)t0) - sc.m;
        f32x16 p0 = cinit(16.f * c2, hi, x0), p1 = cinit(16.f * c2, hi, x0 + c2 * 512.f);
        qk_tile(p0, p1, sK, qr, r32, hi);
        if (__any(nmax - 64 * k < 63)) mask_tile(p0, p1, 0, nmax - 64 * k, hi);
        softmax_step<false>(p0, p1, sc, o, wsf, r32, hi);
    }
    const float lc = halfsum(sc.l), linv = lc > 0.f ? 1.f / lc : 0.f;
    o[0] = f32x16{}; o[1] = f32x16{};
    AT_WAITL(); bar();
#pragma unroll
    for (int k = 0; k < 3; ++k) if (k < ntc) { dma_k(sK0 + k * 8192, KCB, 64, 64 * k, wid, lane); dma_v(sV0 + k * 8192, VCB, 64, 64 * k, wid, lane); }
    for (int k = 0; k < ntc; ++k) {
        const int newer = ntc - 1 - k; AT_WAIT_NEWER(newer, 2);
        AT_WAITL(); bar();
        if (k + 3 < ntc) { dma_k(sK0 + ((k + 3) & 3) * 8192, KCB, 64, 64 * (k + 3), wid, lane); dma_v(sV0 + ((k + 3) & 3) * 8192, VCB, 64, 64 * (k + 3), wid, lane); }
        const lp sK = sK0 + (k & 3) * 8192, sV = sV0 + (k & 3) * 8192;
        const float x0 = c2 * (16.f * (64 * k) + 15.5f - (float)t0) - sc.m;
        f32x16 p0 = cinit(16.f * c2, hi, x0), p1 = cinit(16.f * c2, hi, x0 + c2 * 512.f);
        qk_tile(p0, p1, sK, qr, r32, hi);
        if (__any(nmax - 64 * k < 63)) mask_tile(p0, p1, 0, nmax - 64 * k, hi);
#pragma unroll
        for (int r = 0; r < 16; ++r) { p0[r] = __builtin_amdgcn_exp2f(p0[r]); p1[r] = __builtin_amdgcn_exp2f(p1[r]); }
        { AT_PACK(p0, p1); pv_tile(o, sV, lane, hi, pw0, pw1, pw2, pw3); }
        float gs[8], ls[8];
#pragma unroll
        for (int q4 = 0; q4 < 4; ++q4) { gs[q4] = ((p0[4 * q4] + p0[4 * q4 + 1]) + (p0[4 * q4 + 2] + p0[4 * q4 + 3])) * linv; ls[q4] = p0[4 * q4 + 3] * linv;
                                         gs[4 + q4] = ((p1[4 * q4] + p1[4 * q4 + 1]) + (p1[4 * q4 + 2] + p1[4 * q4 + 3])) * linv; ls[4 + q4] = p1[4 * q4 + 3] * linv; }
#pragma unroll
        for (int q4 = 0; q4 < 8; ++q4) { gs[q4] += __shfl_xor(gs[q4], 8); gs[q4] += __shfl_xor(gs[q4], 16); ls[q4] += __shfl_xor(ls[q4], 8); ls[q4] += __shfl_xor(ls[q4], 16); }
        if (r32 < 8) {
            float* row = imp + qq * 129 + 16 * k + hi;
#pragma unroll
            for (int q4 = 0; q4 < 8; ++q4) row[2 * q4] += gs[q4];
        }
        wsync();
        if (r32 < 8) {
            float* row = imp + qq * 129 + 16 * k + hi + 1;
#pragma unroll
            for (int q4 = 0; q4 < 8; ++q4) row[2 * q4] += ls[q4];
        }
        wsync();
    }
    unsigned mk0 = 0u, mk1 = 0u, mk2 = 0u, mk3 = 0u;
    {
        const int qs = lane >> 3, part = lane & 7;
        float v[16];
#pragma unroll
        for (int i = 0; i < 16; ++i) { const int j = part * 16 + i; float x = imp[qs * 129 + j]; if (j == 0 || j == c || j == c - 1) x = 1e4f; if (j > c) x = NEGS; v[i] = x; }
#pragma unroll 1
        for (int it = 0; it < 16; ++it) {
            float bv = -3e38f; int bi = 0;
#pragma unroll
            for (int i = 0; i < 16; ++i) if (v[i] > bv) { bv = v[i]; bi = part * 16 + i; }
#pragma unroll
            for (int sft = 1; sft < 8; sft <<= 1) { const float ov = __shfl_xor(bv, sft); const int oi = __shfl_xor(bi, sft); if (ov > bv || (ov == bv && oi < bi)) { bv = ov; bi = oi; } }
            if (bv > NEGS) { const unsigned bit = 1u << (bi & 31); const int wq = bi >> 5; if (wq == 0) mk0 |= bit; else if (wq == 1) mk1 |= bit; else if (wq == 2) mk2 |= bit; else mk3 |= bit; }
#pragma unroll
            for (int i = 0; i < 16; ++i) if (part * 16 + i == bi) v[i] = -3.4e38f;
        }
        if (part == 0) { unsigned* sm = selm + (8 * wid + qs) * 4; sm[0] = mk0; sm[1] = mk1; sm[2] = mk2; sm[3] = mk3; }
        unsigned u0 = mk0, u1 = mk1, u2 = mk2, u3 = mk3;
#pragma unroll
        for (int sft = 8; sft < 64; sft <<= 1) { u0 |= __shfl_xor(u0, sft); u1 |= __shfl_xor(u1, sft); u2 |= __shfl_xor(u2, sft); u3 |= __shfl_xor(u3, sft); }
        if (lane == 0) { uni[wid * 4 + 0] = u0; uni[wid * 4 + 1] = u1; uni[wid * 4 + 2] = u2; uni[wid * 4 + 3] = u3; }
    }
    wsync();
    acc_scaled<true>(ostage, o, gt0 * linv, wsf, r32, hi);
    AT_WAITL(); bar();
    unsigned un0 = 0u, un1 = 0u, un2 = 0u, un3 = 0u;
#pragma unroll
    for (int w = 0; w < 8; ++w) { un0 |= uni[w * 4 + 0]; un1 |= uni[w * 4 + 1]; un2 |= uni[w * 4 + 2]; un3 |= uni[w * 4 + 3]; }
    un0 = __builtin_amdgcn_readfirstlane(un0); un1 = __builtin_amdgcn_readfirstlane(un1); un2 = __builtin_amdgcn_readfirstlane(un2); un3 = __builtin_amdgcn_readfirstlane(un3);
    const unsigned my0 = selm[(8 * wid + qq) * 4 + 0], my1 = selm[(8 * wid + qq) * 4 + 1], my2 = selm[(8 * wid + qq) * 4 + 2], my3 = selm[(8 * wid + qq) * 4 + 3];
    {
        const bf16_t* KS = ZB + (size_t)b * S * ZBW + ZB_KS + g * 64; const bf16_t* VS = ZB + (size_t)b * S * ZBW + ZB_VS + g * 64;
        Soft ss; ss.m = 0.f; ss.l = 0.f; o[0] = f32x16{}; o[1] = f32x16{};
        const int nsel = __builtin_popcount(un0) + __builtin_popcount(un1) + __builtin_popcount(un2) + __builtin_popcount(un3);
        int ji = 128;
#pragma unroll
        for (int k = 0; k < 3; ++k) if (k < nsel) { ji = next_bit128(un0, un1, un2, un3, ji); dma_k(sK0 + k * 8192, KS, ZBW, 64 * ji, wid, lane); dma_v(sV0 + k * 8192, VS, ZBW, 64 * ji, wid, lane); }
        int j = 128;
        for (int i = 0; i < nsel; ++i) {
            j = next_bit128(un0, un1, un2, un3, j);
            const int newer = nsel - 1 - i; AT_WAIT_NEWER(newer, 2);
            AT_WAITL(); bar();
            if (i + 3 < nsel) { ji = next_bit128(un0, un1, un2, un3, ji); dma_k(sK0 + ((i + 3) & 3) * 8192, KS, ZBW, 64 * ji, wid, lane); dma_v(sV0 + ((i + 3) & 3) * 8192, VS, ZBW, 64 * ji, wid, lane); }
            const lp sK = sK0 + (i & 3) * 8192, sV = sV0 + (i & 3) * 8192;
            const unsigned mw = (j >> 5) == 0 ? my0 : (j >> 5) == 1 ? my1 : (j >> 5) == 2 ? my2 : my3;
            const bool sel = (mw >> (j & 31)) & 1u;
            const float x0 = sel ? c2 * (float)(64 * j - t0) - ss.m : NEGS;
            f32x16 p0 = cinit(c2, hi, x0), p1 = cinit(c2, hi, sel ? x0 + c2 * 32.f : NEGS);
            qk_tile(p0, p1, sK, qr, r32, hi);
            if (j == c) mask_tile(p0, p1, 0, qi, hi);
            softmax_step<true>(p0, p1, ss, o, wsf, r32, hi);
            { AT_PACK(p0, p1); pv_tile(o, sV, lane, hi, pw0, pw1, pw2, pw3); }
        }
        const float ls_ = halfsum(ss.l);
        acc_scaled<false>(ostage, o, ls_ > 0.f ? gt1 / ls_ : 0.f, wsf, r32, hi);
    }
    {
        const bf16_t* KW = ZB + (size_t)b * S * ZBW + ZB_KW + g * 64; const bf16_t* VW = ZB + (size_t)b * S * ZBW + ZB_VW + g * 64;
        Soft sw; sw.m = 0.f; sw.l = 0.f; o[0] = f32x16{}; o[1] = f32x16{};
        const int k0 = c >= 8 ? 0 : 8 - c, nw = 9 - k0;
        AT_WAITL(); bar();
#pragma unroll
        for (int k = 0; k < 3; ++k) if (k < nw) { dma_k(sK0 + k * 8192, KW, ZBW, t0 - 512 + 64 * (k0 + k), wid, lane); dma_v(sV0 + k * 8192, VW, ZBW, t0 - 512 + 64 * (k0 + k), wid, lane); }
        for (int i = 0; i < nw; ++i) {
            const int k = k0 + i;
            const int newer = nw - 1 - i; AT_WAIT_NEWER(newer, 2);
            AT_WAITL(); bar();
            if (i + 3 < nw) { dma_k(sK0 + ((i + 3) & 3) * 8192, KW, ZBW, t0 - 512 + 64 * (k + 3), wid, lane); dma_v(sV0 + ((i + 3) & 3) * 8192, VW, ZBW, t0 - 512 + 64 * (k + 3), wid, lane); }
            const lp sK = sK0 + (i & 3) * 8192, sV = sV0 + (i & 3) * 8192;
            const float x0 = c2 * (float)(64 * k - 512) - sw.m;
            f32x16 p0 = cinit(c2, hi, x0), p1 = cinit(c2, hi, x0 + c2 * 32.f);
            qk_tile(p0, p1, sK, qr, r32, hi);
            if (k == 0) mask_tile(p0, p1, qi + 1, 63, hi);
            if (k == 8) mask_tile(p0, p1, 0, qi, hi);
            softmax_step<true>(p0, p1, sw, o, wsf, r32, hi);
            { AT_PACK(p0, p1); pv_tile(o, sV, lane, hi, pw0, pw1, pw2, pw3); }
        }
        const float lw = halfsum(sw.l);
        acc_scaled<false>(ostage, o, lw > 0.f ? gt2 / lw : 0.f, wsf, r32, hi);
    }
    {
        bf16_t* AB = (bf16_t*)(p.ws + WS_ATTB);
#pragma unroll
        for (int i = 0; i < 4; ++i) { const int row = i * 8 + (lane >> 3), ch = lane & 7; const float4 a = *(const float4*)(ostage + row * 64 + ch * 8), c4 = *(const float4*)(ostage + row * 64 + ch * 8 + 4);
            const uint4 v = make_uint4(pk2(a.x, a.y), pk2(a.z, a.w), pk2(c4.x, c4.y), pk2(c4.z, c4.w));
            *(uint4*)(AB + ((size_t)b * S + t0 + 8 * wid + (row & 7)) * D + (4 * g + (row >> 3)) * 64 + ch * 8) = v; }
        wsync();
    }
    AT_WAITL(); bar();
}

}

constexpr int MB_CAP = 25600;
namespace at {
__device__ __forceinline__ void moba_route_unit(const Params& p, int b, int h, int qb, unsigned char* lds_raw) {
    const int tid = otid(), lane = tid & 63, r32 = lane & 31, hi = lane >> 5, wid = __builtin_amdgcn_readfirstlane(tid >> 6);
    lp lds = (lp)lds_raw;
    const bf16_t* ZB = (const bf16_t*)(p.ws + WS_ZB);
    const int bh = b * 8 + h;
    const bf16_t* KMB = (const bf16_t*)(p.ws + WS_KMB) + (size_t)bh * 32 * 64;
    const int qi = 32 * wid + r32, t = qb * 256 + qi; const size_t tt = (size_t)b * S + t;
    int* hist = (int*)(lds_raw + L_UNI);
    unsigned* SEL3 = (unsigned*)(p.ws + WS_SEL3); unsigned* LRK = (unsigned*)(p.ws + WS_LRK);
    unsigned char* IL = (unsigned char*)(p.ws + WS_ILIST) + ((size_t)(bh * 32 + qb) * 32) * 256;
    int* BCm = (int*)(p.ws + WS_BCM) + (size_t)(bh * 32 + qb) * 32;
    if (tid < 32) hist[tid] = 0;
    bf16x8 qr[4];
#pragma unroll
    for (int d0 = 0; d0 < 4; ++d0) qr[d0] = *(const bf16x8*)(ZB + tt * ZBW + ZB_MQ + h * 64 + d0 * 16 + hi * 8);
    const lp sKM = lds + L_KMT;
    glds(KMB + (size_t)(lane & 31) * 64 + wid * 8, sKM + wid * 1024);
    AT_WAITV(0); AT_WAITL(); bar();
    f32x16 g0 = f32x16{}, g1 = f32x16{};
    qk_tile(g0, g1, sKM, qr, r32, hi);
    float v1 = NEGS, v2 = NEGS, v3 = NEGS; int i1 = 64, i2 = 64, i3 = 64;
#pragma unroll
    for (int r = 0; r < 16; ++r) { const int n = crow(r, hi); const float s_ = n < qb ? g0[r] : NEGS;
        if (s_ > v1) { v3 = v2; i3 = i2; v2 = v1; i2 = i1; v1 = s_; i1 = n; } else if (s_ > v2) { v3 = v2; i3 = i2; v2 = s_; i2 = n; } else if (s_ > v3) { v3 = s_; i3 = n; } }
    float ov[3]; int oi[3];
    { auto a = __builtin_amdgcn_permlane32_swap(__float_as_uint(v1), __float_as_uint(v1), false, false); ov[0] = __uint_as_float(hi ? a[0] : a[1]); }
    { auto a = __builtin_amdgcn_permlane32_swap(__float_as_uint(v2), __float_as_uint(v2), false, false); ov[1] = __uint_as_float(hi ? a[0] : a[1]); }
    { auto a = __builtin_amdgcn_permlane32_swap(__float_as_uint(v3), __float_as_uint(v3), false, false); ov[2] = __uint_as_float(hi ? a[0] : a[1]); }
    { auto a = __builtin_amdgcn_permlane32_swap((unsigned)i1, (unsigned)i1, false, false); oi[0] = (int)(hi ? a[0] : a[1]); }
    { auto a = __builtin_amdgcn_permlane32_swap((unsigned)i2, (unsigned)i2, false, false); oi[1] = (int)(hi ? a[0] : a[1]); }
    { auto a = __builtin_amdgcn_permlane32_swap((unsigned)i3, (unsigned)i3, false, false); oi[2] = (int)(hi ? a[0] : a[1]); }
#pragma unroll
    for (int k = 0; k < 3; ++k) { const float s_ = ov[k]; const int n = oi[k];
        if (s_ > v1 || (s_ == v1 && n < i1)) { v3 = v2; i3 = i2; v2 = v1; i2 = i1; v1 = s_; i1 = n; }
        else if (s_ > v2 || (s_ == v2 && n < i2)) { v3 = v2; i3 = i2; v2 = s_; i2 = n; }
        else if (s_ > v3 || (s_ == v3 && n < i3)) { v3 = s_; i3 = n; } }
    if (hi == 0) {
        const int j1 = v1 > NEGS ? i1 : 255, j2 = v2 > NEGS ? i2 : 255, j3 = v3 > NEGS ? i3 : 255;
        int l1 = 0, l2 = 0, l3 = 0;
        if (j1 < 32) { l1 = atomicAdd(&hist[j1], 1); IL[j1 * 256 + l1] = (unsigned char)qi; }
        if (j2 < 32) { l2 = atomicAdd(&hist[j2], 1); IL[j2 * 256 + l2] = (unsigned char)qi; }
        if (j3 < 32) { l3 = atomicAdd(&hist[j3], 1); IL[j3 * 256 + l3] = (unsigned char)qi; }
        SEL3[tt * 8 + h] = (unsigned)j1 | ((unsigned)j2 << 8) | ((unsigned)j3 << 16);
        LRK[tt * 8 + h] = (unsigned)l1 | ((unsigned)l2 << 8) | ((unsigned)l3 << 16);
    }
    AT_WAITL(); bar();
    if (tid < 32) BCm[tid] = hist[tid];
    AT_WAITL(); bar();
}
__device__ __forceinline__ void moba_tables(const int* BCmbh, int lane, int& tot, int& seg) {
    int s = 0;
    if (lane < 32) { for (int q = 0; q < 32; ++q) s += BCmbh[q * 32 + lane]; }
    tot = s;
    int pad = (s + 31) & ~31, inc = pad;
#pragma unroll
    for (int sft = 1; sft < 32; sft <<= 1) { const int o_ = __shfl_up(inc, sft); if ((lane & 31) >= sft) inc += o_; }
    seg = inc - pad;
}
__device__ __forceinline__ void moba_gather_unit(const Params& p, int bh, int j, int ch, int segj, bool reload, unsigned char* lds_raw) {
    const int tid = otid(), lane = tid & 63, r32 = lane & 31, hi = lane >> 5, wid = __builtin_amdgcn_readfirstlane(tid >> 6);
    lp lds = (lp)lds_raw;
    const int b = bh >> 3, h = bh & 7;
    const bf16_t* ZB = (const bf16_t*)(p.ws + WS_ZB);
    const int* BCmbh = (const int*)(p.ws + WS_BCM) + (size_t)bh * 32 * 32;
    float* wsf = (float*)(lds_raw + L_WSF) + wid * 64;
    const lp sK0 = lds + L_K, sV0 = lds + L_V;
    const bf16_t* KM_ = ZB + (size_t)b * S * ZBW + ZB_MK + h * 64; const bf16_t* VM_ = ZB + (size_t)b * S * ZBW + ZB_MV + h * 64;
    if (reload) {
#pragma unroll
        for (int k = 0; k < 4; ++k) { dma_k(sK0 + k * 8192, KM_, ZBW, j * 256 + 64 * k, wid, lane); dma_v(sV0 + k * 8192, VM_, ZBW, j * 256 + 64 * k, wid, lane); }
    }
    const int gr = 256 * ch + 32 * wid + r32;
    const int cq = lane < 32 ? BCmbh[lane * 32 + j] : 0;
    int run = 0, qbs = j + 1, lr = 0;
#pragma unroll 4
    for (int q = 0; q < 32; ++q) { const int c_ = __builtin_amdgcn_readlane(cq, q); if (gr >= run && gr < run + c_) { qbs = q; lr = gr - run; } run += c_; }
    const int totj = run;
    const bool valid = gr < totj;
    const unsigned char* IL = (const unsigned char*)(p.ws + WS_ILIST);
    const int qidx = valid ? (int)IL[((size_t)(bh * 32 + qbs) * 32 + j) * 256 + lr] : 0;
    const int t = valid ? qbs * 256 + qidx : (j + 1) * 256; const size_t tt = (size_t)b * S + t;
    const float c2 = exp2f(-(float)(h + 1)) * LOG2E;
    bf16x8 qr[4];
#pragma unroll
    for (int d0 = 0; d0 < 4; ++d0) qr[d0] = *(const bf16x8*)(ZB + tt * ZBW + ZB_MQ + h * 64 + d0 * 16 + hi * 8);
    Soft sm; sm.m = 0.f; sm.l = 0.f; f32x16 o[2]; o[0] = f32x16{}; o[1] = f32x16{};
#pragma unroll 1
    for (int i = 0; i < 4; ++i) {
        if (reload) { const int newer = 3 - i; if (newer >= 3) AT_WAITV(6); else AT_WAIT_NEWER(newer, 2); AT_WAITL(); bar(); }
        const lp sK = sK0 + i * 8192, sV = sV0 + i * 8192;
        const float x0 = c2 * (float)(64 * i) - sm.m;
        f32x16 p0 = cinit(c2, hi, x0), p1 = cinit(c2, hi, x0 + c2 * 32.f);
        qk_tile(p0, p1, sK, qr, r32, hi);
        softmax_step<true>(p0, p1, sm, o, wsf, r32, hi);
        { AT_PACK(p0, p1); pv_tile(o, sV, lane, hi, pw0, pw1, pw2, pw3); }
    }
    {
        const float lt = halfsum(sm.l);
        float* PM = (float*)(p.ws + WS_PM) + (size_t)bh * MB_CAP; float* PL = (float*)(p.ws + WS_PL) + (size_t)bh * MB_CAP;
        if (hi == 0 && valid) { PM[segj + gr] = sm.m; PL[segj + gr] = lt; }
        bf16_t* stg = (bf16_t*)(lds_raw + L_OST) + wid * 4096;
#pragma unroll
        for (int r = 0; r < 16; ++r) { const int orow = crow(r, hi); stg[orow * 64 + r32] = (bf16_t)f2bf(o[0][r]); stg[orow * 64 + 32 + r32] = (bf16_t)f2bf(o[1][r]); }
        wsync();
        bf16_t* PO = (bf16_t*)(p.ws + WS_PO) + ((size_t)bh * MB_CAP + segj + 256 * ch + 32 * wid) * 64;
        const int nrow = totj - (256 * ch + 32 * wid);
#pragma unroll
        for (int i = 0; i < 4; ++i) { const int row = i * 8 + (lane >> 3), c8 = lane & 7; if (row < nrow) *(uint4*)(PO + (size_t)row * 64 + c8 * 8) = *(const uint4*)(stg + row * 64 + c8 * 8); }
        wsync();
    }
    AT_WAITL(); bar();
}
__device__ __forceinline__ void moba_self_unit(const Params& p, int b, int h, int qb, unsigned char* lds_raw) {
    const int tid = otid(), lane = tid & 63, r32 = lane & 31, hi = lane >> 5, wid = __builtin_amdgcn_readfirstlane(tid >> 6);
    lp lds = (lp)lds_raw;
    const int bh = b * 8 + h;
    const bf16_t* ZB = (const bf16_t*)(p.ws + WS_ZB);
    const int* BCmbh = (const int*)(p.ws + WS_BCM) + (size_t)bh * 32 * 32;
    const int qi = 32 * wid + r32, t = qb * 256 + qi; const size_t tt = (size_t)b * S + t;
    float* wsf = (float*)(lds_raw + L_WSF) + wid * 64;
    float* ostage = (float*)(lds_raw + L_OST) + wid * 2048;
    const float c2 = exp2f(-(float)(h + 1)) * LOG2E;
    bf16x8 qr[4];
#pragma unroll
    for (int d0 = 0; d0 < 4; ++d0) qr[d0] = *(const bf16x8*)(ZB + tt * ZBW + ZB_MQ + h * 64 + d0 * 16 + hi * 8);
    const lp sK0 = lds + L_K, sV0 = lds + L_V;
    const bf16_t* KM_ = ZB + (size_t)b * S * ZBW + ZB_MK + h * 64; const bf16_t* VM_ = ZB + (size_t)b * S * ZBW + ZB_MV + h * 64;
    Soft sm; sm.m = 0.f; sm.l = 0.f; f32x16 o[2]; o[0] = f32x16{}; o[1] = f32x16{};
#pragma unroll
    for (int k = 0; k < 3; ++k) { dma_k(sK0 + k * 8192, KM_, ZBW, qb * 256 + 64 * k, wid, lane); dma_v(sV0 + k * 8192, VM_, ZBW, qb * 256 + 64 * k, wid, lane); }
    int tot, seg; moba_tables(BCmbh, lane, tot, seg);
    int before = 0; if (lane < 32) { for (int q = 0; q < qb; ++q) before += BCmbh[q * 32 + lane]; }
    const int base = seg + before;
#pragma unroll 1
    for (int i = 0; i < 4; ++i) {
        const int newer = 3 - i; AT_WAIT_NEWER(newer, 2);
        AT_WAITL(); bar();
        if (i == 0) { dma_k(sK0 + 3 * 8192, KM_, ZBW, qb * 256 + 192, wid, lane); dma_v(sV0 + 3 * 8192, VM_, ZBW, qb * 256 + 192, wid, lane); }
        const lp sK = sK0 + i * 8192, sV = sV0 + i * 8192;
        const bool skip = (32 * wid + 31 < 64 * i);
        if (!skip) {
            const float x0 = c2 * (float)(64 * i) - sm.m;
            f32x16 p0 = cinit(c2, hi, x0), p1 = cinit(c2, hi, x0 + c2 * 32.f);
            qk_tile(p0, p1, sK, qr, r32, hi);
            if (64 * i + 63 > 32 * wid) mask_tile(p0, p1, 0, qi - 64 * i, hi);
            softmax_step<true>(p0, p1, sm, o, wsf, r32, hi);
            { AT_PACK(p0, p1); pv_tile(o, sV, lane, hi, pw0, pw1, pw2, pw3); }
        }
    }
    {
        const float lself = halfsum(sm.l);
        const unsigned s3 = ((const unsigned*)(p.ws + WS_SEL3))[tt * 8 + h], l3 = ((const unsigned*)(p.ws + WS_LRK))[tt * 8 + h];
        const float* PM = (const float*)(p.ws + WS_PM) + (size_t)bh * MB_CAP; const float* PL = (const float*)(p.ws + WS_PL) + (size_t)bh * MB_CAP;
        float mk[3], lk[3]; int pidx[3];
        float M = sm.m + c2 * 256.f * (float)qb;
        const float mself = M;
#pragma unroll
        for (int k = 0; k < 3; ++k) { const int jk = (s3 >> (8 * k)) & 255, lrk = (l3 >> (8 * k)) & 255;
            const int pb = __shfl(base, jk & 31);
            if (jk < 32) { pidx[k] = pb + lrk; mk[k] = PM[pidx[k]] + c2 * 256.f * (float)jk; lk[k] = PL[pidx[k]]; M = __builtin_fmaxf(M, mk[k]); }
            else { pidx[k] = -1; mk[k] = NEGS; lk[k] = 0.f; } }
        const float ws_ = __builtin_amdgcn_exp2f(mself - M);
        float wk[3]; float Lt = lself * ws_;
#pragma unroll
        for (int k = 0; k < 3; ++k) { wk[k] = pidx[k] >= 0 ? __builtin_amdgcn_exp2f(mk[k] - M) : 0.f; Lt += lk[k] * wk[k]; }
        const float inv = Lt > 0.f ? 1.f / Lt : 0.f;
        float* rws = wsf;
        float* rwk = (float*)(lds_raw + L_KMT) + wid * 256;
        int* rpi = (int*)(rwk + 96);
        if (hi == 0) { rws[r32] = ws_ * inv;
#pragma unroll
            for (int k = 0; k < 3; ++k) { rwk[k * 32 + r32] = wk[k] * inv; rpi[k * 32 + r32] = pidx[k]; } }
#pragma unroll
        for (int r = 0; r < 16; ++r) { const int orow = crow(r, hi); ostage[orow * 64 + r32] = o[0][r]; ostage[orow * 64 + 32 + r32] = o[1][r]; }
        wsync();
        const bf16_t* PO = (const bf16_t*)(p.ws + WS_PO) + (size_t)bh * MB_CAP * 64;
        bf16_t* AB = (bf16_t*)(p.ws + WS_ATTB);
#pragma unroll
        for (int i = 0; i < 4; ++i) { const int row = i * 8 + (lane >> 3), c8 = lane & 7;
            const float4 a = *(const float4*)(ostage + row * 64 + c8 * 8), c4 = *(const float4*)(ostage + row * 64 + c8 * 8 + 4);
            const float w0 = rws[row];
            float acc8[8] = {a.x * w0, a.y * w0, a.z * w0, a.w * w0, c4.x * w0, c4.y * w0, c4.z * w0, c4.w * w0};
#pragma unroll
            for (int k = 0; k < 3; ++k) { const int pi = rpi[k * 32 + row]; if (pi >= 0) { const float w = rwk[k * 32 + row]; const uint4 q = *(const uint4*)(PO + (size_t)pi * 64 + c8 * 8);
                const unsigned qq_[4] = {q.x, q.y, q.z, q.w};
#pragma unroll
                for (int e = 0; e < 4; ++e) { acc8[2 * e] += __builtin_bit_cast(float, qq_[e] << 16) * w; acc8[2 * e + 1] += __builtin_bit_cast(float, qq_[e] & 0xffff0000u) * w; } } }
            *(uint4*)(AB + ((size_t)b * S + qb * 256 + 32 * wid + row) * D + 512 + h * 64 + c8 * 8) = make_uint4(pk2(acc8[0], acc8[1]), pk2(acc8[2], acc8[3]), pk2(acc8[4], acc8[5]), pk2(acc8[6], acc8[7])); }
        wsync();
    }
    AT_WAITL(); bar();
}
}

__device__ __forceinline__ void phase_att1(const Params& p, unsigned char* lds_raw) {
    const int tid = otid();
    int* pre = (int*)(lds_raw + at::L_END);
    int* segt = pre + 514;
    { const int* BCm = (const int*)(p.ws + WS_BCM); const int bh = tid >> 5, j = tid & 31; int s = 0;
      for (int q = 0; q < 32; ++q) s += BCm[(size_t)(bh * 32 + q) * 32 + j];
      pre[tid + 1] = (s + 255) >> 8; if (tid == 0) pre[0] = 0;
      segt[tid] = (s + 31) & ~31; }
    __syncthreads();
    for (int sft = 1; sft < 512; sft <<= 1) { int v = 0, w = 0; if (tid >= sft) v = pre[tid + 1 - sft]; if ((tid & 31) >= sft) w = segt[tid - sft]; __syncthreads(); pre[tid + 1] += v; if (sft < 32) segt[tid] += w; __syncthreads(); }
    { const int* BCm = (const int*)(p.ws + WS_BCM); const int bh = tid >> 5, j = tid & 31; int s = 0;
      for (int q = 0; q < 32; ++q) s += BCm[(size_t)(bh * 32 + q) * 32 + j];
      const int excl = segt[tid] - ((s + 31) & ~31); __syncthreads(); segt[tid] = excl; }
    __syncthreads();
    const int nun = pre[512];
    for (int pi = blockIdx.x; pi < 512; pi += gridDim.x) {
        const int rnd = pi >> 8, id = pi & 255;
        const int bg = 2 * rnd + (id >> 7), c = rnd ? 127 - (id & 127) : (id & 127); at::nsa_unit(p, bg >> 1, bg & 1, c, lds_raw);
    }
    {
        const int u0 = (int)(((long)blockIdx.x * nun) / gridDim.x), u1 = (int)(((long)(blockIdx.x + 1) * nun) / gridDim.x);
        int prev = -1;
        for (int u = u0; u < u1; ++u) {
            int lo = 0, hi_ = 511;
            while (lo < hi_) { const int mid = (lo + hi_ + 1) >> 1; if (pre[mid] <= u) lo = mid; else hi_ = mid - 1; }
            at::moba_gather_unit(p, lo >> 5, lo & 31, u - pre[lo], segt[lo], lo != prev, lds_raw);
            prev = lo;
        }
    }
}
__device__ __forceinline__ void phase_att2(const Params& p, unsigned char* lds_raw) {
    for (int pi = blockIdx.x; pi < 512; pi += gridDim.x) {
        const int rnd = pi >> 8, id = pi & 255;
        const int bh = 8 * rnd + (id >> 5), qb = rnd ? 31 - (id & 31) : (id & 31); at::moba_self_unit(p, bh >> 3, bh & 7, qb, lds_raw);
    }
}
__device__ __forceinline__ void phase_route(const Params& p, unsigned char* lds_raw) {
    for (int pi = blockIdx.x; pi < 512; pi += gridDim.x) at::moba_route_unit(p, pi >> 8, (pi >> 5) & 7, pi & 31, lds_raw);
}


__device__ __forceinline__ void phase_r2_fast(const Params& p, int l, unsigned char* lds_raw) {
    using namespace at;
    const int tid = otid(), lane = tid & 63, wave = __builtin_amdgcn_readfirstlane(tid >> 6), r32 = lane & 31, hi = lane >> 5;
    const float* mod = (const float*)(p.ws + WS_MOD);
    const bf16_t* XAB = (const bf16_t*)(p.ws + WS_XAB); bf16_t* XN = (bf16_t*)(p.ws + WS_XN); bf16_t* XL = (bf16_t*)(p.ws + WS_XNLO);
    const float* lng = p.in[5] + (size_t)l * D; const float* rw = p.in[15] + (size_t)l * D * NE; const float* rb = p.in[16] + l * NE;
    int* toke = (int*)(p.ws + WS_TOKE); float* tokw = (float*)(p.ws + WS_TOKW); int* BC = (int*)(p.ws + WS_BC);
    lp lds = (lp)lds_raw;
    int* hist = (int*)(lds_raw + 131072);
    for (int idx = tid; idx < 128 * 32; idx += NT) {
        const int kc = idx >> 5, e = idx & 31; float v[8];
#pragma unroll
        for (int j = 0; j < 8; ++j) v[j] = rw[(size_t)(8 * kc + j) * NE + e];
        unsigned hh[8], ll[8];
#pragma unroll
        for (int j = 0; j < 8; ++j) { hh[j] = f2bf(v[j]); ll[j] = f2bf(v[j] - __builtin_bit_cast(float, hh[j] << 16)); }
        *(uint4*)(lds_raw + (size_t)idx * 16) = make_uint4(hh[0] | (hh[1] << 16), hh[2] | (hh[3] << 16), hh[4] | (hh[5] << 16), hh[6] | (hh[7] << 16));
        *(uint4*)(lds_raw + 65536 + (size_t)idx * 16) = make_uint4(ll[0] | (ll[1] << 16), ll[2] | (ll[3] << 16), ll[4] | (ll[5] << 16), ll[6] | (ll[7] << 16));
    }
    for (int blk = blockIdx.x; blk < T / 64; blk += gridDim.x) {
        if (tid < 32) hist[tid] = 0;
        for (int i = 0; i < 8; ++i) {
            const int t = blk * 64 + wave * 8 + i, b = t / S;
            float4 v[4]; float ss = 0.f;
#pragma unroll
            for (int j = 0; j < 4; ++j) { const uint2 q_ = *(const uint2*)(XAB + (size_t)t * D + 4 * lane + 256 * j);
                v[j] = make_float4(__builtin_bit_cast(float, q_.x << 16), __builtin_bit_cast(float, q_.x & 0xffff0000u), __builtin_bit_cast(float, q_.y << 16), __builtin_bit_cast(float, q_.y & 0xffff0000u));
                ss += (v[j].x * v[j].x + v[j].y * v[j].y) + (v[j].z * v[j].z + v[j].w * v[j].w); }
            ss = wave_sum(ss);
            const float r = rsqrtf(ss * (1.f / D) + EPS);
            const float* sh = mod + ((size_t)l * Bn + b) * 6144 + 3 * D; const float* sc = mod + ((size_t)l * Bn + b) * 6144 + 4 * D;
#pragma unroll
            for (int j = 0; j < 4; ++j) {
                const int col = 4 * lane + 256 * j;
                const float4 g = *(const float4*)(lng + col), s1 = *(const float4*)(sc + col), s0 = *(const float4*)(sh + col);
                const float o[4] = {v[j].x * r * g.x * (1.f + s1.x) + s0.x, v[j].y * r * g.y * (1.f + s1.y) + s0.y, v[j].z * r * g.z * (1.f + s1.z) + s0.z, v[j].w * r * g.w * (1.f + s1.w) + s0.w};
                unsigned hh[4], ll[4];
#pragma unroll
                for (int q = 0; q < 4; ++q) { hh[q] = f2bf(o[q]); ll[q] = f2bf(o[q] - __builtin_bit_cast(float, hh[q] << 16)); }
                *(uint2*)(XN + (size_t)t * D + col) = make_uint2(hh[0] | (hh[1] << 16), hh[2] | (hh[3] << 16));
                *(uint2*)(XL + (size_t)t * D + col) = make_uint2(ll[0] | (ll[1] << 16), ll[2] | (ll[3] << 16));
            }
        }
        asm volatile("s_waitcnt vmcnt(0)" ::: "memory");
        __syncthreads();
        if (wave < 2) {
            const int t = blk * 64 + wave * 32 + r32;
            const bf16_t* xh = XN + (size_t)t * D + 8 * hi; const bf16_t* xl = XL + (size_t)t * D + 8 * hi;
            const AT_LAS unsigned char* wh = lds + (size_t)(hi * 32 + r32) * 16; const AT_LAS unsigned char* wl = wh + 65536;
            f32x16 acc = f32x16{};
#pragma unroll 4
            for (int ks = 0; ks < 64; ++ks) {
                const bf16x8 bh = *(const bf16x8*)(xh + 16 * ks), bl = *(const bf16x8*)(xl + 16 * ks);
                const bf16x8 ah = *(const AT_LAS bf16x8*)(wh + ks * 1024), al = *(const AT_LAS bf16x8*)(wl + ks * 1024);
                acc = __builtin_amdgcn_mfma_f32_32x32x16_bf16(ah, bh, acc, 0, 0, 0);
                acc = __builtin_amdgcn_mfma_f32_32x32x16_bf16(al, bh, acc, 0, 0, 0);
                acc = __builtin_amdgcn_mfma_f32_32x32x16_bf16(ah, bl, acc, 0, 0, 0);
            }
            float a0 = -3e38f, a1 = -3e38f, a2 = -3e38f, a3 = -3e38f; int i0 = 99, i1 = 99, i2 = 99, i3 = 99;
#pragma unroll
            for (int r = 0; r < 16; ++r) { const int e = crow(r, hi); const float s_ = acc[r] + rb[e];
                if (s_ > a0) { a3 = a2; i3 = i2; a2 = a1; i2 = i1; a1 = a0; i1 = i0; a0 = s_; i0 = e; }
                else if (s_ > a1) { a3 = a2; i3 = i2; a2 = a1; i2 = i1; a1 = s_; i1 = e; }
                else if (s_ > a2) { a3 = a2; i3 = i2; a2 = s_; i2 = e; }
                else if (s_ > a3) { a3 = s_; i3 = e; } }
            float ov[4]; int oi[4];
            { const float sv[4] = {a0, a1, a2, a3}; const int si[4] = {i0, i1, i2, i3};
#pragma unroll
              for (int k = 0; k < 4; ++k) { auto a = __builtin_amdgcn_permlane32_swap(__float_as_uint(sv[k]), __float_as_uint(sv[k]), false, false); ov[k] = __uint_as_float(hi ? a[0] : a[1]);
                                            auto c = __builtin_amdgcn_permlane32_swap((unsigned)si[k], (unsigned)si[k], false, false); oi[k] = (int)(hi ? c[0] : c[1]); } }
#pragma unroll
            for (int k = 0; k < 4; ++k) { const float s_ = ov[k]; const int e = oi[k];
                if (s_ > a0 || (s_ == a0 && e < i0)) { a3 = a2; i3 = i2; a2 = a1; i2 = i1; a1 = a0; i1 = i0; a0 = s_; i0 = e; }
                else if (s_ > a1 || (s_ == a1 && e < i1)) { a3 = a2; i3 = i2; a2 = a1; i2 = i1; a1 = s_; i1 = e; }
                else if (s_ > a2 || (s_ == a2 && e < i2)) { a3 = a2; i3 = i2; a2 = s_; i2 = e; }
                else if (s_ > a3 || (s_ == a3 && e < i3)) { a3 = s_; i3 = e; } }
            const float e1 = __expf(a1 - a0), e2 = __expf(a2 - a0), e3 = __expf(a3 - a0), inv = 1.f / (((1.f + e1) + e2) + e3);
            if (hi == 0) {
                *(int4*)(toke + (size_t)t * 4) = make_int4(i0, i1, i2, i3);
                *(float4*)(tokw + (size_t)t * 4) = make_float4(inv, e1 * inv, e2 * inv, e3 * inv);
                atomicAdd(&hist[i0], 1); atomicAdd(&hist[i1], 1); atomicAdd(&hist[i2], 1); atomicAdd(&hist[i3], 1);
            }
        }
        __syncthreads();
        if (tid < 32) BC[blk * 32 + tid] = hist[tid];
        __syncthreads();
    }
}
__device__ __forceinline__ void phase_sc_fast(const Params& p, int l, unsigned char* lds_raw) {
    const int tid = otid();
    const int* BC = (const int*)(p.ws + WS_BC);
    int* cnt = (int*)(p.ws + WS_CNT) + l * 32;
    int* tot = (int*)lds_raw; int* base = tot + 32; int* fillc = tot + 64; int* before = tot + 96;
    const int* toke = (const int*)(p.ws + WS_TOKE); const float* tokw = (const float*)(p.ws + WS_TOKW);
    int* rowtok = (int*)(p.ws + WS_ROWTOK) + (size_t)l * RMAX; float* roww = (float*)(p.ws + WS_ROWW) + (size_t)l * RMAX; int* pos = (int*)(p.ws + WS_POS);
    for (int blk = blockIdx.x; blk < T / 64; blk += gridDim.x) {
        { const int e = tid & 31, part = tid >> 5; int s = 0, bf = 0;
#pragma unroll 4
          for (int i = part * 16; i < part * 16 + 16; ++i) { const int c = BC[i * 32 + e]; s += c; if (i < blk) bf += c; }
          int* ptot = tot + 128; int* pbef = ptot + 512;
          ptot[tid] = s; pbef[tid] = bf; }
        __syncthreads();
        if (tid < 32) { const int* ptot = tot + 128; const int* pbef = ptot + 512; int s = 0, bf = 0;
#pragma unroll
            for (int q = 0; q < 16; ++q) { s += ptot[q * 32 + tid]; bf += pbef[q * 32 + tid]; }
            tot[tid] = s; before[tid] = bf; fillc[tid] = 0; if (blk == 0) cnt[tid] = s; }
        __syncthreads();
        if (tid == 0) { int s = 0; for (int e = 0; e < 32; ++e) { base[e] = s + before[e]; s += (tot[e] + 255) & ~255; } }
        __syncthreads();
        if (tid < 256) {
            const int i = blk * 256 + tid, e = toke[i];
            const int slot = base[e] + atomicAdd(&fillc[e], 1);
            rowtok[slot] = i >> 2; roww[slot] = tokw[i]; pos[i] = slot;
        }
        __syncthreads();
    }
}

#define XB_TMO      128
#define XB_XCNT(j)  (256  + 64 * (j))
#define XB_XSUB(j)  (1280 + 64 * (j))
#define XB_XGEN(j)  (2304 + 64 * (j))
#define XB_TOP      3328
#define XB_TOPGEN   3392
#define XCD_BAR_WORDS 3456
#define XB_SPIN_CAP (1u << 18)
#define XLAS __attribute__((address_space(3)))
__device__ __forceinline__ unsigned xb_ld(unsigned* p)              { return __hip_atomic_load(p, __ATOMIC_RELAXED, __HIP_MEMORY_SCOPE_AGENT); }
__device__ __forceinline__ unsigned xb_add(unsigned* p, unsigned v) { return __hip_atomic_fetch_add(p, v, __ATOMIC_RELAXED, __HIP_MEMORY_SCOPE_AGENT); }
__device__ __forceinline__ unsigned xb_xcc_id() { return (unsigned)__builtin_amdgcn_s_getreg((3 << 11) | 20) & 0xFu; }
#define XB_SPIN(cond, bar) do { unsigned _sp = 0; while (cond) { __builtin_amdgcn_s_sleep(1); \
    if ((++_sp & 255u) == 0u) { if (xb_ld(&(bar)[XB_TMO])) break; if (_sp > XB_SPIN_CAP) { atomicAdd(&(bar)[XB_TMO], 1u); break; } } } } while (0)
constexpr int LDS_BARST_OFF = 147200;
struct XcdBarrier { unsigned* bar; unsigned x; volatile XLAS unsigned* st; };
__device__ __forceinline__ XcdBarrier xcd_barrier_post(unsigned* bar, volatile XLAS unsigned* st) {
    XcdBarrier b; b.bar = bar; b.x = xb_xcc_id(); b.st = st;
    if (threadIdx.x == 0) (void)xb_add(&bar[XB_XCNT(b.x)], 1u);
    return b;
}
__device__ __forceinline__ void xcd_barrier_complete(unsigned* bar, unsigned x, unsigned& nloc, unsigned& nx) {
    const unsigned G = gridDim.x * gridDim.y * gridDim.z;
    unsigned sum, cnt, mine, sp = 0u;
    for (;;) {
        sum = 0u; cnt = 0u; mine = 0u;
#pragma unroll
        for (unsigned j = 0; j < 16; ++j) { const unsigned c = xb_ld(&bar[XB_XCNT(j)]); sum += c; cnt += (c > 0u) ? 1u : 0u; mine = (j == x) ? c : mine; }
        if (sum == G) break;
        __builtin_amdgcn_s_sleep(1);
        if ((++sp & 255u) == 0u) { if (xb_ld(&bar[XB_TMO])) break; if (sp > XB_SPIN_CAP) { atomicAdd(&bar[XB_TMO], 1u); break; } }
    }
    nloc = mine > 0u ? mine : 1u; nx = cnt > 0u ? cnt : 1u;
}
__device__ __forceinline__ void xcd_barrier(unsigned char* ws, unsigned char* lds_raw_) {
    XcdBarrier b; b.bar = (unsigned*)(ws + WS_BAR); b.x = xb_xcc_id(); b.st = (volatile XLAS unsigned*)((XLAS unsigned char*)lds_raw_ + LDS_BARST_OFF);
    asm volatile("s_waitcnt vmcnt(0)" ::: "memory");
    __syncthreads();
    if (threadIdx.x == 0) {
        unsigned* bar = b.bar;
        __builtin_amdgcn_s_waitcnt(0);
        unsigned nloc = b.st[0], nx = b.st[1];
        if (nloc == 0u) { xcd_barrier_complete(bar, b.x, nloc, nx); b.st[0] = nloc; b.st[1] = nx; }
        const unsigned old = xb_add(&bar[XB_XSUB(b.x)], 1u);
        const unsigned gen = old / nloc;
        if (old + 1u == (gen + 1u) * nloc) {
            __builtin_amdgcn_fence(__ATOMIC_RELEASE, "agent");
            asm volatile("s_waitcnt vmcnt(0)" ::: "memory");
            const unsigned og = xb_add(&bar[XB_TOP], 1u);
            const unsigned tg = og / nx;
            if (og + 1u == (tg + 1u) * nx) xb_add(&bar[XB_TOPGEN], 1u);
            else XB_SPIN(xb_ld(&bar[XB_TOPGEN]) == tg, bar);
            __builtin_amdgcn_fence(__ATOMIC_ACQUIRE, "agent");
            xb_add(&bar[XB_XGEN(b.x)], 1u);
            asm volatile("s_waitcnt vmcnt(0)" ::: "memory");
        } else {
            XB_SPIN(xb_ld(&bar[XB_XGEN(b.x)]) == gen, bar);
            __builtin_amdgcn_fence(__ATOMIC_ACQUIRE, "agent");
            asm volatile("s_waitcnt vmcnt(0)" ::: "memory");
        }
    }
    __syncthreads();
}

__global__ void __launch_bounds__(NT, 2) mega_fwd(Params p) {
    extern __shared__ __attribute__((aligned(16))) unsigned char lds_raw[];
    float* lds = (float*)lds_raw;
    volatile XLAS unsigned* bst = (volatile XLAS unsigned*)((XLAS unsigned char*)lds_raw + LDS_BARST_OFF);
    if (threadIdx.x < 2) bst[threadIdx.x] = 0u;
    __syncthreads();
    (void)xcd_barrier_post((unsigned*)(p.ws + WS_BAR), bst);
#define GSYNC() xcd_barrier(p.ws, lds_raw)
    phase_p0a(p, lds);
    __syncthreads();
    phase_convert(p, lds);
    GSYNC();
    phase_p0b(p);
    GSYNC();
    _Pragma("unroll 1") for (int l = 0; l < L; ++l) {
        phase_r1(p, l, true);
        GSYNC();
        phase_g1_fast(p, l, lds_raw);
        GSYNC();
        phase_ck_fast(p, l, lds_raw);
        GSYNC();
        phase_c2(p, l, lds);
        __syncthreads();
        phase_route(p, lds_raw);
        GSYNC();
        phase_att1(p, lds_raw);
        GSYNC();
        phase_att2(p, lds_raw);
        GSYNC();
        phase_g2_fast(p, l, lds_raw);
        GSYNC();
        phase_r2_fast(p, l, lds_raw);
        GSYNC();
        phase_sc_fast(p, l, lds_raw);
        GSYNC();
        phase_m1_fast(p, l, lds_raw);
        GSYNC();
        phase_m2_fast(p, l, lds_raw);
        GSYNC();
    }
    phase_r1(p, L, false);
}

extern "C" void kernel_launch(void* const* d_in, const int* in_sizes, int n_in, void* d_out, int out_size, void* d_ws, size_t ws_size, hipStream_t stream) {
    static int grid_blocks = 0;
    if (grid_blocks == 0) {
        if (n_in != 21 || out_size != T * D || ws_size < WS_END) { fprintf(stderr, "kernel_launch: unexpected shapes (n_in %d out %d ws %zu need %zu)\n", n_in, out_size, ws_size, (size_t)WS_END); grid_blocks = -1; return; }
        int dev = 0, cus = 0, per_cu = 0;
        hipGetDevice(&dev);
        hipDeviceGetAttribute(&cus, hipDeviceAttributeMultiprocessorCount, dev);
        hipFuncSetAttribute((const void*)mega_fwd, hipFuncAttributeMaxDynamicSharedMemorySize, LDS_BYTES);
        hipOccupancyMaxActiveBlocksPerMultiprocessor(&per_cu, (const void*)mega_fwd, NT, LDS_BYTES);
        if (per_cu < 1) { fprintf(stderr, "kernel_launch: occupancy query says %d blocks per CU\n", per_cu); per_cu = 1; }
        (void)hipGetLastError();
        grid_blocks = cus * 1;
    }
    if (grid_blocks < 0) return;
    if (hipMemsetAsync((char*)d_ws + WS_BAR, 0, 16384, stream) != hipSuccess) { fprintf(stderr, "kernel_launch: memset failed\n"); return; }
    Params p{};
    for (int i = 0; i < 21; ++i) p.in[i] = (const float*)d_in[i];
    p.out = (float*)d_out; p.ws = (unsigned char*)d_ws;
    hipLaunchKernelGGL(mega_fwd, dim3(grid_blocks), dim3(NT), LDS_BYTES, stream, p);
    hipError_t e = hipPeekAtLastError();
    if (e != hipSuccess) fprintf(stderr, "launch failed: %s (grid %d)\n", hipGetErrorString(e), grid_blocks);
}
```

```cpp
#include <hip/hip_runtime.h>
#include <cstdio>
#include <cstdint>

constexpr int Bn = 2, S = 8192, D = 1024, L = 2, T = Bn * S;
constexpr int INW = 2840;
constexpr int NE = 32, TOPK = 4, DFF = 1024;
constexpr int A_TOT = T * TOPK;
constexpr int RMAX = A_TOT + NE * 256;
constexpr int NCMP = 511;
constexpr int NT = 512;
constexpr int NW = NT / 64;
constexpr int LDS_BYTES = 147456;
constexpr float EPS = 1e-6f;
constexpr float NEGF = -1e30f;

constexpr int ZBW = 3072;
constexpr int ZB_Q = 0, ZB_KC = 512, ZB_VC = 640, ZB_KS = 768, ZB_VS = 896, ZB_KW = 1024, ZB_VW = 1152, ZB_MQ = 1280, ZB_MK = 1792, ZB_MV = 2304, ZB_G = 2816;
constexpr float QSCALE = 0.125f * 1.4426950408889634f;
constexpr float LOG2E = 1.4426950408889634f;

constexpr size_t al256(size_t x) { return (x + 255) & ~(size_t)255; }
constexpr size_t WS_BAR = 0;
constexpr size_t WS_MODP = 16384;
constexpr size_t WS_MOD = al256(WS_MODP + (size_t)8 * L * Bn * 6144 * 4);
constexpr size_t WS_CNT = al256(WS_MOD + (size_t)L * Bn * 6144 * 4);
constexpr size_t WS_ROWTOK = al256(WS_CNT + L * 32 * 4);
constexpr size_t WS_ROWW = al256(WS_ROWTOK + (size_t)L * RMAX * 4);
constexpr size_t WS_TOKE = al256(WS_ROWW + (size_t)L * RMAX * 4);
constexpr size_t WS_TOKW = al256(WS_TOKE + (size_t)T * 4 * 4);
constexpr size_t WS_POS = al256(WS_TOKW + (size_t)T * 4 * 4);
constexpr size_t WS_Y = al256(WS_POS + (size_t)T * 4 * 4);
constexpr size_t WS_WINT = al256(WS_Y + (size_t)RMAX * 1024 * 4);
constexpr size_t WS_WOT = al256(WS_WINT + (size_t)L * 3072 * 1024 * 2);
constexpr size_t WS_W1T = al256(WS_WOT + (size_t)L * 1024 * 1024 * 2);
constexpr size_t WS_W2T = al256(WS_W1T + (size_t)L * NE * 2048 * 1024 * 2);
constexpr size_t WS_XN = al256(WS_W2T + (size_t)L * NE * 1024 * 1024 * 2);
constexpr size_t WS_ATTB = al256(WS_XN + (size_t)(T + 1) * D * 2);
constexpr size_t WS_ACT = al256(WS_ATTB + (size_t)T * D * 2);
constexpr size_t WS_ZB = al256(WS_ACT + (size_t)RMAX * DFF * 2);
constexpr size_t WS_GATE = al256(WS_ZB + (size_t)T * ZBW * 2);
constexpr size_t WS_KCB = al256(WS_GATE + (size_t)T * 32 * 4);
constexpr size_t WS_VCB = al256(WS_KCB + (size_t)Bn * 2 * 512 * 64 * 2);
constexpr size_t WS_KMB = al256(WS_VCB + (size_t)Bn * 2 * 512 * 64 * 2);
constexpr size_t WS_XNLO = al256(WS_KMB + (size_t)Bn * 8 * 32 * 64 * 2);
constexpr size_t WS_BC = al256(WS_XNLO + (size_t)T * D * 2);
constexpr size_t WS_WCT = al256(WS_BC + (size_t)(T / 64) * 32 * 4);
constexpr size_t WS_CBP = al256(WS_WCT + (size_t)L * 2 * 128 * 2048 * 2);
constexpr size_t WS_CB = al256(WS_CBP + (size_t)16 * L * 2 * 128 * 4);
constexpr size_t WS_HIDP = al256(WS_CB + (size_t)L * 2 * 128 * 4);
constexpr size_t WS_XAB = al256(WS_HIDP + (size_t)4 * 2 * 2044 * 128 * 4);
constexpr size_t WS_SEL3 = al256(WS_XAB + (size_t)T * D * 2);
constexpr size_t WS_LRK = al256(WS_SEL3 + (size_t)T * 8 * 4);
constexpr size_t WS_ILIST = al256(WS_LRK + (size_t)T * 8 * 4);
constexpr size_t WS_BCM = al256(WS_ILIST + (size_t)16 * 32 * 32 * 256);
constexpr size_t WS_PM = al256(WS_BCM + (size_t)16 * 32 * 32 * 4);
constexpr size_t WS_PL = al256(WS_PM + (size_t)16 * 25600 * 4);
constexpr size_t WS_PO = al256(WS_PL + (size_t)16 * 25600 * 4);
constexpr size_t WS_END = al256(WS_PO + (size_t)16 * 25600 * 64 * 2);

struct Params {
    const float* in[21];
    float* out;
    unsigned char* ws;
};

__device__ __forceinline__ int otid() { int t = threadIdx.x; asm volatile("" : "+v"(t)); return t; }
typedef unsigned short bf16_t;
__device__ __forceinline__ unsigned f2bf(float f) { unsigned u = __builtin_bit_cast(unsigned, f); return (u + 0x7fffu + ((u >> 16) & 1u)) >> 16; }
__device__ __forceinline__ unsigned pk2(float lo, float hi) { return f2bf(lo) | (f2bf(hi) << 16); }
__device__ __forceinline__ float bf2f(bf16_t v) { return __builtin_bit_cast(float, (unsigned)v << 16); }
__device__ __forceinline__ float wave_sum(float v) {
#pragma unroll
    for (int o = 1; o < 64; o <<= 1) v += __shfl_xor(v, o);
    return v;
}
__device__ __forceinline__ float sigmoidf_(float x) { return 1.f / (1.f + __expf(-x)); }
__device__ __forceinline__ float gelu_tanh(float x) {
    const float u = 0.7978845608028654f * (x + 0.044715f * x * x * x);
    return 0.5f * x * (1.f + tanhf(u));
}

__device__ __forceinline__ void phase_p0a(const Params& p, float* lds) {
    const int tid = otid(), gtid = blockIdx.x * NT + tid, gsz = gridDim.x * NT;
    int* cnt = (int*)(p.ws + WS_CNT); int* rowtok = (int*)(p.ws + WS_ROWTOK);
    for (int i = gtid; i < L * 32; i += gsz) cnt[i] = 0;
    for (int i = gtid; i < L * RMAX; i += gsz) rowtok[i] = -1;
    const float* c = p.in[1];
    for (int i = tid; i < Bn * D; i += NT) { const float v = c[i]; lds[i] = v / (1.f + __expf(-v)); }
    __syncthreads();
    const float* ada_w = p.in[2];
    float* modp = (float*)(p.ws + WS_MODP);
    for (int idx = gtid; idx < 8 * L * 6144; idx += gsz) {
        const int col = idx % 6144, l = (idx / 6144) % L, kc = idx / (6144 * L);
        const float* w = ada_w + ((size_t)l * D + kc * 128) * 6144 + col;
        float a0 = 0.f, a1 = 0.f;
#pragma unroll 8
        for (int k = 0; k < 128; ++k) { const float wv = w[(size_t)k * 6144]; a0 += lds[kc * 128 + k] * wv; a1 += lds[D + kc * 128 + k] * wv; }
        modp[((size_t)(kc * L + l) * Bn + 0) * 6144 + col] = a0;
        modp[((size_t)(kc * L + l) * Bn + 1) * 6144 + col] = a1;
    }
    { const float* posw = p.in[9]; const float* w1c = p.in[10]; float* cbp = (float*)(p.ws + WS_CBP);
      for (int idx = gtid; idx < 16 * L * 2 * 128; idx += gsz) {
          const int j = idx & 127, li = (idx >> 7) % (L * 2), kc = idx / (L * 2 * 128);
          const float* w = w1c + ((size_t)li * 2048 + kc * 128) * 128 + j; const float* pp = posw + (size_t)li * 2048 + kc * 128;
          float a = 0.f;
#pragma unroll 8
          for (int k = 0; k < 128; ++k) a += pp[k] * w[(size_t)k * 128];
          cbp[idx] = a; } }
}
__device__ __forceinline__ void phase_p0b(const Params& p) {
    const int gtid = blockIdx.x * NT + otid(), gsz = gridDim.x * NT;
    { const float* cbp = (const float*)(p.ws + WS_CBP); float* cb = (float*)(p.ws + WS_CB);
      for (int idx = gtid; idx < L * 2 * 128; idx += gsz) { float s = 0.f;
#pragma unroll
          for (int kc = 0; kc < 16; ++kc) s += cbp[kc * (L * 2 * 128) + idx];
          cb[idx] = s; } }
    const float* modp = (const float*)(p.ws + WS_MODP); float* mod = (float*)(p.ws + WS_MOD); const float* ada_b = p.in[3];
    for (int idx = gtid; idx < L * Bn * 6144; idx += gsz) {
        const int col = idx % 6144, l = idx / (Bn * 6144);
        float s = ada_b[l * 6144 + col];
#pragma unroll
        for (int kc = 0; kc < 8; ++kc) s += modp[(size_t)kc * L * Bn * 6144 + idx];
        mod[idx] = s;
    }
}

__device__ __forceinline__ void phase_r1(const Params& p, int l, bool do_h) {
    const int lane = otid() & 63, wave = otid() >> 6;
    const int gw = blockIdx.x * NW + wave, ngw = gridDim.x * NW;
    const float* mod = (const float*)(p.ws + WS_MOD);
    const float* xin = p.in[0]; float* XA = p.out;
    const bf16_t* Y = (const bf16_t*)(p.ws + WS_Y); const int* pos = (const int*)(p.ws + WS_POS);
    const float* lng = p.in[4] + (size_t)(do_h ? l : 0) * D;
    bf16_t* XN = (bf16_t*)(p.ws + WS_XN);
    for (int t = gw; t < T; t += ngw) {
        const int b = t / S;
        float4 v[4];
        if (l == 0) {
#pragma unroll
            for (int j = 0; j < 4; ++j) v[j] = *(const float4*)(xin + (size_t)t * D + 4 * lane + 256 * j);
        } else {
            const float* g2 = mod + ((size_t)(l - 1) * Bn + b) * 6144 + 5 * D;
            const int p0 = pos[t * 4 + 0], p1 = pos[t * 4 + 1], p2 = pos[t * 4 + 2], p3 = pos[t * 4 + 3];
            const float4 tw = *(const float4*)((const float*)(p.ws + WS_TOKW) + (size_t)t * 4);
            bf16_t* XAB = (bf16_t*)(p.ws + WS_XAB);
#pragma unroll
            for (int j = 0; j < 4; ++j) {
                const int col = 4 * lane + 256 * j;
#define BF4(q) make_float4(__builtin_bit_cast(float, (q).x << 16), __builtin_bit_cast(float, (q).x & 0xffff0000u), __builtin_bit_cast(float, (q).y << 16), __builtin_bit_cast(float, (q).y & 0xffff0000u))
                const uint2 xq = *(const uint2*)(XAB + (size_t)t * D + col);
                const float4 x = BF4(xq);
                const uint2 q0 = *(const uint2*)(Y + (size_t)p0 * D + col), q1 = *(const uint2*)(Y + (size_t)p1 * D + col), q2 = *(const uint2*)(Y + (size_t)p2 * D + col), q3 = *(const uint2*)(Y + (size_t)p3 * D + col);
                const float4 y0 = BF4(q0), y1 = BF4(q1), y2 = BF4(q2), y3 = BF4(q3);
#undef BF4
                const float4 g = *(const float4*)(g2 + col);
                float4 r;
                r.x = x.x + g.x * (((tw.x * y0.x + tw.y * y1.x) + tw.z * y2.x) + tw.w * y3.x); r.y = x.y + g.y * (((tw.x * y0.y + tw.y * y1.y) + tw.z * y2.y) + tw.w * y3.y);
                r.z = x.z + g.z * (((tw.x * y0.z + tw.y * y1.z) + tw.z * y2.z) + tw.w * y3.z); r.w = x.w + g.w * (((tw.x * y0.w + tw.y * y1.w) + tw.z * y2.w) + tw.w * y3.w);
                v[j] = r;
                if (do_h) *(uint2*)(XAB + (size_t)t * D + col) = make_uint2(pk2(r.x, r.y), pk2(r.z, r.w));
                else *(float4*)(XA + (size_t)t * D + col) = r;
            }
        }
        if (do_h) {
            float ss = 0.f;
#pragma unroll
            for (int j = 0; j < 4; ++j) ss += (v[j].x * v[j].x + v[j].y * v[j].y) + (v[j].z * v[j].z + v[j].w * v[j].w);
            ss = wave_sum(ss);
            const float r = rsqrtf(ss * (1.f / D) + EPS);
            const float* sh = mod + ((size_t)l * Bn + b) * 6144 + 0 * D; const float* sc = mod + ((size_t)l * Bn + b) * 6144 + 1 * D;
#pragma unroll
            for (int j = 0; j < 4; ++j) {
                const int col = 4 * lane + 256 * j;
                const float4 g = *(const float4*)(lng + col), s1 = *(const float4*)(sc + col), s0 = *(const float4*)(sh + col);
                float4 o;
                o.x = v[j].x * r * g.x * (1.f + s1.x) + s0.x; o.y = v[j].y * r * g.y * (1.f + s1.y) + s0.y;
                o.z = v[j].z * r * g.z * (1.f + s1.z) + s0.z; o.w = v[j].w * r * g.w * (1.f + s1.w) + s0.w;
                *(uint2*)(XN + (size_t)t * D + col) = make_uint2(pk2(o.x, o.y), pk2(o.z, o.w));
            }
        }
    }
}


__device__ __forceinline__ void phase_c2(const Params& p, int l, float* lds) {
    const int lane = otid() & 63, wave = otid() >> 6;
    const float* HIDP = (const float*)(p.ws + WS_HIDP); const float* cb = (const float*)(p.ws + WS_CB) + l * 2 * 128; const float* w2 = p.in[11] + (size_t)l * 2 * 128 * 64;
    const float gk = p.in[8][l * 64 + lane];
    float* hl = lds + wave * 128;
    for (int r = blockIdx.x * NW + wave; r < 2 * 2044; r += gridDim.x * NW) {
        const int idx = r / 2044, rr = r % 2044;
#pragma unroll
        for (int q = 0; q < 2; ++q) { const int j = lane + 64 * q; float s = cb[idx * 128 + j];
#pragma unroll
            for (int kq = 0; kq < 4; ++kq) s += HIDP[((size_t)(kq * 2 + idx) * 2044 + rr) * 128 + j];
            hl[j] = gelu_tanh(s); }
        asm volatile("s_waitcnt lgkmcnt(0)" ::: "memory"); __builtin_amdgcn_wave_barrier();
        const float* W = w2 + (size_t)idx * 128 * 64;
        float s = 0.f;
#pragma unroll 8
        for (int j = 0; j < 128; ++j) s += hl[j] * W[j * 64 + lane];
        asm volatile("s_waitcnt lgkmcnt(0)" ::: "memory"); __builtin_amdgcn_wave_barrier();
        const int bgi = rr / 511, n = rr % 511;
        if (idx == 0) { const float ss = wave_sum(s * s); const float kv = s * rsqrtf(ss * (1.f / 64.f) + EPS) * gk; ((bf16_t*)(p.ws + WS_KCB))[((size_t)bgi * 512 + n) * 64 + lane] = (bf16_t)f2bf(kv); }
        else { ((bf16_t*)(p.ws + WS_VCB))[((size_t)bgi * 512 + n) * 64 + lane] = (bf16_t)f2bf(s); }
    }
    if (blockIdx.x == 0 && otid() < 2 * 4 * 64) { const int i = otid(); bf16_t* dst = (bf16_t*)(p.ws + (i < 256 ? WS_KCB : WS_VCB)); dst[((size_t)((i & 255) >> 6) * 512 + 511) * 64 + (i & 63)] = 0; }
}

__device__ __forceinline__ void load_pstart(const Params& p, int l, int* ps) {
    const int* cnt = (const int*)(p.ws + WS_CNT) + l * 32;
    if (otid() == 0) { int s = 0; for (int e = 0; e < 32; ++e) { ps[e] = s; s += (cnt[e] + 255) & ~255; } ps[32] = s; }
    __syncthreads();
}


template <int MAP>
__device__ __forceinline__ void tr_tile(const float* W, int Nsrc, bf16_t* WT, int K, int k0, int n0, float* scr, int lane) {
    const int nl = (lane & 15) * 4, kr = lane >> 4;
    int sc = n0 + nl;
    if (MAP == 1) { sc = sc < 1280 ? sc : (sc < 2816 ? sc + 24 : (sc < 2840 ? sc - 2816 + 1280 : -1)); }
    float4 v[16];
#pragma unroll
    for (int it = 0; it < 16; ++it) { if (sc >= 0) { const float* src_ = W + (size_t)(k0 + it * 4 + kr) * Nsrc + sc; typedef float f4v __attribute__((ext_vector_type(4))); const f4v t_ = __builtin_nontemporal_load((const f4v*)src_); v[it] = make_float4(t_[0], t_[1], t_[2], t_[3]); } else v[it] = make_float4(0.f, 0.f, 0.f, 0.f); }
#pragma unroll
    for (int it = 0; it < 16; ++it) { float* s = scr + (it * 4 + kr) * 65 + nl; s[0] = v[it].x; s[1] = v[it].y; s[2] = v[it].z; s[3] = v[it].w; }
    asm volatile("s_waitcnt lgkmcnt(0)" ::: "memory"); __builtin_amdgcn_wave_barrier();
    const int c = lane & 7, nr = lane >> 3;
#pragma unroll
    for (int it = 0; it < 8; ++it) {
        const int n = it * 8 + nr; const float* s = scr + (8 * c) * 65 + n;
        uint4 o; o.x = pk2(s[0], s[65]); o.y = pk2(s[2 * 65], s[3 * 65]); o.z = pk2(s[4 * 65], s[5 * 65]); o.w = pk2(s[6 * 65], s[7 * 65]);
        *(uint4*)(WT + (size_t)(n0 + n) * K + k0 + 8 * c) = o;
    }
    asm volatile("s_waitcnt lgkmcnt(0)" ::: "memory"); __builtin_amdgcn_wave_barrier();
}
__device__ __forceinline__ void phase_convert(const Params& p, float* lds) {
    const int tid = otid(), lane = tid & 63, wave = tid >> 6;
    float* scr = lds + wave * (64 * 65);
    const int gw = blockIdx.x * NW + wave, ngw = gridDim.x * NW;
    bf16_t* WinT = (bf16_t*)(p.ws + WS_WINT); bf16_t* WoT = (bf16_t*)(p.ws + WS_WOT); bf16_t* W1T = (bf16_t*)(p.ws + WS_W1T); bf16_t* W2T = (bf16_t*)(p.ws + WS_W2T);
    constexpr int I_IN = L * 16 * (ZBW / 64), I_O = L * 16 * 16, I_1 = L * NE * 16 * 32, I_2 = L * NE * 16 * 16, I_C = L * 2 * 32 * 2;
    for (int it = gw; it < I_C + I_IN + I_O + I_1 + I_2; it += ngw) {
        int r = it;
        if (r < I_C) { const int li = r / 64, q = r % 64, kb = q / 2, nb = q % 2;
            tr_tile<0>(p.in[10] + (size_t)li * 2048 * 128, 128, (bf16_t*)(p.ws + WS_WCT) + (size_t)li * 128 * 2048, 2048, kb * 64, nb * 64, scr, lane); continue; }
        r -= I_C;
        if (r < I_IN) { const int l = r / (16 * 48), q = r % (16 * 48), kb = q / 48, nb = q % 48;
            tr_tile<1>(p.in[6] + (size_t)l * D * INW, INW, WinT + (size_t)l * ZBW * D, D, kb * 64, nb * 64, scr, lane); continue; }
        r -= I_IN;
        if (r < I_O) { const int l = r / 256, q = r % 256, kb = q / 16, nb = q % 16;
            tr_tile<0>(p.in[14] + (size_t)l * D * D, D, WoT + (size_t)l * D * D, D, kb * 64, nb * 64, scr, lane); continue; }
        r -= I_O;
        if (r < I_1) { const int le = r / 512, q = r % 512, kb = q / 32, nb = q % 32;
            tr_tile<0>(p.in[17] + (size_t)le * D * 2048, 2048, W1T + (size_t)le * 2048 * D, D, kb * 64, nb * 64, scr, lane); continue; }
        r -= I_1;
        { const int le = r / 256, q = r % 256, kb = q / 16, nb = q % 16;
            tr_tile<0>(p.in[19] + (size_t)le * DFF * D, D, W2T + (size_t)le * D * DFF, DFF, kb * 64, nb * 64, scr, lane); }
    }
    if (blockIdx.x == 0) { bf16_t* XN = (bf16_t*)(p.ws + WS_XN); for (int i = tid; i < D / 2; i += NT) ((unsigned*)(XN + (size_t)T * D))[i] = 0u; }
}

namespace pg8 {
#define PG8_LAS __attribute__((address_space(3)))
typedef short bf16x8 __attribute__((ext_vector_type(8)));
typedef float f32x4 __attribute__((ext_vector_type(4)));
typedef unsigned u32x4 __attribute__((ext_vector_type(4)));
constexpr int BM = 256, BK = 64, HALF = 128, HTB = HALF * BK * 2, STAGE_BYTES = 8 * HTB, NXCD = 8, WGM = 8;
__device__ __forceinline__ int lds_byte(int r, int c) { const int st = (r >> 4) * 2 + (c >> 5), rr = r & 15, cc = c & 31, ob = rr * 64 + cc * 2; return st * 1024 + (ob ^ (((ob >> 9) & 1) << 5)); }
__device__ __forceinline__ void stage_rc(int b, int& R, int& C) { const int st = b / 1024, sb = b % 1024, swz = sb ^ (((sb >> 9) & 1) << 5); R = (st >> 1) * 16 + swz / 64; C = (st & 1) * 32 + (swz % 64) / 2; }
__device__ __forceinline__ int perm32(int rho) { const int n = rho >> 4, i = rho & 15; return 8 * (i >> 2) + 4 * n + (i & 3); }
struct Unit { int pm, pn, e; };
__device__ __forceinline__ unsigned cvt_pk_bf16(float lo, float hi) { unsigned r; asm volatile("v_cvt_pk_bf16_f32 %0, %1, %2" : "=v"(r) : "v"(lo), "v"(hi)); return r; }

__device__ __forceinline__ bool static_next(int nM, int nN, int G, int c, int i, Unit& u) {
    const int nwg = nM * nN; const long Lq = (long)i * G + c; if (Lq >= nwg) return false;
    int wgid = (int)Lq; { const int q = nwg / NXCD, r = nwg % NXCD, xcd = wgid % NXCD, off = wgid / NXCD; wgid = (xcd < r ? xcd * (q + 1) : r * (q + 1) + (xcd - r) * q) + off; }
    const int nig = WGM * nN, gid = wgid / nig, fm = gid * WGM, gsz = (nM - fm) < WGM ? (nM - fm) : WGM;
    u.pm = fm + ((wgid % nig) % gsz); u.pn = (wgid % nig) / gsz; u.e = 0; return true;
}

template <class Prob, class Epi, bool ALIGN_EPI, bool SP2>
__device__ __forceinline__ void gemm_phase(PG8_LAS unsigned char* lds, const Prob& P, const Epi& E) {
    const int tid = otid(), wid = __builtin_amdgcn_readfirstlane(tid >> 6), lane = tid & 63, wr = wid >> 2, wc = wid & 3, fr = lane & 15, fq = lane >> 4;
    const int K = P.K, nt = Prob::KT > 0 ? Prob::KT : K / BK;
    int sR[2], sC[2]; unsigned voffB[2];
#pragma unroll
    for (int i = 0; i < 2; ++i) { stage_rc(tid * 16 + i * 8192, sR[i], sC[i]); voffB[i] = (unsigned)(P.b_row(sR[i]) * K + sC[i]) * 2u; }
    const size_t kstep = (size_t)(BK * 2);
    const size_t kstepA = P.a_kstep();
    const size_t hstepB = P.b_hstep();
    const unsigned ldsw = (unsigned)wid * 1024u;
    const int aoff = lds_byte(wr * 64 + fr, fq * 8), boff = lds_byte(wc * 32 + fr, fq * 8);
#define PG8_SA(b, h) (((b) * 2 + (h)) * HTB)
#define PG8_SB(b, h) ((4 + (b) * 2 + (h)) * HTB)
#define PG8_STAGE(bufoff, gbase, voff) do { _Pragma("unroll") for (int _i = 0; _i < 2; ++_i) \
        __builtin_amdgcn_global_load_lds((const unsigned*)((const char*)(gbase) + (voff)[_i]), (PG8_LAS unsigned*)(lds + (bufoff) + ldsw + _i * 8192), 16, 0, 0); } while (0)
#define PG8_STAGE_SEL(bufoff, gbase, h) do { _Pragma("unroll") for (int _i = 0; _i < 2; ++_i) { unsigned _vo = vAc[h][_i]; if constexpr (Prob::GATHER) _vo = last ? vAn[h][_i] : _vo; \
        __builtin_amdgcn_global_load_lds((const unsigned*)((const char*)(gbase) + _vo), (PG8_LAS unsigned*)(lds + (bufoff) + ldsw + _i * 8192), 16, 0, 0); } } while (0)
#define PG8_LDA(dst, b, h) do { _Pragma("unroll") for (int m = 0; m < 4; ++m) _Pragma("unroll") for (int k = 0; k < 2; ++k) dst[m][k] = *(const PG8_LAS bf16x8*)(lds + PG8_SA(b, h) + aoff + m * 2048 + k * 1024); } while (0)
#define PG8_LDB(dst, b, h) do { _Pragma("unroll") for (int n = 0; n < 2; ++n) _Pragma("unroll") for (int k = 0; k < 2; ++k) dst[n][k] = *(const PG8_LAS bf16x8*)(lds + PG8_SB(b, h) + boff + n * 2048 + k * 1024); } while (0)
#define PG8_MMA(ai, bj, At, Bt) do { __builtin_amdgcn_s_setprio(1); _Pragma("unroll") for (int m = 0; m < 4; ++m) _Pragma("unroll") for (int n = 0; n < 2; ++n) _Pragma("unroll") for (int k = 0; k < 2; ++k) \
        acc[ai][bj][m][n] = __builtin_amdgcn_mfma_f32_16x16x32_bf16(Bt[n][k], At[m][k], acc[ai][bj][m][n], 0, 0, 0); __builtin_amdgcn_s_setprio(0); } while (0)
#define PG8_WAIT_V(n) asm volatile("s_waitcnt vmcnt(" #n ")" ::: "memory")
#define PG8_WAIT_L(n) asm volatile("s_waitcnt lgkmcnt(" #n ")" ::: "memory")
#define PG8_BAR __builtin_amdgcn_s_barrier()
#define PG8_SCHED __builtin_amdgcn_sched_barrier(0)
    Unit cur, nxt; int ui = 0;
    if (!P.next(0, cur)) return;
    nxt = cur;
    f32x4 acc[2][2][4][2];
    typename Epi::Pre pre;
    E.prefetch(cur, wc, fq, pre); E.init(acc, pre);
    bf16x8 At[4][2], B0[2][2], B1[2][2];
    unsigned vAc[2][2], vAn[2][2];
    const char* cA = P.a_base(cur); const char* cB = P.b_base(cur);
    P.a_voff(cur, sR, sC, vAc);
#pragma unroll
    for (int h = 0; h < 2; ++h)
#pragma unroll
        for (int i = 0; i < 2; ++i) vAn[h][i] = vAc[h][i];
    if constexpr (SP2) {
        PG8_STAGE(PG8_SB(0, 0), cB, voffB); PG8_STAGE(PG8_SB(0, 1), cB + hstepB, voffB); PG8_STAGE(PG8_SA(0, 0), cA, vAc[0]); PG8_STAGE(PG8_SA(0, 1), cA, vAc[1]);
        if (wr == 1) PG8_BAR;
        PG8_WAIT_V(2); PG8_BAR;
        PG8_STAGE(PG8_SB(1, 0), cB + kstep, voffB); PG8_STAGE(PG8_SA(1, 0), cA + kstepA, vAc[0]); PG8_STAGE(PG8_SB(1, 1), cB + hstepB + kstep, voffB);
        PG8_WAIT_V(6); PG8_BAR;
    } else {
        PG8_STAGE(PG8_SB(0, 0), cB, voffB); PG8_STAGE(PG8_SA(0, 0), cA, vAc[0]); PG8_STAGE(PG8_SB(0, 1), cB + hstepB, voffB); PG8_STAGE(PG8_SA(0, 1), cA, vAc[1]);
        if (wr == 1) PG8_BAR;
        PG8_WAIT_V(4); PG8_BAR;
        PG8_STAGE(PG8_SB(1, 0), cB + kstep, voffB); PG8_STAGE(PG8_SA(1, 0), cA + kstepA, vAc[0]); PG8_STAGE(PG8_SB(1, 1), cB + hstepB + kstep, voffB);
        PG8_WAIT_V(6); PG8_BAR;
    }
    for (;;) {
        const bool has_next = P.next(ui + 1, nxt);
        const char* nA = cA; const char* nB = cB;
        if (has_next) { nA = P.a_base(nxt); nB = P.b_base(nxt); if constexpr (Prob::GATHER) P.a_voff(nxt, sR, sC, vAn); }
        for (int t = 0; t < nt; t += 2) {
            const bool last = (t == nt - 2);
            const char* a1 = cA + (size_t)(t + 1) * kstepA;
            const char* a2 = last ? nA : cA + (size_t)(t + 2) * kstepA; const char* b2 = last ? nB : cB + (size_t)(t + 2) * kstep;
            const char* a3 = a2 + kstepA; const char* b3 = b2 + kstep;
            if constexpr (SP2) {
            PG8_LDB(B0, 0, 0); PG8_LDB(B1, 0, 1); PG8_SCHED; PG8_LDA(At, 0, 0); PG8_STAGE(PG8_SA(1, 1), a1, vAc[1]);
            PG8_WAIT_V(8); PG8_WAIT_L(0); PG8_BAR; PG8_MMA(0, 0, At, B0); PG8_MMA(0, 1, At, B1); PG8_BAR; PG8_SCHED;
            PG8_LDA(At, 0, 1); PG8_STAGE(PG8_SB(0, 0), b2, voffB); PG8_STAGE(PG8_SB(0, 1), b2 + hstepB, voffB); PG8_STAGE_SEL(PG8_SA(0, 0), a2, 0);
            PG8_WAIT_V(8); PG8_WAIT_L(0); PG8_BAR; PG8_MMA(1, 0, At, B0); PG8_MMA(1, 1, At, B1); PG8_BAR; PG8_SCHED;
            PG8_LDB(B0, 1, 0); PG8_LDB(B1, 1, 1); PG8_SCHED; PG8_LDA(At, 1, 0); PG8_STAGE_SEL(PG8_SA(0, 1), a2, 1);
            PG8_WAIT_V(8); PG8_WAIT_L(0); PG8_BAR; PG8_MMA(0, 0, At, B0); PG8_MMA(0, 1, At, B1); PG8_BAR; PG8_SCHED;
            PG8_LDA(At, 1, 1); PG8_STAGE(PG8_SB(1, 0), b3, voffB); PG8_STAGE(PG8_SB(1, 1), b3 + hstepB, voffB); PG8_STAGE_SEL(PG8_SA(1, 0), a3, 0);
            PG8_WAIT_V(8); PG8_WAIT_L(0); PG8_BAR; PG8_MMA(1, 0, At, B0); PG8_MMA(1, 1, At, B1); PG8_BAR; PG8_SCHED;
            } else {
            PG8_LDB(B0, 0, 0); PG8_SCHED; PG8_LDA(At, 0, 0); PG8_STAGE(PG8_SA(1, 1), a1, vAc[1]);
            PG8_WAIT_L(8); PG8_BAR; PG8_WAIT_L(0); PG8_MMA(0, 0, At, B0); PG8_BAR; PG8_SCHED;
            PG8_LDB(B1, 0, 1); PG8_STAGE(PG8_SB(0, 0), b2, voffB);
            PG8_BAR; PG8_WAIT_L(0); PG8_MMA(0, 1, At, B1); PG8_BAR;
            PG8_LDA(At, 0, 1); PG8_STAGE_SEL(PG8_SA(0, 0), a2, 0);
            PG8_BAR; PG8_WAIT_L(0); PG8_MMA(1, 0, At, B0); PG8_BAR; PG8_SCHED;
            PG8_STAGE(PG8_SB(0, 1), b2 + hstepB, voffB);
            PG8_WAIT_V(6); PG8_BAR; PG8_MMA(1, 1, At, B1); PG8_BAR;
            PG8_LDB(B0, 1, 0); PG8_SCHED; PG8_LDA(At, 1, 0); PG8_STAGE_SEL(PG8_SA(0, 1), a2, 1);
            PG8_WAIT_L(8); PG8_BAR; PG8_WAIT_L(0); PG8_MMA(0, 0, At, B0); PG8_BAR; PG8_SCHED;
            PG8_LDB(B1, 1, 1); PG8_STAGE(PG8_SB(1, 0), b3, voffB);
            PG8_BAR; PG8_WAIT_L(0); PG8_MMA(0, 1, At, B1); PG8_BAR;
            PG8_LDA(At, 1, 1); PG8_STAGE_SEL(PG8_SA(1, 0), a3, 0);
            PG8_BAR; PG8_WAIT_L(0); PG8_MMA(1, 0, At, B0); PG8_BAR; PG8_SCHED;
            PG8_STAGE(PG8_SB(1, 1), b3 + hstepB, voffB);
            PG8_WAIT_V(6); PG8_BAR; PG8_MMA(1, 1, At, B1); PG8_BAR;
            }
        }
        if constexpr (ALIGN_EPI) { if (wr == 0) PG8_BAR; }
        E(acc, cur, wr, wc, fr, fq, has_next, nxt, pre);
        if (!has_next) break;
        E.init(acc, pre);
        cur = nxt; cA = nA; cB = nB; ++ui;
        if constexpr (Prob::GATHER) {
#pragma unroll
            for (int h = 0; h < 2; ++h)
#pragma unroll
                for (int i = 0; i < 2; ++i) vAc[h][i] = vAn[h][i];
        }
        if constexpr (ALIGN_EPI) { if (wr == 1) PG8_BAR; }
    }
    PG8_WAIT_V(0);
    if constexpr (!ALIGN_EPI) { if (wr == 0) PG8_BAR; }
    PG8_BAR;
#undef PG8_SA
#undef PG8_SB
#undef PG8_STAGE
#undef PG8_STAGE_SEL
#undef PG8_LDA
#undef PG8_LDB
#undef PG8_MMA
#undef PG8_WAIT_V
#undef PG8_WAIT_L
#undef PG8_BAR
#undef PG8_SCHED
}

struct ProbDense { static constexpr bool GATHER = false; static constexpr int KT = 0;
    const bf16_t* A; const bf16_t* Bt; int K, nM, nN, G, c; bool headperm;
    __device__ __forceinline__ bool next(int i, Unit& u) const { return static_next(nM, nN, G, c, i, u); }
    __device__ __forceinline__ const char* a_base(const Unit& u) const { return (const char*)(A + (size_t)u.pm * BM * K); }
    __device__ __forceinline__ void a_voff(const Unit&, const int (&R)[2], const int (&C)[2], unsigned (&v)[2][2]) const {
#pragma unroll
        for (int h = 0; h < 2; ++h)
#pragma unroll
            for (int i = 0; i < 2; ++i) v[h][i] = (unsigned)((h * HALF + R[i]) * K + C[i]) * 2u;
    }
    __device__ __forceinline__ const char* b_base(const Unit& u) const { return (const char*)(Bt + (size_t)u.pn * BM * K); }
    __device__ __forceinline__ size_t a_kstep() const { return (size_t)BK * 2; }
    __device__ __forceinline__ size_t b_hstep() const { return headperm ? (size_t)32 * K * 2 : (size_t)HALF * K * 2; }
    __device__ __forceinline__ int b_row(int R) const { return headperm ? ((R >> 5) * 64 + perm32(R & 31)) : ((R & ~31) + perm32(R & 31)); }
};
typedef const PG8_LAS int* lds_ints;
__device__ __forceinline__ int expert_of(lds_ints ps, int pm) { int e = 0;
#pragma unroll
    for (int i = 1; i < 32; ++i) if (ps[i] <= pm * 256) e = i;
    return __builtin_amdgcn_readfirstlane(e); }
struct ProbMoe1 { static constexpr bool GATHER = true; static constexpr int KT = 0;
    const bf16_t* XN; const bf16_t* W1T; const int* rowtok; lds_ints ps; int K, ntm, G, c;
    __device__ __forceinline__ bool next(int i, Unit& u) const { const int q = i * G + c; if (q >= ntm * 8) return false; u.pm = q >> 3; u.pn = q & 7; u.e = expert_of(ps, u.pm); return true; }
    __device__ __forceinline__ const char* a_base(const Unit&) const { return (const char*)XN; }
    __device__ __forceinline__ void a_voff(const Unit& u, const int (&R)[2], const int (&C)[2], unsigned (&v)[2][2]) const {
#pragma unroll
        for (int h = 0; h < 2; ++h)
#pragma unroll
            for (int i = 0; i < 2; ++i) { int tk = rowtok[u.pm * BM + h * HALF + R[i]]; if (tk < 0) tk = T; v[h][i] = (unsigned)(tk * K + C[i]) * 2u; }
    }
    __device__ __forceinline__ const char* b_base(const Unit& u) const { return (const char*)(W1T + ((size_t)u.e * 2048 + u.pn * 128) * K); }
    __device__ __forceinline__ size_t a_kstep() const { return (size_t)BK * 2; }
    __device__ __forceinline__ size_t b_hstep() const { return (size_t)1024 * K * 2; }
    __device__ __forceinline__ int b_row(int R) const { return (R & ~31) + perm32(R & 31); }
};
struct ProbMoe2 { static constexpr bool GATHER = false; static constexpr int KT = 0;
    const bf16_t* ACT; const bf16_t* W2T; lds_ints ps; int K, ntm, G, c;
    __device__ __forceinline__ bool next(int i, Unit& u) const { const int q = i * G + c; if (q >= ntm * 4) return false; u.pm = q >> 2; u.pn = q & 3; u.e = expert_of(ps, u.pm); return true; }
    __device__ __forceinline__ const char* a_base(const Unit& u) const { return (const char*)(ACT + (size_t)u.pm * BM * K); }
    __device__ __forceinline__ void a_voff(const Unit&, const int (&R)[2], const int (&C)[2], unsigned (&v)[2][2]) const {
#pragma unroll
        for (int h = 0; h < 2; ++h)
#pragma unroll
            for (int i = 0; i < 2; ++i) v[h][i] = (unsigned)((h * HALF + R[i]) * K + C[i]) * 2u;
    }
    __device__ __forceinline__ const char* b_base(const Unit& u) const { return (const char*)(W2T + ((size_t)u.e * 1024 + u.pn * BM) * K); }
    __device__ __forceinline__ size_t a_kstep() const { return (size_t)BK * 2; }
    __device__ __forceinline__ size_t b_hstep() const { return (size_t)HALF * K * 2; }
    __device__ __forceinline__ int b_row(int R) const { return (R & ~31) + perm32(R & 31); }
};

struct ProbCmp { static constexpr bool GATHER = false; static constexpr int KT = 8;
    const bf16_t* ZB; const bf16_t* W1T; int K, G, c;
    __device__ __forceinline__ bool next(int i, Unit& u) const { const int q = i * G + c; if (q >= 64) return false; u.pm = q & 15; u.pn = 0; u.e = q >> 4; return true; }
    __device__ __forceinline__ const char* a_base(const Unit& u) const { const int idx = u.pm >> 3, bg = (u.pm >> 1) & 3, half = u.pm & 1;
        return (const char*)(ZB + ((size_t)(bg >> 1) * S + 16 * 256 * half + 8 * u.e) * ZBW + ZB_KC + idx * 128 + (bg & 1) * 64); }
    __device__ __forceinline__ void a_voff(const Unit&, const int (&R)[2], const int (&C)[2], unsigned (&v)[2][2]) const {
#pragma unroll
        for (int h = 0; h < 2; ++h)
#pragma unroll
            for (int i = 0; i < 2; ++i) v[h][i] = (unsigned)(16 * (h * HALF + R[i]) * ZBW + C[i]) * 2u;
    }
    __device__ __forceinline__ size_t a_kstep() const { return (size_t)ZBW * 2; }
    __device__ __forceinline__ const char* b_base(const Unit& u) const { return (const char*)(W1T + (size_t)(u.pm >> 3) * 128 * K + 8 * 64 * u.e); }
    __device__ __forceinline__ size_t b_hstep() const { return 0; }
    __device__ __forceinline__ int b_row(int R) const { return (R & ~31) + perm32(R & 31); }
};
struct EpiCmp {
    float* HIDP;
    struct Pre {};
    __device__ __forceinline__ void prefetch(const Unit&, int, int, Pre&) const {}
    __device__ __forceinline__ void init(f32x4 (&acc)[2][2][4][2], const Pre&) const {
#pragma unroll
        for (int a = 0; a < 2; ++a)
#pragma unroll
            for (int b = 0; b < 2; ++b)
#pragma unroll
                for (int m = 0; m < 4; ++m)
#pragma unroll
                    for (int n = 0; n < 2; ++n) acc[a][b][m][n] = (f32x4){0.f, 0.f, 0.f, 0.f};
    }
    __device__ __forceinline__ void operator()(const f32x4 (&acc)[2][2][4][2], const Unit& u, int wr, int wc, int fr, int fq, bool has_next, const Unit& nxt, Pre& pre) const {
        const int idx = u.pm >> 3, bg = (u.pm >> 1) & 3, half = u.pm & 1;
        const int c0 = 32 * wc + 8 * fq;
#pragma unroll
        for (int ai = 0; ai < 2; ++ai)
#pragma unroll
            for (int m = 0; m < 4; ++m) { const int n = 256 * half + ai * HALF + wr * 64 + m * 16 + fr;
                if (n < 511) { float* dst = HIDP + (((size_t)u.e * 2 + idx) * 2044 + bg * 511 + n) * 128 + c0;
                    *(f32x4*)dst = acc[ai][0][m][0]; *(f32x4*)(dst + 4) = acc[ai][0][m][1]; } }
    }
};
struct EpiG1F {
    bf16_t* ZB; float* GATE; const float* gq; const float* gk; const float* gmq; const float* gmk;
    struct Pre {};
    __device__ __forceinline__ void prefetch(const Unit&, int, int, Pre&) const {}
    __device__ __forceinline__ void init(f32x4 (&acc)[2][2][4][2], const Pre&) const {
#pragma unroll
        for (int a = 0; a < 2; ++a)
#pragma unroll
            for (int b = 0; b < 2; ++b)
#pragma unroll
                for (int m = 0; m < 4; ++m)
#pragma unroll
                    for (int n = 0; n < 2; ++n) acc[a][b][m][n] = (f32x4){0.f, 0.f, 0.f, 0.f};
    }
    __device__ __forceinline__ void operator()(const f32x4 (&acc)[2][2][4][2], const Unit& u, int wr, int wc, int fr, int fq, bool has_next, const Unit& nxt, Pre& pre) const {
        const int pn = u.pn;
        const float* gain = nullptr; float sc = 1.f;
        if (pn < 2) { gain = gq; sc = QSCALE; }
        else if (pn == 3 || pn == 4) { if (wc < 2) gain = gk; }
        else if (pn == 5 || pn == 6) { gain = gmq; sc = QSCALE; }
        else if (pn == 7 || pn == 8) { gain = gmk; }
        if (pn == 11) {
            if (wc == 0 && fq < 3) {
#pragma unroll
                for (int ai = 0; ai < 2; ++ai)
#pragma unroll
                    for (int m = 0; m < 4; ++m) { const size_t r = (size_t)u.pm * BM + ai * HALF + wr * 64 + m * 16 + fr;
#pragma unroll
                        for (int n = 0; n < 2; ++n) { const f32x4 v = acc[ai][0][m][n]; f32x4 o;
#pragma unroll
                            for (int i = 0; i < 4; ++i) o[i] = __builtin_amdgcn_rcpf(1.f + __builtin_amdgcn_exp2f(-LOG2E * v[i]));
                            *(f32x4*)(GATE + r * 32 + 8 * fq + 4 * n) = o; } }
            }
            return;
        }
        f32x4 gv[2][2];
#pragma unroll
        for (int bj = 0; bj < 2; ++bj)
#pragma unroll
            for (int n = 0; n < 2; ++n) gv[bj][n] = gain ? *(const f32x4*)(gain + 32 * bj + 8 * fq + 4 * n) * sc : (f32x4){1.f, 1.f, 1.f, 1.f};
#pragma unroll
        for (int ai = 0; ai < 2; ++ai)
#pragma unroll
            for (int m = 0; m < 4; ++m) { const size_t r = (size_t)u.pm * BM + ai * HALF + wr * 64 + m * 16 + fr;
                float rs = 1.f;
                if (gain) { float ss = 0.f;
#pragma unroll
                    for (int bj = 0; bj < 2; ++bj)
#pragma unroll
                        for (int n = 0; n < 2; ++n) { const f32x4 v = acc[ai][bj][m][n]; ss += (v[0] * v[0] + v[1] * v[1]) + (v[2] * v[2] + v[3] * v[3]); }
                    ss += __shfl_xor(ss, 16); ss += __shfl_xor(ss, 32);
                    rs = rsqrtf(ss * (1.f / 64.f) + EPS); }
#pragma unroll
                for (int bj = 0; bj < 2; ++bj) { const f32x4 a = acc[ai][bj][m][0] * gv[bj][0] * rs, b = acc[ai][bj][m][1] * gv[bj][1] * rs;
                    u32x4 w; w.x = cvt_pk_bf16(a[0], a[1]); w.y = cvt_pk_bf16(a[2], a[3]); w.z = cvt_pk_bf16(b[0], b[1]); w.w = cvt_pk_bf16(b[2], b[3]);
                    *(u32x4*)(ZB + r * ZBW + pn * BM + 64 * wc + 32 * bj + 8 * fq) = w; } }
    }
};
struct EpiG2 {
    const float* xin32; bf16_t* XAB; const float* g1;
    struct Pre {};
    __device__ __forceinline__ void prefetch(const Unit&, int, int, Pre&) const {}
    __device__ __forceinline__ void init(f32x4 (&acc)[2][2][4][2], const Pre&) const {
#pragma unroll
        for (int a = 0; a < 2; ++a)
#pragma unroll
            for (int b = 0; b < 2; ++b)
#pragma unroll
                for (int m = 0; m < 4; ++m)
#pragma unroll
                    for (int n = 0; n < 2; ++n) acc[a][b][m][n] = (f32x4){0.f, 0.f, 0.f, 0.f};
    }
    __device__ __forceinline__ void operator()(const f32x4 (&acc)[2][2][4][2], const Unit& u, int wr, int wc, int fr, int fq, bool has_next, const Unit& nxt, Pre& pre) const {
#pragma unroll
        for (int ai = 0; ai < 2; ++ai)
#pragma unroll
            for (int m = 0; m < 4; ++m) { const size_t r = (size_t)u.pm * BM + ai * HALF + wr * 64 + m * 16 + fr; const int b = (int)(r / S);
#pragma unroll
                for (int bj = 0; bj < 2; ++bj) { const int c = u.pn * BM + 128 * bj + 32 * wc + 8 * fq;
                    f32x4 x0, x1;
                    if (xin32) { x0 = *(const f32x4*)(xin32 + r * D + c); x1 = *(const f32x4*)(xin32 + r * D + c + 4); }
                    else { const u32x4 q = *(const u32x4*)(XAB + r * D + c);
                        x0 = (f32x4){__builtin_bit_cast(float, q.x << 16), __builtin_bit_cast(float, q.x & 0xffff0000u), __builtin_bit_cast(float, q.y << 16), __builtin_bit_cast(float, q.y & 0xffff0000u)};
                        x1 = (f32x4){__builtin_bit_cast(float, q.z << 16), __builtin_bit_cast(float, q.z & 0xffff0000u), __builtin_bit_cast(float, q.w << 16), __builtin_bit_cast(float, q.w & 0xffff0000u)}; }
                    const f32x4 g0 = *(const f32x4*)(g1 + (size_t)b * 6144 + c), g1v = *(const f32x4*)(g1 + (size_t)b * 6144 + c + 4);
                    const f32x4 y0 = x0 + g0 * acc[ai][bj][m][0], y1 = x1 + g1v * acc[ai][bj][m][1];
                    u32x4 o; o.x = cvt_pk_bf16(y0[0], y0[1]); o.y = cvt_pk_bf16(y0[2], y0[3]); o.z = cvt_pk_bf16(y1[0], y1[1]); o.w = cvt_pk_bf16(y1[2], y1[3]);
                    *(u32x4*)(XAB + r * D + c) = o; } }
    }
};
struct EpiM1 {
    bf16_t* ACT; const float* b1l;
    struct Pre { f32x4 bg[2], bl[2]; };
    __device__ __forceinline__ void prefetch(const Unit& u, int wc, int fq, Pre& q) const {
        const float* b1 = b1l + (size_t)u.e * 2048 + u.pn * 128 + 32 * wc + 8 * fq;
#pragma unroll
        for (int n = 0; n < 2; ++n) { q.bg[n] = *(const f32x4*)(b1 + 4 * n); q.bl[n] = *(const f32x4*)(b1 + 1024 + 4 * n); }
    }
    __device__ __forceinline__ void init(f32x4 (&acc)[2][2][4][2], const Pre& q) const {
#pragma unroll
        for (int a = 0; a < 2; ++a)
#pragma unroll
            for (int m = 0; m < 4; ++m)
#pragma unroll
                for (int n = 0; n < 2; ++n) { acc[a][0][m][n] = q.bg[n]; acc[a][1][m][n] = q.bl[n]; }
    }
    __device__ __forceinline__ void operator()(const f32x4 (&acc)[2][2][4][2], const Unit& u, int wr, int wc, int fr, int fq, bool has_next, const Unit& nxt, Pre& pre) const {
        const int c0 = u.pn * 128 + 32 * wc + 8 * fq;
#pragma unroll
        for (int ai = 0; ai < 2; ++ai) {
            if (ai == 1) { __builtin_amdgcn_sched_barrier(0); prefetch(nxt, wc, fq, pre); __builtin_amdgcn_sched_barrier(0); }
#pragma unroll
            for (int m = 0; m < 4; ++m) { const size_t r = (size_t)u.pm * BM + ai * HALF + wr * 64 + m * 16 + fr;
                float o[8];
#pragma unroll
                for (int n = 0; n < 2; ++n) { const f32x4 g = acc[ai][0][m][n], li = acc[ai][1][m][n];
#pragma unroll
                    for (int i = 0; i < 4; ++i) { const float gc = fminf(g[i], 7.f), lc = __builtin_amdgcn_fmed3f(li[i], -7.f, 7.f);
                        o[4 * n + i] = (lc + 1.f) * (gc * __builtin_amdgcn_rcpf(1.f + __builtin_amdgcn_exp2f((-1.702f * LOG2E) * gc))); } }
                u32x4 w; w.x = cvt_pk_bf16(o[0], o[1]); w.y = cvt_pk_bf16(o[2], o[3]); w.z = cvt_pk_bf16(o[4], o[5]); w.w = cvt_pk_bf16(o[6], o[7]);
                *(u32x4*)(ACT + r * DFF + c0) = w; }
        }
    }
};
struct EpiM2 {
    bf16_t* Y; const float* b2l;
    struct Pre { f32x4 b[2][2]; };
    __device__ __forceinline__ void prefetch(const Unit& u, int wc, int fq, Pre& q) const {
        const float* b2 = b2l + (size_t)u.e * D + u.pn * BM + 32 * wc + 8 * fq;
#pragma unroll
        for (int bj = 0; bj < 2; ++bj)
#pragma unroll
            for (int n = 0; n < 2; ++n) q.b[bj][n] = *(const f32x4*)(b2 + 128 * bj + 4 * n);
    }
    __device__ __forceinline__ void init(f32x4 (&acc)[2][2][4][2], const Pre& q) const {
#pragma unroll
        for (int a = 0; a < 2; ++a)
#pragma unroll
            for (int bj = 0; bj < 2; ++bj)
#pragma unroll
                for (int m = 0; m < 4; ++m)
#pragma unroll
                    for (int n = 0; n < 2; ++n) acc[a][bj][m][n] = q.b[bj][n];
    }
    __device__ __forceinline__ void operator()(const f32x4 (&acc)[2][2][4][2], const Unit& u, int wr, int wc, int fr, int fq, bool has_next, const Unit& nxt, Pre& pre) const {
#pragma unroll
        for (int ai = 0; ai < 2; ++ai) {
            if (ai == 1) { __builtin_amdgcn_sched_barrier(0); prefetch(nxt, wc, fq, pre); __builtin_amdgcn_sched_barrier(0); }
#pragma unroll
            for (int m = 0; m < 4; ++m) { const size_t r = (size_t)u.pm * BM + ai * HALF + wr * 64 + m * 16 + fr;
#pragma unroll
                for (int bj = 0; bj < 2; ++bj) { const int c = u.pn * BM + 128 * bj + 32 * wc + 8 * fq;
                    const f32x4 v0 = acc[ai][bj][m][0], v1 = acc[ai][bj][m][1];
                    u32x4 o; o.x = cvt_pk_bf16(v0[0], v0[1]); o.y = cvt_pk_bf16(v0[2], v0[3]); o.z = cvt_pk_bf16(v1[0], v1[1]); o.w = cvt_pk_bf16(v1[2], v1[3]);
                    *(u32x4*)(Y + r * D + c) = o; } }
        }
    }
};
}

__device__ __forceinline__ void phase_g1_fast(const Params& p, int l, unsigned char* lds_raw) {
    pg8::ProbDense P{(const bf16_t*)(p.ws + WS_XN), (const bf16_t*)(p.ws + WS_WINT) + (size_t)l * ZBW * D, D, T / 256, ZBW / 256, (int)gridDim.x, (int)blockIdx.x, true};
    pg8::EpiG1F E{(bf16_t*)(p.ws + WS_ZB), (float*)(p.ws + WS_GATE), p.in[7] + l * 64, p.in[8] + l * 64, p.in[12] + l * 64, p.in[13] + l * 64};
    pg8::gemm_phase<pg8::ProbDense, pg8::EpiG1F, true, true>((PG8_LAS unsigned char*)lds_raw, P, E);
}
__device__ __forceinline__ void phase_g2_fast(const Params& p, int l, unsigned char* lds_raw) {
    pg8::ProbDense P{(const bf16_t*)(p.ws + WS_ATTB), (const bf16_t*)(p.ws + WS_WOT) + (size_t)l * D * D, D, T / 256, D / 256, (int)gridDim.x, (int)blockIdx.x, false};
    pg8::EpiG2 E{l == 0 ? p.in[0] : (const float*)nullptr, (bf16_t*)(p.ws + WS_XAB), (const float*)(p.ws + WS_MOD) + (size_t)l * Bn * 6144 + 2 * D};
    pg8::gemm_phase<pg8::ProbDense, pg8::EpiG2, true, true>((PG8_LAS unsigned char*)lds_raw, P, E);
}
constexpr int LDS_PS_OFF = 131072;
__device__ __forceinline__ void phase_ck_fast(const Params& p, int l, unsigned char* lds_raw) {
    pg8::ProbCmp P{(const bf16_t*)(p.ws + WS_ZB), (const bf16_t*)(p.ws + WS_WCT) + (size_t)l * 2 * 128 * 2048, 2048, (int)gridDim.x, (int)blockIdx.x};
    pg8::EpiCmp E{(float*)(p.ws + WS_HIDP)};
    pg8::gemm_phase<pg8::ProbCmp, pg8::EpiCmp, true, true>((PG8_LAS unsigned char*)lds_raw, P, E);
    { const int tid = otid(), lane = tid & 63, wave = tid >> 6, r8 = lane >> 3, c8 = lane & 7;
      const bf16_t* Z = (const bf16_t*)(p.ws + WS_ZB); bf16_t* KMB = (bf16_t*)(p.ws + WS_KMB);
      float* part = (float*)(lds_raw + 131072 + 512);
      for (int it0 = blockIdx.x * 2; it0 < Bn * 8 * 32; it0 += gridDim.x * 2) {
          const int it = it0 + (wave >> 2), q = wave & 3;
          const int b = it / 256, h = (it / 32) & 7, blk = it & 31;
          const bf16_t* base = Z + (size_t)(b * S + blk * 256 + q * 64 + r8) * ZBW + ZB_MK + h * 64 + c8 * 8;
          float s[8] = {0.f, 0.f, 0.f, 0.f, 0.f, 0.f, 0.f, 0.f};
          uint4 v[8];
#pragma unroll
          for (int i = 0; i < 8; ++i) v[i] = *(const uint4*)(base + (size_t)(8 * i) * ZBW);
#pragma unroll
          for (int i = 0; i < 8; ++i) { const unsigned w[4] = {v[i].x, v[i].y, v[i].z, v[i].w};
#pragma unroll
              for (int e = 0; e < 4; ++e) { s[2 * e] += __builtin_bit_cast(float, w[e] << 16); s[2 * e + 1] += __builtin_bit_cast(float, w[e] & 0xffff0000u); } }
#pragma unroll
          for (int e = 0; e < 8; ++e) { s[e] += __shfl_xor(s[e], 8); s[e] += __shfl_xor(s[e], 16); s[e] += __shfl_xor(s[e], 32); }
          if (r8 == 0) {
#pragma unroll
              for (int e = 0; e < 8; ++e) part[wave * 64 + c8 * 8 + e] = s[e]; }
          __syncthreads();
          if (tid < 128) { const int item = tid >> 6, d = tid & 63; const float* pp = part + item * 256 + d;
              KMB[(size_t)(it0 + item) * 64 + d] = (bf16_t)f2bf((((pp[0] + pp[64]) + pp[128]) + pp[192]) * (1.f / 256.f)); }
          __syncthreads();
      } }
}
__device__ __forceinline__ void phase_m1_fast(const Params& p, int l, unsigned char* lds_raw) {
    int* ps = (int*)(lds_raw + LDS_PS_OFF);
    load_pstart(p, l, ps);
    pg8::ProbMoe1 P{(const bf16_t*)(p.ws + WS_XN), (const bf16_t*)(p.ws + WS_W1T) + (size_t)l * NE * 2048 * D, (const int*)(p.ws + WS_ROWTOK) + (size_t)l * RMAX, (pg8::lds_ints)ps, D, ps[32] / 256, (int)gridDim.x, (int)blockIdx.x};
    pg8::EpiM1 E{(bf16_t*)(p.ws + WS_ACT), p.in[18] + (size_t)l * NE * 2048};
    pg8::gemm_phase<pg8::ProbMoe1, pg8::EpiM1, true, true>((PG8_LAS unsigned char*)lds_raw, P, E);
    __syncthreads();
}
__device__ __forceinline__ void phase_m2_fast(const Params& p, int l, unsigned char* lds_raw) {
    int* ps = (int*)(lds_raw + LDS_PS_OFF);
    load_pstart(p, l, ps);
    pg8::ProbMoe2 P{(const bf16_t*)(p.ws + WS_ACT), (const bf16_t*)(p.ws + WS_W2T) + (size_t)l * NE * D * DFF, (pg8::lds_ints)ps, DFF, ps[32] / 256, (int)gridDim.x, (int)blockIdx.x};
    pg8::EpiM2 E{(bf16_t*)(p.ws + WS_Y), p.in[20] + (size_t)l * NE * D};
    pg8::gemm_phase<pg8::ProbMoe2, pg8::EpiM2, true, true>((PG8_LAS unsigned char*)lds_raw, P, E);
    __syncthreads();
}

namespace at {
#define AT_LAS __attribute__((address_space(3)))
typedef short bf16x8 __attribute__((ext_vector_type(8)));
typedef short s16x4 __attribute__((ext_vector_type(4)));
typedef short v4i16_t __attribute__((ext_vector_type(4)));
typedef float f32x16 __attribute__((ext_vector_type(16)));
typedef unsigned u32x4 __attribute__((ext_vector_type(4)));
typedef float f32x2_t __attribute__((ext_vector_type(2))); typedef __bf16 bf16x2_t __attribute__((ext_vector_type(2)));
typedef AT_LAS unsigned char* lp;
constexpr int L_K = 0  , L_V = 32768  , L_WSF = 65536, L_OST = 67584  , L_SELM = 133120, L_UNI = 134144, L_KMT = 134400, L_END = 142592;
constexpr float NEGS = -1e30f;
__device__ __forceinline__ int crow(int r, int hi) { return (r & 3) + 8 * (r >> 2) + 4 * hi; }
__device__ __forceinline__ unsigned cvtpk(float lo, float hi) { f32x2_t v = {lo, hi}; bf16x2_t b = __builtin_convertvector(v, bf16x2_t); return __builtin_bit_cast(unsigned, b); }
__device__ __forceinline__ float mx3(float a, float b, float c) { return __builtin_fmaxf(__builtin_fmaxf(a, b), c); }
__device__ __forceinline__ void wsync() { asm volatile("s_waitcnt lgkmcnt(0)" ::: "memory"); __builtin_amdgcn_wave_barrier(); }
__device__ __forceinline__ void bar() { __builtin_amdgcn_s_barrier(); }
#define AT_WAITV(n) asm volatile("s_waitcnt vmcnt(" #n ")" ::: "memory")
#define AT_WAITL() asm volatile("s_waitcnt lgkmcnt(0)" ::: "memory")
__device__ __forceinline__ void glds(const void* g, lp dst) { __builtin_amdgcn_global_load_lds((const unsigned*)g, (AT_LAS unsigned*)dst, 16, 0, 0); }
__device__ __forceinline__ s16x4 vtr(const AT_LAS unsigned char* p) { return __builtin_bit_cast(s16x4, __builtin_amdgcn_ds_read_tr16_b64_v4i16((AT_LAS v4i16_t*)p)); }

__device__ __forceinline__ void dma_k(lp slot, const bf16_t* kbase, int pitch, int key0, int wid, int lane) { glds(kbase + (size_t)(key0 + lane) * pitch + wid * 8, slot + wid * 1024); }
__device__ __forceinline__ void dma_v(lp slot, const bf16_t* vbase, int pitch, int key0, int wid, int lane) {
    glds(vbase + (size_t)(key0 + 16 * (wid & 3) + (lane >> 2)) * pitch + (wid >> 2) * 32 + (lane & 3) * 8, slot + wid * 1024); }

__device__ __forceinline__ void qk_tile(f32x16& p0, f32x16& p1, lp kslot, const bf16x8 (&qr)[4], int r32, int hi) {
    const AT_LAS unsigned char* kb = kslot + hi * 1024 + r32 * 16;
#pragma unroll
    for (int d0 = 0; d0 < 4; ++d0) {
        const bf16x8 b0 = *(const AT_LAS bf16x8*)(kb + d0 * 2048), b1 = *(const AT_LAS bf16x8*)(kb + d0 * 2048 + 512);
        p0 = __builtin_amdgcn_mfma_f32_32x32x16_bf16(b0, qr[d0], p0, 0, 0, 0);
        p1 = __builtin_amdgcn_mfma_f32_32x32x16_bf16(b1, qr[d0], p1, 0, 0, 0);
    }
}
__device__ __forceinline__ void pv_tile(f32x16 (&o)[2], lp vslot, int lane, int hi, u32x4 pw0, u32x4 pw1, u32x4 pw2, u32x4 pw3) {
    const AT_LAS unsigned char* vp = vslot + ((lane >> 4) & 1) * 32 + (lane & 3) * 8 + (4 * hi + ((lane & 15) >> 2)) * 64;
    const bf16x8 pa[4] = {__builtin_bit_cast(bf16x8, pw0), __builtin_bit_cast(bf16x8, pw1), __builtin_bit_cast(bf16x8, pw2), __builtin_bit_cast(bf16x8, pw3)};
#pragma unroll
    for (int d0 = 0; d0 < 2; ++d0)
#pragma unroll
        for (int ks = 0; ks < 4; ++ks) {
            const s16x4 lo = vtr(vp + d0 * 4096 + ks * 1024), hh = vtr(vp + d0 * 4096 + ks * 1024 + 512);
            const bf16x8 vf = (bf16x8){lo[0], lo[1], lo[2], lo[3], hh[0], hh[1], hh[2], hh[3]};
            o[d0] = __builtin_amdgcn_mfma_f32_32x32x16_bf16(pa[ks], vf, o[d0], 0, 0, 0);
        }
}
__device__ __forceinline__ float rowmax(const f32x16& p0, const f32x16& p1) {
    float a = mx3(p0[0], p0[1], p1[0]), b = mx3(p0[2], p0[3], p1[1]); a = mx3(a, p1[2], p1[3]);
#pragma unroll
    for (int r = 4; r < 16; r += 4) { a = mx3(a, p0[r], p0[r + 1]); b = mx3(b, p0[r + 2], p0[r + 3]); a = mx3(a, p1[r], p1[r + 1]); b = mx3(b, p1[r + 2], p1[r + 3]); }
    const float m = __builtin_fmaxf(a, b);
    auto rr = __builtin_amdgcn_permlane32_swap(__float_as_uint(m), __float_as_uint(m), false, false);
    return __builtin_fmaxf(__uint_as_float(rr[0]), __uint_as_float(rr[1]));
}
__device__ __forceinline__ float halfsum(float v) {
    auto rr = __builtin_amdgcn_permlane32_swap(__float_as_uint(v), __float_as_uint(v), false, false);
    return __uint_as_float(rr[0]) + __uint_as_float(rr[1]);
}
__device__ __forceinline__ void mask_tile(f32x16& p0, f32x16& p1, int lo, int hi_, int hi) {
    const int kb = 4 * hi;
#pragma unroll
    for (int r = 0; r < 16; ++r) { const int kv = kb + (r & 3) + 8 * (r >> 2); if (kv > hi_ || kv < lo) p0[r] = NEGS; if (kv + 32 > hi_ || kv + 32 < lo) p1[r] = NEGS; }
}

__device__ __forceinline__ int next_bit128(unsigned u0, unsigned u1, unsigned u2, unsigned u3, int below) {
    if (below > 96) { unsigned x = u3; if (below < 128) x &= (1u << (below - 96)) - 1u; if (x) return 96 + 31 - __builtin_clz(x); }
    if (below > 64) { unsigned x = u2; if (below < 96) x &= (1u << (below - 64)) - 1u; if (x) return 64 + 31 - __builtin_clz(x); }
    if (below > 32) { unsigned x = u1; if (below < 64) x &= (1u << (below - 32)) - 1u; if (x) return 32 + 31 - __builtin_clz(x); }
    if (below > 0) { unsigned x = u0; if (below < 32) x &= (1u << below) - 1u; if (x) return 31 - __builtin_clz(x); }
    return -1;
}
struct Soft { float m, l; };

template <bool HAS_O>
__device__ __forceinline__ void softmax_step(f32x16& p0, f32x16& p1, Soft& st, f32x16 (&o)[2], float* wsf, int r32, int hi) {
    const float rm = rowmax(p0, p1);
    if (__any(rm > 0.f)) {
        const float dl = __builtin_fmaxf(rm, 0.f); st.m += dl;
#pragma unroll
        for (int r = 0; r < 16; ++r) { p0[r] -= dl; p1[r] -= dl; }
        const float al = __builtin_amdgcn_exp2f(-dl); st.l *= al;
        if (HAS_O) {
            if (hi == 0) wsf[r32] = al;
            wsync();
#pragma unroll
            for (int r = 0; r < 16; ++r) { const float f = wsf[crow(r, hi)]; o[0][r] *= f; o[1][r] *= f; }
            wsync();
        }
    }
    float s = 0.f;
#pragma unroll
    for (int r = 0; r < 16; ++r) { p0[r] = __builtin_amdgcn_exp2f(p0[r]); p1[r] = __builtin_amdgcn_exp2f(p1[r]); s += p0[r] + p1[r]; }
    st.l += s;
}
#define AT_PACK(P0, P1) \
    const u32x4 pw0 = {cvtpk(P0[0], P0[1]), cvtpk(P0[2], P0[3]), cvtpk(P0[4], P0[5]), cvtpk(P0[6], P0[7])}, pw1 = {cvtpk(P0[8], P0[9]), cvtpk(P0[10], P0[11]), cvtpk(P0[12], P0[13]), cvtpk(P0[14], P0[15])}, \
                pw2 = {cvtpk(P1[0], P1[1]), cvtpk(P1[2], P1[3]), cvtpk(P1[4], P1[5]), cvtpk(P1[6], P1[7])}, pw3 = {cvtpk(P1[8], P1[9]), cvtpk(P1[10], P1[11]), cvtpk(P1[12], P1[13]), cvtpk(P1[14], P1[15])}
__device__ __forceinline__ f32x16 cinit(float c2k, int hi, float x) { f32x16 c; const float xb = __builtin_fmaf(c2k, (float)(4 * hi), x);
#pragma unroll
    for (int r = 0; r < 16; ++r) c[r] = __builtin_fmaf(c2k, (float)((r & 3) + 8 * (r >> 2)), xb);
    return c; }
template <bool FIRST>
__device__ __forceinline__ void acc_scaled(float* stage, const f32x16 (&o)[2], float f, float* wsf, int r32, int hi) {
    if (hi == 0) wsf[r32] = f;
    wsync();
#pragma unroll
    for (int r = 0; r < 16; ++r) { const int orow = crow(r, hi); const float g = wsf[orow]; float* s0 = stage + orow * 64 + r32;
        if (FIRST) { s0[0] = o[0][r] * g; s0[32] = o[1][r] * g; } else { s0[0] += o[0][r] * g; s0[32] += o[1][r] * g; } }
    wsync();
}

#define AT_WAIT_NEWER(newer, per) do { if ((newer) >= 2) { if ((per) == 2) AT_WAITV(4); else AT_WAITV(2); } else if ((newer) == 1) { if ((per) == 2) AT_WAITV(2); else AT_WAITV(1); } else AT_WAITV(0); } while (0)

__device__ __forceinline__ void nsa_unit(const Params& p, int b, int g, int c, unsigned char* lds_raw) {
    const int tid = otid(), lane = tid & 63, r32 = lane & 31, hi = lane >> 5, wid = __builtin_amdgcn_readfirstlane(tid >> 6);
    lp lds = (lp)lds_raw;
    const bf16_t* ZB = (const bf16_t*)(p.ws + WS_ZB); const float* GT = (const float*)(p.ws + WS_GATE);
    const bf16_t* KCB = (const bf16_t*)(p.ws + WS_KCB) + (size_t)(b * 2 + g) * 512 * 64; const bf16_t* VCB = (const bf16_t*)(p.ws + WS_VCB) + (size_t)(b * 2 + g) * 512 * 64;
    const int t0 = c * 64, hg = r32 >> 3, qq = r32 & 7, qi = 8 * wid + qq, t = t0 + qi, h = 4 * g + hg; const size_t tt = (size_t)b * S + t;
    float* wsf = (float*)(lds_raw + L_WSF) + wid * 64;
    float* ostage = (float*)(lds_raw + L_OST) + wid * 2048;
    float* imp = ostage;
    unsigned* selm = (unsigned*)(lds_raw + L_SELM);
    unsigned* uni = (unsigned*)(lds_raw + L_UNI);
    const float c2 = exp2f(-(float)(h + 1)) * LOG2E;
    bf16x8 qr[4];
#pragma unroll
    for (int d0 = 0; d0 < 4; ++d0) qr[d0] = *(const bf16x8*)(ZB + tt * ZBW + ZB_Q + h * 64 + d0 * 16 + hi * 8);
    const float gt0 = GT[tt * 32 + h * 3 + 0], gt1 = GT[tt * 32 + h * 3 + 1], gt2 = GT[tt * 32 + h * 3 + 2];
    f32x16 o[2];
    const lp sK0 = lds + L_K, sV0 = lds + L_V;
    const int nmax = t >= 31 ? (t - 31) >> 4 : -1;
    const int ntc = ((4 * c + 2) >> 6) + 1;
    for (int i = lane; i < 8 * 129; i += 64) imp[i] = 0.f;
    Soft sc; sc.m = 0.f; sc.l = 0.f;
#pragma unroll
    for (int k = 0; k < 3; ++k) if (k < ntc) dma_k(sK0 + k * 8192, KCB, 64, 64 * k, wid, lane);
    for (int k = 0; k < ntc; ++k) {
        const int newer = ntc - 1 - k; AT_WAIT_NEWER(newer, 1);
        AT_WAITL(); bar();
        if (k + 3 < ntc) dma_k(sK0 + ((k + 3) & 3) * 8192, KCB, 64, 64 * (k + 3), wid, lane);
        const lp sK = sK0 + (k & 3) * 8192;
        const float x0 = c2 * (16.f * (64 * k) + 15.5f - (float)t0) - sc.m;
        f32x16 p0 = cinit(16.f * c2, hi, x0), p1 = cinit(16.f * c2, hi, x0 + c2 * 512.f);
        qk_tile(p0, p1, sK, qr, r32, hi);
        if (__any(nmax - 64 * k < 63)) mask_tile(p0, p1, 0, nmax - 64 * k, hi);
        softmax_step<false>(p0, p1, sc, o, wsf, r32, hi);
    }
    const float lc = halfsum(sc.l), linv = lc > 0.f ? 1.f / lc : 0.f;
    o[0] = f32x16{}; o[1] = f32x16{};
    AT_WAITL(); bar();
#pragma unroll
    for (int k = 0; k < 3; ++k) if (k < ntc) { dma_k(sK0 + k * 8192, KCB, 64, 64 * k, wid, lane); dma_v(sV0 + k * 8192, VCB, 64, 64 * k, wid, lane); }
    for (int k = 0; k < ntc; ++k) {
        const int newer = ntc - 1 - k; AT_WAIT_NEWER(newer, 2);
        AT_WAITL(); bar();
        if (k + 3 < ntc) { dma_k(sK0 + ((k + 3) & 3) * 8192, KCB, 64, 64 * (k + 3), wid, lane); dma_v(sV0 + ((k + 3) & 3) * 8192, VCB, 64, 64 * (k + 3), wid, lane); }
        const lp sK = sK0 + (k & 3) * 8192, sV = sV0 + (k & 3) * 8192;
        const float x0 = c2 * (16.f * (64 * k) + 15.5f - (float)t0) - sc.m;
        f32x16 p0 = cinit(16.f * c2, hi, x0), p1 = cinit(16.f * c2, hi, x0 + c2 * 512.f);
        qk_tile(p0, p1, sK, qr, r32, hi);
        if (__any(nmax - 64 * k < 63)) mask_tile(p0, p1, 0, nmax - 64 * k, hi);
#pragma unroll
        for (int r = 0; r < 16; ++r) { p0[r] = __builtin_amdgcn_exp2f(p0[r]); p1[r] = __builtin_amdgcn_exp2f(p1[r]); }
        { AT_PACK(p0, p1); pv_tile(o, sV, lane, hi, pw0, pw1, pw2, pw3); }
        float gs[8], ls[8];
#pragma unroll
        for (int q4 = 0; q4 < 4; ++q4) { gs[q4] = ((p0[4 * q4] + p0[4 * q4 + 1]) + (p0[4 * q4 + 2] + p0[4 * q4 + 3])) * linv; ls[q4] = p0[4 * q4 + 3] * linv;
                                         gs[4 + q4] = ((p1[4 * q4] + p1[4 * q4 + 1]) + (p1[4 * q4 + 2] + p1[4 * q4 + 3])) * linv; ls[4 + q4] = p1[4 * q4 + 3] * linv; }
#pragma unroll
        for (int q4 = 0; q4 < 8; ++q4) { gs[q4] += __shfl_xor(gs[q4], 8); gs[q4] += __shfl_xor(gs[q4], 16); ls[q4] += __shfl_xor(ls[q4], 8); ls[q4] += __shfl_xor(ls[q4], 16); }
        if (r32 < 8) {
            float* row = imp + qq * 129 + 16 * k + hi;
#pragma unroll
            for (int q4 = 0; q4 < 8; ++q4) row[2 * q4] += gs[q4];
        }
        wsync();
        if (r32 < 8) {
            float* row = imp + qq * 129 + 16 * k + hi + 1;
#pragma unroll
            for (int q4 = 0; q4 < 8; ++q4) row[2 * q4] += ls[q4];
        }
        wsync();
    }
    unsigned mk0 = 0u, mk1 = 0u, mk2 = 0u, mk3 = 0u;
    {
        const int qs = lane >> 3, part = lane & 7;
        float v[16];
#pragma unroll
        for (int i = 0; i < 16; ++i) { const int j = part * 16 + i; float x = imp[qs * 129 + j]; if (j == 0 || j == c || j == c - 1) x = 1e4f; if (j > c) x = NEGS; v[i] = x; }
#pragma unroll 1
        for (int it = 0; it < 16; ++it) {
            float bv = -3e38f; int bi = 0;
#pragma unroll
            for (int i = 0; i < 16; ++i) if (v[i] > bv) { bv = v[i]; bi = part * 16 + i; }
#pragma unroll
            for (int sft = 1; sft < 8; sft <<= 1) { const float ov = __shfl_xor(bv, sft); const int oi = __shfl_xor(bi, sft); if (ov > bv || (ov == bv && oi < bi)) { bv = ov; bi = oi; } }
            if (bv > NEGS) { const unsigned bit = 1u << (bi & 31); const int wq = bi >> 5; if (wq == 0) mk0 |= bit; else if (wq == 1) mk1 |= bit; else if (wq == 2) mk2 |= bit; else mk3 |= bit; }
#pragma unroll
            for (int i = 0; i < 16; ++i) if (part * 16 + i == bi) v[i] = -3.4e38f;
        }
        if (part == 0) { unsigned* sm = selm + (8 * wid + qs) * 4; sm[0] = mk0; sm[1] = mk1; sm[2] = mk2; sm[3] = mk3; }
        unsigned u0 = mk0, u1 = mk1, u2 = mk2, u3 = mk3;
#pragma unroll
        for (int sft = 8; sft < 64; sft <<= 1) { u0 |= __shfl_xor(u0, sft); u1 |= __shfl_xor(u1, sft); u2 |= __shfl_xor(u2, sft); u3 |= __shfl_xor(u3, sft); }
        if (lane == 0) { uni[wid * 4 + 0] = u0; uni[wid * 4 + 1] = u1; uni[wid * 4 + 2] = u2; uni[wid * 4 + 3] = u3; }
    }
    wsync();
    acc_scaled<true>(ostage, o, gt0 * linv, wsf, r32, hi);
    AT_WAITL(); bar();
    unsigned un0 = 0u, un1 = 0u, un2 = 0u, un3 = 0u;
#pragma unroll
    for (int w = 0; w < 8; ++w) { un0 |= uni[w * 4 + 0]; un1 |= uni[w * 4 + 1]; un2 |= uni[w * 4 + 2]; un3 |= uni[w * 4 + 3]; }
    un0 = __builtin_amdgcn_readfirstlane(un0); un1 = __builtin_amdgcn_readfirstlane(un1); un2 = __builtin_amdgcn_readfirstlane(un2); un3 = __builtin_amdgcn_readfirstlane(un3);
    const unsigned my0 = selm[(8 * wid + qq) * 4 + 0], my1 = selm[(8 * wid + qq) * 4 + 1], my2 = selm[(8 * wid + qq) * 4 + 2], my3 = selm[(8 * wid + qq) * 4 + 3];
    {
        const bf16_t* KS = ZB + (size_t)b * S * ZBW + ZB_KS + g * 64; const bf16_t* VS = ZB + (size_t)b * S * ZBW + ZB_VS + g * 64;
        Soft ss; ss.m = 0.f; ss.l = 0.f; o[0] = f32x16{}; o[1] = f32x16{};
        const int nsel = __builtin_popcount(un0) + __builtin_popcount(un1) + __builtin_popcount(un2) + __builtin_popcount(un3);
        int ji = 128;
#pragma unroll
        for (int k = 0; k < 3; ++k) if (k < nsel) { ji = next_bit128(un0, un1, un2, un3, ji); dma_k(sK0 + k * 8192, KS, ZBW, 64 * ji, wid, lane); dma_v(sV0 + k * 8192, VS, ZBW, 64 * ji, wid, lane); }
        int j = 128;
        for (int i = 0; i < nsel; ++i) {
            j = next_bit128(un0, un1, un2, un3, j);
            const int newer = nsel - 1 - i; AT_WAIT_NEWER(newer, 2);
            AT_WAITL(); bar();
            if (i + 3 < nsel) { ji = next_bit128(un0, un1, un2, un3, ji); dma_k(sK0 + ((i + 3) & 3) * 8192, KS, ZBW, 64 * ji, wid, lane); dma_v(sV0 + ((i + 3) & 3) * 8192, VS, ZBW, 64 * ji, wid, lane); }
            const lp sK = sK0 + (i & 3) * 8192, sV = sV0 + (i & 3) * 8192;
            const unsigned mw = (j >> 5) == 0 ? my0 : (j >> 5) == 1 ? my1 : (j >> 5) == 2 ? my2 : my3;
            const bool sel = (mw >> (j & 31)) & 1u;
            const float x0 = sel ? c2 * (float)(64 * j - t0) - ss.m : NEGS;
            f32x16 p0 = cinit(c2, hi, x0), p1 = cinit(c2, hi, sel ? x0 + c2 * 32.f : NEGS);
            qk_tile(p0, p1, sK, qr, r32, hi);
            if (j == c) mask_tile(p0, p1, 0, qi, hi);
            softmax_step<true>(p0, p1, ss, o, wsf, r32, hi);
            { AT_PACK(p0, p1); pv_tile(o, sV, lane, hi, pw0, pw1, pw2, pw3); }
        }
        const float ls_ = halfsum(ss.l);
        acc_scaled<false>(ostage, o, ls_ > 0.f ? gt1 / ls_ : 0.f, wsf, r32, hi);
    }
    {
        const bf16_t* KW = ZB + (size_t)b * S * ZBW + ZB_KW + g * 64; const bf16_t* VW = ZB + (size_t)b * S * ZBW + ZB_VW + g * 64;
        Soft sw; sw.m = 0.f; sw.l = 0.f; o[0] = f32x16{}; o[1] = f32x16{};
        const int k0 = c >= 8 ? 0 : 8 - c, nw = 9 - k0;
        AT_WAITL(); bar();
#pragma unroll
        for (int k = 0; k < 3; ++k) if (k < nw) { dma_k(sK0 + k * 8192, KW, ZBW, t0 - 512 + 64 * (k0 + k), wid, lane); dma_v(sV0 + k * 8192, VW, ZBW, t0 - 512 + 64 * (k0 + k), wid, lane); }
        for (int i = 0; i < nw; ++i) {
            const int k = k0 + i;
            const int newer = nw - 1 - i; AT_WAIT_NEWER(newer, 2);
            AT_WAITL(); bar();
            if (i + 3 < nw) { dma_k(sK0 + ((i + 3) & 3) * 8192, KW, ZBW, t0 - 512 + 64 * (k + 3), wid, lane); dma_v(sV0 + ((i + 3) & 3) * 8192, VW, ZBW, t0 - 512 + 64 * (k + 3), wid, lane); }
            const lp sK = sK0 + (i & 3) * 8192, sV = sV0 + (i & 3) * 8192;
            const float x0 = c2 * (float)(64 * k - 512) - sw.m;
            f32x16 p0 = cinit(c2, hi, x0), p1 = cinit(c2, hi, x0 + c2 * 32.f);
            qk_tile(p0, p1, sK, qr, r32, hi);
            if (k == 0) mask_tile(p0, p1, qi + 1, 63, hi);
            if (k == 8) mask_tile(p0, p1, 0, qi, hi);
            softmax_step<true>(p0, p1, sw, o, wsf, r32, hi);
            { AT_PACK(p0, p1); pv_tile(o, sV, lane, hi, pw0, pw1, pw2, pw3); }
        }
        const float lw = halfsum(sw.l);
        acc_scaled<false>(ostage, o, lw > 0.f ? gt2 / lw : 0.f, wsf, r32, hi);
    }
    {
        bf16_t* AB = (bf16_t*)(p.ws + WS_ATTB);
#pragma unroll
        for (int i = 0; i < 4; ++i) { const int row = i * 8 + (lane >> 3), ch = lane & 7; const float4 a = *(const float4*)(ostage + row * 64 + ch * 8), c4 = *(const float4*)(ostage + row * 64 + ch * 8 + 4);
            const uint4 v = make_uint4(pk2(a.x, a.y), pk2(a.z, a.w), pk2(c4.x, c4.y), pk2(c4.z, c4.w));
            *(uint4*)(AB + ((size_t)b * S + t0 + 8 * wid + (row & 7)) * D + (4 * g + (row >> 3)) * 64 + ch * 8) = v; }
        wsync();
    }
    AT_WAITL(); bar();
}

}

constexpr int MB_CAP = 25600;
namespace at {
__device__ __forceinline__ void moba_route_unit(const Params& p, int b, int h, int qb, unsigned char* lds_raw) {
    const int tid = otid(), lane = tid & 63, r32 = lane & 31, hi = lane >> 5, wid = __builtin_amdgcn_readfirstlane(tid >> 6);
    lp lds = (lp)lds_raw;
    const bf16_t* ZB = (const bf16_t*)(p.ws + WS_ZB);
    const int bh = b * 8 + h;
    const bf16_t* KMB = (const bf16_t*)(p.ws + WS_KMB) + (size_t)bh * 32 * 64;
    const int qi = 32 * wid + r32, t = qb * 256 + qi; const size_t tt = (size_t)b * S + t;
    int* hist = (int*)(lds_raw + L_UNI);
    unsigned* SEL3 = (unsigned*)(p.ws + WS_SEL3); unsigned* LRK = (unsigned*)(p.ws + WS_LRK);
    unsigned char* IL = (unsigned char*)(p.ws + WS_ILIST) + ((size_t)(bh * 32 + qb) * 32) * 256;
    int* BCm = (int*)(p.ws + WS_BCM) + (size_t)(bh * 32 + qb) * 32;
    if (tid < 32) hist[tid] = 0;
    bf16x8 qr[4];
#pragma unroll
    for (int d0 = 0; d0 < 4; ++d0) qr[d0] = *(const bf16x8*)(ZB + tt * ZBW + ZB_MQ + h * 64 + d0 * 16 + hi * 8);
    const lp sKM = lds + L_KMT;
    glds(KMB + (size_t)(lane & 31) * 64 + wid * 8, sKM + wid * 1024);
    AT_WAITV(0); AT_WAITL(); bar();
    f32x16 g0 = f32x16{}, g1 = f32x16{};
    qk_tile(g0, g1, sKM, qr, r32, hi);
    float v1 = NEGS, v2 = NEGS, v3 = NEGS; int i1 = 64, i2 = 64, i3 = 64;
#pragma unroll
    for (int r = 0; r < 16; ++r) { const int n = crow(r, hi); const float s_ = n < qb ? g0[r] : NEGS;
        if (s_ > v1) { v3 = v2; i3 = i2; v2 = v1; i2 = i1; v1 = s_; i1 = n; } else if (s_ > v2) { v3 = v2; i3 = i2; v2 = s_; i2 = n; } else if (s_ > v3) { v3 = s_; i3 = n; } }
    float ov[3]; int oi[3];
    { auto a = __builtin_amdgcn_permlane32_swap(__float_as_uint(v1), __float_as_uint(v1), false, false); ov[0] = __uint_as_float(hi ? a[0] : a[1]); }
    { auto a = __builtin_amdgcn_permlane32_swap(__float_as_uint(v2), __float_as_uint(v2), false, false); ov[1] = __uint_as_float(hi ? a[0] : a[1]); }
    { auto a = __builtin_amdgcn_permlane32_swap(__float_as_uint(v3), __float_as_uint(v3), false, false); ov[2] = __uint_as_float(hi ? a[0] : a[1]); }
    { auto a = __builtin_amdgcn_permlane32_swap((unsigned)i1, (unsigned)i1, false, false); oi[0] = (int)(hi ? a[0] : a[1]); }
    { auto a = __builtin_amdgcn_permlane32_swap((unsigned)i2, (unsigned)i2, false, false); oi[1] = (int)(hi ? a[0] : a[1]); }
    { auto a = __builtin_amdgcn_permlane32_swap((unsigned)i3, (unsigned)i3, false, false); oi[2] = (int)(hi ? a[0] : a[1]); }
#pragma unroll
    for (int k = 0; k < 3; ++k) { const float s_ = ov[k]; const int n = oi[k];
        if (s_ > v1 || (s_ == v1 && n < i1)) { v3 = v2; i3 = i2; v2 = v1; i2 = i1; v1 = s_; i1 = n; }
        else if (s_ > v2 || (s_ == v2 && n < i2)) { v3 = v2; i3 = i2; v2 = s_; i2 = n; }
        else if (s_ > v3 || (s_ == v3 && n < i3)) { v3 = s_; i3 = n; } }
    if (hi == 0) {
        const int j1 = v1 > NEGS ? i1 : 255, j2 = v2 > NEGS ? i2 : 255, j3 = v3 > NEGS ? i3 : 255;
        int l1 = 0, l2 = 0, l3 = 0;
        if (j1 < 32) { l1 = atomicAdd(&hist[j1], 1); IL[j1 * 256 + l1] = (unsigned char)qi; }
        if (j2 < 32) { l2 = atomicAdd(&hist[j2], 1); IL[j2 * 256 + l2] = (unsigned char)qi; }
        if (j3 < 32) { l3 = atomicAdd(&hist[j3], 1); IL[j3 * 256 + l3] = (unsigned char)qi; }
        SEL3[tt * 8 + h] = (unsigned)j1 | ((unsigned)j2 << 8) | ((unsigned)j3 << 16);
        LRK[tt * 8 + h] = (unsigned)l1 | ((unsigned)l2 << 8) | ((unsigned)l3 << 16);
    }
    AT_WAITL(); bar();
    if (tid < 32) BCm[tid] = hist[tid];
    AT_WAITL(); bar();
}
__device__ __forceinline__ void moba_tables(const int* BCmbh, int lane, int& tot, int& seg) {
    int s = 0;
    if (lane < 32) { for (int q = 0; q < 32; ++q) s += BCmbh[q * 32 + lane]; }
    tot = s;
    int pad = (s + 31) & ~31, inc = pad;
#pragma unroll
    for (int sft = 1; sft < 32; sft <<= 1) { const int o_ = __shfl_up(inc, sft); if ((lane & 31) >= sft) inc += o_; }
    seg = inc - pad;
}
__device__ __forceinline__ void moba_gather_unit(const Params& p, int bh, int j, int ch, int segj, bool reload, unsigned char* lds_raw) {
    const int tid = otid(), lane = tid & 63, r32 = lane & 31, hi = lane >> 5, wid = __builtin_amdgcn_readfirstlane(tid >> 6);
    lp lds = (lp)lds_raw;
    const int b = bh >> 3, h = bh & 7;
    const bf16_t* ZB = (const bf16_t*)(p.ws + WS_ZB);
    const int* BCmbh = (const int*)(p.ws + WS_BCM) + (size_t)bh * 32 * 32;
    float* wsf = (float*)(lds_raw + L_WSF) + wid * 64;
    const lp sK0 = lds + L_K, sV0 = lds + L_V;
    const bf16_t* KM_ = ZB + (size_t)b * S * ZBW + ZB_MK + h * 64; const bf16_t* VM_ = ZB + (size_t)b * S * ZBW + ZB_MV + h * 64;
    if (reload) {
#pragma unroll
        for (int k = 0; k < 4; ++k) { dma_k(sK0 + k * 8192, KM_, ZBW, j * 256 + 64 * k, wid, lane); dma_v(sV0 + k * 8192, VM_, ZBW, j * 256 + 64 * k, wid, lane); }
    }
    const int gr = 256 * ch + 32 * wid + r32;
    const int cq = lane < 32 ? BCmbh[lane * 32 + j] : 0;
    int run = 0, qbs = j + 1, lr = 0;
#pragma unroll 4
    for (int q = 0; q < 32; ++q) { const int c_ = __builtin_amdgcn_readlane(cq, q); if (gr >= run && gr < run + c_) { qbs = q; lr = gr - run; } run += c_; }
    const int totj = run;
    const bool valid = gr < totj;
    const unsigned char* IL = (const unsigned char*)(p.ws + WS_ILIST);
    const int qidx = valid ? (int)IL[((size_t)(bh * 32 + qbs) * 32 + j) * 256 + lr] : 0;
    const int t = valid ? qbs * 256 + qidx : (j + 1) * 256; const size_t tt = (size_t)b * S + t;
    const float c2 = exp2f(-(float)(h + 1)) * LOG2E;
    bf16x8 qr[4];
#pragma unroll
    for (int d0 = 0; d0 < 4; ++d0) qr[d0] = *(const bf16x8*)(ZB + tt * ZBW + ZB_MQ + h * 64 + d0 * 16 + hi * 8);
    Soft sm; sm.m = 0.f; sm.l = 0.f; f32x16 o[2]; o[0] = f32x16{}; o[1] = f32x16{};
#pragma unroll 1
    for (int i = 0; i < 4; ++i) {
        if (reload) { const int newer = 3 - i; if (newer >= 3) AT_WAITV(6); else AT_WAIT_NEWER(newer, 2); AT_WAITL(); bar(); }
        const lp sK = sK0 + i * 8192, sV = sV0 + i * 8192;
        const float x0 = c2 * (float)(64 * i) - sm.m;
        f32x16 p0 = cinit(c2, hi, x0), p1 = cinit(c2, hi, x0 + c2 * 32.f);
        qk_tile(p0, p1, sK, qr, r32, hi);
        softmax_step<true>(p0, p1, sm, o, wsf, r32, hi);
        { AT_PACK(p0, p1); pv_tile(o, sV, lane, hi, pw0, pw1, pw2, pw3); }
    }
    {
        const float lt = halfsum(sm.l);
        float* PM = (float*)(p.ws + WS_PM) + (size_t)bh * MB_CAP; float* PL = (float*)(p.ws + WS_PL) + (size_t)bh * MB_CAP;
        if (hi == 0 && valid) { PM[segj + gr] = sm.m; PL[segj + gr] = lt; }
        bf16_t* stg = (bf16_t*)(lds_raw + L_OST) + wid * 4096;
#pragma unroll
        for (int r = 0; r < 16; ++r) { const int orow = crow(r, hi); stg[orow * 64 + r32] = (bf16_t)f2bf(o[0][r]); stg[orow * 64 + 32 + r32] = (bf16_t)f2bf(o[1][r]); }
        wsync();
        bf16_t* PO = (bf16_t*)(p.ws + WS_PO) + ((size_t)bh * MB_CAP + segj + 256 * ch + 32 * wid) * 64;
        const int nrow = totj - (256 * ch + 32 * wid);
#pragma unroll
        for (int i = 0; i < 4; ++i) { const int row = i * 8 + (lane >> 3), c8 = lane & 7; if (row < nrow) *(uint4*)(PO + (size_t)row * 64 + c8 * 8) = *(const uint4*)(stg + row * 64 + c8 * 8); }
        wsync();
    }
    AT_WAITL(); bar();
}
__device__ __forceinline__ void moba_self_unit(const Params& p, int b, int h, int qb, unsigned char* lds_raw) {
    const int tid = otid(), lane = tid & 63, r32 = lane & 31, hi = lane >> 5, wid = __builtin_amdgcn_readfirstlane(tid >> 6);
    lp lds = (lp)lds_raw;
    const int bh = b * 8 + h;
    const bf16_t* ZB = (const bf16_t*)(p.ws + WS_ZB);
    const int* BCmbh = (const int*)(p.ws + WS_BCM) + (size_t)bh * 32 * 32;
    const int qi = 32 * wid + r32, t = qb * 256 + qi; const size_t tt = (size_t)b * S + t;
    float* wsf = (float*)(lds_raw + L_WSF) + wid * 64;
    float* ostage = (float*)(lds_raw + L_OST) + wid * 2048;
    const float c2 = exp2f(-(float)(h + 1)) * LOG2E;
    bf16x8 qr[4];
#pragma unroll
    for (int d0 = 0; d0 < 4; ++d0) qr[d0] = *(const bf16x8*)(ZB + tt * ZBW + ZB_MQ + h * 64 + d0 * 16 + hi * 8);
    const lp sK0 = lds + L_K, sV0 = lds + L_V;
    const bf16_t* KM_ = ZB + (size_t)b * S * ZBW + ZB_MK + h * 64; const bf16_t* VM_ = ZB + (size_t)b * S * ZBW + ZB_MV + h * 64;
    Soft sm; sm.m = 0.f; sm.l = 0.f; f32x16 o[2]; o[0] = f32x16{}; o[1] = f32x16{};
#pragma unroll
    for (int k = 0; k < 3; ++k) { dma_k(sK0 + k * 8192, KM_, ZBW, qb * 256 + 64 * k, wid, lane); dma_v(sV0 + k * 8192, VM_, ZBW, qb * 256 + 64 * k, wid, lane); }
    int tot, seg; moba_tables(BCmbh, lane, tot, seg);
    int before = 0; if (lane < 32) { for (int q = 0; q < qb; ++q) before += BCmbh[q * 32 + lane]; }
    const int base = seg + before;
#pragma unroll 1
    for (int i = 0; i < 4; ++i) {
        const int newer = 3 - i; AT_WAIT_NEWER(newer, 2);
        AT_WAITL(); bar();
        if (i == 0) { dma_k(sK0 + 3 * 8192, KM_, ZBW, qb * 256 + 192, wid, lane); dma_v(sV0 + 3 * 8192, VM_, ZBW, qb * 256 + 192, wid, lane); }
        const lp sK = sK0 + i * 8192, sV = sV0 + i * 8192;
        const bool skip = (32 * wid + 31 < 64 * i);
        if (!skip) {
            const float x0 = c2 * (float)(64 * i) - sm.m;
            f32x16 p0 = cinit(c2, hi, x0), p1 = cinit(c2, hi, x0 + c2 * 32.f);
            qk_tile(p0, p1, sK, qr, r32, hi);
            if (64 * i + 63 > 32 * wid) mask_tile(p0, p1, 0, qi - 64 * i, hi);
            softmax_step<true>(p0, p1, sm, o, wsf, r32, hi);
            { AT_PACK(p0, p1); pv_tile(o, sV, lane, hi, pw0, pw1, pw2, pw3); }
        }
    }
    {
        const float lself = halfsum(sm.l);
        const unsigned s3 = ((const unsigned*)(p.ws + WS_SEL3))[tt * 8 + h], l3 = ((const unsigned*)(p.ws + WS_LRK))[tt * 8 + h];
        const float* PM = (const float*)(p.ws + WS_PM) + (size_t)bh * MB_CAP; const float* PL = (const float*)(p.ws + WS_PL) + (size_t)bh * MB_CAP;
        float mk[3], lk[3]; int pidx[3];
        float M = sm.m + c2 * 256.f * (float)qb;
        const float mself = M;
#pragma unroll
        for (int k = 0; k < 3; ++k) { const int jk = (s3 >> (8 * k)) & 255, lrk = (l3 >> (8 * k)) & 255;
            const int pb = __shfl(base, jk & 31);
            if (jk < 32) { pidx[k] = pb + lrk; mk[k] = PM[pidx[k]] + c2 * 256.f * (float)jk; lk[k] = PL[pidx[k]]; M = __builtin_fmaxf(M, mk[k]); }
            else { pidx[k] = -1; mk[k] = NEGS; lk[k] = 0.f; } }
        const float ws_ = __builtin_amdgcn_exp2f(mself - M);
        float wk[3]; float Lt = lself * ws_;
#pragma unroll
        for (int k = 0; k < 3; ++k) { wk[k] = pidx[k] >= 0 ? __builtin_amdgcn_exp2f(mk[k] - M) : 0.f; Lt += lk[k] * wk[k]; }
        const float inv = Lt > 0.f ? 1.f / Lt : 0.f;
        float* rws = wsf;
        float* rwk = (float*)(lds_raw + L_KMT) + wid * 256;
        int* rpi = (int*)(rwk + 96);
        if (hi == 0) { rws[r32] = ws_ * inv;
#pragma unroll
            for (int k = 0; k < 3; ++k) { rwk[k * 32 + r32] = wk[k] * inv; rpi[k * 32 + r32] = pidx[k]; } }
#pragma unroll
        for (int r = 0; r < 16; ++r) { const int orow = crow(r, hi); ostage[orow * 64 + r32] = o[0][r]; ostage[orow * 64 + 32 + r32] = o[1][r]; }
        wsync();
        const bf16_t* PO = (const bf16_t*)(p.ws + WS_PO) + (size_t)bh * MB_CAP * 64;
        bf16_t* AB = (bf16_t*)(p.ws + WS_ATTB);
#pragma unroll
        for (int i = 0; i < 4; ++i) { const int row = i * 8 + (lane >> 3), c8 = lane & 7;
            const float4 a = *(const float4*)(ostage + row * 64 + c8 * 8), c4 = *(const float4*)(ostage + row * 64 + c8 * 8 + 4);
            const float w0 = rws[row];
            float acc8[8] = {a.x * w0, a.y * w0, a.z * w0, a.w * w0, c4.x * w0, c4.y * w0, c4.z * w0, c4.w * w0};
#pragma unroll
            for (int k = 0; k < 3; ++k) { const int pi = rpi[k * 32 + row]; if (pi >= 0) { const float w = rwk[k * 32 + row]; const uint4 q = *(const uint4*)(PO + (size_t)pi * 64 + c8 * 8);
                const unsigned qq_[4] = {q.x, q.y, q.z, q.w};
#pragma unroll
                for (int e = 0; e < 4; ++e) { acc8[2 * e] += __builtin_bit_cast(float, qq_[e] << 16) * w; acc8[2 * e + 1] += __builtin_bit_cast(float, qq_[e] & 0xffff0000u) * w; } } }
            *(uint4*)(AB + ((size_t)b * S + qb * 256 + 32 * wid + row) * D + 512 + h * 64 + c8 * 8) = make_uint4(pk2(acc8[0], acc8[1]), pk2(acc8[2], acc8[3]), pk2(acc8[4], acc8[5]), pk2(acc8[6], acc8[7])); }
        wsync();
    }
    AT_WAITL(); bar();
}
}

__device__ __forceinline__ void phase_att1(const Params& p, unsigned char* lds_raw) {
    const int tid = otid();
    int* pre = (int*)(lds_raw + at::L_END);
    int* segt = pre + 514;
    { const int* BCm = (const int*)(p.ws + WS_BCM); const int bh = tid >> 5, j = tid & 31; int s = 0;
      for (int q = 0; q < 32; ++q) s += BCm[(size_t)(bh * 32 + q) * 32 + j];
      pre[tid + 1] = (s + 255) >> 8; if (tid == 0) pre[0] = 0;
      segt[tid] = (s + 31) & ~31; }
    __syncthreads();
    for (int sft = 1; sft < 512; sft <<= 1) { int v = 0, w = 0; if (tid >= sft) v = pre[tid + 1 - sft]; if ((tid & 31) >= sft) w = segt[tid - sft]; __syncthreads(); pre[tid + 1] += v; if (sft < 32) segt[tid] += w; __syncthreads(); }
    { const int* BCm = (const int*)(p.ws + WS_BCM); const int bh = tid >> 5, j = tid & 31; int s = 0;
      for (int q = 0; q < 32; ++q) s += BCm[(size_t)(bh * 32 + q) * 32 + j];
      const int excl = segt[tid] - ((s + 31) & ~31); __syncthreads(); segt[tid] = excl; }
    __syncthreads();
    const int nun = pre[512];
    for (int pi = blockIdx.x; pi < 512; pi += gridDim.x) {
        const int rnd = pi >> 8, id = pi & 255;
        const int bg = 2 * rnd + (id >> 7), c = rnd ? 127 - (id & 127) : (id & 127); at::nsa_unit(p, bg >> 1, bg & 1, c, lds_raw);
    }
    {
        const int u0 = (int)(((long)blockIdx.x * nun) / gridDim.x), u1 = (int)(((long)(blockIdx.x + 1) * nun) / gridDim.x);
        int prev = -1;
        for (int u = u0; u < u1; ++u) {
            int lo = 0, hi_ = 511;
            while (lo < hi_) { const int mid = (lo + hi_ + 1) >> 1; if (pre[mid] <= u) lo = mid; else hi_ = mid - 1; }
            at::moba_gather_unit(p, lo >> 5, lo & 31, u - pre[lo], segt[lo], lo != prev, lds_raw);
            prev = lo;
        }
    }
}
__device__ __forceinline__ void phase_att2(const Params& p, unsigned char* lds_raw) {
    for (int pi = blockIdx.x; pi < 512; pi += gridDim.x) {
        const int rnd = pi >> 8, id = pi & 255;
        const int bh = 8 * rnd + (id >> 5), qb = rnd ? 31 - (id & 31) : (id & 31); at::moba_self_unit(p, bh >> 3, bh & 7, qb, lds_raw);
    }
}
__device__ __forceinline__ void phase_route(const Params& p, unsigned char* lds_raw) {
    for (int pi = blockIdx.x; pi < 512; pi += gridDim.x) at::moba_route_unit(p, pi >> 8, (pi >> 5) & 7, pi & 31, lds_raw);
}


__device__ __forceinline__ void phase_r2_fast(const Params& p, int l, unsigned char* lds_raw) {
    using namespace at;
    const int tid = otid(), lane = tid & 63, wave = __builtin_amdgcn_readfirstlane(tid >> 6), r32 = lane & 31, hi = lane >> 5;
    const float* mod = (const float*)(p.ws + WS_MOD);
    const bf16_t* XAB = (const bf16_t*)(p.ws + WS_XAB); bf16_t* XN = (bf16_t*)(p.ws + WS_XN); bf16_t* XL = (bf16_t*)(p.ws + WS_XNLO);
    const float* lng = p.in[5] + (size_t)l * D; const float* rw = p.in[15] + (size_t)l * D * NE; const float* rb = p.in[16] + l * NE;
    int* toke = (int*)(p.ws + WS_TOKE); float* tokw = (float*)(p.ws + WS_TOKW); int* BC = (int*)(p.ws + WS_BC);
    lp lds = (lp)lds_raw;
    int* hist = (int*)(lds_raw + 131072);
    for (int idx = tid; idx < 128 * 32; idx += NT) {
        const int kc = idx >> 5, e = idx & 31; float v[8];
#pragma unroll
        for (int j = 0; j < 8; ++j) v[j] = rw[(size_t)(8 * kc + j) * NE + e];
        unsigned hh[8], ll[8];
#pragma unroll
        for (int j = 0; j < 8; ++j) { hh[j] = f2bf(v[j]); ll[j] = f2bf(v[j] - __builtin_bit_cast(float, hh[j] << 16)); }
        *(uint4*)(lds_raw + (size_t)idx * 16) = make_uint4(hh[0] | (hh[1] << 16), hh[2] | (hh[3] << 16), hh[4] | (hh[5] << 16), hh[6] | (hh[7] << 16));
        *(uint4*)(lds_raw + 65536 + (size_t)idx * 16) = make_uint4(ll[0] | (ll[1] << 16), ll[2] | (ll[3] << 16), ll[4] | (ll[5] << 16), ll[6] | (ll[7] << 16));
    }
    for (int blk = blockIdx.x; blk < T / 64; blk += gridDim.x) {
        if (tid < 32) hist[tid] = 0;
        for (int i = 0; i < 8; ++i) {
            const int t = blk * 64 + wave * 8 + i, b = t / S;
            float4 v[4]; float ss = 0.f;
#pragma unroll
            for (int j = 0; j < 4; ++j) { const uint2 q_ = *(const uint2*)(XAB + (size_t)t * D + 4 * lane + 256 * j);
                v[j] = make_float4(__builtin_bit_cast(float, q_.x << 16), __builtin_bit_cast(float, q_.x & 0xffff0000u), __builtin_bit_cast(float, q_.y << 16), __builtin_bit_cast(float, q_.y & 0xffff0000u));
                ss += (v[j].x * v[j].x + v[j].y * v[j].y) + (v[j].z * v[j].z + v[j].w * v[j].w); }
            ss = wave_sum(ss);
            const float r = rsqrtf(ss * (1.f / D) + EPS);
            const float* sh = mod + ((size_t)l * Bn + b) * 6144 + 3 * D; const float* sc = mod + ((size_t)l * Bn + b) * 6144 + 4 * D;
#pragma unroll
            for (int j = 0; j < 4; ++j) {
                const int col = 4 * lane + 256 * j;
                const float4 g = *(const float4*)(lng + col), s1 = *(const float4*)(sc + col), s0 = *(const float4*)(sh + col);
                const float o[4] = {v[j].x * r * g.x * (1.f + s1.x) + s0.x, v[j].y * r * g.y * (1.f + s1.y) + s0.y, v[j].z * r * g.z * (1.f + s1.z) + s0.z, v[j].w * r * g.w * (1.f + s1.w) + s0.w};
                unsigned hh[4], ll[4];
#pragma unroll
                for (int q = 0; q < 4; ++q) { hh[q] = f2bf(o[q]); ll[q] = f2bf(o[q] - __builtin_bit_cast(float, hh[q] << 16)); }
                *(uint2*)(XN + (size_t)t * D + col) = make_uint2(hh[0] | (hh[1] << 16), hh[2] | (hh[3] << 16));
                *(uint2*)(XL + (size_t)t * D + col) = make_uint2(ll[0] | (ll[1] << 16), ll[2] | (ll[3] << 16));
            }
        }
        asm volatile("s_waitcnt vmcnt(0)" ::: "memory");
        __syncthreads();
        if (wave < 2) {
            const int t = blk * 64 + wave * 32 + r32;
            const bf16_t* xh = XN + (size_t)t * D + 8 * hi; const bf16_t* xl = XL + (size_t)t * D + 8 * hi;
            const AT_LAS unsigned char* wh = lds + (size_t)(hi * 32 + r32) * 16; const AT_LAS unsigned char* wl = wh + 65536;
            f32x16 acc = f32x16{};
#pragma unroll 4
            for (int ks = 0; ks < 64; ++ks) {
                const bf16x8 bh = *(const bf16x8*)(xh + 16 * ks), bl = *(const bf16x8*)(xl + 16 * ks);
                const bf16x8 ah = *(const AT_LAS bf16x8*)(wh + ks * 1024), al = *(const AT_LAS bf16x8*)(wl + ks * 1024);
                acc = __builtin_amdgcn_mfma_f32_32x32x16_bf16(ah, bh, acc, 0, 0, 0);
                acc = __builtin_amdgcn_mfma_f32_32x32x16_bf16(al, bh, acc, 0, 0, 0);
                acc = __builtin_amdgcn_mfma_f32_32x32x16_bf16(ah, bl, acc, 0, 0, 0);
            }
            float a0 = -3e38f, a1 = -3e38f, a2 = -3e38f, a3 = -3e38f; int i0 = 99, i1 = 99, i2 = 99, i3 = 99;
#pragma unroll
            for (int r = 0; r < 16; ++r) { const int e = crow(r, hi); const float s_ = acc[r] + rb[e];
                if (s_ > a0) { a3 = a2; i3 = i2; a2 = a1; i2 = i1; a1 = a0; i1 = i0; a0 = s_; i0 = e; }
                else if (s_ > a1) { a3 = a2; i3 = i2; a2 = a1; i2 = i1; a1 = s_; i1 = e; }
                else if (s_ > a2) { a3 = a2; i3 = i2; a2 = s_; i2 = e; }
                else if (s_ > a3) { a3 = s_; i3 = e; } }
            float ov[4]; int oi[4];
            { const float sv[4] = {a0, a1, a2, a3}; const int si[4] = {i0, i1, i2, i3};
#pragma unroll
              for (int k = 0; k < 4; ++k) { auto a = __builtin_amdgcn_permlane32_swap(__float_as_uint(sv[k]), __float_as_uint(sv[k]), false, false); ov[k] = __uint_as_float(hi ? a[0] : a[1]);
                                            auto c = __builtin_amdgcn_permlane32_swap((unsigned)si[k], (unsigned)si[k], false, false); oi[k] = (int)(hi ? c[0] : c[1]); } }
#pragma unroll
            for (int k = 0; k < 4; ++k) { const float s_ = ov[k]; const int e = oi[k];
                if (s_ > a0 || (s_ == a0 && e < i0)) { a3 = a2; i3 = i2; a2 = a1; i2 = i1; a1 = a0; i1 = i0; a0 = s_; i0 = e; }
                else if (s_ > a1 || (s_ == a1 && e < i1)) { a3 = a2; i3 = i2; a2 = a1; i2 = i1; a1 = s_; i1 = e; }
                else if (s_ > a2 || (s_ == a2 && e < i2)) { a3 = a2; i3 = i2; a2 = s_; i2 = e; }
                else if (s_ > a3 || (s_ == a3 && e < i3)) { a3 = s_; i3 = e; } }
            const float e1 = __expf(a1 - a0), e2 = __expf(a2 - a0), e3 = __expf(a3 - a0), inv = 1.f / (((1.f + e1) + e2) + e3);
            if (hi == 0) {
                *(int4*)(toke + (size_t)t * 4) = make_int4(i0, i1, i2, i3);
                *(float4*)(tokw + (size_t)t * 4) = make_float4(inv, e1 * inv, e2 * inv, e3 * inv);
                atomicAdd(&hist[i0], 1); atomicAdd(&hist[i1], 1); atomicAdd(&hist[i2], 1); atomicAdd(&hist[i3], 1);
            }
        }
        __syncthreads();
        if (tid < 32) BC[blk * 32 + tid] = hist[tid];
        __syncthreads();
    }
}
__device__ __forceinline__ void phase_sc_fast(const Params& p, int l, unsigned char* lds_raw) {
    const int tid = otid();
    const int* BC = (const int*)(p.ws + WS_BC);
    int* cnt = (int*)(p.ws + WS_CNT) + l * 32;
    int* tot = (int*)lds_raw; int* base = tot + 32; int* fillc = tot + 64; int* before = tot + 96;
    const int* toke = (const int*)(p.ws + WS_TOKE); const float* tokw = (const float*)(p.ws + WS_TOKW);
    int* rowtok = (int*)(p.ws + WS_ROWTOK) + (size_t)l * RMAX; float* roww = (float*)(p.ws + WS_ROWW) + (size_t)l * RMAX; int* pos = (int*)(p.ws + WS_POS);
    for (int blk = blockIdx.x; blk < T / 64; blk += gridDim.x) {
        { const int e = tid & 31, part = tid >> 5; int s = 0, bf = 0;
#pragma unroll 4
          for (int i = part * 16; i < part * 16 + 16; ++i) { const int c = BC[i * 32 + e]; s += c; if (i < blk) bf += c; }
          int* ptot = tot + 128; int* pbef = ptot + 512;
          ptot[tid] = s; pbef[tid] = bf; }
        __syncthreads();
        if (tid < 32) { const int* ptot = tot + 128; const int* pbef = ptot + 512; int s = 0, bf = 0;
#pragma unroll
            for (int q = 0; q < 16; ++q) { s += ptot[q * 32 + tid]; bf += pbef[q * 32 + tid]; }
            tot[tid] = s; before[tid] = bf; fillc[tid] = 0; if (blk == 0) cnt[tid] = s; }
        __syncthreads();
        if (tid == 0) { int s = 0; for (int e = 0; e < 32; ++e) { base[e] = s + before[e]; s += (tot[e] + 255) & ~255; } }
        __syncthreads();
        if (tid < 256) {
            const int i = blk * 256 + tid, e = toke[i];
            const int slot = base[e] + atomicAdd(&fillc[e], 1);
            rowtok[slot] = i >> 2; roww[slot] = tokw[i]; pos[i] = slot;
        }
        __syncthreads();
    }
}

#define XB_TMO      128
#define XB_XCNT(j)  (256  + 64 * (j))
#define XB_XSUB(j)  (1280 + 64 * (j))
#define XB_XGEN(j)  (2304 + 64 * (j))
#define XB_TOP      3328
#define XB_TOPGEN   3392
#define XCD_BAR_WORDS 3456
#define XB_SPIN_CAP (1u << 18)
#define XLAS __attribute__((address_space(3)))
__device__ __forceinline__ unsigned xb_ld(unsigned* p)              { return __hip_atomic_load(p, __ATOMIC_RELAXED, __HIP_MEMORY_SCOPE_AGENT); }
__device__ __forceinline__ unsigned xb_add(unsigned* p, unsigned v) { return __hip_atomic_fetch_add(p, v, __ATOMIC_RELAXED, __HIP_MEMORY_SCOPE_AGENT); }
__device__ __forceinline__ unsigned xb_xcc_id() { return (unsigned)__builtin_amdgcn_s_getreg((3 << 11) | 20) & 0xFu; }
#define XB_SPIN(cond, bar) do { unsigned _sp = 0; while (cond) { __builtin_amdgcn_s_sleep(1); \
    if ((++_sp & 255u) == 0u) { if (xb_ld(&(bar)[XB_TMO])) break; if (_sp > XB_SPIN_CAP) { atomicAdd(&(bar)[XB_TMO], 1u); break; } } } } while (0)
constexpr int LDS_BARST_OFF = 147200;
struct XcdBarrier { unsigned* bar; unsigned x; volatile XLAS unsigned* st; };
__device__ __forceinline__ XcdBarrier xcd_barrier_post(unsigned* bar, volatile XLAS unsigned* st) {
    XcdBarrier b; b.bar = bar; b.x = xb_xcc_id(); b.st = st;
    if (threadIdx.x == 0) (void)xb_add(&bar[XB_XCNT(b.x)], 1u);
    return b;
}
__device__ __forceinline__ void xcd_barrier_complete(unsigned* bar, unsigned x, unsigned& nloc, unsigned& nx) {
    const unsigned G = gridDim.x * gridDim.y * gridDim.z;
    unsigned sum, cnt, mine, sp = 0u;
    for (;;) {
        sum = 0u; cnt = 0u; mine = 0u;
#pragma unroll
        for (unsigned j = 0; j < 16; ++j) { const unsigned c = xb_ld(&bar[XB_XCNT(j)]); sum += c; cnt += (c > 0u) ? 1u : 0u; mine = (j == x) ? c : mine; }
        if (sum == G) break;
        __builtin_amdgcn_s_sleep(1);
        if ((++sp & 255u) == 0u) { if (xb_ld(&bar[XB_TMO])) break; if (sp > XB_SPIN_CAP) { atomicAdd(&bar[XB_TMO], 1u); break; } }
    }
    nloc = mine > 0u ? mine : 1u; nx = cnt > 0u ? cnt : 1u;
}
__device__ __forceinline__ void xcd_barrier(unsigned char* ws, unsigned char* lds_raw_) {
    XcdBarrier b; b.bar = (unsigned*)(ws + WS_BAR); b.x = xb_xcc_id(); b.st = (volatile XLAS unsigned*)((XLAS unsigned char*)lds_raw_ + LDS_BARST_OFF);
    asm volatile("s_waitcnt vmcnt(0)" ::: "memory");
    __syncthreads();
    if (threadIdx.x == 0) {
        unsigned* bar = b.bar;
        __builtin_amdgcn_s_waitcnt(0);
        unsigned nloc = b.st[0], nx = b.st[1];
        if (nloc == 0u) { xcd_barrier_complete(bar, b.x, nloc, nx); b.st[0] = nloc; b.st[1] = nx; }
        const unsigned old = xb_add(&bar[XB_XSUB(b.x)], 1u);
        const unsigned gen = old / nloc;
        if (old + 1u == (gen + 1u) * nloc) {
            __builtin_amdgcn_fence(__ATOMIC_RELEASE, "agent");
            asm volatile("s_waitcnt vmcnt(0)" ::: "memory");
            const unsigned og = xb_add(&bar[XB_TOP], 1u);
            const unsigned tg = og / nx;
            if (og + 1u == (tg + 1u) * nx) xb_add(&bar[XB_TOPGEN], 1u);
            else XB_SPIN(xb_ld(&bar[XB_TOPGEN]) == tg, bar);
            __builtin_amdgcn_fence(__ATOMIC_ACQUIRE, "agent");
            xb_add(&bar[XB_XGEN(b.x)], 1u);
            asm volatile("s_waitcnt vmcnt(0)" ::: "memory");
        } else {
            XB_SPIN(xb_ld(&bar[XB_XGEN(b.x)]) == gen, bar);
            __builtin_amdgcn_fence(__ATOMIC_ACQUIRE, "agent");
            asm volatile("s_waitcnt vmcnt(0)" ::: "memory");
        }
    }
    __syncthreads();
}

__global__ void __launch_bounds__(NT, 2) mega_fwd(Params p) {
    extern __shared__ __attribute__((aligned(16))) unsigned char lds_raw[];
    float* lds = (float*)lds_raw;
    volatile XLAS unsigned* bst = (volatile XLAS unsigned*)((XLAS unsigned char*)lds_raw + LDS_BARST_OFF);
    if (threadIdx.x < 2) bst[threadIdx.x] = 0u;
    __syncthreads();
    (void)xcd_barrier_post((unsigned*)(p.ws + WS_BAR), bst);
#define GSYNC() xcd_barrier(p.ws, lds_raw)
    phase_p0a(p, lds);
    __syncthreads();
    phase_convert(p, lds);
    GSYNC();
    phase_p0b(p);
    GSYNC();
    _Pragma("unroll 1") for (int l = 0; l < L; ++l) {
        phase_r1(p, l, true);
        GSYNC();
        phase_g1_fast(p, l, lds_raw);
        GSYNC();
        phase_ck_fast(p, l, lds_raw);
        GSYNC();
        phase_c2(p, l, lds);
        __syncthreads();
        phase_route(p, lds_raw);
        GSYNC();
        phase_att1(p, lds_raw);
        GSYNC();
        phase_att2(p, lds_raw);
        GSYNC();
        phase_g2_fast(p, l, lds_raw);
        GSYNC();
        phase_r2_fast(p, l, lds_raw);
        GSYNC();
        phase_sc_fast(p, l, lds_raw);
        GSYNC();
        phase_m1_fast(p, l, lds_raw);
        GSYNC();
        phase_m2_fast(p, l, lds_raw);
        GSYNC();
    }
    phase_r1(p, L, false);
}

extern "C" void kernel_launch(void* const* d_in, const int* in_sizes, int n_in, void* d_out, int out_size, void* d_ws, size_t ws_size, hipStream_t stream) {
    static int grid_blocks = 0;
    if (grid_blocks == 0) {
        if (n_in != 21 || out_size != T * D || ws_size < WS_END) { fprintf(stderr, "kernel_launch: unexpected shapes (n_in %d out %d ws %zu need %zu)\n", n_in, out_size, ws_size, (size_t)WS_END); grid_blocks = -1; return; }
        int dev = 0, cus = 0, per_cu = 0;
        hipGetDevice(&dev);
        hipDeviceGetAttribute(&cus, hipDeviceAttributeMultiprocessorCount, dev);
        hipFuncSetAttribute((const void*)mega_fwd, hipFuncAttributeMaxDynamicSharedMemorySize, LDS_BYTES);
        hipOccupancyMaxActiveBlocksPerMultiprocessor(&per_cu, (const void*)mega_fwd, NT, LDS_BYTES);
        if (per_cu < 1) { fprintf(stderr, "kernel_launch: occupancy query says %d blocks per CU\n", per_cu); per_cu = 1; }
        (void)hipGetLastError();
        grid_blocks = cus * 1;
    }
    if (grid_blocks < 0) return;
    if (hipMemsetAsync((char*)d_ws + WS_BAR, 0, 16384, stream) != hipSuccess) { fprintf(stderr, "kernel_launch: memset failed\n"); return; }
    Params p{};
    for (int i = 0; i < 21; ++i) p.in[i] = (const float*)d_in[i];
    p.out = (float*)d_out; p.ws = (unsigned char*)d_ws;
    hipLaunchKernelGGL(mega_fwd, dim3(grid_blocks), dim3(NT), LDS_BYTES, stream, p);
    hipError_t e = hipPeekAtLastError();
    if (e != hipSuccess) fprintf(stderr, "launch failed: %s (grid %d)\n", hipGetErrorString(e), grid_blocks);
}
```

```cpp
#include <hip/hip_runtime.h>
#include <cstdio>
#include <cstdint>

constexpr int Bn = 2, S = 8192, D = 1024, L = 2, T = Bn * S;
constexpr int INW = 2840;
constexpr int NE = 32, TOPK = 4, DFF = 1024;
constexpr int A_TOT = T * TOPK;
constexpr int RMAX = A_TOT + NE * 256;
constexpr int NCMP = 511;
constexpr int NT = 512;
constexpr int NW = NT / 64;
constexpr int LDS_BYTES = 147456;
constexpr float EPS = 1e-6f;
constexpr float NEGF = -1e30f;

constexpr int ZBW = 3072;
constexpr int ZB_Q = 0, ZB_KC = 512, ZB_VC = 640, ZB_KS = 768, ZB_VS = 896, ZB_KW = 1024, ZB_VW = 1152, ZB_MQ = 1280, ZB_MK = 1792, ZB_MV = 2304, ZB_G = 2816;
constexpr float QSCALE = 0.125f * 1.4426950408889634f;
constexpr float LOG2E = 1.4426950408889634f;

constexpr size_t al256(size_t x) { return (x + 255) & ~(size_t)255; }
constexpr size_t WS_BAR = 0;
constexpr size_t WS_MODP = 16384;
constexpr size_t WS_MOD = al256(WS_MODP + (size_t)8 * L * Bn * 6144 * 4);
constexpr size_t WS_CNT = al256(WS_MOD + (size_t)L * Bn * 6144 * 4);
constexpr size_t WS_ROWTOK = al256(WS_CNT + L * 32 * 4);
constexpr size_t WS_ROWW = al256(WS_ROWTOK + (size_t)L * RMAX * 4);
constexpr size_t WS_TOKE = al256(WS_ROWW + (size_t)L * RMAX * 4);
constexpr size_t WS_TOKW = al256(WS_TOKE + (size_t)T * 4 * 4);
constexpr size_t WS_POS = al256(WS_TOKW + (size_t)T * 4 * 4);
constexpr size_t WS_Y = al256(WS_POS + (size_t)T * 4 * 4);
constexpr size_t WS_WINT = al256(WS_Y + (size_t)RMAX * 1024 * 4);
constexpr size_t WS_WOT = al256(WS_WINT + (size_t)L * 3072 * 1024 * 2);
constexpr size_t WS_W1T = al256(WS_WOT + (size_t)L * 1024 * 1024 * 2);
constexpr size_t WS_W2T = al256(WS_W1T + (size_t)L * NE * 2048 * 1024 * 2);
constexpr size_t WS_XN = al256(WS_W2T + (size_t)L * NE * 1024 * 1024 * 2);
constexpr size_t WS_ATTB = al256(WS_XN + (size_t)(T + 1) * D * 2);
constexpr size_t WS_ACT = al256(WS_ATTB + (size_t)T * D * 2);
constexpr size_t WS_ZB = al256(WS_ACT + (size_t)RMAX * DFF * 2);
constexpr size_t WS_GATE = al256(WS_ZB + (size_t)T * ZBW * 2);
constexpr size_t WS_KCB = al256(WS_GATE + (size_t)T * 32 * 4);
constexpr size_t WS_VCB = al256(WS_KCB + (size_t)Bn * 2 * 512 * 64 * 2);
constexpr size_t WS_KMB = al256(WS_VCB + (size_t)Bn * 2 * 512 * 64 * 2);
constexpr size_t WS_XNLO = al256(WS_KMB + (size_t)Bn * 8 * 32 * 64 * 2);
constexpr size_t WS_BC = al256(WS_XNLO + (size_t)T * D * 2);
constexpr size_t WS_WCT = al256(WS_BC + (size_t)(T / 64) * 32 * 4);
constexpr size_t WS_CBP = al256(WS_WCT + (size_t)L * 2 * 128 * 2048 * 2);
constexpr size_t WS_CB = al256(WS_CBP + (size_t)16 * L * 2 * 128 * 4);
constexpr size_t WS_HIDP = al256(WS_CB + (size_t)L * 2 * 128 * 4);
constexpr size_t WS_XAB = al256(WS_HIDP + (size_t)4 * 2 * 2044 * 128 * 4);
constexpr size_t WS_SEL3 = al256(WS_XAB + (size_t)T * D * 2);
constexpr size_t WS_LRK = al256(WS_SEL3 + (size_t)T * 8 * 4);
constexpr size_t WS_ILIST = al256(WS_LRK + (size_t)T * 8 * 4);
constexpr size_t WS_BCM = al256(WS_ILIST + (size_t)16 * 32 * 32 * 256);
constexpr size_t WS_PM = al256(WS_BCM + (size_t)16 * 32 * 32 * 4);
constexpr size_t WS_PL = al256(WS_PM + (size_t)16 * 25600 * 4);
constexpr size_t WS_PO = al256(WS_PL + (size_t)16 * 25600 * 4);
constexpr size_t WS_END = al256(WS_PO + (size_t)16 * 25600 * 64 * 2);

struct Params {
    const float* in[21];
    float* out;
    unsigned char* ws;
};

__device__ __forceinline__ int otid() { int t = threadIdx.x; asm volatile("" : "+v"(t)); return t; }
typedef unsigned short bf16_t;
__device__ __forceinline__ unsigned f2bf(float f) { unsigned u = __builtin_bit_cast(unsigned, f); return (u + 0x7fffu + ((u >> 16) & 1u)) >> 16; }
__device__ __forceinline__ unsigned pk2(float lo, float hi) { return f2bf(lo) | (f2bf(hi) << 16); }
__device__ __forceinline__ float bf2f(bf16_t v) { return __builtin_bit_cast(float, (unsigned)v << 16); }
__device__ __forceinline__ float wave_sum(float v) {
#pragma unroll
    for (int o = 1; o < 64; o <<= 1) v += __shfl_xor(v, o);
    return v;
}
__device__ __forceinline__ float sigmoidf_(float x) { return 1.f / (1.f + __expf(-x)); }
__device__ __forceinline__ float gelu_tanh(float x) {
    const float u = 0.7978845608028654f * (x + 0.044715f * x * x * x);
    return 0.5f * x * (1.f + tanhf(u));
}

__device__ __forceinline__ void phase_p0a(const Params& p, float* lds) {
    const int tid = otid(), gtid = blockIdx.x * NT + tid, gsz = gridDim.x * NT;
    int* cnt = (int*)(p.ws + WS_CNT); int* rowtok = (int*)(p.ws + WS_ROWTOK);
    for (int i = gtid; i < L * 32; i += gsz) cnt[i] = 0;
    for (int i = gtid; i < L * RMAX; i += gsz) rowtok[i] = -1;
    const float* c = p.in[1];
    for (int i = tid; i < Bn * D; i += NT) { const float v = c[i]; lds[i] = v / (1.f + __expf(-v)); }
    __syncthreads();
    const float* ada_w = p.in[2];
    float* modp = (float*)(p.ws + WS_MODP);
    for (int idx = gtid; idx < 8 * L * 6144; idx += gsz) {
        const int col = idx % 6144, l = (idx / 6144) % L, kc = idx / (6144 * L);
        const float* w = ada_w + ((size_t)l * D + kc * 128) * 6144 + col;
        float a0 = 0.f, a1 = 0.f;
#pragma unroll 8
        for (int k = 0; k < 128; ++k) { const float wv = w[(size_t)k * 6144]; a0 += lds[kc * 128 + k] * wv; a1 += lds[D + kc * 128 + k] * wv; }
        modp[((size_t)(kc * L + l) * Bn + 0) * 6144 + col] = a0;
        modp[((size_t)(kc * L + l) * Bn + 1) * 6144 + col] = a1;
    }
    { const float* posw = p.in[9]; const float* w1c = p.in[10]; float* cbp = (float*)(p.ws + WS_CBP);
      for (int idx = gtid; idx < 16 * L * 2 * 128; idx += gsz) {
          const int j = idx & 127, li = (idx >> 7) % (L * 2), kc = idx / (L * 2 * 128);
          const float* w = w1c + ((size_t)li * 2048 + kc * 128) * 128 + j; const float* pp = posw + (size_t)li * 2048 + kc * 128;
          float a = 0.f;
#pragma unroll 8
          for (int k = 0; k < 128; ++k) a += pp[k] * w[(size_t)k * 128];
          cbp[idx] = a; } }
}
__device__ __forceinline__ void phase_p0b(const Params& p) {
    const int gtid = blockIdx.x * NT + otid(), gsz = gridDim.x * NT;
    { const float* cbp = (const float*)(p.ws + WS_CBP); float* cb = (float*)(p.ws + WS_CB);
      for (int idx = gtid; idx < L * 2 * 128; idx += gsz) { float s = 0.f;
#pragma unroll
          for (int kc = 0; kc < 16; ++kc) s += cbp[kc * (L * 2 * 128) + idx];
          cb[idx] = s; } }
    const float* modp = (const float*)(p.ws + WS_MODP); float* mod = (float*)(p.ws + WS_MOD); const float* ada_b = p.in[3];
    for (int idx = gtid; idx < L * Bn * 6144; idx += gsz) {
        const int col = idx % 6144, l = idx / (Bn * 6144);
        float s = ada_b[l * 6144 + col];
#pragma unroll
        for (int kc = 0; kc < 8; ++kc) s += modp[(size_t)kc * L * Bn * 6144 + idx];
        mod[idx] = s;
    }
}

__device__ __forceinline__ void phase_r1(const Params& p, int l, bool do_h) {
    const int lane = otid() & 63, wave = otid() >> 6;
    const int gw = blockIdx.x * NW + wave, ngw = gridDim.x * NW;
    const float* mod = (const float*)(p.ws + WS_MOD);
    const float* xin = p.in[0]; float* XA = p.out;
    const bf16_t* Y = (const bf16_t*)(p.ws + WS_Y); const int* pos = (const int*)(p.ws + WS_POS); const float* tokw = (const float*)(p.ws + WS_TOKW);
    const float* lng = p.in[4] + (size_t)(do_h ? l : 0) * D;
    bf16_t* XN = (bf16_t*)(p.ws + WS_XN); bf16_t* XAB = (bf16_t*)(p.ws + WS_XAB);
#define BF4(q) make_float4(__builtin_bit_cast(float, (q).x << 16), __builtin_bit_cast(float, (q).x & 0xffff0000u), __builtin_bit_cast(float, (q).y << 16), __builtin_bit_cast(float, (q).y & 0xffff0000u))
    int curb = -1; float4 g2v[4], ga[4], s0v[4];
    for (int t0 = gw; t0 < T; t0 += ngw) {
        const int nr = 1;
        float4 v[2][4];
        if (l == 0) {
#pragma unroll
            for (int i = 0; i < 2; ++i) if (i < nr) {
#pragma unroll
                for (int j = 0; j < 4; ++j) v[i][j] = *(const float4*)(xin + (size_t)(t0 + i * ngw) * D + 4 * lane + 256 * j); }
        } else {
            int4 ps[2]; float4 tw[2]; uint2 xq[2][4];
#pragma unroll
            for (int i = 0; i < 2; ++i) if (i < nr) { const int t = t0 + i * ngw; ps[i] = *(const int4*)(pos + (size_t)t * 4); tw[i] = *(const float4*)(tokw + (size_t)t * 4);
#pragma unroll
                for (int j = 0; j < 4; ++j) xq[i][j] = *(const uint2*)(XAB + (size_t)t * D + 4 * lane + 256 * j); }
            uint2 yq[2][4][4];
#pragma unroll
            for (int i = 0; i < 2; ++i) if (i < nr) {
#pragma unroll
                for (int j = 0; j < 4; ++j) { const int col = 4 * lane + 256 * j;
                    yq[i][j][0] = *(const uint2*)(Y + (size_t)ps[i].x * D + col); yq[i][j][1] = *(const uint2*)(Y + (size_t)ps[i].y * D + col);
                    yq[i][j][2] = *(const uint2*)(Y + (size_t)ps[i].z * D + col); yq[i][j][3] = *(const uint2*)(Y + (size_t)ps[i].w * D + col); } }
#pragma unroll
            for (int i = 0; i < 2; ++i) if (i < nr) {
                const int t = t0 + i * ngw, b = t / S;
                if (b != curb) { curb = b;
                    const float* g2 = mod + ((size_t)(l - 1) * Bn + b) * 6144 + 5 * D;
#pragma unroll
                    for (int j = 0; j < 4; ++j) g2v[j] = *(const float4*)(g2 + 4 * lane + 256 * j);
                    if (do_h) { const float* sh = mod + ((size_t)l * Bn + b) * 6144 + 0 * D; const float* sc = mod + ((size_t)l * Bn + b) * 6144 + 1 * D;
#pragma unroll
                        for (int j = 0; j < 4; ++j) { const int col = 4 * lane + 256 * j; const float4 g = *(const float4*)(lng + col), s1 = *(const float4*)(sc + col); s0v[j] = *(const float4*)(sh + col);
                            ga[j] = make_float4(g.x * (1.f + s1.x), g.y * (1.f + s1.y), g.z * (1.f + s1.z), g.w * (1.f + s1.w)); } } }
#pragma unroll
                for (int j = 0; j < 4; ++j) {
                    const int col = 4 * lane + 256 * j;
                    const float4 x = BF4(xq[i][j]);
                    const float4 y0 = BF4(yq[i][j][0]), y1 = BF4(yq[i][j][1]), y2 = BF4(yq[i][j][2]), y3 = BF4(yq[i][j][3]);
                    const float4 g = g2v[j];
                    float4 r;
                    r.x = x.x + g.x * (((tw[i].x * y0.x + tw[i].y * y1.x) + tw[i].z * y2.x) + tw[i].w * y3.x); r.y = x.y + g.y * (((tw[i].x * y0.y + tw[i].y * y1.y) + tw[i].z * y2.y) + tw[i].w * y3.y);
                    r.z = x.z + g.z * (((tw[i].x * y0.z + tw[i].y * y1.z) + tw[i].z * y2.z) + tw[i].w * y3.z); r.w = x.w + g.w * (((tw[i].x * y0.w + tw[i].y * y1.w) + tw[i].z * y2.w) + tw[i].w * y3.w);
                    v[i][j] = r;
                    if (do_h) *(uint2*)(XAB + (size_t)t * D + col) = make_uint2(pk2(r.x, r.y), pk2(r.z, r.w));
                    else *(float4*)(XA + (size_t)t * D + col) = r;
                }
            }
        }
        if (do_h) {
#pragma unroll
            for (int i = 0; i < 2; ++i) if (i < nr) {
                const int t = t0 + i * ngw, b = t / S;
                if (b != curb) { curb = b;
                    const float* sh = mod + ((size_t)l * Bn + b) * 6144 + 0 * D; const float* sc = mod + ((size_t)l * Bn + b) * 6144 + 1 * D;
#pragma unroll
                    for (int j = 0; j < 4; ++j) { const int col = 4 * lane + 256 * j; const float4 g = *(const float4*)(lng + col), s1 = *(const float4*)(sc + col); s0v[j] = *(const float4*)(sh + col);
                        ga[j] = make_float4(g.x * (1.f + s1.x), g.y * (1.f + s1.y), g.z * (1.f + s1.z), g.w * (1.f + s1.w)); } }
                float ss = 0.f;
#pragma unroll
                for (int j = 0; j < 4; ++j) ss += (v[i][j].x * v[i][j].x + v[i][j].y * v[i][j].y) + (v[i][j].z * v[i][j].z + v[i][j].w * v[i][j].w);
                ss = wave_sum(ss);
                const float r = rsqrtf(ss * (1.f / D) + EPS);
#pragma unroll
                for (int j = 0; j < 4; ++j) {
                    const int col = 4 * lane + 256 * j;
                    float4 o;
                    o.x = v[i][j].x * r * ga[j].x + s0v[j].x; o.y = v[i][j].y * r * ga[j].y + s0v[j].y;
                    o.z = v[i][j].z * r * ga[j].z + s0v[j].z; o.w = v[i][j].w * r * ga[j].w + s0v[j].w;
                    *(uint2*)(XN + (size_t)t * D + col) = make_uint2(pk2(o.x, o.y), pk2(o.z, o.w));
                }
            }
        }
    }
#undef BF4
}


__device__ __forceinline__ void phase_c2(const Params& p, int l, float* lds) {
    const int lane = otid() & 63, wave = otid() >> 6;
    const float* HIDP = (const float*)(p.ws + WS_HIDP); const float* cb = (const float*)(p.ws + WS_CB) + l * 2 * 128; const float* w2 = p.in[11] + (size_t)l * 2 * 128 * 64;
    const float gk = p.in[8][l * 64 + lane];
    float* hl = lds + wave * 128;
    for (int r = blockIdx.x * NW + wave; r < 2 * 2044; r += gridDim.x * NW) {
        const int idx = r / 2044, rr = r % 2044;
#pragma unroll
        for (int q = 0; q < 2; ++q) { const int j = lane + 64 * q; float s = cb[idx * 128 + j];
#pragma unroll
            for (int kq = 0; kq < 4; ++kq) s += HIDP[((size_t)(kq * 2 + idx) * 2044 + rr) * 128 + j];
            hl[j] = gelu_tanh(s); }
        asm volatile("s_waitcnt lgkmcnt(0)" ::: "memory"); __builtin_amdgcn_wave_barrier();
        const float* W = w2 + (size_t)idx * 128 * 64;
        float s = 0.f;
#pragma unroll 8
        for (int j = 0; j < 128; ++j) s += hl[j] * W[j * 64 + lane];
        asm volatile("s_waitcnt lgkmcnt(0)" ::: "memory"); __builtin_amdgcn_wave_barrier();
        const int bgi = rr / 511, n = rr % 511;
        if (idx == 0) { const float ss = wave_sum(s * s); const float kv = s * rsqrtf(ss * (1.f / 64.f) + EPS) * gk; ((bf16_t*)(p.ws + WS_KCB))[((size_t)bgi * 512 + n) * 64 + lane] = (bf16_t)f2bf(kv); }
        else { ((bf16_t*)(p.ws + WS_VCB))[((size_t)bgi * 512 + n) * 64 + lane] = (bf16_t)f2bf(s); }
    }
    if (blockIdx.x == 0 && otid() < 2 * 4 * 64) { const int i = otid(); bf16_t* dst = (bf16_t*)(p.ws + (i < 256 ? WS_KCB : WS_VCB)); dst[((size_t)((i & 255) >> 6) * 512 + 511) * 64 + (i & 63)] = 0; }
}

__device__ __forceinline__ void load_pstart(const Params& p, int l, int* ps) {
    const int* cnt = (const int*)(p.ws + WS_CNT) + l * 32;
    if (otid() == 0) { int s = 0; for (int e = 0; e < 32; ++e) { ps[e] = s; s += (cnt[e] + 255) & ~255; } ps[32] = s; }
    __syncthreads();
}


template <int MAP>
__device__ __forceinline__ void tr_tile(const float* W, int Nsrc, bf16_t* WT, int K, int k0, int n0, float* scr, int lane) {
    const int nl = (lane & 15) * 4, kr = lane >> 4;
    int sc = n0 + nl;
    if (MAP == 1) { sc = sc < 1280 ? sc : (sc < 2816 ? sc + 24 : (sc < 2840 ? sc - 2816 + 1280 : -1)); }
    float4 v[16];
#pragma unroll
    for (int it = 0; it < 16; ++it) { if (sc >= 0) { const float* src_ = W + (size_t)(k0 + it * 4 + kr) * Nsrc + sc; typedef float f4v __attribute__((ext_vector_type(4))); const f4v t_ = __builtin_nontemporal_load((const f4v*)src_); v[it] = make_float4(t_[0], t_[1], t_[2], t_[3]); } else v[it] = make_float4(0.f, 0.f, 0.f, 0.f); }
#pragma unroll
    for (int it = 0; it < 16; ++it) { float* s = scr + (it * 4 + kr) * 65 + nl; s[0] = v[it].x; s[1] = v[it].y; s[2] = v[it].z; s[3] = v[it].w; }
    asm volatile("s_waitcnt lgkmcnt(0)" ::: "memory"); __builtin_amdgcn_wave_barrier();
    const int c = lane & 7, nr = lane >> 3;
#pragma unroll
    for (int it = 0; it < 8; ++it) {
        const int n = it * 8 + nr; const float* s = scr + (8 * c) * 65 + n;
        uint4 o; o.x = pk2(s[0], s[65]); o.y = pk2(s[2 * 65], s[3 * 65]); o.z = pk2(s[4 * 65], s[5 * 65]); o.w = pk2(s[6 * 65], s[7 * 65]);
        *(uint4*)(WT + (size_t)(n0 + n) * K + k0 + 8 * c) = o;
    }
    asm volatile("s_waitcnt lgkmcnt(0)" ::: "memory"); __builtin_amdgcn_wave_barrier();
}
__device__ __forceinline__ void phase_convert(const Params& p, float* lds) {
    const int tid = otid(), lane = tid & 63, wave = tid >> 6;
    float* scr = lds + wave * (64 * 65);
    const int gw = blockIdx.x * NW + wave, ngw = gridDim.x * NW;
    bf16_t* WinT = (bf16_t*)(p.ws + WS_WINT); bf16_t* WoT = (bf16_t*)(p.ws + WS_WOT); bf16_t* W1T = (bf16_t*)(p.ws + WS_W1T); bf16_t* W2T = (bf16_t*)(p.ws + WS_W2T);
    constexpr int I_IN = L * 16 * (ZBW / 64), I_O = L * 16 * 16, I_1 = L * NE * 16 * 32, I_2 = L * NE * 16 * 16, I_C = L * 2 * 32 * 2;
    for (int it = gw; it < I_C + I_IN + I_O + I_1 + I_2; it += ngw) {
        int r = it;
        if (r < I_C) { const int li = r / 64, q = r % 64, kb = q / 2, nb = q % 2;
            tr_tile<0>(p.in[10] + (size_t)li * 2048 * 128, 128, (bf16_t*)(p.ws + WS_WCT) + (size_t)li * 128 * 2048, 2048, kb * 64, nb * 64, scr, lane); continue; }
        r -= I_C;
        if (r < I_IN) { const int l = r / (16 * 48), q = r % (16 * 48), kb = q / 48, nb = q % 48;
            tr_tile<1>(p.in[6] + (size_t)l * D * INW, INW, WinT + (size_t)l * ZBW * D, D, kb * 64, nb * 64, scr, lane); continue; }
        r -= I_IN;
        if (r < I_O) { const int l = r / 256, q = r % 256, kb = q / 16, nb = q % 16;
            tr_tile<0>(p.in[14] + (size_t)l * D * D, D, WoT + (size_t)l * D * D, D, kb * 64, nb * 64, scr, lane); continue; }
        r -= I_O;
        if (r < I_1) { const int le = r / 512, q = r % 512, kb = q / 32, nb = q % 32;
            tr_tile<0>(p.in[17] + (size_t)le * D * 2048, 2048, W1T + (size_t)le * 2048 * D, D, kb * 64, nb * 64, scr, lane); continue; }
        r -= I_1;
        { const int le = r / 256, q = r % 256, kb = q / 16, nb = q % 16;
            tr_tile<0>(p.in[19] + (size_t)le * DFF * D, D, W2T + (size_t)le * D * DFF, DFF, kb * 64, nb * 64, scr, lane); }
    }
    if (blockIdx.x == 0) { bf16_t* XN = (bf16_t*)(p.ws + WS_XN); for (int i = tid; i < D / 2; i += NT) ((unsigned*)(XN + (size_t)T * D))[i] = 0u; }
}

namespace pg8 {
#define PG8_LAS __attribute__((address_space(3)))
typedef short bf16x8 __attribute__((ext_vector_type(8)));
typedef float f32x4 __attribute__((ext_vector_type(4)));
typedef unsigned u32x4 __attribute__((ext_vector_type(4)));
constexpr int BM = 256, BK = 64, HALF = 128, HTB = HALF * BK * 2, STAGE_BYTES = 8 * HTB, NXCD = 8, WGM = 8;
__device__ __forceinline__ int lds_byte(int r, int c) { const int st = (r >> 4) * 2 + (c >> 5), rr = r & 15, cc = c & 31, ob = rr * 64 + cc * 2; return st * 1024 + (ob ^ (((ob >> 9) & 1) << 5)); }
__device__ __forceinline__ void stage_rc(int b, int& R, int& C) { const int st = b / 1024, sb = b % 1024, swz = sb ^ (((sb >> 9) & 1) << 5); R = (st >> 1) * 16 + swz / 64; C = (st & 1) * 32 + (swz % 64) / 2; }
__device__ __forceinline__ int perm32(int rho) { const int n = rho >> 4, i = rho & 15; return 8 * (i >> 2) + 4 * n + (i & 3); }
struct Unit { int pm, pn, e; };
__device__ __forceinline__ unsigned cvt_pk_bf16(float lo, float hi) { unsigned r; asm volatile("v_cvt_pk_bf16_f32 %0, %1, %2" : "=v"(r) : "v"(lo), "v"(hi)); return r; }

__device__ __forceinline__ bool static_next(int nM, int nN, int G, int c, int i, Unit& u) {
    const int nwg = nM * nN; const long Lq = (long)i * G + c; if (Lq >= nwg) return false;
    int wgid = (int)Lq; { const int q = nwg / NXCD, r = nwg % NXCD, xcd = wgid % NXCD, off = wgid / NXCD; wgid = (xcd < r ? xcd * (q + 1) : r * (q + 1) + (xcd - r) * q) + off; }
    const int nig = WGM * nN, gid = wgid / nig, fm = gid * WGM, gsz = (nM - fm) < WGM ? (nM - fm) : WGM;
    u.pm = fm + ((wgid % nig) % gsz); u.pn = (wgid % nig) / gsz; u.e = 0; return true;
}

template <class Prob, class Epi, bool ALIGN_EPI, bool SP2>
__device__ __forceinline__ void gemm_phase(PG8_LAS unsigned char* lds, const Prob& P, const Epi& E) {
    const int tid = otid(), wid = __builtin_amdgcn_readfirstlane(tid >> 6), lane = tid & 63, wr = wid >> 2, wc = wid & 3, fr = lane & 15, fq = lane >> 4;
    const int K = P.K, nt = Prob::KT > 0 ? Prob::KT : K / BK;
    int sR[2], sC[2]; unsigned voffB[2];
#pragma unroll
    for (int i = 0; i < 2; ++i) { stage_rc(tid * 16 + i * 8192, sR[i], sC[i]); voffB[i] = (unsigned)(P.b_row(sR[i]) * K + sC[i]) * 2u; }
    const size_t kstep = (size_t)(BK * 2);
    const size_t kstepA = P.a_kstep();
    const size_t hstepB = P.b_hstep();
    const unsigned ldsw = (unsigned)wid * 1024u;
    const int aoff = lds_byte(wr * 64 + fr, fq * 8), boff = lds_byte(wc * 32 + fr, fq * 8);
#define PG8_SA(b, h) (((b) * 2 + (h)) * HTB)
#define PG8_SB(b, h) ((4 + (b) * 2 + (h)) * HTB)
#define PG8_STAGE(bufoff, gbase, voff) do { _Pragma("unroll") for (int _i = 0; _i < 2; ++_i) \
        __builtin_amdgcn_global_load_lds((const unsigned*)((const char*)(gbase) + (voff)[_i]), (PG8_LAS unsigned*)(lds + (bufoff) + ldsw + _i * 8192), 16, 0, 0); } while (0)
#define PG8_STAGE_SEL(bufoff, gbase, h) do { _Pragma("unroll") for (int _i = 0; _i < 2; ++_i) { unsigned _vo = vAc[h][_i]; if constexpr (Prob::GATHER) _vo = last ? vAn[h][_i] : _vo; \
        __builtin_amdgcn_global_load_lds((const unsigned*)((const char*)(gbase) + _vo), (PG8_LAS unsigned*)(lds + (bufoff) + ldsw + _i * 8192), 16, 0, 0); } } while (0)
#define PG8_LDA(dst, b, h) do { _Pragma("unroll") for (int m = 0; m < 4; ++m) _Pragma("unroll") for (int k = 0; k < 2; ++k) dst[m][k] = *(const PG8_LAS bf16x8*)(lds + PG8_SA(b, h) + aoff + m * 2048 + k * 1024); } while (0)
#define PG8_LDB(dst, b, h) do { _Pragma("unroll") for (int n = 0; n < 2; ++n) _Pragma("unroll") for (int k = 0; k < 2; ++k) dst[n][k] = *(const PG8_LAS bf16x8*)(lds + PG8_SB(b, h) + boff + n * 2048 + k * 1024); } while (0)
#define PG8_MMA(ai, bj, At, Bt) do { __builtin_amdgcn_s_setprio(1); _Pragma("unroll") for (int m = 0; m < 4; ++m) _Pragma("unroll") for (int n = 0; n < 2; ++n) _Pragma("unroll") for (int k = 0; k < 2; ++k) \
        acc[ai][bj][m][n] = __builtin_amdgcn_mfma_f32_16x16x32_bf16(Bt[n][k], At[m][k], acc[ai][bj][m][n], 0, 0, 0); __builtin_amdgcn_s_setprio(0); } while (0)
#define PG8_WAIT_V(n) asm volatile("s_waitcnt vmcnt(" #n ")" ::: "memory")
#define PG8_WAIT_L(n) asm volatile("s_waitcnt lgkmcnt(" #n ")" ::: "memory")
#define PG8_BAR __builtin_amdgcn_s_barrier()
#define PG8_SCHED __builtin_amdgcn_sched_barrier(0)
    Unit cur, nxt; int ui = 0;
    if (!P.next(0, cur)) return;
    nxt = cur;
    f32x4 acc[2][2][4][2];
    typename Epi::Pre pre;
    E.prefetch(cur, wc, fq, pre); E.init(acc, pre);
    bf16x8 At[4][2], B0[2][2], B1[2][2];
    unsigned vAc[2][2], vAn[2][2];
    const char* cA = P.a_base(cur); const char* cB = P.b_base(cur);
    P.a_voff(cur, sR, sC, vAc);
#pragma unroll
    for (int h = 0; h < 2; ++h)
#pragma unroll
        for (int i = 0; i < 2; ++i) vAn[h][i] = vAc[h][i];
    if constexpr (SP2) {
        PG8_STAGE(PG8_SB(0, 0), cB, voffB); PG8_STAGE(PG8_SB(0, 1), cB + hstepB, voffB); PG8_STAGE(PG8_SA(0, 0), cA, vAc[0]); PG8_STAGE(PG8_SA(0, 1), cA, vAc[1]);
        if (wr == 1) PG8_BAR;
        PG8_WAIT_V(2); PG8_BAR;
        PG8_STAGE(PG8_SB(1, 0), cB + kstep, voffB); PG8_STAGE(PG8_SA(1, 0), cA + kstepA, vAc[0]); PG8_STAGE(PG8_SB(1, 1), cB + hstepB + kstep, voffB);
        PG8_WAIT_V(6); PG8_BAR;
    } else {
        PG8_STAGE(PG8_SB(0, 0), cB, voffB); PG8_STAGE(PG8_SA(0, 0), cA, vAc[0]); PG8_STAGE(PG8_SB(0, 1), cB + hstepB, voffB); PG8_STAGE(PG8_SA(0, 1), cA, vAc[1]);
        if (wr == 1) PG8_BAR;
        PG8_WAIT_V(4); PG8_BAR;
        PG8_STAGE(PG8_SB(1, 0), cB + kstep, voffB); PG8_STAGE(PG8_SA(1, 0), cA + kstepA, vAc[0]); PG8_STAGE(PG8_SB(1, 1), cB + hstepB + kstep, voffB);
        PG8_WAIT_V(6); PG8_BAR;
    }
    for (;;) {
        const bool has_next = P.next(ui + 1, nxt);
        const char* nA = cA; const char* nB = cB;
        if (has_next) { nA = P.a_base(nxt); nB = P.b_base(nxt); if constexpr (Prob::GATHER) P.a_voff(nxt, sR, sC, vAn); }
        for (int t = 0; t < nt; t += 2) {
            const bool last = (t == nt - 2);
            const char* a1 = cA + (size_t)(t + 1) * kstepA;
            const char* a2 = last ? nA : cA + (size_t)(t + 2) * kstepA; const char* b2 = last ? nB : cB + (size_t)(t + 2) * kstep;
            const char* a3 = a2 + kstepA; const char* b3 = b2 + kstep;
            if constexpr (SP2) {
            PG8_LDB(B0, 0, 0); PG8_LDB(B1, 0, 1); PG8_SCHED; PG8_LDA(At, 0, 0); PG8_STAGE(PG8_SA(1, 1), a1, vAc[1]);
            PG8_WAIT_V(8); PG8_WAIT_L(0); PG8_BAR; PG8_MMA(0, 0, At, B0); PG8_MMA(0, 1, At, B1); PG8_BAR; PG8_SCHED;
            PG8_LDA(At, 0, 1); PG8_STAGE(PG8_SB(0, 0), b2, voffB); PG8_STAGE(PG8_SB(0, 1), b2 + hstepB, voffB); PG8_STAGE_SEL(PG8_SA(0, 0), a2, 0);
            PG8_WAIT_V(8); PG8_WAIT_L(0); PG8_BAR; PG8_MMA(1, 0, At, B0); PG8_MMA(1, 1, At, B1); PG8_BAR; PG8_SCHED;
            PG8_LDB(B0, 1, 0); PG8_LDB(B1, 1, 1); PG8_SCHED; PG8_LDA(At, 1, 0); PG8_STAGE_SEL(PG8_SA(0, 1), a2, 1);
            PG8_WAIT_V(8); PG8_WAIT_L(0); PG8_BAR; PG8_MMA(0, 0, At, B0); PG8_MMA(0, 1, At, B1); PG8_BAR; PG8_SCHED;
            PG8_LDA(At, 1, 1); PG8_STAGE(PG8_SB(1, 0), b3, voffB); PG8_STAGE(PG8_SB(1, 1), b3 + hstepB, voffB); PG8_STAGE_SEL(PG8_SA(1, 0), a3, 0);
            PG8_WAIT_V(8); PG8_WAIT_L(0); PG8_BAR; PG8_MMA(1, 0, At, B0); PG8_MMA(1, 1, At, B1); PG8_BAR; PG8_SCHED;
            } else {
            PG8_LDB(B0, 0, 0); PG8_SCHED; PG8_LDA(At, 0, 0); PG8_STAGE(PG8_SA(1, 1), a1, vAc[1]);
            PG8_WAIT_L(8); PG8_BAR; PG8_WAIT_L(0); PG8_MMA(0, 0, At, B0); PG8_BAR; PG8_SCHED;
            PG8_LDB(B1, 0, 1); PG8_STAGE(PG8_SB(0, 0), b2, voffB);
            PG8_BAR; PG8_WAIT_L(0); PG8_MMA(0, 1, At, B1); PG8_BAR;
            PG8_LDA(At, 0, 1); PG8_STAGE_SEL(PG8_SA(0, 0), a2, 0);
            PG8_BAR; PG8_WAIT_L(0); PG8_MMA(1, 0, At, B0); PG8_BAR; PG8_SCHED;
            PG8_STAGE(PG8_SB(0, 1), b2 + hstepB, voffB);
            PG8_WAIT_V(6); PG8_BAR; PG8_MMA(1, 1, At, B1); PG8_BAR;
            PG8_LDB(B0, 1, 0); PG8_SCHED; PG8_LDA(At, 1, 0); PG8_STAGE_SEL(PG8_SA(0, 1), a2, 1);
            PG8_WAIT_L(8); PG8_BAR; PG8_WAIT_L(0); PG8_MMA(0, 0, At, B0); PG8_BAR; PG8_SCHED;
            PG8_LDB(B1, 1, 1); PG8_STAGE(PG8_SB(1, 0), b3, voffB);
            PG8_BAR; PG8_WAIT_L(0); PG8_MMA(0, 1, At, B1); PG8_BAR;
            PG8_LDA(At, 1, 1); PG8_STAGE_SEL(PG8_SA(1, 0), a3, 0);
            PG8_BAR; PG8_WAIT_L(0); PG8_MMA(1, 0, At, B0); PG8_BAR; PG8_SCHED;
            PG8_STAGE(PG8_SB(1, 1), b3 + hstepB, voffB);
            PG8_WAIT_V(6); PG8_BAR; PG8_MMA(1, 1, At, B1); PG8_BAR;
            }
        }
        if constexpr (ALIGN_EPI) { if (wr == 0) PG8_BAR; }
        E(acc, cur, wr, wc, fr, fq, has_next, nxt, pre);
        if (!has_next) break;
        E.init(acc, pre);
        cur = nxt; cA = nA; cB = nB; ++ui;
        if constexpr (Prob::GATHER) {
#pragma unroll
            for (int h = 0; h < 2; ++h)
#pragma unroll
                for (int i = 0; i < 2; ++i) vAc[h][i] = vAn[h][i];
        }
        if constexpr (ALIGN_EPI) { if (wr == 1) PG8_BAR; }
    }
    PG8_WAIT_V(0);
    if constexpr (!ALIGN_EPI) { if (wr == 0) PG8_BAR; }
    PG8_BAR;
#undef PG8_SA
#undef PG8_SB
#undef PG8_STAGE
#undef PG8_STAGE_SEL
#undef PG8_LDA
#undef PG8_LDB
#undef PG8_MMA
#undef PG8_WAIT_V
#undef PG8_WAIT_L
#undef PG8_BAR
#undef PG8_SCHED
}

struct ProbDense { static constexpr bool GATHER = false; static constexpr int KT = 0;
    const bf16_t* A; const bf16_t* Bt; int K, nM, nN, G, c; bool headperm;
    __device__ __forceinline__ bool next(int i, Unit& u) const { return static_next(nM, nN, G, c, i, u); }
    __device__ __forceinline__ const char* a_base(const Unit& u) const { return (const char*)(A + (size_t)u.pm * BM * K); }
    __device__ __forceinline__ void a_voff(const Unit&, const int (&R)[2], const int (&C)[2], unsigned (&v)[2][2]) const {
#pragma unroll
        for (int h = 0; h < 2; ++h)
#pragma unroll
            for (int i = 0; i < 2; ++i) v[h][i] = (unsigned)((h * HALF + R[i]) * K + C[i]) * 2u;
    }
    __device__ __forceinline__ const char* b_base(const Unit& u) const { return (const char*)(Bt + (size_t)u.pn * BM * K); }
    __device__ __forceinline__ size_t a_kstep() const { return (size_t)BK * 2; }
    __device__ __forceinline__ size_t b_hstep() const { return headperm ? (size_t)32 * K * 2 : (size_t)HALF * K * 2; }
    __device__ __forceinline__ int b_row(int R) const { return headperm ? ((R >> 5) * 64 + perm32(R & 31)) : ((R & ~31) + perm32(R & 31)); }
};
typedef const PG8_LAS int* lds_ints;
__device__ __forceinline__ int expert_of(lds_ints ps, int pm) { int e = 0;
#pragma unroll
    for (int i = 1; i < 32; ++i) if (ps[i] <= pm * 256) e = i;
    return __builtin_amdgcn_readfirstlane(e); }
struct ProbMoe1 { static constexpr bool GATHER = true; static constexpr int KT = 0;
    const bf16_t* XN; const bf16_t* W1T; const int* rowtok; lds_ints ps; int K, ntm, G, c;
    __device__ __forceinline__ bool next(int i, Unit& u) const { const int q = i * G + c; if (q >= ntm * 8) return false; u.pm = q >> 3; u.pn = q & 7; u.e = expert_of(ps, u.pm); return true; }
    __device__ __forceinline__ const char* a_base(const Unit&) const { return (const char*)XN; }
    __device__ __forceinline__ void a_voff(const Unit& u, const int (&R)[2], const int (&C)[2], unsigned (&v)[2][2]) const {
#pragma unroll
        for (int h = 0; h < 2; ++h)
#pragma unroll
            for (int i = 0; i < 2; ++i) { int tk = rowtok[u.pm * BM + h * HALF + R[i]]; if (tk < 0) tk = T; v[h][i] = (unsigned)(tk * K + C[i]) * 2u; }
    }
    __device__ __forceinline__ const char* b_base(const Unit& u) const { return (const char*)(W1T + ((size_t)u.e * 2048 + u.pn * 128) * K); }
    __device__ __forceinline__ size_t a_kstep() const { return (size_t)BK * 2; }
    __device__ __forceinline__ size_t b_hstep() const { return (size_t)1024 * K * 2; }
    __device__ __forceinline__ int b_row(int R) const { return (R & ~31) + perm32(R & 31); }
};
struct ProbMoe2 { static constexpr bool GATHER = false; static constexpr int KT = 0;
    const bf16_t* ACT; const bf16_t* W2T; lds_ints ps; int K, ntm, G, c;
    __device__ __forceinline__ bool next(int i, Unit& u) const { const int q = i * G + c; if (q >= ntm * 4) return false; u.pm = q >> 2; u.pn = q & 3; u.e = expert_of(ps, u.pm); return true; }
    __device__ __forceinline__ const char* a_base(const Unit& u) const { return (const char*)(ACT + (size_t)u.pm * BM * K); }
    __device__ __forceinline__ void a_voff(const Unit&, const int (&R)[2], const int (&C)[2], unsigned (&v)[2][2]) const {
#pragma unroll
        for (int h = 0; h < 2; ++h)
#pragma unroll
            for (int i = 0; i < 2; ++i) v[h][i] = (unsigned)((h * HALF + R[i]) * K + C[i]) * 2u;
    }
    __device__ __forceinline__ const char* b_base(const Unit& u) const { return (const char*)(W2T + ((size_t)u.e * 1024 + u.pn * BM) * K); }
    __device__ __forceinline__ size_t a_kstep() const { return (size_t)BK * 2; }
    __device__ __forceinline__ size_t b_hstep() const { return (size_t)HALF * K * 2; }
    __device__ __forceinline__ int b_row(int R) const { return (R & ~31) + perm32(R & 31); }
};

struct ProbCmp { static constexpr bool GATHER = false; static constexpr int KT = 8;
    const bf16_t* ZB; const bf16_t* W1T; int K, G, c;
    __device__ __forceinline__ bool next(int i, Unit& u) const { const int q = i * G + c; if (q >= 64) return false; u.pm = q & 15; u.pn = 0; u.e = q >> 4; return true; }
    __device__ __forceinline__ const char* a_base(const Unit& u) const { const int idx = u.pm >> 3, bg = (u.pm >> 1) & 3, half = u.pm & 1;
        return (const char*)(ZB + ((size_t)(bg >> 1) * S + 16 * 256 * half + 8 * u.e) * ZBW + ZB_KC + idx * 128 + (bg & 1) * 64); }
    __device__ __forceinline__ void a_voff(const Unit&, const int (&R)[2], const int (&C)[2], unsigned (&v)[2][2]) const {
#pragma unroll
        for (int h = 0; h < 2; ++h)
#pragma unroll
            for (int i = 0; i < 2; ++i) v[h][i] = (unsigned)(16 * (h * HALF + R[i]) * ZBW + C[i]) * 2u;
    }
    __device__ __forceinline__ size_t a_kstep() const { return (size_t)ZBW * 2; }
    __device__ __forceinline__ const char* b_base(const Unit& u) const { return (const char*)(W1T + (size_t)(u.pm >> 3) * 128 * K + 8 * 64 * u.e); }
    __device__ __forceinline__ size_t b_hstep() const { return 0; }
    __device__ __forceinline__ int b_row(int R) const { return (R & ~31) + perm32(R & 31); }
};
struct EpiCmp {
    float* HIDP;
    struct Pre {};
    __device__ __forceinline__ void prefetch(const Unit&, int, int, Pre&) const {}
    __device__ __forceinline__ void init(f32x4 (&acc)[2][2][4][2], const Pre&) const {
#pragma unroll
        for (int a = 0; a < 2; ++a)
#pragma unroll
            for (int b = 0; b < 2; ++b)
#pragma unroll
                for (int m = 0; m < 4; ++m)
#pragma unroll
                    for (int n = 0; n < 2; ++n) acc[a][b][m][n] = (f32x4){0.f, 0.f, 0.f, 0.f};
    }
    __device__ __forceinline__ void operator()(const f32x4 (&acc)[2][2][4][2], const Unit& u, int wr, int wc, int fr, int fq, bool has_next, const Unit& nxt, Pre& pre) const {
        const int idx = u.pm >> 3, bg = (u.pm >> 1) & 3, half = u.pm & 1;
        const int c0 = 32 * wc + 8 * fq;
#pragma unroll
        for (int ai = 0; ai < 2; ++ai)
#pragma unroll
            for (int m = 0; m < 4; ++m) { const int n = 256 * half + ai * HALF + wr * 64 + m * 16 + fr;
                if (n < 511) { float* dst = HIDP + (((size_t)u.e * 2 + idx) * 2044 + bg * 511 + n) * 128 + c0;
                    *(f32x4*)dst = acc[ai][0][m][0]; *(f32x4*)(dst + 4) = acc[ai][0][m][1]; } }
    }
};
struct EpiG1F {
    bf16_t* ZB; float* GATE; const float* gq; const float* gk; const float* gmq; const float* gmk;
    struct Pre {};
    __device__ __forceinline__ void prefetch(const Unit&, int, int, Pre&) const {}
    __device__ __forceinline__ void init(f32x4 (&acc)[2][2][4][2], const Pre&) const {
#pragma unroll
        for (int a = 0; a < 2; ++a)
#pragma unroll
            for (int b = 0; b < 2; ++b)
#pragma unroll
                for (int m = 0; m < 4; ++m)
#pragma unroll
                    for (int n = 0; n < 2; ++n) acc[a][b][m][n] = (f32x4){0.f, 0.f, 0.f, 0.f};
    }
    __device__ __forceinline__ void operator()(const f32x4 (&acc)[2][2][4][2], const Unit& u, int wr, int wc, int fr, int fq, bool has_next, const Unit& nxt, Pre& pre) const {
        const int pn = u.pn;
        const float* gain = nullptr; float sc = 1.f;
        if (pn < 2) { gain = gq; sc = QSCALE; }
        else if (pn == 3 || pn == 4) { if (wc < 2) gain = gk; }
        else if (pn == 5 || pn == 6) { gain = gmq; sc = QSCALE; }
        else if (pn == 7 || pn == 8) { gain = gmk; }
        if (pn == 11) {
            if (wc == 0 && fq < 3) {
#pragma unroll
                for (int ai = 0; ai < 2; ++ai)
#pragma unroll
                    for (int m = 0; m < 4; ++m) { const size_t r = (size_t)u.pm * BM + ai * HALF + wr * 64 + m * 16 + fr;
#pragma unroll
                        for (int n = 0; n < 2; ++n) { const f32x4 v = acc[ai][0][m][n]; f32x4 o;
#pragma unroll
                            for (int i = 0; i < 4; ++i) o[i] = __builtin_amdgcn_rcpf(1.f + __builtin_amdgcn_exp2f(-LOG2E * v[i]));
                            *(f32x4*)(GATE + r * 32 + 8 * fq + 4 * n) = o; } }
            }
            return;
        }
        f32x4 gv[2][2];
#pragma unroll
        for (int bj = 0; bj < 2; ++bj)
#pragma unroll
            for (int n = 0; n < 2; ++n) gv[bj][n] = gain ? *(const f32x4*)(gain + 32 * bj + 8 * fq + 4 * n) * sc : (f32x4){1.f, 1.f, 1.f, 1.f};
#pragma unroll
        for (int ai = 0; ai < 2; ++ai)
#pragma unroll
            for (int m = 0; m < 4; ++m) { const size_t r = (size_t)u.pm * BM + ai * HALF + wr * 64 + m * 16 + fr;
                float rs = 1.f;
                if (gain) { float ss = 0.f;
#pragma unroll
                    for (int bj = 0; bj < 2; ++bj)
#pragma unroll
                        for (int n = 0; n < 2; ++n) { const f32x4 v = acc[ai][bj][m][n]; ss += (v[0] * v[0] + v[1] * v[1]) + (v[2] * v[2] + v[3] * v[3]); }
                    ss += __shfl_xor(ss, 16); ss += __shfl_xor(ss, 32);
                    rs = rsqrtf(ss * (1.f / 64.f) + EPS); }
#pragma unroll
                for (int bj = 0; bj < 2; ++bj) { const f32x4 a = acc[ai][bj][m][0] * gv[bj][0] * rs, b = acc[ai][bj][m][1] * gv[bj][1] * rs;
                    u32x4 w; w.x = cvt_pk_bf16(a[0], a[1]); w.y = cvt_pk_bf16(a[2], a[3]); w.z = cvt_pk_bf16(b[0], b[1]); w.w = cvt_pk_bf16(b[2], b[3]);
                    *(u32x4*)(ZB + r * ZBW + pn * BM + 64 * wc + 32 * bj + 8 * fq) = w; } }
    }
};
struct EpiG2 {
    const float* xin32; bf16_t* XAB; const float* g1;
    struct Pre {};
    __device__ __forceinline__ void prefetch(const Unit&, int, int, Pre&) const {}
    __device__ __forceinline__ void init(f32x4 (&acc)[2][2][4][2], const Pre&) const {
#pragma unroll
        for (int a = 0; a < 2; ++a)
#pragma unroll
            for (int b = 0; b < 2; ++b)
#pragma unroll
                for (int m = 0; m < 4; ++m)
#pragma unroll
                    for (int n = 0; n < 2; ++n) acc[a][b][m][n] = (f32x4){0.f, 0.f, 0.f, 0.f};
    }
    __device__ __forceinline__ void operator()(const f32x4 (&acc)[2][2][4][2], const Unit& u, int wr, int wc, int fr, int fq, bool has_next, const Unit& nxt, Pre& pre) const {
#pragma unroll
        for (int ai = 0; ai < 2; ++ai)
#pragma unroll
            for (int m = 0; m < 4; ++m) { const size_t r = (size_t)u.pm * BM + ai * HALF + wr * 64 + m * 16 + fr; const int b = (int)(r / S);
#pragma unroll
                for (int bj = 0; bj < 2; ++bj) { const int c = u.pn * BM + 128 * bj + 32 * wc + 8 * fq;
                    f32x4 x0, x1;
                    if (xin32) { x0 = *(const f32x4*)(xin32 + r * D + c); x1 = *(const f32x4*)(xin32 + r * D + c + 4); }
                    else { const u32x4 q = *(const u32x4*)(XAB + r * D + c);
                        x0 = (f32x4){__builtin_bit_cast(float, q.x << 16), __builtin_bit_cast(float, q.x & 0xffff0000u), __builtin_bit_cast(float, q.y << 16), __builtin_bit_cast(float, q.y & 0xffff0000u)};
                        x1 = (f32x4){__builtin_bit_cast(float, q.z << 16), __builtin_bit_cast(float, q.z & 0xffff0000u), __builtin_bit_cast(float, q.w << 16), __builtin_bit_cast(float, q.w & 0xffff0000u)}; }
                    const f32x4 g0 = *(const f32x4*)(g1 + (size_t)b * 6144 + c), g1v = *(const f32x4*)(g1 + (size_t)b * 6144 + c + 4);
                    const f32x4 y0 = x0 + g0 * acc[ai][bj][m][0], y1 = x1 + g1v * acc[ai][bj][m][1];
                    u32x4 o; o.x = cvt_pk_bf16(y0[0], y0[1]); o.y = cvt_pk_bf16(y0[2], y0[3]); o.z = cvt_pk_bf16(y1[0], y1[1]); o.w = cvt_pk_bf16(y1[2], y1[3]);
                    *(u32x4*)(XAB + r * D + c) = o; } }
    }
};
struct EpiM1 {
    bf16_t* ACT; const float* b1l;
    struct Pre { f32x4 bg[2], bl[2]; };
    __device__ __forceinline__ void prefetch(const Unit& u, int wc, int fq, Pre& q) const {
        const float* b1 = b1l + (size_t)u.e * 2048 + u.pn * 128 + 32 * wc + 8 * fq;
#pragma unroll
        for (int n = 0; n < 2; ++n) { q.bg[n] = *(const f32x4*)(b1 + 4 * n); q.bl[n] = *(const f32x4*)(b1 + 1024 + 4 * n); }
    }
    __device__ __forceinline__ void init(f32x4 (&acc)[2][2][4][2], const Pre& q) const {
#pragma unroll
        for (int a = 0; a < 2; ++a)
#pragma unroll
            for (int m = 0; m < 4; ++m)
#pragma unroll
                for (int n = 0; n < 2; ++n) { acc[a][0][m][n] = q.bg[n]; acc[a][1][m][n] = q.bl[n]; }
    }
    __device__ __forceinline__ void operator()(const f32x4 (&acc)[2][2][4][2], const Unit& u, int wr, int wc, int fr, int fq, bool has_next, const Unit& nxt, Pre& pre) const {
        const int c0 = u.pn * 128 + 32 * wc + 8 * fq;
#pragma unroll
        for (int ai = 0; ai < 2; ++ai) {
            if (ai == 1) { __builtin_amdgcn_sched_barrier(0); prefetch(nxt, wc, fq, pre); __builtin_amdgcn_sched_barrier(0); }
#pragma unroll
            for (int m = 0; m < 4; ++m) { const size_t r = (size_t)u.pm * BM + ai * HALF + wr * 64 + m * 16 + fr;
                float o[8];
#pragma unroll
                for (int n = 0; n < 2; ++n) { const f32x4 g = acc[ai][0][m][n], li = acc[ai][1][m][n];
#pragma unroll
                    for (int i = 0; i < 4; ++i) { const float gc = fminf(g[i], 7.f), lc = __builtin_amdgcn_fmed3f(li[i], -7.f, 7.f);
                        o[4 * n + i] = (lc + 1.f) * (gc * __builtin_amdgcn_rcpf(1.f + __builtin_amdgcn_exp2f((-1.702f * LOG2E) * gc))); } }
                u32x4 w; w.x = cvt_pk_bf16(o[0], o[1]); w.y = cvt_pk_bf16(o[2], o[3]); w.z = cvt_pk_bf16(o[4], o[5]); w.w = cvt_pk_bf16(o[6], o[7]);
                *(u32x4*)(ACT + r * DFF + c0) = w; }
        }
    }
};
struct EpiM2 {
    bf16_t* Y; const float* b2l;
    struct Pre { f32x4 b[2][2]; };
    __device__ __forceinline__ void prefetch(const Unit& u, int wc, int fq, Pre& q) const {
        const float* b2 = b2l + (size_t)u.e * D + u.pn * BM + 32 * wc + 8 * fq;
#pragma unroll
        for (int bj = 0; bj < 2; ++bj)
#pragma unroll
            for (int n = 0; n < 2; ++n) q.b[bj][n] = *(const f32x4*)(b2 + 128 * bj + 4 * n);
    }
    __device__ __forceinline__ void init(f32x4 (&acc)[2][2][4][2], const Pre& q) const {
#pragma unroll
        for (int a = 0; a < 2; ++a)
#pragma unroll
            for (int bj = 0; bj < 2; ++bj)
#pragma unroll
                for (int m = 0; m < 4; ++m)
#pragma unroll
                    for (int n = 0; n < 2; ++n) acc[a][bj][m][n] = q.b[bj][n];
    }
    __device__ __forceinline__ void operator()(const f32x4 (&acc)[2][2][4][2], const Unit& u, int wr, int wc, int fr, int fq, bool has_next, const Unit& nxt, Pre& pre) const {
#pragma unroll
        for (int ai = 0; ai < 2; ++ai) {
            if (ai == 1) { __builtin_amdgcn_sched_barrier(0); prefetch(nxt, wc, fq, pre); __builtin_amdgcn_sched_barrier(0); }
#pragma unroll
            for (int m = 0; m < 4; ++m) { const size_t r = (size_t)u.pm * BM + ai * HALF + wr * 64 + m * 16 + fr;
#pragma unroll
                for (int bj = 0; bj < 2; ++bj) { const int c = u.pn * BM + 128 * bj + 32 * wc + 8 * fq;
                    const f32x4 v0 = acc[ai][bj][m][0], v1 = acc[ai][bj][m][1];
                    u32x4 o; o.x = cvt_pk_bf16(v0[0], v0[1]); o.y = cvt_pk_bf16(v0[2], v0[3]); o.z = cvt_pk_bf16(v1[0], v1[1]); o.w = cvt_pk_bf16(v1[2], v1[3]);
                    *(u32x4*)(Y + r * D + c) = o; } }
        }
    }
};
}

__device__ __forceinline__ void phase_g1_fast(const Params& p, int l, unsigned char* lds_raw) {
    pg8::ProbDense P{(const bf16_t*)(p.ws + WS_XN), (const bf16_t*)(p.ws + WS_WINT) + (size_t)l * ZBW * D, D, T / 256, ZBW / 256, (int)gridDim.x, (int)blockIdx.x, true};
    pg8::EpiG1F E{(bf16_t*)(p.ws + WS_ZB), (float*)(p.ws + WS_GATE), p.in[7] + l * 64, p.in[8] + l * 64, p.in[12] + l * 64, p.in[13] + l * 64};
    pg8::gemm_phase<pg8::ProbDense, pg8::EpiG1F, true, true>((PG8_LAS unsigned char*)lds_raw, P, E);
}
__device__ __forceinline__ void phase_g2_fast(const Params& p, int l, unsigned char* lds_raw) {
    pg8::ProbDense P{(const bf16_t*)(p.ws + WS_ATTB), (const bf16_t*)(p.ws + WS_WOT) + (size_t)l * D * D, D, T / 256, D / 256, (int)gridDim.x, (int)blockIdx.x, false};
    pg8::EpiG2 E{l == 0 ? p.in[0] : (const float*)nullptr, (bf16_t*)(p.ws + WS_XAB), (const float*)(p.ws + WS_MOD) + (size_t)l * Bn * 6144 + 2 * D};
    pg8::gemm_phase<pg8::ProbDense, pg8::EpiG2, true, true>((PG8_LAS unsigned char*)lds_raw, P, E);
}
constexpr int LDS_PS_OFF = 131072;
__device__ __forceinline__ void phase_ck_fast(const Params& p, int l, unsigned char* lds_raw) {
    pg8::ProbCmp P{(const bf16_t*)(p.ws + WS_ZB), (const bf16_t*)(p.ws + WS_WCT) + (size_t)l * 2 * 128 * 2048, 2048, (int)gridDim.x, (int)blockIdx.x};
    pg8::EpiCmp E{(float*)(p.ws + WS_HIDP)};
    pg8::gemm_phase<pg8::ProbCmp, pg8::EpiCmp, true, true>((PG8_LAS unsigned char*)lds_raw, P, E);
    { const int tid = otid(), lane = tid & 63, wave = tid >> 6, r8 = lane >> 3, c8 = lane & 7;
      const bf16_t* Z = (const bf16_t*)(p.ws + WS_ZB); bf16_t* KMB = (bf16_t*)(p.ws + WS_KMB);
      float* part = (float*)(lds_raw + 131072 + 512);
      for (int it0 = blockIdx.x * 2; it0 < Bn * 8 * 32; it0 += gridDim.x * 2) {
          const int it = it0 + (wave >> 2), q = wave & 3;
          const int b = it / 256, h = (it / 32) & 7, blk = it & 31;
          const bf16_t* base = Z + (size_t)(b * S + blk * 256 + q * 64 + r8) * ZBW + ZB_MK + h * 64 + c8 * 8;
          float s[8] = {0.f, 0.f, 0.f, 0.f, 0.f, 0.f, 0.f, 0.f};
          uint4 v[8];
#pragma unroll
          for (int i = 0; i < 8; ++i) v[i] = *(const uint4*)(base + (size_t)(8 * i) * ZBW);
#pragma unroll
          for (int i = 0; i < 8; ++i) { const unsigned w[4] = {v[i].x, v[i].y, v[i].z, v[i].w};
#pragma unroll
              for (int e = 0; e < 4; ++e) { s[2 * e] += __builtin_bit_cast(float, w[e] << 16); s[2 * e + 1] += __builtin_bit_cast(float, w[e] & 0xffff0000u); } }
#pragma unroll
          for (int e = 0; e < 8; ++e) { s[e] += __shfl_xor(s[e], 8); s[e] += __shfl_xor(s[e], 16); s[e] += __shfl_xor(s[e], 32); }
          if (r8 == 0) {
#pragma unroll
              for (int e = 0; e < 8; ++e) part[wave * 64 + c8 * 8 + e] = s[e]; }
          __syncthreads();
          if (tid < 128) { const int item = tid >> 6, d = tid & 63; const float* pp = part + item * 256 + d;
              KMB[(size_t)(it0 + item) * 64 + d] = (bf16_t)f2bf((((pp[0] + pp[64]) + pp[128]) + pp[192]) * (1.f / 256.f)); }
          __syncthreads();
      } }
}
__device__ __forceinline__ void phase_m1_fast(const Params& p, int l, unsigned char* lds_raw) {
    int* ps = (int*)(lds_raw + LDS_PS_OFF);
    load_pstart(p, l, ps);
    pg8::ProbMoe1 P{(const bf16_t*)(p.ws + WS_XN), (const bf16_t*)(p.ws + WS_W1T) + (size_t)l * NE * 2048 * D, (const int*)(p.ws + WS_ROWTOK) + (size_t)l * RMAX, (pg8::lds_ints)ps, D, ps[32] / 256, (int)gridDim.x, (int)blockIdx.x};
    pg8::EpiM1 E{(bf16_t*)(p.ws + WS_ACT), p.in[18] + (size_t)l * NE * 2048};
    pg8::gemm_phase<pg8::ProbMoe1, pg8::EpiM1, true, true>((PG8_LAS unsigned char*)lds_raw, P, E);
    __syncthreads();
}
__device__ __forceinline__ void phase_m2_fast(const Params& p, int l, unsigned char* lds_raw) {
    int* ps = (int*)(lds_raw + LDS_PS_OFF);
    load_pstart(p, l, ps);
    pg8::ProbMoe2 P{(const bf16_t*)(p.ws + WS_ACT), (const bf16_t*)(p.ws + WS_W2T) + (size_t)l * NE * D * DFF, (pg8::lds_ints)ps, DFF, ps[32] / 256, (int)gridDim.x, (int)blockIdx.x};
    pg8::EpiM2 E{(bf16_t*)(p.ws + WS_Y), p.in[20] + (size_t)l * NE * D};
    pg8::gemm_phase<pg8::ProbMoe2, pg8::EpiM2, true, true>((PG8_LAS unsigned char*)lds_raw, P, E);
    __syncthreads();
}

namespace at {
#define AT_LAS __attribute__((address_space(3)))
typedef short bf16x8 __attribute__((ext_vector_type(8)));
typedef short s16x4 __attribute__((ext_vector_type(4)));
typedef short v4i16_t __attribute__((ext_vector_type(4)));
typedef float f32x16 __attribute__((ext_vector_type(16)));
typedef unsigned u32x4 __attribute__((ext_vector_type(4)));
typedef float f32x2_t __attribute__((ext_vector_type(2))); typedef __bf16 bf16x2_t __attribute__((ext_vector_type(2)));
typedef AT_LAS unsigned char* lp;
constexpr int L_K = 0  , L_V = 32768  , L_WSF = 65536, L_OST = 67584  , L_SELM = 133120, L_UNI = 134144, L_KMT = 134400, L_END = 142592;
constexpr float NEGS = -1e30f;
__device__ __forceinline__ int crow(int r, int hi) { return (r & 3) + 8 * (r >> 2) + 4 * hi; }
__device__ __forceinline__ unsigned cvtpk(float lo, float hi) { f32x2_t v = {lo, hi}; bf16x2_t b = __builtin_convertvector(v, bf16x2_t); return __builtin_bit_cast(unsigned, b); }
__device__ __forceinline__ float mx3(float a, float b, float c) { return __builtin_fmaxf(__builtin_fmaxf(a, b), c); }
__device__ __forceinline__ void wsync() { asm volatile("s_waitcnt lgkmcnt(0)" ::: "memory"); __builtin_amdgcn_wave_barrier(); }
__device__ __forceinline__ void bar() { __builtin_amdgcn_s_barrier(); }
#define AT_WAITV(n) asm volatile("s_waitcnt vmcnt(" #n ")" ::: "memory")
#define AT_WAITL() asm volatile("s_waitcnt lgkmcnt(0)" ::: "memory")
__device__ __forceinline__ void glds(const void* g, lp dst) { __builtin_amdgcn_global_load_lds((const unsigned*)g, (AT_LAS unsigned*)dst, 16, 0, 0); }
__device__ __forceinline__ s16x4 vtr(const AT_LAS unsigned char* p) { return __builtin_bit_cast(s16x4, __builtin_amdgcn_ds_read_tr16_b64_v4i16((AT_LAS v4i16_t*)p)); }

__device__ __forceinline__ void dma_k(lp slot, const bf16_t* kbase, int pitch, int key0, int wid, int lane) { glds(kbase + (size_t)(key0 + lane) * pitch + wid * 8, slot + wid * 1024); }
__device__ __forceinline__ void dma_v(lp slot, const bf16_t* vbase, int pitch, int key0, int wid, int lane) {
    glds(vbase + (size_t)(key0 + 16 * (wid & 3) + (lane >> 2)) * pitch + (wid >> 2) * 32 + (lane & 3) * 8, slot + wid * 1024); }

__device__ __forceinline__ void qk_tile(f32x16& p0, f32x16& p1, lp kslot, const bf16x8 (&qr)[4], int r32, int hi) {
    const AT_LAS unsigned char* kb = kslot + hi * 1024 + r32 * 16;
    bf16x8 b0[4], b1[4];
#pragma unroll
    for (int d0 = 0; d0 < 4; ++d0) { b0[d0] = *(const AT_LAS bf16x8*)(kb + d0 * 2048); b1[d0] = *(const AT_LAS bf16x8*)(kb + d0 * 2048 + 512); }
#pragma unroll
    for (int d0 = 0; d0 < 4; ++d0) {
        p0 = __builtin_amdgcn_mfma_f32_32x32x16_bf16(b0[d0], qr[d0], p0, 0, 0, 0);
        p1 = __builtin_amdgcn_mfma_f32_32x32x16_bf16(b1[d0], qr[d0], p1, 0, 0, 0);
    }
}
struct VFrag { bf16x8 f[8]; };
__device__ __forceinline__ void pv_load(VFrag& v, lp vslot, int lane, int hi) {
    const AT_LAS unsigned char* vp = vslot + ((lane >> 4) & 1) * 32 + (lane & 3) * 8 + (4 * hi + ((lane & 15) >> 2)) * 64;
#pragma unroll
    for (int d0 = 0; d0 < 2; ++d0)
#pragma unroll
        for (int ks = 0; ks < 4; ++ks) {
            const s16x4 lo = vtr(vp + d0 * 4096 + ks * 1024), hh = vtr(vp + d0 * 4096 + ks * 1024 + 512);
            v.f[d0 * 4 + ks] = (bf16x8){lo[0], lo[1], lo[2], lo[3], hh[0], hh[1], hh[2], hh[3]};
        }
}
__device__ __forceinline__ void pv_mfma(f32x16 (&o)[2], const VFrag& v, u32x4 pw0, u32x4 pw1, u32x4 pw2, u32x4 pw3) {
    const bf16x8 pa[4] = {__builtin_bit_cast(bf16x8, pw0), __builtin_bit_cast(bf16x8, pw1), __builtin_bit_cast(bf16x8, pw2), __builtin_bit_cast(bf16x8, pw3)};
#pragma unroll
    for (int ks = 0; ks < 4; ++ks) {
        o[0] = __builtin_amdgcn_mfma_f32_32x32x16_bf16(pa[ks], v.f[ks], o[0], 0, 0, 0);
        o[1] = __builtin_amdgcn_mfma_f32_32x32x16_bf16(pa[ks], v.f[4 + ks], o[1], 0, 0, 0);
    }
}
__device__ __forceinline__ float rowmax(const f32x16& p0, const f32x16& p1) {
    float a = mx3(p0[0], p0[1], p1[0]), b = mx3(p0[2], p0[3], p1[1]); a = mx3(a, p1[2], p1[3]);
#pragma unroll
    for (int r = 4; r < 16; r += 4) { a = mx3(a, p0[r], p0[r + 1]); b = mx3(b, p0[r + 2], p0[r + 3]); a = mx3(a, p1[r], p1[r + 1]); b = mx3(b, p1[r + 2], p1[r + 3]); }
    const float m = __builtin_fmaxf(a, b);
    auto rr = __builtin_amdgcn_permlane32_swap(__float_as_uint(m), __float_as_uint(m), false, false);
    return __builtin_fmaxf(__uint_as_float(rr[0]), __uint_as_float(rr[1]));
}
__device__ __forceinline__ float halfsum(float v) {
    auto rr = __builtin_amdgcn_permlane32_swap(__float_as_uint(v), __float_as_uint(v), false, false);
    return __uint_as_float(rr[0]) + __uint_as_float(rr[1]);
}
__device__ __forceinline__ void mask_tile(f32x16& p0, f32x16& p1, int lo, int hi_, int hi) {
    const int kb = 4 * hi;
#pragma unroll
    for (int r = 0; r < 16; ++r) { const int kv = kb + (r & 3) + 8 * (r >> 2); if (kv > hi_ || kv < lo) p0[r] = NEGS; if (kv + 32 > hi_ || kv + 32 < lo) p1[r] = NEGS; }
}

__device__ __forceinline__ void mask_init(f32x16& p0, f32x16& p1, int hi_, int hi) {
    const int kb = 4 * hi;
#pragma unroll
    for (int r = 0; r < 16; ++r) { const int kv = kb + (r & 3) + 8 * (r >> 2); if (kv > hi_) p0[r] = NEGS; if (kv + 32 > hi_) p1[r] = NEGS; }
}
__device__ __forceinline__ int next_bit128(unsigned u0, unsigned u1, unsigned u2, unsigned u3, int below) {
    if (below > 96) { unsigned x = u3; if (below < 128) x &= (1u << (below - 96)) - 1u; if (x) return 96 + 31 - __builtin_clz(x); }
    if (below > 64) { unsigned x = u2; if (below < 96) x &= (1u << (below - 64)) - 1u; if (x) return 64 + 31 - __builtin_clz(x); }
    if (below > 32) { unsigned x = u1; if (below < 64) x &= (1u << (below - 32)) - 1u; if (x) return 32 + 31 - __builtin_clz(x); }
    if (below > 0) { unsigned x = u0; if (below < 32) x &= (1u << below) - 1u; if (x) return 31 - __builtin_clz(x); }
    return -1;
}
struct Soft { float m, l; };

template <bool HAS_O>
__device__ __forceinline__ void softmax_step(f32x16& p0, f32x16& p1, Soft& st, f32x16 (&o)[2], float* wsf, int r32, int hi) {
    const float rm = rowmax(p0, p1);
    if (__any(rm > 0.f)) {
        const float dl = __builtin_fmaxf(rm, 0.f); st.m += dl;
#pragma unroll
        for (int r = 0; r < 16; ++r) { p0[r] -= dl; p1[r] -= dl; }
        const float al = __builtin_amdgcn_exp2f(-dl); st.l *= al;
        if (HAS_O) {
            if (hi == 0) wsf[r32] = al;
            wsync();
#pragma unroll
            for (int r = 0; r < 16; ++r) { const float f = wsf[crow(r, hi)]; o[0][r] *= f; o[1][r] *= f; }
            wsync();
        }
    }
    float s = 0.f;
#pragma unroll
    for (int r = 0; r < 16; ++r) { p0[r] = __builtin_amdgcn_exp2f(p0[r]); p1[r] = __builtin_amdgcn_exp2f(p1[r]); s += p0[r] + p1[r]; }
    st.l += s;
}
#define AT_PACK(P0, P1) \
    const u32x4 pw0 = {cvtpk(P0[0], P0[1]), cvtpk(P0[2], P0[3]), cvtpk(P0[4], P0[5]), cvtpk(P0[6], P0[7])}, pw1 = {cvtpk(P0[8], P0[9]), cvtpk(P0[10], P0[11]), cvtpk(P0[12], P0[13]), cvtpk(P0[14], P0[15])}, \
                pw2 = {cvtpk(P1[0], P1[1]), cvtpk(P1[2], P1[3]), cvtpk(P1[4], P1[5]), cvtpk(P1[6], P1[7])}, pw3 = {cvtpk(P1[8], P1[9]), cvtpk(P1[10], P1[11]), cvtpk(P1[12], P1[13]), cvtpk(P1[14], P1[15])}
__device__ __forceinline__ float fma_vsv(float a, float k, float x) { float d; asm("v_fma_f32 %0, %1, %2, %3" : "=v"(d) : "v"(a), "s"(k), "v"(x)); return d; }
__device__ __forceinline__ f32x16 cinit(float c2k, int hi, float x) { f32x16 c; const float xb = __builtin_fmaf(c2k, (float)(4 * hi), x);
    c[0] = xb;
#pragma unroll
    for (int r = 1; r < 16; ++r) c[r] = fma_vsv(c2k, (float)((r & 3) + 8 * (r >> 2)), xb);
    return c; }
template <bool FIRST>
__device__ __forceinline__ void acc_scaled(float* stage, const f32x16 (&o)[2], float f, float* wsf, int r32, int hi) {
    if (hi == 0) wsf[r32] = f;
    wsync();
#pragma unroll
    for (int r = 0; r < 16; ++r) { const int orow = crow(r, hi); const float g = wsf[orow]; float* s0 = stage + orow * 64 + r32;
        if (FIRST) { s0[0] = o[0][r] * g; s0[32] = o[1][r] * g; } else { s0[0] += o[0][r] * g; s0[32] += o[1][r] * g; } }
    wsync();
}

#define AT_WAIT_NEWER(newer, per) do { if ((newer) >= 2) { if ((per) == 2) AT_WAITV(4); else AT_WAITV(2); } else if ((newer) == 1) { if ((per) == 2) AT_WAITV(2); else AT_WAITV(1); } else AT_WAITV(0); } while (0)


#define AT_SB() __builtin_amdgcn_sched_barrier(0)
struct PipeOut { float s, rmn; };
__device__ __forceinline__ PipeOut pipe_step(f32x16& c0, f32x16& c1, f32x16& n0, f32x16& n1, f32x16 (&o)[2], lp kslot_next, lp vslot, const bf16x8 (&qr)[4], int lane, int r32, int hi) {
    const AT_LAS unsigned char* kb = kslot_next + hi * 1024 + r32 * 16;
    const AT_LAS unsigned char* vp = vslot + ((lane >> 4) & 1) * 32 + (lane & 3) * 8 + (4 * hi + ((lane & 15) >> 2)) * 64;
    bf16x8 kf[8];
#pragma unroll
    for (int j = 0; j < 4; ++j) kf[j] = *(const AT_LAS bf16x8*)(kb + (j >> 1) * 2048 + (j & 1) * 512);
    AT_SB();
    unsigned w0[8], w1[8]; s16x4 vl[8], vh[8]; float s = 0.f;
#pragma unroll
    for (int j = 0; j < 8; ++j) {
        if (j & 1) n1 = __builtin_amdgcn_mfma_f32_32x32x16_bf16(kf[j], qr[j >> 1], n1, 0, 0, 0);
        else       n0 = __builtin_amdgcn_mfma_f32_32x32x16_bf16(kf[j], qr[j >> 1], n0, 0, 0, 0);
        if (j < 4) kf[j + 4] = *(const AT_LAS bf16x8*)(kb + ((j + 4) >> 1) * 2048 + (j & 1) * 512);
        if (j >= 4) {
#pragma unroll
            for (int q = 0; q < 2; ++q) { const int f = (j - 4) * 2 + q, d0 = f >> 2, ks = f & 3; vl[f] = vtr(vp + d0 * 4096 + ks * 1024); vh[f] = vtr(vp + d0 * 4096 + ks * 1024 + 512); }
        }
        const float e0 = __builtin_amdgcn_exp2f(c0[2 * j]), e1 = __builtin_amdgcn_exp2f(c0[2 * j + 1]), e2 = __builtin_amdgcn_exp2f(c1[2 * j]), e3 = __builtin_amdgcn_exp2f(c1[2 * j + 1]);
        s += (e0 + e1) + (e2 + e3);
        asm volatile("" : "+v"(s));
        w0[j] = cvtpk(e0, e1); w1[j] = cvtpk(e2, e3);
        AT_SB();
    }
    const u32x4 pw0 = {w0[0], w0[1], w0[2], w0[3]}, pw1 = {w0[4], w0[5], w0[6], w0[7]}, pw2 = {w1[0], w1[1], w1[2], w1[3]}, pw3 = {w1[4], w1[5], w1[6], w1[7]};
    const bf16x8 pa[4] = {__builtin_bit_cast(bf16x8, pw0), __builtin_bit_cast(bf16x8, pw1), __builtin_bit_cast(bf16x8, pw2), __builtin_bit_cast(bf16x8, pw3)};
    float a = mx3(n0[0], n0[1], n1[0]), b = mx3(n0[2], n0[3], n1[1]);
#pragma unroll
    for (int f = 0; f < 8; ++f) {
        const int d0 = f >> 2, ks = f & 3;
        const bf16x8 vf = (bf16x8){vl[f][0], vl[f][1], vl[f][2], vl[f][3], vh[f][0], vh[f][1], vh[f][2], vh[f][3]};
        o[d0] = __builtin_amdgcn_mfma_f32_32x32x16_bf16(pa[ks], vf, o[d0], 0, 0, 0);
        if (f == 0) { a = mx3(a, n1[2], n1[3]); }
        else if (f < 4) { const int r = 4 * f; a = mx3(a, n0[r], n0[r + 1]); b = mx3(b, n0[r + 2], n0[r + 3]); a = mx3(a, n1[r], n1[r + 1]); b = mx3(b, n1[r + 2], n1[r + 3]); }
        asm volatile("" : "+v"(a), "+v"(b));
        AT_SB();
    }
    const float m = __builtin_fmaxf(a, b);
    auto rr = __builtin_amdgcn_permlane32_swap(__float_as_uint(m), __float_as_uint(m), false, false);
    PipeOut out; out.s = s; out.rmn = __builtin_fmaxf(__uint_as_float(rr[0]), __uint_as_float(rr[1]));
    return out;
}
__device__ __forceinline__ void nsa_unit(const Params& p, int b, int g, int c, unsigned char* lds_raw) {
    const int tid = otid(), lane = tid & 63, r32 = lane & 31, hi = lane >> 5, wid = __builtin_amdgcn_readfirstlane(tid >> 6);
    lp lds = (lp)lds_raw;
    const bf16_t* ZB = (const bf16_t*)(p.ws + WS_ZB); const float* GT = (const float*)(p.ws + WS_GATE);
    const bf16_t* KCB = (const bf16_t*)(p.ws + WS_KCB) + (size_t)(b * 2 + g) * 512 * 64; const bf16_t* VCB = (const bf16_t*)(p.ws + WS_VCB) + (size_t)(b * 2 + g) * 512 * 64;
    const int t0 = c * 64, hg = r32 >> 3, qq = r32 & 7, qi = 8 * wid + qq, t = t0 + qi, h = 4 * g + hg; const size_t tt = (size_t)b * S + t;
    float* wsf = (float*)(lds_raw + L_WSF) + wid * 64;
    float* ostage = (float*)(lds_raw + L_OST) + wid * 2048;
    float* imp = ostage;
    unsigned* selm = (unsigned*)(lds_raw + L_SELM);
    unsigned* uni = (unsigned*)(lds_raw + L_UNI);
    const float c2 = exp2f(-(float)(h + 1)) * LOG2E;
    bf16x8 qr[4];
#pragma unroll
    for (int d0 = 0; d0 < 4; ++d0) qr[d0] = *(const bf16x8*)(ZB + tt * ZBW + ZB_Q + h * 64 + d0 * 16 + hi * 8);
    const float gt0 = GT[tt * 32 + h * 3 + 0], gt1 = GT[tt * 32 + h * 3 + 1], gt2 = GT[tt * 32 + h * 3 + 2];
    f32x16 o[2];
    const lp sK0 = lds + L_K, sV0 = lds + L_V;
    const int nmax = t >= 31 ? (t - 31) >> 4 : -1;
    const int ntc = ((4 * c + 2) >> 6) + 1;
    for (int i = lane; i < 8 * 129; i += 64) imp[i] = 0.f;
    Soft sc; sc.m = 0.f; sc.l = 0.f;
#pragma unroll
    for (int k = 0; k < 3; ++k) if (k < ntc) dma_k(sK0 + k * 8192, KCB, 64, 64 * k, wid, lane);
    for (int k = 0; k < ntc; ++k) {
        const int newer = ntc - 1 - k; AT_WAIT_NEWER(newer, 1);
        AT_WAITL(); bar();
        if (k + 3 < ntc) dma_k(sK0 + ((k + 3) & 3) * 8192, KCB, 64, 64 * (k + 3), wid, lane);
        const lp sK = sK0 + (k & 3) * 8192;
        const float x0 = c2 * (16.f * (64 * k) + 15.5f - (float)t0) - sc.m;
        f32x16 p0 = cinit(16.f * c2, hi, x0), p1 = cinit(16.f * c2, hi, x0 + c2 * 512.f);
        qk_tile(p0, p1, sK, qr, r32, hi);
        if (__any(nmax - 64 * k < 63)) mask_tile(p0, p1, 0, nmax - 64 * k, hi);
        softmax_step<false>(p0, p1, sc, o, wsf, r32, hi);
    }
    const float lc = halfsum(sc.l), linv = lc > 0.f ? 1.f / lc : 0.f;
    o[0] = f32x16{}; o[1] = f32x16{};
    AT_WAITL(); bar();
#pragma unroll
    for (int k = 0; k < 3; ++k) if (k < ntc) { dma_k(sK0 + k * 8192, KCB, 64, 64 * k, wid, lane); dma_v(sV0 + k * 8192, VCB, 64, 64 * k, wid, lane); }
    for (int k = 0; k < ntc; ++k) {
        const int newer = ntc - 1 - k; AT_WAIT_NEWER(newer, 2);
        AT_WAITL(); bar();
        if (k + 3 < ntc) { dma_k(sK0 + ((k + 3) & 3) * 8192, KCB, 64, 64 * (k + 3), wid, lane); dma_v(sV0 + ((k + 3) & 3) * 8192, VCB, 64, 64 * (k + 3), wid, lane); }
        const lp sK = sK0 + (k & 3) * 8192, sV = sV0 + (k & 3) * 8192;
        const float x0 = c2 * (16.f * (64 * k) + 15.5f - (float)t0) - sc.m;
        f32x16 p0 = cinit(16.f * c2, hi, x0), p1 = cinit(16.f * c2, hi, x0 + c2 * 512.f);
        qk_tile(p0, p1, sK, qr, r32, hi);
        if (__any(nmax - 64 * k < 63)) mask_tile(p0, p1, 0, nmax - 64 * k, hi);
        VFrag vf; pv_load(vf, sV, lane, hi);
#pragma unroll
        for (int r = 0; r < 16; ++r) { p0[r] = __builtin_amdgcn_exp2f(p0[r]); p1[r] = __builtin_amdgcn_exp2f(p1[r]); }
        { AT_PACK(p0, p1); pv_mfma(o, vf, pw0, pw1, pw2, pw3); }
        float gs[8], ls[8];
#pragma unroll
        for (int q4 = 0; q4 < 4; ++q4) { gs[q4] = ((p0[4 * q4] + p0[4 * q4 + 1]) + (p0[4 * q4 + 2] + p0[4 * q4 + 3])) * linv; ls[q4] = p0[4 * q4 + 3] * linv;
                                         gs[4 + q4] = ((p1[4 * q4] + p1[4 * q4 + 1]) + (p1[4 * q4 + 2] + p1[4 * q4 + 3])) * linv; ls[4 + q4] = p1[4 * q4 + 3] * linv; }
#pragma unroll
        for (int q4 = 0; q4 < 8; ++q4) { gs[q4] += __shfl_xor(gs[q4], 8); gs[q4] += __shfl_xor(gs[q4], 16); ls[q4] += __shfl_xor(ls[q4], 8); ls[q4] += __shfl_xor(ls[q4], 16); }
        if (r32 < 8) {
            float* row = imp + qq * 129 + 16 * k + hi;
#pragma unroll
            for (int q4 = 0; q4 < 8; ++q4) row[2 * q4] += gs[q4];
        }
        wsync();
        if (r32 < 8) {
            float* row = imp + qq * 129 + 16 * k + hi + 1;
#pragma unroll
            for (int q4 = 0; q4 < 8; ++q4) row[2 * q4] += ls[q4];
        }
        wsync();
    }
    unsigned mk0 = 0u, mk1 = 0u, mk2 = 0u, mk3 = 0u;
    {
        const int qs = lane >> 3, part = lane & 7;
        float v[16];
#pragma unroll
        for (int i = 0; i < 16; ++i) { const int j = part * 16 + i; float x = imp[qs * 129 + j]; if (j == 0 || j == c || j == c - 1) x = 1e4f; if (j > c) x = NEGS; v[i] = x; }
#pragma unroll 1
        for (int it = 0; it < 16; ++it) {
            float bv = -3e38f; int bi = 0;
#pragma unroll
            for (int i = 0; i < 16; ++i) if (v[i] > bv) { bv = v[i]; bi = part * 16 + i; }
#pragma unroll
            for (int sft = 1; sft < 8; sft <<= 1) { const float ov = __shfl_xor(bv, sft); const int oi = __shfl_xor(bi, sft); if (ov > bv || (ov == bv && oi < bi)) { bv = ov; bi = oi; } }
            if (bv > NEGS) { const unsigned bit = 1u << (bi & 31); const int wq = bi >> 5; if (wq == 0) mk0 |= bit; else if (wq == 1) mk1 |= bit; else if (wq == 2) mk2 |= bit; else mk3 |= bit; }
#pragma unroll
            for (int i = 0; i < 16; ++i) if (part * 16 + i == bi) v[i] = -3.4e38f;
        }
        if (part == 0) { unsigned* sm = selm + (8 * wid + qs) * 4; sm[0] = mk0; sm[1] = mk1; sm[2] = mk2; sm[3] = mk3; }
        unsigned u0 = mk0, u1 = mk1, u2 = mk2, u3 = mk3;
#pragma unroll
        for (int sft = 8; sft < 64; sft <<= 1) { u0 |= __shfl_xor(u0, sft); u1 |= __shfl_xor(u1, sft); u2 |= __shfl_xor(u2, sft); u3 |= __shfl_xor(u3, sft); }
        if (lane == 0) { uni[wid * 4 + 0] = u0; uni[wid * 4 + 1] = u1; uni[wid * 4 + 2] = u2; uni[wid * 4 + 3] = u3; }
    }
    wsync();
    acc_scaled<true>(ostage, o, gt0 * linv, wsf, r32, hi);
    AT_WAITL(); bar();
    unsigned un0 = 0u, un1 = 0u, un2 = 0u, un3 = 0u;
#pragma unroll
    for (int w = 0; w < 8; ++w) { un0 |= uni[w * 4 + 0]; un1 |= uni[w * 4 + 1]; un2 |= uni[w * 4 + 2]; un3 |= uni[w * 4 + 3]; }
    un0 = __builtin_amdgcn_readfirstlane(un0); un1 = __builtin_amdgcn_readfirstlane(un1); un2 = __builtin_amdgcn_readfirstlane(un2); un3 = __builtin_amdgcn_readfirstlane(un3);
    const unsigned my0 = selm[(8 * wid + qq) * 4 + 0], my1 = selm[(8 * wid + qq) * 4 + 1], my2 = selm[(8 * wid + qq) * 4 + 2], my3 = selm[(8 * wid + qq) * 4 + 3];
    {
        const bf16_t* KS = ZB + (size_t)b * S * ZBW + ZB_KS + g * 64; const bf16_t* VS = ZB + (size_t)b * S * ZBW + ZB_VS + g * 64;
        Soft ss; ss.m = 0.f; ss.l = 0.f; o[0] = f32x16{}; o[1] = f32x16{};
        const int nsel = __builtin_popcount(un0) + __builtin_popcount(un1) + __builtin_popcount(un2) + __builtin_popcount(un3);
        int ji = 128;
#pragma unroll
        for (int k = 0; k < 3; ++k) if (k < nsel) { ji = next_bit128(un0, un1, un2, un3, ji); dma_k(sK0 + k * 8192, KS, ZBW, 64 * ji, wid, lane); dma_v(sV0 + k * 8192, VS, ZBW, 64 * ji, wid, lane); }
        int j = 128;
        for (int i = 0; i < nsel; ++i) {
            j = next_bit128(un0, un1, un2, un3, j);
            const int newer = nsel - 1 - i; AT_WAIT_NEWER(newer, 2);
            AT_WAITL(); bar();
            if (i + 3 < nsel) { ji = next_bit128(un0, un1, un2, un3, ji); dma_k(sK0 + ((i + 3) & 3) * 8192, KS, ZBW, 64 * ji, wid, lane); dma_v(sV0 + ((i + 3) & 3) * 8192, VS, ZBW, 64 * ji, wid, lane); }
            const lp sK = sK0 + (i & 3) * 8192, sV = sV0 + (i & 3) * 8192;
            const unsigned mw = (j >> 5) == 0 ? my0 : (j >> 5) == 1 ? my1 : (j >> 5) == 2 ? my2 : my3;
            const bool sel = (mw >> (j & 31)) & 1u;
            const float x0 = sel ? c2 * (float)(64 * j - t0) - ss.m : NEGS;
            f32x16 p0 = cinit(c2, hi, x0), p1 = cinit(c2, hi, sel ? x0 + c2 * 32.f : NEGS);
            qk_tile(p0, p1, sK, qr, r32, hi);
            if (j == c) mask_tile(p0, p1, 0, qi, hi);
            VFrag vf; pv_load(vf, sV, lane, hi);
            softmax_step<true>(p0, p1, ss, o, wsf, r32, hi);
            { AT_PACK(p0, p1); pv_mfma(o, vf, pw0, pw1, pw2, pw3); }
        }
        const float ls_ = halfsum(ss.l);
        acc_scaled<false>(ostage, o, ls_ > 0.f ? gt1 / ls_ : 0.f, wsf, r32, hi);
    }
    {
        const bf16_t* KW = ZB + (size_t)b * S * ZBW + ZB_KW + g * 64; const bf16_t* VW = ZB + (size_t)b * S * ZBW + ZB_VW + g * 64;
        Soft sw; sw.m = 0.f; sw.l = 0.f; o[0] = f32x16{}; o[1] = f32x16{};
        const int k0 = c >= 8 ? 0 : 8 - c, nw = 9 - k0;
        AT_WAITL(); bar();
#pragma unroll
        for (int k = 0; k < 3; ++k) if (k < nw) { dma_k(sK0 + k * 8192, KW, ZBW, t0 - 512 + 64 * (k0 + k), wid, lane); dma_v(sV0 + k * 8192, VW, ZBW, t0 - 512 + 64 * (k0 + k), wid, lane); }
        f32x16 pA0, pA1, pB0, pB1; float rmc;
#define WIN_STEP(C0, C1, N0, N1, I) do { const int i_ = (I); const int k = k0 + i_; \
            if (i_ + 1 < nw) { if (i_ + 2 < nw) AT_WAITV(2); else AT_WAITV(0); } \
            AT_WAITL(); bar(); \
            if (i_ + 3 < nw) { dma_k(sK0 + ((i_ + 3) & 3) * 8192, KW, ZBW, t0 - 512 + 64 * (k + 3), wid, lane); dma_v(sV0 + ((i_ + 3) & 3) * 8192, VW, ZBW, t0 - 512 + 64 * (k + 3), wid, lane); } \
            if (__any(rmc > 0.f)) { \
                const float dl = __builtin_fmaxf(rmc, 0.f); sw.m += dl; \
                _Pragma("unroll") for (int r = 0; r < 16; ++r) { C0[r] -= dl; C1[r] -= dl; } \
                const float al = __builtin_amdgcn_exp2f(-dl); sw.l *= al; \
                if (hi == 0) wsf[r32] = al; \
                wsync(); \
                _Pragma("unroll") for (int r = 0; r < 16; ++r) { const float f = wsf[crow(r, hi)]; o[0][r] *= f; o[1][r] *= f; } \
                wsync(); \
            } \
            { const float x0 = c2 * (float)(64 * (k + 1) - 512) - sw.m; \
              N0 = cinit(c2, hi, x0); N1 = cinit(c2, hi, x0 + c2 * 32.f); \
              if (k + 1 == 8) mask_init(N0, N1, qi, hi); } \
            const PipeOut po = pipe_step(C0, C1, N0, N1, o, sK0 + ((i_ + 1) & 3) * 8192, sV0 + (i_ & 3) * 8192, qr, lane, r32, hi); \
            sw.l += po.s; rmc = po.rmn; } while (0)
        { if (nw >= 3) AT_WAITV(4); else if (nw == 2) AT_WAITV(2); else AT_WAITV(0);
          AT_WAITL(); bar(); }
        { const float x0 = c2 * (float)(64 * k0 - 512);
          pB0 = cinit(c2, hi, x0); pB1 = cinit(c2, hi, x0 + c2 * 32.f);
          qk_tile(pB0, pB1, sK0, qr, r32, hi);
          if (k0 == 0) mask_tile(pB0, pB1, qi + 1, 63, hi);
          if (k0 == 8) mask_tile(pB0, pB1, 0, qi, hi);
          rmc = rowmax(pB0, pB1); }
        int i = 0;
#pragma unroll 1
        for (; i + 1 < nw; i += 2) {
            WIN_STEP(pB0, pB1, pA0, pA1, i);
            WIN_STEP(pA0, pA1, pB0, pB1, i + 1);
        }
        if (i < nw) WIN_STEP(pB0, pB1, pA0, pA1, i);
#undef WIN_STEP
        const float lw = halfsum(sw.l);
        acc_scaled<false>(ostage, o, lw > 0.f ? gt2 / lw : 0.f, wsf, r32, hi);
    }
    {
        bf16_t* AB = (bf16_t*)(p.ws + WS_ATTB);
#pragma unroll
        for (int i = 0; i < 4; ++i) { const int row = i * 8 + (lane >> 3), ch = lane & 7; const float4 a = *(const float4*)(ostage + row * 64 + ch * 8), c4 = *(const float4*)(ostage + row * 64 + ch * 8 + 4);
            const uint4 v = make_uint4(pk2(a.x, a.y), pk2(a.z, a.w), pk2(c4.x, c4.y), pk2(c4.z, c4.w));
            *(uint4*)(AB + ((size_t)b * S + t0 + 8 * wid + (row & 7)) * D + (4 * g + (row >> 3)) * 64 + ch * 8) = v; }
        wsync();
    }
    AT_WAITL(); bar();
}

}

constexpr int MB_CAP = 25600;
namespace at {
__device__ __forceinline__ void moba_route_unit(const Params& p, int b, int h, int qb, unsigned char* lds_raw) {
    const int tid = otid(), lane = tid & 63, r32 = lane & 31, hi = lane >> 5, wid = __builtin_amdgcn_readfirstlane(tid >> 6);
    lp lds = (lp)lds_raw;
    const bf16_t* ZB = (const bf16_t*)(p.ws + WS_ZB);
    const int bh = b * 8 + h;
    const bf16_t* KMB = (const bf16_t*)(p.ws + WS_KMB) + (size_t)bh * 32 * 64;
    const int qi = 32 * wid + r32, t = qb * 256 + qi; const size_t tt = (size_t)b * S + t;
    int* hist = (int*)(lds_raw + L_UNI);
    unsigned* SEL3 = (unsigned*)(p.ws + WS_SEL3); unsigned* LRK = (unsigned*)(p.ws + WS_LRK);
    unsigned char* IL = (unsigned char*)(p.ws + WS_ILIST) + ((size_t)(bh * 32 + qb) * 32) * 256;
    int* BCm = (int*)(p.ws + WS_BCM) + (size_t)(bh * 32 + qb) * 32;
    if (tid < 32) hist[tid] = 0;
    bf16x8 qr[4];
#pragma unroll
    for (int d0 = 0; d0 < 4; ++d0) qr[d0] = *(const bf16x8*)(ZB + tt * ZBW + ZB_MQ + h * 64 + d0 * 16 + hi * 8);
    const lp sKM = lds + L_KMT;
    glds(KMB + (size_t)(lane & 31) * 64 + wid * 8, sKM + wid * 1024);
    AT_WAITV(0); AT_WAITL(); bar();
    f32x16 g0 = f32x16{}, g1 = f32x16{};
    qk_tile(g0, g1, sKM, qr, r32, hi);
    float v1 = NEGS, v2 = NEGS, v3 = NEGS; int i1 = 64, i2 = 64, i3 = 64;
#pragma unroll
    for (int r = 0; r < 16; ++r) { const int n = crow(r, hi); const float s_ = n < qb ? g0[r] : NEGS;
        if (s_ > v1) { v3 = v2; i3 = i2; v2 = v1; i2 = i1; v1 = s_; i1 = n; } else if (s_ > v2) { v3 = v2; i3 = i2; v2 = s_; i2 = n; } else if (s_ > v3) { v3 = s_; i3 = n; } }
    float ov[3]; int oi[3];
    { auto a = __builtin_amdgcn_permlane32_swap(__float_as_uint(v1), __float_as_uint(v1), false, false); ov[0] = __uint_as_float(hi ? a[0] : a[1]); }
    { auto a = __builtin_amdgcn_permlane32_swap(__float_as_uint(v2), __float_as_uint(v2), false, false); ov[1] = __uint_as_float(hi ? a[0] : a[1]); }
    { auto a = __builtin_amdgcn_permlane32_swap(__float_as_uint(v3), __float_as_uint(v3), false, false); ov[2] = __uint_as_float(hi ? a[0] : a[1]); }
    { auto a = __builtin_amdgcn_permlane32_swap((unsigned)i1, (unsigned)i1, false, false); oi[0] = (int)(hi ? a[0] : a[1]); }
    { auto a = __builtin_amdgcn_permlane32_swap((unsigned)i2, (unsigned)i2, false, false); oi[1] = (int)(hi ? a[0] : a[1]); }
    { auto a = __builtin_amdgcn_permlane32_swap((unsigned)i3, (unsigned)i3, false, false); oi[2] = (int)(hi ? a[0] : a[1]); }
#pragma unroll
    for (int k = 0; k < 3; ++k) { const float s_ = ov[k]; const int n = oi[k];
        if (s_ > v1 || (s_ == v1 && n < i1)) { v3 = v2; i3 = i2; v2 = v1; i2 = i1; v1 = s_; i1 = n; }
        else if (s_ > v2 || (s_ == v2 && n < i2)) { v3 = v2; i3 = i2; v2 = s_; i2 = n; }
        else if (s_ > v3 || (s_ == v3 && n < i3)) { v3 = s_; i3 = n; } }
    if (hi == 0) {
        const int j1 = v1 > NEGS ? i1 : 255, j2 = v2 > NEGS ? i2 : 255, j3 = v3 > NEGS ? i3 : 255;
        int l1 = 0, l2 = 0, l3 = 0;
        if (j1 < 32) { l1 = atomicAdd(&hist[j1], 1); IL[j1 * 256 + l1] = (unsigned char)qi; }
        if (j2 < 32) { l2 = atomicAdd(&hist[j2], 1); IL[j2 * 256 + l2] = (unsigned char)qi; }
        if (j3 < 32) { l3 = atomicAdd(&hist[j3], 1); IL[j3 * 256 + l3] = (unsigned char)qi; }
        SEL3[tt * 8 + h] = (unsigned)j1 | ((unsigned)j2 << 8) | ((unsigned)j3 << 16);
        LRK[tt * 8 + h] = (unsigned)l1 | ((unsigned)l2 << 8) | ((unsigned)l3 << 16);
    }
    AT_WAITL(); bar();
    if (tid < 32) BCm[tid] = hist[tid];
    AT_WAITL(); bar();
}
__device__ __forceinline__ void moba_tables(const int* BCmbh, int lane, int& tot, int& seg) {
    int s = 0;
    if (lane < 32) { for (int q = 0; q < 32; ++q) s += BCmbh[q * 32 + lane]; }
    tot = s;
    int pad = (s + 31) & ~31, inc = pad;
#pragma unroll
    for (int sft = 1; sft < 32; sft <<= 1) { const int o_ = __shfl_up(inc, sft); if ((lane & 31) >= sft) inc += o_; }
    seg = inc - pad;
}
__device__ __forceinline__ void moba_gather_unit(const Params& p, int bh, int j, int ch, int segj, bool reload, unsigned char* lds_raw) {
    const int tid = otid(), lane = tid & 63, r32 = lane & 31, hi = lane >> 5, wid = __builtin_amdgcn_readfirstlane(tid >> 6);
    lp lds = (lp)lds_raw;
    const int b = bh >> 3, h = bh & 7;
    const bf16_t* ZB = (const bf16_t*)(p.ws + WS_ZB);
    const int* BCmbh = (const int*)(p.ws + WS_BCM) + (size_t)bh * 32 * 32;
    float* wsf = (float*)(lds_raw + L_WSF) + wid * 64;
    const lp sK0 = lds + L_K, sV0 = lds + L_V;
    const bf16_t* KM_ = ZB + (size_t)b * S * ZBW + ZB_MK + h * 64; const bf16_t* VM_ = ZB + (size_t)b * S * ZBW + ZB_MV + h * 64;
    if (reload) {
#pragma unroll
        for (int k = 0; k < 4; ++k) { dma_k(sK0 + k * 8192, KM_, ZBW, j * 256 + 64 * k, wid, lane); dma_v(sV0 + k * 8192, VM_, ZBW, j * 256 + 64 * k, wid, lane); }
    }
    const int gr = 256 * ch + 32 * wid + r32;
    const int cq = lane < 32 ? BCmbh[lane * 32 + j] : 0;
    int run = 0, qbs = j + 1, lr = 0;
#pragma unroll 4
    for (int q = 0; q < 32; ++q) { const int c_ = __builtin_amdgcn_readlane(cq, q); if (gr >= run && gr < run + c_) { qbs = q; lr = gr - run; } run += c_; }
    const int totj = run;
    const bool valid = gr < totj;
    const unsigned char* IL = (const unsigned char*)(p.ws + WS_ILIST);
    const int qidx = valid ? (int)IL[((size_t)(bh * 32 + qbs) * 32 + j) * 256 + lr] : 0;
    const int t = valid ? qbs * 256 + qidx : (j + 1) * 256; const size_t tt = (size_t)b * S + t;
    const float c2 = exp2f(-(float)(h + 1)) * LOG2E;
    bf16x8 qr[4];
#pragma unroll
    for (int d0 = 0; d0 < 4; ++d0) qr[d0] = *(const bf16x8*)(ZB + tt * ZBW + ZB_MQ + h * 64 + d0 * 16 + hi * 8);
    Soft sm; sm.m = 0.f; sm.l = 0.f; f32x16 o[2]; o[0] = f32x16{}; o[1] = f32x16{};
#pragma unroll 1
    for (int i = 0; i < 4; ++i) {
        if (reload) { const int newer = 3 - i; if (newer >= 3) AT_WAITV(6); else AT_WAIT_NEWER(newer, 2); AT_WAITL(); bar(); }
        const lp sK = sK0 + i * 8192, sV = sV0 + i * 8192;
        const float x0 = c2 * (float)(64 * i) - sm.m;
        f32x16 p0 = cinit(c2, hi, x0), p1 = cinit(c2, hi, x0 + c2 * 32.f);
        qk_tile(p0, p1, sK, qr, r32, hi);
        VFrag vf; pv_load(vf, sV, lane, hi);
        softmax_step<true>(p0, p1, sm, o, wsf, r32, hi);
        { AT_PACK(p0, p1); pv_mfma(o, vf, pw0, pw1, pw2, pw3); }
    }
    {
        const float lt = halfsum(sm.l);
        float* PM = (float*)(p.ws + WS_PM) + (size_t)bh * MB_CAP; float* PL = (float*)(p.ws + WS_PL) + (size_t)bh * MB_CAP;
        if (hi == 0 && valid) { PM[segj + gr] = sm.m; PL[segj + gr] = lt; }
        bf16_t* stg = (bf16_t*)(lds_raw + L_OST) + wid * 4096;
#pragma unroll
        for (int r = 0; r < 16; ++r) { const int orow = crow(r, hi); stg[orow * 64 + r32] = (bf16_t)f2bf(o[0][r]); stg[orow * 64 + 32 + r32] = (bf16_t)f2bf(o[1][r]); }
        wsync();
        bf16_t* PO = (bf16_t*)(p.ws + WS_PO) + ((size_t)bh * MB_CAP + segj + 256 * ch + 32 * wid) * 64;
        const int nrow = totj - (256 * ch + 32 * wid);
#pragma unroll
        for (int i = 0; i < 4; ++i) { const int row = i * 8 + (lane >> 3), c8 = lane & 7; if (row < nrow) *(uint4*)(PO + (size_t)row * 64 + c8 * 8) = *(const uint4*)(stg + row * 64 + c8 * 8); }
        wsync();
    }
    AT_WAITL(); bar();
}
__device__ __forceinline__ void moba_self_unit(const Params& p, int b, int h, int qb, unsigned char* lds_raw) {
    const int tid = otid(), lane = tid & 63, r32 = lane & 31, hi = lane >> 5, wid = __builtin_amdgcn_readfirstlane(tid >> 6);
    lp lds = (lp)lds_raw;
    const int bh = b * 8 + h;
    const bf16_t* ZB = (const bf16_t*)(p.ws + WS_ZB);
    const int* BCmbh = (const int*)(p.ws + WS_BCM) + (size_t)bh * 32 * 32;
    const int qi = 32 * wid + r32, t = qb * 256 + qi; const size_t tt = (size_t)b * S + t;
    float* wsf = (float*)(lds_raw + L_WSF) + wid * 64;
    float* ostage = (float*)(lds_raw + L_OST) + wid * 2048;
    const float c2 = exp2f(-(float)(h + 1)) * LOG2E;
    bf16x8 qr[4];
#pragma unroll
    for (int d0 = 0; d0 < 4; ++d0) qr[d0] = *(const bf16x8*)(ZB + tt * ZBW + ZB_MQ + h * 64 + d0 * 16 + hi * 8);
    const lp sK0 = lds + L_K, sV0 = lds + L_V;
    const bf16_t* KM_ = ZB + (size_t)b * S * ZBW + ZB_MK + h * 64; const bf16_t* VM_ = ZB + (size_t)b * S * ZBW + ZB_MV + h * 64;
    Soft sm; sm.m = 0.f; sm.l = 0.f; f32x16 o[2]; o[0] = f32x16{}; o[1] = f32x16{};
#pragma unroll
    for (int k = 0; k < 3; ++k) { dma_k(sK0 + k * 8192, KM_, ZBW, qb * 256 + 64 * k, wid, lane); dma_v(sV0 + k * 8192, VM_, ZBW, qb * 256 + 64 * k, wid, lane); }
    int tot, seg; moba_tables(BCmbh, lane, tot, seg);
    int before = 0; if (lane < 32) { for (int q = 0; q < qb; ++q) before += BCmbh[q * 32 + lane]; }
    const int base = seg + before;
#pragma unroll 1
    for (int i = 0; i < 4; ++i) {
        const int newer = 3 - i; AT_WAIT_NEWER(newer, 2);
        AT_WAITL(); bar();
        if (i == 0) { dma_k(sK0 + 3 * 8192, KM_, ZBW, qb * 256 + 192, wid, lane); dma_v(sV0 + 3 * 8192, VM_, ZBW, qb * 256 + 192, wid, lane); }
        const lp sK = sK0 + i * 8192, sV = sV0 + i * 8192;
        const bool skip = (32 * wid + 31 < 64 * i);
        if (!skip) {
            const float x0 = c2 * (float)(64 * i) - sm.m;
            f32x16 p0 = cinit(c2, hi, x0), p1 = cinit(c2, hi, x0 + c2 * 32.f);
            qk_tile(p0, p1, sK, qr, r32, hi);
            if (64 * i + 63 > 32 * wid) mask_tile(p0, p1, 0, qi - 64 * i, hi);
            VFrag vf; pv_load(vf, sV, lane, hi);
            softmax_step<true>(p0, p1, sm, o, wsf, r32, hi);
            { AT_PACK(p0, p1); pv_mfma(o, vf, pw0, pw1, pw2, pw3); }
        }
    }
    {
        const float lself = halfsum(sm.l);
        const unsigned s3 = ((const unsigned*)(p.ws + WS_SEL3))[tt * 8 + h], l3 = ((const unsigned*)(p.ws + WS_LRK))[tt * 8 + h];
        const float* PM = (const float*)(p.ws + WS_PM) + (size_t)bh * MB_CAP; const float* PL = (const float*)(p.ws + WS_PL) + (size_t)bh * MB_CAP;
        float mk[3], lk[3]; int pidx[3];
        float M = sm.m + c2 * 256.f * (float)qb;
        const float mself = M;
#pragma unroll
        for (int k = 0; k < 3; ++k) { const int jk = (s3 >> (8 * k)) & 255, lrk = (l3 >> (8 * k)) & 255;
            const int pb = __shfl(base, jk & 31);
            if (jk < 32) { pidx[k] = pb + lrk; mk[k] = PM[pidx[k]] + c2 * 256.f * (float)jk; lk[k] = PL[pidx[k]]; M = __builtin_fmaxf(M, mk[k]); }
            else { pidx[k] = -1; mk[k] = NEGS; lk[k] = 0.f; } }
        const float ws_ = __builtin_amdgcn_exp2f(mself - M);
        float wk[3]; float Lt = lself * ws_;
#pragma unroll
        for (int k = 0; k < 3; ++k) { wk[k] = pidx[k] >= 0 ? __builtin_amdgcn_exp2f(mk[k] - M) : 0.f; Lt += lk[k] * wk[k]; }
        const float inv = Lt > 0.f ? 1.f / Lt : 0.f;
        float* rws = wsf;
        float* rwk = (float*)(lds_raw + L_KMT) + wid * 256;
        int* rpi = (int*)(rwk + 96);
        if (hi == 0) { rws[r32] = ws_ * inv;
#pragma unroll
            for (int k = 0; k < 3; ++k) { rwk[k * 32 + r32] = wk[k] * inv; rpi[k * 32 + r32] = pidx[k]; } }
#pragma unroll
        for (int r = 0; r < 16; ++r) { const int orow = crow(r, hi); ostage[orow * 64 + r32] = o[0][r]; ostage[orow * 64 + 32 + r32] = o[1][r]; }
        wsync();
        const bf16_t* PO = (const bf16_t*)(p.ws + WS_PO) + (size_t)bh * MB_CAP * 64;
        bf16_t* AB = (bf16_t*)(p.ws + WS_ATTB);
#pragma unroll
        for (int i = 0; i < 4; ++i) { const int row = i * 8 + (lane >> 3), c8 = lane & 7;
            const float4 a = *(const float4*)(ostage + row * 64 + c8 * 8), c4 = *(const float4*)(ostage + row * 64 + c8 * 8 + 4);
            const float w0 = rws[row];
            float acc8[8] = {a.x * w0, a.y * w0, a.z * w0, a.w * w0, c4.x * w0, c4.y * w0, c4.z * w0, c4.w * w0};
#pragma unroll
            for (int k = 0; k < 3; ++k) { const int pi = rpi[k * 32 + row]; if (pi >= 0) { const float w = rwk[k * 32 + row]; const uint4 q = *(const uint4*)(PO + (size_t)pi * 64 + c8 * 8);
                const unsigned qq_[4] = {q.x, q.y, q.z, q.w};
#pragma unroll
                for (int e = 0; e < 4; ++e) { acc8[2 * e] += __builtin_bit_cast(float, qq_[e] << 16) * w; acc8[2 * e + 1] += __builtin_bit_cast(float, qq_[e] & 0xffff0000u) * w; } } }
            *(uint4*)(AB + ((size_t)b * S + qb * 256 + 32 * wid + row) * D + 512 + h * 64 + c8 * 8) = make_uint4(pk2(acc8[0], acc8[1]), pk2(acc8[2], acc8[3]), pk2(acc8[4], acc8[5]), pk2(acc8[6], acc8[7])); }
        wsync();
    }
    AT_WAITL(); bar();
}
}

__device__ __forceinline__ void phase_att1(const Params& p, unsigned char* lds_raw) {
    const int tid = otid();
    int* pre = (int*)(lds_raw + at::L_END);
    int* segt = pre + 514;
    { const int* BCm = (const int*)(p.ws + WS_BCM); const int bh = tid >> 5, j = tid & 31; int s = 0;
      for (int q = 0; q < 32; ++q) s += BCm[(size_t)(bh * 32 + q) * 32 + j];
      pre[tid + 1] = (s + 255) >> 8; if (tid == 0) pre[0] = 0;
      segt[tid] = (s + 31) & ~31; }
    __syncthreads();
    for (int sft = 1; sft < 512; sft <<= 1) { int v = 0, w = 0; if (tid >= sft) v = pre[tid + 1 - sft]; if ((tid & 31) >= sft) w = segt[tid - sft]; __syncthreads(); pre[tid + 1] += v; if (sft < 32) segt[tid] += w; __syncthreads(); }
    { const int* BCm = (const int*)(p.ws + WS_BCM); const int bh = tid >> 5, j = tid & 31; int s = 0;
      for (int q = 0; q < 32; ++q) s += BCm[(size_t)(bh * 32 + q) * 32 + j];
      const int excl = segt[tid] - ((s + 31) & ~31); __syncthreads(); segt[tid] = excl; }
    __syncthreads();
    const int nun = pre[512];
    for (int pi = blockIdx.x; pi < 512; pi += gridDim.x) {
        const int rnd = pi >> 8, id = pi & 255;
        const int bg = 2 * rnd + (id >> 7), c = rnd ? 127 - (id & 127) : (id & 127); at::nsa_unit(p, bg >> 1, bg & 1, c, lds_raw);
    }
    {
        const int u0 = (int)(((long)blockIdx.x * nun) / gridDim.x), u1 = (int)(((long)(blockIdx.x + 1) * nun) / gridDim.x);
        int prev = -1;
        for (int u = u0; u < u1; ++u) {
            int lo = 0, hi_ = 511;
            while (lo < hi_) { const int mid = (lo + hi_ + 1) >> 1; if (pre[mid] <= u) lo = mid; else hi_ = mid - 1; }
            at::moba_gather_unit(p, lo >> 5, lo & 31, u - pre[lo], segt[lo], lo != prev, lds_raw);
            prev = lo;
        }
    }
}
__device__ __forceinline__ void phase_att2(const Params& p, unsigned char* lds_raw) {
    for (int pi = blockIdx.x; pi < 512; pi += gridDim.x) {
        const int rnd = pi >> 8, id = pi & 255;
        const int bh = 8 * rnd + (id >> 5), qb = rnd ? 31 - (id & 31) : (id & 31); at::moba_self_unit(p, bh >> 3, bh & 7, qb, lds_raw);
    }
}
__device__ __forceinline__ void phase_route(const Params& p, unsigned char* lds_raw) {
    for (int pi = blockIdx.x; pi < 512; pi += gridDim.x) at::moba_route_unit(p, pi >> 8, (pi >> 5) & 7, pi & 31, lds_raw);
}


__device__ __forceinline__ void phase_r2_fast(const Params& p, int l, unsigned char* lds_raw) {
    using namespace at;
    const int tid = otid(), lane = tid & 63, wave = __builtin_amdgcn_readfirstlane(tid >> 6), r32 = lane & 31, hi = lane >> 5;
    const float* mod = (const float*)(p.ws + WS_MOD);
    const bf16_t* XAB = (const bf16_t*)(p.ws + WS_XAB); bf16_t* XN = (bf16_t*)(p.ws + WS_XN); bf16_t* XL = (bf16_t*)(p.ws + WS_XNLO);
    const float* lng = p.in[5] + (size_t)l * D; const float* rw = p.in[15] + (size_t)l * D * NE; const float* rb = p.in[16] + l * NE;
    int* toke = (int*)(p.ws + WS_TOKE); float* tokw = (float*)(p.ws + WS_TOKW); int* BC = (int*)(p.ws + WS_BC);
    lp lds = (lp)lds_raw;
    int* hist = (int*)(lds_raw + 131072);
    for (int blk = blockIdx.x; blk < T / 64; blk += gridDim.x) {
        for (int idx = tid; idx < 128 * 32; idx += NT) {
            const int kc = idx >> 5, e = idx & 31; float v[8];
#pragma unroll
            for (int j = 0; j < 8; ++j) v[j] = rw[(size_t)(8 * kc + j) * NE + e];
            unsigned hh[8], ll[8];
#pragma unroll
            for (int j = 0; j < 8; ++j) { hh[j] = f2bf(v[j]); ll[j] = f2bf(v[j] - __builtin_bit_cast(float, hh[j] << 16)); }
            *(uint4*)(lds_raw + (size_t)idx * 16) = make_uint4(hh[0] | (hh[1] << 16), hh[2] | (hh[3] << 16), hh[4] | (hh[5] << 16), hh[6] | (hh[7] << 16));
            *(uint4*)(lds_raw + 65536 + (size_t)idx * 16) = make_uint4(ll[0] | (ll[1] << 16), ll[2] | (ll[3] << 16), ll[4] | (ll[5] << 16), ll[6] | (ll[7] << 16));
        }
        if (tid < 32) hist[tid] = 0;
        {
            const int b = (blk * 64) / S;
            const float* sh = mod + ((size_t)l * Bn + b) * 6144 + 3 * D; const float* sc = mod + ((size_t)l * Bn + b) * 6144 + 4 * D;
            float4 ga[4], s0v[4];
#pragma unroll
            for (int j = 0; j < 4; ++j) { const int col = 4 * lane + 256 * j; const float4 g = *(const float4*)(lng + col), s1 = *(const float4*)(sc + col); s0v[j] = *(const float4*)(sh + col);
                ga[j] = make_float4(g.x * (1.f + s1.x), g.y * (1.f + s1.y), g.z * (1.f + s1.z), g.w * (1.f + s1.w)); }
#pragma unroll 1
            for (int i0 = 0; i0 < 8; i0 += 4) {
                uint2 q_[4][4];
#pragma unroll
                for (int i = 0; i < 4; ++i)
#pragma unroll
                    for (int j = 0; j < 4; ++j) q_[i][j] = *(const uint2*)(XAB + (size_t)(blk * 64 + wave * 8 + i0 + i) * D + 4 * lane + 256 * j);
                float ss[4];
#pragma unroll
                for (int i = 0; i < 4; ++i) { float s_ = 0.f;
#pragma unroll
                    for (int j = 0; j < 4; ++j) { const float x0 = __builtin_bit_cast(float, q_[i][j].x << 16), x1 = __builtin_bit_cast(float, q_[i][j].x & 0xffff0000u), x2 = __builtin_bit_cast(float, q_[i][j].y << 16), x3 = __builtin_bit_cast(float, q_[i][j].y & 0xffff0000u);
                        s_ += (x0 * x0 + x1 * x1) + (x2 * x2 + x3 * x3); }
                    ss[i] = s_; }
#pragma unroll
                for (int sft = 32; sft >= 1; sft >>= 1) {
#pragma unroll
                    for (int i = 0; i < 4; ++i) ss[i] += __shfl_xor(ss[i], sft); }
#pragma unroll
                for (int i = 0; i < 4; ++i) {
                    const int t = blk * 64 + wave * 8 + i0 + i;
                    const float r = rsqrtf(ss[i] * (1.f / D) + EPS);
#pragma unroll
                    for (int j = 0; j < 4; ++j) {
                        const int col = 4 * lane + 256 * j;
                        const float x0 = __builtin_bit_cast(float, q_[i][j].x << 16), x1 = __builtin_bit_cast(float, q_[i][j].x & 0xffff0000u), x2 = __builtin_bit_cast(float, q_[i][j].y << 16), x3 = __builtin_bit_cast(float, q_[i][j].y & 0xffff0000u);
                        const float o[4] = {x0 * r * ga[j].x + s0v[j].x, x1 * r * ga[j].y + s0v[j].y, x2 * r * ga[j].z + s0v[j].z, x3 * r * ga[j].w + s0v[j].w};
                        unsigned hh[4], ll[4];
#pragma unroll
                        for (int q = 0; q < 4; ++q) { hh[q] = f2bf(o[q]); ll[q] = f2bf(o[q] - __builtin_bit_cast(float, hh[q] << 16)); }
                        *(uint2*)(XN + (size_t)t * D + col) = make_uint2(hh[0] | (hh[1] << 16), hh[2] | (hh[3] << 16));
                        *(uint2*)(XL + (size_t)t * D + col) = make_uint2(ll[0] | (ll[1] << 16), ll[2] | (ll[3] << 16));
                    }
                }
            }
        }
        asm volatile("s_waitcnt vmcnt(0)" ::: "memory");
        __syncthreads();
        f32x16 acc = f32x16{};
        {
            const int rh = wave & 1, kq = wave >> 1;
            const int t = blk * 64 + rh * 32 + r32;
            const bf16_t* xh = XN + (size_t)t * D + 8 * hi + 256 * kq; const bf16_t* xl = XL + (size_t)t * D + 8 * hi + 256 * kq;
            const AT_LAS unsigned char* wh = lds + (size_t)(hi * 32 + r32) * 16 + (size_t)kq * 16 * 1024; const AT_LAS unsigned char* wl = wh + 65536;
#pragma unroll 8
            for (int ks = 0; ks < 16; ++ks) {
                const bf16x8 bh = *(const bf16x8*)(xh + 16 * ks), bl = *(const bf16x8*)(xl + 16 * ks);
                const bf16x8 ah = *(const AT_LAS bf16x8*)(wh + ks * 1024), al = *(const AT_LAS bf16x8*)(wl + ks * 1024);
                acc = __builtin_amdgcn_mfma_f32_32x32x16_bf16(ah, bh, acc, 0, 0, 0);
                acc = __builtin_amdgcn_mfma_f32_32x32x16_bf16(al, bh, acc, 0, 0, 0);
                acc = __builtin_amdgcn_mfma_f32_32x32x16_bf16(ah, bl, acc, 0, 0, 0);
            }
        }
        __syncthreads();
        { float* part = (float*)lds_raw;
          if (wave >= 2) {
#pragma unroll
              for (int r = 0; r < 16; ++r) part[(wave * 16 + r) * 64 + lane] = acc[r]; } }
        __syncthreads();
        if (wave < 2) {
            const int t = blk * 64 + wave * 32 + r32;
            { const float* part = (const float*)lds_raw;
#pragma unroll
              for (int r = 0; r < 16; ++r) acc[r] = ((acc[r] + part[((wave + 2) * 16 + r) * 64 + lane]) + part[((wave + 4) * 16 + r) * 64 + lane]) + part[((wave + 6) * 16 + r) * 64 + lane]; }
            float a0 = -3e38f, a1 = -3e38f, a2 = -3e38f, a3 = -3e38f; int i0 = 99, i1 = 99, i2 = 99, i3 = 99;
#pragma unroll
            for (int r = 0; r < 16; ++r) { const int e = crow(r, hi); const float s_ = acc[r] + rb[e];
                if (s_ > a0) { a3 = a2; i3 = i2; a2 = a1; i2 = i1; a1 = a0; i1 = i0; a0 = s_; i0 = e; }
                else if (s_ > a1) { a3 = a2; i3 = i2; a2 = a1; i2 = i1; a1 = s_; i1 = e; }
                else if (s_ > a2) { a3 = a2; i3 = i2; a2 = s_; i2 = e; }
                else if (s_ > a3) { a3 = s_; i3 = e; } }
            float ov[4]; int oi[4];
            { const float sv[4] = {a0, a1, a2, a3}; const int si[4] = {i0, i1, i2, i3};
#pragma unroll
              for (int k = 0; k < 4; ++k) { auto a = __builtin_amdgcn_permlane32_swap(__float_as_uint(sv[k]), __float_as_uint(sv[k]), false, false); ov[k] = __uint_as_float(hi ? a[0] : a[1]);
                                            auto c = __builtin_amdgcn_permlane32_swap((unsigned)si[k], (unsigned)si[k], false, false); oi[k] = (int)(hi ? c[0] : c[1]); } }
#pragma unroll
            for (int k = 0; k < 4; ++k) { const float s_ = ov[k]; const int e = oi[k];
                if (s_ > a0 || (s_ == a0 && e < i0)) { a3 = a2; i3 = i2; a2 = a1; i2 = i1; a1 = a0; i1 = i0; a0 = s_; i0 = e; }
                else if (s_ > a1 || (s_ == a1 && e < i1)) { a3 = a2; i3 = i2; a2 = a1; i2 = i1; a1 = s_; i1 = e; }
                else if (s_ > a2 || (s_ == a2 && e < i2)) { a3 = a2; i3 = i2; a2 = s_; i2 = e; }
                else if (s_ > a3 || (s_ == a3 && e < i3)) { a3 = s_; i3 = e; } }
            const float e1 = __expf(a1 - a0), e2 = __expf(a2 - a0), e3 = __expf(a3 - a0), inv = 1.f / (((1.f + e1) + e2) + e3);
            if (hi == 0) {
                *(int4*)(toke + (size_t)t * 4) = make_int4(i0, i1, i2, i3);
                *(float4*)(tokw + (size_t)t * 4) = make_float4(inv, e1 * inv, e2 * inv, e3 * inv);
                atomicAdd(&hist[i0], 1); atomicAdd(&hist[i1], 1); atomicAdd(&hist[i2], 1); atomicAdd(&hist[i3], 1);
            }
        }
        __syncthreads();
        if (tid < 32) BC[blk * 32 + tid] = hist[tid];
        __syncthreads();
    }
}
__device__ __forceinline__ void phase_sc_fast(const Params& p, int l, unsigned char* lds_raw) {
    const int tid = otid();
    const int* BC = (const int*)(p.ws + WS_BC);
    int* cnt = (int*)(p.ws + WS_CNT) + l * 32;
    int* tot = (int*)lds_raw; int* base = tot + 32; int* fillc = tot + 64; int* before = tot + 96;
    const int* toke = (const int*)(p.ws + WS_TOKE); const float* tokw = (const float*)(p.ws + WS_TOKW);
    int* rowtok = (int*)(p.ws + WS_ROWTOK) + (size_t)l * RMAX; float* roww = (float*)(p.ws + WS_ROWW) + (size_t)l * RMAX; int* pos = (int*)(p.ws + WS_POS);
    for (int blk = blockIdx.x; blk < T / 64; blk += gridDim.x) {
        { const int e = tid & 31, part = tid >> 5; int s = 0, bf = 0;
#pragma unroll 4
          for (int i = part * 16; i < part * 16 + 16; ++i) { const int c = BC[i * 32 + e]; s += c; if (i < blk) bf += c; }
          int* ptot = tot + 128; int* pbef = ptot + 512;
          ptot[tid] = s; pbef[tid] = bf; }
        __syncthreads();
        if (tid < 32) { const int* ptot = tot + 128; const int* pbef = ptot + 512; int s = 0, bf = 0;
#pragma unroll
            for (int q = 0; q < 16; ++q) { s += ptot[q * 32 + tid]; bf += pbef[q * 32 + tid]; }
            tot[tid] = s; before[tid] = bf; fillc[tid] = 0; if (blk == 0) cnt[tid] = s; }
        __syncthreads();
        if (tid == 0) { int s = 0; for (int e = 0; e < 32; ++e) { base[e] = s + before[e]; s += (tot[e] + 255) & ~255; } }
        __syncthreads();
        if (tid < 256) {
            const int i = blk * 256 + tid, e = toke[i];
            const int slot = base[e] + atomicAdd(&fillc[e], 1);
            rowtok[slot] = i >> 2; roww[slot] = tokw[i]; pos[i] = slot;
        }
        __syncthreads();
    }
}

#define XB_TMO      128
#define XB_XCNT(j)  (256  + 64 * (j))
#define XB_XSUB(j)  (1280 + 64 * (j))
#define XB_XGEN(j)  (2304 + 64 * (j))
#define XB_TOP      3328
#define XB_TOPGEN   3392
#define XCD_BAR_WORDS 3456
#define XB_SPIN_CAP (1u << 18)
#define XLAS __attribute__((address_space(3)))
__device__ __forceinline__ unsigned xb_ld(unsigned* p)              { return __hip_atomic_load(p, __ATOMIC_RELAXED, __HIP_MEMORY_SCOPE_AGENT); }
__device__ __forceinline__ unsigned xb_add(unsigned* p, unsigned v) { return __hip_atomic_fetch_add(p, v, __ATOMIC_RELAXED, __HIP_MEMORY_SCOPE_AGENT); }
__device__ __forceinline__ unsigned xb_xcc_id() { return (unsigned)__builtin_amdgcn_s_getreg((3 << 11) | 20) & 0xFu; }
#define XB_SPIN(cond, bar) do { unsigned _sp = 0; while (cond) { __builtin_amdgcn_s_sleep(1); \
    if ((++_sp & 255u) == 0u) { if (xb_ld(&(bar)[XB_TMO])) break; if (_sp > XB_SPIN_CAP) { atomicAdd(&(bar)[XB_TMO], 1u); break; } } } } while (0)
constexpr int LDS_BARST_OFF = 147200;
struct XcdBarrier { unsigned* bar; unsigned x; volatile XLAS unsigned* st; };
__device__ __forceinline__ XcdBarrier xcd_barrier_post(unsigned* bar, volatile XLAS unsigned* st) {
    XcdBarrier b; b.bar = bar; b.x = xb_xcc_id(); b.st = st;
    if (threadIdx.x == 0) (void)xb_add(&bar[XB_XCNT(b.x)], 1u);
    return b;
}
__device__ __forceinline__ void xcd_barrier_complete(unsigned* bar, unsigned x, unsigned& nloc, unsigned& nx) {
    const unsigned G = gridDim.x * gridDim.y * gridDim.z;
    unsigned sum, cnt, mine, sp = 0u;
    for (;;) {
        sum = 0u; cnt = 0u; mine = 0u;
#pragma unroll
        for (unsigned j = 0; j < 16; ++j) { const unsigned c = xb_ld(&bar[XB_XCNT(j)]); sum += c; cnt += (c > 0u) ? 1u : 0u; mine = (j == x) ? c : mine; }
        if (sum == G) break;
        __builtin_amdgcn_s_sleep(1);
        if ((++sp & 255u) == 0u) { if (xb_ld(&bar[XB_TMO])) break; if (sp > XB_SPIN_CAP) { atomicAdd(&bar[XB_TMO], 1u); break; } }
    }
    nloc = mine > 0u ? mine : 1u; nx = cnt > 0u ? cnt : 1u;
}
__device__ __forceinline__ void xcd_barrier(unsigned char* ws, unsigned char* lds_raw_) {
    XcdBarrier b; b.bar = (unsigned*)(ws + WS_BAR); b.x = xb_xcc_id(); b.st = (volatile XLAS unsigned*)((XLAS unsigned char*)lds_raw_ + LDS_BARST_OFF);
    asm volatile("s_waitcnt vmcnt(0)" ::: "memory");
    __syncthreads();
    if (threadIdx.x == 0) {
        unsigned* bar = b.bar;
        __builtin_amdgcn_s_waitcnt(0);
        unsigned nloc = b.st[0], nx = b.st[1];
        if (nloc == 0u) { xcd_barrier_complete(bar, b.x, nloc, nx); b.st[0] = nloc; b.st[1] = nx; }
        const unsigned old = xb_add(&bar[XB_XSUB(b.x)], 1u);
        const unsigned gen = old / nloc;
        if (old + 1u == (gen + 1u) * nloc) {
            __builtin_amdgcn_fence(__ATOMIC_RELEASE, "agent");
            asm volatile("s_waitcnt vmcnt(0)" ::: "memory");
            const unsigned og = xb_add(&bar[XB_TOP], 1u);
            const unsigned tg = og / nx;
            if (og + 1u == (tg + 1u) * nx) xb_add(&bar[XB_TOPGEN], 1u);
            else XB_SPIN(xb_ld(&bar[XB_TOPGEN]) == tg, bar);
            __builtin_amdgcn_fence(__ATOMIC_ACQUIRE, "agent");
            xb_add(&bar[XB_XGEN(b.x)], 1u);
            asm volatile("s_waitcnt vmcnt(0)" ::: "memory");
        } else {
            XB_SPIN(xb_ld(&bar[XB_XGEN(b.x)]) == gen, bar);
            __builtin_amdgcn_fence(__ATOMIC_ACQUIRE, "agent");
            asm volatile("s_waitcnt vmcnt(0)" ::: "memory");
        }
    }
    __syncthreads();
}

__global__ void __launch_bounds__(NT, 2) mega_fwd(Params p) {
    extern __shared__ __attribute__((aligned(16))) unsigned char lds_raw[];
    float* lds = (float*)lds_raw;
    volatile XLAS unsigned* bst = (volatile XLAS unsigned*)((XLAS unsigned char*)lds_raw + LDS_BARST_OFF);
    if (threadIdx.x < 2) bst[threadIdx.x] = 0u;
    __syncthreads();
    (void)xcd_barrier_post((unsigned*)(p.ws + WS_BAR), bst);
#define GSYNC() xcd_barrier(p.ws, lds_raw)
    phase_p0a(p, lds);
    __syncthreads();
    phase_convert(p, lds);
    GSYNC();
    phase_p0b(p);
    GSYNC();
    _Pragma("unroll 1") for (int l = 0; l < L; ++l) {
        phase_r1(p, l, true);
        GSYNC();
        phase_g1_fast(p, l, lds_raw);
        GSYNC();
        phase_ck_fast(p, l, lds_raw);
        GSYNC();
        phase_c2(p, l, lds);
        __syncthreads();
        phase_route(p, lds_raw);
        GSYNC();
        phase_att1(p, lds_raw);
        GSYNC();
        phase_att2(p, lds_raw);
        GSYNC();
        phase_g2_fast(p, l, lds_raw);
        GSYNC();
        phase_r2_fast(p, l, lds_raw);
        GSYNC();
        phase_sc_fast(p, l, lds_raw);
        GSYNC();
        phase_m1_fast(p, l, lds_raw);
        GSYNC();
        phase_m2_fast(p, l, lds_raw);
        GSYNC();
    }
    phase_r1(p, L, false);
}

extern "C" void kernel_launch(void* const* d_in, const int* in_sizes, int n_in, void* d_out, int out_size, void* d_ws, size_t ws_size, hipStream_t stream) {
    static int grid_blocks = 0;
    if (grid_blocks == 0) {
        if (n_in != 21 || out_size != T * D || ws_size < WS_END) { fprintf(stderr, "kernel_launch: unexpected shapes (n_in %d out %d ws %zu need %zu)\n", n_in, out_size, ws_size, (size_t)WS_END); grid_blocks = -1; return; }
        int dev = 0, cus = 0, per_cu = 0;
        hipGetDevice(&dev);
        hipDeviceGetAttribute(&cus, hipDeviceAttributeMultiprocessorCount, dev);
        hipFuncSetAttribute((const void*)mega_fwd, hipFuncAttributeMaxDynamicSharedMemorySize, LDS_BYTES);
        hipOccupancyMaxActiveBlocksPerMultiprocessor(&per_cu, (const void*)mega_fwd, NT, LDS_BYTES);
        if (per_cu < 1) { fprintf(stderr, "kernel_launch: occupancy query says %d blocks per CU\n", per_cu); per_cu = 1; }
        (void)hipGetLastError();
        grid_blocks = cus * 1;
    }
    if (grid_blocks < 0) return;
    if (hipMemsetAsync((char*)d_ws + WS_BAR, 0, 16384, stream) != hipSuccess) { fprintf(stderr, "kernel_launch: memset failed\n"); return; }
    Params p{};
    for (int i = 0; i < 21; ++i) p.in[i] = (const float*)d_in[i];
    p.out = (float*)d_out; p.ws = (unsigned char*)d_ws;
    hipLaunchKernelGGL(mega_fwd, dim3(grid_blocks), dim3(NT), LDS_BYTES, stream, p);
    hipError_t e = hipPeekAtLastError();
    if (e != hipSuccess) fprintf(stderr, "launch failed: %s (grid %d)\n", hipGetErrorString(e), grid_blocks);
}
```

```cpp
#include <hip/hip_runtime.h>
#include <cstdio>
#include <cstdint>

constexpr int Bn = 2, S = 8192, D = 1024, L = 2, T = Bn * S;
constexpr int INW = 2840;
constexpr int NE = 32, TOPK = 4, DFF = 1024;
constexpr int A_TOT = T * TOPK;
constexpr int RMAX = A_TOT + NE * 256;
constexpr int NCMP = 511;
constexpr int NT = 512;
constexpr int NW = NT / 64;
constexpr int LDS_BYTES = 147456;
constexpr float EPS = 1e-6f;
constexpr float NEGF = -1e30f;

constexpr int ZBW = 3072;
constexpr int ZB_Q = 0, ZB_KC = 512, ZB_VC = 640, ZB_KS = 768, ZB_VS = 896, ZB_KW = 1024, ZB_VW = 1152, ZB_MQ = 1280, ZB_MK = 1792, ZB_MV = 2304, ZB_G = 2816;
constexpr float QSCALE = 0.125f * 1.4426950408889634f;
constexpr float LOG2E = 1.4426950408889634f;

constexpr size_t al256(size_t x) { return (x + 255) & ~(size_t)255; }
constexpr size_t WS_BAR = 0;
constexpr size_t WS_MODP = 16384;
constexpr size_t WS_MOD = al256(WS_MODP + (size_t)8 * L * Bn * 6144 * 4);
constexpr size_t WS_CNT = al256(WS_MOD + (size_t)L * Bn * 6144 * 4);
constexpr size_t WS_ROWTOK = al256(WS_CNT + L * 32 * 4);
constexpr size_t WS_ROWW = al256(WS_ROWTOK + (size_t)L * RMAX * 4);
constexpr size_t WS_TOKE = al256(WS_ROWW + (size_t)L * RMAX * 4);
constexpr size_t WS_TOKW = al256(WS_TOKE + (size_t)T * 4 * 4);
constexpr size_t WS_POS = al256(WS_TOKW + (size_t)T * 4 * 4);
constexpr size_t WS_Y = al256(WS_POS + (size_t)T * 4 * 4);
constexpr size_t WS_WINT = al256(WS_Y + (size_t)RMAX * 1024 * 4);
constexpr size_t WS_WOT = al256(WS_WINT + (size_t)L * 3072 * 1024 * 2);
constexpr size_t WS_W1T = al256(WS_WOT + (size_t)L * 1024 * 1024 * 2);
constexpr size_t WS_W2T = al256(WS_W1T + (size_t)L * NE * 2048 * 1024 * 2);
constexpr size_t WS_XN = al256(WS_W2T + (size_t)L * NE * 1024 * 1024 * 2);
constexpr size_t WS_ATTB = al256(WS_XN + (size_t)(T + 1) * D * 2);
constexpr size_t WS_ACT = al256(WS_ATTB + (size_t)T * D * 2);
constexpr size_t WS_ZB = al256(WS_ACT + (size_t)RMAX * DFF * 2);
constexpr size_t WS_GATE = al256(WS_ZB + (size_t)T * ZBW * 2);
constexpr size_t WS_KCB = al256(WS_GATE + (size_t)T * 32 * 4);
constexpr size_t WS_VCB = al256(WS_KCB + (size_t)Bn * 2 * 512 * 64 * 2);
constexpr size_t WS_KMB = al256(WS_VCB + (size_t)Bn * 2 * 512 * 64 * 2);
constexpr size_t WS_XNLO = al256(WS_KMB + (size_t)Bn * 8 * 32 * 64 * 2);
constexpr size_t WS_BC = al256(WS_XNLO + (size_t)T * D * 2);
constexpr size_t WS_WCT = al256(WS_BC + (size_t)(T / 64) * 32 * 4);
constexpr size_t WS_CBP = al256(WS_WCT + (size_t)L * 2 * 128 * 2048 * 2);
constexpr size_t WS_CB = al256(WS_CBP + (size_t)16 * L * 2 * 128 * 4);
constexpr size_t WS_HIDP = al256(WS_CB + (size_t)L * 2 * 128 * 4);
constexpr size_t WS_XAB = al256(WS_HIDP + (size_t)4 * 2 * 2044 * 128 * 4);
constexpr size_t WS_SEL3 = al256(WS_XAB + (size_t)T * D * 2);
constexpr size_t WS_LRK = al256(WS_SEL3 + (size_t)T * 8 * 4);
constexpr size_t WS_ILIST = al256(WS_LRK + (size_t)T * 8 * 4);
constexpr size_t WS_BCM = al256(WS_ILIST + (size_t)16 * 32 * 32 * 256);
constexpr size_t WS_PM = al256(WS_BCM + (size_t)16 * 32 * 32 * 4);
constexpr size_t WS_PL = al256(WS_PM + (size_t)16 * 25600 * 4);
constexpr size_t WS_PO = al256(WS_PL + (size_t)16 * 25600 * 4);
constexpr size_t WS_END = al256(WS_PO + (size_t)16 * 25600 * 64 * 2);

struct Params {
    const float* in[21];
    float* out;
    unsigned char* ws;
};

__device__ __forceinline__ int otid() { int t = threadIdx.x; asm volatile("" : "+v"(t)); return t; }
typedef unsigned short bf16_t;
__device__ __forceinline__ unsigned f2bf(float f) { unsigned u = __builtin_bit_cast(unsigned, f); return (u + 0x7fffu + ((u >> 16) & 1u)) >> 16; }
__device__ __forceinline__ unsigned pk2(float lo, float hi) { return f2bf(lo) | (f2bf(hi) << 16); }
__device__ __forceinline__ float bf2f(bf16_t v) { return __builtin_bit_cast(float, (unsigned)v << 16); }
__device__ __forceinline__ float wave_sum(float v) {
#pragma unroll
    for (int o = 1; o < 64; o <<= 1) v += __shfl_xor(v, o);
    return v;
}
__device__ __forceinline__ float sigmoidf_(float x) { return 1.f / (1.f + __expf(-x)); }
__device__ __forceinline__ float gelu_tanh(float x) {
    const float u = 0.7978845608028654f * (x + 0.044715f * x * x * x);
    return 0.5f * x * (1.f + tanhf(u));
}

__device__ __forceinline__ void phase_p0a(const Params& p, float* lds) {
    const int tid = otid(), gtid = blockIdx.x * NT + tid, gsz = gridDim.x * NT;
    int* cnt = (int*)(p.ws + WS_CNT); int* rowtok = (int*)(p.ws + WS_ROWTOK);
    for (int i = gtid; i < L * 32; i += gsz) cnt[i] = 0;
    for (int i = gtid; i < L * RMAX; i += gsz) rowtok[i] = -1;
    const float* c = p.in[1];
    for (int i = tid; i < Bn * D; i += NT) { const float v = c[i]; lds[i] = v / (1.f + __expf(-v)); }
    __syncthreads();
    const float* ada_w = p.in[2];
    float* modp = (float*)(p.ws + WS_MODP);
    for (int idx = gtid; idx < 8 * L * 6144; idx += gsz) {
        const int col = idx % 6144, l = (idx / 6144) % L, kc = idx / (6144 * L);
        const float* w = ada_w + ((size_t)l * D + kc * 128) * 6144 + col;
        float a0 = 0.f, a1 = 0.f, c0 = 0.f, c1 = 0.f;
#pragma unroll 1
        for (int k0 = 0; k0 < 128; k0 += 32) { float wv[32];
#pragma unroll
            for (int k = 0; k < 32; ++k) wv[k] = __builtin_nontemporal_load(w + (size_t)(k0 + k) * 6144);
#pragma unroll
            for (int k = 0; k < 32; k += 2) { a0 += lds[kc * 128 + k0 + k] * wv[k]; a1 += lds[D + kc * 128 + k0 + k] * wv[k]; c0 += lds[kc * 128 + k0 + k + 1] * wv[k + 1]; c1 += lds[D + kc * 128 + k0 + k + 1] * wv[k + 1]; } }
        modp[((size_t)(kc * L + l) * Bn + 0) * 6144 + col] = a0 + c0;
        modp[((size_t)(kc * L + l) * Bn + 1) * 6144 + col] = a1 + c1;
    }
    { const float* posw = p.in[9]; const float* w1c = p.in[10]; float* cbp = (float*)(p.ws + WS_CBP);
      int first = 8 * L * 6144; if (first + 16 * L * 2 * 128 > gsz) first = 0;
      for (int idx = gtid - first; idx < 16 * L * 2 * 128; idx += gsz) { if (idx < 0) continue;
          const int j = idx & 127, li = (idx >> 7) % (L * 2), kc = idx / (L * 2 * 128);
          const float* w = w1c + ((size_t)li * 2048 + kc * 128) * 128 + j; const float* pp = posw + (size_t)li * 2048 + kc * 128;
          float a = 0.f, c_ = 0.f;
#pragma unroll 1
          for (int k0 = 0; k0 < 128; k0 += 32) { float wv[32];
#pragma unroll
              for (int k = 0; k < 32; ++k) wv[k] = w[(size_t)(k0 + k) * 128];
#pragma unroll
              for (int k = 0; k < 32; k += 2) { a += pp[k0 + k] * wv[k]; c_ += pp[k0 + k + 1] * wv[k + 1]; } }
          cbp[idx] = a + c_; } }
}
__device__ __forceinline__ void phase_p0b(const Params& p) {
    const int gtid = blockIdx.x * NT + otid(), gsz = gridDim.x * NT;
    { const float* cbp = (const float*)(p.ws + WS_CBP); float* cb = (float*)(p.ws + WS_CB);
      for (int idx = gtid; idx < L * 2 * 128; idx += gsz) { float s = 0.f;
#pragma unroll
          for (int kc = 0; kc < 16; ++kc) s += cbp[kc * (L * 2 * 128) + idx];
          cb[idx] = s; } }
    const float* modp = (const float*)(p.ws + WS_MODP); float* mod = (float*)(p.ws + WS_MOD); const float* ada_b = p.in[3];
    for (int idx = gtid; idx < L * Bn * 6144; idx += gsz) {
        const int col = idx % 6144, l = idx / (Bn * 6144);
        float s = ada_b[l * 6144 + col];
#pragma unroll
        for (int kc = 0; kc < 8; ++kc) s += modp[(size_t)kc * L * Bn * 6144 + idx];
        mod[idx] = s;
    }
}

__device__ __forceinline__ void phase_r1(const Params& p, int l, bool do_h) {
    const int lane = otid() & 63, wave = otid() >> 6;
    const int gw = blockIdx.x * NW + wave, ngw = gridDim.x * NW;
    const float* mod = (const float*)(p.ws + WS_MOD);
    const float* xin = p.in[0]; float* XA = p.out;
    const bf16_t* Y = (const bf16_t*)(p.ws + WS_Y); const int* pos = (const int*)(p.ws + WS_POS); const float* tokw = (const float*)(p.ws + WS_TOKW);
    const float* lng = p.in[4] + (size_t)(do_h ? l : 0) * D;
    bf16_t* XN = (bf16_t*)(p.ws + WS_XN); bf16_t* XAB = (bf16_t*)(p.ws + WS_XAB);
#define BF4(q) make_float4(__builtin_bit_cast(float, (q).x << 16), __builtin_bit_cast(float, (q).x & 0xffff0000u), __builtin_bit_cast(float, (q).y << 16), __builtin_bit_cast(float, (q).y & 0xffff0000u))
    int curb = -1; float4 g2v[4], ga[4], s0v[4];
    for (int t0 = gw; t0 < T; t0 += ngw) {
        const int nr = 1;
        float4 v[2][4];
        if (l == 0) {
#pragma unroll
            for (int i = 0; i < 2; ++i) if (i < nr) {
#pragma unroll
                for (int j = 0; j < 4; ++j) v[i][j] = *(const float4*)(xin + (size_t)(t0 + i * ngw) * D + 4 * lane + 256 * j); }
        } else {
            int4 ps[2]; float4 tw[2]; uint2 xq[2][4];
#pragma unroll
            for (int i = 0; i < 2; ++i) if (i < nr) { const int t = t0 + i * ngw; ps[i] = *(const int4*)(pos + (size_t)t * 4); tw[i] = *(const float4*)(tokw + (size_t)t * 4);
#pragma unroll
                for (int j = 0; j < 4; ++j) xq[i][j] = *(const uint2*)(XAB + (size_t)t * D + 4 * lane + 256 * j); }
            uint2 yq[2][4][4];
#pragma unroll
            for (int i = 0; i < 2; ++i) if (i < nr) {
#pragma unroll
                for (int j = 0; j < 4; ++j) { const int col = 4 * lane + 256 * j;
                    yq[i][j][0] = *(const uint2*)(Y + (size_t)ps[i].x * D + col); yq[i][j][1] = *(const uint2*)(Y + (size_t)ps[i].y * D + col);
                    yq[i][j][2] = *(const uint2*)(Y + (size_t)ps[i].z * D + col); yq[i][j][3] = *(const uint2*)(Y + (size_t)ps[i].w * D + col); } }
#pragma unroll
            for (int i = 0; i < 2; ++i) if (i < nr) {
                const int t = t0 + i * ngw, b = t / S;
                if (b != curb) { curb = b;
                    const float* g2 = mod + ((size_t)(l - 1) * Bn + b) * 6144 + 5 * D;
#pragma unroll
                    for (int j = 0; j < 4; ++j) g2v[j] = *(const float4*)(g2 + 4 * lane + 256 * j);
                    if (do_h) { const float* sh = mod + ((size_t)l * Bn + b) * 6144 + 0 * D; const float* sc = mod + ((size_t)l * Bn + b) * 6144 + 1 * D;
#pragma unroll
                        for (int j = 0; j < 4; ++j) { const int col = 4 * lane + 256 * j; const float4 g = *(const float4*)(lng + col), s1 = *(const float4*)(sc + col); s0v[j] = *(const float4*)(sh + col);
                            ga[j] = make_float4(g.x * (1.f + s1.x), g.y * (1.f + s1.y), g.z * (1.f + s1.z), g.w * (1.f + s1.w)); } } }
#pragma unroll
                for (int j = 0; j < 4; ++j) {
                    const int col = 4 * lane + 256 * j;
                    const float4 x = BF4(xq[i][j]);
                    const float4 y0 = BF4(yq[i][j][0]), y1 = BF4(yq[i][j][1]), y2 = BF4(yq[i][j][2]), y3 = BF4(yq[i][j][3]);
                    const float4 g = g2v[j];
                    float4 r;
                    r.x = x.x + g.x * (((tw[i].x * y0.x + tw[i].y * y1.x) + tw[i].z * y2.x) + tw[i].w * y3.x); r.y = x.y + g.y * (((tw[i].x * y0.y + tw[i].y * y1.y) + tw[i].z * y2.y) + tw[i].w * y3.y);
                    r.z = x.z + g.z * (((tw[i].x * y0.z + tw[i].y * y1.z) + tw[i].z * y2.z) + tw[i].w * y3.z); r.w = x.w + g.w * (((tw[i].x * y0.w + tw[i].y * y1.w) + tw[i].z * y2.w) + tw[i].w * y3.w);
                    v[i][j] = r;
                    if (do_h) *(uint2*)(XAB + (size_t)t * D + col) = make_uint2(pk2(r.x, r.y), pk2(r.z, r.w));
                    else *(float4*)(XA + (size_t)t * D + col) = r;
                }
            }
        }
        if (do_h) {
#pragma unroll
            for (int i = 0; i < 2; ++i) if (i < nr) {
                const int t = t0 + i * ngw, b = t / S;
                if (b != curb) { curb = b;
                    const float* sh = mod + ((size_t)l * Bn + b) * 6144 + 0 * D; const float* sc = mod + ((size_t)l * Bn + b) * 6144 + 1 * D;
#pragma unroll
                    for (int j = 0; j < 4; ++j) { const int col = 4 * lane + 256 * j; const float4 g = *(const float4*)(lng + col), s1 = *(const float4*)(sc + col); s0v[j] = *(const float4*)(sh + col);
                        ga[j] = make_float4(g.x * (1.f + s1.x), g.y * (1.f + s1.y), g.z * (1.f + s1.z), g.w * (1.f + s1.w)); } }
                float ss = 0.f;
#pragma unroll
                for (int j = 0; j < 4; ++j) ss += (v[i][j].x * v[i][j].x + v[i][j].y * v[i][j].y) + (v[i][j].z * v[i][j].z + v[i][j].w * v[i][j].w);
                ss = wave_sum(ss);
                const float r = rsqrtf(ss * (1.f / D) + EPS);
#pragma unroll
                for (int j = 0; j < 4; ++j) {
                    const int col = 4 * lane + 256 * j;
                    float4 o;
                    o.x = v[i][j].x * r * ga[j].x + s0v[j].x; o.y = v[i][j].y * r * ga[j].y + s0v[j].y;
                    o.z = v[i][j].z * r * ga[j].z + s0v[j].z; o.w = v[i][j].w * r * ga[j].w + s0v[j].w;
                    *(uint2*)(XN + (size_t)t * D + col) = make_uint2(pk2(o.x, o.y), pk2(o.z, o.w));
                }
            }
        }
    }
#undef BF4
}


__device__ __forceinline__ void phase_c2(const Params& p, int l, float* lds) {
    const int lane = otid() & 63, wave = otid() >> 6;
    const float* HIDP = (const float*)(p.ws + WS_HIDP); const float* cb = (const float*)(p.ws + WS_CB) + l * 2 * 128; const float* w2 = p.in[11] + (size_t)l * 2 * 128 * 64;
    const float gk = p.in[8][l * 64 + lane];
    float* hl = lds + wave * 128;
    for (int r = blockIdx.x * NW + wave; r < 2 * 2044; r += gridDim.x * NW) {
        const int idx = r / 2044, rr = r % 2044;
#pragma unroll
        for (int q = 0; q < 2; ++q) { const int j = lane + 64 * q; float s = cb[idx * 128 + j];
#pragma unroll
            for (int kq = 0; kq < 4; ++kq) s += HIDP[((size_t)(kq * 2 + idx) * 2044 + rr) * 128 + j];
            hl[j] = gelu_tanh(s); }
        asm volatile("s_waitcnt lgkmcnt(0)" ::: "memory"); __builtin_amdgcn_wave_barrier();
        const float* W = w2 + (size_t)idx * 128 * 64;
        float s = 0.f;
#pragma unroll 8
        for (int j = 0; j < 128; ++j) s += hl[j] * W[j * 64 + lane];
        asm volatile("s_waitcnt lgkmcnt(0)" ::: "memory"); __builtin_amdgcn_wave_barrier();
        const int bgi = rr / 511, n = rr % 511;
        if (idx == 0) { const float ss = wave_sum(s * s); const float kv = s * rsqrtf(ss * (1.f / 64.f) + EPS) * gk; ((bf16_t*)(p.ws + WS_KCB))[((size_t)bgi * 512 + n) * 64 + lane] = (bf16_t)f2bf(kv); }
        else { ((bf16_t*)(p.ws + WS_VCB))[((size_t)bgi * 512 + n) * 64 + lane] = (bf16_t)f2bf(s); }
    }
    if (blockIdx.x == 0 && otid() < 2 * 4 * 64) { const int i = otid(); bf16_t* dst = (bf16_t*)(p.ws + (i < 256 ? WS_KCB : WS_VCB)); dst[((size_t)((i & 255) >> 6) * 512 + 511) * 64 + (i & 63)] = 0; }
}

__device__ __forceinline__ void load_pstart(const Params& p, int l, int* ps) {
    const int* cnt = (const int*)(p.ws + WS_CNT) + l * 32;
    if (otid() == 0) { int s = 0; for (int e = 0; e < 32; ++e) { ps[e] = s; s += (cnt[e] + 255) & ~255; } ps[32] = s; }
    __syncthreads();
}


template <int MAP>
__device__ __forceinline__ void tr_tile(const float* W, int Nsrc, bf16_t* WT, int K, int k0, int n0, float* scr, int lane) {
    const int nl = (lane & 15) * 4, kr = lane >> 4;
    int sc = n0 + nl;
    if (MAP == 1) { sc = sc < 1280 ? sc : (sc < 2816 ? sc + 24 : (sc < 2840 ? sc - 2816 + 1280 : -1)); }
    float4 v[16];
#pragma unroll
    for (int it = 0; it < 16; ++it) { if (sc >= 0) { const float* src_ = W + (size_t)(k0 + it * 4 + kr) * Nsrc + sc; typedef float f4v __attribute__((ext_vector_type(4))); const f4v t_ = __builtin_nontemporal_load((const f4v*)src_); v[it] = make_float4(t_[0], t_[1], t_[2], t_[3]); } else v[it] = make_float4(0.f, 0.f, 0.f, 0.f); }
#pragma unroll
    for (int it = 0; it < 16; ++it) { float* s = scr + (it * 4 + kr) * 65 + nl; s[0] = v[it].x; s[1] = v[it].y; s[2] = v[it].z; s[3] = v[it].w; }
    asm volatile("s_waitcnt lgkmcnt(0)" ::: "memory"); __builtin_amdgcn_wave_barrier();
    const int c = lane & 7, nr = lane >> 3;
#pragma unroll
    for (int it = 0; it < 8; ++it) {
        const int n = it * 8 + nr; const float* s = scr + (8 * c) * 65 + n;
        uint4 o; o.x = pk2(s[0], s[65]); o.y = pk2(s[2 * 65], s[3 * 65]); o.z = pk2(s[4 * 65], s[5 * 65]); o.w = pk2(s[6 * 65], s[7 * 65]);
        *(uint4*)(WT + (size_t)(n0 + n) * K + k0 + 8 * c) = o;
    }
    asm volatile("s_waitcnt lgkmcnt(0)" ::: "memory"); __builtin_amdgcn_wave_barrier();
}
__device__ __forceinline__ void phase_convert(const Params& p, float* lds) {
    const int tid = otid(), lane = tid & 63, wave = tid >> 6;
    float* scr = lds + wave * (64 * 65);
    const int gw = blockIdx.x * NW + wave, ngw = gridDim.x * NW;
    bf16_t* WinT = (bf16_t*)(p.ws + WS_WINT); bf16_t* WoT = (bf16_t*)(p.ws + WS_WOT); bf16_t* W1T = (bf16_t*)(p.ws + WS_W1T); bf16_t* W2T = (bf16_t*)(p.ws + WS_W2T);
    constexpr int I_IN = L * 16 * (ZBW / 64), I_O = L * 16 * 16, I_1 = L * NE * 16 * 32, I_2 = L * NE * 16 * 16, I_C = L * 2 * 32 * 2;
    for (int it = gw; it < I_C + I_IN + I_O + I_1 + I_2; it += ngw) {
        int r = it;
        if (r < I_C) { const int li = r / 64, q = r % 64, kb = q / 2, nb = q % 2;
            tr_tile<0>(p.in[10] + (size_t)li * 2048 * 128, 128, (bf16_t*)(p.ws + WS_WCT) + (size_t)li * 128 * 2048, 2048, kb * 64, nb * 64, scr, lane); continue; }
        r -= I_C;
        if (r < I_IN) { const int l = r / (16 * 48), q = r % (16 * 48), kb = q / 48, nb = q % 48;
            tr_tile<1>(p.in[6] + (size_t)l * D * INW, INW, WinT + (size_t)l * ZBW * D, D, kb * 64, nb * 64, scr, lane); continue; }
        r -= I_IN;
        if (r < I_O) { const int l = r / 256, q = r % 256, kb = q / 16, nb = q % 16;
            tr_tile<0>(p.in[14] + (size_t)l * D * D, D, WoT + (size_t)l * D * D, D, kb * 64, nb * 64, scr, lane); continue; }
        r -= I_O;
        if (r < I_1) { const int le = r / 512, q = r % 512, kb = q / 32, nb = q % 32;
            tr_tile<0>(p.in[17] + (size_t)le * D * 2048, 2048, W1T + (size_t)le * 2048 * D, D, kb * 64, nb * 64, scr, lane); continue; }
        r -= I_1;
        { const int le = r / 256, q = r % 256, kb = q / 16, nb = q % 16;
            tr_tile<0>(p.in[19] + (size_t)le * DFF * D, D, W2T + (size_t)le * D * DFF, DFF, kb * 64, nb * 64, scr, lane); }
    }
    if (blockIdx.x == 0) { bf16_t* XN = (bf16_t*)(p.ws + WS_XN); for (int i = tid; i < D / 2; i += NT) ((unsigned*)(XN + (size_t)T * D))[i] = 0u; }
}

namespace pg8 {
#define PG8_LAS __attribute__((address_space(3)))
typedef short bf16x8 __attribute__((ext_vector_type(8)));
typedef float f32x4 __attribute__((ext_vector_type(4)));
typedef unsigned u32x4 __attribute__((ext_vector_type(4)));
constexpr int BM = 256, BK = 64, HALF = 128, HTB = HALF * BK * 2, STAGE_BYTES = 8 * HTB, NXCD = 8, WGM = 8;
__device__ __forceinline__ int lds_byte(int r, int c) { const int st = (r >> 4) * 2 + (c >> 5), rr = r & 15, cc = c & 31, ob = rr * 64 + cc * 2; return st * 1024 + (ob ^ (((ob >> 9) & 1) << 5)); }
__device__ __forceinline__ void stage_rc(int b, int& R, int& C) { const int st = b / 1024, sb = b % 1024, swz = sb ^ (((sb >> 9) & 1) << 5); R = (st >> 1) * 16 + swz / 64; C = (st & 1) * 32 + (swz % 64) / 2; }
__device__ __forceinline__ int perm32(int rho) { const int n = rho >> 4, i = rho & 15; return 8 * (i >> 2) + 4 * n + (i & 3); }
struct Unit { int pm, pn, e; };
__device__ __forceinline__ unsigned cvt_pk_bf16(float lo, float hi) { unsigned r; asm volatile("v_cvt_pk_bf16_f32 %0, %1, %2" : "=v"(r) : "v"(lo), "v"(hi)); return r; }

__device__ __forceinline__ bool static_next(int nM, int nN, int G, int c, int i, Unit& u) {
    const int nwg = nM * nN; const long Lq = (long)i * G + c; if (Lq >= nwg) return false;
    int wgid = (int)Lq; { const int q = nwg / NXCD, r = nwg % NXCD, xcd = wgid % NXCD, off = wgid / NXCD; wgid = (xcd < r ? xcd * (q + 1) : r * (q + 1) + (xcd - r) * q) + off; }
    const int nig = WGM * nN, gid = wgid / nig, fm = gid * WGM, gsz = (nM - fm) < WGM ? (nM - fm) : WGM;
    u.pm = fm + ((wgid % nig) % gsz); u.pn = (wgid % nig) / gsz; u.e = 0; return true;
}

template <class Prob, class Epi, bool ALIGN_EPI, bool SP2>
__device__ __forceinline__ void gemm_phase(PG8_LAS unsigned char* lds, const Prob& P, const Epi& E) {
    const int tid = otid(), wid = __builtin_amdgcn_readfirstlane(tid >> 6), lane = tid & 63, wr = wid >> 2, wc = wid & 3, fr = lane & 15, fq = lane >> 4;
    const int K = P.K, nt = Prob::KT > 0 ? Prob::KT : K / BK;
    int sR[2], sC[2]; unsigned voffB[2];
#pragma unroll
    for (int i = 0; i < 2; ++i) { stage_rc(tid * 16 + i * 8192, sR[i], sC[i]); voffB[i] = (unsigned)(P.b_row(sR[i]) * K + sC[i]) * 2u; }
    const size_t kstep = (size_t)(BK * 2);
    const size_t kstepA = P.a_kstep();
    const size_t hstepB = P.b_hstep();
    const unsigned ldsw = (unsigned)wid * 1024u;
    const int aoff = lds_byte(wr * 64 + fr, fq * 8), boff = lds_byte(wc * 32 + fr, fq * 8);
#define PG8_SA(b, h) (((b) * 2 + (h)) * HTB)
#define PG8_SB(b, h) ((4 + (b) * 2 + (h)) * HTB)
#define PG8_STAGE(bufoff, gbase, voff) do { _Pragma("unroll") for (int _i = 0; _i < 2; ++_i) \
        __builtin_amdgcn_global_load_lds((const unsigned*)((const char*)(gbase) + (voff)[_i]), (PG8_LAS unsigned*)(lds + (bufoff) + ldsw + _i * 8192), 16, 0, 0); } while (0)
#define PG8_STAGE_SEL(bufoff, gbase, h) do { _Pragma("unroll") for (int _i = 0; _i < 2; ++_i) { unsigned _vo = vAc[h][_i]; if constexpr (Prob::GATHER) _vo = last ? vAn[h][_i] : _vo; \
        __builtin_amdgcn_global_load_lds((const unsigned*)((const char*)(gbase) + _vo), (PG8_LAS unsigned*)(lds + (bufoff) + ldsw + _i * 8192), 16, 0, 0); } } while (0)
#define PG8_LDA(dst, b, h) do { _Pragma("unroll") for (int m = 0; m < 4; ++m) _Pragma("unroll") for (int k = 0; k < 2; ++k) dst[m][k] = *(const PG8_LAS bf16x8*)(lds + PG8_SA(b, h) + aoff + m * 2048 + k * 1024); } while (0)
#define PG8_LDB(dst, b, h) do { _Pragma("unroll") for (int n = 0; n < 2; ++n) _Pragma("unroll") for (int k = 0; k < 2; ++k) dst[n][k] = *(const PG8_LAS bf16x8*)(lds + PG8_SB(b, h) + boff + n * 2048 + k * 1024); } while (0)
#define PG8_MMA(ai, bj, At, Bt) do { __builtin_amdgcn_s_setprio(1); _Pragma("unroll") for (int m = 0; m < 4; ++m) _Pragma("unroll") for (int n = 0; n < 2; ++n) _Pragma("unroll") for (int k = 0; k < 2; ++k) \
        acc[ai][bj][m][n] = __builtin_amdgcn_mfma_f32_16x16x32_bf16(Bt[n][k], At[m][k], acc[ai][bj][m][n], 0, 0, 0); __builtin_amdgcn_s_setprio(0); } while (0)
#define PG8_WAIT_V(n) asm volatile("s_waitcnt vmcnt(" #n ")" ::: "memory")
#define PG8_WAIT_L(n) asm volatile("s_waitcnt lgkmcnt(" #n ")" ::: "memory")
#define PG8_BAR __builtin_amdgcn_s_barrier()
#define PG8_SCHED __builtin_amdgcn_sched_barrier(0)
    Unit cur, nxt; int ui = 0;
    if (!P.next(0, cur)) return;
    nxt = cur;
    f32x4 acc[2][2][4][2];
    typename Epi::Pre pre;
    E.prefetch(cur, wc, fq, pre); E.init(acc, pre);
    bf16x8 At[4][2], B0[2][2], B1[2][2];
    unsigned vAc[2][2], vAn[2][2];
    const char* cA = P.a_base(cur); const char* cB = P.b_base(cur);
    P.a_voff(cur, sR, sC, vAc);
#pragma unroll
    for (int h = 0; h < 2; ++h)
#pragma unroll
        for (int i = 0; i < 2; ++i) vAn[h][i] = vAc[h][i];
    if constexpr (SP2) {
        PG8_STAGE(PG8_SB(0, 0), cB, voffB); PG8_STAGE(PG8_SB(0, 1), cB + hstepB, voffB); PG8_STAGE(PG8_SA(0, 0), cA, vAc[0]); PG8_STAGE(PG8_SA(0, 1), cA, vAc[1]);
        if (wr == 1) PG8_BAR;
        PG8_WAIT_V(2); PG8_BAR;
        PG8_STAGE(PG8_SB(1, 0), cB + kstep, voffB); PG8_STAGE(PG8_SA(1, 0), cA + kstepA, vAc[0]); PG8_STAGE(PG8_SB(1, 1), cB + hstepB + kstep, voffB);
        PG8_WAIT_V(6); PG8_BAR;
    } else {
        PG8_STAGE(PG8_SB(0, 0), cB, voffB); PG8_STAGE(PG8_SA(0, 0), cA, vAc[0]); PG8_STAGE(PG8_SB(0, 1), cB + hstepB, voffB); PG8_STAGE(PG8_SA(0, 1), cA, vAc[1]);
        if (wr == 1) PG8_BAR;
        PG8_WAIT_V(4); PG8_BAR;
        PG8_STAGE(PG8_SB(1, 0), cB + kstep, voffB); PG8_STAGE(PG8_SA(1, 0), cA + kstepA, vAc[0]); PG8_STAGE(PG8_SB(1, 1), cB + hstepB + kstep, voffB);
        PG8_WAIT_V(6); PG8_BAR;
    }
    for (;;) {
        const bool has_next = P.next(ui + 1, nxt);
        const char* nA = cA; const char* nB = cB;
        if (has_next) { nA = P.a_base(nxt); nB = P.b_base(nxt); if constexpr (Prob::GATHER) P.a_voff(nxt, sR, sC, vAn); }
        for (int t = 0; t < nt; t += 2) {
            const bool last = (t == nt - 2);
            const char* a1 = cA + (size_t)(t + 1) * kstepA;
            const char* a2 = last ? nA : cA + (size_t)(t + 2) * kstepA; const char* b2 = last ? nB : cB + (size_t)(t + 2) * kstep;
            const char* a3 = a2 + kstepA; const char* b3 = b2 + kstep;
            if constexpr (SP2) {
            PG8_LDB(B0, 0, 0); PG8_LDB(B1, 0, 1); PG8_SCHED; PG8_LDA(At, 0, 0); PG8_STAGE(PG8_SA(1, 1), a1, vAc[1]);
            PG8_WAIT_V(8); PG8_WAIT_L(0); PG8_BAR; PG8_MMA(0, 0, At, B0); PG8_MMA(0, 1, At, B1); PG8_BAR; PG8_SCHED;
            PG8_LDA(At, 0, 1); PG8_STAGE(PG8_SB(0, 0), b2, voffB); PG8_STAGE(PG8_SB(0, 1), b2 + hstepB, voffB); PG8_STAGE_SEL(PG8_SA(0, 0), a2, 0);
            PG8_WAIT_V(8); PG8_WAIT_L(0); PG8_BAR; PG8_MMA(1, 0, At, B0); PG8_MMA(1, 1, At, B1); PG8_BAR; PG8_SCHED;
            PG8_LDB(B0, 1, 0); PG8_LDB(B1, 1, 1); PG8_SCHED; PG8_LDA(At, 1, 0); PG8_STAGE_SEL(PG8_SA(0, 1), a2, 1);
            PG8_WAIT_V(8); PG8_WAIT_L(0); PG8_BAR; PG8_MMA(0, 0, At, B0); PG8_MMA(0, 1, At, B1); PG8_BAR; PG8_SCHED;
            PG8_LDA(At, 1, 1); PG8_STAGE(PG8_SB(1, 0), b3, voffB); PG8_STAGE(PG8_SB(1, 1), b3 + hstepB, voffB); PG8_STAGE_SEL(PG8_SA(1, 0), a3, 0);
            PG8_WAIT_V(8); PG8_WAIT_L(0); PG8_BAR; PG8_MMA(1, 0, At, B0); PG8_MMA(1, 1, At, B1); PG8_BAR; PG8_SCHED;
            } else {
            PG8_LDB(B0, 0, 0); PG8_SCHED; PG8_LDA(At, 0, 0); PG8_STAGE(PG8_SA(1, 1), a1, vAc[1]);
            PG8_WAIT_L(8); PG8_BAR; PG8_WAIT_L(0); PG8_MMA(0, 0, At, B0); PG8_BAR; PG8_SCHED;
            PG8_LDB(B1, 0, 1); PG8_STAGE(PG8_SB(0, 0), b2, voffB);
            PG8_BAR; PG8_WAIT_L(0); PG8_MMA(0, 1, At, B1); PG8_BAR;
            PG8_LDA(At, 0, 1); PG8_STAGE_SEL(PG8_SA(0, 0), a2, 0);
            PG8_BAR; PG8_WAIT_L(0); PG8_MMA(1, 0, At, B0); PG8_BAR; PG8_SCHED;
            PG8_STAGE(PG8_SB(0, 1), b2 + hstepB, voffB);
            PG8_WAIT_V(6); PG8_BAR; PG8_MMA(1, 1, At, B1); PG8_BAR;
            PG8_LDB(B0, 1, 0); PG8_SCHED; PG8_LDA(At, 1, 0); PG8_STAGE_SEL(PG8_SA(0, 1), a2, 1);
            PG8_WAIT_L(8); PG8_BAR; PG8_WAIT_L(0); PG8_MMA(0, 0, At, B0); PG8_BAR; PG8_SCHED;
            PG8_LDB(B1, 1, 1); PG8_STAGE(PG8_SB(1, 0), b3, voffB);
            PG8_BAR; PG8_WAIT_L(0); PG8_MMA(0, 1, At, B1); PG8_BAR;
            PG8_LDA(At, 1, 1); PG8_STAGE_SEL(PG8_SA(1, 0), a3, 0);
            PG8_BAR; PG8_WAIT_L(0); PG8_MMA(1, 0, At, B0); PG8_BAR; PG8_SCHED;
            PG8_STAGE(PG8_SB(1, 1), b3 + hstepB, voffB);
            PG8_WAIT_V(6); PG8_BAR; PG8_MMA(1, 1, At, B1); PG8_BAR;
            }
        }
        if constexpr (ALIGN_EPI) { if (wr == 0) PG8_BAR; }
        E(acc, cur, wr, wc, fr, fq, has_next, nxt, pre);
        if (!has_next) break;
        E.init(acc, pre);
        cur = nxt; cA = nA; cB = nB; ++ui;
        if constexpr (Prob::GATHER) {
#pragma unroll
            for (int h = 0; h < 2; ++h)
#pragma unroll
                for (int i = 0; i < 2; ++i) vAc[h][i] = vAn[h][i];
        }
        if constexpr (ALIGN_EPI) { if (wr == 1) PG8_BAR; }
    }
    PG8_WAIT_V(0);
    if constexpr (!ALIGN_EPI) { if (wr == 0) PG8_BAR; }
    PG8_BAR;
#undef PG8_SA
#undef PG8_SB
#undef PG8_STAGE
#undef PG8_STAGE_SEL
#undef PG8_LDA
#undef PG8_LDB
#undef PG8_MMA
#undef PG8_WAIT_V
#undef PG8_WAIT_L
#undef PG8_BAR
#undef PG8_SCHED
}

struct ProbDense { static constexpr bool GATHER = false; static constexpr int KT = 0;
    const bf16_t* A; const bf16_t* Bt; int K, nM, nN, G, c; bool headperm;
    __device__ __forceinline__ bool next(int i, Unit& u) const { return static_next(nM, nN, G, c, i, u); }
    __device__ __forceinline__ const char* a_base(const Unit& u) const { return (const char*)(A + (size_t)u.pm * BM * K); }
    __device__ __forceinline__ void a_voff(const Unit&, const int (&R)[2], const int (&C)[2], unsigned (&v)[2][2]) const {
#pragma unroll
        for (int h = 0; h < 2; ++h)
#pragma unroll
            for (int i = 0; i < 2; ++i) v[h][i] = (unsigned)((h * HALF + R[i]) * K + C[i]) * 2u;
    }
    __device__ __forceinline__ const char* b_base(const Unit& u) const { return (const char*)(Bt + (size_t)u.pn * BM * K); }
    __device__ __forceinline__ size_t a_kstep() const { return (size_t)BK * 2; }
    __device__ __forceinline__ size_t b_hstep() const { return headperm ? (size_t)32 * K * 2 : (size_t)HALF * K * 2; }
    __device__ __forceinline__ int b_row(int R) const { return headperm ? ((R >> 5) * 64 + perm32(R & 31)) : ((R & ~31) + perm32(R & 31)); }
};
typedef const PG8_LAS int* lds_ints;
__device__ __forceinline__ int expert_of(lds_ints ps, int pm) { int e = 0;
#pragma unroll
    for (int i = 1; i < 32; ++i) if (ps[i] <= pm * 256) e = i;
    return __builtin_amdgcn_readfirstlane(e); }
struct ProbMoe1 { static constexpr bool GATHER = true; static constexpr int KT = 0;
    const bf16_t* XN; const bf16_t* W1T; const int* rowtok; lds_ints ps; int K, ntm, G, c;
    __device__ __forceinline__ bool next(int i, Unit& u) const {
        if (G != 256) { const int q = i * G + c; if (q >= ntm * 8) return false; u.pm = q >> 3; u.pn = q & 7; u.e = expert_of(ps, u.pm); return true; }
        const int x = c & 7, s = c >> 3; const int pm = 4 * (i * 8 + x) + (s >> 3); if (pm >= ntm) return false;
        u.pm = pm; u.pn = s & 7; u.e = expert_of(ps, u.pm); return true; }
    __device__ __forceinline__ const char* a_base(const Unit&) const { return (const char*)XN; }
    __device__ __forceinline__ void a_voff(const Unit& u, const int (&R)[2], const int (&C)[2], unsigned (&v)[2][2]) const {
#pragma unroll
        for (int h = 0; h < 2; ++h)
#pragma unroll
            for (int i = 0; i < 2; ++i) { int tk = rowtok[u.pm * BM + h * HALF + R[i]]; if (tk < 0) tk = T; v[h][i] = (unsigned)(tk * K + C[i]) * 2u; }
    }
    __device__ __forceinline__ const char* b_base(const Unit& u) const { return (const char*)(W1T + ((size_t)u.e * 2048 + u.pn * 128) * K); }
    __device__ __forceinline__ size_t a_kstep() const { return (size_t)BK * 2; }
    __device__ __forceinline__ size_t b_hstep() const { return (size_t)1024 * K * 2; }
    __device__ __forceinline__ int b_row(int R) const { return (R & ~31) + perm32(R & 31); }
};
struct ProbMoe2 { static constexpr bool GATHER = false; static constexpr int KT = 0;
    const bf16_t* ACT; const bf16_t* W2T; lds_ints ps; int K, ntm, G, c;
    __device__ __forceinline__ bool next(int i, Unit& u) const {
        if (G != 256) { const int q = i * G + c; if (q >= ntm * 4) return false; u.pm = q >> 2; u.pn = q & 3; u.e = expert_of(ps, u.pm); return true; }
        const int x = c & 7, s = c >> 3; const int pm = 8 * (i * 8 + x) + (s >> 2); if (pm >= ntm) return false;
        u.pm = pm; u.pn = s & 3; u.e = expert_of(ps, u.pm); return true; }
    __device__ __forceinline__ const char* a_base(const Unit& u) const { return (const char*)(ACT + (size_t)u.pm * BM * K); }
    __device__ __forceinline__ void a_voff(const Unit&, const int (&R)[2], const int (&C)[2], unsigned (&v)[2][2]) const {
#pragma unroll
        for (int h = 0; h < 2; ++h)
#pragma unroll
            for (int i = 0; i < 2; ++i) v[h][i] = (unsigned)((h * HALF + R[i]) * K + C[i]) * 2u;
    }
    __device__ __forceinline__ const char* b_base(const Unit& u) const { return (const char*)(W2T + ((size_t)u.e * 1024 + u.pn * BM) * K); }
    __device__ __forceinline__ size_t a_kstep() const { return (size_t)BK * 2; }
    __device__ __forceinline__ size_t b_hstep() const { return (size_t)HALF * K * 2; }
    __device__ __forceinline__ int b_row(int R) const { return (R & ~31) + perm32(R & 31); }
};

struct ProbCmp { static constexpr bool GATHER = false; static constexpr int KT = 8;
    const bf16_t* ZB; const bf16_t* W1T; int K, G, c;
    __device__ __forceinline__ bool next(int i, Unit& u) const { const int q = i * G + c; if (q >= 64) return false; u.pm = q & 15; u.pn = 0; u.e = q >> 4; return true; }
    __device__ __forceinline__ const char* a_base(const Unit& u) const { const int idx = u.pm >> 3, bg = (u.pm >> 1) & 3, half = u.pm & 1;
        return (const char*)(ZB + ((size_t)(bg >> 1) * S + 16 * 256 * half + 8 * u.e) * ZBW + ZB_KC + idx * 128 + (bg & 1) * 64); }
    __device__ __forceinline__ void a_voff(const Unit&, const int (&R)[2], const int (&C)[2], unsigned (&v)[2][2]) const {
#pragma unroll
        for (int h = 0; h < 2; ++h)
#pragma unroll
            for (int i = 0; i < 2; ++i) v[h][i] = (unsigned)(16 * (h * HALF + R[i]) * ZBW + C[i]) * 2u;
    }
    __device__ __forceinline__ size_t a_kstep() const { return (size_t)ZBW * 2; }
    __device__ __forceinline__ const char* b_base(const Unit& u) const { return (const char*)(W1T + (size_t)(u.pm >> 3) * 128 * K + 8 * 64 * u.e); }
    __device__ __forceinline__ size_t b_hstep() const { return 0; }
    __device__ __forceinline__ int b_row(int R) const { return (R & ~31) + perm32(R & 31); }
};
struct EpiCmp {
    float* HIDP;
    struct Pre {};
    __device__ __forceinline__ void prefetch(const Unit&, int, int, Pre&) const {}
    __device__ __forceinline__ void init(f32x4 (&acc)[2][2][4][2], const Pre&) const {
#pragma unroll
        for (int a = 0; a < 2; ++a)
#pragma unroll
            for (int b = 0; b < 2; ++b)
#pragma unroll
                for (int m = 0; m < 4; ++m)
#pragma unroll
                    for (int n = 0; n < 2; ++n) acc[a][b][m][n] = (f32x4){0.f, 0.f, 0.f, 0.f};
    }
    __device__ __forceinline__ void operator()(const f32x4 (&acc)[2][2][4][2], const Unit& u, int wr, int wc, int fr, int fq, bool has_next, const Unit& nxt, Pre& pre) const {
        const int idx = u.pm >> 3, bg = (u.pm >> 1) & 3, half = u.pm & 1;
        const int c0 = 32 * wc + 8 * fq;
#pragma unroll
        for (int ai = 0; ai < 2; ++ai)
#pragma unroll
            for (int m = 0; m < 4; ++m) { const int n = 256 * half + ai * HALF + wr * 64 + m * 16 + fr;
                if (n < 511) { float* dst = HIDP + (((size_t)u.e * 2 + idx) * 2044 + bg * 511 + n) * 128 + c0;
                    *(f32x4*)dst = acc[ai][0][m][0]; *(f32x4*)(dst + 4) = acc[ai][0][m][1]; } }
    }
};
struct EpiG1F {
    bf16_t* ZB; float* GATE; const float* gq; const float* gk; const float* gmq; const float* gmk;
    struct Pre {};
    __device__ __forceinline__ void prefetch(const Unit&, int, int, Pre&) const {}
    __device__ __forceinline__ void init(f32x4 (&acc)[2][2][4][2], const Pre&) const {
#pragma unroll
        for (int a = 0; a < 2; ++a)
#pragma unroll
            for (int b = 0; b < 2; ++b)
#pragma unroll
                for (int m = 0; m < 4; ++m)
#pragma unroll
                    for (int n = 0; n < 2; ++n) acc[a][b][m][n] = (f32x4){0.f, 0.f, 0.f, 0.f};
    }
    __device__ __forceinline__ void operator()(const f32x4 (&acc)[2][2][4][2], const Unit& u, int wr, int wc, int fr, int fq, bool has_next, const Unit& nxt, Pre& pre) const {
        const int pn = u.pn;
        const float* gain = nullptr; float sc = 1.f;
        if (pn < 2) { gain = gq; sc = QSCALE; }
        else if (pn == 3 || pn == 4) { if (wc < 2) gain = gk; }
        else if (pn == 5 || pn == 6) { gain = gmq; sc = QSCALE; }
        else if (pn == 7 || pn == 8) { gain = gmk; }
        if (pn == 11) {
            if (wc == 0 && fq < 3) {
#pragma unroll
                for (int ai = 0; ai < 2; ++ai)
#pragma unroll
                    for (int m = 0; m < 4; ++m) { const size_t r = (size_t)u.pm * BM + ai * HALF + wr * 64 + m * 16 + fr;
#pragma unroll
                        for (int n = 0; n < 2; ++n) { const f32x4 v = acc[ai][0][m][n]; f32x4 o;
#pragma unroll
                            for (int i = 0; i < 4; ++i) o[i] = __builtin_amdgcn_rcpf(1.f + __builtin_amdgcn_exp2f(-LOG2E * v[i]));
                            *(f32x4*)(GATE + r * 32 + 8 * fq + 4 * n) = o; } }
            }
            return;
        }
        f32x4 gv[2][2];
#pragma unroll
        for (int bj = 0; bj < 2; ++bj)
#pragma unroll
            for (int n = 0; n < 2; ++n) gv[bj][n] = gain ? *(const f32x4*)(gain + 32 * bj + 8 * fq + 4 * n) * sc : (f32x4){1.f, 1.f, 1.f, 1.f};
#pragma unroll
        for (int ai = 0; ai < 2; ++ai)
#pragma unroll
            for (int m = 0; m < 4; ++m) { const size_t r = (size_t)u.pm * BM + ai * HALF + wr * 64 + m * 16 + fr;
                float rs = 1.f;
                if (gain) { float ss = 0.f;
#pragma unroll
                    for (int bj = 0; bj < 2; ++bj)
#pragma unroll
                        for (int n = 0; n < 2; ++n) { const f32x4 v = acc[ai][bj][m][n]; ss += (v[0] * v[0] + v[1] * v[1]) + (v[2] * v[2] + v[3] * v[3]); }
                    ss += __shfl_xor(ss, 16); ss += __shfl_xor(ss, 32);
                    rs = rsqrtf(ss * (1.f / 64.f) + EPS); }
#pragma unroll
                for (int bj = 0; bj < 2; ++bj) { const f32x4 a = acc[ai][bj][m][0] * gv[bj][0] * rs, b = acc[ai][bj][m][1] * gv[bj][1] * rs;
                    u32x4 w; w.x = cvt_pk_bf16(a[0], a[1]); w.y = cvt_pk_bf16(a[2], a[3]); w.z = cvt_pk_bf16(b[0], b[1]); w.w = cvt_pk_bf16(b[2], b[3]);
                    *(u32x4*)(ZB + r * ZBW + pn * BM + 64 * wc + 32 * bj + 8 * fq) = w; } }
    }
};
struct EpiG2 {
    const float* xin32; bf16_t* XAB; const float* g1;
    struct Pre {};
    __device__ __forceinline__ void prefetch(const Unit&, int, int, Pre&) const {}
    __device__ __forceinline__ void init(f32x4 (&acc)[2][2][4][2], const Pre&) const {
#pragma unroll
        for (int a = 0; a < 2; ++a)
#pragma unroll
            for (int b = 0; b < 2; ++b)
#pragma unroll
                for (int m = 0; m < 4; ++m)
#pragma unroll
                    for (int n = 0; n < 2; ++n) acc[a][b][m][n] = (f32x4){0.f, 0.f, 0.f, 0.f};
    }
    __device__ __forceinline__ void operator()(const f32x4 (&acc)[2][2][4][2], const Unit& u, int wr, int wc, int fr, int fq, bool has_next, const Unit& nxt, Pre& pre) const {
#pragma unroll
        for (int ai = 0; ai < 2; ++ai)
#pragma unroll
            for (int m = 0; m < 4; ++m) { const size_t r = (size_t)u.pm * BM + ai * HALF + wr * 64 + m * 16 + fr; const int b = (int)(r / S);
#pragma unroll
                for (int bj = 0; bj < 2; ++bj) { const int c = u.pn * BM + 128 * bj + 32 * wc + 8 * fq;
                    f32x4 x0, x1;
                    if (xin32) { x0 = *(const f32x4*)(xin32 + r * D + c); x1 = *(const f32x4*)(xin32 + r * D + c + 4); }
                    else { const u32x4 q = *(const u32x4*)(XAB + r * D + c);
                        x0 = (f32x4){__builtin_bit_cast(float, q.x << 16), __builtin_bit_cast(float, q.x & 0xffff0000u), __builtin_bit_cast(float, q.y << 16), __builtin_bit_cast(float, q.y & 0xffff0000u)};
                        x1 = (f32x4){__builtin_bit_cast(float, q.z << 16), __builtin_bit_cast(float, q.z & 0xffff0000u), __builtin_bit_cast(float, q.w << 16), __builtin_bit_cast(float, q.w & 0xffff0000u)}; }
                    const f32x4 g0 = *(const f32x4*)(g1 + (size_t)b * 6144 + c), g1v = *(const f32x4*)(g1 + (size_t)b * 6144 + c + 4);
                    const f32x4 y0 = x0 + g0 * acc[ai][bj][m][0], y1 = x1 + g1v * acc[ai][bj][m][1];
                    u32x4 o; o.x = cvt_pk_bf16(y0[0], y0[1]); o.y = cvt_pk_bf16(y0[2], y0[3]); o.z = cvt_pk_bf16(y1[0], y1[1]); o.w = cvt_pk_bf16(y1[2], y1[3]);
                    *(u32x4*)(XAB + r * D + c) = o; } }
    }
};
struct EpiM1 {
    bf16_t* ACT; const float* b1l;
    struct Pre { f32x4 bg[2], bl[2]; };
    __device__ __forceinline__ void prefetch(const Unit& u, int wc, int fq, Pre& q) const {
        const float* b1 = b1l + (size_t)u.e * 2048 + u.pn * 128 + 32 * wc + 8 * fq;
#pragma unroll
        for (int n = 0; n < 2; ++n) { q.bg[n] = *(const f32x4*)(b1 + 4 * n); q.bl[n] = *(const f32x4*)(b1 + 1024 + 4 * n); }
    }
    __device__ __forceinline__ void init(f32x4 (&acc)[2][2][4][2], const Pre& q) const {
#pragma unroll
        for (int a = 0; a < 2; ++a)
#pragma unroll
            for (int m = 0; m < 4; ++m)
#pragma unroll
                for (int n = 0; n < 2; ++n) { acc[a][0][m][n] = q.bg[n]; acc[a][1][m][n] = q.bl[n]; }
    }
    __device__ __forceinline__ void operator()(const f32x4 (&acc)[2][2][4][2], const Unit& u, int wr, int wc, int fr, int fq, bool has_next, const Unit& nxt, Pre& pre) const {
        const int c0 = u.pn * 128 + 32 * wc + 8 * fq;
#pragma unroll
        for (int ai = 0; ai < 2; ++ai) {
            if (ai == 1) { __builtin_amdgcn_sched_barrier(0); prefetch(nxt, wc, fq, pre); __builtin_amdgcn_sched_barrier(0); }
#pragma unroll
            for (int m = 0; m < 4; ++m) { const size_t r = (size_t)u.pm * BM + ai * HALF + wr * 64 + m * 16 + fr;
                float o[8];
#pragma unroll
                for (int n = 0; n < 2; ++n) { const f32x4 g = acc[ai][0][m][n], li = acc[ai][1][m][n];
#pragma unroll
                    for (int i = 0; i < 4; ++i) { const float gc = fminf(g[i], 7.f), lc = __builtin_amdgcn_fmed3f(li[i], -7.f, 7.f);
                        o[4 * n + i] = (lc + 1.f) * (gc * __builtin_amdgcn_rcpf(1.f + __builtin_amdgcn_exp2f((-1.702f * LOG2E) * gc))); } }
                u32x4 w; w.x = cvt_pk_bf16(o[0], o[1]); w.y = cvt_pk_bf16(o[2], o[3]); w.z = cvt_pk_bf16(o[4], o[5]); w.w = cvt_pk_bf16(o[6], o[7]);
                *(u32x4*)(ACT + r * DFF + c0) = w; }
        }
    }
};
struct EpiM2 {
    bf16_t* Y; const float* b2l;
    struct Pre { f32x4 b[2][2]; };
    __device__ __forceinline__ void prefetch(const Unit& u, int wc, int fq, Pre& q) const {
        const float* b2 = b2l + (size_t)u.e * D + u.pn * BM + 32 * wc + 8 * fq;
#pragma unroll
        for (int bj = 0; bj < 2; ++bj)
#pragma unroll
            for (int n = 0; n < 2; ++n) q.b[bj][n] = *(const f32x4*)(b2 + 128 * bj + 4 * n);
    }
    __device__ __forceinline__ void init(f32x4 (&acc)[2][2][4][2], const Pre& q) const {
#pragma unroll
        for (int a = 0; a < 2; ++a)
#pragma unroll
            for (int bj = 0; bj < 2; ++bj)
#pragma unroll
                for (int m = 0; m < 4; ++m)
#pragma unroll
                    for (int n = 0; n < 2; ++n) acc[a][bj][m][n] = q.b[bj][n];
    }
    __device__ __forceinline__ void operator()(const f32x4 (&acc)[2][2][4][2], const Unit& u, int wr, int wc, int fr, int fq, bool has_next, const Unit& nxt, Pre& pre) const {
#pragma unroll
        for (int ai = 0; ai < 2; ++ai) {
            if (ai == 1) { __builtin_amdgcn_sched_barrier(0); prefetch(nxt, wc, fq, pre); __builtin_amdgcn_sched_barrier(0); }
#pragma unroll
            for (int m = 0; m < 4; ++m) { const size_t r = (size_t)u.pm * BM + ai * HALF + wr * 64 + m * 16 + fr;
#pragma unroll
                for (int bj = 0; bj < 2; ++bj) { const int c = u.pn * BM + 128 * bj + 32 * wc + 8 * fq;
                    const f32x4 v0 = acc[ai][bj][m][0], v1 = acc[ai][bj][m][1];
                    u32x4 o; o.x = cvt_pk_bf16(v0[0], v0[1]); o.y = cvt_pk_bf16(v0[2], v0[3]); o.z = cvt_pk_bf16(v1[0], v1[1]); o.w = cvt_pk_bf16(v1[2], v1[3]);
                    *(u32x4*)(Y + r * D + c) = o; } }
        }
    }
};
}

__device__ __forceinline__ void phase_g1_fast(const Params& p, int l, unsigned char* lds_raw) {
    pg8::ProbDense P{(const bf16_t*)(p.ws + WS_XN), (const bf16_t*)(p.ws + WS_WINT) + (size_t)l * ZBW * D, D, T / 256, ZBW / 256, (int)gridDim.x, (int)blockIdx.x, true};
    pg8::EpiG1F E{(bf16_t*)(p.ws + WS_ZB), (float*)(p.ws + WS_GATE), p.in[7] + l * 64, p.in[8] + l * 64, p.in[12] + l * 64, p.in[13] + l * 64};
    pg8::gemm_phase<pg8::ProbDense, pg8::EpiG1F, true, true>((PG8_LAS unsigned char*)lds_raw, P, E);
}
__device__ __forceinline__ void phase_g2_fast(const Params& p, int l, unsigned char* lds_raw) {
    pg8::ProbDense P{(const bf16_t*)(p.ws + WS_ATTB), (const bf16_t*)(p.ws + WS_WOT) + (size_t)l * D * D, D, T / 256, D / 256, (int)gridDim.x, (int)blockIdx.x, false};
    pg8::EpiG2 E{l == 0 ? p.in[0] : (const float*)nullptr, (bf16_t*)(p.ws + WS_XAB), (const float*)(p.ws + WS_MOD) + (size_t)l * Bn * 6144 + 2 * D};
    pg8::gemm_phase<pg8::ProbDense, pg8::EpiG2, true, true>((PG8_LAS unsigned char*)lds_raw, P, E);
}
constexpr int LDS_PS_OFF = 131072;
__device__ __forceinline__ void phase_ck_fast(const Params& p, int l, unsigned char* lds_raw) {
    pg8::ProbCmp P{(const bf16_t*)(p.ws + WS_ZB), (const bf16_t*)(p.ws + WS_WCT) + (size_t)l * 2 * 128 * 2048, 2048, (int)gridDim.x, (int)blockIdx.x};
    pg8::EpiCmp E{(float*)(p.ws + WS_HIDP)};
    pg8::gemm_phase<pg8::ProbCmp, pg8::EpiCmp, true, true>((PG8_LAS unsigned char*)lds_raw, P, E);
    { const int tid = otid(), lane = tid & 63, wave = tid >> 6, r8 = lane >> 3, c8 = lane & 7;
      const bf16_t* Z = (const bf16_t*)(p.ws + WS_ZB); bf16_t* KMB = (bf16_t*)(p.ws + WS_KMB);
      float* part = (float*)(lds_raw + 131072 + 512);
      for (int it0 = blockIdx.x * 2; it0 < Bn * 8 * 32; it0 += gridDim.x * 2) {
          const int it = it0 + (wave >> 2), q = wave & 3;
          const int b = it / 256, h = (it / 32) & 7, blk = it & 31;
          const bf16_t* base = Z + (size_t)(b * S + blk * 256 + q * 64 + r8) * ZBW + ZB_MK + h * 64 + c8 * 8;
          float s[8] = {0.f, 0.f, 0.f, 0.f, 0.f, 0.f, 0.f, 0.f};
          uint4 v[8];
#pragma unroll
          for (int i = 0; i < 8; ++i) v[i] = *(const uint4*)(base + (size_t)(8 * i) * ZBW);
#pragma unroll
          for (int i = 0; i < 8; ++i) { const unsigned w[4] = {v[i].x, v[i].y, v[i].z, v[i].w};
#pragma unroll
              for (int e = 0; e < 4; ++e) { s[2 * e] += __builtin_bit_cast(float, w[e] << 16); s[2 * e + 1] += __builtin_bit_cast(float, w[e] & 0xffff0000u); } }
#pragma unroll
          for (int e = 0; e < 8; ++e) { s[e] += __shfl_xor(s[e], 8); s[e] += __shfl_xor(s[e], 16); s[e] += __shfl_xor(s[e], 32); }
          if (r8 == 0) {
#pragma unroll
              for (int e = 0; e < 8; ++e) part[wave * 64 + c8 * 8 + e] = s[e]; }
          __syncthreads();
          if (tid < 128) { const int item = tid >> 6, d = tid & 63; const float* pp = part + item * 256 + d;
              KMB[(size_t)(it0 + item) * 64 + d] = (bf16_t)f2bf((((pp[0] + pp[64]) + pp[128]) + pp[192]) * (1.f / 256.f)); }
          __syncthreads();
      } }
}
__device__ __forceinline__ void phase_m1_fast(const Params& p, int l, unsigned char* lds_raw) {
    int* ps = (int*)(lds_raw + LDS_PS_OFF);
    load_pstart(p, l, ps);
    pg8::ProbMoe1 P{(const bf16_t*)(p.ws + WS_XN), (const bf16_t*)(p.ws + WS_W1T) + (size_t)l * NE * 2048 * D, (const int*)(p.ws + WS_ROWTOK) + (size_t)l * RMAX, (pg8::lds_ints)ps, D, ps[32] / 256, (int)gridDim.x, (int)blockIdx.x};
    pg8::EpiM1 E{(bf16_t*)(p.ws + WS_ACT), p.in[18] + (size_t)l * NE * 2048};
    pg8::gemm_phase<pg8::ProbMoe1, pg8::EpiM1, true, true>((PG8_LAS unsigned char*)lds_raw, P, E);
    __syncthreads();
}
__device__ __forceinline__ void phase_m2_fast(const Params& p, int l, unsigned char* lds_raw) {
    int* ps = (int*)(lds_raw + LDS_PS_OFF);
    load_pstart(p, l, ps);
    pg8::ProbMoe2 P{(const bf16_t*)(p.ws + WS_ACT), (const bf16_t*)(p.ws + WS_W2T) + (size_t)l * NE * D * DFF, (pg8::lds_ints)ps, DFF, ps[32] / 256, (int)gridDim.x, (int)blockIdx.x};
    pg8::EpiM2 E{(bf16_t*)(p.ws + WS_Y), p.in[20] + (size_t)l * NE * D};
    pg8::gemm_phase<pg8::ProbMoe2, pg8::EpiM2, true, true>((PG8_LAS unsigned char*)lds_raw, P, E);
    __syncthreads();
}

namespace at {
#define AT_LAS __attribute__((address_space(3)))
typedef short bf16x8 __attribute__((ext_vector_type(8)));
typedef short s16x4 __attribute__((ext_vector_type(4)));
typedef short v4i16_t __attribute__((ext_vector_type(4)));
typedef float f32x16 __attribute__((ext_vector_type(16)));
typedef unsigned u32x4 __attribute__((ext_vector_type(4)));
typedef float f32x2_t __attribute__((ext_vector_type(2))); typedef __bf16 bf16x2_t __attribute__((ext_vector_type(2)));
typedef AT_LAS unsigned char* lp;
constexpr int L_K = 0  , L_V = 32768  , L_WSF = 65536, L_OST = 67584  , L_SELM = 133120, L_UNI = 134144, L_KMT = 134400, L_END = 142592;
constexpr float NEGS = -1e30f;
__device__ __forceinline__ int crow(int r, int hi) { return (r & 3) + 8 * (r >> 2) + 4 * hi; }
__device__ __forceinline__ unsigned cvtpk(float lo, float hi) { f32x2_t v = {lo, hi}; bf16x2_t b = __builtin_convertvector(v, bf16x2_t); return __builtin_bit_cast(unsigned, b); }
__device__ __forceinline__ float mx3(float a, float b, float c) { return __builtin_fmaxf(__builtin_fmaxf(a, b), c); }
__device__ __forceinline__ void wsync() { asm volatile("s_waitcnt lgkmcnt(0)" ::: "memory"); __builtin_amdgcn_wave_barrier(); }
__device__ __forceinline__ void bar() { __builtin_amdgcn_s_barrier(); }
#define AT_WAITV(n) asm volatile("s_waitcnt vmcnt(" #n ")" ::: "memory")
#define AT_WAITL() asm volatile("s_waitcnt lgkmcnt(0)" ::: "memory")
__device__ __forceinline__ void glds(const void* g, lp dst) { __builtin_amdgcn_global_load_lds((const unsigned*)g, (AT_LAS unsigned*)dst, 16, 0, 0); }
__device__ __forceinline__ s16x4 vtr(const AT_LAS unsigned char* p) { return __builtin_bit_cast(s16x4, __builtin_amdgcn_ds_read_tr16_b64_v4i16((AT_LAS v4i16_t*)p)); }

__device__ __forceinline__ void dma_k(lp slot, const bf16_t* kbase, int pitch, int key0, int wid, int lane) { glds(kbase + (size_t)(key0 + lane) * pitch + wid * 8, slot + wid * 1024); }
__device__ __forceinline__ void dma_v(lp slot, const bf16_t* vbase, int pitch, int key0, int wid, int lane) {
    glds(vbase + (size_t)(key0 + 16 * (wid & 3) + (lane >> 2)) * pitch + (wid >> 2) * 32 + (lane & 3) * 8, slot + wid * 1024); }

__device__ __forceinline__ void qk_tile(f32x16& p0, f32x16& p1, lp kslot, const bf16x8 (&qr)[4], int r32, int hi) {
    const AT_LAS unsigned char* kb = kslot + hi * 1024 + r32 * 16;
    bf16x8 b0[4], b1[4];
#pragma unroll
    for (int d0 = 0; d0 < 4; ++d0) { b0[d0] = *(const AT_LAS bf16x8*)(kb + d0 * 2048); b1[d0] = *(const AT_LAS bf16x8*)(kb + d0 * 2048 + 512); }
#pragma unroll
    for (int d0 = 0; d0 < 4; ++d0) {
        p0 = __builtin_amdgcn_mfma_f32_32x32x16_bf16(b0[d0], qr[d0], p0, 0, 0, 0);
        p1 = __builtin_amdgcn_mfma_f32_32x32x16_bf16(b1[d0], qr[d0], p1, 0, 0, 0);
    }
}
struct VFrag { bf16x8 f[8]; };
__device__ __forceinline__ void pv_load(VFrag& v, lp vslot, int lane, int hi) {
    const AT_LAS unsigned char* vp = vslot + ((lane >> 4) & 1) * 32 + (lane & 3) * 8 + (4 * hi + ((lane & 15) >> 2)) * 64;
#pragma unroll
    for (int d0 = 0; d0 < 2; ++d0)
#pragma unroll
        for (int ks = 0; ks < 4; ++ks) {
            const s16x4 lo = vtr(vp + d0 * 4096 + ks * 1024), hh = vtr(vp + d0 * 4096 + ks * 1024 + 512);
            v.f[d0 * 4 + ks] = (bf16x8){lo[0], lo[1], lo[2], lo[3], hh[0], hh[1], hh[2], hh[3]};
        }
}
__device__ __forceinline__ void pv_mfma(f32x16 (&o)[2], const VFrag& v, u32x4 pw0, u32x4 pw1, u32x4 pw2, u32x4 pw3) {
    const bf16x8 pa[4] = {__builtin_bit_cast(bf16x8, pw0), __builtin_bit_cast(bf16x8, pw1), __builtin_bit_cast(bf16x8, pw2), __builtin_bit_cast(bf16x8, pw3)};
#pragma unroll
    for (int ks = 0; ks < 4; ++ks) {
        o[0] = __builtin_amdgcn_mfma_f32_32x32x16_bf16(pa[ks], v.f[ks], o[0], 0, 0, 0);
        o[1] = __builtin_amdgcn_mfma_f32_32x32x16_bf16(pa[ks], v.f[4 + ks], o[1], 0, 0, 0);
    }
}
__device__ __forceinline__ float rowmax(const f32x16& p0, const f32x16& p1) {
    float a = mx3(p0[0], p0[1], p1[0]), b = mx3(p0[2], p0[3], p1[1]); a = mx3(a, p1[2], p1[3]);
#pragma unroll
    for (int r = 4; r < 16; r += 4) { a = mx3(a, p0[r], p0[r + 1]); b = mx3(b, p0[r + 2], p0[r + 3]); a = mx3(a, p1[r], p1[r + 1]); b = mx3(b, p1[r + 2], p1[r + 3]); }
    const float m = __builtin_fmaxf(a, b);
    auto rr = __builtin_amdgcn_permlane32_swap(__float_as_uint(m), __float_as_uint(m), false, false);
    return __builtin_fmaxf(__uint_as_float(rr[0]), __uint_as_float(rr[1]));
}
__device__ __forceinline__ float halfsum(float v) {
    auto rr = __builtin_amdgcn_permlane32_swap(__float_as_uint(v), __float_as_uint(v), false, false);
    return __uint_as_float(rr[0]) + __uint_as_float(rr[1]);
}
__device__ __forceinline__ void mask_tile(f32x16& p0, f32x16& p1, int lo, int hi_, int hi) {
    const int kb = 4 * hi;
#pragma unroll
    for (int r = 0; r < 16; ++r) { const int kv = kb + (r & 3) + 8 * (r >> 2); if (kv > hi_ || kv < lo) p0[r] = NEGS; if (kv + 32 > hi_ || kv + 32 < lo) p1[r] = NEGS; }
}

__device__ __forceinline__ void mask_init(f32x16& p0, f32x16& p1, int hi_, int hi) {
    const int kb = 4 * hi;
#pragma unroll
    for (int r = 0; r < 16; ++r) { const int kv = kb + (r & 3) + 8 * (r >> 2); if (kv > hi_) p0[r] = NEGS; if (kv + 32 > hi_) p1[r] = NEGS; }
}
__device__ __forceinline__ int next_bit128(unsigned u0, unsigned u1, unsigned u2, unsigned u3, int below) {
    if (below > 96) { unsigned x = u3; if (below < 128) x &= (1u << (below - 96)) - 1u; if (x) return 96 + 31 - __builtin_clz(x); }
    if (below > 64) { unsigned x = u2; if (below < 96) x &= (1u << (below - 64)) - 1u; if (x) return 64 + 31 - __builtin_clz(x); }
    if (below > 32) { unsigned x = u1; if (below < 64) x &= (1u << (below - 32)) - 1u; if (x) return 32 + 31 - __builtin_clz(x); }
    if (below > 0) { unsigned x = u0; if (below < 32) x &= (1u << below) - 1u; if (x) return 31 - __builtin_clz(x); }
    return -1;
}
struct Soft { float m, l; };

template <bool HAS_O>
__device__ __forceinline__ void softmax_step(f32x16& p0, f32x16& p1, Soft& st, f32x16 (&o)[2], float* wsf, int r32, int hi) {
    const float rm = rowmax(p0, p1);
    if (__any(rm > 0.f)) {
        const float dl = __builtin_fmaxf(rm, 0.f); st.m += dl;
#pragma unroll
        for (int r = 0; r < 16; ++r) { p0[r] -= dl; p1[r] -= dl; }
        const float al = __builtin_amdgcn_exp2f(-dl); st.l *= al;
        if (HAS_O) {
            if (hi == 0) wsf[r32] = al;
            wsync();
#pragma unroll
            for (int r = 0; r < 16; ++r) { const float f = wsf[crow(r, hi)]; o[0][r] *= f; o[1][r] *= f; }
            wsync();
        }
    }
    float s = 0.f;
#pragma unroll
    for (int r = 0; r < 16; ++r) { p0[r] = __builtin_amdgcn_exp2f(p0[r]); p1[r] = __builtin_amdgcn_exp2f(p1[r]); s += p0[r] + p1[r]; }
    st.l += s;
}
#define AT_PACK(P0, P1) \
    const u32x4 pw0 = {cvtpk(P0[0], P0[1]), cvtpk(P0[2], P0[3]), cvtpk(P0[4], P0[5]), cvtpk(P0[6], P0[7])}, pw1 = {cvtpk(P0[8], P0[9]), cvtpk(P0[10], P0[11]), cvtpk(P0[12], P0[13]), cvtpk(P0[14], P0[15])}, \
                pw2 = {cvtpk(P1[0], P1[1]), cvtpk(P1[2], P1[3]), cvtpk(P1[4], P1[5]), cvtpk(P1[6], P1[7])}, pw3 = {cvtpk(P1[8], P1[9]), cvtpk(P1[10], P1[11]), cvtpk(P1[12], P1[13]), cvtpk(P1[14], P1[15])}
__device__ __forceinline__ float fma_vsv(float a, float k, float x) { float d; asm("v_fma_f32 %0, %1, %2, %3" : "=v"(d) : "v"(a), "s"(k), "v"(x)); return d; }
__device__ __forceinline__ f32x16 cinit(float c2k, int hi, float x) { f32x16 c; const float xb = __builtin_fmaf(c2k, (float)(4 * hi), x);
    c[0] = xb;
#pragma unroll
    for (int r = 1; r < 16; ++r) c[r] = fma_vsv(c2k, (float)((r & 3) + 8 * (r >> 2)), xb);
    return c; }
template <bool FIRST>
__device__ __forceinline__ void acc_scaled(float* stage, const f32x16 (&o)[2], float f, float* wsf, int r32, int hi) {
    if (hi == 0) wsf[r32] = f;
    wsync();
#pragma unroll
    for (int r = 0; r < 16; ++r) { const int orow = crow(r, hi); const float g = wsf[orow]; float* s0 = stage + orow * 64 + r32;
        if (FIRST) { s0[0] = o[0][r] * g; s0[32] = o[1][r] * g; } else { s0[0] += o[0][r] * g; s0[32] += o[1][r] * g; } }
    wsync();
}

#define AT_WAIT_NEWER(newer, per) do { if ((newer) >= 2) { if ((per) == 2) AT_WAITV(4); else AT_WAITV(2); } else if ((newer) == 1) { if ((per) == 2) AT_WAITV(2); else AT_WAITV(1); } else AT_WAITV(0); } while (0)


#define AT_SB() __builtin_amdgcn_sched_barrier(0)
struct PipeOut { float s, rmn; };
__device__ __forceinline__ PipeOut pipe_step(f32x16& c0, f32x16& c1, f32x16& n0, f32x16& n1, f32x16 (&o)[2], lp kslot_next, lp vslot, const bf16x8 (&qr)[4], int lane, int r32, int hi) {
    const AT_LAS unsigned char* kb = kslot_next + hi * 1024 + r32 * 16;
    const AT_LAS unsigned char* vp = vslot + ((lane >> 4) & 1) * 32 + (lane & 3) * 8 + (4 * hi + ((lane & 15) >> 2)) * 64;
    bf16x8 kf[8];
#pragma unroll
    for (int j = 0; j < 4; ++j) kf[j] = *(const AT_LAS bf16x8*)(kb + (j >> 1) * 2048 + (j & 1) * 512);
    AT_SB();
    unsigned w0[8], w1[8]; s16x4 vl[8], vh[8]; float s = 0.f;
#pragma unroll
    for (int j = 0; j < 8; ++j) {
        if (j & 1) n1 = __builtin_amdgcn_mfma_f32_32x32x16_bf16(kf[j], qr[j >> 1], n1, 0, 0, 0);
        else       n0 = __builtin_amdgcn_mfma_f32_32x32x16_bf16(kf[j], qr[j >> 1], n0, 0, 0, 0);
        if (j < 4) kf[j + 4] = *(const AT_LAS bf16x8*)(kb + ((j + 4) >> 1) * 2048 + (j & 1) * 512);
        if (j >= 4) {
#pragma unroll
            for (int q = 0; q < 2; ++q) { const int f = (j - 4) * 2 + q, d0 = f >> 2, ks = f & 3; vl[f] = vtr(vp + d0 * 4096 + ks * 1024); vh[f] = vtr(vp + d0 * 4096 + ks * 1024 + 512); }
        }
        const float e0 = __builtin_amdgcn_exp2f(c0[2 * j]), e1 = __builtin_amdgcn_exp2f(c0[2 * j + 1]), e2 = __builtin_amdgcn_exp2f(c1[2 * j]), e3 = __builtin_amdgcn_exp2f(c1[2 * j + 1]);
        s += (e0 + e1) + (e2 + e3);
        asm volatile("" : "+v"(s));
        w0[j] = cvtpk(e0, e1); w1[j] = cvtpk(e2, e3);
        AT_SB();
    }
    const u32x4 pw0 = {w0[0], w0[1], w0[2], w0[3]}, pw1 = {w0[4], w0[5], w0[6], w0[7]}, pw2 = {w1[0], w1[1], w1[2], w1[3]}, pw3 = {w1[4], w1[5], w1[6], w1[7]};
    const bf16x8 pa[4] = {__builtin_bit_cast(bf16x8, pw0), __builtin_bit_cast(bf16x8, pw1), __builtin_bit_cast(bf16x8, pw2), __builtin_bit_cast(bf16x8, pw3)};
    float a = mx3(n0[0], n0[1], n1[0]), b = mx3(n0[2], n0[3], n1[1]);
#pragma unroll
    for (int f = 0; f < 8; ++f) {
        const int d0 = f >> 2, ks = f & 3;
        const bf16x8 vf = (bf16x8){vl[f][0], vl[f][1], vl[f][2], vl[f][3], vh[f][0], vh[f][1], vh[f][2], vh[f][3]};
        o[d0] = __builtin_amdgcn_mfma_f32_32x32x16_bf16(pa[ks], vf, o[d0], 0, 0, 0);
        if (f == 0) { a = mx3(a, n1[2], n1[3]); }
        else if (f < 4) { const int r = 4 * f; a = mx3(a, n0[r], n0[r + 1]); b = mx3(b, n0[r + 2], n0[r + 3]); a = mx3(a, n1[r], n1[r + 1]); b = mx3(b, n1[r + 2], n1[r + 3]); }
        asm volatile("" : "+v"(a), "+v"(b));
        AT_SB();
    }
    const float m = __builtin_fmaxf(a, b);
    auto rr = __builtin_amdgcn_permlane32_swap(__float_as_uint(m), __float_as_uint(m), false, false);
    PipeOut out; out.s = s; out.rmn = __builtin_fmaxf(__uint_as_float(rr[0]), __uint_as_float(rr[1]));
    return out;
}
__device__ __forceinline__ void nsa_unit(const Params& p, int b, int g, int c, unsigned char* lds_raw) {
    const int tid = otid(), lane = tid & 63, r32 = lane & 31, hi = lane >> 5, wid = __builtin_amdgcn_readfirstlane(tid >> 6);
    lp lds = (lp)lds_raw;
    const bf16_t* ZB = (const bf16_t*)(p.ws + WS_ZB); const float* GT = (const float*)(p.ws + WS_GATE);
    const bf16_t* KCB = (const bf16_t*)(p.ws + WS_KCB) + (size_t)(b * 2 + g) * 512 * 64; const bf16_t* VCB = (const bf16_t*)(p.ws + WS_VCB) + (size_t)(b * 2 + g) * 512 * 64;
    const int t0 = c * 64, hg = r32 >> 3, qq = r32 & 7, qi = 8 * wid + qq, t = t0 + qi, h = 4 * g + hg; const size_t tt = (size_t)b * S + t;
    float* wsf = (float*)(lds_raw + L_WSF) + wid * 64;
    float* ostage = (float*)(lds_raw + L_OST) + wid * 2048;
    float* imp = ostage;
    unsigned* selm = (unsigned*)(lds_raw + L_SELM);
    unsigned* uni = (unsigned*)(lds_raw + L_UNI);
    const float c2 = exp2f(-(float)(h + 1)) * LOG2E;
    bf16x8 qr[4];
#pragma unroll
    for (int d0 = 0; d0 < 4; ++d0) qr[d0] = *(const bf16x8*)(ZB + tt * ZBW + ZB_Q + h * 64 + d0 * 16 + hi * 8);
    const float gt0 = GT[tt * 32 + h * 3 + 0], gt1 = GT[tt * 32 + h * 3 + 1], gt2 = GT[tt * 32 + h * 3 + 2];
    f32x16 o[2];
    const lp sK0 = lds + L_K, sV0 = lds + L_V;
    const int nmax = t >= 31 ? (t - 31) >> 4 : -1;
    const int ntc = ((4 * c + 2) >> 6) + 1;
    for (int i = lane; i < 8 * 129; i += 64) imp[i] = 0.f;
    Soft sc; sc.m = 0.f; sc.l = 0.f;
#pragma unroll
    for (int k = 0; k < 3; ++k) if (k < ntc) dma_k(sK0 + k * 8192, KCB, 64, 64 * k, wid, lane);
    for (int k = 0; k < ntc; ++k) {
        const int newer = ntc - 1 - k; AT_WAIT_NEWER(newer, 1);
        AT_WAITL(); bar();
        if (k + 3 < ntc) dma_k(sK0 + ((k + 3) & 3) * 8192, KCB, 64, 64 * (k + 3), wid, lane);
        const lp sK = sK0 + (k & 3) * 8192;
        const float x0 = c2 * (16.f * (64 * k) + 15.5f - (float)t0) - sc.m;
        f32x16 p0 = cinit(16.f * c2, hi, x0), p1 = cinit(16.f * c2, hi, x0 + c2 * 512.f);
        qk_tile(p0, p1, sK, qr, r32, hi);
        if (__any(nmax - 64 * k < 63)) mask_tile(p0, p1, 0, nmax - 64 * k, hi);
        softmax_step<false>(p0, p1, sc, o, wsf, r32, hi);
    }
    const float lc = halfsum(sc.l), linv = lc > 0.f ? 1.f / lc : 0.f;
    o[0] = f32x16{}; o[1] = f32x16{};
    AT_WAITL(); bar();
#pragma unroll
    for (int k = 0; k < 3; ++k) if (k < ntc) { dma_k(sK0 + k * 8192, KCB, 64, 64 * k, wid, lane); dma_v(sV0 + k * 8192, VCB, 64, 64 * k, wid, lane); }
    for (int k = 0; k < ntc; ++k) {
        const int newer = ntc - 1 - k; AT_WAIT_NEWER(newer, 2);
        AT_WAITL(); bar();
        if (k + 3 < ntc) { dma_k(sK0 + ((k + 3) & 3) * 8192, KCB, 64, 64 * (k + 3), wid, lane); dma_v(sV0 + ((k + 3) & 3) * 8192, VCB, 64, 64 * (k + 3), wid, lane); }
        const lp sK = sK0 + (k & 3) * 8192, sV = sV0 + (k & 3) * 8192;
        const float x0 = c2 * (16.f * (64 * k) + 15.5f - (float)t0) - sc.m;
        f32x16 p0 = cinit(16.f * c2, hi, x0), p1 = cinit(16.f * c2, hi, x0 + c2 * 512.f);
        qk_tile(p0, p1, sK, qr, r32, hi);
        if (__any(nmax - 64 * k < 63)) mask_tile(p0, p1, 0, nmax - 64 * k, hi);
        VFrag vf; pv_load(vf, sV, lane, hi);
#pragma unroll
        for (int r = 0; r < 16; ++r) { p0[r] = __builtin_amdgcn_exp2f(p0[r]); p1[r] = __builtin_amdgcn_exp2f(p1[r]); }
        { AT_PACK(p0, p1); pv_mfma(o, vf, pw0, pw1, pw2, pw3); }
        float gs[8], ls[8];
#pragma unroll
        for (int q4 = 0; q4 < 4; ++q4) { gs[q4] = ((p0[4 * q4] + p0[4 * q4 + 1]) + (p0[4 * q4 + 2] + p0[4 * q4 + 3])) * linv; ls[q4] = p0[4 * q4 + 3] * linv;
                                         gs[4 + q4] = ((p1[4 * q4] + p1[4 * q4 + 1]) + (p1[4 * q4 + 2] + p1[4 * q4 + 3])) * linv; ls[4 + q4] = p1[4 * q4 + 3] * linv; }
#pragma unroll
        for (int q4 = 0; q4 < 8; ++q4) { gs[q4] += __shfl_xor(gs[q4], 8); gs[q4] += __shfl_xor(gs[q4], 16); ls[q4] += __shfl_xor(ls[q4], 8); ls[q4] += __shfl_xor(ls[q4], 16); }
        if (r32 < 8) {
            float* row = imp + qq * 129 + 16 * k + hi;
#pragma unroll
            for (int q4 = 0; q4 < 8; ++q4) row[2 * q4] += gs[q4];
        }
        wsync();
        if (r32 < 8) {
            float* row = imp + qq * 129 + 16 * k + hi + 1;
#pragma unroll
            for (int q4 = 0; q4 < 8; ++q4) row[2 * q4] += ls[q4];
        }
        wsync();
    }
    unsigned mk0 = 0u, mk1 = 0u, mk2 = 0u, mk3 = 0u;
    {
        const int qs = lane >> 3, part = lane & 7;
        float v[16];
#pragma unroll
        for (int i = 0; i < 16; ++i) { const int j = part * 16 + i; float x = imp[qs * 129 + j]; if (j == 0 || j == c || j == c - 1) x = 1e4f; if (j > c) x = NEGS; v[i] = x; }
#pragma unroll 1
        for (int it = 0; it < 16; ++it) {
            float bv = -3e38f; int bi = 0;
#pragma unroll
            for (int i = 0; i < 16; ++i) if (v[i] > bv) { bv = v[i]; bi = part * 16 + i; }
#pragma unroll
            for (int sft = 1; sft < 8; sft <<= 1) { const float ov = __shfl_xor(bv, sft); const int oi = __shfl_xor(bi, sft); if (ov > bv || (ov == bv && oi < bi)) { bv = ov; bi = oi; } }
            if (bv > NEGS) { const unsigned bit = 1u << (bi & 31); const int wq = bi >> 5; if (wq == 0) mk0 |= bit; else if (wq == 1) mk1 |= bit; else if (wq == 2) mk2 |= bit; else mk3 |= bit; }
#pragma unroll
            for (int i = 0; i < 16; ++i) if (part * 16 + i == bi) v[i] = -3.4e38f;
        }
        if (part == 0) { unsigned* sm = selm + (8 * wid + qs) * 4; sm[0] = mk0; sm[1] = mk1; sm[2] = mk2; sm[3] = mk3; }
        unsigned u0 = mk0, u1 = mk1, u2 = mk2, u3 = mk3;
#pragma unroll
        for (int sft = 8; sft < 64; sft <<= 1) { u0 |= __shfl_xor(u0, sft); u1 |= __shfl_xor(u1, sft); u2 |= __shfl_xor(u2, sft); u3 |= __shfl_xor(u3, sft); }
        if (lane == 0) { uni[wid * 4 + 0] = u0; uni[wid * 4 + 1] = u1; uni[wid * 4 + 2] = u2; uni[wid * 4 + 3] = u3; }
    }
    wsync();
    acc_scaled<true>(ostage, o, gt0 * linv, wsf, r32, hi);
    AT_WAITL(); bar();
    unsigned un0 = 0u, un1 = 0u, un2 = 0u, un3 = 0u;
#pragma unroll
    for (int w = 0; w < 8; ++w) { un0 |= uni[w * 4 + 0]; un1 |= uni[w * 4 + 1]; un2 |= uni[w * 4 + 2]; un3 |= uni[w * 4 + 3]; }
    un0 = __builtin_amdgcn_readfirstlane(un0); un1 = __builtin_amdgcn_readfirstlane(un1); un2 = __builtin_amdgcn_readfirstlane(un2); un3 = __builtin_amdgcn_readfirstlane(un3);
    const unsigned my0 = selm[(8 * wid + qq) * 4 + 0], my1 = selm[(8 * wid + qq) * 4 + 1], my2 = selm[(8 * wid + qq) * 4 + 2], my3 = selm[(8 * wid + qq) * 4 + 3];
    {
        const bf16_t* KS = ZB + (size_t)b * S * ZBW + ZB_KS + g * 64; const bf16_t* VS = ZB + (size_t)b * S * ZBW + ZB_VS + g * 64;
        Soft ss; ss.m = 0.f; ss.l = 0.f; o[0] = f32x16{}; o[1] = f32x16{};
        const int nsel = __builtin_popcount(un0) + __builtin_popcount(un1) + __builtin_popcount(un2) + __builtin_popcount(un3);
        int ji = 128;
#pragma unroll
        for (int k = 0; k < 3; ++k) if (k < nsel) { ji = next_bit128(un0, un1, un2, un3, ji); dma_k(sK0 + k * 8192, KS, ZBW, 64 * ji, wid, lane); dma_v(sV0 + k * 8192, VS, ZBW, 64 * ji, wid, lane); }
        int j = 128;
        for (int i = 0; i < nsel; ++i) {
            j = next_bit128(un0, un1, un2, un3, j);
            const int newer = nsel - 1 - i; AT_WAIT_NEWER(newer, 2);
            AT_WAITL(); bar();
            if (i + 3 < nsel) { ji = next_bit128(un0, un1, un2, un3, ji); dma_k(sK0 + ((i + 3) & 3) * 8192, KS, ZBW, 64 * ji, wid, lane); dma_v(sV0 + ((i + 3) & 3) * 8192, VS, ZBW, 64 * ji, wid, lane); }
            const lp sK = sK0 + (i & 3) * 8192, sV = sV0 + (i & 3) * 8192;
            const unsigned mw = (j >> 5) == 0 ? my0 : (j >> 5) == 1 ? my1 : (j >> 5) == 2 ? my2 : my3;
            const bool sel = (mw >> (j & 31)) & 1u;
            const float x0 = sel ? c2 * (float)(64 * j - t0) - ss.m : NEGS;
            f32x16 p0 = cinit(c2, hi, x0), p1 = cinit(c2, hi, sel ? x0 + c2 * 32.f : NEGS);
            qk_tile(p0, p1, sK, qr, r32, hi);
            if (j == c) mask_tile(p0, p1, 0, qi, hi);
            VFrag vf; pv_load(vf, sV, lane, hi);
            softmax_step<true>(p0, p1, ss, o, wsf, r32, hi);
            { AT_PACK(p0, p1); pv_mfma(o, vf, pw0, pw1, pw2, pw3); }
        }
        const float ls_ = halfsum(ss.l);
        acc_scaled<false>(ostage, o, ls_ > 0.f ? gt1 / ls_ : 0.f, wsf, r32, hi);
    }
    {
        const bf16_t* KW = ZB + (size_t)b * S * ZBW + ZB_KW + g * 64; const bf16_t* VW = ZB + (size_t)b * S * ZBW + ZB_VW + g * 64;
        Soft sw; sw.m = 0.f; sw.l = 0.f; o[0] = f32x16{}; o[1] = f32x16{};
        const int k0 = c >= 8 ? 0 : 8 - c, nw = 9 - k0;
        AT_WAITL(); bar();
#pragma unroll
        for (int k = 0; k < 3; ++k) if (k < nw) { dma_k(sK0 + k * 8192, KW, ZBW, t0 - 512 + 64 * (k0 + k), wid, lane); dma_v(sV0 + k * 8192, VW, ZBW, t0 - 512 + 64 * (k0 + k), wid, lane); }
        f32x16 pA0, pA1, pB0, pB1; float rmc;
#define WIN_STEP(C0, C1, N0, N1, I) do { const int i_ = (I); const int k = k0 + i_; \
            if (i_ + 1 < nw) { if (i_ + 2 < nw) AT_WAITV(2); else AT_WAITV(0); } \
            AT_WAITL(); bar(); \
            if (i_ + 3 < nw) { dma_k(sK0 + ((i_ + 3) & 3) * 8192, KW, ZBW, t0 - 512 + 64 * (k + 3), wid, lane); dma_v(sV0 + ((i_ + 3) & 3) * 8192, VW, ZBW, t0 - 512 + 64 * (k + 3), wid, lane); } \
            if (__any(rmc > 0.f)) { \
                const float dl = __builtin_fmaxf(rmc, 0.f); sw.m += dl; \
                _Pragma("unroll") for (int r = 0; r < 16; ++r) { C0[r] -= dl; C1[r] -= dl; } \
                const float al = __builtin_amdgcn_exp2f(-dl); sw.l *= al; \
                if (hi == 0) wsf[r32] = al; \
                wsync(); \
                _Pragma("unroll") for (int r = 0; r < 16; ++r) { const float f = wsf[crow(r, hi)]; o[0][r] *= f; o[1][r] *= f; } \
                wsync(); \
            } \
            { const float x0 = c2 * (float)(64 * (k + 1) - 512) - sw.m; \
              N0 = cinit(c2, hi, x0); N1 = cinit(c2, hi, x0 + c2 * 32.f); \
              if (k + 1 == 8) mask_init(N0, N1, qi, hi); } \
            const PipeOut po = pipe_step(C0, C1, N0, N1, o, sK0 + ((i_ + 1) & 3) * 8192, sV0 + (i_ & 3) * 8192, qr, lane, r32, hi); \
            sw.l += po.s; rmc = po.rmn; } while (0)
        { if (nw >= 3) AT_WAITV(4); else if (nw == 2) AT_WAITV(2); else AT_WAITV(0);
          AT_WAITL(); bar(); }
        { const float x0 = c2 * (float)(64 * k0 - 512);
          pB0 = cinit(c2, hi, x0); pB1 = cinit(c2, hi, x0 + c2 * 32.f);
          qk_tile(pB0, pB1, sK0, qr, r32, hi);
          if (k0 == 0) mask_tile(pB0, pB1, qi + 1, 63, hi);
          if (k0 == 8) mask_tile(pB0, pB1, 0, qi, hi);
          rmc = rowmax(pB0, pB1); }
        int i = 0;
#pragma unroll 1
        for (; i + 1 < nw; i += 2) {
            WIN_STEP(pB0, pB1, pA0, pA1, i);
            WIN_STEP(pA0, pA1, pB0, pB1, i + 1);
        }
        if (i < nw) WIN_STEP(pB0, pB1, pA0, pA1, i);
#undef WIN_STEP
        const float lw = halfsum(sw.l);
        acc_scaled<false>(ostage, o, lw > 0.f ? gt2 / lw : 0.f, wsf, r32, hi);
    }
    {
        bf16_t* AB = (bf16_t*)(p.ws + WS_ATTB);
#pragma unroll
        for (int i = 0; i < 4; ++i) { const int row = i * 8 + (lane >> 3), ch = lane & 7; const float4 a = *(const float4*)(ostage + row * 64 + ch * 8), c4 = *(const float4*)(ostage + row * 64 + ch * 8 + 4);
            const uint4 v = make_uint4(pk2(a.x, a.y), pk2(a.z, a.w), pk2(c4.x, c4.y), pk2(c4.z, c4.w));
            *(uint4*)(AB + ((size_t)b * S + t0 + 8 * wid + (row & 7)) * D + (4 * g + (row >> 3)) * 64 + ch * 8) = v; }
        wsync();
    }
    AT_WAITL(); bar();
}

}

constexpr int MB_CAP = 25600;
namespace at {
__device__ __forceinline__ void moba_route_unit(const Params& p, int b, int h, int qb, unsigned char* lds_raw) {
    const int tid = otid(), lane = tid & 63, r32 = lane & 31, hi = lane >> 5, wid = __builtin_amdgcn_readfirstlane(tid >> 6);
    lp lds = (lp)lds_raw;
    const bf16_t* ZB = (const bf16_t*)(p.ws + WS_ZB);
    const int bh = b * 8 + h;
    const bf16_t* KMB = (const bf16_t*)(p.ws + WS_KMB) + (size_t)bh * 32 * 64;
    const int qi = 32 * wid + r32, t = qb * 256 + qi; const size_t tt = (size_t)b * S + t;
    int* hist = (int*)(lds_raw + L_UNI);
    unsigned* SEL3 = (unsigned*)(p.ws + WS_SEL3); unsigned* LRK = (unsigned*)(p.ws + WS_LRK);
    unsigned char* IL = (unsigned char*)(p.ws + WS_ILIST) + ((size_t)(bh * 32 + qb) * 32) * 256;
    int* BCm = (int*)(p.ws + WS_BCM) + (size_t)(bh * 32 + qb) * 32;
    if (tid < 32) hist[tid] = 0;
    bf16x8 qr[4];
#pragma unroll
    for (int d0 = 0; d0 < 4; ++d0) qr[d0] = *(const bf16x8*)(ZB + tt * ZBW + ZB_MQ + h * 64 + d0 * 16 + hi * 8);
    const lp sKM = lds + L_KMT;
    glds(KMB + (size_t)(lane & 31) * 64 + wid * 8, sKM + wid * 1024);
    AT_WAITV(0); AT_WAITL(); bar();
    f32x16 g0 = f32x16{}, g1 = f32x16{};
    qk_tile(g0, g1, sKM, qr, r32, hi);
    float v1 = NEGS, v2 = NEGS, v3 = NEGS; int i1 = 64, i2 = 64, i3 = 64;
#pragma unroll
    for (int r = 0; r < 16; ++r) { const int n = crow(r, hi); const float s_ = n < qb ? g0[r] : NEGS;
        if (s_ > v1) { v3 = v2; i3 = i2; v2 = v1; i2 = i1; v1 = s_; i1 = n; } else if (s_ > v2) { v3 = v2; i3 = i2; v2 = s_; i2 = n; } else if (s_ > v3) { v3 = s_; i3 = n; } }
    float ov[3]; int oi[3];
    { auto a = __builtin_amdgcn_permlane32_swap(__float_as_uint(v1), __float_as_uint(v1), false, false); ov[0] = __uint_as_float(hi ? a[0] : a[1]); }
    { auto a = __builtin_amdgcn_permlane32_swap(__float_as_uint(v2), __float_as_uint(v2), false, false); ov[1] = __uint_as_float(hi ? a[0] : a[1]); }
    { auto a = __builtin_amdgcn_permlane32_swap(__float_as_uint(v3), __float_as_uint(v3), false, false); ov[2] = __uint_as_float(hi ? a[0] : a[1]); }
    { auto a = __builtin_amdgcn_permlane32_swap((unsigned)i1, (unsigned)i1, false, false); oi[0] = (int)(hi ? a[0] : a[1]); }
    { auto a = __builtin_amdgcn_permlane32_swap((unsigned)i2, (unsigned)i2, false, false); oi[1] = (int)(hi ? a[0] : a[1]); }
    { auto a = __builtin_amdgcn_permlane32_swap((unsigned)i3, (unsigned)i3, false, false); oi[2] = (int)(hi ? a[0] : a[1]); }
#pragma unroll
    for (int k = 0; k < 3; ++k) { const float s_ = ov[k]; const int n = oi[k];
        if (s_ > v1 || (s_ == v1 && n < i1)) { v3 = v2; i3 = i2; v2 = v1; i2 = i1; v1 = s_; i1 = n; }
        else if (s_ > v2 || (s_ == v2 && n < i2)) { v3 = v2; i3 = i2; v2 = s_; i2 = n; }
        else if (s_ > v3 || (s_ == v3 && n < i3)) { v3 = s_; i3 = n; } }
    if (hi == 0) {
        const int j1 = v1 > NEGS ? i1 : 255, j2 = v2 > NEGS ? i2 : 255, j3 = v3 > NEGS ? i3 : 255;
        int l1 = 0, l2 = 0, l3 = 0;
        if (j1 < 32) { l1 = atomicAdd(&hist[j1], 1); IL[j1 * 256 + l1] = (unsigned char)qi; }
        if (j2 < 32) { l2 = atomicAdd(&hist[j2], 1); IL[j2 * 256 + l2] = (unsigned char)qi; }
        if (j3 < 32) { l3 = atomicAdd(&hist[j3], 1); IL[j3 * 256 + l3] = (unsigned char)qi; }
        SEL3[tt * 8 + h] = (unsigned)j1 | ((unsigned)j2 << 8) | ((unsigned)j3 << 16);
        LRK[tt * 8 + h] = (unsigned)l1 | ((unsigned)l2 << 8) | ((unsigned)l3 << 16);
    }
    AT_WAITL(); bar();
    if (tid < 32) BCm[tid] = hist[tid];
    AT_WAITL(); bar();
}
__device__ __forceinline__ void moba_tables(const int* BCmbh, int lane, int& tot, int& seg) {
    int s = 0;
    if (lane < 32) { for (int q = 0; q < 32; ++q) s += BCmbh[q * 32 + lane]; }
    tot = s;
    int pad = (s + 31) & ~31, inc = pad;
#pragma unroll
    for (int sft = 1; sft < 32; sft <<= 1) { const int o_ = __shfl_up(inc, sft); if ((lane & 31) >= sft) inc += o_; }
    seg = inc - pad;
}
__device__ __forceinline__ void moba_gather_unit(const Params& p, int bh, int j, int ch, int segj, bool reload, unsigned char* lds_raw) {
    const int tid = otid(), lane = tid & 63, r32 = lane & 31, hi = lane >> 5, wid = __builtin_amdgcn_readfirstlane(tid >> 6);
    lp lds = (lp)lds_raw;
    const int b = bh >> 3, h = bh & 7;
    const bf16_t* ZB = (const bf16_t*)(p.ws + WS_ZB);
    const int* BCmbh = (const int*)(p.ws + WS_BCM) + (size_t)bh * 32 * 32;
    float* wsf = (float*)(lds_raw + L_WSF) + wid * 64;
    const lp sK0 = lds + L_K, sV0 = lds + L_V;
    const bf16_t* KM_ = ZB + (size_t)b * S * ZBW + ZB_MK + h * 64; const bf16_t* VM_ = ZB + (size_t)b * S * ZBW + ZB_MV + h * 64;
    if (reload) {
#pragma unroll
        for (int k = 0; k < 4; ++k) { dma_k(sK0 + k * 8192, KM_, ZBW, j * 256 + 64 * k, wid, lane); dma_v(sV0 + k * 8192, VM_, ZBW, j * 256 + 64 * k, wid, lane); }
    }
    const int gr = 256 * ch + 32 * wid + r32;
    const int cq = lane < 32 ? BCmbh[lane * 32 + j] : 0;
    int run = 0, qbs = j + 1, lr = 0;
#pragma unroll 4
    for (int q = 0; q < 32; ++q) { const int c_ = __builtin_amdgcn_readlane(cq, q); if (gr >= run && gr < run + c_) { qbs = q; lr = gr - run; } run += c_; }
    const int totj = run;
    const bool valid = gr < totj;
    const unsigned char* IL = (const unsigned char*)(p.ws + WS_ILIST);
    const int qidx = valid ? (int)IL[((size_t)(bh * 32 + qbs) * 32 + j) * 256 + lr] : 0;
    const int t = valid ? qbs * 256 + qidx : (j + 1) * 256; const size_t tt = (size_t)b * S + t;
    const float c2 = exp2f(-(float)(h + 1)) * LOG2E;
    bf16x8 qr[4];
#pragma unroll
    for (int d0 = 0; d0 < 4; ++d0) qr[d0] = *(const bf16x8*)(ZB + tt * ZBW + ZB_MQ + h * 64 + d0 * 16 + hi * 8);
    Soft sm; sm.m = 0.f; sm.l = 0.f; f32x16 o[2]; o[0] = f32x16{}; o[1] = f32x16{};
#pragma unroll 1
    for (int i = 0; i < 4; ++i) {
        if (reload) { const int newer = 3 - i; if (newer >= 3) AT_WAITV(6); else AT_WAIT_NEWER(newer, 2); AT_WAITL(); bar(); }
        const lp sK = sK0 + i * 8192, sV = sV0 + i * 8192;
        const float x0 = c2 * (float)(64 * i) - sm.m;
        f32x16 p0 = cinit(c2, hi, x0), p1 = cinit(c2, hi, x0 + c2 * 32.f);
        qk_tile(p0, p1, sK, qr, r32, hi);
        VFrag vf; pv_load(vf, sV, lane, hi);
        softmax_step<true>(p0, p1, sm, o, wsf, r32, hi);
        { AT_PACK(p0, p1); pv_mfma(o, vf, pw0, pw1, pw2, pw3); }
    }
    {
        const float lt = halfsum(sm.l);
        float* PM = (float*)(p.ws + WS_PM) + (size_t)bh * MB_CAP; float* PL = (float*)(p.ws + WS_PL) + (size_t)bh * MB_CAP;
        if (hi == 0 && valid) { PM[segj + gr] = sm.m; PL[segj + gr] = lt; }
        bf16_t* stg = (bf16_t*)(lds_raw + L_OST) + wid * 4096;
#pragma unroll
        for (int r = 0; r < 16; ++r) { const int orow = crow(r, hi); stg[orow * 64 + r32] = (bf16_t)f2bf(o[0][r]); stg[orow * 64 + 32 + r32] = (bf16_t)f2bf(o[1][r]); }
        wsync();
        bf16_t* PO = (bf16_t*)(p.ws + WS_PO) + ((size_t)bh * MB_CAP + segj + 256 * ch + 32 * wid) * 64;
        const int nrow = totj - (256 * ch + 32 * wid);
#pragma unroll
        for (int i = 0; i < 4; ++i) { const int row = i * 8 + (lane >> 3), c8 = lane & 7; if (row < nrow) *(uint4*)(PO + (size_t)row * 64 + c8 * 8) = *(const uint4*)(stg + row * 64 + c8 * 8); }
        wsync();
    }
    AT_WAITL(); bar();
}
__device__ __forceinline__ void moba_self_unit(const Params& p, int b, int h, int qb, unsigned char* lds_raw) {
    const int tid = otid(), lane = tid & 63, r32 = lane & 31, hi = lane >> 5, wid = __builtin_amdgcn_readfirstlane(tid >> 6);
    lp lds = (lp)lds_raw;
    const int bh = b * 8 + h;
    const bf16_t* ZB = (const bf16_t*)(p.ws + WS_ZB);
    const int* BCmbh = (const int*)(p.ws + WS_BCM) + (size_t)bh * 32 * 32;
    const int qi = 32 * wid + r32, t = qb * 256 + qi; const size_t tt = (size_t)b * S + t;
    float* wsf = (float*)(lds_raw + L_WSF) + wid * 64;
    float* ostage = (float*)(lds_raw + L_OST) + wid * 2048;
    const float c2 = exp2f(-(float)(h + 1)) * LOG2E;
    bf16x8 qr[4];
#pragma unroll
    for (int d0 = 0; d0 < 4; ++d0) qr[d0] = *(const bf16x8*)(ZB + tt * ZBW + ZB_MQ + h * 64 + d0 * 16 + hi * 8);
    const lp sK0 = lds + L_K, sV0 = lds + L_V;
    const bf16_t* KM_ = ZB + (size_t)b * S * ZBW + ZB_MK + h * 64; const bf16_t* VM_ = ZB + (size_t)b * S * ZBW + ZB_MV + h * 64;
    Soft sm; sm.m = 0.f; sm.l = 0.f; f32x16 o[2]; o[0] = f32x16{}; o[1] = f32x16{};
#pragma unroll
    for (int k = 0; k < 3; ++k) { dma_k(sK0 + k * 8192, KM_, ZBW, qb * 256 + 64 * k, wid, lane); dma_v(sV0 + k * 8192, VM_, ZBW, qb * 256 + 64 * k, wid, lane); }
    int tot, seg; moba_tables(BCmbh, lane, tot, seg);
    int before = 0; if (lane < 32) { for (int q = 0; q < qb; ++q) before += BCmbh[q * 32 + lane]; }
    const int base = seg + before;
#pragma unroll 1
    for (int i = 0; i < 4; ++i) {
        const int newer = 3 - i; AT_WAIT_NEWER(newer, 2);
        AT_WAITL(); bar();
        if (i == 0) { dma_k(sK0 + 3 * 8192, KM_, ZBW, qb * 256 + 192, wid, lane); dma_v(sV0 + 3 * 8192, VM_, ZBW, qb * 256 + 192, wid, lane); }
        const lp sK = sK0 + i * 8192, sV = sV0 + i * 8192;
        const bool skip = (32 * wid + 31 < 64 * i);
        if (!skip) {
            const float x0 = c2 * (float)(64 * i) - sm.m;
            f32x16 p0 = cinit(c2, hi, x0), p1 = cinit(c2, hi, x0 + c2 * 32.f);
            qk_tile(p0, p1, sK, qr, r32, hi);
            if (64 * i + 63 > 32 * wid) mask_tile(p0, p1, 0, qi - 64 * i, hi);
            VFrag vf; pv_load(vf, sV, lane, hi);
            softmax_step<true>(p0, p1, sm, o, wsf, r32, hi);
            { AT_PACK(p0, p1); pv_mfma(o, vf, pw0, pw1, pw2, pw3); }
        }
    }
    {
        const float lself = halfsum(sm.l);
        const unsigned s3 = ((const unsigned*)(p.ws + WS_SEL3))[tt * 8 + h], l3 = ((const unsigned*)(p.ws + WS_LRK))[tt * 8 + h];
        const float* PM = (const float*)(p.ws + WS_PM) + (size_t)bh * MB_CAP; const float* PL = (const float*)(p.ws + WS_PL) + (size_t)bh * MB_CAP;
        float mk[3], lk[3]; int pidx[3];
        float M = sm.m + c2 * 256.f * (float)qb;
        const float mself = M;
#pragma unroll
        for (int k = 0; k < 3; ++k) { const int jk = (s3 >> (8 * k)) & 255, lrk = (l3 >> (8 * k)) & 255;
            const int pb = __shfl(base, jk & 31);
            if (jk < 32) { pidx[k] = pb + lrk; mk[k] = PM[pidx[k]] + c2 * 256.f * (float)jk; lk[k] = PL[pidx[k]]; M = __builtin_fmaxf(M, mk[k]); }
            else { pidx[k] = -1; mk[k] = NEGS; lk[k] = 0.f; } }
        const float ws_ = __builtin_amdgcn_exp2f(mself - M);
        float wk[3]; float Lt = lself * ws_;
#pragma unroll
        for (int k = 0; k < 3; ++k) { wk[k] = pidx[k] >= 0 ? __builtin_amdgcn_exp2f(mk[k] - M) : 0.f; Lt += lk[k] * wk[k]; }
        const float inv = Lt > 0.f ? 1.f / Lt : 0.f;
        float* rws = wsf;
        float* rwk = (float*)(lds_raw + L_KMT) + wid * 256;
        int* rpi = (int*)(rwk + 96);
        if (hi == 0) { rws[r32] = ws_ * inv;
#pragma unroll
            for (int k = 0; k < 3; ++k) { rwk[k * 32 + r32] = wk[k] * inv; rpi[k * 32 + r32] = pidx[k]; } }
#pragma unroll
        for (int r = 0; r < 16; ++r) { const int orow = crow(r, hi); ostage[orow * 64 + r32] = o[0][r]; ostage[orow * 64 + 32 + r32] = o[1][r]; }
        wsync();
        const bf16_t* PO = (const bf16_t*)(p.ws + WS_PO) + (size_t)bh * MB_CAP * 64;
        bf16_t* AB = (bf16_t*)(p.ws + WS_ATTB);
#pragma unroll
        for (int i = 0; i < 4; ++i) { const int row = i * 8 + (lane >> 3), c8 = lane & 7;
            const float4 a = *(const float4*)(ostage + row * 64 + c8 * 8), c4 = *(const float4*)(ostage + row * 64 + c8 * 8 + 4);
            const float w0 = rws[row];
            float acc8[8] = {a.x * w0, a.y * w0, a.z * w0, a.w * w0, c4.x * w0, c4.y * w0, c4.z * w0, c4.w * w0};
#pragma unroll
            for (int k = 0; k < 3; ++k) { const int pi = rpi[k * 32 + row]; if (pi >= 0) { const float w = rwk[k * 32 + row]; const uint4 q = *(const uint4*)(PO + (size_t)pi * 64 + c8 * 8);
                const unsigned qq_[4] = {q.x, q.y, q.z, q.w};
#pragma unroll
                for (int e = 0; e < 4; ++e) { acc8[2 * e] += __builtin_bit_cast(float, qq_[e] << 16) * w; acc8[2 * e + 1] += __builtin_bit_cast(float, qq_[e] & 0xffff0000u) * w; } } }
            *(uint4*)(AB + ((size_t)b * S + qb * 256 + 32 * wid + row) * D + 512 + h * 64 + c8 * 8) = make_uint4(pk2(acc8[0], acc8[1]), pk2(acc8[2], acc8[3]), pk2(acc8[4], acc8[5]), pk2(acc8[6], acc8[7])); }
        wsync();
    }
    AT_WAITL(); bar();
}
}

__device__ __forceinline__ void phase_att1(const Params& p, unsigned char* lds_raw) {
    const int tid = otid();
    int* pre = (int*)(lds_raw + at::L_END);
    int* segt = pre + 514;
    { const int* BCm = (const int*)(p.ws + WS_BCM); const int bh = tid >> 5, j = tid & 31; int s = 0;
      for (int q = 0; q < 32; ++q) s += BCm[(size_t)(bh * 32 + q) * 32 + j];
      pre[tid + 1] = (s + 255) >> 8; if (tid == 0) pre[0] = 0;
      segt[tid] = (s + 31) & ~31; }
    __syncthreads();
    for (int sft = 1; sft < 512; sft <<= 1) { int v = 0, w = 0; if (tid >= sft) v = pre[tid + 1 - sft]; if ((tid & 31) >= sft) w = segt[tid - sft]; __syncthreads(); pre[tid + 1] += v; if (sft < 32) segt[tid] += w; __syncthreads(); }
    { const int* BCm = (const int*)(p.ws + WS_BCM); const int bh = tid >> 5, j = tid & 31; int s = 0;
      for (int q = 0; q < 32; ++q) s += BCm[(size_t)(bh * 32 + q) * 32 + j];
      const int excl = segt[tid] - ((s + 31) & ~31); __syncthreads(); segt[tid] = excl; }
    __syncthreads();
    const int nun = pre[512];
    for (int pi = blockIdx.x; pi < 512; pi += gridDim.x) {
        const int rnd = pi >> 8, id = pi & 255;
        const int bg = 2 * rnd + (id >> 7), c = rnd ? 127 - (id & 127) : (id & 127); at::nsa_unit(p, bg >> 1, bg & 1, c, lds_raw);
    }
    {
        const int u0 = (int)(((long)blockIdx.x * nun) / gridDim.x), u1 = (int)(((long)(blockIdx.x + 1) * nun) / gridDim.x);
        int prev = -1;
        for (int u = u0; u < u1; ++u) {
            int lo = 0, hi_ = 511;
            while (lo < hi_) { const int mid = (lo + hi_ + 1) >> 1; if (pre[mid] <= u) lo = mid; else hi_ = mid - 1; }
            at::moba_gather_unit(p, lo >> 5, lo & 31, u - pre[lo], segt[lo], lo != prev, lds_raw);
            prev = lo;
        }
    }
}
__device__ __forceinline__ void phase_att2(const Params& p, unsigned char* lds_raw) {
    for (int pi = blockIdx.x; pi < 512; pi += gridDim.x) {
        const int rnd = pi >> 8, id = pi & 255;
        const int bh = 8 * rnd + (id >> 5), qb = rnd ? 31 - (id & 31) : (id & 31); at::moba_self_unit(p, bh >> 3, bh & 7, qb, lds_raw);
    }
}
__device__ __forceinline__ void phase_route(const Params& p, unsigned char* lds_raw) {
    for (int pi = blockIdx.x; pi < 512; pi += gridDim.x) at::moba_route_unit(p, pi >> 8, (pi >> 5) & 7, pi & 31, lds_raw);
}


__device__ __forceinline__ void phase_r2_fast(const Params& p, int l, unsigned char* lds_raw) {
    using namespace at;
    const int tid = otid(), lane = tid & 63, wave = __builtin_amdgcn_readfirstlane(tid >> 6), r32 = lane & 31, hi = lane >> 5;
    const float* mod = (const float*)(p.ws + WS_MOD);
    const bf16_t* XAB = (const bf16_t*)(p.ws + WS_XAB); bf16_t* XN = (bf16_t*)(p.ws + WS_XN); bf16_t* XL = (bf16_t*)(p.ws + WS_XNLO);
    const float* lng = p.in[5] + (size_t)l * D; const float* rw = p.in[15] + (size_t)l * D * NE; const float* rb = p.in[16] + l * NE;
    int* toke = (int*)(p.ws + WS_TOKE); float* tokw = (float*)(p.ws + WS_TOKW); int* BC = (int*)(p.ws + WS_BC);
    lp lds = (lp)lds_raw;
    int* hist = (int*)(lds_raw + 131072);
    for (int blk = blockIdx.x; blk < T / 64; blk += gridDim.x) {
        for (int idx = tid; idx < 128 * 32; idx += NT) {
            const int kc = idx >> 5, e = idx & 31; float v[8];
#pragma unroll
            for (int j = 0; j < 8; ++j) v[j] = rw[(size_t)(8 * kc + j) * NE + e];
            unsigned hh[8], ll[8];
#pragma unroll
            for (int j = 0; j < 8; ++j) { hh[j] = f2bf(v[j]); ll[j] = f2bf(v[j] - __builtin_bit_cast(float, hh[j] << 16)); }
            *(uint4*)(lds_raw + (size_t)idx * 16) = make_uint4(hh[0] | (hh[1] << 16), hh[2] | (hh[3] << 16), hh[4] | (hh[5] << 16), hh[6] | (hh[7] << 16));
            *(uint4*)(lds_raw + 65536 + (size_t)idx * 16) = make_uint4(ll[0] | (ll[1] << 16), ll[2] | (ll[3] << 16), ll[4] | (ll[5] << 16), ll[6] | (ll[7] << 16));
        }
        if (tid < 32) hist[tid] = 0;
        {
            const int b = (blk * 64) / S;
            const float* sh = mod + ((size_t)l * Bn + b) * 6144 + 3 * D; const float* sc = mod + ((size_t)l * Bn + b) * 6144 + 4 * D;
            float4 ga[4], s0v[4];
#pragma unroll
            for (int j = 0; j < 4; ++j) { const int col = 4 * lane + 256 * j; const float4 g = *(const float4*)(lng + col), s1 = *(const float4*)(sc + col); s0v[j] = *(const float4*)(sh + col);
                ga[j] = make_float4(g.x * (1.f + s1.x), g.y * (1.f + s1.y), g.z * (1.f + s1.z), g.w * (1.f + s1.w)); }
#pragma unroll 1
            for (int i0 = 0; i0 < 8; i0 += 4) {
                uint2 q_[4][4];
#pragma unroll
                for (int i = 0; i < 4; ++i)
#pragma unroll
                    for (int j = 0; j < 4; ++j) q_[i][j] = *(const uint2*)(XAB + (size_t)(blk * 64 + wave * 8 + i0 + i) * D + 4 * lane + 256 * j);
                float ss[4];
#pragma unroll
                for (int i = 0; i < 4; ++i) { float s_ = 0.f;
#pragma unroll
                    for (int j = 0; j < 4; ++j) { const float x0 = __builtin_bit_cast(float, q_[i][j].x << 16), x1 = __builtin_bit_cast(float, q_[i][j].x & 0xffff0000u), x2 = __builtin_bit_cast(float, q_[i][j].y << 16), x3 = __builtin_bit_cast(float, q_[i][j].y & 0xffff0000u);
                        s_ += (x0 * x0 + x1 * x1) + (x2 * x2 + x3 * x3); }
                    ss[i] = s_; }
#pragma unroll
                for (int sft = 32; sft >= 1; sft >>= 1) {
#pragma unroll
                    for (int i = 0; i < 4; ++i) ss[i] += __shfl_xor(ss[i], sft); }
#pragma unroll
                for (int i = 0; i < 4; ++i) {
                    const int t = blk * 64 + wave * 8 + i0 + i;
                    const float r = rsqrtf(ss[i] * (1.f / D) + EPS);
#pragma unroll
                    for (int j = 0; j < 4; ++j) {
                        const int col = 4 * lane + 256 * j;
                        const float x0 = __builtin_bit_cast(float, q_[i][j].x << 16), x1 = __builtin_bit_cast(float, q_[i][j].x & 0xffff0000u), x2 = __builtin_bit_cast(float, q_[i][j].y << 16), x3 = __builtin_bit_cast(float, q_[i][j].y & 0xffff0000u);
                        const float o[4] = {x0 * r * ga[j].x + s0v[j].x, x1 * r * ga[j].y + s0v[j].y, x2 * r * ga[j].z + s0v[j].z, x3 * r * ga[j].w + s0v[j].w};
                        unsigned hh[4], ll[4];
#pragma unroll
                        for (int q = 0; q < 4; ++q) { hh[q] = f2bf(o[q]); ll[q] = f2bf(o[q] - __builtin_bit_cast(float, hh[q] << 16)); }
                        *(uint2*)(XN + (size_t)t * D + col) = make_uint2(hh[0] | (hh[1] << 16), hh[2] | (hh[3] << 16));
                        *(uint2*)(XL + (size_t)t * D + col) = make_uint2(ll[0] | (ll[1] << 16), ll[2] | (ll[3] << 16));
                    }
                }
            }
        }
        asm volatile("s_waitcnt vmcnt(0)" ::: "memory");
        __syncthreads();
        f32x16 acc = f32x16{};
        {
            const int rh = wave & 1, kq = wave >> 1;
            const int t = blk * 64 + rh * 32 + r32;
            const bf16_t* xh = XN + (size_t)t * D + 8 * hi + 256 * kq; const bf16_t* xl = XL + (size_t)t * D + 8 * hi + 256 * kq;
            const AT_LAS unsigned char* wh = lds + (size_t)(hi * 32 + r32) * 16 + (size_t)kq * 16 * 1024; const AT_LAS unsigned char* wl = wh + 65536;
#pragma unroll 8
            for (int ks = 0; ks < 16; ++ks) {
                const bf16x8 bh = *(const bf16x8*)(xh + 16 * ks), bl = *(const bf16x8*)(xl + 16 * ks);
                const bf16x8 ah = *(const AT_LAS bf16x8*)(wh + ks * 1024), al = *(const AT_LAS bf16x8*)(wl + ks * 1024);
                acc = __builtin_amdgcn_mfma_f32_32x32x16_bf16(ah, bh, acc, 0, 0, 0);
                acc = __builtin_amdgcn_mfma_f32_32x32x16_bf16(al, bh, acc, 0, 0, 0);
                acc = __builtin_amdgcn_mfma_f32_32x32x16_bf16(ah, bl, acc, 0, 0, 0);
            }
        }
        __syncthreads();
        { float* part = (float*)lds_raw;
          if (wave >= 2) {
#pragma unroll
              for (int r = 0; r < 16; ++r) part[(wave * 16 + r) * 64 + lane] = acc[r]; } }
        __syncthreads();
        if (wave < 2) {
            const int t = blk * 64 + wave * 32 + r32;
            { const float* part = (const float*)lds_raw;
#pragma unroll
              for (int r = 0; r < 16; ++r) acc[r] = ((acc[r] + part[((wave + 2) * 16 + r) * 64 + lane]) + part[((wave + 4) * 16 + r) * 64 + lane]) + part[((wave + 6) * 16 + r) * 64 + lane]; }
            float a0 = -3e38f, a1 = -3e38f, a2 = -3e38f, a3 = -3e38f; int i0 = 99, i1 = 99, i2 = 99, i3 = 99;
#pragma unroll
            for (int r = 0; r < 16; ++r) { const int e = crow(r, hi); const float s_ = acc[r] + rb[e];
                if (s_ > a0) { a3 = a2; i3 = i2; a2 = a1; i2 = i1; a1 = a0; i1 = i0; a0 = s_; i0 = e; }
                else if (s_ > a1) { a3 = a2; i3 = i2; a2 = a1; i2 = i1; a1 = s_; i1 = e; }
                else if (s_ > a2) { a3 = a2; i3 = i2; a2 = s_; i2 = e; }
                else if (s_ > a3) { a3 = s_; i3 = e; } }
            float ov[4]; int oi[4];
            { const float sv[4] = {a0, a1, a2, a3}; const int si[4] = {i0, i1, i2, i3};
#pragma unroll
              for (int k = 0; k < 4; ++k) { auto a = __builtin_amdgcn_permlane32_swap(__float_as_uint(sv[k]), __float_as_uint(sv[k]), false, false); ov[k] = __uint_as_float(hi ? a[0] : a[1]);
                                            auto c = __builtin_amdgcn_permlane32_swap((unsigned)si[k], (unsigned)si[k], false, false); oi[k] = (int)(hi ? c[0] : c[1]); } }
#pragma unroll
            for (int k = 0; k < 4; ++k) { const float s_ = ov[k]; const int e = oi[k];
                if (s_ > a0 || (s_ == a0 && e < i0)) { a3 = a2; i3 = i2; a2 = a1; i2 = i1; a1 = a0; i1 = i0; a0 = s_; i0 = e; }
                else if (s_ > a1 || (s_ == a1 && e < i1)) { a3 = a2; i3 = i2; a2 = a1; i2 = i1; a1 = s_; i1 = e; }
                else if (s_ > a2 || (s_ == a2 && e < i2)) { a3 = a2; i3 = i2; a2 = s_; i2 = e; }
                else if (s_ > a3 || (s_ == a3 && e < i3)) { a3 = s_; i3 = e; } }
            const float e1 = __expf(a1 - a0), e2 = __expf(a2 - a0), e3 = __expf(a3 - a0), inv = 1.f / (((1.f + e1) + e2) + e3);
            if (hi == 0) {
                *(int4*)(toke + (size_t)t * 4) = make_int4(i0, i1, i2, i3);
                *(float4*)(tokw + (size_t)t * 4) = make_float4(inv, e1 * inv, e2 * inv, e3 * inv);
                atomicAdd(&hist[i0], 1); atomicAdd(&hist[i1], 1); atomicAdd(&hist[i2], 1); atomicAdd(&hist[i3], 1);
            }
        }
        __syncthreads();
        if (tid < 32) BC[blk * 32 + tid] = hist[tid];
        __syncthreads();
    }
}
__device__ __forceinline__ void phase_sc_fast(const Params& p, int l, unsigned char* lds_raw) {
    const int tid = otid();
    const int* BC = (const int*)(p.ws + WS_BC);
    int* cnt = (int*)(p.ws + WS_CNT) + l * 32;
    int* tot = (int*)lds_raw; int* base = tot + 32; int* fillc = tot + 64; int* before = tot + 96;
    const int* toke = (const int*)(p.ws + WS_TOKE); const float* tokw = (const float*)(p.ws + WS_TOKW);
    int* rowtok = (int*)(p.ws + WS_ROWTOK) + (size_t)l * RMAX; float* roww = (float*)(p.ws + WS_ROWW) + (size_t)l * RMAX; int* pos = (int*)(p.ws + WS_POS);
    for (int blk = blockIdx.x; blk < T / 64; blk += gridDim.x) {
        { const int e = tid & 31, part = tid >> 5; int s = 0, bf = 0;
#pragma unroll 4
          for (int i = part * 16; i < part * 16 + 16; ++i) { const int c = BC[i * 32 + e]; s += c; if (i < blk) bf += c; }
          int* ptot = tot + 128; int* pbef = ptot + 512;
          ptot[tid] = s; pbef[tid] = bf; }
        __syncthreads();
        if (tid < 32) { const int* ptot = tot + 128; const int* pbef = ptot + 512; int s = 0, bf = 0;
#pragma unroll
            for (int q = 0; q < 16; ++q) { s += ptot[q * 32 + tid]; bf += pbef[q * 32 + tid]; }
            tot[tid] = s; before[tid] = bf; fillc[tid] = 0; if (blk == 0) cnt[tid] = s; }
        __syncthreads();
        if (tid == 0) { int s = 0; for (int e = 0; e < 32; ++e) { base[e] = s + before[e]; s += (tot[e] + 255) & ~255; } }
        __syncthreads();
        if (tid < 256) {
            const int i = blk * 256 + tid, e = toke[i];
            const int slot = base[e] + atomicAdd(&fillc[e], 1);
            rowtok[slot] = i >> 2; roww[slot] = tokw[i]; pos[i] = slot;
        }
        __syncthreads();
    }
}

#define XB_TMO      128
#define XB_XCNT(j)  (256  + 64 * (j))
#define XB_XSUB(j)  (1280 + 64 * (j))
#define XB_XGEN(j)  (2304 + 64 * (j))
#define XB_TOP      3328
#define XB_TOPGEN   3392
#define XCD_BAR_WORDS 3456
#define XB_SPIN_CAP (1u << 18)
#define XLAS __attribute__((address_space(3)))
__device__ __forceinline__ unsigned xb_ld(unsigned* p)              { return __hip_atomic_load(p, __ATOMIC_RELAXED, __HIP_MEMORY_SCOPE_AGENT); }
__device__ __forceinline__ unsigned xb_add(unsigned* p, unsigned v) { return __hip_atomic_fetch_add(p, v, __ATOMIC_RELAXED, __HIP_MEMORY_SCOPE_AGENT); }
__device__ __forceinline__ unsigned xb_xcc_id() { return (unsigned)__builtin_amdgcn_s_getreg((3 << 11) | 20) & 0xFu; }
#define XB_SPIN(cond, bar) do { unsigned _sp = 0; while (cond) { __builtin_amdgcn_s_sleep(1); \
    if ((++_sp & 255u) == 0u) { if (xb_ld(&(bar)[XB_TMO])) break; if (_sp > XB_SPIN_CAP) { atomicAdd(&(bar)[XB_TMO], 1u); break; } } } } while (0)
constexpr int LDS_BARST_OFF = 147200;
struct XcdBarrier { unsigned* bar; unsigned x; volatile XLAS unsigned* st; };
__device__ __forceinline__ XcdBarrier xcd_barrier_post(unsigned* bar, volatile XLAS unsigned* st) {
    XcdBarrier b; b.bar = bar; b.x = xb_xcc_id(); b.st = st;
    if (threadIdx.x == 0) (void)xb_add(&bar[XB_XCNT(b.x)], 1u);
    return b;
}
__device__ __forceinline__ void xcd_barrier_complete(unsigned* bar, unsigned x, unsigned& nloc, unsigned& nx) {
    const unsigned G = gridDim.x * gridDim.y * gridDim.z;
    unsigned sum, cnt, mine, sp = 0u;
    for (;;) {
        sum = 0u; cnt = 0u; mine = 0u;
#pragma unroll
        for (unsigned j = 0; j < 16; ++j) { const unsigned c = xb_ld(&bar[XB_XCNT(j)]); sum += c; cnt += (c > 0u) ? 1u : 0u; mine = (j == x) ? c : mine; }
        if (sum == G) break;
        __builtin_amdgcn_s_sleep(1);
        if ((++sp & 255u) == 0u) { if (xb_ld(&bar[XB_TMO])) break; if (sp > XB_SPIN_CAP) { atomicAdd(&bar[XB_TMO], 1u); break; } }
    }
    nloc = mine > 0u ? mine : 1u; nx = cnt > 0u ? cnt : 1u;
}
__device__ __forceinline__ void xcd_barrier(unsigned char* ws, unsigned char* lds_raw_) {
    XcdBarrier b; b.bar = (unsigned*)(ws + WS_BAR); b.x = xb_xcc_id(); b.st = (volatile XLAS unsigned*)((XLAS unsigned char*)lds_raw_ + LDS_BARST_OFF);
    asm volatile("s_waitcnt vmcnt(0)" ::: "memory");
    __syncthreads();
    if (threadIdx.x == 0) {
        unsigned* bar = b.bar;
        __builtin_amdgcn_s_waitcnt(0);
        unsigned nloc = b.st[0], nx = b.st[1];
        if (nloc == 0u) { xcd_barrier_complete(bar, b.x, nloc, nx); b.st[0] = nloc; b.st[1] = nx; }
        const unsigned old = xb_add(&bar[XB_XSUB(b.x)], 1u);
        const unsigned gen = old / nloc;
        if (old + 1u == (gen + 1u) * nloc) {
            __builtin_amdgcn_fence(__ATOMIC_RELEASE, "agent");
            asm volatile("s_waitcnt vmcnt(0)" ::: "memory");
            const unsigned og = xb_add(&bar[XB_TOP], 1u);
            const unsigned tg = og / nx;
            if (og + 1u == (tg + 1u) * nx) xb_add(&bar[XB_TOPGEN], 1u);
            else XB_SPIN(xb_ld(&bar[XB_TOPGEN]) == tg, bar);
            __builtin_amdgcn_fence(__ATOMIC_ACQUIRE, "agent");
            xb_add(&bar[XB_XGEN(b.x)], 1u);
            asm volatile("s_waitcnt vmcnt(0)" ::: "memory");
        } else {
            XB_SPIN(xb_ld(&bar[XB_XGEN(b.x)]) == gen, bar);
            __builtin_amdgcn_fence(__ATOMIC_ACQUIRE, "agent");
            asm volatile("s_waitcnt vmcnt(0)" ::: "memory");
        }
    }
    __syncthreads();
}

__global__ void __launch_bounds__(NT, 2) mega_fwd(Params p) {
    extern __shared__ __attribute__((aligned(16))) unsigned char lds_raw[];
    float* lds = (float*)lds_raw;
    volatile XLAS unsigned* bst = (volatile XLAS unsigned*)((XLAS unsigned char*)lds_raw + LDS_BARST_OFF);
    if (threadIdx.x < 2) bst[threadIdx.x] = 0u;
    __syncthreads();
    (void)xcd_barrier_post((unsigned*)(p.ws + WS_BAR), bst);
#define GSYNC() xcd_barrier(p.ws, lds_raw)
    phase_p0a(p, lds);
    __syncthreads();
    phase_convert(p, lds);
    GSYNC();
    phase_p0b(p);
    GSYNC();
    _Pragma("unroll 1") for (int l = 0; l < L; ++l) {
        phase_r1(p, l, true);
        GSYNC();
        phase_g1_fast(p, l, lds_raw);
        GSYNC();
        phase_ck_fast(p, l, lds_raw);
        GSYNC();
        phase_c2(p, l, lds);
        __syncthreads();
        phase_route(p, lds_raw);
        GSYNC();
        phase_att1(p, lds_raw);
        GSYNC();
        phase_att2(p, lds_raw);
        GSYNC();
        phase_g2_fast(p, l, lds_raw);
        GSYNC();
        phase_r2_fast(p, l, lds_raw);
        GSYNC();
        phase_sc_fast(p, l, lds_raw);
        GSYNC();
        phase_m1_fast(p, l, lds_raw);
        GSYNC();
        phase_m2_fast(p, l, lds_raw);
        GSYNC();
    }
    phase_r1(p, L, false);
}

extern "C" void kernel_launch(void* const* d_in, const int* in_sizes, int n_in, void* d_out, int out_size, void* d_ws, size_t ws_size, hipStream_t stream) {
    static int grid_blocks = 0;
    if (grid_blocks == 0) {
        if (n_in != 21 || out_size != T * D || ws_size < WS_END) { fprintf(stderr, "kernel_launch: unexpected shapes (n_in %d out %d ws %zu need %zu)\n", n_in, out_size, ws_size, (size_t)WS_END); grid_blocks = -1; return; }
        int dev = 0, cus = 0, per_cu = 0;
        hipGetDevice(&dev);
        hipDeviceGetAttribute(&cus, hipDeviceAttributeMultiprocessorCount, dev);
        hipFuncSetAttribute((const void*)mega_fwd, hipFuncAttributeMaxDynamicSharedMemorySize, LDS_BYTES);
        hipOccupancyMaxActiveBlocksPerMultiprocessor(&per_cu, (const void*)mega_fwd, NT, LDS_BYTES);
        if (per_cu < 1) { fprintf(stderr, "kernel_launch: occupancy query says %d blocks per CU\n", per_cu); per_cu = 1; }
        (void)hipGetLastError();
        grid_blocks = cus * 1;
    }
    if (grid_blocks < 0) return;
    if (hipMemsetAsync((char*)d_ws + WS_BAR, 0, 16384, stream) != hipSuccess) { fprintf(stderr, "kernel_launch: memset failed\n"); return; }
    Params p{};
    for (int i = 0; i < 21; ++i) p.in[i] = (const float*)d_in[i];
    p.out = (float*)d_out; p.ws = (unsigned char*)d_ws;
    hipLaunchKernelGGL(mega_fwd, dim3(grid_blocks), dim3(NT), LDS_BYTES, stream, p);
    hipError_t e = hipPeekAtLastError();
    if (e != hipSuccess) fprintf(stderr, "launch failed: %s (grid %d)\n", hipGetErrorString(e), grid_blocks);
}
```

```cpp
#include <hip/hip_runtime.h>
#include <cstdio>
#include <cstdint>

constexpr int Bn = 2, S = 8192, D = 1024, L = 2, T = Bn * S;
constexpr int INW = 2840;
constexpr int NE = 32, TOPK = 4, DFF = 1024;
constexpr int A_TOT = T * TOPK;
constexpr int RMAX = A_TOT + NE * 256;
constexpr int NCMP = 511;
constexpr int NT = 512;
constexpr int NW = NT / 64;
constexpr int LDS_BYTES = 147456;
constexpr float EPS = 1e-6f;
constexpr float NEGF = -1e30f;

constexpr int ZBW = 3072;
constexpr int ZB_Q = 0, ZB_KC = 512, ZB_VC = 640, ZB_KS = 768, ZB_VS = 896, ZB_KW = 1024, ZB_VW = 1152, ZB_MQ = 1280, ZB_MK = 1792, ZB_MV = 2304, ZB_G = 2816;
constexpr float QSCALE = 0.125f * 1.4426950408889634f;
constexpr float LOG2E = 1.4426950408889634f;

constexpr size_t al256(size_t x) { return (x + 255) & ~(size_t)255; }
constexpr size_t WS_BAR = 0;
constexpr size_t WS_MODP = 16384;
constexpr size_t WS_MOD = al256(WS_MODP + (size_t)8 * L * Bn * 6144 * 4);
constexpr size_t WS_CNT = al256(WS_MOD + (size_t)L * Bn * 6144 * 4);
constexpr size_t WS_ROWTOK = al256(WS_CNT + L * 32 * 4);
constexpr size_t WS_ROWW = al256(WS_ROWTOK + (size_t)L * RMAX * 4);
constexpr size_t WS_TOKE = al256(WS_ROWW + (size_t)L * RMAX * 4);
constexpr size_t WS_TOKW = al256(WS_TOKE + (size_t)T * 4 * 4);
constexpr size_t WS_POS = al256(WS_TOKW + (size_t)T * 4 * 4);
constexpr size_t WS_Y = al256(WS_POS + (size_t)T * 4 * 4);
constexpr size_t WS_WINT = al256(WS_Y + (size_t)RMAX * 1024 * 4);
constexpr size_t WS_WOT = al256(WS_WINT + (size_t)L * 3072 * 1024 * 2);
constexpr size_t WS_W1T = al256(WS_WOT + (size_t)L * 1024 * 1024 * 2);
constexpr size_t WS_W2T = al256(WS_W1T + (size_t)L * NE * 2048 * 1024 * 2);
constexpr size_t WS_XN = al256(WS_W2T + (size_t)L * NE * 1024 * 1024 * 2);
constexpr size_t WS_ATTB = al256(WS_XN + (size_t)(T + 1) * D * 2);
constexpr size_t WS_ACT = al256(WS_ATTB + (size_t)T * D * 2);
constexpr size_t WS_ZB = al256(WS_ACT + (size_t)RMAX * DFF * 2);
constexpr size_t WS_GATE = al256(WS_ZB + (size_t)T * ZBW * 2);
constexpr size_t WS_KCB = al256(WS_GATE + (size_t)T * 32 * 4);
constexpr size_t WS_VCB = al256(WS_KCB + (size_t)Bn * 2 * 512 * 64 * 2);
constexpr size_t WS_KMB = al256(WS_VCB + (size_t)Bn * 2 * 512 * 64 * 2);
constexpr size_t WS_XNLO = al256(WS_KMB + (size_t)Bn * 8 * 32 * 64 * 2);
constexpr size_t WS_BC = al256(WS_XNLO + (size_t)T * D * 2);
constexpr size_t WS_WCT = al256(WS_BC + (size_t)(T / 64) * 32 * 4);
constexpr size_t WS_CBP = al256(WS_WCT + (size_t)L * 2 * 128 * 2048 * 2);
constexpr size_t WS_CB = al256(WS_CBP + (size_t)16 * L * 2 * 128 * 4);
constexpr size_t WS_HIDP = al256(WS_CB + (size_t)L * 2 * 128 * 4);
constexpr size_t WS_XAB = al256(WS_HIDP + (size_t)4 * 2 * 2044 * 128 * 4);
constexpr size_t WS_SEL3 = al256(WS_XAB + (size_t)T * D * 2);
constexpr size_t WS_LRK = al256(WS_SEL3 + (size_t)T * 8 * 4);
constexpr size_t WS_ILIST = al256(WS_LRK + (size_t)T * 8 * 4);
constexpr size_t WS_BCM = al256(WS_ILIST + (size_t)16 * 32 * 32 * 256);
constexpr size_t WS_PM = al256(WS_BCM + (size_t)16 * 32 * 32 * 4);
constexpr size_t WS_PL = al256(WS_PM + (size_t)16 * 25600 * 4);
constexpr size_t WS_PO = al256(WS_PL + (size_t)16 * 25600 * 4);
constexpr size_t WS_END = al256(WS_PO + (size_t)16 * 25600 * 64 * 2);

struct Params {
    const float* in[21];
    float* out;
    unsigned char* ws;
};

__device__ __forceinline__ int otid() { int t = threadIdx.x; asm volatile("" : "+v"(t)); return t; }
typedef unsigned short bf16_t;
__device__ __forceinline__ unsigned f2bf(float f) { unsigned u = __builtin_bit_cast(unsigned, f); return (u + 0x7fffu + ((u >> 16) & 1u)) >> 16; }
__device__ __forceinline__ unsigned pk2(float lo, float hi) { return f2bf(lo) | (f2bf(hi) << 16); }
__device__ __forceinline__ float bf2f(bf16_t v) { return __builtin_bit_cast(float, (unsigned)v << 16); }
__device__ __forceinline__ float wave_sum(float v) {
#pragma unroll
    for (int o = 1; o < 64; o <<= 1) v += __shfl_xor(v, o);
    return v;
}
__device__ __forceinline__ float sigmoidf_(float x) { return 1.f / (1.f + __expf(-x)); }
__device__ __forceinline__ float gelu_tanh(float x) {
    const float u = 0.7978845608028654f * (x + 0.044715f * x * x * x);
    return 0.5f * x * (1.f + tanhf(u));
}

__device__ __forceinline__ void phase_p0a(const Params& p, float* lds) {
    const int tid = otid(), gtid = blockIdx.x * NT + tid, gsz = gridDim.x * NT;
    int* cnt = (int*)(p.ws + WS_CNT); int* rowtok = (int*)(p.ws + WS_ROWTOK);
    for (int i = gtid; i < L * 32; i += gsz) cnt[i] = 0;
    for (int i = gtid; i < L * RMAX; i += gsz) rowtok[i] = -1;
    const float* c = p.in[1];
    for (int i = tid; i < Bn * D; i += NT) { const float v = c[i]; lds[i] = v / (1.f + __expf(-v)); }
    __syncthreads();
    const float* ada_w = p.in[2];
    float* modp = (float*)(p.ws + WS_MODP);
    for (int idx = gtid; idx < 8 * L * 6144; idx += gsz) {
        const int col = idx % 6144, l = (idx / 6144) % L, kc = idx / (6144 * L);
        const float* w = ada_w + ((size_t)l * D + kc * 128) * 6144 + col;
        float a0 = 0.f, a1 = 0.f, c0 = 0.f, c1 = 0.f;
#pragma unroll 1
        for (int k0 = 0; k0 < 128; k0 += 32) { float wv[32];
#pragma unroll
            for (int k = 0; k < 32; ++k) wv[k] = __builtin_nontemporal_load(w + (size_t)(k0 + k) * 6144);
#pragma unroll
            for (int k = 0; k < 32; k += 2) { a0 += lds[kc * 128 + k0 + k] * wv[k]; a1 += lds[D + kc * 128 + k0 + k] * wv[k]; c0 += lds[kc * 128 + k0 + k + 1] * wv[k + 1]; c1 += lds[D + kc * 128 + k0 + k + 1] * wv[k + 1]; } }
        modp[((size_t)(kc * L + l) * Bn + 0) * 6144 + col] = a0 + c0;
        modp[((size_t)(kc * L + l) * Bn + 1) * 6144 + col] = a1 + c1;
    }
    { const float* posw = p.in[9]; const float* w1c = p.in[10]; float* cbp = (float*)(p.ws + WS_CBP);
      int first = 8 * L * 6144; if (first + 16 * L * 2 * 128 > gsz) first = 0;
      for (int idx = gtid - first; idx < 16 * L * 2 * 128; idx += gsz) { if (idx < 0) continue;
          const int j = idx & 127, li = (idx >> 7) % (L * 2), kc = idx / (L * 2 * 128);
          const float* w = w1c + ((size_t)li * 2048 + kc * 128) * 128 + j; const float* pp = posw + (size_t)li * 2048 + kc * 128;
          float a = 0.f, c_ = 0.f;
#pragma unroll 1
          for (int k0 = 0; k0 < 128; k0 += 32) { float wv[32];
#pragma unroll
              for (int k = 0; k < 32; ++k) wv[k] = w[(size_t)(k0 + k) * 128];
#pragma unroll
              for (int k = 0; k < 32; k += 2) { a += pp[k0 + k] * wv[k]; c_ += pp[k0 + k + 1] * wv[k + 1]; } }
          cbp[idx] = a + c_; } }
}
__device__ __forceinline__ void phase_p0b(const Params& p) {
    const int gtid = blockIdx.x * NT + otid(), gsz = gridDim.x * NT;
    { const float* cbp = (const float*)(p.ws + WS_CBP); float* cb = (float*)(p.ws + WS_CB);
      for (int idx = gtid; idx < L * 2 * 128; idx += gsz) { float s = 0.f;
#pragma unroll
          for (int kc = 0; kc < 16; ++kc) s += cbp[kc * (L * 2 * 128) + idx];
          cb[idx] = s; } }
    const float* modp = (const float*)(p.ws + WS_MODP); float* mod = (float*)(p.ws + WS_MOD); const float* ada_b = p.in[3];
    for (int idx = gtid; idx < L * Bn * 6144; idx += gsz) {
        const int col = idx % 6144, l = idx / (Bn * 6144);
        float s = ada_b[l * 6144 + col];
#pragma unroll
        for (int kc = 0; kc < 8; ++kc) s += modp[(size_t)kc * L * Bn * 6144 + idx];
        mod[idx] = s;
    }
}

__device__ __forceinline__ void phase_r1(const Params& p, int l, bool do_h) {
    const int lane = otid() & 63, wave = otid() >> 6;
    const int gw = blockIdx.x * NW + wave, ngw = gridDim.x * NW;
    const float* mod = (const float*)(p.ws + WS_MOD);
    const float* xin = p.in[0]; float* XA = p.out;
    const bf16_t* Y = (const bf16_t*)(p.ws + WS_Y); const int* pos = (const int*)(p.ws + WS_POS); const float* tokw = (const float*)(p.ws + WS_TOKW);
    const float* lng = p.in[4] + (size_t)(do_h ? l : 0) * D;
    bf16_t* XN = (bf16_t*)(p.ws + WS_XN); bf16_t* XAB = (bf16_t*)(p.ws + WS_XAB);
#define BF4(q) make_float4(__builtin_bit_cast(float, (q).x << 16), __builtin_bit_cast(float, (q).x & 0xffff0000u), __builtin_bit_cast(float, (q).y << 16), __builtin_bit_cast(float, (q).y & 0xffff0000u))
    int curb = -1; float4 g2v[4], ga[4], s0v[4];
    for (int t0 = gw; t0 < T; t0 += ngw) {
        const int nr = 1;
        float4 v[2][4];
        if (l == 0) {
#pragma unroll
            for (int i = 0; i < 2; ++i) if (i < nr) {
#pragma unroll
                for (int j = 0; j < 4; ++j) v[i][j] = *(const float4*)(xin + (size_t)(t0 + i * ngw) * D + 4 * lane + 256 * j); }
        } else {
            int4 ps[2]; float4 tw[2]; uint2 xq[2][4];
#pragma unroll
            for (int i = 0; i < 2; ++i) if (i < nr) { const int t = t0 + i * ngw; ps[i] = *(const int4*)(pos + (size_t)t * 4); tw[i] = *(const float4*)(tokw + (size_t)t * 4);
#pragma unroll
                for (int j = 0; j < 4; ++j) xq[i][j] = *(const uint2*)(XAB + (size_t)t * D + 4 * lane + 256 * j); }
            uint2 yq[2][4][4];
#pragma unroll
            for (int i = 0; i < 2; ++i) if (i < nr) {
#pragma unroll
                for (int j = 0; j < 4; ++j) { const int col = 4 * lane + 256 * j;
                    yq[i][j][0] = *(const uint2*)(Y + (size_t)ps[i].x * D + col); yq[i][j][1] = *(const uint2*)(Y + (size_t)ps[i].y * D + col);
                    yq[i][j][2] = *(const uint2*)(Y + (size_t)ps[i].z * D + col); yq[i][j][3] = *(const uint2*)(Y + (size_t)ps[i].w * D + col); } }
#pragma unroll
            for (int i = 0; i < 2; ++i) if (i < nr) {
                const int t = t0 + i * ngw, b = t / S;
                if (b != curb) { curb = b;
                    const float* g2 = mod + ((size_t)(l - 1) * Bn + b) * 6144 + 5 * D;
#pragma unroll
                    for (int j = 0; j < 4; ++j) g2v[j] = *(const float4*)(g2 + 4 * lane + 256 * j);
                    if (do_h) { const float* sh = mod + ((size_t)l * Bn + b) * 6144 + 0 * D; const float* sc = mod + ((size_t)l * Bn + b) * 6144 + 1 * D;
#pragma unroll
                        for (int j = 0; j < 4; ++j) { const int col = 4 * lane + 256 * j; const float4 g = *(const float4*)(lng + col), s1 = *(const float4*)(sc + col); s0v[j] = *(const float4*)(sh + col);
                            ga[j] = make_float4(g.x * (1.f + s1.x), g.y * (1.f + s1.y), g.z * (1.f + s1.z), g.w * (1.f + s1.w)); } } }
#pragma unroll
                for (int j = 0; j < 4; ++j) {
                    const int col = 4 * lane + 256 * j;
                    const float4 x = BF4(xq[i][j]);
                    const float4 y0 = BF4(yq[i][j][0]), y1 = BF4(yq[i][j][1]), y2 = BF4(yq[i][j][2]), y3 = BF4(yq[i][j][3]);
                    const float4 g = g2v[j];
                    float4 r;
                    r.x = x.x + g.x * (((tw[i].x * y0.x + tw[i].y * y1.x) + tw[i].z * y2.x) + tw[i].w * y3.x); r.y = x.y + g.y * (((tw[i].x * y0.y + tw[i].y * y1.y) + tw[i].z * y2.y) + tw[i].w * y3.y);
                    r.z = x.z + g.z * (((tw[i].x * y0.z + tw[i].y * y1.z) + tw[i].z * y2.z) + tw[i].w * y3.z); r.w = x.w + g.w * (((tw[i].x * y0.w + tw[i].y * y1.w) + tw[i].z * y2.w) + tw[i].w * y3.w);
                    v[i][j] = r;
                    if (do_h) *(uint2*)(XAB + (size_t)t * D + col) = make_uint2(pk2(r.x, r.y), pk2(r.z, r.w));
                    else *(float4*)(XA + (size_t)t * D + col) = r;
                }
            }
        }
        if (do_h) {
#pragma unroll
            for (int i = 0; i < 2; ++i) if (i < nr) {
                const int t = t0 + i * ngw, b = t / S;
                if (b != curb) { curb = b;
                    const float* sh = mod + ((size_t)l * Bn + b) * 6144 + 0 * D; const float* sc = mod + ((size_t)l * Bn + b) * 6144 + 1 * D;
#pragma unroll
                    for (int j = 0; j < 4; ++j) { const int col = 4 * lane + 256 * j; const float4 g = *(const float4*)(lng + col), s1 = *(const float4*)(sc + col); s0v[j] = *(const float4*)(sh + col);
                        ga[j] = make_float4(g.x * (1.f + s1.x), g.y * (1.f + s1.y), g.z * (1.f + s1.z), g.w * (1.f + s1.w)); } }
                float ss = 0.f;
#pragma unroll
                for (int j = 0; j < 4; ++j) ss += (v[i][j].x * v[i][j].x + v[i][j].y * v[i][j].y) + (v[i][j].z * v[i][j].z + v[i][j].w * v[i][j].w);
                ss = wave_sum(ss);
                const float r = rsqrtf(ss * (1.f / D) + EPS);
#pragma unroll
                for (int j = 0; j < 4; ++j) {
                    const int col = 4 * lane + 256 * j;
                    float4 o;
                    o.x = v[i][j].x * r * ga[j].x + s0v[j].x; o.y = v[i][j].y * r * ga[j].y + s0v[j].y;
                    o.z = v[i][j].z * r * ga[j].z + s0v[j].z; o.w = v[i][j].w * r * ga[j].w + s0v[j].w;
                    *(uint2*)(XN + (size_t)t * D + col) = make_uint2(pk2(o.x, o.y), pk2(o.z, o.w));
                }
            }
        }
    }
#undef BF4
}


__device__ __forceinline__ void phase_c2(const Params& p, int l, float* lds) {
    const int lane = otid() & 63, wave = otid() >> 6;
    const float* HIDP = (const float*)(p.ws + WS_HIDP); const float* cb = (const float*)(p.ws + WS_CB) + l * 2 * 128; const float* w2 = p.in[11] + (size_t)l * 2 * 128 * 64;
    const float gk = p.in[8][l * 64 + lane];
    float* hl = lds + wave * 128;
    for (int r = blockIdx.x * NW + wave; r < 2 * 2044; r += gridDim.x * NW) {
        const int idx = r / 2044, rr = r % 2044;
#pragma unroll
        for (int q = 0; q < 2; ++q) { const int j = lane + 64 * q; float s = cb[idx * 128 + j];
#pragma unroll
            for (int kq = 0; kq < 4; ++kq) s += HIDP[((size_t)(kq * 2 + idx) * 2044 + rr) * 128 + j];
            hl[j] = gelu_tanh(s); }
        asm volatile("s_waitcnt lgkmcnt(0)" ::: "memory"); __builtin_amdgcn_wave_barrier();
        const float* W = w2 + (size_t)idx * 128 * 64;
        float s = 0.f;
#pragma unroll 8
        for (int j = 0; j < 128; ++j) s += hl[j] * W[j * 64 + lane];
        asm volatile("s_waitcnt lgkmcnt(0)" ::: "memory"); __builtin_amdgcn_wave_barrier();
        const int bgi = rr / 511, n = rr % 511;
        if (idx == 0) { const float ss = wave_sum(s * s); const float kv = s * rsqrtf(ss * (1.f / 64.f) + EPS) * gk; ((bf16_t*)(p.ws + WS_KCB))[((size_t)bgi * 512 + n) * 64 + lane] = (bf16_t)f2bf(kv); }
        else { ((bf16_t*)(p.ws + WS_VCB))[((size_t)bgi * 512 + n) * 64 + lane] = (bf16_t)f2bf(s); }
    }
    if (blockIdx.x == 0 && otid() < 2 * 4 * 64) { const int i = otid(); bf16_t* dst = (bf16_t*)(p.ws + (i < 256 ? WS_KCB : WS_VCB)); dst[((size_t)((i & 255) >> 6) * 512 + 511) * 64 + (i & 63)] = 0; }
}

__device__ __forceinline__ void load_pstart(const Params& p, int l, int* ps) {
    const int* cnt = (const int*)(p.ws + WS_CNT) + l * 32;
    if (otid() == 0) { int s = 0; for (int e = 0; e < 32; ++e) { ps[e] = s; s += (cnt[e] + 255) & ~255; } ps[32] = s; }
    __syncthreads();
}


template <int MAP>
__device__ __forceinline__ void tr_tile(const float* W, int Nsrc, bf16_t* WT, int K, int k0, int n0, float* scr, int lane) {
    const int nl = (lane & 15) * 4, kr = lane >> 4;
    int sc = n0 + nl;
    if (MAP == 1) { sc = sc < 1280 ? sc : (sc < 2816 ? sc + 24 : (sc < 2840 ? sc - 2816 + 1280 : -1)); }
    float4 v[16];
#pragma unroll
    for (int it = 0; it < 16; ++it) { if (sc >= 0) { const float* src_ = W + (size_t)(k0 + it * 4 + kr) * Nsrc + sc; typedef float f4v __attribute__((ext_vector_type(4))); const f4v t_ = __builtin_nontemporal_load((const f4v*)src_); v[it] = make_float4(t_[0], t_[1], t_[2], t_[3]); } else v[it] = make_float4(0.f, 0.f, 0.f, 0.f); }
#pragma unroll
    for (int it = 0; it < 16; ++it) { float* s = scr + (it * 4 + kr) * 65 + nl; s[0] = v[it].x; s[1] = v[it].y; s[2] = v[it].z; s[3] = v[it].w; }
    asm volatile("s_waitcnt lgkmcnt(0)" ::: "memory"); __builtin_amdgcn_wave_barrier();
    const int c = lane & 7, nr = lane >> 3;
#pragma unroll
    for (int it = 0; it < 8; ++it) {
        const int n = it * 8 + nr; const float* s = scr + (8 * c) * 65 + n;
        uint4 o; o.x = pk2(s[0], s[65]); o.y = pk2(s[2 * 65], s[3 * 65]); o.z = pk2(s[4 * 65], s[5 * 65]); o.w = pk2(s[6 * 65], s[7 * 65]);
        *(uint4*)(WT + (size_t)(n0 + n) * K + k0 + 8 * c) = o;
    }
    asm volatile("s_waitcnt lgkmcnt(0)" ::: "memory"); __builtin_amdgcn_wave_barrier();
}
__device__ __forceinline__ void phase_convert(const Params& p, float* lds) {
    const int tid = otid(), lane = tid & 63, wave = tid >> 6;
    float* scr = lds + wave * (64 * 65);
    const int gw = blockIdx.x * NW + wave, ngw = gridDim.x * NW;
    bf16_t* WinT = (bf16_t*)(p.ws + WS_WINT); bf16_t* WoT = (bf16_t*)(p.ws + WS_WOT); bf16_t* W1T = (bf16_t*)(p.ws + WS_W1T); bf16_t* W2T = (bf16_t*)(p.ws + WS_W2T);
    constexpr int I_IN = L * 16 * (ZBW / 64), I_O = L * 16 * 16, I_1 = L * NE * 16 * 32, I_2 = L * NE * 16 * 16, I_C = L * 2 * 32 * 2;
    for (int it = gw; it < I_C + I_IN + I_O + I_1 + I_2; it += ngw) {
        int r = it;
        if (r < I_C) { const int li = r / 64, q = r % 64, kb = q / 2, nb = q % 2;
            tr_tile<0>(p.in[10] + (size_t)li * 2048 * 128, 128, (bf16_t*)(p.ws + WS_WCT) + (size_t)li * 128 * 2048, 2048, kb * 64, nb * 64, scr, lane); continue; }
        r -= I_C;
        if (r < I_IN) { const int l = r / (16 * 48), q = r % (16 * 48), kb = q / 48, nb = q % 48;
            tr_tile<1>(p.in[6] + (size_t)l * D * INW, INW, WinT + (size_t)l * ZBW * D, D, kb * 64, nb * 64, scr, lane); continue; }
        r -= I_IN;
        if (r < I_O) { const int l = r / 256, q = r % 256, kb = q / 16, nb = q % 16;
            tr_tile<0>(p.in[14] + (size_t)l * D * D, D, WoT + (size_t)l * D * D, D, kb * 64, nb * 64, scr, lane); continue; }
        r -= I_O;
        if (r < I_1) { const int le = r / 512, q = r % 512, kb = q / 32, nb = q % 32;
            tr_tile<0>(p.in[17] + (size_t)le * D * 2048, 2048, W1T + (size_t)le * 2048 * D, D, kb * 64, nb * 64, scr, lane); continue; }
        r -= I_1;
        { const int le = r / 256, q = r % 256, kb = q / 16, nb = q % 16;
            tr_tile<0>(p.in[19] + (size_t)le * DFF * D, D, W2T + (size_t)le * D * DFF, DFF, kb * 64, nb * 64, scr, lane); }
    }
    if (blockIdx.x == 0) { bf16_t* XN = (bf16_t*)(p.ws + WS_XN); for (int i = tid; i < D / 2; i += NT) ((unsigned*)(XN + (size_t)T * D))[i] = 0u; }
}

namespace pg8 {
#define PG8_LAS __attribute__((address_space(3)))
typedef short bf16x8 __attribute__((ext_vector_type(8)));
typedef float f32x4 __attribute__((ext_vector_type(4)));
typedef unsigned u32x4 __attribute__((ext_vector_type(4)));
constexpr int BM = 256, BK = 64, HALF = 128, HTB = HALF * BK * 2, STAGE_BYTES = 8 * HTB, NXCD = 8, WGM = 8;
__device__ __forceinline__ int lds_byte(int r, int c) { const int st = (r >> 4) * 2 + (c >> 5), rr = r & 15, cc = c & 31, ob = rr * 64 + cc * 2; return st * 1024 + (ob ^ (((ob >> 9) & 1) << 5)); }
__device__ __forceinline__ void stage_rc(int b, int& R, int& C) { const int st = b / 1024, sb = b % 1024, swz = sb ^ (((sb >> 9) & 1) << 5); R = (st >> 1) * 16 + swz / 64; C = (st & 1) * 32 + (swz % 64) / 2; }
__device__ __forceinline__ int perm32(int rho) { const int n = rho >> 4, i = rho & 15; return 8 * (i >> 2) + 4 * n + (i & 3); }
struct Unit { int pm, pn, e; };
__device__ __forceinline__ unsigned cvt_pk_bf16(float lo, float hi) { unsigned r; asm volatile("v_cvt_pk_bf16_f32 %0, %1, %2" : "=v"(r) : "v"(lo), "v"(hi)); return r; }

__device__ __forceinline__ bool static_next(int nM, int nN, int G, int c, int i, Unit& u) {
    const int nwg = nM * nN; const long Lq = (long)i * G + c; if (Lq >= nwg) return false;
    int wgid = (int)Lq; { const int q = nwg / NXCD, r = nwg % NXCD, xcd = wgid % NXCD, off = wgid / NXCD; wgid = (xcd < r ? xcd * (q + 1) : r * (q + 1) + (xcd - r) * q) + off; }
    const int nig = WGM * nN, gid = wgid / nig, fm = gid * WGM, gsz = (nM - fm) < WGM ? (nM - fm) : WGM;
    u.pm = fm + ((wgid % nig) % gsz); u.pn = (wgid % nig) / gsz; u.e = 0; return true;
}

template <class Prob, class Epi, bool ALIGN_EPI, bool SP2>
__device__ __forceinline__ void gemm_phase(PG8_LAS unsigned char* lds, const Prob& P, const Epi& E) {
    const int tid = otid(), wid = __builtin_amdgcn_readfirstlane(tid >> 6), lane = tid & 63, wr = wid >> 2, wc = wid & 3, fr = lane & 15, fq = lane >> 4;
    const int K = P.K, nt = Prob::KT > 0 ? Prob::KT : K / BK;
    int sR[2], sC[2]; unsigned voffB[2];
#pragma unroll
    for (int i = 0; i < 2; ++i) { stage_rc(tid * 16 + i * 8192, sR[i], sC[i]); voffB[i] = (unsigned)(P.b_row(sR[i]) * K + sC[i]) * 2u; }
    const size_t kstep = (size_t)(BK * 2);
    const size_t kstepA = P.a_kstep();
    const size_t hstepB = P.b_hstep();
    const unsigned ldsw = (unsigned)wid * 1024u;
    const int aoff = lds_byte(wr * 64 + fr, fq * 8), boff = lds_byte(wc * 32 + fr, fq * 8);
#define PG8_SA(b, h) (((b) * 2 + (h)) * HTB)
#define PG8_SB(b, h) ((4 + (b) * 2 + (h)) * HTB)
#define PG8_STAGE(bufoff, gbase, voff) do { _Pragma("unroll") for (int _i = 0; _i < 2; ++_i) \
        __builtin_amdgcn_global_load_lds((const unsigned*)((const char*)(gbase) + (voff)[_i]), (PG8_LAS unsigned*)(lds + (bufoff) + ldsw + _i * 8192), 16, 0, 0); } while (0)
#define PG8_STAGE_SEL(bufoff, gbase, h) do { _Pragma("unroll") for (int _i = 0; _i < 2; ++_i) { unsigned _vo = vAc[h][_i]; if constexpr (Prob::GATHER) _vo = last ? vAn[h][_i] : _vo; \
        __builtin_amdgcn_global_load_lds((const unsigned*)((const char*)(gbase) + _vo), (PG8_LAS unsigned*)(lds + (bufoff) + ldsw + _i * 8192), 16, 0, 0); } } while (0)
#define PG8_LDA(dst, b, h) do { _Pragma("unroll") for (int m = 0; m < 4; ++m) _Pragma("unroll") for (int k = 0; k < 2; ++k) dst[m][k] = *(const PG8_LAS bf16x8*)(lds + PG8_SA(b, h) + aoff + m * 2048 + k * 1024); } while (0)
#define PG8_LDB(dst, b, h) do { _Pragma("unroll") for (int n = 0; n < 2; ++n) _Pragma("unroll") for (int k = 0; k < 2; ++k) dst[n][k] = *(const PG8_LAS bf16x8*)(lds + PG8_SB(b, h) + boff + n * 2048 + k * 1024); } while (0)
#define PG8_MMA(ai, bj, At, Bt) do { __builtin_amdgcn_s_setprio(1); _Pragma("unroll") for (int m = 0; m < 4; ++m) _Pragma("unroll") for (int n = 0; n < 2; ++n) _Pragma("unroll") for (int k = 0; k < 2; ++k) \
        acc[ai][bj][m][n] = __builtin_amdgcn_mfma_f32_16x16x32_bf16(Bt[n][k], At[m][k], acc[ai][bj][m][n], 0, 0, 0); __builtin_amdgcn_s_setprio(0); } while (0)
#define PG8_WAIT_V(n) asm volatile("s_waitcnt vmcnt(" #n ")" ::: "memory")
#define PG8_WAIT_L(n) asm volatile("s_waitcnt lgkmcnt(" #n ")" ::: "memory")
#define PG8_BAR __builtin_amdgcn_s_barrier()
#define PG8_SCHED __builtin_amdgcn_sched_barrier(0)
    Unit cur, nxt; int ui = 0;
    if (!P.next(0, cur)) return;
    nxt = cur;
    f32x4 acc[2][2][4][2];
    typename Epi::Pre pre;
    E.prefetch(cur, wc, fq, pre); E.init(acc, pre);
    bf16x8 At[4][2], B0[2][2], B1[2][2];
    unsigned vAc[2][2], vAn[2][2];
    const char* cA = P.a_base(cur); const char* cB = P.b_base(cur);
    P.a_voff(cur, sR, sC, vAc);
#pragma unroll
    for (int h = 0; h < 2; ++h)
#pragma unroll
        for (int i = 0; i < 2; ++i) vAn[h][i] = vAc[h][i];
    if constexpr (SP2) {
        PG8_STAGE(PG8_SB(0, 0), cB, voffB); PG8_STAGE(PG8_SB(0, 1), cB + hstepB, voffB); PG8_STAGE(PG8_SA(0, 0), cA, vAc[0]); PG8_STAGE(PG8_SA(0, 1), cA, vAc[1]);
        if (wr == 1) PG8_BAR;
        PG8_WAIT_V(2); PG8_BAR;
        PG8_STAGE(PG8_SB(1, 0), cB + kstep, voffB); PG8_STAGE(PG8_SA(1, 0), cA + kstepA, vAc[0]); PG8_STAGE(PG8_SB(1, 1), cB + hstepB + kstep, voffB);
        PG8_WAIT_V(6); PG8_BAR;
    } else {
        PG8_STAGE(PG8_SB(0, 0), cB, voffB); PG8_STAGE(PG8_SA(0, 0), cA, vAc[0]); PG8_STAGE(PG8_SB(0, 1), cB + hstepB, voffB); PG8_STAGE(PG8_SA(0, 1), cA, vAc[1]);
        if (wr == 1) PG8_BAR;
        PG8_WAIT_V(4); PG8_BAR;
        PG8_STAGE(PG8_SB(1, 0), cB + kstep, voffB); PG8_STAGE(PG8_SA(1, 0), cA + kstepA, vAc[0]); PG8_STAGE(PG8_SB(1, 1), cB + hstepB + kstep, voffB);
        PG8_WAIT_V(6); PG8_BAR;
    }
    for (;;) {
        const bool has_next = P.next(ui + 1, nxt);
        const char* nA = cA; const char* nB = cB;
        if (has_next) { nA = P.a_base(nxt); nB = P.b_base(nxt); if constexpr (Prob::GATHER) P.a_voff(nxt, sR, sC, vAn); }
        for (int t = 0; t < nt; t += 2) {
            const bool last = (t == nt - 2);
            const char* a1 = cA + (size_t)(t + 1) * kstepA;
            const char* a2 = last ? nA : cA + (size_t)(t + 2) * kstepA; const char* b2 = last ? nB : cB + (size_t)(t + 2) * kstep;
            const char* a3 = a2 + kstepA; const char* b3 = b2 + kstep;
            if constexpr (SP2) {
            PG8_LDB(B0, 0, 0); PG8_LDB(B1, 0, 1); PG8_SCHED; PG8_LDA(At, 0, 0); PG8_STAGE(PG8_SA(1, 1), a1, vAc[1]);
            PG8_WAIT_V(8); PG8_WAIT_L(0); PG8_BAR; PG8_MMA(0, 0, At, B0); PG8_MMA(0, 1, At, B1); PG8_BAR; PG8_SCHED;
            PG8_LDA(At, 0, 1); PG8_STAGE(PG8_SB(0, 0), b2, voffB); PG8_STAGE(PG8_SB(0, 1), b2 + hstepB, voffB); PG8_STAGE_SEL(PG8_SA(0, 0), a2, 0);
            PG8_WAIT_V(8); PG8_WAIT_L(0); PG8_BAR; PG8_MMA(1, 0, At, B0); PG8_MMA(1, 1, At, B1); PG8_BAR; PG8_SCHED;
            PG8_LDB(B0, 1, 0); PG8_LDB(B1, 1, 1); PG8_SCHED; PG8_LDA(At, 1, 0); PG8_STAGE_SEL(PG8_SA(0, 1), a2, 1);
            PG8_WAIT_V(8); PG8_WAIT_L(0); PG8_BAR; PG8_MMA(0, 0, At, B0); PG8_MMA(0, 1, At, B1); PG8_BAR; PG8_SCHED;
            PG8_LDA(At, 1, 1); PG8_STAGE(PG8_SB(1, 0), b3, voffB); PG8_STAGE(PG8_SB(1, 1), b3 + hstepB, voffB); PG8_STAGE_SEL(PG8_SA(1, 0), a3, 0);
            PG8_WAIT_V(8); PG8_WAIT_L(0); PG8_BAR; PG8_MMA(1, 0, At, B0); PG8_MMA(1, 1, At, B1); PG8_BAR; PG8_SCHED;
            } else {
            PG8_LDB(B0, 0, 0); PG8_SCHED; PG8_LDA(At, 0, 0); PG8_STAGE(PG8_SA(1, 1), a1, vAc[1]);
            PG8_WAIT_L(8); PG8_BAR; PG8_WAIT_L(0); PG8_MMA(0, 0, At, B0); PG8_BAR; PG8_SCHED;
            PG8_LDB(B1, 0, 1); PG8_STAGE(PG8_SB(0, 0), b2, voffB);
            PG8_BAR; PG8_WAIT_L(0); PG8_MMA(0, 1, At, B1); PG8_BAR;
            PG8_LDA(At, 0, 1); PG8_STAGE_SEL(PG8_SA(0, 0), a2, 0);
            PG8_BAR; PG8_WAIT_L(0); PG8_MMA(1, 0, At, B0); PG8_BAR; PG8_SCHED;
            PG8_STAGE(PG8_SB(0, 1), b2 + hstepB, voffB);
            PG8_WAIT_V(6); PG8_BAR; PG8_MMA(1, 1, At, B1); PG8_BAR;
            PG8_LDB(B0, 1, 0); PG8_SCHED; PG8_LDA(At, 1, 0); PG8_STAGE_SEL(PG8_SA(0, 1), a2, 1);
            PG8_WAIT_L(8); PG8_BAR; PG8_WAIT_L(0); PG8_MMA(0, 0, At, B0); PG8_BAR; PG8_SCHED;
            PG8_LDB(B1, 1, 1); PG8_STAGE(PG8_SB(1, 0), b3, voffB);
            PG8_BAR; PG8_WAIT_L(0); PG8_MMA(0, 1, At, B1); PG8_BAR;
            PG8_LDA(At, 1, 1); PG8_STAGE_SEL(PG8_SA(1, 0), a3, 0);
            PG8_BAR; PG8_WAIT_L(0); PG8_MMA(1, 0, At, B0); PG8_BAR; PG8_SCHED;
            PG8_STAGE(PG8_SB(1, 1), b3 + hstepB, voffB);
            PG8_WAIT_V(6); PG8_BAR; PG8_MMA(1, 1, At, B1); PG8_BAR;
            }
        }
        if constexpr (ALIGN_EPI) { if (wr == 0) PG8_BAR; }
        E(acc, cur, wr, wc, fr, fq, has_next, nxt, pre);
        if (!has_next) break;
        E.init(acc, pre);
        cur = nxt; cA = nA; cB = nB; ++ui;
        if constexpr (Prob::GATHER) {
#pragma unroll
            for (int h = 0; h < 2; ++h)
#pragma unroll
                for (int i = 0; i < 2; ++i) vAc[h][i] = vAn[h][i];
        }
        if constexpr (ALIGN_EPI) { if (wr == 1) PG8_BAR; }
    }
    PG8_WAIT_V(0);
    if constexpr (!ALIGN_EPI) { if (wr == 0) PG8_BAR; }
    PG8_BAR;
#undef PG8_SA
#undef PG8_SB
#undef PG8_STAGE
#undef PG8_STAGE_SEL
#undef PG8_LDA
#undef PG8_LDB
#undef PG8_MMA
#undef PG8_WAIT_V
#undef PG8_WAIT_L
#undef PG8_BAR
#undef PG8_SCHED
}

struct ProbDense { static constexpr bool GATHER = false; static constexpr int KT = 0;
    const bf16_t* A; const bf16_t* Bt; int K, nM, nN, G, c; bool headperm;
    __device__ __forceinline__ bool next(int i, Unit& u) const { return static_next(nM, nN, G, c, i, u); }
    __device__ __forceinline__ const char* a_base(const Unit& u) const { return (const char*)(A + (size_t)u.pm * BM * K); }
    __device__ __forceinline__ void a_voff(const Unit&, const int (&R)[2], const int (&C)[2], unsigned (&v)[2][2]) const {
#pragma unroll
        for (int h = 0; h < 2; ++h)
#pragma unroll
            for (int i = 0; i < 2; ++i) v[h][i] = (unsigned)((h * HALF + R[i]) * K + C[i]) * 2u;
    }
    __device__ __forceinline__ const char* b_base(const Unit& u) const { return (const char*)(Bt + (size_t)u.pn * BM * K); }
    __device__ __forceinline__ size_t a_kstep() const { return (size_t)BK * 2; }
    __device__ __forceinline__ size_t b_hstep() const { return headperm ? (size_t)32 * K * 2 : (size_t)HALF * K * 2; }
    __device__ __forceinline__ int b_row(int R) const { return headperm ? ((R >> 5) * 64 + perm32(R & 31)) : ((R & ~31) + perm32(R & 31)); }
};
typedef const PG8_LAS int* lds_ints;
__device__ __forceinline__ int expert_of(lds_ints ps, int pm) { int e = 0;
#pragma unroll
    for (int i = 1; i < 32; ++i) if (ps[i] <= pm * 256) e = i;
    return __builtin_amdgcn_readfirstlane(e); }
struct ProbMoe1 { static constexpr bool GATHER = true; static constexpr int KT = 0;
    const bf16_t* XN; const bf16_t* W1T; const int* rowtok; lds_ints ps; int K, ntm, G, c;
    __device__ __forceinline__ bool next(int i, Unit& u) const {
        if (G != 256) { const int q = i * G + c; if (q >= ntm * 8) return false; u.pm = q >> 3; u.pn = q & 7; u.e = expert_of(ps, u.pm); return true; }
        const int x = c & 7, s = c >> 3; const int pm = 4 * (i * 8 + x) + (s >> 3); if (pm >= ntm) return false;
        u.pm = pm; u.pn = s & 7; u.e = expert_of(ps, u.pm); return true; }
    __device__ __forceinline__ const char* a_base(const Unit&) const { return (const char*)XN; }
    __device__ __forceinline__ void a_voff(const Unit& u, const int (&R)[2], const int (&C)[2], unsigned (&v)[2][2]) const {
#pragma unroll
        for (int h = 0; h < 2; ++h)
#pragma unroll
            for (int i = 0; i < 2; ++i) { int tk = rowtok[u.pm * BM + h * HALF + R[i]]; if (tk < 0) tk = T; v[h][i] = (unsigned)(tk * K + C[i]) * 2u; }
    }
    __device__ __forceinline__ const char* b_base(const Unit& u) const { return (const char*)(W1T + ((size_t)u.e * 2048 + u.pn * 128) * K); }
    __device__ __forceinline__ size_t a_kstep() const { return (size_t)BK * 2; }
    __device__ __forceinline__ size_t b_hstep() const { return (size_t)1024 * K * 2; }
    __device__ __forceinline__ int b_row(int R) const { return (R & ~31) + perm32(R & 31); }
};
struct ProbMoe2 { static constexpr bool GATHER = false; static constexpr int KT = 0;
    const bf16_t* ACT; const bf16_t* W2T; lds_ints ps; int K, ntm, G, c;
    __device__ __forceinline__ bool next(int i, Unit& u) const {
        if (G != 256) { const int q = i * G + c; if (q >= ntm * 4) return false; u.pm = q >> 2; u.pn = q & 3; u.e = expert_of(ps, u.pm); return true; }
        const int x = c & 7, s = c >> 3; const int pm = 8 * (i * 8 + x) + (s >> 2); if (pm >= ntm) return false;
        u.pm = pm; u.pn = s & 3; u.e = expert_of(ps, u.pm); return true; }
    __device__ __forceinline__ const char* a_base(const Unit& u) const { return (const char*)(ACT + (size_t)u.pm * BM * K); }
    __device__ __forceinline__ void a_voff(const Unit&, const int (&R)[2], const int (&C)[2], unsigned (&v)[2][2]) const {
#pragma unroll
        for (int h = 0; h < 2; ++h)
#pragma unroll
            for (int i = 0; i < 2; ++i) v[h][i] = (unsigned)((h * HALF + R[i]) * K + C[i]) * 2u;
    }
    __device__ __forceinline__ const char* b_base(const Unit& u) const { return (const char*)(W2T + ((size_t)u.e * 1024 + u.pn * BM) * K); }
    __device__ __forceinline__ size_t a_kstep() const { return (size_t)BK * 2; }
    __device__ __forceinline__ size_t b_hstep() const { return (size_t)HALF * K * 2; }
    __device__ __forceinline__ int b_row(int R) const { return (R & ~31) + perm32(R & 31); }
};

struct ProbCmp { static constexpr bool GATHER = false; static constexpr int KT = 8;
    const bf16_t* ZB; const bf16_t* W1T; int K, G, c;
    __device__ __forceinline__ bool next(int i, Unit& u) const { const int q = i * G + c; if (q >= 64) return false; u.pm = q & 15; u.pn = 0; u.e = q >> 4; return true; }
    __device__ __forceinline__ const char* a_base(const Unit& u) const { const int idx = u.pm >> 3, bg = (u.pm >> 1) & 3, half = u.pm & 1;
        return (const char*)(ZB + ((size_t)(bg >> 1) * S + 16 * 256 * half + 8 * u.e) * ZBW + ZB_KC + idx * 128 + (bg & 1) * 64); }
    __device__ __forceinline__ void a_voff(const Unit&, const int (&R)[2], const int (&C)[2], unsigned (&v)[2][2]) const {
#pragma unroll
        for (int h = 0; h < 2; ++h)
#pragma unroll
            for (int i = 0; i < 2; ++i) v[h][i] = (unsigned)(16 * (h * HALF + R[i]) * ZBW + C[i]) * 2u;
    }
    __device__ __forceinline__ size_t a_kstep() const { return (size_t)ZBW * 2; }
    __device__ __forceinline__ const char* b_base(const Unit& u) const { return (const char*)(W1T + (size_t)(u.pm >> 3) * 128 * K + 8 * 64 * u.e); }
    __device__ __forceinline__ size_t b_hstep() const { return 0; }
    __device__ __forceinline__ int b_row(int R) const { return (R & ~31) + perm32(R & 31); }
};
struct EpiCmp {
    float* HIDP;
    struct Pre {};
    __device__ __forceinline__ void prefetch(const Unit&, int, int, Pre&) const {}
    __device__ __forceinline__ void init(f32x4 (&acc)[2][2][4][2], const Pre&) const {
#pragma unroll
        for (int a = 0; a < 2; ++a)
#pragma unroll
            for (int b = 0; b < 2; ++b)
#pragma unroll
                for (int m = 0; m < 4; ++m)
#pragma unroll
                    for (int n = 0; n < 2; ++n) acc[a][b][m][n] = (f32x4){0.f, 0.f, 0.f, 0.f};
    }
    __device__ __forceinline__ void operator()(const f32x4 (&acc)[2][2][4][2], const Unit& u, int wr, int wc, int fr, int fq, bool has_next, const Unit& nxt, Pre& pre) const {
        const int idx = u.pm >> 3, bg = (u.pm >> 1) & 3, half = u.pm & 1;
        const int c0 = 32 * wc + 8 * fq;
#pragma unroll
        for (int ai = 0; ai < 2; ++ai)
#pragma unroll
            for (int m = 0; m < 4; ++m) { const int n = 256 * half + ai * HALF + wr * 64 + m * 16 + fr;
                if (n < 511) { float* dst = HIDP + (((size_t)u.e * 2 + idx) * 2044 + bg * 511 + n) * 128 + c0;
                    *(f32x4*)dst = acc[ai][0][m][0]; *(f32x4*)(dst + 4) = acc[ai][0][m][1]; } }
    }
};
struct EpiG1F {
    bf16_t* ZB; float* GATE; const float* gq; const float* gk; const float* gmq; const float* gmk;
    struct Pre {};
    __device__ __forceinline__ void prefetch(const Unit&, int, int, Pre&) const {}
    __device__ __forceinline__ void init(f32x4 (&acc)[2][2][4][2], const Pre&) const {
#pragma unroll
        for (int a = 0; a < 2; ++a)
#pragma unroll
            for (int b = 0; b < 2; ++b)
#pragma unroll
                for (int m = 0; m < 4; ++m)
#pragma unroll
                    for (int n = 0; n < 2; ++n) acc[a][b][m][n] = (f32x4){0.f, 0.f, 0.f, 0.f};
    }
    __device__ __forceinline__ void operator()(const f32x4 (&acc)[2][2][4][2], const Unit& u, int wr, int wc, int fr, int fq, bool has_next, const Unit& nxt, Pre& pre) const {
        const int pn = u.pn;
        const float* gain = nullptr; float sc = 1.f;
        if (pn < 2) { gain = gq; sc = QSCALE; }
        else if (pn == 3 || pn == 4) { if (wc < 2) gain = gk; }
        else if (pn == 5 || pn == 6) { gain = gmq; sc = QSCALE; }
        else if (pn == 7 || pn == 8) { gain = gmk; }
        if (pn == 11) {
            if (wc == 0 && fq < 3) {
#pragma unroll
                for (int ai = 0; ai < 2; ++ai)
#pragma unroll
                    for (int m = 0; m < 4; ++m) { const size_t r = (size_t)u.pm * BM + ai * HALF + wr * 64 + m * 16 + fr;
#pragma unroll
                        for (int n = 0; n < 2; ++n) { const f32x4 v = acc[ai][0][m][n]; f32x4 o;
#pragma unroll
                            for (int i = 0; i < 4; ++i) o[i] = __builtin_amdgcn_rcpf(1.f + __builtin_amdgcn_exp2f(-LOG2E * v[i]));
                            *(f32x4*)(GATE + r * 32 + 8 * fq + 4 * n) = o; } }
            }
            return;
        }
        f32x4 gv[2][2];
#pragma unroll
        for (int bj = 0; bj < 2; ++bj)
#pragma unroll
            for (int n = 0; n < 2; ++n) gv[bj][n] = gain ? *(const f32x4*)(gain + 32 * bj + 8 * fq + 4 * n) * sc : (f32x4){1.f, 1.f, 1.f, 1.f};
#pragma unroll
        for (int ai = 0; ai < 2; ++ai)
#pragma unroll
            for (int m = 0; m < 4; ++m) { const size_t r = (size_t)u.pm * BM + ai * HALF + wr * 64 + m * 16 + fr;
                float rs = 1.f;
                if (gain) { float ss = 0.f;
#pragma unroll
                    for (int bj = 0; bj < 2; ++bj)
#pragma unroll
                        for (int n = 0; n < 2; ++n) { const f32x4 v = acc[ai][bj][m][n]; ss += (v[0] * v[0] + v[1] * v[1]) + (v[2] * v[2] + v[3] * v[3]); }
                    ss += __shfl_xor(ss, 16); ss += __shfl_xor(ss, 32);
                    rs = rsqrtf(ss * (1.f / 64.f) + EPS); }
#pragma unroll
                for (int bj = 0; bj < 2; ++bj) { const f32x4 a = acc[ai][bj][m][0] * gv[bj][0] * rs, b = acc[ai][bj][m][1] * gv[bj][1] * rs;
                    u32x4 w; w.x = cvt_pk_bf16(a[0], a[1]); w.y = cvt_pk_bf16(a[2], a[3]); w.z = cvt_pk_bf16(b[0], b[1]); w.w = cvt_pk_bf16(b[2], b[3]);
                    *(u32x4*)(ZB + r * ZBW + pn * BM + 64 * wc + 32 * bj + 8 * fq) = w; } }
    }
};
struct EpiG2 {
    const float* xin32; bf16_t* XAB; const float* g1;
    struct Pre {};
    __device__ __forceinline__ void prefetch(const Unit&, int, int, Pre&) const {}
    __device__ __forceinline__ void init(f32x4 (&acc)[2][2][4][2], const Pre&) const {
#pragma unroll
        for (int a = 0; a < 2; ++a)
#pragma unroll
            for (int b = 0; b < 2; ++b)
#pragma unroll
                for (int m = 0; m < 4; ++m)
#pragma unroll
                    for (int n = 0; n < 2; ++n) acc[a][b][m][n] = (f32x4){0.f, 0.f, 0.f, 0.f};
    }
    __device__ __forceinline__ void operator()(const f32x4 (&acc)[2][2][4][2], const Unit& u, int wr, int wc, int fr, int fq, bool has_next, const Unit& nxt, Pre& pre) const {
#pragma unroll
        for (int ai = 0; ai < 2; ++ai)
#pragma unroll
            for (int m = 0; m < 4; ++m) { const size_t r = (size_t)u.pm * BM + ai * HALF + wr * 64 + m * 16 + fr; const int b = (int)(r / S);
#pragma unroll
                for (int bj = 0; bj < 2; ++bj) { const int c = u.pn * BM + 128 * bj + 32 * wc + 8 * fq;
                    f32x4 x0, x1;
                    if (xin32) { x0 = *(const f32x4*)(xin32 + r * D + c); x1 = *(const f32x4*)(xin32 + r * D + c + 4); }
                    else { const u32x4 q = *(const u32x4*)(XAB + r * D + c);
                        x0 = (f32x4){__builtin_bit_cast(float, q.x << 16), __builtin_bit_cast(float, q.x & 0xffff0000u), __builtin_bit_cast(float, q.y << 16), __builtin_bit_cast(float, q.y & 0xffff0000u)};
                        x1 = (f32x4){__builtin_bit_cast(float, q.z << 16), __builtin_bit_cast(float, q.z & 0xffff0000u), __builtin_bit_cast(float, q.w << 16), __builtin_bit_cast(float, q.w & 0xffff0000u)}; }
                    const f32x4 g0 = *(const f32x4*)(g1 + (size_t)b * 6144 + c), g1v = *(const f32x4*)(g1 + (size_t)b * 6144 + c + 4);
                    const f32x4 y0 = x0 + g0 * acc[ai][bj][m][0], y1 = x1 + g1v * acc[ai][bj][m][1];
                    u32x4 o; o.x = cvt_pk_bf16(y0[0], y0[1]); o.y = cvt_pk_bf16(y0[2], y0[3]); o.z = cvt_pk_bf16(y1[0], y1[1]); o.w = cvt_pk_bf16(y1[2], y1[3]);
                    *(u32x4*)(XAB + r * D + c) = o; } }
    }
};
struct EpiM1 {
    bf16_t* ACT; const float* b1l;
    struct Pre { f32x4 bg[2], bl[2]; };
    __device__ __forceinline__ void prefetch(const Unit& u, int wc, int fq, Pre& q) const {
        const float* b1 = b1l + (size_t)u.e * 2048 + u.pn * 128 + 32 * wc + 8 * fq;
#pragma unroll
        for (int n = 0; n < 2; ++n) { q.bg[n] = *(const f32x4*)(b1 + 4 * n); q.bl[n] = *(const f32x4*)(b1 + 1024 + 4 * n); }
    }
    __device__ __forceinline__ void init(f32x4 (&acc)[2][2][4][2], const Pre& q) const {
#pragma unroll
        for (int a = 0; a < 2; ++a)
#pragma unroll
            for (int m = 0; m < 4; ++m)
#pragma unroll
                for (int n = 0; n < 2; ++n) { acc[a][0][m][n] = q.bg[n]; acc[a][1][m][n] = q.bl[n]; }
    }
    __device__ __forceinline__ void operator()(const f32x4 (&acc)[2][2][4][2], const Unit& u, int wr, int wc, int fr, int fq, bool has_next, const Unit& nxt, Pre& pre) const {
        const int c0 = u.pn * 128 + 32 * wc + 8 * fq;
#pragma unroll
        for (int ai = 0; ai < 2; ++ai) {
            if (ai == 1) { __builtin_amdgcn_sched_barrier(0); prefetch(nxt, wc, fq, pre); __builtin_amdgcn_sched_barrier(0); }
#pragma unroll
            for (int m = 0; m < 4; ++m) { const size_t r = (size_t)u.pm * BM + ai * HALF + wr * 64 + m * 16 + fr;
                float o[8];
#pragma unroll
                for (int n = 0; n < 2; ++n) { const f32x4 g = acc[ai][0][m][n], li = acc[ai][1][m][n];
#pragma unroll
                    for (int i = 0; i < 4; ++i) { const float gc = fminf(g[i], 7.f), lc = __builtin_amdgcn_fmed3f(li[i], -7.f, 7.f);
                        o[4 * n + i] = (lc + 1.f) * (gc * __builtin_amdgcn_rcpf(1.f + __builtin_amdgcn_exp2f((-1.702f * LOG2E) * gc))); } }
                u32x4 w; w.x = cvt_pk_bf16(o[0], o[1]); w.y = cvt_pk_bf16(o[2], o[3]); w.z = cvt_pk_bf16(o[4], o[5]); w.w = cvt_pk_bf16(o[6], o[7]);
                *(u32x4*)(ACT + r * DFF + c0) = w; }
        }
    }
};
struct EpiM2 {
    bf16_t* Y; const float* b2l;
    struct Pre { f32x4 b[2][2]; };
    __device__ __forceinline__ void prefetch(const Unit& u, int wc, int fq, Pre& q) const {
        const float* b2 = b2l + (size_t)u.e * D + u.pn * BM + 32 * wc + 8 * fq;
#pragma unroll
        for (int bj = 0; bj < 2; ++bj)
#pragma unroll
            for (int n = 0; n < 2; ++n) q.b[bj][n] = *(const f32x4*)(b2 + 128 * bj + 4 * n);
    }
    __device__ __forceinline__ void init(f32x4 (&acc)[2][2][4][2], const Pre& q) const {
#pragma unroll
        for (int a = 0; a < 2; ++a)
#pragma unroll
            for (int bj = 0; bj < 2; ++bj)
#pragma unroll
                for (int m = 0; m < 4; ++m)
#pragma unroll
                    for (int n = 0; n < 2; ++n) acc[a][bj][m][n] = q.b[bj][n];
    }
    __device__ __forceinline__ void operator()(const f32x4 (&acc)[2][2][4][2], const Unit& u, int wr, int wc, int fr, int fq, bool has_next, const Unit& nxt, Pre& pre) const {
#pragma unroll
        for (int ai = 0; ai < 2; ++ai) {
            if (ai == 1) { __builtin_amdgcn_sched_barrier(0); prefetch(nxt, wc, fq, pre); __builtin_amdgcn_sched_barrier(0); }
#pragma unroll
            for (int m = 0; m < 4; ++m) { const size_t r = (size_t)u.pm * BM + ai * HALF + wr * 64 + m * 16 + fr;
#pragma unroll
                for (int bj = 0; bj < 2; ++bj) { const int c = u.pn * BM + 128 * bj + 32 * wc + 8 * fq;
                    const f32x4 v0 = acc[ai][bj][m][0], v1 = acc[ai][bj][m][1];
                    u32x4 o; o.x = cvt_pk_bf16(v0[0], v0[1]); o.y = cvt_pk_bf16(v0[2], v0[3]); o.z = cvt_pk_bf16(v1[0], v1[1]); o.w = cvt_pk_bf16(v1[2], v1[3]);
                    *(u32x4*)(Y + r * D + c) = o; } }
        }
    }
};
}

__device__ __forceinline__ void phase_g1_fast(const Params& p, int l, unsigned char* lds_raw) {
    pg8::ProbDense P{(const bf16_t*)(p.ws + WS_XN), (const bf16_t*)(p.ws + WS_WINT) + (size_t)l * ZBW * D, D, T / 256, ZBW / 256, (int)gridDim.x, (int)blockIdx.x, true};
    pg8::EpiG1F E{(bf16_t*)(p.ws + WS_ZB), (float*)(p.ws + WS_GATE), p.in[7] + l * 64, p.in[8] + l * 64, p.in[12] + l * 64, p.in[13] + l * 64};
    pg8::gemm_phase<pg8::ProbDense, pg8::EpiG1F, true, true>((PG8_LAS unsigned char*)lds_raw, P, E);
}
__device__ __forceinline__ void phase_g2_fast(const Params& p, int l, unsigned char* lds_raw) {
    pg8::ProbDense P{(const bf16_t*)(p.ws + WS_ATTB), (const bf16_t*)(p.ws + WS_WOT) + (size_t)l * D * D, D, T / 256, D / 256, (int)gridDim.x, (int)blockIdx.x, false};
    pg8::EpiG2 E{l == 0 ? p.in[0] : (const float*)nullptr, (bf16_t*)(p.ws + WS_XAB), (const float*)(p.ws + WS_MOD) + (size_t)l * Bn * 6144 + 2 * D};
    pg8::gemm_phase<pg8::ProbDense, pg8::EpiG2, true, true>((PG8_LAS unsigned char*)lds_raw, P, E);
}
constexpr int LDS_PS_OFF = 131072;
__device__ __forceinline__ void phase_ck_fast(const Params& p, int l, unsigned char* lds_raw) {
    pg8::ProbCmp P{(const bf16_t*)(p.ws + WS_ZB), (const bf16_t*)(p.ws + WS_WCT) + (size_t)l * 2 * 128 * 2048, 2048, (int)gridDim.x, (int)blockIdx.x};
    pg8::EpiCmp E{(float*)(p.ws + WS_HIDP)};
    pg8::gemm_phase<pg8::ProbCmp, pg8::EpiCmp, true, true>((PG8_LAS unsigned char*)lds_raw, P, E);
    { const int tid = otid(), lane = tid & 63, wave = tid >> 6, r8 = lane >> 3, c8 = lane & 7;
      const bf16_t* Z = (const bf16_t*)(p.ws + WS_ZB); bf16_t* KMB = (bf16_t*)(p.ws + WS_KMB);
      float* part = (float*)(lds_raw + 131072 + 512);
      for (int it0 = blockIdx.x * 2; it0 < Bn * 8 * 32; it0 += gridDim.x * 2) {
          const int it = it0 + (wave >> 2), q = wave & 3;
          const int b = it / 256, h = (it / 32) & 7, blk = it & 31;
          const bf16_t* base = Z + (size_t)(b * S + blk * 256 + q * 64 + r8) * ZBW + ZB_MK + h * 64 + c8 * 8;
          float s[8] = {0.f, 0.f, 0.f, 0.f, 0.f, 0.f, 0.f, 0.f};
          uint4 v[8];
#pragma unroll
          for (int i = 0; i < 8; ++i) v[i] = *(const uint4*)(base + (size_t)(8 * i) * ZBW);
#pragma unroll
          for (int i = 0; i < 8; ++i) { const unsigned w[4] = {v[i].x, v[i].y, v[i].z, v[i].w};
#pragma unroll
              for (int e = 0; e < 4; ++e) { s[2 * e] += __builtin_bit_cast(float, w[e] << 16); s[2 * e + 1] += __builtin_bit_cast(float, w[e] & 0xffff0000u); } }
#pragma unroll
          for (int e = 0; e < 8; ++e) { s[e] += __shfl_xor(s[e], 8); s[e] += __shfl_xor(s[e], 16); s[e] += __shfl_xor(s[e], 32); }
          if (r8 == 0) {
#pragma unroll
              for (int e = 0; e < 8; ++e) part[wave * 64 + c8 * 8 + e] = s[e]; }
          __syncthreads();
          if (tid < 128) { const int item = tid >> 6, d = tid & 63; const float* pp = part + item * 256 + d;
              KMB[(size_t)(it0 + item) * 64 + d] = (bf16_t)f2bf((((pp[0] + pp[64]) + pp[128]) + pp[192]) * (1.f / 256.f)); }
          __syncthreads();
      } }
}
__device__ __forceinline__ void phase_m1_fast(const Params& p, int l, unsigned char* lds_raw) {
    int* ps = (int*)(lds_raw + LDS_PS_OFF);
    load_pstart(p, l, ps);
    pg8::ProbMoe1 P{(const bf16_t*)(p.ws + WS_XN), (const bf16_t*)(p.ws + WS_W1T) + (size_t)l * NE * 2048 * D, (const int*)(p.ws + WS_ROWTOK) + (size_t)l * RMAX, (pg8::lds_ints)ps, D, ps[32] / 256, (int)gridDim.x, (int)blockIdx.x};
    pg8::EpiM1 E{(bf16_t*)(p.ws + WS_ACT), p.in[18] + (size_t)l * NE * 2048};
    pg8::gemm_phase<pg8::ProbMoe1, pg8::EpiM1, true, true>((PG8_LAS unsigned char*)lds_raw, P, E);
    __syncthreads();
}
__device__ __forceinline__ void phase_m2_fast(const Params& p, int l, unsigned char* lds_raw) {
    int* ps = (int*)(lds_raw + LDS_PS_OFF);
    load_pstart(p, l, ps);
    pg8::ProbMoe2 P{(const bf16_t*)(p.ws + WS_ACT), (const bf16_t*)(p.ws + WS_W2T) + (size_t)l * NE * D * DFF, (pg8::lds_ints)ps, DFF, ps[32] / 256, (int)gridDim.x, (int)blockIdx.x};
    pg8::EpiM2 E{(bf16_t*)(p.ws + WS_Y), p.in[20] + (size_t)l * NE * D};
    pg8::gemm_phase<pg8::ProbMoe2, pg8::EpiM2, true, true>((PG8_LAS unsigned char*)lds_raw, P, E);
    __syncthreads();
}

namespace at {
#define AT_LAS __attribute__((address_space(3)))
typedef short bf16x8 __attribute__((ext_vector_type(8)));
typedef short s16x4 __attribute__((ext_vector_type(4)));
typedef short v4i16_t __attribute__((ext_vector_type(4)));
typedef float f32x16 __attribute__((ext_vector_type(16)));
typedef unsigned u32x4 __attribute__((ext_vector_type(4)));
typedef float f32x2_t __attribute__((ext_vector_type(2))); typedef __bf16 bf16x2_t __attribute__((ext_vector_type(2)));
typedef AT_LAS unsigned char* lp;
constexpr int L_K = 0  , L_V = 32768  , L_WSF = 65536, L_OST = 67584  , L_SELM = 133120, L_UNI = 134144, L_KMT = 134400, L_END = 142592;
constexpr float NEGS = -1e30f;
__device__ __forceinline__ int crow(int r, int hi) { return (r & 3) + 8 * (r >> 2) + 4 * hi; }
__device__ __forceinline__ unsigned cvtpk(float lo, float hi) { f32x2_t v = {lo, hi}; bf16x2_t b = __builtin_convertvector(v, bf16x2_t); return __builtin_bit_cast(unsigned, b); }
__device__ __forceinline__ float mx3(float a, float b, float c) { return __builtin_fmaxf(__builtin_fmaxf(a, b), c); }
__device__ __forceinline__ void wsync() { asm volatile("s_waitcnt lgkmcnt(0)" ::: "memory"); __builtin_amdgcn_wave_barrier(); }
__device__ __forceinline__ void bar() { __builtin_amdgcn_s_barrier(); }
#define AT_WAITV(n) asm volatile("s_waitcnt vmcnt(" #n ")" ::: "memory")
#define AT_WAITL() asm volatile("s_waitcnt lgkmcnt(0)" ::: "memory")
__device__ __forceinline__ void glds(const void* g, lp dst) { __builtin_amdgcn_global_load_lds((const unsigned*)g, (AT_LAS unsigned*)dst, 16, 0, 0); }
__device__ __forceinline__ s16x4 vtr(const AT_LAS unsigned char* p) { return __builtin_bit_cast(s16x4, __builtin_amdgcn_ds_read_tr16_b64_v4i16((AT_LAS v4i16_t*)p)); }

__device__ __forceinline__ void dma_k(lp slot, const bf16_t* kbase, int pitch, int key0, int wid, int lane) { glds(kbase + (size_t)(key0 + lane) * pitch + wid * 8, slot + wid * 1024); }
__device__ __forceinline__ void dma_v(lp slot, const bf16_t* vbase, int pitch, int key0, int wid, int lane) {
    glds(vbase + (size_t)(key0 + 16 * (wid & 3) + (lane >> 2)) * pitch + (wid >> 2) * 32 + (lane & 3) * 8, slot + wid * 1024); }

__device__ __forceinline__ void qk_tile(f32x16& p0, f32x16& p1, lp kslot, const bf16x8 (&qr)[4], int r32, int hi) {
    const AT_LAS unsigned char* kb = kslot + hi * 1024 + r32 * 16;
    bf16x8 b0[4], b1[4];
#pragma unroll
    for (int d0 = 0; d0 < 4; ++d0) { b0[d0] = *(const AT_LAS bf16x8*)(kb + d0 * 2048); b1[d0] = *(const AT_LAS bf16x8*)(kb + d0 * 2048 + 512); }
#pragma unroll
    for (int d0 = 0; d0 < 4; ++d0) {
        p0 = __builtin_amdgcn_mfma_f32_32x32x16_bf16(b0[d0], qr[d0], p0, 0, 0, 0);
        p1 = __builtin_amdgcn_mfma_f32_32x32x16_bf16(b1[d0], qr[d0], p1, 0, 0, 0);
    }
}
struct VFrag { bf16x8 f[8]; };
__device__ __forceinline__ void pv_load(VFrag& v, lp vslot, int lane, int hi) {
    const AT_LAS unsigned char* vp = vslot + ((lane >> 4) & 1) * 32 + (lane & 3) * 8 + (4 * hi + ((lane & 15) >> 2)) * 64;
#pragma unroll
    for (int d0 = 0; d0 < 2; ++d0)
#pragma unroll
        for (int ks = 0; ks < 4; ++ks) {
            const s16x4 lo = vtr(vp + d0 * 4096 + ks * 1024), hh = vtr(vp + d0 * 4096 + ks * 1024 + 512);
            v.f[d0 * 4 + ks] = (bf16x8){lo[0], lo[1], lo[2], lo[3], hh[0], hh[1], hh[2], hh[3]};
        }
}
__device__ __forceinline__ void pv_mfma(f32x16 (&o)[2], const VFrag& v, u32x4 pw0, u32x4 pw1, u32x4 pw2, u32x4 pw3) {
    const bf16x8 pa[4] = {__builtin_bit_cast(bf16x8, pw0), __builtin_bit_cast(bf16x8, pw1), __builtin_bit_cast(bf16x8, pw2), __builtin_bit_cast(bf16x8, pw3)};
#pragma unroll
    for (int ks = 0; ks < 4; ++ks) {
        o[0] = __builtin_amdgcn_mfma_f32_32x32x16_bf16(pa[ks], v.f[ks], o[0], 0, 0, 0);
        o[1] = __builtin_amdgcn_mfma_f32_32x32x16_bf16(pa[ks], v.f[4 + ks], o[1], 0, 0, 0);
    }
}
__device__ __forceinline__ float rowmax(const f32x16& p0, const f32x16& p1) {
    float a = mx3(p0[0], p0[1], p1[0]), b = mx3(p0[2], p0[3], p1[1]); a = mx3(a, p1[2], p1[3]);
#pragma unroll
    for (int r = 4; r < 16; r += 4) { a = mx3(a, p0[r], p0[r + 1]); b = mx3(b, p0[r + 2], p0[r + 3]); a = mx3(a, p1[r], p1[r + 1]); b = mx3(b, p1[r + 2], p1[r + 3]); }
    const float m = __builtin_fmaxf(a, b);
    auto rr = __builtin_amdgcn_permlane32_swap(__float_as_uint(m), __float_as_uint(m), false, false);
    return __builtin_fmaxf(__uint_as_float(rr[0]), __uint_as_float(rr[1]));
}
__device__ __forceinline__ float halfsum(float v) {
    auto rr = __builtin_amdgcn_permlane32_swap(__float_as_uint(v), __float_as_uint(v), false, false);
    return __uint_as_float(rr[0]) + __uint_as_float(rr[1]);
}
__device__ __forceinline__ void mask_tile(f32x16& p0, f32x16& p1, int lo, int hi_, int hi) {
    const int kb = 4 * hi;
#pragma unroll
    for (int r = 0; r < 16; ++r) { const int kv = kb + (r & 3) + 8 * (r >> 2); if (kv > hi_ || kv < lo) p0[r] = NEGS; if (kv + 32 > hi_ || kv + 32 < lo) p1[r] = NEGS; }
}

__device__ __forceinline__ void mask_init_lo(f32x16& p0, f32x16& p1, int lo, int hi) {
    const int kb = 4 * hi;
#pragma unroll
    for (int r = 0; r < 16; ++r) { const int kv = kb + (r & 3) + 8 * (r >> 2); if (kv < lo) p0[r] = NEGS; if (kv + 32 < lo) p1[r] = NEGS; }
}
__device__ __forceinline__ void mask_init(f32x16& p0, f32x16& p1, int hi_, int hi) {
    const int kb = 4 * hi;
#pragma unroll
    for (int r = 0; r < 16; ++r) { const int kv = kb + (r & 3) + 8 * (r >> 2); if (kv > hi_) p0[r] = NEGS; if (kv + 32 > hi_) p1[r] = NEGS; }
}
__device__ __forceinline__ int next_bit128(unsigned u0, unsigned u1, unsigned u2, unsigned u3, int below) {
    if (below > 96) { unsigned x = u3; if (below < 128) x &= (1u << (below - 96)) - 1u; if (x) return 96 + 31 - __builtin_clz(x); }
    if (below > 64) { unsigned x = u2; if (below < 96) x &= (1u << (below - 64)) - 1u; if (x) return 64 + 31 - __builtin_clz(x); }
    if (below > 32) { unsigned x = u1; if (below < 64) x &= (1u << (below - 32)) - 1u; if (x) return 32 + 31 - __builtin_clz(x); }
    if (below > 0) { unsigned x = u0; if (below < 32) x &= (1u << below) - 1u; if (x) return 31 - __builtin_clz(x); }
    return -1;
}
struct Soft { float m, l; };

template <bool HAS_O>
__device__ __forceinline__ void softmax_step(f32x16& p0, f32x16& p1, Soft& st, f32x16 (&o)[2], float* wsf, int r32, int hi) {
    const float rm = rowmax(p0, p1);
    if (__any(rm > 0.f)) {
        const float dl = __builtin_fmaxf(rm, 0.f); st.m += dl;
#pragma unroll
        for (int r = 0; r < 16; ++r) { p0[r] -= dl; p1[r] -= dl; }
        const float al = __builtin_amdgcn_exp2f(-dl); st.l *= al;
        if (HAS_O) {
            if (hi == 0) wsf[r32] = al;
            wsync();
#pragma unroll
            for (int r = 0; r < 16; ++r) { const float f = wsf[crow(r, hi)]; o[0][r] *= f; o[1][r] *= f; }
            wsync();
        }
    }
    float s = 0.f;
#pragma unroll
    for (int r = 0; r < 16; ++r) { p0[r] = __builtin_amdgcn_exp2f(p0[r]); p1[r] = __builtin_amdgcn_exp2f(p1[r]); s += p0[r] + p1[r]; }
    st.l += s;
}
#define AT_PACK(P0, P1) \
    const u32x4 pw0 = {cvtpk(P0[0], P0[1]), cvtpk(P0[2], P0[3]), cvtpk(P0[4], P0[5]), cvtpk(P0[6], P0[7])}, pw1 = {cvtpk(P0[8], P0[9]), cvtpk(P0[10], P0[11]), cvtpk(P0[12], P0[13]), cvtpk(P0[14], P0[15])}, \
                pw2 = {cvtpk(P1[0], P1[1]), cvtpk(P1[2], P1[3]), cvtpk(P1[4], P1[5]), cvtpk(P1[6], P1[7])}, pw3 = {cvtpk(P1[8], P1[9]), cvtpk(P1[10], P1[11]), cvtpk(P1[12], P1[13]), cvtpk(P1[14], P1[15])}
__device__ __forceinline__ float fma_vsv(float a, float k, float x) { float d; asm("v_fma_f32 %0, %1, %2, %3" : "=v"(d) : "v"(a), "s"(k), "v"(x)); return d; }
__device__ __forceinline__ f32x16 cinit(float c2k, int hi, float x) { f32x16 c; const float xb = __builtin_fmaf(c2k, (float)(4 * hi), x);
    c[0] = xb;
#pragma unroll
    for (int r = 1; r < 16; ++r) c[r] = fma_vsv(c2k, (float)((r & 3) + 8 * (r >> 2)), xb);
    return c; }
template <bool FIRST>
__device__ __forceinline__ void acc_scaled(float* stage, const f32x16 (&o)[2], float f, float* wsf, int r32, int hi) {
    if (hi == 0) wsf[r32] = f;
    wsync();
#pragma unroll
    for (int r = 0; r < 16; ++r) { const int orow = crow(r, hi); const float g = wsf[orow]; float* s0 = stage + orow * 64 + r32;
        if (FIRST) { s0[0] = o[0][r] * g; s0[32] = o[1][r] * g; } else { s0[0] += o[0][r] * g; s0[32] += o[1][r] * g; } }
    wsync();
}

#define AT_WAIT_NEWER(newer, per) do { if ((newer) >= 2) { if ((per) == 2) AT_WAITV(4); else AT_WAITV(2); } else if ((newer) == 1) { if ((per) == 2) AT_WAITV(2); else AT_WAITV(1); } else AT_WAITV(0); } while (0)


#define AT_SB() __builtin_amdgcn_sched_barrier(0)
struct PipeOut { float s, rmn; };
__device__ __forceinline__ PipeOut pipe_step(f32x16& c0, f32x16& c1, f32x16& n0, f32x16& n1, f32x16 (&o)[2], lp kslot_next, lp vslot, const bf16x8 (&qr)[4], int lane, int r32, int hi) {
    const AT_LAS unsigned char* kb = kslot_next + hi * 1024 + r32 * 16;
    const AT_LAS unsigned char* vp = vslot + ((lane >> 4) & 1) * 32 + (lane & 3) * 8 + (4 * hi + ((lane & 15) >> 2)) * 64;
    bf16x8 kf[8];
#pragma unroll
    for (int j = 0; j < 4; ++j) kf[j] = *(const AT_LAS bf16x8*)(kb + (j >> 1) * 2048 + (j & 1) * 512);
    AT_SB();
    unsigned w0[8], w1[8]; s16x4 vl[8], vh[8]; float s = 0.f;
#pragma unroll
    for (int j = 0; j < 8; ++j) {
        if (j & 1) n1 = __builtin_amdgcn_mfma_f32_32x32x16_bf16(kf[j], qr[j >> 1], n1, 0, 0, 0);
        else       n0 = __builtin_amdgcn_mfma_f32_32x32x16_bf16(kf[j], qr[j >> 1], n0, 0, 0, 0);
        if (j < 4) kf[j + 4] = *(const AT_LAS bf16x8*)(kb + ((j + 4) >> 1) * 2048 + (j & 1) * 512);
        if (j >= 4) {
#pragma unroll
            for (int q = 0; q < 2; ++q) { const int f = (j - 4) * 2 + q, d0 = f >> 2, ks = f & 3; vl[f] = vtr(vp + d0 * 4096 + ks * 1024); vh[f] = vtr(vp + d0 * 4096 + ks * 1024 + 512); }
        }
        const float e0 = __builtin_amdgcn_exp2f(c0[2 * j]), e1 = __builtin_amdgcn_exp2f(c0[2 * j + 1]), e2 = __builtin_amdgcn_exp2f(c1[2 * j]), e3 = __builtin_amdgcn_exp2f(c1[2 * j + 1]);
        s += (e0 + e1) + (e2 + e3);
        asm volatile("" : "+v"(s));
        w0[j] = cvtpk(e0, e1); w1[j] = cvtpk(e2, e3);
        AT_SB();
    }
    const u32x4 pw0 = {w0[0], w0[1], w0[2], w0[3]}, pw1 = {w0[4], w0[5], w0[6], w0[7]}, pw2 = {w1[0], w1[1], w1[2], w1[3]}, pw3 = {w1[4], w1[5], w1[6], w1[7]};
    const bf16x8 pa[4] = {__builtin_bit_cast(bf16x8, pw0), __builtin_bit_cast(bf16x8, pw1), __builtin_bit_cast(bf16x8, pw2), __builtin_bit_cast(bf16x8, pw3)};
    float a = mx3(n0[0], n0[1], n1[0]), b = mx3(n0[2], n0[3], n1[1]);
#pragma unroll
    for (int f = 0; f < 8; ++f) {
        const int d0 = f >> 2, ks = f & 3;
        const bf16x8 vf = (bf16x8){vl[f][0], vl[f][1], vl[f][2], vl[f][3], vh[f][0], vh[f][1], vh[f][2], vh[f][3]};
        o[d0] = __builtin_amdgcn_mfma_f32_32x32x16_bf16(pa[ks], vf, o[d0], 0, 0, 0);
        if (f == 0) { a = mx3(a, n1[2], n1[3]); }
        else if (f < 4) { const int r = 4 * f; a = mx3(a, n0[r], n0[r + 1]); b = mx3(b, n0[r + 2], n0[r + 3]); a = mx3(a, n1[r], n1[r + 1]); b = mx3(b, n1[r + 2], n1[r + 3]); }
        asm volatile("" : "+v"(a), "+v"(b));
        AT_SB();
    }
    const float m = __builtin_fmaxf(a, b);
    auto rr = __builtin_amdgcn_permlane32_swap(__float_as_uint(m), __float_as_uint(m), false, false);
    PipeOut out; out.s = s; out.rmn = __builtin_fmaxf(__uint_as_float(rr[0]), __uint_as_float(rr[1]));
    return out;
}
__device__ __forceinline__ void nsa_unit(const Params& p, int b, int g, int c, unsigned char* lds_raw) {
    const int tid = otid(), lane = tid & 63, r32 = lane & 31, hi = lane >> 5, wid = __builtin_amdgcn_readfirstlane(tid >> 6);
    lp lds = (lp)lds_raw;
    const bf16_t* ZB = (const bf16_t*)(p.ws + WS_ZB); const float* GT = (const float*)(p.ws + WS_GATE);
    const bf16_t* KCB = (const bf16_t*)(p.ws + WS_KCB) + (size_t)(b * 2 + g) * 512 * 64; const bf16_t* VCB = (const bf16_t*)(p.ws + WS_VCB) + (size_t)(b * 2 + g) * 512 * 64;
    const int t0 = c * 64, hg = r32 >> 3, qq = r32 & 7, qi = 8 * wid + qq, t = t0 + qi, h = 4 * g + hg; const size_t tt = (size_t)b * S + t;
    float* wsf = (float*)(lds_raw + L_WSF) + wid * 64;
    float* ostage = (float*)(lds_raw + L_OST) + wid * 2048;
    float* imp = ostage;
    unsigned* selm = (unsigned*)(lds_raw + L_SELM);
    unsigned* uni = (unsigned*)(lds_raw + L_UNI);
    const float c2 = exp2f(-(float)(h + 1)) * LOG2E;
    bf16x8 qr[4];
#pragma unroll
    for (int d0 = 0; d0 < 4; ++d0) qr[d0] = *(const bf16x8*)(ZB + tt * ZBW + ZB_Q + h * 64 + d0 * 16 + hi * 8);
    const float gt0 = GT[tt * 32 + h * 3 + 0], gt1 = GT[tt * 32 + h * 3 + 1], gt2 = GT[tt * 32 + h * 3 + 2];
    f32x16 o[2];
    const lp sK0 = lds + L_K, sV0 = lds + L_V;
    const int nmax = t >= 31 ? (t - 31) >> 4 : -1;
    const int ntc = ((4 * c + 2) >> 6) + 1;
    for (int i = lane; i < 8 * 129; i += 64) imp[i] = 0.f;
    Soft sc; sc.m = 0.f; sc.l = 0.f;
#pragma unroll
    for (int k = 0; k < 3; ++k) if (k < ntc) dma_k(sK0 + k * 8192, KCB, 64, 64 * k, wid, lane);
    for (int k = 0; k < ntc; ++k) {
        const int newer = ntc - 1 - k; AT_WAIT_NEWER(newer, 1);
        AT_WAITL(); bar();
        if (k + 3 < ntc) dma_k(sK0 + ((k + 3) & 3) * 8192, KCB, 64, 64 * (k + 3), wid, lane);
        const lp sK = sK0 + (k & 3) * 8192;
        const float x0 = c2 * (16.f * (64 * k) + 15.5f - (float)t0) - sc.m;
        f32x16 p0 = cinit(16.f * c2, hi, x0), p1 = cinit(16.f * c2, hi, x0 + c2 * 512.f);
        qk_tile(p0, p1, sK, qr, r32, hi);
        if (__any(nmax - 64 * k < 63)) mask_tile(p0, p1, 0, nmax - 64 * k, hi);
        softmax_step<false>(p0, p1, sc, o, wsf, r32, hi);
    }
    const float lc = halfsum(sc.l), linv = lc > 0.f ? 1.f / lc : 0.f;
    o[0] = f32x16{}; o[1] = f32x16{};
    AT_WAITL(); bar();
#pragma unroll
    for (int k = 0; k < 3; ++k) if (k < ntc) { dma_k(sK0 + k * 8192, KCB, 64, 64 * k, wid, lane); dma_v(sV0 + k * 8192, VCB, 64, 64 * k, wid, lane); }
    for (int k = 0; k < ntc; ++k) {
        const int newer = ntc - 1 - k; AT_WAIT_NEWER(newer, 2);
        AT_WAITL(); bar();
        if (k + 3 < ntc) { dma_k(sK0 + ((k + 3) & 3) * 8192, KCB, 64, 64 * (k + 3), wid, lane); dma_v(sV0 + ((k + 3) & 3) * 8192, VCB, 64, 64 * (k + 3), wid, lane); }
        const lp sK = sK0 + (k & 3) * 8192, sV = sV0 + (k & 3) * 8192;
        const float x0 = c2 * (16.f * (64 * k) + 15.5f - (float)t0) - sc.m;
        f32x16 p0 = cinit(16.f * c2, hi, x0), p1 = cinit(16.f * c2, hi, x0 + c2 * 512.f);
        qk_tile(p0, p1, sK, qr, r32, hi);
        if (__any(nmax - 64 * k < 63)) mask_tile(p0, p1, 0, nmax - 64 * k, hi);
        VFrag vf; pv_load(vf, sV, lane, hi);
#pragma unroll
        for (int r = 0; r < 16; ++r) { p0[r] = __builtin_amdgcn_exp2f(p0[r]); p1[r] = __builtin_amdgcn_exp2f(p1[r]); }
        { AT_PACK(p0, p1); pv_mfma(o, vf, pw0, pw1, pw2, pw3); }
        float gs[8], ls[8];
#pragma unroll
        for (int q4 = 0; q4 < 4; ++q4) { gs[q4] = ((p0[4 * q4] + p0[4 * q4 + 1]) + (p0[4 * q4 + 2] + p0[4 * q4 + 3])) * linv; ls[q4] = p0[4 * q4 + 3] * linv;
                                         gs[4 + q4] = ((p1[4 * q4] + p1[4 * q4 + 1]) + (p1[4 * q4 + 2] + p1[4 * q4 + 3])) * linv; ls[4 + q4] = p1[4 * q4 + 3] * linv; }
#pragma unroll
        for (int q4 = 0; q4 < 8; ++q4) { gs[q4] += __shfl_xor(gs[q4], 8); gs[q4] += __shfl_xor(gs[q4], 16); ls[q4] += __shfl_xor(ls[q4], 8); ls[q4] += __shfl_xor(ls[q4], 16); }
        if (r32 < 8) {
            float* row = imp + qq * 129 + 16 * k + hi;
#pragma unroll
            for (int q4 = 0; q4 < 8; ++q4) row[2 * q4] += gs[q4];
        }
        wsync();
        if (r32 < 8) {
            float* row = imp + qq * 129 + 16 * k + hi + 1;
#pragma unroll
            for (int q4 = 0; q4 < 8; ++q4) row[2 * q4] += ls[q4];
        }
        wsync();
    }
    unsigned mk0 = 0u, mk1 = 0u, mk2 = 0u, mk3 = 0u;
    {
        const int qs = lane >> 3, part = lane & 7;
        float v[16];
#pragma unroll
        for (int i = 0; i < 16; ++i) { const int j = part * 16 + i; float x = imp[qs * 129 + j]; if (j == 0 || j == c || j == c - 1) x = 1e4f; if (j > c) x = NEGS; v[i] = x; }
#pragma unroll 1
        for (int it = 0; it < 16; ++it) {
            float bv = -3e38f; int bi = 0;
#pragma unroll
            for (int i = 0; i < 16; ++i) if (v[i] > bv) { bv = v[i]; bi = part * 16 + i; }
#pragma unroll
            for (int sft = 1; sft < 8; sft <<= 1) { const float ov = __shfl_xor(bv, sft); const int oi = __shfl_xor(bi, sft); if (ov > bv || (ov == bv && oi < bi)) { bv = ov; bi = oi; } }
            if (bv > NEGS) { const unsigned bit = 1u << (bi & 31); const int wq = bi >> 5; if (wq == 0) mk0 |= bit; else if (wq == 1) mk1 |= bit; else if (wq == 2) mk2 |= bit; else mk3 |= bit; }
#pragma unroll
            for (int i = 0; i < 16; ++i) if (part * 16 + i == bi) v[i] = -3.4e38f;
        }
        if (part == 0) { unsigned* sm = selm + (8 * wid + qs) * 4; sm[0] = mk0; sm[1] = mk1; sm[2] = mk2; sm[3] = mk3; }
        unsigned u0 = mk0, u1 = mk1, u2 = mk2, u3 = mk3;
#pragma unroll
        for (int sft = 8; sft < 64; sft <<= 1) { u0 |= __shfl_xor(u0, sft); u1 |= __shfl_xor(u1, sft); u2 |= __shfl_xor(u2, sft); u3 |= __shfl_xor(u3, sft); }
        if (lane == 0) { uni[wid * 4 + 0] = u0; uni[wid * 4 + 1] = u1; uni[wid * 4 + 2] = u2; uni[wid * 4 + 3] = u3; }
    }
    wsync();
    acc_scaled<true>(ostage, o, gt0 * linv, wsf, r32, hi);
    AT_WAITL(); bar();
    unsigned un0 = 0u, un1 = 0u, un2 = 0u, un3 = 0u;
#pragma unroll
    for (int w = 0; w < 8; ++w) { un0 |= uni[w * 4 + 0]; un1 |= uni[w * 4 + 1]; un2 |= uni[w * 4 + 2]; un3 |= uni[w * 4 + 3]; }
    un0 = __builtin_amdgcn_readfirstlane(un0); un1 = __builtin_amdgcn_readfirstlane(un1); un2 = __builtin_amdgcn_readfirstlane(un2); un3 = __builtin_amdgcn_readfirstlane(un3);
    const unsigned my0 = selm[(8 * wid + qq) * 4 + 0], my1 = selm[(8 * wid + qq) * 4 + 1], my2 = selm[(8 * wid + qq) * 4 + 2], my3 = selm[(8 * wid + qq) * 4 + 3];
    {
        const bf16_t* KS = ZB + (size_t)b * S * ZBW + ZB_KS + g * 64; const bf16_t* VS = ZB + (size_t)b * S * ZBW + ZB_VS + g * 64;
        Soft ss; ss.m = 0.f; ss.l = 0.f; o[0] = f32x16{}; o[1] = f32x16{};
        const int nsel = __builtin_popcount(un0) + __builtin_popcount(un1) + __builtin_popcount(un2) + __builtin_popcount(un3);
        int ji = 128;
#pragma unroll
        for (int k = 0; k < 3; ++k) if (k < nsel) { ji = next_bit128(un0, un1, un2, un3, ji); dma_k(sK0 + k * 8192, KS, ZBW, 64 * ji, wid, lane); dma_v(sV0 + k * 8192, VS, ZBW, 64 * ji, wid, lane); }
        int j = 128;
        for (int i = 0; i < nsel; ++i) {
            j = next_bit128(un0, un1, un2, un3, j);
            const int newer = nsel - 1 - i; AT_WAIT_NEWER(newer, 2);
            AT_WAITL(); bar();
            if (i + 3 < nsel) { ji = next_bit128(un0, un1, un2, un3, ji); dma_k(sK0 + ((i + 3) & 3) * 8192, KS, ZBW, 64 * ji, wid, lane); dma_v(sV0 + ((i + 3) & 3) * 8192, VS, ZBW, 64 * ji, wid, lane); }
            const lp sK = sK0 + (i & 3) * 8192, sV = sV0 + (i & 3) * 8192;
            const unsigned mw = (j >> 5) == 0 ? my0 : (j >> 5) == 1 ? my1 : (j >> 5) == 2 ? my2 : my3;
            const bool sel = (mw >> (j & 31)) & 1u;
            const float x0 = sel ? c2 * (float)(64 * j - t0) - ss.m : NEGS;
            f32x16 p0 = cinit(c2, hi, x0), p1 = cinit(c2, hi, sel ? x0 + c2 * 32.f : NEGS);
            qk_tile(p0, p1, sK, qr, r32, hi);
            if (j == c) mask_tile(p0, p1, 0, qi, hi);
            VFrag vf; pv_load(vf, sV, lane, hi);
            softmax_step<true>(p0, p1, ss, o, wsf, r32, hi);
            { AT_PACK(p0, p1); pv_mfma(o, vf, pw0, pw1, pw2, pw3); }
        }
        const float ls_ = halfsum(ss.l);
        acc_scaled<false>(ostage, o, ls_ > 0.f ? gt1 / ls_ : 0.f, wsf, r32, hi);
    }
    {
        const bf16_t* KW = ZB + (size_t)b * S * ZBW + ZB_KW + g * 64; const bf16_t* VW = ZB + (size_t)b * S * ZBW + ZB_VW + g * 64;
        Soft sw; sw.m = 0.f; sw.l = 0.f; o[0] = f32x16{}; o[1] = f32x16{};
        const int k0 = c >= 8 ? 0 : 8 - c, nw = 9 - k0;
        AT_WAITL(); bar();
#pragma unroll
        for (int k = 0; k < 3; ++k) if (k < nw) { dma_k(sK0 + k * 8192, KW, ZBW, t0 - 64 * k, wid, lane); dma_v(sV0 + k * 8192, VW, ZBW, t0 - 64 * k, wid, lane); }
        f32x16 pA0, pA1, pB0, pB1; float rmc;
#define WIN_STEP(C0, C1, N0, N1, I) do { const int i_ = (I); \
            if (i_ + 1 < nw) { if (i_ + 2 < nw) AT_WAITV(2); else AT_WAITV(0); } \
            AT_WAITL(); bar(); \
            if (i_ + 3 < nw) { dma_k(sK0 + ((i_ + 3) & 3) * 8192, KW, ZBW, t0 - 64 * (i_ + 3), wid, lane); dma_v(sV0 + ((i_ + 3) & 3) * 8192, VW, ZBW, t0 - 64 * (i_ + 3), wid, lane); } \
            if (__any(rmc > 0.f)) { \
                const float dl = __builtin_fmaxf(rmc, 0.f); sw.m += dl; \
                _Pragma("unroll") for (int r = 0; r < 16; ++r) { C0[r] -= dl; C1[r] -= dl; } \
                const float al = __builtin_amdgcn_exp2f(-dl); sw.l *= al; \
                if (hi == 0) wsf[r32] = al; \
                wsync(); \
                _Pragma("unroll") for (int r = 0; r < 16; ++r) { const float f = wsf[crow(r, hi)]; o[0][r] *= f; o[1][r] *= f; } \
                wsync(); \
            } \
            { const float x0 = c2 * (float)(-64 * (i_ + 1)) - sw.m; \
              N0 = cinit(c2, hi, x0); N1 = cinit(c2, hi, x0 + c2 * 32.f); \
              if (i_ + 1 == 8) mask_init_lo(N0, N1, qi + 1, hi); }        \
            const PipeOut po = pipe_step(C0, C1, N0, N1, o, sK0 + ((i_ + 1) & 3) * 8192, sV0 + (i_ & 3) * 8192, qr, lane, r32, hi); \
            sw.l += po.s; rmc = po.rmn; } while (0)
        { if (nw >= 3) AT_WAITV(4); else if (nw == 2) AT_WAITV(2); else AT_WAITV(0);
          AT_WAITL(); bar(); }
        { pB0 = cinit(c2, hi, 0.f); pB1 = cinit(c2, hi, c2 * 32.f);
          qk_tile(pB0, pB1, sK0, qr, r32, hi);
          mask_tile(pB0, pB1, 0, qi, hi);
          rmc = rowmax(pB0, pB1); }
        int i = 0;
#pragma unroll 1
        for (; i + 1 < nw; i += 2) {
            WIN_STEP(pB0, pB1, pA0, pA1, i);
            WIN_STEP(pA0, pA1, pB0, pB1, i + 1);
        }
        if (i < nw) WIN_STEP(pB0, pB1, pA0, pA1, i);
#undef WIN_STEP
        const float lw = halfsum(sw.l);
        acc_scaled<false>(ostage, o, lw > 0.f ? gt2 / lw : 0.f, wsf, r32, hi);
    }
    {
        bf16_t* AB = (bf16_t*)(p.ws + WS_ATTB);
#pragma unroll
        for (int i = 0; i < 4; ++i) { const int row = i * 8 + (lane >> 3), ch = lane & 7; const float4 a = *(const float4*)(ostage + row * 64 + ch * 8), c4 = *(const float4*)(ostage + row * 64 + ch * 8 + 4);
            const uint4 v = make_uint4(pk2(a.x, a.y), pk2(a.z, a.w), pk2(c4.x, c4.y), pk2(c4.z, c4.w));
            *(uint4*)(AB + ((size_t)b * S + t0 + 8 * wid + (row & 7)) * D + (4 * g + (row >> 3)) * 64 + ch * 8) = v; }
        wsync();
    }
    AT_WAITL(); bar();
}

}

constexpr int MB_CAP = 25600;
namespace at {
__device__ __forceinline__ void moba_route_unit(const Params& p, int b, int h, int qb, unsigned char* lds_raw) {
    const int tid = otid(), lane = tid & 63, r32 = lane & 31, hi = lane >> 5, wid = __builtin_amdgcn_readfirstlane(tid >> 6);
    lp lds = (lp)lds_raw;
    const bf16_t* ZB = (const bf16_t*)(p.ws + WS_ZB);
    const int bh = b * 8 + h;
    const bf16_t* KMB = (const bf16_t*)(p.ws + WS_KMB) + (size_t)bh * 32 * 64;
    const int qi = 32 * wid + r32, t = qb * 256 + qi; const size_t tt = (size_t)b * S + t;
    int* hist = (int*)(lds_raw + L_UNI);
    unsigned* SEL3 = (unsigned*)(p.ws + WS_SEL3); unsigned* LRK = (unsigned*)(p.ws + WS_LRK);
    unsigned char* IL = (unsigned char*)(p.ws + WS_ILIST) + ((size_t)(bh * 32 + qb) * 32) * 256;
    int* BCm = (int*)(p.ws + WS_BCM) + (size_t)(bh * 32 + qb) * 32;
    if (tid < 32) hist[tid] = 0;
    bf16x8 qr[4];
#pragma unroll
    for (int d0 = 0; d0 < 4; ++d0) qr[d0] = *(const bf16x8*)(ZB + tt * ZBW + ZB_MQ + h * 64 + d0 * 16 + hi * 8);
    const lp sKM = lds + L_KMT;
    glds(KMB + (size_t)(lane & 31) * 64 + wid * 8, sKM + wid * 1024);
    AT_WAITV(0); AT_WAITL(); bar();
    f32x16 g0 = f32x16{}, g1 = f32x16{};
    qk_tile(g0, g1, sKM, qr, r32, hi);
    float v1 = NEGS, v2 = NEGS, v3 = NEGS; int i1 = 64, i2 = 64, i3 = 64;
#pragma unroll
    for (int r = 0; r < 16; ++r) { const int n = crow(r, hi); const float s_ = n < qb ? g0[r] : NEGS;
        if (s_ > v1) { v3 = v2; i3 = i2; v2 = v1; i2 = i1; v1 = s_; i1 = n; } else if (s_ > v2) { v3 = v2; i3 = i2; v2 = s_; i2 = n; } else if (s_ > v3) { v3 = s_; i3 = n; } }
    float ov[3]; int oi[3];
    { auto a = __builtin_amdgcn_permlane32_swap(__float_as_uint(v1), __float_as_uint(v1), false, false); ov[0] = __uint_as_float(hi ? a[0] : a[1]); }
    { auto a = __builtin_amdgcn_permlane32_swap(__float_as_uint(v2), __float_as_uint(v2), false, false); ov[1] = __uint_as_float(hi ? a[0] : a[1]); }
    { auto a = __builtin_amdgcn_permlane32_swap(__float_as_uint(v3), __float_as_uint(v3), false, false); ov[2] = __uint_as_float(hi ? a[0] : a[1]); }
    { auto a = __builtin_amdgcn_permlane32_swap((unsigned)i1, (unsigned)i1, false, false); oi[0] = (int)(hi ? a[0] : a[1]); }
    { auto a = __builtin_amdgcn_permlane32_swap((unsigned)i2, (unsigned)i2, false, false); oi[1] = (int)(hi ? a[0] : a[1]); }
    { auto a = __builtin_amdgcn_permlane32_swap((unsigned)i3, (unsigned)i3, false, false); oi[2] = (int)(hi ? a[0] : a[1]); }
#pragma unroll
    for (int k = 0; k < 3; ++k) { const float s_ = ov[k]; const int n = oi[k];
        if (s_ > v1 || (s_ == v1 && n < i1)) { v3 = v2; i3 = i2; v2 = v1; i2 = i1; v1 = s_; i1 = n; }
        else if (s_ > v2 || (s_ == v2 && n < i2)) { v3 = v2; i3 = i2; v2 = s_; i2 = n; }
        else if (s_ > v3 || (s_ == v3 && n < i3)) { v3 = s_; i3 = n; } }
    if (hi == 0) {
        const int j1 = v1 > NEGS ? i1 : 255, j2 = v2 > NEGS ? i2 : 255, j3 = v3 > NEGS ? i3 : 255;
        int l1 = 0, l2 = 0, l3 = 0;
        if (j1 < 32) { l1 = atomicAdd(&hist[j1], 1); IL[j1 * 256 + l1] = (unsigned char)qi; }
        if (j2 < 32) { l2 = atomicAdd(&hist[j2], 1); IL[j2 * 256 + l2] = (unsigned char)qi; }
        if (j3 < 32) { l3 = atomicAdd(&hist[j3], 1); IL[j3 * 256 + l3] = (unsigned char)qi; }
        SEL3[tt * 8 + h] = (unsigned)j1 | ((unsigned)j2 << 8) | ((unsigned)j3 << 16);
        LRK[tt * 8 + h] = (unsigned)l1 | ((unsigned)l2 << 8) | ((unsigned)l3 << 16);
    }
    AT_WAITL(); bar();
    if (tid < 32) BCm[tid] = hist[tid];
    AT_WAITL(); bar();
}
__device__ __forceinline__ void moba_tables(const int* BCmbh, int lane, int& tot, int& seg) {
    int s = 0;
    if (lane < 32) { for (int q = 0; q < 32; ++q) s += BCmbh[q * 32 + lane]; }
    tot = s;
    int pad = (s + 31) & ~31, inc = pad;
#pragma unroll
    for (int sft = 1; sft < 32; sft <<= 1) { const int o_ = __shfl_up(inc, sft); if ((lane & 31) >= sft) inc += o_; }
    seg = inc - pad;
}
__device__ __forceinline__ void moba_gather_unit(const Params& p, int bh, int j, int ch, int segj, bool reload, unsigned char* lds_raw) {
    const int tid = otid(), lane = tid & 63, r32 = lane & 31, hi = lane >> 5, wid = __builtin_amdgcn_readfirstlane(tid >> 6);
    lp lds = (lp)lds_raw;
    const int b = bh >> 3, h = bh & 7;
    const bf16_t* ZB = (const bf16_t*)(p.ws + WS_ZB);
    const int* BCmbh = (const int*)(p.ws + WS_BCM) + (size_t)bh * 32 * 32;
    float* wsf = (float*)(lds_raw + L_WSF) + wid * 64;
    const lp sK0 = lds + L_K, sV0 = lds + L_V;
    const bf16_t* KM_ = ZB + (size_t)b * S * ZBW + ZB_MK + h * 64; const bf16_t* VM_ = ZB + (size_t)b * S * ZBW + ZB_MV + h * 64;
    if (reload) {
#pragma unroll
        for (int k = 3; k >= 0; --k) { dma_k(sK0 + k * 8192, KM_, ZBW, j * 256 + 64 * k, wid, lane); dma_v(sV0 + k * 8192, VM_, ZBW, j * 256 + 64 * k, wid, lane); }
    }
    const int gr = 256 * ch + 32 * wid + r32;
    const int cq = lane < 32 ? BCmbh[lane * 32 + j] : 0;
    int run = 0, qbs = j + 1, lr = 0;
#pragma unroll 4
    for (int q = 0; q < 32; ++q) { const int c_ = __builtin_amdgcn_readlane(cq, q); if (gr >= run && gr < run + c_) { qbs = q; lr = gr - run; } run += c_; }
    const int totj = run;
    const bool valid = gr < totj;
    const unsigned char* IL = (const unsigned char*)(p.ws + WS_ILIST);
    const int qidx = valid ? (int)IL[((size_t)(bh * 32 + qbs) * 32 + j) * 256 + lr] : 0;
    const int t = valid ? qbs * 256 + qidx : (j + 1) * 256; const size_t tt = (size_t)b * S + t;
    const float c2 = exp2f(-(float)(h + 1)) * LOG2E;
    bf16x8 qr[4];
#pragma unroll
    for (int d0 = 0; d0 < 4; ++d0) qr[d0] = *(const bf16x8*)(ZB + tt * ZBW + ZB_MQ + h * 64 + d0 * 16 + hi * 8);
    Soft sm; sm.m = 0.f; sm.l = 0.f; f32x16 o[2]; o[0] = f32x16{}; o[1] = f32x16{};
#pragma unroll 1
    for (int i = 0; i < 4; ++i) {
        if (reload) { const int newer = 3 - i; if (newer >= 3) AT_WAITV(6); else AT_WAIT_NEWER(newer, 2); AT_WAITL(); bar(); }
        const int kt = 3 - i;
        const lp sK = sK0 + kt * 8192, sV = sV0 + kt * 8192;
        const float x0 = c2 * (float)(64 * kt) - sm.m;
        f32x16 p0 = cinit(c2, hi, x0), p1 = cinit(c2, hi, x0 + c2 * 32.f);
        qk_tile(p0, p1, sK, qr, r32, hi);
        VFrag vf; pv_load(vf, sV, lane, hi);
        softmax_step<true>(p0, p1, sm, o, wsf, r32, hi);
        { AT_PACK(p0, p1); pv_mfma(o, vf, pw0, pw1, pw2, pw3); }
    }
    {
        const float lt = halfsum(sm.l);
        float* PM = (float*)(p.ws + WS_PM) + (size_t)bh * MB_CAP; float* PL = (float*)(p.ws + WS_PL) + (size_t)bh * MB_CAP;
        if (hi == 0 && valid) { PM[segj + gr] = sm.m; PL[segj + gr] = lt; }
        bf16_t* stg = (bf16_t*)(lds_raw + L_OST) + wid * 4096;
#pragma unroll
        for (int r = 0; r < 16; ++r) { const int orow = crow(r, hi); stg[orow * 64 + r32] = (bf16_t)f2bf(o[0][r]); stg[orow * 64 + 32 + r32] = (bf16_t)f2bf(o[1][r]); }
        wsync();
        bf16_t* PO = (bf16_t*)(p.ws + WS_PO) + ((size_t)bh * MB_CAP + segj + 256 * ch + 32 * wid) * 64;
        const int nrow = totj - (256 * ch + 32 * wid);
#pragma unroll
        for (int i = 0; i < 4; ++i) { const int row = i * 8 + (lane >> 3), c8 = lane & 7; if (row < nrow) *(uint4*)(PO + (size_t)row * 64 + c8 * 8) = *(const uint4*)(stg + row * 64 + c8 * 8); }
        wsync();
    }
    AT_WAITL(); bar();
}
__device__ __forceinline__ void moba_self_unit(const Params& p, int b, int h, int qb, unsigned char* lds_raw) {
    const int tid = otid(), lane = tid & 63, r32 = lane & 31, hi = lane >> 5, wid = __builtin_amdgcn_readfirstlane(tid >> 6);
    lp lds = (lp)lds_raw;
    const int bh = b * 8 + h;
    const bf16_t* ZB = (const bf16_t*)(p.ws + WS_ZB);
    const int* BCmbh = (const int*)(p.ws + WS_BCM) + (size_t)bh * 32 * 32;
    const int qi = 32 * wid + r32, t = qb * 256 + qi; const size_t tt = (size_t)b * S + t;
    float* wsf = (float*)(lds_raw + L_WSF) + wid * 64;
    float* ostage = (float*)(lds_raw + L_OST) + wid * 2048;
    const float c2 = exp2f(-(float)(h + 1)) * LOG2E;
    bf16x8 qr[4];
#pragma unroll
    for (int d0 = 0; d0 < 4; ++d0) qr[d0] = *(const bf16x8*)(ZB + tt * ZBW + ZB_MQ + h * 64 + d0 * 16 + hi * 8);
    const lp sK0 = lds + L_K, sV0 = lds + L_V;
    const bf16_t* KM_ = ZB + (size_t)b * S * ZBW + ZB_MK + h * 64; const bf16_t* VM_ = ZB + (size_t)b * S * ZBW + ZB_MV + h * 64;
    Soft sm; sm.m = 0.f; sm.l = 0.f; f32x16 o[2]; o[0] = f32x16{}; o[1] = f32x16{};
#pragma unroll
    for (int k = 0; k < 3; ++k) { dma_k(sK0 + k * 8192, KM_, ZBW, qb * 256 + 64 * (3 - k), wid, lane); dma_v(sV0 + k * 8192, VM_, ZBW, qb * 256 + 64 * (3 - k), wid, lane); }
    int tot, seg; moba_tables(BCmbh, lane, tot, seg);
    int before = 0; if (lane < 32) { for (int q = 0; q < qb; ++q) before += BCmbh[q * 32 + lane]; }
    const int base = seg + before;
#pragma unroll 1
    for (int i = 0; i < 4; ++i) {
        const int newer = 3 - i; AT_WAIT_NEWER(newer, 2);
        AT_WAITL(); bar();
        if (i == 0) { dma_k(sK0 + 3 * 8192, KM_, ZBW, qb * 256, wid, lane); dma_v(sV0 + 3 * 8192, VM_, ZBW, qb * 256, wid, lane); }
        const lp sK = sK0 + i * 8192, sV = sV0 + i * 8192;
        const int kt = 3 - i;
        const bool skip = (32 * wid + 31 < 64 * kt);
        if (!skip) {
            const float x0 = c2 * (float)(64 * kt) - sm.m;
            f32x16 p0 = cinit(c2, hi, x0), p1 = cinit(c2, hi, x0 + c2 * 32.f);
            qk_tile(p0, p1, sK, qr, r32, hi);
            if (64 * kt + 63 > 32 * wid) mask_tile(p0, p1, 0, qi - 64 * kt, hi);
            VFrag vf; pv_load(vf, sV, lane, hi);
            softmax_step<true>(p0, p1, sm, o, wsf, r32, hi);
            { AT_PACK(p0, p1); pv_mfma(o, vf, pw0, pw1, pw2, pw3); }
        }
    }
    {
        const float lself = halfsum(sm.l);
        const unsigned s3 = ((const unsigned*)(p.ws + WS_SEL3))[tt * 8 + h], l3 = ((const unsigned*)(p.ws + WS_LRK))[tt * 8 + h];
        const float* PM = (const float*)(p.ws + WS_PM) + (size_t)bh * MB_CAP; const float* PL = (const float*)(p.ws + WS_PL) + (size_t)bh * MB_CAP;
        float mk[3], lk[3]; int pidx[3];
        float M = sm.m + c2 * 256.f * (float)qb;
        const float mself = M;
#pragma unroll
        for (int k = 0; k < 3; ++k) { const int jk = (s3 >> (8 * k)) & 255, lrk = (l3 >> (8 * k)) & 255;
            const int pb = __shfl(base, jk & 31);
            if (jk < 32) { pidx[k] = pb + lrk; mk[k] = PM[pidx[k]] + c2 * 256.f * (float)jk; lk[k] = PL[pidx[k]]; M = __builtin_fmaxf(M, mk[k]); }
            else { pidx[k] = -1; mk[k] = NEGS; lk[k] = 0.f; } }
        const float ws_ = __builtin_amdgcn_exp2f(mself - M);
        float wk[3]; float Lt = lself * ws_;
#pragma unroll
        for (int k = 0; k < 3; ++k) { wk[k] = pidx[k] >= 0 ? __builtin_amdgcn_exp2f(mk[k] - M) : 0.f; Lt += lk[k] * wk[k]; }
        const float inv = Lt > 0.f ? 1.f / Lt : 0.f;
        float* rws = wsf;
        float* rwk = (float*)(lds_raw + L_KMT) + wid * 256;
        int* rpi = (int*)(rwk + 96);
        if (hi == 0) { rws[r32] = ws_ * inv;
#pragma unroll
            for (int k = 0; k < 3; ++k) { rwk[k * 32 + r32] = wk[k] * inv; rpi[k * 32 + r32] = pidx[k]; } }
#pragma unroll
        for (int r = 0; r < 16; ++r) { const int orow = crow(r, hi); ostage[orow * 64 + r32] = o[0][r]; ostage[orow * 64 + 32 + r32] = o[1][r]; }
        wsync();
        const bf16_t* PO = (const bf16_t*)(p.ws + WS_PO) + (size_t)bh * MB_CAP * 64;
        bf16_t* AB = (bf16_t*)(p.ws + WS_ATTB);
#pragma unroll
        for (int i = 0; i < 4; ++i) { const int row = i * 8 + (lane >> 3), c8 = lane & 7;
            const float4 a = *(const float4*)(ostage + row * 64 + c8 * 8), c4 = *(const float4*)(ostage + row * 64 + c8 * 8 + 4);
            const float w0 = rws[row];
            float acc8[8] = {a.x * w0, a.y * w0, a.z * w0, a.w * w0, c4.x * w0, c4.y * w0, c4.z * w0, c4.w * w0};
#pragma unroll
            for (int k = 0; k < 3; ++k) { const int pi = rpi[k * 32 + row]; if (pi >= 0) { const float w = rwk[k * 32 + row]; const uint4 q = *(const uint4*)(PO + (size_t)pi * 64 + c8 * 8);
                const unsigned qq_[4] = {q.x, q.y, q.z, q.w};
#pragma unroll
                for (int e = 0; e < 4; ++e) { acc8[2 * e] += __builtin_bit_cast(float, qq_[e] << 16) * w; acc8[2 * e + 1] += __builtin_bit_cast(float, qq_[e] & 0xffff0000u) * w; } } }
            *(uint4*)(AB + ((size_t)b * S + qb * 256 + 32 * wid + row) * D + 512 + h * 64 + c8 * 8) = make_uint4(pk2(acc8[0], acc8[1]), pk2(acc8[2], acc8[3]), pk2(acc8[4], acc8[5]), pk2(acc8[6], acc8[7])); }
        wsync();
    }
    AT_WAITL(); bar();
}
}

__device__ __forceinline__ void phase_att1(const Params& p, unsigned char* lds_raw) {
    const int tid = otid();
    int* pre = (int*)(lds_raw + at::L_END);
    int* segt = pre + 514;
    { const int* BCm = (const int*)(p.ws + WS_BCM); const int bh = tid >> 5, j = tid & 31; int s = 0;
      for (int q = 0; q < 32; ++q) s += BCm[(size_t)(bh * 32 + q) * 32 + j];
      pre[tid + 1] = (s + 255) >> 8; if (tid == 0) pre[0] = 0;
      segt[tid] = (s + 31) & ~31; }
    __syncthreads();
    for (int sft = 1; sft < 512; sft <<= 1) { int v = 0, w = 0; if (tid >= sft) v = pre[tid + 1 - sft]; if ((tid & 31) >= sft) w = segt[tid - sft]; __syncthreads(); pre[tid + 1] += v; if (sft < 32) segt[tid] += w; __syncthreads(); }
    { const int* BCm = (const int*)(p.ws + WS_BCM); const int bh = tid >> 5, j = tid & 31; int s = 0;
      for (int q = 0; q < 32; ++q) s += BCm[(size_t)(bh * 32 + q) * 32 + j];
      const int excl = segt[tid] - ((s + 31) & ~31); __syncthreads(); segt[tid] = excl; }
    __syncthreads();
    const int nun = pre[512];
    for (int pi = blockIdx.x; pi < 512; pi += gridDim.x) {
        const int rnd = pi >> 8, id = pi & 255;
        const int bg = 2 * rnd + (id >> 7), c = rnd ? 127 - (id & 127) : (id & 127); at::nsa_unit(p, bg >> 1, bg & 1, c, lds_raw);
    }
    {
        const int u0 = (int)(((long)blockIdx.x * nun) / gridDim.x), u1 = (int)(((long)(blockIdx.x + 1) * nun) / gridDim.x);
        int prev = -1;
        for (int u = u0; u < u1; ++u) {
            int lo = 0, hi_ = 511;
            while (lo < hi_) { const int mid = (lo + hi_ + 1) >> 1; if (pre[mid] <= u) lo = mid; else hi_ = mid - 1; }
            at::moba_gather_unit(p, lo >> 5, lo & 31, u - pre[lo], segt[lo], lo != prev, lds_raw);
            prev = lo;
        }
    }
}
__device__ __forceinline__ void phase_att2(const Params& p, unsigned char* lds_raw) {
    for (int pi = blockIdx.x; pi < 512; pi += gridDim.x) {
        const int rnd = pi >> 8, id = pi & 255;
        const int bh = 8 * rnd + (id >> 5), qb = rnd ? 31 - (id & 31) : (id & 31); at::moba_self_unit(p, bh >> 3, bh & 7, qb, lds_raw);
    }
}
__device__ __forceinline__ void phase_route(const Params& p, unsigned char* lds_raw) {
    for (int pi = blockIdx.x; pi < 512; pi += gridDim.x) at::moba_route_unit(p, pi >> 8, (pi >> 5) & 7, pi & 31, lds_raw);
}


__device__ __forceinline__ void phase_r2_fast(const Params& p, int l, unsigned char* lds_raw) {
    using namespace at;
    const int tid = otid(), lane = tid & 63, wave = __builtin_amdgcn_readfirstlane(tid >> 6), r32 = lane & 31, hi = lane >> 5;
    const float* mod = (const float*)(p.ws + WS_MOD);
    const bf16_t* XAB = (const bf16_t*)(p.ws + WS_XAB); bf16_t* XN = (bf16_t*)(p.ws + WS_XN); bf16_t* XL = (bf16_t*)(p.ws + WS_XNLO);
    const float* lng = p.in[5] + (size_t)l * D; const float* rw = p.in[15] + (size_t)l * D * NE; const float* rb = p.in[16] + l * NE;
    int* toke = (int*)(p.ws + WS_TOKE); float* tokw = (float*)(p.ws + WS_TOKW); int* BC = (int*)(p.ws + WS_BC);
    lp lds = (lp)lds_raw;
    int* hist = (int*)(lds_raw + 131072);
    for (int blk = blockIdx.x; blk < T / 64; blk += gridDim.x) {
        for (int idx = tid; idx < 128 * 32; idx += NT) {
            const int kc = idx >> 5, e = idx & 31; float v[8];
#pragma unroll
            for (int j = 0; j < 8; ++j) v[j] = rw[(size_t)(8 * kc + j) * NE + e];
            unsigned hh[8], ll[8];
#pragma unroll
            for (int j = 0; j < 8; ++j) { hh[j] = f2bf(v[j]); ll[j] = f2bf(v[j] - __builtin_bit_cast(float, hh[j] << 16)); }
            *(uint4*)(lds_raw + (size_t)idx * 16) = make_uint4(hh[0] | (hh[1] << 16), hh[2] | (hh[3] << 16), hh[4] | (hh[5] << 16), hh[6] | (hh[7] << 16));
            *(uint4*)(lds_raw + 65536 + (size_t)idx * 16) = make_uint4(ll[0] | (ll[1] << 16), ll[2] | (ll[3] << 16), ll[4] | (ll[5] << 16), ll[6] | (ll[7] << 16));
        }
        if (tid < 32) hist[tid] = 0;
        {
            const int b = (blk * 64) / S;
            const float* sh = mod + ((size_t)l * Bn + b) * 6144 + 3 * D; const float* sc = mod + ((size_t)l * Bn + b) * 6144 + 4 * D;
            float4 ga[4], s0v[4];
#pragma unroll
            for (int j = 0; j < 4; ++j) { const int col = 4 * lane + 256 * j; const float4 g = *(const float4*)(lng + col), s1 = *(const float4*)(sc + col); s0v[j] = *(const float4*)(sh + col);
                ga[j] = make_float4(g.x * (1.f + s1.x), g.y * (1.f + s1.y), g.z * (1.f + s1.z), g.w * (1.f + s1.w)); }
#pragma unroll 1
            for (int i0 = 0; i0 < 8; i0 += 4) {
                uint2 q_[4][4];
#pragma unroll
                for (int i = 0; i < 4; ++i)
#pragma unroll
                    for (int j = 0; j < 4; ++j) q_[i][j] = *(const uint2*)(XAB + (size_t)(blk * 64 + wave * 8 + i0 + i) * D + 4 * lane + 256 * j);
                float ss[4];
#pragma unroll
                for (int i = 0; i < 4; ++i) { float s_ = 0.f;
#pragma unroll
                    for (int j = 0; j < 4; ++j) { const float x0 = __builtin_bit_cast(float, q_[i][j].x << 16), x1 = __builtin_bit_cast(float, q_[i][j].x & 0xffff0000u), x2 = __builtin_bit_cast(float, q_[i][j].y << 16), x3 = __builtin_bit_cast(float, q_[i][j].y & 0xffff0000u);
                        s_ += (x0 * x0 + x1 * x1) + (x2 * x2 + x3 * x3); }
                    ss[i] = s_; }
#pragma unroll
                for (int sft = 32; sft >= 1; sft >>= 1) {
#pragma unroll
                    for (int i = 0; i < 4; ++i) ss[i] += __shfl_xor(ss[i], sft); }
#pragma unroll
                for (int i = 0; i < 4; ++i) {
                    const int t = blk * 64 + wave * 8 + i0 + i;
                    const float r = rsqrtf(ss[i] * (1.f / D) + EPS);
#pragma unroll
                    for (int j = 0; j < 4; ++j) {
                        const int col = 4 * lane + 256 * j;
                        const float x0 = __builtin_bit_cast(float, q_[i][j].x << 16), x1 = __builtin_bit_cast(float, q_[i][j].x & 0xffff0000u), x2 = __builtin_bit_cast(float, q_[i][j].y << 16), x3 = __builtin_bit_cast(float, q_[i][j].y & 0xffff0000u);
                        const float o[4] = {x0 * r * ga[j].x + s0v[j].x, x1 * r * ga[j].y + s0v[j].y, x2 * r * ga[j].z + s0v[j].z, x3 * r * ga[j].w + s0v[j].w};
                        unsigned hh[4], ll[4];
#pragma unroll
                        for (int q = 0; q < 4; ++q) { hh[q] = f2bf(o[q]); ll[q] = f2bf(o[q] - __builtin_bit_cast(float, hh[q] << 16)); }
                        *(uint2*)(XN + (size_t)t * D + col) = make_uint2(hh[0] | (hh[1] << 16), hh[2] | (hh[3] << 16));
                        *(uint2*)(XL + (size_t)t * D + col) = make_uint2(ll[0] | (ll[1] << 16), ll[2] | (ll[3] << 16));
                    }
                }
            }
        }
        asm volatile("s_waitcnt vmcnt(0)" ::: "memory");
        __syncthreads();
        f32x16 acc = f32x16{};
        {
            const int rh = wave & 1, kq = wave >> 1;
            const int t = blk * 64 + rh * 32 + r32;
            const bf16_t* xh = XN + (size_t)t * D + 8 * hi + 256 * kq; const bf16_t* xl = XL + (size_t)t * D + 8 * hi + 256 * kq;
            const AT_LAS unsigned char* wh = lds + (size_t)(hi * 32 + r32) * 16 + (size_t)kq * 16 * 1024; const AT_LAS unsigned char* wl = wh + 65536;
#pragma unroll 8
            for (int ks = 0; ks < 16; ++ks) {
                const bf16x8 bh = *(const bf16x8*)(xh + 16 * ks), bl = *(const bf16x8*)(xl + 16 * ks);
                const bf16x8 ah = *(const AT_LAS bf16x8*)(wh + ks * 1024), al = *(const AT_LAS bf16x8*)(wl + ks * 1024);
                acc = __builtin_amdgcn_mfma_f32_32x32x16_bf16(ah, bh, acc, 0, 0, 0);
                acc = __builtin_amdgcn_mfma_f32_32x32x16_bf16(al, bh, acc, 0, 0, 0);
                acc = __builtin_amdgcn_mfma_f32_32x32x16_bf16(ah, bl, acc, 0, 0, 0);
            }
        }
        __syncthreads();
        { float* part = (float*)lds_raw;
          if (wave >= 2) {
#pragma unroll
              for (int r = 0; r < 16; ++r) part[(wave * 16 + r) * 64 + lane] = acc[r]; } }
        __syncthreads();
        if (wave < 2) {
            const int t = blk * 64 + wave * 32 + r32;
            { const float* part = (const float*)lds_raw;
#pragma unroll
              for (int r = 0; r < 16; ++r) acc[r] = ((acc[r] + part[((wave + 2) * 16 + r) * 64 + lane]) + part[((wave + 4) * 16 + r) * 64 + lane]) + part[((wave + 6) * 16 + r) * 64 + lane]; }
            float a0 = -3e38f, a1 = -3e38f, a2 = -3e38f, a3 = -3e38f; int i0 = 99, i1 = 99, i2 = 99, i3 = 99;
#pragma unroll
            for (int r = 0; r < 16; ++r) { const int e = crow(r, hi); const float s_ = acc[r] + rb[e];
                if (s_ > a0) { a3 = a2; i3 = i2; a2 = a1; i2 = i1; a1 = a0; i1 = i0; a0 = s_; i0 = e; }
                else if (s_ > a1) { a3 = a2; i3 = i2; a2 = a1; i2 = i1; a1 = s_; i1 = e; }
                else if (s_ > a2) { a3 = a2; i3 = i2; a2 = s_; i2 = e; }
                else if (s_ > a3) { a3 = s_; i3 = e; } }
            float ov[4]; int oi[4];
            { const float sv[4] = {a0, a1, a2, a3}; const int si[4] = {i0, i1, i2, i3};
#pragma unroll
              for (int k = 0; k < 4; ++k) { auto a = __builtin_amdgcn_permlane32_swap(__float_as_uint(sv[k]), __float_as_uint(sv[k]), false, false); ov[k] = __uint_as_float(hi ? a[0] : a[1]);
                                            auto c = __builtin_amdgcn_permlane32_swap((unsigned)si[k], (unsigned)si[k], false, false); oi[k] = (int)(hi ? c[0] : c[1]); } }
#pragma unroll
            for (int k = 0; k < 4; ++k) { const float s_ = ov[k]; const int e = oi[k];
                if (s_ > a0 || (s_ == a0 && e < i0)) { a3 = a2; i3 = i2; a2 = a1; i2 = i1; a1 = a0; i1 = i0; a0 = s_; i0 = e; }
                else if (s_ > a1 || (s_ == a1 && e < i1)) { a3 = a2; i3 = i2; a2 = a1; i2 = i1; a1 = s_; i1 = e; }
                else if (s_ > a2 || (s_ == a2 && e < i2)) { a3 = a2; i3 = i2; a2 = s_; i2 = e; }
                else if (s_ > a3 || (s_ == a3 && e < i3)) { a3 = s_; i3 = e; } }
            const float e1 = __expf(a1 - a0), e2 = __expf(a2 - a0), e3 = __expf(a3 - a0), inv = 1.f / (((1.f + e1) + e2) + e3);
            if (hi == 0) {
                *(int4*)(toke + (size_t)t * 4) = make_int4(i0, i1, i2, i3);
                *(float4*)(tokw + (size_t)t * 4) = make_float4(inv, e1 * inv, e2 * inv, e3 * inv);
                atomicAdd(&hist[i0], 1); atomicAdd(&hist[i1], 1); atomicAdd(&hist[i2], 1); atomicAdd(&hist[i3], 1);
            }
        }
        __syncthreads();
        if (tid < 32) BC[blk * 32 + tid] = hist[tid];
        __syncthreads();
    }
}
__device__ __forceinline__ void phase_sc_fast(const Params& p, int l, unsigned char* lds_raw) {
    const int tid = otid();
    const int* BC = (const int*)(p.ws + WS_BC);
    int* cnt = (int*)(p.ws + WS_CNT) + l * 32;
    int* tot = (int*)lds_raw; int* base = tot + 32; int* fillc = tot + 64; int* before = tot + 96;
    const int* toke = (const int*)(p.ws + WS_TOKE); const float* tokw = (const float*)(p.ws + WS_TOKW);
    int* rowtok = (int*)(p.ws + WS_ROWTOK) + (size_t)l * RMAX; float* roww = (float*)(p.ws + WS_ROWW) + (size_t)l * RMAX; int* pos = (int*)(p.ws + WS_POS);
    for (int blk = blockIdx.x; blk < T / 64; blk += gridDim.x) {
        { const int e = tid & 31, part = tid >> 5; int s = 0, bf = 0;
#pragma unroll 4
          for (int i = part * 16; i < part * 16 + 16; ++i) { const int c = BC[i * 32 + e]; s += c; if (i < blk) bf += c; }
          int* ptot = tot + 128; int* pbef = ptot + 512;
          ptot[tid] = s; pbef[tid] = bf; }
        __syncthreads();
        if (tid < 32) { const int* ptot = tot + 128; const int* pbef = ptot + 512; int s = 0, bf = 0;
#pragma unroll
            for (int q = 0; q < 16; ++q) { s += ptot[q * 32 + tid]; bf += pbef[q * 32 + tid]; }
            tot[tid] = s; before[tid] = bf; fillc[tid] = 0; if (blk == 0) cnt[tid] = s; }
        __syncthreads();
        if (tid == 0) { int s = 0; for (int e = 0; e < 32; ++e) { base[e] = s + before[e]; s += (tot[e] + 255) & ~255; } }
        __syncthreads();
        if (tid < 256) {
            const int i = blk * 256 + tid, e = toke[i];
            const int slot = base[e] + atomicAdd(&fillc[e], 1);
            rowtok[slot] = i >> 2; roww[slot] = tokw[i]; pos[i] = slot;
        }
        __syncthreads();
    }
}

#define XB_TMO      128
#define XB_XCNT(j)  (256  + 64 * (j))
#define XB_XSUB(j)  (1280 + 64 * (j))
#define XB_XGEN(j)  (2304 + 64 * (j))
#define XB_TOP      3328
#define XB_TOPGEN   3392
#define XCD_BAR_WORDS 3456
#define XB_SPIN_CAP (1u << 18)
#define XLAS __attribute__((address_space(3)))
__device__ __forceinline__ unsigned xb_ld(unsigned* p)              { return __hip_atomic_load(p, __ATOMIC_RELAXED, __HIP_MEMORY_SCOPE_AGENT); }
__device__ __forceinline__ unsigned xb_add(unsigned* p, unsigned v) { return __hip_atomic_fetch_add(p, v, __ATOMIC_RELAXED, __HIP_MEMORY_SCOPE_AGENT); }
__device__ __forceinline__ unsigned xb_xcc_id() { return (unsigned)__builtin_amdgcn_s_getreg((3 << 11) | 20) & 0xFu; }
#define XB_SPIN(cond, bar) do { unsigned _sp = 0; while (cond) { __builtin_amdgcn_s_sleep(1); \
    if ((++_sp & 255u) == 0u) { if (xb_ld(&(bar)[XB_TMO])) break; if (_sp > XB_SPIN_CAP) { atomicAdd(&(bar)[XB_TMO], 1u); break; } } } } while (0)
constexpr int LDS_BARST_OFF = 147200;
struct XcdBarrier { unsigned* bar; unsigned x; volatile XLAS unsigned* st; };
__device__ __forceinline__ XcdBarrier xcd_barrier_post(unsigned* bar, volatile XLAS unsigned* st) {
    XcdBarrier b; b.bar = bar; b.x = xb_xcc_id(); b.st = st;
    if (threadIdx.x == 0) (void)xb_add(&bar[XB_XCNT(b.x)], 1u);
    return b;
}
__device__ __forceinline__ void xcd_barrier_complete(unsigned* bar, unsigned x, unsigned& nloc, unsigned& nx) {
    const unsigned G = gridDim.x * gridDim.y * gridDim.z;
    unsigned sum, cnt, mine, sp = 0u;
    for (;;) {
        sum = 0u; cnt = 0u; mine = 0u;
#pragma unroll
        for (unsigned j = 0; j < 16; ++j) { const unsigned c = xb_ld(&bar[XB_XCNT(j)]); sum += c; cnt += (c > 0u) ? 1u : 0u; mine = (j == x) ? c : mine; }
        if (sum == G) break;
        __builtin_amdgcn_s_sleep(1);
        if ((++sp & 255u) == 0u) { if (xb_ld(&bar[XB_TMO])) break; if (sp > XB_SPIN_CAP) { atomicAdd(&bar[XB_TMO], 1u); break; } }
    }
    nloc = mine > 0u ? mine : 1u; nx = cnt > 0u ? cnt : 1u;
}
__device__ __forceinline__ void xcd_barrier(unsigned char* ws, unsigned char* lds_raw_) {
    XcdBarrier b; b.bar = (unsigned*)(ws + WS_BAR); b.x = xb_xcc_id(); b.st = (volatile XLAS unsigned*)((XLAS unsigned char*)lds_raw_ + LDS_BARST_OFF);
    asm volatile("s_waitcnt vmcnt(0)" ::: "memory");
    __syncthreads();
    if (threadIdx.x == 0) {
        unsigned* bar = b.bar;
        __builtin_amdgcn_s_waitcnt(0);
        unsigned nloc = b.st[0], nx = b.st[1];
        if (nloc == 0u) { xcd_barrier_complete(bar, b.x, nloc, nx); b.st[0] = nloc; b.st[1] = nx; }
        const unsigned old = xb_add(&bar[XB_XSUB(b.x)], 1u);
        const unsigned gen = old / nloc;
        if (old + 1u == (gen + 1u) * nloc) {
            __builtin_amdgcn_fence(__ATOMIC_RELEASE, "agent");
            asm volatile("s_waitcnt vmcnt(0)" ::: "memory");
            const unsigned og = xb_add(&bar[XB_TOP], 1u);
            const unsigned tg = og / nx;
            if (og + 1u == (tg + 1u) * nx) xb_add(&bar[XB_TOPGEN], 1u);
            else XB_SPIN(xb_ld(&bar[XB_TOPGEN]) == tg, bar);
            __builtin_amdgcn_fence(__ATOMIC_ACQUIRE, "agent");
            xb_add(&bar[XB_XGEN(b.x)], 1u);
            asm volatile("s_waitcnt vmcnt(0)" ::: "memory");
        } else {
            XB_SPIN(xb_ld(&bar[XB_XGEN(b.x)]) == gen, bar);
            __builtin_amdgcn_fence(__ATOMIC_ACQUIRE, "agent");
            asm volatile("s_waitcnt vmcnt(0)" ::: "memory");
        }
    }
    __syncthreads();
}

__global__ void __launch_bounds__(NT, 2) mega_fwd(Params p) {
    extern __shared__ __attribute__((aligned(16))) unsigned char lds_raw[];
    float* lds = (float*)lds_raw;
    volatile XLAS unsigned* bst = (volatile XLAS unsigned*)((XLAS unsigned char*)lds_raw + LDS_BARST_OFF);
    if (threadIdx.x < 2) bst[threadIdx.x] = 0u;
    __syncthreads();
    (void)xcd_barrier_post((unsigned*)(p.ws + WS_BAR), bst);
#define GSYNC() xcd_barrier(p.ws, lds_raw)
    phase_p0a(p, lds);
    __syncthreads();
    phase_convert(p, lds);
    GSYNC();
    phase_p0b(p);
    GSYNC();
    _Pragma("unroll 1") for (int l = 0; l < L; ++l) {
        phase_r1(p, l, true);
        GSYNC();
        phase_g1_fast(p, l, lds_raw);
        GSYNC();
        phase_ck_fast(p, l, lds_raw);
        GSYNC();
        phase_c2(p, l, lds);
        __syncthreads();
        phase_route(p, lds_raw);
        GSYNC();
        phase_att1(p, lds_raw);
        GSYNC();
        phase_att2(p, lds_raw);
        GSYNC();
        phase_g2_fast(p, l, lds_raw);
        GSYNC();
        phase_r2_fast(p, l, lds_raw);
        GSYNC();
        phase_sc_fast(p, l, lds_raw);
        GSYNC();
        phase_m1_fast(p, l, lds_raw);
        GSYNC();
        phase_m2_fast(p, l, lds_raw);
        GSYNC();
    }
    phase_r1(p, L, false);
}

extern "C" void kernel_launch(void* const* d_in, const int* in_sizes, int n_in, void* d_out, int out_size, void* d_ws, size_t ws_size, hipStream_t stream) {
    static int grid_blocks = 0;
    if (grid_blocks == 0) {
        if (n_in != 21 || out_size != T * D || ws_size < WS_END) { fprintf(stderr, "kernel_launch: unexpected shapes (n_in %d out %d ws %zu need %zu)\n", n_in, out_size, ws_size, (size_t)WS_END); grid_blocks = -1; return; }
        int dev = 0, cus = 0, per_cu = 0;
        hipGetDevice(&dev);
        hipDeviceGetAttribute(&cus, hipDeviceAttributeMultiprocessorCount, dev);
        hipFuncSetAttribute((const void*)mega_fwd, hipFuncAttributeMaxDynamicSharedMemorySize, LDS_BYTES);
        hipOccupancyMaxActiveBlocksPerMultiprocessor(&per_cu, (const void*)mega_fwd, NT, LDS_BYTES);
        if (per_cu < 1) { fprintf(stderr, "kernel_launch: occupancy query says %d blocks per CU\n", per_cu); per_cu = 1; }
        (void)hipGetLastError();
        grid_blocks = cus * 1;
    }
    if (grid_blocks < 0) return;
    if (hipMemsetAsync((char*)d_ws + WS_BAR, 0, 16384, stream) != hipSuccess) { fprintf(stderr, "kernel_launch: memset failed\n"); return; }
    Params p{};
    for (int i = 0; i < 21; ++i) p.in[i] = (const float*)d_in[i];
    p.out = (float*)d_out; p.ws = (unsigned char*)d_ws;
    hipLaunchKernelGGL(mega_fwd, dim3(grid_blocks), dim3(NT), LDS_BYTES, stream, p);
    hipError_t e = hipPeekAtLastError();
    if (e != hipSuccess) fprintf(stderr, "launch failed: %s (grid %d)\n", hipGetErrorString(e), grid_blocks);
}
```

```cpp
#include <hip/hip_runtime.h>
#include <cstdio>
#include <cstdint>

constexpr int Bn = 2, S = 8192, D = 1024, L = 2, T = Bn * S;
constexpr int INW = 2840;
constexpr int NE = 32, TOPK = 4, DFF = 1024;
constexpr int A_TOT = T * TOPK;
constexpr int RMAX = A_TOT + NE * 256;
constexpr int NCMP = 511;
constexpr int NT = 512;
constexpr int NW = NT / 64;
constexpr int LDS_BYTES = 147456;
constexpr float EPS = 1e-6f;
constexpr float NEGF = -1e30f;

constexpr int ZBW = 3072;
constexpr int ZB_Q = 0, ZB_KC = 512, ZB_VC = 640, ZB_KS = 768, ZB_VS = 896, ZB_KW = 1024, ZB_VW = 1152, ZB_MQ = 1280, ZB_MK = 1792, ZB_MV = 2304, ZB_G = 2816;
constexpr float QSCALE = 0.125f * 1.4426950408889634f;
constexpr float LOG2E = 1.4426950408889634f;

constexpr size_t al256(size_t x) { return (x + 255) & ~(size_t)255; }
constexpr size_t WS_BAR = 0;
constexpr size_t WS_MODP = 16384;
constexpr size_t WS_MOD = al256(WS_MODP + (size_t)8 * L * Bn * 6144 * 4);
constexpr size_t WS_CNT = al256(WS_MOD + (size_t)L * Bn * 6144 * 4);
constexpr size_t WS_ROWTOK = al256(WS_CNT + L * 32 * 4);
constexpr size_t WS_ROWW = al256(WS_ROWTOK + (size_t)L * RMAX * 4);
constexpr size_t WS_TOKE = al256(WS_ROWW + (size_t)L * RMAX * 4);
constexpr size_t WS_TOKW = al256(WS_TOKE + (size_t)T * 4 * 4);
constexpr size_t WS_POS = al256(WS_TOKW + (size_t)T * 4 * 4);
constexpr size_t WS_Y = al256(WS_POS + (size_t)T * 4 * 4);
constexpr size_t WS_WINT = al256(WS_Y + (size_t)RMAX * 1024 * 4);
constexpr size_t WS_WOT = al256(WS_WINT + (size_t)L * 3072 * 1024 * 2);
constexpr size_t WS_W1T = al256(WS_WOT + (size_t)L * 1024 * 1024 * 2);
constexpr size_t WS_W2T = al256(WS_W1T + (size_t)L * NE * 2048 * 1024 * 2);
constexpr size_t WS_XN = al256(WS_W2T + (size_t)L * NE * 1024 * 1024 * 2);
constexpr size_t WS_ATTB = al256(WS_XN + (size_t)(T + 1) * D * 2);
constexpr size_t WS_ACT = al256(WS_ATTB + (size_t)T * D * 2);
constexpr size_t WS_ZB = al256(WS_ACT + (size_t)RMAX * DFF * 2);
constexpr size_t WS_GATE = al256(WS_ZB + (size_t)T * ZBW * 2);
constexpr size_t WS_KCB = al256(WS_GATE + (size_t)T * 32 * 4);
constexpr size_t WS_VCB = al256(WS_KCB + (size_t)Bn * 2 * 512 * 64 * 2);
constexpr size_t WS_KMB = al256(WS_VCB + (size_t)Bn * 2 * 512 * 64 * 2);
constexpr size_t WS_XNLO = al256(WS_KMB + (size_t)Bn * 8 * 32 * 64 * 2);
constexpr size_t WS_BC = al256(WS_XNLO + (size_t)T * D * 2);
constexpr size_t WS_WCT = al256(WS_BC + (size_t)(T / 64) * 32 * 4);
constexpr size_t WS_CBP = al256(WS_WCT + (size_t)L * 2 * 128 * 2048 * 2);
constexpr size_t WS_CB = al256(WS_CBP + (size_t)16 * L * 2 * 128 * 4);
constexpr size_t WS_HIDP = al256(WS_CB + (size_t)L * 2 * 128 * 4);
constexpr size_t WS_XAB = al256(WS_HIDP + (size_t)4 * 2 * 2044 * 128 * 4);
constexpr size_t WS_SEL3 = al256(WS_XAB + (size_t)T * D * 2);
constexpr size_t WS_LRK = al256(WS_SEL3 + (size_t)T * 8 * 4);
constexpr size_t WS_ILIST = al256(WS_LRK + (size_t)T * 8 * 4);
constexpr size_t WS_BCM = al256(WS_ILIST + (size_t)16 * 32 * 32 * 256);
constexpr size_t WS_PM = al256(WS_BCM + (size_t)16 * 32 * 32 * 4);
constexpr size_t WS_PL = al256(WS_PM + (size_t)16 * 25600 * 4);
constexpr size_t WS_PO = al256(WS_PL + (size_t)16 * 25600 * 4);
constexpr size_t WS_END = al256(WS_PO + (size_t)16 * 25600 * 64 * 2);

struct Params {
    const float* in[21];
    float* out;
    unsigned char* ws;
};

__device__ __forceinline__ int otid() { int t = threadIdx.x; asm volatile("" : "+v"(t)); return t; }
typedef unsigned short bf16_t;
__device__ __forceinline__ unsigned f2bf(float f) { unsigned u = __builtin_bit_cast(unsigned, f); return (u + 0x7fffu + ((u >> 16) & 1u)) >> 16; }
__device__ __forceinline__ unsigned pk2(float lo, float hi) { return f2bf(lo) | (f2bf(hi) << 16); }
__device__ __forceinline__ float bf2f(bf16_t v) { return __builtin_bit_cast(float, (unsigned)v << 16); }
__device__ __forceinline__ float wave_sum(float v) {
#pragma unroll
    for (int o = 1; o < 64; o <<= 1) v += __shfl_xor(v, o);
    return v;
}
__device__ __forceinline__ float sigmoidf_(float x) { return 1.f / (1.f + __expf(-x)); }
__device__ __forceinline__ float gelu_tanh(float x) {
    const float u = 0.7978845608028654f * (x + 0.044715f * x * x * x);
    return 0.5f * x * (1.f + tanhf(u));
}

__device__ __forceinline__ void phase_p0a(const Params& p, float* lds) {
    const int tid = otid(), gtid = blockIdx.x * NT + tid, gsz = gridDim.x * NT;
    int* cnt = (int*)(p.ws + WS_CNT); int* rowtok = (int*)(p.ws + WS_ROWTOK);
    for (int i = gtid; i < L * 32; i += gsz) cnt[i] = 0;
    for (int i = gtid; i < L * RMAX; i += gsz) rowtok[i] = -1;
    const float* c = p.in[1];
    for (int i = tid; i < Bn * D; i += NT) { const float v = c[i]; lds[i] = v / (1.f + __expf(-v)); }
    __syncthreads();
    const float* ada_w = p.in[2];
    float* modp = (float*)(p.ws + WS_MODP);
    for (int idx = gtid; idx < 8 * L * 6144; idx += gsz) {
        const int col = idx % 6144, l = (idx / 6144) % L, kc = idx / (6144 * L);
        const float* w = ada_w + ((size_t)l * D + kc * 128) * 6144 + col;
        float a0 = 0.f, a1 = 0.f, c0 = 0.f, c1 = 0.f;
#pragma unroll 1
        for (int k0 = 0; k0 < 128; k0 += 32) { float wv[32];
#pragma unroll
            for (int k = 0; k < 32; ++k) wv[k] = __builtin_nontemporal_load(w + (size_t)(k0 + k) * 6144);
#pragma unroll
            for (int k = 0; k < 32; k += 2) { a0 += lds[kc * 128 + k0 + k] * wv[k]; a1 += lds[D + kc * 128 + k0 + k] * wv[k]; c0 += lds[kc * 128 + k0 + k + 1] * wv[k + 1]; c1 += lds[D + kc * 128 + k0 + k + 1] * wv[k + 1]; } }
        modp[((size_t)(kc * L + l) * Bn + 0) * 6144 + col] = a0 + c0;
        modp[((size_t)(kc * L + l) * Bn + 1) * 6144 + col] = a1 + c1;
    }
    { const float* posw = p.in[9]; const float* w1c = p.in[10]; float* cbp = (float*)(p.ws + WS_CBP);
      int first = 8 * L * 6144; if (first + 16 * L * 2 * 128 > gsz) first = 0;
      for (int idx = gtid - first; idx < 16 * L * 2 * 128; idx += gsz) { if (idx < 0) continue;
          const int j = idx & 127, li = (idx >> 7) % (L * 2), kc = idx / (L * 2 * 128);
          const float* w = w1c + ((size_t)li * 2048 + kc * 128) * 128 + j; const float* pp = posw + (size_t)li * 2048 + kc * 128;
          float a = 0.f, c_ = 0.f;
#pragma unroll 1
          for (int k0 = 0; k0 < 128; k0 += 32) { float wv[32];
#pragma unroll
              for (int k = 0; k < 32; ++k) wv[k] = w[(size_t)(k0 + k) * 128];
#pragma unroll
              for (int k = 0; k < 32; k += 2) { a += pp[k0 + k] * wv[k]; c_ += pp[k0 + k + 1] * wv[k + 1]; } }
          cbp[idx] = a + c_; } }
}
__device__ __forceinline__ void phase_p0b(const Params& p) {
    const int gtid = blockIdx.x * NT + otid(), gsz = gridDim.x * NT;
    { const float* cbp = (const float*)(p.ws + WS_CBP); float* cb = (float*)(p.ws + WS_CB);
      for (int idx = gtid; idx < L * 2 * 128; idx += gsz) { float s = 0.f;
#pragma unroll
          for (int kc = 0; kc < 16; ++kc) s += cbp[kc * (L * 2 * 128) + idx];
          cb[idx] = s; } }
    const float* modp = (const float*)(p.ws + WS_MODP); float* mod = (float*)(p.ws + WS_MOD); const float* ada_b = p.in[3];
    for (int idx = gtid; idx < L * Bn * 6144; idx += gsz) {
        const int col = idx % 6144, l = idx / (Bn * 6144);
        float s = ada_b[l * 6144 + col];
#pragma unroll
        for (int kc = 0; kc < 8; ++kc) s += modp[(size_t)kc * L * Bn * 6144 + idx];
        mod[idx] = s;
    }
}

__device__ __forceinline__ void phase_r1(const Params& p, int l, bool do_h) {
    const int lane = otid() & 63, wave = otid() >> 6;
    const int gw = blockIdx.x * NW + wave, ngw = gridDim.x * NW;
    const float* mod = (const float*)(p.ws + WS_MOD);
    const float* xin = p.in[0]; float* XA = p.out;
    const bf16_t* Y = (const bf16_t*)(p.ws + WS_Y); const int* pos = (const int*)(p.ws + WS_POS); const float* tokw = (const float*)(p.ws + WS_TOKW);
    const float* lng = p.in[4] + (size_t)(do_h ? l : 0) * D;
    bf16_t* XN = (bf16_t*)(p.ws + WS_XN); bf16_t* XAB = (bf16_t*)(p.ws + WS_XAB);
#define BF4(q) make_float4(__builtin_bit_cast(float, (q).x << 16), __builtin_bit_cast(float, (q).x & 0xffff0000u), __builtin_bit_cast(float, (q).y << 16), __builtin_bit_cast(float, (q).y & 0xffff0000u))
    int curb = -1; float4 g2v[4], ga[4], s0v[4];
    for (int t0 = gw; t0 < T; t0 += ngw) {
        const int nr = 1;
        float4 v[2][4];
        if (l == 0) {
#pragma unroll
            for (int i = 0; i < 2; ++i) if (i < nr) {
#pragma unroll
                for (int j = 0; j < 4; ++j) v[i][j] = *(const float4*)(xin + (size_t)(t0 + i * ngw) * D + 4 * lane + 256 * j); }
        } else {
            int4 ps[2]; float4 tw[2]; uint2 xq[2][4];
#pragma unroll
            for (int i = 0; i < 2; ++i) if (i < nr) { const int t = t0 + i * ngw; ps[i] = *(const int4*)(pos + (size_t)t * 4); tw[i] = *(const float4*)(tokw + (size_t)t * 4);
#pragma unroll
                for (int j = 0; j < 4; ++j) xq[i][j] = *(const uint2*)(XAB + (size_t)t * D + 4 * lane + 256 * j); }
            uint2 yq[2][4][4];
#pragma unroll
            for (int i = 0; i < 2; ++i) if (i < nr) {
#pragma unroll
                for (int j = 0; j < 4; ++j) { const int col = 4 * lane + 256 * j;
                    yq[i][j][0] = *(const uint2*)(Y + (size_t)ps[i].x * D + col); yq[i][j][1] = *(const uint2*)(Y + (size_t)ps[i].y * D + col);
                    yq[i][j][2] = *(const uint2*)(Y + (size_t)ps[i].z * D + col); yq[i][j][3] = *(const uint2*)(Y + (size_t)ps[i].w * D + col); } }
#pragma unroll
            for (int i = 0; i < 2; ++i) if (i < nr) {
                const int t = t0 + i * ngw, b = t / S;
                if (b != curb) { curb = b;
                    const float* g2 = mod + ((size_t)(l - 1) * Bn + b) * 6144 + 5 * D;
#pragma unroll
                    for (int j = 0; j < 4; ++j) g2v[j] = *(const float4*)(g2 + 4 * lane + 256 * j);
                    if (do_h) { const float* sh = mod + ((size_t)l * Bn + b) * 6144 + 0 * D; const float* sc = mod + ((size_t)l * Bn + b) * 6144 + 1 * D;
#pragma unroll
                        for (int j = 0; j < 4; ++j) { const int col = 4 * lane + 256 * j; const float4 g = *(const float4*)(lng + col), s1 = *(const float4*)(sc + col); s0v[j] = *(const float4*)(sh + col);
                            ga[j] = make_float4(g.x * (1.f + s1.x), g.y * (1.f + s1.y), g.z * (1.f + s1.z), g.w * (1.f + s1.w)); } } }
#pragma unroll
                for (int j = 0; j < 4; ++j) {
                    const int col = 4 * lane + 256 * j;
                    const float4 x = BF4(xq[i][j]);
                    const float4 y0 = BF4(yq[i][j][0]), y1 = BF4(yq[i][j][1]), y2 = BF4(yq[i][j][2]), y3 = BF4(yq[i][j][3]);
                    const float4 g = g2v[j];
                    float4 r;
                    r.x = x.x + g.x * (((tw[i].x * y0.x + tw[i].y * y1.x) + tw[i].z * y2.x) + tw[i].w * y3.x); r.y = x.y + g.y * (((tw[i].x * y0.y + tw[i].y * y1.y) + tw[i].z * y2.y) + tw[i].w * y3.y);
                    r.z = x.z + g.z * (((tw[i].x * y0.z + tw[i].y * y1.z) + tw[i].z * y2.z) + tw[i].w * y3.z); r.w = x.w + g.w * (((tw[i].x * y0.w + tw[i].y * y1.w) + tw[i].z * y2.w) + tw[i].w * y3.w);
                    v[i][j] = r;
                    if (do_h) *(uint2*)(XAB + (size_t)t * D + col) = make_uint2(pk2(r.x, r.y), pk2(r.z, r.w));
                    else *(float4*)(XA + (size_t)t * D + col) = r;
                }
            }
        }
        if (do_h) {
#pragma unroll
            for (int i = 0; i < 2; ++i) if (i < nr) {
                const int t = t0 + i * ngw, b = t / S;
                if (b != curb) { curb = b;
                    const float* sh = mod + ((size_t)l * Bn + b) * 6144 + 0 * D; const float* sc = mod + ((size_t)l * Bn + b) * 6144 + 1 * D;
#pragma unroll
                    for (int j = 0; j < 4; ++j) { const int col = 4 * lane + 256 * j; const float4 g = *(const float4*)(lng + col), s1 = *(const float4*)(sc + col); s0v[j] = *(const float4*)(sh + col);
                        ga[j] = make_float4(g.x * (1.f + s1.x), g.y * (1.f + s1.y), g.z * (1.f + s1.z), g.w * (1.f + s1.w)); } }
                float ss = 0.f;
#pragma unroll
                for (int j = 0; j < 4; ++j) ss += (v[i][j].x * v[i][j].x + v[i][j].y * v[i][j].y) + (v[i][j].z * v[i][j].z + v[i][j].w * v[i][j].w);
                ss = wave_sum(ss);
                const float r = rsqrtf(ss * (1.f / D) + EPS);
#pragma unroll
                for (int j = 0; j < 4; ++j) {
                    const int col = 4 * lane + 256 * j;
                    float4 o;
                    o.x = v[i][j].x * r * ga[j].x + s0v[j].x; o.y = v[i][j].y * r * ga[j].y + s0v[j].y;
                    o.z = v[i][j].z * r * ga[j].z + s0v[j].z; o.w = v[i][j].w * r * ga[j].w + s0v[j].w;
                    *(uint2*)(XN + (size_t)t * D + col) = make_uint2(pk2(o.x, o.y), pk2(o.z, o.w));
                }
            }
        }
    }
#undef BF4
}


__device__ __forceinline__ void phase_c2(const Params& p, int l, float* lds) {
    const int lane = otid() & 63, wave = otid() >> 6;
    const float* HIDP = (const float*)(p.ws + WS_HIDP); const float* cb = (const float*)(p.ws + WS_CB) + l * 2 * 128; const float* w2 = p.in[11] + (size_t)l * 2 * 128 * 64;
    const float gk = p.in[8][l * 64 + lane];
    float* hl = lds + wave * 128;
    for (int r = blockIdx.x * NW + wave; r < 2 * 2044; r += gridDim.x * NW) {
        const int idx = r / 2044, rr = r % 2044;
#pragma unroll
        for (int q = 0; q < 2; ++q) { const int j = lane + 64 * q; float s = cb[idx * 128 + j];
#pragma unroll
            for (int kq = 0; kq < 4; ++kq) s += HIDP[((size_t)(kq * 2 + idx) * 2044 + rr) * 128 + j];
            hl[j] = gelu_tanh(s); }
        asm volatile("s_waitcnt lgkmcnt(0)" ::: "memory"); __builtin_amdgcn_wave_barrier();
        const float* W = w2 + (size_t)idx * 128 * 64;
        float s = 0.f;
#pragma unroll 8
        for (int j = 0; j < 128; ++j) s += hl[j] * W[j * 64 + lane];
        asm volatile("s_waitcnt lgkmcnt(0)" ::: "memory"); __builtin_amdgcn_wave_barrier();
        const int bgi = rr / 511, n = rr % 511;
        if (idx == 0) { const float ss = wave_sum(s * s); const float kv = s * rsqrtf(ss * (1.f / 64.f) + EPS) * gk; ((bf16_t*)(p.ws + WS_KCB))[((size_t)bgi * 512 + n) * 64 + lane] = (bf16_t)f2bf(kv); }
        else { ((bf16_t*)(p.ws + WS_VCB))[((size_t)bgi * 512 + n) * 64 + lane] = (bf16_t)f2bf(s); }
    }
    if (blockIdx.x == 0 && otid() < 2 * 4 * 64) { const int i = otid(); bf16_t* dst = (bf16_t*)(p.ws + (i < 256 ? WS_KCB : WS_VCB)); dst[((size_t)((i & 255) >> 6) * 512 + 511) * 64 + (i & 63)] = 0; }
}

__device__ __forceinline__ void load_pstart(const Params& p, int l, int* ps) {
    const int* cnt = (const int*)(p.ws + WS_CNT) + l * 32;
    if (otid() == 0) { int s = 0; for (int e = 0; e < 32; ++e) { ps[e] = s; s += (cnt[e] + 255) & ~255; } ps[32] = s; }
    __syncthreads();
}


template <int MAP>
__device__ __forceinline__ void tr_tile(const float* W, int Nsrc, bf16_t* WT, int K, int k0, int n0, float* scr, int lane) {
    const int nl = (lane & 15) * 4, kr = lane >> 4;
    int sc = n0 + nl;
    if (MAP == 1) { sc = sc < 1280 ? sc : (sc < 2816 ? sc + 24 : (sc < 2840 ? sc - 2816 + 1280 : -1)); }
    float4 v[16];
#pragma unroll
    for (int it = 0; it < 16; ++it) { if (sc >= 0) { const float* src_ = W + (size_t)(k0 + it * 4 + kr) * Nsrc + sc; typedef float f4v __attribute__((ext_vector_type(4))); const f4v t_ = __builtin_nontemporal_load((const f4v*)src_); v[it] = make_float4(t_[0], t_[1], t_[2], t_[3]); } else v[it] = make_float4(0.f, 0.f, 0.f, 0.f); }
#pragma unroll
    for (int it = 0; it < 16; ++it) { float* s = scr + (it * 4 + kr) * 65 + nl; s[0] = v[it].x; s[1] = v[it].y; s[2] = v[it].z; s[3] = v[it].w; }
    asm volatile("s_waitcnt lgkmcnt(0)" ::: "memory"); __builtin_amdgcn_wave_barrier();
    const int c = lane & 7, nr = lane >> 3;
#pragma unroll
    for (int it = 0; it < 8; ++it) {
        const int n = it * 8 + nr; const float* s = scr + (8 * c) * 65 + n;
        uint4 o; o.x = pk2(s[0], s[65]); o.y = pk2(s[2 * 65], s[3 * 65]); o.z = pk2(s[4 * 65], s[5 * 65]); o.w = pk2(s[6 * 65], s[7 * 65]);
        *(uint4*)(WT + (size_t)(n0 + n) * K + k0 + 8 * c) = o;
    }
    asm volatile("s_waitcnt lgkmcnt(0)" ::: "memory"); __builtin_amdgcn_wave_barrier();
}
__device__ __forceinline__ void phase_convert(const Params& p, float* lds) {
    const int tid = otid(), lane = tid & 63, wave = tid >> 6;
    float* scr = lds + wave * (64 * 65);
    const int gw = blockIdx.x * NW + wave, ngw = gridDim.x * NW;
    bf16_t* WinT = (bf16_t*)(p.ws + WS_WINT); bf16_t* WoT = (bf16_t*)(p.ws + WS_WOT); bf16_t* W1T = (bf16_t*)(p.ws + WS_W1T); bf16_t* W2T = (bf16_t*)(p.ws + WS_W2T);
    constexpr int I_IN = L * 16 * (ZBW / 64), I_O = L * 16 * 16, I_1 = L * NE * 16 * 32, I_2 = L * NE * 16 * 16, I_C = L * 2 * 32 * 2;
    for (int it = gw; it < I_C + I_IN + I_O + I_1 + I_2; it += ngw) {
        int r = it;
        if (r < I_C) { const int li = r / 64, q = r % 64, kb = q / 2, nb = q % 2;
            tr_tile<0>(p.in[10] + (size_t)li * 2048 * 128, 128, (bf16_t*)(p.ws + WS_WCT) + (size_t)li * 128 * 2048, 2048, kb * 64, nb * 64, scr, lane); continue; }
        r -= I_C;
        if (r < I_IN) { const int l = r / (16 * 48), q = r % (16 * 48), kb = q / 48, nb = q % 48;
            tr_tile<1>(p.in[6] + (size_t)l * D * INW, INW, WinT + (size_t)l * ZBW * D, D, kb * 64, nb * 64, scr, lane); continue; }
        r -= I_IN;
        if (r < I_O) { const int l = r / 256, q = r % 256, kb = q / 16, nb = q % 16;
            tr_tile<0>(p.in[14] + (size_t)l * D * D, D, WoT + (size_t)l * D * D, D, kb * 64, nb * 64, scr, lane); continue; }
        r -= I_O;
        if (r < I_1) { const int le = r / 512, q = r % 512, kb = q / 32, nb = q % 32;
            tr_tile<0>(p.in[17] + (size_t)le * D * 2048, 2048, W1T + (size_t)le * 2048 * D, D, kb * 64, nb * 64, scr, lane); continue; }
        r -= I_1;
        { const int le = r / 256, q = r % 256, kb = q / 16, nb = q % 16;
            tr_tile<0>(p.in[19] + (size_t)le * DFF * D, D, W2T + (size_t)le * D * DFF, DFF, kb * 64, nb * 64, scr, lane); }
    }
    if (blockIdx.x == 0) { bf16_t* XN = (bf16_t*)(p.ws + WS_XN); for (int i = tid; i < D / 2; i += NT) ((unsigned*)(XN + (size_t)T * D))[i] = 0u; }
}

namespace pg8 {
#define PG8_LAS __attribute__((address_space(3)))
typedef short bf16x8 __attribute__((ext_vector_type(8)));
typedef float f32x4 __attribute__((ext_vector_type(4)));
typedef unsigned u32x4 __attribute__((ext_vector_type(4)));
constexpr int BM = 256, BK = 64, HALF = 128, HTB = HALF * BK * 2, STAGE_BYTES = 8 * HTB, NXCD = 8, WGM = 8;
__device__ __forceinline__ int lds_byte(int r, int c) { const int st = (r >> 4) * 2 + (c >> 5), rr = r & 15, cc = c & 31, ob = rr * 64 + cc * 2; return st * 1024 + (ob ^ (((ob >> 9) & 1) << 5)); }
__device__ __forceinline__ void stage_rc(int b, int& R, int& C) { const int st = b / 1024, sb = b % 1024, swz = sb ^ (((sb >> 9) & 1) << 5); R = (st >> 1) * 16 + swz / 64; C = (st & 1) * 32 + (swz % 64) / 2; }
__device__ __forceinline__ int perm32(int rho) { const int n = rho >> 4, i = rho & 15; return 8 * (i >> 2) + 4 * n + (i & 3); }
struct Unit { int pm, pn, e; };
__device__ __forceinline__ unsigned cvt_pk_bf16(float lo, float hi) { unsigned r; asm volatile("v_cvt_pk_bf16_f32 %0, %1, %2" : "=v"(r) : "v"(lo), "v"(hi)); return r; }

__device__ __forceinline__ bool static_next(int nM, int nN, int G, int c, int i, Unit& u) {
    const int nwg = nM * nN; const long Lq = (long)i * G + c; if (Lq >= nwg) return false;
    int wgid = (int)Lq; { const int q = nwg / NXCD, r = nwg % NXCD, xcd = wgid % NXCD, off = wgid / NXCD; wgid = (xcd < r ? xcd * (q + 1) : r * (q + 1) + (xcd - r) * q) + off; }
    const int nig = WGM * nN, gid = wgid / nig, fm = gid * WGM, gsz = (nM - fm) < WGM ? (nM - fm) : WGM;
    u.pm = fm + ((wgid % nig) % gsz); u.pn = (wgid % nig) / gsz; u.e = 0; return true;
}

template <class Prob, class Epi, bool ALIGN_EPI, bool SP2>
__device__ __forceinline__ void gemm_phase(PG8_LAS unsigned char* lds, const Prob& P, const Epi& E) {
    const int tid = otid(), wid = __builtin_amdgcn_readfirstlane(tid >> 6), lane = tid & 63, wr = wid >> 2, wc = wid & 3, fr = lane & 15, fq = lane >> 4;
    const int K = P.K, nt = Prob::KT > 0 ? Prob::KT : K / BK;
    int sR[2], sC[2]; unsigned voffB[2];
#pragma unroll
    for (int i = 0; i < 2; ++i) { stage_rc(tid * 16 + i * 8192, sR[i], sC[i]); voffB[i] = (unsigned)(P.b_row(sR[i]) * K + sC[i]) * 2u; }
    const size_t kstep = (size_t)(BK * 2);
    const size_t kstepA = P.a_kstep();
    const size_t hstepB = P.b_hstep();
    const unsigned ldsw = (unsigned)wid * 1024u;
    const int aoff = lds_byte(wr * 64 + fr, fq * 8), boff = lds_byte(wc * 32 + fr, fq * 8);
#define PG8_SA(b, h) (((b) * 2 + (h)) * HTB)
#define PG8_SB(b, h) ((4 + (b) * 2 + (h)) * HTB)
#define PG8_STAGE(bufoff, gbase, voff) do { _Pragma("unroll") for (int _i = 0; _i < 2; ++_i) \
        __builtin_amdgcn_global_load_lds((const unsigned*)((const char*)(gbase) + (voff)[_i]), (PG8_LAS unsigned*)(lds + (bufoff) + ldsw + _i * 8192), 16, 0, 0); } while (0)
#define PG8_STAGE_SEL(bufoff, gbase, h) do { _Pragma("unroll") for (int _i = 0; _i < 2; ++_i) { unsigned _vo = vAc[h][_i]; if constexpr (Prob::GATHER) _vo = last ? vAn[h][_i] : _vo; \
        __builtin_amdgcn_global_load_lds((const unsigned*)((const char*)(gbase) + _vo), (PG8_LAS unsigned*)(lds + (bufoff) + ldsw + _i * 8192), 16, 0, 0); } } while (0)
#define PG8_LDA(dst, b, h) do { _Pragma("unroll") for (int m = 0; m < 4; ++m) _Pragma("unroll") for (int k = 0; k < 2; ++k) dst[m][k] = *(const PG8_LAS bf16x8*)(lds + PG8_SA(b, h) + aoff + m * 2048 + k * 1024); } while (0)
#define PG8_LDB(dst, b, h) do { _Pragma("unroll") for (int n = 0; n < 2; ++n) _Pragma("unroll") for (int k = 0; k < 2; ++k) dst[n][k] = *(const PG8_LAS bf16x8*)(lds + PG8_SB(b, h) + boff + n * 2048 + k * 1024); } while (0)
#define PG8_MMA(ai, bj, At, Bt) do { __builtin_amdgcn_s_setprio(1); _Pragma("unroll") for (int m = 0; m < 4; ++m) _Pragma("unroll") for (int n = 0; n < 2; ++n) _Pragma("unroll") for (int k = 0; k < 2; ++k) \
        acc[ai][bj][m][n] = __builtin_amdgcn_mfma_f32_16x16x32_bf16(Bt[n][k], At[m][k], acc[ai][bj][m][n], 0, 0, 0); __builtin_amdgcn_s_setprio(0); } while (0)
#define PG8_WAIT_V(n) asm volatile("s_waitcnt vmcnt(" #n ")" ::: "memory")
#define PG8_WAIT_L(n) asm volatile("s_waitcnt lgkmcnt(" #n ")" ::: "memory")
#define PG8_BAR __builtin_amdgcn_s_barrier()
#define PG8_SCHED __builtin_amdgcn_sched_barrier(0)
    Unit cur, nxt; int ui = 0;
    if (!P.next(0, cur)) return;
    nxt = cur;
    f32x4 acc[2][2][4][2];
    typename Epi::Pre pre;
    E.prefetch(cur, wc, fq, pre); E.init(acc, pre);
    bf16x8 At[4][2], B0[2][2], B1[2][2];
    unsigned vAc[2][2], vAn[2][2];
    const char* cA = P.a_base(cur); const char* cB = P.b_base(cur);
    P.a_voff(cur, sR, sC, vAc);
#pragma unroll
    for (int h = 0; h < 2; ++h)
#pragma unroll
        for (int i = 0; i < 2; ++i) vAn[h][i] = vAc[h][i];
    if constexpr (SP2) {
        PG8_STAGE(PG8_SB(0, 0), cB, voffB); PG8_STAGE(PG8_SB(0, 1), cB + hstepB, voffB); PG8_STAGE(PG8_SA(0, 0), cA, vAc[0]); PG8_STAGE(PG8_SA(0, 1), cA, vAc[1]);
        if (wr == 1) PG8_BAR;
        PG8_WAIT_V(2); PG8_BAR;
        PG8_STAGE(PG8_SB(1, 0), cB + kstep, voffB); PG8_STAGE(PG8_SA(1, 0), cA + kstepA, vAc[0]); PG8_STAGE(PG8_SB(1, 1), cB + hstepB + kstep, voffB);
        PG8_WAIT_V(6); PG8_BAR;
    } else {
        PG8_STAGE(PG8_SB(0, 0), cB, voffB); PG8_STAGE(PG8_SA(0, 0), cA, vAc[0]); PG8_STAGE(PG8_SB(0, 1), cB + hstepB, voffB); PG8_STAGE(PG8_SA(0, 1), cA, vAc[1]);
        if (wr == 1) PG8_BAR;
        PG8_WAIT_V(4); PG8_BAR;
        PG8_STAGE(PG8_SB(1, 0), cB + kstep, voffB); PG8_STAGE(PG8_SA(1, 0), cA + kstepA, vAc[0]); PG8_STAGE(PG8_SB(1, 1), cB + hstepB + kstep, voffB);
        PG8_WAIT_V(6); PG8_BAR;
    }
    for (;;) {
        const bool has_next = P.next(ui + 1, nxt);
        const char* nA = cA; const char* nB = cB;
        if (has_next) { nA = P.a_base(nxt); nB = P.b_base(nxt); if constexpr (Prob::GATHER) P.a_voff(nxt, sR, sC, vAn); }
        for (int t = 0; t < nt; t += 2) {
            const bool last = (t == nt - 2);
            const char* a1 = cA + (size_t)(t + 1) * kstepA;
            const char* a2 = last ? nA : cA + (size_t)(t + 2) * kstepA; const char* b2 = last ? nB : cB + (size_t)(t + 2) * kstep;
            const char* a3 = a2 + kstepA; const char* b3 = b2 + kstep;
            if constexpr (SP2) {
            PG8_LDB(B0, 0, 0); PG8_LDB(B1, 0, 1); PG8_SCHED; PG8_LDA(At, 0, 0); PG8_STAGE(PG8_SA(1, 1), a1, vAc[1]);
            PG8_WAIT_V(8); PG8_WAIT_L(0); PG8_BAR; PG8_MMA(0, 0, At, B0); PG8_MMA(0, 1, At, B1); PG8_BAR; PG8_SCHED;
            PG8_LDA(At, 0, 1); PG8_STAGE(PG8_SB(0, 0), b2, voffB); PG8_STAGE(PG8_SB(0, 1), b2 + hstepB, voffB); PG8_STAGE_SEL(PG8_SA(0, 0), a2, 0);
            PG8_WAIT_V(8); PG8_WAIT_L(0); PG8_BAR; PG8_MMA(1, 0, At, B0); PG8_MMA(1, 1, At, B1); PG8_BAR; PG8_SCHED;
            PG8_LDB(B0, 1, 0); PG8_LDB(B1, 1, 1); PG8_SCHED; PG8_LDA(At, 1, 0); PG8_STAGE_SEL(PG8_SA(0, 1), a2, 1);
            PG8_WAIT_V(8); PG8_WAIT_L(0); PG8_BAR; PG8_MMA(0, 0, At, B0); PG8_MMA(0, 1, At, B1); PG8_BAR; PG8_SCHED;
            PG8_LDA(At, 1, 1); PG8_STAGE(PG8_SB(1, 0), b3, voffB); PG8_STAGE(PG8_SB(1, 1), b3 + hstepB, voffB); PG8_STAGE_SEL(PG8_SA(1, 0), a3, 0);
            PG8_WAIT_V(8); PG8_WAIT_L(0); PG8_BAR; PG8_MMA(1, 0, At, B0); PG8_MMA(1, 1, At, B1); PG8_BAR; PG8_SCHED;
            } else {
            PG8_LDB(B0, 0, 0); PG8_SCHED; PG8_LDA(At, 0, 0); PG8_STAGE(PG8_SA(1, 1), a1, vAc[1]);
            PG8_WAIT_L(8); PG8_BAR; PG8_WAIT_L(0); PG8_MMA(0, 0, At, B0); PG8_BAR; PG8_SCHED;
            PG8_LDB(B1, 0, 1); PG8_STAGE(PG8_SB(0, 0), b2, voffB);
            PG8_BAR; PG8_WAIT_L(0); PG8_MMA(0, 1, At, B1); PG8_BAR;
            PG8_LDA(At, 0, 1); PG8_STAGE_SEL(PG8_SA(0, 0), a2, 0);
            PG8_BAR; PG8_WAIT_L(0); PG8_MMA(1, 0, At, B0); PG8_BAR; PG8_SCHED;
            PG8_STAGE(PG8_SB(0, 1), b2 + hstepB, voffB);
            PG8_WAIT_V(6); PG8_BAR; PG8_MMA(1, 1, At, B1); PG8_BAR;
            PG8_LDB(B0, 1, 0); PG8_SCHED; PG8_LDA(At, 1, 0); PG8_STAGE_SEL(PG8_SA(0, 1), a2, 1);
            PG8_WAIT_L(8); PG8_BAR; PG8_WAIT_L(0); PG8_MMA(0, 0, At, B0); PG8_BAR; PG8_SCHED;
            PG8_LDB(B1, 1, 1); PG8_STAGE(PG8_SB(1, 0), b3, voffB);
            PG8_BAR; PG8_WAIT_L(0); PG8_MMA(0, 1, At, B1); PG8_BAR;
            PG8_LDA(At, 1, 1); PG8_STAGE_SEL(PG8_SA(1, 0), a3, 0);
            PG8_BAR; PG8_WAIT_L(0); PG8_MMA(1, 0, At, B0); PG8_BAR; PG8_SCHED;
            PG8_STAGE(PG8_SB(1, 1), b3 + hstepB, voffB);
            PG8_WAIT_V(6); PG8_BAR; PG8_MMA(1, 1, At, B1); PG8_BAR;
            }
        }
        if constexpr (ALIGN_EPI) { if (wr == 0) PG8_BAR; }
        E(acc, cur, wr, wc, fr, fq, has_next, nxt, pre);
        if (!has_next) break;
        E.init(acc, pre);
        cur = nxt; cA = nA; cB = nB; ++ui;
        if constexpr (Prob::GATHER) {
#pragma unroll
            for (int h = 0; h < 2; ++h)
#pragma unroll
                for (int i = 0; i < 2; ++i) vAc[h][i] = vAn[h][i];
        }
        if constexpr (ALIGN_EPI) { if (wr == 1) PG8_BAR; }
    }
    PG8_WAIT_V(0);
    if constexpr (!ALIGN_EPI) { if (wr == 0) PG8_BAR; }
    PG8_BAR;
#undef PG8_SA
#undef PG8_SB
#undef PG8_STAGE
#undef PG8_STAGE_SEL
#undef PG8_LDA
#undef PG8_LDB
#undef PG8_MMA
#undef PG8_WAIT_V
#undef PG8_WAIT_L
#undef PG8_BAR
#undef PG8_SCHED
}

struct ProbDense { static constexpr bool GATHER = false; static constexpr int KT = 0;
    const bf16_t* A; const bf16_t* Bt; int K, nM, nN, G, c; bool headperm;
    __device__ __forceinline__ bool next(int i, Unit& u) const { return static_next(nM, nN, G, c, i, u); }
    __device__ __forceinline__ const char* a_base(const Unit& u) const { return (const char*)(A + (size_t)u.pm * BM * K); }
    __device__ __forceinline__ void a_voff(const Unit&, const int (&R)[2], const int (&C)[2], unsigned (&v)[2][2]) const {
#pragma unroll
        for (int h = 0; h < 2; ++h)
#pragma unroll
            for (int i = 0; i < 2; ++i) v[h][i] = (unsigned)((h * HALF + R[i]) * K + C[i]) * 2u;
    }
    __device__ __forceinline__ const char* b_base(const Unit& u) const { return (const char*)(Bt + (size_t)u.pn * BM * K); }
    __device__ __forceinline__ size_t a_kstep() const { return (size_t)BK * 2; }
    __device__ __forceinline__ size_t b_hstep() const { return headperm ? (size_t)32 * K * 2 : (size_t)HALF * K * 2; }
    __device__ __forceinline__ int b_row(int R) const { return headperm ? ((R >> 5) * 64 + perm32(R & 31)) : ((R & ~31) + perm32(R & 31)); }
};
typedef const PG8_LAS int* lds_ints;
__device__ __forceinline__ int expert_of(lds_ints ps, int pm) { int e = 0;
#pragma unroll
    for (int i = 1; i < 32; ++i) if (ps[i] <= pm * 256) e = i;
    return __builtin_amdgcn_readfirstlane(e); }
struct ProbMoe1 { static constexpr bool GATHER = true; static constexpr int KT = 0;
    const bf16_t* XN; const bf16_t* W1T; const int* rowtok; lds_ints ps; int K, ntm, G, c;
    __device__ __forceinline__ bool next(int i, Unit& u) const {
        if (G != 256) { const int q = i * G + c; if (q >= ntm * 8) return false; u.pm = q >> 3; u.pn = q & 7; u.e = expert_of(ps, u.pm); return true; }
        const int x = c & 7, s = c >> 3; const int pm = 4 * (i * 8 + x) + (s >> 3); if (pm >= ntm) return false;
        u.pm = pm; u.pn = s & 7; u.e = expert_of(ps, u.pm); return true; }
    __device__ __forceinline__ const char* a_base(const Unit&) const { return (const char*)XN; }
    __device__ __forceinline__ void a_voff(const Unit& u, const int (&R)[2], const int (&C)[2], unsigned (&v)[2][2]) const {
#pragma unroll
        for (int h = 0; h < 2; ++h)
#pragma unroll
            for (int i = 0; i < 2; ++i) { int tk = rowtok[u.pm * BM + h * HALF + R[i]]; if (tk < 0) tk = T; v[h][i] = (unsigned)(tk * K + C[i]) * 2u; }
    }
    __device__ __forceinline__ const char* b_base(const Unit& u) const { return (const char*)(W1T + ((size_t)u.e * 2048 + u.pn * 128) * K); }
    __device__ __forceinline__ size_t a_kstep() const { return (size_t)BK * 2; }
    __device__ __forceinline__ size_t b_hstep() const { return (size_t)1024 * K * 2; }
    __device__ __forceinline__ int b_row(int R) const { return (R & ~31) + perm32(R & 31); }
};
struct ProbMoe2 { static constexpr bool GATHER = false; static constexpr int KT = 0;
    const bf16_t* ACT; const bf16_t* W2T; lds_ints ps; int K, ntm, G, c;
    __device__ __forceinline__ bool next(int i, Unit& u) const {
        if (G != 256) { const int q = i * G + c; if (q >= ntm * 4) return false; u.pm = q >> 2; u.pn = q & 3; u.e = expert_of(ps, u.pm); return true; }
        const int x = c & 7, s = c >> 3; const int pm = 8 * (i * 8 + x) + (s >> 2); if (pm >= ntm) return false;
        u.pm = pm; u.pn = s & 3; u.e = expert_of(ps, u.pm); return true; }
    __device__ __forceinline__ const char* a_base(const Unit& u) const { return (const char*)(ACT + (size_t)u.pm * BM * K); }
    __device__ __forceinline__ void a_voff(const Unit&, const int (&R)[2], const int (&C)[2], unsigned (&v)[2][2]) const {
#pragma unroll
        for (int h = 0; h < 2; ++h)
#pragma unroll
            for (int i = 0; i < 2; ++i) v[h][i] = (unsigned)((h * HALF + R[i]) * K + C[i]) * 2u;
    }
    __device__ __forceinline__ const char* b_base(const Unit& u) const { return (const char*)(W2T + ((size_t)u.e * 1024 + u.pn * BM) * K); }
    __device__ __forceinline__ size_t a_kstep() const { return (size_t)BK * 2; }
    __device__ __forceinline__ size_t b_hstep() const { return (size_t)HALF * K * 2; }
    __device__ __forceinline__ int b_row(int R) const { return (R & ~31) + perm32(R & 31); }
};

struct ProbCmp { static constexpr bool GATHER = false; static constexpr int KT = 8;
    const bf16_t* ZB; const bf16_t* W1T; int K, G, c;
    __device__ __forceinline__ bool next(int i, Unit& u) const { const int q = i * G + c; if (q >= 64) return false; u.pm = q & 15; u.pn = 0; u.e = q >> 4; return true; }
    __device__ __forceinline__ const char* a_base(const Unit& u) const { const int idx = u.pm >> 3, bg = (u.pm >> 1) & 3, half = u.pm & 1;
        return (const char*)(ZB + ((size_t)(bg >> 1) * S + 16 * 256 * half + 8 * u.e) * ZBW + ZB_KC + idx * 128 + (bg & 1) * 64); }
    __device__ __forceinline__ void a_voff(const Unit&, const int (&R)[2], const int (&C)[2], unsigned (&v)[2][2]) const {
#pragma unroll
        for (int h = 0; h < 2; ++h)
#pragma unroll
            for (int i = 0; i < 2; ++i) v[h][i] = (unsigned)(16 * (h * HALF + R[i]) * ZBW + C[i]) * 2u;
    }
    __device__ __forceinline__ size_t a_kstep() const { return (size_t)ZBW * 2; }
    __device__ __forceinline__ const char* b_base(const Unit& u) const { return (const char*)(W1T + (size_t)(u.pm >> 3) * 128 * K + 8 * 64 * u.e); }
    __device__ __forceinline__ size_t b_hstep() const { return 0; }
    __device__ __forceinline__ int b_row(int R) const { return (R & ~31) + perm32(R & 31); }
};
struct EpiCmp {
    float* HIDP;
    struct Pre {};
    __device__ __forceinline__ void prefetch(const Unit&, int, int, Pre&) const {}
    __device__ __forceinline__ void init(f32x4 (&acc)[2][2][4][2], const Pre&) const {
#pragma unroll
        for (int a = 0; a < 2; ++a)
#pragma unroll
            for (int b = 0; b < 2; ++b)
#pragma unroll
                for (int m = 0; m < 4; ++m)
#pragma unroll
                    for (int n = 0; n < 2; ++n) acc[a][b][m][n] = (f32x4){0.f, 0.f, 0.f, 0.f};
    }
    __device__ __forceinline__ void operator()(const f32x4 (&acc)[2][2][4][2], const Unit& u, int wr, int wc, int fr, int fq, bool has_next, const Unit& nxt, Pre& pre) const {
        const int idx = u.pm >> 3, bg = (u.pm >> 1) & 3, half = u.pm & 1;
        const int c0 = 32 * wc + 8 * fq;
#pragma unroll
        for (int ai = 0; ai < 2; ++ai)
#pragma unroll
            for (int m = 0; m < 4; ++m) { const int n = 256 * half + ai * HALF + wr * 64 + m * 16 + fr;
                if (n < 511) { float* dst = HIDP + (((size_t)u.e * 2 + idx) * 2044 + bg * 511 + n) * 128 + c0;
                    *(f32x4*)dst = acc[ai][0][m][0]; *(f32x4*)(dst + 4) = acc[ai][0][m][1]; } }
    }
};
struct EpiG1F {
    bf16_t* ZB; float* GATE; const float* gq; const float* gk; const float* gmq; const float* gmk;
    struct Pre {};
    __device__ __forceinline__ void prefetch(const Unit&, int, int, Pre&) const {}
    __device__ __forceinline__ void init(f32x4 (&acc)[2][2][4][2], const Pre&) const {
#pragma unroll
        for (int a = 0; a < 2; ++a)
#pragma unroll
            for (int b = 0; b < 2; ++b)
#pragma unroll
                for (int m = 0; m < 4; ++m)
#pragma unroll
                    for (int n = 0; n < 2; ++n) acc[a][b][m][n] = (f32x4){0.f, 0.f, 0.f, 0.f};
    }
    __device__ __forceinline__ void operator()(const f32x4 (&acc)[2][2][4][2], const Unit& u, int wr, int wc, int fr, int fq, bool has_next, const Unit& nxt, Pre& pre) const {
        const int pn = u.pn;
        const float* gain = nullptr; float sc = 1.f;
        if (pn < 2) { gain = gq; sc = QSCALE; }
        else if (pn == 3 || pn == 4) { if (wc < 2) gain = gk; }
        else if (pn == 5 || pn == 6) { gain = gmq; sc = QSCALE; }
        else if (pn == 7 || pn == 8) { gain = gmk; }
        if (pn == 11) {
            if (wc == 0 && fq < 3) {
#pragma unroll
                for (int ai = 0; ai < 2; ++ai)
#pragma unroll
                    for (int m = 0; m < 4; ++m) { const size_t r = (size_t)u.pm * BM + ai * HALF + wr * 64 + m * 16 + fr;
#pragma unroll
                        for (int n = 0; n < 2; ++n) { const f32x4 v = acc[ai][0][m][n]; f32x4 o;
#pragma unroll
                            for (int i = 0; i < 4; ++i) o[i] = __builtin_amdgcn_rcpf(1.f + __builtin_amdgcn_exp2f(-LOG2E * v[i]));
                            *(f32x4*)(GATE + r * 32 + 8 * fq + 4 * n) = o; } }
            }
            return;
        }
        f32x4 gv[2][2];
#pragma unroll
        for (int bj = 0; bj < 2; ++bj)
#pragma unroll
            for (int n = 0; n < 2; ++n) gv[bj][n] = gain ? *(const f32x4*)(gain + 32 * bj + 8 * fq + 4 * n) * sc : (f32x4){1.f, 1.f, 1.f, 1.f};
#pragma unroll
        for (int ai = 0; ai < 2; ++ai)
#pragma unroll
            for (int m = 0; m < 4; ++m) { const size_t r = (size_t)u.pm * BM + ai * HALF + wr * 64 + m * 16 + fr;
                float rs = 1.f;
                if (gain) { float ss = 0.f;
#pragma unroll
                    for (int bj = 0; bj < 2; ++bj)
#pragma unroll
                        for (int n = 0; n < 2; ++n) { const f32x4 v = acc[ai][bj][m][n]; ss += (v[0] * v[0] + v[1] * v[1]) + (v[2] * v[2] + v[3] * v[3]); }
                    ss += __shfl_xor(ss, 16); ss += __shfl_xor(ss, 32);
                    rs = rsqrtf(ss * (1.f / 64.f) + EPS); }
#pragma unroll
                for (int bj = 0; bj < 2; ++bj) { const f32x4 a = acc[ai][bj][m][0] * gv[bj][0] * rs, b = acc[ai][bj][m][1] * gv[bj][1] * rs;
                    u32x4 w; w.x = cvt_pk_bf16(a[0], a[1]); w.y = cvt_pk_bf16(a[2], a[3]); w.z = cvt_pk_bf16(b[0], b[1]); w.w = cvt_pk_bf16(b[2], b[3]);
                    *(u32x4*)(ZB + r * ZBW + pn * BM + 64 * wc + 32 * bj + 8 * fq) = w; } }
    }
};
struct EpiG2 {
    const float* xin32; bf16_t* XAB; const float* g1;
    struct Pre {};
    __device__ __forceinline__ void prefetch(const Unit&, int, int, Pre&) const {}
    __device__ __forceinline__ void init(f32x4 (&acc)[2][2][4][2], const Pre&) const {
#pragma unroll
        for (int a = 0; a < 2; ++a)
#pragma unroll
            for (int b = 0; b < 2; ++b)
#pragma unroll
                for (int m = 0; m < 4; ++m)
#pragma unroll
                    for (int n = 0; n < 2; ++n) acc[a][b][m][n] = (f32x4){0.f, 0.f, 0.f, 0.f};
    }
    __device__ __forceinline__ void operator()(const f32x4 (&acc)[2][2][4][2], const Unit& u, int wr, int wc, int fr, int fq, bool has_next, const Unit& nxt, Pre& pre) const {
#pragma unroll
        for (int ai = 0; ai < 2; ++ai)
#pragma unroll
            for (int m = 0; m < 4; ++m) { const size_t r = (size_t)u.pm * BM + ai * HALF + wr * 64 + m * 16 + fr; const int b = (int)(r / S);
#pragma unroll
                for (int bj = 0; bj < 2; ++bj) { const int c = u.pn * BM + 128 * bj + 32 * wc + 8 * fq;
                    f32x4 x0, x1;
                    if (xin32) { x0 = *(const f32x4*)(xin32 + r * D + c); x1 = *(const f32x4*)(xin32 + r * D + c + 4); }
                    else { const u32x4 q = *(const u32x4*)(XAB + r * D + c);
                        x0 = (f32x4){__builtin_bit_cast(float, q.x << 16), __builtin_bit_cast(float, q.x & 0xffff0000u), __builtin_bit_cast(float, q.y << 16), __builtin_bit_cast(float, q.y & 0xffff0000u)};
                        x1 = (f32x4){__builtin_bit_cast(float, q.z << 16), __builtin_bit_cast(float, q.z & 0xffff0000u), __builtin_bit_cast(float, q.w << 16), __builtin_bit_cast(float, q.w & 0xffff0000u)}; }
                    const f32x4 g0 = *(const f32x4*)(g1 + (size_t)b * 6144 + c), g1v = *(const f32x4*)(g1 + (size_t)b * 6144 + c + 4);
                    const f32x4 y0 = x0 + g0 * acc[ai][bj][m][0], y1 = x1 + g1v * acc[ai][bj][m][1];
                    u32x4 o; o.x = cvt_pk_bf16(y0[0], y0[1]); o.y = cvt_pk_bf16(y0[2], y0[3]); o.z = cvt_pk_bf16(y1[0], y1[1]); o.w = cvt_pk_bf16(y1[2], y1[3]);
                    *(u32x4*)(XAB + r * D + c) = o; } }
    }
};
struct EpiM1 {
    bf16_t* ACT; const float* b1l;
    struct Pre { f32x4 bg[2], bl[2]; };
    __device__ __forceinline__ void prefetch(const Unit& u, int wc, int fq, Pre& q) const {
        const float* b1 = b1l + (size_t)u.e * 2048 + u.pn * 128 + 32 * wc + 8 * fq;
#pragma unroll
        for (int n = 0; n < 2; ++n) { q.bg[n] = *(const f32x4*)(b1 + 4 * n); q.bl[n] = *(const f32x4*)(b1 + 1024 + 4 * n); }
    }
    __device__ __forceinline__ void init(f32x4 (&acc)[2][2][4][2], const Pre& q) const {
#pragma unroll
        for (int a = 0; a < 2; ++a)
#pragma unroll
            for (int m = 0; m < 4; ++m)
#pragma unroll
                for (int n = 0; n < 2; ++n) { acc[a][0][m][n] = q.bg[n]; acc[a][1][m][n] = q.bl[n]; }
    }
    __device__ __forceinline__ void operator()(const f32x4 (&acc)[2][2][4][2], const Unit& u, int wr, int wc, int fr, int fq, bool has_next, const Unit& nxt, Pre& pre) const {
        const int c0 = u.pn * 128 + 32 * wc + 8 * fq;
#pragma unroll
        for (int ai = 0; ai < 2; ++ai) {
            if (ai == 1) { __builtin_amdgcn_sched_barrier(0); prefetch(nxt, wc, fq, pre); __builtin_amdgcn_sched_barrier(0); }
#pragma unroll
            for (int m = 0; m < 4; ++m) { const size_t r = (size_t)u.pm * BM + ai * HALF + wr * 64 + m * 16 + fr;
                float o[8];
#pragma unroll
                for (int n = 0; n < 2; ++n) { const f32x4 g = acc[ai][0][m][n], li = acc[ai][1][m][n];
#pragma unroll
                    for (int i = 0; i < 4; ++i) { const float gc = fminf(g[i], 7.f), lc = __builtin_amdgcn_fmed3f(li[i], -7.f, 7.f);
                        o[4 * n + i] = (lc + 1.f) * (gc * __builtin_amdgcn_rcpf(1.f + __builtin_amdgcn_exp2f((-1.702f * LOG2E) * gc))); } }
                u32x4 w; w.x = cvt_pk_bf16(o[0], o[1]); w.y = cvt_pk_bf16(o[2], o[3]); w.z = cvt_pk_bf16(o[4], o[5]); w.w = cvt_pk_bf16(o[6], o[7]);
                *(u32x4*)(ACT + r * DFF + c0) = w; }
        }
    }
};
struct EpiM2 {
    bf16_t* Y; const float* b2l;
    struct Pre { f32x4 b[2][2]; };
    __device__ __forceinline__ void prefetch(const Unit& u, int wc, int fq, Pre& q) const {
        const float* b2 = b2l + (size_t)u.e * D + u.pn * BM + 32 * wc + 8 * fq;
#pragma unroll
        for (int bj = 0; bj < 2; ++bj)
#pragma unroll
            for (int n = 0; n < 2; ++n) q.b[bj][n] = *(const f32x4*)(b2 + 128 * bj + 4 * n);
    }
    __device__ __forceinline__ void init(f32x4 (&acc)[2][2][4][2], const Pre& q) const {
#pragma unroll
        for (int a = 0; a < 2; ++a)
#pragma unroll
            for (int bj = 0; bj < 2; ++bj)
#pragma unroll
                for (int m = 0; m < 4; ++m)
#pragma unroll
                    for (int n = 0; n < 2; ++n) acc[a][bj][m][n] = q.b[bj][n];
    }
    __device__ __forceinline__ void operator()(const f32x4 (&acc)[2][2][4][2], const Unit& u, int wr, int wc, int fr, int fq, bool has_next, const Unit& nxt, Pre& pre) const {
#pragma unroll
        for (int ai = 0; ai < 2; ++ai) {
            if (ai == 1) { __builtin_amdgcn_sched_barrier(0); prefetch(nxt, wc, fq, pre); __builtin_amdgcn_sched_barrier(0); }
#pragma unroll
            for (int m = 0; m < 4; ++m) { const size_t r = (size_t)u.pm * BM + ai * HALF + wr * 64 + m * 16 + fr;
#pragma unroll
                for (int bj = 0; bj < 2; ++bj) { const int c = u.pn * BM + 128 * bj + 32 * wc + 8 * fq;
                    const f32x4 v0 = acc[ai][bj][m][0], v1 = acc[ai][bj][m][1];
                    u32x4 o; o.x = cvt_pk_bf16(v0[0], v0[1]); o.y = cvt_pk_bf16(v0[2], v0[3]); o.z = cvt_pk_bf16(v1[0], v1[1]); o.w = cvt_pk_bf16(v1[2], v1[3]);
                    *(u32x4*)(Y + r * D + c) = o; } }
        }
    }
};
}

__device__ __forceinline__ void phase_g1_fast(const Params& p, int l, unsigned char* lds_raw) {
    pg8::ProbDense P{(const bf16_t*)(p.ws + WS_XN), (const bf16_t*)(p.ws + WS_WINT) + (size_t)l * ZBW * D, D, T / 256, ZBW / 256, (int)gridDim.x, (int)blockIdx.x, true};
    pg8::EpiG1F E{(bf16_t*)(p.ws + WS_ZB), (float*)(p.ws + WS_GATE), p.in[7] + l * 64, p.in[8] + l * 64, p.in[12] + l * 64, p.in[13] + l * 64};
    pg8::gemm_phase<pg8::ProbDense, pg8::EpiG1F, true, true>((PG8_LAS unsigned char*)lds_raw, P, E);
}
__device__ __forceinline__ void phase_g2_fast(const Params& p, int l, unsigned char* lds_raw) {
    pg8::ProbDense P{(const bf16_t*)(p.ws + WS_ATTB), (const bf16_t*)(p.ws + WS_WOT) + (size_t)l * D * D, D, T / 256, D / 256, (int)gridDim.x, (int)blockIdx.x, false};
    pg8::EpiG2 E{l == 0 ? p.in[0] : (const float*)nullptr, (bf16_t*)(p.ws + WS_XAB), (const float*)(p.ws + WS_MOD) + (size_t)l * Bn * 6144 + 2 * D};
    pg8::gemm_phase<pg8::ProbDense, pg8::EpiG2, true, true>((PG8_LAS unsigned char*)lds_raw, P, E);
}
constexpr int LDS_PS_OFF = 131072;
__device__ __forceinline__ void phase_ck_fast(const Params& p, int l, unsigned char* lds_raw) {
    pg8::ProbCmp P{(const bf16_t*)(p.ws + WS_ZB), (const bf16_t*)(p.ws + WS_WCT) + (size_t)l * 2 * 128 * 2048, 2048, (int)gridDim.x, (int)blockIdx.x};
    pg8::EpiCmp E{(float*)(p.ws + WS_HIDP)};
    pg8::gemm_phase<pg8::ProbCmp, pg8::EpiCmp, true, true>((PG8_LAS unsigned char*)lds_raw, P, E);
    { const int tid = otid(), lane = tid & 63, wave = tid >> 6, r8 = lane >> 3, c8 = lane & 7;
      const bf16_t* Z = (const bf16_t*)(p.ws + WS_ZB); bf16_t* KMB = (bf16_t*)(p.ws + WS_KMB);
      float* part = (float*)(lds_raw + 131072 + 512);
      for (int it0 = blockIdx.x * 2; it0 < Bn * 8 * 32; it0 += gridDim.x * 2) {
          const int it = it0 + (wave >> 2), q = wave & 3;
          const int b = it / 256, h = (it / 32) & 7, blk = it & 31;
          const bf16_t* base = Z + (size_t)(b * S + blk * 256 + q * 64 + r8) * ZBW + ZB_MK + h * 64 + c8 * 8;
          float s[8] = {0.f, 0.f, 0.f, 0.f, 0.f, 0.f, 0.f, 0.f};
          uint4 v[8];
#pragma unroll
          for (int i = 0; i < 8; ++i) v[i] = *(const uint4*)(base + (size_t)(8 * i) * ZBW);
#pragma unroll
          for (int i = 0; i < 8; ++i) { const unsigned w[4] = {v[i].x, v[i].y, v[i].z, v[i].w};
#pragma unroll
              for (int e = 0; e < 4; ++e) { s[2 * e] += __builtin_bit_cast(float, w[e] << 16); s[2 * e + 1] += __builtin_bit_cast(float, w[e] & 0xffff0000u); } }
#pragma unroll
          for (int e = 0; e < 8; ++e) { s[e] += __shfl_xor(s[e], 8); s[e] += __shfl_xor(s[e], 16); s[e] += __shfl_xor(s[e], 32); }
          if (r8 == 0) {
#pragma unroll
              for (int e = 0; e < 8; ++e) part[wave * 64 + c8 * 8 + e] = s[e]; }
          __syncthreads();
          if (tid < 128) { const int item = tid >> 6, d = tid & 63; const float* pp = part + item * 256 + d;
              KMB[(size_t)(it0 + item) * 64 + d] = (bf16_t)f2bf((((pp[0] + pp[64]) + pp[128]) + pp[192]) * (1.f / 256.f)); }
          __syncthreads();
      } }
}
__device__ __forceinline__ void phase_m1_fast(const Params& p, int l, unsigned char* lds_raw) {
    int* ps = (int*)(lds_raw + LDS_PS_OFF);
    load_pstart(p, l, ps);
    pg8::ProbMoe1 P{(const bf16_t*)(p.ws + WS_XN), (const bf16_t*)(p.ws + WS_W1T) + (size_t)l * NE * 2048 * D, (const int*)(p.ws + WS_ROWTOK) + (size_t)l * RMAX, (pg8::lds_ints)ps, D, ps[32] / 256, (int)gridDim.x, (int)blockIdx.x};
    pg8::EpiM1 E{(bf16_t*)(p.ws + WS_ACT), p.in[18] + (size_t)l * NE * 2048};
    pg8::gemm_phase<pg8::ProbMoe1, pg8::EpiM1, true, true>((PG8_LAS unsigned char*)lds_raw, P, E);
    __syncthreads();
}
__device__ __forceinline__ void phase_m2_fast(const Params& p, int l, unsigned char* lds_raw) {
    int* ps = (int*)(lds_raw + LDS_PS_OFF);
    load_pstart(p, l, ps);
    pg8::ProbMoe2 P{(const bf16_t*)(p.ws + WS_ACT), (const bf16_t*)(p.ws + WS_W2T) + (size_t)l * NE * D * DFF, (pg8::lds_ints)ps, DFF, ps[32] / 256, (int)gridDim.x, (int)blockIdx.x};
    pg8::EpiM2 E{(bf16_t*)(p.ws + WS_Y), p.in[20] + (size_t)l * NE * D};
    pg8::gemm_phase<pg8::ProbMoe2, pg8::EpiM2, true, true>((PG8_LAS unsigned char*)lds_raw, P, E);
    __syncthreads();
}

namespace at {
#define AT_LAS __attribute__((address_space(3)))
typedef short bf16x8 __attribute__((ext_vector_type(8)));
typedef short s16x4 __attribute__((ext_vector_type(4)));
typedef short v4i16_t __attribute__((ext_vector_type(4)));
typedef float f32x16 __attribute__((ext_vector_type(16)));
typedef unsigned u32x4 __attribute__((ext_vector_type(4)));
typedef float f32x2_t __attribute__((ext_vector_type(2))); typedef __bf16 bf16x2_t __attribute__((ext_vector_type(2)));
typedef AT_LAS unsigned char* lp;
constexpr int L_K = 0  , L_V = 32768  , L_WSF = 65536, L_OST = 67584  , L_SELM = 133120, L_UNI = 134144, L_KMT = 134400, L_END = 142592;
constexpr float NEGS = -1e30f;
constexpr float MAXTHR = 12.f;
__device__ __forceinline__ int crow(int r, int hi) { return (r & 3) + 8 * (r >> 2) + 4 * hi; }
__device__ __forceinline__ unsigned cvtpk(float lo, float hi) { f32x2_t v = {lo, hi}; bf16x2_t b = __builtin_convertvector(v, bf16x2_t); return __builtin_bit_cast(unsigned, b); }
__device__ __forceinline__ float mx3(float a, float b, float c) { return __builtin_fmaxf(__builtin_fmaxf(a, b), c); }
__device__ __forceinline__ void wsync() { asm volatile("s_waitcnt lgkmcnt(0)" ::: "memory"); __builtin_amdgcn_wave_barrier(); }
__device__ __forceinline__ void bar() { __builtin_amdgcn_s_barrier(); }
#define AT_WAITV(n) asm volatile("s_waitcnt vmcnt(" #n ")" ::: "memory")
#define AT_WAITL() asm volatile("s_waitcnt lgkmcnt(0)" ::: "memory")
__device__ __forceinline__ void glds(const void* g, lp dst) { __builtin_amdgcn_global_load_lds((const unsigned*)g, (AT_LAS unsigned*)dst, 16, 0, 0); }
__device__ __forceinline__ s16x4 vtr(const AT_LAS unsigned char* p) { return __builtin_bit_cast(s16x4, __builtin_amdgcn_ds_read_tr16_b64_v4i16((AT_LAS v4i16_t*)p)); }

__device__ __forceinline__ void dma_k(lp slot, const bf16_t* kbase, int pitch, int key0, int wid, int lane) { glds(kbase + (size_t)(key0 + lane) * pitch + wid * 8, slot + wid * 1024); }
__device__ __forceinline__ void dma_v(lp slot, const bf16_t* vbase, int pitch, int key0, int wid, int lane) {
    glds(vbase + (size_t)(key0 + 16 * (wid & 3) + (lane >> 2)) * pitch + (wid >> 2) * 32 + (lane & 3) * 8, slot + wid * 1024); }

__device__ __forceinline__ void qk_tile(f32x16& p0, f32x16& p1, lp kslot, const bf16x8 (&qr)[4], int r32, int hi) {
    const AT_LAS unsigned char* kb = kslot + hi * 1024 + r32 * 16;
    bf16x8 b0[4], b1[4];
#pragma unroll
    for (int d0 = 0; d0 < 4; ++d0) { b0[d0] = *(const AT_LAS bf16x8*)(kb + d0 * 2048); b1[d0] = *(const AT_LAS bf16x8*)(kb + d0 * 2048 + 512); }
#pragma unroll
    for (int d0 = 0; d0 < 4; ++d0) {
        p0 = __builtin_amdgcn_mfma_f32_32x32x16_bf16(b0[d0], qr[d0], p0, 0, 0, 0);
        p1 = __builtin_amdgcn_mfma_f32_32x32x16_bf16(b1[d0], qr[d0], p1, 0, 0, 0);
    }
}
struct VFrag { bf16x8 f[8]; };
__device__ __forceinline__ void pv_load(VFrag& v, lp vslot, int lane, int hi) {
    const AT_LAS unsigned char* vp = vslot + ((lane >> 4) & 1) * 32 + (lane & 3) * 8 + (4 * hi + ((lane & 15) >> 2)) * 64;
#pragma unroll
    for (int d0 = 0; d0 < 2; ++d0)
#pragma unroll
        for (int ks = 0; ks < 4; ++ks) {
            const s16x4 lo = vtr(vp + d0 * 4096 + ks * 1024), hh = vtr(vp + d0 * 4096 + ks * 1024 + 512);
            v.f[d0 * 4 + ks] = (bf16x8){lo[0], lo[1], lo[2], lo[3], hh[0], hh[1], hh[2], hh[3]};
        }
}
__device__ __forceinline__ void pv_mfma(f32x16 (&o)[2], const VFrag& v, u32x4 pw0, u32x4 pw1, u32x4 pw2, u32x4 pw3) {
    const bf16x8 pa[4] = {__builtin_bit_cast(bf16x8, pw0), __builtin_bit_cast(bf16x8, pw1), __builtin_bit_cast(bf16x8, pw2), __builtin_bit_cast(bf16x8, pw3)};
#pragma unroll
    for (int ks = 0; ks < 4; ++ks) {
        o[0] = __builtin_amdgcn_mfma_f32_32x32x16_bf16(pa[ks], v.f[ks], o[0], 0, 0, 0);
        o[1] = __builtin_amdgcn_mfma_f32_32x32x16_bf16(pa[ks], v.f[4 + ks], o[1], 0, 0, 0);
    }
}
__device__ __forceinline__ float rowmax(const f32x16& p0, const f32x16& p1) {
    float a = mx3(p0[0], p0[1], p1[0]), b = mx3(p0[2], p0[3], p1[1]); a = mx3(a, p1[2], p1[3]);
#pragma unroll
    for (int r = 4; r < 16; r += 4) { a = mx3(a, p0[r], p0[r + 1]); b = mx3(b, p0[r + 2], p0[r + 3]); a = mx3(a, p1[r], p1[r + 1]); b = mx3(b, p1[r + 2], p1[r + 3]); }
    const float m = __builtin_fmaxf(a, b);
    auto rr = __builtin_amdgcn_permlane32_swap(__float_as_uint(m), __float_as_uint(m), false, false);
    return __builtin_fmaxf(__uint_as_float(rr[0]), __uint_as_float(rr[1]));
}
__device__ __forceinline__ float halfsum(float v) {
    auto rr = __builtin_amdgcn_permlane32_swap(__float_as_uint(v), __float_as_uint(v), false, false);
    return __uint_as_float(rr[0]) + __uint_as_float(rr[1]);
}
__device__ __forceinline__ void mask_tile(f32x16& p0, f32x16& p1, int lo, int hi_, int hi) {
    const int kb = 4 * hi;
#pragma unroll
    for (int r = 0; r < 16; ++r) { const int kv = kb + (r & 3) + 8 * (r >> 2); if (kv > hi_ || kv < lo) p0[r] = NEGS; if (kv + 32 > hi_ || kv + 32 < lo) p1[r] = NEGS; }
}

__device__ __forceinline__ void mask_init_lo(f32x16& p0, f32x16& p1, int lo, int hi) {
    const int kb = 4 * hi;
#pragma unroll
    for (int r = 0; r < 16; ++r) { const int kv = kb + (r & 3) + 8 * (r >> 2); if (kv < lo) p0[r] = NEGS; if (kv + 32 < lo) p1[r] = NEGS; }
}
__device__ __forceinline__ void mask_init(f32x16& p0, f32x16& p1, int hi_, int hi) {
    const int kb = 4 * hi;
#pragma unroll
    for (int r = 0; r < 16; ++r) { const int kv = kb + (r & 3) + 8 * (r >> 2); if (kv > hi_) p0[r] = NEGS; if (kv + 32 > hi_) p1[r] = NEGS; }
}
__device__ __forceinline__ int next_bit128(unsigned u0, unsigned u1, unsigned u2, unsigned u3, int below) {
    if (below > 96) { unsigned x = u3; if (below < 128) x &= (1u << (below - 96)) - 1u; if (x) return 96 + 31 - __builtin_clz(x); }
    if (below > 64) { unsigned x = u2; if (below < 96) x &= (1u << (below - 64)) - 1u; if (x) return 64 + 31 - __builtin_clz(x); }
    if (below > 32) { unsigned x = u1; if (below < 64) x &= (1u << (below - 32)) - 1u; if (x) return 32 + 31 - __builtin_clz(x); }
    if (below > 0) { unsigned x = u0; if (below < 32) x &= (1u << below) - 1u; if (x) return 31 - __builtin_clz(x); }
    return -1;
}
struct Soft { float m, l; };

template <bool HAS_O>
__device__ __forceinline__ void softmax_step(f32x16& p0, f32x16& p1, Soft& st, f32x16 (&o)[2], float* wsf, int r32, int hi) {
    const float rm = rowmax(p0, p1);
    if (__any(rm > MAXTHR)) {
        const float dl = __builtin_fmaxf(rm, 0.f); st.m += dl;
#pragma unroll
        for (int r = 0; r < 16; ++r) { p0[r] -= dl; p1[r] -= dl; }
        const float al = __builtin_amdgcn_exp2f(-dl); st.l *= al;
        if (HAS_O) {
            if (hi == 0) wsf[r32] = al;
            wsync();
#pragma unroll
            for (int r = 0; r < 16; ++r) { const float f = wsf[crow(r, hi)]; o[0][r] *= f; o[1][r] *= f; }
            wsync();
        }
    }
    float s = 0.f;
#pragma unroll
    for (int r = 0; r < 16; ++r) { p0[r] = __builtin_amdgcn_exp2f(p0[r]); p1[r] = __builtin_amdgcn_exp2f(p1[r]); s += p0[r] + p1[r]; }
    st.l += s;
}
#define AT_PACK(P0, P1) \
    const u32x4 pw0 = {cvtpk(P0[0], P0[1]), cvtpk(P0[2], P0[3]), cvtpk(P0[4], P0[5]), cvtpk(P0[6], P0[7])}, pw1 = {cvtpk(P0[8], P0[9]), cvtpk(P0[10], P0[11]), cvtpk(P0[12], P0[13]), cvtpk(P0[14], P0[15])}, \
                pw2 = {cvtpk(P1[0], P1[1]), cvtpk(P1[2], P1[3]), cvtpk(P1[4], P1[5]), cvtpk(P1[6], P1[7])}, pw3 = {cvtpk(P1[8], P1[9]), cvtpk(P1[10], P1[11]), cvtpk(P1[12], P1[13]), cvtpk(P1[14], P1[15])}
__device__ __forceinline__ float fma_vsv(float a, float k, float x) { float d; asm("v_fma_f32 %0, %1, %2, %3" : "=v"(d) : "v"(a), "s"(k), "v"(x)); return d; }
__device__ __forceinline__ f32x16 cinit(float c2k, int hi, float x) { f32x16 c; const float xb = __builtin_fmaf(c2k, (float)(4 * hi), x);
    c[0] = xb;
#pragma unroll
    for (int r = 1; r < 16; ++r) c[r] = fma_vsv(c2k, (float)((r & 3) + 8 * (r >> 2)), xb);
    return c; }
template <bool FIRST>
__device__ __forceinline__ void acc_scaled(float* stage, const f32x16 (&o)[2], float f, float* wsf, int r32, int hi) {
    if (hi == 0) wsf[r32] = f;
    wsync();
#pragma unroll
    for (int r = 0; r < 16; ++r) { const int orow = crow(r, hi); const float g = wsf[orow]; float* s0 = stage + orow * 64 + r32;
        if (FIRST) { s0[0] = o[0][r] * g; s0[32] = o[1][r] * g; } else { s0[0] += o[0][r] * g; s0[32] += o[1][r] * g; } }
    wsync();
}

#define AT_WAIT_NEWER(newer, per) do { if ((newer) >= 2) { if ((per) == 2) AT_WAITV(4); else AT_WAITV(2); } else if ((newer) == 1) { if ((per) == 2) AT_WAITV(2); else AT_WAITV(1); } else AT_WAITV(0); } while (0)


#define AT_SB() __builtin_amdgcn_sched_barrier(0)
struct PipeOut { float s, rmn; };
__device__ __forceinline__ PipeOut pipe_step(f32x16& c0, f32x16& c1, f32x16& n0, f32x16& n1, f32x16 (&o)[2], lp kslot_next, lp vslot, const bf16x8 (&qr)[4], int lane, int r32, int hi) {
    const AT_LAS unsigned char* kb = kslot_next + hi * 1024 + r32 * 16;
    const AT_LAS unsigned char* vp = vslot + ((lane >> 4) & 1) * 32 + (lane & 3) * 8 + (4 * hi + ((lane & 15) >> 2)) * 64;
    bf16x8 kf[8];
#pragma unroll
    for (int j = 0; j < 4; ++j) kf[j] = *(const AT_LAS bf16x8*)(kb + (j >> 1) * 2048 + (j & 1) * 512);
    AT_SB();
    unsigned w0[8], w1[8]; s16x4 vl[8], vh[8]; float s = 0.f;
#pragma unroll
    for (int j = 0; j < 8; ++j) {
        if (j & 1) n1 = __builtin_amdgcn_mfma_f32_32x32x16_bf16(kf[j], qr[j >> 1], n1, 0, 0, 0);
        else       n0 = __builtin_amdgcn_mfma_f32_32x32x16_bf16(kf[j], qr[j >> 1], n0, 0, 0, 0);
        if (j < 4) kf[j + 4] = *(const AT_LAS bf16x8*)(kb + ((j + 4) >> 1) * 2048 + (j & 1) * 512);
        if (j >= 4) {
#pragma unroll
            for (int q = 0; q < 2; ++q) { const int f = (j - 4) * 2 + q, d0 = f >> 2, ks = f & 3; vl[f] = vtr(vp + d0 * 4096 + ks * 1024); vh[f] = vtr(vp + d0 * 4096 + ks * 1024 + 512); }
        }
        const float e0 = __builtin_amdgcn_exp2f(c0[2 * j]), e1 = __builtin_amdgcn_exp2f(c0[2 * j + 1]), e2 = __builtin_amdgcn_exp2f(c1[2 * j]), e3 = __builtin_amdgcn_exp2f(c1[2 * j + 1]);
        s += (e0 + e1) + (e2 + e3);
        asm volatile("" : "+v"(s));
        w0[j] = cvtpk(e0, e1); w1[j] = cvtpk(e2, e3);
        AT_SB();
    }
    const u32x4 pw0 = {w0[0], w0[1], w0[2], w0[3]}, pw1 = {w0[4], w0[5], w0[6], w0[7]}, pw2 = {w1[0], w1[1], w1[2], w1[3]}, pw3 = {w1[4], w1[5], w1[6], w1[7]};
    const bf16x8 pa[4] = {__builtin_bit_cast(bf16x8, pw0), __builtin_bit_cast(bf16x8, pw1), __builtin_bit_cast(bf16x8, pw2), __builtin_bit_cast(bf16x8, pw3)};
    float a = mx3(n0[0], n0[1], n1[0]), b = mx3(n0[2], n0[3], n1[1]);
#pragma unroll
    for (int f = 0; f < 8; ++f) {
        const int d0 = f >> 2, ks = f & 3;
        const bf16x8 vf = (bf16x8){vl[f][0], vl[f][1], vl[f][2], vl[f][3], vh[f][0], vh[f][1], vh[f][2], vh[f][3]};
        o[d0] = __builtin_amdgcn_mfma_f32_32x32x16_bf16(pa[ks], vf, o[d0], 0, 0, 0);
        if (f == 0) { a = mx3(a, n1[2], n1[3]); }
        else if (f < 4) { const int r = 4 * f; a = mx3(a, n0[r], n0[r + 1]); b = mx3(b, n0[r + 2], n0[r + 3]); a = mx3(a, n1[r], n1[r + 1]); b = mx3(b, n1[r + 2], n1[r + 3]); }
        asm volatile("" : "+v"(a), "+v"(b));
        AT_SB();
    }
    const float m = __builtin_fmaxf(a, b);
    auto rr = __builtin_amdgcn_permlane32_swap(__float_as_uint(m), __float_as_uint(m), false, false);
    PipeOut out; out.s = s; out.rmn = __builtin_fmaxf(__uint_as_float(rr[0]), __uint_as_float(rr[1]));
    return out;
}
__device__ __forceinline__ void nsa_unit(const Params& p, int b, int g, int c, unsigned char* lds_raw) {
    const int tid = otid(), lane = tid & 63, r32 = lane & 31, hi = lane >> 5, wid = __builtin_amdgcn_readfirstlane(tid >> 6);
    lp lds = (lp)lds_raw;
    const bf16_t* ZB = (const bf16_t*)(p.ws + WS_ZB); const float* GT = (const float*)(p.ws + WS_GATE);
    const bf16_t* KCB = (const bf16_t*)(p.ws + WS_KCB) + (size_t)(b * 2 + g) * 512 * 64; const bf16_t* VCB = (const bf16_t*)(p.ws + WS_VCB) + (size_t)(b * 2 + g) * 512 * 64;
    const int t0 = c * 64, hg = r32 >> 3, qq = r32 & 7, qi = 8 * wid + qq, t = t0 + qi, h = 4 * g + hg; const size_t tt = (size_t)b * S + t;
    float* wsf = (float*)(lds_raw + L_WSF) + wid * 64;
    float* ostage = (float*)(lds_raw + L_OST) + wid * 2048;
    float* imp = ostage;
    unsigned* selm = (unsigned*)(lds_raw + L_SELM);
    unsigned* uni = (unsigned*)(lds_raw + L_UNI);
    const float c2 = exp2f(-(float)(h + 1)) * LOG2E;
    bf16x8 qr[4];
#pragma unroll
    for (int d0 = 0; d0 < 4; ++d0) qr[d0] = *(const bf16x8*)(ZB + tt * ZBW + ZB_Q + h * 64 + d0 * 16 + hi * 8);
    const float gt0 = GT[tt * 32 + h * 3 + 0], gt1 = GT[tt * 32 + h * 3 + 1], gt2 = GT[tt * 32 + h * 3 + 2];
    f32x16 o[2];
    const lp sK0 = lds + L_K, sV0 = lds + L_V;
    const int nmax = t >= 31 ? (t - 31) >> 4 : -1;
    const int ntc = ((4 * c + 2) >> 6) + 1;
    for (int i = lane; i < 8 * 129; i += 64) imp[i] = 0.f;
    Soft sc; sc.m = 0.f; sc.l = 0.f;
#pragma unroll
    for (int k = 0; k < 3; ++k) if (k < ntc) dma_k(sK0 + k * 8192, KCB, 64, 64 * k, wid, lane);
    for (int k = 0; k < ntc; ++k) {
        const int newer = ntc - 1 - k; AT_WAIT_NEWER(newer, 1);
        AT_WAITL(); bar();
        if (k + 3 < ntc) dma_k(sK0 + ((k + 3) & 3) * 8192, KCB, 64, 64 * (k + 3), wid, lane);
        const lp sK = sK0 + (k & 3) * 8192;
        const float x0 = c2 * (16.f * (64 * k) + 15.5f - (float)t0) - sc.m;
        f32x16 p0 = cinit(16.f * c2, hi, x0), p1 = cinit(16.f * c2, hi, x0 + c2 * 512.f);
        qk_tile(p0, p1, sK, qr, r32, hi);
        if (__any(nmax - 64 * k < 63)) mask_tile(p0, p1, 0, nmax - 64 * k, hi);
        softmax_step<false>(p0, p1, sc, o, wsf, r32, hi);
    }
    const float lc = halfsum(sc.l), linv = lc > 0.f ? 1.f / lc : 0.f;
    o[0] = f32x16{}; o[1] = f32x16{};
    AT_WAITL(); bar();
#pragma unroll
    for (int k = 0; k < 3; ++k) if (k < ntc) { dma_k(sK0 + k * 8192, KCB, 64, 64 * k, wid, lane); dma_v(sV0 + k * 8192, VCB, 64, 64 * k, wid, lane); }
    for (int k = 0; k < ntc; ++k) {
        const int newer = ntc - 1 - k; AT_WAIT_NEWER(newer, 2);
        AT_WAITL(); bar();
        if (k + 3 < ntc) { dma_k(sK0 + ((k + 3) & 3) * 8192, KCB, 64, 64 * (k + 3), wid, lane); dma_v(sV0 + ((k + 3) & 3) * 8192, VCB, 64, 64 * (k + 3), wid, lane); }
        const lp sK = sK0 + (k & 3) * 8192, sV = sV0 + (k & 3) * 8192;
        const float x0 = c2 * (16.f * (64 * k) + 15.5f - (float)t0) - sc.m;
        f32x16 p0 = cinit(16.f * c2, hi, x0), p1 = cinit(16.f * c2, hi, x0 + c2 * 512.f);
        qk_tile(p0, p1, sK, qr, r32, hi);
        if (__any(nmax - 64 * k < 63)) mask_tile(p0, p1, 0, nmax - 64 * k, hi);
        VFrag vf; pv_load(vf, sV, lane, hi);
#pragma unroll
        for (int r = 0; r < 16; ++r) { p0[r] = __builtin_amdgcn_exp2f(p0[r]); p1[r] = __builtin_amdgcn_exp2f(p1[r]); }
        { AT_PACK(p0, p1); pv_mfma(o, vf, pw0, pw1, pw2, pw3); }
        float gs[8], ls[8];
#pragma unroll
        for (int q4 = 0; q4 < 4; ++q4) { gs[q4] = ((p0[4 * q4] + p0[4 * q4 + 1]) + (p0[4 * q4 + 2] + p0[4 * q4 + 3])) * linv; ls[q4] = p0[4 * q4 + 3] * linv;
                                         gs[4 + q4] = ((p1[4 * q4] + p1[4 * q4 + 1]) + (p1[4 * q4 + 2] + p1[4 * q4 + 3])) * linv; ls[4 + q4] = p1[4 * q4 + 3] * linv; }
#pragma unroll
        for (int q4 = 0; q4 < 8; ++q4) { gs[q4] += __shfl_xor(gs[q4], 8); gs[q4] += __shfl_xor(gs[q4], 16); ls[q4] += __shfl_xor(ls[q4], 8); ls[q4] += __shfl_xor(ls[q4], 16); }
        if (r32 < 8) {
            float* row = imp + qq * 129 + 16 * k + hi;
#pragma unroll
            for (int q4 = 0; q4 < 8; ++q4) row[2 * q4] += gs[q4];
        }
        wsync();
        if (r32 < 8) {
            float* row = imp + qq * 129 + 16 * k + hi + 1;
#pragma unroll
            for (int q4 = 0; q4 < 8; ++q4) row[2 * q4] += ls[q4];
        }
        wsync();
    }
    unsigned mk0 = 0u, mk1 = 0u, mk2 = 0u, mk3 = 0u;
    {
        const int qs = lane >> 3, part = lane & 7;
        float v[16];
#pragma unroll
        for (int i = 0; i < 16; ++i) { const int j = part * 16 + i; float x = imp[qs * 129 + j]; if (j == 0 || j == c || j == c - 1) x = 1e4f; if (j > c) x = NEGS; v[i] = x; }
#pragma unroll 1
        for (int it = 0; it < 16; ++it) {
            float bv = -3e38f; int bi = 0;
#pragma unroll
            for (int i = 0; i < 16; ++i) if (v[i] > bv) { bv = v[i]; bi = part * 16 + i; }
#pragma unroll
            for (int sft = 1; sft < 8; sft <<= 1) { const float ov = __shfl_xor(bv, sft); const int oi = __shfl_xor(bi, sft); if (ov > bv || (ov == bv && oi < bi)) { bv = ov; bi = oi; } }
            if (bv > NEGS) { const unsigned bit = 1u << (bi & 31); const int wq = bi >> 5; if (wq == 0) mk0 |= bit; else if (wq == 1) mk1 |= bit; else if (wq == 2) mk2 |= bit; else mk3 |= bit; }
#pragma unroll
            for (int i = 0; i < 16; ++i) if (part * 16 + i == bi) v[i] = -3.4e38f;
        }
        if (part == 0) { unsigned* sm = selm + (8 * wid + qs) * 4; sm[0] = mk0; sm[1] = mk1; sm[2] = mk2; sm[3] = mk3; }
        unsigned u0 = mk0, u1 = mk1, u2 = mk2, u3 = mk3;
#pragma unroll
        for (int sft = 8; sft < 64; sft <<= 1) { u0 |= __shfl_xor(u0, sft); u1 |= __shfl_xor(u1, sft); u2 |= __shfl_xor(u2, sft); u3 |= __shfl_xor(u3, sft); }
        if (lane == 0) { uni[wid * 4 + 0] = u0; uni[wid * 4 + 1] = u1; uni[wid * 4 + 2] = u2; uni[wid * 4 + 3] = u3; }
    }
    wsync();
    acc_scaled<true>(ostage, o, gt0 * linv, wsf, r32, hi);
    AT_WAITL(); bar();
    unsigned un0 = 0u, un1 = 0u, un2 = 0u, un3 = 0u;
#pragma unroll
    for (int w = 0; w < 8; ++w) { un0 |= uni[w * 4 + 0]; un1 |= uni[w * 4 + 1]; un2 |= uni[w * 4 + 2]; un3 |= uni[w * 4 + 3]; }
    un0 = __builtin_amdgcn_readfirstlane(un0); un1 = __builtin_amdgcn_readfirstlane(un1); un2 = __builtin_amdgcn_readfirstlane(un2); un3 = __builtin_amdgcn_readfirstlane(un3);
    const unsigned my0 = selm[(8 * wid + qq) * 4 + 0], my1 = selm[(8 * wid + qq) * 4 + 1], my2 = selm[(8 * wid + qq) * 4 + 2], my3 = selm[(8 * wid + qq) * 4 + 3];
    {
        const bf16_t* KS = ZB + (size_t)b * S * ZBW + ZB_KS + g * 64; const bf16_t* VS = ZB + (size_t)b * S * ZBW + ZB_VS + g * 64;
        Soft ss; ss.m = 0.f; ss.l = 0.f; o[0] = f32x16{}; o[1] = f32x16{};
        const int nsel = __builtin_popcount(un0) + __builtin_popcount(un1) + __builtin_popcount(un2) + __builtin_popcount(un3);
        int ji = 128;
#pragma unroll
        for (int k = 0; k < 3; ++k) if (k < nsel) { ji = next_bit128(un0, un1, un2, un3, ji); dma_k(sK0 + k * 8192, KS, ZBW, 64 * ji, wid, lane); dma_v(sV0 + k * 8192, VS, ZBW, 64 * ji, wid, lane); }
        int j = 128;
        for (int i = 0; i < nsel; ++i) {
            j = next_bit128(un0, un1, un2, un3, j);
            const int newer = nsel - 1 - i; AT_WAIT_NEWER(newer, 2);
            AT_WAITL(); bar();
            if (i + 3 < nsel) { ji = next_bit128(un0, un1, un2, un3, ji); dma_k(sK0 + ((i + 3) & 3) * 8192, KS, ZBW, 64 * ji, wid, lane); dma_v(sV0 + ((i + 3) & 3) * 8192, VS, ZBW, 64 * ji, wid, lane); }
            const lp sK = sK0 + (i & 3) * 8192, sV = sV0 + (i & 3) * 8192;
            const unsigned mw = (j >> 5) == 0 ? my0 : (j >> 5) == 1 ? my1 : (j >> 5) == 2 ? my2 : my3;
            const bool sel = (mw >> (j & 31)) & 1u;
            const float x0 = sel ? c2 * (float)(64 * j - t0) - ss.m : NEGS;
            f32x16 p0 = cinit(c2, hi, x0), p1 = cinit(c2, hi, sel ? x0 + c2 * 32.f : NEGS);
            qk_tile(p0, p1, sK, qr, r32, hi);
            if (j == c) mask_tile(p0, p1, 0, qi, hi);
            VFrag vf; pv_load(vf, sV, lane, hi);
            softmax_step<true>(p0, p1, ss, o, wsf, r32, hi);
            { AT_PACK(p0, p1); pv_mfma(o, vf, pw0, pw1, pw2, pw3); }
        }
        const float ls_ = halfsum(ss.l);
        acc_scaled<false>(ostage, o, ls_ > 0.f ? gt1 / ls_ : 0.f, wsf, r32, hi);
    }
    {
        const bf16_t* KW = ZB + (size_t)b * S * ZBW + ZB_KW + g * 64; const bf16_t* VW = ZB + (size_t)b * S * ZBW + ZB_VW + g * 64;
        Soft sw; sw.m = 0.f; sw.l = 0.f; o[0] = f32x16{}; o[1] = f32x16{};
        const int k0 = c >= 8 ? 0 : 8 - c, nw = 9 - k0;
        AT_WAITL(); bar();
#pragma unroll
        for (int k = 0; k < 3; ++k) if (k < nw) { dma_k(sK0 + k * 8192, KW, ZBW, t0 - 64 * k, wid, lane); dma_v(sV0 + k * 8192, VW, ZBW, t0 - 64 * k, wid, lane); }
        f32x16 pA0, pA1, pB0, pB1; float rmc;
#define WIN_STEP(C0, C1, N0, N1, I) do { const int i_ = (I); \
            if (i_ + 1 < nw) { if (i_ + 2 < nw) AT_WAITV(2); else AT_WAITV(0); } \
            AT_WAITL(); bar(); \
            if (i_ + 3 < nw) { dma_k(sK0 + ((i_ + 3) & 3) * 8192, KW, ZBW, t0 - 64 * (i_ + 3), wid, lane); dma_v(sV0 + ((i_ + 3) & 3) * 8192, VW, ZBW, t0 - 64 * (i_ + 3), wid, lane); } \
            if (__any(rmc > MAXTHR)) { \
                const float dl = __builtin_fmaxf(rmc, 0.f); sw.m += dl; \
                _Pragma("unroll") for (int r = 0; r < 16; ++r) { C0[r] -= dl; C1[r] -= dl; } \
                const float al = __builtin_amdgcn_exp2f(-dl); sw.l *= al; \
                if (hi == 0) wsf[r32] = al; \
                wsync(); \
                _Pragma("unroll") for (int r = 0; r < 16; ++r) { const float f = wsf[crow(r, hi)]; o[0][r] *= f; o[1][r] *= f; } \
                wsync(); \
            } \
            { const float x0 = c2 * (float)(-64 * (i_ + 1)) - sw.m; \
              N0 = cinit(c2, hi, x0); N1 = cinit(c2, hi, x0 + c2 * 32.f); \
              if (i_ + 1 == 8) mask_init_lo(N0, N1, qi + 1, hi); }        \
            const PipeOut po = pipe_step(C0, C1, N0, N1, o, sK0 + ((i_ + 1) & 3) * 8192, sV0 + (i_ & 3) * 8192, qr, lane, r32, hi); \
            sw.l += po.s; rmc = po.rmn; } while (0)
        { if (nw >= 3) AT_WAITV(4); else if (nw == 2) AT_WAITV(2); else AT_WAITV(0);
          AT_WAITL(); bar(); }
        { pB0 = cinit(c2, hi, 0.f); pB1 = cinit(c2, hi, c2 * 32.f);
          qk_tile(pB0, pB1, sK0, qr, r32, hi);
          mask_tile(pB0, pB1, 0, qi, hi);
          rmc = rowmax(pB0, pB1); }
        int i = 0;
#pragma unroll 1
        for (; i + 1 < nw; i += 2) {
            WIN_STEP(pB0, pB1, pA0, pA1, i);
            WIN_STEP(pA0, pA1, pB0, pB1, i + 1);
        }
        if (i < nw) WIN_STEP(pB0, pB1, pA0, pA1, i);
#undef WIN_STEP
        const float lw = halfsum(sw.l);
        acc_scaled<false>(ostage, o, lw > 0.f ? gt2 / lw : 0.f, wsf, r32, hi);
    }
    {
        bf16_t* AB = (bf16_t*)(p.ws + WS_ATTB);
#pragma unroll
        for (int i = 0; i < 4; ++i) { const int row = i * 8 + (lane >> 3), ch = lane & 7; const float4 a = *(const float4*)(ostage + row * 64 + ch * 8), c4 = *(const float4*)(ostage + row * 64 + ch * 8 + 4);
            const uint4 v = make_uint4(pk2(a.x, a.y), pk2(a.z, a.w), pk2(c4.x, c4.y), pk2(c4.z, c4.w));
            *(uint4*)(AB + ((size_t)b * S + t0 + 8 * wid + (row & 7)) * D + (4 * g + (row >> 3)) * 64 + ch * 8) = v; }
        wsync();
    }
    AT_WAITL(); bar();
}

}

constexpr int MB_CAP = 25600;
namespace at {
__device__ __forceinline__ void moba_route_unit(const Params& p, int b, int h, int qb, unsigned char* lds_raw) {
    const int tid = otid(), lane = tid & 63, r32 = lane & 31, hi = lane >> 5, wid = __builtin_amdgcn_readfirstlane(tid >> 6);
    lp lds = (lp)lds_raw;
    const bf16_t* ZB = (const bf16_t*)(p.ws + WS_ZB);
    const int bh = b * 8 + h;
    const bf16_t* KMB = (const bf16_t*)(p.ws + WS_KMB) + (size_t)bh * 32 * 64;
    const int qi = 32 * wid + r32, t = qb * 256 + qi; const size_t tt = (size_t)b * S + t;
    int* hist = (int*)(lds_raw + L_UNI);
    unsigned* SEL3 = (unsigned*)(p.ws + WS_SEL3); unsigned* LRK = (unsigned*)(p.ws + WS_LRK);
    unsigned char* IL = (unsigned char*)(p.ws + WS_ILIST) + ((size_t)(bh * 32 + qb) * 32) * 256;
    int* BCm = (int*)(p.ws + WS_BCM) + (size_t)(bh * 32 + qb) * 32;
    if (tid < 32) hist[tid] = 0;
    bf16x8 qr[4];
#pragma unroll
    for (int d0 = 0; d0 < 4; ++d0) qr[d0] = *(const bf16x8*)(ZB + tt * ZBW + ZB_MQ + h * 64 + d0 * 16 + hi * 8);
    const lp sKM = lds + L_KMT;
    glds(KMB + (size_t)(lane & 31) * 64 + wid * 8, sKM + wid * 1024);
    AT_WAITV(0); AT_WAITL(); bar();
    f32x16 g0 = f32x16{}, g1 = f32x16{};
    qk_tile(g0, g1, sKM, qr, r32, hi);
    float v1 = NEGS, v2 = NEGS, v3 = NEGS; int i1 = 64, i2 = 64, i3 = 64;
#pragma unroll
    for (int r = 0; r < 16; ++r) { const int n = crow(r, hi); const float s_ = n < qb ? g0[r] : NEGS;
        if (s_ > v1) { v3 = v2; i3 = i2; v2 = v1; i2 = i1; v1 = s_; i1 = n; } else if (s_ > v2) { v3 = v2; i3 = i2; v2 = s_; i2 = n; } else if (s_ > v3) { v3 = s_; i3 = n; } }
    float ov[3]; int oi[3];
    { auto a = __builtin_amdgcn_permlane32_swap(__float_as_uint(v1), __float_as_uint(v1), false, false); ov[0] = __uint_as_float(hi ? a[0] : a[1]); }
    { auto a = __builtin_amdgcn_permlane32_swap(__float_as_uint(v2), __float_as_uint(v2), false, false); ov[1] = __uint_as_float(hi ? a[0] : a[1]); }
    { auto a = __builtin_amdgcn_permlane32_swap(__float_as_uint(v3), __float_as_uint(v3), false, false); ov[2] = __uint_as_float(hi ? a[0] : a[1]); }
    { auto a = __builtin_amdgcn_permlane32_swap((unsigned)i1, (unsigned)i1, false, false); oi[0] = (int)(hi ? a[0] : a[1]); }
    { auto a = __builtin_amdgcn_permlane32_swap((unsigned)i2, (unsigned)i2, false, false); oi[1] = (int)(hi ? a[0] : a[1]); }
    { auto a = __builtin_amdgcn_permlane32_swap((unsigned)i3, (unsigned)i3, false, false); oi[2] = (int)(hi ? a[0] : a[1]); }
#pragma unroll
    for (int k = 0; k < 3; ++k) { const float s_ = ov[k]; const int n = oi[k];
        if (s_ > v1 || (s_ == v1 && n < i1)) { v3 = v2; i3 = i2; v2 = v1; i2 = i1; v1 = s_; i1 = n; }
        else if (s_ > v2 || (s_ == v2 && n < i2)) { v3 = v2; i3 = i2; v2 = s_; i2 = n; }
        else if (s_ > v3 || (s_ == v3 && n < i3)) { v3 = s_; i3 = n; } }
    if (hi == 0) {
        const int j1 = v1 > NEGS ? i1 : 255, j2 = v2 > NEGS ? i2 : 255, j3 = v3 > NEGS ? i3 : 255;
        int l1 = 0, l2 = 0, l3 = 0;
        if (j1 < 32) { l1 = atomicAdd(&hist[j1], 1); IL[j1 * 256 + l1] = (unsigned char)qi; }
        if (j2 < 32) { l2 = atomicAdd(&hist[j2], 1); IL[j2 * 256 + l2] = (unsigned char)qi; }
        if (j3 < 32) { l3 = atomicAdd(&hist[j3], 1); IL[j3 * 256 + l3] = (unsigned char)qi; }
        SEL3[tt * 8 + h] = (unsigned)j1 | ((unsigned)j2 << 8) | ((unsigned)j3 << 16);
        LRK[tt * 8 + h] = (unsigned)l1 | ((unsigned)l2 << 8) | ((unsigned)l3 << 16);
    }
    AT_WAITL(); bar();
    if (tid < 32) BCm[tid] = hist[tid];
    AT_WAITL(); bar();
}
__device__ __forceinline__ void moba_tables(const int* BCmbh, int lane, int& tot, int& seg) {
    int s = 0;
    if (lane < 32) { for (int q = 0; q < 32; ++q) s += BCmbh[q * 32 + lane]; }
    tot = s;
    int pad = (s + 31) & ~31, inc = pad;
#pragma unroll
    for (int sft = 1; sft < 32; sft <<= 1) { const int o_ = __shfl_up(inc, sft); if ((lane & 31) >= sft) inc += o_; }
    seg = inc - pad;
}
__device__ __forceinline__ void moba_gather_unit(const Params& p, int bh, int j, int ch, int segj, bool reload, unsigned char* lds_raw) {
    const int tid = otid(), lane = tid & 63, r32 = lane & 31, hi = lane >> 5, wid = __builtin_amdgcn_readfirstlane(tid >> 6);
    lp lds = (lp)lds_raw;
    const int b = bh >> 3, h = bh & 7;
    const bf16_t* ZB = (const bf16_t*)(p.ws + WS_ZB);
    const int* BCmbh = (const int*)(p.ws + WS_BCM) + (size_t)bh * 32 * 32;
    float* wsf = (float*)(lds_raw + L_WSF) + wid * 64;
    const lp sK0 = lds + L_K, sV0 = lds + L_V;
    const bf16_t* KM_ = ZB + (size_t)b * S * ZBW + ZB_MK + h * 64; const bf16_t* VM_ = ZB + (size_t)b * S * ZBW + ZB_MV + h * 64;
    if (reload) {
#pragma unroll
        for (int k = 3; k >= 0; --k) { dma_k(sK0 + k * 8192, KM_, ZBW, j * 256 + 64 * k, wid, lane); dma_v(sV0 + k * 8192, VM_, ZBW, j * 256 + 64 * k, wid, lane); }
    }
    const int gr = 256 * ch + 32 * wid + r32;
    const int cq = lane < 32 ? BCmbh[lane * 32 + j] : 0;
    int run = 0, qbs = j + 1, lr = 0;
#pragma unroll 4
    for (int q = 0; q < 32; ++q) { const int c_ = __builtin_amdgcn_readlane(cq, q); if (gr >= run && gr < run + c_) { qbs = q; lr = gr - run; } run += c_; }
    const int totj = run;
    const bool valid = gr < totj;
    const unsigned char* IL = (const unsigned char*)(p.ws + WS_ILIST);
    const int qidx = valid ? (int)IL[((size_t)(bh * 32 + qbs) * 32 + j) * 256 + lr] : 0;
    const int t = valid ? qbs * 256 + qidx : (j + 1) * 256; const size_t tt = (size_t)b * S + t;
    const float c2 = exp2f(-(float)(h + 1)) * LOG2E;
    bf16x8 qr[4];
#pragma unroll
    for (int d0 = 0; d0 < 4; ++d0) qr[d0] = *(const bf16x8*)(ZB + tt * ZBW + ZB_MQ + h * 64 + d0 * 16 + hi * 8);
    Soft sm; sm.m = 0.f; sm.l = 0.f; f32x16 o[2]; o[0] = f32x16{}; o[1] = f32x16{};
#pragma unroll 1
    for (int i = 0; i < 4; ++i) {
        if (reload) { const int newer = 3 - i; if (newer >= 3) AT_WAITV(6); else AT_WAIT_NEWER(newer, 2); AT_WAITL(); bar(); }
        const int kt = 3 - i;
        const lp sK = sK0 + kt * 8192, sV = sV0 + kt * 8192;
        const float x0 = c2 * (float)(64 * kt) - sm.m;
        f32x16 p0 = cinit(c2, hi, x0), p1 = cinit(c2, hi, x0 + c2 * 32.f);
        qk_tile(p0, p1, sK, qr, r32, hi);
        VFrag vf; pv_load(vf, sV, lane, hi);
        softmax_step<true>(p0, p1, sm, o, wsf, r32, hi);
        { AT_PACK(p0, p1); pv_mfma(o, vf, pw0, pw1, pw2, pw3); }
    }
    {
        const float lt = halfsum(sm.l);
        float* PM = (float*)(p.ws + WS_PM) + (size_t)bh * MB_CAP; float* PL = (float*)(p.ws + WS_PL) + (size_t)bh * MB_CAP;
        if (hi == 0 && valid) { PM[segj + gr] = sm.m; PL[segj + gr] = lt; }
        bf16_t* stg = (bf16_t*)(lds_raw + L_OST) + wid * 4096;
#pragma unroll
        for (int r = 0; r < 16; ++r) { const int orow = crow(r, hi); stg[orow * 64 + r32] = (bf16_t)f2bf(o[0][r]); stg[orow * 64 + 32 + r32] = (bf16_t)f2bf(o[1][r]); }
        wsync();
        bf16_t* PO = (bf16_t*)(p.ws + WS_PO) + ((size_t)bh * MB_CAP + segj + 256 * ch + 32 * wid) * 64;
        const int nrow = totj - (256 * ch + 32 * wid);
#pragma unroll
        for (int i = 0; i < 4; ++i) { const int row = i * 8 + (lane >> 3), c8 = lane & 7; if (row < nrow) *(uint4*)(PO + (size_t)row * 64 + c8 * 8) = *(const uint4*)(stg + row * 64 + c8 * 8); }
        wsync();
    }
    AT_WAITL(); bar();
}
__device__ __forceinline__ void moba_self_unit(const Params& p, int b, int h, int qb, unsigned char* lds_raw) {
    const int tid = otid(), lane = tid & 63, r32 = lane & 31, hi = lane >> 5, wid = __builtin_amdgcn_readfirstlane(tid >> 6);
    lp lds = (lp)lds_raw;
    const int bh = b * 8 + h;
    const bf16_t* ZB = (const bf16_t*)(p.ws + WS_ZB);
    const int* BCmbh = (const int*)(p.ws + WS_BCM) + (size_t)bh * 32 * 32;
    const int qi = 32 * wid + r32, t = qb * 256 + qi; const size_t tt = (size_t)b * S + t;
    float* wsf = (float*)(lds_raw + L_WSF) + wid * 64;
    float* ostage = (float*)(lds_raw + L_OST) + wid * 2048;
    const float c2 = exp2f(-(float)(h + 1)) * LOG2E;
    bf16x8 qr[4];
#pragma unroll
    for (int d0 = 0; d0 < 4; ++d0) qr[d0] = *(const bf16x8*)(ZB + tt * ZBW + ZB_MQ + h * 64 + d0 * 16 + hi * 8);
    const lp sK0 = lds + L_K, sV0 = lds + L_V;
    const bf16_t* KM_ = ZB + (size_t)b * S * ZBW + ZB_MK + h * 64; const bf16_t* VM_ = ZB + (size_t)b * S * ZBW + ZB_MV + h * 64;
    Soft sm; sm.m = 0.f; sm.l = 0.f; f32x16 o[2]; o[0] = f32x16{}; o[1] = f32x16{};
#pragma unroll
    for (int k = 0; k < 3; ++k) { dma_k(sK0 + k * 8192, KM_, ZBW, qb * 256 + 64 * (3 - k), wid, lane); dma_v(sV0 + k * 8192, VM_, ZBW, qb * 256 + 64 * (3 - k), wid, lane); }
    int tot, seg; moba_tables(BCmbh, lane, tot, seg);
    int before = 0; if (lane < 32) { for (int q = 0; q < qb; ++q) before += BCmbh[q * 32 + lane]; }
    const int base = seg + before;
#pragma unroll 1
    for (int i = 0; i < 4; ++i) {
        const int newer = 3 - i; AT_WAIT_NEWER(newer, 2);
        AT_WAITL(); bar();
        if (i == 0) { dma_k(sK0 + 3 * 8192, KM_, ZBW, qb * 256, wid, lane); dma_v(sV0 + 3 * 8192, VM_, ZBW, qb * 256, wid, lane); }
        const lp sK = sK0 + i * 8192, sV = sV0 + i * 8192;
        const int kt = 3 - i;
        const bool skip = (32 * wid + 31 < 64 * kt);
        if (!skip) {
            const float x0 = c2 * (float)(64 * kt) - sm.m;
            f32x16 p0 = cinit(c2, hi, x0), p1 = cinit(c2, hi, x0 + c2 * 32.f);
            qk_tile(p0, p1, sK, qr, r32, hi);
            if (64 * kt + 63 > 32 * wid) mask_tile(p0, p1, 0, qi - 64 * kt, hi);
            VFrag vf; pv_load(vf, sV, lane, hi);
            softmax_step<true>(p0, p1, sm, o, wsf, r32, hi);
            { AT_PACK(p0, p1); pv_mfma(o, vf, pw0, pw1, pw2, pw3); }
        }
    }
    {
        const float lself = halfsum(sm.l);
        const unsigned s3 = ((const unsigned*)(p.ws + WS_SEL3))[tt * 8 + h], l3 = ((const unsigned*)(p.ws + WS_LRK))[tt * 8 + h];
        const float* PM = (const float*)(p.ws + WS_PM) + (size_t)bh * MB_CAP; const float* PL = (const float*)(p.ws + WS_PL) + (size_t)bh * MB_CAP;
        float mk[3], lk[3]; int pidx[3];
        float M = sm.m + c2 * 256.f * (float)qb;
        const float mself = M;
#pragma unroll
        for (int k = 0; k < 3; ++k) { const int jk = (s3 >> (8 * k)) & 255, lrk = (l3 >> (8 * k)) & 255;
            const int pb = __shfl(base, jk & 31);
            if (jk < 32) { pidx[k] = pb + lrk; mk[k] = PM[pidx[k]] + c2 * 256.f * (float)jk; lk[k] = PL[pidx[k]]; M = __builtin_fmaxf(M, mk[k]); }
            else { pidx[k] = -1; mk[k] = NEGS; lk[k] = 0.f; } }
        const float ws_ = __builtin_amdgcn_exp2f(mself - M);
        float wk[3]; float Lt = lself * ws_;
#pragma unroll
        for (int k = 0; k < 3; ++k) { wk[k] = pidx[k] >= 0 ? __builtin_amdgcn_exp2f(mk[k] - M) : 0.f; Lt += lk[k] * wk[k]; }
        const float inv = Lt > 0.f ? 1.f / Lt : 0.f;
        float* rws = wsf;
        float* rwk = (float*)(lds_raw + L_KMT) + wid * 256;
        int* rpi = (int*)(rwk + 96);
        if (hi == 0) { rws[r32] = ws_ * inv;
#pragma unroll
            for (int k = 0; k < 3; ++k) { rwk[k * 32 + r32] = wk[k] * inv; rpi[k * 32 + r32] = pidx[k]; } }
#pragma unroll
        for (int r = 0; r < 16; ++r) { const int orow = crow(r, hi); ostage[orow * 64 + r32] = o[0][r]; ostage[orow * 64 + 32 + r32] = o[1][r]; }
        wsync();
        const bf16_t* PO = (const bf16_t*)(p.ws + WS_PO) + (size_t)bh * MB_CAP * 64;
        bf16_t* AB = (bf16_t*)(p.ws + WS_ATTB);
#pragma unroll
        for (int i = 0; i < 4; ++i) { const int row = i * 8 + (lane >> 3), c8 = lane & 7;
            const float4 a = *(const float4*)(ostage + row * 64 + c8 * 8), c4 = *(const float4*)(ostage + row * 64 + c8 * 8 + 4);
            const float w0 = rws[row];
            float acc8[8] = {a.x * w0, a.y * w0, a.z * w0, a.w * w0, c4.x * w0, c4.y * w0, c4.z * w0, c4.w * w0};
#pragma unroll
            for (int k = 0; k < 3; ++k) { const int pi = rpi[k * 32 + row]; if (pi >= 0) { const float w = rwk[k * 32 + row]; const uint4 q = *(const uint4*)(PO + (size_t)pi * 64 + c8 * 8);
                const unsigned qq_[4] = {q.x, q.y, q.z, q.w};
#pragma unroll
                for (int e = 0; e < 4; ++e) { acc8[2 * e] += __builtin_bit_cast(float, qq_[e] << 16) * w; acc8[2 * e + 1] += __builtin_bit_cast(float, qq_[e] & 0xffff0000u) * w; } } }
            *(uint4*)(AB + ((size_t)b * S + qb * 256 + 32 * wid + row) * D + 512 + h * 64 + c8 * 8) = make_uint4(pk2(acc8[0], acc8[1]), pk2(acc8[2], acc8[3]), pk2(acc8[4], acc8[5]), pk2(acc8[6], acc8[7])); }
        wsync();
    }
    AT_WAITL(); bar();
}
}

__device__ __forceinline__ void phase_att1(const Params& p, unsigned char* lds_raw) {
    const int tid = otid();
    int* pre = (int*)(lds_raw + at::L_END);
    int* segt = pre + 514;
    { const int* BCm = (const int*)(p.ws + WS_BCM); const int bh = tid >> 5, j = tid & 31; int s = 0;
      for (int q = 0; q < 32; ++q) s += BCm[(size_t)(bh * 32 + q) * 32 + j];
      pre[tid + 1] = (s + 255) >> 8; if (tid == 0) pre[0] = 0;
      segt[tid] = (s + 31) & ~31; }
    __syncthreads();
    for (int sft = 1; sft < 512; sft <<= 1) { int v = 0, w = 0; if (tid >= sft) v = pre[tid + 1 - sft]; if ((tid & 31) >= sft) w = segt[tid - sft]; __syncthreads(); pre[tid + 1] += v; if (sft < 32) segt[tid] += w; __syncthreads(); }
    { const int* BCm = (const int*)(p.ws + WS_BCM); const int bh = tid >> 5, j = tid & 31; int s = 0;
      for (int q = 0; q < 32; ++q) s += BCm[(size_t)(bh * 32 + q) * 32 + j];
      const int excl = segt[tid] - ((s + 31) & ~31); __syncthreads(); segt[tid] = excl; }
    __syncthreads();
    const int nun = pre[512];
    for (int pi = blockIdx.x; pi < 512; pi += gridDim.x) {
        const int rnd = pi >> 8, id = pi & 255;
        const int bg = 2 * rnd + (id >> 7), c = rnd ? 127 - (id & 127) : (id & 127); at::nsa_unit(p, bg >> 1, bg & 1, c, lds_raw);
    }
    {
        const int u0 = (int)(((long)blockIdx.x * nun) / gridDim.x), u1 = (int)(((long)(blockIdx.x + 1) * nun) / gridDim.x);
        int prev = -1;
        for (int u = u0; u < u1; ++u) {
            int lo = 0, hi_ = 511;
            while (lo < hi_) { const int mid = (lo + hi_ + 1) >> 1; if (pre[mid] <= u) lo = mid; else hi_ = mid - 1; }
            at::moba_gather_unit(p, lo >> 5, lo & 31, u - pre[lo], segt[lo], lo != prev, lds_raw);
            prev = lo;
        }
    }
}
__device__ __forceinline__ void phase_att2(const Params& p, unsigned char* lds_raw) {
    for (int pi = blockIdx.x; pi < 512; pi += gridDim.x) {
        const int rnd = pi >> 8, id = pi & 255;
        const int bh = 8 * rnd + (id >> 5), qb = rnd ? 31 - (id & 31) : (id & 31); at::moba_self_unit(p, bh >> 3, bh & 7, qb, lds_raw);
    }
}
__device__ __forceinline__ void phase_route(const Params& p, unsigned char* lds_raw) {
    for (int pi = blockIdx.x; pi < 512; pi += gridDim.x) at::moba_route_unit(p, pi >> 8, (pi >> 5) & 7, pi & 31, lds_raw);
}


__device__ __forceinline__ void phase_r2_fast(const Params& p, int l, unsigned char* lds_raw) {
    using namespace at;
    const int tid = otid(), lane = tid & 63, wave = __builtin_amdgcn_readfirstlane(tid >> 6), r32 = lane & 31, hi = lane >> 5;
    const float* mod = (const float*)(p.ws + WS_MOD);
    const bf16_t* XAB = (const bf16_t*)(p.ws + WS_XAB); bf16_t* XN = (bf16_t*)(p.ws + WS_XN); bf16_t* XL = (bf16_t*)(p.ws + WS_XNLO);
    const float* lng = p.in[5] + (size_t)l * D; const float* rw = p.in[15] + (size_t)l * D * NE; const float* rb = p.in[16] + l * NE;
    int* toke = (int*)(p.ws + WS_TOKE); float* tokw = (float*)(p.ws + WS_TOKW); int* BC = (int*)(p.ws + WS_BC);
    lp lds = (lp)lds_raw;
    int* hist = (int*)(lds_raw + 131072);
    for (int blk = blockIdx.x; blk < T / 64; blk += gridDim.x) {
        for (int idx = tid; idx < 128 * 32; idx += NT) {
            const int kc = idx >> 5, e = idx & 31; float v[8];
#pragma unroll
            for (int j = 0; j < 8; ++j) v[j] = rw[(size_t)(8 * kc + j) * NE + e];
            unsigned hh[8], ll[8];
#pragma unroll
            for (int j = 0; j < 8; ++j) { hh[j] = f2bf(v[j]); ll[j] = f2bf(v[j] - __builtin_bit_cast(float, hh[j] << 16)); }
            *(uint4*)(lds_raw + (size_t)idx * 16) = make_uint4(hh[0] | (hh[1] << 16), hh[2] | (hh[3] << 16), hh[4] | (hh[5] << 16), hh[6] | (hh[7] << 16));
            *(uint4*)(lds_raw + 65536 + (size_t)idx * 16) = make_uint4(ll[0] | (ll[1] << 16), ll[2] | (ll[3] << 16), ll[4] | (ll[5] << 16), ll[6] | (ll[7] << 16));
        }
        if (tid < 32) hist[tid] = 0;
        {
            const int b = (blk * 64) / S;
            const float* sh = mod + ((size_t)l * Bn + b) * 6144 + 3 * D; const float* sc = mod + ((size_t)l * Bn + b) * 6144 + 4 * D;
            float4 ga[4], s0v[4];
#pragma unroll
            for (int j = 0; j < 4; ++j) { const int col = 4 * lane + 256 * j; const float4 g = *(const float4*)(lng + col), s1 = *(const float4*)(sc + col); s0v[j] = *(const float4*)(sh + col);
                ga[j] = make_float4(g.x * (1.f + s1.x), g.y * (1.f + s1.y), g.z * (1.f + s1.z), g.w * (1.f + s1.w)); }
#pragma unroll 1
            for (int i0 = 0; i0 < 8; i0 += 4) {
                uint2 q_[4][4];
#pragma unroll
                for (int i = 0; i < 4; ++i)
#pragma unroll
                    for (int j = 0; j < 4; ++j) q_[i][j] = *(const uint2*)(XAB + (size_t)(blk * 64 + wave * 8 + i0 + i) * D + 4 * lane + 256 * j);
                float ss[4];
#pragma unroll
                for (int i = 0; i < 4; ++i) { float s_ = 0.f;
#pragma unroll
                    for (int j = 0; j < 4; ++j) { const float x0 = __builtin_bit_cast(float, q_[i][j].x << 16), x1 = __builtin_bit_cast(float, q_[i][j].x & 0xffff0000u), x2 = __builtin_bit_cast(float, q_[i][j].y << 16), x3 = __builtin_bit_cast(float, q_[i][j].y & 0xffff0000u);
                        s_ += (x0 * x0 + x1 * x1) + (x2 * x2 + x3 * x3); }
                    ss[i] = s_; }
#pragma unroll
                for (int sft = 32; sft >= 1; sft >>= 1) {
#pragma unroll
                    for (int i = 0; i < 4; ++i) ss[i] += __shfl_xor(ss[i], sft); }
#pragma unroll
                for (int i = 0; i < 4; ++i) {
                    const int t = blk * 64 + wave * 8 + i0 + i;
                    const float r = rsqrtf(ss[i] * (1.f / D) + EPS);
#pragma unroll
                    for (int j = 0; j < 4; ++j) {
                        const int col = 4 * lane + 256 * j;
                        const float x0 = __builtin_bit_cast(float, q_[i][j].x << 16), x1 = __builtin_bit_cast(float, q_[i][j].x & 0xffff0000u), x2 = __builtin_bit_cast(float, q_[i][j].y << 16), x3 = __builtin_bit_cast(float, q_[i][j].y & 0xffff0000u);
                        const float o[4] = {x0 * r * ga[j].x + s0v[j].x, x1 * r * ga[j].y + s0v[j].y, x2 * r * ga[j].z + s0v[j].z, x3 * r * ga[j].w + s0v[j].w};
                        unsigned hh[4], ll[4];
#pragma unroll
                        for (int q = 0; q < 4; ++q) { hh[q] = f2bf(o[q]); ll[q] = f2bf(o[q] - __builtin_bit_cast(float, hh[q] << 16)); }
                        *(uint2*)(XN + (size_t)t * D + col) = make_uint2(hh[0] | (hh[1] << 16), hh[2] | (hh[3] << 16));
                        *(uint2*)(XL + (size_t)t * D + col) = make_uint2(ll[0] | (ll[1] << 16), ll[2] | (ll[3] << 16));
                    }
                }
            }
        }
        asm volatile("s_waitcnt vmcnt(0)" ::: "memory");
        __syncthreads();
        f32x16 acc = f32x16{};
        {
            const int rh = wave & 1, kq = wave >> 1;
            const int t = blk * 64 + rh * 32 + r32;
            const bf16_t* xh = XN + (size_t)t * D + 8 * hi + 256 * kq; const bf16_t* xl = XL + (size_t)t * D + 8 * hi + 256 * kq;
            const AT_LAS unsigned char* wh = lds + (size_t)(hi * 32 + r32) * 16 + (size_t)kq * 16 * 1024; const AT_LAS unsigned char* wl = wh + 65536;
#pragma unroll 8
            for (int ks = 0; ks < 16; ++ks) {
                const bf16x8 bh = *(const bf16x8*)(xh + 16 * ks), bl = *(const bf16x8*)(xl + 16 * ks);
                const bf16x8 ah = *(const AT_LAS bf16x8*)(wh + ks * 1024), al = *(const AT_LAS bf16x8*)(wl + ks * 1024);
                acc = __builtin_amdgcn_mfma_f32_32x32x16_bf16(ah, bh, acc, 0, 0, 0);
                acc = __builtin_amdgcn_mfma_f32_32x32x16_bf16(al, bh, acc, 0, 0, 0);
                acc = __builtin_amdgcn_mfma_f32_32x32x16_bf16(ah, bl, acc, 0, 0, 0);
            }
        }
        __syncthreads();
        { float* part = (float*)lds_raw;
          if (wave >= 2) {
#pragma unroll
              for (int r = 0; r < 16; ++r) part[(wave * 16 + r) * 64 + lane] = acc[r]; } }
        __syncthreads();
        if (wave < 2) {
            const int t = blk * 64 + wave * 32 + r32;
            { const float* part = (const float*)lds_raw;
#pragma unroll
              for (int r = 0; r < 16; ++r) acc[r] = ((acc[r] + part[((wave + 2) * 16 + r) * 64 + lane]) + part[((wave + 4) * 16 + r) * 64 + lane]) + part[((wave + 6) * 16 + r) * 64 + lane]; }
            float a0 = -3e38f, a1 = -3e38f, a2 = -3e38f, a3 = -3e38f; int i0 = 99, i1 = 99, i2 = 99, i3 = 99;
#pragma unroll
            for (int r = 0; r < 16; ++r) { const int e = crow(r, hi); const float s_ = acc[r] + rb[e];
                if (s_ > a0) { a3 = a2; i3 = i2; a2 = a1; i2 = i1; a1 = a0; i1 = i0; a0 = s_; i0 = e; }
                else if (s_ > a1) { a3 = a2; i3 = i2; a2 = a1; i2 = i1; a1 = s_; i1 = e; }
                else if (s_ > a2) { a3 = a2; i3 = i2; a2 = s_; i2 = e; }
                else if (s_ > a3) { a3 = s_; i3 = e; } }
            float ov[4]; int oi[4];
            { const float sv[4] = {a0, a1, a2, a3}; const int si[4] = {i0, i1, i2, i3};
#pragma unroll
              for (int k = 0; k < 4; ++k) { auto a = __builtin_amdgcn_permlane32_swap(__float_as_uint(sv[k]), __float_as_uint(sv[k]), false, false); ov[k] = __uint_as_float(hi ? a[0] : a[1]);
                                            auto c = __builtin_amdgcn_permlane32_swap((unsigned)si[k], (unsigned)si[k], false, false); oi[k] = (int)(hi ? c[0] : c[1]); } }
#pragma unroll
            for (int k = 0; k < 4; ++k) { const float s_ = ov[k]; const int e = oi[k];
                if (s_ > a0 || (s_ == a0 && e < i0)) { a3 = a2; i3 = i2; a2 = a1; i2 = i1; a1 = a0; i1 = i0; a0 = s_; i0 = e; }
                else if (s_ > a1 || (s_ == a1 && e < i1)) { a3 = a2; i3 = i2; a2 = a1; i2 = i1; a1 = s_; i1 = e; }
                else if (s_ > a2 || (s_ == a2 && e < i2)) { a3 = a2; i3 = i2; a2 = s_; i2 = e; }
                else if (s_ > a3 || (s_ == a3 && e < i3)) { a3 = s_; i3 = e; } }
            const float e1 = __expf(a1 - a0), e2 = __expf(a2 - a0), e3 = __expf(a3 - a0), inv = 1.f / (((1.f + e1) + e2) + e3);
            if (hi == 0) {
                *(int4*)(toke + (size_t)t * 4) = make_int4(i0, i1, i2, i3);
                *(float4*)(tokw + (size_t)t * 4) = make_float4(inv, e1 * inv, e2 * inv, e3 * inv);
                atomicAdd(&hist[i0], 1); atomicAdd(&hist[i1], 1); atomicAdd(&hist[i2], 1); atomicAdd(&hist[i3], 1);
            }
        }
        __syncthreads();
        if (tid < 32) BC[blk * 32 + tid] = hist[tid];
        __syncthreads();
    }
}
__device__ __forceinline__ void phase_sc_fast(const Params& p, int l, unsigned char* lds_raw) {
    const int tid = otid();
    const int* BC = (const int*)(p.ws + WS_BC);
    int* cnt = (int*)(p.ws + WS_CNT) + l * 32;
    int* tot = (int*)lds_raw; int* base = tot + 32; int* fillc = tot + 64; int* before = tot + 96;
    const int* toke = (const int*)(p.ws + WS_TOKE); const float* tokw = (const float*)(p.ws + WS_TOKW);
    int* rowtok = (int*)(p.ws + WS_ROWTOK) + (size_t)l * RMAX; float* roww = (float*)(p.ws + WS_ROWW) + (size_t)l * RMAX; int* pos = (int*)(p.ws + WS_POS);
    for (int blk = blockIdx.x; blk < T / 64; blk += gridDim.x) {
        { const int e = tid & 31, part = tid >> 5; int s = 0, bf = 0;
#pragma unroll 4
          for (int i = part * 16; i < part * 16 + 16; ++i) { const int c = BC[i * 32 + e]; s += c; if (i < blk) bf += c; }
          int* ptot = tot + 128; int* pbef = ptot + 512;
          ptot[tid] = s; pbef[tid] = bf; }
        __syncthreads();
        if (tid < 32) { const int* ptot = tot + 128; const int* pbef = ptot + 512; int s = 0, bf = 0;
#pragma unroll
            for (int q = 0; q < 16; ++q) { s += ptot[q * 32 + tid]; bf += pbef[q * 32 + tid]; }
            tot[tid] = s; before[tid] = bf; fillc[tid] = 0; if (blk == 0) cnt[tid] = s; }
        __syncthreads();
        if (tid == 0) { int s = 0; for (int e = 0; e < 32; ++e) { base[e] = s + before[e]; s += (tot[e] + 255) & ~255; } }
        __syncthreads();
        if (tid < 256) {
            const int i = blk * 256 + tid, e = toke[i];
            const int slot = base[e] + atomicAdd(&fillc[e], 1);
            rowtok[slot] = i >> 2; roww[slot] = tokw[i]; pos[i] = slot;
        }
        __syncthreads();
    }
}

#define XB_TMO      128
#define XB_XCNT(j)  (256  + 64 * (j))
#define XB_XSUB(j)  (1280 + 64 * (j))
#define XB_XGEN(j)  (2304 + 64 * (j))
#define XB_TOP      3328
#define XB_TOPGEN   3392
#define XCD_BAR_WORDS 3456
#define XB_SPIN_CAP (1u << 18)
#define XLAS __attribute__((address_space(3)))
__device__ __forceinline__ unsigned xb_ld(unsigned* p)              { return __hip_atomic_load(p, __ATOMIC_RELAXED, __HIP_MEMORY_SCOPE_AGENT); }
__device__ __forceinline__ unsigned xb_add(unsigned* p, unsigned v) { return __hip_atomic_fetch_add(p, v, __ATOMIC_RELAXED, __HIP_MEMORY_SCOPE_AGENT); }
__device__ __forceinline__ unsigned xb_xcc_id() { return (unsigned)__builtin_amdgcn_s_getreg((3 << 11) | 20) & 0xFu; }
#define XB_SPIN(cond, bar) do { unsigned _sp = 0; while (cond) { __builtin_amdgcn_s_sleep(1); \
    if ((++_sp & 255u) == 0u) { if (xb_ld(&(bar)[XB_TMO])) break; if (_sp > XB_SPIN_CAP) { atomicAdd(&(bar)[XB_TMO], 1u); break; } } } } while (0)
constexpr int LDS_BARST_OFF = 147200;
struct XcdBarrier { unsigned* bar; unsigned x; volatile XLAS unsigned* st; };
__device__ __forceinline__ XcdBarrier xcd_barrier_post(unsigned* bar, volatile XLAS unsigned* st) {
    XcdBarrier b; b.bar = bar; b.x = xb_xcc_id(); b.st = st;
    if (threadIdx.x == 0) (void)xb_add(&bar[XB_XCNT(b.x)], 1u);
    return b;
}
__device__ __forceinline__ void xcd_barrier_complete(unsigned* bar, unsigned x, unsigned& nloc, unsigned& nx) {
    const unsigned G = gridDim.x * gridDim.y * gridDim.z;
    unsigned sum, cnt, mine, sp = 0u;
    for (;;) {
        sum = 0u; cnt = 0u; mine = 0u;
#pragma unroll
        for (unsigned j = 0; j < 16; ++j) { const unsigned c = xb_ld(&bar[XB_XCNT(j)]); sum += c; cnt += (c > 0u) ? 1u : 0u; mine = (j == x) ? c : mine; }
        if (sum == G) break;
        __builtin_amdgcn_s_sleep(1);
        if ((++sp & 255u) == 0u) { if (xb_ld(&bar[XB_TMO])) break; if (sp > XB_SPIN_CAP) { atomicAdd(&bar[XB_TMO], 1u); break; } }
    }
    nloc = mine > 0u ? mine : 1u; nx = cnt > 0u ? cnt : 1u;
}
__device__ __forceinline__ void xcd_barrier(unsigned char* ws, unsigned char* lds_raw_) {
    XcdBarrier b; b.bar = (unsigned*)(ws + WS_BAR); b.x = xb_xcc_id(); b.st = (volatile XLAS unsigned*)((XLAS unsigned char*)lds_raw_ + LDS_BARST_OFF);
    asm volatile("s_waitcnt vmcnt(0)" ::: "memory");
    __syncthreads();
    if (threadIdx.x == 0) {
        unsigned* bar = b.bar;
        __builtin_amdgcn_s_waitcnt(0);
        unsigned nloc = b.st[0], nx = b.st[1];
        if (nloc == 0u) { xcd_barrier_complete(bar, b.x, nloc, nx); b.st[0] = nloc; b.st[1] = nx; }
        const unsigned old = xb_add(&bar[XB_XSUB(b.x)], 1u);
        const unsigned gen = old / nloc;
        if (old + 1u == (gen + 1u) * nloc) {
            __builtin_amdgcn_fence(__ATOMIC_RELEASE, "agent");
            asm volatile("s_waitcnt vmcnt(0)" ::: "memory");
            const unsigned og = xb_add(&bar[XB_TOP], 1u);
            const unsigned tg = og / nx;
            if (og + 1u == (tg + 1u) * nx) xb_add(&bar[XB_TOPGEN], 1u);
            else XB_SPIN(xb_ld(&bar[XB_TOPGEN]) == tg, bar);
            __builtin_amdgcn_fence(__ATOMIC_ACQUIRE, "agent");
            xb_add(&bar[XB_XGEN(b.x)], 1u);
            asm volatile("s_waitcnt vmcnt(0)" ::: "memory");
        } else {
            XB_SPIN(xb_ld(&bar[XB_XGEN(b.x)]) == gen, bar);
            __builtin_amdgcn_fence(__ATOMIC_ACQUIRE, "agent");
            asm volatile("s_waitcnt vmcnt(0)" ::: "memory");
        }
    }
    __syncthreads();
}

__global__ void __launch_bounds__(NT, 2) mega_fwd(Params p) {
    extern __shared__ __attribute__((aligned(16))) unsigned char lds_raw[];
    float* lds = (float*)lds_raw;
    volatile XLAS unsigned* bst = (volatile XLAS unsigned*)((XLAS unsigned char*)lds_raw + LDS_BARST_OFF);
    if (threadIdx.x < 2) bst[threadIdx.x] = 0u;
    __syncthreads();
    (void)xcd_barrier_post((unsigned*)(p.ws + WS_BAR), bst);
#define GSYNC() xcd_barrier(p.ws, lds_raw)
    phase_p0a(p, lds);
    __syncthreads();
    phase_convert(p, lds);
    GSYNC();
    phase_p0b(p);
    GSYNC();
    _Pragma("unroll 1") for (int l = 0; l < L; ++l) {
        phase_r1(p, l, true);
        GSYNC();
        phase_g1_fast(p, l, lds_raw);
        GSYNC();
        phase_ck_fast(p, l, lds_raw);
        GSYNC();
        phase_c2(p, l, lds);
        __syncthreads();
        phase_route(p, lds_raw);
        GSYNC();
        phase_att1(p, lds_raw);
        GSYNC();
        phase_att2(p, lds_raw);
        GSYNC();
        phase_g2_fast(p, l, lds_raw);
        GSYNC();
        phase_r2_fast(p, l, lds_raw);
        GSYNC();
        phase_sc_fast(p, l, lds_raw);
        GSYNC();
        phase_m1_fast(p, l, lds_raw);
        GSYNC();
        phase_m2_fast(p, l, lds_raw);
        GSYNC();
    }
    phase_r1(p, L, false);
}

extern "C" void kernel_launch(void* const* d_in, const int* in_sizes, int n_in, void* d_out, int out_size, void* d_ws, size_t ws_size, hipStream_t stream) {
    static int grid_blocks = 0;
    if (grid_blocks == 0) {
        if (n_in != 21 || out_size != T * D || ws_size < WS_END) { fprintf(stderr, "kernel_launch: unexpected shapes (n_in %d out %d ws %zu need %zu)\n", n_in, out_size, ws_size, (size_t)WS_END); grid_blocks = -1; return; }
        int dev = 0, cus = 0, per_cu = 0;
        hipGetDevice(&dev);
        hipDeviceGetAttribute(&cus, hipDeviceAttributeMultiprocessorCount, dev);
        hipFuncSetAttribute((const void*)mega_fwd, hipFuncAttributeMaxDynamicSharedMemorySize, LDS_BYTES);
        hipOccupancyMaxActiveBlocksPerMultiprocessor(&per_cu, (const void*)mega_fwd, NT, LDS_BYTES);
        if (per_cu < 1) { fprintf(stderr, "kernel_launch: occupancy query says %d blocks per CU\n", per_cu); per_cu = 1; }
        (void)hipGetLastError();
        grid_blocks = cus * 1;
    }
    if (grid_blocks < 0) return;
    if (hipMemsetAsync((char*)d_ws + WS_BAR, 0, 16384, stream) != hipSuccess) { fprintf(stderr, "kernel_launch: memset failed\n"); return; }
    Params p{};
    for (int i = 0; i < 21; ++i) p.in[i] = (const float*)d_in[i];
    p.out = (float*)d_out; p.ws = (unsigned char*)d_ws;
    hipLaunchKernelGGL(mega_fwd, dim3(grid_blocks), dim3(NT), LDS_BYTES, stream, p);
    hipError_t e = hipPeekAtLastError();
    if (e != hipSuccess) fprintf(stderr, "launch failed: %s (grid %d)\n", hipGetErrorString(e), grid_blocks);
}
```

```cpp
#include <hip/hip_runtime.h>
#include <cstdio>
#include <cstdint>

constexpr int Bn = 2, S = 8192, D = 1024, L = 2, T = Bn * S;
constexpr int INW = 2840;
constexpr int NE = 32, TOPK = 4, DFF = 1024;
constexpr int A_TOT = T * TOPK;
constexpr int RMAX = A_TOT + NE * 256;
constexpr int NCMP = 511;
constexpr int NT = 512;
constexpr int NW = NT / 64;
constexpr int LDS_BYTES = 147456;
constexpr float EPS = 1e-6f;
constexpr float NEGF = -1e30f;

constexpr int ZBW = 3072;
constexpr int ZB_Q = 0, ZB_KC = 512, ZB_VC = 640, ZB_KS = 768, ZB_VS = 896, ZB_KW = 1024, ZB_VW = 1152, ZB_MQ = 1280, ZB_MK = 1792, ZB_MV = 2304, ZB_G = 2816;
constexpr float QSCALE = 0.125f * 1.4426950408889634f;
constexpr float LOG2E = 1.4426950408889634f;

constexpr size_t al256(size_t x) { return (x + 255) & ~(size_t)255; }
constexpr size_t WS_BAR = 0;
constexpr size_t WS_MODP = 16384;
constexpr size_t WS_MOD = al256(WS_MODP + (size_t)8 * L * Bn * 6144 * 4);
constexpr size_t WS_CNT = al256(WS_MOD + (size_t)L * Bn * 6144 * 4);
constexpr size_t WS_ROWTOK = al256(WS_CNT + L * 32 * 4);
constexpr size_t WS_ROWW = al256(WS_ROWTOK + (size_t)L * RMAX * 4);
constexpr size_t WS_TOKE = al256(WS_ROWW + (size_t)L * RMAX * 4);
constexpr size_t WS_TOKW = al256(WS_TOKE + (size_t)T * 4 * 4);
constexpr size_t WS_POS = al256(WS_TOKW + (size_t)T * 4 * 4);
constexpr size_t WS_Y = al256(WS_POS + (size_t)T * 4 * 4);
constexpr size_t WS_WINT = al256(WS_Y + (size_t)RMAX * 1024 * 4);
constexpr size_t WS_WOT = al256(WS_WINT + (size_t)L * 3072 * 1024 * 2);
constexpr size_t WS_W1T = al256(WS_WOT + (size_t)L * 1024 * 1024 * 2);
constexpr size_t WS_W2T = al256(WS_W1T + (size_t)L * NE * 2048 * 1024 * 2);
constexpr size_t WS_XN = al256(WS_W2T + (size_t)L * NE * 1024 * 1024 * 2);
constexpr size_t WS_ATTB = al256(WS_XN + (size_t)(T + 1) * D * 2);
constexpr size_t WS_ACT = al256(WS_ATTB + (size_t)T * D * 2);
constexpr size_t WS_ZB = al256(WS_ACT + (size_t)RMAX * DFF * 2);
constexpr size_t WS_GATE = al256(WS_ZB + (size_t)T * ZBW * 2);
constexpr size_t WS_KCB = al256(WS_GATE + (size_t)T * 32 * 4);
constexpr size_t WS_VCB = al256(WS_KCB + (size_t)Bn * 2 * 512 * 64 * 2);
constexpr size_t WS_KMB = al256(WS_VCB + (size_t)Bn * 2 * 512 * 64 * 2);
constexpr size_t WS_XNLO = al256(WS_KMB + (size_t)Bn * 8 * 32 * 64 * 2);
constexpr size_t WS_BC = al256(WS_XNLO + (size_t)T * D * 2);
constexpr size_t WS_WCT = al256(WS_BC + (size_t)(T / 64) * 32 * 4);
constexpr size_t WS_CBP = al256(WS_WCT + (size_t)L * 2 * 128 * 2048 * 2);
constexpr size_t WS_CB = al256(WS_CBP + (size_t)16 * L * 2 * 128 * 4);
constexpr size_t WS_HIDP = al256(WS_CB + (size_t)L * 2 * 128 * 4);
constexpr size_t WS_XAB = al256(WS_HIDP + (size_t)4 * 2 * 2044 * 128 * 4);
constexpr size_t WS_SEL3 = al256(WS_XAB + (size_t)T * D * 2);
constexpr size_t WS_LRK = al256(WS_SEL3 + (size_t)T * 8 * 4);
constexpr size_t WS_ILIST = al256(WS_LRK + (size_t)T * 8 * 4);
constexpr size_t WS_BCM = al256(WS_ILIST + (size_t)16 * 32 * 32 * 256);
constexpr size_t WS_PM = al256(WS_BCM + (size_t)16 * 32 * 32 * 4);
constexpr size_t WS_PL = al256(WS_PM + (size_t)16 * 25600 * 4);
constexpr size_t WS_PO = al256(WS_PL + (size_t)16 * 25600 * 4);
constexpr size_t WS_XN8 = al256(WS_PO + (size_t)16 * 25600 * 64 * 2);
constexpr size_t WS_DQ1 = al256(WS_XN8 + (size_t)(T + 1) * D);
constexpr size_t WS_DQ2 = al256(WS_DQ1 + (size_t)L * NE * 2048 * 4);
constexpr size_t WS_END = al256(WS_DQ2 + (size_t)L * NE * 1024 * 4);
constexpr float XS8 = 16.f, AS8 = 8.f;

struct Params {
    const float* in[21];
    float* out;
    unsigned char* ws;
};

__device__ __forceinline__ int otid() { int t = threadIdx.x; asm volatile("" : "+v"(t)); return t; }
typedef unsigned short bf16_t;
__device__ __forceinline__ unsigned f2bf(float f) { unsigned u = __builtin_bit_cast(unsigned, f); return (u + 0x7fffu + ((u >> 16) & 1u)) >> 16; }
__device__ __forceinline__ unsigned pk2(float lo, float hi) { return f2bf(lo) | (f2bf(hi) << 16); }
__device__ __forceinline__ unsigned pk_fp8x4(float a, float b, float c, float d) {
    a = __builtin_amdgcn_fmed3f(a, -448.f, 448.f); b = __builtin_amdgcn_fmed3f(b, -448.f, 448.f); c = __builtin_amdgcn_fmed3f(c, -448.f, 448.f); d = __builtin_amdgcn_fmed3f(d, -448.f, 448.f);
    int r = __builtin_amdgcn_cvt_pk_fp8_f32(a, b, 0, false);
    r = __builtin_amdgcn_cvt_pk_fp8_f32(c, d, r, true);
    return (unsigned)r; }
__device__ __forceinline__ float bf2f(bf16_t v) { return __builtin_bit_cast(float, (unsigned)v << 16); }
__device__ __forceinline__ float wave_sum(float v) {
#pragma unroll
    for (int o = 1; o < 64; o <<= 1) v += __shfl_xor(v, o);
    return v;
}
__device__ __forceinline__ float sigmoidf_(float x) { return 1.f / (1.f + __expf(-x)); }
__device__ __forceinline__ float gelu_tanh(float x) {
    const float u = 0.7978845608028654f * (x + 0.044715f * x * x * x);
    return 0.5f * x * (1.f + tanhf(u));
}

__device__ __forceinline__ void phase_p0a(const Params& p, float* lds) {
    const int tid = otid(), gtid = blockIdx.x * NT + tid, gsz = gridDim.x * NT;
    int* cnt = (int*)(p.ws + WS_CNT); int* rowtok = (int*)(p.ws + WS_ROWTOK);
    for (int i = gtid; i < L * 32; i += gsz) cnt[i] = 0;
    for (int i = gtid; i < L * RMAX; i += gsz) rowtok[i] = -1;
    const float* c = p.in[1];
    for (int i = tid; i < Bn * D; i += NT) { const float v = c[i]; lds[i] = v / (1.f + __expf(-v)); }
    __syncthreads();
    const float* ada_w = p.in[2];
    float* modp = (float*)(p.ws + WS_MODP);
    for (int idx = gtid; idx < 8 * L * 6144; idx += gsz) {
        const int col = idx % 6144, l = (idx / 6144) % L, kc = idx / (6144 * L);
        const float* w = ada_w + ((size_t)l * D + kc * 128) * 6144 + col;
        float a0 = 0.f, a1 = 0.f, c0 = 0.f, c1 = 0.f;
#pragma unroll 1
        for (int k0 = 0; k0 < 128; k0 += 32) { float wv[32];
#pragma unroll
            for (int k = 0; k < 32; ++k) wv[k] = __builtin_nontemporal_load(w + (size_t)(k0 + k) * 6144);
#pragma unroll
            for (int k = 0; k < 32; k += 2) { a0 += lds[kc * 128 + k0 + k] * wv[k]; a1 += lds[D + kc * 128 + k0 + k] * wv[k]; c0 += lds[kc * 128 + k0 + k + 1] * wv[k + 1]; c1 += lds[D + kc * 128 + k0 + k + 1] * wv[k + 1]; } }
        modp[((size_t)(kc * L + l) * Bn + 0) * 6144 + col] = a0 + c0;
        modp[((size_t)(kc * L + l) * Bn + 1) * 6144 + col] = a1 + c1;
    }
    { const float* posw = p.in[9]; const float* w1c = p.in[10]; float* cbp = (float*)(p.ws + WS_CBP);
      int first = 8 * L * 6144; if (first + 16 * L * 2 * 128 > gsz) first = 0;
      for (int idx = gtid - first; idx < 16 * L * 2 * 128; idx += gsz) { if (idx < 0) continue;
          const int j = idx & 127, li = (idx >> 7) % (L * 2), kc = idx / (L * 2 * 128);
          const float* w = w1c + ((size_t)li * 2048 + kc * 128) * 128 + j; const float* pp = posw + (size_t)li * 2048 + kc * 128;
          float a = 0.f, c_ = 0.f;
#pragma unroll 1
          for (int k0 = 0; k0 < 128; k0 += 32) { float wv[32];
#pragma unroll
              for (int k = 0; k < 32; ++k) wv[k] = w[(size_t)(k0 + k) * 128];
#pragma unroll
              for (int k = 0; k < 32; k += 2) { a += pp[k0 + k] * wv[k]; c_ += pp[k0 + k + 1] * wv[k + 1]; } }
          cbp[idx] = a + c_; } }
}
__device__ __forceinline__ void phase_p0b(const Params& p) {
    const int gtid = blockIdx.x * NT + otid(), gsz = gridDim.x * NT;
    { const float* cbp = (const float*)(p.ws + WS_CBP); float* cb = (float*)(p.ws + WS_CB);
      for (int idx = gtid; idx < L * 2 * 128; idx += gsz) { float s = 0.f;
#pragma unroll
          for (int kc = 0; kc < 16; ++kc) s += cbp[kc * (L * 2 * 128) + idx];
          cb[idx] = s; } }
    const float* modp = (const float*)(p.ws + WS_MODP); float* mod = (float*)(p.ws + WS_MOD); const float* ada_b = p.in[3];
    for (int idx = gtid; idx < L * Bn * 6144; idx += gsz) {
        const int col = idx % 6144, l = idx / (Bn * 6144);
        float s = ada_b[l * 6144 + col];
#pragma unroll
        for (int kc = 0; kc < 8; ++kc) s += modp[(size_t)kc * L * Bn * 6144 + idx];
        mod[idx] = s;
    }
}

__device__ __forceinline__ void phase_r1(const Params& p, int l, bool do_h) {
    const int lane = otid() & 63, wave = otid() >> 6;
    const int gw = blockIdx.x * NW + wave, ngw = gridDim.x * NW;
    const float* mod = (const float*)(p.ws + WS_MOD);
    const float* xin = p.in[0]; float* XA = p.out;
    const bf16_t* Y = (const bf16_t*)(p.ws + WS_Y); const int* pos = (const int*)(p.ws + WS_POS); const float* tokw = (const float*)(p.ws + WS_TOKW);
    const float* lng = p.in[4] + (size_t)(do_h ? l : 0) * D;
    bf16_t* XN = (bf16_t*)(p.ws + WS_XN); bf16_t* XAB = (bf16_t*)(p.ws + WS_XAB);
#define BF4(q) make_float4(__builtin_bit_cast(float, (q).x << 16), __builtin_bit_cast(float, (q).x & 0xffff0000u), __builtin_bit_cast(float, (q).y << 16), __builtin_bit_cast(float, (q).y & 0xffff0000u))
    int curb = -1; float4 g2v[4], ga[4], s0v[4];
    for (int t0 = gw; t0 < T; t0 += ngw) {
        const int nr = 1;
        float4 v[2][4];
        if (l == 0) {
#pragma unroll
            for (int i = 0; i < 2; ++i) if (i < nr) {
#pragma unroll
                for (int j = 0; j < 4; ++j) v[i][j] = *(const float4*)(xin + (size_t)(t0 + i * ngw) * D + 4 * lane + 256 * j); }
        } else {
            int4 ps[2]; float4 tw[2]; uint2 xq[2][4];
#pragma unroll
            for (int i = 0; i < 2; ++i) if (i < nr) { const int t = t0 + i * ngw; ps[i] = *(const int4*)(pos + (size_t)t * 4); tw[i] = *(const float4*)(tokw + (size_t)t * 4);
#pragma unroll
                for (int j = 0; j < 4; ++j) xq[i][j] = *(const uint2*)(XAB + (size_t)t * D + 4 * lane + 256 * j); }
            uint2 yq[2][4][4];
#pragma unroll
            for (int i = 0; i < 2; ++i) if (i < nr) {
#pragma unroll
                for (int j = 0; j < 4; ++j) { const int col = 4 * lane + 256 * j;
                    yq[i][j][0] = *(const uint2*)(Y + (size_t)ps[i].x * D + col); yq[i][j][1] = *(const uint2*)(Y + (size_t)ps[i].y * D + col);
                    yq[i][j][2] = *(const uint2*)(Y + (size_t)ps[i].z * D + col); yq[i][j][3] = *(const uint2*)(Y + (size_t)ps[i].w * D + col); } }
#pragma unroll
            for (int i = 0; i < 2; ++i) if (i < nr) {
                const int t = t0 + i * ngw, b = t / S;
                if (b != curb) { curb = b;
                    const float* g2 = mod + ((size_t)(l - 1) * Bn + b) * 6144 + 5 * D;
#pragma unroll
                    for (int j = 0; j < 4; ++j) g2v[j] = *(const float4*)(g2 + 4 * lane + 256 * j);
                    if (do_h) { const float* sh = mod + ((size_t)l * Bn + b) * 6144 + 0 * D; const float* sc = mod + ((size_t)l * Bn + b) * 6144 + 1 * D;
#pragma unroll
                        for (int j = 0; j < 4; ++j) { const int col = 4 * lane + 256 * j; const float4 g = *(const float4*)(lng + col), s1 = *(const float4*)(sc + col); s0v[j] = *(const float4*)(sh + col);
                            ga[j] = make_float4(g.x * (1.f + s1.x), g.y * (1.f + s1.y), g.z * (1.f + s1.z), g.w * (1.f + s1.w)); } } }
#pragma unroll
                for (int j = 0; j < 4; ++j) {
                    const int col = 4 * lane + 256 * j;
                    const float4 x = BF4(xq[i][j]);
                    const float4 y0 = BF4(yq[i][j][0]), y1 = BF4(yq[i][j][1]), y2 = BF4(yq[i][j][2]), y3 = BF4(yq[i][j][3]);
                    const float4 g = g2v[j];
                    float4 r;
                    r.x = x.x + g.x * (((tw[i].x * y0.x + tw[i].y * y1.x) + tw[i].z * y2.x) + tw[i].w * y3.x); r.y = x.y + g.y * (((tw[i].x * y0.y + tw[i].y * y1.y) + tw[i].z * y2.y) + tw[i].w * y3.y);
                    r.z = x.z + g.z * (((tw[i].x * y0.z + tw[i].y * y1.z) + tw[i].z * y2.z) + tw[i].w * y3.z); r.w = x.w + g.w * (((tw[i].x * y0.w + tw[i].y * y1.w) + tw[i].z * y2.w) + tw[i].w * y3.w);
                    v[i][j] = r;
                    if (do_h) *(uint2*)(XAB + (size_t)t * D + col) = make_uint2(pk2(r.x, r.y), pk2(r.z, r.w));
                    else *(float4*)(XA + (size_t)t * D + col) = r;
                }
            }
        }
        if (do_h) {
#pragma unroll
            for (int i = 0; i < 2; ++i) if (i < nr) {
                const int t = t0 + i * ngw, b = t / S;
                if (b != curb) { curb = b;
                    const float* sh = mod + ((size_t)l * Bn + b) * 6144 + 0 * D; const float* sc = mod + ((size_t)l * Bn + b) * 6144 + 1 * D;
#pragma unroll
                    for (int j = 0; j < 4; ++j) { const int col = 4 * lane + 256 * j; const float4 g = *(const float4*)(lng + col), s1 = *(const float4*)(sc + col); s0v[j] = *(const float4*)(sh + col);
                        ga[j] = make_float4(g.x * (1.f + s1.x), g.y * (1.f + s1.y), g.z * (1.f + s1.z), g.w * (1.f + s1.w)); } }
                float ss = 0.f;
#pragma unroll
                for (int j = 0; j < 4; ++j) ss += (v[i][j].x * v[i][j].x + v[i][j].y * v[i][j].y) + (v[i][j].z * v[i][j].z + v[i][j].w * v[i][j].w);
                ss = wave_sum(ss);
                const float r = rsqrtf(ss * (1.f / D) + EPS);
#pragma unroll
                for (int j = 0; j < 4; ++j) {
                    const int col = 4 * lane + 256 * j;
                    float4 o;
                    o.x = v[i][j].x * r * ga[j].x + s0v[j].x; o.y = v[i][j].y * r * ga[j].y + s0v[j].y;
                    o.z = v[i][j].z * r * ga[j].z + s0v[j].z; o.w = v[i][j].w * r * ga[j].w + s0v[j].w;
                    *(uint2*)(XN + (size_t)t * D + col) = make_uint2(pk2(o.x, o.y), pk2(o.z, o.w));
                }
            }
        }
    }
#undef BF4
}


__device__ __forceinline__ void phase_c2(const Params& p, int l, float* lds) {
    const int lane = otid() & 63, wave = otid() >> 6;
    const float* HIDP = (const float*)(p.ws + WS_HIDP); const float* cb = (const float*)(p.ws + WS_CB) + l * 2 * 128; const float* w2 = p.in[11] + (size_t)l * 2 * 128 * 64;
    const float gk = p.in[8][l * 64 + lane];
    float* hl = lds + wave * 128;
    for (int r = blockIdx.x * NW + wave; r < 2 * 2044; r += gridDim.x * NW) {
        const int idx = r / 2044, rr = r % 2044;
#pragma unroll
        for (int q = 0; q < 2; ++q) { const int j = lane + 64 * q; float s = cb[idx * 128 + j];
#pragma unroll
            for (int kq = 0; kq < 4; ++kq) s += HIDP[((size_t)(kq * 2 + idx) * 2044 + rr) * 128 + j];
            hl[j] = gelu_tanh(s); }
        asm volatile("s_waitcnt lgkmcnt(0)" ::: "memory"); __builtin_amdgcn_wave_barrier();
        const float* W = w2 + (size_t)idx * 128 * 64;
        float s = 0.f;
#pragma unroll 8
        for (int j = 0; j < 128; ++j) s += hl[j] * W[j * 64 + lane];
        asm volatile("s_waitcnt lgkmcnt(0)" ::: "memory"); __builtin_amdgcn_wave_barrier();
        const int bgi = rr / 511, n = rr % 511;
        if (idx == 0) { const float ss = wave_sum(s * s); const float kv = s * rsqrtf(ss * (1.f / 64.f) + EPS) * gk; ((bf16_t*)(p.ws + WS_KCB))[((size_t)bgi * 512 + n) * 64 + lane] = (bf16_t)f2bf(kv); }
        else { ((bf16_t*)(p.ws + WS_VCB))[((size_t)bgi * 512 + n) * 64 + lane] = (bf16_t)f2bf(s); }
    }
    if (blockIdx.x == 0 && otid() < 2 * 4 * 64) { const int i = otid(); bf16_t* dst = (bf16_t*)(p.ws + (i < 256 ? WS_KCB : WS_VCB)); dst[((size_t)((i & 255) >> 6) * 512 + 511) * 64 + (i & 63)] = 0; }
}

__device__ __forceinline__ void load_pstart(const Params& p, int l, int* ps) {
    const int* cnt = (const int*)(p.ws + WS_CNT) + l * 32;
    if (otid() == 0) { int s = 0; for (int e = 0; e < 32; ++e) { ps[e] = s; s += (cnt[e] + 255) & ~255; } ps[32] = s; }
    __syncthreads();
}


template <int MAP>
__device__ __forceinline__ void tr_tile(const float* W, int Nsrc, bf16_t* WT, int K, int k0, int n0, float* scr, int lane) {
    const int nl = (lane & 15) * 4, kr = lane >> 4;
    int sc = n0 + nl;
    if (MAP == 1) { sc = sc < 1280 ? sc : (sc < 2816 ? sc + 24 : (sc < 2840 ? sc - 2816 + 1280 : -1)); }
    float4 v[16];
#pragma unroll
    for (int it = 0; it < 16; ++it) { if (sc >= 0) { const float* src_ = W + (size_t)(k0 + it * 4 + kr) * Nsrc + sc; typedef float f4v __attribute__((ext_vector_type(4))); const f4v t_ = __builtin_nontemporal_load((const f4v*)src_); v[it] = make_float4(t_[0], t_[1], t_[2], t_[3]); } else v[it] = make_float4(0.f, 0.f, 0.f, 0.f); }
#pragma unroll
    for (int it = 0; it < 16; ++it) { float* s = scr + (it * 4 + kr) * 65 + nl; s[0] = v[it].x; s[1] = v[it].y; s[2] = v[it].z; s[3] = v[it].w; }
    asm volatile("s_waitcnt lgkmcnt(0)" ::: "memory"); __builtin_amdgcn_wave_barrier();
    const int c = lane & 7, nr = lane >> 3;
#pragma unroll
    for (int it = 0; it < 8; ++it) {
        const int n = it * 8 + nr; const float* s = scr + (8 * c) * 65 + n;
        uint4 o; o.x = pk2(s[0], s[65]); o.y = pk2(s[2 * 65], s[3 * 65]); o.z = pk2(s[4 * 65], s[5 * 65]); o.w = pk2(s[6 * 65], s[7 * 65]);
        *(uint4*)(WT + (size_t)(n0 + n) * K + k0 + 8 * c) = o;
    }
    asm volatile("s_waitcnt lgkmcnt(0)" ::: "memory"); __builtin_amdgcn_wave_barrier();
}
__device__ __forceinline__ void phase_convert(const Params& p, float* lds) {
    const int tid = otid(), lane = tid & 63, wave = tid >> 6;
    float* scr = lds + wave * (64 * 65);
    const int gw = blockIdx.x * NW + wave, ngw = gridDim.x * NW;
    bf16_t* WinT = (bf16_t*)(p.ws + WS_WINT); bf16_t* WoT = (bf16_t*)(p.ws + WS_WOT);
    constexpr int I_IN = L * 16 * (ZBW / 64), I_O = L * 16 * 16, I_C = L * 2 * 32 * 2;
    { float* cm = lds + NW * (64 * 65);
      constexpr int S1 = L * NE * 32, S2 = L * NE * 16;
      for (int s = blockIdx.x; s < S1 + S2; s += gridDim.x) {
          const bool is1 = s < S1; const int q = is1 ? s : s - S1;
          const int le = is1 ? (q >> 5) : (q >> 4), nb = is1 ? (q & 31) : (q & 15), Nsrc = is1 ? 2048 : 1024;
          const float* W = (is1 ? p.in[17] : p.in[19]) + (size_t)le * 1024 * Nsrc;
          unsigned char* WT8 = p.ws + (is1 ? WS_W1T : WS_W2T) + (size_t)le * Nsrc * 1024;
          float* DQ = (float*)(p.ws + (is1 ? WS_DQ1 : WS_DQ2)) + (size_t)le * Nsrc;
          const int n0 = nb * 64, nl = (lane & 15) * 4, kr = lane >> 4, k0 = wave * 128;
          typedef float f4v __attribute__((ext_vector_type(4)));
          f4v va[16], vb[16];
#pragma unroll
          for (int it = 0; it < 16; ++it) { va[it] = __builtin_nontemporal_load((const f4v*)(W + (size_t)(k0 + it * 4 + kr) * Nsrc + n0 + nl));
                                            vb[it] = __builtin_nontemporal_load((const f4v*)(W + (size_t)(k0 + 64 + it * 4 + kr) * Nsrc + n0 + nl)); }
          float m[4] = {0.f, 0.f, 0.f, 0.f};
#pragma unroll
          for (int it = 0; it < 16; ++it)
#pragma unroll
              for (int j = 0; j < 4; ++j) m[j] = __builtin_fmaxf(m[j], __builtin_fmaxf(__builtin_fabsf(va[it][j]), __builtin_fabsf(vb[it][j])));
#pragma unroll
          for (int j = 0; j < 4; ++j) { m[j] = __builtin_fmaxf(m[j], __shfl_xor(m[j], 16)); m[j] = __builtin_fmaxf(m[j], __shfl_xor(m[j], 32)); }
          if (kr == 0) {
#pragma unroll
              for (int j = 0; j < 4; ++j) cm[wave * 64 + nl + j] = m[j]; }
          __syncthreads();
          float sc[4];
#pragma unroll
          for (int j = 0; j < 4; ++j) { float a = cm[nl + j];
#pragma unroll
              for (int w = 1; w < NW; ++w) a = __builtin_fmaxf(a, cm[w * 64 + nl + j]);
              sc[j] = a > 0.f ? 448.f / a : 0.f;
              if (wave == 0 && kr == 0) DQ[n0 + nl + j] = a * (1.f / 448.f); }
#pragma unroll
          for (int half = 0; half < 2; ++half) {
#pragma unroll
              for (int it = 0; it < 16; ++it) { const f4v v = half ? vb[it] : va[it]; float* d = scr + (it * 4 + kr) * 65 + nl; d[0] = v[0] * sc[0]; d[1] = v[1] * sc[1]; d[2] = v[2] * sc[2]; d[3] = v[3] * sc[3]; }
              asm volatile("s_waitcnt lgkmcnt(0)" ::: "memory"); __builtin_amdgcn_wave_barrier();
              const int c = lane & 7, nr = lane >> 3;
#pragma unroll
              for (int it = 0; it < 8; ++it) { const int n = it * 8 + nr; const float* sp = scr + (8 * c) * 65 + n;
                  uint2 o; o.x = pk_fp8x4(sp[0], sp[65], sp[2 * 65], sp[3 * 65]); o.y = pk_fp8x4(sp[4 * 65], sp[5 * 65], sp[6 * 65], sp[7 * 65]);
                  *(uint2*)(WT8 + (size_t)(n0 + n) * 1024 + k0 + half * 64 + 8 * c) = o; }
              asm volatile("s_waitcnt lgkmcnt(0)" ::: "memory"); __builtin_amdgcn_wave_barrier();
          }
          __syncthreads();
      } }
    for (int it = gw; it < I_C + I_IN + I_O; it += ngw) {
        int r = it;
        if (r < I_C) { const int li = r / 64, q = r % 64, kb = q / 2, nb = q % 2;
            tr_tile<0>(p.in[10] + (size_t)li * 2048 * 128, 128, (bf16_t*)(p.ws + WS_WCT) + (size_t)li * 128 * 2048, 2048, kb * 64, nb * 64, scr, lane); continue; }
        r -= I_C;
        if (r < I_IN) { const int l = r / (16 * 48), q = r % (16 * 48), kb = q / 48, nb = q % 48;
            tr_tile<1>(p.in[6] + (size_t)l * D * INW, INW, WinT + (size_t)l * ZBW * D, D, kb * 64, nb * 64, scr, lane); continue; }
        r -= I_IN;
        { const int l = r / 256, q = r % 256, kb = q / 16, nb = q % 16;
            tr_tile<0>(p.in[14] + (size_t)l * D * D, D, WoT + (size_t)l * D * D, D, kb * 64, nb * 64, scr, lane); }
    }
    if (blockIdx.x == 0) { bf16_t* XN = (bf16_t*)(p.ws + WS_XN); for (int i = tid; i < D / 2; i += NT) ((unsigned*)(XN + (size_t)T * D))[i] = 0u;
                           for (int i = tid; i < D / 4; i += NT) ((unsigned*)(p.ws + WS_XN8 + (size_t)T * D))[i] = 0u; }
}

namespace pg8 {
#define PG8_LAS __attribute__((address_space(3)))
typedef short bf16x8 __attribute__((ext_vector_type(8)));
typedef float f32x4 __attribute__((ext_vector_type(4)));
typedef unsigned u32x4 __attribute__((ext_vector_type(4)));
typedef long l64x2 __attribute__((ext_vector_type(2)));
constexpr int BM = 256, BK = 64, HALF = 128, HTB = HALF * BK * 2, STAGE_BYTES = 8 * HTB, NXCD = 8, WGM = 8;
__device__ __forceinline__ int lds_byte(int r, int c) { const int st = (r >> 4) * 2 + (c >> 5), rr = r & 15, cc = c & 31, ob = rr * 64 + cc * 2; return st * 1024 + (ob ^ (((ob >> 9) & 1) << 5)); }
__device__ __forceinline__ void stage_rc(int b, int& R, int& C) { const int st = b / 1024, sb = b % 1024, swz = sb ^ (((sb >> 9) & 1) << 5); R = (st >> 1) * 16 + swz / 64; C = (st & 1) * 32 + (swz % 64) / 2; }
__device__ __forceinline__ int perm32(int rho) { const int n = rho >> 4, i = rho & 15; return 8 * (i >> 2) + 4 * n + (i & 3); }
struct Unit { int pm, pn, e; };
__device__ __forceinline__ unsigned cvt_pk_bf16(float lo, float hi) { unsigned r; asm volatile("v_cvt_pk_bf16_f32 %0, %1, %2" : "=v"(r) : "v"(lo), "v"(hi)); return r; }

__device__ __forceinline__ bool static_next(int nM, int nN, int G, int c, int i, Unit& u) {
    const int nwg = nM * nN; const long Lq = (long)i * G + c; if (Lq >= nwg) return false;
    int wgid = (int)Lq; { const int q = nwg / NXCD, r = nwg % NXCD, xcd = wgid % NXCD, off = wgid / NXCD; wgid = (xcd < r ? xcd * (q + 1) : r * (q + 1) + (xcd - r) * q) + off; }
    const int nig = WGM * nN, gid = wgid / nig, fm = gid * WGM, gsz = (nM - fm) < WGM ? (nM - fm) : WGM;
    u.pm = fm + ((wgid % nig) % gsz); u.pn = (wgid % nig) / gsz; u.e = 0; return true;
}

template <class Prob, class Epi, bool ALIGN_EPI, bool SP2>
__device__ __forceinline__ void gemm_phase(PG8_LAS unsigned char* lds, const Prob& P, const Epi& E) {
    const int tid = otid(), wid = __builtin_amdgcn_readfirstlane(tid >> 6), lane = tid & 63, wr = wid >> 2, wc = wid & 3, fr = lane & 15, fq = lane >> 4;
    const int K = P.K, nt = Prob::KT > 0 ? Prob::KT : K / BK;
    int sR[2], sC[2]; unsigned voffB[2];
#pragma unroll
    for (int i = 0; i < 2; ++i) { stage_rc(tid * 16 + i * 8192, sR[i], sC[i]); voffB[i] = (unsigned)(P.b_row(sR[i]) * K + sC[i]) * 2u; }
    const size_t kstep = (size_t)(BK * 2);
    const size_t kstepA = P.a_kstep();
    const size_t hstepB = P.b_hstep();
    const unsigned ldsw = (unsigned)wid * 1024u;
    const int aoff = lds_byte(wr * 64 + fr, fq * 8), boff = lds_byte(wc * 32 + fr, fq * 8);
#define PG8_SA(b, h) (((b) * 2 + (h)) * HTB)
#define PG8_SB(b, h) ((4 + (b) * 2 + (h)) * HTB)
#define PG8_STAGE(bufoff, gbase, voff) do { _Pragma("unroll") for (int _i = 0; _i < 2; ++_i) \
        __builtin_amdgcn_global_load_lds((const unsigned*)((const char*)(gbase) + (voff)[_i]), (PG8_LAS unsigned*)(lds + (bufoff) + ldsw + _i * 8192), 16, 0, 0); } while (0)
#define PG8_STAGE_SEL(bufoff, gbase, h) do { _Pragma("unroll") for (int _i = 0; _i < 2; ++_i) { unsigned _vo = vAc[h][_i]; if constexpr (Prob::GATHER) _vo = last ? vAn[h][_i] : _vo; \
        __builtin_amdgcn_global_load_lds((const unsigned*)((const char*)(gbase) + _vo), (PG8_LAS unsigned*)(lds + (bufoff) + ldsw + _i * 8192), 16, 0, 0); } } while (0)
#define PG8_LDA(dst, b, h) do { _Pragma("unroll") for (int m = 0; m < 4; ++m) _Pragma("unroll") for (int k = 0; k < 2; ++k) dst[m][k] = *(const PG8_LAS bf16x8*)(lds + PG8_SA(b, h) + aoff + m * 2048 + k * 1024); } while (0)
#define PG8_LDB(dst, b, h) do { _Pragma("unroll") for (int n = 0; n < 2; ++n) _Pragma("unroll") for (int k = 0; k < 2; ++k) dst[n][k] = *(const PG8_LAS bf16x8*)(lds + PG8_SB(b, h) + boff + n * 2048 + k * 1024); } while (0)
#define PG8_MMA(ai, bj, At, Bt) do { __builtin_amdgcn_s_setprio(1); _Pragma("unroll") for (int m = 0; m < 4; ++m) _Pragma("unroll") for (int n = 0; n < 2; ++n) _Pragma("unroll") for (int k = 0; k < 2; ++k) { \
        if constexpr (Prob::F8) { const l64x2 b_ = __builtin_bit_cast(l64x2, Bt[n][k]), a_ = __builtin_bit_cast(l64x2, At[m][k]); \
            acc[ai][bj][m][n] = __builtin_amdgcn_mfma_f32_16x16x32_fp8_fp8(b_[0], a_[0], acc[ai][bj][m][n], 0, 0, 0); \
            acc[ai][bj][m][n] = __builtin_amdgcn_mfma_f32_16x16x32_fp8_fp8(b_[1], a_[1], acc[ai][bj][m][n], 0, 0, 0); } \
        else acc[ai][bj][m][n] = __builtin_amdgcn_mfma_f32_16x16x32_bf16(Bt[n][k], At[m][k], acc[ai][bj][m][n], 0, 0, 0); } __builtin_amdgcn_s_setprio(0); } while (0)
#define PG8_WAIT_V(n) asm volatile("s_waitcnt vmcnt(" #n ")" ::: "memory")
#define PG8_WAIT_L(n) asm volatile("s_waitcnt lgkmcnt(" #n ")" ::: "memory")
#define PG8_BAR __builtin_amdgcn_s_barrier()
#define PG8_SCHED __builtin_amdgcn_sched_barrier(0)
    Unit cur, nxt; int ui = 0;
    if (!P.next(0, cur)) return;
    nxt = cur;
    f32x4 acc[2][2][4][2];
    typename Epi::Pre pre;
    E.prefetch(cur, wc, fq, pre); E.init(acc, pre);
    bf16x8 At[4][2], B0[2][2], B1[2][2];
    unsigned vAc[2][2], vAn[2][2];
    const char* cA = P.a_base(cur); const char* cB = P.b_base(cur);
    P.a_voff(cur, sR, sC, vAc);
#pragma unroll
    for (int h = 0; h < 2; ++h)
#pragma unroll
        for (int i = 0; i < 2; ++i) vAn[h][i] = vAc[h][i];
    if constexpr (SP2) {
        PG8_STAGE(PG8_SB(0, 0), cB, voffB); PG8_STAGE(PG8_SB(0, 1), cB + hstepB, voffB); PG8_STAGE(PG8_SA(0, 0), cA, vAc[0]); PG8_STAGE(PG8_SA(0, 1), cA, vAc[1]);
        if (wr == 1) PG8_BAR;
        PG8_WAIT_V(2); PG8_BAR;
        PG8_STAGE(PG8_SB(1, 0), cB + kstep, voffB); PG8_STAGE(PG8_SA(1, 0), cA + kstepA, vAc[0]); PG8_STAGE(PG8_SB(1, 1), cB + hstepB + kstep, voffB);
        PG8_WAIT_V(6); PG8_BAR;
    } else {
        PG8_STAGE(PG8_SB(0, 0), cB, voffB); PG8_STAGE(PG8_SA(0, 0), cA, vAc[0]); PG8_STAGE(PG8_SB(0, 1), cB + hstepB, voffB); PG8_STAGE(PG8_SA(0, 1), cA, vAc[1]);
        if (wr == 1) PG8_BAR;
        PG8_WAIT_V(4); PG8_BAR;
        PG8_STAGE(PG8_SB(1, 0), cB + kstep, voffB); PG8_STAGE(PG8_SA(1, 0), cA + kstepA, vAc[0]); PG8_STAGE(PG8_SB(1, 1), cB + hstepB + kstep, voffB);
        PG8_WAIT_V(6); PG8_BAR;
    }
    for (;;) {
        const bool has_next = P.next(ui + 1, nxt);
        const char* nA = cA; const char* nB = cB;
        if (has_next) { nA = P.a_base(nxt); nB = P.b_base(nxt); if constexpr (Prob::GATHER) P.a_voff(nxt, sR, sC, vAn); }
        for (int t = 0; t < nt; t += 2) {
            const bool last = (t == nt - 2);
            const char* a1 = cA + (size_t)(t + 1) * kstepA;
            const char* a2 = last ? nA : cA + (size_t)(t + 2) * kstepA; const char* b2 = last ? nB : cB + (size_t)(t + 2) * kstep;
            const char* a3 = a2 + kstepA; const char* b3 = b2 + kstep;
            if constexpr (SP2) {
            PG8_LDB(B0, 0, 0); PG8_LDB(B1, 0, 1); PG8_SCHED; PG8_LDA(At, 0, 0); PG8_STAGE(PG8_SA(1, 1), a1, vAc[1]);
            PG8_WAIT_V(8); PG8_WAIT_L(0); PG8_BAR; PG8_MMA(0, 0, At, B0); PG8_MMA(0, 1, At, B1); PG8_BAR; PG8_SCHED;
            PG8_LDA(At, 0, 1); PG8_STAGE(PG8_SB(0, 0), b2, voffB); PG8_STAGE(PG8_SB(0, 1), b2 + hstepB, voffB); PG8_STAGE_SEL(PG8_SA(0, 0), a2, 0);
            PG8_WAIT_V(8); PG8_WAIT_L(0); PG8_BAR; PG8_MMA(1, 0, At, B0); PG8_MMA(1, 1, At, B1); PG8_BAR; PG8_SCHED;
            PG8_LDB(B0, 1, 0); PG8_LDB(B1, 1, 1); PG8_SCHED; PG8_LDA(At, 1, 0); PG8_STAGE_SEL(PG8_SA(0, 1), a2, 1);
            PG8_WAIT_V(8); PG8_WAIT_L(0); PG8_BAR; PG8_MMA(0, 0, At, B0); PG8_MMA(0, 1, At, B1); PG8_BAR; PG8_SCHED;
            PG8_LDA(At, 1, 1); PG8_STAGE(PG8_SB(1, 0), b3, voffB); PG8_STAGE(PG8_SB(1, 1), b3 + hstepB, voffB); PG8_STAGE_SEL(PG8_SA(1, 0), a3, 0);
            PG8_WAIT_V(8); PG8_WAIT_L(0); PG8_BAR; PG8_MMA(1, 0, At, B0); PG8_MMA(1, 1, At, B1); PG8_BAR; PG8_SCHED;
            } else {
            PG8_LDB(B0, 0, 0); PG8_SCHED; PG8_LDA(At, 0, 0); PG8_STAGE(PG8_SA(1, 1), a1, vAc[1]);
            PG8_WAIT_L(8); PG8_BAR; PG8_WAIT_L(0); PG8_MMA(0, 0, At, B0); PG8_BAR; PG8_SCHED;
            PG8_LDB(B1, 0, 1); PG8_STAGE(PG8_SB(0, 0), b2, voffB);
            PG8_BAR; PG8_WAIT_L(0); PG8_MMA(0, 1, At, B1); PG8_BAR;
            PG8_LDA(At, 0, 1); PG8_STAGE_SEL(PG8_SA(0, 0), a2, 0);
            PG8_BAR; PG8_WAIT_L(0); PG8_MMA(1, 0, At, B0); PG8_BAR; PG8_SCHED;
            PG8_STAGE(PG8_SB(0, 1), b2 + hstepB, voffB);
            PG8_WAIT_V(6); PG8_BAR; PG8_MMA(1, 1, At, B1); PG8_BAR;
            PG8_LDB(B0, 1, 0); PG8_SCHED; PG8_LDA(At, 1, 0); PG8_STAGE_SEL(PG8_SA(0, 1), a2, 1);
            PG8_WAIT_L(8); PG8_BAR; PG8_WAIT_L(0); PG8_MMA(0, 0, At, B0); PG8_BAR; PG8_SCHED;
            PG8_LDB(B1, 1, 1); PG8_STAGE(PG8_SB(1, 0), b3, voffB);
            PG8_BAR; PG8_WAIT_L(0); PG8_MMA(0, 1, At, B1); PG8_BAR;
            PG8_LDA(At, 1, 1); PG8_STAGE_SEL(PG8_SA(1, 0), a3, 0);
            PG8_BAR; PG8_WAIT_L(0); PG8_MMA(1, 0, At, B0); PG8_BAR; PG8_SCHED;
            PG8_STAGE(PG8_SB(1, 1), b3 + hstepB, voffB);
            PG8_WAIT_V(6); PG8_BAR; PG8_MMA(1, 1, At, B1); PG8_BAR;
            }
        }
        if constexpr (ALIGN_EPI) { if (wr == 0) PG8_BAR; }
        E(acc, cur, wr, wc, fr, fq, has_next, nxt, pre);
        if (!has_next) break;
        E.init(acc, pre);
        cur = nxt; cA = nA; cB = nB; ++ui;
        if constexpr (Prob::GATHER) {
#pragma unroll
            for (int h = 0; h < 2; ++h)
#pragma unroll
                for (int i = 0; i < 2; ++i) vAc[h][i] = vAn[h][i];
        }
        if constexpr (ALIGN_EPI) { if (wr == 1) PG8_BAR; }
    }
    PG8_WAIT_V(0);
    if constexpr (!ALIGN_EPI) { if (wr == 0) PG8_BAR; }
    PG8_BAR;
#undef PG8_SA
#undef PG8_SB
#undef PG8_STAGE
#undef PG8_STAGE_SEL
#undef PG8_LDA
#undef PG8_LDB
#undef PG8_MMA
#undef PG8_WAIT_V
#undef PG8_WAIT_L
#undef PG8_BAR
#undef PG8_SCHED
}

struct ProbDense { static constexpr bool F8 = false; static constexpr bool GATHER = false; static constexpr int KT = 0;
    const bf16_t* A; const bf16_t* Bt; int K, nM, nN, G, c; bool headperm;
    __device__ __forceinline__ bool next(int i, Unit& u) const { return static_next(nM, nN, G, c, i, u); }
    __device__ __forceinline__ const char* a_base(const Unit& u) const { return (const char*)(A + (size_t)u.pm * BM * K); }
    __device__ __forceinline__ void a_voff(const Unit&, const int (&R)[2], const int (&C)[2], unsigned (&v)[2][2]) const {
#pragma unroll
        for (int h = 0; h < 2; ++h)
#pragma unroll
            for (int i = 0; i < 2; ++i) v[h][i] = (unsigned)((h * HALF + R[i]) * K + C[i]) * 2u;
    }
    __device__ __forceinline__ const char* b_base(const Unit& u) const { return (const char*)(Bt + (size_t)u.pn * BM * K); }
    __device__ __forceinline__ size_t a_kstep() const { return (size_t)BK * 2; }
    __device__ __forceinline__ size_t b_hstep() const { return headperm ? (size_t)32 * K * 2 : (size_t)HALF * K * 2; }
    __device__ __forceinline__ int b_row(int R) const { return headperm ? ((R >> 5) * 64 + perm32(R & 31)) : ((R & ~31) + perm32(R & 31)); }
};
typedef const PG8_LAS int* lds_ints;
__device__ __forceinline__ int expert_of(lds_ints ps, int pm) { int e = 0;
#pragma unroll
    for (int i = 1; i < 32; ++i) if (ps[i] <= pm * 256) e = i;
    return __builtin_amdgcn_readfirstlane(e); }
struct ProbMoe1 { static constexpr bool F8 = true; static constexpr bool GATHER = true; static constexpr int KT = 0;
    const bf16_t* XN; const bf16_t* W1T; const int* rowtok; lds_ints ps; int K, ntm, G, c;
    __device__ __forceinline__ bool next(int i, Unit& u) const {
        if (G != 256) { const int q = i * G + c; if (q >= ntm * 8) return false; u.pm = q >> 3; u.pn = q & 7; u.e = expert_of(ps, u.pm); return true; }
        const int x = c & 7, s = c >> 3; const int pm = 4 * (i * 8 + x) + (s >> 3); if (pm >= ntm) return false;
        u.pm = pm; u.pn = s & 7; u.e = expert_of(ps, u.pm); return true; }
    __device__ __forceinline__ const char* a_base(const Unit&) const { return (const char*)XN; }
    __device__ __forceinline__ void a_voff(const Unit& u, const int (&R)[2], const int (&C)[2], unsigned (&v)[2][2]) const {
#pragma unroll
        for (int h = 0; h < 2; ++h)
#pragma unroll
            for (int i = 0; i < 2; ++i) { int tk = rowtok[u.pm * BM + h * HALF + R[i]]; if (tk < 0) tk = T; v[h][i] = (unsigned)(tk * K + C[i]) * 2u; }
    }
    __device__ __forceinline__ const char* b_base(const Unit& u) const { return (const char*)(W1T + ((size_t)u.e * 2048 + u.pn * 128) * K); }
    __device__ __forceinline__ size_t a_kstep() const { return (size_t)BK * 2; }
    __device__ __forceinline__ size_t b_hstep() const { return (size_t)1024 * K * 2; }
    __device__ __forceinline__ int b_row(int R) const { return (R & ~31) + perm32(R & 31); }
};
struct ProbMoe2 { static constexpr bool F8 = true; static constexpr bool GATHER = false; static constexpr int KT = 0;
    const bf16_t* ACT; const bf16_t* W2T; lds_ints ps; int K, ntm, G, c;
    __device__ __forceinline__ bool next(int i, Unit& u) const {
        if (G != 256) { const int q = i * G + c; if (q >= ntm * 4) return false; u.pm = q >> 2; u.pn = q & 3; u.e = expert_of(ps, u.pm); return true; }
        const int x = c & 7, s = c >> 3; const int pm = 8 * (i * 8 + x) + (s >> 2); if (pm >= ntm) return false;
        u.pm = pm; u.pn = s & 3; u.e = expert_of(ps, u.pm); return true; }
    __device__ __forceinline__ const char* a_base(const Unit& u) const { return (const char*)(ACT + (size_t)u.pm * BM * K); }
    __device__ __forceinline__ void a_voff(const Unit&, const int (&R)[2], const int (&C)[2], unsigned (&v)[2][2]) const {
#pragma unroll
        for (int h = 0; h < 2; ++h)
#pragma unroll
            for (int i = 0; i < 2; ++i) v[h][i] = (unsigned)((h * HALF + R[i]) * K + C[i]) * 2u;
    }
    __device__ __forceinline__ const char* b_base(const Unit& u) const { return (const char*)(W2T + ((size_t)u.e * 1024 + u.pn * BM) * K); }
    __device__ __forceinline__ size_t a_kstep() const { return (size_t)BK * 2; }
    __device__ __forceinline__ size_t b_hstep() const { return (size_t)HALF * K * 2; }
    __device__ __forceinline__ int b_row(int R) const { return (R & ~31) + perm32(R & 31); }
};

struct ProbCmp { static constexpr bool F8 = false; static constexpr bool GATHER = false; static constexpr int KT = 8;
    const bf16_t* ZB; const bf16_t* W1T; int K, G, c;
    __device__ __forceinline__ bool next(int i, Unit& u) const { const int q = i * G + c; if (q >= 64) return false; u.pm = q & 15; u.pn = 0; u.e = q >> 4; return true; }
    __device__ __forceinline__ const char* a_base(const Unit& u) const { const int idx = u.pm >> 3, bg = (u.pm >> 1) & 3, half = u.pm & 1;
        return (const char*)(ZB + ((size_t)(bg >> 1) * S + 16 * 256 * half + 8 * u.e) * ZBW + ZB_KC + idx * 128 + (bg & 1) * 64); }
    __device__ __forceinline__ void a_voff(const Unit&, const int (&R)[2], const int (&C)[2], unsigned (&v)[2][2]) const {
#pragma unroll
        for (int h = 0; h < 2; ++h)
#pragma unroll
            for (int i = 0; i < 2; ++i) v[h][i] = (unsigned)(16 * (h * HALF + R[i]) * ZBW + C[i]) * 2u;
    }
    __device__ __forceinline__ size_t a_kstep() const { return (size_t)ZBW * 2; }
    __device__ __forceinline__ const char* b_base(const Unit& u) const { return (const char*)(W1T + (size_t)(u.pm >> 3) * 128 * K + 8 * 64 * u.e); }
    __device__ __forceinline__ size_t b_hstep() const { return 0; }
    __device__ __forceinline__ int b_row(int R) const { return (R & ~31) + perm32(R & 31); }
};
struct EpiCmp {
    float* HIDP;
    struct Pre {};
    __device__ __forceinline__ void prefetch(const Unit&, int, int, Pre&) const {}
    __device__ __forceinline__ void init(f32x4 (&acc)[2][2][4][2], const Pre&) const {
#pragma unroll
        for (int a = 0; a < 2; ++a)
#pragma unroll
            for (int b = 0; b < 2; ++b)
#pragma unroll
                for (int m = 0; m < 4; ++m)
#pragma unroll
                    for (int n = 0; n < 2; ++n) acc[a][b][m][n] = (f32x4){0.f, 0.f, 0.f, 0.f};
    }
    __device__ __forceinline__ void operator()(const f32x4 (&acc)[2][2][4][2], const Unit& u, int wr, int wc, int fr, int fq, bool has_next, const Unit& nxt, Pre& pre) const {
        const int idx = u.pm >> 3, bg = (u.pm >> 1) & 3, half = u.pm & 1;
        const int c0 = 32 * wc + 8 * fq;
#pragma unroll
        for (int ai = 0; ai < 2; ++ai)
#pragma unroll
            for (int m = 0; m < 4; ++m) { const int n = 256 * half + ai * HALF + wr * 64 + m * 16 + fr;
                if (n < 511) { float* dst = HIDP + (((size_t)u.e * 2 + idx) * 2044 + bg * 511 + n) * 128 + c0;
                    *(f32x4*)dst = acc[ai][0][m][0]; *(f32x4*)(dst + 4) = acc[ai][0][m][1]; } }
    }
};
struct EpiG1F {
    bf16_t* ZB; float* GATE; const float* gq; const float* gk; const float* gmq; const float* gmk;
    struct Pre {};
    __device__ __forceinline__ void prefetch(const Unit&, int, int, Pre&) const {}
    __device__ __forceinline__ void init(f32x4 (&acc)[2][2][4][2], const Pre&) const {
#pragma unroll
        for (int a = 0; a < 2; ++a)
#pragma unroll
            for (int b = 0; b < 2; ++b)
#pragma unroll
                for (int m = 0; m < 4; ++m)
#pragma unroll
                    for (int n = 0; n < 2; ++n) acc[a][b][m][n] = (f32x4){0.f, 0.f, 0.f, 0.f};
    }
    __device__ __forceinline__ void operator()(const f32x4 (&acc)[2][2][4][2], const Unit& u, int wr, int wc, int fr, int fq, bool has_next, const Unit& nxt, Pre& pre) const {
        const int pn = u.pn;
        const float* gain = nullptr; float sc = 1.f;
        if (pn < 2) { gain = gq; sc = QSCALE; }
        else if (pn == 3 || pn == 4) { if (wc < 2) gain = gk; }
        else if (pn == 5 || pn == 6) { gain = gmq; sc = QSCALE; }
        else if (pn == 7 || pn == 8) { gain = gmk; }
        if (pn == 11) {
            if (wc == 0 && fq < 3) {
#pragma unroll
                for (int ai = 0; ai < 2; ++ai)
#pragma unroll
                    for (int m = 0; m < 4; ++m) { const size_t r = (size_t)u.pm * BM + ai * HALF + wr * 64 + m * 16 + fr;
#pragma unroll
                        for (int n = 0; n < 2; ++n) { const f32x4 v = acc[ai][0][m][n]; f32x4 o;
#pragma unroll
                            for (int i = 0; i < 4; ++i) o[i] = __builtin_amdgcn_rcpf(1.f + __builtin_amdgcn_exp2f(-LOG2E * v[i]));
                            *(f32x4*)(GATE + r * 32 + 8 * fq + 4 * n) = o; } }
            }
            return;
        }
        f32x4 gv[2][2];
#pragma unroll
        for (int bj = 0; bj < 2; ++bj)
#pragma unroll
            for (int n = 0; n < 2; ++n) gv[bj][n] = gain ? *(const f32x4*)(gain + 32 * bj + 8 * fq + 4 * n) * sc : (f32x4){1.f, 1.f, 1.f, 1.f};
#pragma unroll
        for (int ai = 0; ai < 2; ++ai)
#pragma unroll
            for (int m = 0; m < 4; ++m) { const size_t r = (size_t)u.pm * BM + ai * HALF + wr * 64 + m * 16 + fr;
                float rs = 1.f;
                if (gain) { float ss = 0.f;
#pragma unroll
                    for (int bj = 0; bj < 2; ++bj)
#pragma unroll
                        for (int n = 0; n < 2; ++n) { const f32x4 v = acc[ai][bj][m][n]; ss += (v[0] * v[0] + v[1] * v[1]) + (v[2] * v[2] + v[3] * v[3]); }
                    ss += __shfl_xor(ss, 16); ss += __shfl_xor(ss, 32);
                    rs = rsqrtf(ss * (1.f / 64.f) + EPS); }
#pragma unroll
                for (int bj = 0; bj < 2; ++bj) { const f32x4 a = acc[ai][bj][m][0] * gv[bj][0] * rs, b = acc[ai][bj][m][1] * gv[bj][1] * rs;
                    u32x4 w; w.x = cvt_pk_bf16(a[0], a[1]); w.y = cvt_pk_bf16(a[2], a[3]); w.z = cvt_pk_bf16(b[0], b[1]); w.w = cvt_pk_bf16(b[2], b[3]);
                    *(u32x4*)(ZB + r * ZBW + pn * BM + 64 * wc + 32 * bj + 8 * fq) = w; } }
    }
};
struct EpiG2 {
    const float* xin32; bf16_t* XAB; const float* g1;
    struct Pre {};
    __device__ __forceinline__ void prefetch(const Unit&, int, int, Pre&) const {}
    __device__ __forceinline__ void init(f32x4 (&acc)[2][2][4][2], const Pre&) const {
#pragma unroll
        for (int a = 0; a < 2; ++a)
#pragma unroll
            for (int b = 0; b < 2; ++b)
#pragma unroll
                for (int m = 0; m < 4; ++m)
#pragma unroll
                    for (int n = 0; n < 2; ++n) acc[a][b][m][n] = (f32x4){0.f, 0.f, 0.f, 0.f};
    }
    __device__ __forceinline__ void operator()(const f32x4 (&acc)[2][2][4][2], const Unit& u, int wr, int wc, int fr, int fq, bool has_next, const Unit& nxt, Pre& pre) const {
#pragma unroll
        for (int ai = 0; ai < 2; ++ai)
#pragma unroll
            for (int m = 0; m < 4; ++m) { const size_t r = (size_t)u.pm * BM + ai * HALF + wr * 64 + m * 16 + fr; const int b = (int)(r / S);
#pragma unroll
                for (int bj = 0; bj < 2; ++bj) { const int c = u.pn * BM + 128 * bj + 32 * wc + 8 * fq;
                    f32x4 x0, x1;
                    if (xin32) { x0 = *(const f32x4*)(xin32 + r * D + c); x1 = *(const f32x4*)(xin32 + r * D + c + 4); }
                    else { const u32x4 q = *(const u32x4*)(XAB + r * D + c);
                        x0 = (f32x4){__builtin_bit_cast(float, q.x << 16), __builtin_bit_cast(float, q.x & 0xffff0000u), __builtin_bit_cast(float, q.y << 16), __builtin_bit_cast(float, q.y & 0xffff0000u)};
                        x1 = (f32x4){__builtin_bit_cast(float, q.z << 16), __builtin_bit_cast(float, q.z & 0xffff0000u), __builtin_bit_cast(float, q.w << 16), __builtin_bit_cast(float, q.w & 0xffff0000u)}; }
                    const f32x4 g0 = *(const f32x4*)(g1 + (size_t)b * 6144 + c), g1v = *(const f32x4*)(g1 + (size_t)b * 6144 + c + 4);
                    const f32x4 y0 = x0 + g0 * acc[ai][bj][m][0], y1 = x1 + g1v * acc[ai][bj][m][1];
                    u32x4 o; o.x = cvt_pk_bf16(y0[0], y0[1]); o.y = cvt_pk_bf16(y0[2], y0[3]); o.z = cvt_pk_bf16(y1[0], y1[1]); o.w = cvt_pk_bf16(y1[2], y1[3]);
                    *(u32x4*)(XAB + r * D + c) = o; } }
    }
};
struct EpiM1 {
    unsigned char* ACT8; const float* b1l; const float* dq1l;
    struct Pre {};
    __device__ __forceinline__ void prefetch(const Unit&, int, int, Pre&) const {}
    __device__ __forceinline__ void init(f32x4 (&acc)[2][2][4][2], const Pre&) const {
#pragma unroll
        for (int a = 0; a < 2; ++a)
#pragma unroll
            for (int b = 0; b < 2; ++b)
#pragma unroll
                for (int m = 0; m < 4; ++m)
#pragma unroll
                    for (int n = 0; n < 2; ++n) acc[a][b][m][n] = (f32x4){0.f, 0.f, 0.f, 0.f};
    }
    __device__ __forceinline__ void operator()(const f32x4 (&acc)[2][2][4][2], const Unit& u, int wr, int wc, int fr, int fq, bool has_next, const Unit& nxt, Pre& pre) const {
        const int c0 = u.pn * 128 + 32 * wc + 8 * fq;
        const float* b1 = b1l + (size_t)u.e * 2048 + c0; const float* dq = dq1l + (size_t)u.e * 2048 + c0;
        unsigned w[2][4][2];
#pragma unroll
        for (int n = 0; n < 2; ++n) {
            __builtin_amdgcn_sched_barrier(0);
            const f32x4 bg = *(const f32x4*)(b1 + 4 * n), bl = *(const f32x4*)(b1 + 1024 + 4 * n);
            const f32x4 sg = *(const f32x4*)(dq + 4 * n) * (1.f / XS8), sl = *(const f32x4*)(dq + 1024 + 4 * n) * (1.f / XS8);
#pragma unroll
            for (int ai = 0; ai < 2; ++ai)
#pragma unroll
                for (int m = 0; m < 4; ++m) { const f32x4 g = acc[ai][0][m][n] * sg + bg, li = acc[ai][1][m][n] * sl + bl; float o[4];
#pragma unroll
                    for (int i = 0; i < 4; ++i) { const float gc = fminf(g[i], 7.f), lc = __builtin_amdgcn_fmed3f(li[i], -7.f, 7.f);
                        o[i] = (AS8 * (lc + 1.f)) * (gc * __builtin_amdgcn_rcpf(1.f + __builtin_amdgcn_exp2f((-1.702f * LOG2E) * gc))); }
                    w[ai][m][n] = pk_fp8x4(o[0], o[1], o[2], o[3]); }
        }
#pragma unroll
        for (int ai = 0; ai < 2; ++ai)
#pragma unroll
            for (int m = 0; m < 4; ++m) { const size_t r = (size_t)u.pm * BM + ai * HALF + wr * 64 + m * 16 + fr;
                *(uint2*)(ACT8 + r * DFF + c0) = make_uint2(w[ai][m][0], w[ai][m][1]); }
    }
};
struct EpiM2 {
    bf16_t* Y; const float* b2l; const float* dq2l;
    struct Pre {};
    __device__ __forceinline__ void prefetch(const Unit&, int, int, Pre&) const {}
    __device__ __forceinline__ void init(f32x4 (&acc)[2][2][4][2], const Pre&) const {
#pragma unroll
        for (int a = 0; a < 2; ++a)
#pragma unroll
            for (int b = 0; b < 2; ++b)
#pragma unroll
                for (int m = 0; m < 4; ++m)
#pragma unroll
                    for (int n = 0; n < 2; ++n) acc[a][b][m][n] = (f32x4){0.f, 0.f, 0.f, 0.f};
    }
    __device__ __forceinline__ void operator()(const f32x4 (&acc)[2][2][4][2], const Unit& u, int wr, int wc, int fr, int fq, bool has_next, const Unit& nxt, Pre& pre) const {
        const int cb = u.pn * BM + 32 * wc + 8 * fq;
        const float* b2 = b2l + (size_t)u.e * D + cb; const float* dq = dq2l + (size_t)u.e * D + cb;
#pragma unroll
        for (int bj = 0; bj < 2; ++bj) { const int c = cb + 128 * bj;
            const f32x4 b0 = *(const f32x4*)(b2 + 128 * bj), b1_ = *(const f32x4*)(b2 + 128 * bj + 4);
            const f32x4 s0 = *(const f32x4*)(dq + 128 * bj) * (1.f / AS8), s1 = *(const f32x4*)(dq + 128 * bj + 4) * (1.f / AS8);
#pragma unroll
            for (int ai = 0; ai < 2; ++ai)
#pragma unroll
                for (int m = 0; m < 4; ++m) { const size_t r = (size_t)u.pm * BM + ai * HALF + wr * 64 + m * 16 + fr;
                    const f32x4 v0 = acc[ai][bj][m][0] * s0 + b0, v1 = acc[ai][bj][m][1] * s1 + b1_;
                    u32x4 o; o.x = cvt_pk_bf16(v0[0], v0[1]); o.y = cvt_pk_bf16(v0[2], v0[3]); o.z = cvt_pk_bf16(v1[0], v1[1]); o.w = cvt_pk_bf16(v1[2], v1[3]);
                    *(u32x4*)(Y + r * D + c) = o; }
        }
    }
};
}

__device__ __forceinline__ void phase_g1_fast(const Params& p, int l, unsigned char* lds_raw) {
    pg8::ProbDense P{(const bf16_t*)(p.ws + WS_XN), (const bf16_t*)(p.ws + WS_WINT) + (size_t)l * ZBW * D, D, T / 256, ZBW / 256, (int)gridDim.x, (int)blockIdx.x, true};
    pg8::EpiG1F E{(bf16_t*)(p.ws + WS_ZB), (float*)(p.ws + WS_GATE), p.in[7] + l * 64, p.in[8] + l * 64, p.in[12] + l * 64, p.in[13] + l * 64};
    pg8::gemm_phase<pg8::ProbDense, pg8::EpiG1F, true, true>((PG8_LAS unsigned char*)lds_raw, P, E);
}
__device__ __forceinline__ void phase_g2_fast(const Params& p, int l, unsigned char* lds_raw) {
    pg8::ProbDense P{(const bf16_t*)(p.ws + WS_ATTB), (const bf16_t*)(p.ws + WS_WOT) + (size_t)l * D * D, D, T / 256, D / 256, (int)gridDim.x, (int)blockIdx.x, false};
    pg8::EpiG2 E{l == 0 ? p.in[0] : (const float*)nullptr, (bf16_t*)(p.ws + WS_XAB), (const float*)(p.ws + WS_MOD) + (size_t)l * Bn * 6144 + 2 * D};
    pg8::gemm_phase<pg8::ProbDense, pg8::EpiG2, true, true>((PG8_LAS unsigned char*)lds_raw, P, E);
}
constexpr int LDS_PS_OFF = 131072;
__device__ __forceinline__ void phase_ck_fast(const Params& p, int l, unsigned char* lds_raw) {
    pg8::ProbCmp P{(const bf16_t*)(p.ws + WS_ZB), (const bf16_t*)(p.ws + WS_WCT) + (size_t)l * 2 * 128 * 2048, 2048, (int)gridDim.x, (int)blockIdx.x};
    pg8::EpiCmp E{(float*)(p.ws + WS_HIDP)};
    pg8::gemm_phase<pg8::ProbCmp, pg8::EpiCmp, true, true>((PG8_LAS unsigned char*)lds_raw, P, E);
    { const int tid = otid(), lane = tid & 63, wave = tid >> 6, r8 = lane >> 3, c8 = lane & 7;
      const bf16_t* Z = (const bf16_t*)(p.ws + WS_ZB); bf16_t* KMB = (bf16_t*)(p.ws + WS_KMB);
      float* part = (float*)(lds_raw + 131072 + 512);
      for (int it0 = blockIdx.x * 2; it0 < Bn * 8 * 32; it0 += gridDim.x * 2) {
          const int it = it0 + (wave >> 2), q = wave & 3;
          const int b = it / 256, h = (it / 32) & 7, blk = it & 31;
          const bf16_t* base = Z + (size_t)(b * S + blk * 256 + q * 64 + r8) * ZBW + ZB_MK + h * 64 + c8 * 8;
          float s[8] = {0.f, 0.f, 0.f, 0.f, 0.f, 0.f, 0.f, 0.f};
          uint4 v[8];
#pragma unroll
          for (int i = 0; i < 8; ++i) v[i] = *(const uint4*)(base + (size_t)(8 * i) * ZBW);
#pragma unroll
          for (int i = 0; i < 8; ++i) { const unsigned w[4] = {v[i].x, v[i].y, v[i].z, v[i].w};
#pragma unroll
              for (int e = 0; e < 4; ++e) { s[2 * e] += __builtin_bit_cast(float, w[e] << 16); s[2 * e + 1] += __builtin_bit_cast(float, w[e] & 0xffff0000u); } }
#pragma unroll
          for (int e = 0; e < 8; ++e) { s[e] += __shfl_xor(s[e], 8); s[e] += __shfl_xor(s[e], 16); s[e] += __shfl_xor(s[e], 32); }
          if (r8 == 0) {
#pragma unroll
              for (int e = 0; e < 8; ++e) part[wave * 64 + c8 * 8 + e] = s[e]; }
          __syncthreads();
          if (tid < 128) { const int item = tid >> 6, d = tid & 63; const float* pp = part + item * 256 + d;
              KMB[(size_t)(it0 + item) * 64 + d] = (bf16_t)f2bf((((pp[0] + pp[64]) + pp[128]) + pp[192]) * (1.f / 256.f)); }
          __syncthreads();
      } }
}
__device__ __forceinline__ void phase_m1_fast(const Params& p, int l, unsigned char* lds_raw) {
    int* ps = (int*)(lds_raw + LDS_PS_OFF);
    load_pstart(p, l, ps);
    pg8::ProbMoe1 P{(const bf16_t*)(p.ws + WS_XN8), (const bf16_t*)(p.ws + WS_W1T) + (size_t)l * NE * 2048 * 512, (const int*)(p.ws + WS_ROWTOK) + (size_t)l * RMAX, (pg8::lds_ints)ps, 512, ps[32] / 256, (int)gridDim.x, (int)blockIdx.x};
    pg8::EpiM1 E{p.ws + WS_ACT, p.in[18] + (size_t)l * NE * 2048, (const float*)(p.ws + WS_DQ1) + (size_t)l * NE * 2048};
    pg8::gemm_phase<pg8::ProbMoe1, pg8::EpiM1, true, true>((PG8_LAS unsigned char*)lds_raw, P, E);
    __syncthreads();
}
__device__ __forceinline__ void phase_m2_fast(const Params& p, int l, unsigned char* lds_raw) {
    int* ps = (int*)(lds_raw + LDS_PS_OFF);
    load_pstart(p, l, ps);
    pg8::ProbMoe2 P{(const bf16_t*)(p.ws + WS_ACT), (const bf16_t*)(p.ws + WS_W2T) + (size_t)l * NE * D * 512, (pg8::lds_ints)ps, 512, ps[32] / 256, (int)gridDim.x, (int)blockIdx.x};
    pg8::EpiM2 E{(bf16_t*)(p.ws + WS_Y), p.in[20] + (size_t)l * NE * D, (const float*)(p.ws + WS_DQ2) + (size_t)l * NE * D};
    pg8::gemm_phase<pg8::ProbMoe2, pg8::EpiM2, true, true>((PG8_LAS unsigned char*)lds_raw, P, E);
    __syncthreads();
}

namespace at {
#define AT_LAS __attribute__((address_space(3)))
typedef short bf16x8 __attribute__((ext_vector_type(8)));
typedef short s16x4 __attribute__((ext_vector_type(4)));
typedef short v4i16_t __attribute__((ext_vector_type(4)));
typedef float f32x16 __attribute__((ext_vector_type(16)));
typedef unsigned u32x4 __attribute__((ext_vector_type(4)));
typedef float f32x2_t __attribute__((ext_vector_type(2))); typedef __bf16 bf16x2_t __attribute__((ext_vector_type(2)));
typedef AT_LAS unsigned char* lp;
constexpr int L_K = 0  , L_V = 32768  , L_WSF = 65536, L_OST = 67584  , L_SELM = 133120, L_UNI = 134144, L_KMT = 134400, L_END = 142592;
constexpr float NEGS = -1e30f;
constexpr float MAXTHR = 12.f;
__device__ __forceinline__ int crow(int r, int hi) { return (r & 3) + 8 * (r >> 2) + 4 * hi; }
__device__ __forceinline__ unsigned cvtpk(float lo, float hi) { f32x2_t v = {lo, hi}; bf16x2_t b = __builtin_convertvector(v, bf16x2_t); return __builtin_bit_cast(unsigned, b); }
__device__ __forceinline__ float mx3(float a, float b, float c) { return __builtin_fmaxf(__builtin_fmaxf(a, b), c); }
__device__ __forceinline__ void wsync() { asm volatile("s_waitcnt lgkmcnt(0)" ::: "memory"); __builtin_amdgcn_wave_barrier(); }
__device__ __forceinline__ void bar() { __builtin_amdgcn_s_barrier(); }
#define AT_WAITV(n) asm volatile("s_waitcnt vmcnt(" #n ")" ::: "memory")
#define AT_WAITL() asm volatile("s_waitcnt lgkmcnt(0)" ::: "memory")
__device__ __forceinline__ void glds(const void* g, lp dst) { __builtin_amdgcn_global_load_lds((const unsigned*)g, (AT_LAS unsigned*)dst, 16, 0, 0); }
__device__ __forceinline__ s16x4 vtr(const AT_LAS unsigned char* p) { return __builtin_bit_cast(s16x4, __builtin_amdgcn_ds_read_tr16_b64_v4i16((AT_LAS v4i16_t*)p)); }

__device__ __forceinline__ void dma_k(lp slot, const bf16_t* kbase, int pitch, int key0, int wid, int lane) { glds(kbase + (size_t)(key0 + lane) * pitch + wid * 8, slot + wid * 1024); }
__device__ __forceinline__ void dma_v(lp slot, const bf16_t* vbase, int pitch, int key0, int wid, int lane) {
    glds(vbase + (size_t)(key0 + 16 * (wid & 3) + (lane >> 2)) * pitch + (wid >> 2) * 32 + (lane & 3) * 8, slot + wid * 1024); }

__device__ __forceinline__ void qk_tile(f32x16& p0, f32x16& p1, lp kslot, const bf16x8 (&qr)[4], int r32, int hi) {
    const AT_LAS unsigned char* kb = kslot + hi * 1024 + r32 * 16;
    bf16x8 b0[4], b1[4];
#pragma unroll
    for (int d0 = 0; d0 < 4; ++d0) { b0[d0] = *(const AT_LAS bf16x8*)(kb + d0 * 2048); b1[d0] = *(const AT_LAS bf16x8*)(kb + d0 * 2048 + 512); }
#pragma unroll
    for (int d0 = 0; d0 < 4; ++d0) {
        p0 = __builtin_amdgcn_mfma_f32_32x32x16_bf16(b0[d0], qr[d0], p0, 0, 0, 0);
        p1 = __builtin_amdgcn_mfma_f32_32x32x16_bf16(b1[d0], qr[d0], p1, 0, 0, 0);
    }
}
struct VFrag { bf16x8 f[8]; };
__device__ __forceinline__ void pv_load(VFrag& v, lp vslot, int lane, int hi) {
    const AT_LAS unsigned char* vp = vslot + ((lane >> 4) & 1) * 32 + (lane & 3) * 8 + (4 * hi + ((lane & 15) >> 2)) * 64;
#pragma unroll
    for (int d0 = 0; d0 < 2; ++d0)
#pragma unroll
        for (int ks = 0; ks < 4; ++ks) {
            const s16x4 lo = vtr(vp + d0 * 4096 + ks * 1024), hh = vtr(vp + d0 * 4096 + ks * 1024 + 512);
            v.f[d0 * 4 + ks] = (bf16x8){lo[0], lo[1], lo[2], lo[3], hh[0], hh[1], hh[2], hh[3]};
        }
}
__device__ __forceinline__ void pv_mfma(f32x16 (&o)[2], const VFrag& v, u32x4 pw0, u32x4 pw1, u32x4 pw2, u32x4 pw3) {
    const bf16x8 pa[4] = {__builtin_bit_cast(bf16x8, pw0), __builtin_bit_cast(bf16x8, pw1), __builtin_bit_cast(bf16x8, pw2), __builtin_bit_cast(bf16x8, pw3)};
#pragma unroll
    for (int ks = 0; ks < 4; ++ks) {
        o[0] = __builtin_amdgcn_mfma_f32_32x32x16_bf16(pa[ks], v.f[ks], o[0], 0, 0, 0);
        o[1] = __builtin_amdgcn_mfma_f32_32x32x16_bf16(pa[ks], v.f[4 + ks], o[1], 0, 0, 0);
    }
}
__device__ __forceinline__ float rowmax(const f32x16& p0, const f32x16& p1) {
    float a = mx3(p0[0], p0[1], p1[0]), b = mx3(p0[2], p0[3], p1[1]); a = mx3(a, p1[2], p1[3]);
#pragma unroll
    for (int r = 4; r < 16; r += 4) { a = mx3(a, p0[r], p0[r + 1]); b = mx3(b, p0[r + 2], p0[r + 3]); a = mx3(a, p1[r], p1[r + 1]); b = mx3(b, p1[r + 2], p1[r + 3]); }
    const float m = __builtin_fmaxf(a, b);
    auto rr = __builtin_amdgcn_permlane32_swap(__float_as_uint(m), __float_as_uint(m), false, false);
    return __builtin_fmaxf(__uint_as_float(rr[0]), __uint_as_float(rr[1]));
}
__device__ __forceinline__ float halfsum(float v) {
    auto rr = __builtin_amdgcn_permlane32_swap(__float_as_uint(v), __float_as_uint(v), false, false);
    return __uint_as_float(rr[0]) + __uint_as_float(rr[1]);
}
__device__ __forceinline__ void mask_tile(f32x16& p0, f32x16& p1, int lo, int hi_, int hi) {
    const int kb = 4 * hi;
#pragma unroll
    for (int r = 0; r < 16; ++r) { const int kv = kb + (r & 3) + 8 * (r >> 2); if (kv > hi_ || kv < lo) p0[r] = NEGS; if (kv + 32 > hi_ || kv + 32 < lo) p1[r] = NEGS; }
}

__device__ __forceinline__ void mask_init_lo(f32x16& p0, f32x16& p1, int lo, int hi) {
    const int kb = 4 * hi;
#pragma unroll
    for (int r = 0; r < 16; ++r) { const int kv = kb + (r & 3) + 8 * (r >> 2); if (kv < lo) p0[r] = NEGS; if (kv + 32 < lo) p1[r] = NEGS; }
}
__device__ __forceinline__ void mask_init(f32x16& p0, f32x16& p1, int hi_, int hi) {
    const int kb = 4 * hi;
#pragma unroll
    for (int r = 0; r < 16; ++r) { const int kv = kb + (r & 3) + 8 * (r >> 2); if (kv > hi_) p0[r] = NEGS; if (kv + 32 > hi_) p1[r] = NEGS; }
}
__device__ __forceinline__ int next_bit128(unsigned u0, unsigned u1, unsigned u2, unsigned u3, int below) {
    if (below > 96) { unsigned x = u3; if (below < 128) x &= (1u << (below - 96)) - 1u; if (x) return 96 + 31 - __builtin_clz(x); }
    if (below > 64) { unsigned x = u2; if (below < 96) x &= (1u << (below - 64)) - 1u; if (x) return 64 + 31 - __builtin_clz(x); }
    if (below > 32) { unsigned x = u1; if (below < 64) x &= (1u << (below - 32)) - 1u; if (x) return 32 + 31 - __builtin_clz(x); }
    if (below > 0) { unsigned x = u0; if (below < 32) x &= (1u << below) - 1u; if (x) return 31 - __builtin_clz(x); }
    return -1;
}
struct Soft { float m, l; };

template <bool HAS_O>
__device__ __forceinline__ void softmax_step(f32x16& p0, f32x16& p1, Soft& st, f32x16 (&o)[2], float* wsf, int r32, int hi) {
    const float rm = rowmax(p0, p1);
    if (__any(rm > MAXTHR)) {
        const float dl = __builtin_fmaxf(rm, 0.f); st.m += dl;
#pragma unroll
        for (int r = 0; r < 16; ++r) { p0[r] -= dl; p1[r] -= dl; }
        const float al = __builtin_amdgcn_exp2f(-dl); st.l *= al;
        if (HAS_O) {
            if (hi == 0) wsf[r32] = al;
            wsync();
#pragma unroll
            for (int r = 0; r < 16; ++r) { const float f = wsf[crow(r, hi)]; o[0][r] *= f; o[1][r] *= f; }
            wsync();
        }
    }
    float s = 0.f;
#pragma unroll
    for (int r = 0; r < 16; ++r) { p0[r] = __builtin_amdgcn_exp2f(p0[r]); p1[r] = __builtin_amdgcn_exp2f(p1[r]); s += p0[r] + p1[r]; }
    st.l += s;
}
#define AT_PACK(P0, P1) \
    const u32x4 pw0 = {cvtpk(P0[0], P0[1]), cvtpk(P0[2], P0[3]), cvtpk(P0[4], P0[5]), cvtpk(P0[6], P0[7])}, pw1 = {cvtpk(P0[8], P0[9]), cvtpk(P0[10], P0[11]), cvtpk(P0[12], P0[13]), cvtpk(P0[14], P0[15])}, \
                pw2 = {cvtpk(P1[0], P1[1]), cvtpk(P1[2], P1[3]), cvtpk(P1[4], P1[5]), cvtpk(P1[6], P1[7])}, pw3 = {cvtpk(P1[8], P1[9]), cvtpk(P1[10], P1[11]), cvtpk(P1[12], P1[13]), cvtpk(P1[14], P1[15])}
__device__ __forceinline__ float fma_vsv(float a, float k, float x) { float d; asm("v_fma_f32 %0, %1, %2, %3" : "=v"(d) : "v"(a), "s"(k), "v"(x)); return d; }
__device__ __forceinline__ f32x16 cinit(float c2k, int hi, float x) { f32x16 c; const float xb = __builtin_fmaf(c2k, (float)(4 * hi), x);
    c[0] = xb;
#pragma unroll
    for (int r = 1; r < 16; ++r) c[r] = fma_vsv(c2k, (float)((r & 3) + 8 * (r >> 2)), xb);
    return c; }
template <bool FIRST>
__device__ __forceinline__ void acc_scaled(float* stage, const f32x16 (&o)[2], float f, float* wsf, int r32, int hi) {
    if (hi == 0) wsf[r32] = f;
    wsync();
#pragma unroll
    for (int r = 0; r < 16; ++r) { const int orow = crow(r, hi); const float g = wsf[orow]; float* s0 = stage + orow * 64 + r32;
        if (FIRST) { s0[0] = o[0][r] * g; s0[32] = o[1][r] * g; } else { s0[0] += o[0][r] * g; s0[32] += o[1][r] * g; } }
    wsync();
}

#define AT_WAIT_NEWER(newer, per) do { if ((newer) >= 2) { if ((per) == 2) AT_WAITV(4); else AT_WAITV(2); } else if ((newer) == 1) { if ((per) == 2) AT_WAITV(2); else AT_WAITV(1); } else AT_WAITV(0); } while (0)


#define AT_SB() __builtin_amdgcn_sched_barrier(0)
struct PipeOut { float s, rmn; };
__device__ __forceinline__ PipeOut pipe_step(f32x16& c0, f32x16& c1, f32x16& n0, f32x16& n1, f32x16 (&o)[2], lp kslot_next, lp vslot, const bf16x8 (&qr)[4], int lane, int r32, int hi) {
    const AT_LAS unsigned char* kb = kslot_next + hi * 1024 + r32 * 16;
    const AT_LAS unsigned char* vp = vslot + ((lane >> 4) & 1) * 32 + (lane & 3) * 8 + (4 * hi + ((lane & 15) >> 2)) * 64;
    bf16x8 kf[8];
#pragma unroll
    for (int j = 0; j < 4; ++j) kf[j] = *(const AT_LAS bf16x8*)(kb + (j >> 1) * 2048 + (j & 1) * 512);
    AT_SB();
    unsigned w0[8], w1[8]; s16x4 vl[8], vh[8]; float s = 0.f;
#pragma unroll
    for (int j = 0; j < 8; ++j) {
        if (j & 1) n1 = __builtin_amdgcn_mfma_f32_32x32x16_bf16(kf[j], qr[j >> 1], n1, 0, 0, 0);
        else       n0 = __builtin_amdgcn_mfma_f32_32x32x16_bf16(kf[j], qr[j >> 1], n0, 0, 0, 0);
        if (j < 4) kf[j + 4] = *(const AT_LAS bf16x8*)(kb + ((j + 4) >> 1) * 2048 + (j & 1) * 512);
        if (j >= 4) {
#pragma unroll
            for (int q = 0; q < 2; ++q) { const int f = (j - 4) * 2 + q, d0 = f >> 2, ks = f & 3; vl[f] = vtr(vp + d0 * 4096 + ks * 1024); vh[f] = vtr(vp + d0 * 4096 + ks * 1024 + 512); }
        }
        const float e0 = __builtin_amdgcn_exp2f(c0[2 * j]), e1 = __builtin_amdgcn_exp2f(c0[2 * j + 1]), e2 = __builtin_amdgcn_exp2f(c1[2 * j]), e3 = __builtin_amdgcn_exp2f(c1[2 * j + 1]);
        s += (e0 + e1) + (e2 + e3);
        asm volatile("" : "+v"(s));
        w0[j] = cvtpk(e0, e1); w1[j] = cvtpk(e2, e3);
        AT_SB();
    }
    const u32x4 pw0 = {w0[0], w0[1], w0[2], w0[3]}, pw1 = {w0[4], w0[5], w0[6], w0[7]}, pw2 = {w1[0], w1[1], w1[2], w1[3]}, pw3 = {w1[4], w1[5], w1[6], w1[7]};
    const bf16x8 pa[4] = {__builtin_bit_cast(bf16x8, pw0), __builtin_bit_cast(bf16x8, pw1), __builtin_bit_cast(bf16x8, pw2), __builtin_bit_cast(bf16x8, pw3)};
    float a = mx3(n0[0], n0[1], n1[0]), b = mx3(n0[2], n0[3], n1[1]);
#pragma unroll
    for (int f = 0; f < 8; ++f) {
        const int d0 = f >> 2, ks = f & 3;
        const bf16x8 vf = (bf16x8){vl[f][0], vl[f][1], vl[f][2], vl[f][3], vh[f][0], vh[f][1], vh[f][2], vh[f][3]};
        o[d0] = __builtin_amdgcn_mfma_f32_32x32x16_bf16(pa[ks], vf, o[d0], 0, 0, 0);
        if (f == 0) { a = mx3(a, n1[2], n1[3]); }
        else if (f < 4) { const int r = 4 * f; a = mx3(a, n0[r], n0[r + 1]); b = mx3(b, n0[r + 2], n0[r + 3]); a = mx3(a, n1[r], n1[r + 1]); b = mx3(b, n1[r + 2], n1[r + 3]); }
        asm volatile("" : "+v"(a), "+v"(b));
        AT_SB();
    }
    const float m = __builtin_fmaxf(a, b);
    auto rr = __builtin_amdgcn_permlane32_swap(__float_as_uint(m), __float_as_uint(m), false, false);
    PipeOut out; out.s = s; out.rmn = __builtin_fmaxf(__uint_as_float(rr[0]), __uint_as_float(rr[1]));
    return out;
}
__device__ __forceinline__ void nsa_unit(const Params& p, int b, int g, int c, unsigned char* lds_raw) {
    const int tid = otid(), lane = tid & 63, r32 = lane & 31, hi = lane >> 5, wid = __builtin_amdgcn_readfirstlane(tid >> 6);
    lp lds = (lp)lds_raw;
    const bf16_t* ZB = (const bf16_t*)(p.ws + WS_ZB); const float* GT = (const float*)(p.ws + WS_GATE);
    const bf16_t* KCB = (const bf16_t*)(p.ws + WS_KCB) + (size_t)(b * 2 + g) * 512 * 64; const bf16_t* VCB = (const bf16_t*)(p.ws + WS_VCB) + (size_t)(b * 2 + g) * 512 * 64;
    const int t0 = c * 64, hg = r32 >> 3, qq = r32 & 7, qi = 8 * wid + qq, t = t0 + qi, h = 4 * g + hg; const size_t tt = (size_t)b * S + t;
    float* wsf = (float*)(lds_raw + L_WSF) + wid * 64;
    float* ostage = (float*)(lds_raw + L_OST) + wid * 2048;
    float* imp = ostage;
    unsigned* selm = (unsigned*)(lds_raw + L_SELM);
    unsigned* uni = (unsigned*)(lds_raw + L_UNI);
    const float c2 = exp2f(-(float)(h + 1)) * LOG2E;
    bf16x8 qr[4];
#pragma unroll
    for (int d0 = 0; d0 < 4; ++d0) qr[d0] = *(const bf16x8*)(ZB + tt * ZBW + ZB_Q + h * 64 + d0 * 16 + hi * 8);
    const float gt0 = GT[tt * 32 + h * 3 + 0], gt1 = GT[tt * 32 + h * 3 + 1], gt2 = GT[tt * 32 + h * 3 + 2];
    f32x16 o[2];
    const lp sK0 = lds + L_K, sV0 = lds + L_V;
    const int nmax = t >= 31 ? (t - 31) >> 4 : -1;
    const int ntc = ((4 * c + 2) >> 6) + 1;
    for (int i = lane; i < 8 * 129; i += 64) imp[i] = 0.f;
    Soft sc; sc.m = 0.f; sc.l = 0.f;
#pragma unroll
    for (int k = 0; k < 3; ++k) if (k < ntc) dma_k(sK0 + k * 8192, KCB, 64, 64 * k, wid, lane);
    for (int k = 0; k < ntc; ++k) {
        const int newer = ntc - 1 - k; AT_WAIT_NEWER(newer, 1);
        AT_WAITL(); bar();
        if (k + 3 < ntc) dma_k(sK0 + ((k + 3) & 3) * 8192, KCB, 64, 64 * (k + 3), wid, lane);
        const lp sK = sK0 + (k & 3) * 8192;
        const float x0 = c2 * (16.f * (64 * k) + 15.5f - (float)t0) - sc.m;
        f32x16 p0 = cinit(16.f * c2, hi, x0), p1 = cinit(16.f * c2, hi, x0 + c2 * 512.f);
        qk_tile(p0, p1, sK, qr, r32, hi);
        if (__any(nmax - 64 * k < 63)) mask_tile(p0, p1, 0, nmax - 64 * k, hi);
        softmax_step<false>(p0, p1, sc, o, wsf, r32, hi);
    }
    const float lc = halfsum(sc.l), linv = lc > 0.f ? 1.f / lc : 0.f;
    o[0] = f32x16{}; o[1] = f32x16{};
    AT_WAITL(); bar();
#pragma unroll
    for (int k = 0; k < 3; ++k) if (k < ntc) { dma_k(sK0 + k * 8192, KCB, 64, 64 * k, wid, lane); dma_v(sV0 + k * 8192, VCB, 64, 64 * k, wid, lane); }
    for (int k = 0; k < ntc; ++k) {
        const int newer = ntc - 1 - k; AT_WAIT_NEWER(newer, 2);
        AT_WAITL(); bar();
        if (k + 3 < ntc) { dma_k(sK0 + ((k + 3) & 3) * 8192, KCB, 64, 64 * (k + 3), wid, lane); dma_v(sV0 + ((k + 3) & 3) * 8192, VCB, 64, 64 * (k + 3), wid, lane); }
        const lp sK = sK0 + (k & 3) * 8192, sV = sV0 + (k & 3) * 8192;
        const float x0 = c2 * (16.f * (64 * k) + 15.5f - (float)t0) - sc.m;
        f32x16 p0 = cinit(16.f * c2, hi, x0), p1 = cinit(16.f * c2, hi, x0 + c2 * 512.f);
        qk_tile(p0, p1, sK, qr, r32, hi);
        if (__any(nmax - 64 * k < 63)) mask_tile(p0, p1, 0, nmax - 64 * k, hi);
        VFrag vf; pv_load(vf, sV, lane, hi);
#pragma unroll
        for (int r = 0; r < 16; ++r) { p0[r] = __builtin_amdgcn_exp2f(p0[r]); p1[r] = __builtin_amdgcn_exp2f(p1[r]); }
        { AT_PACK(p0, p1); pv_mfma(o, vf, pw0, pw1, pw2, pw3); }
        float gs[8], ls[8];
#pragma unroll
        for (int q4 = 0; q4 < 4; ++q4) { gs[q4] = ((p0[4 * q4] + p0[4 * q4 + 1]) + (p0[4 * q4 + 2] + p0[4 * q4 + 3])) * linv; ls[q4] = p0[4 * q4 + 3] * linv;
                                         gs[4 + q4] = ((p1[4 * q4] + p1[4 * q4 + 1]) + (p1[4 * q4 + 2] + p1[4 * q4 + 3])) * linv; ls[4 + q4] = p1[4 * q4 + 3] * linv; }
#pragma unroll
        for (int q4 = 0; q4 < 8; ++q4) { gs[q4] += __shfl_xor(gs[q4], 8); gs[q4] += __shfl_xor(gs[q4], 16); ls[q4] += __shfl_xor(ls[q4], 8); ls[q4] += __shfl_xor(ls[q4], 16); }
        if (r32 < 8) {
            float* row = imp + qq * 129 + 16 * k + hi;
#pragma unroll
            for (int q4 = 0; q4 < 8; ++q4) row[2 * q4] += gs[q4];
        }
        wsync();
        if (r32 < 8) {
            float* row = imp + qq * 129 + 16 * k + hi + 1;
#pragma unroll
            for (int q4 = 0; q4 < 8; ++q4) row[2 * q4] += ls[q4];
        }
        wsync();
    }
    unsigned mk0 = 0u, mk1 = 0u, mk2 = 0u, mk3 = 0u;
    {
        const int qs = lane >> 3, part = lane & 7;
        float v[16];
#pragma unroll
        for (int i = 0; i < 16; ++i) { const int j = part * 16 + i; float x = imp[qs * 129 + j]; if (j == 0 || j == c || j == c - 1) x = 1e4f; if (j > c) x = NEGS; v[i] = x; }
#pragma unroll 1
        for (int it = 0; it < 16; ++it) {
            float bv = -3e38f; int bi = 0;
#pragma unroll
            for (int i = 0; i < 16; ++i) if (v[i] > bv) { bv = v[i]; bi = part * 16 + i; }
#pragma unroll
            for (int sft = 1; sft < 8; sft <<= 1) { const float ov = __shfl_xor(bv, sft); const int oi = __shfl_xor(bi, sft); if (ov > bv || (ov == bv && oi < bi)) { bv = ov; bi = oi; } }
            if (bv > NEGS) { const unsigned bit = 1u << (bi & 31); const int wq = bi >> 5; if (wq == 0) mk0 |= bit; else if (wq == 1) mk1 |= bit; else if (wq == 2) mk2 |= bit; else mk3 |= bit; }
#pragma unroll
            for (int i = 0; i < 16; ++i) if (part * 16 + i == bi) v[i] = -3.4e38f;
        }
        if (part == 0) { unsigned* sm = selm + (8 * wid + qs) * 4; sm[0] = mk0; sm[1] = mk1; sm[2] = mk2; sm[3] = mk3; }
        unsigned u0 = mk0, u1 = mk1, u2 = mk2, u3 = mk3;
#pragma unroll
        for (int sft = 8; sft < 64; sft <<= 1) { u0 |= __shfl_xor(u0, sft); u1 |= __shfl_xor(u1, sft); u2 |= __shfl_xor(u2, sft); u3 |= __shfl_xor(u3, sft); }
        if (lane == 0) { uni[wid * 4 + 0] = u0; uni[wid * 4 + 1] = u1; uni[wid * 4 + 2] = u2; uni[wid * 4 + 3] = u3; }
    }
    wsync();
    acc_scaled<true>(ostage, o, gt0 * linv, wsf, r32, hi);
    AT_WAITL(); bar();
    unsigned un0 = 0u, un1 = 0u, un2 = 0u, un3 = 0u;
#pragma unroll
    for (int w = 0; w < 8; ++w) { un0 |= uni[w * 4 + 0]; un1 |= uni[w * 4 + 1]; un2 |= uni[w * 4 + 2]; un3 |= uni[w * 4 + 3]; }
    un0 = __builtin_amdgcn_readfirstlane(un0); un1 = __builtin_amdgcn_readfirstlane(un1); un2 = __builtin_amdgcn_readfirstlane(un2); un3 = __builtin_amdgcn_readfirstlane(un3);
    const unsigned my0 = selm[(8 * wid + qq) * 4 + 0], my1 = selm[(8 * wid + qq) * 4 + 1], my2 = selm[(8 * wid + qq) * 4 + 2], my3 = selm[(8 * wid + qq) * 4 + 3];
    {
        const bf16_t* KS = ZB + (size_t)b * S * ZBW + ZB_KS + g * 64; const bf16_t* VS = ZB + (size_t)b * S * ZBW + ZB_VS + g * 64;
        Soft ss; ss.m = 0.f; ss.l = 0.f; o[0] = f32x16{}; o[1] = f32x16{};
        const int nsel = __builtin_popcount(un0) + __builtin_popcount(un1) + __builtin_popcount(un2) + __builtin_popcount(un3);
        int ji = 128;
#pragma unroll
        for (int k = 0; k < 3; ++k) if (k < nsel) { ji = next_bit128(un0, un1, un2, un3, ji); dma_k(sK0 + k * 8192, KS, ZBW, 64 * ji, wid, lane); dma_v(sV0 + k * 8192, VS, ZBW, 64 * ji, wid, lane); }
        int j = 128;
        for (int i = 0; i < nsel; ++i) {
            j = next_bit128(un0, un1, un2, un3, j);
            const int newer = nsel - 1 - i; AT_WAIT_NEWER(newer, 2);
            AT_WAITL(); bar();
            if (i + 3 < nsel) { ji = next_bit128(un0, un1, un2, un3, ji); dma_k(sK0 + ((i + 3) & 3) * 8192, KS, ZBW, 64 * ji, wid, lane); dma_v(sV0 + ((i + 3) & 3) * 8192, VS, ZBW, 64 * ji, wid, lane); }
            const lp sK = sK0 + (i & 3) * 8192, sV = sV0 + (i & 3) * 8192;
            const unsigned mw = (j >> 5) == 0 ? my0 : (j >> 5) == 1 ? my1 : (j >> 5) == 2 ? my2 : my3;
            const bool sel = (mw >> (j & 31)) & 1u;
            const float x0 = sel ? c2 * (float)(64 * j - t0) - ss.m : NEGS;
            f32x16 p0 = cinit(c2, hi, x0), p1 = cinit(c2, hi, sel ? x0 + c2 * 32.f : NEGS);
            qk_tile(p0, p1, sK, qr, r32, hi);
            if (j == c) mask_tile(p0, p1, 0, qi, hi);
            VFrag vf; pv_load(vf, sV, lane, hi);
            softmax_step<true>(p0, p1, ss, o, wsf, r32, hi);
            { AT_PACK(p0, p1); pv_mfma(o, vf, pw0, pw1, pw2, pw3); }
        }
        const float ls_ = halfsum(ss.l);
        acc_scaled<false>(ostage, o, ls_ > 0.f ? gt1 / ls_ : 0.f, wsf, r32, hi);
    }
    {
        const bf16_t* KW = ZB + (size_t)b * S * ZBW + ZB_KW + g * 64; const bf16_t* VW = ZB + (size_t)b * S * ZBW + ZB_VW + g * 64;
        Soft sw; sw.m = 0.f; sw.l = 0.f; o[0] = f32x16{}; o[1] = f32x16{};
        const int k0 = c >= 8 ? 0 : 8 - c, nw = 9 - k0;
        AT_WAITL(); bar();
#pragma unroll
        for (int k = 0; k < 3; ++k) if (k < nw) { dma_k(sK0 + k * 8192, KW, ZBW, t0 - 64 * k, wid, lane); dma_v(sV0 + k * 8192, VW, ZBW, t0 - 64 * k, wid, lane); }
        f32x16 pA0, pA1, pB0, pB1; float rmc;
#define WIN_STEP(C0, C1, N0, N1, I) do { const int i_ = (I); \
            if (i_ + 1 < nw) { if (i_ + 2 < nw) AT_WAITV(2); else AT_WAITV(0); } \
            AT_WAITL(); bar(); \
            if (i_ + 3 < nw) { dma_k(sK0 + ((i_ + 3) & 3) * 8192, KW, ZBW, t0 - 64 * (i_ + 3), wid, lane); dma_v(sV0 + ((i_ + 3) & 3) * 8192, VW, ZBW, t0 - 64 * (i_ + 3), wid, lane); } \
            if (__any(rmc > MAXTHR)) { \
                const float dl = __builtin_fmaxf(rmc, 0.f); sw.m += dl; \
                _Pragma("unroll") for (int r = 0; r < 16; ++r) { C0[r] -= dl; C1[r] -= dl; } \
                const float al = __builtin_amdgcn_exp2f(-dl); sw.l *= al; \
                if (hi == 0) wsf[r32] = al; \
                wsync(); \
                _Pragma("unroll") for (int r = 0; r < 16; ++r) { const float f = wsf[crow(r, hi)]; o[0][r] *= f; o[1][r] *= f; } \
                wsync(); \
            } \
            { const float x0 = c2 * (float)(-64 * (i_ + 1)) - sw.m; \
              N0 = cinit(c2, hi, x0); N1 = cinit(c2, hi, x0 + c2 * 32.f); \
              if (i_ + 1 == 8) mask_init_lo(N0, N1, qi + 1, hi); }        \
            const PipeOut po = pipe_step(C0, C1, N0, N1, o, sK0 + ((i_ + 1) & 3) * 8192, sV0 + (i_ & 3) * 8192, qr, lane, r32, hi); \
            sw.l += po.s; rmc = po.rmn; } while (0)
        { if (nw >= 3) AT_WAITV(4); else if (nw == 2) AT_WAITV(2); else AT_WAITV(0);
          AT_WAITL(); bar(); }
        { pB0 = cinit(c2, hi, 0.f); pB1 = cinit(c2, hi, c2 * 32.f);
          qk_tile(pB0, pB1, sK0, qr, r32, hi);
          mask_tile(pB0, pB1, 0, qi, hi);
          rmc = rowmax(pB0, pB1); }
        int i = 0;
#pragma unroll 1
        for (; i + 1 < nw; i += 2) {
            WIN_STEP(pB0, pB1, pA0, pA1, i);
            WIN_STEP(pA0, pA1, pB0, pB1, i + 1);
        }
        if (i < nw) WIN_STEP(pB0, pB1, pA0, pA1, i);
#undef WIN_STEP
        const float lw = halfsum(sw.l);
        acc_scaled<false>(ostage, o, lw > 0.f ? gt2 / lw : 0.f, wsf, r32, hi);
    }
    {
        bf16_t* AB = (bf16_t*)(p.ws + WS_ATTB);
#pragma unroll
        for (int i = 0; i < 4; ++i) { const int row = i * 8 + (lane >> 3), ch = lane & 7; const float4 a = *(const float4*)(ostage + row * 64 + ch * 8), c4 = *(const float4*)(ostage + row * 64 + ch * 8 + 4);
            const uint4 v = make_uint4(pk2(a.x, a.y), pk2(a.z, a.w), pk2(c4.x, c4.y), pk2(c4.z, c4.w));
            *(uint4*)(AB + ((size_t)b * S + t0 + 8 * wid + (row & 7)) * D + (4 * g + (row >> 3)) * 64 + ch * 8) = v; }
        wsync();
    }
    AT_WAITL(); bar();
}

}

constexpr int MB_CAP = 25600;
namespace at {
__device__ __forceinline__ void moba_route_unit(const Params& p, int b, int h, int qb, unsigned char* lds_raw) {
    const int tid = otid(), lane = tid & 63, r32 = lane & 31, hi = lane >> 5, wid = __builtin_amdgcn_readfirstlane(tid >> 6);
    lp lds = (lp)lds_raw;
    const bf16_t* ZB = (const bf16_t*)(p.ws + WS_ZB);
    const int bh = b * 8 + h;
    const bf16_t* KMB = (const bf16_t*)(p.ws + WS_KMB) + (size_t)bh * 32 * 64;
    const int qi = 32 * wid + r32, t = qb * 256 + qi; const size_t tt = (size_t)b * S + t;
    int* hist = (int*)(lds_raw + L_UNI);
    unsigned* SEL3 = (unsigned*)(p.ws + WS_SEL3); unsigned* LRK = (unsigned*)(p.ws + WS_LRK);
    unsigned char* IL = (unsigned char*)(p.ws + WS_ILIST) + ((size_t)(bh * 32 + qb) * 32) * 256;
    int* BCm = (int*)(p.ws + WS_BCM) + (size_t)(bh * 32 + qb) * 32;
    if (tid < 32) hist[tid] = 0;
    bf16x8 qr[4];
#pragma unroll
    for (int d0 = 0; d0 < 4; ++d0) qr[d0] = *(const bf16x8*)(ZB + tt * ZBW + ZB_MQ + h * 64 + d0 * 16 + hi * 8);
    const lp sKM = lds + L_KMT;
    glds(KMB + (size_t)(lane & 31) * 64 + wid * 8, sKM + wid * 1024);
    AT_WAITV(0); AT_WAITL(); bar();
    f32x16 g0 = f32x16{}, g1 = f32x16{};
    qk_tile(g0, g1, sKM, qr, r32, hi);
    float v1 = NEGS, v2 = NEGS, v3 = NEGS; int i1 = 64, i2 = 64, i3 = 64;
#pragma unroll
    for (int r = 0; r < 16; ++r) { const int n = crow(r, hi); const float s_ = n < qb ? g0[r] : NEGS;
        if (s_ > v1) { v3 = v2; i3 = i2; v2 = v1; i2 = i1; v1 = s_; i1 = n; } else if (s_ > v2) { v3 = v2; i3 = i2; v2 = s_; i2 = n; } else if (s_ > v3) { v3 = s_; i3 = n; } }
    float ov[3]; int oi[3];
    { auto a = __builtin_amdgcn_permlane32_swap(__float_as_uint(v1), __float_as_uint(v1), false, false); ov[0] = __uint_as_float(hi ? a[0] : a[1]); }
    { auto a = __builtin_amdgcn_permlane32_swap(__float_as_uint(v2), __float_as_uint(v2), false, false); ov[1] = __uint_as_float(hi ? a[0] : a[1]); }
    { auto a = __builtin_amdgcn_permlane32_swap(__float_as_uint(v3), __float_as_uint(v3), false, false); ov[2] = __uint_as_float(hi ? a[0] : a[1]); }
    { auto a = __builtin_amdgcn_permlane32_swap((unsigned)i1, (unsigned)i1, false, false); oi[0] = (int)(hi ? a[0] : a[1]); }
    { auto a = __builtin_amdgcn_permlane32_swap((unsigned)i2, (unsigned)i2, false, false); oi[1] = (int)(hi ? a[0] : a[1]); }
    { auto a = __builtin_amdgcn_permlane32_swap((unsigned)i3, (unsigned)i3, false, false); oi[2] = (int)(hi ? a[0] : a[1]); }
#pragma unroll
    for (int k = 0; k < 3; ++k) { const float s_ = ov[k]; const int n = oi[k];
        if (s_ > v1 || (s_ == v1 && n < i1)) { v3 = v2; i3 = i2; v2 = v1; i2 = i1; v1 = s_; i1 = n; }
        else if (s_ > v2 || (s_ == v2 && n < i2)) { v3 = v2; i3 = i2; v2 = s_; i2 = n; }
        else if (s_ > v3 || (s_ == v3 && n < i3)) { v3 = s_; i3 = n; } }
    if (hi == 0) {
        const int j1 = v1 > NEGS ? i1 : 255, j2 = v2 > NEGS ? i2 : 255, j3 = v3 > NEGS ? i3 : 255;
        int l1 = 0, l2 = 0, l3 = 0;
        if (j1 < 32) { l1 = atomicAdd(&hist[j1], 1); IL[j1 * 256 + l1] = (unsigned char)qi; }
        if (j2 < 32) { l2 = atomicAdd(&hist[j2], 1); IL[j2 * 256 + l2] = (unsigned char)qi; }
        if (j3 < 32) { l3 = atomicAdd(&hist[j3], 1); IL[j3 * 256 + l3] = (unsigned char)qi; }
        SEL3[tt * 8 + h] = (unsigned)j1 | ((unsigned)j2 << 8) | ((unsigned)j3 << 16);
        LRK[tt * 8 + h] = (unsigned)l1 | ((unsigned)l2 << 8) | ((unsigned)l3 << 16);
    }
    AT_WAITL(); bar();
    if (tid < 32) BCm[tid] = hist[tid];
    AT_WAITL(); bar();
}
__device__ __forceinline__ void moba_tables(const int* BCmbh, int lane, int& tot, int& seg) {
    int s = 0;
    if (lane < 32) { for (int q = 0; q < 32; ++q) s += BCmbh[q * 32 + lane]; }
    tot = s;
    int pad = (s + 31) & ~31, inc = pad;
#pragma unroll
    for (int sft = 1; sft < 32; sft <<= 1) { const int o_ = __shfl_up(inc, sft); if ((lane & 31) >= sft) inc += o_; }
    seg = inc - pad;
}
__device__ __forceinline__ void moba_gather_unit(const Params& p, int bh, int j, int ch, int segj, bool reload, unsigned char* lds_raw) {
    const int tid = otid(), lane = tid & 63, r32 = lane & 31, hi = lane >> 5, wid = __builtin_amdgcn_readfirstlane(tid >> 6);
    lp lds = (lp)lds_raw;
    const int b = bh >> 3, h = bh & 7;
    const bf16_t* ZB = (const bf16_t*)(p.ws + WS_ZB);
    const int* BCmbh = (const int*)(p.ws + WS_BCM) + (size_t)bh * 32 * 32;
    float* wsf = (float*)(lds_raw + L_WSF) + wid * 64;
    const lp sK0 = lds + L_K, sV0 = lds + L_V;
    const bf16_t* KM_ = ZB + (size_t)b * S * ZBW + ZB_MK + h * 64; const bf16_t* VM_ = ZB + (size_t)b * S * ZBW + ZB_MV + h * 64;
    if (reload) {
#pragma unroll
        for (int k = 3; k >= 0; --k) { dma_k(sK0 + k * 8192, KM_, ZBW, j * 256 + 64 * k, wid, lane); dma_v(sV0 + k * 8192, VM_, ZBW, j * 256 + 64 * k, wid, lane); }
    }
    const int gr = 256 * ch + 32 * wid + r32;
    const int cq = lane < 32 ? BCmbh[lane * 32 + j] : 0;
    int run = 0, qbs = j + 1, lr = 0;
#pragma unroll 4
    for (int q = 0; q < 32; ++q) { const int c_ = __builtin_amdgcn_readlane(cq, q); if (gr >= run && gr < run + c_) { qbs = q; lr = gr - run; } run += c_; }
    const int totj = run;
    const bool valid = gr < totj;
    const unsigned char* IL = (const unsigned char*)(p.ws + WS_ILIST);
    const int qidx = valid ? (int)IL[((size_t)(bh * 32 + qbs) * 32 + j) * 256 + lr] : 0;
    const int t = valid ? qbs * 256 + qidx : (j + 1) * 256; const size_t tt = (size_t)b * S + t;
    const float c2 = exp2f(-(float)(h + 1)) * LOG2E;
    bf16x8 qr[4];
#pragma unroll
    for (int d0 = 0; d0 < 4; ++d0) qr[d0] = *(const bf16x8*)(ZB + tt * ZBW + ZB_MQ + h * 64 + d0 * 16 + hi * 8);
    Soft sm; sm.m = 0.f; sm.l = 0.f; f32x16 o[2]; o[0] = f32x16{}; o[1] = f32x16{};
#pragma unroll 1
    for (int i = 0; i < 4; ++i) {
        if (reload) { const int newer = 3 - i; if (newer >= 3) AT_WAITV(6); else AT_WAIT_NEWER(newer, 2); AT_WAITL(); bar(); }
        const int kt = 3 - i;
        const lp sK = sK0 + kt * 8192, sV = sV0 + kt * 8192;
        const float x0 = c2 * (float)(64 * kt) - sm.m;
        f32x16 p0 = cinit(c2, hi, x0), p1 = cinit(c2, hi, x0 + c2 * 32.f);
        qk_tile(p0, p1, sK, qr, r32, hi);
        VFrag vf; pv_load(vf, sV, lane, hi);
        softmax_step<true>(p0, p1, sm, o, wsf, r32, hi);
        { AT_PACK(p0, p1); pv_mfma(o, vf, pw0, pw1, pw2, pw3); }
    }
    {
        const float lt = halfsum(sm.l);
        float* PM = (float*)(p.ws + WS_PM) + (size_t)bh * MB_CAP; float* PL = (float*)(p.ws + WS_PL) + (size_t)bh * MB_CAP;
        if (hi == 0 && valid) { PM[segj + gr] = sm.m; PL[segj + gr] = lt; }
        bf16_t* stg = (bf16_t*)(lds_raw + L_OST) + wid * 4096;
#pragma unroll
        for (int r = 0; r < 16; ++r) { const int orow = crow(r, hi); stg[orow * 64 + r32] = (bf16_t)f2bf(o[0][r]); stg[orow * 64 + 32 + r32] = (bf16_t)f2bf(o[1][r]); }
        wsync();
        bf16_t* PO = (bf16_t*)(p.ws + WS_PO) + ((size_t)bh * MB_CAP + segj + 256 * ch + 32 * wid) * 64;
        const int nrow = totj - (256 * ch + 32 * wid);
#pragma unroll
        for (int i = 0; i < 4; ++i) { const int row = i * 8 + (lane >> 3), c8 = lane & 7; if (row < nrow) *(uint4*)(PO + (size_t)row * 64 + c8 * 8) = *(const uint4*)(stg + row * 64 + c8 * 8); }
        wsync();
    }
    AT_WAITL(); bar();
}
__device__ __forceinline__ void moba_self_unit(const Params& p, int b, int h, int qb, unsigned char* lds_raw) {
    const int tid = otid(), lane = tid & 63, r32 = lane & 31, hi = lane >> 5, wid = __builtin_amdgcn_readfirstlane(tid >> 6);
    lp lds = (lp)lds_raw;
    const int bh = b * 8 + h;
    const bf16_t* ZB = (const bf16_t*)(p.ws + WS_ZB);
    const int* BCmbh = (const int*)(p.ws + WS_BCM) + (size_t)bh * 32 * 32;
    const int qi = 32 * wid + r32, t = qb * 256 + qi; const size_t tt = (size_t)b * S + t;
    float* wsf = (float*)(lds_raw + L_WSF) + wid * 64;
    float* ostage = (float*)(lds_raw + L_OST) + wid * 2048;
    const float c2 = exp2f(-(float)(h + 1)) * LOG2E;
    bf16x8 qr[4];
#pragma unroll
    for (int d0 = 0; d0 < 4; ++d0) qr[d0] = *(const bf16x8*)(ZB + tt * ZBW + ZB_MQ + h * 64 + d0 * 16 + hi * 8);
    const lp sK0 = lds + L_K, sV0 = lds + L_V;
    const bf16_t* KM_ = ZB + (size_t)b * S * ZBW + ZB_MK + h * 64; const bf16_t* VM_ = ZB + (size_t)b * S * ZBW + ZB_MV + h * 64;
    Soft sm; sm.m = 0.f; sm.l = 0.f; f32x16 o[2]; o[0] = f32x16{}; o[1] = f32x16{};
#pragma unroll
    for (int k = 0; k < 3; ++k) { dma_k(sK0 + k * 8192, KM_, ZBW, qb * 256 + 64 * (3 - k), wid, lane); dma_v(sV0 + k * 8192, VM_, ZBW, qb * 256 + 64 * (3 - k), wid, lane); }
    int tot, seg; moba_tables(BCmbh, lane, tot, seg);
    int before = 0; if (lane < 32) { for (int q = 0; q < qb; ++q) before += BCmbh[q * 32 + lane]; }
    const int base = seg + before;
#pragma unroll 1
    for (int i = 0; i < 4; ++i) {
        const int newer = 3 - i; AT_WAIT_NEWER(newer, 2);
        AT_WAITL(); bar();
        if (i == 0) { dma_k(sK0 + 3 * 8192, KM_, ZBW, qb * 256, wid, lane); dma_v(sV0 + 3 * 8192, VM_, ZBW, qb * 256, wid, lane); }
        const lp sK = sK0 + i * 8192, sV = sV0 + i * 8192;
        const int kt = 3 - i;
        const bool skip = (32 * wid + 31 < 64 * kt);
        if (!skip) {
            const float x0 = c2 * (float)(64 * kt) - sm.m;
            f32x16 p0 = cinit(c2, hi, x0), p1 = cinit(c2, hi, x0 + c2 * 32.f);
            qk_tile(p0, p1, sK, qr, r32, hi);
            if (64 * kt + 63 > 32 * wid) mask_tile(p0, p1, 0, qi - 64 * kt, hi);
            VFrag vf; pv_load(vf, sV, lane, hi);
            softmax_step<true>(p0, p1, sm, o, wsf, r32, hi);
            { AT_PACK(p0, p1); pv_mfma(o, vf, pw0, pw1, pw2, pw3); }
        }
    }
    {
        const float lself = halfsum(sm.l);
        const unsigned s3 = ((const unsigned*)(p.ws + WS_SEL3))[tt * 8 + h], l3 = ((const unsigned*)(p.ws + WS_LRK))[tt * 8 + h];
        const float* PM = (const float*)(p.ws + WS_PM) + (size_t)bh * MB_CAP; const float* PL = (const float*)(p.ws + WS_PL) + (size_t)bh * MB_CAP;
        float mk[3], lk[3]; int pidx[3];
        float M = sm.m + c2 * 256.f * (float)qb;
        const float mself = M;
#pragma unroll
        for (int k = 0; k < 3; ++k) { const int jk = (s3 >> (8 * k)) & 255, lrk = (l3 >> (8 * k)) & 255;
            const int pb = __shfl(base, jk & 31);
            if (jk < 32) { pidx[k] = pb + lrk; mk[k] = PM[pidx[k]] + c2 * 256.f * (float)jk; lk[k] = PL[pidx[k]]; M = __builtin_fmaxf(M, mk[k]); }
            else { pidx[k] = -1; mk[k] = NEGS; lk[k] = 0.f; } }
        const float ws_ = __builtin_amdgcn_exp2f(mself - M);
        float wk[3]; float Lt = lself * ws_;
#pragma unroll
        for (int k = 0; k < 3; ++k) { wk[k] = pidx[k] >= 0 ? __builtin_amdgcn_exp2f(mk[k] - M) : 0.f; Lt += lk[k] * wk[k]; }
        const float inv = Lt > 0.f ? 1.f / Lt : 0.f;
        float* rws = wsf;
        float* rwk = (float*)(lds_raw + L_KMT) + wid * 256;
        int* rpi = (int*)(rwk + 96);
        if (hi == 0) { rws[r32] = ws_ * inv;
#pragma unroll
            for (int k = 0; k < 3; ++k) { rwk[k * 32 + r32] = wk[k] * inv; rpi[k * 32 + r32] = pidx[k]; } }
#pragma unroll
        for (int r = 0; r < 16; ++r) { const int orow = crow(r, hi); ostage[orow * 64 + r32] = o[0][r]; ostage[orow * 64 + 32 + r32] = o[1][r]; }
        wsync();
        const bf16_t* PO = (const bf16_t*)(p.ws + WS_PO) + (size_t)bh * MB_CAP * 64;
        bf16_t* AB = (bf16_t*)(p.ws + WS_ATTB);
#pragma unroll
        for (int i = 0; i < 4; ++i) { const int row = i * 8 + (lane >> 3), c8 = lane & 7;
            const float4 a = *(const float4*)(ostage + row * 64 + c8 * 8), c4 = *(const float4*)(ostage + row * 64 + c8 * 8 + 4);
            const float w0 = rws[row];
            float acc8[8] = {a.x * w0, a.y * w0, a.z * w0, a.w * w0, c4.x * w0, c4.y * w0, c4.z * w0, c4.w * w0};
#pragma unroll
            for (int k = 0; k < 3; ++k) { const int pi = rpi[k * 32 + row]; if (pi >= 0) { const float w = rwk[k * 32 + row]; const uint4 q = *(const uint4*)(PO + (size_t)pi * 64 + c8 * 8);
                const unsigned qq_[4] = {q.x, q.y, q.z, q.w};
#pragma unroll
                for (int e = 0; e < 4; ++e) { acc8[2 * e] += __builtin_bit_cast(float, qq_[e] << 16) * w; acc8[2 * e + 1] += __builtin_bit_cast(float, qq_[e] & 0xffff0000u) * w; } } }
            *(uint4*)(AB + ((size_t)b * S + qb * 256 + 32 * wid + row) * D + 512 + h * 64 + c8 * 8) = make_uint4(pk2(acc8[0], acc8[1]), pk2(acc8[2], acc8[3]), pk2(acc8[4], acc8[5]), pk2(acc8[6], acc8[7])); }
        wsync();
    }
    AT_WAITL(); bar();
}
}

__device__ __forceinline__ void phase_att1(const Params& p, unsigned char* lds_raw) {
    const int tid = otid();
    int* pre = (int*)(lds_raw + at::L_END);
    int* segt = pre + 514;
    { const int* BCm = (const int*)(p.ws + WS_BCM); const int bh = tid >> 5, j = tid & 31; int s = 0;
      for (int q = 0; q < 32; ++q) s += BCm[(size_t)(bh * 32 + q) * 32 + j];
      pre[tid + 1] = (s + 255) >> 8; if (tid == 0) pre[0] = 0;
      segt[tid] = (s + 31) & ~31; }
    __syncthreads();
    for (int sft = 1; sft < 512; sft <<= 1) { int v = 0, w = 0; if (tid >= sft) v = pre[tid + 1 - sft]; if ((tid & 31) >= sft) w = segt[tid - sft]; __syncthreads(); pre[tid + 1] += v; if (sft < 32) segt[tid] += w; __syncthreads(); }
    { const int* BCm = (const int*)(p.ws + WS_BCM); const int bh = tid >> 5, j = tid & 31; int s = 0;
      for (int q = 0; q < 32; ++q) s += BCm[(size_t)(bh * 32 + q) * 32 + j];
      const int excl = segt[tid] - ((s + 31) & ~31); __syncthreads(); segt[tid] = excl; }
    __syncthreads();
    const int nun = pre[512];
    for (int pi = blockIdx.x; pi < 512; pi += gridDim.x) {
        const int rnd = pi >> 8, id = pi & 255;
        const int bg = 2 * rnd + (id >> 7), c = rnd ? 127 - (id & 127) : (id & 127); at::nsa_unit(p, bg >> 1, bg & 1, c, lds_raw);
    }
    {
        const int u0 = (int)(((long)blockIdx.x * nun) / gridDim.x), u1 = (int)(((long)(blockIdx.x + 1) * nun) / gridDim.x);
        int prev = -1;
        for (int u = u0; u < u1; ++u) {
            int lo = 0, hi_ = 511;
            while (lo < hi_) { const int mid = (lo + hi_ + 1) >> 1; if (pre[mid] <= u) lo = mid; else hi_ = mid - 1; }
            at::moba_gather_unit(p, lo >> 5, lo & 31, u - pre[lo], segt[lo], lo != prev, lds_raw);
            prev = lo;
        }
    }
}
__device__ __forceinline__ void phase_att2(const Params& p, unsigned char* lds_raw) {
    for (int pi = blockIdx.x; pi < 512; pi += gridDim.x) {
        const int rnd = pi >> 8, id = pi & 255;
        const int bh = 8 * rnd + (id >> 5), qb = rnd ? 31 - (id & 31) : (id & 31); at::moba_self_unit(p, bh >> 3, bh & 7, qb, lds_raw);
    }
}
__device__ __forceinline__ void phase_route(const Params& p, unsigned char* lds_raw) {
    for (int pi = blockIdx.x; pi < 512; pi += gridDim.x) at::moba_route_unit(p, pi >> 8, (pi >> 5) & 7, pi & 31, lds_raw);
}


__device__ __forceinline__ void phase_r2_fast(const Params& p, int l, unsigned char* lds_raw) {
    using namespace at;
    const int tid = otid(), lane = tid & 63, wave = __builtin_amdgcn_readfirstlane(tid >> 6), r32 = lane & 31, hi = lane >> 5;
    const float* mod = (const float*)(p.ws + WS_MOD);
    const bf16_t* XAB = (const bf16_t*)(p.ws + WS_XAB); bf16_t* XN = (bf16_t*)(p.ws + WS_XN); bf16_t* XL = (bf16_t*)(p.ws + WS_XNLO);
    const float* lng = p.in[5] + (size_t)l * D; const float* rw = p.in[15] + (size_t)l * D * NE; const float* rb = p.in[16] + l * NE;
    int* toke = (int*)(p.ws + WS_TOKE); float* tokw = (float*)(p.ws + WS_TOKW); int* BC = (int*)(p.ws + WS_BC);
    lp lds = (lp)lds_raw;
    int* hist = (int*)(lds_raw + 131072);
    for (int blk = blockIdx.x; blk < T / 64; blk += gridDim.x) {
        for (int idx = tid; idx < 128 * 32; idx += NT) {
            const int kc = idx >> 5, e = idx & 31; float v[8];
#pragma unroll
            for (int j = 0; j < 8; ++j) v[j] = rw[(size_t)(8 * kc + j) * NE + e];
            unsigned hh[8], ll[8];
#pragma unroll
            for (int j = 0; j < 8; ++j) { hh[j] = f2bf(v[j]); ll[j] = f2bf(v[j] - __builtin_bit_cast(float, hh[j] << 16)); }
            *(uint4*)(lds_raw + (size_t)idx * 16) = make_uint4(hh[0] | (hh[1] << 16), hh[2] | (hh[3] << 16), hh[4] | (hh[5] << 16), hh[6] | (hh[7] << 16));
            *(uint4*)(lds_raw + 65536 + (size_t)idx * 16) = make_uint4(ll[0] | (ll[1] << 16), ll[2] | (ll[3] << 16), ll[4] | (ll[5] << 16), ll[6] | (ll[7] << 16));
        }
        if (tid < 32) hist[tid] = 0;
        {
            const int b = (blk * 64) / S;
            const float* sh = mod + ((size_t)l * Bn + b) * 6144 + 3 * D; const float* sc = mod + ((size_t)l * Bn + b) * 6144 + 4 * D;
            float4 ga[4], s0v[4];
#pragma unroll
            for (int j = 0; j < 4; ++j) { const int col = 4 * lane + 256 * j; const float4 g = *(const float4*)(lng + col), s1 = *(const float4*)(sc + col); s0v[j] = *(const float4*)(sh + col);
                ga[j] = make_float4(g.x * (1.f + s1.x), g.y * (1.f + s1.y), g.z * (1.f + s1.z), g.w * (1.f + s1.w)); }
#pragma unroll 1
            for (int i0 = 0; i0 < 8; i0 += 4) {
                uint2 q_[4][4];
#pragma unroll
                for (int i = 0; i < 4; ++i)
#pragma unroll
                    for (int j = 0; j < 4; ++j) q_[i][j] = *(const uint2*)(XAB + (size_t)(blk * 64 + wave * 8 + i0 + i) * D + 4 * lane + 256 * j);
                float ss[4];
#pragma unroll
                for (int i = 0; i < 4; ++i) { float s_ = 0.f;
#pragma unroll
                    for (int j = 0; j < 4; ++j) { const float x0 = __builtin_bit_cast(float, q_[i][j].x << 16), x1 = __builtin_bit_cast(float, q_[i][j].x & 0xffff0000u), x2 = __builtin_bit_cast(float, q_[i][j].y << 16), x3 = __builtin_bit_cast(float, q_[i][j].y & 0xffff0000u);
                        s_ += (x0 * x0 + x1 * x1) + (x2 * x2 + x3 * x3); }
                    ss[i] = s_; }
#pragma unroll
                for (int sft = 32; sft >= 1; sft >>= 1) {
#pragma unroll
                    for (int i = 0; i < 4; ++i) ss[i] += __shfl_xor(ss[i], sft); }
#pragma unroll
                for (int i = 0; i < 4; ++i) {
                    const int t = blk * 64 + wave * 8 + i0 + i;
                    const float r = rsqrtf(ss[i] * (1.f / D) + EPS);
#pragma unroll
                    for (int j = 0; j < 4; ++j) {
                        const int col = 4 * lane + 256 * j;
                        const float x0 = __builtin_bit_cast(float, q_[i][j].x << 16), x1 = __builtin_bit_cast(float, q_[i][j].x & 0xffff0000u), x2 = __builtin_bit_cast(float, q_[i][j].y << 16), x3 = __builtin_bit_cast(float, q_[i][j].y & 0xffff0000u);
                        const float o[4] = {x0 * r * ga[j].x + s0v[j].x, x1 * r * ga[j].y + s0v[j].y, x2 * r * ga[j].z + s0v[j].z, x3 * r * ga[j].w + s0v[j].w};
                        unsigned hh[4], ll[4];
#pragma unroll
                        for (int q = 0; q < 4; ++q) { hh[q] = f2bf(o[q]); ll[q] = f2bf(o[q] - __builtin_bit_cast(float, hh[q] << 16)); }
                        *(uint2*)(XN + (size_t)t * D + col) = make_uint2(hh[0] | (hh[1] << 16), hh[2] | (hh[3] << 16));
                        *(uint2*)(XL + (size_t)t * D + col) = make_uint2(ll[0] | (ll[1] << 16), ll[2] | (ll[3] << 16));
                        *(unsigned*)(p.ws + WS_XN8 + (size_t)t * D + col) = pk_fp8x4(o[0] * XS8, o[1] * XS8, o[2] * XS8, o[3] * XS8);
                    }
                }
            }
        }
        asm volatile("s_waitcnt vmcnt(0)" ::: "memory");
        __syncthreads();
        f32x16 acc = f32x16{};
        {
            const int rh = wave & 1, kq = wave >> 1;
            const int t = blk * 64 + rh * 32 + r32;
            const bf16_t* xh = XN + (size_t)t * D + 8 * hi + 256 * kq; const bf16_t* xl = XL + (size_t)t * D + 8 * hi + 256 * kq;
            const AT_LAS unsigned char* wh = lds + (size_t)(hi * 32 + r32) * 16 + (size_t)kq * 16 * 1024; const AT_LAS unsigned char* wl = wh + 65536;
#pragma unroll 8
            for (int ks = 0; ks < 16; ++ks) {
                const bf16x8 bh = *(const bf16x8*)(xh + 16 * ks), bl = *(const bf16x8*)(xl + 16 * ks);
                const bf16x8 ah = *(const AT_LAS bf16x8*)(wh + ks * 1024), al = *(const AT_LAS bf16x8*)(wl + ks * 1024);
                acc = __builtin_amdgcn_mfma_f32_32x32x16_bf16(ah, bh, acc, 0, 0, 0);
                acc = __builtin_amdgcn_mfma_f32_32x32x16_bf16(al, bh, acc, 0, 0, 0);
                acc = __builtin_amdgcn_mfma_f32_32x32x16_bf16(ah, bl, acc, 0, 0, 0);
            }
        }
        __syncthreads();
        { float* part = (float*)lds_raw;
          if (wave >= 2) {
#pragma unroll
              for (int r = 0; r < 16; ++r) part[(wave * 16 + r) * 64 + lane] = acc[r]; } }
        __syncthreads();
        if (wave < 2) {
            const int t = blk * 64 + wave * 32 + r32;
            { const float* part = (const float*)lds_raw;
#pragma unroll
              for (int r = 0; r < 16; ++r) acc[r] = ((acc[r] + part[((wave + 2) * 16 + r) * 64 + lane]) + part[((wave + 4) * 16 + r) * 64 + lane]) + part[((wave + 6) * 16 + r) * 64 + lane]; }
            float a0 = -3e38f, a1 = -3e38f, a2 = -3e38f, a3 = -3e38f; int i0 = 99, i1 = 99, i2 = 99, i3 = 99;
#pragma unroll
            for (int r = 0; r < 16; ++r) { const int e = crow(r, hi); const float s_ = acc[r] + rb[e];
                if (s_ > a0) { a3 = a2; i3 = i2; a2 = a1; i2 = i1; a1 = a0; i1 = i0; a0 = s_; i0 = e; }
                else if (s_ > a1) { a3 = a2; i3 = i2; a2 = a1; i2 = i1; a1 = s_; i1 = e; }
                else if (s_ > a2) { a3 = a2; i3 = i2; a2 = s_; i2 = e; }
                else if (s_ > a3) { a3 = s_; i3 = e; } }
            float ov[4]; int oi[4];
            { const float sv[4] = {a0, a1, a2, a3}; const int si[4] = {i0, i1, i2, i3};
#pragma unroll
              for (int k = 0; k < 4; ++k) { auto a = __builtin_amdgcn_permlane32_swap(__float_as_uint(sv[k]), __float_as_uint(sv[k]), false, false); ov[k] = __uint_as_float(hi ? a[0] : a[1]);
                                            auto c = __builtin_amdgcn_permlane32_swap((unsigned)si[k], (unsigned)si[k], false, false); oi[k] = (int)(hi ? c[0] : c[1]); } }
#pragma unroll
            for (int k = 0; k < 4; ++k) { const float s_ = ov[k]; const int e = oi[k];
                if (s_ > a0 || (s_ == a0 && e < i0)) { a3 = a2; i3 = i2; a2 = a1; i2 = i1; a1 = a0; i1 = i0; a0 = s_; i0 = e; }
                else if (s_ > a1 || (s_ == a1 && e < i1)) { a3 = a2; i3 = i2; a2 = a1; i2 = i1; a1 = s_; i1 = e; }
                else if (s_ > a2 || (s_ == a2 && e < i2)) { a3 = a2; i3 = i2; a2 = s_; i2 = e; }
                else if (s_ > a3 || (s_ == a3 && e < i3)) { a3 = s_; i3 = e; } }
            const float e1 = __expf(a1 - a0), e2 = __expf(a2 - a0), e3 = __expf(a3 - a0), inv = 1.f / (((1.f + e1) + e2) + e3);
            if (hi == 0) {
                *(int4*)(toke + (size_t)t * 4) = make_int4(i0, i1, i2, i3);
                *(float4*)(tokw + (size_t)t * 4) = make_float4(inv, e1 * inv, e2 * inv, e3 * inv);
                atomicAdd(&hist[i0], 1); atomicAdd(&hist[i1], 1); atomicAdd(&hist[i2], 1); atomicAdd(&hist[i3], 1);
            }
        }
        __syncthreads();
        if (tid < 32) BC[blk * 32 + tid] = hist[tid];
        __syncthreads();
    }
}
__device__ __forceinline__ void phase_sc_fast(const Params& p, int l, unsigned char* lds_raw) {
    const int tid = otid();
    const int* BC = (const int*)(p.ws + WS_BC);
    int* cnt = (int*)(p.ws + WS_CNT) + l * 32;
    int* tot = (int*)lds_raw; int* base = tot + 32; int* fillc = tot + 64; int* before = tot + 96;
    const int* toke = (const int*)(p.ws + WS_TOKE); const float* tokw = (const float*)(p.ws + WS_TOKW);
    int* rowtok = (int*)(p.ws + WS_ROWTOK) + (size_t)l * RMAX; float* roww = (float*)(p.ws + WS_ROWW) + (size_t)l * RMAX; int* pos = (int*)(p.ws + WS_POS);
    for (int blk = blockIdx.x; blk < T / 64; blk += gridDim.x) {
        { const int e = tid & 31, part = tid >> 5; int s = 0, bf = 0;
#pragma unroll 4
          for (int i = part * 16; i < part * 16 + 16; ++i) { const int c = BC[i * 32 + e]; s += c; if (i < blk) bf += c; }
          int* ptot = tot + 128; int* pbef = ptot + 512;
          ptot[tid] = s; pbef[tid] = bf; }
        __syncthreads();
        if (tid < 32) { const int* ptot = tot + 128; const int* pbef = ptot + 512; int s = 0, bf = 0;
#pragma unroll
            for (int q = 0; q < 16; ++q) { s += ptot[q * 32 + tid]; bf += pbef[q * 32 + tid]; }
            tot[tid] = s; before[tid] = bf; fillc[tid] = 0; if (blk == 0) cnt[tid] = s; }
        __syncthreads();
        if (tid == 0) { int s = 0; for (int e = 0; e < 32; ++e) { base[e] = s + before[e]; s += (tot[e] + 255) & ~255; } }
        __syncthreads();
        if (tid < 256) {
            const int i = blk * 256 + tid, e = toke[i];
            const int slot = base[e] + atomicAdd(&fillc[e], 1);
            rowtok[slot] = i >> 2; roww[slot] = tokw[i]; pos[i] = slot;
        }
        __syncthreads();
    }
}

#define XB_TMO      128
#define XB_XCNT(j)  (256  + 64 * (j))
#define XB_XSUB(j)  (1280 + 64 * (j))
#define XB_XGEN(j)  (2304 + 64 * (j))
#define XB_TOP      3328
#define XB_TOPGEN   3392
#define XCD_BAR_WORDS 3456
#define XB_SPIN_CAP (1u << 18)
#define XLAS __attribute__((address_space(3)))
__device__ __forceinline__ unsigned xb_ld(unsigned* p)              { return __hip_atomic_load(p, __ATOMIC_RELAXED, __HIP_MEMORY_SCOPE_AGENT); }
__device__ __forceinline__ unsigned xb_add(unsigned* p, unsigned v) { return __hip_atomic_fetch_add(p, v, __ATOMIC_RELAXED, __HIP_MEMORY_SCOPE_AGENT); }
__device__ __forceinline__ unsigned xb_xcc_id() { return (unsigned)__builtin_amdgcn_s_getreg((3 << 11) | 20) & 0xFu; }
#define XB_SPIN(cond, bar) do { unsigned _sp = 0; while (cond) { __builtin_amdgcn_s_sleep(1); \
    if ((++_sp & 255u) == 0u) { if (xb_ld(&(bar)[XB_TMO])) break; if (_sp > XB_SPIN_CAP) { atomicAdd(&(bar)[XB_TMO], 1u); break; } } } } while (0)
constexpr int LDS_BARST_OFF = 147200;
struct XcdBarrier { unsigned* bar; unsigned x; volatile XLAS unsigned* st; };
__device__ __forceinline__ XcdBarrier xcd_barrier_post(unsigned* bar, volatile XLAS unsigned* st) {
    XcdBarrier b; b.bar = bar; b.x = xb_xcc_id(); b.st = st;
    if (threadIdx.x == 0) (void)xb_add(&bar[XB_XCNT(b.x)], 1u);
    return b;
}
__device__ __forceinline__ void xcd_barrier_complete(unsigned* bar, unsigned x, unsigned& nloc, unsigned& nx) {
    const unsigned G = gridDim.x * gridDim.y * gridDim.z;
    unsigned sum, cnt, mine, sp = 0u;
    for (;;) {
        sum = 0u; cnt = 0u; mine = 0u;
#pragma unroll
        for (unsigned j = 0; j < 16; ++j) { const unsigned c = xb_ld(&bar[XB_XCNT(j)]); sum += c; cnt += (c > 0u) ? 1u : 0u; mine = (j == x) ? c : mine; }
        if (sum == G) break;
        __builtin_amdgcn_s_sleep(1);
        if ((++sp & 255u) == 0u) { if (xb_ld(&bar[XB_TMO])) break; if (sp > XB_SPIN_CAP) { atomicAdd(&bar[XB_TMO], 1u); break; } }
    }
    nloc = mine > 0u ? mine : 1u; nx = cnt > 0u ? cnt : 1u;
}
__device__ __forceinline__ void xcd_barrier(unsigned char* ws, unsigned char* lds_raw_) {
    XcdBarrier b; b.bar = (unsigned*)(ws + WS_BAR); b.x = xb_xcc_id(); b.st = (volatile XLAS unsigned*)((XLAS unsigned char*)lds_raw_ + LDS_BARST_OFF);
    asm volatile("s_waitcnt vmcnt(0)" ::: "memory");
    __syncthreads();
    if (threadIdx.x == 0) {
        unsigned* bar = b.bar;
        __builtin_amdgcn_s_waitcnt(0);
        unsigned nloc = b.st[0], nx = b.st[1];
        if (nloc == 0u) { xcd_barrier_complete(bar, b.x, nloc, nx); b.st[0] = nloc; b.st[1] = nx; }
        const unsigned old = xb_add(&bar[XB_XSUB(b.x)], 1u);
        const unsigned gen = old / nloc;
        if (old + 1u == (gen + 1u) * nloc) {
            __builtin_amdgcn_fence(__ATOMIC_RELEASE, "agent");
            asm volatile("s_waitcnt vmcnt(0)" ::: "memory");
            const unsigned og = xb_add(&bar[XB_TOP], 1u);
            const unsigned tg = og / nx;
            if (og + 1u == (tg + 1u) * nx) xb_add(&bar[XB_TOPGEN], 1u);
            else XB_SPIN(xb_ld(&bar[XB_TOPGEN]) == tg, bar);
            __builtin_amdgcn_fence(__ATOMIC_ACQUIRE, "agent");
            xb_add(&bar[XB_XGEN(b.x)], 1u);
            asm volatile("s_waitcnt vmcnt(0)" ::: "memory");
        } else {
            XB_SPIN(xb_ld(&bar[XB_XGEN(b.x)]) == gen, bar);
            __builtin_amdgcn_fence(__ATOMIC_ACQUIRE, "agent");
            asm volatile("s_waitcnt vmcnt(0)" ::: "memory");
        }
    }
    __syncthreads();
}

__global__ void __launch_bounds__(NT, 2) mega_fwd(Params p) {
    extern __shared__ __attribute__((aligned(16))) unsigned char lds_raw[];
    float* lds = (float*)lds_raw;
    volatile XLAS unsigned* bst = (volatile XLAS unsigned*)((XLAS unsigned char*)lds_raw + LDS_BARST_OFF);
    if (threadIdx.x < 2) bst[threadIdx.x] = 0u;
    __syncthreads();
    (void)xcd_barrier_post((unsigned*)(p.ws + WS_BAR), bst);
#define GSYNC() xcd_barrier(p.ws, lds_raw)
    phase_p0a(p, lds);
    __syncthreads();
    phase_convert(p, lds);
    GSYNC();
    phase_p0b(p);
    GSYNC();
    _Pragma("unroll 1") for (int l = 0; l < L; ++l) {
        phase_r1(p, l, true);
        GSYNC();
        phase_g1_fast(p, l, lds_raw);
        GSYNC();
        phase_ck_fast(p, l, lds_raw);
        GSYNC();
        phase_c2(p, l, lds);
        __syncthreads();
        phase_route(p, lds_raw);
        GSYNC();
        phase_att1(p, lds_raw);
        GSYNC();
        phase_att2(p, lds_raw);
        GSYNC();
        phase_g2_fast(p, l, lds_raw);
        GSYNC();
        phase_r2_fast(p, l, lds_raw);
        GSYNC();
        phase_sc_fast(p, l, lds_raw);
        GSYNC();
        phase_m1_fast(p, l, lds_raw);
        GSYNC();
        phase_m2_fast(p, l, lds_raw);
        GSYNC();
    }
    phase_r1(p, L, false);
}

extern "C" void kernel_launch(void* const* d_in, const int* in_sizes, int n_in, void* d_out, int out_size, void* d_ws, size_t ws_size, hipStream_t stream) {
    static int grid_blocks = 0;
    if (grid_blocks == 0) {
        if (n_in != 21 || out_size != T * D || ws_size < WS_END) { fprintf(stderr, "kernel_launch: unexpected shapes (n_in %d out %d ws %zu need %zu)\n", n_in, out_size, ws_size, (size_t)WS_END); grid_blocks = -1; return; }
        int dev = 0, cus = 0, per_cu = 0;
        hipGetDevice(&dev);
        hipDeviceGetAttribute(&cus, hipDeviceAttributeMultiprocessorCount, dev);
        hipFuncSetAttribute((const void*)mega_fwd, hipFuncAttributeMaxDynamicSharedMemorySize, LDS_BYTES);
        hipOccupancyMaxActiveBlocksPerMultiprocessor(&per_cu, (const void*)mega_fwd, NT, LDS_BYTES);
        if (per_cu < 1) { fprintf(stderr, "kernel_launch: occupancy query says %d blocks per CU\n", per_cu); per_cu = 1; }
        (void)hipGetLastError();
        grid_blocks = cus * 1;
    }
    if (grid_blocks < 0) return;
    if (hipMemsetAsync((char*)d_ws + WS_BAR, 0, 16384, stream) != hipSuccess) { fprintf(stderr, "kernel_launch: memset failed\n"); return; }
    Params p{};
    for (int i = 0; i < 21; ++i) p.in[i] = (const float*)d_in[i];
    p.out = (float*)d_out; p.ws = (unsigned char*)d_ws;
    hipLaunchKernelGGL(mega_fwd, dim3(grid_blocks), dim3(NT), LDS_BYTES, stream, p);
    hipError_t e = hipPeekAtLastError();
    if (e != hipSuccess) fprintf(stderr, "launch failed: %s (grid %d)\n", hipGetErrorString(e), grid_blocks);
}
```

```cpp
#include <hip/hip_runtime.h>
#include <cstdio>
#include <cstdint>

constexpr int Bn = 2, S = 8192, D = 1024, L = 2, T = Bn * S;
constexpr int INW = 2840;
constexpr int NE = 32, TOPK = 4, DFF = 1024;
constexpr int A_TOT = T * TOPK;
constexpr int RMAX = A_TOT + NE * 256;
constexpr int NCMP = 511;
constexpr int NT = 512;
constexpr int NW = NT / 64;
constexpr int LDS_BYTES = 147456;
constexpr float EPS = 1e-6f;
constexpr float NEGF = -1e30f;

constexpr int ZBW = 3072;
constexpr int ZB_Q = 0, ZB_KC = 512, ZB_VC = 640, ZB_KS = 768, ZB_VS = 896, ZB_KW = 1024, ZB_VW = 1152, ZB_MQ = 1280, ZB_MK = 1792, ZB_MV = 2304, ZB_G = 2816;
constexpr float QSCALE = 0.125f * 1.4426950408889634f;
constexpr float LOG2E = 1.4426950408889634f;

constexpr size_t al256(size_t x) { return (x + 255) & ~(size_t)255; }
constexpr size_t WS_BAR = 0;
constexpr size_t WS_MODP = 16384;
constexpr size_t WS_MOD = al256(WS_MODP + (size_t)8 * L * Bn * 6144 * 4);
constexpr size_t WS_CNT = al256(WS_MOD + (size_t)L * Bn * 6144 * 4);
constexpr size_t WS_ROWTOK = al256(WS_CNT + L * 32 * 4);
constexpr size_t WS_ROWW = al256(WS_ROWTOK + (size_t)L * RMAX * 4);
constexpr size_t WS_TOKE = al256(WS_ROWW + (size_t)L * RMAX * 4);
constexpr size_t WS_TOKW = al256(WS_TOKE + (size_t)T * 4 * 4);
constexpr size_t WS_POS = al256(WS_TOKW + (size_t)T * 4 * 4);
constexpr size_t WS_Y = al256(WS_POS + (size_t)T * 4 * 4);
constexpr size_t WS_WINT = al256(WS_Y + (size_t)RMAX * 1024 * 4);
constexpr size_t WS_WOT = al256(WS_WINT + (size_t)L * 3072 * 1024 * 2);
constexpr size_t WS_W1T = al256(WS_WOT + (size_t)L * 1024 * 1024 * 2);
constexpr size_t WS_W2T = al256(WS_W1T + (size_t)L * NE * 2048 * 1024 * 2);
constexpr size_t WS_XN = al256(WS_W2T + (size_t)L * NE * 1024 * 1024 * 2);
constexpr size_t WS_ATTB = al256(WS_XN + (size_t)(T + 1) * D * 2);
constexpr size_t WS_ACT = al256(WS_ATTB + (size_t)T * D * 2);
constexpr size_t WS_ZB = al256(WS_ACT + (size_t)RMAX * DFF * 2);
constexpr size_t WS_GATE = al256(WS_ZB + (size_t)T * ZBW * 2);
constexpr size_t WS_KCB = al256(WS_GATE + (size_t)T * 32 * 4);
constexpr size_t WS_VCB = al256(WS_KCB + (size_t)Bn * 2 * 512 * 64 * 2);
constexpr size_t WS_KMB = al256(WS_VCB + (size_t)Bn * 2 * 512 * 64 * 2);
constexpr size_t WS_XNLO = al256(WS_KMB + (size_t)Bn * 8 * 32 * 64 * 2);
constexpr size_t WS_BC = al256(WS_XNLO + (size_t)T * D * 2);
constexpr size_t WS_WCT = al256(WS_BC + (size_t)(T / 64) * 32 * 4);
constexpr size_t WS_CBP = al256(WS_WCT + (size_t)L * 2 * 128 * 2048 * 2);
constexpr size_t WS_CB = al256(WS_CBP + (size_t)16 * L * 2 * 128 * 4);
constexpr size_t WS_HIDP = al256(WS_CB + (size_t)L * 2 * 128 * 4);
constexpr size_t WS_XAB = al256(WS_HIDP + (size_t)4 * 2 * 2044 * 128 * 4);
constexpr size_t WS_SEL3 = al256(WS_XAB + (size_t)T * D * 2);
constexpr size_t WS_LRK = al256(WS_SEL3 + (size_t)T * 8 * 4);
constexpr size_t WS_ILIST = al256(WS_LRK + (size_t)T * 8 * 4);
constexpr size_t WS_BCM = al256(WS_ILIST + (size_t)16 * 32 * 32 * 256);
constexpr size_t WS_PM = al256(WS_BCM + (size_t)16 * 32 * 32 * 4);
constexpr size_t WS_PL = al256(WS_PM + (size_t)16 * 25600 * 4);
constexpr size_t WS_PO = al256(WS_PL + (size_t)16 * 25600 * 4);
constexpr size_t WS_XN8 = al256(WS_PO + (size_t)16 * 25600 * 64 * 2);
constexpr size_t WS_DQ1 = al256(WS_XN8 + (size_t)(T + 1) * D);
constexpr size_t WS_DQ2 = al256(WS_DQ1 + (size_t)L * NE * 2048 * 4);
constexpr size_t WS_END = al256(WS_DQ2 + (size_t)L * NE * 1024 * 4);
constexpr float XS8 = 16.f, AS8 = 8.f;

struct Params {
    const float* in[21];
    float* out;
    unsigned char* ws;
};

__device__ __forceinline__ int otid() { int t = threadIdx.x; asm volatile("" : "+v"(t)); return t; }
typedef unsigned short bf16_t;
__device__ __forceinline__ unsigned f2bf(float f) { unsigned u = __builtin_bit_cast(unsigned, f); return (u + 0x7fffu + ((u >> 16) & 1u)) >> 16; }
__device__ __forceinline__ unsigned pk2(float lo, float hi) { return f2bf(lo) | (f2bf(hi) << 16); }
__device__ __forceinline__ unsigned pk_fp8x4(float a, float b, float c, float d) {
    a = __builtin_amdgcn_fmed3f(a, -448.f, 448.f); b = __builtin_amdgcn_fmed3f(b, -448.f, 448.f); c = __builtin_amdgcn_fmed3f(c, -448.f, 448.f); d = __builtin_amdgcn_fmed3f(d, -448.f, 448.f);
    int r = __builtin_amdgcn_cvt_pk_fp8_f32(a, b, 0, false);
    r = __builtin_amdgcn_cvt_pk_fp8_f32(c, d, r, true);
    return (unsigned)r; }
__device__ __forceinline__ float bf2f(bf16_t v) { return __builtin_bit_cast(float, (unsigned)v << 16); }
__device__ __forceinline__ float wave_sum(float v) {
#pragma unroll
    for (int o = 1; o < 64; o <<= 1) v += __shfl_xor(v, o);
    return v;
}
__device__ __forceinline__ float sigmoidf_(float x) { return 1.f / (1.f + __expf(-x)); }
__device__ __forceinline__ float gelu_tanh(float x) {
    const float u = 0.7978845608028654f * (x + 0.044715f * x * x * x);
    return 0.5f * x * (1.f + tanhf(u));
}

__device__ __forceinline__ void phase_p0a(const Params& p, float* lds) {
    const int tid = otid(), gtid = blockIdx.x * NT + tid, gsz = gridDim.x * NT;
    int* cnt = (int*)(p.ws + WS_CNT); int* rowtok = (int*)(p.ws + WS_ROWTOK);
    for (int i = gtid; i < L * 32; i += gsz) cnt[i] = 0;
    for (int i = gtid; i < L * RMAX; i += gsz) rowtok[i] = -1;
    const float* c = p.in[1];
    for (int i = tid; i < Bn * D; i += NT) { const float v = c[i]; lds[i] = v / (1.f + __expf(-v)); }
    __syncthreads();
    const float* ada_w = p.in[2];
    float* modp = (float*)(p.ws + WS_MODP);
    for (int idx = gtid; idx < 8 * L * 6144; idx += gsz) {
        const int col = idx % 6144, l = (idx / 6144) % L, kc = idx / (6144 * L);
        const float* w = ada_w + ((size_t)l * D + kc * 128) * 6144 + col;
        float a0 = 0.f, a1 = 0.f, c0 = 0.f, c1 = 0.f;
#pragma unroll 1
        for (int k0 = 0; k0 < 128; k0 += 32) { float wv[32];
#pragma unroll
            for (int k = 0; k < 32; ++k) wv[k] = __builtin_nontemporal_load(w + (size_t)(k0 + k) * 6144);
#pragma unroll
            for (int k = 0; k < 32; k += 2) { a0 += lds[kc * 128 + k0 + k] * wv[k]; a1 += lds[D + kc * 128 + k0 + k] * wv[k]; c0 += lds[kc * 128 + k0 + k + 1] * wv[k + 1]; c1 += lds[D + kc * 128 + k0 + k + 1] * wv[k + 1]; } }
        modp[((size_t)(kc * L + l) * Bn + 0) * 6144 + col] = a0 + c0;
        modp[((size_t)(kc * L + l) * Bn + 1) * 6144 + col] = a1 + c1;
    }
    { const float* posw = p.in[9]; const float* w1c = p.in[10]; float* cbp = (float*)(p.ws + WS_CBP);
      int first = 8 * L * 6144; if (first + 16 * L * 2 * 128 > gsz) first = 0;
      for (int idx = gtid - first; idx < 16 * L * 2 * 128; idx += gsz) { if (idx < 0) continue;
          const int j = idx & 127, li = (idx >> 7) % (L * 2), kc = idx / (L * 2 * 128);
          const float* w = w1c + ((size_t)li * 2048 + kc * 128) * 128 + j; const float* pp = posw + (size_t)li * 2048 + kc * 128;
          float a = 0.f, c_ = 0.f;
#pragma unroll 1
          for (int k0 = 0; k0 < 128; k0 += 32) { float wv[32];
#pragma unroll
              for (int k = 0; k < 32; ++k) wv[k] = w[(size_t)(k0 + k) * 128];
#pragma unroll
              for (int k = 0; k < 32; k += 2) { a += pp[k0 + k] * wv[k]; c_ += pp[k0 + k + 1] * wv[k + 1]; } }
          cbp[idx] = a + c_; } }
}
__device__ __forceinline__ void phase_p0b(const Params& p) {
    const int gtid = blockIdx.x * NT + otid(), gsz = gridDim.x * NT;
    { const float* cbp = (const float*)(p.ws + WS_CBP); float* cb = (float*)(p.ws + WS_CB);
      for (int idx = gtid; idx < L * 2 * 128; idx += gsz) { float s = 0.f;
#pragma unroll
          for (int kc = 0; kc < 16; ++kc) s += cbp[kc * (L * 2 * 128) + idx];
          cb[idx] = s; } }
    const float* modp = (const float*)(p.ws + WS_MODP); float* mod = (float*)(p.ws + WS_MOD); const float* ada_b = p.in[3];
    for (int idx = gtid; idx < L * Bn * 6144; idx += gsz) {
        const int col = idx % 6144, l = idx / (Bn * 6144);
        float s = ada_b[l * 6144 + col];
#pragma unroll
        for (int kc = 0; kc < 8; ++kc) s += modp[(size_t)kc * L * Bn * 6144 + idx];
        mod[idx] = s;
    }
}

__device__ __forceinline__ void phase_r1(const Params& p, int l, bool do_h) {
    const int lane = otid() & 63, wave = otid() >> 6;
    const int gw = blockIdx.x * NW + wave, ngw = gridDim.x * NW;
    const float* mod = (const float*)(p.ws + WS_MOD);
    const float* xin = p.in[0]; float* XA = p.out;
    const bf16_t* Y = (const bf16_t*)(p.ws + WS_Y); const int* pos = (const int*)(p.ws + WS_POS); const float* tokw = (const float*)(p.ws + WS_TOKW);
    const float* lng = p.in[4] + (size_t)(do_h ? l : 0) * D;
    bf16_t* XN = (bf16_t*)(p.ws + WS_XN); bf16_t* XAB = (bf16_t*)(p.ws + WS_XAB);
#define BF4(q) make_float4(__builtin_bit_cast(float, (q).x << 16), __builtin_bit_cast(float, (q).x & 0xffff0000u), __builtin_bit_cast(float, (q).y << 16), __builtin_bit_cast(float, (q).y & 0xffff0000u))
    int curb = -1; float4 g2v[4], ga[4], s0v[4];
    for (int t0 = gw; t0 < T; t0 += ngw) {
        const int nr = 1;
        float4 v[2][4];
        if (l == 0) {
#pragma unroll
            for (int i = 0; i < 2; ++i) if (i < nr) {
#pragma unroll
                for (int j = 0; j < 4; ++j) v[i][j] = *(const float4*)(xin + (size_t)(t0 + i * ngw) * D + 4 * lane + 256 * j); }
        } else {
            int4 ps[2]; float4 tw[2]; uint2 xq[2][4];
#pragma unroll
            for (int i = 0; i < 2; ++i) if (i < nr) { const int t = t0 + i * ngw; ps[i] = *(const int4*)(pos + (size_t)t * 4); tw[i] = *(const float4*)(tokw + (size_t)t * 4);
#pragma unroll
                for (int j = 0; j < 4; ++j) xq[i][j] = *(const uint2*)(XAB + (size_t)t * D + 4 * lane + 256 * j); }
            uint2 yq[2][4][4];
#pragma unroll
            for (int i = 0; i < 2; ++i) if (i < nr) {
#pragma unroll
                for (int j = 0; j < 4; ++j) { const int col = 4 * lane + 256 * j;
                    yq[i][j][0] = *(const uint2*)(Y + (size_t)ps[i].x * D + col); yq[i][j][1] = *(const uint2*)(Y + (size_t)ps[i].y * D + col);
                    yq[i][j][2] = *(const uint2*)(Y + (size_t)ps[i].z * D + col); yq[i][j][3] = *(const uint2*)(Y + (size_t)ps[i].w * D + col); } }
#pragma unroll
            for (int i = 0; i < 2; ++i) if (i < nr) {
                const int t = t0 + i * ngw, b = t / S;
                if (b != curb) { curb = b;
                    const float* g2 = mod + ((size_t)(l - 1) * Bn + b) * 6144 + 5 * D;
#pragma unroll
                    for (int j = 0; j < 4; ++j) g2v[j] = *(const float4*)(g2 + 4 * lane + 256 * j);
                    if (do_h) { const float* sh = mod + ((size_t)l * Bn + b) * 6144 + 0 * D; const float* sc = mod + ((size_t)l * Bn + b) * 6144 + 1 * D;
#pragma unroll
                        for (int j = 0; j < 4; ++j) { const int col = 4 * lane + 256 * j; const float4 g = *(const float4*)(lng + col), s1 = *(const float4*)(sc + col); s0v[j] = *(const float4*)(sh + col);
                            ga[j] = make_float4(g.x * (1.f + s1.x), g.y * (1.f + s1.y), g.z * (1.f + s1.z), g.w * (1.f + s1.w)); } } }
#pragma unroll
                for (int j = 0; j < 4; ++j) {
                    const int col = 4 * lane + 256 * j;
                    const float4 x = BF4(xq[i][j]);
                    const float4 y0 = BF4(yq[i][j][0]), y1 = BF4(yq[i][j][1]), y2 = BF4(yq[i][j][2]), y3 = BF4(yq[i][j][3]);
                    const float4 g = g2v[j];
                    float4 r;
                    r.x = x.x + g.x * (((tw[i].x * y0.x + tw[i].y * y1.x) + tw[i].z * y2.x) + tw[i].w * y3.x); r.y = x.y + g.y * (((tw[i].x * y0.y + tw[i].y * y1.y) + tw[i].z * y2.y) + tw[i].w * y3.y);
                    r.z = x.z + g.z * (((tw[i].x * y0.z + tw[i].y * y1.z) + tw[i].z * y2.z) + tw[i].w * y3.z); r.w = x.w + g.w * (((tw[i].x * y0.w + tw[i].y * y1.w) + tw[i].z * y2.w) + tw[i].w * y3.w);
                    v[i][j] = r;
                    if (do_h) *(uint2*)(XAB + (size_t)t * D + col) = make_uint2(pk2(r.x, r.y), pk2(r.z, r.w));
                    else *(float4*)(XA + (size_t)t * D + col) = r;
                }
            }
        }
        if (do_h) {
#pragma unroll
            for (int i = 0; i < 2; ++i) if (i < nr) {
                const int t = t0 + i * ngw, b = t / S;
                if (b != curb) { curb = b;
                    const float* sh = mod + ((size_t)l * Bn + b) * 6144 + 0 * D; const float* sc = mod + ((size_t)l * Bn + b) * 6144 + 1 * D;
#pragma unroll
                    for (int j = 0; j < 4; ++j) { const int col = 4 * lane + 256 * j; const float4 g = *(const float4*)(lng + col), s1 = *(const float4*)(sc + col); s0v[j] = *(const float4*)(sh + col);
                        ga[j] = make_float4(g.x * (1.f + s1.x), g.y * (1.f + s1.y), g.z * (1.f + s1.z), g.w * (1.f + s1.w)); } }
                float ss = 0.f;
#pragma unroll
                for (int j = 0; j < 4; ++j) ss += (v[i][j].x * v[i][j].x + v[i][j].y * v[i][j].y) + (v[i][j].z * v[i][j].z + v[i][j].w * v[i][j].w);
                ss = wave_sum(ss);
                const float r = rsqrtf(ss * (1.f / D) + EPS);
#pragma unroll
                for (int j = 0; j < 4; ++j) {
                    const int col = 4 * lane + 256 * j;
                    float4 o;
                    o.x = v[i][j].x * r * ga[j].x + s0v[j].x; o.y = v[i][j].y * r * ga[j].y + s0v[j].y;
                    o.z = v[i][j].z * r * ga[j].z + s0v[j].z; o.w = v[i][j].w * r * ga[j].w + s0v[j].w;
                    *(uint2*)(XN + (size_t)t * D + col) = make_uint2(pk2(o.x, o.y), pk2(o.z, o.w));
                }
            }
        }
    }
#undef BF4
}


__device__ __forceinline__ void phase_c2(const Params& p, int l, float* lds) {
    const int lane = otid() & 63, wave = otid() >> 6;
    const float* HIDP = (const float*)(p.ws + WS_HIDP); const float* cb = (const float*)(p.ws + WS_CB) + l * 2 * 128; const float* w2 = p.in[11] + (size_t)l * 2 * 128 * 64;
    const float gk = p.in[8][l * 64 + lane];
    float* hl = lds + wave * 128;
    for (int r = blockIdx.x * NW + wave; r < 2 * 2044; r += gridDim.x * NW) {
        const int idx = r / 2044, rr = r % 2044;
#pragma unroll
        for (int q = 0; q < 2; ++q) { const int j = lane + 64 * q; float s = cb[idx * 128 + j];
#pragma unroll
            for (int kq = 0; kq < 4; ++kq) s += HIDP[((size_t)(kq * 2 + idx) * 2044 + rr) * 128 + j];
            hl[j] = gelu_tanh(s); }
        asm volatile("s_waitcnt lgkmcnt(0)" ::: "memory"); __builtin_amdgcn_wave_barrier();
        const float* W = w2 + (size_t)idx * 128 * 64;
        float s = 0.f;
#pragma unroll 8
        for (int j = 0; j < 128; ++j) s += hl[j] * W[j * 64 + lane];
        asm volatile("s_waitcnt lgkmcnt(0)" ::: "memory"); __builtin_amdgcn_wave_barrier();
        const int bgi = rr / 511, n = rr % 511;
        if (idx == 0) { const float ss = wave_sum(s * s); const float kv = s * rsqrtf(ss * (1.f / 64.f) + EPS) * gk; ((bf16_t*)(p.ws + WS_KCB))[((size_t)bgi * 512 + n) * 64 + lane] = (bf16_t)f2bf(kv); }
        else { ((bf16_t*)(p.ws + WS_VCB))[((size_t)bgi * 512 + n) * 64 + lane] = (bf16_t)f2bf(s); }
    }
    if (blockIdx.x == 0 && otid() < 2 * 4 * 64) { const int i = otid(); bf16_t* dst = (bf16_t*)(p.ws + (i < 256 ? WS_KCB : WS_VCB)); dst[((size_t)((i & 255) >> 6) * 512 + 511) * 64 + (i & 63)] = 0; }
}

__device__ __forceinline__ void load_pstart(const Params& p, int l, int* ps) {
    const int* cnt = (const int*)(p.ws + WS_CNT) + l * 32;
    if (otid() == 0) { int s = 0; for (int e = 0; e < 32; ++e) { ps[e] = s; s += (cnt[e] + 255) & ~255; } ps[32] = s; }
    __syncthreads();
}


template <int MAP>
__device__ __forceinline__ void tr_tile(const float* W, int Nsrc, bf16_t* WT, int K, int k0, int n0, float* scr, int lane) {
    const int nl = (lane & 15) * 4, kr = lane >> 4;
    int sc = n0 + nl;
    if (MAP == 1) { sc = sc < 1280 ? sc : (sc < 2816 ? sc + 24 : (sc < 2840 ? sc - 2816 + 1280 : -1)); }
    float4 v[16];
#pragma unroll
    for (int it = 0; it < 16; ++it) { if (sc >= 0) { const float* src_ = W + (size_t)(k0 + it * 4 + kr) * Nsrc + sc; typedef float f4v __attribute__((ext_vector_type(4))); const f4v t_ = __builtin_nontemporal_load((const f4v*)src_); v[it] = make_float4(t_[0], t_[1], t_[2], t_[3]); } else v[it] = make_float4(0.f, 0.f, 0.f, 0.f); }
#pragma unroll
    for (int it = 0; it < 16; ++it) { float* s = scr + (it * 4 + kr) * 65 + nl; s[0] = v[it].x; s[1] = v[it].y; s[2] = v[it].z; s[3] = v[it].w; }
    asm volatile("s_waitcnt lgkmcnt(0)" ::: "memory"); __builtin_amdgcn_wave_barrier();
    const int c = lane & 7, nr = lane >> 3;
#pragma unroll
    for (int it = 0; it < 8; ++it) {
        const int n = it * 8 + nr; const float* s = scr + (8 * c) * 65 + n;
        uint4 o; o.x = pk2(s[0], s[65]); o.y = pk2(s[2 * 65], s[3 * 65]); o.z = pk2(s[4 * 65], s[5 * 65]); o.w = pk2(s[6 * 65], s[7 * 65]);
        *(uint4*)(WT + (size_t)(n0 + n) * K + k0 + 8 * c) = o;
    }
    asm volatile("s_waitcnt lgkmcnt(0)" ::: "memory"); __builtin_amdgcn_wave_barrier();
}
__device__ __forceinline__ void phase_convert(const Params& p, float* lds) {
    const int tid = otid(), lane = tid & 63, wave = tid >> 6;
    float* scr = lds + wave * (64 * 65);
    const int gw = blockIdx.x * NW + wave, ngw = gridDim.x * NW;
    bf16_t* WinT = (bf16_t*)(p.ws + WS_WINT); bf16_t* WoT = (bf16_t*)(p.ws + WS_WOT);
    constexpr int I_IN = L * 16 * (ZBW / 64), I_O = L * 16 * 16, I_C = L * 2 * 32 * 2;
    { float* cm = lds + NW * (64 * 65);
      constexpr int S1 = L * NE * 32, S2 = L * NE * 16;
      for (int s = blockIdx.x; s < S1 + S2; s += gridDim.x) {
          const bool is1 = s < S1; const int q = is1 ? s : s - S1;
          const int le = is1 ? (q >> 5) : (q >> 4), nb = is1 ? (q & 31) : (q & 15), Nsrc = is1 ? 2048 : 1024;
          const float* W = (is1 ? p.in[17] : p.in[19]) + (size_t)le * 1024 * Nsrc;
          unsigned char* WT8 = p.ws + (is1 ? WS_W1T : WS_W2T) + (size_t)le * Nsrc * 1024;
          float* DQ = (float*)(p.ws + (is1 ? WS_DQ1 : WS_DQ2)) + (size_t)le * Nsrc;
          const int n0 = nb * 64, nl = (lane & 15) * 4, kr = lane >> 4, k0 = wave * 128;
          typedef float f4v __attribute__((ext_vector_type(4)));
          f4v va[16], vb[16];
#pragma unroll
          for (int it = 0; it < 16; ++it) { va[it] = __builtin_nontemporal_load((const f4v*)(W + (size_t)(k0 + it * 4 + kr) * Nsrc + n0 + nl));
                                            vb[it] = __builtin_nontemporal_load((const f4v*)(W + (size_t)(k0 + 64 + it * 4 + kr) * Nsrc + n0 + nl)); }
          float m[4] = {0.f, 0.f, 0.f, 0.f};
#pragma unroll
          for (int it = 0; it < 16; ++it)
#pragma unroll
              for (int j = 0; j < 4; ++j) m[j] = __builtin_fmaxf(m[j], __builtin_fmaxf(__builtin_fabsf(va[it][j]), __builtin_fabsf(vb[it][j])));
#pragma unroll
          for (int j = 0; j < 4; ++j) { m[j] = __builtin_fmaxf(m[j], __shfl_xor(m[j], 16)); m[j] = __builtin_fmaxf(m[j], __shfl_xor(m[j], 32)); }
          if (kr == 0) {
#pragma unroll
              for (int j = 0; j < 4; ++j) cm[wave * 64 + nl + j] = m[j]; }
          __syncthreads();
          float sc[4];
#pragma unroll
          for (int j = 0; j < 4; ++j) { float a = cm[nl + j];
#pragma unroll
              for (int w = 1; w < NW; ++w) a = __builtin_fmaxf(a, cm[w * 64 + nl + j]);
              sc[j] = a > 0.f ? 448.f / a : 0.f;
              if (wave == 0 && kr == 0) DQ[n0 + nl + j] = a * (1.f / 448.f); }
#pragma unroll
          for (int half = 0; half < 2; ++half) {
#pragma unroll
              for (int it = 0; it < 16; ++it) { const f4v v = half ? vb[it] : va[it]; float* d = scr + (it * 4 + kr) * 65 + nl; d[0] = v[0] * sc[0]; d[1] = v[1] * sc[1]; d[2] = v[2] * sc[2]; d[3] = v[3] * sc[3]; }
              asm volatile("s_waitcnt lgkmcnt(0)" ::: "memory"); __builtin_amdgcn_wave_barrier();
              const int c = lane & 7, nr = lane >> 3;
#pragma unroll
              for (int it = 0; it < 8; ++it) { const int n = it * 8 + nr; const float* sp = scr + (8 * c) * 65 + n;
                  uint2 o; o.x = pk_fp8x4(sp[0], sp[65], sp[2 * 65], sp[3 * 65]); o.y = pk_fp8x4(sp[4 * 65], sp[5 * 65], sp[6 * 65], sp[7 * 65]);
                  *(uint2*)(WT8 + (size_t)(n0 + n) * 1024 + k0 + half * 64 + 8 * c) = o; }
              asm volatile("s_waitcnt lgkmcnt(0)" ::: "memory"); __builtin_amdgcn_wave_barrier();
          }
          __syncthreads();
      } }
    for (int it = gw; it < I_C + I_IN + I_O; it += ngw) {
        int r = it;
        if (r < I_C) { const int li = r / 64, q = r % 64, kb = q / 2, nb = q % 2;
            tr_tile<0>(p.in[10] + (size_t)li * 2048 * 128, 128, (bf16_t*)(p.ws + WS_WCT) + (size_t)li * 128 * 2048, 2048, kb * 64, nb * 64, scr, lane); continue; }
        r -= I_C;
        if (r < I_IN) { const int l = r / (16 * 48), q = r % (16 * 48), kb = q / 48, nb = q % 48;
            tr_tile<1>(p.in[6] + (size_t)l * D * INW, INW, WinT + (size_t)l * ZBW * D, D, kb * 64, nb * 64, scr, lane); continue; }
        r -= I_IN;
        { const int l = r / 256, q = r % 256, kb = q / 16, nb = q % 16;
            tr_tile<0>(p.in[14] + (size_t)l * D * D, D, WoT + (size_t)l * D * D, D, kb * 64, nb * 64, scr, lane); }
    }
    if (blockIdx.x == 0) { bf16_t* XN = (bf16_t*)(p.ws + WS_XN); for (int i = tid; i < D / 2; i += NT) ((unsigned*)(XN + (size_t)T * D))[i] = 0u;
                           for (int i = tid; i < D / 4; i += NT) ((unsigned*)(p.ws + WS_XN8 + (size_t)T * D))[i] = 0u; }
}

namespace pg8 {
#define PG8_LAS __attribute__((address_space(3)))
typedef short bf16x8 __attribute__((ext_vector_type(8)));
typedef float f32x4 __attribute__((ext_vector_type(4)));
typedef unsigned u32x4 __attribute__((ext_vector_type(4)));
typedef long l64x2 __attribute__((ext_vector_type(2)));
typedef int i32x4 __attribute__((ext_vector_type(4)));
typedef int i32x8 __attribute__((ext_vector_type(8)));
constexpr int BM = 256, BK = 64, HALF = 128, HTB = HALF * BK * 2, STAGE_BYTES = 8 * HTB, NXCD = 8, WGM = 8;
__device__ __forceinline__ int lds_byte(int r, int c) { const int st = (r >> 4) * 2 + (c >> 5), rr = r & 15, cc = c & 31, ob = rr * 64 + cc * 2; return st * 1024 + (ob ^ (((ob >> 9) & 1) << 5)); }
__device__ __forceinline__ void stage_rc(int b, int& R, int& C) { const int st = b / 1024, sb = b % 1024, swz = sb ^ (((sb >> 9) & 1) << 5); R = (st >> 1) * 16 + swz / 64; C = (st & 1) * 32 + (swz % 64) / 2; }
__device__ __forceinline__ int perm32(int rho) { const int n = rho >> 4, i = rho & 15; return 8 * (i >> 2) + 4 * n + (i & 3); }
struct Unit { int pm, pn, e; };
__device__ __forceinline__ unsigned cvt_pk_bf16(float lo, float hi) { unsigned r; asm volatile("v_cvt_pk_bf16_f32 %0, %1, %2" : "=v"(r) : "v"(lo), "v"(hi)); return r; }

__device__ __forceinline__ bool static_next(int nM, int nN, int G, int c, int i, Unit& u) {
    const int nwg = nM * nN; const long Lq = (long)i * G + c; if (Lq >= nwg) return false;
    int wgid = (int)Lq; { const int q = nwg / NXCD, r = nwg % NXCD, xcd = wgid % NXCD, off = wgid / NXCD; wgid = (xcd < r ? xcd * (q + 1) : r * (q + 1) + (xcd - r) * q) + off; }
    const int nig = WGM * nN, gid = wgid / nig, fm = gid * WGM, gsz = (nM - fm) < WGM ? (nM - fm) : WGM;
    u.pm = fm + ((wgid % nig) % gsz); u.pn = (wgid % nig) / gsz; u.e = 0; return true;
}

template <class Prob, class Epi, bool ALIGN_EPI, bool SP2>
__device__ __forceinline__ void gemm_phase(PG8_LAS unsigned char* lds, const Prob& P, const Epi& E) {
    const int tid = otid(), wid = __builtin_amdgcn_readfirstlane(tid >> 6), lane = tid & 63, wr = wid >> 2, wc = wid & 3, fr = lane & 15, fq = lane >> 4;
    const int K = P.K, nt = Prob::KT > 0 ? Prob::KT : K / BK;
    int sR[2], sC[2]; unsigned voffB[2];
#pragma unroll
    for (int i = 0; i < 2; ++i) { stage_rc(tid * 16 + i * 8192, sR[i], sC[i]); voffB[i] = (unsigned)(P.b_row(sR[i]) * K + sC[i]) * 2u; }
    const size_t kstep = (size_t)(BK * 2);
    const size_t kstepA = P.a_kstep();
    const size_t hstepB = P.b_hstep();
    const unsigned ldsw = (unsigned)wid * 1024u;
    const int aoff = lds_byte(wr * 64 + fr, fq * 8), boff = lds_byte(wc * 32 + fr, fq * 8);
#define PG8_SA(b, h) (((b) * 2 + (h)) * HTB)
#define PG8_SB(b, h) ((4 + (b) * 2 + (h)) * HTB)
#define PG8_STAGE(bufoff, gbase, voff) do { _Pragma("unroll") for (int _i = 0; _i < 2; ++_i) { unsigned _vo = (voff)[_i]; asm volatile("" : "+v"(_vo));        \
        __builtin_amdgcn_global_load_lds((const unsigned*)((const char*)(gbase) + _vo), (PG8_LAS unsigned*)(lds + (bufoff) + ldsw + _i * 8192), 16, 0, 0); } } while (0)
#define PG8_STAGE_SEL(bufoff, gbase, h) do { _Pragma("unroll") for (int _i = 0; _i < 2; ++_i) { unsigned _vo = vAc[h][_i]; if constexpr (Prob::GATHER) { const unsigned _vn = van[(h) * 2 + _i]; _vo = last ? _vn : _vo; } asm volatile("" : "+v"(_vo)); \
        __builtin_amdgcn_global_load_lds((const unsigned*)((const char*)(gbase) + _vo), (PG8_LAS unsigned*)(lds + (bufoff) + ldsw + _i * 8192), 16, 0, 0); } } while (0)
#define PG8_LDA(dst, b, h) do { if constexpr (Prob::F8) { _Pragma("unroll") for (int m = 0; m < 2; ++m) { \
            const i32x4 lo_ = *(const PG8_LAS i32x4*)(lds + PG8_SA(b, h) + aoff + m * 2048), hi_ = *(const PG8_LAS i32x4*)(lds + PG8_SA(b, h) + aoff + m * 2048 + 1024); \
            dst##8[m] = __builtin_shufflevector(lo_, hi_, 0, 1, 2, 3, 4, 5, 6, 7); } } \
        else { _Pragma("unroll") for (int m = 0; m < 4; ++m) _Pragma("unroll") for (int k = 0; k < 2; ++k) dst[m][k] = *(const PG8_LAS bf16x8*)(lds + PG8_SA(b, h) + aoff + m * 2048 + k * 1024); } } while (0)
#define PG8_LDB(dst, b, h) do { if constexpr (Prob::F8) { _Pragma("unroll") for (int n = 0; n < 2; ++n) { \
            const i32x4 lo_ = *(const PG8_LAS i32x4*)(lds + PG8_SB(b, h) + boff + n * 2048), hi_ = *(const PG8_LAS i32x4*)(lds + PG8_SB(b, h) + boff + n * 2048 + 1024); \
            dst##8[n] = __builtin_shufflevector(lo_, hi_, 0, 1, 2, 3, 4, 5, 6, 7); } } \
        else { _Pragma("unroll") for (int n = 0; n < 2; ++n) _Pragma("unroll") for (int k = 0; k < 2; ++k) dst[n][k] = *(const PG8_LAS bf16x8*)(lds + PG8_SB(b, h) + boff + n * 2048 + k * 1024); } } while (0)
#define PG8_MMA(ai, bj, At, Bt) do { __builtin_amdgcn_s_setprio(1); _Pragma("unroll") for (int m = 0; m < 4; ++m) _Pragma("unroll") for (int n = 0; n < 2; ++n) { \
        if constexpr (Prob::F8)          \
            acc[ai][bj][m][n] = __builtin_amdgcn_mfma_scale_f32_16x16x128_f8f6f4(Bt##8[n], At##8[m], acc[ai][bj][m][n], 0, 0, 0, 0x7f7f7f7f, 0, 0x7f7f7f7f); \
        else { _Pragma("unroll") for (int k = 0; k < 2; ++k) acc[ai][bj][m][n] = __builtin_amdgcn_mfma_f32_16x16x32_bf16(Bt[n][k], At[m][k], acc[ai][bj][m][n], 0, 0, 0); } } __builtin_amdgcn_s_setprio(0); } while (0)
#define PG8_MMA2(ai, At, B0, B1, b, h) do { if constexpr (Prob::F8) { __builtin_amdgcn_s_setprio(1); \
        _Pragma("unroll") for (int m = 0; m < 2; ++m) _Pragma("unroll") for (int n = 0; n < 2; ++n) { \
            acc[ai][0][m][n] = __builtin_amdgcn_mfma_scale_f32_16x16x128_f8f6f4(B0##8[n], At##8[m], acc[ai][0][m][n], 0, 0, 0, 0x7f7f7f7f, 0, 0x7f7f7f7f); \
            acc[ai][1][m][n] = __builtin_amdgcn_mfma_scale_f32_16x16x128_f8f6f4(B1##8[n], At##8[m], acc[ai][1][m][n], 0, 0, 0, 0x7f7f7f7f, 0, 0x7f7f7f7f); } \
        _Pragma("unroll") for (int m = 0; m < 2; ++m) { \
            const i32x4 lo_ = *(const PG8_LAS i32x4*)(lds + PG8_SA(b, h) + aoff + (m + 2) * 2048), hi_ = *(const PG8_LAS i32x4*)(lds + PG8_SA(b, h) + aoff + (m + 2) * 2048 + 1024); \
            At##8[m] = __builtin_shufflevector(lo_, hi_, 0, 1, 2, 3, 4, 5, 6, 7); } \
        _Pragma("unroll") for (int m = 0; m < 2; ++m) _Pragma("unroll") for (int n = 0; n < 2; ++n) { \
            acc[ai][0][m + 2][n] = __builtin_amdgcn_mfma_scale_f32_16x16x128_f8f6f4(B0##8[n], At##8[m], acc[ai][0][m + 2][n], 0, 0, 0, 0x7f7f7f7f, 0, 0x7f7f7f7f); \
            acc[ai][1][m + 2][n] = __builtin_amdgcn_mfma_scale_f32_16x16x128_f8f6f4(B1##8[n], At##8[m], acc[ai][1][m + 2][n], 0, 0, 0, 0x7f7f7f7f, 0, 0x7f7f7f7f); } \
        __builtin_amdgcn_s_setprio(0); } else { PG8_MMA(ai, 0, At, B0); PG8_MMA(ai, 1, At, B1); } } while (0)
#define PG8_WAIT_V(n) asm volatile("s_waitcnt vmcnt(" #n ")" ::: "memory")
#define PG8_WAIT_L(n) asm volatile("s_waitcnt lgkmcnt(" #n ")" ::: "memory")
#define PG8_BAR __builtin_amdgcn_s_barrier()
#define PG8_SCHED __builtin_amdgcn_sched_barrier(0)
    Unit cur, nxt; int ui = 0;
    if (!P.next(0, cur)) return;
    nxt = cur;
    f32x4 acc[2][2][4][2];
    typename Epi::Pre pre;
    E.prefetch(cur, wc, fq, pre); E.init(acc, pre);
    bf16x8 At[4][2], B0[2][2], B1[2][2];
    i32x8 At8[2], B08[2], B18[2];
    unsigned vAc[2][2];
    PG8_LAS unsigned* van = (PG8_LAS unsigned*)(lds + 131072 + 1024) + tid * 4;
    const char* cA = P.a_base(cur); const char* cB = P.b_base(cur);
    P.a_voff(cur, sR, sC, vAc);
    if constexpr (Prob::GATHER) { van[0] = vAc[0][0]; van[1] = vAc[0][1]; van[2] = vAc[1][0]; van[3] = vAc[1][1]; }
    if constexpr (SP2) {
        PG8_STAGE(PG8_SB(0, 0), cB, voffB); PG8_STAGE(PG8_SB(0, 1), cB + hstepB, voffB); PG8_STAGE(PG8_SA(0, 0), cA, vAc[0]); PG8_STAGE(PG8_SA(0, 1), cA, vAc[1]);
        if (wr == 1) PG8_BAR;
        PG8_WAIT_V(2); PG8_BAR;
        PG8_STAGE(PG8_SB(1, 0), cB + kstep, voffB); PG8_STAGE(PG8_SA(1, 0), cA + kstepA, vAc[0]); PG8_STAGE(PG8_SB(1, 1), cB + hstepB + kstep, voffB);
        PG8_WAIT_V(6); PG8_BAR;
    } else {
        PG8_STAGE(PG8_SB(0, 0), cB, voffB); PG8_STAGE(PG8_SA(0, 0), cA, vAc[0]); PG8_STAGE(PG8_SB(0, 1), cB + hstepB, voffB); PG8_STAGE(PG8_SA(0, 1), cA, vAc[1]);
        if (wr == 1) PG8_BAR;
        PG8_WAIT_V(4); PG8_BAR;
        PG8_STAGE(PG8_SB(1, 0), cB + kstep, voffB); PG8_STAGE(PG8_SA(1, 0), cA + kstepA, vAc[0]); PG8_STAGE(PG8_SB(1, 1), cB + hstepB + kstep, voffB);
        PG8_WAIT_V(6); PG8_BAR;
    }
    for (;;) {
        const bool has_next = P.next(ui + 1, nxt);
        const char* nA = cA; const char* nB = cB;
        if (has_next) { nA = P.a_base(nxt); nB = P.b_base(nxt);
            if constexpr (Prob::GATHER) { int r2[2], c2[2]; const int t2 = otid();
#pragma unroll
                for (int i = 0; i < 2; ++i) stage_rc(t2 * 16 + i * 8192, r2[i], c2[i]);
                unsigned vn[2][2]; P.a_voff(nxt, r2, c2, vn); van[0] = vn[0][0]; van[1] = vn[0][1]; van[2] = vn[1][0]; van[3] = vn[1][1]; } }
        for (int t = 0; t < nt; t += 2) {
            const bool last = (t == nt - 2);
            const char* a1 = cA + (size_t)(t + 1) * kstepA;
            const char* a2 = last ? nA : cA + (size_t)(t + 2) * kstepA; const char* b2 = last ? nB : cB + (size_t)(t + 2) * kstep;
            const char* a3 = a2 + kstepA; const char* b3 = b2 + kstep;
            if constexpr (SP2) {
            PG8_LDB(B0, 0, 0); PG8_LDB(B1, 0, 1); PG8_SCHED; PG8_LDA(At, 0, 0); PG8_STAGE(PG8_SA(1, 1), a1, vAc[1]);
            PG8_WAIT_V(8); PG8_WAIT_L(0); PG8_BAR; PG8_MMA2(0, At, B0, B1, 0, 0); PG8_BAR; PG8_SCHED;
            PG8_LDA(At, 0, 1); PG8_STAGE(PG8_SB(0, 0), b2, voffB); PG8_STAGE(PG8_SB(0, 1), b2 + hstepB, voffB); PG8_STAGE_SEL(PG8_SA(0, 0), a2, 0);
            PG8_WAIT_V(8); PG8_WAIT_L(0); PG8_BAR; PG8_MMA2(1, At, B0, B1, 0, 1); PG8_BAR; PG8_SCHED;
            PG8_LDB(B0, 1, 0); PG8_LDB(B1, 1, 1); PG8_SCHED; PG8_LDA(At, 1, 0); PG8_STAGE_SEL(PG8_SA(0, 1), a2, 1);
            PG8_WAIT_V(8); PG8_WAIT_L(0); PG8_BAR; PG8_MMA2(0, At, B0, B1, 1, 0); PG8_BAR; PG8_SCHED;
            PG8_LDA(At, 1, 1); PG8_STAGE(PG8_SB(1, 0), b3, voffB); PG8_STAGE(PG8_SB(1, 1), b3 + hstepB, voffB); PG8_STAGE_SEL(PG8_SA(1, 0), a3, 0);
            PG8_WAIT_V(8); PG8_WAIT_L(0); PG8_BAR; PG8_MMA2(1, At, B0, B1, 1, 1); PG8_BAR; PG8_SCHED;
            } else {
            PG8_LDB(B0, 0, 0); PG8_SCHED; PG8_LDA(At, 0, 0); PG8_STAGE(PG8_SA(1, 1), a1, vAc[1]);
            PG8_WAIT_L(8); PG8_BAR; PG8_WAIT_L(0); PG8_MMA(0, 0, At, B0); PG8_BAR; PG8_SCHED;
            PG8_LDB(B1, 0, 1); PG8_STAGE(PG8_SB(0, 0), b2, voffB);
            PG8_BAR; PG8_WAIT_L(0); PG8_MMA(0, 1, At, B1); PG8_BAR;
            PG8_LDA(At, 0, 1); PG8_STAGE_SEL(PG8_SA(0, 0), a2, 0);
            PG8_BAR; PG8_WAIT_L(0); PG8_MMA(1, 0, At, B0); PG8_BAR; PG8_SCHED;
            PG8_STAGE(PG8_SB(0, 1), b2 + hstepB, voffB);
            PG8_WAIT_V(6); PG8_BAR; PG8_MMA(1, 1, At, B1); PG8_BAR;
            PG8_LDB(B0, 1, 0); PG8_SCHED; PG8_LDA(At, 1, 0); PG8_STAGE_SEL(PG8_SA(0, 1), a2, 1);
            PG8_WAIT_L(8); PG8_BAR; PG8_WAIT_L(0); PG8_MMA(0, 0, At, B0); PG8_BAR; PG8_SCHED;
            PG8_LDB(B1, 1, 1); PG8_STAGE(PG8_SB(1, 0), b3, voffB);
            PG8_BAR; PG8_WAIT_L(0); PG8_MMA(0, 1, At, B1); PG8_BAR;
            PG8_LDA(At, 1, 1); PG8_STAGE_SEL(PG8_SA(1, 0), a3, 0);
            PG8_BAR; PG8_WAIT_L(0); PG8_MMA(1, 0, At, B0); PG8_BAR; PG8_SCHED;
            PG8_STAGE(PG8_SB(1, 1), b3 + hstepB, voffB);
            PG8_WAIT_V(6); PG8_BAR; PG8_MMA(1, 1, At, B1); PG8_BAR;
            }
        }
        if constexpr (ALIGN_EPI) { if (wr == 0) PG8_BAR; }
        E(acc, cur, wr, wc, fr, fq, has_next, nxt, pre);
        if (!has_next) break;
        E.init(acc, pre);
        cur = nxt; cA = nA; cB = nB; ++ui;
        if constexpr (Prob::GATHER) {
#pragma unroll
            for (int h = 0; h < 2; ++h)
#pragma unroll
                for (int i = 0; i < 2; ++i) vAc[h][i] = van[h * 2 + i];
        }
        if constexpr (ALIGN_EPI) { if (wr == 1) PG8_BAR; }
    }
    PG8_WAIT_V(0);
    if constexpr (!ALIGN_EPI) { if (wr == 0) PG8_BAR; }
    PG8_BAR;
#undef PG8_SA
#undef PG8_SB
#undef PG8_STAGE
#undef PG8_STAGE_SEL
#undef PG8_LDA
#undef PG8_LDB
#undef PG8_MMA
#undef PG8_WAIT_V
#undef PG8_WAIT_L
#undef PG8_BAR
#undef PG8_SCHED
}

struct ProbDense { static constexpr bool F8 = false; static constexpr bool GATHER = false; static constexpr int KT = 0;
    const bf16_t* A; const bf16_t* Bt; int K, nM, nN, G, c; bool headperm;
    __device__ __forceinline__ bool next(int i, Unit& u) const { return static_next(nM, nN, G, c, i, u); }
    __device__ __forceinline__ const char* a_base(const Unit& u) const { return (const char*)(A + (size_t)u.pm * BM * K); }
    __device__ __forceinline__ void a_voff(const Unit&, const int (&R)[2], const int (&C)[2], unsigned (&v)[2][2]) const {
#pragma unroll
        for (int h = 0; h < 2; ++h)
#pragma unroll
            for (int i = 0; i < 2; ++i) v[h][i] = (unsigned)((h * HALF + R[i]) * K + C[i]) * 2u;
    }
    __device__ __forceinline__ const char* b_base(const Unit& u) const { return (const char*)(Bt + (size_t)u.pn * BM * K); }
    __device__ __forceinline__ size_t a_kstep() const { return (size_t)BK * 2; }
    __device__ __forceinline__ size_t b_hstep() const { return headperm ? (size_t)32 * K * 2 : (size_t)HALF * K * 2; }
    __device__ __forceinline__ int b_row(int R) const { return headperm ? ((R >> 5) * 64 + perm32(R & 31)) : ((R & ~31) + perm32(R & 31)); }
};
typedef const PG8_LAS int* lds_ints;
__device__ __forceinline__ int expert_of(lds_ints ps, int pm) { int e = 0;
#pragma unroll
    for (int i = 1; i < 32; ++i) if (ps[i] <= pm * 256) e = i;
    return __builtin_amdgcn_readfirstlane(e); }
struct ProbMoe1 { static constexpr bool F8 = true; static constexpr bool GATHER = true; static constexpr int KT = 0;
    const bf16_t* XN; const bf16_t* W1T; const int* rowtok; lds_ints ps; int K, ntm, G, c;
    __device__ __forceinline__ bool next(int i, Unit& u) const {
        if (G != 256) { const int q = i * G + c; if (q >= ntm * 8) return false; u.pm = q >> 3; u.pn = q & 7; u.e = expert_of(ps, u.pm); return true; }
        const int x = c & 7, s = c >> 3; const int pm = 4 * (i * 8 + x) + (s >> 3); if (pm >= ntm) return false;
        u.pm = pm; u.pn = s & 7; u.e = expert_of(ps, u.pm); return true; }
    __device__ __forceinline__ const char* a_base(const Unit&) const { return (const char*)XN; }
    __device__ __forceinline__ void a_voff(const Unit& u, const int (&R)[2], const int (&C)[2], unsigned (&v)[2][2]) const {
#pragma unroll
        for (int h = 0; h < 2; ++h)
#pragma unroll
            for (int i = 0; i < 2; ++i) { int tk = rowtok[u.pm * BM + h * HALF + R[i]]; if (tk < 0) tk = T; v[h][i] = (unsigned)(tk * K + C[i]) * 2u; }
    }
    __device__ __forceinline__ const char* b_base(const Unit& u) const { return (const char*)(W1T + ((size_t)u.e * 2048 + u.pn * 128) * K); }
    __device__ __forceinline__ size_t a_kstep() const { return (size_t)BK * 2; }
    __device__ __forceinline__ size_t b_hstep() const { return (size_t)1024 * K * 2; }
    __device__ __forceinline__ int b_row(int R) const { return (R & ~31) + perm32(R & 31); }
};
struct ProbMoe2 { static constexpr bool F8 = true; static constexpr bool GATHER = false; static constexpr int KT = 0;
    const bf16_t* ACT; const bf16_t* W2T; lds_ints ps; int K, ntm, G, c;
    __device__ __forceinline__ bool next(int i, Unit& u) const {
        if (G != 256) { const int q = i * G + c; if (q >= ntm * 4) return false; u.pm = q >> 2; u.pn = q & 3; u.e = expert_of(ps, u.pm); return true; }
        const int x = c & 7, s = c >> 3; const int pm = 8 * (i * 8 + x) + (s >> 2); if (pm >= ntm) return false;
        u.pm = pm; u.pn = s & 3; u.e = expert_of(ps, u.pm); return true; }
    __device__ __forceinline__ const char* a_base(const Unit& u) const { return (const char*)(ACT + (size_t)u.pm * BM * K); }
    __device__ __forceinline__ void a_voff(const Unit&, const int (&R)[2], const int (&C)[2], unsigned (&v)[2][2]) const {
#pragma unroll
        for (int h = 0; h < 2; ++h)
#pragma unroll
            for (int i = 0; i < 2; ++i) v[h][i] = (unsigned)((h * HALF + R[i]) * K + C[i]) * 2u;
    }
    __device__ __forceinline__ const char* b_base(const Unit& u) const { return (const char*)(W2T + ((size_t)u.e * 1024 + u.pn * BM) * K); }
    __device__ __forceinline__ size_t a_kstep() const { return (size_t)BK * 2; }
    __device__ __forceinline__ size_t b_hstep() const { return (size_t)HALF * K * 2; }
    __device__ __forceinline__ int b_row(int R) const { return (R & ~31) + perm32(R & 31); }
};

struct ProbCmp { static constexpr bool F8 = false; static constexpr bool GATHER = false; static constexpr int KT = 8;
    const bf16_t* ZB; const bf16_t* W1T; int K, G, c;
    __device__ __forceinline__ bool next(int i, Unit& u) const { const int q = i * G + c; if (q >= 64) return false; u.pm = q & 15; u.pn = 0; u.e = q >> 4; return true; }
    __device__ __forceinline__ const char* a_base(const Unit& u) const { const int idx = u.pm >> 3, bg = (u.pm >> 1) & 3, half = u.pm & 1;
        return (const char*)(ZB + ((size_t)(bg >> 1) * S + 16 * 256 * half + 8 * u.e) * ZBW + ZB_KC + idx * 128 + (bg & 1) * 64); }
    __device__ __forceinline__ void a_voff(const Unit&, const int (&R)[2], const int (&C)[2], unsigned (&v)[2][2]) const {
#pragma unroll
        for (int h = 0; h < 2; ++h)
#pragma unroll
            for (int i = 0; i < 2; ++i) v[h][i] = (unsigned)(16 * (h * HALF + R[i]) * ZBW + C[i]) * 2u;
    }
    __device__ __forceinline__ size_t a_kstep() const { return (size_t)ZBW * 2; }
    __device__ __forceinline__ const char* b_base(const Unit& u) const { return (const char*)(W1T + (size_t)(u.pm >> 3) * 128 * K + 8 * 64 * u.e); }
    __device__ __forceinline__ size_t b_hstep() const { return 0; }
    __device__ __forceinline__ int b_row(int R) const { return (R & ~31) + perm32(R & 31); }
};
struct EpiCmp {
    float* HIDP;
    struct Pre {};
    __device__ __forceinline__ void prefetch(const Unit&, int, int, Pre&) const {}
    __device__ __forceinline__ void init(f32x4 (&acc)[2][2][4][2], const Pre&) const {
#pragma unroll
        for (int a = 0; a < 2; ++a)
#pragma unroll
            for (int b = 0; b < 2; ++b)
#pragma unroll
                for (int m = 0; m < 4; ++m)
#pragma unroll
                    for (int n = 0; n < 2; ++n) acc[a][b][m][n] = (f32x4){0.f, 0.f, 0.f, 0.f};
    }
    __device__ __forceinline__ void operator()(const f32x4 (&acc)[2][2][4][2], const Unit& u, int wr, int wc, int fr, int fq, bool has_next, const Unit& nxt, Pre& pre) const {
        const int idx = u.pm >> 3, bg = (u.pm >> 1) & 3, half = u.pm & 1;
        const int c0 = 32 * wc + 8 * fq;
#pragma unroll
        for (int ai = 0; ai < 2; ++ai)
#pragma unroll
            for (int m = 0; m < 4; ++m) { const int n = 256 * half + ai * HALF + wr * 64 + m * 16 + fr;
                if (n < 511) { float* dst = HIDP + (((size_t)u.e * 2 + idx) * 2044 + bg * 511 + n) * 128 + c0;
                    *(f32x4*)dst = acc[ai][0][m][0]; *(f32x4*)(dst + 4) = acc[ai][0][m][1]; } }
    }
};
struct EpiG1F {
    bf16_t* ZB; float* GATE; const float* gq; const float* gk; const float* gmq; const float* gmk;
    struct Pre {};
    __device__ __forceinline__ void prefetch(const Unit&, int, int, Pre&) const {}
    __device__ __forceinline__ void init(f32x4 (&acc)[2][2][4][2], const Pre&) const {
#pragma unroll
        for (int a = 0; a < 2; ++a)
#pragma unroll
            for (int b = 0; b < 2; ++b)
#pragma unroll
                for (int m = 0; m < 4; ++m)
#pragma unroll
                    for (int n = 0; n < 2; ++n) acc[a][b][m][n] = (f32x4){0.f, 0.f, 0.f, 0.f};
    }
    __device__ __forceinline__ void operator()(const f32x4 (&acc)[2][2][4][2], const Unit& u, int wr, int wc, int fr, int fq, bool has_next, const Unit& nxt, Pre& pre) const {
        const int pn = u.pn;
        const float* gain = nullptr; float sc = 1.f;
        if (pn < 2) { gain = gq; sc = QSCALE; }
        else if (pn == 3 || pn == 4) { if (wc < 2) gain = gk; }
        else if (pn == 5 || pn == 6) { gain = gmq; sc = QSCALE; }
        else if (pn == 7 || pn == 8) { gain = gmk; }
        if (pn == 11) {
            if (wc == 0 && fq < 3) {
#pragma unroll
                for (int ai = 0; ai < 2; ++ai)
#pragma unroll
                    for (int m = 0; m < 4; ++m) { const size_t r = (size_t)u.pm * BM + ai * HALF + wr * 64 + m * 16 + fr;
#pragma unroll
                        for (int n = 0; n < 2; ++n) { const f32x4 v = acc[ai][0][m][n]; f32x4 o;
#pragma unroll
                            for (int i = 0; i < 4; ++i) o[i] = __builtin_amdgcn_rcpf(1.f + __builtin_amdgcn_exp2f(-LOG2E * v[i]));
                            *(f32x4*)(GATE + r * 32 + 8 * fq + 4 * n) = o; } }
            }
            return;
        }
        f32x4 gv[2][2];
#pragma unroll
        for (int bj = 0; bj < 2; ++bj)
#pragma unroll
            for (int n = 0; n < 2; ++n) gv[bj][n] = gain ? *(const f32x4*)(gain + 32 * bj + 8 * fq + 4 * n) * sc : (f32x4){1.f, 1.f, 1.f, 1.f};
#pragma unroll
        for (int ai = 0; ai < 2; ++ai)
#pragma unroll
            for (int m = 0; m < 4; ++m) { const size_t r = (size_t)u.pm * BM + ai * HALF + wr * 64 + m * 16 + fr;
                float rs = 1.f;
                if (gain) { float ss = 0.f;
#pragma unroll
                    for (int bj = 0; bj < 2; ++bj)
#pragma unroll
                        for (int n = 0; n < 2; ++n) { const f32x4 v = acc[ai][bj][m][n]; ss += (v[0] * v[0] + v[1] * v[1]) + (v[2] * v[2] + v[3] * v[3]); }
                    ss += __shfl_xor(ss, 16); ss += __shfl_xor(ss, 32);
                    rs = rsqrtf(ss * (1.f / 64.f) + EPS); }
#pragma unroll
                for (int bj = 0; bj < 2; ++bj) { const f32x4 a = acc[ai][bj][m][0] * gv[bj][0] * rs, b = acc[ai][bj][m][1] * gv[bj][1] * rs;
                    u32x4 w; w.x = cvt_pk_bf16(a[0], a[1]); w.y = cvt_pk_bf16(a[2], a[3]); w.z = cvt_pk_bf16(b[0], b[1]); w.w = cvt_pk_bf16(b[2], b[3]);
                    *(u32x4*)(ZB + r * ZBW + pn * BM + 64 * wc + 32 * bj + 8 * fq) = w; } }
    }
};
struct EpiG2 {
    const float* xin32; bf16_t* XAB; const float* g1;
    struct Pre {};
    __device__ __forceinline__ void prefetch(const Unit&, int, int, Pre&) const {}
    __device__ __forceinline__ void init(f32x4 (&acc)[2][2][4][2], const Pre&) const {
#pragma unroll
        for (int a = 0; a < 2; ++a)
#pragma unroll
            for (int b = 0; b < 2; ++b)
#pragma unroll
                for (int m = 0; m < 4; ++m)
#pragma unroll
                    for (int n = 0; n < 2; ++n) acc[a][b][m][n] = (f32x4){0.f, 0.f, 0.f, 0.f};
    }
    __device__ __forceinline__ void operator()(const f32x4 (&acc)[2][2][4][2], const Unit& u, int wr, int wc, int fr, int fq, bool has_next, const Unit& nxt, Pre& pre) const {
#pragma unroll
        for (int ai = 0; ai < 2; ++ai)
#pragma unroll
            for (int m = 0; m < 4; ++m) { const size_t r = (size_t)u.pm * BM + ai * HALF + wr * 64 + m * 16 + fr; const int b = (int)(r / S);
#pragma unroll
                for (int bj = 0; bj < 2; ++bj) { const int c = u.pn * BM + 128 * bj + 32 * wc + 8 * fq;
                    f32x4 x0, x1;
                    if (xin32) { x0 = *(const f32x4*)(xin32 + r * D + c); x1 = *(const f32x4*)(xin32 + r * D + c + 4); }
                    else { const u32x4 q = *(const u32x4*)(XAB + r * D + c);
                        x0 = (f32x4){__builtin_bit_cast(float, q.x << 16), __builtin_bit_cast(float, q.x & 0xffff0000u), __builtin_bit_cast(float, q.y << 16), __builtin_bit_cast(float, q.y & 0xffff0000u)};
                        x1 = (f32x4){__builtin_bit_cast(float, q.z << 16), __builtin_bit_cast(float, q.z & 0xffff0000u), __builtin_bit_cast(float, q.w << 16), __builtin_bit_cast(float, q.w & 0xffff0000u)}; }
                    const f32x4 g0 = *(const f32x4*)(g1 + (size_t)b * 6144 + c), g1v = *(const f32x4*)(g1 + (size_t)b * 6144 + c + 4);
                    const f32x4 y0 = x0 + g0 * acc[ai][bj][m][0], y1 = x1 + g1v * acc[ai][bj][m][1];
                    u32x4 o; o.x = cvt_pk_bf16(y0[0], y0[1]); o.y = cvt_pk_bf16(y0[2], y0[3]); o.z = cvt_pk_bf16(y1[0], y1[1]); o.w = cvt_pk_bf16(y1[2], y1[3]);
                    *(u32x4*)(XAB + r * D + c) = o; } }
    }
};
struct EpiM1 {
    unsigned char* ACT8; const float* b1l; const float* dq1l;
    struct Pre {};
    __device__ __forceinline__ void prefetch(const Unit&, int, int, Pre&) const {}
    __device__ __forceinline__ void init(f32x4 (&acc)[2][2][4][2], const Pre&) const {
#pragma unroll
        for (int a = 0; a < 2; ++a)
#pragma unroll
            for (int b = 0; b < 2; ++b)
#pragma unroll
                for (int m = 0; m < 4; ++m)
#pragma unroll
                    for (int n = 0; n < 2; ++n) acc[a][b][m][n] = (f32x4){0.f, 0.f, 0.f, 0.f};
    }
    __device__ __forceinline__ void operator()(const f32x4 (&acc)[2][2][4][2], const Unit& u, int wr, int wc, int fr, int fq, bool has_next, const Unit& nxt, Pre& pre) const {
        const int c0 = u.pn * 128 + 32 * wc + 8 * fq;
        const float* b1 = b1l + (size_t)u.e * 2048 + c0; const float* dq = dq1l + (size_t)u.e * 2048 + c0;
        unsigned w[2][4][2];
#pragma unroll
        for (int n = 0; n < 2; ++n) {
            __builtin_amdgcn_sched_barrier(0);
            const f32x4 bg = *(const f32x4*)(b1 + 4 * n), bl = *(const f32x4*)(b1 + 1024 + 4 * n);
            const f32x4 sg = *(const f32x4*)(dq + 4 * n) * (1.f / XS8), sl = *(const f32x4*)(dq + 1024 + 4 * n) * (1.f / XS8);
#pragma unroll
            for (int ai = 0; ai < 2; ++ai)
#pragma unroll
                for (int m = 0; m < 4; ++m) { const f32x4 g = acc[ai][0][m][n] * sg + bg, li = acc[ai][1][m][n] * sl + bl; float o[4];
#pragma unroll
                    for (int i = 0; i < 4; ++i) { const float gc = fminf(g[i], 7.f), lc = __builtin_amdgcn_fmed3f(li[i], -7.f, 7.f);
                        o[i] = (AS8 * (lc + 1.f)) * (gc * __builtin_amdgcn_rcpf(1.f + __builtin_amdgcn_exp2f((-1.702f * LOG2E) * gc))); }
                    w[ai][m][n] = pk_fp8x4(o[0], o[1], o[2], o[3]); }
        }
#pragma unroll
        for (int ai = 0; ai < 2; ++ai)
#pragma unroll
            for (int m = 0; m < 4; ++m) { const size_t r = (size_t)u.pm * BM + ai * HALF + wr * 64 + m * 16 + fr;
                *(uint2*)(ACT8 + r * DFF + c0) = make_uint2(w[ai][m][0], w[ai][m][1]); }
    }
};
struct EpiM2 {
    bf16_t* Y; const float* b2l; const float* dq2l;
    struct Pre {};
    __device__ __forceinline__ void prefetch(const Unit&, int, int, Pre&) const {}
    __device__ __forceinline__ void init(f32x4 (&acc)[2][2][4][2], const Pre&) const {
#pragma unroll
        for (int a = 0; a < 2; ++a)
#pragma unroll
            for (int b = 0; b < 2; ++b)
#pragma unroll
                for (int m = 0; m < 4; ++m)
#pragma unroll
                    for (int n = 0; n < 2; ++n) acc[a][b][m][n] = (f32x4){0.f, 0.f, 0.f, 0.f};
    }
    __device__ __forceinline__ void operator()(const f32x4 (&acc)[2][2][4][2], const Unit& u, int wr, int wc, int fr, int fq, bool has_next, const Unit& nxt, Pre& pre) const {
        const int cb = u.pn * BM + 32 * wc + 8 * fq;
        const float* b2 = b2l + (size_t)u.e * D + cb; const float* dq = dq2l + (size_t)u.e * D + cb;
#pragma unroll
        for (int bj = 0; bj < 2; ++bj) { const int c = cb + 128 * bj;
            const f32x4 b0 = *(const f32x4*)(b2 + 128 * bj), b1_ = *(const f32x4*)(b2 + 128 * bj + 4);
            const f32x4 s0 = *(const f32x4*)(dq + 128 * bj) * (1.f / AS8), s1 = *(const f32x4*)(dq + 128 * bj + 4) * (1.f / AS8);
#pragma unroll
            for (int ai = 0; ai < 2; ++ai)
#pragma unroll
                for (int m = 0; m < 4; ++m) { const size_t r = (size_t)u.pm * BM + ai * HALF + wr * 64 + m * 16 + fr;
                    const f32x4 v0 = acc[ai][bj][m][0] * s0 + b0, v1 = acc[ai][bj][m][1] * s1 + b1_;
                    u32x4 o; o.x = cvt_pk_bf16(v0[0], v0[1]); o.y = cvt_pk_bf16(v0[2], v0[3]); o.z = cvt_pk_bf16(v1[0], v1[1]); o.w = cvt_pk_bf16(v1[2], v1[3]);
                    *(u32x4*)(Y + r * D + c) = o; }
        }
    }
};
}

__device__ __forceinline__ void phase_g1_fast(const Params& p, int l, unsigned char* lds_raw) {
    pg8::ProbDense P{(const bf16_t*)(p.ws + WS_XN), (const bf16_t*)(p.ws + WS_WINT) + (size_t)l * ZBW * D, D, T / 256, ZBW / 256, (int)gridDim.x, (int)blockIdx.x, true};
    pg8::EpiG1F E{(bf16_t*)(p.ws + WS_ZB), (float*)(p.ws + WS_GATE), p.in[7] + l * 64, p.in[8] + l * 64, p.in[12] + l * 64, p.in[13] + l * 64};
    pg8::gemm_phase<pg8::ProbDense, pg8::EpiG1F, true, true>((PG8_LAS unsigned char*)lds_raw, P, E);
}
__device__ __forceinline__ void phase_g2_fast(const Params& p, int l, unsigned char* lds_raw) {
    pg8::ProbDense P{(const bf16_t*)(p.ws + WS_ATTB), (const bf16_t*)(p.ws + WS_WOT) + (size_t)l * D * D, D, T / 256, D / 256, (int)gridDim.x, (int)blockIdx.x, false};
    pg8::EpiG2 E{l == 0 ? p.in[0] : (const float*)nullptr, (bf16_t*)(p.ws + WS_XAB), (const float*)(p.ws + WS_MOD) + (size_t)l * Bn * 6144 + 2 * D};
    pg8::gemm_phase<pg8::ProbDense, pg8::EpiG2, true, true>((PG8_LAS unsigned char*)lds_raw, P, E);
}
constexpr int LDS_PS_OFF = 131072;
__device__ __forceinline__ void phase_ck_fast(const Params& p, int l, unsigned char* lds_raw) {
    pg8::ProbCmp P{(const bf16_t*)(p.ws + WS_ZB), (const bf16_t*)(p.ws + WS_WCT) + (size_t)l * 2 * 128 * 2048, 2048, (int)gridDim.x, (int)blockIdx.x};
    pg8::EpiCmp E{(float*)(p.ws + WS_HIDP)};
    pg8::gemm_phase<pg8::ProbCmp, pg8::EpiCmp, true, true>((PG8_LAS unsigned char*)lds_raw, P, E);
    { const int tid = otid(), lane = tid & 63, wave = tid >> 6, r8 = lane >> 3, c8 = lane & 7;
      const bf16_t* Z = (const bf16_t*)(p.ws + WS_ZB); bf16_t* KMB = (bf16_t*)(p.ws + WS_KMB);
      float* part = (float*)(lds_raw + 131072 + 512);
      for (int it0 = blockIdx.x * 2; it0 < Bn * 8 * 32; it0 += gridDim.x * 2) {
          const int it = it0 + (wave >> 2), q = wave & 3;
          const int b = it / 256, h = (it / 32) & 7, blk = it & 31;
          const bf16_t* base = Z + (size_t)(b * S + blk * 256 + q * 64 + r8) * ZBW + ZB_MK + h * 64 + c8 * 8;
          float s[8] = {0.f, 0.f, 0.f, 0.f, 0.f, 0.f, 0.f, 0.f};
          uint4 v[8];
#pragma unroll
          for (int i = 0; i < 8; ++i) v[i] = *(const uint4*)(base + (size_t)(8 * i) * ZBW);
#pragma unroll
          for (int i = 0; i < 8; ++i) { const unsigned w[4] = {v[i].x, v[i].y, v[i].z, v[i].w};
#pragma unroll
              for (int e = 0; e < 4; ++e) { s[2 * e] += __builtin_bit_cast(float, w[e] << 16); s[2 * e + 1] += __builtin_bit_cast(float, w[e] & 0xffff0000u); } }
#pragma unroll
          for (int e = 0; e < 8; ++e) { s[e] += __shfl_xor(s[e], 8); s[e] += __shfl_xor(s[e], 16); s[e] += __shfl_xor(s[e], 32); }
          if (r8 == 0) {
#pragma unroll
              for (int e = 0; e < 8; ++e) part[wave * 64 + c8 * 8 + e] = s[e]; }
          __syncthreads();
          if (tid < 128) { const int item = tid >> 6, d = tid & 63; const float* pp = part + item * 256 + d;
              KMB[(size_t)(it0 + item) * 64 + d] = (bf16_t)f2bf((((pp[0] + pp[64]) + pp[128]) + pp[192]) * (1.f / 256.f)); }
          __syncthreads();
      } }
}
__device__ __forceinline__ void phase_m1_fast(const Params& p, int l, unsigned char* lds_raw) {
    int* ps = (int*)(lds_raw + LDS_PS_OFF);
    load_pstart(p, l, ps);
    pg8::ProbMoe1 P{(const bf16_t*)(p.ws + WS_XN8), (const bf16_t*)(p.ws + WS_W1T) + (size_t)l * NE * 2048 * 512, (const int*)(p.ws + WS_ROWTOK) + (size_t)l * RMAX, (pg8::lds_ints)ps, 512, ps[32] / 256, (int)gridDim.x, (int)blockIdx.x};
    pg8::EpiM1 E{p.ws + WS_ACT, p.in[18] + (size_t)l * NE * 2048, (const float*)(p.ws + WS_DQ1) + (size_t)l * NE * 2048};
    pg8::gemm_phase<pg8::ProbMoe1, pg8::EpiM1, true, true>((PG8_LAS unsigned char*)lds_raw, P, E);
    __syncthreads();
}
__device__ __forceinline__ void phase_m2_fast(const Params& p, int l, unsigned char* lds_raw) {
    int* ps = (int*)(lds_raw + LDS_PS_OFF);
    load_pstart(p, l, ps);
    pg8::ProbMoe2 P{(const bf16_t*)(p.ws + WS_ACT), (const bf16_t*)(p.ws + WS_W2T) + (size_t)l * NE * D * 512, (pg8::lds_ints)ps, 512, ps[32] / 256, (int)gridDim.x, (int)blockIdx.x};
    pg8::EpiM2 E{(bf16_t*)(p.ws + WS_Y), p.in[20] + (size_t)l * NE * D, (const float*)(p.ws + WS_DQ2) + (size_t)l * NE * D};
    pg8::gemm_phase<pg8::ProbMoe2, pg8::EpiM2, true, true>((PG8_LAS unsigned char*)lds_raw, P, E);
    __syncthreads();
}

namespace at {
#define AT_LAS __attribute__((address_space(3)))
typedef short bf16x8 __attribute__((ext_vector_type(8)));
typedef short s16x4 __attribute__((ext_vector_type(4)));
typedef short v4i16_t __attribute__((ext_vector_type(4)));
typedef float f32x16 __attribute__((ext_vector_type(16)));
typedef unsigned u32x4 __attribute__((ext_vector_type(4)));
typedef float f32x2_t __attribute__((ext_vector_type(2))); typedef __bf16 bf16x2_t __attribute__((ext_vector_type(2)));
typedef AT_LAS unsigned char* lp;
constexpr int L_K = 0  , L_V = 32768  , L_WSF = 65536, L_OST = 67584  , L_SELM = 133120, L_UNI = 134144, L_KMT = 134400, L_END = 142592;
constexpr float NEGS = -1e30f;
constexpr float MAXTHR = 12.f;
__device__ __forceinline__ int crow(int r, int hi) { return (r & 3) + 8 * (r >> 2) + 4 * hi; }
__device__ __forceinline__ unsigned cvtpk(float lo, float hi) { f32x2_t v = {lo, hi}; bf16x2_t b = __builtin_convertvector(v, bf16x2_t); return __builtin_bit_cast(unsigned, b); }
__device__ __forceinline__ float mx3(float a, float b, float c) { return __builtin_fmaxf(__builtin_fmaxf(a, b), c); }
__device__ __forceinline__ void wsync() { asm volatile("s_waitcnt lgkmcnt(0)" ::: "memory"); __builtin_amdgcn_wave_barrier(); }
__device__ __forceinline__ void bar() { __builtin_amdgcn_s_barrier(); }
#define AT_WAITV(n) asm volatile("s_waitcnt vmcnt(" #n ")" ::: "memory")
#define AT_WAITL() asm volatile("s_waitcnt lgkmcnt(0)" ::: "memory")
__device__ __forceinline__ void glds(const void* g, lp dst) { __builtin_amdgcn_global_load_lds((const unsigned*)g, (AT_LAS unsigned*)dst, 16, 0, 0); }
__device__ __forceinline__ s16x4 vtr(const AT_LAS unsigned char* p) { return __builtin_bit_cast(s16x4, __builtin_amdgcn_ds_read_tr16_b64_v4i16((AT_LAS v4i16_t*)p)); }

__device__ __forceinline__ void dma_k(lp slot, const bf16_t* kbase, int pitch, int key0, int wid, int lane) { glds(kbase + (size_t)(key0 + lane) * pitch + wid * 8, slot + wid * 1024); }
__device__ __forceinline__ void dma_v(lp slot, const bf16_t* vbase, int pitch, int key0, int wid, int lane) {
    glds(vbase + (size_t)(key0 + 16 * (wid & 3) + (lane >> 2)) * pitch + (wid >> 2) * 32 + (lane & 3) * 8, slot + wid * 1024); }

__device__ __forceinline__ void qk_tile(f32x16& p0, f32x16& p1, lp kslot, const bf16x8 (&qr)[4], int r32, int hi) {
    const AT_LAS unsigned char* kb = kslot + hi * 1024 + r32 * 16;
    bf16x8 b0[4], b1[4];
#pragma unroll
    for (int d0 = 0; d0 < 4; ++d0) { b0[d0] = *(const AT_LAS bf16x8*)(kb + d0 * 2048); b1[d0] = *(const AT_LAS bf16x8*)(kb + d0 * 2048 + 512); }
#pragma unroll
    for (int d0 = 0; d0 < 4; ++d0) {
        p0 = __builtin_amdgcn_mfma_f32_32x32x16_bf16(b0[d0], qr[d0], p0, 0, 0, 0);
        p1 = __builtin_amdgcn_mfma_f32_32x32x16_bf16(b1[d0], qr[d0], p1, 0, 0, 0);
    }
}
struct VFrag { bf16x8 f[8]; };
__device__ __forceinline__ void pv_load(VFrag& v, lp vslot, int lane, int hi) {
    const AT_LAS unsigned char* vp = vslot + ((lane >> 4) & 1) * 32 + (lane & 3) * 8 + (4 * hi + ((lane & 15) >> 2)) * 64;
#pragma unroll
    for (int d0 = 0; d0 < 2; ++d0)
#pragma unroll
        for (int ks = 0; ks < 4; ++ks) {
            const s16x4 lo = vtr(vp + d0 * 4096 + ks * 1024), hh = vtr(vp + d0 * 4096 + ks * 1024 + 512);
            v.f[d0 * 4 + ks] = (bf16x8){lo[0], lo[1], lo[2], lo[3], hh[0], hh[1], hh[2], hh[3]};
        }
}
__device__ __forceinline__ void pv_mfma(f32x16 (&o)[2], const VFrag& v, u32x4 pw0, u32x4 pw1, u32x4 pw2, u32x4 pw3) {
    const bf16x8 pa[4] = {__builtin_bit_cast(bf16x8, pw0), __builtin_bit_cast(bf16x8, pw1), __builtin_bit_cast(bf16x8, pw2), __builtin_bit_cast(bf16x8, pw3)};
#pragma unroll
    for (int ks = 0; ks < 4; ++ks) {
        o[0] = __builtin_amdgcn_mfma_f32_32x32x16_bf16(pa[ks], v.f[ks], o[0], 0, 0, 0);
        o[1] = __builtin_amdgcn_mfma_f32_32x32x16_bf16(pa[ks], v.f[4 + ks], o[1], 0, 0, 0);
    }
}
__device__ __forceinline__ float rowmax(const f32x16& p0, const f32x16& p1) {
    float a = mx3(p0[0], p0[1], p1[0]), b = mx3(p0[2], p0[3], p1[1]); a = mx3(a, p1[2], p1[3]);
#pragma unroll
    for (int r = 4; r < 16; r += 4) { a = mx3(a, p0[r], p0[r + 1]); b = mx3(b, p0[r + 2], p0[r + 3]); a = mx3(a, p1[r], p1[r + 1]); b = mx3(b, p1[r + 2], p1[r + 3]); }
    const float m = __builtin_fmaxf(a, b);
    auto rr = __builtin_amdgcn_permlane32_swap(__float_as_uint(m), __float_as_uint(m), false, false);
    return __builtin_fmaxf(__uint_as_float(rr[0]), __uint_as_float(rr[1]));
}
__device__ __forceinline__ float halfsum(float v) {
    auto rr = __builtin_amdgcn_permlane32_swap(__float_as_uint(v), __float_as_uint(v), false, false);
    return __uint_as_float(rr[0]) + __uint_as_float(rr[1]);
}
__device__ __forceinline__ void mask_tile(f32x16& p0, f32x16& p1, int lo, int hi_, int hi) {
    const int kb = 4 * hi;
#pragma unroll
    for (int r = 0; r < 16; ++r) { const int kv = kb + (r & 3) + 8 * (r >> 2); if (kv > hi_ || kv < lo) p0[r] = NEGS; if (kv + 32 > hi_ || kv + 32 < lo) p1[r] = NEGS; }
}

__device__ __forceinline__ void mask_init_lo(f32x16& p0, f32x16& p1, int lo, int hi) {
    const int kb = 4 * hi;
#pragma unroll
    for (int r = 0; r < 16; ++r) { const int kv = kb + (r & 3) + 8 * (r >> 2); if (kv < lo) p0[r] = NEGS; if (kv + 32 < lo) p1[r] = NEGS; }
}
__device__ __forceinline__ void mask_init(f32x16& p0, f32x16& p1, int hi_, int hi) {
    const int kb = 4 * hi;
#pragma unroll
    for (int r = 0; r < 16; ++r) { const int kv = kb + (r & 3) + 8 * (r >> 2); if (kv > hi_) p0[r] = NEGS; if (kv + 32 > hi_) p1[r] = NEGS; }
}
__device__ __forceinline__ int next_bit128(unsigned u0, unsigned u1, unsigned u2, unsigned u3, int below) {
    if (below > 96) { unsigned x = u3; if (below < 128) x &= (1u << (below - 96)) - 1u; if (x) return 96 + 31 - __builtin_clz(x); }
    if (below > 64) { unsigned x = u2; if (below < 96) x &= (1u << (below - 64)) - 1u; if (x) return 64 + 31 - __builtin_clz(x); }
    if (below > 32) { unsigned x = u1; if (below < 64) x &= (1u << (below - 32)) - 1u; if (x) return 32 + 31 - __builtin_clz(x); }
    if (below > 0) { unsigned x = u0; if (below < 32) x &= (1u << below) - 1u; if (x) return 31 - __builtin_clz(x); }
    return -1;
}
struct Soft { float m, l; };

template <bool HAS_O>
__device__ __forceinline__ void softmax_step(f32x16& p0, f32x16& p1, Soft& st, f32x16 (&o)[2], float* wsf, int r32, int hi) {
    const float rm = rowmax(p0, p1);
    if (__any(rm > MAXTHR)) {
        const float dl = __builtin_fmaxf(rm, 0.f); st.m += dl;
#pragma unroll
        for (int r = 0; r < 16; ++r) { p0[r] -= dl; p1[r] -= dl; }
        const float al = __builtin_amdgcn_exp2f(-dl); st.l *= al;
        if (HAS_O) {
            if (hi == 0) wsf[r32] = al;
            wsync();
#pragma unroll
            for (int r = 0; r < 16; ++r) { const float f = wsf[crow(r, hi)]; o[0][r] *= f; o[1][r] *= f; }
            wsync();
        }
    }
    float s = 0.f;
#pragma unroll
    for (int r = 0; r < 16; ++r) { p0[r] = __builtin_amdgcn_exp2f(p0[r]); p1[r] = __builtin_amdgcn_exp2f(p1[r]); s += p0[r] + p1[r]; }
    st.l += s;
}
#define AT_PACK(P0, P1) \
    const u32x4 pw0 = {cvtpk(P0[0], P0[1]), cvtpk(P0[2], P0[3]), cvtpk(P0[4], P0[5]), cvtpk(P0[6], P0[7])}, pw1 = {cvtpk(P0[8], P0[9]), cvtpk(P0[10], P0[11]), cvtpk(P0[12], P0[13]), cvtpk(P0[14], P0[15])}, \
                pw2 = {cvtpk(P1[0], P1[1]), cvtpk(P1[2], P1[3]), cvtpk(P1[4], P1[5]), cvtpk(P1[6], P1[7])}, pw3 = {cvtpk(P1[8], P1[9]), cvtpk(P1[10], P1[11]), cvtpk(P1[12], P1[13]), cvtpk(P1[14], P1[15])}
__device__ __forceinline__ float fma_vsv(float a, float k, float x) { float d; asm("v_fma_f32 %0, %1, %2, %3" : "=v"(d) : "v"(a), "s"(k), "v"(x)); return d; }
__device__ __forceinline__ f32x16 cinit(float c2k, int hi, float x) { f32x16 c; const float xb = __builtin_fmaf(c2k, (float)(4 * hi), x);
    c[0] = xb;
#pragma unroll
    for (int r = 1; r < 16; ++r) c[r] = fma_vsv(c2k, (float)((r & 3) + 8 * (r >> 2)), xb);
    return c; }
template <bool FIRST>
__device__ __forceinline__ void acc_scaled(float* stage, const f32x16 (&o)[2], float f, float* wsf, int r32, int hi) {
    if (hi == 0) wsf[r32] = f;
    wsync();
#pragma unroll
    for (int r = 0; r < 16; ++r) { const int orow = crow(r, hi); const float g = wsf[orow]; float* s0 = stage + orow * 64 + r32;
        if (FIRST) { s0[0] = o[0][r] * g; s0[32] = o[1][r] * g; } else { s0[0] += o[0][r] * g; s0[32] += o[1][r] * g; } }
    wsync();
}

#define AT_WAIT_NEWER(newer, per) do { if ((newer) >= 2) { if ((per) == 2) AT_WAITV(4); else AT_WAITV(2); } else if ((newer) == 1) { if ((per) == 2) AT_WAITV(2); else AT_WAITV(1); } else AT_WAITV(0); } while (0)


#define AT_SB() __builtin_amdgcn_sched_barrier(0)
struct PipeOut { float s, rmn; };
__device__ __forceinline__ PipeOut pipe_step(f32x16& c0, f32x16& c1, f32x16& n0, f32x16& n1, f32x16 (&o)[2], lp kslot_next, lp vslot, const bf16x8 (&qr)[4], int lane, int r32, int hi) {
    const AT_LAS unsigned char* kb = kslot_next + hi * 1024 + r32 * 16;
    const AT_LAS unsigned char* vp = vslot + ((lane >> 4) & 1) * 32 + (lane & 3) * 8 + (4 * hi + ((lane & 15) >> 2)) * 64;
    bf16x8 kf[8];
#pragma unroll
    for (int j = 0; j < 4; ++j) kf[j] = *(const AT_LAS bf16x8*)(kb + (j >> 1) * 2048 + (j & 1) * 512);
    AT_SB();
    unsigned w0[8], w1[8]; s16x4 vl[8], vh[8]; float s = 0.f;
#pragma unroll
    for (int j = 0; j < 8; ++j) {
        if (j & 1) n1 = __builtin_amdgcn_mfma_f32_32x32x16_bf16(kf[j], qr[j >> 1], n1, 0, 0, 0);
        else       n0 = __builtin_amdgcn_mfma_f32_32x32x16_bf16(kf[j], qr[j >> 1], n0, 0, 0, 0);
        if (j < 4) kf[j + 4] = *(const AT_LAS bf16x8*)(kb + ((j + 4) >> 1) * 2048 + (j & 1) * 512);
        if (j >= 4) {
#pragma unroll
            for (int q = 0; q < 2; ++q) { const int f = (j - 4) * 2 + q, d0 = f >> 2, ks = f & 3; vl[f] = vtr(vp + d0 * 4096 + ks * 1024); vh[f] = vtr(vp + d0 * 4096 + ks * 1024 + 512); }
        }
        const float e0 = __builtin_amdgcn_exp2f(c0[2 * j]), e1 = __builtin_amdgcn_exp2f(c0[2 * j + 1]), e2 = __builtin_amdgcn_exp2f(c1[2 * j]), e3 = __builtin_amdgcn_exp2f(c1[2 * j + 1]);
        s += (e0 + e1) + (e2 + e3);
        asm volatile("" : "+v"(s));
        w0[j] = cvtpk(e0, e1); w1[j] = cvtpk(e2, e3);
        AT_SB();
    }
    const u32x4 pw0 = {w0[0], w0[1], w0[2], w0[3]}, pw1 = {w0[4], w0[5], w0[6], w0[7]}, pw2 = {w1[0], w1[1], w1[2], w1[3]}, pw3 = {w1[4], w1[5], w1[6], w1[7]};
    const bf16x8 pa[4] = {__builtin_bit_cast(bf16x8, pw0), __builtin_bit_cast(bf16x8, pw1), __builtin_bit_cast(bf16x8, pw2), __builtin_bit_cast(bf16x8, pw3)};
    float a = mx3(n0[0], n0[1], n1[0]), b = mx3(n0[2], n0[3], n1[1]);
#pragma unroll
    for (int f = 0; f < 8; ++f) {
        const int d0 = f >> 2, ks = f & 3;
        const bf16x8 vf = (bf16x8){vl[f][0], vl[f][1], vl[f][2], vl[f][3], vh[f][0], vh[f][1], vh[f][2], vh[f][3]};
        o[d0] = __builtin_amdgcn_mfma_f32_32x32x16_bf16(pa[ks], vf, o[d0], 0, 0, 0);
        if (f == 0) { a = mx3(a, n1[2], n1[3]); }
        else if (f < 4) { const int r = 4 * f; a = mx3(a, n0[r], n0[r + 1]); b = mx3(b, n0[r + 2], n0[r + 3]); a = mx3(a, n1[r], n1[r + 1]); b = mx3(b, n1[r + 2], n1[r + 3]); }
        asm volatile("" : "+v"(a), "+v"(b));
        AT_SB();
    }
    const float m = __builtin_fmaxf(a, b);
    auto rr = __builtin_amdgcn_permlane32_swap(__float_as_uint(m), __float_as_uint(m), false, false);
    PipeOut out; out.s = s; out.rmn = __builtin_fmaxf(__uint_as_float(rr[0]), __uint_as_float(rr[1]));
    return out;
}
__device__ __forceinline__ void nsa_unit(const Params& p, int b, int g, int c, unsigned char* lds_raw) {
    const int tid = otid(), lane = tid & 63, r32 = lane & 31, hi = lane >> 5, wid = __builtin_amdgcn_readfirstlane(tid >> 6);
    lp lds = (lp)lds_raw;
    const bf16_t* ZB = (const bf16_t*)(p.ws + WS_ZB); const float* GT = (const float*)(p.ws + WS_GATE);
    const bf16_t* KCB = (const bf16_t*)(p.ws + WS_KCB) + (size_t)(b * 2 + g) * 512 * 64; const bf16_t* VCB = (const bf16_t*)(p.ws + WS_VCB) + (size_t)(b * 2 + g) * 512 * 64;
    const int t0 = c * 64, hg = r32 >> 3, qq = r32 & 7, qi = 8 * wid + qq, t = t0 + qi, h = 4 * g + hg; const size_t tt = (size_t)b * S + t;
    float* wsf = (float*)(lds_raw + L_WSF) + wid * 64;
    float* ostage = (float*)(lds_raw + L_OST) + wid * 2048;
    float* imp = ostage;
    unsigned* selm = (unsigned*)(lds_raw + L_SELM);
    unsigned* uni = (unsigned*)(lds_raw + L_UNI);
    const float c2 = exp2f(-(float)(h + 1)) * LOG2E;
    bf16x8 qr[4];
#pragma unroll
    for (int d0 = 0; d0 < 4; ++d0) qr[d0] = *(const bf16x8*)(ZB + tt * ZBW + ZB_Q + h * 64 + d0 * 16 + hi * 8);
    const float gt0 = GT[tt * 32 + h * 3 + 0], gt1 = GT[tt * 32 + h * 3 + 1], gt2 = GT[tt * 32 + h * 3 + 2];
    f32x16 o[2];
    const lp sK0 = lds + L_K, sV0 = lds + L_V;
    const int nmax = t >= 31 ? (t - 31) >> 4 : -1;
    const int ntc = ((4 * c + 2) >> 6) + 1;
    for (int i = lane; i < 8 * 129; i += 64) imp[i] = 0.f;
    Soft sc; sc.m = 0.f; sc.l = 0.f;
#pragma unroll
    for (int k = 0; k < 3; ++k) if (k < ntc) dma_k(sK0 + k * 8192, KCB, 64, 64 * k, wid, lane);
    for (int k = 0; k < ntc; ++k) {
        const int newer = ntc - 1 - k; AT_WAIT_NEWER(newer, 1);
        AT_WAITL(); bar();
        if (k + 3 < ntc) dma_k(sK0 + ((k + 3) & 3) * 8192, KCB, 64, 64 * (k + 3), wid, lane);
        const lp sK = sK0 + (k & 3) * 8192;
        const float x0 = c2 * (16.f * (64 * k) + 15.5f - (float)t0) - sc.m;
        f32x16 p0 = cinit(16.f * c2, hi, x0), p1 = cinit(16.f * c2, hi, x0 + c2 * 512.f);
        qk_tile(p0, p1, sK, qr, r32, hi);
        if (__any(nmax - 64 * k < 63)) mask_tile(p0, p1, 0, nmax - 64 * k, hi);
        softmax_step<false>(p0, p1, sc, o, wsf, r32, hi);
    }
    const float lc = halfsum(sc.l), linv = lc > 0.f ? 1.f / lc : 0.f;
    o[0] = f32x16{}; o[1] = f32x16{};
    AT_WAITL(); bar();
#pragma unroll
    for (int k = 0; k < 3; ++k) if (k < ntc) { dma_k(sK0 + k * 8192, KCB, 64, 64 * k, wid, lane); dma_v(sV0 + k * 8192, VCB, 64, 64 * k, wid, lane); }
    for (int k = 0; k < ntc; ++k) {
        const int newer = ntc - 1 - k; AT_WAIT_NEWER(newer, 2);
        AT_WAITL(); bar();
        if (k + 3 < ntc) { dma_k(sK0 + ((k + 3) & 3) * 8192, KCB, 64, 64 * (k + 3), wid, lane); dma_v(sV0 + ((k + 3) & 3) * 8192, VCB, 64, 64 * (k + 3), wid, lane); }
        const lp sK = sK0 + (k & 3) * 8192, sV = sV0 + (k & 3) * 8192;
        const float x0 = c2 * (16.f * (64 * k) + 15.5f - (float)t0) - sc.m;
        f32x16 p0 = cinit(16.f * c2, hi, x0), p1 = cinit(16.f * c2, hi, x0 + c2 * 512.f);
        qk_tile(p0, p1, sK, qr, r32, hi);
        if (__any(nmax - 64 * k < 63)) mask_tile(p0, p1, 0, nmax - 64 * k, hi);
        VFrag vf; pv_load(vf, sV, lane, hi);
#pragma unroll
        for (int r = 0; r < 16; ++r) { p0[r] = __builtin_amdgcn_exp2f(p0[r]); p1[r] = __builtin_amdgcn_exp2f(p1[r]); }
        { AT_PACK(p0, p1); pv_mfma(o, vf, pw0, pw1, pw2, pw3); }
        float gs[8], ls[8];
#pragma unroll
        for (int q4 = 0; q4 < 4; ++q4) { gs[q4] = ((p0[4 * q4] + p0[4 * q4 + 1]) + (p0[4 * q4 + 2] + p0[4 * q4 + 3])) * linv; ls[q4] = p0[4 * q4 + 3] * linv;
                                         gs[4 + q4] = ((p1[4 * q4] + p1[4 * q4 + 1]) + (p1[4 * q4 + 2] + p1[4 * q4 + 3])) * linv; ls[4 + q4] = p1[4 * q4 + 3] * linv; }
#pragma unroll
        for (int q4 = 0; q4 < 8; ++q4) { gs[q4] += __shfl_xor(gs[q4], 8); gs[q4] += __shfl_xor(gs[q4], 16); ls[q4] += __shfl_xor(ls[q4], 8); ls[q4] += __shfl_xor(ls[q4], 16); }
        if (r32 < 8) {
            float* row = imp + qq * 129 + 16 * k + hi;
#pragma unroll
            for (int q4 = 0; q4 < 8; ++q4) row[2 * q4] += gs[q4];
        }
        wsync();
        if (r32 < 8) {
            float* row = imp + qq * 129 + 16 * k + hi + 1;
#pragma unroll
            for (int q4 = 0; q4 < 8; ++q4) row[2 * q4] += ls[q4];
        }
        wsync();
    }
    unsigned mk0 = 0u, mk1 = 0u, mk2 = 0u, mk3 = 0u;
    {
        const int qs = lane >> 3, part = lane & 7;
        float v[16];
#pragma unroll
        for (int i = 0; i < 16; ++i) { const int j = part * 16 + i; float x = imp[qs * 129 + j]; if (j == 0 || j == c || j == c - 1) x = 1e4f; if (j > c) x = NEGS; v[i] = x; }
#pragma unroll 1
        for (int it = 0; it < 16; ++it) {
            float bv = -3e38f; int bi = 0;
#pragma unroll
            for (int i = 0; i < 16; ++i) if (v[i] > bv) { bv = v[i]; bi = part * 16 + i; }
#pragma unroll
            for (int sft = 1; sft < 8; sft <<= 1) { const float ov = __shfl_xor(bv, sft); const int oi = __shfl_xor(bi, sft); if (ov > bv || (ov == bv && oi < bi)) { bv = ov; bi = oi; } }
            if (bv > NEGS) { const unsigned bit = 1u << (bi & 31); const int wq = bi >> 5; if (wq == 0) mk0 |= bit; else if (wq == 1) mk1 |= bit; else if (wq == 2) mk2 |= bit; else mk3 |= bit; }
#pragma unroll
            for (int i = 0; i < 16; ++i) if (part * 16 + i == bi) v[i] = -3.4e38f;
        }
        if (part == 0) { unsigned* sm = selm + (8 * wid + qs) * 4; sm[0] = mk0; sm[1] = mk1; sm[2] = mk2; sm[3] = mk3; }
        unsigned u0 = mk0, u1 = mk1, u2 = mk2, u3 = mk3;
#pragma unroll
        for (int sft = 8; sft < 64; sft <<= 1) { u0 |= __shfl_xor(u0, sft); u1 |= __shfl_xor(u1, sft); u2 |= __shfl_xor(u2, sft); u3 |= __shfl_xor(u3, sft); }
        if (lane == 0) { uni[wid * 4 + 0] = u0; uni[wid * 4 + 1] = u1; uni[wid * 4 + 2] = u2; uni[wid * 4 + 3] = u3; }
    }
    wsync();
    acc_scaled<true>(ostage, o, gt0 * linv, wsf, r32, hi);
    AT_WAITL(); bar();
    unsigned un0 = 0u, un1 = 0u, un2 = 0u, un3 = 0u;
#pragma unroll
    for (int w = 0; w < 8; ++w) { un0 |= uni[w * 4 + 0]; un1 |= uni[w * 4 + 1]; un2 |= uni[w * 4 + 2]; un3 |= uni[w * 4 + 3]; }
    un0 = __builtin_amdgcn_readfirstlane(un0); un1 = __builtin_amdgcn_readfirstlane(un1); un2 = __builtin_amdgcn_readfirstlane(un2); un3 = __builtin_amdgcn_readfirstlane(un3);
    const unsigned my0 = selm[(8 * wid + qq) * 4 + 0], my1 = selm[(8 * wid + qq) * 4 + 1], my2 = selm[(8 * wid + qq) * 4 + 2], my3 = selm[(8 * wid + qq) * 4 + 3];
    {
        const bf16_t* KS = ZB + (size_t)b * S * ZBW + ZB_KS + g * 64; const bf16_t* VS = ZB + (size_t)b * S * ZBW + ZB_VS + g * 64;
        Soft ss; ss.m = 0.f; ss.l = 0.f; o[0] = f32x16{}; o[1] = f32x16{};
        const int nsel = __builtin_popcount(un0) + __builtin_popcount(un1) + __builtin_popcount(un2) + __builtin_popcount(un3);
        int ji = 128;
#pragma unroll
        for (int k = 0; k < 3; ++k) if (k < nsel) { ji = next_bit128(un0, un1, un2, un3, ji); dma_k(sK0 + k * 8192, KS, ZBW, 64 * ji, wid, lane); dma_v(sV0 + k * 8192, VS, ZBW, 64 * ji, wid, lane); }
        int j = 128;
        for (int i = 0; i < nsel; ++i) {
            j = next_bit128(un0, un1, un2, un3, j);
            const int newer = nsel - 1 - i; AT_WAIT_NEWER(newer, 2);
            AT_WAITL(); bar();
            if (i + 3 < nsel) { ji = next_bit128(un0, un1, un2, un3, ji); dma_k(sK0 + ((i + 3) & 3) * 8192, KS, ZBW, 64 * ji, wid, lane); dma_v(sV0 + ((i + 3) & 3) * 8192, VS, ZBW, 64 * ji, wid, lane); }
            const lp sK = sK0 + (i & 3) * 8192, sV = sV0 + (i & 3) * 8192;
            const unsigned mw = (j >> 5) == 0 ? my0 : (j >> 5) == 1 ? my1 : (j >> 5) == 2 ? my2 : my3;
            const bool sel = (mw >> (j & 31)) & 1u;
            const float x0 = sel ? c2 * (float)(64 * j - t0) - ss.m : NEGS;
            f32x16 p0 = cinit(c2, hi, x0), p1 = cinit(c2, hi, sel ? x0 + c2 * 32.f : NEGS);
            qk_tile(p0, p1, sK, qr, r32, hi);
            if (j == c) mask_tile(p0, p1, 0, qi, hi);
            VFrag vf; pv_load(vf, sV, lane, hi);
            softmax_step<true>(p0, p1, ss, o, wsf, r32, hi);
            { AT_PACK(p0, p1); pv_mfma(o, vf, pw0, pw1, pw2, pw3); }
        }
        const float ls_ = halfsum(ss.l);
        acc_scaled<false>(ostage, o, ls_ > 0.f ? gt1 / ls_ : 0.f, wsf, r32, hi);
    }
    {
        const bf16_t* KW = ZB + (size_t)b * S * ZBW + ZB_KW + g * 64; const bf16_t* VW = ZB + (size_t)b * S * ZBW + ZB_VW + g * 64;
        Soft sw; sw.m = 0.f; sw.l = 0.f; o[0] = f32x16{}; o[1] = f32x16{};
        const int k0 = c >= 8 ? 0 : 8 - c, nw = 9 - k0;
        AT_WAITL(); bar();
#pragma unroll
        for (int k = 0; k < 3; ++k) if (k < nw) { dma_k(sK0 + k * 8192, KW, ZBW, t0 - 64 * k, wid, lane); dma_v(sV0 + k * 8192, VW, ZBW, t0 - 64 * k, wid, lane); }
        f32x16 pA0, pA1, pB0, pB1; float rmc;
#define WIN_STEP(C0, C1, N0, N1, I) do { const int i_ = (I); \
            if (i_ + 1 < nw) { if (i_ + 2 < nw) AT_WAITV(2); else AT_WAITV(0); } \
            AT_WAITL(); bar(); \
            if (i_ + 3 < nw) { dma_k(sK0 + ((i_ + 3) & 3) * 8192, KW, ZBW, t0 - 64 * (i_ + 3), wid, lane); dma_v(sV0 + ((i_ + 3) & 3) * 8192, VW, ZBW, t0 - 64 * (i_ + 3), wid, lane); } \
            if (__any(rmc > MAXTHR)) { \
                const float dl = __builtin_fmaxf(rmc, 0.f); sw.m += dl; \
                _Pragma("unroll") for (int r = 0; r < 16; ++r) { C0[r] -= dl; C1[r] -= dl; } \
                const float al = __builtin_amdgcn_exp2f(-dl); sw.l *= al; \
                if (hi == 0) wsf[r32] = al; \
                wsync(); \
                _Pragma("unroll") for (int r = 0; r < 16; ++r) { const float f = wsf[crow(r, hi)]; o[0][r] *= f; o[1][r] *= f; } \
                wsync(); \
            } \
            { const float x0 = c2 * (float)(-64 * (i_ + 1)) - sw.m; \
              N0 = cinit(c2, hi, x0); N1 = cinit(c2, hi, x0 + c2 * 32.f); \
              if (i_ + 1 == 8) mask_init_lo(N0, N1, qi + 1, hi); }        \
            const PipeOut po = pipe_step(C0, C1, N0, N1, o, sK0 + ((i_ + 1) & 3) * 8192, sV0 + (i_ & 3) * 8192, qr, lane, r32, hi); \
            sw.l += po.s; rmc = po.rmn; } while (0)
        { if (nw >= 3) AT_WAITV(4); else if (nw == 2) AT_WAITV(2); else AT_WAITV(0);
          AT_WAITL(); bar(); }
        { pB0 = cinit(c2, hi, 0.f); pB1 = cinit(c2, hi, c2 * 32.f);
          qk_tile(pB0, pB1, sK0, qr, r32, hi);
          mask_tile(pB0, pB1, 0, qi, hi);
          rmc = rowmax(pB0, pB1); }
        int i = 0;
#pragma unroll 1
        for (; i + 1 < nw; i += 2) {
            WIN_STEP(pB0, pB1, pA0, pA1, i);
            WIN_STEP(pA0, pA1, pB0, pB1, i + 1);
        }
        if (i < nw) WIN_STEP(pB0, pB1, pA0, pA1, i);
#undef WIN_STEP
        const float lw = halfsum(sw.l);
        acc_scaled<false>(ostage, o, lw > 0.f ? gt2 / lw : 0.f, wsf, r32, hi);
    }
    {
        bf16_t* AB = (bf16_t*)(p.ws + WS_ATTB);
#pragma unroll
        for (int i = 0; i < 4; ++i) { const int row = i * 8 + (lane >> 3), ch = lane & 7; const float4 a = *(const float4*)(ostage + row * 64 + ch * 8), c4 = *(const float4*)(ostage + row * 64 + ch * 8 + 4);
            const uint4 v = make_uint4(pk2(a.x, a.y), pk2(a.z, a.w), pk2(c4.x, c4.y), pk2(c4.z, c4.w));
            *(uint4*)(AB + ((size_t)b * S + t0 + 8 * wid + (row & 7)) * D + (4 * g + (row >> 3)) * 64 + ch * 8) = v; }
        wsync();
    }
    AT_WAITL(); bar();
}

}

constexpr int MB_CAP = 25600;
namespace at {
__device__ __forceinline__ void moba_route_unit(const Params& p, int b, int h, int qb, unsigned char* lds_raw) {
    const int tid = otid(), lane = tid & 63, r32 = lane & 31, hi = lane >> 5, wid = __builtin_amdgcn_readfirstlane(tid >> 6);
    lp lds = (lp)lds_raw;
    const bf16_t* ZB = (const bf16_t*)(p.ws + WS_ZB);
    const int bh = b * 8 + h;
    const bf16_t* KMB = (const bf16_t*)(p.ws + WS_KMB) + (size_t)bh * 32 * 64;
    const int qi = 32 * wid + r32, t = qb * 256 + qi; const size_t tt = (size_t)b * S + t;
    int* hist = (int*)(lds_raw + L_UNI);
    unsigned* SEL3 = (unsigned*)(p.ws + WS_SEL3); unsigned* LRK = (unsigned*)(p.ws + WS_LRK);
    unsigned char* IL = (unsigned char*)(p.ws + WS_ILIST) + ((size_t)(bh * 32 + qb) * 32) * 256;
    int* BCm = (int*)(p.ws + WS_BCM) + (size_t)(bh * 32 + qb) * 32;
    if (tid < 32) hist[tid] = 0;
    bf16x8 qr[4];
#pragma unroll
    for (int d0 = 0; d0 < 4; ++d0) qr[d0] = *(const bf16x8*)(ZB + tt * ZBW + ZB_MQ + h * 64 + d0 * 16 + hi * 8);
    const lp sKM = lds + L_KMT;
    glds(KMB + (size_t)(lane & 31) * 64 + wid * 8, sKM + wid * 1024);
    AT_WAITV(0); AT_WAITL(); bar();
    f32x16 g0 = f32x16{}, g1 = f32x16{};
    qk_tile(g0, g1, sKM, qr, r32, hi);
    float v1 = NEGS, v2 = NEGS, v3 = NEGS; int i1 = 64, i2 = 64, i3 = 64;
#pragma unroll
    for (int r = 0; r < 16; ++r) { const int n = crow(r, hi); const float s_ = n < qb ? g0[r] : NEGS;
        if (s_ > v1) { v3 = v2; i3 = i2; v2 = v1; i2 = i1; v1 = s_; i1 = n; } else if (s_ > v2) { v3 = v2; i3 = i2; v2 = s_; i2 = n; } else if (s_ > v3) { v3 = s_; i3 = n; } }
    float ov[3]; int oi[3];
    { auto a = __builtin_amdgcn_permlane32_swap(__float_as_uint(v1), __float_as_uint(v1), false, false); ov[0] = __uint_as_float(hi ? a[0] : a[1]); }
    { auto a = __builtin_amdgcn_permlane32_swap(__float_as_uint(v2), __float_as_uint(v2), false, false); ov[1] = __uint_as_float(hi ? a[0] : a[1]); }
    { auto a = __builtin_amdgcn_permlane32_swap(__float_as_uint(v3), __float_as_uint(v3), false, false); ov[2] = __uint_as_float(hi ? a[0] : a[1]); }
    { auto a = __builtin_amdgcn_permlane32_swap((unsigned)i1, (unsigned)i1, false, false); oi[0] = (int)(hi ? a[0] : a[1]); }
    { auto a = __builtin_amdgcn_permlane32_swap((unsigned)i2, (unsigned)i2, false, false); oi[1] = (int)(hi ? a[0] : a[1]); }
    { auto a = __builtin_amdgcn_permlane32_swap((unsigned)i3, (unsigned)i3, false, false); oi[2] = (int)(hi ? a[0] : a[1]); }
#pragma unroll
    for (int k = 0; k < 3; ++k) { const float s_ = ov[k]; const int n = oi[k];
        if (s_ > v1 || (s_ == v1 && n < i1)) { v3 = v2; i3 = i2; v2 = v1; i2 = i1; v1 = s_; i1 = n; }
        else if (s_ > v2 || (s_ == v2 && n < i2)) { v3 = v2; i3 = i2; v2 = s_; i2 = n; }
        else if (s_ > v3 || (s_ == v3 && n < i3)) { v3 = s_; i3 = n; } }
    if (hi == 0) {
        const int j1 = v1 > NEGS ? i1 : 255, j2 = v2 > NEGS ? i2 : 255, j3 = v3 > NEGS ? i3 : 255;
        int l1 = 0, l2 = 0, l3 = 0;
        if (j1 < 32) { l1 = atomicAdd(&hist[j1], 1); IL[j1 * 256 + l1] = (unsigned char)qi; }
        if (j2 < 32) { l2 = atomicAdd(&hist[j2], 1); IL[j2 * 256 + l2] = (unsigned char)qi; }
        if (j3 < 32) { l3 = atomicAdd(&hist[j3], 1); IL[j3 * 256 + l3] = (unsigned char)qi; }
        SEL3[tt * 8 + h] = (unsigned)j1 | ((unsigned)j2 << 8) | ((unsigned)j3 << 16);
        LRK[tt * 8 + h] = (unsigned)l1 | ((unsigned)l2 << 8) | ((unsigned)l3 << 16);
    }
    AT_WAITL(); bar();
    if (tid < 32) BCm[tid] = hist[tid];
    AT_WAITL(); bar();
}
__device__ __forceinline__ void moba_tables(const int* BCmbh, int lane, int& tot, int& seg) {
    int s = 0;
    if (lane < 32) { for (int q = 0; q < 32; ++q) s += BCmbh[q * 32 + lane]; }
    tot = s;
    int pad = (s + 31) & ~31, inc = pad;
#pragma unroll
    for (int sft = 1; sft < 32; sft <<= 1) { const int o_ = __shfl_up(inc, sft); if ((lane & 31) >= sft) inc += o_; }
    seg = inc - pad;
}
__device__ __forceinline__ void moba_gather_unit(const Params& p, int bh, int j, int ch, int segj, bool reload, unsigned char* lds_raw) {
    const int tid = otid(), lane = tid & 63, r32 = lane & 31, hi = lane >> 5, wid = __builtin_amdgcn_readfirstlane(tid >> 6);
    lp lds = (lp)lds_raw;
    const int b = bh >> 3, h = bh & 7;
    const bf16_t* ZB = (const bf16_t*)(p.ws + WS_ZB);
    const int* BCmbh = (const int*)(p.ws + WS_BCM) + (size_t)bh * 32 * 32;
    float* wsf = (float*)(lds_raw + L_WSF) + wid * 64;
    const lp sK0 = lds + L_K, sV0 = lds + L_V;
    const bf16_t* KM_ = ZB + (size_t)b * S * ZBW + ZB_MK + h * 64; const bf16_t* VM_ = ZB + (size_t)b * S * ZBW + ZB_MV + h * 64;
    if (reload) {
#pragma unroll
        for (int k = 3; k >= 0; --k) { dma_k(sK0 + k * 8192, KM_, ZBW, j * 256 + 64 * k, wid, lane); dma_v(sV0 + k * 8192, VM_, ZBW, j * 256 + 64 * k, wid, lane); }
    }
    const int gr = 256 * ch + 32 * wid + r32;
    const int cq = lane < 32 ? BCmbh[lane * 32 + j] : 0;
    int run = 0, qbs = j + 1, lr = 0;
#pragma unroll 4
    for (int q = 0; q < 32; ++q) { const int c_ = __builtin_amdgcn_readlane(cq, q); if (gr >= run && gr < run + c_) { qbs = q; lr = gr - run; } run += c_; }
    const int totj = run;
    const bool valid = gr < totj;
    const unsigned char* IL = (const unsigned char*)(p.ws + WS_ILIST);
    const int qidx = valid ? (int)IL[((size_t)(bh * 32 + qbs) * 32 + j) * 256 + lr] : 0;
    const int t = valid ? qbs * 256 + qidx : (j + 1) * 256; const size_t tt = (size_t)b * S + t;
    const float c2 = exp2f(-(float)(h + 1)) * LOG2E;
    bf16x8 qr[4];
#pragma unroll
    for (int d0 = 0; d0 < 4; ++d0) qr[d0] = *(const bf16x8*)(ZB + tt * ZBW + ZB_MQ + h * 64 + d0 * 16 + hi * 8);
    Soft sm; sm.m = 0.f; sm.l = 0.f; f32x16 o[2]; o[0] = f32x16{}; o[1] = f32x16{};
#pragma unroll 1
    for (int i = 0; i < 4; ++i) {
        if (reload) { const int newer = 3 - i; if (newer >= 3) AT_WAITV(6); else AT_WAIT_NEWER(newer, 2); AT_WAITL(); bar(); }
        const int kt = 3 - i;
        const lp sK = sK0 + kt * 8192, sV = sV0 + kt * 8192;
        const float x0 = c2 * (float)(64 * kt) - sm.m;
        f32x16 p0 = cinit(c2, hi, x0), p1 = cinit(c2, hi, x0 + c2 * 32.f);
        qk_tile(p0, p1, sK, qr, r32, hi);
        VFrag vf; pv_load(vf, sV, lane, hi);
        softmax_step<true>(p0, p1, sm, o, wsf, r32, hi);
        { AT_PACK(p0, p1); pv_mfma(o, vf, pw0, pw1, pw2, pw3); }
    }
    {
        const float lt = halfsum(sm.l);
        float* PM = (float*)(p.ws + WS_PM) + (size_t)bh * MB_CAP; float* PL = (float*)(p.ws + WS_PL) + (size_t)bh * MB_CAP;
        if (hi == 0 && valid) { PM[segj + gr] = sm.m; PL[segj + gr] = lt; }
        bf16_t* stg = (bf16_t*)(lds_raw + L_OST) + wid * 4096;
#pragma unroll
        for (int r = 0; r < 16; ++r) { const int orow = crow(r, hi); stg[orow * 64 + r32] = (bf16_t)f2bf(o[0][r]); stg[orow * 64 + 32 + r32] = (bf16_t)f2bf(o[1][r]); }
        wsync();
        bf16_t* PO = (bf16_t*)(p.ws + WS_PO) + ((size_t)bh * MB_CAP + segj + 256 * ch + 32 * wid) * 64;
        const int nrow = totj - (256 * ch + 32 * wid);
#pragma unroll
        for (int i = 0; i < 4; ++i) { const int row = i * 8 + (lane >> 3), c8 = lane & 7; if (row < nrow) *(uint4*)(PO + (size_t)row * 64 + c8 * 8) = *(const uint4*)(stg + row * 64 + c8 * 8); }
        wsync();
    }
    AT_WAITL(); bar();
}
__device__ __forceinline__ void moba_self_unit(const Params& p, int b, int h, int qb, unsigned char* lds_raw) {
    const int tid = otid(), lane = tid & 63, r32 = lane & 31, hi = lane >> 5, wid = __builtin_amdgcn_readfirstlane(tid >> 6);
    lp lds = (lp)lds_raw;
    const int bh = b * 8 + h;
    const bf16_t* ZB = (const bf16_t*)(p.ws + WS_ZB);
    const int* BCmbh = (const int*)(p.ws + WS_BCM) + (size_t)bh * 32 * 32;
    const int qi = 32 * wid + r32, t = qb * 256 + qi; const size_t tt = (size_t)b * S + t;
    float* wsf = (float*)(lds_raw + L_WSF) + wid * 64;
    float* ostage = (float*)(lds_raw + L_OST) + wid * 2048;
    const float c2 = exp2f(-(float)(h + 1)) * LOG2E;
    bf16x8 qr[4];
#pragma unroll
    for (int d0 = 0; d0 < 4; ++d0) qr[d0] = *(const bf16x8*)(ZB + tt * ZBW + ZB_MQ + h * 64 + d0 * 16 + hi * 8);
    const lp sK0 = lds + L_K, sV0 = lds + L_V;
    const bf16_t* KM_ = ZB + (size_t)b * S * ZBW + ZB_MK + h * 64; const bf16_t* VM_ = ZB + (size_t)b * S * ZBW + ZB_MV + h * 64;
    Soft sm; sm.m = 0.f; sm.l = 0.f; f32x16 o[2]; o[0] = f32x16{}; o[1] = f32x16{};
#pragma unroll
    for (int k = 0; k < 3; ++k) { dma_k(sK0 + k * 8192, KM_, ZBW, qb * 256 + 64 * (3 - k), wid, lane); dma_v(sV0 + k * 8192, VM_, ZBW, qb * 256 + 64 * (3 - k), wid, lane); }
    int tot, seg; moba_tables(BCmbh, lane, tot, seg);
    int before = 0; if (lane < 32) { for (int q = 0; q < qb; ++q) before += BCmbh[q * 32 + lane]; }
    const int base = seg + before;
#pragma unroll 1
    for (int i = 0; i < 4; ++i) {
        const int newer = 3 - i; AT_WAIT_NEWER(newer, 2);
        AT_WAITL(); bar();
        if (i == 0) { dma_k(sK0 + 3 * 8192, KM_, ZBW, qb * 256, wid, lane); dma_v(sV0 + 3 * 8192, VM_, ZBW, qb * 256, wid, lane); }
        const lp sK = sK0 + i * 8192, sV = sV0 + i * 8192;
        const int kt = 3 - i;
        const bool skip = (32 * wid + 31 < 64 * kt);
        if (!skip) {
            const float x0 = c2 * (float)(64 * kt) - sm.m;
            f32x16 p0 = cinit(c2, hi, x0), p1 = cinit(c2, hi, x0 + c2 * 32.f);
            qk_tile(p0, p1, sK, qr, r32, hi);
            if (64 * kt + 63 > 32 * wid) mask_tile(p0, p1, 0, qi - 64 * kt, hi);
            VFrag vf; pv_load(vf, sV, lane, hi);
            softmax_step<true>(p0, p1, sm, o, wsf, r32, hi);
            { AT_PACK(p0, p1); pv_mfma(o, vf, pw0, pw1, pw2, pw3); }
        }
    }
    {
        const float lself = halfsum(sm.l);
        const unsigned s3 = ((const unsigned*)(p.ws + WS_SEL3))[tt * 8 + h], l3 = ((const unsigned*)(p.ws + WS_LRK))[tt * 8 + h];
        const float* PM = (const float*)(p.ws + WS_PM) + (size_t)bh * MB_CAP; const float* PL = (const float*)(p.ws + WS_PL) + (size_t)bh * MB_CAP;
        float mk[3], lk[3]; int pidx[3];
        float M = sm.m + c2 * 256.f * (float)qb;
        const float mself = M;
#pragma unroll
        for (int k = 0; k < 3; ++k) { const int jk = (s3 >> (8 * k)) & 255, lrk = (l3 >> (8 * k)) & 255;
            const int pb = __shfl(base, jk & 31);
            if (jk < 32) { pidx[k] = pb + lrk; mk[k] = PM[pidx[k]] + c2 * 256.f * (float)jk; lk[k] = PL[pidx[k]]; M = __builtin_fmaxf(M, mk[k]); }
            else { pidx[k] = -1; mk[k] = NEGS; lk[k] = 0.f; } }
        const float ws_ = __builtin_amdgcn_exp2f(mself - M);
        float wk[3]; float Lt = lself * ws_;
#pragma unroll
        for (int k = 0; k < 3; ++k) { wk[k] = pidx[k] >= 0 ? __builtin_amdgcn_exp2f(mk[k] - M) : 0.f; Lt += lk[k] * wk[k]; }
        const float inv = Lt > 0.f ? 1.f / Lt : 0.f;
        float* rws = wsf;
        float* rwk = (float*)(lds_raw + L_KMT) + wid * 256;
        int* rpi = (int*)(rwk + 96);
        if (hi == 0) { rws[r32] = ws_ * inv;
#pragma unroll
            for (int k = 0; k < 3; ++k) { rwk[k * 32 + r32] = wk[k] * inv; rpi[k * 32 + r32] = pidx[k]; } }
#pragma unroll
        for (int r = 0; r < 16; ++r) { const int orow = crow(r, hi); ostage[orow * 64 + r32] = o[0][r]; ostage[orow * 64 + 32 + r32] = o[1][r]; }
        wsync();
        const bf16_t* PO = (const bf16_t*)(p.ws + WS_PO) + (size_t)bh * MB_CAP * 64;
        bf16_t* AB = (bf16_t*)(p.ws + WS_ATTB);
#pragma unroll
        for (int i = 0; i < 4; ++i) { const int row = i * 8 + (lane >> 3), c8 = lane & 7;
            const float4 a = *(const float4*)(ostage + row * 64 + c8 * 8), c4 = *(const float4*)(ostage + row * 64 + c8 * 8 + 4);
            const float w0 = rws[row];
            float acc8[8] = {a.x * w0, a.y * w0, a.z * w0, a.w * w0, c4.x * w0, c4.y * w0, c4.z * w0, c4.w * w0};
#pragma unroll
            for (int k = 0; k < 3; ++k) { const int pi = rpi[k * 32 + row]; if (pi >= 0) { const float w = rwk[k * 32 + row]; const uint4 q = *(const uint4*)(PO + (size_t)pi * 64 + c8 * 8);
                const unsigned qq_[4] = {q.x, q.y, q.z, q.w};
#pragma unroll
                for (int e = 0; e < 4; ++e) { acc8[2 * e] += __builtin_bit_cast(float, qq_[e] << 16) * w; acc8[2 * e + 1] += __builtin_bit_cast(float, qq_[e] & 0xffff0000u) * w; } } }
            *(uint4*)(AB + ((size_t)b * S + qb * 256 + 32 * wid + row) * D + 512 + h * 64 + c8 * 8) = make_uint4(pk2(acc8[0], acc8[1]), pk2(acc8[2], acc8[3]), pk2(acc8[4], acc8[5]), pk2(acc8[6], acc8[7])); }
        wsync();
    }
    AT_WAITL(); bar();
}
}

__device__ __forceinline__ void phase_att1(const Params& p, unsigned char* lds_raw) {
    const int tid = otid();
    int* pre = (int*)(lds_raw + at::L_END);
    int* segt = pre + 514;
    { const int* BCm = (const int*)(p.ws + WS_BCM); const int bh = tid >> 5, j = tid & 31; int s = 0;
      for (int q = 0; q < 32; ++q) s += BCm[(size_t)(bh * 32 + q) * 32 + j];
      pre[tid + 1] = (s + 255) >> 8; if (tid == 0) pre[0] = 0;
      segt[tid] = (s + 31) & ~31; }
    __syncthreads();
    for (int sft = 1; sft < 512; sft <<= 1) { int v = 0, w = 0; if (tid >= sft) v = pre[tid + 1 - sft]; if ((tid & 31) >= sft) w = segt[tid - sft]; __syncthreads(); pre[tid + 1] += v; if (sft < 32) segt[tid] += w; __syncthreads(); }
    { const int* BCm = (const int*)(p.ws + WS_BCM); const int bh = tid >> 5, j = tid & 31; int s = 0;
      for (int q = 0; q < 32; ++q) s += BCm[(size_t)(bh * 32 + q) * 32 + j];
      const int excl = segt[tid] - ((s + 31) & ~31); __syncthreads(); segt[tid] = excl; }
    __syncthreads();
    const int nun = pre[512];
    for (int pi = blockIdx.x; pi < 512; pi += gridDim.x) {
        const int rnd = pi >> 8, id = pi & 255;
        const int bg = 2 * rnd + (id >> 7), c = rnd ? 127 - (id & 127) : (id & 127); at::nsa_unit(p, bg >> 1, bg & 1, c, lds_raw);
    }
    {
        const int u0 = (int)(((long)blockIdx.x * nun) / gridDim.x), u1 = (int)(((long)(blockIdx.x + 1) * nun) / gridDim.x);
        int prev = -1;
        for (int u = u0; u < u1; ++u) {
            int lo = 0, hi_ = 511;
            while (lo < hi_) { const int mid = (lo + hi_ + 1) >> 1; if (pre[mid] <= u) lo = mid; else hi_ = mid - 1; }
            at::moba_gather_unit(p, lo >> 5, lo & 31, u - pre[lo], segt[lo], lo != prev, lds_raw);
            prev = lo;
        }
    }
}
__device__ __forceinline__ void phase_att2(const Params& p, unsigned char* lds_raw) {
    for (int pi = blockIdx.x; pi < 512; pi += gridDim.x) {
        const int rnd = pi >> 8, id = pi & 255;
        const int bh = 8 * rnd + (id >> 5), qb = rnd ? 31 - (id & 31) : (id & 31); at::moba_self_unit(p, bh >> 3, bh & 7, qb, lds_raw);
    }
}
__device__ __forceinline__ void phase_route(const Params& p, unsigned char* lds_raw) {
    for (int pi = blockIdx.x; pi < 512; pi += gridDim.x) at::moba_route_unit(p, pi >> 8, (pi >> 5) & 7, pi & 31, lds_raw);
}


__device__ __forceinline__ void phase_r2_fast(const Params& p, int l, unsigned char* lds_raw) {
    using namespace at;
    const int tid = otid(), lane = tid & 63, wave = __builtin_amdgcn_readfirstlane(tid >> 6), r32 = lane & 31, hi = lane >> 5;
    const float* mod = (const float*)(p.ws + WS_MOD);
    const bf16_t* XAB = (const bf16_t*)(p.ws + WS_XAB); bf16_t* XN = (bf16_t*)(p.ws + WS_XN); bf16_t* XL = (bf16_t*)(p.ws + WS_XNLO);
    const float* lng = p.in[5] + (size_t)l * D; const float* rw = p.in[15] + (size_t)l * D * NE; const float* rb = p.in[16] + l * NE;
    int* toke = (int*)(p.ws + WS_TOKE); float* tokw = (float*)(p.ws + WS_TOKW); int* BC = (int*)(p.ws + WS_BC);
    lp lds = (lp)lds_raw;
    int* hist = (int*)(lds_raw + 131072);
    for (int blk = blockIdx.x; blk < T / 64; blk += gridDim.x) {
        for (int idx = tid; idx < 128 * 32; idx += NT) {
            const int kc = idx >> 5, e = idx & 31; float v[8];
#pragma unroll
            for (int j = 0; j < 8; ++j) v[j] = rw[(size_t)(8 * kc + j) * NE + e];
            unsigned hh[8], ll[8];
#pragma unroll
            for (int j = 0; j < 8; ++j) { hh[j] = f2bf(v[j]); ll[j] = f2bf(v[j] - __builtin_bit_cast(float, hh[j] << 16)); }
            *(uint4*)(lds_raw + (size_t)idx * 16) = make_uint4(hh[0] | (hh[1] << 16), hh[2] | (hh[3] << 16), hh[4] | (hh[5] << 16), hh[6] | (hh[7] << 16));
            *(uint4*)(lds_raw + 65536 + (size_t)idx * 16) = make_uint4(ll[0] | (ll[1] << 16), ll[2] | (ll[3] << 16), ll[4] | (ll[5] << 16), ll[6] | (ll[7] << 16));
        }
        if (tid < 32) hist[tid] = 0;
        {
            const int b = (blk * 64) / S;
            const float* sh = mod + ((size_t)l * Bn + b) * 6144 + 3 * D; const float* sc = mod + ((size_t)l * Bn + b) * 6144 + 4 * D;
            float4 ga[4], s0v[4];
#pragma unroll
            for (int j = 0; j < 4; ++j) { const int col = 4 * lane + 256 * j; const float4 g = *(const float4*)(lng + col), s1 = *(const float4*)(sc + col); s0v[j] = *(const float4*)(sh + col);
                ga[j] = make_float4(g.x * (1.f + s1.x), g.y * (1.f + s1.y), g.z * (1.f + s1.z), g.w * (1.f + s1.w)); }
#pragma unroll 1
            for (int i0 = 0; i0 < 8; i0 += 4) {
                uint2 q_[4][4];
#pragma unroll
                for (int i = 0; i < 4; ++i)
#pragma unroll
                    for (int j = 0; j < 4; ++j) q_[i][j] = *(const uint2*)(XAB + (size_t)(blk * 64 + wave * 8 + i0 + i) * D + 4 * lane + 256 * j);
                float ss[4];
#pragma unroll
                for (int i = 0; i < 4; ++i) { float s_ = 0.f;
#pragma unroll
                    for (int j = 0; j < 4; ++j) { const float x0 = __builtin_bit_cast(float, q_[i][j].x << 16), x1 = __builtin_bit_cast(float, q_[i][j].x & 0xffff0000u), x2 = __builtin_bit_cast(float, q_[i][j].y << 16), x3 = __builtin_bit_cast(float, q_[i][j].y & 0xffff0000u);
                        s_ += (x0 * x0 + x1 * x1) + (x2 * x2 + x3 * x3); }
                    ss[i] = s_; }
#pragma unroll
                for (int sft = 32; sft >= 1; sft >>= 1) {
#pragma unroll
                    for (int i = 0; i < 4; ++i) ss[i] += __shfl_xor(ss[i], sft); }
#pragma unroll
                for (int i = 0; i < 4; ++i) {
                    const int t = blk * 64 + wave * 8 + i0 + i;
                    const float r = rsqrtf(ss[i] * (1.f / D) + EPS);
#pragma unroll
                    for (int j = 0; j < 4; ++j) {
                        const int col = 4 * lane + 256 * j;
                        const float x0 = __builtin_bit_cast(float, q_[i][j].x << 16), x1 = __builtin_bit_cast(float, q_[i][j].x & 0xffff0000u), x2 = __builtin_bit_cast(float, q_[i][j].y << 16), x3 = __builtin_bit_cast(float, q_[i][j].y & 0xffff0000u);
                        const float o[4] = {x0 * r * ga[j].x + s0v[j].x, x1 * r * ga[j].y + s0v[j].y, x2 * r * ga[j].z + s0v[j].z, x3 * r * ga[j].w + s0v[j].w};
                        unsigned hh[4], ll[4];
#pragma unroll
                        for (int q = 0; q < 4; ++q) { hh[q] = f2bf(o[q]); ll[q] = f2bf(o[q] - __builtin_bit_cast(float, hh[q] << 16)); }
                        *(uint2*)(XN + (size_t)t * D + col) = make_uint2(hh[0] | (hh[1] << 16), hh[2] | (hh[3] << 16));
                        *(uint2*)(XL + (size_t)t * D + col) = make_uint2(ll[0] | (ll[1] << 16), ll[2] | (ll[3] << 16));
                        *(unsigned*)(p.ws + WS_XN8 + (size_t)t * D + col) = pk_fp8x4(o[0] * XS8, o[1] * XS8, o[2] * XS8, o[3] * XS8);
                    }
                }
            }
        }
        asm volatile("s_waitcnt vmcnt(0)" ::: "memory");
        __syncthreads();
        f32x16 acc = f32x16{};
        {
            const int rh = wave & 1, kq = wave >> 1;
            const int t = blk * 64 + rh * 32 + r32;
            const bf16_t* xh = XN + (size_t)t * D + 8 * hi + 256 * kq; const bf16_t* xl = XL + (size_t)t * D + 8 * hi + 256 * kq;
            const AT_LAS unsigned char* wh = lds + (size_t)(hi * 32 + r32) * 16 + (size_t)kq * 16 * 1024; const AT_LAS unsigned char* wl = wh + 65536;
#pragma unroll 8
            for (int ks = 0; ks < 16; ++ks) {
                const bf16x8 bh = *(const bf16x8*)(xh + 16 * ks), bl = *(const bf16x8*)(xl + 16 * ks);
                const bf16x8 ah = *(const AT_LAS bf16x8*)(wh + ks * 1024), al = *(const AT_LAS bf16x8*)(wl + ks * 1024);
                acc = __builtin_amdgcn_mfma_f32_32x32x16_bf16(ah, bh, acc, 0, 0, 0);
                acc = __builtin_amdgcn_mfma_f32_32x32x16_bf16(al, bh, acc, 0, 0, 0);
                acc = __builtin_amdgcn_mfma_f32_32x32x16_bf16(ah, bl, acc, 0, 0, 0);
            }
        }
        __syncthreads();
        { float* part = (float*)lds_raw;
          if (wave >= 2) {
#pragma unroll
              for (int r = 0; r < 16; ++r) part[(wave * 16 + r) * 64 + lane] = acc[r]; } }
        __syncthreads();
        if (wave < 2) {
            const int t = blk * 64 + wave * 32 + r32;
            { const float* part = (const float*)lds_raw;
#pragma unroll
              for (int r = 0; r < 16; ++r) acc[r] = ((acc[r] + part[((wave + 2) * 16 + r) * 64 + lane]) + part[((wave + 4) * 16 + r) * 64 + lane]) + part[((wave + 6) * 16 + r) * 64 + lane]; }
            float a0 = -3e38f, a1 = -3e38f, a2 = -3e38f, a3 = -3e38f; int i0 = 99, i1 = 99, i2 = 99, i3 = 99;
#pragma unroll
            for (int r = 0; r < 16; ++r) { const int e = crow(r, hi); const float s_ = acc[r] + rb[e];
                if (s_ > a0) { a3 = a2; i3 = i2; a2 = a1; i2 = i1; a1 = a0; i1 = i0; a0 = s_; i0 = e; }
                else if (s_ > a1) { a3 = a2; i3 = i2; a2 = a1; i2 = i1; a1 = s_; i1 = e; }
                else if (s_ > a2) { a3 = a2; i3 = i2; a2 = s_; i2 = e; }
                else if (s_ > a3) { a3 = s_; i3 = e; } }
            float ov[4]; int oi[4];
            { const float sv[4] = {a0, a1, a2, a3}; const int si[4] = {i0, i1, i2, i3};
#pragma unroll
              for (int k = 0; k < 4; ++k) { auto a = __builtin_amdgcn_permlane32_swap(__float_as_uint(sv[k]), __float_as_uint(sv[k]), false, false); ov[k] = __uint_as_float(hi ? a[0] : a[1]);
                                            auto c = __builtin_amdgcn_permlane32_swap((unsigned)si[k], (unsigned)si[k], false, false); oi[k] = (int)(hi ? c[0] : c[1]); } }
#pragma unroll
            for (int k = 0; k < 4; ++k) { const float s_ = ov[k]; const int e = oi[k];
                if (s_ > a0 || (s_ == a0 && e < i0)) { a3 = a2; i3 = i2; a2 = a1; i2 = i1; a1 = a0; i1 = i0; a0 = s_; i0 = e; }
                else if (s_ > a1 || (s_ == a1 && e < i1)) { a3 = a2; i3 = i2; a2 = a1; i2 = i1; a1 = s_; i1 = e; }
                else if (s_ > a2 || (s_ == a2 && e < i2)) { a3 = a2; i3 = i2; a2 = s_; i2 = e; }
                else if (s_ > a3 || (s_ == a3 && e < i3)) { a3 = s_; i3 = e; } }
            const float e1 = __expf(a1 - a0), e2 = __expf(a2 - a0), e3 = __expf(a3 - a0), inv = 1.f / (((1.f + e1) + e2) + e3);
            if (hi == 0) {
                *(int4*)(toke + (size_t)t * 4) = make_int4(i0, i1, i2, i3);
                *(float4*)(tokw + (size_t)t * 4) = make_float4(inv, e1 * inv, e2 * inv, e3 * inv);
                atomicAdd(&hist[i0], 1); atomicAdd(&hist[i1], 1); atomicAdd(&hist[i2], 1); atomicAdd(&hist[i3], 1);
            }
        }
        __syncthreads();
        if (tid < 32) BC[blk * 32 + tid] = hist[tid];
        __syncthreads();
    }
}
__device__ __forceinline__ void phase_sc_fast(const Params& p, int l, unsigned char* lds_raw) {
    const int tid = otid();
    const int* BC = (const int*)(p.ws + WS_BC);
    int* cnt = (int*)(p.ws + WS_CNT) + l * 32;
    int* tot = (int*)lds_raw; int* base = tot + 32; int* fillc = tot + 64; int* before = tot + 96;
    const int* toke = (const int*)(p.ws + WS_TOKE); const float* tokw = (const float*)(p.ws + WS_TOKW);
    int* rowtok = (int*)(p.ws + WS_ROWTOK) + (size_t)l * RMAX; float* roww = (float*)(p.ws + WS_ROWW) + (size_t)l * RMAX; int* pos = (int*)(p.ws + WS_POS);
    for (int blk = blockIdx.x; blk < T / 64; blk += gridDim.x) {
        { const int e = tid & 31, part = tid >> 5; int s = 0, bf = 0;
#pragma unroll 4
          for (int i = part * 16; i < part * 16 + 16; ++i) { const int c = BC[i * 32 + e]; s += c; if (i < blk) bf += c; }
          int* ptot = tot + 128; int* pbef = ptot + 512;
          ptot[tid] = s; pbef[tid] = bf; }
        __syncthreads();
        if (tid < 32) { const int* ptot = tot + 128; const int* pbef = ptot + 512; int s = 0, bf = 0;
#pragma unroll
            for (int q = 0; q < 16; ++q) { s += ptot[q * 32 + tid]; bf += pbef[q * 32 + tid]; }
            tot[tid] = s; before[tid] = bf; fillc[tid] = 0; if (blk == 0) cnt[tid] = s; }
        __syncthreads();
        if (tid == 0) { int s = 0; for (int e = 0; e < 32; ++e) { base[e] = s + before[e]; s += (tot[e] + 255) & ~255; } }
        __syncthreads();
        if (tid < 256) {
            const int i = blk * 256 + tid, e = toke[i];
            const int slot = base[e] + atomicAdd(&fillc[e], 1);
            rowtok[slot] = i >> 2; roww[slot] = tokw[i]; pos[i] = slot;
        }
        __syncthreads();
    }
}

#define XB_TMO      128
#define XB_XCNT(j)  (256  + 64 * (j))
#define XB_XSUB(j)  (1280 + 64 * (j))
#define XB_XGEN(j)  (2304 + 64 * (j))
#define XB_TOP      3328
#define XB_TOPGEN   3392
#define XCD_BAR_WORDS 3456
#define XB_SPIN_CAP (1u << 18)
#define XLAS __attribute__((address_space(3)))
__device__ __forceinline__ unsigned xb_ld(unsigned* p)              { return __hip_atomic_load(p, __ATOMIC_RELAXED, __HIP_MEMORY_SCOPE_AGENT); }
__device__ __forceinline__ unsigned xb_add(unsigned* p, unsigned v) { return __hip_atomic_fetch_add(p, v, __ATOMIC_RELAXED, __HIP_MEMORY_SCOPE_AGENT); }
__device__ __forceinline__ unsigned xb_xcc_id() { return (unsigned)__builtin_amdgcn_s_getreg((3 << 11) | 20) & 0xFu; }
#define XB_SPIN(cond, bar) do { unsigned _sp = 0; while (cond) { __builtin_amdgcn_s_sleep(1); \
    if ((++_sp & 255u) == 0u) { if (xb_ld(&(bar)[XB_TMO])) break; if (_sp > XB_SPIN_CAP) { atomicAdd(&(bar)[XB_TMO], 1u); break; } } } } while (0)
constexpr int LDS_BARST_OFF = 147200;
struct XcdBarrier { unsigned* bar; unsigned x; volatile XLAS unsigned* st; };
__device__ __forceinline__ XcdBarrier xcd_barrier_post(unsigned* bar, volatile XLAS unsigned* st) {
    XcdBarrier b; b.bar = bar; b.x = xb_xcc_id(); b.st = st;
    if (threadIdx.x == 0) (void)xb_add(&bar[XB_XCNT(b.x)], 1u);
    return b;
}
__device__ __forceinline__ void xcd_barrier_complete(unsigned* bar, unsigned x, unsigned& nloc, unsigned& nx) {
    const unsigned G = gridDim.x * gridDim.y * gridDim.z;
    unsigned sum, cnt, mine, sp = 0u;
    for (;;) {
        sum = 0u; cnt = 0u; mine = 0u;
#pragma unroll
        for (unsigned j = 0; j < 16; ++j) { const unsigned c = xb_ld(&bar[XB_XCNT(j)]); sum += c; cnt += (c > 0u) ? 1u : 0u; mine = (j == x) ? c : mine; }
        if (sum == G) break;
        __builtin_amdgcn_s_sleep(1);
        if ((++sp & 255u) == 0u) { if (xb_ld(&bar[XB_TMO])) break; if (sp > XB_SPIN_CAP) { atomicAdd(&bar[XB_TMO], 1u); break; } }
    }
    nloc = mine > 0u ? mine : 1u; nx = cnt > 0u ? cnt : 1u;
}
__device__ __forceinline__ void xcd_barrier(unsigned char* ws, unsigned char* lds_raw_) {
    XcdBarrier b; b.bar = (unsigned*)(ws + WS_BAR); b.x = xb_xcc_id(); b.st = (volatile XLAS unsigned*)((XLAS unsigned char*)lds_raw_ + LDS_BARST_OFF);
    asm volatile("s_waitcnt vmcnt(0)" ::: "memory");
    __syncthreads();
    if (threadIdx.x == 0) {
        unsigned* bar = b.bar;
        __builtin_amdgcn_s_waitcnt(0);
        unsigned nloc = b.st[0], nx = b.st[1];
        if (nloc == 0u) { xcd_barrier_complete(bar, b.x, nloc, nx); b.st[0] = nloc; b.st[1] = nx; }
        const unsigned old = xb_add(&bar[XB_XSUB(b.x)], 1u);
        const unsigned gen = old / nloc;
        if (old + 1u == (gen + 1u) * nloc) {
            __builtin_amdgcn_fence(__ATOMIC_RELEASE, "agent");
            asm volatile("s_waitcnt vmcnt(0)" ::: "memory");
            const unsigned og = xb_add(&bar[XB_TOP], 1u);
            const unsigned tg = og / nx;
            if (og + 1u == (tg + 1u) * nx) xb_add(&bar[XB_TOPGEN], 1u);
            else XB_SPIN(xb_ld(&bar[XB_TOPGEN]) == tg, bar);
            __builtin_amdgcn_fence(__ATOMIC_ACQUIRE, "agent");
            xb_add(&bar[XB_XGEN(b.x)], 1u);
            asm volatile("s_waitcnt vmcnt(0)" ::: "memory");
        } else {
            XB_SPIN(xb_ld(&bar[XB_XGEN(b.x)]) == gen, bar);
            __builtin_amdgcn_fence(__ATOMIC_ACQUIRE, "agent");
            asm volatile("s_waitcnt vmcnt(0)" ::: "memory");
        }
    }
    __syncthreads();
}

__global__ void __launch_bounds__(NT, 2) mega_fwd(Params p) {
    extern __shared__ __attribute__((aligned(16))) unsigned char lds_raw[];
    float* lds = (float*)lds_raw;
    volatile XLAS unsigned* bst = (volatile XLAS unsigned*)((XLAS unsigned char*)lds_raw + LDS_BARST_OFF);
    if (threadIdx.x < 2) bst[threadIdx.x] = 0u;
    __syncthreads();
    (void)xcd_barrier_post((unsigned*)(p.ws + WS_BAR), bst);
#define GSYNC() xcd_barrier(p.ws, lds_raw)
    phase_p0a(p, lds);
    __syncthreads();
    phase_convert(p, lds);
    GSYNC();
    phase_p0b(p);
    GSYNC();
    _Pragma("unroll 1") for (int l = 0; l < L; ++l) {
        phase_r1(p, l, true);
        GSYNC();
        phase_g1_fast(p, l, lds_raw);
        GSYNC();
        phase_ck_fast(p, l, lds_raw);
        GSYNC();
        phase_c2(p, l, lds);
        __syncthreads();
        phase_route(p, lds_raw);
        GSYNC();
        phase_att1(p, lds_raw);
        GSYNC();
        phase_att2(p, lds_raw);
        GSYNC();
        phase_g2_fast(p, l, lds_raw);
        GSYNC();
        phase_r2_fast(p, l, lds_raw);
        GSYNC();
        phase_sc_fast(p, l, lds_raw);
        GSYNC();
        phase_m1_fast(p, l, lds_raw);
        GSYNC();
        phase_m2_fast(p, l, lds_raw);
        GSYNC();
    }
    phase_r1(p, L, false);
}

extern "C" void kernel_launch(void* const* d_in, const int* in_sizes, int n_in, void* d_out, int out_size, void* d_ws, size_t ws_size, hipStream_t stream) {
    static int grid_blocks = 0;
    if (grid_blocks == 0) {
        if (n_in != 21 || out_size != T * D || ws_size < WS_END) { fprintf(stderr, "kernel_launch: unexpected shapes (n_in %d out %d ws %zu need %zu)\n", n_in, out_size, ws_size, (size_t)WS_END); grid_blocks = -1; return; }
        int dev = 0, cus = 0, per_cu = 0;
        hipGetDevice(&dev);
        hipDeviceGetAttribute(&cus, hipDeviceAttributeMultiprocessorCount, dev);
        hipFuncSetAttribute((const void*)mega_fwd, hipFuncAttributeMaxDynamicSharedMemorySize, LDS_BYTES);
        hipOccupancyMaxActiveBlocksPerMultiprocessor(&per_cu, (const void*)mega_fwd, NT, LDS_BYTES);
        if (per_cu < 1) { fprintf(stderr, "kernel_launch: occupancy query says %d blocks per CU\n", per_cu); per_cu = 1; }
        (void)hipGetLastError();
        grid_blocks = cus * 1;
    }
    if (grid_blocks < 0) return;
    if (hipMemsetAsync((char*)d_ws + WS_BAR, 0, 16384, stream) != hipSuccess) { fprintf(stderr, "kernel_launch: memset failed\n"); return; }
    Params p{};
    for (int i = 0; i < 21; ++i) p.in[i] = (const float*)d_in[i];
    p.out = (float*)d_out; p.ws = (unsigned char*)d_ws;
    hipLaunchKernelGGL(mega_fwd, dim3(grid_blocks), dim3(NT), LDS_BYTES, stream, p);
    hipError_t e = hipPeekAtLastError();
    if (e != hipSuccess) fprintf(stderr, "launch failed: %s (grid %d)\n", hipGetErrorString(e), grid_blocks);
}
```

```cpp
#include <hip/hip_runtime.h>
#include <cstdio>
#include <cstdint>

constexpr int Bn = 2, S = 8192, D = 1024, L = 2, T = Bn * S;
constexpr int INW = 2840;
constexpr int NE = 32, TOPK = 4, DFF = 1024;
constexpr int A_TOT = T * TOPK;
constexpr int RMAX = A_TOT + NE * 256;
constexpr int NCMP = 511;
constexpr int NT = 512;
constexpr int NW = NT / 64;
constexpr int LDS_BYTES = 147456;
constexpr float EPS = 1e-6f;
constexpr float NEGF = -1e30f;

constexpr int ZBW = 3072;
constexpr int ZB_Q = 0, ZB_KC = 512, ZB_VC = 640, ZB_KS = 768, ZB_VS = 896, ZB_KW = 1024, ZB_VW = 1152, ZB_MQ = 1280, ZB_MK = 1792, ZB_MV = 2304, ZB_G = 2816;
constexpr float QSCALE = 0.125f * 1.4426950408889634f;
constexpr float LOG2E = 1.4426950408889634f;

constexpr size_t al256(size_t x) { return (x + 255) & ~(size_t)255; }
constexpr size_t WS_BAR = 0;
constexpr size_t WS_MODP = 16384;
constexpr size_t WS_MOD = al256(WS_MODP + (size_t)8 * L * Bn * 6144 * 4);
constexpr size_t WS_CNT = al256(WS_MOD + (size_t)L * Bn * 6144 * 4);
constexpr size_t WS_ROWTOK = al256(WS_CNT + L * 32 * 4);
constexpr size_t WS_ROWW = al256(WS_ROWTOK + (size_t)L * RMAX * 4);
constexpr size_t WS_TOKE = al256(WS_ROWW + (size_t)L * RMAX * 4);
constexpr size_t WS_TOKW = al256(WS_TOKE + (size_t)T * 4 * 4);
constexpr size_t WS_POS = al256(WS_TOKW + (size_t)T * 4 * 4);
constexpr size_t WS_Y = al256(WS_POS + (size_t)T * 4 * 4);
constexpr size_t WS_WINT = al256(WS_Y + (size_t)RMAX * 1024 * 4);
constexpr size_t WS_WOT = al256(WS_WINT + (size_t)L * 3072 * 1024 * 2);
constexpr size_t WS_W1T = al256(WS_WOT + (size_t)L * 1024 * 1024 * 2);
constexpr size_t WS_W2T = al256(WS_W1T + (size_t)L * NE * 2048 * 1024 * 2);
constexpr size_t WS_XN = al256(WS_W2T + (size_t)L * NE * 1024 * 1024 * 2);
constexpr size_t WS_ATTB = al256(WS_XN + (size_t)(T + 1) * D * 2);
constexpr size_t WS_ACT = al256(WS_ATTB + (size_t)T * D * 2);
constexpr size_t WS_ZB = al256(WS_ACT + (size_t)RMAX * DFF * 2);
constexpr size_t WS_GATE = al256(WS_ZB + (size_t)T * ZBW * 2);
constexpr size_t WS_KCB = al256(WS_GATE + (size_t)T * 32 * 4);
constexpr size_t WS_VCB = al256(WS_KCB + (size_t)Bn * 2 * 512 * 64 * 2);
constexpr size_t WS_KMB = al256(WS_VCB + (size_t)Bn * 2 * 512 * 64 * 2);
constexpr size_t WS_XNLO = al256(WS_KMB + (size_t)Bn * 8 * 32 * 64 * 2);
constexpr size_t WS_BC = al256(WS_XNLO + (size_t)T * D * 2);
constexpr size_t WS_WCT = al256(WS_BC + (size_t)(T / 64) * 32 * 4);
constexpr size_t WS_CBP = al256(WS_WCT + (size_t)L * 2 * 128 * 2048 * 2);
constexpr size_t WS_CB = al256(WS_CBP + (size_t)16 * L * 2 * 128 * 4);
constexpr size_t WS_HIDP = al256(WS_CB + (size_t)L * 2 * 128 * 4);
constexpr size_t WS_XAB = al256(WS_HIDP + (size_t)4 * 2 * 2044 * 128 * 4);
constexpr size_t WS_SEL3 = al256(WS_XAB + (size_t)T * D * 2);
constexpr size_t WS_LRK = al256(WS_SEL3 + (size_t)T * 8 * 4);
constexpr size_t WS_ILIST = al256(WS_LRK + (size_t)T * 8 * 4);
constexpr size_t WS_BCM = al256(WS_ILIST + (size_t)16 * 32 * 32 * 256);
constexpr size_t WS_PM = al256(WS_BCM + (size_t)16 * 32 * 32 * 4);
constexpr size_t WS_PL = al256(WS_PM + (size_t)16 * 25600 * 4);
constexpr size_t WS_PO = al256(WS_PL + (size_t)16 * 25600 * 4);
constexpr size_t WS_XN8 = al256(WS_PO + (size_t)16 * 25600 * 64 * 2);
constexpr size_t WS_DQ1 = al256(WS_XN8 + (size_t)(T + 1) * D);
constexpr size_t WS_DQ2 = al256(WS_DQ1 + (size_t)L * NE * 2048 * 4);
constexpr size_t WS_END = al256(WS_DQ2 + (size_t)L * NE * 1024 * 4);
constexpr float XS8 = 16.f, AS8 = 8.f;

struct Params {
    const float* in[21];
    float* out;
    unsigned char* ws;
};

__device__ __forceinline__ int otid() { int t = threadIdx.x; asm volatile("" : "+v"(t)); return t; }
typedef unsigned short bf16_t;
__device__ __forceinline__ unsigned f2bf(float f) { unsigned u = __builtin_bit_cast(unsigned, f); return (u + 0x7fffu + ((u >> 16) & 1u)) >> 16; }
__device__ __forceinline__ unsigned pk2(float lo, float hi) { return f2bf(lo) | (f2bf(hi) << 16); }
__device__ __forceinline__ unsigned pk_fp8x4(float a, float b, float c, float d) {
    a = __builtin_amdgcn_fmed3f(a, -448.f, 448.f); b = __builtin_amdgcn_fmed3f(b, -448.f, 448.f); c = __builtin_amdgcn_fmed3f(c, -448.f, 448.f); d = __builtin_amdgcn_fmed3f(d, -448.f, 448.f);
    int r = __builtin_amdgcn_cvt_pk_fp8_f32(a, b, 0, false);
    r = __builtin_amdgcn_cvt_pk_fp8_f32(c, d, r, true);
    return (unsigned)r; }
__device__ __forceinline__ float bf2f(bf16_t v) { return __builtin_bit_cast(float, (unsigned)v << 16); }
__device__ __forceinline__ float wave_sum(float v) {
#pragma unroll
    for (int o = 1; o < 64; o <<= 1) v += __shfl_xor(v, o);
    return v;
}
__device__ __forceinline__ float sigmoidf_(float x) { return 1.f / (1.f + __expf(-x)); }
__device__ __forceinline__ float gelu_tanh(float x) {
    const float u = 0.7978845608028654f * (x + 0.044715f * x * x * x);
    return 0.5f * x * (1.f + tanhf(u));
}

__device__ __forceinline__ void phase_p0a(const Params& p, float* lds) {
    const int tid = otid(), gtid = blockIdx.x * NT + tid, gsz = gridDim.x * NT;
    int* cnt = (int*)(p.ws + WS_CNT); int* rowtok = (int*)(p.ws + WS_ROWTOK);
    for (int i = gtid; i < L * 32; i += gsz) cnt[i] = 0;
    for (int i = gtid; i < L * RMAX; i += gsz) rowtok[i] = -1;
    const float* c = p.in[1];
    for (int i = tid; i < Bn * D; i += NT) { const float v = c[i]; lds[i] = v / (1.f + __expf(-v)); }
    __syncthreads();
    const float* ada_w = p.in[2];
    float* modp = (float*)(p.ws + WS_MODP);
    for (int idx = gtid; idx < 8 * L * 6144; idx += gsz) {
        const int col = idx % 6144, l = (idx / 6144) % L, kc = idx / (6144 * L);
        const float* w = ada_w + ((size_t)l * D + kc * 128) * 6144 + col;
        float a0 = 0.f, a1 = 0.f, c0 = 0.f, c1 = 0.f;
#pragma unroll 1
        for (int k0 = 0; k0 < 128; k0 += 32) { float wv[32];
#pragma unroll
            for (int k = 0; k < 32; ++k) wv[k] = __builtin_nontemporal_load(w + (size_t)(k0 + k) * 6144);
#pragma unroll
            for (int k = 0; k < 32; k += 2) { a0 += lds[kc * 128 + k0 + k] * wv[k]; a1 += lds[D + kc * 128 + k0 + k] * wv[k]; c0 += lds[kc * 128 + k0 + k + 1] * wv[k + 1]; c1 += lds[D + kc * 128 + k0 + k + 1] * wv[k + 1]; } }
        modp[((size_t)(kc * L + l) * Bn + 0) * 6144 + col] = a0 + c0;
        modp[((size_t)(kc * L + l) * Bn + 1) * 6144 + col] = a1 + c1;
    }
    { const float* posw = p.in[9]; const float* w1c = p.in[10]; float* cbp = (float*)(p.ws + WS_CBP);
      int first = 8 * L * 6144; if (first + 16 * L * 2 * 128 > gsz) first = 0;
      for (int idx = gtid - first; idx < 16 * L * 2 * 128; idx += gsz) { if (idx < 0) continue;
          const int j = idx & 127, li = (idx >> 7) % (L * 2), kc = idx / (L * 2 * 128);
          const float* w = w1c + ((size_t)li * 2048 + kc * 128) * 128 + j; const float* pp = posw + (size_t)li * 2048 + kc * 128;
          float a = 0.f, c_ = 0.f;
#pragma unroll 1
          for (int k0 = 0; k0 < 128; k0 += 32) { float wv[32];
#pragma unroll
              for (int k = 0; k < 32; ++k) wv[k] = w[(size_t)(k0 + k) * 128];
#pragma unroll
              for (int k = 0; k < 32; k += 2) { a += pp[k0 + k] * wv[k]; c_ += pp[k0 + k + 1] * wv[k + 1]; } }
          cbp[idx] = a + c_; } }
}
__device__ __forceinline__ void phase_p0b(const Params& p) {
    const int gtid = blockIdx.x * NT + otid(), gsz = gridDim.x * NT;
    { const float* cbp = (const float*)(p.ws + WS_CBP); float* cb = (float*)(p.ws + WS_CB);
      for (int idx = gtid; idx < L * 2 * 128; idx += gsz) { float s = 0.f;
#pragma unroll
          for (int kc = 0; kc < 16; ++kc) s += cbp[kc * (L * 2 * 128) + idx];
          cb[idx] = s; } }
    const float* modp = (const float*)(p.ws + WS_MODP); float* mod = (float*)(p.ws + WS_MOD); const float* ada_b = p.in[3];
    for (int idx = gtid; idx < L * Bn * 6144; idx += gsz) {
        const int col = idx % 6144, l = idx / (Bn * 6144);
        float s = ada_b[l * 6144 + col];
#pragma unroll
        for (int kc = 0; kc < 8; ++kc) s += modp[(size_t)kc * L * Bn * 6144 + idx];
        mod[idx] = s;
    }
}

__device__ __forceinline__ void phase_r1(const Params& p, int l, bool do_h) {
    const int lane = otid() & 63, wave = otid() >> 6;
    const int gw = blockIdx.x * NW + wave, ngw = gridDim.x * NW;
    const float* mod = (const float*)(p.ws + WS_MOD);
    const float* xin = p.in[0]; float* XA = p.out;
    const bf16_t* Y = (const bf16_t*)(p.ws + WS_Y); const int* pos = (const int*)(p.ws + WS_POS); const float* tokw = (const float*)(p.ws + WS_TOKW);
    const float* lng = p.in[4] + (size_t)(do_h ? l : 0) * D;
    bf16_t* XN = (bf16_t*)(p.ws + WS_XN); bf16_t* XAB = (bf16_t*)(p.ws + WS_XAB);
#define BF4(q) make_float4(__builtin_bit_cast(float, (q).x << 16), __builtin_bit_cast(float, (q).x & 0xffff0000u), __builtin_bit_cast(float, (q).y << 16), __builtin_bit_cast(float, (q).y & 0xffff0000u))
    int curb = -1; float4 g2v[4], ga[4], s0v[4];
    for (int t0 = gw; t0 < T; t0 += ngw) {
        const int nr = 1;
        float4 v[2][4];
        if (l == 0) {
#pragma unroll
            for (int i = 0; i < 2; ++i) if (i < nr) {
#pragma unroll
                for (int j = 0; j < 4; ++j) v[i][j] = *(const float4*)(xin + (size_t)(t0 + i * ngw) * D + 4 * lane + 256 * j); }
        } else {
            int4 ps[2]; float4 tw[2]; uint2 xq[2][4];
#pragma unroll
            for (int i = 0; i < 2; ++i) if (i < nr) { const int t = t0 + i * ngw; ps[i] = *(const int4*)(pos + (size_t)t * 4); tw[i] = *(const float4*)(tokw + (size_t)t * 4);
#pragma unroll
                for (int j = 0; j < 4; ++j) xq[i][j] = *(const uint2*)(XAB + (size_t)t * D + 4 * lane + 256 * j); }
            uint2 yq[2][4][4];
#pragma unroll
            for (int i = 0; i < 2; ++i) if (i < nr) {
#pragma unroll
                for (int j = 0; j < 4; ++j) { const int col = 4 * lane + 256 * j;
                    yq[i][j][0] = *(const uint2*)(Y + (size_t)ps[i].x * D + col); yq[i][j][1] = *(const uint2*)(Y + (size_t)ps[i].y * D + col);
                    yq[i][j][2] = *(const uint2*)(Y + (size_t)ps[i].z * D + col); yq[i][j][3] = *(const uint2*)(Y + (size_t)ps[i].w * D + col); } }
#pragma unroll
            for (int i = 0; i < 2; ++i) if (i < nr) {
                const int t = t0 + i * ngw, b = t / S;
                if (b != curb) { curb = b;
                    const float* g2 = mod + ((size_t)(l - 1) * Bn + b) * 6144 + 5 * D;
#pragma unroll
                    for (int j = 0; j < 4; ++j) g2v[j] = *(const float4*)(g2 + 4 * lane + 256 * j);
                    if (do_h) { const float* sh = mod + ((size_t)l * Bn + b) * 6144 + 0 * D; const float* sc = mod + ((size_t)l * Bn + b) * 6144 + 1 * D;
#pragma unroll
                        for (int j = 0; j < 4; ++j) { const int col = 4 * lane + 256 * j; const float4 g = *(const float4*)(lng + col), s1 = *(const float4*)(sc + col); s0v[j] = *(const float4*)(sh + col);
                            ga[j] = make_float4(g.x * (1.f + s1.x), g.y * (1.f + s1.y), g.z * (1.f + s1.z), g.w * (1.f + s1.w)); } } }
#pragma unroll
                for (int j = 0; j < 4; ++j) {
                    const int col = 4 * lane + 256 * j;
                    const float4 x = BF4(xq[i][j]);
                    const float4 y0 = BF4(yq[i][j][0]), y1 = BF4(yq[i][j][1]), y2 = BF4(yq[i][j][2]), y3 = BF4(yq[i][j][3]);
                    const float4 g = g2v[j];
                    float4 r;
                    r.x = x.x + g.x * (((tw[i].x * y0.x + tw[i].y * y1.x) + tw[i].z * y2.x) + tw[i].w * y3.x); r.y = x.y + g.y * (((tw[i].x * y0.y + tw[i].y * y1.y) + tw[i].z * y2.y) + tw[i].w * y3.y);
                    r.z = x.z + g.z * (((tw[i].x * y0.z + tw[i].y * y1.z) + tw[i].z * y2.z) + tw[i].w * y3.z); r.w = x.w + g.w * (((tw[i].x * y0.w + tw[i].y * y1.w) + tw[i].z * y2.w) + tw[i].w * y3.w);
                    v[i][j] = r;
                    if (do_h) *(uint2*)(XAB + (size_t)t * D + col) = make_uint2(pk2(r.x, r.y), pk2(r.z, r.w));
                    else *(float4*)(XA + (size_t)t * D + col) = r;
                }
            }
        }
        if (do_h) {
#pragma unroll
            for (int i = 0; i < 2; ++i) if (i < nr) {
                const int t = t0 + i * ngw, b = t / S;
                if (b != curb) { curb = b;
                    const float* sh = mod + ((size_t)l * Bn + b) * 6144 + 0 * D; const float* sc = mod + ((size_t)l * Bn + b) * 6144 + 1 * D;
#pragma unroll
                    for (int j = 0; j < 4; ++j) { const int col = 4 * lane + 256 * j; const float4 g = *(const float4*)(lng + col), s1 = *(const float4*)(sc + col); s0v[j] = *(const float4*)(sh + col);
                        ga[j] = make_float4(g.x * (1.f + s1.x), g.y * (1.f + s1.y), g.z * (1.f + s1.z), g.w * (1.f + s1.w)); } }
                float ss = 0.f;
#pragma unroll
                for (int j = 0; j < 4; ++j) ss += (v[i][j].x * v[i][j].x + v[i][j].y * v[i][j].y) + (v[i][j].z * v[i][j].z + v[i][j].w * v[i][j].w);
                ss = wave_sum(ss);
                const float r = rsqrtf(ss * (1.f / D) + EPS);
#pragma unroll
                for (int j = 0; j < 4; ++j) {
                    const int col = 4 * lane + 256 * j;
                    float4 o;
                    o.x = v[i][j].x * r * ga[j].x + s0v[j].x; o.y = v[i][j].y * r * ga[j].y + s0v[j].y;
                    o.z = v[i][j].z * r * ga[j].z + s0v[j].z; o.w = v[i][j].w * r * ga[j].w + s0v[j].w;
                    *(uint2*)(XN + (size_t)t * D + col) = make_uint2(pk2(o.x, o.y), pk2(o.z, o.w));
                }
            }
        }
    }
#undef BF4
}


__device__ __forceinline__ void phase_c2(const Params& p, int l, float* lds) {
    const int lane = otid() & 63, wave = otid() >> 6;
    const float* HIDP = (const float*)(p.ws + WS_HIDP); const float* cb = (const float*)(p.ws + WS_CB) + l * 2 * 128; const float* w2 = p.in[11] + (size_t)l * 2 * 128 * 64;
    const float gk = p.in[8][l * 64 + lane];
    float* hl = lds + wave * 128;
    for (int r = blockIdx.x * NW + wave; r < 2 * 2044; r += gridDim.x * NW) {
        const int idx = r / 2044, rr = r % 2044;
#pragma unroll
        for (int q = 0; q < 2; ++q) { const int j = lane + 64 * q; float s = cb[idx * 128 + j];
#pragma unroll
            for (int kq = 0; kq < 4; ++kq) s += HIDP[((size_t)(kq * 2 + idx) * 2044 + rr) * 128 + j];
            hl[j] = gelu_tanh(s); }
        asm volatile("s_waitcnt lgkmcnt(0)" ::: "memory"); __builtin_amdgcn_wave_barrier();
        const float* W = w2 + (size_t)idx * 128 * 64;
        float s = 0.f;
#pragma unroll 8
        for (int j = 0; j < 128; ++j) s += hl[j] * W[j * 64 + lane];
        asm volatile("s_waitcnt lgkmcnt(0)" ::: "memory"); __builtin_amdgcn_wave_barrier();
        const int bgi = rr / 511, n = rr % 511;
        if (idx == 0) { const float ss = wave_sum(s * s); const float kv = s * rsqrtf(ss * (1.f / 64.f) + EPS) * gk; ((bf16_t*)(p.ws + WS_KCB))[((size_t)bgi * 512 + n) * 64 + lane] = (bf16_t)f2bf(kv); }
        else { ((bf16_t*)(p.ws + WS_VCB))[((size_t)bgi * 512 + n) * 64 + lane] = (bf16_t)f2bf(s); }
    }
    if (blockIdx.x == 0 && otid() < 2 * 4 * 64) { const int i = otid(); bf16_t* dst = (bf16_t*)(p.ws + (i < 256 ? WS_KCB : WS_VCB)); dst[((size_t)((i & 255) >> 6) * 512 + 511) * 64 + (i & 63)] = 0; }
}

__device__ __forceinline__ void load_pstart(const Params& p, int l, int* ps) {
    const int* cnt = (const int*)(p.ws + WS_CNT) + l * 32;
    if (otid() == 0) { int s = 0; for (int e = 0; e < 32; ++e) { ps[e] = s; s += (cnt[e] + 255) & ~255; } ps[32] = s; }
    __syncthreads();
}


template <int MAP>
__device__ __forceinline__ void tr_tile(const float* W, int Nsrc, bf16_t* WT, int K, int k0, int n0, float* scr, int lane) {
    const int nl = (lane & 15) * 4, kr = lane >> 4;
    int sc = n0 + nl;
    if (MAP == 1) { sc = sc < 1280 ? sc : (sc < 2816 ? sc + 24 : (sc < 2840 ? sc - 2816 + 1280 : -1)); }
    float4 v[16];
#pragma unroll
    for (int it = 0; it < 16; ++it) { if (sc >= 0) { const float* src_ = W + (size_t)(k0 + it * 4 + kr) * Nsrc + sc; typedef float f4v __attribute__((ext_vector_type(4))); const f4v t_ = __builtin_nontemporal_load((const f4v*)src_); v[it] = make_float4(t_[0], t_[1], t_[2], t_[3]); } else v[it] = make_float4(0.f, 0.f, 0.f, 0.f); }
#pragma unroll
    for (int it = 0; it < 16; ++it) { float* s = scr + (it * 4 + kr) * 65 + nl; s[0] = v[it].x; s[1] = v[it].y; s[2] = v[it].z; s[3] = v[it].w; }
    asm volatile("s_waitcnt lgkmcnt(0)" ::: "memory"); __builtin_amdgcn_wave_barrier();
    const int c = lane & 7, nr = lane >> 3;
#pragma unroll
    for (int it = 0; it < 8; ++it) {
        const int n = it * 8 + nr; const float* s = scr + (8 * c) * 65 + n;
        uint4 o; o.x = pk2(s[0], s[65]); o.y = pk2(s[2 * 65], s[3 * 65]); o.z = pk2(s[4 * 65], s[5 * 65]); o.w = pk2(s[6 * 65], s[7 * 65]);
        *(uint4*)(WT + (size_t)(n0 + n) * K + k0 + 8 * c) = o;
    }
    asm volatile("s_waitcnt lgkmcnt(0)" ::: "memory"); __builtin_amdgcn_wave_barrier();
}
__device__ __forceinline__ void phase_convert(const Params& p, float* lds) {
    const int tid = otid(), lane = tid & 63, wave = tid >> 6;
    float* scr = lds + wave * (64 * 65);
    const int gw = blockIdx.x * NW + wave, ngw = gridDim.x * NW;
    bf16_t* WinT = (bf16_t*)(p.ws + WS_WINT); bf16_t* WoT = (bf16_t*)(p.ws + WS_WOT);
    constexpr int I_IN = L * 16 * (ZBW / 64), I_O = L * 16 * 16, I_C = L * 2 * 32 * 2;
    { float* cm = lds + NW * (64 * 65);
      constexpr int S1 = L * NE * 32, S2 = L * NE * 16;
      for (int s = blockIdx.x; s < S1 + S2; s += gridDim.x) {
          const bool is1 = s < S1; const int q = is1 ? s : s - S1;
          const int le = is1 ? (q >> 5) : (q >> 4), nb = is1 ? (q & 31) : (q & 15), Nsrc = is1 ? 2048 : 1024;
          const float* W = (is1 ? p.in[17] : p.in[19]) + (size_t)le * 1024 * Nsrc;
          unsigned char* WT8 = p.ws + (is1 ? WS_W1T : WS_W2T) + (size_t)le * Nsrc * 1024;
          float* DQ = (float*)(p.ws + (is1 ? WS_DQ1 : WS_DQ2)) + (size_t)le * Nsrc;
          const int n0 = nb * 64, nl = (lane & 15) * 4, kr = lane >> 4, k0 = wave * 128;
          typedef float f4v __attribute__((ext_vector_type(4)));
          f4v va[16], vb[16];
#pragma unroll
          for (int it = 0; it < 16; ++it) { va[it] = __builtin_nontemporal_load((const f4v*)(W + (size_t)(k0 + it * 4 + kr) * Nsrc + n0 + nl));
                                            vb[it] = __builtin_nontemporal_load((const f4v*)(W + (size_t)(k0 + 64 + it * 4 + kr) * Nsrc + n0 + nl)); }
          float m[4] = {0.f, 0.f, 0.f, 0.f};
#pragma unroll
          for (int it = 0; it < 16; ++it)
#pragma unroll
              for (int j = 0; j < 4; ++j) m[j] = __builtin_fmaxf(m[j], __builtin_fmaxf(__builtin_fabsf(va[it][j]), __builtin_fabsf(vb[it][j])));
#pragma unroll
          for (int j = 0; j < 4; ++j) { m[j] = __builtin_fmaxf(m[j], __shfl_xor(m[j], 16)); m[j] = __builtin_fmaxf(m[j], __shfl_xor(m[j], 32)); }
          if (kr == 0) {
#pragma unroll
              for (int j = 0; j < 4; ++j) cm[wave * 64 + nl + j] = m[j]; }
          __syncthreads();
          float sc[4];
#pragma unroll
          for (int j = 0; j < 4; ++j) { float a = cm[nl + j];
#pragma unroll
              for (int w = 1; w < NW; ++w) a = __builtin_fmaxf(a, cm[w * 64 + nl + j]);
              sc[j] = a > 0.f ? 448.f / a : 0.f;
              if (wave == 0 && kr == 0) DQ[n0 + nl + j] = a * (1.f / 448.f); }
#pragma unroll
          for (int half = 0; half < 2; ++half) {
#pragma unroll
              for (int it = 0; it < 16; ++it) { const f4v v = half ? vb[it] : va[it]; float* d = scr + (it * 4 + kr) * 65 + nl; d[0] = v[0] * sc[0]; d[1] = v[1] * sc[1]; d[2] = v[2] * sc[2]; d[3] = v[3] * sc[3]; }
              asm volatile("s_waitcnt lgkmcnt(0)" ::: "memory"); __builtin_amdgcn_wave_barrier();
              const int c = lane & 7, nr = lane >> 3;
#pragma unroll
              for (int it = 0; it < 8; ++it) { const int n = it * 8 + nr; const float* sp = scr + (8 * c) * 65 + n;
                  uint2 o; o.x = pk_fp8x4(sp[0], sp[65], sp[2 * 65], sp[3 * 65]); o.y = pk_fp8x4(sp[4 * 65], sp[5 * 65], sp[6 * 65], sp[7 * 65]);
                  *(uint2*)(WT8 + (size_t)(n0 + n) * 1024 + k0 + half * 64 + 8 * c) = o; }
              asm volatile("s_waitcnt lgkmcnt(0)" ::: "memory"); __builtin_amdgcn_wave_barrier();
          }
          __syncthreads();
      } }
    for (int it = gw; it < I_C + I_IN + I_O; it += ngw) {
        int r = it;
        if (r < I_C) { const int li = r / 64, q = r % 64, kb = q / 2, nb = q % 2;
            tr_tile<0>(p.in[10] + (size_t)li * 2048 * 128, 128, (bf16_t*)(p.ws + WS_WCT) + (size_t)li * 128 * 2048, 2048, kb * 64, nb * 64, scr, lane); continue; }
        r -= I_C;
        if (r < I_IN) { const int l = r / (16 * 48), q = r % (16 * 48), kb = q / 48, nb = q % 48;
            tr_tile<1>(p.in[6] + (size_t)l * D * INW, INW, WinT + (size_t)l * ZBW * D, D, kb * 64, nb * 64, scr, lane); continue; }
        r -= I_IN;
        { const int l = r / 256, q = r % 256, kb = q / 16, nb = q % 16;
            tr_tile<0>(p.in[14] + (size_t)l * D * D, D, WoT + (size_t)l * D * D, D, kb * 64, nb * 64, scr, lane); }
    }
    if (blockIdx.x == 0) { bf16_t* XN = (bf16_t*)(p.ws + WS_XN); for (int i = tid; i < D / 2; i += NT) ((unsigned*)(XN + (size_t)T * D))[i] = 0u;
                           for (int i = tid; i < D / 4; i += NT) ((unsigned*)(p.ws + WS_XN8 + (size_t)T * D))[i] = 0u; }
}

namespace pg8 {
#define PG8_LAS __attribute__((address_space(3)))
typedef short bf16x8 __attribute__((ext_vector_type(8)));
typedef float f32x4 __attribute__((ext_vector_type(4)));
typedef unsigned u32x4 __attribute__((ext_vector_type(4)));
typedef long l64x2 __attribute__((ext_vector_type(2)));
typedef int i32x4 __attribute__((ext_vector_type(4)));
typedef int i32x8 __attribute__((ext_vector_type(8)));
constexpr int BM = 256, BK = 64, HALF = 128, HTB = HALF * BK * 2, STAGE_BYTES = 8 * HTB, NXCD = 8, WGM = 8;
__device__ __forceinline__ int lds_byte(int r, int c) { const int st = (r >> 4) * 2 + (c >> 5), rr = r & 15, cc = c & 31, ob = rr * 64 + cc * 2; return st * 1024 + (ob ^ (((ob >> 9) & 1) << 5)); }
__device__ __forceinline__ void stage_rc(int b, int& R, int& C) { const int st = b / 1024, sb = b % 1024, swz = sb ^ (((sb >> 9) & 1) << 5); R = (st >> 1) * 16 + swz / 64; C = (st & 1) * 32 + (swz % 64) / 2; }
__device__ __forceinline__ int perm32(int rho) { const int n = rho >> 4, i = rho & 15; return 8 * (i >> 2) + 4 * n + (i & 3); }
struct Unit { int pm, pn, e; };
__device__ __forceinline__ unsigned cvt_pk_bf16(float lo, float hi) { unsigned r; asm volatile("v_cvt_pk_bf16_f32 %0, %1, %2" : "=v"(r) : "v"(lo), "v"(hi)); return r; }

__device__ __forceinline__ bool static_next(int nM, int nN, int G, int c, int i, Unit& u) {
    const int nwg = nM * nN; const long Lq = (long)i * G + c; if (Lq >= nwg) return false;
    int wgid = (int)Lq; { const int q = nwg / NXCD, r = nwg % NXCD, xcd = wgid % NXCD, off = wgid / NXCD; wgid = (xcd < r ? xcd * (q + 1) : r * (q + 1) + (xcd - r) * q) + off; }
    const int nig = WGM * nN, gid = wgid / nig, fm = gid * WGM, gsz = (nM - fm) < WGM ? (nM - fm) : WGM;
    u.pm = fm + ((wgid % nig) % gsz); u.pn = (wgid % nig) / gsz; u.e = 0; return true;
}

template <class Prob, class Epi, bool ALIGN_EPI, bool SP2>
__device__ __forceinline__ void gemm_phase(PG8_LAS unsigned char* lds, const Prob& P, const Epi& E) {
    const int tid = otid(), wid = __builtin_amdgcn_readfirstlane(tid >> 6), lane = tid & 63, wr = wid >> 2, wc = wid & 3, fr = lane & 15, fq = lane >> 4;
    const int K = P.K, nt = Prob::KT > 0 ? Prob::KT : K / BK;
    int sR[2], sC[2]; unsigned voffB[2];
#pragma unroll
    for (int i = 0; i < 2; ++i) { stage_rc(tid * 16 + i * 8192, sR[i], sC[i]); voffB[i] = (unsigned)(P.b_row(sR[i]) * K + sC[i]) * 2u; }
    const size_t kstep = (size_t)(BK * 2);
    const size_t kstepA = P.a_kstep();
    const size_t hstepB = P.b_hstep();
    const unsigned ldsw = (unsigned)wid * 1024u;
    const int aoff = lds_byte(wr * 64 + fr, fq * 8), boff = lds_byte(wc * 32 + fr, fq * 8);
#define PG8_SA(b, h) (((b) * 2 + (h)) * HTB)
#define PG8_SB(b, h) ((4 + (b) * 2 + (h)) * HTB)
#define PG8_STAGE(bufoff, gbase, voff) do { _Pragma("unroll") for (int _i = 0; _i < 2; ++_i) { unsigned _vo = (voff)[_i]; asm volatile("" : "+v"(_vo));        \
        __builtin_amdgcn_global_load_lds((const unsigned*)((const char*)(gbase) + _vo), (PG8_LAS unsigned*)(lds + (bufoff) + ldsw + _i * 8192), 16, 0, 0); } } while (0)
#define PG8_STAGE_SEL(bufoff, gbase, h) do { _Pragma("unroll") for (int _i = 0; _i < 2; ++_i) { unsigned _vo = vAc[h][_i]; if constexpr (Prob::GATHER) { const unsigned _vn = van[(h) * 2 + _i]; _vo = last ? _vn : _vo; } asm volatile("" : "+v"(_vo)); \
        __builtin_amdgcn_global_load_lds((const unsigned*)((const char*)(gbase) + _vo), (PG8_LAS unsigned*)(lds + (bufoff) + ldsw + _i * 8192), 16, 0, 0); } } while (0)
#define PG8_LDA(dst, b, h) do { if constexpr (Prob::F8) { _Pragma("unroll") for (int m = 0; m < 2; ++m) { \
            const i32x4 lo_ = *(const PG8_LAS i32x4*)(lds + PG8_SA(b, h) + aoff + m * 2048), hi_ = *(const PG8_LAS i32x4*)(lds + PG8_SA(b, h) + aoff + m * 2048 + 1024); \
            dst##8[m] = __builtin_shufflevector(lo_, hi_, 0, 1, 2, 3, 4, 5, 6, 7); } } \
        else { _Pragma("unroll") for (int m = 0; m < 4; ++m) _Pragma("unroll") for (int k = 0; k < 2; ++k) dst[m][k] = *(const PG8_LAS bf16x8*)(lds + PG8_SA(b, h) + aoff + m * 2048 + k * 1024); } } while (0)
#define PG8_LDB(dst, b, h) do { if constexpr (Prob::F8) { _Pragma("unroll") for (int n = 0; n < 2; ++n) { \
            const i32x4 lo_ = *(const PG8_LAS i32x4*)(lds + PG8_SB(b, h) + boff + n * 2048), hi_ = *(const PG8_LAS i32x4*)(lds + PG8_SB(b, h) + boff + n * 2048 + 1024); \
            dst##8[n] = __builtin_shufflevector(lo_, hi_, 0, 1, 2, 3, 4, 5, 6, 7); } } \
        else { _Pragma("unroll") for (int n = 0; n < 2; ++n) _Pragma("unroll") for (int k = 0; k < 2; ++k) dst[n][k] = *(const PG8_LAS bf16x8*)(lds + PG8_SB(b, h) + boff + n * 2048 + k * 1024); } } while (0)
#define PG8_MMA(ai, bj, At, Bt) do { __builtin_amdgcn_s_setprio(1); _Pragma("unroll") for (int m = 0; m < 4; ++m) _Pragma("unroll") for (int n = 0; n < 2; ++n) { \
        if constexpr (Prob::F8)          \
            acc[ai][bj][m][n] = __builtin_amdgcn_mfma_scale_f32_16x16x128_f8f6f4(Bt##8[n], At##8[m], acc[ai][bj][m][n], 0, 0, 0, 0x7f7f7f7f, 0, 0x7f7f7f7f); \
        else { _Pragma("unroll") for (int k = 0; k < 2; ++k) acc[ai][bj][m][n] = __builtin_amdgcn_mfma_f32_16x16x32_bf16(Bt[n][k], At[m][k], acc[ai][bj][m][n], 0, 0, 0); } } __builtin_amdgcn_s_setprio(0); } while (0)
#define PG8_MMA2(ai, At, B0, B1, b, h) do { if constexpr (Prob::F8) { __builtin_amdgcn_s_setprio(1); \
        _Pragma("unroll") for (int m = 0; m < 2; ++m) _Pragma("unroll") for (int n = 0; n < 2; ++n) { \
            acc[ai][0][m][n] = __builtin_amdgcn_mfma_scale_f32_16x16x128_f8f6f4(B0##8[n], At##8[m], acc[ai][0][m][n], 0, 0, 0, 0x7f7f7f7f, 0, 0x7f7f7f7f); \
            acc[ai][1][m][n] = __builtin_amdgcn_mfma_scale_f32_16x16x128_f8f6f4(B1##8[n], At##8[m], acc[ai][1][m][n], 0, 0, 0, 0x7f7f7f7f, 0, 0x7f7f7f7f); } \
        _Pragma("unroll") for (int m = 0; m < 2; ++m) { \
            const i32x4 lo_ = *(const PG8_LAS i32x4*)(lds + PG8_SA(b, h) + aoff + (m + 2) * 2048), hi_ = *(const PG8_LAS i32x4*)(lds + PG8_SA(b, h) + aoff + (m + 2) * 2048 + 1024); \
            At##8[m] = __builtin_shufflevector(lo_, hi_, 0, 1, 2, 3, 4, 5, 6, 7); } \
        _Pragma("unroll") for (int m = 0; m < 2; ++m) _Pragma("unroll") for (int n = 0; n < 2; ++n) { \
            acc[ai][0][m + 2][n] = __builtin_amdgcn_mfma_scale_f32_16x16x128_f8f6f4(B0##8[n], At##8[m], acc[ai][0][m + 2][n], 0, 0, 0, 0x7f7f7f7f, 0, 0x7f7f7f7f); \
            acc[ai][1][m + 2][n] = __builtin_amdgcn_mfma_scale_f32_16x16x128_f8f6f4(B1##8[n], At##8[m], acc[ai][1][m + 2][n], 0, 0, 0, 0x7f7f7f7f, 0, 0x7f7f7f7f); } \
        __builtin_amdgcn_s_setprio(0); } else { PG8_MMA(ai, 0, At, B0); PG8_MMA(ai, 1, At, B1); } } while (0)
#define PG8_WAIT_V(n) asm volatile("s_waitcnt vmcnt(" #n ")" ::: "memory")
#define PG8_WAIT_L(n) asm volatile("s_waitcnt lgkmcnt(" #n ")" ::: "memory")
#define PG8_BAR __builtin_amdgcn_s_barrier()
#define PG8_SCHED __builtin_amdgcn_sched_barrier(0)
    Unit cur, nxt; int ui = 0;
    if (!P.next(0, cur)) return;
    nxt = cur;
    f32x4 acc[2][2][4][2];
    typename Epi::Pre pre;
    E.prefetch(cur, wc, fq, pre); E.init(acc, pre);
    bf16x8 At[4][2], B0[2][2], B1[2][2];
    i32x8 At8[2], B08[2], B18[2];
    unsigned vAc[2][2];
    PG8_LAS unsigned* van = (PG8_LAS unsigned*)(lds + 131072 + 1024) + tid * 4;
    const char* cA = P.a_base(cur); const char* cB = P.b_base(cur);
    P.a_voff(cur, sR, sC, vAc);
    if constexpr (Prob::GATHER) { van[0] = vAc[0][0]; van[1] = vAc[0][1]; van[2] = vAc[1][0]; van[3] = vAc[1][1]; }
    if constexpr (SP2) {
        PG8_STAGE(PG8_SB(0, 0), cB, voffB); PG8_STAGE(PG8_SB(0, 1), cB + hstepB, voffB); PG8_STAGE(PG8_SA(0, 0), cA, vAc[0]); PG8_STAGE(PG8_SA(0, 1), cA, vAc[1]);
        if (wr == 1) PG8_BAR;
        PG8_WAIT_V(2); PG8_BAR;
        PG8_STAGE(PG8_SB(1, 0), cB + kstep, voffB); PG8_STAGE(PG8_SA(1, 0), cA + kstepA, vAc[0]); PG8_STAGE(PG8_SB(1, 1), cB + hstepB + kstep, voffB);
        PG8_WAIT_V(6); PG8_BAR;
    } else {
        PG8_STAGE(PG8_SB(0, 0), cB, voffB); PG8_STAGE(PG8_SA(0, 0), cA, vAc[0]); PG8_STAGE(PG8_SB(0, 1), cB + hstepB, voffB); PG8_STAGE(PG8_SA(0, 1), cA, vAc[1]);
        if (wr == 1) PG8_BAR;
        PG8_WAIT_V(4); PG8_BAR;
        PG8_STAGE(PG8_SB(1, 0), cB + kstep, voffB); PG8_STAGE(PG8_SA(1, 0), cA + kstepA, vAc[0]); PG8_STAGE(PG8_SB(1, 1), cB + hstepB + kstep, voffB);
        PG8_WAIT_V(6); PG8_BAR;
    }
    for (;;) {
        E.preload(cur, wc, fq, pre);
        const bool has_next = P.next(ui + 1, nxt);
        const char* nA = cA; const char* nB = cB;
        if (has_next) { nA = P.a_base(nxt); nB = P.b_base(nxt);
            if constexpr (Prob::GATHER) { int r2[2], c2[2]; const int t2 = otid();
#pragma unroll
                for (int i = 0; i < 2; ++i) stage_rc(t2 * 16 + i * 8192, r2[i], c2[i]);
                unsigned vn[2][2]; P.a_voff(nxt, r2, c2, vn); van[0] = vn[0][0]; van[1] = vn[0][1]; van[2] = vn[1][0]; van[3] = vn[1][1]; } }
        for (int t = 0; t < nt; t += 2) {
            const bool last = (t == nt - 2);
            const char* a1 = cA + (size_t)(t + 1) * kstepA;
            const char* a2 = last ? nA : cA + (size_t)(t + 2) * kstepA; const char* b2 = last ? nB : cB + (size_t)(t + 2) * kstep;
            const char* a3 = a2 + kstepA; const char* b3 = b2 + kstep;
            if constexpr (SP2) {
            PG8_LDB(B0, 0, 0); PG8_LDB(B1, 0, 1); PG8_SCHED; PG8_LDA(At, 0, 0); PG8_STAGE(PG8_SA(1, 1), a1, vAc[1]);
            PG8_WAIT_V(8); PG8_WAIT_L(0); PG8_BAR; PG8_MMA2(0, At, B0, B1, 0, 0); PG8_BAR; PG8_SCHED;
            PG8_LDA(At, 0, 1); PG8_STAGE(PG8_SB(0, 0), b2, voffB); PG8_STAGE(PG8_SB(0, 1), b2 + hstepB, voffB); PG8_STAGE_SEL(PG8_SA(0, 0), a2, 0);
            PG8_WAIT_V(8); PG8_WAIT_L(0); PG8_BAR; PG8_MMA2(1, At, B0, B1, 0, 1); PG8_BAR; PG8_SCHED;
            PG8_LDB(B0, 1, 0); PG8_LDB(B1, 1, 1); PG8_SCHED; PG8_LDA(At, 1, 0); PG8_STAGE_SEL(PG8_SA(0, 1), a2, 1);
            PG8_WAIT_V(8); PG8_WAIT_L(0); PG8_BAR; PG8_MMA2(0, At, B0, B1, 1, 0); PG8_BAR; PG8_SCHED;
            PG8_LDA(At, 1, 1); PG8_STAGE(PG8_SB(1, 0), b3, voffB); PG8_STAGE(PG8_SB(1, 1), b3 + hstepB, voffB); PG8_STAGE_SEL(PG8_SA(1, 0), a3, 0);
            PG8_WAIT_V(8); PG8_WAIT_L(0); PG8_BAR; PG8_MMA2(1, At, B0, B1, 1, 1); PG8_BAR; PG8_SCHED;
            } else {
            PG8_LDB(B0, 0, 0); PG8_SCHED; PG8_LDA(At, 0, 0); PG8_STAGE(PG8_SA(1, 1), a1, vAc[1]);
            PG8_WAIT_L(8); PG8_BAR; PG8_WAIT_L(0); PG8_MMA(0, 0, At, B0); PG8_BAR; PG8_SCHED;
            PG8_LDB(B1, 0, 1); PG8_STAGE(PG8_SB(0, 0), b2, voffB);
            PG8_BAR; PG8_WAIT_L(0); PG8_MMA(0, 1, At, B1); PG8_BAR;
            PG8_LDA(At, 0, 1); PG8_STAGE_SEL(PG8_SA(0, 0), a2, 0);
            PG8_BAR; PG8_WAIT_L(0); PG8_MMA(1, 0, At, B0); PG8_BAR; PG8_SCHED;
            PG8_STAGE(PG8_SB(0, 1), b2 + hstepB, voffB);
            PG8_WAIT_V(6); PG8_BAR; PG8_MMA(1, 1, At, B1); PG8_BAR;
            PG8_LDB(B0, 1, 0); PG8_SCHED; PG8_LDA(At, 1, 0); PG8_STAGE_SEL(PG8_SA(0, 1), a2, 1);
            PG8_WAIT_L(8); PG8_BAR; PG8_WAIT_L(0); PG8_MMA(0, 0, At, B0); PG8_BAR; PG8_SCHED;
            PG8_LDB(B1, 1, 1); PG8_STAGE(PG8_SB(1, 0), b3, voffB);
            PG8_BAR; PG8_WAIT_L(0); PG8_MMA(0, 1, At, B1); PG8_BAR;
            PG8_LDA(At, 1, 1); PG8_STAGE_SEL(PG8_SA(1, 0), a3, 0);
            PG8_BAR; PG8_WAIT_L(0); PG8_MMA(1, 0, At, B0); PG8_BAR; PG8_SCHED;
            PG8_STAGE(PG8_SB(1, 1), b3 + hstepB, voffB);
            PG8_WAIT_V(6); PG8_BAR; PG8_MMA(1, 1, At, B1); PG8_BAR;
            }
        }
        if constexpr (ALIGN_EPI) { if (wr == 0) PG8_BAR; }
        E(acc, cur, wr, wc, fr, fq, has_next, nxt, pre);
        if (!has_next) break;
        E.init(acc, pre);
        cur = nxt; cA = nA; cB = nB; ++ui;
        if constexpr (Prob::GATHER) {
#pragma unroll
            for (int h = 0; h < 2; ++h)
#pragma unroll
                for (int i = 0; i < 2; ++i) vAc[h][i] = van[h * 2 + i];
        }
        if constexpr (ALIGN_EPI) { if (wr == 1) PG8_BAR; }
    }
    PG8_WAIT_V(0);
    if constexpr (!ALIGN_EPI) { if (wr == 0) PG8_BAR; }
    PG8_BAR;
#undef PG8_SA
#undef PG8_SB
#undef PG8_STAGE
#undef PG8_STAGE_SEL
#undef PG8_LDA
#undef PG8_LDB
#undef PG8_MMA
#undef PG8_WAIT_V
#undef PG8_WAIT_L
#undef PG8_BAR
#undef PG8_SCHED
}

struct ProbDense { static constexpr bool F8 = false; static constexpr bool GATHER = false; static constexpr int KT = 0;
    const bf16_t* A; const bf16_t* Bt; int K, nM, nN, G, c; bool headperm;
    __device__ __forceinline__ bool next(int i, Unit& u) const { return static_next(nM, nN, G, c, i, u); }
    __device__ __forceinline__ const char* a_base(const Unit& u) const { return (const char*)(A + (size_t)u.pm * BM * K); }
    __device__ __forceinline__ void a_voff(const Unit&, const int (&R)[2], const int (&C)[2], unsigned (&v)[2][2]) const {
#pragma unroll
        for (int h = 0; h < 2; ++h)
#pragma unroll
            for (int i = 0; i < 2; ++i) v[h][i] = (unsigned)((h * HALF + R[i]) * K + C[i]) * 2u;
    }
    __device__ __forceinline__ const char* b_base(const Unit& u) const { return (const char*)(Bt + (size_t)u.pn * BM * K); }
    __device__ __forceinline__ size_t a_kstep() const { return (size_t)BK * 2; }
    __device__ __forceinline__ size_t b_hstep() const { return headperm ? (size_t)32 * K * 2 : (size_t)HALF * K * 2; }
    __device__ __forceinline__ int b_row(int R) const { return headperm ? ((R >> 5) * 64 + perm32(R & 31)) : ((R & ~31) + perm32(R & 31)); }
};
typedef const PG8_LAS int* lds_ints;
__device__ __forceinline__ int expert_of(lds_ints ps, int pm) { int e = 0;
#pragma unroll
    for (int i = 1; i < 32; ++i) if (ps[i] <= pm * 256) e = i;
    return __builtin_amdgcn_readfirstlane(e); }
struct ProbMoe1 { static constexpr bool F8 = true; static constexpr bool GATHER = true; static constexpr int KT = 0;
    const bf16_t* XN; const bf16_t* W1T; const int* rowtok; lds_ints ps; int K, ntm, G, c;
    __device__ __forceinline__ bool next(int i, Unit& u) const {
        if (G != 256) { const int q = i * G + c; if (q >= ntm * 8) return false; u.pm = q >> 3; u.pn = q & 7; u.e = expert_of(ps, u.pm); return true; }
        const int x = c & 7, s = c >> 3; const int pm = 4 * (i * 8 + x) + (s >> 3); if (pm >= ntm) return false;
        u.pm = pm; u.pn = s & 7; u.e = expert_of(ps, u.pm); return true; }
    __device__ __forceinline__ const char* a_base(const Unit&) const { return (const char*)XN; }
    __device__ __forceinline__ void a_voff(const Unit& u, const int (&R)[2], const int (&C)[2], unsigned (&v)[2][2]) const {
#pragma unroll
        for (int h = 0; h < 2; ++h)
#pragma unroll
            for (int i = 0; i < 2; ++i) { int tk = rowtok[u.pm * BM + h * HALF + R[i]]; if (tk < 0) tk = T; v[h][i] = (unsigned)(tk * K + C[i]) * 2u; }
    }
    __device__ __forceinline__ const char* b_base(const Unit& u) const { return (const char*)(W1T + ((size_t)u.e * 2048 + u.pn * 128) * K); }
    __device__ __forceinline__ size_t a_kstep() const { return (size_t)BK * 2; }
    __device__ __forceinline__ size_t b_hstep() const { return (size_t)1024 * K * 2; }
    __device__ __forceinline__ int b_row(int R) const { return (R & ~31) + perm32(R & 31); }
};
struct ProbMoe2 { static constexpr bool F8 = true; static constexpr bool GATHER = false; static constexpr int KT = 0;
    const bf16_t* ACT; const bf16_t* W2T; lds_ints ps; int K, ntm, G, c;
    __device__ __forceinline__ bool next(int i, Unit& u) const {
        if (G != 256) { const int q = i * G + c; if (q >= ntm * 4) return false; u.pm = q >> 2; u.pn = q & 3; u.e = expert_of(ps, u.pm); return true; }
        const int x = c & 7, s = c >> 3; const int pm = 8 * (i * 8 + x) + (s >> 2); if (pm >= ntm) return false;
        u.pm = pm; u.pn = s & 3; u.e = expert_of(ps, u.pm); return true; }
    __device__ __forceinline__ const char* a_base(const Unit& u) const { return (const char*)(ACT + (size_t)u.pm * BM * K); }
    __device__ __forceinline__ void a_voff(const Unit&, const int (&R)[2], const int (&C)[2], unsigned (&v)[2][2]) const {
#pragma unroll
        for (int h = 0; h < 2; ++h)
#pragma unroll
            for (int i = 0; i < 2; ++i) v[h][i] = (unsigned)((h * HALF + R[i]) * K + C[i]) * 2u;
    }
    __device__ __forceinline__ const char* b_base(const Unit& u) const { return (const char*)(W2T + ((size_t)u.e * 1024 + u.pn * BM) * K); }
    __device__ __forceinline__ size_t a_kstep() const { return (size_t)BK * 2; }
    __device__ __forceinline__ size_t b_hstep() const { return (size_t)HALF * K * 2; }
    __device__ __forceinline__ int b_row(int R) const { return (R & ~31) + perm32(R & 31); }
};

struct ProbCmp { static constexpr bool F8 = false; static constexpr bool GATHER = false; static constexpr int KT = 8;
    const bf16_t* ZB; const bf16_t* W1T; int K, G, c;
    __device__ __forceinline__ bool next(int i, Unit& u) const { const int q = i * G + c; if (q >= 64) return false; u.pm = q & 15; u.pn = 0; u.e = q >> 4; return true; }
    __device__ __forceinline__ const char* a_base(const Unit& u) const { const int idx = u.pm >> 3, bg = (u.pm >> 1) & 3, half = u.pm & 1;
        return (const char*)(ZB + ((size_t)(bg >> 1) * S + 16 * 256 * half + 8 * u.e) * ZBW + ZB_KC + idx * 128 + (bg & 1) * 64); }
    __device__ __forceinline__ void a_voff(const Unit&, const int (&R)[2], const int (&C)[2], unsigned (&v)[2][2]) const {
#pragma unroll
        for (int h = 0; h < 2; ++h)
#pragma unroll
            for (int i = 0; i < 2; ++i) v[h][i] = (unsigned)(16 * (h * HALF + R[i]) * ZBW + C[i]) * 2u;
    }
    __device__ __forceinline__ size_t a_kstep() const { return (size_t)ZBW * 2; }
    __device__ __forceinline__ const char* b_base(const Unit& u) const { return (const char*)(W1T + (size_t)(u.pm >> 3) * 128 * K + 8 * 64 * u.e); }
    __device__ __forceinline__ size_t b_hstep() const { return 0; }
    __device__ __forceinline__ int b_row(int R) const { return (R & ~31) + perm32(R & 31); }
};
struct EpiCmp {
    float* HIDP;
    struct Pre {};
    __device__ __forceinline__ void prefetch(const Unit&, int, int, Pre&) const {}
    __device__ __forceinline__ void preload(const Unit&, int, int, Pre&) const {}
    __device__ __forceinline__ void init(f32x4 (&acc)[2][2][4][2], const Pre&) const {
#pragma unroll
        for (int a = 0; a < 2; ++a)
#pragma unroll
            for (int b = 0; b < 2; ++b)
#pragma unroll
                for (int m = 0; m < 4; ++m)
#pragma unroll
                    for (int n = 0; n < 2; ++n) acc[a][b][m][n] = (f32x4){0.f, 0.f, 0.f, 0.f};
    }
    __device__ __forceinline__ void operator()(const f32x4 (&acc)[2][2][4][2], const Unit& u, int wr, int wc, int fr, int fq, bool has_next, const Unit& nxt, Pre& pre) const {
        const int idx = u.pm >> 3, bg = (u.pm >> 1) & 3, half = u.pm & 1;
        const int c0 = 32 * wc + 8 * fq;
#pragma unroll
        for (int ai = 0; ai < 2; ++ai)
#pragma unroll
            for (int m = 0; m < 4; ++m) { const int n = 256 * half + ai * HALF + wr * 64 + m * 16 + fr;
                if (n < 511) { float* dst = HIDP + (((size_t)u.e * 2 + idx) * 2044 + bg * 511 + n) * 128 + c0;
                    *(f32x4*)dst = acc[ai][0][m][0]; *(f32x4*)(dst + 4) = acc[ai][0][m][1]; } }
    }
};
struct EpiG1F {
    bf16_t* ZB; float* GATE; const float* gq; const float* gk; const float* gmq; const float* gmk;
    struct Pre {};
    __device__ __forceinline__ void prefetch(const Unit&, int, int, Pre&) const {}
    __device__ __forceinline__ void preload(const Unit&, int, int, Pre&) const {}
    __device__ __forceinline__ void init(f32x4 (&acc)[2][2][4][2], const Pre&) const {
#pragma unroll
        for (int a = 0; a < 2; ++a)
#pragma unroll
            for (int b = 0; b < 2; ++b)
#pragma unroll
                for (int m = 0; m < 4; ++m)
#pragma unroll
                    for (int n = 0; n < 2; ++n) acc[a][b][m][n] = (f32x4){0.f, 0.f, 0.f, 0.f};
    }
    __device__ __forceinline__ void operator()(const f32x4 (&acc)[2][2][4][2], const Unit& u, int wr, int wc, int fr, int fq, bool has_next, const Unit& nxt, Pre& pre) const {
        const int pn = u.pn;
        const float* gain = nullptr; float sc = 1.f;
        if (pn < 2) { gain = gq; sc = QSCALE; }
        else if (pn == 3 || pn == 4) { if (wc < 2) gain = gk; }
        else if (pn == 5 || pn == 6) { gain = gmq; sc = QSCALE; }
        else if (pn == 7 || pn == 8) { gain = gmk; }
        if (pn == 11) {
            if (wc == 0 && fq < 3) {
#pragma unroll
                for (int ai = 0; ai < 2; ++ai)
#pragma unroll
                    for (int m = 0; m < 4; ++m) { const size_t r = (size_t)u.pm * BM + ai * HALF + wr * 64 + m * 16 + fr;
#pragma unroll
                        for (int n = 0; n < 2; ++n) { const f32x4 v = acc[ai][0][m][n]; f32x4 o;
#pragma unroll
                            for (int i = 0; i < 4; ++i) o[i] = __builtin_amdgcn_rcpf(1.f + __builtin_amdgcn_exp2f(-LOG2E * v[i]));
                            *(f32x4*)(GATE + r * 32 + 8 * fq + 4 * n) = o; } }
            }
            return;
        }
        f32x4 gv[2][2];
#pragma unroll
        for (int bj = 0; bj < 2; ++bj)
#pragma unroll
            for (int n = 0; n < 2; ++n) gv[bj][n] = gain ? *(const f32x4*)(gain + 32 * bj + 8 * fq + 4 * n) * sc : (f32x4){1.f, 1.f, 1.f, 1.f};
#pragma unroll
        for (int ai = 0; ai < 2; ++ai)
#pragma unroll
            for (int m = 0; m < 4; ++m) { const size_t r = (size_t)u.pm * BM + ai * HALF + wr * 64 + m * 16 + fr;
                float rs = 1.f;
                if (gain) { float ss = 0.f;
#pragma unroll
                    for (int bj = 0; bj < 2; ++bj)
#pragma unroll
                        for (int n = 0; n < 2; ++n) { const f32x4 v = acc[ai][bj][m][n]; ss += (v[0] * v[0] + v[1] * v[1]) + (v[2] * v[2] + v[3] * v[3]); }
                    ss += __shfl_xor(ss, 16); ss += __shfl_xor(ss, 32);
                    rs = rsqrtf(ss * (1.f / 64.f) + EPS); }
#pragma unroll
                for (int bj = 0; bj < 2; ++bj) { const f32x4 a = acc[ai][bj][m][0] * gv[bj][0] * rs, b = acc[ai][bj][m][1] * gv[bj][1] * rs;
                    u32x4 w; w.x = cvt_pk_bf16(a[0], a[1]); w.y = cvt_pk_bf16(a[2], a[3]); w.z = cvt_pk_bf16(b[0], b[1]); w.w = cvt_pk_bf16(b[2], b[3]);
                    *(u32x4*)(ZB + r * ZBW + pn * BM + 64 * wc + 32 * bj + 8 * fq) = w; } }
    }
};
struct EpiG2 {
    const float* xin32; bf16_t* XAB; const float* g1;
    struct Pre {};
    __device__ __forceinline__ void prefetch(const Unit&, int, int, Pre&) const {}
    __device__ __forceinline__ void preload(const Unit&, int, int, Pre&) const {}
    __device__ __forceinline__ void init(f32x4 (&acc)[2][2][4][2], const Pre&) const {
#pragma unroll
        for (int a = 0; a < 2; ++a)
#pragma unroll
            for (int b = 0; b < 2; ++b)
#pragma unroll
                for (int m = 0; m < 4; ++m)
#pragma unroll
                    for (int n = 0; n < 2; ++n) acc[a][b][m][n] = (f32x4){0.f, 0.f, 0.f, 0.f};
    }
    __device__ __forceinline__ void operator()(const f32x4 (&acc)[2][2][4][2], const Unit& u, int wr, int wc, int fr, int fq, bool has_next, const Unit& nxt, Pre& pre) const {
#pragma unroll
        for (int ai = 0; ai < 2; ++ai)
#pragma unroll
            for (int m = 0; m < 4; ++m) { const size_t r = (size_t)u.pm * BM + ai * HALF + wr * 64 + m * 16 + fr; const int b = (int)(r / S);
#pragma unroll
                for (int bj = 0; bj < 2; ++bj) { const int c = u.pn * BM + 128 * bj + 32 * wc + 8 * fq;
                    f32x4 x0, x1;
                    if (xin32) { x0 = *(const f32x4*)(xin32 + r * D + c); x1 = *(const f32x4*)(xin32 + r * D + c + 4); }
                    else { const u32x4 q = *(const u32x4*)(XAB + r * D + c);
                        x0 = (f32x4){__builtin_bit_cast(float, q.x << 16), __builtin_bit_cast(float, q.x & 0xffff0000u), __builtin_bit_cast(float, q.y << 16), __builtin_bit_cast(float, q.y & 0xffff0000u)};
                        x1 = (f32x4){__builtin_bit_cast(float, q.z << 16), __builtin_bit_cast(float, q.z & 0xffff0000u), __builtin_bit_cast(float, q.w << 16), __builtin_bit_cast(float, q.w & 0xffff0000u)}; }
                    const f32x4 g0 = *(const f32x4*)(g1 + (size_t)b * 6144 + c), g1v = *(const f32x4*)(g1 + (size_t)b * 6144 + c + 4);
                    const f32x4 y0 = x0 + g0 * acc[ai][bj][m][0], y1 = x1 + g1v * acc[ai][bj][m][1];
                    u32x4 o; o.x = cvt_pk_bf16(y0[0], y0[1]); o.y = cvt_pk_bf16(y0[2], y0[3]); o.z = cvt_pk_bf16(y1[0], y1[1]); o.w = cvt_pk_bf16(y1[2], y1[3]);
                    *(u32x4*)(XAB + r * D + c) = o; } }
    }
};
struct EpiM1 {
    unsigned char* ACT8; const float* b1l; const float* dq1l;
    struct Pre { f32x4 bg, bl, sg, sl; };
    __device__ __forceinline__ void prefetch(const Unit&, int, int, Pre&) const {}
    __device__ __forceinline__ void preload(const Unit& u, int wc, int fq, Pre& q) const {
        const int c0 = u.pn * 128 + 32 * wc + 8 * fq; const float* b1 = b1l + (size_t)u.e * 2048 + c0; const float* dq = dq1l + (size_t)u.e * 2048 + c0;
        q.bg = *(const f32x4*)(b1); q.bl = *(const f32x4*)(b1 + 1024); q.sg = *(const f32x4*)(dq); q.sl = *(const f32x4*)(dq + 1024); }
    __device__ __forceinline__ void init(f32x4 (&acc)[2][2][4][2], const Pre&) const {
#pragma unroll
        for (int a = 0; a < 2; ++a)
#pragma unroll
            for (int b = 0; b < 2; ++b)
#pragma unroll
                for (int m = 0; m < 4; ++m)
#pragma unroll
                    for (int n = 0; n < 2; ++n) acc[a][b][m][n] = (f32x4){0.f, 0.f, 0.f, 0.f};
    }
    __device__ __forceinline__ void operator()(const f32x4 (&acc)[2][2][4][2], const Unit& u, int wr, int wc, int fr, int fq, bool has_next, const Unit& nxt, Pre& pre) const {
        const int c0 = u.pn * 128 + 32 * wc + 8 * fq;
        const float* b1 = b1l + (size_t)u.e * 2048 + c0; const float* dq = dq1l + (size_t)u.e * 2048 + c0;
        unsigned w[2][4][2];
        const f32x4 bg1 = *(const f32x4*)(b1 + 4), bl1 = *(const f32x4*)(b1 + 1024 + 4), sg1 = *(const f32x4*)(dq + 4), sl1 = *(const f32x4*)(dq + 1024 + 4);
#pragma unroll
        for (int n = 0; n < 2; ++n) {
            const f32x4 bg = n ? bg1 : pre.bg, bl = n ? bl1 : pre.bl;
            const f32x4 sg = (n ? sg1 : pre.sg) * (1.f / XS8), sl = (n ? sl1 : pre.sl) * (1.f / XS8);
#pragma unroll
            for (int ai = 0; ai < 2; ++ai)
#pragma unroll
                for (int m = 0; m < 4; ++m) { const f32x4 g = acc[ai][0][m][n] * sg + bg, li = acc[ai][1][m][n] * sl + bl; float o[4];
#pragma unroll
                    for (int i = 0; i < 4; ++i) { const float gc = fminf(g[i], 7.f), lc = __builtin_amdgcn_fmed3f(li[i], -7.f, 7.f);
                        o[i] = (AS8 * (lc + 1.f)) * (gc * __builtin_amdgcn_rcpf(1.f + __builtin_amdgcn_exp2f((-1.702f * LOG2E) * gc))); }
                    w[ai][m][n] = pk_fp8x4(o[0], o[1], o[2], o[3]); }
        }
#pragma unroll
        for (int ai = 0; ai < 2; ++ai)
#pragma unroll
            for (int m = 0; m < 4; ++m) { const size_t r = (size_t)u.pm * BM + ai * HALF + wr * 64 + m * 16 + fr;
                *(uint2*)(ACT8 + r * DFF + c0) = make_uint2(w[ai][m][0], w[ai][m][1]); }
    }
};
struct EpiM2 {
    bf16_t* Y; const float* b2l; const float* dq2l;
    struct Pre {};
    __device__ __forceinline__ void prefetch(const Unit&, int, int, Pre&) const {}
    __device__ __forceinline__ void preload(const Unit&, int, int, Pre&) const {}
    __device__ __forceinline__ void init(f32x4 (&acc)[2][2][4][2], const Pre&) const {
#pragma unroll
        for (int a = 0; a < 2; ++a)
#pragma unroll
            for (int b = 0; b < 2; ++b)
#pragma unroll
                for (int m = 0; m < 4; ++m)
#pragma unroll
                    for (int n = 0; n < 2; ++n) acc[a][b][m][n] = (f32x4){0.f, 0.f, 0.f, 0.f};
    }
    __device__ __forceinline__ void operator()(const f32x4 (&acc)[2][2][4][2], const Unit& u, int wr, int wc, int fr, int fq, bool has_next, const Unit& nxt, Pre& pre) const {
        const int cb = u.pn * BM + 32 * wc + 8 * fq;
        const float* b2 = b2l + (size_t)u.e * D + cb; const float* dq = dq2l + (size_t)u.e * D + cb;
#pragma unroll
        for (int bj = 0; bj < 2; ++bj) { const int c = cb + 128 * bj;
            const f32x4 b0 = *(const f32x4*)(b2 + 128 * bj), b1_ = *(const f32x4*)(b2 + 128 * bj + 4);
            const f32x4 s0 = *(const f32x4*)(dq + 128 * bj) * (1.f / AS8), s1 = *(const f32x4*)(dq + 128 * bj + 4) * (1.f / AS8);
#pragma unroll
            for (int ai = 0; ai < 2; ++ai)
#pragma unroll
                for (int m = 0; m < 4; ++m) { const size_t r = (size_t)u.pm * BM + ai * HALF + wr * 64 + m * 16 + fr;
                    const f32x4 v0 = acc[ai][bj][m][0] * s0 + b0, v1 = acc[ai][bj][m][1] * s1 + b1_;
                    u32x4 o; o.x = cvt_pk_bf16(v0[0], v0[1]); o.y = cvt_pk_bf16(v0[2], v0[3]); o.z = cvt_pk_bf16(v1[0], v1[1]); o.w = cvt_pk_bf16(v1[2], v1[3]);
                    *(u32x4*)(Y + r * D + c) = o; }
        }
    }
};
}

__device__ __forceinline__ void phase_g1_fast(const Params& p, int l, unsigned char* lds_raw) {
    pg8::ProbDense P{(const bf16_t*)(p.ws + WS_XN), (const bf16_t*)(p.ws + WS_WINT) + (size_t)l * ZBW * D, D, T / 256, ZBW / 256, (int)gridDim.x, (int)blockIdx.x, true};
    pg8::EpiG1F E{(bf16_t*)(p.ws + WS_ZB), (float*)(p.ws + WS_GATE), p.in[7] + l * 64, p.in[8] + l * 64, p.in[12] + l * 64, p.in[13] + l * 64};
    pg8::gemm_phase<pg8::ProbDense, pg8::EpiG1F, true, true>((PG8_LAS unsigned char*)lds_raw, P, E);
}
__device__ __forceinline__ void phase_g2_fast(const Params& p, int l, unsigned char* lds_raw) {
    pg8::ProbDense P{(const bf16_t*)(p.ws + WS_ATTB), (const bf16_t*)(p.ws + WS_WOT) + (size_t)l * D * D, D, T / 256, D / 256, (int)gridDim.x, (int)blockIdx.x, false};
    pg8::EpiG2 E{l == 0 ? p.in[0] : (const float*)nullptr, (bf16_t*)(p.ws + WS_XAB), (const float*)(p.ws + WS_MOD) + (size_t)l * Bn * 6144 + 2 * D};
    pg8::gemm_phase<pg8::ProbDense, pg8::EpiG2, true, true>((PG8_LAS unsigned char*)lds_raw, P, E);
}
constexpr int LDS_PS_OFF = 131072;
__device__ __forceinline__ void phase_ck_fast(const Params& p, int l, unsigned char* lds_raw) {
    pg8::ProbCmp P{(const bf16_t*)(p.ws + WS_ZB), (const bf16_t*)(p.ws + WS_WCT) + (size_t)l * 2 * 128 * 2048, 2048, (int)gridDim.x, (int)blockIdx.x};
    pg8::EpiCmp E{(float*)(p.ws + WS_HIDP)};
    pg8::gemm_phase<pg8::ProbCmp, pg8::EpiCmp, true, true>((PG8_LAS unsigned char*)lds_raw, P, E);
    { const int tid = otid(), lane = tid & 63, wave = tid >> 6, r8 = lane >> 3, c8 = lane & 7;
      const bf16_t* Z = (const bf16_t*)(p.ws + WS_ZB); bf16_t* KMB = (bf16_t*)(p.ws + WS_KMB);
      float* part = (float*)(lds_raw + 131072 + 512);
      for (int it0 = blockIdx.x * 2; it0 < Bn * 8 * 32; it0 += gridDim.x * 2) {
          const int it = it0 + (wave >> 2), q = wave & 3;
          const int b = it / 256, h = (it / 32) & 7, blk = it & 31;
          const bf16_t* base = Z + (size_t)(b * S + blk * 256 + q * 64 + r8) * ZBW + ZB_MK + h * 64 + c8 * 8;
          float s[8] = {0.f, 0.f, 0.f, 0.f, 0.f, 0.f, 0.f, 0.f};
          uint4 v[8];
#pragma unroll
          for (int i = 0; i < 8; ++i) v[i] = *(const uint4*)(base + (size_t)(8 * i) * ZBW);
#pragma unroll
          for (int i = 0; i < 8; ++i) { const unsigned w[4] = {v[i].x, v[i].y, v[i].z, v[i].w};
#pragma unroll
              for (int e = 0; e < 4; ++e) { s[2 * e] += __builtin_bit_cast(float, w[e] << 16); s[2 * e + 1] += __builtin_bit_cast(float, w[e] & 0xffff0000u); } }
#pragma unroll
          for (int e = 0; e < 8; ++e) { s[e] += __shfl_xor(s[e], 8); s[e] += __shfl_xor(s[e], 16); s[e] += __shfl_xor(s[e], 32); }
          if (r8 == 0) {
#pragma unroll
              for (int e = 0; e < 8; ++e) part[wave * 64 + c8 * 8 + e] = s[e]; }
          __syncthreads();
          if (tid < 128) { const int item = tid >> 6, d = tid & 63; const float* pp = part + item * 256 + d;
              KMB[(size_t)(it0 + item) * 64 + d] = (bf16_t)f2bf((((pp[0] + pp[64]) + pp[128]) + pp[192]) * (1.f / 256.f)); }
          __syncthreads();
      } }
}
__device__ __forceinline__ void phase_m1_fast(const Params& p, int l, unsigned char* lds_raw) {
    int* ps = (int*)(lds_raw + LDS_PS_OFF);
    load_pstart(p, l, ps);
    pg8::ProbMoe1 P{(const bf16_t*)(p.ws + WS_XN8), (const bf16_t*)(p.ws + WS_W1T) + (size_t)l * NE * 2048 * 512, (const int*)(p.ws + WS_ROWTOK) + (size_t)l * RMAX, (pg8::lds_ints)ps, 512, ps[32] / 256, (int)gridDim.x, (int)blockIdx.x};
    pg8::EpiM1 E{p.ws + WS_ACT, p.in[18] + (size_t)l * NE * 2048, (const float*)(p.ws + WS_DQ1) + (size_t)l * NE * 2048};
    pg8::gemm_phase<pg8::ProbMoe1, pg8::EpiM1, true, true>((PG8_LAS unsigned char*)lds_raw, P, E);
    __syncthreads();
}
__device__ __forceinline__ void phase_m2_fast(const Params& p, int l, unsigned char* lds_raw) {
    int* ps = (int*)(lds_raw + LDS_PS_OFF);
    load_pstart(p, l, ps);
    pg8::ProbMoe2 P{(const bf16_t*)(p.ws + WS_ACT), (const bf16_t*)(p.ws + WS_W2T) + (size_t)l * NE * D * 512, (pg8::lds_ints)ps, 512, ps[32] / 256, (int)gridDim.x, (int)blockIdx.x};
    pg8::EpiM2 E{(bf16_t*)(p.ws + WS_Y), p.in[20] + (size_t)l * NE * D, (const float*)(p.ws + WS_DQ2) + (size_t)l * NE * D};
    pg8::gemm_phase<pg8::ProbMoe2, pg8::EpiM2, true, true>((PG8_LAS unsigned char*)lds_raw, P, E);
    __syncthreads();
}

namespace at {
#define AT_LAS __attribute__((address_space(3)))
typedef short bf16x8 __attribute__((ext_vector_type(8)));
typedef short s16x4 __attribute__((ext_vector_type(4)));
typedef short v4i16_t __attribute__((ext_vector_type(4)));
typedef float f32x16 __attribute__((ext_vector_type(16)));
typedef unsigned u32x4 __attribute__((ext_vector_type(4)));
typedef float f32x2_t __attribute__((ext_vector_type(2))); typedef __bf16 bf16x2_t __attribute__((ext_vector_type(2)));
typedef AT_LAS unsigned char* lp;
constexpr int L_K = 0  , L_V = 32768  , L_WSF = 65536, L_OST = 67584  , L_SELM = 133120, L_UNI = 134144, L_KMT = 134400, L_END = 142592;
constexpr float NEGS = -1e30f;
constexpr float MAXTHR = 12.f;
__device__ __forceinline__ int crow(int r, int hi) { return (r & 3) + 8 * (r >> 2) + 4 * hi; }
__device__ __forceinline__ unsigned cvtpk(float lo, float hi) { f32x2_t v = {lo, hi}; bf16x2_t b = __builtin_convertvector(v, bf16x2_t); return __builtin_bit_cast(unsigned, b); }
__device__ __forceinline__ float mx3(float a, float b, float c) { return __builtin_fmaxf(__builtin_fmaxf(a, b), c); }
__device__ __forceinline__ void wsync() { asm volatile("s_waitcnt lgkmcnt(0)" ::: "memory"); __builtin_amdgcn_wave_barrier(); }
__device__ __forceinline__ void bar() { __builtin_amdgcn_s_barrier(); }
#define AT_WAITV(n) asm volatile("s_waitcnt vmcnt(" #n ")" ::: "memory")
#define AT_WAITL() asm volatile("s_waitcnt lgkmcnt(0)" ::: "memory")
__device__ __forceinline__ void glds(const void* g, lp dst) { __builtin_amdgcn_global_load_lds((const unsigned*)g, (AT_LAS unsigned*)dst, 16, 0, 0); }
__device__ __forceinline__ s16x4 vtr(const AT_LAS unsigned char* p) { return __builtin_bit_cast(s16x4, __builtin_amdgcn_ds_read_tr16_b64_v4i16((AT_LAS v4i16_t*)p)); }

__device__ __forceinline__ void dma_k(lp slot, const bf16_t* kbase, int pitch, int key0, int wid, int lane) { glds(kbase + (size_t)(key0 + lane) * pitch + wid * 8, slot + wid * 1024); }
__device__ __forceinline__ void dma_v(lp slot, const bf16_t* vbase, int pitch, int key0, int wid, int lane) {
    glds(vbase + (size_t)(key0 + 16 * (wid & 3) + (lane >> 2)) * pitch + (wid >> 2) * 32 + (lane & 3) * 8, slot + wid * 1024); }

__device__ __forceinline__ void qk_tile(f32x16& p0, f32x16& p1, lp kslot, const bf16x8 (&qr)[4], int r32, int hi) {
    const AT_LAS unsigned char* kb = kslot + hi * 1024 + r32 * 16;
    bf16x8 b0[4], b1[4];
#pragma unroll
    for (int d0 = 0; d0 < 4; ++d0) { b0[d0] = *(const AT_LAS bf16x8*)(kb + d0 * 2048); b1[d0] = *(const AT_LAS bf16x8*)(kb + d0 * 2048 + 512); }
#pragma unroll
    for (int d0 = 0; d0 < 4; ++d0) {
        p0 = __builtin_amdgcn_mfma_f32_32x32x16_bf16(b0[d0], qr[d0], p0, 0, 0, 0);
        p1 = __builtin_amdgcn_mfma_f32_32x32x16_bf16(b1[d0], qr[d0], p1, 0, 0, 0);
    }
}
struct VFrag { bf16x8 f[8]; };
__device__ __forceinline__ void pv_load(VFrag& v, lp vslot, int lane, int hi) {
    const AT_LAS unsigned char* vp = vslot + ((lane >> 4) & 1) * 32 + (lane & 3) * 8 + (4 * hi + ((lane & 15) >> 2)) * 64;
#pragma unroll
    for (int d0 = 0; d0 < 2; ++d0)
#pragma unroll
        for (int ks = 0; ks < 4; ++ks) {
            const s16x4 lo = vtr(vp + d0 * 4096 + ks * 1024), hh = vtr(vp + d0 * 4096 + ks * 1024 + 512);
            v.f[d0 * 4 + ks] = (bf16x8){lo[0], lo[1], lo[2], lo[3], hh[0], hh[1], hh[2], hh[3]};
        }
}
__device__ __forceinline__ void pv_mfma(f32x16 (&o)[2], const VFrag& v, u32x4 pw0, u32x4 pw1, u32x4 pw2, u32x4 pw3) {
    const bf16x8 pa[4] = {__builtin_bit_cast(bf16x8, pw0), __builtin_bit_cast(bf16x8, pw1), __builtin_bit_cast(bf16x8, pw2), __builtin_bit_cast(bf16x8, pw3)};
#pragma unroll
    for (int ks = 0; ks < 4; ++ks) {
        o[0] = __builtin_amdgcn_mfma_f32_32x32x16_bf16(pa[ks], v.f[ks], o[0], 0, 0, 0);
        o[1] = __builtin_amdgcn_mfma_f32_32x32x16_bf16(pa[ks], v.f[4 + ks], o[1], 0, 0, 0);
    }
}
__device__ __forceinline__ float rowmax(const f32x16& p0, const f32x16& p1) {
    float a = mx3(p0[0], p0[1], p1[0]), b = mx3(p0[2], p0[3], p1[1]); a = mx3(a, p1[2], p1[3]);
#pragma unroll
    for (int r = 4; r < 16; r += 4) { a = mx3(a, p0[r], p0[r + 1]); b = mx3(b, p0[r + 2], p0[r + 3]); a = mx3(a, p1[r], p1[r + 1]); b = mx3(b, p1[r + 2], p1[r + 3]); }
    const float m = __builtin_fmaxf(a, b);
    auto rr = __builtin_amdgcn_permlane32_swap(__float_as_uint(m), __float_as_uint(m), false, false);
    return __builtin_fmaxf(__uint_as_float(rr[0]), __uint_as_float(rr[1]));
}
__device__ __forceinline__ float halfsum(float v) {
    auto rr = __builtin_amdgcn_permlane32_swap(__float_as_uint(v), __float_as_uint(v), false, false);
    return __uint_as_float(rr[0]) + __uint_as_float(rr[1]);
}
__device__ __forceinline__ void mask_tile(f32x16& p0, f32x16& p1, int lo, int hi_, int hi) {
    const int kb = 4 * hi;
#pragma unroll
    for (int r = 0; r < 16; ++r) { const int kv = kb + (r & 3) + 8 * (r >> 2); if (kv > hi_ || kv < lo) p0[r] = NEGS; if (kv + 32 > hi_ || kv + 32 < lo) p1[r] = NEGS; }
}

__device__ __forceinline__ void mask_init_lo(f32x16& p0, f32x16& p1, int lo, int hi) {
    const int kb = 4 * hi;
#pragma unroll
    for (int r = 0; r < 16; ++r) { const int kv = kb + (r & 3) + 8 * (r >> 2); if (kv < lo) p0[r] = NEGS; if (kv + 32 < lo) p1[r] = NEGS; }
}
__device__ __forceinline__ void mask_init(f32x16& p0, f32x16& p1, int hi_, int hi) {
    const int kb = 4 * hi;
#pragma unroll
    for (int r = 0; r < 16; ++r) { const int kv = kb + (r & 3) + 8 * (r >> 2); if (kv > hi_) p0[r] = NEGS; if (kv + 32 > hi_) p1[r] = NEGS; }
}
__device__ __forceinline__ int next_bit128(unsigned u0, unsigned u1, unsigned u2, unsigned u3, int below) {
    if (below > 96) { unsigned x = u3; if (below < 128) x &= (1u << (below - 96)) - 1u; if (x) return 96 + 31 - __builtin_clz(x); }
    if (below > 64) { unsigned x = u2; if (below < 96) x &= (1u << (below - 64)) - 1u; if (x) return 64 + 31 - __builtin_clz(x); }
    if (below > 32) { unsigned x = u1; if (below < 64) x &= (1u << (below - 32)) - 1u; if (x) return 32 + 31 - __builtin_clz(x); }
    if (below > 0) { unsigned x = u0; if (below < 32) x &= (1u << below) - 1u; if (x) return 31 - __builtin_clz(x); }
    return -1;
}
struct Soft { float m, l; };

template <bool HAS_O>
__device__ __forceinline__ void softmax_step(f32x16& p0, f32x16& p1, Soft& st, f32x16 (&o)[2], float* wsf, int r32, int hi) {
    const float rm = rowmax(p0, p1);
    if (__any(rm > MAXTHR)) {
        const float dl = __builtin_fmaxf(rm, 0.f); st.m += dl;
#pragma unroll
        for (int r = 0; r < 16; ++r) { p0[r] -= dl; p1[r] -= dl; }
        const float al = __builtin_amdgcn_exp2f(-dl); st.l *= al;
        if (HAS_O) {
            if (hi == 0) wsf[r32] = al;
            wsync();
#pragma unroll
            for (int r = 0; r < 16; ++r) { const float f = wsf[crow(r, hi)]; o[0][r] *= f; o[1][r] *= f; }
            wsync();
        }
    }
    float s = 0.f;
#pragma unroll
    for (int r = 0; r < 16; ++r) { p0[r] = __builtin_amdgcn_exp2f(p0[r]); p1[r] = __builtin_amdgcn_exp2f(p1[r]); s += p0[r] + p1[r]; }
    st.l += s;
}
#define AT_PACK(P0, P1) \
    const u32x4 pw0 = {cvtpk(P0[0], P0[1]), cvtpk(P0[2], P0[3]), cvtpk(P0[4], P0[5]), cvtpk(P0[6], P0[7])}, pw1 = {cvtpk(P0[8], P0[9]), cvtpk(P0[10], P0[11]), cvtpk(P0[12], P0[13]), cvtpk(P0[14], P0[15])}, \
                pw2 = {cvtpk(P1[0], P1[1]), cvtpk(P1[2], P1[3]), cvtpk(P1[4], P1[5]), cvtpk(P1[6], P1[7])}, pw3 = {cvtpk(P1[8], P1[9]), cvtpk(P1[10], P1[11]), cvtpk(P1[12], P1[13]), cvtpk(P1[14], P1[15])}
__device__ __forceinline__ float fma_vsv(float a, float k, float x) { float d; asm("v_fma_f32 %0, %1, %2, %3" : "=v"(d) : "v"(a), "s"(k), "v"(x)); return d; }
__device__ __forceinline__ f32x16 cinit(float c2k, int hi, float x) { f32x16 c; const float xb = __builtin_fmaf(c2k, (float)(4 * hi), x);
    c[0] = xb;
#pragma unroll
    for (int r = 1; r < 16; ++r) c[r] = fma_vsv(c2k, (float)((r & 3) + 8 * (r >> 2)), xb);
    return c; }
template <bool FIRST>
__device__ __forceinline__ void acc_scaled(float* stage, const f32x16 (&o)[2], float f, float* wsf, int r32, int hi) {
    if (hi == 0) wsf[r32] = f;
    wsync();
#pragma unroll
    for (int r = 0; r < 16; ++r) { const int orow = crow(r, hi); const float g = wsf[orow]; float* s0 = stage + orow * 64 + r32;
        if (FIRST) { s0[0] = o[0][r] * g; s0[32] = o[1][r] * g; } else { s0[0] += o[0][r] * g; s0[32] += o[1][r] * g; } }
    wsync();
}

#define AT_WAIT_NEWER(newer, per) do { if ((newer) >= 2) { if ((per) == 2) AT_WAITV(4); else AT_WAITV(2); } else if ((newer) == 1) { if ((per) == 2) AT_WAITV(2); else AT_WAITV(1); } else AT_WAITV(0); } while (0)


#define AT_SB() __builtin_amdgcn_sched_barrier(0)
struct PipeOut { float s, rmn; };
__device__ __forceinline__ PipeOut pipe_step(f32x16& c0, f32x16& c1, f32x16& n0, f32x16& n1, f32x16 (&o)[2], lp kslot_next, lp vslot, const bf16x8 (&qr)[4], int lane, int r32, int hi) {
    const AT_LAS unsigned char* kb = kslot_next + hi * 1024 + r32 * 16;
    const AT_LAS unsigned char* vp = vslot + ((lane >> 4) & 1) * 32 + (lane & 3) * 8 + (4 * hi + ((lane & 15) >> 2)) * 64;
    bf16x8 kf[8];
#pragma unroll
    for (int j = 0; j < 4; ++j) kf[j] = *(const AT_LAS bf16x8*)(kb + (j >> 1) * 2048 + (j & 1) * 512);
    AT_SB();
    unsigned w0[8], w1[8]; s16x4 vl[8], vh[8]; float s = 0.f;
#pragma unroll
    for (int j = 0; j < 8; ++j) {
        if (j & 1) n1 = __builtin_amdgcn_mfma_f32_32x32x16_bf16(kf[j], qr[j >> 1], n1, 0, 0, 0);
        else       n0 = __builtin_amdgcn_mfma_f32_32x32x16_bf16(kf[j], qr[j >> 1], n0, 0, 0, 0);
        if (j < 4) kf[j + 4] = *(const AT_LAS bf16x8*)(kb + ((j + 4) >> 1) * 2048 + (j & 1) * 512);
        if (j >= 4) {
#pragma unroll
            for (int q = 0; q < 2; ++q) { const int f = (j - 4) * 2 + q, d0 = f >> 2, ks = f & 3; vl[f] = vtr(vp + d0 * 4096 + ks * 1024); vh[f] = vtr(vp + d0 * 4096 + ks * 1024 + 512); }
        }
        const float e0 = __builtin_amdgcn_exp2f(c0[2 * j]), e1 = __builtin_amdgcn_exp2f(c0[2 * j + 1]), e2 = __builtin_amdgcn_exp2f(c1[2 * j]), e3 = __builtin_amdgcn_exp2f(c1[2 * j + 1]);
        s += (e0 + e1) + (e2 + e3);
        asm volatile("" : "+v"(s));
        w0[j] = cvtpk(e0, e1); w1[j] = cvtpk(e2, e3);
        AT_SB();
    }
    const u32x4 pw0 = {w0[0], w0[1], w0[2], w0[3]}, pw1 = {w0[4], w0[5], w0[6], w0[7]}, pw2 = {w1[0], w1[1], w1[2], w1[3]}, pw3 = {w1[4], w1[5], w1[6], w1[7]};
    const bf16x8 pa[4] = {__builtin_bit_cast(bf16x8, pw0), __builtin_bit_cast(bf16x8, pw1), __builtin_bit_cast(bf16x8, pw2), __builtin_bit_cast(bf16x8, pw3)};
    float a = mx3(n0[0], n0[1], n1[0]), b = mx3(n0[2], n0[3], n1[1]);
#pragma unroll
    for (int f = 0; f < 8; ++f) {
        const int d0 = f >> 2, ks = f & 3;
        const bf16x8 vf = (bf16x8){vl[f][0], vl[f][1], vl[f][2], vl[f][3], vh[f][0], vh[f][1], vh[f][2], vh[f][3]};
        o[d0] = __builtin_amdgcn_mfma_f32_32x32x16_bf16(pa[ks], vf, o[d0], 0, 0, 0);
        if (f == 0) { a = mx3(a, n1[2], n1[3]); }
        else if (f < 4) { const int r = 4 * f; a = mx3(a, n0[r], n0[r + 1]); b = mx3(b, n0[r + 2], n0[r + 3]); a = mx3(a, n1[r], n1[r + 1]); b = mx3(b, n1[r + 2], n1[r + 3]); }
        asm volatile("" : "+v"(a), "+v"(b));
        AT_SB();
    }
    const float m = __builtin_fmaxf(a, b);
    auto rr = __builtin_amdgcn_permlane32_swap(__float_as_uint(m), __float_as_uint(m), false, false);
    PipeOut out; out.s = s; out.rmn = __builtin_fmaxf(__uint_as_float(rr[0]), __uint_as_float(rr[1]));
    return out;
}
__device__ __forceinline__ void nsa_unit(const Params& p, int b, int g, int c, unsigned char* lds_raw) {
    const int tid = otid(), lane = tid & 63, r32 = lane & 31, hi = lane >> 5, wid = __builtin_amdgcn_readfirstlane(tid >> 6);
    lp lds = (lp)lds_raw;
    const bf16_t* ZB = (const bf16_t*)(p.ws + WS_ZB); const float* GT = (const float*)(p.ws + WS_GATE);
    const bf16_t* KCB = (const bf16_t*)(p.ws + WS_KCB) + (size_t)(b * 2 + g) * 512 * 64; const bf16_t* VCB = (const bf16_t*)(p.ws + WS_VCB) + (size_t)(b * 2 + g) * 512 * 64;
    const int t0 = c * 64, hg = r32 >> 3, qq = r32 & 7, qi = 8 * wid + qq, t = t0 + qi, h = 4 * g + hg; const size_t tt = (size_t)b * S + t;
    float* wsf = (float*)(lds_raw + L_WSF) + wid * 64;
    float* ostage = (float*)(lds_raw + L_OST) + wid * 2048;
    float* imp = ostage;
    unsigned* selm = (unsigned*)(lds_raw + L_SELM);
    unsigned* uni = (unsigned*)(lds_raw + L_UNI);
    const float c2 = exp2f(-(float)(h + 1)) * LOG2E;
    bf16x8 qr[4];
#pragma unroll
    for (int d0 = 0; d0 < 4; ++d0) qr[d0] = *(const bf16x8*)(ZB + tt * ZBW + ZB_Q + h * 64 + d0 * 16 + hi * 8);
    const float gt0 = GT[tt * 32 + h * 3 + 0], gt1 = GT[tt * 32 + h * 3 + 1], gt2 = GT[tt * 32 + h * 3 + 2];
    f32x16 o[2];
    const lp sK0 = lds + L_K, sV0 = lds + L_V;
    const int nmax = t >= 31 ? (t - 31) >> 4 : -1;
    const int ntc = ((4 * c + 2) >> 6) + 1;
    for (int i = lane; i < 8 * 129; i += 64) imp[i] = 0.f;
    Soft sc; sc.m = 0.f; sc.l = 0.f;
#pragma unroll
    for (int k = 0; k < 3; ++k) if (k < ntc) dma_k(sK0 + k * 8192, KCB, 64, 64 * k, wid, lane);
    for (int k = 0; k < ntc; ++k) {
        const int newer = ntc - 1 - k; AT_WAIT_NEWER(newer, 1);
        AT_WAITL(); bar();
        if (k + 3 < ntc) dma_k(sK0 + ((k + 3) & 3) * 8192, KCB, 64, 64 * (k + 3), wid, lane);
        const lp sK = sK0 + (k & 3) * 8192;
        const float x0 = c2 * (16.f * (64 * k) + 15.5f - (float)t0) - sc.m;
        f32x16 p0 = cinit(16.f * c2, hi, x0), p1 = cinit(16.f * c2, hi, x0 + c2 * 512.f);
        qk_tile(p0, p1, sK, qr, r32, hi);
        if (__any(nmax - 64 * k < 63)) mask_tile(p0, p1, 0, nmax - 64 * k, hi);
        softmax_step<false>(p0, p1, sc, o, wsf, r32, hi);
    }
    const float lc = halfsum(sc.l), linv = lc > 0.f ? 1.f / lc : 0.f;
    o[0] = f32x16{}; o[1] = f32x16{};
    AT_WAITL(); bar();
#pragma unroll
    for (int k = 0; k < 3; ++k) if (k < ntc) { dma_k(sK0 + k * 8192, KCB, 64, 64 * k, wid, lane); dma_v(sV0 + k * 8192, VCB, 64, 64 * k, wid, lane); }
    for (int k = 0; k < ntc; ++k) {
        const int newer = ntc - 1 - k; AT_WAIT_NEWER(newer, 2);
        AT_WAITL(); bar();
        if (k + 3 < ntc) { dma_k(sK0 + ((k + 3) & 3) * 8192, KCB, 64, 64 * (k + 3), wid, lane); dma_v(sV0 + ((k + 3) & 3) * 8192, VCB, 64, 64 * (k + 3), wid, lane); }
        const lp sK = sK0 + (k & 3) * 8192, sV = sV0 + (k & 3) * 8192;
        const float x0 = c2 * (16.f * (64 * k) + 15.5f - (float)t0) - sc.m;
        f32x16 p0 = cinit(16.f * c2, hi, x0), p1 = cinit(16.f * c2, hi, x0 + c2 * 512.f);
        qk_tile(p0, p1, sK, qr, r32, hi);
        if (__any(nmax - 64 * k < 63)) mask_tile(p0, p1, 0, nmax - 64 * k, hi);
        VFrag vf; pv_load(vf, sV, lane, hi);
#pragma unroll
        for (int r = 0; r < 16; ++r) { p0[r] = __builtin_amdgcn_exp2f(p0[r]); p1[r] = __builtin_amdgcn_exp2f(p1[r]); }
        { AT_PACK(p0, p1); pv_mfma(o, vf, pw0, pw1, pw2, pw3); }
        float gs[8], ls[8];
#pragma unroll
        for (int q4 = 0; q4 < 4; ++q4) { gs[q4] = ((p0[4 * q4] + p0[4 * q4 + 1]) + (p0[4 * q4 + 2] + p0[4 * q4 + 3])) * linv; ls[q4] = p0[4 * q4 + 3] * linv;
                                         gs[4 + q4] = ((p1[4 * q4] + p1[4 * q4 + 1]) + (p1[4 * q4 + 2] + p1[4 * q4 + 3])) * linv; ls[4 + q4] = p1[4 * q4 + 3] * linv; }
#pragma unroll
        for (int q4 = 0; q4 < 8; ++q4) { gs[q4] += __shfl_xor(gs[q4], 8); gs[q4] += __shfl_xor(gs[q4], 16); ls[q4] += __shfl_xor(ls[q4], 8); ls[q4] += __shfl_xor(ls[q4], 16); }
        if (r32 < 8) {
            float* row = imp + qq * 129 + 16 * k + hi;
#pragma unroll
            for (int q4 = 0; q4 < 8; ++q4) row[2 * q4] += gs[q4];
        }
        wsync();
        if (r32 < 8) {
            float* row = imp + qq * 129 + 16 * k + hi + 1;
#pragma unroll
            for (int q4 = 0; q4 < 8; ++q4) row[2 * q4] += ls[q4];
        }
        wsync();
    }
    unsigned mk0 = 0u, mk1 = 0u, mk2 = 0u, mk3 = 0u;
    {
        const int qs = lane >> 3, part = lane & 7;
        float v[16];
#pragma unroll
        for (int i = 0; i < 16; ++i) { const int j = part * 16 + i; float x = imp[qs * 129 + j]; if (j == 0 || j == c || j == c - 1) x = 1e4f; if (j > c) x = NEGS; v[i] = x; }
#pragma unroll 1
        for (int it = 0; it < 16; ++it) {
            float bv = -3e38f; int bi = 0;
#pragma unroll
            for (int i = 0; i < 16; ++i) if (v[i] > bv) { bv = v[i]; bi = part * 16 + i; }
#pragma unroll
            for (int sft = 1; sft < 8; sft <<= 1) { const float ov = __shfl_xor(bv, sft); const int oi = __shfl_xor(bi, sft); if (ov > bv || (ov == bv && oi < bi)) { bv = ov; bi = oi; } }
            if (bv > NEGS) { const unsigned bit = 1u << (bi & 31); const int wq = bi >> 5; if (wq == 0) mk0 |= bit; else if (wq == 1) mk1 |= bit; else if (wq == 2) mk2 |= bit; else mk3 |= bit; }
#pragma unroll
            for (int i = 0; i < 16; ++i) if (part * 16 + i == bi) v[i] = -3.4e38f;
        }
        if (part == 0) { unsigned* sm = selm + (8 * wid + qs) * 4; sm[0] = mk0; sm[1] = mk1; sm[2] = mk2; sm[3] = mk3; }
        unsigned u0 = mk0, u1 = mk1, u2 = mk2, u3 = mk3;
#pragma unroll
        for (int sft = 8; sft < 64; sft <<= 1) { u0 |= __shfl_xor(u0, sft); u1 |= __shfl_xor(u1, sft); u2 |= __shfl_xor(u2, sft); u3 |= __shfl_xor(u3, sft); }
        if (lane == 0) { uni[wid * 4 + 0] = u0; uni[wid * 4 + 1] = u1; uni[wid * 4 + 2] = u2; uni[wid * 4 + 3] = u3; }
    }
    wsync();
    acc_scaled<true>(ostage, o, gt0 * linv, wsf, r32, hi);
    AT_WAITL(); bar();
    unsigned un0 = 0u, un1 = 0u, un2 = 0u, un3 = 0u;
#pragma unroll
    for (int w = 0; w < 8; ++w) { un0 |= uni[w * 4 + 0]; un1 |= uni[w * 4 + 1]; un2 |= uni[w * 4 + 2]; un3 |= uni[w * 4 + 3]; }
    un0 = __builtin_amdgcn_readfirstlane(un0); un1 = __builtin_amdgcn_readfirstlane(un1); un2 = __builtin_amdgcn_readfirstlane(un2); un3 = __builtin_amdgcn_readfirstlane(un3);
    const unsigned my0 = selm[(8 * wid + qq) * 4 + 0], my1 = selm[(8 * wid + qq) * 4 + 1], my2 = selm[(8 * wid + qq) * 4 + 2], my3 = selm[(8 * wid + qq) * 4 + 3];
    {
        const bf16_t* KS = ZB + (size_t)b * S * ZBW + ZB_KS + g * 64; const bf16_t* VS = ZB + (size_t)b * S * ZBW + ZB_VS + g * 64;
        Soft ss; ss.m = 0.f; ss.l = 0.f; o[0] = f32x16{}; o[1] = f32x16{};
        const int nsel = __builtin_popcount(un0) + __builtin_popcount(un1) + __builtin_popcount(un2) + __builtin_popcount(un3);
        int ji = 128;
#pragma unroll
        for (int k = 0; k < 3; ++k) if (k < nsel) { ji = next_bit128(un0, un1, un2, un3, ji); dma_k(sK0 + k * 8192, KS, ZBW, 64 * ji, wid, lane); dma_v(sV0 + k * 8192, VS, ZBW, 64 * ji, wid, lane); }
        int j = 128;
        for (int i = 0; i < nsel; ++i) {
            j = next_bit128(un0, un1, un2, un3, j);
            const int newer = nsel - 1 - i; AT_WAIT_NEWER(newer, 2);
            AT_WAITL(); bar();
            if (i + 3 < nsel) { ji = next_bit128(un0, un1, un2, un3, ji); dma_k(sK0 + ((i + 3) & 3) * 8192, KS, ZBW, 64 * ji, wid, lane); dma_v(sV0 + ((i + 3) & 3) * 8192, VS, ZBW, 64 * ji, wid, lane); }
            const lp sK = sK0 + (i & 3) * 8192, sV = sV0 + (i & 3) * 8192;
            const unsigned mw = (j >> 5) == 0 ? my0 : (j >> 5) == 1 ? my1 : (j >> 5) == 2 ? my2 : my3;
            const bool sel = (mw >> (j & 31)) & 1u;
            const float x0 = sel ? c2 * (float)(64 * j - t0) - ss.m : NEGS;
            f32x16 p0 = cinit(c2, hi, x0), p1 = cinit(c2, hi, sel ? x0 + c2 * 32.f : NEGS);
            qk_tile(p0, p1, sK, qr, r32, hi);
            if (j == c) mask_tile(p0, p1, 0, qi, hi);
            VFrag vf; pv_load(vf, sV, lane, hi);
            softmax_step<true>(p0, p1, ss, o, wsf, r32, hi);
            { AT_PACK(p0, p1); pv_mfma(o, vf, pw0, pw1, pw2, pw3); }
        }
        const float ls_ = halfsum(ss.l);
        acc_scaled<false>(ostage, o, ls_ > 0.f ? gt1 / ls_ : 0.f, wsf, r32, hi);
    }
    {
        const bf16_t* KW = ZB + (size_t)b * S * ZBW + ZB_KW + g * 64; const bf16_t* VW = ZB + (size_t)b * S * ZBW + ZB_VW + g * 64;
        Soft sw; sw.m = 0.f; sw.l = 0.f; o[0] = f32x16{}; o[1] = f32x16{};
        const int k0 = c >= 8 ? 0 : 8 - c, nw = 9 - k0;
        AT_WAITL(); bar();
#pragma unroll
        for (int k = 0; k < 3; ++k) if (k < nw) { dma_k(sK0 + k * 8192, KW, ZBW, t0 - 64 * k, wid, lane); dma_v(sV0 + k * 8192, VW, ZBW, t0 - 64 * k, wid, lane); }
        f32x16 pA0, pA1, pB0, pB1; float rmc;
#define WIN_STEP(C0, C1, N0, N1, I) do { const int i_ = (I); \
            if (i_ + 1 < nw) { if (i_ + 2 < nw) AT_WAITV(2); else AT_WAITV(0); } \
            AT_WAITL(); bar(); \
            if (i_ + 3 < nw) { dma_k(sK0 + ((i_ + 3) & 3) * 8192, KW, ZBW, t0 - 64 * (i_ + 3), wid, lane); dma_v(sV0 + ((i_ + 3) & 3) * 8192, VW, ZBW, t0 - 64 * (i_ + 3), wid, lane); } \
            if (__any(rmc > MAXTHR)) { \
                const float dl = __builtin_fmaxf(rmc, 0.f); sw.m += dl; \
                _Pragma("unroll") for (int r = 0; r < 16; ++r) { C0[r] -= dl; C1[r] -= dl; } \
                const float al = __builtin_amdgcn_exp2f(-dl); sw.l *= al; \
                if (hi == 0) wsf[r32] = al; \
                wsync(); \
                _Pragma("unroll") for (int r = 0; r < 16; ++r) { const float f = wsf[crow(r, hi)]; o[0][r] *= f; o[1][r] *= f; } \
                wsync(); \
            } \
            { const float x0 = c2 * (float)(-64 * (i_ + 1)) - sw.m; \
              N0 = cinit(c2, hi, x0); N1 = cinit(c2, hi, x0 + c2 * 32.f); \
              if (i_ + 1 == 8) mask_init_lo(N0, N1, qi + 1, hi); }        \
            const PipeOut po = pipe_step(C0, C1, N0, N1, o, sK0 + ((i_ + 1) & 3) * 8192, sV0 + (i_ & 3) * 8192, qr, lane, r32, hi); \
            sw.l += po.s; rmc = po.rmn; } while (0)
        { if (nw >= 3) AT_WAITV(4); else if (nw == 2) AT_WAITV(2); else AT_WAITV(0);
          AT_WAITL(); bar(); }
        { pB0 = cinit(c2, hi, 0.f); pB1 = cinit(c2, hi, c2 * 32.f);
          qk_tile(pB0, pB1, sK0, qr, r32, hi);
          mask_tile(pB0, pB1, 0, qi, hi);
          rmc = rowmax(pB0, pB1); }
        int i = 0;
#pragma unroll 1
        for (; i + 1 < nw; i += 2) {
            WIN_STEP(pB0, pB1, pA0, pA1, i);
            WIN_STEP(pA0, pA1, pB0, pB1, i + 1);
        }
        if (i < nw) WIN_STEP(pB0, pB1, pA0, pA1, i);
#undef WIN_STEP
        const float lw = halfsum(sw.l);
        acc_scaled<false>(ostage, o, lw > 0.f ? gt2 / lw : 0.f, wsf, r32, hi);
    }
    {
        bf16_t* AB = (bf16_t*)(p.ws + WS_ATTB);
#pragma unroll
        for (int i = 0; i < 4; ++i) { const int row = i * 8 + (lane >> 3), ch = lane & 7; const float4 a = *(const float4*)(ostage + row * 64 + ch * 8), c4 = *(const float4*)(ostage + row * 64 + ch * 8 + 4);
            const uint4 v = make_uint4(pk2(a.x, a.y), pk2(a.z, a.w), pk2(c4.x, c4.y), pk2(c4.z, c4.w));
            *(uint4*)(AB + ((size_t)b * S + t0 + 8 * wid + (row & 7)) * D + (4 * g + (row >> 3)) * 64 + ch * 8) = v; }
        wsync();
    }
    AT_WAITL(); bar();
}

}

constexpr int MB_CAP = 25600;
namespace at {
__device__ __forceinline__ void moba_route_unit(const Params& p, int b, int h, int qb, unsigned char* lds_raw) {
    const int tid = otid(), lane = tid & 63, r32 = lane & 31, hi = lane >> 5, wid = __builtin_amdgcn_readfirstlane(tid >> 6);
    lp lds = (lp)lds_raw;
    const bf16_t* ZB = (const bf16_t*)(p.ws + WS_ZB);
    const int bh = b * 8 + h;
    const bf16_t* KMB = (const bf16_t*)(p.ws + WS_KMB) + (size_t)bh * 32 * 64;
    const int qi = 32 * wid + r32, t = qb * 256 + qi; const size_t tt = (size_t)b * S + t;
    int* hist = (int*)(lds_raw + L_UNI);
    unsigned* SEL3 = (unsigned*)(p.ws + WS_SEL3); unsigned* LRK = (unsigned*)(p.ws + WS_LRK);
    unsigned char* IL = (unsigned char*)(p.ws + WS_ILIST) + ((size_t)(bh * 32 + qb) * 32) * 256;
    int* BCm = (int*)(p.ws + WS_BCM) + (size_t)(bh * 32 + qb) * 32;
    if (tid < 32) hist[tid] = 0;
    bf16x8 qr[4];
#pragma unroll
    for (int d0 = 0; d0 < 4; ++d0) qr[d0] = *(const bf16x8*)(ZB + tt * ZBW + ZB_MQ + h * 64 + d0 * 16 + hi * 8);
    const lp sKM = lds + L_KMT;
    glds(KMB + (size_t)(lane & 31) * 64 + wid * 8, sKM + wid * 1024);
    AT_WAITV(0); AT_WAITL(); bar();
    f32x16 g0 = f32x16{}, g1 = f32x16{};
    qk_tile(g0, g1, sKM, qr, r32, hi);
    float v1 = NEGS, v2 = NEGS, v3 = NEGS; int i1 = 64, i2 = 64, i3 = 64;
#pragma unroll
    for (int r = 0; r < 16; ++r) { const int n = crow(r, hi); const float s_ = n < qb ? g0[r] : NEGS;
        if (s_ > v1) { v3 = v2; i3 = i2; v2 = v1; i2 = i1; v1 = s_; i1 = n; } else if (s_ > v2) { v3 = v2; i3 = i2; v2 = s_; i2 = n; } else if (s_ > v3) { v3 = s_; i3 = n; } }
    float ov[3]; int oi[3];
    { auto a = __builtin_amdgcn_permlane32_swap(__float_as_uint(v1), __float_as_uint(v1), false, false); ov[0] = __uint_as_float(hi ? a[0] : a[1]); }
    { auto a = __builtin_amdgcn_permlane32_swap(__float_as_uint(v2), __float_as_uint(v2), false, false); ov[1] = __uint_as_float(hi ? a[0] : a[1]); }
    { auto a = __builtin_amdgcn_permlane32_swap(__float_as_uint(v3), __float_as_uint(v3), false, false); ov[2] = __uint_as_float(hi ? a[0] : a[1]); }
    { auto a = __builtin_amdgcn_permlane32_swap((unsigned)i1, (unsigned)i1, false, false); oi[0] = (int)(hi ? a[0] : a[1]); }
    { auto a = __builtin_amdgcn_permlane32_swap((unsigned)i2, (unsigned)i2, false, false); oi[1] = (int)(hi ? a[0] : a[1]); }
    { auto a = __builtin_amdgcn_permlane32_swap((unsigned)i3, (unsigned)i3, false, false); oi[2] = (int)(hi ? a[0] : a[1]); }
#pragma unroll
    for (int k = 0; k < 3; ++k) { const float s_ = ov[k]; const int n = oi[k];
        if (s_ > v1 || (s_ == v1 && n < i1)) { v3 = v2; i3 = i2; v2 = v1; i2 = i1; v1 = s_; i1 = n; }
        else if (s_ > v2 || (s_ == v2 && n < i2)) { v3 = v2; i3 = i2; v2 = s_; i2 = n; }
        else if (s_ > v3 || (s_ == v3 && n < i3)) { v3 = s_; i3 = n; } }
    if (hi == 0) {
        const int j1 = v1 > NEGS ? i1 : 255, j2 = v2 > NEGS ? i2 : 255, j3 = v3 > NEGS ? i3 : 255;
        int l1 = 0, l2 = 0, l3 = 0;
        if (j1 < 32) { l1 = atomicAdd(&hist[j1], 1); IL[j1 * 256 + l1] = (unsigned char)qi; }
        if (j2 < 32) { l2 = atomicAdd(&hist[j2], 1); IL[j2 * 256 + l2] = (unsigned char)qi; }
        if (j3 < 32) { l3 = atomicAdd(&hist[j3], 1); IL[j3 * 256 + l3] = (unsigned char)qi; }
        SEL3[tt * 8 + h] = (unsigned)j1 | ((unsigned)j2 << 8) | ((unsigned)j3 << 16);
        LRK[tt * 8 + h] = (unsigned)l1 | ((unsigned)l2 << 8) | ((unsigned)l3 << 16);
    }
    AT_WAITL(); bar();
    if (tid < 32) BCm[tid] = hist[tid];
    AT_WAITL(); bar();
}
__device__ __forceinline__ void moba_tables(const int* BCmbh, int lane, int& tot, int& seg) {
    int s = 0;
    if (lane < 32) { for (int q = 0; q < 32; ++q) s += BCmbh[q * 32 + lane]; }
    tot = s;
    int pad = (s + 31) & ~31, inc = pad;
#pragma unroll
    for (int sft = 1; sft < 32; sft <<= 1) { const int o_ = __shfl_up(inc, sft); if ((lane & 31) >= sft) inc += o_; }
    seg = inc - pad;
}
__device__ __forceinline__ void moba_gather_unit(const Params& p, int bh, int j, int ch, int segj, bool reload, unsigned char* lds_raw) {
    const int tid = otid(), lane = tid & 63, r32 = lane & 31, hi = lane >> 5, wid = __builtin_amdgcn_readfirstlane(tid >> 6);
    lp lds = (lp)lds_raw;
    const int b = bh >> 3, h = bh & 7;
    const bf16_t* ZB = (const bf16_t*)(p.ws + WS_ZB);
    const int* BCmbh = (const int*)(p.ws + WS_BCM) + (size_t)bh * 32 * 32;
    float* wsf = (float*)(lds_raw + L_WSF) + wid * 64;
    const lp sK0 = lds + L_K, sV0 = lds + L_V;
    const bf16_t* KM_ = ZB + (size_t)b * S * ZBW + ZB_MK + h * 64; const bf16_t* VM_ = ZB + (size_t)b * S * ZBW + ZB_MV + h * 64;
    if (reload) {
#pragma unroll
        for (int k = 3; k >= 0; --k) { dma_k(sK0 + k * 8192, KM_, ZBW, j * 256 + 64 * k, wid, lane); dma_v(sV0 + k * 8192, VM_, ZBW, j * 256 + 64 * k, wid, lane); }
    }
    const int gr = 256 * ch + 32 * wid + r32;
    const int cq = lane < 32 ? BCmbh[lane * 32 + j] : 0;
    int run = 0, qbs = j + 1, lr = 0;
#pragma unroll 4
    for (int q = 0; q < 32; ++q) { const int c_ = __builtin_amdgcn_readlane(cq, q); if (gr >= run && gr < run + c_) { qbs = q; lr = gr - run; } run += c_; }
    const int totj = run;
    const bool valid = gr < totj;
    const unsigned char* IL = (const unsigned char*)(p.ws + WS_ILIST);
    const int qidx = valid ? (int)IL[((size_t)(bh * 32 + qbs) * 32 + j) * 256 + lr] : 0;
    const int t = valid ? qbs * 256 + qidx : (j + 1) * 256; const size_t tt = (size_t)b * S + t;
    const float c2 = exp2f(-(float)(h + 1)) * LOG2E;
    bf16x8 qr[4];
#pragma unroll
    for (int d0 = 0; d0 < 4; ++d0) qr[d0] = *(const bf16x8*)(ZB + tt * ZBW + ZB_MQ + h * 64 + d0 * 16 + hi * 8);
    Soft sm; sm.m = 0.f; sm.l = 0.f; f32x16 o[2]; o[0] = f32x16{}; o[1] = f32x16{};
#pragma unroll 1
    for (int i = 0; i < 4; ++i) {
        if (reload) { const int newer = 3 - i; if (newer >= 3) AT_WAITV(6); else AT_WAIT_NEWER(newer, 2); AT_WAITL(); bar(); }
        const int kt = 3 - i;
        const lp sK = sK0 + kt * 8192, sV = sV0 + kt * 8192;
        const float x0 = c2 * (float)(64 * kt) - sm.m;
        f32x16 p0 = cinit(c2, hi, x0), p1 = cinit(c2, hi, x0 + c2 * 32.f);
        qk_tile(p0, p1, sK, qr, r32, hi);
        VFrag vf; pv_load(vf, sV, lane, hi);
        softmax_step<true>(p0, p1, sm, o, wsf, r32, hi);
        { AT_PACK(p0, p1); pv_mfma(o, vf, pw0, pw1, pw2, pw3); }
    }
    {
        const float lt = halfsum(sm.l);
        float* PM = (float*)(p.ws + WS_PM) + (size_t)bh * MB_CAP; float* PL = (float*)(p.ws + WS_PL) + (size_t)bh * MB_CAP;
        if (hi == 0 && valid) { PM[segj + gr] = sm.m; PL[segj + gr] = lt; }
        bf16_t* stg = (bf16_t*)(lds_raw + L_OST) + wid * 4096;
#pragma unroll
        for (int r = 0; r < 16; ++r) { const int orow = crow(r, hi); stg[orow * 64 + r32] = (bf16_t)f2bf(o[0][r]); stg[orow * 64 + 32 + r32] = (bf16_t)f2bf(o[1][r]); }
        wsync();
        bf16_t* PO = (bf16_t*)(p.ws + WS_PO) + ((size_t)bh * MB_CAP + segj + 256 * ch + 32 * wid) * 64;
        const int nrow = totj - (256 * ch + 32 * wid);
#pragma unroll
        for (int i = 0; i < 4; ++i) { const int row = i * 8 + (lane >> 3), c8 = lane & 7; if (row < nrow) *(uint4*)(PO + (size_t)row * 64 + c8 * 8) = *(const uint4*)(stg + row * 64 + c8 * 8); }
        wsync();
    }
    AT_WAITL(); bar();
}
__device__ __forceinline__ void moba_self_unit(const Params& p, int b, int h, int qb, unsigned char* lds_raw) {
    const int tid = otid(), lane = tid & 63, r32 = lane & 31, hi = lane >> 5, wid = __builtin_amdgcn_readfirstlane(tid >> 6);
    lp lds = (lp)lds_raw;
    const int bh = b * 8 + h;
    const bf16_t* ZB = (const bf16_t*)(p.ws + WS_ZB);
    const int* BCmbh = (const int*)(p.ws + WS_BCM) + (size_t)bh * 32 * 32;
    const int qi = 32 * wid + r32, t = qb * 256 + qi; const size_t tt = (size_t)b * S + t;
    float* wsf = (float*)(lds_raw + L_WSF) + wid * 64;
    float* ostage = (float*)(lds_raw + L_OST) + wid * 2048;
    const float c2 = exp2f(-(float)(h + 1)) * LOG2E;
    bf16x8 qr[4];
#pragma unroll
    for (int d0 = 0; d0 < 4; ++d0) qr[d0] = *(const bf16x8*)(ZB + tt * ZBW + ZB_MQ + h * 64 + d0 * 16 + hi * 8);
    const lp sK0 = lds + L_K, sV0 = lds + L_V;
    const bf16_t* KM_ = ZB + (size_t)b * S * ZBW + ZB_MK + h * 64; const bf16_t* VM_ = ZB + (size_t)b * S * ZBW + ZB_MV + h * 64;
    Soft sm; sm.m = 0.f; sm.l = 0.f; f32x16 o[2]; o[0] = f32x16{}; o[1] = f32x16{};
#pragma unroll
    for (int k = 0; k < 3; ++k) { dma_k(sK0 + k * 8192, KM_, ZBW, qb * 256 + 64 * (3 - k), wid, lane); dma_v(sV0 + k * 8192, VM_, ZBW, qb * 256 + 64 * (3 - k), wid, lane); }
    int tot, seg; moba_tables(BCmbh, lane, tot, seg);
    int before = 0; if (lane < 32) { for (int q = 0; q < qb; ++q) before += BCmbh[q * 32 + lane]; }
    const int base = seg + before;
#pragma unroll 1
    for (int i = 0; i < 4; ++i) {
        const int newer = 3 - i; AT_WAIT_NEWER(newer, 2);
        AT_WAITL(); bar();
        if (i == 0) { dma_k(sK0 + 3 * 8192, KM_, ZBW, qb * 256, wid, lane); dma_v(sV0 + 3 * 8192, VM_, ZBW, qb * 256, wid, lane); }
        const lp sK = sK0 + i * 8192, sV = sV0 + i * 8192;
        const int kt = 3 - i;
        const bool skip = (32 * wid + 31 < 64 * kt);
        if (!skip) {
            const float x0 = c2 * (float)(64 * kt) - sm.m;
            f32x16 p0 = cinit(c2, hi, x0), p1 = cinit(c2, hi, x0 + c2 * 32.f);
            qk_tile(p0, p1, sK, qr, r32, hi);
            if (64 * kt + 63 > 32 * wid) mask_tile(p0, p1, 0, qi - 64 * kt, hi);
            VFrag vf; pv_load(vf, sV, lane, hi);
            softmax_step<true>(p0, p1, sm, o, wsf, r32, hi);
            { AT_PACK(p0, p1); pv_mfma(o, vf, pw0, pw1, pw2, pw3); }
        }
    }
    {
        const float lself = halfsum(sm.l);
        const unsigned s3 = ((const unsigned*)(p.ws + WS_SEL3))[tt * 8 + h], l3 = ((const unsigned*)(p.ws + WS_LRK))[tt * 8 + h];
        const float* PM = (const float*)(p.ws + WS_PM) + (size_t)bh * MB_CAP; const float* PL = (const float*)(p.ws + WS_PL) + (size_t)bh * MB_CAP;
        float mk[3], lk[3]; int pidx[3];
        float M = sm.m + c2 * 256.f * (float)qb;
        const float mself = M;
#pragma unroll
        for (int k = 0; k < 3; ++k) { const int jk = (s3 >> (8 * k)) & 255, lrk = (l3 >> (8 * k)) & 255;
            const int pb = __shfl(base, jk & 31);
            if (jk < 32) { pidx[k] = pb + lrk; mk[k] = PM[pidx[k]] + c2 * 256.f * (float)jk; lk[k] = PL[pidx[k]]; M = __builtin_fmaxf(M, mk[k]); }
            else { pidx[k] = -1; mk[k] = NEGS; lk[k] = 0.f; } }
        const float ws_ = __builtin_amdgcn_exp2f(mself - M);
        float wk[3]; float Lt = lself * ws_;
#pragma unroll
        for (int k = 0; k < 3; ++k) { wk[k] = pidx[k] >= 0 ? __builtin_amdgcn_exp2f(mk[k] - M) : 0.f; Lt += lk[k] * wk[k]; }
        const float inv = Lt > 0.f ? 1.f / Lt : 0.f;
        float* rws = wsf;
        float* rwk = (float*)(lds_raw + L_KMT) + wid * 256;
        int* rpi = (int*)(rwk + 96);
        if (hi == 0) { rws[r32] = ws_ * inv;
#pragma unroll
            for (int k = 0; k < 3; ++k) { rwk[k * 32 + r32] = wk[k] * inv; rpi[k * 32 + r32] = pidx[k]; } }
#pragma unroll
        for (int r = 0; r < 16; ++r) { const int orow = crow(r, hi); ostage[orow * 64 + r32] = o[0][r]; ostage[orow * 64 + 32 + r32] = o[1][r]; }
        wsync();
        const bf16_t* PO = (const bf16_t*)(p.ws + WS_PO) + (size_t)bh * MB_CAP * 64;
        bf16_t* AB = (bf16_t*)(p.ws + WS_ATTB);
#pragma unroll
        for (int i = 0; i < 4; ++i) { const int row = i * 8 + (lane >> 3), c8 = lane & 7;
            const float4 a = *(const float4*)(ostage + row * 64 + c8 * 8), c4 = *(const float4*)(ostage + row * 64 + c8 * 8 + 4);
            const float w0 = rws[row];
            float acc8[8] = {a.x * w0, a.y * w0, a.z * w0, a.w * w0, c4.x * w0, c4.y * w0, c4.z * w0, c4.w * w0};
#pragma unroll
            for (int k = 0; k < 3; ++k) { const int pi = rpi[k * 32 + row]; if (pi >= 0) { const float w = rwk[k * 32 + row]; const uint4 q = *(const uint4*)(PO + (size_t)pi * 64 + c8 * 8);
                const unsigned qq_[4] = {q.x, q.y, q.z, q.w};
#pragma unroll
                for (int e = 0; e < 4; ++e) { acc8[2 * e] += __builtin_bit_cast(float, qq_[e] << 16) * w; acc8[2 * e + 1] += __builtin_bit_cast(float, qq_[e] & 0xffff0000u) * w; } } }
            *(uint4*)(AB + ((size_t)b * S + qb * 256 + 32 * wid + row) * D + 512 + h * 64 + c8 * 8) = make_uint4(pk2(acc8[0], acc8[1]), pk2(acc8[2], acc8[3]), pk2(acc8[4], acc8[5]), pk2(acc8[6], acc8[7])); }
        wsync();
    }
    AT_WAITL(); bar();
}
}

__device__ __forceinline__ void phase_att1(const Params& p, unsigned char* lds_raw) {
    const int tid = otid();
    int* pre = (int*)(lds_raw + at::L_END);
    int* segt = pre + 514;
    { const int* BCm = (const int*)(p.ws + WS_BCM); const int bh = tid >> 5, j = tid & 31; int s = 0;
      for (int q = 0; q < 32; ++q) s += BCm[(size_t)(bh * 32 + q) * 32 + j];
      pre[tid + 1] = (s + 255) >> 8; if (tid == 0) pre[0] = 0;
      segt[tid] = (s + 31) & ~31; }
    __syncthreads();
    for (int sft = 1; sft < 512; sft <<= 1) { int v = 0, w = 0; if (tid >= sft) v = pre[tid + 1 - sft]; if ((tid & 31) >= sft) w = segt[tid - sft]; __syncthreads(); pre[tid + 1] += v; if (sft < 32) segt[tid] += w; __syncthreads(); }
    { const int* BCm = (const int*)(p.ws + WS_BCM); const int bh = tid >> 5, j = tid & 31; int s = 0;
      for (int q = 0; q < 32; ++q) s += BCm[(size_t)(bh * 32 + q) * 32 + j];
      const int excl = segt[tid] - ((s + 31) & ~31); __syncthreads(); segt[tid] = excl; }
    __syncthreads();
    const int nun = pre[512];
    for (int pi = blockIdx.x; pi < 512; pi += gridDim.x) {
        const int rnd = pi >> 8, id = pi & 255;
        const int bg = 2 * rnd + (id >> 7), c = rnd ? 127 - (id & 127) : (id & 127); at::nsa_unit(p, bg >> 1, bg & 1, c, lds_raw);
    }
    {
        const int u0 = (int)(((long)blockIdx.x * nun) / gridDim.x), u1 = (int)(((long)(blockIdx.x + 1) * nun) / gridDim.x);
        int prev = -1;
        for (int u = u0; u < u1; ++u) {
            int lo = 0, hi_ = 511;
            while (lo < hi_) { const int mid = (lo + hi_ + 1) >> 1; if (pre[mid] <= u) lo = mid; else hi_ = mid - 1; }
            at::moba_gather_unit(p, lo >> 5, lo & 31, u - pre[lo], segt[lo], lo != prev, lds_raw);
            prev = lo;
        }
    }
}
__device__ __forceinline__ void phase_att2(const Params& p, unsigned char* lds_raw) {
    for (int pi = blockIdx.x; pi < 512; pi += gridDim.x) {
        const int rnd = pi >> 8, id = pi & 255;
        const int bh = 8 * rnd + (id >> 5), qb = rnd ? 31 - (id & 31) : (id & 31); at::moba_self_unit(p, bh >> 3, bh & 7, qb, lds_raw);
    }
}
__device__ __forceinline__ void phase_route(const Params& p, unsigned char* lds_raw) {
    for (int pi = blockIdx.x; pi < 512; pi += gridDim.x) at::moba_route_unit(p, pi >> 8, (pi >> 5) & 7, pi & 31, lds_raw);
}


__device__ __forceinline__ void phase_r2_fast(const Params& p, int l, unsigned char* lds_raw) {
    using namespace at;
    const int tid = otid(), lane = tid & 63, wave = __builtin_amdgcn_readfirstlane(tid >> 6), r32 = lane & 31, hi = lane >> 5;
    const float* mod = (const float*)(p.ws + WS_MOD);
    const bf16_t* XAB = (const bf16_t*)(p.ws + WS_XAB); bf16_t* XN = (bf16_t*)(p.ws + WS_XN); bf16_t* XL = (bf16_t*)(p.ws + WS_XNLO);
    const float* lng = p.in[5] + (size_t)l * D; const float* rw = p.in[15] + (size_t)l * D * NE; const float* rb = p.in[16] + l * NE;
    int* toke = (int*)(p.ws + WS_TOKE); float* tokw = (float*)(p.ws + WS_TOKW); int* BC = (int*)(p.ws + WS_BC);
    lp lds = (lp)lds_raw;
    int* hist = (int*)(lds_raw + 131072);
    for (int blk = blockIdx.x; blk < T / 64; blk += gridDim.x) {
        for (int idx = tid; idx < 128 * 32; idx += NT) {
            const int kc = idx >> 5, e = idx & 31; float v[8];
#pragma unroll
            for (int j = 0; j < 8; ++j) v[j] = rw[(size_t)(8 * kc + j) * NE + e];
            unsigned hh[8], ll[8];
#pragma unroll
            for (int j = 0; j < 8; ++j) { hh[j] = f2bf(v[j]); ll[j] = f2bf(v[j] - __builtin_bit_cast(float, hh[j] << 16)); }
            *(uint4*)(lds_raw + (size_t)idx * 16) = make_uint4(hh[0] | (hh[1] << 16), hh[2] | (hh[3] << 16), hh[4] | (hh[5] << 16), hh[6] | (hh[7] << 16));
            *(uint4*)(lds_raw + 65536 + (size_t)idx * 16) = make_uint4(ll[0] | (ll[1] << 16), ll[2] | (ll[3] << 16), ll[4] | (ll[5] << 16), ll[6] | (ll[7] << 16));
        }
        if (tid < 32) hist[tid] = 0;
        {
            const int b = (blk * 64) / S;
            const float* sh = mod + ((size_t)l * Bn + b) * 6144 + 3 * D; const float* sc = mod + ((size_t)l * Bn + b) * 6144 + 4 * D;
            float4 ga[4], s0v[4];
#pragma unroll
            for (int j = 0; j < 4; ++j) { const int col = 4 * lane + 256 * j; const float4 g = *(const float4*)(lng + col), s1 = *(const float4*)(sc + col); s0v[j] = *(const float4*)(sh + col);
                ga[j] = make_float4(g.x * (1.f + s1.x), g.y * (1.f + s1.y), g.z * (1.f + s1.z), g.w * (1.f + s1.w)); }
#pragma unroll 1
            for (int i0 = 0; i0 < 8; i0 += 4) {
                uint2 q_[4][4];
#pragma unroll
                for (int i = 0; i < 4; ++i)
#pragma unroll
                    for (int j = 0; j < 4; ++j) q_[i][j] = *(const uint2*)(XAB + (size_t)(blk * 64 + wave * 8 + i0 + i) * D + 4 * lane + 256 * j);
                float ss[4];
#pragma unroll
                for (int i = 0; i < 4; ++i) { float s_ = 0.f;
#pragma unroll
                    for (int j = 0; j < 4; ++j) { const float x0 = __builtin_bit_cast(float, q_[i][j].x << 16), x1 = __builtin_bit_cast(float, q_[i][j].x & 0xffff0000u), x2 = __builtin_bit_cast(float, q_[i][j].y << 16), x3 = __builtin_bit_cast(float, q_[i][j].y & 0xffff0000u);
                        s_ += (x0 * x0 + x1 * x1) + (x2 * x2 + x3 * x3); }
                    ss[i] = s_; }
#pragma unroll
                for (int sft = 32; sft >= 1; sft >>= 1) {
#pragma unroll
                    for (int i = 0; i < 4; ++i) ss[i] += __shfl_xor(ss[i], sft); }
#pragma unroll
                for (int i = 0; i < 4; ++i) {
                    const int t = blk * 64 + wave * 8 + i0 + i;
                    const float r = rsqrtf(ss[i] * (1.f / D) + EPS);
#pragma unroll
                    for (int j = 0; j < 4; ++j) {
                        const int col = 4 * lane + 256 * j;
                        const float x0 = __builtin_bit_cast(float, q_[i][j].x << 16), x1 = __builtin_bit_cast(float, q_[i][j].x & 0xffff0000u), x2 = __builtin_bit_cast(float, q_[i][j].y << 16), x3 = __builtin_bit_cast(float, q_[i][j].y & 0xffff0000u);
                        const float o[4] = {x0 * r * ga[j].x + s0v[j].x, x1 * r * ga[j].y + s0v[j].y, x2 * r * ga[j].z + s0v[j].z, x3 * r * ga[j].w + s0v[j].w};
                        unsigned hh[4], ll[4];
#pragma unroll
                        for (int q = 0; q < 4; ++q) { hh[q] = f2bf(o[q]); ll[q] = f2bf(o[q] - __builtin_bit_cast(float, hh[q] << 16)); }
                        *(uint2*)(XN + (size_t)t * D + col) = make_uint2(hh[0] | (hh[1] << 16), hh[2] | (hh[3] << 16));
                        *(uint2*)(XL + (size_t)t * D + col) = make_uint2(ll[0] | (ll[1] << 16), ll[2] | (ll[3] << 16));
                        *(unsigned*)(p.ws + WS_XN8 + (size_t)t * D + col) = pk_fp8x4(o[0] * XS8, o[1] * XS8, o[2] * XS8, o[3] * XS8);
                    }
                }
            }
        }
        asm volatile("s_waitcnt vmcnt(0)" ::: "memory");
        __syncthreads();
        f32x16 acc = f32x16{};
        {
            const int rh = wave & 1, kq = wave >> 1;
            const int t = blk * 64 + rh * 32 + r32;
            const bf16_t* xh = XN + (size_t)t * D + 8 * hi + 256 * kq; const bf16_t* xl = XL + (size_t)t * D + 8 * hi + 256 * kq;
            const AT_LAS unsigned char* wh = lds + (size_t)(hi * 32 + r32) * 16 + (size_t)kq * 16 * 1024; const AT_LAS unsigned char* wl = wh + 65536;
#pragma unroll 8
            for (int ks = 0; ks < 16; ++ks) {
                const bf16x8 bh = *(const bf16x8*)(xh + 16 * ks), bl = *(const bf16x8*)(xl + 16 * ks);
                const bf16x8 ah = *(const AT_LAS bf16x8*)(wh + ks * 1024), al = *(const AT_LAS bf16x8*)(wl + ks * 1024);
                acc = __builtin_amdgcn_mfma_f32_32x32x16_bf16(ah, bh, acc, 0, 0, 0);
                acc = __builtin_amdgcn_mfma_f32_32x32x16_bf16(al, bh, acc, 0, 0, 0);
                acc = __builtin_amdgcn_mfma_f32_32x32x16_bf16(ah, bl, acc, 0, 0, 0);
            }
        }
        __syncthreads();
        { float* part = (float*)lds_raw;
          if (wave >= 2) {
#pragma unroll
              for (int r = 0; r < 16; ++r) part[(wave * 16 + r) * 64 + lane] = acc[r]; } }
        __syncthreads();
        if (wave < 2) {
            const int t = blk * 64 + wave * 32 + r32;
            { const float* part = (const float*)lds_raw;
#pragma unroll
              for (int r = 0; r < 16; ++r) acc[r] = ((acc[r] + part[((wave + 2) * 16 + r) * 64 + lane]) + part[((wave + 4) * 16 + r) * 64 + lane]) + part[((wave + 6) * 16 + r) * 64 + lane]; }
            float a0 = -3e38f, a1 = -3e38f, a2 = -3e38f, a3 = -3e38f; int i0 = 99, i1 = 99, i2 = 99, i3 = 99;
#pragma unroll
            for (int r = 0; r < 16; ++r) { const int e = crow(r, hi); const float s_ = acc[r] + rb[e];
                if (s_ > a0) { a3 = a2; i3 = i2; a2 = a1; i2 = i1; a1 = a0; i1 = i0; a0 = s_; i0 = e; }
                else if (s_ > a1) { a3 = a2; i3 = i2; a2 = a1; i2 = i1; a1 = s_; i1 = e; }
                else if (s_ > a2) { a3 = a2; i3 = i2; a2 = s_; i2 = e; }
                else if (s_ > a3) { a3 = s_; i3 = e; } }
            float ov[4]; int oi[4];
            { const float sv[4] = {a0, a1, a2, a3}; const int si[4] = {i0, i1, i2, i3};
#pragma unroll
              for (int k = 0; k < 4; ++k) { auto a = __builtin_amdgcn_permlane32_swap(__float_as_uint(sv[k]), __float_as_uint(sv[k]), false, false); ov[k] = __uint_as_float(hi ? a[0] : a[1]);
                                            auto c = __builtin_amdgcn_permlane32_swap((unsigned)si[k], (unsigned)si[k], false, false); oi[k] = (int)(hi ? c[0] : c[1]); } }
#pragma unroll
            for (int k = 0; k < 4; ++k) { const float s_ = ov[k]; const int e = oi[k];
                if (s_ > a0 || (s_ == a0 && e < i0)) { a3 = a2; i3 = i2; a2 = a1; i2 = i1; a1 = a0; i1 = i0; a0 = s_; i0 = e; }
                else if (s_ > a1 || (s_ == a1 && e < i1)) { a3 = a2; i3 = i2; a2 = a1; i2 = i1; a1 = s_; i1 = e; }
                else if (s_ > a2 || (s_ == a2 && e < i2)) { a3 = a2; i3 = i2; a2 = s_; i2 = e; }
                else if (s_ > a3 || (s_ == a3 && e < i3)) { a3 = s_; i3 = e; } }
            const float e1 = __expf(a1 - a0), e2 = __expf(a2 - a0), e3 = __expf(a3 - a0), inv = 1.f / (((1.f + e1) + e2) + e3);
            if (hi == 0) {
                *(int4*)(toke + (size_t)t * 4) = make_int4(i0, i1, i2, i3);
                *(float4*)(tokw + (size_t)t * 4) = make_float4(inv, e1 * inv, e2 * inv, e3 * inv);
                atomicAdd(&hist[i0], 1); atomicAdd(&hist[i1], 1); atomicAdd(&hist[i2], 1); atomicAdd(&hist[i3], 1);
            }
        }
        __syncthreads();
        if (tid < 32) BC[blk * 32 + tid] = hist[tid];
        __syncthreads();
    }
}
__device__ __forceinline__ void phase_sc_fast(const Params& p, int l, unsigned char* lds_raw) {
    const int tid = otid();
    const int* BC = (const int*)(p.ws + WS_BC);
    int* cnt = (int*)(p.ws + WS_CNT) + l * 32;
    int* tot = (int*)lds_raw; int* base = tot + 32; int* fillc = tot + 64; int* before = tot + 96;
    const int* toke = (const int*)(p.ws + WS_TOKE); const float* tokw = (const float*)(p.ws + WS_TOKW);
    int* rowtok = (int*)(p.ws + WS_ROWTOK) + (size_t)l * RMAX; float* roww = (float*)(p.ws + WS_ROWW) + (size_t)l * RMAX; int* pos = (int*)(p.ws + WS_POS);
    for (int blk = blockIdx.x; blk < T / 64; blk += gridDim.x) {
        { const int e = tid & 31, part = tid >> 5; int s = 0, bf = 0;
#pragma unroll 4
          for (int i = part * 16; i < part * 16 + 16; ++i) { const int c = BC[i * 32 + e]; s += c; if (i < blk) bf += c; }
          int* ptot = tot + 128; int* pbef = ptot + 512;
          ptot[tid] = s; pbef[tid] = bf; }
        __syncthreads();
        if (tid < 32) { const int* ptot = tot + 128; const int* pbef = ptot + 512; int s = 0, bf = 0;
#pragma unroll
            for (int q = 0; q < 16; ++q) { s += ptot[q * 32 + tid]; bf += pbef[q * 32 + tid]; }
            tot[tid] = s; before[tid] = bf; fillc[tid] = 0; if (blk == 0) cnt[tid] = s; }
        __syncthreads();
        if (tid == 0) { int s = 0; for (int e = 0; e < 32; ++e) { base[e] = s + before[e]; s += (tot[e] + 255) & ~255; } }
        __syncthreads();
        if (tid < 256) {
            const int i = blk * 256 + tid, e = toke[i];
            const int slot = base[e] + atomicAdd(&fillc[e], 1);
            rowtok[slot] = i >> 2; roww[slot] = tokw[i]; pos[i] = slot;
        }
        __syncthreads();
    }
}

#define XB_TMO      128
#define XB_XCNT(j)  (256  + 64 * (j))
#define XB_XSUB(j)  (1280 + 64 * (j))
#define XB_XGEN(j)  (2304 + 64 * (j))
#define XB_TOP      3328
#define XB_TOPGEN   3392
#define XCD_BAR_WORDS 3456
#define XB_SPIN_CAP (1u << 18)
#define XLAS __attribute__((address_space(3)))
__device__ __forceinline__ unsigned xb_ld(unsigned* p)              { return __hip_atomic_load(p, __ATOMIC_RELAXED, __HIP_MEMORY_SCOPE_AGENT); }
__device__ __forceinline__ unsigned xb_add(unsigned* p, unsigned v) { return __hip_atomic_fetch_add(p, v, __ATOMIC_RELAXED, __HIP_MEMORY_SCOPE_AGENT); }
__device__ __forceinline__ unsigned xb_xcc_id() { return (unsigned)__builtin_amdgcn_s_getreg((3 << 11) | 20) & 0xFu; }
#define XB_SPIN(cond, bar) do { unsigned _sp = 0; while (cond) { __builtin_amdgcn_s_sleep(1); \
    if ((++_sp & 255u) == 0u) { if (xb_ld(&(bar)[XB_TMO])) break; if (_sp > XB_SPIN_CAP) { atomicAdd(&(bar)[XB_TMO], 1u); break; } } } } while (0)
constexpr int LDS_BARST_OFF = 147200;
struct XcdBarrier { unsigned* bar; unsigned x; volatile XLAS unsigned* st; };
__device__ __forceinline__ XcdBarrier xcd_barrier_post(unsigned* bar, volatile XLAS unsigned* st) {
    XcdBarrier b; b.bar = bar; b.x = xb_xcc_id(); b.st = st;
    if (threadIdx.x == 0) (void)xb_add(&bar[XB_XCNT(b.x)], 1u);
    return b;
}
__device__ __forceinline__ void xcd_barrier_complete(unsigned* bar, unsigned x, unsigned& nloc, unsigned& nx) {
    const unsigned G = gridDim.x * gridDim.y * gridDim.z;
    unsigned sum, cnt, mine, sp = 0u;
    for (;;) {
        sum = 0u; cnt = 0u; mine = 0u;
#pragma unroll
        for (unsigned j = 0; j < 16; ++j) { const unsigned c = xb_ld(&bar[XB_XCNT(j)]); sum += c; cnt += (c > 0u) ? 1u : 0u; mine = (j == x) ? c : mine; }
        if (sum == G) break;
        __builtin_amdgcn_s_sleep(1);
        if ((++sp & 255u) == 0u) { if (xb_ld(&bar[XB_TMO])) break; if (sp > XB_SPIN_CAP) { atomicAdd(&bar[XB_TMO], 1u); break; } }
    }
    nloc = mine > 0u ? mine : 1u; nx = cnt > 0u ? cnt : 1u;
}
__device__ __forceinline__ void xcd_barrier(unsigned char* ws, unsigned char* lds_raw_) {
    XcdBarrier b; b.bar = (unsigned*)(ws + WS_BAR); b.x = xb_xcc_id(); b.st = (volatile XLAS unsigned*)((XLAS unsigned char*)lds_raw_ + LDS_BARST_OFF);
    asm volatile("s_waitcnt vmcnt(0)" ::: "memory");
    __syncthreads();
    if (threadIdx.x == 0) {
        unsigned* bar = b.bar;
        __builtin_amdgcn_s_waitcnt(0);
        unsigned nloc = b.st[0], nx = b.st[1];
        if (nloc == 0u) { xcd_barrier_complete(bar, b.x, nloc, nx); b.st[0] = nloc; b.st[1] = nx; }
        const unsigned old = xb_add(&bar[XB_XSUB(b.x)], 1u);
        const unsigned gen = old / nloc;
        if (old + 1u == (gen + 1u) * nloc) {
            __builtin_amdgcn_fence(__ATOMIC_RELEASE, "agent");
            asm volatile("s_waitcnt vmcnt(0)" ::: "memory");
            const unsigned og = xb_add(&bar[XB_TOP], 1u);
            const unsigned tg = og / nx;
            if (og + 1u == (tg + 1u) * nx) xb_add(&bar[XB_TOPGEN], 1u);
            else XB_SPIN(xb_ld(&bar[XB_TOPGEN]) == tg, bar);
            __builtin_amdgcn_fence(__ATOMIC_ACQUIRE, "agent");
            xb_add(&bar[XB_XGEN(b.x)], 1u);
            asm volatile("s_waitcnt vmcnt(0)" ::: "memory");
        } else {
            XB_SPIN(xb_ld(&bar[XB_XGEN(b.x)]) == gen, bar);
            __builtin_amdgcn_fence(__ATOMIC_ACQUIRE, "agent");
            asm volatile("s_waitcnt vmcnt(0)" ::: "memory");
        }
    }
    __syncthreads();
}

__global__ void __launch_bounds__(NT, 2) mega_fwd(Params p) {
    extern __shared__ __attribute__((aligned(16))) unsigned char lds_raw[];
    float* lds = (float*)lds_raw;
    volatile XLAS unsigned* bst = (volatile XLAS unsigned*)((XLAS unsigned char*)lds_raw + LDS_BARST_OFF);
    if (threadIdx.x < 2) bst[threadIdx.x] = 0u;
    __syncthreads();
    (void)xcd_barrier_post((unsigned*)(p.ws + WS_BAR), bst);
#define GSYNC() xcd_barrier(p.ws, lds_raw)
    phase_p0a(p, lds);
    __syncthreads();
    phase_convert(p, lds);
    GSYNC();
    phase_p0b(p);
    GSYNC();
    _Pragma("unroll 1") for (int l = 0; l < L; ++l) {
        phase_r1(p, l, true);
        GSYNC();
        phase_g1_fast(p, l, lds_raw);
        GSYNC();
        phase_ck_fast(p, l, lds_raw);
        GSYNC();
        phase_c2(p, l, lds);
        __syncthreads();
        phase_route(p, lds_raw);
        GSYNC();
        phase_att1(p, lds_raw);
        GSYNC();
        phase_att2(p, lds_raw);
        GSYNC();
        phase_g2_fast(p, l, lds_raw);
        GSYNC();
        phase_r2_fast(p, l, lds_raw);
        GSYNC();
        phase_sc_fast(p, l, lds_raw);
        GSYNC();
        phase_m1_fast(p, l, lds_raw);
        GSYNC();
        phase_m2_fast(p, l, lds_raw);
        GSYNC();
    }
    phase_r1(p, L, false);
}

extern "C" void kernel_launch(void* const* d_in, const int* in_sizes, int n_in, void* d_out, int out_size, void* d_ws, size_t ws_size, hipStream_t stream) {
    static int grid_blocks = 0;
    if (grid_blocks == 0) {
        if (n_in != 21 || out_size != T * D || ws_size < WS_END) { fprintf(stderr, "kernel_launch: unexpected shapes (n_in %d out %d ws %zu need %zu)\n", n_in, out_size, ws_size, (size_t)WS_END); grid_blocks = -1; return; }
        int dev = 0, cus = 0, per_cu = 0;
        hipGetDevice(&dev);
        hipDeviceGetAttribute(&cus, hipDeviceAttributeMultiprocessorCount, dev);
        hipFuncSetAttribute((const void*)mega_fwd, hipFuncAttributeMaxDynamicSharedMemorySize, LDS_BYTES);
        hipOccupancyMaxActiveBlocksPerMultiprocessor(&per_cu, (const void*)mega_fwd, NT, LDS_BYTES);
        if (per_cu < 1) { fprintf(stderr, "kernel_launch: occupancy query says %d blocks per CU\n", per_cu); per_cu = 1; }
        (void)hipGetLastError();
        grid_blocks = cus * 1;
    }
    if (grid_blocks < 0) return;
    if (hipMemsetAsync((char*)d_ws + WS_BAR, 0, 16384, stream) != hipSuccess) { fprintf(stderr, "kernel_launch: memset failed\n"); return; }
    Params p{};
    for (int i = 0; i < 21; ++i) p.in[i] = (const float*)d_in[i];
    p.out = (float*)d_out; p.ws = (unsigned char*)d_ws;
    hipLaunchKernelGGL(mega_fwd, dim3(grid_blocks), dim3(NT), LDS_BYTES, stream, p);
    hipError_t e = hipPeekAtLastError();
    if (e != hipSuccess) fprintf(stderr, "launch failed: %s (grid %d)\n", hipGetErrorString(e), grid_blocks);
}
```

```cpp
#include <hip/hip_runtime.h>
#include <cstdio>
#include <cstdint>

constexpr int Bn = 2, S = 8192, D = 1024, L = 2, T = Bn * S;
constexpr int INW = 2840;
constexpr int NE = 32, TOPK = 4, DFF = 1024;
constexpr int A_TOT = T * TOPK;
constexpr int RMAX = A_TOT + NE * 256;
constexpr int NCMP = 511;
constexpr int NT = 512;
constexpr int NW = NT / 64;
constexpr int LDS_BYTES = 147456;
constexpr float EPS = 1e-6f;
constexpr float NEGF = -1e30f;

constexpr int ZBW = 3072;
constexpr int ZB_Q = 0, ZB_KC = 512, ZB_VC = 640, ZB_KS = 768, ZB_VS = 896, ZB_KW = 1024, ZB_VW = 1152, ZB_MQ = 1280, ZB_MK = 1792, ZB_MV = 2304, ZB_G = 2816;
constexpr float QSCALE = 0.125f * 1.4426950408889634f;
constexpr float LOG2E = 1.4426950408889634f;

constexpr size_t al256(size_t x) { return (x + 255) & ~(size_t)255; }
constexpr size_t WS_BAR = 0;
constexpr size_t WS_MODP = 16384;
constexpr size_t WS_MOD = al256(WS_MODP + (size_t)8 * L * Bn * 6144 * 4);
constexpr size_t WS_CNT = al256(WS_MOD + (size_t)L * Bn * 6144 * 4);
constexpr size_t WS_ROWTOK = al256(WS_CNT + L * 32 * 4);
constexpr size_t WS_ROWW = al256(WS_ROWTOK + (size_t)L * RMAX * 4);
constexpr size_t WS_TOKE = al256(WS_ROWW + (size_t)L * RMAX * 4);
constexpr size_t WS_TOKW = al256(WS_TOKE + (size_t)T * 4 * 4);
constexpr size_t WS_POS = al256(WS_TOKW + (size_t)T * 4 * 4);
constexpr size_t WS_Y = al256(WS_POS + (size_t)T * 4 * 4);
constexpr size_t WS_WINT = al256(WS_Y + (size_t)RMAX * 1024 * 4);
constexpr size_t WS_WOT = al256(WS_WINT + (size_t)L * 3072 * 1024 * 2);
constexpr size_t WS_W1T = al256(WS_WOT + (size_t)L * 1024 * 1024 * 2);
constexpr size_t WS_W2T = al256(WS_W1T + (size_t)L * NE * 2048 * 1024 * 2);
constexpr size_t WS_XN = al256(WS_W2T + (size_t)L * NE * 1024 * 1024 * 2);
constexpr size_t WS_ATTB = al256(WS_XN + (size_t)(T + 1) * D * 2);
constexpr size_t WS_ACT = al256(WS_ATTB + (size_t)T * D * 2);
constexpr size_t WS_ZB = al256(WS_ACT + (size_t)RMAX * DFF * 2);
constexpr size_t WS_GATE = al256(WS_ZB + (size_t)T * ZBW * 2);
constexpr size_t WS_KCB = al256(WS_GATE + (size_t)T * 32 * 4);
constexpr size_t WS_VCB = al256(WS_KCB + (size_t)Bn * 2 * 512 * 64 * 2);
constexpr size_t WS_KMB = al256(WS_VCB + (size_t)Bn * 2 * 512 * 64 * 2);
constexpr size_t WS_XNLO = al256(WS_KMB + (size_t)Bn * 8 * 32 * 64 * 2);
constexpr size_t WS_BC = al256(WS_XNLO + (size_t)T * D * 2);
constexpr size_t WS_WCT = al256(WS_BC + (size_t)(T / 64) * 32 * 4);
constexpr size_t WS_CBP = al256(WS_WCT + (size_t)L * 2 * 128 * 2048 * 2);
constexpr size_t WS_CB = al256(WS_CBP + (size_t)16 * L * 2 * 128 * 4);
constexpr size_t WS_HIDP = al256(WS_CB + (size_t)L * 2 * 128 * 4);
constexpr size_t WS_XAB = al256(WS_HIDP + (size_t)4 * 2 * 2044 * 128 * 4);
constexpr size_t WS_SEL3 = al256(WS_XAB + (size_t)T * D * 2);
constexpr size_t WS_LRK = al256(WS_SEL3 + (size_t)T * 8 * 4);
constexpr size_t WS_ILIST = al256(WS_LRK + (size_t)T * 8 * 4);
constexpr size_t WS_BCM = al256(WS_ILIST + (size_t)16 * 32 * 32 * 256);
constexpr size_t WS_PM = al256(WS_BCM + (size_t)16 * 32 * 32 * 4);
constexpr size_t WS_PL = al256(WS_PM + (size_t)16 * 25600 * 4);
constexpr size_t WS_PO = al256(WS_PL + (size_t)16 * 25600 * 4);
constexpr size_t WS_XN8 = al256(WS_PO + (size_t)16 * 25600 * 64 * 2);
constexpr size_t WS_DQ1 = al256(WS_XN8 + (size_t)(T + 1) * D);
constexpr size_t WS_DQ2 = al256(WS_DQ1 + (size_t)L * NE * 2048 * 4);
constexpr size_t WS_RWI = al256(WS_DQ2 + (size_t)L * NE * 1024 * 4);
constexpr size_t WS_END = al256(WS_RWI + (size_t)L * 131072);
constexpr float XS8 = 16.f, AS8 = 8.f;

struct Params {
    const float* in[21];
    float* out;
    unsigned char* ws;
};

__device__ __forceinline__ int otid() { int t = threadIdx.x; asm volatile("" : "+v"(t)); return t; }
typedef unsigned short bf16_t;
__device__ __forceinline__ unsigned f2bf(float f) { unsigned u = __builtin_bit_cast(unsigned, f); return (u + 0x7fffu + ((u >> 16) & 1u)) >> 16; }
__device__ __forceinline__ unsigned pk2(float lo, float hi) { return f2bf(lo) | (f2bf(hi) << 16); }
__device__ __forceinline__ unsigned pk_fp8x4(float a, float b, float c, float d) {
    a = __builtin_amdgcn_fmed3f(a, -448.f, 448.f); b = __builtin_amdgcn_fmed3f(b, -448.f, 448.f); c = __builtin_amdgcn_fmed3f(c, -448.f, 448.f); d = __builtin_amdgcn_fmed3f(d, -448.f, 448.f);
    int r = __builtin_amdgcn_cvt_pk_fp8_f32(a, b, 0, false);
    r = __builtin_amdgcn_cvt_pk_fp8_f32(c, d, r, true);
    return (unsigned)r; }
__device__ __forceinline__ float bf2f(bf16_t v) { return __builtin_bit_cast(float, (unsigned)v << 16); }
__device__ __forceinline__ float wave_sum(float v) {
#pragma unroll
    for (int o = 1; o < 64; o <<= 1) v += __shfl_xor(v, o);
    return v;
}
__device__ __forceinline__ float sigmoidf_(float x) { return 1.f / (1.f + __expf(-x)); }
__device__ __forceinline__ float gelu_tanh(float x) {
    const float u = 0.7978845608028654f * (x + 0.044715f * x * x * x);
    return 0.5f * x * (1.f + tanhf(u));
}

__device__ __forceinline__ void phase_p0a(const Params& p, float* lds) {
    const int tid = otid(), gtid = blockIdx.x * NT + tid, gsz = gridDim.x * NT;
    int* cnt = (int*)(p.ws + WS_CNT); int* rowtok = (int*)(p.ws + WS_ROWTOK);
    for (int i = gtid; i < L * 32; i += gsz) cnt[i] = 0;
    for (int i = gtid; i < L * RMAX; i += gsz) rowtok[i] = -1;
    const float* c = p.in[1];
    for (int i = tid; i < Bn * D; i += NT) { const float v = c[i]; lds[i] = v / (1.f + __expf(-v)); }
    __syncthreads();
    const float* ada_w = p.in[2];
    float* modp = (float*)(p.ws + WS_MODP);
    for (int idx = gtid; idx < 8 * L * 6144; idx += gsz) {
        const int col = idx % 6144, l = (idx / 6144) % L, kc = idx / (6144 * L);
        const float* w = ada_w + ((size_t)l * D + kc * 128) * 6144 + col;
        float a0 = 0.f, a1 = 0.f, c0 = 0.f, c1 = 0.f;
#pragma unroll 1
        for (int k0 = 0; k0 < 128; k0 += 32) { float wv[32];
#pragma unroll
            for (int k = 0; k < 32; ++k) wv[k] = __builtin_nontemporal_load(w + (size_t)(k0 + k) * 6144);
#pragma unroll
            for (int k = 0; k < 32; k += 2) { a0 += lds[kc * 128 + k0 + k] * wv[k]; a1 += lds[D + kc * 128 + k0 + k] * wv[k]; c0 += lds[kc * 128 + k0 + k + 1] * wv[k + 1]; c1 += lds[D + kc * 128 + k0 + k + 1] * wv[k + 1]; } }
        modp[((size_t)(kc * L + l) * Bn + 0) * 6144 + col] = a0 + c0;
        modp[((size_t)(kc * L + l) * Bn + 1) * 6144 + col] = a1 + c1;
    }
    { const float* posw = p.in[9]; const float* w1c = p.in[10]; float* cbp = (float*)(p.ws + WS_CBP);
      int first = 8 * L * 6144; if (first + 16 * L * 2 * 128 > gsz) first = 0;
      for (int idx = gtid - first; idx < 16 * L * 2 * 128; idx += gsz) { if (idx < 0) continue;
          const int j = idx & 127, li = (idx >> 7) % (L * 2), kc = idx / (L * 2 * 128);
          const float* w = w1c + ((size_t)li * 2048 + kc * 128) * 128 + j; const float* pp = posw + (size_t)li * 2048 + kc * 128;
          float a = 0.f, c_ = 0.f;
#pragma unroll 1
          for (int k0 = 0; k0 < 128; k0 += 32) { float wv[32];
#pragma unroll
              for (int k = 0; k < 32; ++k) wv[k] = w[(size_t)(k0 + k) * 128];
#pragma unroll
              for (int k = 0; k < 32; k += 2) { a += pp[k0 + k] * wv[k]; c_ += pp[k0 + k + 1] * wv[k + 1]; } }
          cbp[idx] = a + c_; } }
}
__device__ __forceinline__ void phase_p0b(const Params& p) {
    const int gtid = blockIdx.x * NT + otid(), gsz = gridDim.x * NT;
    { const float* cbp = (const float*)(p.ws + WS_CBP); float* cb = (float*)(p.ws + WS_CB);
      for (int idx = gtid; idx < L * 2 * 128; idx += gsz) { float s = 0.f;
#pragma unroll
          for (int kc = 0; kc < 16; ++kc) s += cbp[kc * (L * 2 * 128) + idx];
          cb[idx] = s; } }
    const float* modp = (const float*)(p.ws + WS_MODP); float* mod = (float*)(p.ws + WS_MOD); const float* ada_b = p.in[3];
    for (int idx = gtid; idx < L * Bn * 6144; idx += gsz) {
        const int col = idx % 6144, l = idx / (Bn * 6144);
        float s = ada_b[l * 6144 + col];
#pragma unroll
        for (int kc = 0; kc < 8; ++kc) s += modp[(size_t)kc * L * Bn * 6144 + idx];
        mod[idx] = s;
    }
}

__device__ __forceinline__ void phase_r1(const Params& p, int l, bool do_h) {
    const int lane = otid() & 63, wave = otid() >> 6;
    const int gw = blockIdx.x * NW + wave, ngw = gridDim.x * NW;
    const float* mod = (const float*)(p.ws + WS_MOD);
    const float* xin = p.in[0]; float* XA = p.out;
    const bf16_t* Y = (const bf16_t*)(p.ws + WS_Y); const int* pos = (const int*)(p.ws + WS_POS); const float* tokw = (const float*)(p.ws + WS_TOKW);
    const float* lng = p.in[4] + (size_t)(do_h ? l : 0) * D;
    bf16_t* XN = (bf16_t*)(p.ws + WS_XN); bf16_t* XAB = (bf16_t*)(p.ws + WS_XAB);
#define BF4(q) make_float4(__builtin_bit_cast(float, (q).x << 16), __builtin_bit_cast(float, (q).x & 0xffff0000u), __builtin_bit_cast(float, (q).y << 16), __builtin_bit_cast(float, (q).y & 0xffff0000u))
    int curb = -1; float4 g2v[4], ga[4], s0v[4];
    for (int t0 = gw; t0 < T; t0 += ngw) {
        const int nr = 1;
        float4 v[2][4];
        if (l == 0) {
#pragma unroll
            for (int i = 0; i < 2; ++i) if (i < nr) {
#pragma unroll
                for (int j = 0; j < 4; ++j) v[i][j] = *(const float4*)(xin + (size_t)(t0 + i * ngw) * D + 4 * lane + 256 * j); }
        } else {
            int4 ps[2]; float4 tw[2]; uint2 xq[2][4];
#pragma unroll
            for (int i = 0; i < 2; ++i) if (i < nr) { const int t = t0 + i * ngw; ps[i] = *(const int4*)(pos + (size_t)t * 4); tw[i] = *(const float4*)(tokw + (size_t)t * 4);
#pragma unroll
                for (int j = 0; j < 4; ++j) xq[i][j] = *(const uint2*)(XAB + (size_t)t * D + 4 * lane + 256 * j); }
            uint2 yq[2][4][4];
#pragma unroll
            for (int i = 0; i < 2; ++i) if (i < nr) {
#pragma unroll
                for (int j = 0; j < 4; ++j) { const int col = 4 * lane + 256 * j;
                    yq[i][j][0] = *(const uint2*)(Y + (size_t)ps[i].x * D + col); yq[i][j][1] = *(const uint2*)(Y + (size_t)ps[i].y * D + col);
                    yq[i][j][2] = *(const uint2*)(Y + (size_t)ps[i].z * D + col); yq[i][j][3] = *(const uint2*)(Y + (size_t)ps[i].w * D + col); } }
#pragma unroll
            for (int i = 0; i < 2; ++i) if (i < nr) {
                const int t = t0 + i * ngw, b = t / S;
                if (b != curb) { curb = b;
                    const float* g2 = mod + ((size_t)(l - 1) * Bn + b) * 6144 + 5 * D;
#pragma unroll
                    for (int j = 0; j < 4; ++j) g2v[j] = *(const float4*)(g2 + 4 * lane + 256 * j);
                    if (do_h) { const float* sh = mod + ((size_t)l * Bn + b) * 6144 + 0 * D; const float* sc = mod + ((size_t)l * Bn + b) * 6144 + 1 * D;
#pragma unroll
                        for (int j = 0; j < 4; ++j) { const int col = 4 * lane + 256 * j; const float4 g = *(const float4*)(lng + col), s1 = *(const float4*)(sc + col); s0v[j] = *(const float4*)(sh + col);
                            ga[j] = make_float4(g.x * (1.f + s1.x), g.y * (1.f + s1.y), g.z * (1.f + s1.z), g.w * (1.f + s1.w)); } } }
#pragma unroll
                for (int j = 0; j < 4; ++j) {
                    const int col = 4 * lane + 256 * j;
                    const float4 x = BF4(xq[i][j]);
                    const float4 y0 = BF4(yq[i][j][0]), y1 = BF4(yq[i][j][1]), y2 = BF4(yq[i][j][2]), y3 = BF4(yq[i][j][3]);
                    const float4 g = g2v[j];
                    float4 r;
                    r.x = x.x + g.x * (((tw[i].x * y0.x + tw[i].y * y1.x) + tw[i].z * y2.x) + tw[i].w * y3.x); r.y = x.y + g.y * (((tw[i].x * y0.y + tw[i].y * y1.y) + tw[i].z * y2.y) + tw[i].w * y3.y);
                    r.z = x.z + g.z * (((tw[i].x * y0.z + tw[i].y * y1.z) + tw[i].z * y2.z) + tw[i].w * y3.z); r.w = x.w + g.w * (((tw[i].x * y0.w + tw[i].y * y1.w) + tw[i].z * y2.w) + tw[i].w * y3.w);
                    v[i][j] = r;
                    if (do_h) *(uint2*)(XAB + (size_t)t * D + col) = make_uint2(pk2(r.x, r.y), pk2(r.z, r.w));
                    else *(float4*)(XA + (size_t)t * D + col) = r;
                }
            }
        }
        if (do_h) {
#pragma unroll
            for (int i = 0; i < 2; ++i) if (i < nr) {
                const int t = t0 + i * ngw, b = t / S;
                if (b != curb) { curb = b;
                    const float* sh = mod + ((size_t)l * Bn + b) * 6144 + 0 * D; const float* sc = mod + ((size_t)l * Bn + b) * 6144 + 1 * D;
#pragma unroll
                    for (int j = 0; j < 4; ++j) { const int col = 4 * lane + 256 * j; const float4 g = *(const float4*)(lng + col), s1 = *(const float4*)(sc + col); s0v[j] = *(const float4*)(sh + col);
                        ga[j] = make_float4(g.x * (1.f + s1.x), g.y * (1.f + s1.y), g.z * (1.f + s1.z), g.w * (1.f + s1.w)); } }
                float ss = 0.f;
#pragma unroll
                for (int j = 0; j < 4; ++j) ss += (v[i][j].x * v[i][j].x + v[i][j].y * v[i][j].y) + (v[i][j].z * v[i][j].z + v[i][j].w * v[i][j].w);
                ss = wave_sum(ss);
                const float r = rsqrtf(ss * (1.f / D) + EPS);
#pragma unroll
                for (int j = 0; j < 4; ++j) {
                    const int col = 4 * lane + 256 * j;
                    float4 o;
                    o.x = v[i][j].x * r * ga[j].x + s0v[j].x; o.y = v[i][j].y * r * ga[j].y + s0v[j].y;
                    o.z = v[i][j].z * r * ga[j].z + s0v[j].z; o.w = v[i][j].w * r * ga[j].w + s0v[j].w;
                    *(uint2*)(XN + (size_t)t * D + col) = make_uint2(pk2(o.x, o.y), pk2(o.z, o.w));
                }
            }
        }
    }
#undef BF4
}


__device__ __forceinline__ void phase_c2(const Params& p, int l, float* lds) {
    const int lane = otid() & 63, wave = otid() >> 6;
    const float* HIDP = (const float*)(p.ws + WS_HIDP); const float* cb = (const float*)(p.ws + WS_CB) + l * 2 * 128; const float* w2 = p.in[11] + (size_t)l * 2 * 128 * 64;
    const float gk = p.in[8][l * 64 + lane];
    float* hl = lds + wave * 128;
    for (int r = blockIdx.x * NW + wave; r < 2 * 2044; r += gridDim.x * NW) {
        const int idx = r / 2044, rr = r % 2044;
#pragma unroll
        for (int q = 0; q < 2; ++q) { const int j = lane + 64 * q; float s = cb[idx * 128 + j];
#pragma unroll
            for (int kq = 0; kq < 4; ++kq) s += HIDP[((size_t)(kq * 2 + idx) * 2044 + rr) * 128 + j];
            hl[j] = gelu_tanh(s); }
        asm volatile("s_waitcnt lgkmcnt(0)" ::: "memory"); __builtin_amdgcn_wave_barrier();
        const float* W = w2 + (size_t)idx * 128 * 64;
        float s = 0.f;
#pragma unroll 8
        for (int j = 0; j < 128; ++j) s += hl[j] * W[j * 64 + lane];
        asm volatile("s_waitcnt lgkmcnt(0)" ::: "memory"); __builtin_amdgcn_wave_barrier();
        const int bgi = rr / 511, n = rr % 511;
        if (idx == 0) { const float ss = wave_sum(s * s); const float kv = s * rsqrtf(ss * (1.f / 64.f) + EPS) * gk; ((bf16_t*)(p.ws + WS_KCB))[((size_t)bgi * 512 + n) * 64 + lane] = (bf16_t)f2bf(kv); }
        else { ((bf16_t*)(p.ws + WS_VCB))[((size_t)bgi * 512 + n) * 64 + lane] = (bf16_t)f2bf(s); }
    }
    if (blockIdx.x == 0 && otid() < 2 * 4 * 64) { const int i = otid(); bf16_t* dst = (bf16_t*)(p.ws + (i < 256 ? WS_KCB : WS_VCB)); dst[((size_t)((i & 255) >> 6) * 512 + 511) * 64 + (i & 63)] = 0; }
}

__device__ __forceinline__ void load_pstart(const Params& p, int l, int* ps) {
    const int* cnt = (const int*)(p.ws + WS_CNT) + l * 32;
    if (otid() == 0) { int s = 0; for (int e = 0; e < 32; ++e) { ps[e] = s; s += (cnt[e] + 255) & ~255; } ps[32] = s; }
    __syncthreads();
}


template <int MAP>
__device__ __forceinline__ void tr_tile(const float* W, int Nsrc, bf16_t* WT, int K, int k0, int n0, float* scr, int lane) {
    const int nl = (lane & 15) * 4, kr = lane >> 4;
    int sc = n0 + nl;
    if (MAP == 1) { sc = sc < 1280 ? sc : (sc < 2816 ? sc + 24 : (sc < 2840 ? sc - 2816 + 1280 : -1)); }
    float4 v[16];
#pragma unroll
    for (int it = 0; it < 16; ++it) { if (sc >= 0) { const float* src_ = W + (size_t)(k0 + it * 4 + kr) * Nsrc + sc; typedef float f4v __attribute__((ext_vector_type(4))); const f4v t_ = __builtin_nontemporal_load((const f4v*)src_); v[it] = make_float4(t_[0], t_[1], t_[2], t_[3]); } else v[it] = make_float4(0.f, 0.f, 0.f, 0.f); }
#pragma unroll
    for (int it = 0; it < 16; ++it) { float* s = scr + (it * 4 + kr) * 65 + nl; s[0] = v[it].x; s[1] = v[it].y; s[2] = v[it].z; s[3] = v[it].w; }
    asm volatile("s_waitcnt lgkmcnt(0)" ::: "memory"); __builtin_amdgcn_wave_barrier();
    const int c = lane & 7, nr = lane >> 3;
#pragma unroll
    for (int it = 0; it < 8; ++it) {
        const int n = it * 8 + nr; const float* s = scr + (8 * c) * 65 + n;
        uint4 o; o.x = pk2(s[0], s[65]); o.y = pk2(s[2 * 65], s[3 * 65]); o.z = pk2(s[4 * 65], s[5 * 65]); o.w = pk2(s[6 * 65], s[7 * 65]);
        *(uint4*)(WT + (size_t)(n0 + n) * K + k0 + 8 * c) = o;
    }
    asm volatile("s_waitcnt lgkmcnt(0)" ::: "memory"); __builtin_amdgcn_wave_barrier();
}
__device__ __forceinline__ void phase_convert(const Params& p, float* lds) {
    const int tid = otid(), lane = tid & 63, wave = tid >> 6;
    float* scr = lds + wave * (64 * 65);
    const int gw = blockIdx.x * NW + wave, ngw = gridDim.x * NW;
    bf16_t* WinT = (bf16_t*)(p.ws + WS_WINT); bf16_t* WoT = (bf16_t*)(p.ws + WS_WOT);
    constexpr int I_IN = L * 16 * (ZBW / 64), I_O = L * 16 * 16, I_C = L * 2 * 32 * 2;
    { float* cm = lds + NW * (64 * 65);
      constexpr int S1 = L * NE * 32, S2 = L * NE * 16;
      for (int s = blockIdx.x; s < S1 + S2; s += gridDim.x) {
          const bool is1 = s < S1; const int q = is1 ? s : s - S1;
          const int le = is1 ? (q >> 5) : (q >> 4), nb = is1 ? (q & 31) : (q & 15), Nsrc = is1 ? 2048 : 1024;
          const float* W = (is1 ? p.in[17] : p.in[19]) + (size_t)le * 1024 * Nsrc;
          unsigned char* WT8 = p.ws + (is1 ? WS_W1T : WS_W2T) + (size_t)le * Nsrc * 1024;
          float* DQ = (float*)(p.ws + (is1 ? WS_DQ1 : WS_DQ2)) + (size_t)le * Nsrc;
          const int n0 = nb * 64, nl = (lane & 15) * 4, kr = lane >> 4, k0 = wave * 128;
          typedef float f4v __attribute__((ext_vector_type(4)));
          f4v va[16], vb[16];
#pragma unroll
          for (int it = 0; it < 16; ++it) { va[it] = __builtin_nontemporal_load((const f4v*)(W + (size_t)(k0 + it * 4 + kr) * Nsrc + n0 + nl));
                                            vb[it] = __builtin_nontemporal_load((const f4v*)(W + (size_t)(k0 + 64 + it * 4 + kr) * Nsrc + n0 + nl)); }
          float m[4] = {0.f, 0.f, 0.f, 0.f};
#pragma unroll
          for (int it = 0; it < 16; ++it)
#pragma unroll
              for (int j = 0; j < 4; ++j) m[j] = __builtin_fmaxf(m[j], __builtin_fmaxf(__builtin_fabsf(va[it][j]), __builtin_fabsf(vb[it][j])));
#pragma unroll
          for (int j = 0; j < 4; ++j) { m[j] = __builtin_fmaxf(m[j], __shfl_xor(m[j], 16)); m[j] = __builtin_fmaxf(m[j], __shfl_xor(m[j], 32)); }
          if (kr == 0) {
#pragma unroll
              for (int j = 0; j < 4; ++j) cm[wave * 64 + nl + j] = m[j]; }
          __syncthreads();
          float sc[4];
#pragma unroll
          for (int j = 0; j < 4; ++j) { float a = cm[nl + j];
#pragma unroll
              for (int w = 1; w < NW; ++w) a = __builtin_fmaxf(a, cm[w * 64 + nl + j]);
              sc[j] = a > 0.f ? 448.f / a : 0.f;
              if (wave == 0 && kr == 0) DQ[n0 + nl + j] = a * (1.f / 448.f); }
#pragma unroll
          for (int half = 0; half < 2; ++half) {
#pragma unroll
              for (int it = 0; it < 16; ++it) { const f4v v = half ? vb[it] : va[it]; float* d = scr + (it * 4 + kr) * 65 + nl; d[0] = v[0] * sc[0]; d[1] = v[1] * sc[1]; d[2] = v[2] * sc[2]; d[3] = v[3] * sc[3]; }
              asm volatile("s_waitcnt lgkmcnt(0)" ::: "memory"); __builtin_amdgcn_wave_barrier();
              const int c = lane & 7, nr = lane >> 3;
#pragma unroll
              for (int it = 0; it < 8; ++it) { const int n = it * 8 + nr; const float* sp = scr + (8 * c) * 65 + n;
                  uint2 o; o.x = pk_fp8x4(sp[0], sp[65], sp[2 * 65], sp[3 * 65]); o.y = pk_fp8x4(sp[4 * 65], sp[5 * 65], sp[6 * 65], sp[7 * 65]);
                  *(uint2*)(WT8 + (size_t)(n0 + n) * 1024 + k0 + half * 64 + 8 * c) = o; }
              asm volatile("s_waitcnt lgkmcnt(0)" ::: "memory"); __builtin_amdgcn_wave_barrier();
          }
          __syncthreads();
      } }
    for (int it = gw; it < I_C + I_IN + I_O; it += ngw) {
        int r = it;
        if (r < I_C) { const int li = r / 64, q = r % 64, kb = q / 2, nb = q % 2;
            tr_tile<0>(p.in[10] + (size_t)li * 2048 * 128, 128, (bf16_t*)(p.ws + WS_WCT) + (size_t)li * 128 * 2048, 2048, kb * 64, nb * 64, scr, lane); continue; }
        r -= I_C;
        if (r < I_IN) { const int l = r / (16 * 48), q = r % (16 * 48), kb = q / 48, nb = q % 48;
            tr_tile<1>(p.in[6] + (size_t)l * D * INW, INW, WinT + (size_t)l * ZBW * D, D, kb * 64, nb * 64, scr, lane); continue; }
        r -= I_IN;
        { const int l = r / 256, q = r % 256, kb = q / 16, nb = q % 16;
            tr_tile<0>(p.in[14] + (size_t)l * D * D, D, WoT + (size_t)l * D * D, D, kb * 64, nb * 64, scr, lane); }
    }
    for (int idx = blockIdx.x * NT + tid; idx < L * 128 * 32; idx += gridDim.x * NT) {
        const int l = idx >> 12, kc = (idx >> 5) & 127, e = idx & 31; const float* rw = p.in[15] + (size_t)l * D * NE; float v[8];
#pragma unroll
        for (int j = 0; j < 8; ++j) v[j] = rw[(size_t)(8 * kc + j) * NE + e];
        unsigned hh[8], ll[8];
#pragma unroll
        for (int j = 0; j < 8; ++j) { hh[j] = f2bf(v[j]); ll[j] = f2bf(v[j] - __builtin_bit_cast(float, hh[j] << 16)); }
        unsigned char* img = p.ws + WS_RWI + (size_t)l * 131072;
        *(uint4*)(img + (size_t)(idx & 4095) * 16) = make_uint4(hh[0] | (hh[1] << 16), hh[2] | (hh[3] << 16), hh[4] | (hh[5] << 16), hh[6] | (hh[7] << 16));
        *(uint4*)(img + 65536 + (size_t)(idx & 4095) * 16) = make_uint4(ll[0] | (ll[1] << 16), ll[2] | (ll[3] << 16), ll[4] | (ll[5] << 16), ll[6] | (ll[7] << 16));
    }
    if (blockIdx.x == 0) { bf16_t* XN = (bf16_t*)(p.ws + WS_XN); for (int i = tid; i < D / 2; i += NT) ((unsigned*)(XN + (size_t)T * D))[i] = 0u;
                           for (int i = tid; i < D / 4; i += NT) ((unsigned*)(p.ws + WS_XN8 + (size_t)T * D))[i] = 0u; }
}

namespace pg8 {
#define PG8_LAS __attribute__((address_space(3)))
typedef short bf16x8 __attribute__((ext_vector_type(8)));
typedef float f32x4 __attribute__((ext_vector_type(4)));
typedef unsigned u32x4 __attribute__((ext_vector_type(4)));
typedef long l64x2 __attribute__((ext_vector_type(2)));
typedef int i32x4 __attribute__((ext_vector_type(4)));
typedef int i32x8 __attribute__((ext_vector_type(8)));
constexpr int BM = 256, BK = 64, HALF = 128, HTB = HALF * BK * 2, STAGE_BYTES = 8 * HTB, NXCD = 8, WGM = 8;
__device__ __forceinline__ int lds_byte(int r, int c) { const int st = (r >> 4) * 2 + (c >> 5), rr = r & 15, cc = c & 31, ob = rr * 64 + cc * 2; return st * 1024 + (ob ^ (((ob >> 9) & 1) << 5)); }
__device__ __forceinline__ void stage_rc(int b, int& R, int& C) { const int st = b / 1024, sb = b % 1024, swz = sb ^ (((sb >> 9) & 1) << 5); R = (st >> 1) * 16 + swz / 64; C = (st & 1) * 32 + (swz % 64) / 2; }
__device__ __forceinline__ int perm32(int rho) { const int n = rho >> 4, i = rho & 15; return 8 * (i >> 2) + 4 * n + (i & 3); }
struct Unit { int pm, pn, e; };
__device__ __forceinline__ unsigned cvt_pk_bf16(float lo, float hi) { unsigned r; asm volatile("v_cvt_pk_bf16_f32 %0, %1, %2" : "=v"(r) : "v"(lo), "v"(hi)); return r; }

__device__ __forceinline__ bool static_next(int nM, int nN, int G, int c, int i, Unit& u) {
    const int nwg = nM * nN; const long Lq = (long)i * G + c; if (Lq >= nwg) return false;
    int wgid = (int)Lq; { const int q = nwg / NXCD, r = nwg % NXCD, xcd = wgid % NXCD, off = wgid / NXCD; wgid = (xcd < r ? xcd * (q + 1) : r * (q + 1) + (xcd - r) * q) + off; }
    const int nig = WGM * nN, gid = wgid / nig, fm = gid * WGM, gsz = (nM - fm) < WGM ? (nM - fm) : WGM;
    u.pm = fm + ((wgid % nig) % gsz); u.pn = (wgid % nig) / gsz; u.e = 0; return true;
}

template <class Prob, class Epi, bool ALIGN_EPI, bool SP2>
__device__ __forceinline__ void gemm_phase(PG8_LAS unsigned char* lds, const Prob& P, const Epi& E) {
    const int tid = otid(), wid = __builtin_amdgcn_readfirstlane(tid >> 6), lane = tid & 63, wr = wid >> 2, wc = wid & 3, fr = lane & 15, fq = lane >> 4;
    const int K = P.K, nt = Prob::KT > 0 ? Prob::KT : K / BK;
    int sR[2], sC[2]; unsigned voffB[2];
#pragma unroll
    for (int i = 0; i < 2; ++i) { stage_rc(tid * 16 + i * 8192, sR[i], sC[i]); voffB[i] = (unsigned)(P.b_row(sR[i]) * K + sC[i]) * 2u; }
    const size_t kstep = (size_t)(BK * 2);
    const size_t kstepA = P.a_kstep();
    const size_t hstepB = P.b_hstep();
    const unsigned ldsw = (unsigned)wid * 1024u;
    const int aoff = lds_byte(wr * 64 + fr, fq * 8), boff = lds_byte(wc * 32 + fr, fq * 8);
#define PG8_SA(b, h) (((b) * 2 + (h)) * HTB)
#define PG8_SB(b, h) ((4 + (b) * 2 + (h)) * HTB)
#define PG8_STAGE(bufoff, gbase, voff) do { _Pragma("unroll") for (int _i = 0; _i < 2; ++_i) { unsigned _vo = (voff)[_i]; asm volatile("" : "+v"(_vo));        \
        __builtin_amdgcn_global_load_lds((const unsigned*)((const char*)(gbase) + _vo), (PG8_LAS unsigned*)(lds + (bufoff) + ldsw + _i * 8192), 16, 0, 0); } } while (0)
#define PG8_STAGE_SEL(bufoff, gbase, h) do { _Pragma("unroll") for (int _i = 0; _i < 2; ++_i) { unsigned _vo = vAc[h][_i]; if constexpr (Prob::GATHER) { const unsigned _vn = van[(h) * 2 + _i]; _vo = last ? _vn : _vo; } asm volatile("" : "+v"(_vo)); \
        __builtin_amdgcn_global_load_lds((const unsigned*)((const char*)(gbase) + _vo), (PG8_LAS unsigned*)(lds + (bufoff) + ldsw + _i * 8192), 16, 0, 0); } } while (0)
#define PG8_LDA(dst, b, h) do { if constexpr (Prob::F8) { _Pragma("unroll") for (int m = 0; m < 2; ++m) { \
            const i32x4 lo_ = *(const PG8_LAS i32x4*)(lds + PG8_SA(b, h) + aoff + m * 2048), hi_ = *(const PG8_LAS i32x4*)(lds + PG8_SA(b, h) + aoff + m * 2048 + 1024); \
            dst##8[m] = __builtin_shufflevector(lo_, hi_, 0, 1, 2, 3, 4, 5, 6, 7); } } \
        else { _Pragma("unroll") for (int m = 0; m < 4; ++m) _Pragma("unroll") for (int k = 0; k < 2; ++k) dst[m][k] = *(const PG8_LAS bf16x8*)(lds + PG8_SA(b, h) + aoff + m * 2048 + k * 1024); } } while (0)
#define PG8_LDB(dst, b, h) do { if constexpr (Prob::F8) { _Pragma("unroll") for (int n = 0; n < 2; ++n) { \
            const i32x4 lo_ = *(const PG8_LAS i32x4*)(lds + PG8_SB(b, h) + boff + n * 2048), hi_ = *(const PG8_LAS i32x4*)(lds + PG8_SB(b, h) + boff + n * 2048 + 1024); \
            dst##8[n] = __builtin_shufflevector(lo_, hi_, 0, 1, 2, 3, 4, 5, 6, 7); } } \
        else { _Pragma("unroll") for (int n = 0; n < 2; ++n) _Pragma("unroll") for (int k = 0; k < 2; ++k) dst[n][k] = *(const PG8_LAS bf16x8*)(lds + PG8_SB(b, h) + boff + n * 2048 + k * 1024); } } while (0)
#define PG8_MMA(ai, bj, At, Bt) do { __builtin_amdgcn_s_setprio(1); _Pragma("unroll") for (int m = 0; m < 4; ++m) _Pragma("unroll") for (int n = 0; n < 2; ++n) { \
        if constexpr (Prob::F8)          \
            acc[ai][bj][m][n] = __builtin_amdgcn_mfma_scale_f32_16x16x128_f8f6f4(Bt##8[n], At##8[m], acc[ai][bj][m][n], 0, 0, 0, 0x7f7f7f7f, 0, 0x7f7f7f7f); \
        else { _Pragma("unroll") for (int k = 0; k < 2; ++k) acc[ai][bj][m][n] = __builtin_amdgcn_mfma_f32_16x16x32_bf16(Bt[n][k], At[m][k], acc[ai][bj][m][n], 0, 0, 0); } } __builtin_amdgcn_s_setprio(0); } while (0)
#define PG8_MMA2(ai, At, B0, B1, b, h) do { if constexpr (Prob::F8) { __builtin_amdgcn_s_setprio(1); \
        _Pragma("unroll") for (int m = 0; m < 2; ++m) _Pragma("unroll") for (int n = 0; n < 2; ++n) { \
            acc[ai][0][m][n] = __builtin_amdgcn_mfma_scale_f32_16x16x128_f8f6f4(B0##8[n], At##8[m], acc[ai][0][m][n], 0, 0, 0, 0x7f7f7f7f, 0, 0x7f7f7f7f); \
            acc[ai][1][m][n] = __builtin_amdgcn_mfma_scale_f32_16x16x128_f8f6f4(B1##8[n], At##8[m], acc[ai][1][m][n], 0, 0, 0, 0x7f7f7f7f, 0, 0x7f7f7f7f); } \
        _Pragma("unroll") for (int m = 0; m < 2; ++m) { \
            const i32x4 lo_ = *(const PG8_LAS i32x4*)(lds + PG8_SA(b, h) + aoff + (m + 2) * 2048), hi_ = *(const PG8_LAS i32x4*)(lds + PG8_SA(b, h) + aoff + (m + 2) * 2048 + 1024); \
            At##8[m] = __builtin_shufflevector(lo_, hi_, 0, 1, 2, 3, 4, 5, 6, 7); } \
        _Pragma("unroll") for (int m = 0; m < 2; ++m) _Pragma("unroll") for (int n = 0; n < 2; ++n) { \
            acc[ai][0][m + 2][n] = __builtin_amdgcn_mfma_scale_f32_16x16x128_f8f6f4(B0##8[n], At##8[m], acc[ai][0][m + 2][n], 0, 0, 0, 0x7f7f7f7f, 0, 0x7f7f7f7f); \
            acc[ai][1][m + 2][n] = __builtin_amdgcn_mfma_scale_f32_16x16x128_f8f6f4(B1##8[n], At##8[m], acc[ai][1][m + 2][n], 0, 0, 0, 0x7f7f7f7f, 0, 0x7f7f7f7f); } \
        __builtin_amdgcn_s_setprio(0); } else { PG8_MMA(ai, 0, At, B0); PG8_MMA(ai, 1, At, B1); } } while (0)
#define PG8_WAIT_V(n) asm volatile("s_waitcnt vmcnt(" #n ")" ::: "memory")
#define PG8_WAIT_L(n) asm volatile("s_waitcnt lgkmcnt(" #n ")" ::: "memory")
#define PG8_BAR __builtin_amdgcn_s_barrier()
#define PG8_SCHED __builtin_amdgcn_sched_barrier(0)
    Unit cur, nxt; int ui = 0;
    if (!P.next(0, cur)) return;
    nxt = cur;
    f32x4 acc[2][2][4][2];
    typename Epi::Pre pre;
    E.prefetch(cur, wc, fq, pre); E.init(acc, pre);
    bf16x8 At[4][2], B0[2][2], B1[2][2];
    i32x8 At8[2], B08[2], B18[2];
    unsigned vAc[2][2];
    PG8_LAS unsigned* van = (PG8_LAS unsigned*)(lds + 131072 + 1024) + tid * 4;
    const char* cA = P.a_base(cur); const char* cB = P.b_base(cur);
    P.a_voff(cur, sR, sC, vAc);
    if constexpr (Prob::GATHER) { van[0] = vAc[0][0]; van[1] = vAc[0][1]; van[2] = vAc[1][0]; van[3] = vAc[1][1]; }
    if constexpr (SP2) {
        PG8_STAGE(PG8_SB(0, 0), cB, voffB); PG8_STAGE(PG8_SB(0, 1), cB + hstepB, voffB); PG8_STAGE(PG8_SA(0, 0), cA, vAc[0]); PG8_STAGE(PG8_SA(0, 1), cA, vAc[1]);
        if (wr == 1) PG8_BAR;
        PG8_WAIT_V(2); PG8_BAR;
        PG8_STAGE(PG8_SB(1, 0), cB + kstep, voffB); PG8_STAGE(PG8_SA(1, 0), cA + kstepA, vAc[0]); PG8_STAGE(PG8_SB(1, 1), cB + hstepB + kstep, voffB);
        PG8_WAIT_V(6); PG8_BAR;
    } else {
        PG8_STAGE(PG8_SB(0, 0), cB, voffB); PG8_STAGE(PG8_SA(0, 0), cA, vAc[0]); PG8_STAGE(PG8_SB(0, 1), cB + hstepB, voffB); PG8_STAGE(PG8_SA(0, 1), cA, vAc[1]);
        if (wr == 1) PG8_BAR;
        PG8_WAIT_V(4); PG8_BAR;
        PG8_STAGE(PG8_SB(1, 0), cB + kstep, voffB); PG8_STAGE(PG8_SA(1, 0), cA + kstepA, vAc[0]); PG8_STAGE(PG8_SB(1, 1), cB + hstepB + kstep, voffB);
        PG8_WAIT_V(6); PG8_BAR;
    }
    for (;;) {
        E.preload(cur, wc, fq, pre);
        const bool has_next = P.next(ui + 1, nxt);
        const char* nA = cA; const char* nB = cB;
        if (has_next) { nA = P.a_base(nxt); nB = P.b_base(nxt);
            if constexpr (Prob::GATHER) { int r2[2], c2[2]; const int t2 = otid();
#pragma unroll
                for (int i = 0; i < 2; ++i) stage_rc(t2 * 16 + i * 8192, r2[i], c2[i]);
                unsigned vn[2][2]; P.a_voff(nxt, r2, c2, vn); van[0] = vn[0][0]; van[1] = vn[0][1]; van[2] = vn[1][0]; van[3] = vn[1][1]; } }
        for (int t = 0; t < nt; t += 2) {
            const bool last = (t == nt - 2);
            const char* a1 = cA + (size_t)(t + 1) * kstepA;
            const char* a2 = last ? nA : cA + (size_t)(t + 2) * kstepA; const char* b2 = last ? nB : cB + (size_t)(t + 2) * kstep;
            const char* a3 = a2 + kstepA; const char* b3 = b2 + kstep;
            if constexpr (SP2) {
            PG8_LDB(B0, 0, 0); PG8_LDB(B1, 0, 1); PG8_SCHED; PG8_LDA(At, 0, 0); PG8_STAGE(PG8_SA(1, 1), a1, vAc[1]);
            PG8_WAIT_V(8); PG8_WAIT_L(0); PG8_BAR; PG8_MMA2(0, At, B0, B1, 0, 0); PG8_BAR; PG8_SCHED;
            PG8_LDA(At, 0, 1); PG8_STAGE(PG8_SB(0, 0), b2, voffB); PG8_STAGE(PG8_SB(0, 1), b2 + hstepB, voffB); PG8_STAGE_SEL(PG8_SA(0, 0), a2, 0);
            PG8_WAIT_V(8); PG8_WAIT_L(0); PG8_BAR; PG8_MMA2(1, At, B0, B1, 0, 1); PG8_BAR; PG8_SCHED;
            PG8_LDB(B0, 1, 0); PG8_LDB(B1, 1, 1); PG8_SCHED; PG8_LDA(At, 1, 0); PG8_STAGE_SEL(PG8_SA(0, 1), a2, 1);
            PG8_WAIT_V(8); PG8_WAIT_L(0); PG8_BAR; PG8_MMA2(0, At, B0, B1, 1, 0); PG8_BAR; PG8_SCHED;
            PG8_LDA(At, 1, 1); PG8_STAGE(PG8_SB(1, 0), b3, voffB); PG8_STAGE(PG8_SB(1, 1), b3 + hstepB, voffB); PG8_STAGE_SEL(PG8_SA(1, 0), a3, 0);
            PG8_WAIT_V(8); PG8_WAIT_L(0); PG8_BAR; PG8_MMA2(1, At, B0, B1, 1, 1); PG8_BAR; PG8_SCHED;
            } else {
            PG8_LDB(B0, 0, 0); PG8_SCHED; PG8_LDA(At, 0, 0); PG8_STAGE(PG8_SA(1, 1), a1, vAc[1]);
            PG8_WAIT_L(8); PG8_BAR; PG8_WAIT_L(0); PG8_MMA(0, 0, At, B0); PG8_BAR; PG8_SCHED;
            PG8_LDB(B1, 0, 1); PG8_STAGE(PG8_SB(0, 0), b2, voffB);
            PG8_BAR; PG8_WAIT_L(0); PG8_MMA(0, 1, At, B1); PG8_BAR;
            PG8_LDA(At, 0, 1); PG8_STAGE_SEL(PG8_SA(0, 0), a2, 0);
            PG8_BAR; PG8_WAIT_L(0); PG8_MMA(1, 0, At, B0); PG8_BAR; PG8_SCHED;
            PG8_STAGE(PG8_SB(0, 1), b2 + hstepB, voffB);
            PG8_WAIT_V(6); PG8_BAR; PG8_MMA(1, 1, At, B1); PG8_BAR;
            PG8_LDB(B0, 1, 0); PG8_SCHED; PG8_LDA(At, 1, 0); PG8_STAGE_SEL(PG8_SA(0, 1), a2, 1);
            PG8_WAIT_L(8); PG8_BAR; PG8_WAIT_L(0); PG8_MMA(0, 0, At, B0); PG8_BAR; PG8_SCHED;
            PG8_LDB(B1, 1, 1); PG8_STAGE(PG8_SB(1, 0), b3, voffB);
            PG8_BAR; PG8_WAIT_L(0); PG8_MMA(0, 1, At, B1); PG8_BAR;
            PG8_LDA(At, 1, 1); PG8_STAGE_SEL(PG8_SA(1, 0), a3, 0);
            PG8_BAR; PG8_WAIT_L(0); PG8_MMA(1, 0, At, B0); PG8_BAR; PG8_SCHED;
            PG8_STAGE(PG8_SB(1, 1), b3 + hstepB, voffB);
            PG8_WAIT_V(6); PG8_BAR; PG8_MMA(1, 1, At, B1); PG8_BAR;
            }
        }
        if constexpr (ALIGN_EPI) { if (wr == 0) PG8_BAR; }
        E(acc, cur, wr, wc, fr, fq, has_next, nxt, pre);
        if (!has_next) break;
        E.init(acc, pre);
        cur = nxt; cA = nA; cB = nB; ++ui;
        if constexpr (Prob::GATHER) {
#pragma unroll
            for (int h = 0; h < 2; ++h)
#pragma unroll
                for (int i = 0; i < 2; ++i) vAc[h][i] = van[h * 2 + i];
        }
        if constexpr (ALIGN_EPI) { if (wr == 1) PG8_BAR; }
    }
    PG8_WAIT_V(0);
    if constexpr (!ALIGN_EPI) { if (wr == 0) PG8_BAR; }
    PG8_BAR;
#undef PG8_SA
#undef PG8_SB
#undef PG8_STAGE
#undef PG8_STAGE_SEL
#undef PG8_LDA
#undef PG8_LDB
#undef PG8_MMA
#undef PG8_WAIT_V
#undef PG8_WAIT_L
#undef PG8_BAR
#undef PG8_SCHED
}

struct ProbDense { static constexpr bool F8 = false; static constexpr bool GATHER = false; static constexpr int KT = 0;
    const bf16_t* A; const bf16_t* Bt; int K, nM, nN, G, c; bool headperm;
    __device__ __forceinline__ bool next(int i, Unit& u) const { return static_next(nM, nN, G, c, i, u); }
    __device__ __forceinline__ const char* a_base(const Unit& u) const { return (const char*)(A + (size_t)u.pm * BM * K); }
    __device__ __forceinline__ void a_voff(const Unit&, const int (&R)[2], const int (&C)[2], unsigned (&v)[2][2]) const {
#pragma unroll
        for (int h = 0; h < 2; ++h)
#pragma unroll
            for (int i = 0; i < 2; ++i) v[h][i] = (unsigned)((h * HALF + R[i]) * K + C[i]) * 2u;
    }
    __device__ __forceinline__ const char* b_base(const Unit& u) const { return (const char*)(Bt + (size_t)u.pn * BM * K); }
    __device__ __forceinline__ size_t a_kstep() const { return (size_t)BK * 2; }
    __device__ __forceinline__ size_t b_hstep() const { return headperm ? (size_t)32 * K * 2 : (size_t)HALF * K * 2; }
    __device__ __forceinline__ int b_row(int R) const { return headperm ? ((R >> 5) * 64 + perm32(R & 31)) : ((R & ~31) + perm32(R & 31)); }
};
typedef const PG8_LAS int* lds_ints;
__device__ __forceinline__ int expert_of(lds_ints ps, int pm) { int e = 0;
#pragma unroll
    for (int i = 1; i < 32; ++i) if (ps[i] <= pm * 256) e = i;
    return __builtin_amdgcn_readfirstlane(e); }
struct ProbMoe1 { static constexpr bool F8 = true; static constexpr bool GATHER = true; static constexpr int KT = 0;
    const bf16_t* XN; const bf16_t* W1T; const int* rowtok; lds_ints ps; int K, ntm, G, c;
    __device__ __forceinline__ bool next(int i, Unit& u) const {
        if (G != 256) { const int q = i * G + c; if (q >= ntm * 8) return false; u.pm = q >> 3; u.pn = q & 7; u.e = expert_of(ps, u.pm); return true; }
        const int x = c & 7, s = c >> 3; const int pm = 4 * (i * 8 + x) + (s >> 3); if (pm >= ntm) return false;
        u.pm = pm; u.pn = s & 7; u.e = expert_of(ps, u.pm); return true; }
    __device__ __forceinline__ const char* a_base(const Unit&) const { return (const char*)XN; }
    __device__ __forceinline__ void a_voff(const Unit& u, const int (&R)[2], const int (&C)[2], unsigned (&v)[2][2]) const {
#pragma unroll
        for (int h = 0; h < 2; ++h)
#pragma unroll
            for (int i = 0; i < 2; ++i) { int tk = rowtok[u.pm * BM + h * HALF + R[i]]; if (tk < 0) tk = T; v[h][i] = (unsigned)(tk * K + C[i]) * 2u; }
    }
    __device__ __forceinline__ const char* b_base(const Unit& u) const { return (const char*)(W1T + ((size_t)u.e * 2048 + u.pn * 128) * K); }
    __device__ __forceinline__ size_t a_kstep() const { return (size_t)BK * 2; }
    __device__ __forceinline__ size_t b_hstep() const { return (size_t)1024 * K * 2; }
    __device__ __forceinline__ int b_row(int R) const { return (R & ~31) + perm32(R & 31); }
};
struct ProbMoe2 { static constexpr bool F8 = true; static constexpr bool GATHER = false; static constexpr int KT = 0;
    const bf16_t* ACT; const bf16_t* W2T; lds_ints ps; int K, ntm, G, c;
    __device__ __forceinline__ bool next(int i, Unit& u) const {
        if (G != 256) { const int q = i * G + c; if (q >= ntm * 4) return false; u.pm = q >> 2; u.pn = q & 3; u.e = expert_of(ps, u.pm); return true; }
        const int x = c & 7, s = c >> 3; const int pm = 8 * (i * 8 + x) + (s >> 2); if (pm >= ntm) return false;
        u.pm = pm; u.pn = s & 3; u.e = expert_of(ps, u.pm); return true; }
    __device__ __forceinline__ const char* a_base(const Unit& u) const { return (const char*)(ACT + (size_t)u.pm * BM * K); }
    __device__ __forceinline__ void a_voff(const Unit&, const int (&R)[2], const int (&C)[2], unsigned (&v)[2][2]) const {
#pragma unroll
        for (int h = 0; h < 2; ++h)
#pragma unroll
            for (int i = 0; i < 2; ++i) v[h][i] = (unsigned)((h * HALF + R[i]) * K + C[i]) * 2u;
    }
    __device__ __forceinline__ const char* b_base(const Unit& u) const { return (const char*)(W2T + ((size_t)u.e * 1024 + u.pn * BM) * K); }
    __device__ __forceinline__ size_t a_kstep() const { return (size_t)BK * 2; }
    __device__ __forceinline__ size_t b_hstep() const { return (size_t)HALF * K * 2; }
    __device__ __forceinline__ int b_row(int R) const { return (R & ~31) + perm32(R & 31); }
};

struct ProbCmp { static constexpr bool F8 = false; static constexpr bool GATHER = false; static constexpr int KT = 8;
    const bf16_t* ZB; const bf16_t* W1T; int K, G, c;
    __device__ __forceinline__ bool next(int i, Unit& u) const { const int q = i * G + c; if (q >= 64) return false; u.pm = q & 15; u.pn = 0; u.e = q >> 4; return true; }
    __device__ __forceinline__ const char* a_base(const Unit& u) const { const int idx = u.pm >> 3, bg = (u.pm >> 1) & 3, half = u.pm & 1;
        return (const char*)(ZB + ((size_t)(bg >> 1) * S + 16 * 256 * half + 8 * u.e) * ZBW + ZB_KC + idx * 128 + (bg & 1) * 64); }
    __device__ __forceinline__ void a_voff(const Unit&, const int (&R)[2], const int (&C)[2], unsigned (&v)[2][2]) const {
#pragma unroll
        for (int h = 0; h < 2; ++h)
#pragma unroll
            for (int i = 0; i < 2; ++i) v[h][i] = (unsigned)(16 * (h * HALF + R[i]) * ZBW + C[i]) * 2u;
    }
    __device__ __forceinline__ size_t a_kstep() const { return (size_t)ZBW * 2; }
    __device__ __forceinline__ const char* b_base(const Unit& u) const { return (const char*)(W1T + (size_t)(u.pm >> 3) * 128 * K + 8 * 64 * u.e); }
    __device__ __forceinline__ size_t b_hstep() const { return 0; }
    __device__ __forceinline__ int b_row(int R) const { return (R & ~31) + perm32(R & 31); }
};
struct EpiCmp {
    float* HIDP;
    struct Pre {};
    __device__ __forceinline__ void prefetch(const Unit&, int, int, Pre&) const {}
    __device__ __forceinline__ void preload(const Unit&, int, int, Pre&) const {}
    __device__ __forceinline__ void init(f32x4 (&acc)[2][2][4][2], const Pre&) const {
#pragma unroll
        for (int a = 0; a < 2; ++a)
#pragma unroll
            for (int b = 0; b < 2; ++b)
#pragma unroll
                for (int m = 0; m < 4; ++m)
#pragma unroll
                    for (int n = 0; n < 2; ++n) acc[a][b][m][n] = (f32x4){0.f, 0.f, 0.f, 0.f};
    }
    __device__ __forceinline__ void operator()(const f32x4 (&acc)[2][2][4][2], const Unit& u, int wr, int wc, int fr, int fq, bool has_next, const Unit& nxt, Pre& pre) const {
        const int idx = u.pm >> 3, bg = (u.pm >> 1) & 3, half = u.pm & 1;
        const int c0 = 32 * wc + 8 * fq;
#pragma unroll
        for (int ai = 0; ai < 2; ++ai)
#pragma unroll
            for (int m = 0; m < 4; ++m) { const int n = 256 * half + ai * HALF + wr * 64 + m * 16 + fr;
                if (n < 511) { float* dst = HIDP + (((size_t)u.e * 2 + idx) * 2044 + bg * 511 + n) * 128 + c0;
                    *(f32x4*)dst = acc[ai][0][m][0]; *(f32x4*)(dst + 4) = acc[ai][0][m][1]; } }
    }
};
struct EpiG1F {
    bf16_t* ZB; float* GATE; const float* gq; const float* gk; const float* gmq; const float* gmk;
    struct Pre {};
    __device__ __forceinline__ void prefetch(const Unit&, int, int, Pre&) const {}
    __device__ __forceinline__ void preload(const Unit&, int, int, Pre&) const {}
    __device__ __forceinline__ void init(f32x4 (&acc)[2][2][4][2], const Pre&) const {
#pragma unroll
        for (int a = 0; a < 2; ++a)
#pragma unroll
            for (int b = 0; b < 2; ++b)
#pragma unroll
                for (int m = 0; m < 4; ++m)
#pragma unroll
                    for (int n = 0; n < 2; ++n) acc[a][b][m][n] = (f32x4){0.f, 0.f, 0.f, 0.f};
    }
    __device__ __forceinline__ void operator()(const f32x4 (&acc)[2][2][4][2], const Unit& u, int wr, int wc, int fr, int fq, bool has_next, const Unit& nxt, Pre& pre) const {
        const int pn = u.pn;
        const float* gain = nullptr; float sc = 1.f;
        if (pn < 2) { gain = gq; sc = QSCALE; }
        else if (pn == 3 || pn == 4) { if (wc < 2) gain = gk; }
        else if (pn == 5 || pn == 6) { gain = gmq; sc = QSCALE; }
        else if (pn == 7 || pn == 8) { gain = gmk; }
        if (pn == 11) {
            if (wc == 0 && fq < 3) {
#pragma unroll
                for (int ai = 0; ai < 2; ++ai)
#pragma unroll
                    for (int m = 0; m < 4; ++m) { const size_t r = (size_t)u.pm * BM + ai * HALF + wr * 64 + m * 16 + fr;
#pragma unroll
                        for (int n = 0; n < 2; ++n) { const f32x4 v = acc[ai][0][m][n]; f32x4 o;
#pragma unroll
                            for (int i = 0; i < 4; ++i) o[i] = __builtin_amdgcn_rcpf(1.f + __builtin_amdgcn_exp2f(-LOG2E * v[i]));
                            *(f32x4*)(GATE + r * 32 + 8 * fq + 4 * n) = o; } }
            }
            return;
        }
        f32x4 gv[2][2];
#pragma unroll
        for (int bj = 0; bj < 2; ++bj)
#pragma unroll
            for (int n = 0; n < 2; ++n) gv[bj][n] = gain ? *(const f32x4*)(gain + 32 * bj + 8 * fq + 4 * n) * sc : (f32x4){1.f, 1.f, 1.f, 1.f};
#pragma unroll
        for (int ai = 0; ai < 2; ++ai)
#pragma unroll
            for (int m = 0; m < 4; ++m) { const size_t r = (size_t)u.pm * BM + ai * HALF + wr * 64 + m * 16 + fr;
                float rs = 1.f;
                if (gain) { float ss = 0.f;
#pragma unroll
                    for (int bj = 0; bj < 2; ++bj)
#pragma unroll
                        for (int n = 0; n < 2; ++n) { const f32x4 v = acc[ai][bj][m][n]; ss += (v[0] * v[0] + v[1] * v[1]) + (v[2] * v[2] + v[3] * v[3]); }
                    ss += __shfl_xor(ss, 16); ss += __shfl_xor(ss, 32);
                    rs = rsqrtf(ss * (1.f / 64.f) + EPS); }
#pragma unroll
                for (int bj = 0; bj < 2; ++bj) { const f32x4 a = acc[ai][bj][m][0] * gv[bj][0] * rs, b = acc[ai][bj][m][1] * gv[bj][1] * rs;
                    u32x4 w; w.x = cvt_pk_bf16(a[0], a[1]); w.y = cvt_pk_bf16(a[2], a[3]); w.z = cvt_pk_bf16(b[0], b[1]); w.w = cvt_pk_bf16(b[2], b[3]);
                    *(u32x4*)(ZB + r * ZBW + pn * BM + 64 * wc + 32 * bj + 8 * fq) = w; } }
    }
};
struct EpiG2 {
    const float* xin32; bf16_t* XAB; const float* g1;
    struct Pre {};
    __device__ __forceinline__ void prefetch(const Unit&, int, int, Pre&) const {}
    __device__ __forceinline__ void preload(const Unit&, int, int, Pre&) const {}
    __device__ __forceinline__ void init(f32x4 (&acc)[2][2][4][2], const Pre&) const {
#pragma unroll
        for (int a = 0; a < 2; ++a)
#pragma unroll
            for (int b = 0; b < 2; ++b)
#pragma unroll
                for (int m = 0; m < 4; ++m)
#pragma unroll
                    for (int n = 0; n < 2; ++n) acc[a][b][m][n] = (f32x4){0.f, 0.f, 0.f, 0.f};
    }
    __device__ __forceinline__ void operator()(const f32x4 (&acc)[2][2][4][2], const Unit& u, int wr, int wc, int fr, int fq, bool has_next, const Unit& nxt, Pre& pre) const {
#pragma unroll
        for (int ai = 0; ai < 2; ++ai)
#pragma unroll
            for (int m = 0; m < 4; ++m) { const size_t r = (size_t)u.pm * BM + ai * HALF + wr * 64 + m * 16 + fr; const int b = (int)(r / S);
#pragma unroll
                for (int bj = 0; bj < 2; ++bj) { const int c = u.pn * BM + 128 * bj + 32 * wc + 8 * fq;
                    f32x4 x0, x1;
                    if (xin32) { x0 = *(const f32x4*)(xin32 + r * D + c); x1 = *(const f32x4*)(xin32 + r * D + c + 4); }
                    else { const u32x4 q = *(const u32x4*)(XAB + r * D + c);
                        x0 = (f32x4){__builtin_bit_cast(float, q.x << 16), __builtin_bit_cast(float, q.x & 0xffff0000u), __builtin_bit_cast(float, q.y << 16), __builtin_bit_cast(float, q.y & 0xffff0000u)};
                        x1 = (f32x4){__builtin_bit_cast(float, q.z << 16), __builtin_bit_cast(float, q.z & 0xffff0000u), __builtin_bit_cast(float, q.w << 16), __builtin_bit_cast(float, q.w & 0xffff0000u)}; }
                    const f32x4 g0 = *(const f32x4*)(g1 + (size_t)b * 6144 + c), g1v = *(const f32x4*)(g1 + (size_t)b * 6144 + c + 4);
                    const f32x4 y0 = x0 + g0 * acc[ai][bj][m][0], y1 = x1 + g1v * acc[ai][bj][m][1];
                    u32x4 o; o.x = cvt_pk_bf16(y0[0], y0[1]); o.y = cvt_pk_bf16(y0[2], y0[3]); o.z = cvt_pk_bf16(y1[0], y1[1]); o.w = cvt_pk_bf16(y1[2], y1[3]);
                    *(u32x4*)(XAB + r * D + c) = o; } }
    }
};
struct EpiM1 {
    unsigned char* ACT8; const float* b1l; const float* dq1l;
    struct Pre { f32x4 bg, bl, sg, sl; };
    __device__ __forceinline__ void prefetch(const Unit&, int, int, Pre&) const {}
    __device__ __forceinline__ void preload(const Unit& u, int wc, int fq, Pre& q) const {
        const int c0 = u.pn * 128 + 32 * wc + 8 * fq; const float* b1 = b1l + (size_t)u.e * 2048 + c0; const float* dq = dq1l + (size_t)u.e * 2048 + c0;
        q.bg = *(const f32x4*)(b1); q.bl = *(const f32x4*)(b1 + 1024); q.sg = *(const f32x4*)(dq); q.sl = *(const f32x4*)(dq + 1024); }
    __device__ __forceinline__ void init(f32x4 (&acc)[2][2][4][2], const Pre&) const {
#pragma unroll
        for (int a = 0; a < 2; ++a)
#pragma unroll
            for (int b = 0; b < 2; ++b)
#pragma unroll
                for (int m = 0; m < 4; ++m)
#pragma unroll
                    for (int n = 0; n < 2; ++n) acc[a][b][m][n] = (f32x4){0.f, 0.f, 0.f, 0.f};
    }
    __device__ __forceinline__ void operator()(const f32x4 (&acc)[2][2][4][2], const Unit& u, int wr, int wc, int fr, int fq, bool has_next, const Unit& nxt, Pre& pre) const {
        { const int t_ = otid(); fr = t_ & 15; fq = (t_ >> 4) & 3; }
        const int c0 = u.pn * 128 + 32 * wc + 8 * fq;
        const float* b1 = b1l + (size_t)u.e * 2048 + c0; const float* dq = dq1l + (size_t)u.e * 2048 + c0;
        unsigned w[2][4][2];
        const f32x4 bg1 = *(const f32x4*)(b1 + 4), bl1 = *(const f32x4*)(b1 + 1024 + 4), sg1 = *(const f32x4*)(dq + 4), sl1 = *(const f32x4*)(dq + 1024 + 4);
#pragma unroll
        for (int n = 0; n < 2; ++n) {
            const f32x4 bg = n ? bg1 : pre.bg, bl = n ? bl1 : pre.bl;
            const f32x4 sg = (n ? sg1 : pre.sg) * (1.f / XS8), sl = (n ? sl1 : pre.sl) * (1.f / XS8);
#pragma unroll
            for (int ai = 0; ai < 2; ++ai)
#pragma unroll
                for (int m = 0; m < 4; ++m) { const f32x4 g = acc[ai][0][m][n] * sg + bg, li = acc[ai][1][m][n] * sl + bl; float o[4];
#pragma unroll
                    for (int i = 0; i < 4; ++i) { const float gc = fminf(g[i], 7.f), lc = __builtin_amdgcn_fmed3f(li[i], -7.f, 7.f);
                        o[i] = (AS8 * (lc + 1.f)) * (gc * __builtin_amdgcn_rcpf(1.f + __builtin_amdgcn_exp2f((-1.702f * LOG2E) * gc))); }
                    w[ai][m][n] = pk_fp8x4(o[0], o[1], o[2], o[3]); }
        }
#pragma unroll
        for (int ai = 0; ai < 2; ++ai)
#pragma unroll
            for (int m = 0; m < 4; ++m) { const size_t r = (size_t)u.pm * BM + ai * HALF + wr * 64 + m * 16 + fr;
                *(uint2*)(ACT8 + r * DFF + c0) = make_uint2(w[ai][m][0], w[ai][m][1]); }
    }
};
struct EpiM2 {
    bf16_t* Y; const float* b2l; const float* dq2l;
    struct Pre {};
    __device__ __forceinline__ void prefetch(const Unit&, int, int, Pre&) const {}
    __device__ __forceinline__ void preload(const Unit&, int, int, Pre&) const {}
    __device__ __forceinline__ void init(f32x4 (&acc)[2][2][4][2], const Pre&) const {
#pragma unroll
        for (int a = 0; a < 2; ++a)
#pragma unroll
            for (int b = 0; b < 2; ++b)
#pragma unroll
                for (int m = 0; m < 4; ++m)
#pragma unroll
                    for (int n = 0; n < 2; ++n) acc[a][b][m][n] = (f32x4){0.f, 0.f, 0.f, 0.f};
    }
    __device__ __forceinline__ void operator()(const f32x4 (&acc)[2][2][4][2], const Unit& u, int wr, int wc, int fr, int fq, bool has_next, const Unit& nxt, Pre& pre) const {
        { const int t_ = otid(); fr = t_ & 15; fq = (t_ >> 4) & 3; }
        const int cb = u.pn * BM + 32 * wc + 8 * fq;
        const float* b2 = b2l + (size_t)u.e * D + cb; const float* dq = dq2l + (size_t)u.e * D + cb;
#pragma unroll
        for (int bj = 0; bj < 2; ++bj) { const int c = cb + 128 * bj;
            const f32x4 b0 = *(const f32x4*)(b2 + 128 * bj), b1_ = *(const f32x4*)(b2 + 128 * bj + 4);
            const f32x4 s0 = *(const f32x4*)(dq + 128 * bj) * (1.f / AS8), s1 = *(const f32x4*)(dq + 128 * bj + 4) * (1.f / AS8);
#pragma unroll
            for (int ai = 0; ai < 2; ++ai)
#pragma unroll
                for (int m = 0; m < 4; ++m) { const size_t r = (size_t)u.pm * BM + ai * HALF + wr * 64 + m * 16 + fr;
                    const f32x4 v0 = acc[ai][bj][m][0] * s0 + b0, v1 = acc[ai][bj][m][1] * s1 + b1_;
                    u32x4 o; o.x = cvt_pk_bf16(v0[0], v0[1]); o.y = cvt_pk_bf16(v0[2], v0[3]); o.z = cvt_pk_bf16(v1[0], v1[1]); o.w = cvt_pk_bf16(v1[2], v1[3]);
                    *(u32x4*)(Y + r * D + c) = o; }
        }
    }
};
}

__device__ __forceinline__ void phase_g1_fast(const Params& p, int l, unsigned char* lds_raw) {
    pg8::ProbDense P{(const bf16_t*)(p.ws + WS_XN), (const bf16_t*)(p.ws + WS_WINT) + (size_t)l * ZBW * D, D, T / 256, ZBW / 256, (int)gridDim.x, (int)blockIdx.x, true};
    pg8::EpiG1F E{(bf16_t*)(p.ws + WS_ZB), (float*)(p.ws + WS_GATE), p.in[7] + l * 64, p.in[8] + l * 64, p.in[12] + l * 64, p.in[13] + l * 64};
    pg8::gemm_phase<pg8::ProbDense, pg8::EpiG1F, true, true>((PG8_LAS unsigned char*)lds_raw, P, E);
}
__device__ __forceinline__ void phase_g2_fast(const Params& p, int l, unsigned char* lds_raw) {
    pg8::ProbDense P{(const bf16_t*)(p.ws + WS_ATTB), (const bf16_t*)(p.ws + WS_WOT) + (size_t)l * D * D, D, T / 256, D / 256, (int)gridDim.x, (int)blockIdx.x, false};
    pg8::EpiG2 E{l == 0 ? p.in[0] : (const float*)nullptr, (bf16_t*)(p.ws + WS_XAB), (const float*)(p.ws + WS_MOD) + (size_t)l * Bn * 6144 + 2 * D};
    pg8::gemm_phase<pg8::ProbDense, pg8::EpiG2, true, true>((PG8_LAS unsigned char*)lds_raw, P, E);
}
constexpr int LDS_PS_OFF = 131072;
__device__ __forceinline__ void phase_ck_fast(const Params& p, int l, unsigned char* lds_raw) {
    pg8::ProbCmp P{(const bf16_t*)(p.ws + WS_ZB), (const bf16_t*)(p.ws + WS_WCT) + (size_t)l * 2 * 128 * 2048, 2048, (int)gridDim.x, (int)blockIdx.x};
    pg8::EpiCmp E{(float*)(p.ws + WS_HIDP)};
    pg8::gemm_phase<pg8::ProbCmp, pg8::EpiCmp, true, true>((PG8_LAS unsigned char*)lds_raw, P, E);
    { const int tid = otid(), lane = tid & 63, wave = tid >> 6, r8 = lane >> 3, c8 = lane & 7;
      const bf16_t* Z = (const bf16_t*)(p.ws + WS_ZB); bf16_t* KMB = (bf16_t*)(p.ws + WS_KMB);
      float* part = (float*)(lds_raw + 131072 + 512);
      for (int it0 = blockIdx.x * 2; it0 < Bn * 8 * 32; it0 += gridDim.x * 2) {
          const int it = it0 + (wave >> 2), q = wave & 3;
          const int b = it / 256, h = (it / 32) & 7, blk = it & 31;
          const bf16_t* base = Z + (size_t)(b * S + blk * 256 + q * 64 + r8) * ZBW + ZB_MK + h * 64 + c8 * 8;
          float s[8] = {0.f, 0.f, 0.f, 0.f, 0.f, 0.f, 0.f, 0.f};
          uint4 v[8];
#pragma unroll
          for (int i = 0; i < 8; ++i) v[i] = *(const uint4*)(base + (size_t)(8 * i) * ZBW);
#pragma unroll
          for (int i = 0; i < 8; ++i) { const unsigned w[4] = {v[i].x, v[i].y, v[i].z, v[i].w};
#pragma unroll
              for (int e = 0; e < 4; ++e) { s[2 * e] += __builtin_bit_cast(float, w[e] << 16); s[2 * e + 1] += __builtin_bit_cast(float, w[e] & 0xffff0000u); } }
#pragma unroll
          for (int e = 0; e < 8; ++e) { s[e] += __shfl_xor(s[e], 8); s[e] += __shfl_xor(s[e], 16); s[e] += __shfl_xor(s[e], 32); }
          if (r8 == 0) {
#pragma unroll
              for (int e = 0; e < 8; ++e) part[wave * 64 + c8 * 8 + e] = s[e]; }
          __syncthreads();
          if (tid < 128) { const int item = tid >> 6, d = tid & 63; const float* pp = part + item * 256 + d;
              KMB[(size_t)(it0 + item) * 64 + d] = (bf16_t)f2bf((((pp[0] + pp[64]) + pp[128]) + pp[192]) * (1.f / 256.f)); }
          __syncthreads();
      } }
}
__device__ __forceinline__ void phase_m1_fast(const Params& p, int l, unsigned char* lds_raw) {
    int* ps = (int*)(lds_raw + LDS_PS_OFF);
    load_pstart(p, l, ps);
    pg8::ProbMoe1 P{(const bf16_t*)(p.ws + WS_XN8), (const bf16_t*)(p.ws + WS_W1T) + (size_t)l * NE * 2048 * 512, (const int*)(p.ws + WS_ROWTOK) + (size_t)l * RMAX, (pg8::lds_ints)ps, 512, ps[32] / 256, (int)gridDim.x, (int)blockIdx.x};
    pg8::EpiM1 E{p.ws + WS_ACT, p.in[18] + (size_t)l * NE * 2048, (const float*)(p.ws + WS_DQ1) + (size_t)l * NE * 2048};
    pg8::gemm_phase<pg8::ProbMoe1, pg8::EpiM1, true, true>((PG8_LAS unsigned char*)lds_raw, P, E);
    __syncthreads();
}
__device__ __forceinline__ void phase_m2_fast(const Params& p, int l, unsigned char* lds_raw) {
    int* ps = (int*)(lds_raw + LDS_PS_OFF);
    load_pstart(p, l, ps);
    pg8::ProbMoe2 P{(const bf16_t*)(p.ws + WS_ACT), (const bf16_t*)(p.ws + WS_W2T) + (size_t)l * NE * D * 512, (pg8::lds_ints)ps, 512, ps[32] / 256, (int)gridDim.x, (int)blockIdx.x};
    pg8::EpiM2 E{(bf16_t*)(p.ws + WS_Y), p.in[20] + (size_t)l * NE * D, (const float*)(p.ws + WS_DQ2) + (size_t)l * NE * D};
    pg8::gemm_phase<pg8::ProbMoe2, pg8::EpiM2, true, true>((PG8_LAS unsigned char*)lds_raw, P, E);
    __syncthreads();
}

namespace at {
#define AT_LAS __attribute__((address_space(3)))
typedef short bf16x8 __attribute__((ext_vector_type(8)));
typedef short s16x4 __attribute__((ext_vector_type(4)));
typedef short v4i16_t __attribute__((ext_vector_type(4)));
typedef float f32x16 __attribute__((ext_vector_type(16)));
typedef unsigned u32x4 __attribute__((ext_vector_type(4)));
typedef float f32x2_t __attribute__((ext_vector_type(2))); typedef __bf16 bf16x2_t __attribute__((ext_vector_type(2)));
typedef AT_LAS unsigned char* lp;
constexpr int L_K = 0  , L_V = 32768  , L_WSF = 65536, L_OST = 67584  , L_SELM = 133120, L_UNI = 134144, L_KMT = 134400, L_END = 142592;
constexpr float NEGS = -1e30f;
constexpr float MAXTHR = 12.f;
__device__ __forceinline__ int crow(int r, int hi) { return (r & 3) + 8 * (r >> 2) + 4 * hi; }
__device__ __forceinline__ unsigned cvtpk(float lo, float hi) { f32x2_t v = {lo, hi}; bf16x2_t b = __builtin_convertvector(v, bf16x2_t); return __builtin_bit_cast(unsigned, b); }
__device__ __forceinline__ float mx3(float a, float b, float c) { return __builtin_fmaxf(__builtin_fmaxf(a, b), c); }
__device__ __forceinline__ void wsync() { asm volatile("s_waitcnt lgkmcnt(0)" ::: "memory"); __builtin_amdgcn_wave_barrier(); }
__device__ __forceinline__ void bar() { __builtin_amdgcn_s_barrier(); }
#define AT_WAITV(n) asm volatile("s_waitcnt vmcnt(" #n ")" ::: "memory")
#define AT_WAITL() asm volatile("s_waitcnt lgkmcnt(0)" ::: "memory")
__device__ __forceinline__ void glds(const void* g, lp dst) { __builtin_amdgcn_global_load_lds((const unsigned*)g, (AT_LAS unsigned*)dst, 16, 0, 0); }
__device__ __forceinline__ s16x4 vtr(const AT_LAS unsigned char* p) { return __builtin_bit_cast(s16x4, __builtin_amdgcn_ds_read_tr16_b64_v4i16((AT_LAS v4i16_t*)p)); }

__device__ __forceinline__ void dma_k(lp slot, const bf16_t* kbase, int pitch, int key0, int wid, int lane) { glds(kbase + (size_t)(key0 + lane) * pitch + wid * 8, slot + wid * 1024); }
__device__ __forceinline__ void dma_v(lp slot, const bf16_t* vbase, int pitch, int key0, int wid, int lane) {
    glds(vbase + (size_t)(key0 + 16 * (wid & 3) + (lane >> 2)) * pitch + (wid >> 2) * 32 + (lane & 3) * 8, slot + wid * 1024); }

__device__ __forceinline__ void qk_tile(f32x16& p0, f32x16& p1, lp kslot, const bf16x8 (&qr)[4], int r32, int hi) {
    const AT_LAS unsigned char* kb = kslot + hi * 1024 + r32 * 16;
    bf16x8 b0[4], b1[4];
#pragma unroll
    for (int d0 = 0; d0 < 4; ++d0) { b0[d0] = *(const AT_LAS bf16x8*)(kb + d0 * 2048); b1[d0] = *(const AT_LAS bf16x8*)(kb + d0 * 2048 + 512); }
#pragma unroll
    for (int d0 = 0; d0 < 4; ++d0) {
        p0 = __builtin_amdgcn_mfma_f32_32x32x16_bf16(b0[d0], qr[d0], p0, 0, 0, 0);
        p1 = __builtin_amdgcn_mfma_f32_32x32x16_bf16(b1[d0], qr[d0], p1, 0, 0, 0);
    }
}
struct VFrag { bf16x8 f[8]; };
__device__ __forceinline__ void pv_load(VFrag& v, lp vslot, int lane, int hi) {
    const AT_LAS unsigned char* vp = vslot + ((lane >> 4) & 1) * 32 + (lane & 3) * 8 + (4 * hi + ((lane & 15) >> 2)) * 64;
#pragma unroll
    for (int d0 = 0; d0 < 2; ++d0)
#pragma unroll
        for (int ks = 0; ks < 4; ++ks) {
            const s16x4 lo = vtr(vp + d0 * 4096 + ks * 1024), hh = vtr(vp + d0 * 4096 + ks * 1024 + 512);
            v.f[d0 * 4 + ks] = (bf16x8){lo[0], lo[1], lo[2], lo[3], hh[0], hh[1], hh[2], hh[3]};
        }
}
__device__ __forceinline__ void pv_mfma(f32x16 (&o)[2], const VFrag& v, u32x4 pw0, u32x4 pw1, u32x4 pw2, u32x4 pw3) {
    const bf16x8 pa[4] = {__builtin_bit_cast(bf16x8, pw0), __builtin_bit_cast(bf16x8, pw1), __builtin_bit_cast(bf16x8, pw2), __builtin_bit_cast(bf16x8, pw3)};
#pragma unroll
    for (int ks = 0; ks < 4; ++ks) {
        o[0] = __builtin_amdgcn_mfma_f32_32x32x16_bf16(pa[ks], v.f[ks], o[0], 0, 0, 0);
        o[1] = __builtin_amdgcn_mfma_f32_32x32x16_bf16(pa[ks], v.f[4 + ks], o[1], 0, 0, 0);
    }
}
__device__ __forceinline__ float rowmax(const f32x16& p0, const f32x16& p1) {
    float a = mx3(p0[0], p0[1], p1[0]), b = mx3(p0[2], p0[3], p1[1]); a = mx3(a, p1[2], p1[3]);
#pragma unroll
    for (int r = 4; r < 16; r += 4) { a = mx3(a, p0[r], p0[r + 1]); b = mx3(b, p0[r + 2], p0[r + 3]); a = mx3(a, p1[r], p1[r + 1]); b = mx3(b, p1[r + 2], p1[r + 3]); }
    const float m = __builtin_fmaxf(a, b);
    auto rr = __builtin_amdgcn_permlane32_swap(__float_as_uint(m), __float_as_uint(m), false, false);
    return __builtin_fmaxf(__uint_as_float(rr[0]), __uint_as_float(rr[1]));
}
__device__ __forceinline__ float halfsum(float v) {
    auto rr = __builtin_amdgcn_permlane32_swap(__float_as_uint(v), __float_as_uint(v), false, false);
    return __uint_as_float(rr[0]) + __uint_as_float(rr[1]);
}
__device__ __forceinline__ void mask_tile(f32x16& p0, f32x16& p1, int lo, int hi_, int hi) {
    const int kb = 4 * hi;
#pragma unroll
    for (int r = 0; r < 16; ++r) { const int kv = kb + (r & 3) + 8 * (r >> 2); if (kv > hi_ || kv < lo) p0[r] = NEGS; if (kv + 32 > hi_ || kv + 32 < lo) p1[r] = NEGS; }
}

__device__ __forceinline__ void mask_init_lo(f32x16& p0, f32x16& p1, int lo, int hi) {
    const int kb = 4 * hi;
#pragma unroll
    for (int r = 0; r < 16; ++r) { const int kv = kb + (r & 3) + 8 * (r >> 2); if (kv < lo) p0[r] = NEGS; if (kv + 32 < lo) p1[r] = NEGS; }
}
__device__ __forceinline__ void mask_init(f32x16& p0, f32x16& p1, int hi_, int hi) {
    const int kb = 4 * hi;
#pragma unroll
    for (int r = 0; r < 16; ++r) { const int kv = kb + (r & 3) + 8 * (r >> 2); if (kv > hi_) p0[r] = NEGS; if (kv + 32 > hi_) p1[r] = NEGS; }
}
__device__ __forceinline__ int next_bit128(unsigned u0, unsigned u1, unsigned u2, unsigned u3, int below) {
    if (below > 96) { unsigned x = u3; if (below < 128) x &= (1u << (below - 96)) - 1u; if (x) return 96 + 31 - __builtin_clz(x); }
    if (below > 64) { unsigned x = u2; if (below < 96) x &= (1u << (below - 64)) - 1u; if (x) return 64 + 31 - __builtin_clz(x); }
    if (below > 32) { unsigned x = u1; if (below < 64) x &= (1u << (below - 32)) - 1u; if (x) return 32 + 31 - __builtin_clz(x); }
    if (below > 0) { unsigned x = u0; if (below < 32) x &= (1u << below) - 1u; if (x) return 31 - __builtin_clz(x); }
    return -1;
}
struct Soft { float m, l; };

template <bool HAS_O>
__device__ __forceinline__ void softmax_step(f32x16& p0, f32x16& p1, Soft& st, f32x16 (&o)[2], float* wsf, int r32, int hi) {
    const float rm = rowmax(p0, p1);
    if (__any(rm > MAXTHR)) {
        const float dl = __builtin_fmaxf(rm, 0.f); st.m += dl;
#pragma unroll
        for (int r = 0; r < 16; ++r) { p0[r] -= dl; p1[r] -= dl; }
        const float al = __builtin_amdgcn_exp2f(-dl); st.l *= al;
        if (HAS_O) {
            if (hi == 0) wsf[r32] = al;
            wsync();
#pragma unroll
            for (int r = 0; r < 16; ++r) { const float f = wsf[crow(r, hi)]; o[0][r] *= f; o[1][r] *= f; }
            wsync();
        }
    }
    float s = 0.f;
#pragma unroll
    for (int r = 0; r < 16; ++r) { p0[r] = __builtin_amdgcn_exp2f(p0[r]); p1[r] = __builtin_amdgcn_exp2f(p1[r]); s += p0[r] + p1[r]; }
    st.l += s;
}
#define AT_PACK(P0, P1) \
    const u32x4 pw0 = {cvtpk(P0[0], P0[1]), cvtpk(P0[2], P0[3]), cvtpk(P0[4], P0[5]), cvtpk(P0[6], P0[7])}, pw1 = {cvtpk(P0[8], P0[9]), cvtpk(P0[10], P0[11]), cvtpk(P0[12], P0[13]), cvtpk(P0[14], P0[15])}, \
                pw2 = {cvtpk(P1[0], P1[1]), cvtpk(P1[2], P1[3]), cvtpk(P1[4], P1[5]), cvtpk(P1[6], P1[7])}, pw3 = {cvtpk(P1[8], P1[9]), cvtpk(P1[10], P1[11]), cvtpk(P1[12], P1[13]), cvtpk(P1[14], P1[15])}
__device__ __forceinline__ float fma_vsv(float a, float k, float x) { float d; asm("v_fma_f32 %0, %1, %2, %3" : "=v"(d) : "v"(a), "s"(k), "v"(x)); return d; }
__device__ __forceinline__ f32x16 cinit(float c2k, int hi, float x) { f32x16 c; const float xb = __builtin_fmaf(c2k, (float)(4 * hi), x);
    c[0] = xb;
#pragma unroll
    for (int r = 1; r < 16; ++r) c[r] = fma_vsv(c2k, (float)((r & 3) + 8 * (r >> 2)), xb);
    return c; }
template <bool FIRST>
__device__ __forceinline__ void acc_scaled(float* stage, const f32x16 (&o)[2], float f, float* wsf, int r32, int hi) {
    if (hi == 0) wsf[r32] = f;
    wsync();
#pragma unroll
    for (int r = 0; r < 16; ++r) { const int orow = crow(r, hi); const float g = wsf[orow]; float* s0 = stage + orow * 64 + r32;
        if (FIRST) { s0[0] = o[0][r] * g; s0[32] = o[1][r] * g; } else { s0[0] += o[0][r] * g; s0[32] += o[1][r] * g; } }
    wsync();
}

#define AT_WAIT_NEWER(newer, per) do { if ((newer) >= 2) { if ((per) == 2) AT_WAITV(4); else AT_WAITV(2); } else if ((newer) == 1) { if ((per) == 2) AT_WAITV(2); else AT_WAITV(1); } else AT_WAITV(0); } while (0)


#define AT_SB() __builtin_amdgcn_sched_barrier(0)
struct PipeOut { float s, rmn; };
__device__ __forceinline__ PipeOut pipe_step(f32x16& c0, f32x16& c1, f32x16& n0, f32x16& n1, f32x16 (&o)[2], lp kslot_next, lp vslot, const bf16x8 (&qr)[4], int lane, int r32, int hi) {
    const AT_LAS unsigned char* kb = kslot_next + hi * 1024 + r32 * 16;
    const AT_LAS unsigned char* vp = vslot + ((lane >> 4) & 1) * 32 + (lane & 3) * 8 + (4 * hi + ((lane & 15) >> 2)) * 64;
    bf16x8 kf[8];
#pragma unroll
    for (int j = 0; j < 4; ++j) kf[j] = *(const AT_LAS bf16x8*)(kb + (j >> 1) * 2048 + (j & 1) * 512);
    AT_SB();
    unsigned w0[8], w1[8]; s16x4 vl[8], vh[8]; float s = 0.f;
#pragma unroll
    for (int j = 0; j < 8; ++j) {
        if (j & 1) n1 = __builtin_amdgcn_mfma_f32_32x32x16_bf16(kf[j], qr[j >> 1], n1, 0, 0, 0);
        else       n0 = __builtin_amdgcn_mfma_f32_32x32x16_bf16(kf[j], qr[j >> 1], n0, 0, 0, 0);
        if (j < 4) kf[j + 4] = *(const AT_LAS bf16x8*)(kb + ((j + 4) >> 1) * 2048 + (j & 1) * 512);
        if (j >= 4) {
#pragma unroll
            for (int q = 0; q < 2; ++q) { const int f = (j - 4) * 2 + q, d0 = f >> 2, ks = f & 3; vl[f] = vtr(vp + d0 * 4096 + ks * 1024); vh[f] = vtr(vp + d0 * 4096 + ks * 1024 + 512); }
        }
        const float e0 = __builtin_amdgcn_exp2f(c0[2 * j]), e1 = __builtin_amdgcn_exp2f(c0[2 * j + 1]), e2 = __builtin_amdgcn_exp2f(c1[2 * j]), e3 = __builtin_amdgcn_exp2f(c1[2 * j + 1]);
        s += (e0 + e1) + (e2 + e3);
        asm volatile("" : "+v"(s));
        w0[j] = cvtpk(e0, e1); w1[j] = cvtpk(e2, e3);
        AT_SB();
    }
    const u32x4 pw0 = {w0[0], w0[1], w0[2], w0[3]}, pw1 = {w0[4], w0[5], w0[6], w0[7]}, pw2 = {w1[0], w1[1], w1[2], w1[3]}, pw3 = {w1[4], w1[5], w1[6], w1[7]};
    const bf16x8 pa[4] = {__builtin_bit_cast(bf16x8, pw0), __builtin_bit_cast(bf16x8, pw1), __builtin_bit_cast(bf16x8, pw2), __builtin_bit_cast(bf16x8, pw3)};
    float a = mx3(n0[0], n0[1], n1[0]), b = mx3(n0[2], n0[3], n1[1]);
#pragma unroll
    for (int f = 0; f < 8; ++f) {
        const int d0 = f >> 2, ks = f & 3;
        const bf16x8 vf = (bf16x8){vl[f][0], vl[f][1], vl[f][2], vl[f][3], vh[f][0], vh[f][1], vh[f][2], vh[f][3]};
        o[d0] = __builtin_amdgcn_mfma_f32_32x32x16_bf16(pa[ks], vf, o[d0], 0, 0, 0);
        if (f == 0) { a = mx3(a, n1[2], n1[3]); }
        else if (f < 4) { const int r = 4 * f; a = mx3(a, n0[r], n0[r + 1]); b = mx3(b, n0[r + 2], n0[r + 3]); a = mx3(a, n1[r], n1[r + 1]); b = mx3(b, n1[r + 2], n1[r + 3]); }
        asm volatile("" : "+v"(a), "+v"(b));
        AT_SB();
    }
    const float m = __builtin_fmaxf(a, b);
    auto rr = __builtin_amdgcn_permlane32_swap(__float_as_uint(m), __float_as_uint(m), false, false);
    PipeOut out; out.s = s; out.rmn = __builtin_fmaxf(__uint_as_float(rr[0]), __uint_as_float(rr[1]));
    return out;
}
__device__ __forceinline__ void nsa_unit(const Params& p, int b, int g, int c, unsigned char* lds_raw) {
    const int tid = otid(), lane = tid & 63, r32 = lane & 31, hi = lane >> 5, wid = __builtin_amdgcn_readfirstlane(tid >> 6);
    lp lds = (lp)lds_raw;
    const bf16_t* ZB = (const bf16_t*)(p.ws + WS_ZB); const float* GT = (const float*)(p.ws + WS_GATE);
    const bf16_t* KCB = (const bf16_t*)(p.ws + WS_KCB) + (size_t)(b * 2 + g) * 512 * 64; const bf16_t* VCB = (const bf16_t*)(p.ws + WS_VCB) + (size_t)(b * 2 + g) * 512 * 64;
    const int t0 = c * 64, hg = r32 >> 3, qq = r32 & 7, qi = 8 * wid + qq, t = t0 + qi, h = 4 * g + hg; const size_t tt = (size_t)b * S + t;
    float* wsf = (float*)(lds_raw + L_WSF) + wid * 64;
    float* ostage = (float*)(lds_raw + L_OST) + wid * 2048;
    float* imp = ostage;
    unsigned* selm = (unsigned*)(lds_raw + L_SELM);
    unsigned* uni = (unsigned*)(lds_raw + L_UNI);
    const float c2 = exp2f(-(float)(h + 1)) * LOG2E;
    bf16x8 qr[4];
#pragma unroll
    for (int d0 = 0; d0 < 4; ++d0) qr[d0] = *(const bf16x8*)(ZB + tt * ZBW + ZB_Q + h * 64 + d0 * 16 + hi * 8);
    const float gt0 = GT[tt * 32 + h * 3 + 0], gt1 = GT[tt * 32 + h * 3 + 1], gt2 = GT[tt * 32 + h * 3 + 2];
    f32x16 o[2];
    const lp sK0 = lds + L_K, sV0 = lds + L_V;
    const int nmax = t >= 31 ? (t - 31) >> 4 : -1;
    const int ntc = ((4 * c + 2) >> 6) + 1;
    for (int i = lane; i < 8 * 129; i += 64) imp[i] = 0.f;
    Soft sc; sc.m = 0.f; sc.l = 0.f;
#pragma unroll
    for (int k = 0; k < 3; ++k) if (k < ntc) dma_k(sK0 + k * 8192, KCB, 64, 64 * k, wid, lane);
    for (int k = 0; k < ntc; ++k) {
        const int newer = ntc - 1 - k; AT_WAIT_NEWER(newer, 1);
        AT_WAITL(); bar();
        if (k + 3 < ntc) dma_k(sK0 + ((k + 3) & 3) * 8192, KCB, 64, 64 * (k + 3), wid, lane);
        const lp sK = sK0 + (k & 3) * 8192;
        const float x0 = c2 * (16.f * (64 * k) + 15.5f - (float)t0) - sc.m;
        f32x16 p0 = cinit(16.f * c2, hi, x0), p1 = cinit(16.f * c2, hi, x0 + c2 * 512.f);
        qk_tile(p0, p1, sK, qr, r32, hi);
        if (__any(nmax - 64 * k < 63)) mask_tile(p0, p1, 0, nmax - 64 * k, hi);
        softmax_step<false>(p0, p1, sc, o, wsf, r32, hi);
    }
    const float lc = halfsum(sc.l), linv = lc > 0.f ? 1.f / lc : 0.f;
    o[0] = f32x16{}; o[1] = f32x16{};
    AT_WAITL(); bar();
#pragma unroll
    for (int k = 0; k < 3; ++k) if (k < ntc) { dma_k(sK0 + k * 8192, KCB, 64, 64 * k, wid, lane); dma_v(sV0 + k * 8192, VCB, 64, 64 * k, wid, lane); }
    for (int k = 0; k < ntc; ++k) {
        const int newer = ntc - 1 - k; AT_WAIT_NEWER(newer, 2);
        AT_WAITL(); bar();
        if (k + 3 < ntc) { dma_k(sK0 + ((k + 3) & 3) * 8192, KCB, 64, 64 * (k + 3), wid, lane); dma_v(sV0 + ((k + 3) & 3) * 8192, VCB, 64, 64 * (k + 3), wid, lane); }
        const lp sK = sK0 + (k & 3) * 8192, sV = sV0 + (k & 3) * 8192;
        const float x0 = c2 * (16.f * (64 * k) + 15.5f - (float)t0) - sc.m;
        f32x16 p0 = cinit(16.f * c2, hi, x0), p1 = cinit(16.f * c2, hi, x0 + c2 * 512.f);
        qk_tile(p0, p1, sK, qr, r32, hi);
        if (__any(nmax - 64 * k < 63)) mask_tile(p0, p1, 0, nmax - 64 * k, hi);
        VFrag vf; pv_load(vf, sV, lane, hi);
#pragma unroll
        for (int r = 0; r < 16; ++r) { p0[r] = __builtin_amdgcn_exp2f(p0[r]); p1[r] = __builtin_amdgcn_exp2f(p1[r]); }
        { AT_PACK(p0, p1); pv_mfma(o, vf, pw0, pw1, pw2, pw3); }
        float gs[8], ls[8];
#pragma unroll
        for (int q4 = 0; q4 < 4; ++q4) { gs[q4] = ((p0[4 * q4] + p0[4 * q4 + 1]) + (p0[4 * q4 + 2] + p0[4 * q4 + 3])) * linv; ls[q4] = p0[4 * q4 + 3] * linv;
                                         gs[4 + q4] = ((p1[4 * q4] + p1[4 * q4 + 1]) + (p1[4 * q4 + 2] + p1[4 * q4 + 3])) * linv; ls[4 + q4] = p1[4 * q4 + 3] * linv; }
#pragma unroll
        for (int q4 = 0; q4 < 8; ++q4) { gs[q4] += __shfl_xor(gs[q4], 8); gs[q4] += __shfl_xor(gs[q4], 16); ls[q4] += __shfl_xor(ls[q4], 8); ls[q4] += __shfl_xor(ls[q4], 16); }
        if (r32 < 8) {
            float* row = imp + qq * 129 + 16 * k + hi;
#pragma unroll
            for (int q4 = 0; q4 < 8; ++q4) row[2 * q4] += gs[q4];
        }
        wsync();
        if (r32 < 8) {
            float* row = imp + qq * 129 + 16 * k + hi + 1;
#pragma unroll
            for (int q4 = 0; q4 < 8; ++q4) row[2 * q4] += ls[q4];
        }
        wsync();
    }
    unsigned mk0 = 0u, mk1 = 0u, mk2 = 0u, mk3 = 0u;
    {
        const int qs = lane >> 3, part = lane & 7;
        float v[16];
#pragma unroll
        for (int i = 0; i < 16; ++i) { const int j = part * 16 + i; float x = imp[qs * 129 + j]; if (j == 0 || j == c || j == c - 1) x = 1e4f; if (j > c) x = NEGS; v[i] = x; }
#pragma unroll 1
        for (int it = 0; it < 16; ++it) {
            float bv = -3e38f; int bi = 0;
#pragma unroll
            for (int i = 0; i < 16; ++i) if (v[i] > bv) { bv = v[i]; bi = part * 16 + i; }
#pragma unroll
            for (int sft = 1; sft < 8; sft <<= 1) { const float ov = __shfl_xor(bv, sft); const int oi = __shfl_xor(bi, sft); if (ov > bv || (ov == bv && oi < bi)) { bv = ov; bi = oi; } }
            if (bv > NEGS) { const unsigned bit = 1u << (bi & 31); const int wq = bi >> 5; if (wq == 0) mk0 |= bit; else if (wq == 1) mk1 |= bit; else if (wq == 2) mk2 |= bit; else mk3 |= bit; }
#pragma unroll
            for (int i = 0; i < 16; ++i) if (part * 16 + i == bi) v[i] = -3.4e38f;
        }
        if (part == 0) { unsigned* sm = selm + (8 * wid + qs) * 4; sm[0] = mk0; sm[1] = mk1; sm[2] = mk2; sm[3] = mk3; }
        unsigned u0 = mk0, u1 = mk1, u2 = mk2, u3 = mk3;
#pragma unroll
        for (int sft = 8; sft < 64; sft <<= 1) { u0 |= __shfl_xor(u0, sft); u1 |= __shfl_xor(u1, sft); u2 |= __shfl_xor(u2, sft); u3 |= __shfl_xor(u3, sft); }
        if (lane == 0) { uni[wid * 4 + 0] = u0; uni[wid * 4 + 1] = u1; uni[wid * 4 + 2] = u2; uni[wid * 4 + 3] = u3; }
    }
    wsync();
    acc_scaled<true>(ostage, o, gt0 * linv, wsf, r32, hi);
    AT_WAITL(); bar();
    unsigned un0 = 0u, un1 = 0u, un2 = 0u, un3 = 0u;
#pragma unroll
    for (int w = 0; w < 8; ++w) { un0 |= uni[w * 4 + 0]; un1 |= uni[w * 4 + 1]; un2 |= uni[w * 4 + 2]; un3 |= uni[w * 4 + 3]; }
    un0 = __builtin_amdgcn_readfirstlane(un0); un1 = __builtin_amdgcn_readfirstlane(un1); un2 = __builtin_amdgcn_readfirstlane(un2); un3 = __builtin_amdgcn_readfirstlane(un3);
    const unsigned my0 = selm[(8 * wid + qq) * 4 + 0], my1 = selm[(8 * wid + qq) * 4 + 1], my2 = selm[(8 * wid + qq) * 4 + 2], my3 = selm[(8 * wid + qq) * 4 + 3];
    {
        const bf16_t* KS = ZB + (size_t)b * S * ZBW + ZB_KS + g * 64; const bf16_t* VS = ZB + (size_t)b * S * ZBW + ZB_VS + g * 64;
        Soft ss; ss.m = 0.f; ss.l = 0.f; o[0] = f32x16{}; o[1] = f32x16{};
        const int nsel = __builtin_popcount(un0) + __builtin_popcount(un1) + __builtin_popcount(un2) + __builtin_popcount(un3);
        int ji = 128;
#pragma unroll
        for (int k = 0; k < 3; ++k) if (k < nsel) { ji = next_bit128(un0, un1, un2, un3, ji); dma_k(sK0 + k * 8192, KS, ZBW, 64 * ji, wid, lane); dma_v(sV0 + k * 8192, VS, ZBW, 64 * ji, wid, lane); }
        int j = 128;
        for (int i = 0; i < nsel; ++i) {
            j = next_bit128(un0, un1, un2, un3, j);
            const int newer = nsel - 1 - i; AT_WAIT_NEWER(newer, 2);
            AT_WAITL(); bar();
            if (i + 3 < nsel) { ji = next_bit128(un0, un1, un2, un3, ji); dma_k(sK0 + ((i + 3) & 3) * 8192, KS, ZBW, 64 * ji, wid, lane); dma_v(sV0 + ((i + 3) & 3) * 8192, VS, ZBW, 64 * ji, wid, lane); }
            const lp sK = sK0 + (i & 3) * 8192, sV = sV0 + (i & 3) * 8192;
            const unsigned mw = (j >> 5) == 0 ? my0 : (j >> 5) == 1 ? my1 : (j >> 5) == 2 ? my2 : my3;
            const bool sel = (mw >> (j & 31)) & 1u;
            const float x0 = sel ? c2 * (float)(64 * j - t0) - ss.m : NEGS;
            f32x16 p0 = cinit(c2, hi, x0), p1 = cinit(c2, hi, sel ? x0 + c2 * 32.f : NEGS);
            qk_tile(p0, p1, sK, qr, r32, hi);
            if (j == c) mask_tile(p0, p1, 0, qi, hi);
            VFrag vf; pv_load(vf, sV, lane, hi);
            softmax_step<true>(p0, p1, ss, o, wsf, r32, hi);
            { AT_PACK(p0, p1); pv_mfma(o, vf, pw0, pw1, pw2, pw3); }
        }
        const float ls_ = halfsum(ss.l);
        acc_scaled<false>(ostage, o, ls_ > 0.f ? gt1 / ls_ : 0.f, wsf, r32, hi);
    }
    {
        const bf16_t* KW = ZB + (size_t)b * S * ZBW + ZB_KW + g * 64; const bf16_t* VW = ZB + (size_t)b * S * ZBW + ZB_VW + g * 64;
        Soft sw; sw.m = 0.f; sw.l = 0.f; o[0] = f32x16{}; o[1] = f32x16{};
        const int k0 = c >= 8 ? 0 : 8 - c, nw = 9 - k0;
        AT_WAITL(); bar();
#pragma unroll
        for (int k = 0; k < 3; ++k) if (k < nw) { dma_k(sK0 + k * 8192, KW, ZBW, t0 - 64 * k, wid, lane); dma_v(sV0 + k * 8192, VW, ZBW, t0 - 64 * k, wid, lane); }
        f32x16 pA0, pA1, pB0, pB1; float rmc;
#define WIN_STEP(C0, C1, N0, N1, I) do { const int i_ = (I); \
            if (i_ + 1 < nw) { if (i_ + 2 < nw) AT_WAITV(2); else AT_WAITV(0); } \
            AT_WAITL(); bar(); \
            if (i_ + 3 < nw) { dma_k(sK0 + ((i_ + 3) & 3) * 8192, KW, ZBW, t0 - 64 * (i_ + 3), wid, lane); dma_v(sV0 + ((i_ + 3) & 3) * 8192, VW, ZBW, t0 - 64 * (i_ + 3), wid, lane); } \
            if (__any(rmc > MAXTHR)) { \
                const float dl = __builtin_fmaxf(rmc, 0.f); sw.m += dl; \
                _Pragma("unroll") for (int r = 0; r < 16; ++r) { C0[r] -= dl; C1[r] -= dl; } \
                const float al = __builtin_amdgcn_exp2f(-dl); sw.l *= al; \
                if (hi == 0) wsf[r32] = al; \
                wsync(); \
                _Pragma("unroll") for (int r = 0; r < 16; ++r) { const float f = wsf[crow(r, hi)]; o[0][r] *= f; o[1][r] *= f; } \
                wsync(); \
            } \
            { const float x0 = c2 * (float)(-64 * (i_ + 1)) - sw.m; \
              N0 = cinit(c2, hi, x0); N1 = cinit(c2, hi, x0 + c2 * 32.f); \
              if (i_ + 1 == 8) mask_init_lo(N0, N1, qi + 1, hi); }        \
            const PipeOut po = pipe_step(C0, C1, N0, N1, o, sK0 + ((i_ + 1) & 3) * 8192, sV0 + (i_ & 3) * 8192, qr, lane, r32, hi); \
            sw.l += po.s; rmc = po.rmn; } while (0)
        { if (nw >= 3) AT_WAITV(4); else if (nw == 2) AT_WAITV(2); else AT_WAITV(0);
          AT_WAITL(); bar(); }
        { pB0 = cinit(c2, hi, 0.f); pB1 = cinit(c2, hi, c2 * 32.f);
          qk_tile(pB0, pB1, sK0, qr, r32, hi);
          mask_tile(pB0, pB1, 0, qi, hi);
          rmc = rowmax(pB0, pB1); }
        int i = 0;
#pragma unroll 1
        for (; i + 1 < nw; i += 2) {
            WIN_STEP(pB0, pB1, pA0, pA1, i);
            WIN_STEP(pA0, pA1, pB0, pB1, i + 1);
        }
        if (i < nw) WIN_STEP(pB0, pB1, pA0, pA1, i);
#undef WIN_STEP
        const float lw = halfsum(sw.l);
        acc_scaled<false>(ostage, o, lw > 0.f ? gt2 / lw : 0.f, wsf, r32, hi);
    }
    {
        bf16_t* AB = (bf16_t*)(p.ws + WS_ATTB);
#pragma unroll
        for (int i = 0; i < 4; ++i) { const int row = i * 8 + (lane >> 3), ch = lane & 7; const float4 a = *(const float4*)(ostage + row * 64 + ch * 8), c4 = *(const float4*)(ostage + row * 64 + ch * 8 + 4);
            const uint4 v = make_uint4(pk2(a.x, a.y), pk2(a.z, a.w), pk2(c4.x, c4.y), pk2(c4.z, c4.w));
            *(uint4*)(AB + ((size_t)b * S + t0 + 8 * wid + (row & 7)) * D + (4 * g + (row >> 3)) * 64 + ch * 8) = v; }
        wsync();
    }
    AT_WAITL(); bar();
}

}

constexpr int MB_CAP = 25600;
namespace at {
__device__ __forceinline__ void moba_route_unit(const Params& p, int b, int h, int qb, unsigned char* lds_raw) {
    const int tid = otid(), lane = tid & 63, r32 = lane & 31, hi = lane >> 5, wid = __builtin_amdgcn_readfirstlane(tid >> 6);
    lp lds = (lp)lds_raw;
    const bf16_t* ZB = (const bf16_t*)(p.ws + WS_ZB);
    const int bh = b * 8 + h;
    const bf16_t* KMB = (const bf16_t*)(p.ws + WS_KMB) + (size_t)bh * 32 * 64;
    const int qi = 32 * wid + r32, t = qb * 256 + qi; const size_t tt = (size_t)b * S + t;
    int* hist = (int*)(lds_raw + L_UNI);
    unsigned* SEL3 = (unsigned*)(p.ws + WS_SEL3); unsigned* LRK = (unsigned*)(p.ws + WS_LRK);
    unsigned char* IL = (unsigned char*)(p.ws + WS_ILIST) + ((size_t)(bh * 32 + qb) * 32) * 256;
    int* BCm = (int*)(p.ws + WS_BCM) + (size_t)(bh * 32 + qb) * 32;
    if (tid < 32) hist[tid] = 0;
    bf16x8 qr[4];
#pragma unroll
    for (int d0 = 0; d0 < 4; ++d0) qr[d0] = *(const bf16x8*)(ZB + tt * ZBW + ZB_MQ + h * 64 + d0 * 16 + hi * 8);
    const lp sKM = lds + L_KMT;
    glds(KMB + (size_t)(lane & 31) * 64 + wid * 8, sKM + wid * 1024);
    AT_WAITV(0); AT_WAITL(); bar();
    f32x16 g0 = f32x16{}, g1 = f32x16{};
    qk_tile(g0, g1, sKM, qr, r32, hi);
    float v1 = NEGS, v2 = NEGS, v3 = NEGS; int i1 = 64, i2 = 64, i3 = 64;
#pragma unroll
    for (int r = 0; r < 16; ++r) { const int n = crow(r, hi); const float s_ = n < qb ? g0[r] : NEGS;
        if (s_ > v1) { v3 = v2; i3 = i2; v2 = v1; i2 = i1; v1 = s_; i1 = n; } else if (s_ > v2) { v3 = v2; i3 = i2; v2 = s_; i2 = n; } else if (s_ > v3) { v3 = s_; i3 = n; } }
    float ov[3]; int oi[3];
    { auto a = __builtin_amdgcn_permlane32_swap(__float_as_uint(v1), __float_as_uint(v1), false, false); ov[0] = __uint_as_float(hi ? a[0] : a[1]); }
    { auto a = __builtin_amdgcn_permlane32_swap(__float_as_uint(v2), __float_as_uint(v2), false, false); ov[1] = __uint_as_float(hi ? a[0] : a[1]); }
    { auto a = __builtin_amdgcn_permlane32_swap(__float_as_uint(v3), __float_as_uint(v3), false, false); ov[2] = __uint_as_float(hi ? a[0] : a[1]); }
    { auto a = __builtin_amdgcn_permlane32_swap((unsigned)i1, (unsigned)i1, false, false); oi[0] = (int)(hi ? a[0] : a[1]); }
    { auto a = __builtin_amdgcn_permlane32_swap((unsigned)i2, (unsigned)i2, false, false); oi[1] = (int)(hi ? a[0] : a[1]); }
    { auto a = __builtin_amdgcn_permlane32_swap((unsigned)i3, (unsigned)i3, false, false); oi[2] = (int)(hi ? a[0] : a[1]); }
#pragma unroll
    for (int k = 0; k < 3; ++k) { const float s_ = ov[k]; const int n = oi[k];
        if (s_ > v1 || (s_ == v1 && n < i1)) { v3 = v2; i3 = i2; v2 = v1; i2 = i1; v1 = s_; i1 = n; }
        else if (s_ > v2 || (s_ == v2 && n < i2)) { v3 = v2; i3 = i2; v2 = s_; i2 = n; }
        else if (s_ > v3 || (s_ == v3 && n < i3)) { v3 = s_; i3 = n; } }
    if (hi == 0) {
        const int j1 = v1 > NEGS ? i1 : 255, j2 = v2 > NEGS ? i2 : 255, j3 = v3 > NEGS ? i3 : 255;
        int l1 = 0, l2 = 0, l3 = 0;
        if (j1 < 32) { l1 = atomicAdd(&hist[j1], 1); IL[j1 * 256 + l1] = (unsigned char)qi; }
        if (j2 < 32) { l2 = atomicAdd(&hist[j2], 1); IL[j2 * 256 + l2] = (unsigned char)qi; }
        if (j3 < 32) { l3 = atomicAdd(&hist[j3], 1); IL[j3 * 256 + l3] = (unsigned char)qi; }
        SEL3[tt * 8 + h] = (unsigned)j1 | ((unsigned)j2 << 8) | ((unsigned)j3 << 16);
        LRK[tt * 8 + h] = (unsigned)l1 | ((unsigned)l2 << 8) | ((unsigned)l3 << 16);
    }
    AT_WAITL(); bar();
    if (tid < 32) BCm[tid] = hist[tid];
    AT_WAITL(); bar();
}
__device__ __forceinline__ void moba_tables(const int* BCmbh, int lane, int& tot, int& seg) {
    int s = 0;
    if (lane < 32) { for (int q = 0; q < 32; ++q) s += BCmbh[q * 32 + lane]; }
    tot = s;
    int pad = (s + 31) & ~31, inc = pad;
#pragma unroll
    for (int sft = 1; sft < 32; sft <<= 1) { const int o_ = __shfl_up(inc, sft); if ((lane & 31) >= sft) inc += o_; }
    seg = inc - pad;
}
__device__ __forceinline__ void moba_gather_unit(const Params& p, int bh, int j, int ch, int segj, bool reload, unsigned char* lds_raw) {
    const int tid = otid(), lane = tid & 63, r32 = lane & 31, hi = lane >> 5, wid = __builtin_amdgcn_readfirstlane(tid >> 6);
    lp lds = (lp)lds_raw;
    const int b = bh >> 3, h = bh & 7;
    const bf16_t* ZB = (const bf16_t*)(p.ws + WS_ZB);
    const int* BCmbh = (const int*)(p.ws + WS_BCM) + (size_t)bh * 32 * 32;
    float* wsf = (float*)(lds_raw + L_WSF) + wid * 64;
    const lp sK0 = lds + L_K, sV0 = lds + L_V;
    const bf16_t* KM_ = ZB + (size_t)b * S * ZBW + ZB_MK + h * 64; const bf16_t* VM_ = ZB + (size_t)b * S * ZBW + ZB_MV + h * 64;
    if (reload) {
#pragma unroll
        for (int k = 3; k >= 0; --k) { dma_k(sK0 + k * 8192, KM_, ZBW, j * 256 + 64 * k, wid, lane); dma_v(sV0 + k * 8192, VM_, ZBW, j * 256 + 64 * k, wid, lane); }
    }
    const int gr = 256 * ch + 32 * wid + r32;
    const int cq = lane < 32 ? BCmbh[lane * 32 + j] : 0;
    int run = 0, qbs = j + 1, lr = 0;
#pragma unroll 4
    for (int q = 0; q < 32; ++q) { const int c_ = __builtin_amdgcn_readlane(cq, q); if (gr >= run && gr < run + c_) { qbs = q; lr = gr - run; } run += c_; }
    const int totj = run;
    const bool valid = gr < totj;
    const unsigned char* IL = (const unsigned char*)(p.ws + WS_ILIST);
    const int qidx = valid ? (int)IL[((size_t)(bh * 32 + qbs) * 32 + j) * 256 + lr] : 0;
    const int t = valid ? qbs * 256 + qidx : (j + 1) * 256; const size_t tt = (size_t)b * S + t;
    const float c2 = exp2f(-(float)(h + 1)) * LOG2E;
    bf16x8 qr[4];
#pragma unroll
    for (int d0 = 0; d0 < 4; ++d0) qr[d0] = *(const bf16x8*)(ZB + tt * ZBW + ZB_MQ + h * 64 + d0 * 16 + hi * 8);
    Soft sm; sm.m = 0.f; sm.l = 0.f; f32x16 o[2]; o[0] = f32x16{}; o[1] = f32x16{};
#pragma unroll 1
    for (int i = 0; i < 4; ++i) {
        if (reload) { const int newer = 3 - i; if (newer >= 3) AT_WAITV(6); else AT_WAIT_NEWER(newer, 2); AT_WAITL(); bar(); }
        const int kt = 3 - i;
        const lp sK = sK0 + kt * 8192, sV = sV0 + kt * 8192;
        const float x0 = c2 * (float)(64 * kt) - sm.m;
        f32x16 p0 = cinit(c2, hi, x0), p1 = cinit(c2, hi, x0 + c2 * 32.f);
        qk_tile(p0, p1, sK, qr, r32, hi);
        VFrag vf; pv_load(vf, sV, lane, hi);
        softmax_step<true>(p0, p1, sm, o, wsf, r32, hi);
        { AT_PACK(p0, p1); pv_mfma(o, vf, pw0, pw1, pw2, pw3); }
    }
    {
        const float lt = halfsum(sm.l);
        float* PM = (float*)(p.ws + WS_PM) + (size_t)bh * MB_CAP; float* PL = (float*)(p.ws + WS_PL) + (size_t)bh * MB_CAP;
        if (hi == 0 && valid) { PM[segj + gr] = sm.m; PL[segj + gr] = lt; }
        bf16_t* stg = (bf16_t*)(lds_raw + L_OST) + wid * 4096;
#pragma unroll
        for (int r = 0; r < 16; ++r) { const int orow = crow(r, hi); stg[orow * 64 + r32] = (bf16_t)f2bf(o[0][r]); stg[orow * 64 + 32 + r32] = (bf16_t)f2bf(o[1][r]); }
        wsync();
        bf16_t* PO = (bf16_t*)(p.ws + WS_PO) + ((size_t)bh * MB_CAP + segj + 256 * ch + 32 * wid) * 64;
        const int nrow = totj - (256 * ch + 32 * wid);
#pragma unroll
        for (int i = 0; i < 4; ++i) { const int row = i * 8 + (lane >> 3), c8 = lane & 7; if (row < nrow) *(uint4*)(PO + (size_t)row * 64 + c8 * 8) = *(const uint4*)(stg + row * 64 + c8 * 8); }
        wsync();
    }
    AT_WAITL(); bar();
}
__device__ __forceinline__ void moba_self_unit(const Params& p, int b, int h, int qb, unsigned char* lds_raw) {
    const int tid = otid(), lane = tid & 63, r32 = lane & 31, hi = lane >> 5, wid = __builtin_amdgcn_readfirstlane(tid >> 6);
    lp lds = (lp)lds_raw;
    const int bh = b * 8 + h;
    const bf16_t* ZB = (const bf16_t*)(p.ws + WS_ZB);
    const int* BCmbh = (const int*)(p.ws + WS_BCM) + (size_t)bh * 32 * 32;
    const int qi = 32 * wid + r32, t = qb * 256 + qi; const size_t tt = (size_t)b * S + t;
    float* wsf = (float*)(lds_raw + L_WSF) + wid * 64;
    float* ostage = (float*)(lds_raw + L_OST) + wid * 2048;
    const float c2 = exp2f(-(float)(h + 1)) * LOG2E;
    bf16x8 qr[4];
#pragma unroll
    for (int d0 = 0; d0 < 4; ++d0) qr[d0] = *(const bf16x8*)(ZB + tt * ZBW + ZB_MQ + h * 64 + d0 * 16 + hi * 8);
    const lp sK0 = lds + L_K, sV0 = lds + L_V;
    const bf16_t* KM_ = ZB + (size_t)b * S * ZBW + ZB_MK + h * 64; const bf16_t* VM_ = ZB + (size_t)b * S * ZBW + ZB_MV + h * 64;
    Soft sm; sm.m = 0.f; sm.l = 0.f; f32x16 o[2]; o[0] = f32x16{}; o[1] = f32x16{};
#pragma unroll
    for (int k = 0; k < 3; ++k) { dma_k(sK0 + k * 8192, KM_, ZBW, qb * 256 + 64 * (3 - k), wid, lane); dma_v(sV0 + k * 8192, VM_, ZBW, qb * 256 + 64 * (3 - k), wid, lane); }
    int tot, seg; moba_tables(BCmbh, lane, tot, seg);
    int before = 0; if (lane < 32) { for (int q = 0; q < qb; ++q) before += BCmbh[q * 32 + lane]; }
    const int base = seg + before;
#pragma unroll 1
    for (int i = 0; i < 4; ++i) {
        const int newer = 3 - i; AT_WAIT_NEWER(newer, 2);
        AT_WAITL(); bar();
        if (i == 0) { dma_k(sK0 + 3 * 8192, KM_, ZBW, qb * 256, wid, lane); dma_v(sV0 + 3 * 8192, VM_, ZBW, qb * 256, wid, lane); }
        const lp sK = sK0 + i * 8192, sV = sV0 + i * 8192;
        const int kt = 3 - i;
        const bool skip = (32 * wid + 31 < 64 * kt);
        if (!skip) {
            const float x0 = c2 * (float)(64 * kt) - sm.m;
            f32x16 p0 = cinit(c2, hi, x0), p1 = cinit(c2, hi, x0 + c2 * 32.f);
            qk_tile(p0, p1, sK, qr, r32, hi);
            if (64 * kt + 63 > 32 * wid) mask_tile(p0, p1, 0, qi - 64 * kt, hi);
            VFrag vf; pv_load(vf, sV, lane, hi);
            softmax_step<true>(p0, p1, sm, o, wsf, r32, hi);
            { AT_PACK(p0, p1); pv_mfma(o, vf, pw0, pw1, pw2, pw3); }
        }
    }
    {
        const float lself = halfsum(sm.l);
        const unsigned s3 = ((const unsigned*)(p.ws + WS_SEL3))[tt * 8 + h], l3 = ((const unsigned*)(p.ws + WS_LRK))[tt * 8 + h];
        const float* PM = (const float*)(p.ws + WS_PM) + (size_t)bh * MB_CAP; const float* PL = (const float*)(p.ws + WS_PL) + (size_t)bh * MB_CAP;
        float mk[3], lk[3]; int pidx[3];
        float M = sm.m + c2 * 256.f * (float)qb;
        const float mself = M;
#pragma unroll
        for (int k = 0; k < 3; ++k) { const int jk = (s3 >> (8 * k)) & 255, lrk = (l3 >> (8 * k)) & 255;
            const int pb = __shfl(base, jk & 31);
            if (jk < 32) { pidx[k] = pb + lrk; mk[k] = PM[pidx[k]] + c2 * 256.f * (float)jk; lk[k] = PL[pidx[k]]; M = __builtin_fmaxf(M, mk[k]); }
            else { pidx[k] = -1; mk[k] = NEGS; lk[k] = 0.f; } }
        const float ws_ = __builtin_amdgcn_exp2f(mself - M);
        float wk[3]; float Lt = lself * ws_;
#pragma unroll
        for (int k = 0; k < 3; ++k) { wk[k] = pidx[k] >= 0 ? __builtin_amdgcn_exp2f(mk[k] - M) : 0.f; Lt += lk[k] * wk[k]; }
        const float inv = Lt > 0.f ? 1.f / Lt : 0.f;
        float* rws = wsf;
        float* rwk = (float*)(lds_raw + L_KMT) + wid * 256;
        int* rpi = (int*)(rwk + 96);
        if (hi == 0) { rws[r32] = ws_ * inv;
#pragma unroll
            for (int k = 0; k < 3; ++k) { rwk[k * 32 + r32] = wk[k] * inv; rpi[k * 32 + r32] = pidx[k]; } }
#pragma unroll
        for (int r = 0; r < 16; ++r) { const int orow = crow(r, hi); ostage[orow * 64 + r32] = o[0][r]; ostage[orow * 64 + 32 + r32] = o[1][r]; }
        wsync();
        const bf16_t* PO = (const bf16_t*)(p.ws + WS_PO) + (size_t)bh * MB_CAP * 64;
        bf16_t* AB = (bf16_t*)(p.ws + WS_ATTB);
#pragma unroll
        for (int i = 0; i < 4; ++i) { const int row = i * 8 + (lane >> 3), c8 = lane & 7;
            const float4 a = *(const float4*)(ostage + row * 64 + c8 * 8), c4 = *(const float4*)(ostage + row * 64 + c8 * 8 + 4);
            const float w0 = rws[row];
            float acc8[8] = {a.x * w0, a.y * w0, a.z * w0, a.w * w0, c4.x * w0, c4.y * w0, c4.z * w0, c4.w * w0};
#pragma unroll
            for (int k = 0; k < 3; ++k) { const int pi = rpi[k * 32 + row]; if (pi >= 0) { const float w = rwk[k * 32 + row]; const uint4 q = *(const uint4*)(PO + (size_t)pi * 64 + c8 * 8);
                const unsigned qq_[4] = {q.x, q.y, q.z, q.w};
#pragma unroll
                for (int e = 0; e < 4; ++e) { acc8[2 * e] += __builtin_bit_cast(float, qq_[e] << 16) * w; acc8[2 * e + 1] += __builtin_bit_cast(float, qq_[e] & 0xffff0000u) * w; } } }
            *(uint4*)(AB + ((size_t)b * S + qb * 256 + 32 * wid + row) * D + 512 + h * 64 + c8 * 8) = make_uint4(pk2(acc8[0], acc8[1]), pk2(acc8[2], acc8[3]), pk2(acc8[4], acc8[5]), pk2(acc8[6], acc8[7])); }
        wsync();
    }
    AT_WAITL(); bar();
}
}

__device__ __forceinline__ void phase_att1(const Params& p, unsigned char* lds_raw) {
    const int tid = otid();
    int* pre = (int*)(lds_raw + at::L_END);
    int* segt = pre + 514;
    { const int* BCm = (const int*)(p.ws + WS_BCM); const int bh = tid >> 5, j = tid & 31; int s = 0;
      for (int q = 0; q < 32; ++q) s += BCm[(size_t)(bh * 32 + q) * 32 + j];
      pre[tid + 1] = (s + 255) >> 8; if (tid == 0) pre[0] = 0;
      segt[tid] = (s + 31) & ~31; }
    __syncthreads();
    for (int sft = 1; sft < 512; sft <<= 1) { int v = 0, w = 0; if (tid >= sft) v = pre[tid + 1 - sft]; if ((tid & 31) >= sft) w = segt[tid - sft]; __syncthreads(); pre[tid + 1] += v; if (sft < 32) segt[tid] += w; __syncthreads(); }
    { const int* BCm = (const int*)(p.ws + WS_BCM); const int bh = tid >> 5, j = tid & 31; int s = 0;
      for (int q = 0; q < 32; ++q) s += BCm[(size_t)(bh * 32 + q) * 32 + j];
      const int excl = segt[tid] - ((s + 31) & ~31); __syncthreads(); segt[tid] = excl; }
    __syncthreads();
    const int nun = pre[512];
    for (int pi = blockIdx.x; pi < 512; pi += gridDim.x) {
        const int rnd = pi >> 8, id = pi & 255;
        const int bg = 2 * rnd + (id >> 7), c = rnd ? 127 - (id & 127) : (id & 127); at::nsa_unit(p, bg >> 1, bg & 1, c, lds_raw);
    }
    {
        const int u0 = (int)(((long)blockIdx.x * nun) / gridDim.x), u1 = (int)(((long)(blockIdx.x + 1) * nun) / gridDim.x);
        int prev = -1;
        for (int u = u0; u < u1; ++u) {
            int lo = 0, hi_ = 511;
            while (lo < hi_) { const int mid = (lo + hi_ + 1) >> 1; if (pre[mid] <= u) lo = mid; else hi_ = mid - 1; }
            at::moba_gather_unit(p, lo >> 5, lo & 31, u - pre[lo], segt[lo], lo != prev, lds_raw);
            prev = lo;
        }
    }
}
__device__ __forceinline__ void phase_att2(const Params& p, unsigned char* lds_raw) {
    for (int pi = blockIdx.x; pi < 512; pi += gridDim.x) {
        const int rnd = pi >> 8, id = pi & 255;
        const int bh = 8 * rnd + (id >> 5), qb = rnd ? 31 - (id & 31) : (id & 31); at::moba_self_unit(p, bh >> 3, bh & 7, qb, lds_raw);
    }
}
__device__ __forceinline__ void phase_route(const Params& p, unsigned char* lds_raw) {
    for (int pi = blockIdx.x; pi < 512; pi += gridDim.x) at::moba_route_unit(p, pi >> 8, (pi >> 5) & 7, pi & 31, lds_raw);
}


__device__ __forceinline__ void phase_r2_fast(const Params& p, int l, unsigned char* lds_raw) {
    using namespace at;
    const int tid = otid(), lane = tid & 63, wave = __builtin_amdgcn_readfirstlane(tid >> 6), r32 = lane & 31, hi = lane >> 5;
    const float* mod = (const float*)(p.ws + WS_MOD);
    const bf16_t* XAB = (const bf16_t*)(p.ws + WS_XAB);
    const float* lng = p.in[5] + (size_t)l * D; const float* rb = p.in[16] + l * NE;
    int* toke = (int*)(p.ws + WS_TOKE); float* tokw = (float*)(p.ws + WS_TOKW); int* BC = (int*)(p.ws + WS_BC);
    const unsigned char* img = p.ws + WS_RWI + (size_t)l * 131072;
    constexpr int PP = 2064;
    unsigned char* pl_hi = lds_raw; unsigned char* pl_lo = lds_raw + 32 * PP;
    int* hist = (int*)(lds_raw + 2 * 32 * PP);
    for (int blk = blockIdx.x; blk < T / 64; blk += gridDim.x) {
        if (tid < 32) hist[tid] = 0;
        const int b = (blk * 64) / S;
        const float* sh = mod + ((size_t)l * Bn + b) * 6144 + 3 * D; const float* sc = mod + ((size_t)l * Bn + b) * 6144 + 4 * D;
        float4 ga[4], s0v[4];
#pragma unroll
        for (int j = 0; j < 4; ++j) { const int col = 4 * lane + 256 * j; const float4 g = *(const float4*)(lng + col), s1 = *(const float4*)(sc + col); s0v[j] = *(const float4*)(sh + col);
            ga[j] = make_float4(g.x * (1.f + s1.x), g.y * (1.f + s1.y), g.z * (1.f + s1.z), g.w * (1.f + s1.w)); }
#pragma unroll 1
        for (int half = 0; half < 2; ++half) {
            const int trow0 = blk * 64 + half * 32;
            {
                uint2 q_[4][4];
#pragma unroll
                for (int i = 0; i < 4; ++i)
#pragma unroll
                    for (int j = 0; j < 4; ++j) q_[i][j] = *(const uint2*)(XAB + (size_t)(trow0 + wave * 4 + i) * D + 4 * lane + 256 * j);
                float ss[4];
#pragma unroll
                for (int i = 0; i < 4; ++i) { float s_ = 0.f;
#pragma unroll
                    for (int j = 0; j < 4; ++j) { const float x0 = __builtin_bit_cast(float, q_[i][j].x << 16), x1 = __builtin_bit_cast(float, q_[i][j].x & 0xffff0000u), x2 = __builtin_bit_cast(float, q_[i][j].y << 16), x3 = __builtin_bit_cast(float, q_[i][j].y & 0xffff0000u);
                        s_ += (x0 * x0 + x1 * x1) + (x2 * x2 + x3 * x3); }
                    ss[i] = s_; }
#pragma unroll
                for (int sft = 32; sft >= 1; sft >>= 1) {
#pragma unroll
                    for (int i = 0; i < 4; ++i) ss[i] += __shfl_xor(ss[i], sft); }
#pragma unroll
                for (int i = 0; i < 4; ++i) {
                    const int rl = wave * 4 + i, t = trow0 + rl;
                    const float r = rsqrtf(ss[i] * (1.f / D) + EPS);
#pragma unroll
                    for (int j = 0; j < 4; ++j) {
                        const int col = 4 * lane + 256 * j;
                        const float x0 = __builtin_bit_cast(float, q_[i][j].x << 16), x1 = __builtin_bit_cast(float, q_[i][j].x & 0xffff0000u), x2 = __builtin_bit_cast(float, q_[i][j].y << 16), x3 = __builtin_bit_cast(float, q_[i][j].y & 0xffff0000u);
                        const float o[4] = {x0 * r * ga[j].x + s0v[j].x, x1 * r * ga[j].y + s0v[j].y, x2 * r * ga[j].z + s0v[j].z, x3 * r * ga[j].w + s0v[j].w};
                        unsigned hh[4], ll[4];
#pragma unroll
                        for (int q = 0; q < 4; ++q) { hh[q] = f2bf(o[q]); ll[q] = f2bf(o[q] - __builtin_bit_cast(float, hh[q] << 16)); }
                        *(uint2*)(pl_hi + rl * PP + col * 2) = make_uint2(hh[0] | (hh[1] << 16), hh[2] | (hh[3] << 16));
                        *(uint2*)(pl_lo + rl * PP + col * 2) = make_uint2(ll[0] | (ll[1] << 16), ll[2] | (ll[3] << 16));
                        *(unsigned*)(p.ws + WS_XN8 + (size_t)t * D + col) = pk_fp8x4(o[0] * XS8, o[1] * XS8, o[2] * XS8, o[3] * XS8);
                    }
                }
            }
            __syncthreads();
            f32x16 acc = f32x16{};
            {
                const AT_LAS unsigned char* xh = (lp)pl_hi + r32 * PP + (128 * wave + 8 * hi) * 2; const AT_LAS unsigned char* xl = (lp)pl_lo + r32 * PP + (128 * wave + 8 * hi) * 2;
                const unsigned char* wh = img + (size_t)((16 * wave + hi) * 32 + r32) * 16; const unsigned char* wl = wh + 65536;
#pragma unroll 1
                for (int k4 = 0; k4 < 8; k4 += 4) {
                    bf16x8 ah[4], al[4];
#pragma unroll
                    for (int ks = 0; ks < 4; ++ks) { ah[ks] = *(const bf16x8*)(wh + (k4 + ks) * 1024); al[ks] = *(const bf16x8*)(wl + (k4 + ks) * 1024); }
#pragma unroll
                    for (int ks = 0; ks < 4; ++ks) {
                        const bf16x8 bh = *(const AT_LAS bf16x8*)(xh + 32 * (k4 + ks)), bl = *(const AT_LAS bf16x8*)(xl + 32 * (k4 + ks));
                        acc = __builtin_amdgcn_mfma_f32_32x32x16_bf16(ah[ks], bh, acc, 0, 0, 0);
                        acc = __builtin_amdgcn_mfma_f32_32x32x16_bf16(al[ks], bh, acc, 0, 0, 0);
                        acc = __builtin_amdgcn_mfma_f32_32x32x16_bf16(ah[ks], bl, acc, 0, 0, 0);
                    }
                }
            }
            __syncthreads();
            { float* part = (float*)lds_raw;
              if (wave >= 1) {
#pragma unroll
                  for (int r = 0; r < 16; ++r) part[(wave * 16 + r) * 64 + lane] = acc[r]; } }
            __syncthreads();
            if (wave == 0) {
                const int t = trow0 + r32;
                { const float* part = (const float*)lds_raw;
#pragma unroll
                  for (int r = 0; r < 16; ++r) { float a = acc[r];
#pragma unroll
                      for (int w = 1; w < 8; ++w) a += part[(w * 16 + r) * 64 + lane];
                      acc[r] = a; } }
                float a0 = -3e38f, a1 = -3e38f, a2 = -3e38f, a3 = -3e38f; int i0 = 99, i1 = 99, i2 = 99, i3 = 99;
#pragma unroll
                for (int r = 0; r < 16; ++r) { const int e = crow(r, hi); const float s_ = acc[r] + rb[e];
                    if (s_ > a0) { a3 = a2; i3 = i2; a2 = a1; i2 = i1; a1 = a0; i1 = i0; a0 = s_; i0 = e; }
                    else if (s_ > a1) { a3 = a2; i3 = i2; a2 = a1; i2 = i1; a1 = s_; i1 = e; }
                    else if (s_ > a2) { a3 = a2; i3 = i2; a2 = s_; i2 = e; }
                    else if (s_ > a3) { a3 = s_; i3 = e; } }
                float ov[4]; int oi[4];
                { const float sv[4] = {a0, a1, a2, a3}; const int si[4] = {i0, i1, i2, i3};
#pragma unroll
                  for (int k = 0; k < 4; ++k) { auto a = __builtin_amdgcn_permlane32_swap(__float_as_uint(sv[k]), __float_as_uint(sv[k]), false, false); ov[k] = __uint_as_float(hi ? a[0] : a[1]);
                                                auto c = __builtin_amdgcn_permlane32_swap((unsigned)si[k], (unsigned)si[k], false, false); oi[k] = (int)(hi ? c[0] : c[1]); } }
#pragma unroll
                for (int k = 0; k < 4; ++k) { const float s_ = ov[k]; const int e = oi[k];
                    if (s_ > a0 || (s_ == a0 && e < i0)) { a3 = a2; i3 = i2; a2 = a1; i2 = i1; a1 = a0; i1 = i0; a0 = s_; i0 = e; }
                    else if (s_ > a1 || (s_ == a1 && e < i1)) { a3 = a2; i3 = i2; a2 = a1; i2 = i1; a1 = s_; i1 = e; }
                    else if (s_ > a2 || (s_ == a2 && e < i2)) { a3 = a2; i3 = i2; a2 = s_; i2 = e; }
                    else if (s_ > a3 || (s_ == a3 && e < i3)) { a3 = s_; i3 = e; } }
                const float e1 = __expf(a1 - a0), e2 = __expf(a2 - a0), e3 = __expf(a3 - a0), inv = 1.f / (((1.f + e1) + e2) + e3);
                if (hi == 0) {
                    *(int4*)(toke + (size_t)t * 4) = make_int4(i0, i1, i2, i3);
                    *(float4*)(tokw + (size_t)t * 4) = make_float4(inv, e1 * inv, e2 * inv, e3 * inv);
                    atomicAdd(&hist[i0], 1); atomicAdd(&hist[i1], 1); atomicAdd(&hist[i2], 1); atomicAdd(&hist[i3], 1);
                }
            }
            __syncthreads();
        }
        if (tid < 32) BC[blk * 32 + tid] = hist[tid];
        __syncthreads();
    }
}
__device__ __forceinline__ void phase_sc_fast(const Params& p, int l, unsigned char* lds_raw) {
    const int tid = otid();
    const int* BC = (const int*)(p.ws + WS_BC);
    int* cnt = (int*)(p.ws + WS_CNT) + l * 32;
    int* tot = (int*)lds_raw; int* base = tot + 32; int* fillc = tot + 64; int* before = tot + 96;
    const int* toke = (const int*)(p.ws + WS_TOKE); const float* tokw = (const float*)(p.ws + WS_TOKW);
    int* rowtok = (int*)(p.ws + WS_ROWTOK) + (size_t)l * RMAX; float* roww = (float*)(p.ws + WS_ROWW) + (size_t)l * RMAX; int* pos = (int*)(p.ws + WS_POS);
    for (int blk = blockIdx.x; blk < T / 64; blk += gridDim.x) {
        { const int e = tid & 31, part = tid >> 5; int s = 0, bf = 0;
#pragma unroll 4
          for (int i = part * 16; i < part * 16 + 16; ++i) { const int c = BC[i * 32 + e]; s += c; if (i < blk) bf += c; }
          int* ptot = tot + 128; int* pbef = ptot + 512;
          ptot[tid] = s; pbef[tid] = bf; }
        __syncthreads();
        if (tid < 32) { const int* ptot = tot + 128; const int* pbef = ptot + 512; int s = 0, bf = 0;
#pragma unroll
            for (int q = 0; q < 16; ++q) { s += ptot[q * 32 + tid]; bf += pbef[q * 32 + tid]; }
            tot[tid] = s; before[tid] = bf; fillc[tid] = 0; if (blk == 0) cnt[tid] = s; }
        __syncthreads();
        if (tid == 0) { int s = 0; for (int e = 0; e < 32; ++e) { base[e] = s + before[e]; s += (tot[e] + 255) & ~255; } }
        __syncthreads();
        if (tid < 256) {
            const int i = blk * 256 + tid, e = toke[i];
            const int slot = base[e] + atomicAdd(&fillc[e], 1);
            rowtok[slot] = i >> 2; roww[slot] = tokw[i]; pos[i] = slot;
        }
        __syncthreads();
    }
}

#define XB_TMO      128
#define XB_XCNT(j)  (256  + 64 * (j))
#define XB_XSUB(j)  (1280 + 64 * (j))
#define XB_XGEN(j)  (2304 + 64 * (j))
#define XB_TOP      3328
#define XB_TOPGEN   3392
#define XCD_BAR_WORDS 3456
#define XB_SPIN_CAP (1u << 18)
#define XLAS __attribute__((address_space(3)))
__device__ __forceinline__ unsigned xb_ld(unsigned* p)              { return __hip_atomic_load(p, __ATOMIC_RELAXED, __HIP_MEMORY_SCOPE_AGENT); }
__device__ __forceinline__ unsigned xb_add(unsigned* p, unsigned v) { return __hip_atomic_fetch_add(p, v, __ATOMIC_RELAXED, __HIP_MEMORY_SCOPE_AGENT); }
__device__ __forceinline__ unsigned xb_xcc_id() { return (unsigned)__builtin_amdgcn_s_getreg((3 << 11) | 20) & 0xFu; }
#define XB_SPIN(cond, bar) do { unsigned _sp = 0; while (cond) { __builtin_amdgcn_s_sleep(1); \
    if ((++_sp & 255u) == 0u) { if (xb_ld(&(bar)[XB_TMO])) break; if (_sp > XB_SPIN_CAP) { atomicAdd(&(bar)[XB_TMO], 1u); break; } } } } while (0)
constexpr int LDS_BARST_OFF = 147200;
struct XcdBarrier { unsigned* bar; unsigned x; volatile XLAS unsigned* st; };
__device__ __forceinline__ XcdBarrier xcd_barrier_post(unsigned* bar, volatile XLAS unsigned* st) {
    XcdBarrier b; b.bar = bar; b.x = xb_xcc_id(); b.st = st;
    if (threadIdx.x == 0) (void)xb_add(&bar[XB_XCNT(b.x)], 1u);
    return b;
}
__device__ __forceinline__ void xcd_barrier_complete(unsigned* bar, unsigned x, unsigned& nloc, unsigned& nx) {
    const unsigned G = gridDim.x * gridDim.y * gridDim.z;
    unsigned sum, cnt, mine, sp = 0u;
    for (;;) {
        sum = 0u; cnt = 0u; mine = 0u;
#pragma unroll
        for (unsigned j = 0; j < 16; ++j) { const unsigned c = xb_ld(&bar[XB_XCNT(j)]); sum += c; cnt += (c > 0u) ? 1u : 0u; mine = (j == x) ? c : mine; }
        if (sum == G) break;
        __builtin_amdgcn_s_sleep(1);
        if ((++sp & 255u) == 0u) { if (xb_ld(&bar[XB_TMO])) break; if (sp > XB_SPIN_CAP) { atomicAdd(&bar[XB_TMO], 1u); break; } }
    }
    nloc = mine > 0u ? mine : 1u; nx = cnt > 0u ? cnt : 1u;
}
__device__ __forceinline__ void xcd_barrier(unsigned char* ws, unsigned char* lds_raw_) {
    XcdBarrier b; b.bar = (unsigned*)(ws + WS_BAR); b.x = xb_xcc_id(); b.st = (volatile XLAS unsigned*)((XLAS unsigned char*)lds_raw_ + LDS_BARST_OFF);
    asm volatile("s_waitcnt vmcnt(0)" ::: "memory");
    __syncthreads();
    if (threadIdx.x == 0) {
        unsigned* bar = b.bar;
        __builtin_amdgcn_s_waitcnt(0);
        unsigned nloc = b.st[0], nx = b.st[1];
        if (nloc == 0u) { xcd_barrier_complete(bar, b.x, nloc, nx); b.st[0] = nloc; b.st[1] = nx; }
        const unsigned old = xb_add(&bar[XB_XSUB(b.x)], 1u);
        const unsigned gen = old / nloc;
        if (old + 1u == (gen + 1u) * nloc) {
            __builtin_amdgcn_fence(__ATOMIC_RELEASE, "agent");
            asm volatile("s_waitcnt vmcnt(0)" ::: "memory");
            const unsigned og = xb_add(&bar[XB_TOP], 1u);
            const unsigned tg = og / nx;
            if (og + 1u == (tg + 1u) * nx) xb_add(&bar[XB_TOPGEN], 1u);
            else XB_SPIN(xb_ld(&bar[XB_TOPGEN]) == tg, bar);
            __builtin_amdgcn_fence(__ATOMIC_ACQUIRE, "agent");
            xb_add(&bar[XB_XGEN(b.x)], 1u);
            asm volatile("s_waitcnt vmcnt(0)" ::: "memory");
        } else {
            XB_SPIN(xb_ld(&bar[XB_XGEN(b.x)]) == gen, bar);
            __builtin_amdgcn_fence(__ATOMIC_ACQUIRE, "agent");
            asm volatile("s_waitcnt vmcnt(0)" ::: "memory");
        }
    }
    __syncthreads();
}

__global__ void __launch_bounds__(NT, 2) mega_fwd(Params p) {
    extern __shared__ __attribute__((aligned(16))) unsigned char lds_raw[];
    float* lds = (float*)lds_raw;
    volatile XLAS unsigned* bst = (volatile XLAS unsigned*)((XLAS unsigned char*)lds_raw + LDS_BARST_OFF);
    if (threadIdx.x < 2) bst[threadIdx.x] = 0u;
    __syncthreads();
    (void)xcd_barrier_post((unsigned*)(p.ws + WS_BAR), bst);
#define GSYNC() xcd_barrier(p.ws, lds_raw)
    phase_p0a(p, lds);
    __syncthreads();
    phase_convert(p, lds);
    GSYNC();
    phase_p0b(p);
    GSYNC();
    _Pragma("unroll 1") for (int l = 0; l < L; ++l) {
        phase_r1(p, l, true);
        GSYNC();
        phase_g1_fast(p, l, lds_raw);
        GSYNC();
        phase_ck_fast(p, l, lds_raw);
        GSYNC();
        phase_c2(p, l, lds);
        __syncthreads();
        phase_route(p, lds_raw);
        GSYNC();
        phase_att1(p, lds_raw);
        GSYNC();
        phase_att2(p, lds_raw);
        GSYNC();
        phase_g2_fast(p, l, lds_raw);
        GSYNC();
        phase_r2_fast(p, l, lds_raw);
        GSYNC();
        phase_sc_fast(p, l, lds_raw);
        GSYNC();
        phase_m1_fast(p, l, lds_raw);
        GSYNC();
        phase_m2_fast(p, l, lds_raw);
        GSYNC();
    }
    phase_r1(p, L, false);
}

extern "C" void kernel_launch(void* const* d_in, const int* in_sizes, int n_in, void* d_out, int out_size, void* d_ws, size_t ws_size, hipStream_t stream) {
    static int grid_blocks = 0;
    if (grid_blocks == 0) {
        if (n_in != 21 || out_size != T * D || ws_size < WS_END) { fprintf(stderr, "kernel_launch: unexpected shapes (n_in %d out %d ws %zu need %zu)\n", n_in, out_size, ws_size, (size_t)WS_END); grid_blocks = -1; return; }
        int dev = 0, cus = 0, per_cu = 0;
        hipGetDevice(&dev);
        hipDeviceGetAttribute(&cus, hipDeviceAttributeMultiprocessorCount, dev);
        hipFuncSetAttribute((const void*)mega_fwd, hipFuncAttributeMaxDynamicSharedMemorySize, LDS_BYTES);
        hipOccupancyMaxActiveBlocksPerMultiprocessor(&per_cu, (const void*)mega_fwd, NT, LDS_BYTES);
        if (per_cu < 1) { fprintf(stderr, "kernel_launch: occupancy query says %d blocks per CU\n", per_cu); per_cu = 1; }
        (void)hipGetLastError();
        grid_blocks = cus * 1;
    }
    if (grid_blocks < 0) return;
    if (hipMemsetAsync((char*)d_ws + WS_BAR, 0, 16384, stream) != hipSuccess) { fprintf(stderr, "kernel_launch: memset failed\n"); return; }
    Params p{};
    for (int i = 0; i < 21; ++i) p.in[i] = (const float*)d_in[i];
    p.out = (float*)d_out; p.ws = (unsigned char*)d_ws;
    hipLaunchKernelGGL(mega_fwd, dim3(grid_blocks), dim3(NT), LDS_BYTES, stream, p);
    hipError_t e = hipPeekAtLastError();
    if (e != hipSuccess) fprintf(stderr, "launch failed: %s (grid %d)\n", hipGetErrorString(e), grid_blocks);
}
```

```cpp
#include <hip/hip_runtime.h>
#include <cstdio>
#include <cstdint>

constexpr int Bn = 2, S = 8192, D = 1024, L = 2, T = Bn * S;
constexpr int INW = 2840;
constexpr int NE = 32, TOPK = 4, DFF = 1024;
constexpr int A_TOT = T * TOPK;
constexpr int RMAX = A_TOT + NE * 256;
constexpr int NCMP = 511;
constexpr int NT = 512;
constexpr int NW = NT / 64;
constexpr int LDS_BYTES = 147456;
constexpr float EPS = 1e-6f;
constexpr float NEGF = -1e30f;

constexpr int ZBW = 3072;
constexpr int ZB_Q = 0, ZB_KC = 512, ZB_VC = 640, ZB_KS = 768, ZB_VS = 896, ZB_KW = 1024, ZB_VW = 1152, ZB_MQ = 1280, ZB_MK = 1792, ZB_MV = 2304, ZB_G = 2816;
constexpr float QSCALE = 0.125f * 1.4426950408889634f;
constexpr float LOG2E = 1.4426950408889634f;

constexpr size_t al256(size_t x) { return (x + 255) & ~(size_t)255; }
constexpr size_t WS_BAR = 0;
constexpr size_t WS_MODP = 16384;
constexpr size_t WS_MOD = al256(WS_MODP + (size_t)8 * L * Bn * 6144 * 4);
constexpr size_t WS_CNT = al256(WS_MOD + (size_t)L * Bn * 6144 * 4);
constexpr size_t WS_ROWTOK = al256(WS_CNT + L * 32 * 4);
constexpr size_t WS_ROWW = al256(WS_ROWTOK + (size_t)L * RMAX * 4);
constexpr size_t WS_TOKE = al256(WS_ROWW + (size_t)L * RMAX * 4);
constexpr size_t WS_TOKW = al256(WS_TOKE + (size_t)T * 4 * 4);
constexpr size_t WS_POS = al256(WS_TOKW + (size_t)T * 4 * 4);
constexpr size_t WS_Y = al256(WS_POS + (size_t)T * 4 * 4);
constexpr size_t WS_WINT = al256(WS_Y + (size_t)RMAX * 1024 * 4);
constexpr size_t WS_WOT = al256(WS_WINT + (size_t)L * 3072 * 1024 * 2);
constexpr size_t WS_W1T = al256(WS_WOT + (size_t)L * 1024 * 1024 * 2);
constexpr size_t WS_W2T = al256(WS_W1T + (size_t)L * NE * 2048 * 1024 * 2);
constexpr size_t WS_XN = al256(WS_W2T + (size_t)L * NE * 1024 * 1024 * 2);
constexpr size_t WS_ATTB = al256(WS_XN + (size_t)(T + 1) * D * 2);
constexpr size_t WS_ACT = al256(WS_ATTB + (size_t)T * D * 2);
constexpr size_t WS_ZB = al256(WS_ACT + (size_t)RMAX * DFF * 2);
constexpr size_t WS_GATE = al256(WS_ZB + (size_t)T * ZBW * 2);
constexpr size_t WS_KCB = al256(WS_GATE + (size_t)T * 32 * 4);
constexpr size_t WS_VCB = al256(WS_KCB + (size_t)Bn * 2 * 512 * 64 * 2);
constexpr size_t WS_KMB = al256(WS_VCB + (size_t)Bn * 2 * 512 * 64 * 2);
constexpr size_t WS_XNLO = al256(WS_KMB + (size_t)Bn * 8 * 32 * 64 * 2);
constexpr size_t WS_BC = al256(WS_XNLO + (size_t)T * D * 2);
constexpr size_t WS_WCT = al256(WS_BC + (size_t)(T / 64) * 32 * 4);
constexpr size_t WS_CBP = al256(WS_WCT + (size_t)L * 2 * 128 * 2048 * 2);
constexpr size_t WS_CB = al256(WS_CBP + (size_t)16 * L * 2 * 128 * 4);
constexpr size_t WS_HIDP = al256(WS_CB + (size_t)L * 2 * 128 * 4);
constexpr size_t WS_XAB = al256(WS_HIDP + (size_t)4 * 2 * 2044 * 128 * 4);
constexpr size_t WS_SEL3 = al256(WS_XAB + (size_t)T * D * 2);
constexpr size_t WS_LRK = al256(WS_SEL3 + (size_t)T * 8 * 4);
constexpr size_t WS_ILIST = al256(WS_LRK + (size_t)T * 8 * 4);
constexpr size_t WS_BCM = al256(WS_ILIST + (size_t)16 * 32 * 32 * 256);
constexpr size_t WS_PM = al256(WS_BCM + (size_t)16 * 32 * 32 * 4);
constexpr size_t WS_PL = al256(WS_PM + (size_t)16 * 25600 * 4);
constexpr size_t WS_PO = al256(WS_PL + (size_t)16 * 25600 * 4);
constexpr size_t WS_XN8 = al256(WS_PO + (size_t)16 * 25600 * 64 * 2);
constexpr size_t WS_DQ1 = al256(WS_XN8 + (size_t)(T + 1) * D);
constexpr size_t WS_DQ2 = al256(WS_DQ1 + (size_t)L * NE * 2048 * 4);
constexpr size_t WS_RWI = al256(WS_DQ2 + (size_t)L * NE * 1024 * 4);
constexpr size_t WS_END = al256(WS_RWI + (size_t)L * 131072);
constexpr float XS8 = 16.f, AS8 = 8.f, YS8 = 16.f;

struct Params {
    const float* in[21];
    float* out;
    unsigned char* ws;
};

__device__ __forceinline__ int otid() { int t = threadIdx.x; asm volatile("" : "+v"(t)); return t; }
typedef unsigned short bf16_t;
__device__ __forceinline__ unsigned f2bf(float f) { unsigned u = __builtin_bit_cast(unsigned, f); return (u + 0x7fffu + ((u >> 16) & 1u)) >> 16; }
__device__ __forceinline__ unsigned pk2(float lo, float hi) { return f2bf(lo) | (f2bf(hi) << 16); }
typedef float f32x2v __attribute__((ext_vector_type(2)));
__device__ __forceinline__ float4 f84(unsigned q) {
    const f32x2v lo = __builtin_amdgcn_cvt_pk_f32_fp8((int)q, false), hi = __builtin_amdgcn_cvt_pk_f32_fp8((int)q, true);
    return make_float4(lo[0] * (1.f / 16.f), lo[1] * (1.f / 16.f), hi[0] * (1.f / 16.f), hi[1] * (1.f / 16.f)); }
__device__ __forceinline__ unsigned pk_fp8x4(float a, float b, float c, float d) {
    a = __builtin_amdgcn_fmed3f(a, -448.f, 448.f); b = __builtin_amdgcn_fmed3f(b, -448.f, 448.f); c = __builtin_amdgcn_fmed3f(c, -448.f, 448.f); d = __builtin_amdgcn_fmed3f(d, -448.f, 448.f);
    int r = __builtin_amdgcn_cvt_pk_fp8_f32(a, b, 0, false);
    r = __builtin_amdgcn_cvt_pk_fp8_f32(c, d, r, true);
    return (unsigned)r; }
__device__ __forceinline__ float bf2f(bf16_t v) { return __builtin_bit_cast(float, (unsigned)v << 16); }
__device__ __forceinline__ float wave_sum(float v) {
#pragma unroll
    for (int o = 1; o < 64; o <<= 1) v += __shfl_xor(v, o);
    return v;
}
__device__ __forceinline__ float sigmoidf_(float x) { return 1.f / (1.f + __expf(-x)); }
__device__ __forceinline__ float gelu_tanh(float x) {
    const float u = 0.7978845608028654f * (x + 0.044715f * x * x * x);
    return 0.5f * x * (1.f + tanhf(u));
}

__device__ __forceinline__ void phase_p0a(const Params& p, float* lds) {
    const int tid = otid(), gtid = blockIdx.x * NT + tid, gsz = gridDim.x * NT;
    int* cnt = (int*)(p.ws + WS_CNT); int* rowtok = (int*)(p.ws + WS_ROWTOK);
    for (int i = gtid; i < L * 32; i += gsz) cnt[i] = 0;
    for (int i = gtid; i < L * RMAX; i += gsz) rowtok[i] = -1;
    const float* c = p.in[1];
    for (int i = tid; i < Bn * D; i += NT) { const float v = c[i]; lds[i] = v / (1.f + __expf(-v)); }
    __syncthreads();
    const float* ada_w = p.in[2];
    float* modp = (float*)(p.ws + WS_MODP);
    for (int idx = gtid; idx < 8 * L * 6144; idx += gsz) {
        const int col = idx % 6144, l = (idx / 6144) % L, kc = idx / (6144 * L);
        const float* w = ada_w + ((size_t)l * D + kc * 128) * 6144 + col;
        float a0 = 0.f, a1 = 0.f, c0 = 0.f, c1 = 0.f;
#pragma unroll 1
        for (int k0 = 0; k0 < 128; k0 += 32) { float wv[32];
#pragma unroll
            for (int k = 0; k < 32; ++k) wv[k] = __builtin_nontemporal_load(w + (size_t)(k0 + k) * 6144);
#pragma unroll
            for (int k = 0; k < 32; k += 2) { a0 += lds[kc * 128 + k0 + k] * wv[k]; a1 += lds[D + kc * 128 + k0 + k] * wv[k]; c0 += lds[kc * 128 + k0 + k + 1] * wv[k + 1]; c1 += lds[D + kc * 128 + k0 + k + 1] * wv[k + 1]; } }
        modp[((size_t)(kc * L + l) * Bn + 0) * 6144 + col] = a0 + c0;
        modp[((size_t)(kc * L + l) * Bn + 1) * 6144 + col] = a1 + c1;
    }
    { const float* posw = p.in[9]; const float* w1c = p.in[10]; float* cbp = (float*)(p.ws + WS_CBP);
      int first = 8 * L * 6144; if (first + 16 * L * 2 * 128 > gsz) first = 0;
      for (int idx = gtid - first; idx < 16 * L * 2 * 128; idx += gsz) { if (idx < 0) continue;
          const int j = idx & 127, li = (idx >> 7) % (L * 2), kc = idx / (L * 2 * 128);
          const float* w = w1c + ((size_t)li * 2048 + kc * 128) * 128 + j; const float* pp = posw + (size_t)li * 2048 + kc * 128;
          float a = 0.f, c_ = 0.f;
#pragma unroll 1
          for (int k0 = 0; k0 < 128; k0 += 32) { float wv[32];
#pragma unroll
              for (int k = 0; k < 32; ++k) wv[k] = w[(size_t)(k0 + k) * 128];
#pragma unroll
              for (int k = 0; k < 32; k += 2) { a += pp[k0 + k] * wv[k]; c_ += pp[k0 + k + 1] * wv[k + 1]; } }
          cbp[idx] = a + c_; } }
}
__device__ __forceinline__ void phase_p0b(const Params& p) {
    const int gtid = blockIdx.x * NT + otid(), gsz = gridDim.x * NT;
    { const float* cbp = (const float*)(p.ws + WS_CBP); float* cb = (float*)(p.ws + WS_CB);
      for (int idx = gtid; idx < L * 2 * 128; idx += gsz) { float s = 0.f;
#pragma unroll
          for (int kc = 0; kc < 16; ++kc) s += cbp[kc * (L * 2 * 128) + idx];
          cb[idx] = s; } }
    const float* modp = (const float*)(p.ws + WS_MODP); float* mod = (float*)(p.ws + WS_MOD); const float* ada_b = p.in[3];
    for (int idx = gtid; idx < L * Bn * 6144; idx += gsz) {
        const int col = idx % 6144, l = idx / (Bn * 6144);
        float s = ada_b[l * 6144 + col];
#pragma unroll
        for (int kc = 0; kc < 8; ++kc) s += modp[(size_t)kc * L * Bn * 6144 + idx];
        mod[idx] = s;
    }
}

__device__ __forceinline__ void phase_r1(const Params& p, int l, bool do_h) {
    const int lane = otid() & 63, wave = otid() >> 6;
    const int gw = blockIdx.x * NW + wave, ngw = gridDim.x * NW;
    const float* mod = (const float*)(p.ws + WS_MOD);
    const float* xin = p.in[0]; float* XA = p.out;
    const unsigned char* Y8 = p.ws + WS_Y; const int* pos = (const int*)(p.ws + WS_POS); const float* tokw = (const float*)(p.ws + WS_TOKW);
    const float* lng = p.in[4] + (size_t)(do_h ? l : 0) * D;
    bf16_t* XN = (bf16_t*)(p.ws + WS_XN); bf16_t* XAB = (bf16_t*)(p.ws + WS_XAB);
#define BF4(q) make_float4(__builtin_bit_cast(float, (q).x << 16), __builtin_bit_cast(float, (q).x & 0xffff0000u), __builtin_bit_cast(float, (q).y << 16), __builtin_bit_cast(float, (q).y & 0xffff0000u))
#define F84(q) f84((q))
    int curb = -1; float4 g2v[4], ga[4], s0v[4];
    for (int t0 = gw; t0 < T; t0 += ngw) {
        const int nr = 1;
        float4 v[2][4];
        if (l == 0) {
#pragma unroll
            for (int i = 0; i < 2; ++i) if (i < nr) {
#pragma unroll
                for (int j = 0; j < 4; ++j) v[i][j] = *(const float4*)(xin + (size_t)(t0 + i * ngw) * D + 4 * lane + 256 * j); }
        } else {
            int4 ps[2]; float4 tw[2]; uint2 xq[2][4];
#pragma unroll
            for (int i = 0; i < 2; ++i) if (i < nr) { const int t = t0 + i * ngw; ps[i] = *(const int4*)(pos + (size_t)t * 4); tw[i] = *(const float4*)(tokw + (size_t)t * 4);
#pragma unroll
                for (int j = 0; j < 4; ++j) xq[i][j] = *(const uint2*)(XAB + (size_t)t * D + 4 * lane + 256 * j); }
            unsigned yq[2][4][4];
#pragma unroll
            for (int i = 0; i < 2; ++i) if (i < nr) {
#pragma unroll
                for (int j = 0; j < 4; ++j) { const int col = 4 * lane + 256 * j;
                    yq[i][j][0] = *(const unsigned*)(Y8 + (size_t)ps[i].x * D + col); yq[i][j][1] = *(const unsigned*)(Y8 + (size_t)ps[i].y * D + col);
                    yq[i][j][2] = *(const unsigned*)(Y8 + (size_t)ps[i].z * D + col); yq[i][j][3] = *(const unsigned*)(Y8 + (size_t)ps[i].w * D + col); } }
#pragma unroll
            for (int i = 0; i < 2; ++i) if (i < nr) {
                const int t = t0 + i * ngw, b = t / S;
                if (b != curb) { curb = b;
                    const float* g2 = mod + ((size_t)(l - 1) * Bn + b) * 6144 + 5 * D;
#pragma unroll
                    for (int j = 0; j < 4; ++j) g2v[j] = *(const float4*)(g2 + 4 * lane + 256 * j);
                    if (do_h) { const float* sh = mod + ((size_t)l * Bn + b) * 6144 + 0 * D; const float* sc = mod + ((size_t)l * Bn + b) * 6144 + 1 * D;
#pragma unroll
                        for (int j = 0; j < 4; ++j) { const int col = 4 * lane + 256 * j; const float4 g = *(const float4*)(lng + col), s1 = *(const float4*)(sc + col); s0v[j] = *(const float4*)(sh + col);
                            ga[j] = make_float4(g.x * (1.f + s1.x), g.y * (1.f + s1.y), g.z * (1.f + s1.z), g.w * (1.f + s1.w)); } } }
#pragma unroll
                for (int j = 0; j < 4; ++j) {
                    const int col = 4 * lane + 256 * j;
                    const float4 x = BF4(xq[i][j]);
                    const float4 y0 = F84(yq[i][j][0]), y1 = F84(yq[i][j][1]), y2 = F84(yq[i][j][2]), y3 = F84(yq[i][j][3]);
                    const float4 g = g2v[j];
                    float4 r;
                    r.x = x.x + g.x * (((tw[i].x * y0.x + tw[i].y * y1.x) + tw[i].z * y2.x) + tw[i].w * y3.x); r.y = x.y + g.y * (((tw[i].x * y0.y + tw[i].y * y1.y) + tw[i].z * y2.y) + tw[i].w * y3.y);
                    r.z = x.z + g.z * (((tw[i].x * y0.z + tw[i].y * y1.z) + tw[i].z * y2.z) + tw[i].w * y3.z); r.w = x.w + g.w * (((tw[i].x * y0.w + tw[i].y * y1.w) + tw[i].z * y2.w) + tw[i].w * y3.w);
                    v[i][j] = r;
                    if (do_h) *(uint2*)(XAB + (size_t)t * D + col) = make_uint2(pk2(r.x, r.y), pk2(r.z, r.w));
                    else *(float4*)(XA + (size_t)t * D + col) = r;
                }
            }
        }
        if (do_h) {
#pragma unroll
            for (int i = 0; i < 2; ++i) if (i < nr) {
                const int t = t0 + i * ngw, b = t / S;
                if (b != curb) { curb = b;
                    const float* sh = mod + ((size_t)l * Bn + b) * 6144 + 0 * D; const float* sc = mod + ((size_t)l * Bn + b) * 6144 + 1 * D;
#pragma unroll
                    for (int j = 0; j < 4; ++j) { const int col = 4 * lane + 256 * j; const float4 g = *(const float4*)(lng + col), s1 = *(const float4*)(sc + col); s0v[j] = *(const float4*)(sh + col);
                        ga[j] = make_float4(g.x * (1.f + s1.x), g.y * (1.f + s1.y), g.z * (1.f + s1.z), g.w * (1.f + s1.w)); } }
                float ss = 0.f;
#pragma unroll
                for (int j = 0; j < 4; ++j) ss += (v[i][j].x * v[i][j].x + v[i][j].y * v[i][j].y) + (v[i][j].z * v[i][j].z + v[i][j].w * v[i][j].w);
                ss = wave_sum(ss);
                const float r = rsqrtf(ss * (1.f / D) + EPS);
#pragma unroll
                for (int j = 0; j < 4; ++j) {
                    const int col = 4 * lane + 256 * j;
                    float4 o;
                    o.x = v[i][j].x * r * ga[j].x + s0v[j].x; o.y = v[i][j].y * r * ga[j].y + s0v[j].y;
                    o.z = v[i][j].z * r * ga[j].z + s0v[j].z; o.w = v[i][j].w * r * ga[j].w + s0v[j].w;
                    *(uint2*)(XN + (size_t)t * D + col) = make_uint2(pk2(o.x, o.y), pk2(o.z, o.w));
                }
            }
        }
    }
#undef BF4
}


__device__ __forceinline__ void phase_c2(const Params& p, int l, float* lds) {
    const int lane = otid() & 63, wave = otid() >> 6;
    const float* HIDP = (const float*)(p.ws + WS_HIDP); const float* cb = (const float*)(p.ws + WS_CB) + l * 2 * 128; const float* w2 = p.in[11] + (size_t)l * 2 * 128 * 64;
    const float gk = p.in[8][l * 64 + lane];
    float* hl = lds + wave * 128;
    for (int r = blockIdx.x * NW + wave; r < 2 * 2044; r += gridDim.x * NW) {
        const int idx = r / 2044, rr = r % 2044;
#pragma unroll
        for (int q = 0; q < 2; ++q) { const int j = lane + 64 * q; float s = cb[idx * 128 + j];
#pragma unroll
            for (int kq = 0; kq < 4; ++kq) s += HIDP[((size_t)(kq * 2 + idx) * 2044 + rr) * 128 + j];
            hl[j] = gelu_tanh(s); }
        asm volatile("s_waitcnt lgkmcnt(0)" ::: "memory"); __builtin_amdgcn_wave_barrier();
        const float* W = w2 + (size_t)idx * 128 * 64;
        float s = 0.f;
#pragma unroll 8
        for (int j = 0; j < 128; ++j) s += hl[j] * W[j * 64 + lane];
        asm volatile("s_waitcnt lgkmcnt(0)" ::: "memory"); __builtin_amdgcn_wave_barrier();
        const int bgi = rr / 511, n = rr % 511;
        if (idx == 0) { const float ss = wave_sum(s * s); const float kv = s * rsqrtf(ss * (1.f / 64.f) + EPS) * gk; ((bf16_t*)(p.ws + WS_KCB))[((size_t)bgi * 512 + n) * 64 + lane] = (bf16_t)f2bf(kv); }
        else { ((bf16_t*)(p.ws + WS_VCB))[((size_t)bgi * 512 + n) * 64 + lane] = (bf16_t)f2bf(s); }
    }
    if (blockIdx.x == 0 && otid() < 2 * 4 * 64) { const int i = otid(); bf16_t* dst = (bf16_t*)(p.ws + (i < 256 ? WS_KCB : WS_VCB)); dst[((size_t)((i & 255) >> 6) * 512 + 511) * 64 + (i & 63)] = 0; }
}

__device__ __forceinline__ void load_pstart(const Params& p, int l, int* ps) {
    const int* cnt = (const int*)(p.ws + WS_CNT) + l * 32;
    if (otid() == 0) { int s = 0; for (int e = 0; e < 32; ++e) { ps[e] = s; s += (cnt[e] + 255) & ~255; } ps[32] = s; }
    __syncthreads();
}


template <int MAP>
__device__ __forceinline__ void tr_tile(const float* W, int Nsrc, bf16_t* WT, int K, int k0, int n0, float* scr, int lane) {
    const int nl = (lane & 15) * 4, kr = lane >> 4;
    int sc = n0 + nl;
    if (MAP == 1) { sc = sc < 1280 ? sc : (sc < 2816 ? sc + 24 : (sc < 2840 ? sc - 2816 + 1280 : -1)); }
    float4 v[16];
#pragma unroll
    for (int it = 0; it < 16; ++it) { if (sc >= 0) { const float* src_ = W + (size_t)(k0 + it * 4 + kr) * Nsrc + sc; typedef float f4v __attribute__((ext_vector_type(4))); const f4v t_ = __builtin_nontemporal_load((const f4v*)src_); v[it] = make_float4(t_[0], t_[1], t_[2], t_[3]); } else v[it] = make_float4(0.f, 0.f, 0.f, 0.f); }
#pragma unroll
    for (int it = 0; it < 16; ++it) { float* s = scr + (it * 4 + kr) * 65 + nl; s[0] = v[it].x; s[1] = v[it].y; s[2] = v[it].z; s[3] = v[it].w; }
    asm volatile("s_waitcnt lgkmcnt(0)" ::: "memory"); __builtin_amdgcn_wave_barrier();
    const int c = lane & 7, nr = lane >> 3;
#pragma unroll
    for (int it = 0; it < 8; ++it) {
        const int n = it * 8 + nr; const float* s = scr + (8 * c) * 65 + n;
        uint4 o; o.x = pk2(s[0], s[65]); o.y = pk2(s[2 * 65], s[3 * 65]); o.z = pk2(s[4 * 65], s[5 * 65]); o.w = pk2(s[6 * 65], s[7 * 65]);
        *(uint4*)(WT + (size_t)(n0 + n) * K + k0 + 8 * c) = o;
    }
    asm volatile("s_waitcnt lgkmcnt(0)" ::: "memory"); __builtin_amdgcn_wave_barrier();
}
__device__ __forceinline__ void phase_convert(const Params& p, float* lds) {
    const int tid = otid(), lane = tid & 63, wave = tid >> 6;
    float* scr = lds + wave * (64 * 65);
    const int gw = blockIdx.x * NW + wave, ngw = gridDim.x * NW;
    bf16_t* WinT = (bf16_t*)(p.ws + WS_WINT); bf16_t* WoT = (bf16_t*)(p.ws + WS_WOT);
    constexpr int I_IN = L * 16 * (ZBW / 64), I_O = L * 16 * 16, I_C = L * 2 * 32 * 2;
    { float* cm = lds + NW * (64 * 65);
      constexpr int S1 = L * NE * 32, S2 = L * NE * 16;
      for (int s = blockIdx.x; s < S1 + S2; s += gridDim.x) {
          const bool is1 = s < S1; const int q = is1 ? s : s - S1;
          const int le = is1 ? (q >> 5) : (q >> 4), nb = is1 ? (q & 31) : (q & 15), Nsrc = is1 ? 2048 : 1024;
          const float* W = (is1 ? p.in[17] : p.in[19]) + (size_t)le * 1024 * Nsrc;
          unsigned char* WT8 = p.ws + (is1 ? WS_W1T : WS_W2T) + (size_t)le * Nsrc * 1024;
          float* DQ = (float*)(p.ws + (is1 ? WS_DQ1 : WS_DQ2)) + (size_t)le * Nsrc;
          const int n0 = nb * 64, nl = (lane & 15) * 4, kr = lane >> 4, k0 = wave * 128;
          typedef float f4v __attribute__((ext_vector_type(4)));
          f4v va[16], vb[16];
#pragma unroll
          for (int it = 0; it < 16; ++it) { va[it] = __builtin_nontemporal_load((const f4v*)(W + (size_t)(k0 + it * 4 + kr) * Nsrc + n0 + nl));
                                            vb[it] = __builtin_nontemporal_load((const f4v*)(W + (size_t)(k0 + 64 + it * 4 + kr) * Nsrc + n0 + nl)); }
          float m[4] = {0.f, 0.f, 0.f, 0.f};
#pragma unroll
          for (int it = 0; it < 16; ++it)
#pragma unroll
              for (int j = 0; j < 4; ++j) m[j] = __builtin_fmaxf(m[j], __builtin_fmaxf(__builtin_fabsf(va[it][j]), __builtin_fabsf(vb[it][j])));
#pragma unroll
          for (int j = 0; j < 4; ++j) { m[j] = __builtin_fmaxf(m[j], __shfl_xor(m[j], 16)); m[j] = __builtin_fmaxf(m[j], __shfl_xor(m[j], 32)); }
          if (kr == 0) {
#pragma unroll
              for (int j = 0; j < 4; ++j) cm[wave * 64 + nl + j] = m[j]; }
          __syncthreads();
          float sc[4];
#pragma unroll
          for (int j = 0; j < 4; ++j) { float a = cm[nl + j];
#pragma unroll
              for (int w = 1; w < NW; ++w) a = __builtin_fmaxf(a, cm[w * 64 + nl + j]);
              sc[j] = a > 0.f ? 448.f / a : 0.f;
              if (wave == 0 && kr == 0) DQ[n0 + nl + j] = a * (1.f / 448.f); }
#pragma unroll
          for (int half = 0; half < 2; ++half) {
#pragma unroll
              for (int it = 0; it < 16; ++it) { const f4v v = half ? vb[it] : va[it]; float* d = scr + (it * 4 + kr) * 65 + nl; d[0] = v[0] * sc[0]; d[1] = v[1] * sc[1]; d[2] = v[2] * sc[2]; d[3] = v[3] * sc[3]; }
              asm volatile("s_waitcnt lgkmcnt(0)" ::: "memory"); __builtin_amdgcn_wave_barrier();
              const int c = lane & 7, nr = lane >> 3;
#pragma unroll
              for (int it = 0; it < 8; ++it) { const int n = it * 8 + nr; const float* sp = scr + (8 * c) * 65 + n;
                  uint2 o; o.x = pk_fp8x4(sp[0], sp[65], sp[2 * 65], sp[3 * 65]); o.y = pk_fp8x4(sp[4 * 65], sp[5 * 65], sp[6 * 65], sp[7 * 65]);
                  *(uint2*)(WT8 + (size_t)(n0 + n) * 1024 + k0 + half * 64 + 8 * c) = o; }
              asm volatile("s_waitcnt lgkmcnt(0)" ::: "memory"); __builtin_amdgcn_wave_barrier();
          }
          __syncthreads();
      } }
    for (int it = gw; it < I_C + I_IN + I_O; it += ngw) {
        int r = it;
        if (r < I_C) { const int li = r / 64, q = r % 64, kb = q / 2, nb = q % 2;
            tr_tile<0>(p.in[10] + (size_t)li * 2048 * 128, 128, (bf16_t*)(p.ws + WS_WCT) + (size_t)li * 128 * 2048, 2048, kb * 64, nb * 64, scr, lane); continue; }
        r -= I_C;
        if (r < I_IN) { const int l = r / (16 * 48), q = r % (16 * 48), kb = q / 48, nb = q % 48;
            tr_tile<1>(p.in[6] + (size_t)l * D * INW, INW, WinT + (size_t)l * ZBW * D, D, kb * 64, nb * 64, scr, lane); continue; }
        r -= I_IN;
        { const int l = r / 256, q = r % 256, kb = q / 16, nb = q % 16;
            tr_tile<0>(p.in[14] + (size_t)l * D * D, D, WoT + (size_t)l * D * D, D, kb * 64, nb * 64, scr, lane); }
    }
    for (int idx = blockIdx.x * NT + tid; idx < L * 128 * 32; idx += gridDim.x * NT) {
        const int l = idx >> 12, kc = (idx >> 5) & 127, e = idx & 31; const float* rw = p.in[15] + (size_t)l * D * NE; float v[8];
#pragma unroll
        for (int j = 0; j < 8; ++j) v[j] = rw[(size_t)(8 * kc + j) * NE + e];
        unsigned hh[8], ll[8];
#pragma unroll
        for (int j = 0; j < 8; ++j) { hh[j] = f2bf(v[j]); ll[j] = f2bf(v[j] - __builtin_bit_cast(float, hh[j] << 16)); }
        unsigned char* img = p.ws + WS_RWI + (size_t)l * 131072;
        *(uint4*)(img + (size_t)(idx & 4095) * 16) = make_uint4(hh[0] | (hh[1] << 16), hh[2] | (hh[3] << 16), hh[4] | (hh[5] << 16), hh[6] | (hh[7] << 16));
        *(uint4*)(img + 65536 + (size_t)(idx & 4095) * 16) = make_uint4(ll[0] | (ll[1] << 16), ll[2] | (ll[3] << 16), ll[4] | (ll[5] << 16), ll[6] | (ll[7] << 16));
    }
    if (blockIdx.x == 0) { bf16_t* XN = (bf16_t*)(p.ws + WS_XN); for (int i = tid; i < D / 2; i += NT) ((unsigned*)(XN + (size_t)T * D))[i] = 0u;
                           for (int i = tid; i < D / 4; i += NT) ((unsigned*)(p.ws + WS_XN8 + (size_t)T * D))[i] = 0u; }
}

namespace pg8 {
#define PG8_LAS __attribute__((address_space(3)))
typedef short bf16x8 __attribute__((ext_vector_type(8)));
typedef float f32x4 __attribute__((ext_vector_type(4)));
typedef unsigned u32x4 __attribute__((ext_vector_type(4)));
typedef long l64x2 __attribute__((ext_vector_type(2)));
typedef int i32x4 __attribute__((ext_vector_type(4)));
typedef int i32x8 __attribute__((ext_vector_type(8)));
constexpr int BM = 256, BK = 64, HALF = 128, HTB = HALF * BK * 2, STAGE_BYTES = 8 * HTB, NXCD = 8, WGM = 8;
__device__ __forceinline__ int lds_byte(int r, int c) { const int st = (r >> 4) * 2 + (c >> 5), rr = r & 15, cc = c & 31, ob = rr * 64 + cc * 2; return st * 1024 + (ob ^ (((ob >> 9) & 1) << 5)); }
__device__ __forceinline__ void stage_rc(int b, int& R, int& C) { const int st = b / 1024, sb = b % 1024, swz = sb ^ (((sb >> 9) & 1) << 5); R = (st >> 1) * 16 + swz / 64; C = (st & 1) * 32 + (swz % 64) / 2; }
__device__ __forceinline__ int perm32(int rho) { const int n = rho >> 4, i = rho & 15; return 8 * (i >> 2) + 4 * n + (i & 3); }
struct Unit { int pm, pn, e; };
__device__ __forceinline__ unsigned cvt_pk_bf16(float lo, float hi) { unsigned r; asm volatile("v_cvt_pk_bf16_f32 %0, %1, %2" : "=v"(r) : "v"(lo), "v"(hi)); return r; }

__device__ __forceinline__ bool static_next(int nM, int nN, int G, int c, int i, Unit& u) {
    const int nwg = nM * nN; const long Lq = (long)i * G + c; if (Lq >= nwg) return false;
    int wgid = (int)Lq; { const int q = nwg / NXCD, r = nwg % NXCD, xcd = wgid % NXCD, off = wgid / NXCD; wgid = (xcd < r ? xcd * (q + 1) : r * (q + 1) + (xcd - r) * q) + off; }
    const int nig = WGM * nN, gid = wgid / nig, fm = gid * WGM, gsz = (nM - fm) < WGM ? (nM - fm) : WGM;
    u.pm = fm + ((wgid % nig) % gsz); u.pn = (wgid % nig) / gsz; u.e = 0; return true;
}

template <class Prob, class Epi, bool ALIGN_EPI, bool SP2>
__device__ __forceinline__ void gemm_phase(PG8_LAS unsigned char* lds, const Prob& P, const Epi& E) {
    const int tid = otid(), wid = __builtin_amdgcn_readfirstlane(tid >> 6), lane = tid & 63, wr = wid >> 2, wc = wid & 3, fr = lane & 15, fq = lane >> 4;
    const int K = P.K, nt = Prob::KT > 0 ? Prob::KT : K / BK;
    int sR[2], sC[2]; unsigned voffB[2];
#pragma unroll
    for (int i = 0; i < 2; ++i) { stage_rc(tid * 16 + i * 8192, sR[i], sC[i]); voffB[i] = (unsigned)(P.b_row(sR[i]) * K + sC[i]) * 2u; }
    const size_t kstep = (size_t)(BK * 2);
    const size_t kstepA = P.a_kstep();
    const size_t hstepB = P.b_hstep();
    const unsigned ldsw = (unsigned)wid * 1024u;
    const int aoff = lds_byte(wr * 64 + fr, fq * 8), boff = lds_byte(wc * 32 + fr, fq * 8);
#define PG8_SA(b, h) (((b) * 2 + (h)) * HTB)
#define PG8_SB(b, h) ((4 + (b) * 2 + (h)) * HTB)
#define PG8_STAGE(bufoff, gbase, voff) do { _Pragma("unroll") for (int _i = 0; _i < 2; ++_i) { unsigned _vo = (voff)[_i]; asm volatile("" : "+v"(_vo));        \
        __builtin_amdgcn_global_load_lds((const unsigned*)((const char*)(gbase) + _vo), (PG8_LAS unsigned*)(lds + (bufoff) + ldsw + _i * 8192), 16, 0, 0); } } while (0)
#define PG8_STAGE_SEL(bufoff, gbase, h) do { _Pragma("unroll") for (int _i = 0; _i < 2; ++_i) { unsigned _vo = vAc[h][_i]; if constexpr (Prob::GATHER) { const unsigned _vn = van[(h) * 2 + _i]; _vo = last ? _vn : _vo; } asm volatile("" : "+v"(_vo)); \
        __builtin_amdgcn_global_load_lds((const unsigned*)((const char*)(gbase) + _vo), (PG8_LAS unsigned*)(lds + (bufoff) + ldsw + _i * 8192), 16, 0, 0); } } while (0)
#define PG8_LDA(dst, b, h) do { if constexpr (Prob::F8) { _Pragma("unroll") for (int m = 0; m < 2; ++m) { \
            const i32x4 lo_ = *(const PG8_LAS i32x4*)(lds + PG8_SA(b, h) + aoff + m * 2048), hi_ = *(const PG8_LAS i32x4*)(lds + PG8_SA(b, h) + aoff + m * 2048 + 1024); \
            dst##8[m] = __builtin_shufflevector(lo_, hi_, 0, 1, 2, 3, 4, 5, 6, 7); } } \
        else { _Pragma("unroll") for (int m = 0; m < 4; ++m) _Pragma("unroll") for (int k = 0; k < 2; ++k) dst[m][k] = *(const PG8_LAS bf16x8*)(lds + PG8_SA(b, h) + aoff + m * 2048 + k * 1024); } } while (0)
#define PG8_LDB(dst, b, h) do { if constexpr (Prob::F8) { _Pragma("unroll") for (int n = 0; n < 2; ++n) { \
            const i32x4 lo_ = *(const PG8_LAS i32x4*)(lds + PG8_SB(b, h) + boff + n * 2048), hi_ = *(const PG8_LAS i32x4*)(lds + PG8_SB(b, h) + boff + n * 2048 + 1024); \
            dst##8[n] = __builtin_shufflevector(lo_, hi_, 0, 1, 2, 3, 4, 5, 6, 7); } } \
        else { _Pragma("unroll") for (int n = 0; n < 2; ++n) _Pragma("unroll") for (int k = 0; k < 2; ++k) dst[n][k] = *(const PG8_LAS bf16x8*)(lds + PG8_SB(b, h) + boff + n * 2048 + k * 1024); } } while (0)
#define PG8_MMA(ai, bj, At, Bt) do { __builtin_amdgcn_s_setprio(1); _Pragma("unroll") for (int m = 0; m < 4; ++m) _Pragma("unroll") for (int n = 0; n < 2; ++n) { \
        if constexpr (Prob::F8)          \
            acc[ai][bj][m][n] = __builtin_amdgcn_mfma_scale_f32_16x16x128_f8f6f4(Bt##8[n], At##8[m], acc[ai][bj][m][n], 0, 0, 0, 0x7f7f7f7f, 0, 0x7f7f7f7f); \
        else { _Pragma("unroll") for (int k = 0; k < 2; ++k) acc[ai][bj][m][n] = __builtin_amdgcn_mfma_f32_16x16x32_bf16(Bt[n][k], At[m][k], acc[ai][bj][m][n], 0, 0, 0); } } __builtin_amdgcn_s_setprio(0); } while (0)
#define PG8_MMA2(ai, At, B0, B1, b, h) do { if constexpr (Prob::F8) { __builtin_amdgcn_s_setprio(1); \
        _Pragma("unroll") for (int m = 0; m < 2; ++m) _Pragma("unroll") for (int n = 0; n < 2; ++n) { \
            acc[ai][0][m][n] = __builtin_amdgcn_mfma_scale_f32_16x16x128_f8f6f4(B0##8[n], At##8[m], acc[ai][0][m][n], 0, 0, 0, 0x7f7f7f7f, 0, 0x7f7f7f7f); \
            acc[ai][1][m][n] = __builtin_amdgcn_mfma_scale_f32_16x16x128_f8f6f4(B1##8[n], At##8[m], acc[ai][1][m][n], 0, 0, 0, 0x7f7f7f7f, 0, 0x7f7f7f7f); } \
        _Pragma("unroll") for (int m = 0; m < 2; ++m) { \
            const i32x4 lo_ = *(const PG8_LAS i32x4*)(lds + PG8_SA(b, h) + aoff + (m + 2) * 2048), hi_ = *(const PG8_LAS i32x4*)(lds + PG8_SA(b, h) + aoff + (m + 2) * 2048 + 1024); \
            At##8[m] = __builtin_shufflevector(lo_, hi_, 0, 1, 2, 3, 4, 5, 6, 7); } \
        _Pragma("unroll") for (int m = 0; m < 2; ++m) _Pragma("unroll") for (int n = 0; n < 2; ++n) { \
            acc[ai][0][m + 2][n] = __builtin_amdgcn_mfma_scale_f32_16x16x128_f8f6f4(B0##8[n], At##8[m], acc[ai][0][m + 2][n], 0, 0, 0, 0x7f7f7f7f, 0, 0x7f7f7f7f); \
            acc[ai][1][m + 2][n] = __builtin_amdgcn_mfma_scale_f32_16x16x128_f8f6f4(B1##8[n], At##8[m], acc[ai][1][m + 2][n], 0, 0, 0, 0x7f7f7f7f, 0, 0x7f7f7f7f); } \
        __builtin_amdgcn_s_setprio(0); } else { PG8_MMA(ai, 0, At, B0); PG8_MMA(ai, 1, At, B1); } } while (0)
#define PG8_WAIT_V(n) asm volatile("s_waitcnt vmcnt(" #n ")" ::: "memory")
#define PG8_WAIT_L(n) asm volatile("s_waitcnt lgkmcnt(" #n ")" ::: "memory")
#define PG8_BAR __builtin_amdgcn_s_barrier()
#define PG8_SCHED __builtin_amdgcn_sched_barrier(0)
    Unit cur, nxt; int ui = 0;
    if (!P.next(0, cur)) return;
    nxt = cur;
    f32x4 acc[2][2][4][2];
    typename Epi::Pre pre;
    E.prefetch(cur, wc, fq, pre); E.init(acc, pre);
    bf16x8 At[4][2], B0[2][2], B1[2][2];
    i32x8 At8[2], B08[2], B18[2];
    unsigned vAc[2][2];
    PG8_LAS unsigned* van = (PG8_LAS unsigned*)(lds + 131072 + 1024) + tid * 4;
    const char* cA = P.a_base(cur); const char* cB = P.b_base(cur);
    P.a_voff(cur, sR, sC, vAc);
    if constexpr (Prob::GATHER) { van[0] = vAc[0][0]; van[1] = vAc[0][1]; van[2] = vAc[1][0]; van[3] = vAc[1][1]; }
    if constexpr (SP2) {
        PG8_STAGE(PG8_SB(0, 0), cB, voffB); PG8_STAGE(PG8_SB(0, 1), cB + hstepB, voffB); PG8_STAGE(PG8_SA(0, 0), cA, vAc[0]); PG8_STAGE(PG8_SA(0, 1), cA, vAc[1]);
        if (wr == 1) PG8_BAR;
        PG8_WAIT_V(2); PG8_BAR;
        PG8_STAGE(PG8_SB(1, 0), cB + kstep, voffB); PG8_STAGE(PG8_SA(1, 0), cA + kstepA, vAc[0]); PG8_STAGE(PG8_SB(1, 1), cB + hstepB + kstep, voffB);
        PG8_WAIT_V(6); PG8_BAR;
    } else {
        PG8_STAGE(PG8_SB(0, 0), cB, voffB); PG8_STAGE(PG8_SA(0, 0), cA, vAc[0]); PG8_STAGE(PG8_SB(0, 1), cB + hstepB, voffB); PG8_STAGE(PG8_SA(0, 1), cA, vAc[1]);
        if (wr == 1) PG8_BAR;
        PG8_WAIT_V(4); PG8_BAR;
        PG8_STAGE(PG8_SB(1, 0), cB + kstep, voffB); PG8_STAGE(PG8_SA(1, 0), cA + kstepA, vAc[0]); PG8_STAGE(PG8_SB(1, 1), cB + hstepB + kstep, voffB);
        PG8_WAIT_V(6); PG8_BAR;
    }
    for (;;) {
        E.preload(cur, wc, fq, pre);
        const bool has_next = P.next(ui + 1, nxt);
        const char* nA = cA; const char* nB = cB;
        if (has_next) { nA = P.a_base(nxt); nB = P.b_base(nxt);
            if constexpr (Prob::GATHER) { int r2[2], c2[2]; const int t2 = otid();
#pragma unroll
                for (int i = 0; i < 2; ++i) stage_rc(t2 * 16 + i * 8192, r2[i], c2[i]);
                unsigned vn[2][2]; P.a_voff(nxt, r2, c2, vn); van[0] = vn[0][0]; van[1] = vn[0][1]; van[2] = vn[1][0]; van[3] = vn[1][1]; } }
        for (int t = 0; t < nt; t += 2) {
            const bool last = (t == nt - 2);
            const char* a1 = cA + (size_t)(t + 1) * kstepA;
            const char* a2 = last ? nA : cA + (size_t)(t + 2) * kstepA; const char* b2 = last ? nB : cB + (size_t)(t + 2) * kstep;
            const char* a3 = a2 + kstepA; const char* b3 = b2 + kstep;
            if constexpr (SP2) {
            PG8_LDB(B0, 0, 0); PG8_LDB(B1, 0, 1); PG8_SCHED; PG8_LDA(At, 0, 0); PG8_STAGE(PG8_SA(1, 1), a1, vAc[1]);
            PG8_WAIT_V(8); PG8_WAIT_L(0); PG8_BAR; PG8_MMA2(0, At, B0, B1, 0, 0); PG8_BAR; PG8_SCHED;
            PG8_LDA(At, 0, 1); PG8_STAGE(PG8_SB(0, 0), b2, voffB); PG8_STAGE(PG8_SB(0, 1), b2 + hstepB, voffB); PG8_STAGE_SEL(PG8_SA(0, 0), a2, 0);
            PG8_WAIT_V(8); PG8_WAIT_L(0); PG8_BAR; PG8_MMA2(1, At, B0, B1, 0, 1); PG8_BAR; PG8_SCHED;
            PG8_LDB(B0, 1, 0); PG8_LDB(B1, 1, 1); PG8_SCHED; PG8_LDA(At, 1, 0); PG8_STAGE_SEL(PG8_SA(0, 1), a2, 1);
            PG8_WAIT_V(8); PG8_WAIT_L(0); PG8_BAR; PG8_MMA2(0, At, B0, B1, 1, 0); PG8_BAR; PG8_SCHED;
            PG8_LDA(At, 1, 1); PG8_STAGE(PG8_SB(1, 0), b3, voffB); PG8_STAGE(PG8_SB(1, 1), b3 + hstepB, voffB); PG8_STAGE_SEL(PG8_SA(1, 0), a3, 0);
            PG8_WAIT_V(8); PG8_WAIT_L(0); PG8_BAR; PG8_MMA2(1, At, B0, B1, 1, 1); PG8_BAR; PG8_SCHED;
            } else {
            PG8_LDB(B0, 0, 0); PG8_SCHED; PG8_LDA(At, 0, 0); PG8_STAGE(PG8_SA(1, 1), a1, vAc[1]);
            PG8_WAIT_L(8); PG8_BAR; PG8_WAIT_L(0); PG8_MMA(0, 0, At, B0); PG8_BAR; PG8_SCHED;
            PG8_LDB(B1, 0, 1); PG8_STAGE(PG8_SB(0, 0), b2, voffB);
            PG8_BAR; PG8_WAIT_L(0); PG8_MMA(0, 1, At, B1); PG8_BAR;
            PG8_LDA(At, 0, 1); PG8_STAGE_SEL(PG8_SA(0, 0), a2, 0);
            PG8_BAR; PG8_WAIT_L(0); PG8_MMA(1, 0, At, B0); PG8_BAR; PG8_SCHED;
            PG8_STAGE(PG8_SB(0, 1), b2 + hstepB, voffB);
            PG8_WAIT_V(6); PG8_BAR; PG8_MMA(1, 1, At, B1); PG8_BAR;
            PG8_LDB(B0, 1, 0); PG8_SCHED; PG8_LDA(At, 1, 0); PG8_STAGE_SEL(PG8_SA(0, 1), a2, 1);
            PG8_WAIT_L(8); PG8_BAR; PG8_WAIT_L(0); PG8_MMA(0, 0, At, B0); PG8_BAR; PG8_SCHED;
            PG8_LDB(B1, 1, 1); PG8_STAGE(PG8_SB(1, 0), b3, voffB);
            PG8_BAR; PG8_WAIT_L(0); PG8_MMA(0, 1, At, B1); PG8_BAR;
            PG8_LDA(At, 1, 1); PG8_STAGE_SEL(PG8_SA(1, 0), a3, 0);
            PG8_BAR; PG8_WAIT_L(0); PG8_MMA(1, 0, At, B0); PG8_BAR; PG8_SCHED;
            PG8_STAGE(PG8_SB(1, 1), b3 + hstepB, voffB);
            PG8_WAIT_V(6); PG8_BAR; PG8_MMA(1, 1, At, B1); PG8_BAR;
            }
        }
        if constexpr (ALIGN_EPI) { if (wr == 0) PG8_BAR; }
        E(acc, cur, wr, wc, fr, fq, has_next, nxt, pre);
        if (!has_next) break;
        E.init(acc, pre);
        cur = nxt; cA = nA; cB = nB; ++ui;
        if constexpr (Prob::GATHER) {
#pragma unroll
            for (int h = 0; h < 2; ++h)
#pragma unroll
                for (int i = 0; i < 2; ++i) vAc[h][i] = van[h * 2 + i];
        }
        if constexpr (ALIGN_EPI) { if (wr == 1) PG8_BAR; }
    }
    PG8_WAIT_V(0);
    if constexpr (!ALIGN_EPI) { if (wr == 0) PG8_BAR; }
    PG8_BAR;
#undef PG8_SA
#undef PG8_SB
#undef PG8_STAGE
#undef PG8_STAGE_SEL
#undef PG8_LDA
#undef PG8_LDB
#undef PG8_MMA
#undef PG8_WAIT_V
#undef PG8_WAIT_L
#undef PG8_BAR
#undef PG8_SCHED
}

struct ProbDense { static constexpr bool F8 = false; static constexpr bool GATHER = false; static constexpr int KT = 0;
    const bf16_t* A; const bf16_t* Bt; int K, nM, nN, G, c; bool headperm;
    __device__ __forceinline__ bool next(int i, Unit& u) const { return static_next(nM, nN, G, c, i, u); }
    __device__ __forceinline__ const char* a_base(const Unit& u) const { return (const char*)(A + (size_t)u.pm * BM * K); }
    __device__ __forceinline__ void a_voff(const Unit&, const int (&R)[2], const int (&C)[2], unsigned (&v)[2][2]) const {
#pragma unroll
        for (int h = 0; h < 2; ++h)
#pragma unroll
            for (int i = 0; i < 2; ++i) v[h][i] = (unsigned)((h * HALF + R[i]) * K + C[i]) * 2u;
    }
    __device__ __forceinline__ const char* b_base(const Unit& u) const { return (const char*)(Bt + (size_t)u.pn * BM * K); }
    __device__ __forceinline__ size_t a_kstep() const { return (size_t)BK * 2; }
    __device__ __forceinline__ size_t b_hstep() const { return headperm ? (size_t)32 * K * 2 : (size_t)HALF * K * 2; }
    __device__ __forceinline__ int b_row(int R) const { return headperm ? ((R >> 5) * 64 + perm32(R & 31)) : ((R & ~31) + perm32(R & 31)); }
};
typedef const PG8_LAS int* lds_ints;
__device__ __forceinline__ int expert_of(lds_ints ps, int pm) { int e = 0;
#pragma unroll
    for (int i = 1; i < 32; ++i) if (ps[i] <= pm * 256) e = i;
    return __builtin_amdgcn_readfirstlane(e); }
struct ProbMoe1 { static constexpr bool F8 = true; static constexpr bool GATHER = true; static constexpr int KT = 0;
    const bf16_t* XN; const bf16_t* W1T; const int* rowtok; lds_ints ps; int K, ntm, G, c;
    __device__ __forceinline__ bool next(int i, Unit& u) const {
        if (G != 256) { const int q = i * G + c; if (q >= ntm * 8) return false; u.pm = q >> 3; u.pn = q & 7; u.e = expert_of(ps, u.pm); return true; }
        const int x = c & 7, s = c >> 3; const int pm = 4 * (i * 8 + x) + (s >> 3); if (pm >= ntm) return false;
        u.pm = pm; u.pn = s & 7; u.e = expert_of(ps, u.pm); return true; }
    __device__ __forceinline__ const char* a_base(const Unit&) const { return (const char*)XN; }
    __device__ __forceinline__ void a_voff(const Unit& u, const int (&R)[2], const int (&C)[2], unsigned (&v)[2][2]) const {
#pragma unroll
        for (int h = 0; h < 2; ++h)
#pragma unroll
            for (int i = 0; i < 2; ++i) { int tk = rowtok[u.pm * BM + h * HALF + R[i]]; if (tk < 0) tk = T; v[h][i] = (unsigned)(tk * K + C[i]) * 2u; }
    }
    __device__ __forceinline__ const char* b_base(const Unit& u) const { return (const char*)(W1T + ((size_t)u.e * 2048 + u.pn * 128) * K); }
    __device__ __forceinline__ size_t a_kstep() const { return (size_t)BK * 2; }
    __device__ __forceinline__ size_t b_hstep() const { return (size_t)1024 * K * 2; }
    __device__ __forceinline__ int b_row(int R) const { return (R & ~31) + perm32(R & 31); }
};
struct ProbMoe2 { static constexpr bool F8 = true; static constexpr bool GATHER = false; static constexpr int KT = 0;
    const bf16_t* ACT; const bf16_t* W2T; lds_ints ps; int K, ntm, G, c;
    __device__ __forceinline__ bool next(int i, Unit& u) const {
        if (G != 256) { const int q = i * G + c; if (q >= ntm * 4) return false; u.pm = q >> 2; u.pn = q & 3; u.e = expert_of(ps, u.pm); return true; }
        const int x = c & 7, s = c >> 3; const int pm = 8 * (i * 8 + x) + (s >> 2); if (pm >= ntm) return false;
        u.pm = pm; u.pn = s & 3; u.e = expert_of(ps, u.pm); return true; }
    __device__ __forceinline__ const char* a_base(const Unit& u) const { return (const char*)(ACT + (size_t)u.pm * BM * K); }
    __device__ __forceinline__ void a_voff(const Unit&, const int (&R)[2], const int (&C)[2], unsigned (&v)[2][2]) const {
#pragma unroll
        for (int h = 0; h < 2; ++h)
#pragma unroll
            for (int i = 0; i < 2; ++i) v[h][i] = (unsigned)((h * HALF + R[i]) * K + C[i]) * 2u;
    }
    __device__ __forceinline__ const char* b_base(const Unit& u) const { return (const char*)(W2T + ((size_t)u.e * 1024 + u.pn * BM) * K); }
    __device__ __forceinline__ size_t a_kstep() const { return (size_t)BK * 2; }
    __device__ __forceinline__ size_t b_hstep() const { return (size_t)HALF * K * 2; }
    __device__ __forceinline__ int b_row(int R) const { return (R & ~31) + perm32(R & 31); }
};

struct ProbCmp { static constexpr bool F8 = false; static constexpr bool GATHER = false; static constexpr int KT = 8;
    const bf16_t* ZB; const bf16_t* W1T; int K, G, c;
    __device__ __forceinline__ bool next(int i, Unit& u) const { const int q = i * G + c; if (q >= 64) return false; u.pm = q & 15; u.pn = 0; u.e = q >> 4; return true; }
    __device__ __forceinline__ const char* a_base(const Unit& u) const { const int idx = u.pm >> 3, bg = (u.pm >> 1) & 3, half = u.pm & 1;
        return (const char*)(ZB + ((size_t)(bg >> 1) * S + 16 * 256 * half + 8 * u.e) * ZBW + ZB_KC + idx * 128 + (bg & 1) * 64); }
    __device__ __forceinline__ void a_voff(const Unit&, const int (&R)[2], const int (&C)[2], unsigned (&v)[2][2]) const {
#pragma unroll
        for (int h = 0; h < 2; ++h)
#pragma unroll
            for (int i = 0; i < 2; ++i) v[h][i] = (unsigned)(16 * (h * HALF + R[i]) * ZBW + C[i]) * 2u;
    }
    __device__ __forceinline__ size_t a_kstep() const { return (size_t)ZBW * 2; }
    __device__ __forceinline__ const char* b_base(const Unit& u) const { return (const char*)(W1T + (size_t)(u.pm >> 3) * 128 * K + 8 * 64 * u.e); }
    __device__ __forceinline__ size_t b_hstep() const { return 0; }
    __device__ __forceinline__ int b_row(int R) const { return (R & ~31) + perm32(R & 31); }
};
struct EpiCmp {
    float* HIDP;
    struct Pre {};
    __device__ __forceinline__ void prefetch(const Unit&, int, int, Pre&) const {}
    __device__ __forceinline__ void preload(const Unit&, int, int, Pre&) const {}
    __device__ __forceinline__ void init(f32x4 (&acc)[2][2][4][2], const Pre&) const {
#pragma unroll
        for (int a = 0; a < 2; ++a)
#pragma unroll
            for (int b = 0; b < 2; ++b)
#pragma unroll
                for (int m = 0; m < 4; ++m)
#pragma unroll
                    for (int n = 0; n < 2; ++n) acc[a][b][m][n] = (f32x4){0.f, 0.f, 0.f, 0.f};
    }
    __device__ __forceinline__ void operator()(const f32x4 (&acc)[2][2][4][2], const Unit& u, int wr, int wc, int fr, int fq, bool has_next, const Unit& nxt, Pre& pre) const {
        const int idx = u.pm >> 3, bg = (u.pm >> 1) & 3, half = u.pm & 1;
        const int c0 = 32 * wc + 8 * fq;
#pragma unroll
        for (int ai = 0; ai < 2; ++ai)
#pragma unroll
            for (int m = 0; m < 4; ++m) { const int n = 256 * half + ai * HALF + wr * 64 + m * 16 + fr;
                if (n < 511) { float* dst = HIDP + (((size_t)u.e * 2 + idx) * 2044 + bg * 511 + n) * 128 + c0;
                    *(f32x4*)dst = acc[ai][0][m][0]; *(f32x4*)(dst + 4) = acc[ai][0][m][1]; } }
    }
};
struct EpiG1F {
    bf16_t* ZB; float* GATE; const float* gq; const float* gk; const float* gmq; const float* gmk;
    struct Pre {};
    __device__ __forceinline__ void prefetch(const Unit&, int, int, Pre&) const {}
    __device__ __forceinline__ void preload(const Unit&, int, int, Pre&) const {}
    __device__ __forceinline__ void init(f32x4 (&acc)[2][2][4][2], const Pre&) const {
#pragma unroll
        for (int a = 0; a < 2; ++a)
#pragma unroll
            for (int b = 0; b < 2; ++b)
#pragma unroll
                for (int m = 0; m < 4; ++m)
#pragma unroll
                    for (int n = 0; n < 2; ++n) acc[a][b][m][n] = (f32x4){0.f, 0.f, 0.f, 0.f};
    }
    __device__ __forceinline__ void operator()(const f32x4 (&acc)[2][2][4][2], const Unit& u, int wr, int wc, int fr, int fq, bool has_next, const Unit& nxt, Pre& pre) const {
        const int pn = u.pn;
        const float* gain = nullptr; float sc = 1.f;
        if (pn < 2) { gain = gq; sc = QSCALE; }
        else if (pn == 3 || pn == 4) { if (wc < 2) gain = gk; }
        else if (pn == 5 || pn == 6) { gain = gmq; sc = QSCALE; }
        else if (pn == 7 || pn == 8) { gain = gmk; }
        if (pn == 11) {
            if (wc == 0 && fq < 3) {
#pragma unroll
                for (int ai = 0; ai < 2; ++ai)
#pragma unroll
                    for (int m = 0; m < 4; ++m) { const size_t r = (size_t)u.pm * BM + ai * HALF + wr * 64 + m * 16 + fr;
#pragma unroll
                        for (int n = 0; n < 2; ++n) { const f32x4 v = acc[ai][0][m][n]; f32x4 o;
#pragma unroll
                            for (int i = 0; i < 4; ++i) o[i] = __builtin_amdgcn_rcpf(1.f + __builtin_amdgcn_exp2f(-LOG2E * v[i]));
                            *(f32x4*)(GATE + r * 32 + 8 * fq + 4 * n) = o; } }
            }
            return;
        }
        f32x4 gv[2][2];
#pragma unroll
        for (int bj = 0; bj < 2; ++bj)
#pragma unroll
            for (int n = 0; n < 2; ++n) gv[bj][n] = gain ? *(const f32x4*)(gain + 32 * bj + 8 * fq + 4 * n) * sc : (f32x4){1.f, 1.f, 1.f, 1.f};
#pragma unroll
        for (int ai = 0; ai < 2; ++ai)
#pragma unroll
            for (int m = 0; m < 4; ++m) { const size_t r = (size_t)u.pm * BM + ai * HALF + wr * 64 + m * 16 + fr;
                float rs = 1.f;
                if (gain) { float ss = 0.f;
#pragma unroll
                    for (int bj = 0; bj < 2; ++bj)
#pragma unroll
                        for (int n = 0; n < 2; ++n) { const f32x4 v = acc[ai][bj][m][n]; ss += (v[0] * v[0] + v[1] * v[1]) + (v[2] * v[2] + v[3] * v[3]); }
                    ss += __shfl_xor(ss, 16); ss += __shfl_xor(ss, 32);
                    rs = rsqrtf(ss * (1.f / 64.f) + EPS); }
#pragma unroll
                for (int bj = 0; bj < 2; ++bj) { const f32x4 a = acc[ai][bj][m][0] * gv[bj][0] * rs, b = acc[ai][bj][m][1] * gv[bj][1] * rs;
                    u32x4 w; w.x = cvt_pk_bf16(a[0], a[1]); w.y = cvt_pk_bf16(a[2], a[3]); w.z = cvt_pk_bf16(b[0], b[1]); w.w = cvt_pk_bf16(b[2], b[3]);
                    *(u32x4*)(ZB + r * ZBW + pn * BM + 64 * wc + 32 * bj + 8 * fq) = w; } }
    }
};
struct EpiG2 {
    const float* xin32; bf16_t* XAB; const float* g1;
    struct Pre {};
    __device__ __forceinline__ void prefetch(const Unit&, int, int, Pre&) const {}
    __device__ __forceinline__ void preload(const Unit&, int, int, Pre&) const {}
    __device__ __forceinline__ void init(f32x4 (&acc)[2][2][4][2], const Pre&) const {
#pragma unroll
        for (int a = 0; a < 2; ++a)
#pragma unroll
            for (int b = 0; b < 2; ++b)
#pragma unroll
                for (int m = 0; m < 4; ++m)
#pragma unroll
                    for (int n = 0; n < 2; ++n) acc[a][b][m][n] = (f32x4){0.f, 0.f, 0.f, 0.f};
    }
    __device__ __forceinline__ void operator()(const f32x4 (&acc)[2][2][4][2], const Unit& u, int wr, int wc, int fr, int fq, bool has_next, const Unit& nxt, Pre& pre) const {
#pragma unroll
        for (int ai = 0; ai < 2; ++ai)
#pragma unroll
            for (int m = 0; m < 4; ++m) { const size_t r = (size_t)u.pm * BM + ai * HALF + wr * 64 + m * 16 + fr; const int b = (int)(r / S);
#pragma unroll
                for (int bj = 0; bj < 2; ++bj) { const int c = u.pn * BM + 128 * bj + 32 * wc + 8 * fq;
                    f32x4 x0, x1;
                    if (xin32) { x0 = *(const f32x4*)(xin32 + r * D + c); x1 = *(const f32x4*)(xin32 + r * D + c + 4); }
                    else { const u32x4 q = *(const u32x4*)(XAB + r * D + c);
                        x0 = (f32x4){__builtin_bit_cast(float, q.x << 16), __builtin_bit_cast(float, q.x & 0xffff0000u), __builtin_bit_cast(float, q.y << 16), __builtin_bit_cast(float, q.y & 0xffff0000u)};
                        x1 = (f32x4){__builtin_bit_cast(float, q.z << 16), __builtin_bit_cast(float, q.z & 0xffff0000u), __builtin_bit_cast(float, q.w << 16), __builtin_bit_cast(float, q.w & 0xffff0000u)}; }
                    const f32x4 g0 = *(const f32x4*)(g1 + (size_t)b * 6144 + c), g1v = *(const f32x4*)(g1 + (size_t)b * 6144 + c + 4);
                    const f32x4 y0 = x0 + g0 * acc[ai][bj][m][0], y1 = x1 + g1v * acc[ai][bj][m][1];
                    u32x4 o; o.x = cvt_pk_bf16(y0[0], y0[1]); o.y = cvt_pk_bf16(y0[2], y0[3]); o.z = cvt_pk_bf16(y1[0], y1[1]); o.w = cvt_pk_bf16(y1[2], y1[3]);
                    *(u32x4*)(XAB + r * D + c) = o; } }
    }
};
struct EpiM1 {
    unsigned char* ACT8; const float* b1l; const float* dq1l;
    struct Pre { f32x4 bg, bl, sg, sl; };
    __device__ __forceinline__ void prefetch(const Unit&, int, int, Pre&) const {}
    __device__ __forceinline__ void preload(const Unit& u, int wc, int fq, Pre& q) const {
        const int c0 = u.pn * 128 + 32 * wc + 8 * fq; const float* b1 = b1l + (size_t)u.e * 2048 + c0; const float* dq = dq1l + (size_t)u.e * 2048 + c0;
        q.bg = *(const f32x4*)(b1); q.bl = *(const f32x4*)(b1 + 1024); q.sg = *(const f32x4*)(dq); q.sl = *(const f32x4*)(dq + 1024); }
    __device__ __forceinline__ void init(f32x4 (&acc)[2][2][4][2], const Pre&) const {
#pragma unroll
        for (int a = 0; a < 2; ++a)
#pragma unroll
            for (int b = 0; b < 2; ++b)
#pragma unroll
                for (int m = 0; m < 4; ++m)
#pragma unroll
                    for (int n = 0; n < 2; ++n) acc[a][b][m][n] = (f32x4){0.f, 0.f, 0.f, 0.f};
    }
    __device__ __forceinline__ void operator()(const f32x4 (&acc)[2][2][4][2], const Unit& u, int wr, int wc, int fr, int fq, bool has_next, const Unit& nxt, Pre& pre) const {
        { const int t_ = otid(); fr = t_ & 15; fq = (t_ >> 4) & 3; }
        const int c0 = u.pn * 128 + 32 * wc + 8 * fq;
        const float* b1 = b1l + (size_t)u.e * 2048 + c0; const float* dq = dq1l + (size_t)u.e * 2048 + c0;
        unsigned w[2][4][2];
        const f32x4 bg1 = *(const f32x4*)(b1 + 4), bl1 = *(const f32x4*)(b1 + 1024 + 4), sg1 = *(const f32x4*)(dq + 4), sl1 = *(const f32x4*)(dq + 1024 + 4);
#pragma unroll
        for (int n = 0; n < 2; ++n) {
            const f32x4 bg = n ? bg1 : pre.bg, bl = n ? bl1 : pre.bl;
            const f32x4 sg = (n ? sg1 : pre.sg) * (1.f / XS8), sl = (n ? sl1 : pre.sl) * (1.f / XS8);
#pragma unroll
            for (int ai = 0; ai < 2; ++ai)
#pragma unroll
                for (int m = 0; m < 4; ++m) { const f32x4 g = acc[ai][0][m][n] * sg + bg, li = acc[ai][1][m][n] * sl + bl; float o[4];
#pragma unroll
                    for (int i = 0; i < 4; ++i) { const float gc = fminf(g[i], 7.f), lc = __builtin_amdgcn_fmed3f(li[i], -7.f, 7.f);
                        o[i] = (AS8 * (lc + 1.f)) * (gc * __builtin_amdgcn_rcpf(1.f + __builtin_amdgcn_exp2f((-1.702f * LOG2E) * gc))); }
                    w[ai][m][n] = pk_fp8x4(o[0], o[1], o[2], o[3]); }
        }
#pragma unroll
        for (int ai = 0; ai < 2; ++ai)
#pragma unroll
            for (int m = 0; m < 4; ++m) { const size_t r = (size_t)u.pm * BM + ai * HALF + wr * 64 + m * 16 + fr;
                *(uint2*)(ACT8 + r * DFF + c0) = make_uint2(w[ai][m][0], w[ai][m][1]); }
    }
};
struct EpiM2 {
    bf16_t* Y; const float* b2l; const float* dq2l;
    struct Pre {};
    __device__ __forceinline__ void prefetch(const Unit&, int, int, Pre&) const {}
    __device__ __forceinline__ void preload(const Unit&, int, int, Pre&) const {}
    __device__ __forceinline__ void init(f32x4 (&acc)[2][2][4][2], const Pre&) const {
#pragma unroll
        for (int a = 0; a < 2; ++a)
#pragma unroll
            for (int b = 0; b < 2; ++b)
#pragma unroll
                for (int m = 0; m < 4; ++m)
#pragma unroll
                    for (int n = 0; n < 2; ++n) acc[a][b][m][n] = (f32x4){0.f, 0.f, 0.f, 0.f};
    }
    __device__ __forceinline__ void operator()(const f32x4 (&acc)[2][2][4][2], const Unit& u, int wr, int wc, int fr, int fq, bool has_next, const Unit& nxt, Pre& pre) const {
        { const int t_ = otid(); fr = t_ & 15; fq = (t_ >> 4) & 3; }
        const int cb = u.pn * BM + 32 * wc + 8 * fq;
        const float* b2 = b2l + (size_t)u.e * D + cb; const float* dq = dq2l + (size_t)u.e * D + cb;
#pragma unroll
        for (int bj = 0; bj < 2; ++bj) { const int c = cb + 128 * bj;
            const f32x4 b0 = *(const f32x4*)(b2 + 128 * bj), b1_ = *(const f32x4*)(b2 + 128 * bj + 4);
            const f32x4 s0 = *(const f32x4*)(dq + 128 * bj) * (1.f / AS8), s1 = *(const f32x4*)(dq + 128 * bj + 4) * (1.f / AS8);
#pragma unroll
            for (int ai = 0; ai < 2; ++ai)
#pragma unroll
                for (int m = 0; m < 4; ++m) { const size_t r = (size_t)u.pm * BM + ai * HALF + wr * 64 + m * 16 + fr;
                    const f32x4 v0 = acc[ai][bj][m][0] * s0 + b0, v1 = acc[ai][bj][m][1] * s1 + b1_;
                    *(uint2*)((unsigned char*)Y + r * D + c) = make_uint2(pk_fp8x4(v0[0] * YS8, v0[1] * YS8, v0[2] * YS8, v0[3] * YS8), pk_fp8x4(v1[0] * YS8, v1[1] * YS8, v1[2] * YS8, v1[3] * YS8)); }
        }
    }
};
}

__device__ __forceinline__ void phase_g1_fast(const Params& p, int l, unsigned char* lds_raw) {
    pg8::ProbDense P{(const bf16_t*)(p.ws + WS_XN), (const bf16_t*)(p.ws + WS_WINT) + (size_t)l * ZBW * D, D, T / 256, ZBW / 256, (int)gridDim.x, (int)blockIdx.x, true};
    pg8::EpiG1F E{(bf16_t*)(p.ws + WS_ZB), (float*)(p.ws + WS_GATE), p.in[7] + l * 64, p.in[8] + l * 64, p.in[12] + l * 64, p.in[13] + l * 64};
    pg8::gemm_phase<pg8::ProbDense, pg8::EpiG1F, true, true>((PG8_LAS unsigned char*)lds_raw, P, E);
}
__device__ __forceinline__ void phase_g2_fast(const Params& p, int l, unsigned char* lds_raw) {
    pg8::ProbDense P{(const bf16_t*)(p.ws + WS_ATTB), (const bf16_t*)(p.ws + WS_WOT) + (size_t)l * D * D, D, T / 256, D / 256, (int)gridDim.x, (int)blockIdx.x, false};
    pg8::EpiG2 E{l == 0 ? p.in[0] : (const float*)nullptr, (bf16_t*)(p.ws + WS_XAB), (const float*)(p.ws + WS_MOD) + (size_t)l * Bn * 6144 + 2 * D};
    pg8::gemm_phase<pg8::ProbDense, pg8::EpiG2, true, true>((PG8_LAS unsigned char*)lds_raw, P, E);
}
constexpr int LDS_PS_OFF = 131072;
__device__ __forceinline__ void phase_ck_fast(const Params& p, int l, unsigned char* lds_raw) {
    pg8::ProbCmp P{(const bf16_t*)(p.ws + WS_ZB), (const bf16_t*)(p.ws + WS_WCT) + (size_t)l * 2 * 128 * 2048, 2048, (int)gridDim.x, (int)blockIdx.x};
    pg8::EpiCmp E{(float*)(p.ws + WS_HIDP)};
    pg8::gemm_phase<pg8::ProbCmp, pg8::EpiCmp, true, true>((PG8_LAS unsigned char*)lds_raw, P, E);
    { const int tid = otid(), lane = tid & 63, wave = tid >> 6, r8 = lane >> 3, c8 = lane & 7;
      const bf16_t* Z = (const bf16_t*)(p.ws + WS_ZB); bf16_t* KMB = (bf16_t*)(p.ws + WS_KMB);
      float* part = (float*)(lds_raw + 131072 + 512);
      for (int it0 = blockIdx.x * 2; it0 < Bn * 8 * 32; it0 += gridDim.x * 2) {
          const int it = it0 + (wave >> 2), q = wave & 3;
          const int b = it / 256, h = (it / 32) & 7, blk = it & 31;
          const bf16_t* base = Z + (size_t)(b * S + blk * 256 + q * 64 + r8) * ZBW + ZB_MK + h * 64 + c8 * 8;
          float s[8] = {0.f, 0.f, 0.f, 0.f, 0.f, 0.f, 0.f, 0.f};
          uint4 v[8];
#pragma unroll
          for (int i = 0; i < 8; ++i) v[i] = *(const uint4*)(base + (size_t)(8 * i) * ZBW);
#pragma unroll
          for (int i = 0; i < 8; ++i) { const unsigned w[4] = {v[i].x, v[i].y, v[i].z, v[i].w};
#pragma unroll
              for (int e = 0; e < 4; ++e) { s[2 * e] += __builtin_bit_cast(float, w[e] << 16); s[2 * e + 1] += __builtin_bit_cast(float, w[e] & 0xffff0000u); } }
#pragma unroll
          for (int e = 0; e < 8; ++e) { s[e] += __shfl_xor(s[e], 8); s[e] += __shfl_xor(s[e], 16); s[e] += __shfl_xor(s[e], 32); }
          if (r8 == 0) {
#pragma unroll
              for (int e = 0; e < 8; ++e) part[wave * 64 + c8 * 8 + e] = s[e]; }
          __syncthreads();
          if (tid < 128) { const int item = tid >> 6, d = tid & 63; const float* pp = part + item * 256 + d;
              KMB[(size_t)(it0 + item) * 64 + d] = (bf16_t)f2bf((((pp[0] + pp[64]) + pp[128]) + pp[192]) * (1.f / 256.f)); }
          __syncthreads();
      } }
}
__device__ __forceinline__ void phase_m1_fast(const Params& p, int l, unsigned char* lds_raw) {
    int* ps = (int*)(lds_raw + LDS_PS_OFF);
    load_pstart(p, l, ps);
    pg8::ProbMoe1 P{(const bf16_t*)(p.ws + WS_XN8), (const bf16_t*)(p.ws + WS_W1T) + (size_t)l * NE * 2048 * 512, (const int*)(p.ws + WS_ROWTOK) + (size_t)l * RMAX, (pg8::lds_ints)ps, 512, ps[32] / 256, (int)gridDim.x, (int)blockIdx.x};
    pg8::EpiM1 E{p.ws + WS_ACT, p.in[18] + (size_t)l * NE * 2048, (const float*)(p.ws + WS_DQ1) + (size_t)l * NE * 2048};
    pg8::gemm_phase<pg8::ProbMoe1, pg8::EpiM1, true, true>((PG8_LAS unsigned char*)lds_raw, P, E);
    __syncthreads();
}
__device__ __forceinline__ void phase_m2_fast(const Params& p, int l, unsigned char* lds_raw) {
    int* ps = (int*)(lds_raw + LDS_PS_OFF);
    load_pstart(p, l, ps);
    pg8::ProbMoe2 P{(const bf16_t*)(p.ws + WS_ACT), (const bf16_t*)(p.ws + WS_W2T) + (size_t)l * NE * D * 512, (pg8::lds_ints)ps, 512, ps[32] / 256, (int)gridDim.x, (int)blockIdx.x};
    pg8::EpiM2 E{(bf16_t*)(p.ws + WS_Y), p.in[20] + (size_t)l * NE * D, (const float*)(p.ws + WS_DQ2) + (size_t)l * NE * D};
    pg8::gemm_phase<pg8::ProbMoe2, pg8::EpiM2, true, true>((PG8_LAS unsigned char*)lds_raw, P, E);
    __syncthreads();
}

namespace at {
#define AT_LAS __attribute__((address_space(3)))
typedef short bf16x8 __attribute__((ext_vector_type(8)));
typedef short s16x4 __attribute__((ext_vector_type(4)));
typedef short v4i16_t __attribute__((ext_vector_type(4)));
typedef float f32x16 __attribute__((ext_vector_type(16)));
typedef unsigned u32x4 __attribute__((ext_vector_type(4)));
typedef float f32x2_t __attribute__((ext_vector_type(2))); typedef __bf16 bf16x2_t __attribute__((ext_vector_type(2)));
typedef AT_LAS unsigned char* lp;
constexpr int L_K = 0  , L_V = 32768  , L_WSF = 65536, L_OST = 67584  , L_SELM = 133120, L_UNI = 134144, L_KMT = 134400, L_END = 142592;
constexpr float NEGS = -1e30f;
constexpr float MAXTHR = 12.f;
__device__ __forceinline__ int crow(int r, int hi) { return (r & 3) + 8 * (r >> 2) + 4 * hi; }
__device__ __forceinline__ unsigned cvtpk(float lo, float hi) { f32x2_t v = {lo, hi}; bf16x2_t b = __builtin_convertvector(v, bf16x2_t); return __builtin_bit_cast(unsigned, b); }
__device__ __forceinline__ float mx3(float a, float b, float c) { return __builtin_fmaxf(__builtin_fmaxf(a, b), c); }
__device__ __forceinline__ void wsync() { asm volatile("s_waitcnt lgkmcnt(0)" ::: "memory"); __builtin_amdgcn_wave_barrier(); }
__device__ __forceinline__ void bar() { __builtin_amdgcn_s_barrier(); }
#define AT_WAITV(n) asm volatile("s_waitcnt vmcnt(" #n ")" ::: "memory")
#define AT_WAITL() asm volatile("s_waitcnt lgkmcnt(0)" ::: "memory")
__device__ __forceinline__ void glds(const void* g, lp dst) { __builtin_amdgcn_global_load_lds((const unsigned*)g, (AT_LAS unsigned*)dst, 16, 0, 0); }
__device__ __forceinline__ s16x4 vtr(const AT_LAS unsigned char* p) { return __builtin_bit_cast(s16x4, __builtin_amdgcn_ds_read_tr16_b64_v4i16((AT_LAS v4i16_t*)p)); }

__device__ __forceinline__ void dma_k(lp slot, const bf16_t* kbase, int pitch, int key0, int wid, int lane) { glds(kbase + (size_t)(key0 + lane) * pitch + wid * 8, slot + wid * 1024); }
__device__ __forceinline__ void dma_v(lp slot, const bf16_t* vbase, int pitch, int key0, int wid, int lane) {
    glds(vbase + (size_t)(key0 + 16 * (wid & 3) + (lane >> 2)) * pitch + (wid >> 2) * 32 + (lane & 3) * 8, slot + wid * 1024); }

__device__ __forceinline__ void qk_tile(f32x16& p0, f32x16& p1, lp kslot, const bf16x8 (&qr)[4], int r32, int hi) {
    const AT_LAS unsigned char* kb = kslot + hi * 1024 + r32 * 16;
    bf16x8 b0[4], b1[4];
#pragma unroll
    for (int d0 = 0; d0 < 4; ++d0) { b0[d0] = *(const AT_LAS bf16x8*)(kb + d0 * 2048); b1[d0] = *(const AT_LAS bf16x8*)(kb + d0 * 2048 + 512); }
#pragma unroll
    for (int d0 = 0; d0 < 4; ++d0) {
        p0 = __builtin_amdgcn_mfma_f32_32x32x16_bf16(b0[d0], qr[d0], p0, 0, 0, 0);
        p1 = __builtin_amdgcn_mfma_f32_32x32x16_bf16(b1[d0], qr[d0], p1, 0, 0, 0);
    }
}
struct VFrag { bf16x8 f[8]; };
__device__ __forceinline__ void pv_load(VFrag& v, lp vslot, int lane, int hi) {
    const AT_LAS unsigned char* vp = vslot + ((lane >> 4) & 1) * 32 + (lane & 3) * 8 + (4 * hi + ((lane & 15) >> 2)) * 64;
#pragma unroll
    for (int d0 = 0; d0 < 2; ++d0)
#pragma unroll
        for (int ks = 0; ks < 4; ++ks) {
            const s16x4 lo = vtr(vp + d0 * 4096 + ks * 1024), hh = vtr(vp + d0 * 4096 + ks * 1024 + 512);
            v.f[d0 * 4 + ks] = (bf16x8){lo[0], lo[1], lo[2], lo[3], hh[0], hh[1], hh[2], hh[3]};
        }
}
__device__ __forceinline__ void pv_mfma(f32x16 (&o)[2], const VFrag& v, u32x4 pw0, u32x4 pw1, u32x4 pw2, u32x4 pw3) {
    const bf16x8 pa[4] = {__builtin_bit_cast(bf16x8, pw0), __builtin_bit_cast(bf16x8, pw1), __builtin_bit_cast(bf16x8, pw2), __builtin_bit_cast(bf16x8, pw3)};
#pragma unroll
    for (int ks = 0; ks < 4; ++ks) {
        o[0] = __builtin_amdgcn_mfma_f32_32x32x16_bf16(pa[ks], v.f[ks], o[0], 0, 0, 0);
        o[1] = __builtin_amdgcn_mfma_f32_32x32x16_bf16(pa[ks], v.f[4 + ks], o[1], 0, 0, 0);
    }
}
__device__ __forceinline__ float rowmax(const f32x16& p0, const f32x16& p1) {
    float a = mx3(p0[0], p0[1], p1[0]), b = mx3(p0[2], p0[3], p1[1]); a = mx3(a, p1[2], p1[3]);
#pragma unroll
    for (int r = 4; r < 16; r += 4) { a = mx3(a, p0[r], p0[r + 1]); b = mx3(b, p0[r + 2], p0[r + 3]); a = mx3(a, p1[r], p1[r + 1]); b = mx3(b, p1[r + 2], p1[r + 3]); }
    const float m = __builtin_fmaxf(a, b);
    auto rr = __builtin_amdgcn_permlane32_swap(__float_as_uint(m), __float_as_uint(m), false, false);
    return __builtin_fmaxf(__uint_as_float(rr[0]), __uint_as_float(rr[1]));
}
__device__ __forceinline__ float halfsum(float v) {
    auto rr = __builtin_amdgcn_permlane32_swap(__float_as_uint(v), __float_as_uint(v), false, false);
    return __uint_as_float(rr[0]) + __uint_as_float(rr[1]);
}
__device__ __forceinline__ void mask_tile(f32x16& p0, f32x16& p1, int lo, int hi_, int hi) {
    const int kb = 4 * hi;
#pragma unroll
    for (int r = 0; r < 16; ++r) { const int kv = kb + (r & 3) + 8 * (r >> 2); if (kv > hi_ || kv < lo) p0[r] = NEGS; if (kv + 32 > hi_ || kv + 32 < lo) p1[r] = NEGS; }
}

__device__ __forceinline__ void mask_init_lo(f32x16& p0, f32x16& p1, int lo, int hi) {
    const int kb = 4 * hi;
#pragma unroll
    for (int r = 0; r < 16; ++r) { const int kv = kb + (r & 3) + 8 * (r >> 2); if (kv < lo) p0[r] = NEGS; if (kv + 32 < lo) p1[r] = NEGS; }
}
__device__ __forceinline__ void mask_init(f32x16& p0, f32x16& p1, int hi_, int hi) {
    const int kb = 4 * hi;
#pragma unroll
    for (int r = 0; r < 16; ++r) { const int kv = kb + (r & 3) + 8 * (r >> 2); if (kv > hi_) p0[r] = NEGS; if (kv + 32 > hi_) p1[r] = NEGS; }
}
__device__ __forceinline__ int next_bit128(unsigned u0, unsigned u1, unsigned u2, unsigned u3, int below) {
    if (below > 96) { unsigned x = u3; if (below < 128) x &= (1u << (below - 96)) - 1u; if (x) return 96 + 31 - __builtin_clz(x); }
    if (below > 64) { unsigned x = u2; if (below < 96) x &= (1u << (below - 64)) - 1u; if (x) return 64 + 31 - __builtin_clz(x); }
    if (below > 32) { unsigned x = u1; if (below < 64) x &= (1u << (below - 32)) - 1u; if (x) return 32 + 31 - __builtin_clz(x); }
    if (below > 0) { unsigned x = u0; if (below < 32) x &= (1u << below) - 1u; if (x) return 31 - __builtin_clz(x); }
    return -1;
}
struct Soft { float m, l; };

template <bool HAS_O>
__device__ __forceinline__ void softmax_step(f32x16& p0, f32x16& p1, Soft& st, f32x16 (&o)[2], float* wsf, int r32, int hi) {
    const float rm = rowmax(p0, p1);
    if (__any(rm > MAXTHR)) {
        const float dl = __builtin_fmaxf(rm, 0.f); st.m += dl;
#pragma unroll
        for (int r = 0; r < 16; ++r) { p0[r] -= dl; p1[r] -= dl; }
        const float al = __builtin_amdgcn_exp2f(-dl); st.l *= al;
        if (HAS_O) {
            if (hi == 0) wsf[r32] = al;
            wsync();
#pragma unroll
            for (int r = 0; r < 16; ++r) { const float f = wsf[crow(r, hi)]; o[0][r] *= f; o[1][r] *= f; }
            wsync();
        }
    }
    float s = 0.f;
#pragma unroll
    for (int r = 0; r < 16; ++r) { p0[r] = __builtin_amdgcn_exp2f(p0[r]); p1[r] = __builtin_amdgcn_exp2f(p1[r]); s += p0[r] + p1[r]; }
    st.l += s;
}
#define AT_PACK(P0, P1) \
    const u32x4 pw0 = {cvtpk(P0[0], P0[1]), cvtpk(P0[2], P0[3]), cvtpk(P0[4], P0[5]), cvtpk(P0[6], P0[7])}, pw1 = {cvtpk(P0[8], P0[9]), cvtpk(P0[10], P0[11]), cvtpk(P0[12], P0[13]), cvtpk(P0[14], P0[15])}, \
                pw2 = {cvtpk(P1[0], P1[1]), cvtpk(P1[2], P1[3]), cvtpk(P1[4], P1[5]), cvtpk(P1[6], P1[7])}, pw3 = {cvtpk(P1[8], P1[9]), cvtpk(P1[10], P1[11]), cvtpk(P1[12], P1[13]), cvtpk(P1[14], P1[15])}
__device__ __forceinline__ float fma_vsv(float a, float k, float x) { float d; asm("v_fma_f32 %0, %1, %2, %3" : "=v"(d) : "v"(a), "s"(k), "v"(x)); return d; }
__device__ __forceinline__ f32x16 cinit(float c2k, int hi, float x) { f32x16 c; const float xb = __builtin_fmaf(c2k, (float)(4 * hi), x);
    c[0] = xb;
#pragma unroll
    for (int r = 1; r < 16; ++r) c[r] = fma_vsv(c2k, (float)((r & 3) + 8 * (r >> 2)), xb);
    return c; }
template <bool FIRST>
__device__ __forceinline__ void acc_scaled(float* stage, const f32x16 (&o)[2], float f, float* wsf, int r32, int hi) {
    if (hi == 0) wsf[r32] = f;
    wsync();
#pragma unroll
    for (int r = 0; r < 16; ++r) { const int orow = crow(r, hi); const float g = wsf[orow]; float* s0 = stage + orow * 64 + r32;
        if (FIRST) { s0[0] = o[0][r] * g; s0[32] = o[1][r] * g; } else { s0[0] += o[0][r] * g; s0[32] += o[1][r] * g; } }
    wsync();
}

#define AT_WAIT_NEWER(newer, per) do { if ((newer) >= 2) { if ((per) == 2) AT_WAITV(4); else AT_WAITV(2); } else if ((newer) == 1) { if ((per) == 2) AT_WAITV(2); else AT_WAITV(1); } else AT_WAITV(0); } while (0)


#define AT_SB() __builtin_amdgcn_sched_barrier(0)
struct PipeOut { float s, rmn; };
__device__ __forceinline__ PipeOut pipe_step(f32x16& c0, f32x16& c1, f32x16& n0, f32x16& n1, f32x16 (&o)[2], lp kslot_next, lp vslot, const bf16x8 (&qr)[4], int lane, int r32, int hi) {
    const AT_LAS unsigned char* kb = kslot_next + hi * 1024 + r32 * 16;
    const AT_LAS unsigned char* vp = vslot + ((lane >> 4) & 1) * 32 + (lane & 3) * 8 + (4 * hi + ((lane & 15) >> 2)) * 64;
    bf16x8 kf[8];
#pragma unroll
    for (int j = 0; j < 4; ++j) kf[j] = *(const AT_LAS bf16x8*)(kb + (j >> 1) * 2048 + (j & 1) * 512);
    AT_SB();
    unsigned w0[8], w1[8]; s16x4 vl[8], vh[8]; float s = 0.f;
#pragma unroll
    for (int j = 0; j < 8; ++j) {
        if (j & 1) n1 = __builtin_amdgcn_mfma_f32_32x32x16_bf16(kf[j], qr[j >> 1], n1, 0, 0, 0);
        else       n0 = __builtin_amdgcn_mfma_f32_32x32x16_bf16(kf[j], qr[j >> 1], n0, 0, 0, 0);
        if (j < 4) kf[j + 4] = *(const AT_LAS bf16x8*)(kb + ((j + 4) >> 1) * 2048 + (j & 1) * 512);
        if (j >= 4) {
#pragma unroll
            for (int q = 0; q < 2; ++q) { const int f = (j - 4) * 2 + q, d0 = f >> 2, ks = f & 3; vl[f] = vtr(vp + d0 * 4096 + ks * 1024); vh[f] = vtr(vp + d0 * 4096 + ks * 1024 + 512); }
        }
        const float e0 = __builtin_amdgcn_exp2f(c0[2 * j]), e1 = __builtin_amdgcn_exp2f(c0[2 * j + 1]), e2 = __builtin_amdgcn_exp2f(c1[2 * j]), e3 = __builtin_amdgcn_exp2f(c1[2 * j + 1]);
        s += (e0 + e1) + (e2 + e3);
        asm volatile("" : "+v"(s));
        w0[j] = cvtpk(e0, e1); w1[j] = cvtpk(e2, e3);
        AT_SB();
    }
    const u32x4 pw0 = {w0[0], w0[1], w0[2], w0[3]}, pw1 = {w0[4], w0[5], w0[6], w0[7]}, pw2 = {w1[0], w1[1], w1[2], w1[3]}, pw3 = {w1[4], w1[5], w1[6], w1[7]};
    const bf16x8 pa[4] = {__builtin_bit_cast(bf16x8, pw0), __builtin_bit_cast(bf16x8, pw1), __builtin_bit_cast(bf16x8, pw2), __builtin_bit_cast(bf16x8, pw3)};
    float a = mx3(n0[0], n0[1], n1[0]), b = mx3(n0[2], n0[3], n1[1]);
#pragma unroll
    for (int f = 0; f < 8; ++f) {
        const int d0 = f >> 2, ks = f & 3;
        const bf16x8 vf = (bf16x8){vl[f][0], vl[f][1], vl[f][2], vl[f][3], vh[f][0], vh[f][1], vh[f][2], vh[f][3]};
        o[d0] = __builtin_amdgcn_mfma_f32_32x32x16_bf16(pa[ks], vf, o[d0], 0, 0, 0);
        if (f == 0) { a = mx3(a, n1[2], n1[3]); }
        else if (f < 4) { const int r = 4 * f; a = mx3(a, n0[r], n0[r + 1]); b = mx3(b, n0[r + 2], n0[r + 3]); a = mx3(a, n1[r], n1[r + 1]); b = mx3(b, n1[r + 2], n1[r + 3]); }
        asm volatile("" : "+v"(a), "+v"(b));
        AT_SB();
    }
    const float m = __builtin_fmaxf(a, b);
    auto rr = __builtin_amdgcn_permlane32_swap(__float_as_uint(m), __float_as_uint(m), false, false);
    PipeOut out; out.s = s; out.rmn = __builtin_fmaxf(__uint_as_float(rr[0]), __uint_as_float(rr[1]));
    return out;
}
__device__ __forceinline__ void nsa_unit(const Params& p, int b, int g, int c, unsigned char* lds_raw) {
    const int tid = otid(), lane = tid & 63, r32 = lane & 31, hi = lane >> 5, wid = __builtin_amdgcn_readfirstlane(tid >> 6);
    lp lds = (lp)lds_raw;
    const bf16_t* ZB = (const bf16_t*)(p.ws + WS_ZB); const float* GT = (const float*)(p.ws + WS_GATE);
    const bf16_t* KCB = (const bf16_t*)(p.ws + WS_KCB) + (size_t)(b * 2 + g) * 512 * 64; const bf16_t* VCB = (const bf16_t*)(p.ws + WS_VCB) + (size_t)(b * 2 + g) * 512 * 64;
    const int t0 = c * 64, hg = r32 >> 3, qq = r32 & 7, qi = 8 * wid + qq, t = t0 + qi, h = 4 * g + hg; const size_t tt = (size_t)b * S + t;
    float* wsf = (float*)(lds_raw + L_WSF) + wid * 64;
    float* ostage = (float*)(lds_raw + L_OST) + wid * 2048;
    float* imp = ostage;
    unsigned* selm = (unsigned*)(lds_raw + L_SELM);
    unsigned* uni = (unsigned*)(lds_raw + L_UNI);
    const float c2 = exp2f(-(float)(h + 1)) * LOG2E;
    bf16x8 qr[4];
#pragma unroll
    for (int d0 = 0; d0 < 4; ++d0) qr[d0] = *(const bf16x8*)(ZB + tt * ZBW + ZB_Q + h * 64 + d0 * 16 + hi * 8);
    const float gt0 = GT[tt * 32 + h * 3 + 0], gt1 = GT[tt * 32 + h * 3 + 1], gt2 = GT[tt * 32 + h * 3 + 2];
    f32x16 o[2];
    const lp sK0 = lds + L_K, sV0 = lds + L_V;
    const int nmax = t >= 31 ? (t - 31) >> 4 : -1;
    const int ntc = ((4 * c + 2) >> 6) + 1;
    for (int i = lane; i < 8 * 129; i += 64) imp[i] = 0.f;
    Soft sc; sc.m = 0.f; sc.l = 0.f;
#pragma unroll
    for (int k = 0; k < 3; ++k) if (k < ntc) dma_k(sK0 + k * 8192, KCB, 64, 64 * k, wid, lane);
    for (int k = 0; k < ntc; ++k) {
        const int newer = ntc - 1 - k; AT_WAIT_NEWER(newer, 1);
        AT_WAITL(); bar();
        if (k + 3 < ntc) dma_k(sK0 + ((k + 3) & 3) * 8192, KCB, 64, 64 * (k + 3), wid, lane);
        const lp sK = sK0 + (k & 3) * 8192;
        const float x0 = c2 * (16.f * (64 * k) + 15.5f - (float)t0) - sc.m;
        f32x16 p0 = cinit(16.f * c2, hi, x0), p1 = cinit(16.f * c2, hi, x0 + c2 * 512.f);
        qk_tile(p0, p1, sK, qr, r32, hi);
        if (__any(nmax - 64 * k < 63)) mask_tile(p0, p1, 0, nmax - 64 * k, hi);
        softmax_step<false>(p0, p1, sc, o, wsf, r32, hi);
    }
    const float lc = halfsum(sc.l), linv = lc > 0.f ? 1.f / lc : 0.f;
    o[0] = f32x16{}; o[1] = f32x16{};
    AT_WAITL(); bar();
#pragma unroll
    for (int k = 0; k < 3; ++k) if (k < ntc) { dma_k(sK0 + k * 8192, KCB, 64, 64 * k, wid, lane); dma_v(sV0 + k * 8192, VCB, 64, 64 * k, wid, lane); }
    for (int k = 0; k < ntc; ++k) {
        const int newer = ntc - 1 - k; AT_WAIT_NEWER(newer, 2);
        AT_WAITL(); bar();
        if (k + 3 < ntc) { dma_k(sK0 + ((k + 3) & 3) * 8192, KCB, 64, 64 * (k + 3), wid, lane); dma_v(sV0 + ((k + 3) & 3) * 8192, VCB, 64, 64 * (k + 3), wid, lane); }
        const lp sK = sK0 + (k & 3) * 8192, sV = sV0 + (k & 3) * 8192;
        const float x0 = c2 * (16.f * (64 * k) + 15.5f - (float)t0) - sc.m;
        f32x16 p0 = cinit(16.f * c2, hi, x0), p1 = cinit(16.f * c2, hi, x0 + c2 * 512.f);
        qk_tile(p0, p1, sK, qr, r32, hi);
        if (__any(nmax - 64 * k < 63)) mask_tile(p0, p1, 0, nmax - 64 * k, hi);
        VFrag vf; pv_load(vf, sV, lane, hi);
#pragma unroll
        for (int r = 0; r < 16; ++r) { p0[r] = __builtin_amdgcn_exp2f(p0[r]); p1[r] = __builtin_amdgcn_exp2f(p1[r]); }
        { AT_PACK(p0, p1); pv_mfma(o, vf, pw0, pw1, pw2, pw3); }
        float gs[8], ls[8];
#pragma unroll
        for (int q4 = 0; q4 < 4; ++q4) { gs[q4] = ((p0[4 * q4] + p0[4 * q4 + 1]) + (p0[4 * q4 + 2] + p0[4 * q4 + 3])) * linv; ls[q4] = p0[4 * q4 + 3] * linv;
                                         gs[4 + q4] = ((p1[4 * q4] + p1[4 * q4 + 1]) + (p1[4 * q4 + 2] + p1[4 * q4 + 3])) * linv; ls[4 + q4] = p1[4 * q4 + 3] * linv; }
#pragma unroll
        for (int q4 = 0; q4 < 8; ++q4) { gs[q4] += __shfl_xor(gs[q4], 8); gs[q4] += __shfl_xor(gs[q4], 16); ls[q4] += __shfl_xor(ls[q4], 8); ls[q4] += __shfl_xor(ls[q4], 16); }
        if (r32 < 8) {
            float* row = imp + qq * 129 + 16 * k + hi;
#pragma unroll
            for (int q4 = 0; q4 < 8; ++q4) row[2 * q4] += gs[q4];
        }
        wsync();
        if (r32 < 8) {
            float* row = imp + qq * 129 + 16 * k + hi + 1;
#pragma unroll
            for (int q4 = 0; q4 < 8; ++q4) row[2 * q4] += ls[q4];
        }
        wsync();
    }
    unsigned mk0 = 0u, mk1 = 0u, mk2 = 0u, mk3 = 0u;
    {
        const int qs = lane >> 3, part = lane & 7;
        float v[16];
#pragma unroll
        for (int i = 0; i < 16; ++i) { const int j = part * 16 + i; float x = imp[qs * 129 + j]; if (j == 0 || j == c || j == c - 1) x = 1e4f; if (j > c) x = NEGS; v[i] = x; }
#pragma unroll 1
        for (int it = 0; it < 16; ++it) {
            float bv = -3e38f; int bi = 0;
#pragma unroll
            for (int i = 0; i < 16; ++i) if (v[i] > bv) { bv = v[i]; bi = part * 16 + i; }
#pragma unroll
            for (int sft = 1; sft < 8; sft <<= 1) { const float ov = __shfl_xor(bv, sft); const int oi = __shfl_xor(bi, sft); if (ov > bv || (ov == bv && oi < bi)) { bv = ov; bi = oi; } }
            if (bv > NEGS) { const unsigned bit = 1u << (bi & 31); const int wq = bi >> 5; if (wq == 0) mk0 |= bit; else if (wq == 1) mk1 |= bit; else if (wq == 2) mk2 |= bit; else mk3 |= bit; }
#pragma unroll
            for (int i = 0; i < 16; ++i) if (part * 16 + i == bi) v[i] = -3.4e38f;
        }
        if (part == 0) { unsigned* sm = selm + (8 * wid + qs) * 4; sm[0] = mk0; sm[1] = mk1; sm[2] = mk2; sm[3] = mk3; }
        unsigned u0 = mk0, u1 = mk1, u2 = mk2, u3 = mk3;
#pragma unroll
        for (int sft = 8; sft < 64; sft <<= 1) { u0 |= __shfl_xor(u0, sft); u1 |= __shfl_xor(u1, sft); u2 |= __shfl_xor(u2, sft); u3 |= __shfl_xor(u3, sft); }
        if (lane == 0) { uni[wid * 4 + 0] = u0; uni[wid * 4 + 1] = u1; uni[wid * 4 + 2] = u2; uni[wid * 4 + 3] = u3; }
    }
    wsync();
    acc_scaled<true>(ostage, o, gt0 * linv, wsf, r32, hi);
    AT_WAITL(); bar();
    unsigned un0 = 0u, un1 = 0u, un2 = 0u, un3 = 0u;
#pragma unroll
    for (int w = 0; w < 8; ++w) { un0 |= uni[w * 4 + 0]; un1 |= uni[w * 4 + 1]; un2 |= uni[w * 4 + 2]; un3 |= uni[w * 4 + 3]; }
    un0 = __builtin_amdgcn_readfirstlane(un0); un1 = __builtin_amdgcn_readfirstlane(un1); un2 = __builtin_amdgcn_readfirstlane(un2); un3 = __builtin_amdgcn_readfirstlane(un3);
    const unsigned my0 = selm[(8 * wid + qq) * 4 + 0], my1 = selm[(8 * wid + qq) * 4 + 1], my2 = selm[(8 * wid + qq) * 4 + 2], my3 = selm[(8 * wid + qq) * 4 + 3];
    {
        const bf16_t* KS = ZB + (size_t)b * S * ZBW + ZB_KS + g * 64; const bf16_t* VS = ZB + (size_t)b * S * ZBW + ZB_VS + g * 64;
        Soft ss; ss.m = 0.f; ss.l = 0.f; o[0] = f32x16{}; o[1] = f32x16{};
        const int nsel = __builtin_popcount(un0) + __builtin_popcount(un1) + __builtin_popcount(un2) + __builtin_popcount(un3);
        int ji = 128;
#pragma unroll
        for (int k = 0; k < 3; ++k) if (k < nsel) { ji = next_bit128(un0, un1, un2, un3, ji); dma_k(sK0 + k * 8192, KS, ZBW, 64 * ji, wid, lane); dma_v(sV0 + k * 8192, VS, ZBW, 64 * ji, wid, lane); }
        int j = 128;
        for (int i = 0; i < nsel; ++i) {
            j = next_bit128(un0, un1, un2, un3, j);
            const int newer = nsel - 1 - i; AT_WAIT_NEWER(newer, 2);
            AT_WAITL(); bar();
            if (i + 3 < nsel) { ji = next_bit128(un0, un1, un2, un3, ji); dma_k(sK0 + ((i + 3) & 3) * 8192, KS, ZBW, 64 * ji, wid, lane); dma_v(sV0 + ((i + 3) & 3) * 8192, VS, ZBW, 64 * ji, wid, lane); }
            const lp sK = sK0 + (i & 3) * 8192, sV = sV0 + (i & 3) * 8192;
            const unsigned mw = (j >> 5) == 0 ? my0 : (j >> 5) == 1 ? my1 : (j >> 5) == 2 ? my2 : my3;
            const bool sel = (mw >> (j & 31)) & 1u;
            const float x0 = sel ? c2 * (float)(64 * j - t0) - ss.m : NEGS;
            f32x16 p0 = cinit(c2, hi, x0), p1 = cinit(c2, hi, sel ? x0 + c2 * 32.f : NEGS);
            qk_tile(p0, p1, sK, qr, r32, hi);
            if (j == c) mask_tile(p0, p1, 0, qi, hi);
            VFrag vf; pv_load(vf, sV, lane, hi);
            softmax_step<true>(p0, p1, ss, o, wsf, r32, hi);
            { AT_PACK(p0, p1); pv_mfma(o, vf, pw0, pw1, pw2, pw3); }
        }
        const float ls_ = halfsum(ss.l);
        acc_scaled<false>(ostage, o, ls_ > 0.f ? gt1 / ls_ : 0.f, wsf, r32, hi);
    }
    {
        const bf16_t* KW = ZB + (size_t)b * S * ZBW + ZB_KW + g * 64; const bf16_t* VW = ZB + (size_t)b * S * ZBW + ZB_VW + g * 64;
        Soft sw; sw.m = 0.f; sw.l = 0.f; o[0] = f32x16{}; o[1] = f32x16{};
        const int k0 = c >= 8 ? 0 : 8 - c, nw = 9 - k0;
        AT_WAITL(); bar();
#pragma unroll
        for (int k = 0; k < 3; ++k) if (k < nw) { dma_k(sK0 + k * 8192, KW, ZBW, t0 - 64 * k, wid, lane); dma_v(sV0 + k * 8192, VW, ZBW, t0 - 64 * k, wid, lane); }
        f32x16 pA0, pA1, pB0, pB1; float rmc;
#define WIN_STEP(C0, C1, N0, N1, I) do { const int i_ = (I); \
            if (i_ + 1 < nw) { if (i_ + 2 < nw) AT_WAITV(2); else AT_WAITV(0); } \
            AT_WAITL(); bar(); \
            if (i_ + 3 < nw) { dma_k(sK0 + ((i_ + 3) & 3) * 8192, KW, ZBW, t0 - 64 * (i_ + 3), wid, lane); dma_v(sV0 + ((i_ + 3) & 3) * 8192, VW, ZBW, t0 - 64 * (i_ + 3), wid, lane); } \
            if (__any(rmc > MAXTHR)) { \
                const float dl = __builtin_fmaxf(rmc, 0.f); sw.m += dl; \
                _Pragma("unroll") for (int r = 0; r < 16; ++r) { C0[r] -= dl; C1[r] -= dl; } \
                const float al = __builtin_amdgcn_exp2f(-dl); sw.l *= al; \
                if (hi == 0) wsf[r32] = al; \
                wsync(); \
                _Pragma("unroll") for (int r = 0; r < 16; ++r) { const float f = wsf[crow(r, hi)]; o[0][r] *= f; o[1][r] *= f; } \
                wsync(); \
            } \
            { const float x0 = c2 * (float)(-64 * (i_ + 1)) - sw.m; \
              N0 = cinit(c2, hi, x0); N1 = cinit(c2, hi, x0 + c2 * 32.f); \
              if (i_ + 1 == 8) mask_init_lo(N0, N1, qi + 1, hi); }        \
            const PipeOut po = pipe_step(C0, C1, N0, N1, o, sK0 + ((i_ + 1) & 3) * 8192, sV0 + (i_ & 3) * 8192, qr, lane, r32, hi); \
            sw.l += po.s; rmc = po.rmn; } while (0)
        { if (nw >= 3) AT_WAITV(4); else if (nw == 2) AT_WAITV(2); else AT_WAITV(0);
          AT_WAITL(); bar(); }
        { pB0 = cinit(c2, hi, 0.f); pB1 = cinit(c2, hi, c2 * 32.f);
          qk_tile(pB0, pB1, sK0, qr, r32, hi);
          mask_tile(pB0, pB1, 0, qi, hi);
          rmc = rowmax(pB0, pB1); }
        int i = 0;
#pragma unroll 1
        for (; i + 1 < nw; i += 2) {
            WIN_STEP(pB0, pB1, pA0, pA1, i);
            WIN_STEP(pA0, pA1, pB0, pB1, i + 1);
        }
        if (i < nw) WIN_STEP(pB0, pB1, pA0, pA1, i);
#undef WIN_STEP
        const float lw = halfsum(sw.l);
        acc_scaled<false>(ostage, o, lw > 0.f ? gt2 / lw : 0.f, wsf, r32, hi);
    }
    {
        bf16_t* AB = (bf16_t*)(p.ws + WS_ATTB);
#pragma unroll
        for (int i = 0; i < 4; ++i) { const int row = i * 8 + (lane >> 3), ch = lane & 7; const float4 a = *(const float4*)(ostage + row * 64 + ch * 8), c4 = *(const float4*)(ostage + row * 64 + ch * 8 + 4);
            const uint4 v = make_uint4(pk2(a.x, a.y), pk2(a.z, a.w), pk2(c4.x, c4.y), pk2(c4.z, c4.w));
            *(uint4*)(AB + ((size_t)b * S + t0 + 8 * wid + (row & 7)) * D + (4 * g + (row >> 3)) * 64 + ch * 8) = v; }
        wsync();
    }
    AT_WAITL(); bar();
}

}

constexpr int MB_CAP = 25600;
namespace at {
__device__ __forceinline__ void moba_route_unit(const Params& p, int b, int h, int qb, unsigned char* lds_raw) {
    const int tid = otid(), lane = tid & 63, r32 = lane & 31, hi = lane >> 5, wid = __builtin_amdgcn_readfirstlane(tid >> 6);
    lp lds = (lp)lds_raw;
    const bf16_t* ZB = (const bf16_t*)(p.ws + WS_ZB);
    const int bh = b * 8 + h;
    const bf16_t* KMB = (const bf16_t*)(p.ws + WS_KMB) + (size_t)bh * 32 * 64;
    const int qi = 32 * wid + r32, t = qb * 256 + qi; const size_t tt = (size_t)b * S + t;
    int* hist = (int*)(lds_raw + L_UNI);
    unsigned* SEL3 = (unsigned*)(p.ws + WS_SEL3); unsigned* LRK = (unsigned*)(p.ws + WS_LRK);
    unsigned char* IL = (unsigned char*)(p.ws + WS_ILIST) + ((size_t)(bh * 32 + qb) * 32) * 256;
    int* BCm = (int*)(p.ws + WS_BCM) + (size_t)(bh * 32 + qb) * 32;
    if (tid < 32) hist[tid] = 0;
    bf16x8 qr[4];
#pragma unroll
    for (int d0 = 0; d0 < 4; ++d0) qr[d0] = *(const bf16x8*)(ZB + tt * ZBW + ZB_MQ + h * 64 + d0 * 16 + hi * 8);
    const lp sKM = lds + L_KMT;
    glds(KMB + (size_t)(lane & 31) * 64 + wid * 8, sKM + wid * 1024);
    AT_WAITV(0); AT_WAITL(); bar();
    f32x16 g0 = f32x16{}, g1 = f32x16{};
    qk_tile(g0, g1, sKM, qr, r32, hi);
    float v1 = NEGS, v2 = NEGS, v3 = NEGS; int i1 = 64, i2 = 64, i3 = 64;
#pragma unroll
    for (int r = 0; r < 16; ++r) { const int n = crow(r, hi); const float s_ = n < qb ? g0[r] : NEGS;
        if (s_ > v1) { v3 = v2; i3 = i2; v2 = v1; i2 = i1; v1 = s_; i1 = n; } else if (s_ > v2) { v3 = v2; i3 = i2; v2 = s_; i2 = n; } else if (s_ > v3) { v3 = s_; i3 = n; } }
    float ov[3]; int oi[3];
    { auto a = __builtin_amdgcn_permlane32_swap(__float_as_uint(v1), __float_as_uint(v1), false, false); ov[0] = __uint_as_float(hi ? a[0] : a[1]); }
    { auto a = __builtin_amdgcn_permlane32_swap(__float_as_uint(v2), __float_as_uint(v2), false, false); ov[1] = __uint_as_float(hi ? a[0] : a[1]); }
    { auto a = __builtin_amdgcn_permlane32_swap(__float_as_uint(v3), __float_as_uint(v3), false, false); ov[2] = __uint_as_float(hi ? a[0] : a[1]); }
    { auto a = __builtin_amdgcn_permlane32_swap((unsigned)i1, (unsigned)i1, false, false); oi[0] = (int)(hi ? a[0] : a[1]); }
    { auto a = __builtin_amdgcn_permlane32_swap((unsigned)i2, (unsigned)i2, false, false); oi[1] = (int)(hi ? a[0] : a[1]); }
    { auto a = __builtin_amdgcn_permlane32_swap((unsigned)i3, (unsigned)i3, false, false); oi[2] = (int)(hi ? a[0] : a[1]); }
#pragma unroll
    for (int k = 0; k < 3; ++k) { const float s_ = ov[k]; const int n = oi[k];
        if (s_ > v1 || (s_ == v1 && n < i1)) { v3 = v2; i3 = i2; v2 = v1; i2 = i1; v1 = s_; i1 = n; }
        else if (s_ > v2 || (s_ == v2 && n < i2)) { v3 = v2; i3 = i2; v2 = s_; i2 = n; }
        else if (s_ > v3 || (s_ == v3 && n < i3)) { v3 = s_; i3 = n; } }
    if (hi == 0) {
        const int j1 = v1 > NEGS ? i1 : 255, j2 = v2 > NEGS ? i2 : 255, j3 = v3 > NEGS ? i3 : 255;
        int l1 = 0, l2 = 0, l3 = 0;
        if (j1 < 32) { l1 = atomicAdd(&hist[j1], 1); IL[j1 * 256 + l1] = (unsigned char)qi; }
        if (j2 < 32) { l2 = atomicAdd(&hist[j2], 1); IL[j2 * 256 + l2] = (unsigned char)qi; }
        if (j3 < 32) { l3 = atomicAdd(&hist[j3], 1); IL[j3 * 256 + l3] = (unsigned char)qi; }
        SEL3[tt * 8 + h] = (unsigned)j1 | ((unsigned)j2 << 8) | ((unsigned)j3 << 16);
        LRK[tt * 8 + h] = (unsigned)l1 | ((unsigned)l2 << 8) | ((unsigned)l3 << 16);
    }
    AT_WAITL(); bar();
    if (tid < 32) BCm[tid] = hist[tid];
    AT_WAITL(); bar();
}
__device__ __forceinline__ void moba_tables(const int* BCmbh, int lane, int& tot, int& seg) {
    int s = 0;
    if (lane < 32) { for (int q = 0; q < 32; ++q) s += BCmbh[q * 32 + lane]; }
    tot = s;
    int pad = (s + 31) & ~31, inc = pad;
#pragma unroll
    for (int sft = 1; sft < 32; sft <<= 1) { const int o_ = __shfl_up(inc, sft); if ((lane & 31) >= sft) inc += o_; }
    seg = inc - pad;
}
__device__ __forceinline__ void moba_gather_unit(const Params& p, int bh, int j, int ch, int segj, bool reload, unsigned char* lds_raw) {
    const int tid = otid(), lane = tid & 63, r32 = lane & 31, hi = lane >> 5, wid = __builtin_amdgcn_readfirstlane(tid >> 6);
    lp lds = (lp)lds_raw;
    const int b = bh >> 3, h = bh & 7;
    const bf16_t* ZB = (const bf16_t*)(p.ws + WS_ZB);
    const int* BCmbh = (const int*)(p.ws + WS_BCM) + (size_t)bh * 32 * 32;
    float* wsf = (float*)(lds_raw + L_WSF) + wid * 64;
    const lp sK0 = lds + L_K, sV0 = lds + L_V;
    const bf16_t* KM_ = ZB + (size_t)b * S * ZBW + ZB_MK + h * 64; const bf16_t* VM_ = ZB + (size_t)b * S * ZBW + ZB_MV + h * 64;
    if (reload) {
#pragma unroll
        for (int k = 3; k >= 0; --k) { dma_k(sK0 + k * 8192, KM_, ZBW, j * 256 + 64 * k, wid, lane); dma_v(sV0 + k * 8192, VM_, ZBW, j * 256 + 64 * k, wid, lane); }
    }
    const int gr = 256 * ch + 32 * wid + r32;
    const int cq = lane < 32 ? BCmbh[lane * 32 + j] : 0;
    int run = 0, qbs = j + 1, lr = 0;
#pragma unroll 4
    for (int q = 0; q < 32; ++q) { const int c_ = __builtin_amdgcn_readlane(cq, q); if (gr >= run && gr < run + c_) { qbs = q; lr = gr - run; } run += c_; }
    const int totj = run;
    const bool valid = gr < totj;
    const unsigned char* IL = (const unsigned char*)(p.ws + WS_ILIST);
    const int qidx = valid ? (int)IL[((size_t)(bh * 32 + qbs) * 32 + j) * 256 + lr] : 0;
    const int t = valid ? qbs * 256 + qidx : (j + 1) * 256; const size_t tt = (size_t)b * S + t;
    const float c2 = exp2f(-(float)(h + 1)) * LOG2E;
    bf16x8 qr[4];
#pragma unroll
    for (int d0 = 0; d0 < 4; ++d0) qr[d0] = *(const bf16x8*)(ZB + tt * ZBW + ZB_MQ + h * 64 + d0 * 16 + hi * 8);
    Soft sm; sm.m = 0.f; sm.l = 0.f; f32x16 o[2]; o[0] = f32x16{}; o[1] = f32x16{};
#pragma unroll 1
    for (int i = 0; i < 4; ++i) {
        if (reload) { const int newer = 3 - i; if (newer >= 3) AT_WAITV(6); else AT_WAIT_NEWER(newer, 2); AT_WAITL(); bar(); }
        const int kt = 3 - i;
        const lp sK = sK0 + kt * 8192, sV = sV0 + kt * 8192;
        const float x0 = c2 * (float)(64 * kt) - sm.m;
        f32x16 p0 = cinit(c2, hi, x0), p1 = cinit(c2, hi, x0 + c2 * 32.f);
        qk_tile(p0, p1, sK, qr, r32, hi);
        VFrag vf; pv_load(vf, sV, lane, hi);
        softmax_step<true>(p0, p1, sm, o, wsf, r32, hi);
        { AT_PACK(p0, p1); pv_mfma(o, vf, pw0, pw1, pw2, pw3); }
    }
    {
        const float lt = halfsum(sm.l);
        float* PM = (float*)(p.ws + WS_PM) + (size_t)bh * MB_CAP; float* PL = (float*)(p.ws + WS_PL) + (size_t)bh * MB_CAP;
        if (hi == 0 && valid) { PM[segj + gr] = sm.m; PL[segj + gr] = lt; }
        bf16_t* stg = (bf16_t*)(lds_raw + L_OST) + wid * 4096;
#pragma unroll
        for (int r = 0; r < 16; ++r) { const int orow = crow(r, hi); stg[orow * 64 + r32] = (bf16_t)f2bf(o[0][r]); stg[orow * 64 + 32 + r32] = (bf16_t)f2bf(o[1][r]); }
        wsync();
        bf16_t* PO = (bf16_t*)(p.ws + WS_PO) + ((size_t)bh * MB_CAP + segj + 256 * ch + 32 * wid) * 64;
        const int nrow = totj - (256 * ch + 32 * wid);
#pragma unroll
        for (int i = 0; i < 4; ++i) { const int row = i * 8 + (lane >> 3), c8 = lane & 7; if (row < nrow) *(uint4*)(PO + (size_t)row * 64 + c8 * 8) = *(const uint4*)(stg + row * 64 + c8 * 8); }
        wsync();
    }
    AT_WAITL(); bar();
}
__device__ __forceinline__ void moba_self_unit(const Params& p, int b, int h, int qb, unsigned char* lds_raw) {
    const int tid = otid(), lane = tid & 63, r32 = lane & 31, hi = lane >> 5, wid = __builtin_amdgcn_readfirstlane(tid >> 6);
    lp lds = (lp)lds_raw;
    const int bh = b * 8 + h;
    const bf16_t* ZB = (const bf16_t*)(p.ws + WS_ZB);
    const int* BCmbh = (const int*)(p.ws + WS_BCM) + (size_t)bh * 32 * 32;
    const int qi = 32 * wid + r32, t = qb * 256 + qi; const size_t tt = (size_t)b * S + t;
    float* wsf = (float*)(lds_raw + L_WSF) + wid * 64;
    float* ostage = (float*)(lds_raw + L_OST) + wid * 2048;
    const float c2 = exp2f(-(float)(h + 1)) * LOG2E;
    bf16x8 qr[4];
#pragma unroll
    for (int d0 = 0; d0 < 4; ++d0) qr[d0] = *(const bf16x8*)(ZB + tt * ZBW + ZB_MQ + h * 64 + d0 * 16 + hi * 8);
    const lp sK0 = lds + L_K, sV0 = lds + L_V;
    const bf16_t* KM_ = ZB + (size_t)b * S * ZBW + ZB_MK + h * 64; const bf16_t* VM_ = ZB + (size_t)b * S * ZBW + ZB_MV + h * 64;
    Soft sm; sm.m = 0.f; sm.l = 0.f; f32x16 o[2]; o[0] = f32x16{}; o[1] = f32x16{};
#pragma unroll
    for (int k = 0; k < 3; ++k) { dma_k(sK0 + k * 8192, KM_, ZBW, qb * 256 + 64 * (3 - k), wid, lane); dma_v(sV0 + k * 8192, VM_, ZBW, qb * 256 + 64 * (3 - k), wid, lane); }
    int tot, seg; moba_tables(BCmbh, lane, tot, seg);
    int before = 0; if (lane < 32) { for (int q = 0; q < qb; ++q) before += BCmbh[q * 32 + lane]; }
    const int base = seg + before;
#pragma unroll 1
    for (int i = 0; i < 4; ++i) {
        const int newer = 3 - i; AT_WAIT_NEWER(newer, 2);
        AT_WAITL(); bar();
        if (i == 0) { dma_k(sK0 + 3 * 8192, KM_, ZBW, qb * 256, wid, lane); dma_v(sV0 + 3 * 8192, VM_, ZBW, qb * 256, wid, lane); }
        const lp sK = sK0 + i * 8192, sV = sV0 + i * 8192;
        const int kt = 3 - i;
        const bool skip = (32 * wid + 31 < 64 * kt);
        if (!skip) {
            const float x0 = c2 * (float)(64 * kt) - sm.m;
            f32x16 p0 = cinit(c2, hi, x0), p1 = cinit(c2, hi, x0 + c2 * 32.f);
            qk_tile(p0, p1, sK, qr, r32, hi);
            if (64 * kt + 63 > 32 * wid) mask_tile(p0, p1, 0, qi - 64 * kt, hi);
            VFrag vf; pv_load(vf, sV, lane, hi);
            softmax_step<true>(p0, p1, sm, o, wsf, r32, hi);
            { AT_PACK(p0, p1); pv_mfma(o, vf, pw0, pw1, pw2, pw3); }
        }
    }
    {
        const float lself = halfsum(sm.l);
        const unsigned s3 = ((const unsigned*)(p.ws + WS_SEL3))[tt * 8 + h], l3 = ((const unsigned*)(p.ws + WS_LRK))[tt * 8 + h];
        const float* PM = (const float*)(p.ws + WS_PM) + (size_t)bh * MB_CAP; const float* PL = (const float*)(p.ws + WS_PL) + (size_t)bh * MB_CAP;
        float mk[3], lk[3]; int pidx[3];
        float M = sm.m + c2 * 256.f * (float)qb;
        const float mself = M;
#pragma unroll
        for (int k = 0; k < 3; ++k) { const int jk = (s3 >> (8 * k)) & 255, lrk = (l3 >> (8 * k)) & 255;
            const int pb = __shfl(base, jk & 31);
            if (jk < 32) { pidx[k] = pb + lrk; mk[k] = PM[pidx[k]] + c2 * 256.f * (float)jk; lk[k] = PL[pidx[k]]; M = __builtin_fmaxf(M, mk[k]); }
            else { pidx[k] = -1; mk[k] = NEGS; lk[k] = 0.f; } }
        const float ws_ = __builtin_amdgcn_exp2f(mself - M);
        float wk[3]; float Lt = lself * ws_;
#pragma unroll
        for (int k = 0; k < 3; ++k) { wk[k] = pidx[k] >= 0 ? __builtin_amdgcn_exp2f(mk[k] - M) : 0.f; Lt += lk[k] * wk[k]; }
        const float inv = Lt > 0.f ? 1.f / Lt : 0.f;
        float* rws = wsf;
        float* rwk = (float*)(lds_raw + L_KMT) + wid * 256;
        int* rpi = (int*)(rwk + 96);
        if (hi == 0) { rws[r32] = ws_ * inv;
#pragma unroll
            for (int k = 0; k < 3; ++k) { rwk[k * 32 + r32] = wk[k] * inv; rpi[k * 32 + r32] = pidx[k]; } }
#pragma unroll
        for (int r = 0; r < 16; ++r) { const int orow = crow(r, hi); ostage[orow * 64 + r32] = o[0][r]; ostage[orow * 64 + 32 + r32] = o[1][r]; }
        wsync();
        const bf16_t* PO = (const bf16_t*)(p.ws + WS_PO) + (size_t)bh * MB_CAP * 64;
        bf16_t* AB = (bf16_t*)(p.ws + WS_ATTB);
#pragma unroll
        for (int i = 0; i < 4; ++i) { const int row = i * 8 + (lane >> 3), c8 = lane & 7;
            const float4 a = *(const float4*)(ostage + row * 64 + c8 * 8), c4 = *(const float4*)(ostage + row * 64 + c8 * 8 + 4);
            const float w0 = rws[row];
            float acc8[8] = {a.x * w0, a.y * w0, a.z * w0, a.w * w0, c4.x * w0, c4.y * w0, c4.z * w0, c4.w * w0};
#pragma unroll
            for (int k = 0; k < 3; ++k) { const int pi = rpi[k * 32 + row]; if (pi >= 0) { const float w = rwk[k * 32 + row]; const uint4 q = *(const uint4*)(PO + (size_t)pi * 64 + c8 * 8);
                const unsigned qq_[4] = {q.x, q.y, q.z, q.w};
#pragma unroll
                for (int e = 0; e < 4; ++e) { acc8[2 * e] += __builtin_bit_cast(float, qq_[e] << 16) * w; acc8[2 * e + 1] += __builtin_bit_cast(float, qq_[e] & 0xffff0000u) * w; } } }
            *(uint4*)(AB + ((size_t)b * S + qb * 256 + 32 * wid + row) * D + 512 + h * 64 + c8 * 8) = make_uint4(pk2(acc8[0], acc8[1]), pk2(acc8[2], acc8[3]), pk2(acc8[4], acc8[5]), pk2(acc8[6], acc8[7])); }
        wsync();
    }
    AT_WAITL(); bar();
}
}

__device__ __forceinline__ void phase_att1(const Params& p, unsigned char* lds_raw) {
    const int tid = otid();
    int* pre = (int*)(lds_raw + at::L_END);
    int* segt = pre + 514;
    { const int* BCm = (const int*)(p.ws + WS_BCM); const int bh = tid >> 5, j = tid & 31; int s = 0;
      for (int q = 0; q < 32; ++q) s += BCm[(size_t)(bh * 32 + q) * 32 + j];
      pre[tid + 1] = (s + 255) >> 8; if (tid == 0) pre[0] = 0;
      segt[tid] = (s + 31) & ~31; }
    __syncthreads();
    for (int sft = 1; sft < 512; sft <<= 1) { int v = 0, w = 0; if (tid >= sft) v = pre[tid + 1 - sft]; if ((tid & 31) >= sft) w = segt[tid - sft]; __syncthreads(); pre[tid + 1] += v; if (sft < 32) segt[tid] += w; __syncthreads(); }
    { const int* BCm = (const int*)(p.ws + WS_BCM); const int bh = tid >> 5, j = tid & 31; int s = 0;
      for (int q = 0; q < 32; ++q) s += BCm[(size_t)(bh * 32 + q) * 32 + j];
      const int excl = segt[tid] - ((s + 31) & ~31); __syncthreads(); segt[tid] = excl; }
    __syncthreads();
    const int nun = pre[512];
    for (int pi = blockIdx.x; pi < 512; pi += gridDim.x) {
        const int rnd = pi >> 8, id = pi & 255;
        const int bg = 2 * rnd + (id >> 7), c = rnd ? 127 - (id & 127) : (id & 127); at::nsa_unit(p, bg >> 1, bg & 1, c, lds_raw);
    }
    {
        const int u0 = (int)(((long)blockIdx.x * nun) / gridDim.x), u1 = (int)(((long)(blockIdx.x + 1) * nun) / gridDim.x);
        int prev = -1;
        for (int u = u0; u < u1; ++u) {
            int lo = 0, hi_ = 511;
            while (lo < hi_) { const int mid = (lo + hi_ + 1) >> 1; if (pre[mid] <= u) lo = mid; else hi_ = mid - 1; }
            at::moba_gather_unit(p, lo >> 5, lo & 31, u - pre[lo], segt[lo], lo != prev, lds_raw);
            prev = lo;
        }
    }
}
__device__ __forceinline__ void phase_att2(const Params& p, unsigned char* lds_raw) {
    for (int pi = blockIdx.x; pi < 512; pi += gridDim.x) {
        const int rnd = pi >> 8, id = pi & 255;
        const int bh = 8 * rnd + (id >> 5), qb = rnd ? 31 - (id & 31) : (id & 31); at::moba_self_unit(p, bh >> 3, bh & 7, qb, lds_raw);
    }
}
__device__ __forceinline__ void phase_route(const Params& p, unsigned char* lds_raw) {
    for (int pi = blockIdx.x; pi < 512; pi += gridDim.x) at::moba_route_unit(p, pi >> 8, (pi >> 5) & 7, pi & 31, lds_raw);
}


__device__ __forceinline__ void phase_r2_fast(const Params& p, int l, unsigned char* lds_raw) {
    using namespace at;
    const int tid = otid(), lane = tid & 63, wave = __builtin_amdgcn_readfirstlane(tid >> 6), r32 = lane & 31, hi = lane >> 5;
    const float* mod = (const float*)(p.ws + WS_MOD);
    const bf16_t* XAB = (const bf16_t*)(p.ws + WS_XAB);
    const float* lng = p.in[5] + (size_t)l * D; const float* rb = p.in[16] + l * NE;
    int* toke = (int*)(p.ws + WS_TOKE); float* tokw = (float*)(p.ws + WS_TOKW); int* BC = (int*)(p.ws + WS_BC);
    const unsigned char* img = p.ws + WS_RWI + (size_t)l * 131072;
    constexpr int PP = 2064;
    unsigned char* pl_hi = lds_raw; unsigned char* pl_lo = lds_raw + 32 * PP;
    int* hist = (int*)(lds_raw + 2 * 32 * PP);
    for (int blk = blockIdx.x; blk < T / 64; blk += gridDim.x) {
        if (tid < 32) hist[tid] = 0;
        const int b = (blk * 64) / S;
        const float* sh = mod + ((size_t)l * Bn + b) * 6144 + 3 * D; const float* sc = mod + ((size_t)l * Bn + b) * 6144 + 4 * D;
        float4 ga[4], s0v[4];
#pragma unroll
        for (int j = 0; j < 4; ++j) { const int col = 4 * lane + 256 * j; const float4 g = *(const float4*)(lng + col), s1 = *(const float4*)(sc + col); s0v[j] = *(const float4*)(sh + col);
            ga[j] = make_float4(g.x * (1.f + s1.x), g.y * (1.f + s1.y), g.z * (1.f + s1.z), g.w * (1.f + s1.w)); }
#pragma unroll 1
        for (int half = 0; half < 2; ++half) {
            const int trow0 = blk * 64 + half * 32;
            {
                uint2 q_[4][4];
#pragma unroll
                for (int i = 0; i < 4; ++i)
#pragma unroll
                    for (int j = 0; j < 4; ++j) q_[i][j] = *(const uint2*)(XAB + (size_t)(trow0 + wave * 4 + i) * D + 4 * lane + 256 * j);
                float ss[4];
#pragma unroll
                for (int i = 0; i < 4; ++i) { float s_ = 0.f;
#pragma unroll
                    for (int j = 0; j < 4; ++j) { const float x0 = __builtin_bit_cast(float, q_[i][j].x << 16), x1 = __builtin_bit_cast(float, q_[i][j].x & 0xffff0000u), x2 = __builtin_bit_cast(float, q_[i][j].y << 16), x3 = __builtin_bit_cast(float, q_[i][j].y & 0xffff0000u);
                        s_ += (x0 * x0 + x1 * x1) + (x2 * x2 + x3 * x3); }
                    ss[i] = s_; }
#pragma unroll
                for (int sft = 32; sft >= 1; sft >>= 1) {
#pragma unroll
                    for (int i = 0; i < 4; ++i) ss[i] += __shfl_xor(ss[i], sft); }
#pragma unroll
                for (int i = 0; i < 4; ++i) {
                    const int rl = wave * 4 + i, t = trow0 + rl;
                    const float r = rsqrtf(ss[i] * (1.f / D) + EPS);
#pragma unroll
                    for (int j = 0; j < 4; ++j) {
                        const int col = 4 * lane + 256 * j;
                        const float x0 = __builtin_bit_cast(float, q_[i][j].x << 16), x1 = __builtin_bit_cast(float, q_[i][j].x & 0xffff0000u), x2 = __builtin_bit_cast(float, q_[i][j].y << 16), x3 = __builtin_bit_cast(float, q_[i][j].y & 0xffff0000u);
                        const float o[4] = {x0 * r * ga[j].x + s0v[j].x, x1 * r * ga[j].y + s0v[j].y, x2 * r * ga[j].z + s0v[j].z, x3 * r * ga[j].w + s0v[j].w};
                        unsigned hh[4], ll[4];
#pragma unroll
                        for (int q = 0; q < 4; ++q) { hh[q] = f2bf(o[q]); ll[q] = f2bf(o[q] - __builtin_bit_cast(float, hh[q] << 16)); }
                        *(uint2*)(pl_hi + rl * PP + col * 2) = make_uint2(hh[0] | (hh[1] << 16), hh[2] | (hh[3] << 16));
                        *(uint2*)(pl_lo + rl * PP + col * 2) = make_uint2(ll[0] | (ll[1] << 16), ll[2] | (ll[3] << 16));
                        *(unsigned*)(p.ws + WS_XN8 + (size_t)t * D + col) = pk_fp8x4(o[0] * XS8, o[1] * XS8, o[2] * XS8, o[3] * XS8);
                    }
                }
            }
            __syncthreads();
            f32x16 acc = f32x16{};
            {
                const AT_LAS unsigned char* xh = (lp)pl_hi + r32 * PP + (128 * wave + 8 * hi) * 2; const AT_LAS unsigned char* xl = (lp)pl_lo + r32 * PP + (128 * wave + 8 * hi) * 2;
                const unsigned char* wh = img + (size_t)((16 * wave + hi) * 32 + r32) * 16; const unsigned char* wl = wh + 65536;
#pragma unroll 1
                for (int k4 = 0; k4 < 8; k4 += 4) {
                    bf16x8 ah[4], al[4];
#pragma unroll
                    for (int ks = 0; ks < 4; ++ks) { ah[ks] = *(const bf16x8*)(wh + (k4 + ks) * 1024); al[ks] = *(const bf16x8*)(wl + (k4 + ks) * 1024); }
#pragma unroll
                    for (int ks = 0; ks < 4; ++ks) {
                        const bf16x8 bh = *(const AT_LAS bf16x8*)(xh + 32 * (k4 + ks)), bl = *(const AT_LAS bf16x8*)(xl + 32 * (k4 + ks));
                        acc = __builtin_amdgcn_mfma_f32_32x32x16_bf16(ah[ks], bh, acc, 0, 0, 0);
                        acc = __builtin_amdgcn_mfma_f32_32x32x16_bf16(al[ks], bh, acc, 0, 0, 0);
                        acc = __builtin_amdgcn_mfma_f32_32x32x16_bf16(ah[ks], bl, acc, 0, 0, 0);
                    }
                }
            }
            __syncthreads();
            { float* part = (float*)lds_raw;
              if (wave >= 1) {
#pragma unroll
                  for (int r = 0; r < 16; ++r) part[(wave * 16 + r) * 64 + lane] = acc[r]; } }
            __syncthreads();
            if (wave == 0) {
                const int t = trow0 + r32;
                { const float* part = (const float*)lds_raw;
#pragma unroll
                  for (int r = 0; r < 16; ++r) { float a = acc[r];
#pragma unroll
                      for (int w = 1; w < 8; ++w) a += part[(w * 16 + r) * 64 + lane];
                      acc[r] = a; } }
                float a0 = -3e38f, a1 = -3e38f, a2 = -3e38f, a3 = -3e38f; int i0 = 99, i1 = 99, i2 = 99, i3 = 99;
#pragma unroll
                for (int r = 0; r < 16; ++r) { const int e = crow(r, hi); const float s_ = acc[r] + rb[e];
                    if (s_ > a0) { a3 = a2; i3 = i2; a2 = a1; i2 = i1; a1 = a0; i1 = i0; a0 = s_; i0 = e; }
                    else if (s_ > a1) { a3 = a2; i3 = i2; a2 = a1; i2 = i1; a1 = s_; i1 = e; }
                    else if (s_ > a2) { a3 = a2; i3 = i2; a2 = s_; i2 = e; }
                    else if (s_ > a3) { a3 = s_; i3 = e; } }
                float ov[4]; int oi[4];
                { const float sv[4] = {a0, a1, a2, a3}; const int si[4] = {i0, i1, i2, i3};
#pragma unroll
                  for (int k = 0; k < 4; ++k) { auto a = __builtin_amdgcn_permlane32_swap(__float_as_uint(sv[k]), __float_as_uint(sv[k]), false, false); ov[k] = __uint_as_float(hi ? a[0] : a[1]);
                                                auto c = __builtin_amdgcn_permlane32_swap((unsigned)si[k], (unsigned)si[k], false, false); oi[k] = (int)(hi ? c[0] : c[1]); } }
#pragma unroll
                for (int k = 0; k < 4; ++k) { const float s_ = ov[k]; const int e = oi[k];
                    if (s_ > a0 || (s_ == a0 && e < i0)) { a3 = a2; i3 = i2; a2 = a1; i2 = i1; a1 = a0; i1 = i0; a0 = s_; i0 = e; }
                    else if (s_ > a1 || (s_ == a1 && e < i1)) { a3 = a2; i3 = i2; a2 = a1; i2 = i1; a1 = s_; i1 = e; }
                    else if (s_ > a2 || (s_ == a2 && e < i2)) { a3 = a2; i3 = i2; a2 = s_; i2 = e; }
                    else if (s_ > a3 || (s_ == a3 && e < i3)) { a3 = s_; i3 = e; } }
                const float e1 = __expf(a1 - a0), e2 = __expf(a2 - a0), e3 = __expf(a3 - a0), inv = 1.f / (((1.f + e1) + e2) + e3);
                if (hi == 0) {
                    *(int4*)(toke + (size_t)t * 4) = make_int4(i0, i1, i2, i3);
                    *(float4*)(tokw + (size_t)t * 4) = make_float4(inv, e1 * inv, e2 * inv, e3 * inv);
                    atomicAdd(&hist[i0], 1); atomicAdd(&hist[i1], 1); atomicAdd(&hist[i2], 1); atomicAdd(&hist[i3], 1);
                }
            }
            __syncthreads();
        }
        if (tid < 32) BC[blk * 32 + tid] = hist[tid];
        __syncthreads();
    }
}
__device__ __forceinline__ void phase_sc_fast(const Params& p, int l, unsigned char* lds_raw) {
    const int tid = otid();
    const int* BC = (const int*)(p.ws + WS_BC);
    int* cnt = (int*)(p.ws + WS_CNT) + l * 32;
    int* tot = (int*)lds_raw; int* base = tot + 32; int* fillc = tot + 64; int* before = tot + 96;
    const int* toke = (const int*)(p.ws + WS_TOKE); const float* tokw = (const float*)(p.ws + WS_TOKW);
    int* rowtok = (int*)(p.ws + WS_ROWTOK) + (size_t)l * RMAX; float* roww = (float*)(p.ws + WS_ROWW) + (size_t)l * RMAX; int* pos = (int*)(p.ws + WS_POS);
    for (int blk = blockIdx.x; blk < T / 64; blk += gridDim.x) {
        { const int e = tid & 31, part = tid >> 5; int s = 0, bf = 0;
#pragma unroll 4
          for (int i = part * 16; i < part * 16 + 16; ++i) { const int c = BC[i * 32 + e]; s += c; if (i < blk) bf += c; }
          int* ptot = tot + 128; int* pbef = ptot + 512;
          ptot[tid] = s; pbef[tid] = bf; }
        __syncthreads();
        if (tid < 32) { const int* ptot = tot + 128; const int* pbef = ptot + 512; int s = 0, bf = 0;
#pragma unroll
            for (int q = 0; q < 16; ++q) { s += ptot[q * 32 + tid]; bf += pbef[q * 32 + tid]; }
            tot[tid] = s; before[tid] = bf; fillc[tid] = 0; if (blk == 0) cnt[tid] = s; }
        __syncthreads();
        if (tid == 0) { int s = 0; for (int e = 0; e < 32; ++e) { base[e] = s + before[e]; s += (tot[e] + 255) & ~255; } }
        __syncthreads();
        if (tid < 256) {
            const int i = blk * 256 + tid, e = toke[i];
            const int slot = base[e] + atomicAdd(&fillc[e], 1);
            rowtok[slot] = i >> 2; roww[slot] = tokw[i]; pos[i] = slot;
        }
        __syncthreads();
    }
}

#define XB_TMO      128
#define XB_XCNT(j)  (256  + 64 * (j))
#define XB_XSUB(j)  (1280 + 64 * (j))
#define XB_XGEN(j)  (2304 + 64 * (j))
#define XB_TOP      3328
#define XB_TOPGEN   3392
#define XCD_BAR_WORDS 3456
#define XB_SPIN_CAP (1u << 18)
#define XLAS __attribute__((address_space(3)))
__device__ __forceinline__ unsigned xb_ld(unsigned* p)              { return __hip_atomic_load(p, __ATOMIC_RELAXED, __HIP_MEMORY_SCOPE_AGENT); }
__device__ __forceinline__ unsigned xb_add(unsigned* p, unsigned v) { return __hip_atomic_fetch_add(p, v, __ATOMIC_RELAXED, __HIP_MEMORY_SCOPE_AGENT); }
__device__ __forceinline__ unsigned xb_xcc_id() { return (unsigned)__builtin_amdgcn_s_getreg((3 << 11) | 20) & 0xFu; }
#define XB_SPIN(cond, bar) do { unsigned _sp = 0; while (cond) { __builtin_amdgcn_s_sleep(1); \
    if ((++_sp & 255u) == 0u) { if (xb_ld(&(bar)[XB_TMO])) break; if (_sp > XB_SPIN_CAP) { atomicAdd(&(bar)[XB_TMO], 1u); break; } } } } while (0)
constexpr int LDS_BARST_OFF = 147200;
struct XcdBarrier { unsigned* bar; unsigned x; volatile XLAS unsigned* st; };
__device__ __forceinline__ XcdBarrier xcd_barrier_post(unsigned* bar, volatile XLAS unsigned* st) {
    XcdBarrier b; b.bar = bar; b.x = xb_xcc_id(); b.st = st;
    if (threadIdx.x == 0) (void)xb_add(&bar[XB_XCNT(b.x)], 1u);
    return b;
}
__device__ __forceinline__ void xcd_barrier_complete(unsigned* bar, unsigned x, unsigned& nloc, unsigned& nx) {
    const unsigned G = gridDim.x * gridDim.y * gridDim.z;
    unsigned sum, cnt, mine, sp = 0u;
    for (;;) {
        sum = 0u; cnt = 0u; mine = 0u;
#pragma unroll
        for (unsigned j = 0; j < 16; ++j) { const unsigned c = xb_ld(&bar[XB_XCNT(j)]); sum += c; cnt += (c > 0u) ? 1u : 0u; mine = (j == x) ? c : mine; }
        if (sum == G) break;
        __builtin_amdgcn_s_sleep(1);
        if ((++sp & 255u) == 0u) { if (xb_ld(&bar[XB_TMO])) break; if (sp > XB_SPIN_CAP) { atomicAdd(&bar[XB_TMO], 1u); break; } }
    }
    nloc = mine > 0u ? mine : 1u; nx = cnt > 0u ? cnt : 1u;
}
__device__ __forceinline__ void xcd_barrier(unsigned char* ws, unsigned char* lds_raw_) {
    XcdBarrier b; b.bar = (unsigned*)(ws + WS_BAR); b.x = xb_xcc_id(); b.st = (volatile XLAS unsigned*)((XLAS unsigned char*)lds_raw_ + LDS_BARST_OFF);
    asm volatile("s_waitcnt vmcnt(0)" ::: "memory");
    __syncthreads();
    if (threadIdx.x == 0) {
        unsigned* bar = b.bar;
        __builtin_amdgcn_s_waitcnt(0);
        unsigned nloc = b.st[0], nx = b.st[1];
        if (nloc == 0u) { xcd_barrier_complete(bar, b.x, nloc, nx); b.st[0] = nloc; b.st[1] = nx; }
        const unsigned old = xb_add(&bar[XB_XSUB(b.x)], 1u);
        const unsigned gen = old / nloc;
        if (old + 1u == (gen + 1u) * nloc) {
            __builtin_amdgcn_fence(__ATOMIC_RELEASE, "agent");
            asm volatile("s_waitcnt vmcnt(0)" ::: "memory");
            const unsigned og = xb_add(&bar[XB_TOP], 1u);
            const unsigned tg = og / nx;
            if (og + 1u == (tg + 1u) * nx) xb_add(&bar[XB_TOPGEN], 1u);
            else XB_SPIN(xb_ld(&bar[XB_TOPGEN]) == tg, bar);
            __builtin_amdgcn_fence(__ATOMIC_ACQUIRE, "agent");
            xb_add(&bar[XB_XGEN(b.x)], 1u);
            asm volatile("s_waitcnt vmcnt(0)" ::: "memory");
        } else {
            XB_SPIN(xb_ld(&bar[XB_XGEN(b.x)]) == gen, bar);
            __builtin_amdgcn_fence(__ATOMIC_ACQUIRE, "agent");
            asm volatile("s_waitcnt vmcnt(0)" ::: "memory");
        }
    }
    __syncthreads();
}

__global__ void __launch_bounds__(NT, 2) mega_fwd(Params p) {
    extern __shared__ __attribute__((aligned(16))) unsigned char lds_raw[];
    float* lds = (float*)lds_raw;
    volatile XLAS unsigned* bst = (volatile XLAS unsigned*)((XLAS unsigned char*)lds_raw + LDS_BARST_OFF);
    if (threadIdx.x < 2) bst[threadIdx.x] = 0u;
    __syncthreads();
    (void)xcd_barrier_post((unsigned*)(p.ws + WS_BAR), bst);
#define GSYNC() xcd_barrier(p.ws, lds_raw)
    phase_p0a(p, lds);
    __syncthreads();
    phase_convert(p, lds);
    GSYNC();
    phase_p0b(p);
    GSYNC();
    _Pragma("unroll 1") for (int l = 0; l < L; ++l) {
        phase_r1(p, l, true);
        GSYNC();
        phase_g1_fast(p, l, lds_raw);
        GSYNC();
        phase_ck_fast(p, l, lds_raw);
        GSYNC();
        phase_c2(p, l, lds);
        __syncthreads();
        phase_route(p, lds_raw);
        GSYNC();
        phase_att1(p, lds_raw);
        GSYNC();
        phase_att2(p, lds_raw);
        GSYNC();
        phase_g2_fast(p, l, lds_raw);
        GSYNC();
        phase_r2_fast(p, l, lds_raw);
        GSYNC();
        phase_sc_fast(p, l, lds_raw);
        GSYNC();
        phase_m1_fast(p, l, lds_raw);
        GSYNC();
        phase_m2_fast(p, l, lds_raw);
        GSYNC();
    }
    phase_r1(p, L, false);
}

extern "C" void kernel_launch(void* const* d_in, const int* in_sizes, int n_in, void* d_out, int out_size, void* d_ws, size_t ws_size, hipStream_t stream) {
    static int grid_blocks = 0;
    if (grid_blocks == 0) {
        if (n_in != 21 || out_size != T * D || ws_size < WS_END) { fprintf(stderr, "kernel_launch: unexpected shapes (n_in %d out %d ws %zu need %zu)\n", n_in, out_size, ws_size, (size_t)WS_END); grid_blocks = -1; return; }
        int dev = 0, cus = 0, per_cu = 0;
        hipGetDevice(&dev);
        hipDeviceGetAttribute(&cus, hipDeviceAttributeMultiprocessorCount, dev);
        hipFuncSetAttribute((const void*)mega_fwd, hipFuncAttributeMaxDynamicSharedMemorySize, LDS_BYTES);
        hipOccupancyMaxActiveBlocksPerMultiprocessor(&per_cu, (const void*)mega_fwd, NT, LDS_BYTES);
        if (per_cu < 1) { fprintf(stderr, "kernel_launch: occupancy query says %d blocks per CU\n", per_cu); per_cu = 1; }
        (void)hipGetLastError();
        grid_blocks = cus * 1;
    }
    if (grid_blocks < 0) return;
    if (hipMemsetAsync((char*)d_ws + WS_BAR, 0, 16384, stream) != hipSuccess) { fprintf(stderr, "kernel_launch: memset failed\n"); return; }
    Params p{};
    for (int i = 0; i < 21; ++i) p.in[i] = (const float*)d_in[i];
    p.out = (float*)d_out; p.ws = (unsigned char*)d_ws;
    hipLaunchKernelGGL(mega_fwd, dim3(grid_blocks), dim3(NT), LDS_BYTES, stream, p);
    hipError_t e = hipPeekAtLastError();
    if (e != hipSuccess) fprintf(stderr, "launch failed: %s (grid %d)\n", hipGetErrorString(e), grid_blocks);
}
```

```cpp
#include <hip/hip_runtime.h>
#include <cstdio>
#include <cstdint>

constexpr int Bn = 2, S = 8192, D = 1024, L = 2, T = Bn * S;
constexpr int INW = 2840;
constexpr int NE = 32, TOPK = 4, DFF = 1024;
constexpr int A_TOT = T * TOPK;
constexpr int RMAX = A_TOT + NE * 256;
constexpr int NCMP = 511;
constexpr int NT = 512;
constexpr int NW = NT / 64;
constexpr int LDS_BYTES = 147456;
constexpr float EPS = 1e-6f;
constexpr float NEGF = -1e30f;

constexpr int ZBW = 3072;
constexpr int ZB_Q = 0, ZB_KC = 512, ZB_VC = 640, ZB_KS = 768, ZB_VS = 896, ZB_KW = 1024, ZB_VW = 1152, ZB_MQ = 1280, ZB_MK = 1792, ZB_MV = 2304, ZB_G = 2816;
constexpr float QSCALE = 0.125f * 1.4426950408889634f;
constexpr float LOG2E = 1.4426950408889634f;

constexpr size_t al256(size_t x) { return (x + 255) & ~(size_t)255; }
constexpr size_t WS_BAR = 0;
constexpr size_t WS_MODP = 16384;
constexpr size_t WS_MOD = al256(WS_MODP + (size_t)8 * L * Bn * 6144 * 4);
constexpr size_t WS_CNT = al256(WS_MOD + (size_t)L * Bn * 6144 * 4);
constexpr size_t WS_ROWTOK = al256(WS_CNT + L * 32 * 4);
constexpr size_t WS_ROWW = al256(WS_ROWTOK + (size_t)L * RMAX * 4);
constexpr size_t WS_TOKE = al256(WS_ROWW + (size_t)L * RMAX * 4);
constexpr size_t WS_TOKW = al256(WS_TOKE + (size_t)T * 4 * 4);
constexpr size_t WS_POS = al256(WS_TOKW + (size_t)T * 4 * 4);
constexpr size_t WS_Y = al256(WS_POS + (size_t)T * 4 * 4);
constexpr size_t WS_WINT = al256(WS_Y + (size_t)RMAX * 1024 * 4);
constexpr size_t WS_WOT = al256(WS_WINT + (size_t)L * 3072 * 1024 * 2);
constexpr size_t WS_W1T = al256(WS_WOT + (size_t)L * 1024 * 1024 * 2);
constexpr size_t WS_W2T = al256(WS_W1T + (size_t)L * NE * 2048 * 1024 * 2);
constexpr size_t WS_XN = al256(WS_W2T + (size_t)L * NE * 1024 * 1024 * 2);
constexpr size_t WS_ATTB = al256(WS_XN + (size_t)(T + 1) * D * 2);
constexpr size_t WS_ACT = al256(WS_ATTB + (size_t)T * D * 2);
constexpr size_t WS_ZB = al256(WS_ACT + (size_t)RMAX * DFF * 2);
constexpr size_t WS_GATE = al256(WS_ZB + (size_t)T * ZBW * 2);
constexpr size_t WS_KCB = al256(WS_GATE + (size_t)T * 32 * 4);
constexpr size_t WS_VCB = al256(WS_KCB + (size_t)Bn * 2 * 512 * 64 * 2);
constexpr size_t WS_KMB = al256(WS_VCB + (size_t)Bn * 2 * 512 * 64 * 2);
constexpr size_t WS_XNLO = al256(WS_KMB + (size_t)Bn * 8 * 32 * 64 * 2);
constexpr size_t WS_BC = al256(WS_XNLO + (size_t)T * D * 2);
constexpr size_t WS_WCT = al256(WS_BC + (size_t)(T / 64) * 32 * 4);
constexpr size_t WS_CBP = al256(WS_WCT + (size_t)L * 2 * 128 * 2048 * 2);
constexpr size_t WS_CB = al256(WS_CBP + (size_t)16 * L * 2 * 128 * 4);
constexpr size_t WS_HIDP = al256(WS_CB + (size_t)L * 2 * 128 * 4);
constexpr size_t WS_XAB = al256(WS_HIDP + (size_t)4 * 2 * 2044 * 128 * 4);
constexpr size_t WS_SEL3 = al256(WS_XAB + (size_t)T * D * 2);
constexpr size_t WS_LRK = al256(WS_SEL3 + (size_t)T * 8 * 4);
constexpr size_t WS_ILIST = al256(WS_LRK + (size_t)T * 8 * 4);
constexpr size_t WS_BCM = al256(WS_ILIST + (size_t)16 * 32 * 32 * 256);
constexpr size_t WS_PM = al256(WS_BCM + (size_t)16 * 32 * 32 * 4);
constexpr size_t WS_PL = al256(WS_PM + (size_t)16 * 25600 * 4);
constexpr size_t WS_PO = al256(WS_PL + (size_t)16 * 25600 * 4);
constexpr size_t WS_XN8 = al256(WS_PO + (size_t)16 * 25600 * 64 * 2);
constexpr size_t WS_DQ1 = al256(WS_XN8 + (size_t)(T + 1) * D);
constexpr size_t WS_DQ2 = al256(WS_DQ1 + (size_t)L * NE * 2048 * 4);
constexpr size_t WS_RWI = al256(WS_DQ2 + (size_t)L * NE * 1024 * 4);
constexpr size_t WS_END = al256(WS_RWI + (size_t)L * 131072);
constexpr float XS8 = 16.f, AS8 = 8.f, YS8 = 16.f;

struct Params {
    const float* in[21];
    float* out;
    unsigned char* ws;
};

__device__ __forceinline__ int otid() { int t = threadIdx.x; asm volatile("" : "+v"(t)); return t; }
typedef unsigned short bf16_t;
__device__ __forceinline__ unsigned f2bf(float f) { unsigned u = __builtin_bit_cast(unsigned, f); return (u + 0x7fffu + ((u >> 16) & 1u)) >> 16; }
__device__ __forceinline__ unsigned pk2(float lo, float hi) { return f2bf(lo) | (f2bf(hi) << 16); }
typedef float f32x2v __attribute__((ext_vector_type(2)));
__device__ __forceinline__ float4 f84(unsigned q) {
    const f32x2v lo = __builtin_amdgcn_cvt_pk_f32_fp8((int)q, false), hi = __builtin_amdgcn_cvt_pk_f32_fp8((int)q, true);
    return make_float4(lo[0] * (1.f / 16.f), lo[1] * (1.f / 16.f), hi[0] * (1.f / 16.f), hi[1] * (1.f / 16.f)); }
__device__ __forceinline__ unsigned pk_fp8x4(float a, float b, float c, float d) {
    a = __builtin_amdgcn_fmed3f(a, -448.f, 448.f); b = __builtin_amdgcn_fmed3f(b, -448.f, 448.f); c = __builtin_amdgcn_fmed3f(c, -448.f, 448.f); d = __builtin_amdgcn_fmed3f(d, -448.f, 448.f);
    int r = __builtin_amdgcn_cvt_pk_fp8_f32(a, b, 0, false);
    r = __builtin_amdgcn_cvt_pk_fp8_f32(c, d, r, true);
    return (unsigned)r; }
__device__ __forceinline__ float bf2f(bf16_t v) { return __builtin_bit_cast(float, (unsigned)v << 16); }
__device__ __forceinline__ float wave_sum(float v) {
#pragma unroll
    for (int o = 1; o < 64; o <<= 1) v += __shfl_xor(v, o);
    return v;
}
__device__ __forceinline__ float sigmoidf_(float x) { return 1.f / (1.f + __expf(-x)); }
__device__ __forceinline__ float gelu_tanh(float x) {
    const float u = 0.7978845608028654f * (x + 0.044715f * x * x * x);
    return 0.5f * x * (1.f + tanhf(u));
}

__device__ __forceinline__ void phase_p0a(const Params& p, float* lds) {
    const int tid = otid(), gtid = blockIdx.x * NT + tid, gsz = gridDim.x * NT;
    int* cnt = (int*)(p.ws + WS_CNT); int* rowtok = (int*)(p.ws + WS_ROWTOK);
    for (int i = gtid; i < L * 32; i += gsz) cnt[i] = 0;
    for (int i = gtid; i < L * RMAX; i += gsz) rowtok[i] = -1;
    const float* c = p.in[1];
    for (int i = tid; i < Bn * D; i += NT) { const float v = c[i]; lds[i] = v / (1.f + __expf(-v)); }
    __syncthreads();
    const float* ada_w = p.in[2];
    float* modp = (float*)(p.ws + WS_MODP);
    for (int idx = gtid; idx < 8 * L * 6144; idx += gsz) {
        const int col = idx % 6144, l = (idx / 6144) % L, kc = idx / (6144 * L);
        const float* w = ada_w + ((size_t)l * D + kc * 128) * 6144 + col;
        float a0 = 0.f, a1 = 0.f, c0 = 0.f, c1 = 0.f;
#pragma unroll 1
        for (int k0 = 0; k0 < 128; k0 += 32) { float wv[32];
#pragma unroll
            for (int k = 0; k < 32; ++k) wv[k] = __builtin_nontemporal_load(w + (size_t)(k0 + k) * 6144);
#pragma unroll
            for (int k = 0; k < 32; k += 2) { a0 += lds[kc * 128 + k0 + k] * wv[k]; a1 += lds[D + kc * 128 + k0 + k] * wv[k]; c0 += lds[kc * 128 + k0 + k + 1] * wv[k + 1]; c1 += lds[D + kc * 128 + k0 + k + 1] * wv[k + 1]; } }
        modp[((size_t)(kc * L + l) * Bn + 0) * 6144 + col] = a0 + c0;
        modp[((size_t)(kc * L + l) * Bn + 1) * 6144 + col] = a1 + c1;
    }
    { const float* posw = p.in[9]; const float* w1c = p.in[10]; float* cbp = (float*)(p.ws + WS_CBP);
      int first = 8 * L * 6144; if (first + 16 * L * 2 * 128 > gsz) first = 0;
      for (int idx = gtid - first; idx < 16 * L * 2 * 128; idx += gsz) { if (idx < 0) continue;
          const int j = idx & 127, li = (idx >> 7) % (L * 2), kc = idx / (L * 2 * 128);
          const float* w = w1c + ((size_t)li * 2048 + kc * 128) * 128 + j; const float* pp = posw + (size_t)li * 2048 + kc * 128;
          float a = 0.f, c_ = 0.f;
#pragma unroll 1
          for (int k0 = 0; k0 < 128; k0 += 32) { float wv[32];
#pragma unroll
              for (int k = 0; k < 32; ++k) wv[k] = w[(size_t)(k0 + k) * 128];
#pragma unroll
              for (int k = 0; k < 32; k += 2) { a += pp[k0 + k] * wv[k]; c_ += pp[k0 + k + 1] * wv[k + 1]; } }
          cbp[idx] = a + c_; } }
}
__device__ __forceinline__ void phase_p0b(const Params& p) {
    const int gtid = blockIdx.x * NT + otid(), gsz = gridDim.x * NT;
    { const float* cbp = (const float*)(p.ws + WS_CBP); float* cb = (float*)(p.ws + WS_CB);
      for (int idx = gtid; idx < L * 2 * 128; idx += gsz) { float s = 0.f;
#pragma unroll
          for (int kc = 0; kc < 16; ++kc) s += cbp[kc * (L * 2 * 128) + idx];
          cb[idx] = s; } }
    const float* modp = (const float*)(p.ws + WS_MODP); float* mod = (float*)(p.ws + WS_MOD); const float* ada_b = p.in[3];
    for (int idx = gtid; idx < L * Bn * 6144; idx += gsz) {
        const int col = idx % 6144, l = idx / (Bn * 6144);
        float s = ada_b[l * 6144 + col];
#pragma unroll
        for (int kc = 0; kc < 8; ++kc) s += modp[(size_t)kc * L * Bn * 6144 + idx];
        mod[idx] = s;
    }
}

__device__ __forceinline__ void phase_r1(const Params& p, int l, bool do_h) {
    const int lane = otid() & 63, wave = otid() >> 6;
    const int gw = blockIdx.x * NW + wave, ngw = gridDim.x * NW;
    const float* mod = (const float*)(p.ws + WS_MOD);
    const float* xin = p.in[0]; float* XA = p.out;
    const unsigned char* Y8 = p.ws + WS_Y; const int* pos = (const int*)(p.ws + WS_POS); const float* tokw = (const float*)(p.ws + WS_TOKW);
    const float* lng = p.in[4] + (size_t)(do_h ? l : 0) * D;
    bf16_t* XN = (bf16_t*)(p.ws + WS_XN); bf16_t* XAB = (bf16_t*)(p.ws + WS_XAB);
#define BF4(q) make_float4(__builtin_bit_cast(float, (q).x << 16), __builtin_bit_cast(float, (q).x & 0xffff0000u), __builtin_bit_cast(float, (q).y << 16), __builtin_bit_cast(float, (q).y & 0xffff0000u))
#define F84(q) f84((q))
    int curb = -1; float4 g2v[4], ga[4], s0v[4];
    for (int t0 = gw; t0 < T; t0 += ngw) {
        const int nr = 1;
        float4 v[2][4];
        if (l == 0) {
#pragma unroll
            for (int i = 0; i < 2; ++i) if (i < nr) {
#pragma unroll
                for (int j = 0; j < 4; ++j) v[i][j] = *(const float4*)(xin + (size_t)(t0 + i * ngw) * D + 4 * lane + 256 * j); }
        } else {
            int4 ps[2]; float4 tw[2]; uint2 xq[2][4];
#pragma unroll
            for (int i = 0; i < 2; ++i) if (i < nr) { const int t = t0 + i * ngw; ps[i] = *(const int4*)(pos + (size_t)t * 4); tw[i] = *(const float4*)(tokw + (size_t)t * 4);
#pragma unroll
                for (int j = 0; j < 4; ++j) xq[i][j] = *(const uint2*)(XAB + (size_t)t * D + 4 * lane + 256 * j); }
            unsigned yq[2][4][4];
#pragma unroll
            for (int i = 0; i < 2; ++i) if (i < nr) {
#pragma unroll
                for (int j = 0; j < 4; ++j) { const int col = 4 * lane + 256 * j;
                    yq[i][j][0] = *(const unsigned*)(Y8 + (size_t)ps[i].x * D + col); yq[i][j][1] = *(const unsigned*)(Y8 + (size_t)ps[i].y * D + col);
                    yq[i][j][2] = *(const unsigned*)(Y8 + (size_t)ps[i].z * D + col); yq[i][j][3] = *(const unsigned*)(Y8 + (size_t)ps[i].w * D + col); } }
#pragma unroll
            for (int i = 0; i < 2; ++i) if (i < nr) {
                const int t = t0 + i * ngw, b = t / S;
                if (b != curb) { curb = b;
                    const float* g2 = mod + ((size_t)(l - 1) * Bn + b) * 6144 + 5 * D;
#pragma unroll
                    for (int j = 0; j < 4; ++j) g2v[j] = *(const float4*)(g2 + 4 * lane + 256 * j);
                    if (do_h) { const float* sh = mod + ((size_t)l * Bn + b) * 6144 + 0 * D; const float* sc = mod + ((size_t)l * Bn + b) * 6144 + 1 * D;
#pragma unroll
                        for (int j = 0; j < 4; ++j) { const int col = 4 * lane + 256 * j; const float4 g = *(const float4*)(lng + col), s1 = *(const float4*)(sc + col); s0v[j] = *(const float4*)(sh + col);
                            ga[j] = make_float4(g.x * (1.f + s1.x), g.y * (1.f + s1.y), g.z * (1.f + s1.z), g.w * (1.f + s1.w)); } } }
#pragma unroll
                for (int j = 0; j < 4; ++j) {
                    const int col = 4 * lane + 256 * j;
                    const float4 x = BF4(xq[i][j]);
                    const float4 y0 = F84(yq[i][j][0]), y1 = F84(yq[i][j][1]), y2 = F84(yq[i][j][2]), y3 = F84(yq[i][j][3]);
                    const float4 g = g2v[j];
                    float4 r;
                    r.x = x.x + g.x * (((tw[i].x * y0.x + tw[i].y * y1.x) + tw[i].z * y2.x) + tw[i].w * y3.x); r.y = x.y + g.y * (((tw[i].x * y0.y + tw[i].y * y1.y) + tw[i].z * y2.y) + tw[i].w * y3.y);
                    r.z = x.z + g.z * (((tw[i].x * y0.z + tw[i].y * y1.z) + tw[i].z * y2.z) + tw[i].w * y3.z); r.w = x.w + g.w * (((tw[i].x * y0.w + tw[i].y * y1.w) + tw[i].z * y2.w) + tw[i].w * y3.w);
                    v[i][j] = r;
                    if (do_h) *(uint2*)(XAB + (size_t)t * D + col) = make_uint2(pk2(r.x, r.y), pk2(r.z, r.w));
                    else *(float4*)(XA + (size_t)t * D + col) = r;
                }
            }
        }
        if (do_h) {
#pragma unroll
            for (int i = 0; i < 2; ++i) if (i < nr) {
                const int t = t0 + i * ngw, b = t / S;
                if (b != curb) { curb = b;
                    const float* sh = mod + ((size_t)l * Bn + b) * 6144 + 0 * D; const float* sc = mod + ((size_t)l * Bn + b) * 6144 + 1 * D;
#pragma unroll
                    for (int j = 0; j < 4; ++j) { const int col = 4 * lane + 256 * j; const float4 g = *(const float4*)(lng + col), s1 = *(const float4*)(sc + col); s0v[j] = *(const float4*)(sh + col);
                        ga[j] = make_float4(g.x * (1.f + s1.x), g.y * (1.f + s1.y), g.z * (1.f + s1.z), g.w * (1.f + s1.w)); } }
                float ss = 0.f;
#pragma unroll
                for (int j = 0; j < 4; ++j) ss += (v[i][j].x * v[i][j].x + v[i][j].y * v[i][j].y) + (v[i][j].z * v[i][j].z + v[i][j].w * v[i][j].w);
                ss = wave_sum(ss);
                const float r = rsqrtf(ss * (1.f / D) + EPS);
#pragma unroll
                for (int j = 0; j < 4; ++j) {
                    const int col = 4 * lane + 256 * j;
                    float4 o;
                    o.x = v[i][j].x * r * ga[j].x + s0v[j].x; o.y = v[i][j].y * r * ga[j].y + s0v[j].y;
                    o.z = v[i][j].z * r * ga[j].z + s0v[j].z; o.w = v[i][j].w * r * ga[j].w + s0v[j].w;
                    *(uint2*)(XN + (size_t)t * D + col) = make_uint2(pk2(o.x, o.y), pk2(o.z, o.w));
                }
            }
        }
    }
#undef BF4
}


__device__ __forceinline__ void phase_c2(const Params& p, int l, float* lds) {
    const int lane = otid() & 63, wave = otid() >> 6;
    const float* HIDP = (const float*)(p.ws + WS_HIDP); const float* cb = (const float*)(p.ws + WS_CB) + l * 2 * 128; const float* w2 = p.in[11] + (size_t)l * 2 * 128 * 64;
    const float gk = p.in[8][l * 64 + lane];
    float* hl = lds + wave * 128;
    for (int r = blockIdx.x * NW + wave; r < 2 * 2044; r += gridDim.x * NW) {
        const int idx = r / 2044, rr = r % 2044;
#pragma unroll
        for (int q = 0; q < 2; ++q) { const int j = lane + 64 * q; float s = cb[idx * 128 + j];
#pragma unroll
            for (int kq = 0; kq < 4; ++kq) s += HIDP[((size_t)(kq * 2 + idx) * 2044 + rr) * 128 + j];
            hl[j] = gelu_tanh(s); }
        asm volatile("s_waitcnt lgkmcnt(0)" ::: "memory"); __builtin_amdgcn_wave_barrier();
        const float* W = w2 + (size_t)idx * 128 * 64;
        float s = 0.f;
#pragma unroll 8
        for (int j = 0; j < 128; ++j) s += hl[j] * W[j * 64 + lane];
        asm volatile("s_waitcnt lgkmcnt(0)" ::: "memory"); __builtin_amdgcn_wave_barrier();
        const int bgi = rr / 511, n = rr % 511;
        if (idx == 0) { const float ss = wave_sum(s * s); const float kv = s * rsqrtf(ss * (1.f / 64.f) + EPS) * gk; ((bf16_t*)(p.ws + WS_KCB))[((size_t)bgi * 512 + n) * 64 + lane] = (bf16_t)f2bf(kv); }
        else { ((bf16_t*)(p.ws + WS_VCB))[((size_t)bgi * 512 + n) * 64 + lane] = (bf16_t)f2bf(s); }
    }
    if (blockIdx.x == 0 && otid() < 2 * 4 * 64) { const int i = otid(); bf16_t* dst = (bf16_t*)(p.ws + (i < 256 ? WS_KCB : WS_VCB)); dst[((size_t)((i & 255) >> 6) * 512 + 511) * 64 + (i & 63)] = 0; }
}

__device__ __forceinline__ void load_pstart(const Params& p, int l, int* ps) {
    const int* cnt = (const int*)(p.ws + WS_CNT) + l * 32;
    if (otid() == 0) { int s = 0; for (int e = 0; e < 32; ++e) { ps[e] = s; s += (cnt[e] + 255) & ~255; } ps[32] = s; }
    __syncthreads();
}


template <int MAP>
__device__ __forceinline__ void tr_tile(const float* W, int Nsrc, bf16_t* WT, int K, int k0, int n0, float* scr, int lane) {
    const int nl = (lane & 15) * 4, kr = lane >> 4;
    int sc = n0 + nl;
    if (MAP == 1) { sc = sc < 1280 ? sc : (sc < 2816 ? sc + 24 : (sc < 2840 ? sc - 2816 + 1280 : -1)); }
    float4 v[16];
#pragma unroll
    for (int it = 0; it < 16; ++it) { if (sc >= 0) { const float* src_ = W + (size_t)(k0 + it * 4 + kr) * Nsrc + sc; typedef float f4v __attribute__((ext_vector_type(4))); const f4v t_ = __builtin_nontemporal_load((const f4v*)src_); v[it] = make_float4(t_[0], t_[1], t_[2], t_[3]); } else v[it] = make_float4(0.f, 0.f, 0.f, 0.f); }
#pragma unroll
    for (int it = 0; it < 16; ++it) { float* s = scr + (it * 4 + kr) * 65 + nl; s[0] = v[it].x; s[1] = v[it].y; s[2] = v[it].z; s[3] = v[it].w; }
    asm volatile("s_waitcnt lgkmcnt(0)" ::: "memory"); __builtin_amdgcn_wave_barrier();
    const int c = lane & 7, nr = lane >> 3;
#pragma unroll
    for (int it = 0; it < 8; ++it) {
        const int n = it * 8 + nr; const float* s = scr + (8 * c) * 65 + n;
        uint4 o; o.x = pk2(s[0], s[65]); o.y = pk2(s[2 * 65], s[3 * 65]); o.z = pk2(s[4 * 65], s[5 * 65]); o.w = pk2(s[6 * 65], s[7 * 65]);
        *(uint4*)(WT + (size_t)(n0 + n) * K + k0 + 8 * c) = o;
    }
    asm volatile("s_waitcnt lgkmcnt(0)" ::: "memory"); __builtin_amdgcn_wave_barrier();
}
__device__ __forceinline__ void phase_convert(const Params& p, float* lds) {
    const int tid = otid(), lane = tid & 63, wave = tid >> 6;
    float* scr = lds + wave * (64 * 65);
    const int gw = blockIdx.x * NW + wave, ngw = gridDim.x * NW;
    bf16_t* WinT = (bf16_t*)(p.ws + WS_WINT); bf16_t* WoT = (bf16_t*)(p.ws + WS_WOT);
    constexpr int I_IN = L * 16 * (ZBW / 64), I_O = L * 16 * 16, I_C = L * 2 * 32 * 2;
    { float* cm = lds + NW * (64 * 65);
      constexpr int S1 = L * NE * 32, S2 = L * NE * 16;
      for (int s = blockIdx.x; s < S1 + S2; s += gridDim.x) {
          const bool is1 = s < S1; const int q = is1 ? s : s - S1;
          const int le = is1 ? (q >> 5) : (q >> 4), nb = is1 ? (q & 31) : (q & 15), Nsrc = is1 ? 2048 : 1024;
          const float* W = (is1 ? p.in[17] : p.in[19]) + (size_t)le * 1024 * Nsrc;
          unsigned char* WT8 = p.ws + (is1 ? WS_W1T : WS_W2T) + (size_t)le * Nsrc * 1024;
          float* DQ = (float*)(p.ws + (is1 ? WS_DQ1 : WS_DQ2)) + (size_t)le * Nsrc;
          const int n0 = nb * 64, nl = (lane & 15) * 4, kr = lane >> 4, k0 = wave * 128;
          typedef float f4v __attribute__((ext_vector_type(4)));
          f4v va[16], vb[16];
#pragma unroll
          for (int it = 0; it < 16; ++it) { va[it] = __builtin_nontemporal_load((const f4v*)(W + (size_t)(k0 + it * 4 + kr) * Nsrc + n0 + nl));
                                            vb[it] = __builtin_nontemporal_load((const f4v*)(W + (size_t)(k0 + 64 + it * 4 + kr) * Nsrc + n0 + nl)); }
          float m[4] = {0.f, 0.f, 0.f, 0.f};
#pragma unroll
          for (int it = 0; it < 16; ++it)
#pragma unroll
              for (int j = 0; j < 4; ++j) m[j] = __builtin_fmaxf(m[j], __builtin_fmaxf(__builtin_fabsf(va[it][j]), __builtin_fabsf(vb[it][j])));
#pragma unroll
          for (int j = 0; j < 4; ++j) { m[j] = __builtin_fmaxf(m[j], __shfl_xor(m[j], 16)); m[j] = __builtin_fmaxf(m[j], __shfl_xor(m[j], 32)); }
          if (kr == 0) {
#pragma unroll
              for (int j = 0; j < 4; ++j) cm[wave * 64 + nl + j] = m[j]; }
          __syncthreads();
          float sc[4];
#pragma unroll
          for (int j = 0; j < 4; ++j) { float a = cm[nl + j];
#pragma unroll
              for (int w = 1; w < NW; ++w) a = __builtin_fmaxf(a, cm[w * 64 + nl + j]);
              sc[j] = a > 0.f ? 448.f / a : 0.f;
              if (wave == 0 && kr == 0) DQ[n0 + nl + j] = a * (1.f / 448.f); }
#pragma unroll
          for (int half = 0; half < 2; ++half) {
#pragma unroll
              for (int it = 0; it < 16; ++it) { const f4v v = half ? vb[it] : va[it]; float* d = scr + (it * 4 + kr) * 65 + nl; d[0] = v[0] * sc[0]; d[1] = v[1] * sc[1]; d[2] = v[2] * sc[2]; d[3] = v[3] * sc[3]; }
              asm volatile("s_waitcnt lgkmcnt(0)" ::: "memory"); __builtin_amdgcn_wave_barrier();
              const int c = lane & 7, nr = lane >> 3;
#pragma unroll
              for (int it = 0; it < 8; ++it) { const int n = it * 8 + nr; const float* sp = scr + (8 * c) * 65 + n;
                  uint2 o; o.x = pk_fp8x4(sp[0], sp[65], sp[2 * 65], sp[3 * 65]); o.y = pk_fp8x4(sp[4 * 65], sp[5 * 65], sp[6 * 65], sp[7 * 65]);
                  *(uint2*)(WT8 + (size_t)(n0 + n) * 1024 + k0 + half * 64 + 8 * c) = o; }
              asm volatile("s_waitcnt lgkmcnt(0)" ::: "memory"); __builtin_amdgcn_wave_barrier();
          }
          __syncthreads();
      } }
    for (int it = gw; it < I_C + I_IN + I_O; it += ngw) {
        int r = it;
        if (r < I_C) { const int li = r / 64, q = r % 64, kb = q / 2, nb = q % 2;
            tr_tile<0>(p.in[10] + (size_t)li * 2048 * 128, 128, (bf16_t*)(p.ws + WS_WCT) + (size_t)li * 128 * 2048, 2048, kb * 64, nb * 64, scr, lane); continue; }
        r -= I_C;
        if (r < I_IN) { const int l = r / (16 * 48), q = r % (16 * 48), kb = q / 48, nb = q % 48;
            tr_tile<1>(p.in[6] + (size_t)l * D * INW, INW, WinT + (size_t)l * ZBW * D, D, kb * 64, nb * 64, scr, lane); continue; }
        r -= I_IN;
        { const int l = r / 256, q = r % 256, kb = q / 16, nb = q % 16;
            tr_tile<0>(p.in[14] + (size_t)l * D * D, D, WoT + (size_t)l * D * D, D, kb * 64, nb * 64, scr, lane); }
    }
    for (int idx = blockIdx.x * NT + tid; idx < L * 128 * 32; idx += gridDim.x * NT) {
        const int l = idx >> 12, kc = (idx >> 5) & 127, e = idx & 31; const float* rw = p.in[15] + (size_t)l * D * NE; float v[8];
#pragma unroll
        for (int j = 0; j < 8; ++j) v[j] = rw[(size_t)(8 * kc + j) * NE + e];
        unsigned hh[8], ll[8];
#pragma unroll
        for (int j = 0; j < 8; ++j) { hh[j] = f2bf(v[j]); ll[j] = f2bf(v[j] - __builtin_bit_cast(float, hh[j] << 16)); }
        unsigned char* img = p.ws + WS_RWI + (size_t)l * 131072;
        *(uint4*)(img + (size_t)(idx & 4095) * 16) = make_uint4(hh[0] | (hh[1] << 16), hh[2] | (hh[3] << 16), hh[4] | (hh[5] << 16), hh[6] | (hh[7] << 16));
        *(uint4*)(img + 65536 + (size_t)(idx & 4095) * 16) = make_uint4(ll[0] | (ll[1] << 16), ll[2] | (ll[3] << 16), ll[4] | (ll[5] << 16), ll[6] | (ll[7] << 16));
    }
    if (blockIdx.x == 0) { bf16_t* XN = (bf16_t*)(p.ws + WS_XN); for (int i = tid; i < D / 2; i += NT) ((unsigned*)(XN + (size_t)T * D))[i] = 0u;
                           for (int i = tid; i < D / 4; i += NT) ((unsigned*)(p.ws + WS_XN8 + (size_t)T * D))[i] = 0u; }
}

namespace pg8 {
#define PG8_LAS __attribute__((address_space(3)))
typedef short bf16x8 __attribute__((ext_vector_type(8)));
typedef float f32x4 __attribute__((ext_vector_type(4)));
typedef unsigned u32x4 __attribute__((ext_vector_type(4)));
typedef long l64x2 __attribute__((ext_vector_type(2)));
typedef int i32x4 __attribute__((ext_vector_type(4)));
typedef int i32x8 __attribute__((ext_vector_type(8)));
constexpr int BM = 256, BK = 64, HALF = 128, HTB = HALF * BK * 2, STAGE_BYTES = 8 * HTB, NXCD = 8, WGM = 8;
__device__ __forceinline__ int lds_byte(int r, int c) { const int st = (r >> 4) * 2 + (c >> 5), rr = r & 15, cc = c & 31, ob = rr * 64 + cc * 2; return st * 1024 + (ob ^ (((ob >> 9) & 1) << 5)); }
__device__ __forceinline__ void stage_rc(int b, int& R, int& C) { const int st = b / 1024, sb = b % 1024, swz = sb ^ (((sb >> 9) & 1) << 5); R = (st >> 1) * 16 + swz / 64; C = (st & 1) * 32 + (swz % 64) / 2; }
__device__ __forceinline__ int perm32(int rho) { const int n = rho >> 4, i = rho & 15; return 8 * (i >> 2) + 4 * n + (i & 3); }
struct Unit { int pm, pn, e; };
__device__ __forceinline__ unsigned cvt_pk_bf16(float lo, float hi) { unsigned r; asm volatile("v_cvt_pk_bf16_f32 %0, %1, %2" : "=v"(r) : "v"(lo), "v"(hi)); return r; }

__device__ __forceinline__ bool static_next(int nM, int nN, int G, int c, int i, Unit& u) {
    const int nwg = nM * nN; const long Lq = (long)i * G + c; if (Lq >= nwg) return false;
    int wgid = (int)Lq; { const int q = nwg / NXCD, r = nwg % NXCD, xcd = wgid % NXCD, off = wgid / NXCD; wgid = (xcd < r ? xcd * (q + 1) : r * (q + 1) + (xcd - r) * q) + off; }
    const int nig = WGM * nN, gid = wgid / nig, fm = gid * WGM, gsz = (nM - fm) < WGM ? (nM - fm) : WGM;
    u.pm = fm + ((wgid % nig) % gsz); u.pn = (wgid % nig) / gsz; u.e = 0; return true;
}

template <class Prob, class Epi, bool ALIGN_EPI, bool SP2>
__device__ __forceinline__ void gemm_phase(PG8_LAS unsigned char* lds, const Prob& P, const Epi& E) {
    const int tid = otid(), wid = __builtin_amdgcn_readfirstlane(tid >> 6), lane = tid & 63, wr = wid >> 2, wc = wid & 3, fr = lane & 15, fq = lane >> 4;
    const int K = P.K, nt = Prob::KT > 0 ? Prob::KT : K / BK;
    int sR[2], sC[2]; unsigned voffB[2];
#pragma unroll
    for (int i = 0; i < 2; ++i) { stage_rc(tid * 16 + i * 8192, sR[i], sC[i]); voffB[i] = (unsigned)(P.b_row(sR[i]) * K + sC[i]) * 2u; }
    const size_t kstep = (size_t)(BK * 2);
    const size_t kstepA = P.a_kstep();
    const size_t hstepB = P.b_hstep();
    const unsigned ldsw = (unsigned)wid * 1024u;
    const int aoff = lds_byte(wr * 64 + fr, fq * 8), boff = lds_byte(wc * 32 + fr, fq * 8);
#define PG8_SA(b, h) (((b) * 2 + (h)) * HTB)
#define PG8_SB(b, h) ((4 + (b) * 2 + (h)) * HTB)
#define PG8_STAGE(bufoff, gbase, voff) do { _Pragma("unroll") for (int _i = 0; _i < 2; ++_i) { unsigned _vo = (voff)[_i]; asm volatile("" : "+v"(_vo));        \
        __builtin_amdgcn_global_load_lds((const unsigned*)((const char*)(gbase) + _vo), (PG8_LAS unsigned*)(lds + (bufoff) + ldsw + _i * 8192), 16, 0, 0); } } while (0)
#define PG8_STAGE_SEL(bufoff, gbase, h) do { _Pragma("unroll") for (int _i = 0; _i < 2; ++_i) { unsigned _vo = vAc[h][_i]; if constexpr (Prob::GATHER) { const unsigned _vn = van[(h) * 2 + _i]; _vo = last ? _vn : _vo; } asm volatile("" : "+v"(_vo)); \
        __builtin_amdgcn_global_load_lds((const unsigned*)((const char*)(gbase) + _vo), (PG8_LAS unsigned*)(lds + (bufoff) + ldsw + _i * 8192), 16, 0, 0); } } while (0)
#define PG8_LDA(dst, b, h) do { if constexpr (Prob::F8) { _Pragma("unroll") for (int m = 0; m < 2; ++m) { \
            const i32x4 lo_ = *(const PG8_LAS i32x4*)(lds + PG8_SA(b, h) + aoff + m * 2048), hi_ = *(const PG8_LAS i32x4*)(lds + PG8_SA(b, h) + aoff + m * 2048 + 1024); \
            dst##8[m] = __builtin_shufflevector(lo_, hi_, 0, 1, 2, 3, 4, 5, 6, 7); } } \
        else { _Pragma("unroll") for (int m = 0; m < 4; ++m) _Pragma("unroll") for (int k = 0; k < 2; ++k) dst[m][k] = *(const PG8_LAS bf16x8*)(lds + PG8_SA(b, h) + aoff + m * 2048 + k * 1024); } } while (0)
#define PG8_LDB(dst, b, h) do { if constexpr (Prob::F8) { _Pragma("unroll") for (int n = 0; n < 2; ++n) { \
            const i32x4 lo_ = *(const PG8_LAS i32x4*)(lds + PG8_SB(b, h) + boff + n * 2048), hi_ = *(const PG8_LAS i32x4*)(lds + PG8_SB(b, h) + boff + n * 2048 + 1024); \
            dst##8[n] = __builtin_shufflevector(lo_, hi_, 0, 1, 2, 3, 4, 5, 6, 7); } } \
        else { _Pragma("unroll") for (int n = 0; n < 2; ++n) _Pragma("unroll") for (int k = 0; k < 2; ++k) dst[n][k] = *(const PG8_LAS bf16x8*)(lds + PG8_SB(b, h) + boff + n * 2048 + k * 1024); } } while (0)
#define PG8_MMA(ai, bj, At, Bt) do { __builtin_amdgcn_s_setprio(1); _Pragma("unroll") for (int m = 0; m < 4; ++m) _Pragma("unroll") for (int n = 0; n < 2; ++n) { \
        if constexpr (Prob::F8)          \
            acc[ai][bj][m][n] = __builtin_amdgcn_mfma_scale_f32_16x16x128_f8f6f4(Bt##8[n], At##8[m], acc[ai][bj][m][n], 0, 0, 0, 0x7f7f7f7f, 0, 0x7f7f7f7f); \
        else { _Pragma("unroll") for (int k = 0; k < 2; ++k) acc[ai][bj][m][n] = __builtin_amdgcn_mfma_f32_16x16x32_bf16(Bt[n][k], At[m][k], acc[ai][bj][m][n], 0, 0, 0); } } __builtin_amdgcn_s_setprio(0); } while (0)
#define PG8_MMA2(ai, At, B0, B1, b, h) do { if constexpr (Prob::F8) { __builtin_amdgcn_s_setprio(1); \
        _Pragma("unroll") for (int m = 0; m < 2; ++m) _Pragma("unroll") for (int n = 0; n < 2; ++n) { \
            acc[ai][0][m][n] = __builtin_amdgcn_mfma_scale_f32_16x16x128_f8f6f4(B0##8[n], At##8[m], acc[ai][0][m][n], 0, 0, 0, 0x7f7f7f7f, 0, 0x7f7f7f7f); \
            acc[ai][1][m][n] = __builtin_amdgcn_mfma_scale_f32_16x16x128_f8f6f4(B1##8[n], At##8[m], acc[ai][1][m][n], 0, 0, 0, 0x7f7f7f7f, 0, 0x7f7f7f7f); } \
        _Pragma("unroll") for (int m = 0; m < 2; ++m) { \
            const i32x4 lo_ = *(const PG8_LAS i32x4*)(lds + PG8_SA(b, h) + aoff + (m + 2) * 2048), hi_ = *(const PG8_LAS i32x4*)(lds + PG8_SA(b, h) + aoff + (m + 2) * 2048 + 1024); \
            At##8[m] = __builtin_shufflevector(lo_, hi_, 0, 1, 2, 3, 4, 5, 6, 7); } \
        _Pragma("unroll") for (int m = 0; m < 2; ++m) _Pragma("unroll") for (int n = 0; n < 2; ++n) { \
            acc[ai][0][m + 2][n] = __builtin_amdgcn_mfma_scale_f32_16x16x128_f8f6f4(B0##8[n], At##8[m], acc[ai][0][m + 2][n], 0, 0, 0, 0x7f7f7f7f, 0, 0x7f7f7f7f); \
            acc[ai][1][m + 2][n] = __builtin_amdgcn_mfma_scale_f32_16x16x128_f8f6f4(B1##8[n], At##8[m], acc[ai][1][m + 2][n], 0, 0, 0, 0x7f7f7f7f, 0, 0x7f7f7f7f); } \
        __builtin_amdgcn_s_setprio(0); } else { PG8_MMA(ai, 0, At, B0); PG8_MMA(ai, 1, At, B1); } } while (0)
#define PG8_WAIT_V(n) asm volatile("s_waitcnt vmcnt(" #n ")" ::: "memory")
#define PG8_WAIT_L(n) asm volatile("s_waitcnt lgkmcnt(" #n ")" ::: "memory")
#define PG8_BAR __builtin_amdgcn_s_barrier()
#define PG8_SCHED __builtin_amdgcn_sched_barrier(0)
    Unit cur, nxt; int ui = 0;
    if (!P.next(0, cur)) return;
    nxt = cur;
    f32x4 acc[2][2][4][2];
    typename Epi::Pre pre;
    E.prefetch(cur, wc, fq, pre); E.init(acc, pre);
    bf16x8 At[4][2], B0[2][2], B1[2][2];
    i32x8 At8[2], B08[2], B18[2];
    unsigned vAc[2][2];
    PG8_LAS unsigned* van = (PG8_LAS unsigned*)(lds + 131072 + 1024) + tid * 4;
    const char* cA = P.a_base(cur); const char* cB = P.b_base(cur);
    P.a_voff(cur, sR, sC, vAc);
    if constexpr (Prob::GATHER) { van[0] = vAc[0][0]; van[1] = vAc[0][1]; van[2] = vAc[1][0]; van[3] = vAc[1][1]; }
    if constexpr (SP2) {
        PG8_STAGE(PG8_SB(0, 0), cB, voffB); PG8_STAGE(PG8_SB(0, 1), cB + hstepB, voffB); PG8_STAGE(PG8_SA(0, 0), cA, vAc[0]); PG8_STAGE(PG8_SA(0, 1), cA, vAc[1]);
        if (wr == 1) PG8_BAR;
        PG8_WAIT_V(2); PG8_BAR;
        PG8_STAGE(PG8_SB(1, 0), cB + kstep, voffB); PG8_STAGE(PG8_SA(1, 0), cA + kstepA, vAc[0]); PG8_STAGE(PG8_SB(1, 1), cB + hstepB + kstep, voffB);
        PG8_WAIT_V(6); PG8_BAR;
    } else {
        PG8_STAGE(PG8_SB(0, 0), cB, voffB); PG8_STAGE(PG8_SA(0, 0), cA, vAc[0]); PG8_STAGE(PG8_SB(0, 1), cB + hstepB, voffB); PG8_STAGE(PG8_SA(0, 1), cA, vAc[1]);
        if (wr == 1) PG8_BAR;
        PG8_WAIT_V(4); PG8_BAR;
        PG8_STAGE(PG8_SB(1, 0), cB + kstep, voffB); PG8_STAGE(PG8_SA(1, 0), cA + kstepA, vAc[0]); PG8_STAGE(PG8_SB(1, 1), cB + hstepB + kstep, voffB);
        PG8_WAIT_V(6); PG8_BAR;
    }
    for (;;) {
        E.preload(cur, wc, fq, pre);
        const bool has_next = P.next(ui + 1, nxt);
        const char* nA = cA; const char* nB = cB;
        if (has_next) { nA = P.a_base(nxt); nB = P.b_base(nxt);
            if constexpr (Prob::GATHER) { int r2[2], c2[2]; const int t2 = otid();
#pragma unroll
                for (int i = 0; i < 2; ++i) stage_rc(t2 * 16 + i * 8192, r2[i], c2[i]);
                unsigned vn[2][2]; P.a_voff(nxt, r2, c2, vn); van[0] = vn[0][0]; van[1] = vn[0][1]; van[2] = vn[1][0]; van[3] = vn[1][1]; } }
        for (int t = 0; t < nt; t += 2) {
            const bool last = (t == nt - 2);
            const char* a1 = cA + (size_t)(t + 1) * kstepA;
            const char* a2 = last ? nA : cA + (size_t)(t + 2) * kstepA; const char* b2 = last ? nB : cB + (size_t)(t + 2) * kstep;
            const char* a3 = a2 + kstepA; const char* b3 = b2 + kstep;
            if constexpr (SP2) {
            PG8_LDB(B0, 0, 0); PG8_LDB(B1, 0, 1); PG8_SCHED; PG8_LDA(At, 0, 0); PG8_STAGE(PG8_SA(1, 1), a1, vAc[1]);
            PG8_WAIT_V(8); PG8_WAIT_L(0); PG8_BAR; PG8_MMA2(0, At, B0, B1, 0, 0); PG8_BAR; PG8_SCHED;
            PG8_LDA(At, 0, 1); PG8_STAGE(PG8_SB(0, 0), b2, voffB); PG8_STAGE(PG8_SB(0, 1), b2 + hstepB, voffB); PG8_STAGE_SEL(PG8_SA(0, 0), a2, 0);
            PG8_WAIT_V(8); PG8_WAIT_L(0); PG8_BAR; PG8_MMA2(1, At, B0, B1, 0, 1); PG8_BAR; PG8_SCHED;
            PG8_LDB(B0, 1, 0); PG8_LDB(B1, 1, 1); PG8_SCHED; PG8_LDA(At, 1, 0); PG8_STAGE_SEL(PG8_SA(0, 1), a2, 1);
            PG8_WAIT_V(8); PG8_WAIT_L(0); PG8_BAR; PG8_MMA2(0, At, B0, B1, 1, 0); PG8_BAR; PG8_SCHED;
            PG8_LDA(At, 1, 1); PG8_STAGE(PG8_SB(1, 0), b3, voffB); PG8_STAGE(PG8_SB(1, 1), b3 + hstepB, voffB); PG8_STAGE_SEL(PG8_SA(1, 0), a3, 0);
            PG8_WAIT_V(8); PG8_WAIT_L(0); PG8_BAR; PG8_MMA2(1, At, B0, B1, 1, 1); PG8_BAR; PG8_SCHED;
            } else {
            PG8_LDB(B0, 0, 0); PG8_SCHED; PG8_LDA(At, 0, 0); PG8_STAGE(PG8_SA(1, 1), a1, vAc[1]);
            PG8_WAIT_L(8); PG8_BAR; PG8_WAIT_L(0); PG8_MMA(0, 0, At, B0); PG8_BAR; PG8_SCHED;
            PG8_LDB(B1, 0, 1); PG8_STAGE(PG8_SB(0, 0), b2, voffB);
            PG8_BAR; PG8_WAIT_L(0); PG8_MMA(0, 1, At, B1); PG8_BAR;
            PG8_LDA(At, 0, 1); PG8_STAGE_SEL(PG8_SA(0, 0), a2, 0);
            PG8_BAR; PG8_WAIT_L(0); PG8_MMA(1, 0, At, B0); PG8_BAR; PG8_SCHED;
            PG8_STAGE(PG8_SB(0, 1), b2 + hstepB, voffB);
            PG8_WAIT_V(6); PG8_BAR; PG8_MMA(1, 1, At, B1); PG8_BAR;
            PG8_LDB(B0, 1, 0); PG8_SCHED; PG8_LDA(At, 1, 0); PG8_STAGE_SEL(PG8_SA(0, 1), a2, 1);
            PG8_WAIT_L(8); PG8_BAR; PG8_WAIT_L(0); PG8_MMA(0, 0, At, B0); PG8_BAR; PG8_SCHED;
            PG8_LDB(B1, 1, 1); PG8_STAGE(PG8_SB(1, 0), b3, voffB);
            PG8_BAR; PG8_WAIT_L(0); PG8_MMA(0, 1, At, B1); PG8_BAR;
            PG8_LDA(At, 1, 1); PG8_STAGE_SEL(PG8_SA(1, 0), a3, 0);
            PG8_BAR; PG8_WAIT_L(0); PG8_MMA(1, 0, At, B0); PG8_BAR; PG8_SCHED;
            PG8_STAGE(PG8_SB(1, 1), b3 + hstepB, voffB);
            PG8_WAIT_V(6); PG8_BAR; PG8_MMA(1, 1, At, B1); PG8_BAR;
            }
        }
        if constexpr (ALIGN_EPI) { if (wr == 0) PG8_BAR; }
        E(acc, cur, wr, wc, fr, fq, has_next, nxt, pre);
        if (!has_next) break;
        E.init(acc, pre);
        cur = nxt; cA = nA; cB = nB; ++ui;
        if constexpr (Prob::GATHER) {
#pragma unroll
            for (int h = 0; h < 2; ++h)
#pragma unroll
                for (int i = 0; i < 2; ++i) vAc[h][i] = van[h * 2 + i];
        }
        if constexpr (ALIGN_EPI) { if (wr == 1) PG8_BAR; }
    }
    PG8_WAIT_V(0);
    if constexpr (!ALIGN_EPI) { if (wr == 0) PG8_BAR; }
    PG8_BAR;
#undef PG8_SA
#undef PG8_SB
#undef PG8_STAGE
#undef PG8_STAGE_SEL
#undef PG8_LDA
#undef PG8_LDB
#undef PG8_MMA
#undef PG8_WAIT_V
#undef PG8_WAIT_L
#undef PG8_BAR
#undef PG8_SCHED
}

struct ProbDense { static constexpr bool F8 = false; static constexpr bool GATHER = false; static constexpr int KT = 0;
    const bf16_t* A; const bf16_t* Bt; int K, nM, nN, G, c; bool headperm;
    __device__ __forceinline__ bool next(int i, Unit& u) const { return static_next(nM, nN, G, c, i, u); }
    __device__ __forceinline__ const char* a_base(const Unit& u) const { return (const char*)(A + (size_t)u.pm * BM * K); }
    __device__ __forceinline__ void a_voff(const Unit&, const int (&R)[2], const int (&C)[2], unsigned (&v)[2][2]) const {
#pragma unroll
        for (int h = 0; h < 2; ++h)
#pragma unroll
            for (int i = 0; i < 2; ++i) v[h][i] = (unsigned)((h * HALF + R[i]) * K + C[i]) * 2u;
    }
    __device__ __forceinline__ const char* b_base(const Unit& u) const { return (const char*)(Bt + (size_t)u.pn * BM * K); }
    __device__ __forceinline__ size_t a_kstep() const { return (size_t)BK * 2; }
    __device__ __forceinline__ size_t b_hstep() const { return headperm ? (size_t)32 * K * 2 : (size_t)HALF * K * 2; }
    __device__ __forceinline__ int b_row(int R) const { return headperm ? ((R >> 5) * 64 + perm32(R & 31)) : ((R & ~31) + perm32(R & 31)); }
};
typedef const PG8_LAS int* lds_ints;
__device__ __forceinline__ int expert_of(lds_ints ps, int pm) { int e = 0;
#pragma unroll
    for (int i = 1; i < 32; ++i) if (ps[i] <= pm * 256) e = i;
    return __builtin_amdgcn_readfirstlane(e); }
struct ProbMoe1 { static constexpr bool F8 = true; static constexpr bool GATHER = true; static constexpr int KT = 0;
    const bf16_t* XN; const bf16_t* W1T; const int* rowtok; lds_ints ps; int K, ntm, G, c;
    __device__ __forceinline__ bool next(int i, Unit& u) const {
        if (G != 256) { const int q = i * G + c; if (q >= ntm * 8) return false; u.pm = q >> 3; u.pn = q & 7; u.e = expert_of(ps, u.pm); return true; }
        const int x = c & 7, s = c >> 3; const int pm = 4 * (i * 8 + x) + (s >> 3); if (pm >= ntm) return false;
        u.pm = pm; u.pn = s & 7; u.e = expert_of(ps, u.pm); return true; }
    __device__ __forceinline__ const char* a_base(const Unit&) const { return (const char*)XN; }
    __device__ __forceinline__ void a_voff(const Unit& u, const int (&R)[2], const int (&C)[2], unsigned (&v)[2][2]) const {
#pragma unroll
        for (int h = 0; h < 2; ++h)
#pragma unroll
            for (int i = 0; i < 2; ++i) { int tk = rowtok[u.pm * BM + h * HALF + R[i]]; if (tk < 0) tk = T; v[h][i] = (unsigned)(tk * K + C[i]) * 2u; }
    }
    __device__ __forceinline__ const char* b_base(const Unit& u) const { return (const char*)(W1T + ((size_t)u.e * 2048 + u.pn * 128) * K); }
    __device__ __forceinline__ size_t a_kstep() const { return (size_t)BK * 2; }
    __device__ __forceinline__ size_t b_hstep() const { return (size_t)1024 * K * 2; }
    __device__ __forceinline__ int b_row(int R) const { return (R & ~31) + perm32(R & 31); }
};
struct ProbMoe2 { static constexpr bool F8 = true; static constexpr bool GATHER = false; static constexpr int KT = 0;
    const bf16_t* ACT; const bf16_t* W2T; lds_ints ps; int K, ntm, G, c;
    __device__ __forceinline__ bool next(int i, Unit& u) const {
        if (G != 256) { const int q = i * G + c; if (q >= ntm * 4) return false; u.pm = q >> 2; u.pn = q & 3; u.e = expert_of(ps, u.pm); return true; }
        const int x = c & 7, s = c >> 3; const int pm = 8 * (i * 8 + x) + (s >> 2); if (pm >= ntm) return false;
        u.pm = pm; u.pn = s & 3; u.e = expert_of(ps, u.pm); return true; }
    __device__ __forceinline__ const char* a_base(const Unit& u) const { return (const char*)(ACT + (size_t)u.pm * BM * K); }
    __device__ __forceinline__ void a_voff(const Unit&, const int (&R)[2], const int (&C)[2], unsigned (&v)[2][2]) const {
#pragma unroll
        for (int h = 0; h < 2; ++h)
#pragma unroll
            for (int i = 0; i < 2; ++i) v[h][i] = (unsigned)((h * HALF + R[i]) * K + C[i]) * 2u;
    }
    __device__ __forceinline__ const char* b_base(const Unit& u) const { return (const char*)(W2T + ((size_t)u.e * 1024 + u.pn * BM) * K); }
    __device__ __forceinline__ size_t a_kstep() const { return (size_t)BK * 2; }
    __device__ __forceinline__ size_t b_hstep() const { return (size_t)HALF * K * 2; }
    __device__ __forceinline__ int b_row(int R) const { return (R & ~31) + perm32(R & 31); }
};

struct ProbCmp { static constexpr bool F8 = false; static constexpr bool GATHER = false; static constexpr int KT = 8;
    const bf16_t* ZB; const bf16_t* W1T; int K, G, c;
    __device__ __forceinline__ bool next(int i, Unit& u) const { const int q = i * G + c; if (q >= 64) return false; u.pm = q & 15; u.pn = 0; u.e = q >> 4; return true; }
    __device__ __forceinline__ const char* a_base(const Unit& u) const { const int idx = u.pm >> 3, bg = (u.pm >> 1) & 3, half = u.pm & 1;
        return (const char*)(ZB + ((size_t)(bg >> 1) * S + 16 * 256 * half + 8 * u.e) * ZBW + ZB_KC + idx * 128 + (bg & 1) * 64); }
    __device__ __forceinline__ void a_voff(const Unit&, const int (&R)[2], const int (&C)[2], unsigned (&v)[2][2]) const {
#pragma unroll
        for (int h = 0; h < 2; ++h)
#pragma unroll
            for (int i = 0; i < 2; ++i) v[h][i] = (unsigned)(16 * (h * HALF + R[i]) * ZBW + C[i]) * 2u;
    }
    __device__ __forceinline__ size_t a_kstep() const { return (size_t)ZBW * 2; }
    __device__ __forceinline__ const char* b_base(const Unit& u) const { return (const char*)(W1T + (size_t)(u.pm >> 3) * 128 * K + 8 * 64 * u.e); }
    __device__ __forceinline__ size_t b_hstep() const { return 0; }
    __device__ __forceinline__ int b_row(int R) const { return (R & ~31) + perm32(R & 31); }
};
struct EpiCmp {
    float* HIDP;
    struct Pre {};
    __device__ __forceinline__ void prefetch(const Unit&, int, int, Pre&) const {}
    __device__ __forceinline__ void preload(const Unit&, int, int, Pre&) const {}
    __device__ __forceinline__ void init(f32x4 (&acc)[2][2][4][2], const Pre&) const {
#pragma unroll
        for (int a = 0; a < 2; ++a)
#pragma unroll
            for (int b = 0; b < 2; ++b)
#pragma unroll
                for (int m = 0; m < 4; ++m)
#pragma unroll
                    for (int n = 0; n < 2; ++n) acc[a][b][m][n] = (f32x4){0.f, 0.f, 0.f, 0.f};
    }
    __device__ __forceinline__ void operator()(const f32x4 (&acc)[2][2][4][2], const Unit& u, int wr, int wc, int fr, int fq, bool has_next, const Unit& nxt, Pre& pre) const {
        const int idx = u.pm >> 3, bg = (u.pm >> 1) & 3, half = u.pm & 1;
        const int c0 = 32 * wc + 8 * fq;
#pragma unroll
        for (int ai = 0; ai < 2; ++ai)
#pragma unroll
            for (int m = 0; m < 4; ++m) { const int n = 256 * half + ai * HALF + wr * 64 + m * 16 + fr;
                if (n < 511) { float* dst = HIDP + (((size_t)u.e * 2 + idx) * 2044 + bg * 511 + n) * 128 + c0;
                    *(f32x4*)dst = acc[ai][0][m][0]; *(f32x4*)(dst + 4) = acc[ai][0][m][1]; } }
    }
};
struct EpiG1F {
    bf16_t* ZB; float* GATE; const float* gq; const float* gk; const float* gmq; const float* gmk;
    struct Pre {};
    __device__ __forceinline__ void prefetch(const Unit&, int, int, Pre&) const {}
    __device__ __forceinline__ void preload(const Unit&, int, int, Pre&) const {}
    __device__ __forceinline__ void init(f32x4 (&acc)[2][2][4][2], const Pre&) const {
#pragma unroll
        for (int a = 0; a < 2; ++a)
#pragma unroll
            for (int b = 0; b < 2; ++b)
#pragma unroll
                for (int m = 0; m < 4; ++m)
#pragma unroll
                    for (int n = 0; n < 2; ++n) acc[a][b][m][n] = (f32x4){0.f, 0.f, 0.f, 0.f};
    }
    __device__ __forceinline__ void operator()(const f32x4 (&acc)[2][2][4][2], const Unit& u, int wr, int wc, int fr, int fq, bool has_next, const Unit& nxt, Pre& pre) const {
        const int pn = u.pn;
        const float* gain = nullptr; float sc = 1.f;
        if (pn < 2) { gain = gq; sc = QSCALE; }
        else if (pn == 3 || pn == 4) { if (wc < 2) gain = gk; }
        else if (pn == 5 || pn == 6) { gain = gmq; sc = QSCALE; }
        else if (pn == 7 || pn == 8) { gain = gmk; }
        if (pn == 11) {
            if (wc == 0 && fq < 3) {
#pragma unroll
                for (int ai = 0; ai < 2; ++ai)
#pragma unroll
                    for (int m = 0; m < 4; ++m) { const size_t r = (size_t)u.pm * BM + ai * HALF + wr * 64 + m * 16 + fr;
#pragma unroll
                        for (int n = 0; n < 2; ++n) { const f32x4 v = acc[ai][0][m][n]; f32x4 o;
#pragma unroll
                            for (int i = 0; i < 4; ++i) o[i] = __builtin_amdgcn_rcpf(1.f + __builtin_amdgcn_exp2f(-LOG2E * v[i]));
                            *(f32x4*)(GATE + r * 32 + 8 * fq + 4 * n) = o; } }
            }
            return;
        }
        f32x4 gv[2][2];
#pragma unroll
        for (int bj = 0; bj < 2; ++bj)
#pragma unroll
            for (int n = 0; n < 2; ++n) gv[bj][n] = gain ? *(const f32x4*)(gain + 32 * bj + 8 * fq + 4 * n) * sc : (f32x4){1.f, 1.f, 1.f, 1.f};
#pragma unroll
        for (int ai = 0; ai < 2; ++ai)
#pragma unroll
            for (int m = 0; m < 4; ++m) { const size_t r = (size_t)u.pm * BM + ai * HALF + wr * 64 + m * 16 + fr;
                float rs = 1.f;
                if (gain) { float ss = 0.f;
#pragma unroll
                    for (int bj = 0; bj < 2; ++bj)
#pragma unroll
                        for (int n = 0; n < 2; ++n) { const f32x4 v = acc[ai][bj][m][n]; ss += (v[0] * v[0] + v[1] * v[1]) + (v[2] * v[2] + v[3] * v[3]); }
                    ss += __shfl_xor(ss, 16); ss += __shfl_xor(ss, 32);
                    rs = rsqrtf(ss * (1.f / 64.f) + EPS); }
#pragma unroll
                for (int bj = 0; bj < 2; ++bj) { const f32x4 a = acc[ai][bj][m][0] * gv[bj][0] * rs, b = acc[ai][bj][m][1] * gv[bj][1] * rs;
                    u32x4 w; w.x = cvt_pk_bf16(a[0], a[1]); w.y = cvt_pk_bf16(a[2], a[3]); w.z = cvt_pk_bf16(b[0], b[1]); w.w = cvt_pk_bf16(b[2], b[3]);
                    *(u32x4*)(ZB + r * ZBW + pn * BM + 64 * wc + 32 * bj + 8 * fq) = w; } }
    }
};
struct EpiG2 {
    const float* xin32; bf16_t* XAB; const float* g1;
    struct Pre {};
    __device__ __forceinline__ void prefetch(const Unit&, int, int, Pre&) const {}
    __device__ __forceinline__ void preload(const Unit&, int, int, Pre&) const {}
    __device__ __forceinline__ void init(f32x4 (&acc)[2][2][4][2], const Pre&) const {
#pragma unroll
        for (int a = 0; a < 2; ++a)
#pragma unroll
            for (int b = 0; b < 2; ++b)
#pragma unroll
                for (int m = 0; m < 4; ++m)
#pragma unroll
                    for (int n = 0; n < 2; ++n) acc[a][b][m][n] = (f32x4){0.f, 0.f, 0.f, 0.f};
    }
    __device__ __forceinline__ void operator()(const f32x4 (&acc)[2][2][4][2], const Unit& u, int wr, int wc, int fr, int fq, bool has_next, const Unit& nxt, Pre& pre) const {
        { const int t_ = otid(); fr = t_ & 15; fq = (t_ >> 4) & 3; }
        const int b = (u.pm * BM) / S;
        f32x4 gg[2][2];
#pragma unroll
        for (int bj = 0; bj < 2; ++bj) { const int c = u.pn * BM + 128 * bj + 32 * wc + 8 * fq; gg[bj][0] = *(const f32x4*)(g1 + (size_t)b * 6144 + c); gg[bj][1] = *(const f32x4*)(g1 + (size_t)b * 6144 + c + 4); }
#pragma unroll
        for (int ai = 0; ai < 2; ++ai)
#pragma unroll
            for (int m = 0; m < 4; ++m) { const size_t r = (size_t)u.pm * BM + ai * HALF + wr * 64 + m * 16 + fr;
#pragma unroll
                for (int bj = 0; bj < 2; ++bj) { const int c = u.pn * BM + 128 * bj + 32 * wc + 8 * fq;
                    f32x4 x0, x1;
                    if (xin32) { x0 = *(const f32x4*)(xin32 + r * D + c); x1 = *(const f32x4*)(xin32 + r * D + c + 4); }
                    else { const u32x4 q = *(const u32x4*)(XAB + r * D + c);
                        x0 = (f32x4){__builtin_bit_cast(float, q.x << 16), __builtin_bit_cast(float, q.x & 0xffff0000u), __builtin_bit_cast(float, q.y << 16), __builtin_bit_cast(float, q.y & 0xffff0000u)};
                        x1 = (f32x4){__builtin_bit_cast(float, q.z << 16), __builtin_bit_cast(float, q.z & 0xffff0000u), __builtin_bit_cast(float, q.w << 16), __builtin_bit_cast(float, q.w & 0xffff0000u)}; }
                    const f32x4 g0 = gg[bj][0], g1v = gg[bj][1];
                    const f32x4 y0 = x0 + g0 * acc[ai][bj][m][0], y1 = x1 + g1v * acc[ai][bj][m][1];
                    u32x4 o; o.x = cvt_pk_bf16(y0[0], y0[1]); o.y = cvt_pk_bf16(y0[2], y0[3]); o.z = cvt_pk_bf16(y1[0], y1[1]); o.w = cvt_pk_bf16(y1[2], y1[3]);
                    *(u32x4*)(XAB + r * D + c) = o; } }
    }
};
struct EpiM1 {
    unsigned char* ACT8; const float* b1l; const float* dq1l;
    struct Pre { f32x4 bg, bl, sg, sl; };
    __device__ __forceinline__ void prefetch(const Unit&, int, int, Pre&) const {}
    __device__ __forceinline__ void preload(const Unit& u, int wc, int fq, Pre& q) const {
        const int c0 = u.pn * 128 + 32 * wc + 8 * fq; const float* b1 = b1l + (size_t)u.e * 2048 + c0; const float* dq = dq1l + (size_t)u.e * 2048 + c0;
        q.bg = *(const f32x4*)(b1); q.bl = *(const f32x4*)(b1 + 1024); q.sg = *(const f32x4*)(dq); q.sl = *(const f32x4*)(dq + 1024); }
    __device__ __forceinline__ void init(f32x4 (&acc)[2][2][4][2], const Pre&) const {
#pragma unroll
        for (int a = 0; a < 2; ++a)
#pragma unroll
            for (int b = 0; b < 2; ++b)
#pragma unroll
                for (int m = 0; m < 4; ++m)
#pragma unroll
                    for (int n = 0; n < 2; ++n) acc[a][b][m][n] = (f32x4){0.f, 0.f, 0.f, 0.f};
    }
    __device__ __forceinline__ void operator()(const f32x4 (&acc)[2][2][4][2], const Unit& u, int wr, int wc, int fr, int fq, bool has_next, const Unit& nxt, Pre& pre) const {
        { const int t_ = otid(); fr = t_ & 15; fq = (t_ >> 4) & 3; }
        const int c0 = u.pn * 128 + 32 * wc + 8 * fq;
        const float* b1 = b1l + (size_t)u.e * 2048 + c0; const float* dq = dq1l + (size_t)u.e * 2048 + c0;
        unsigned w[2][4][2];
        const f32x4 bg1 = *(const f32x4*)(b1 + 4), bl1 = *(const f32x4*)(b1 + 1024 + 4), sg1 = *(const f32x4*)(dq + 4), sl1 = *(const f32x4*)(dq + 1024 + 4);
#pragma unroll
        for (int n = 0; n < 2; ++n) {
            const f32x4 bg = n ? bg1 : pre.bg, bl = n ? bl1 : pre.bl;
            const f32x4 sg = (n ? sg1 : pre.sg) * (1.f / XS8), sl = (n ? sl1 : pre.sl) * (1.f / XS8);
#pragma unroll
            for (int ai = 0; ai < 2; ++ai)
#pragma unroll
                for (int m = 0; m < 4; ++m) { const f32x4 g = acc[ai][0][m][n] * sg + bg, li = acc[ai][1][m][n] * sl + bl; float o[4];
#pragma unroll
                    for (int i = 0; i < 4; ++i) { const float gc = fminf(g[i], 7.f), lc = __builtin_amdgcn_fmed3f(li[i], -7.f, 7.f);
                        o[i] = (AS8 * (lc + 1.f)) * (gc * __builtin_amdgcn_rcpf(1.f + __builtin_amdgcn_exp2f((-1.702f * LOG2E) * gc))); }
                    w[ai][m][n] = pk_fp8x4(o[0], o[1], o[2], o[3]); }
        }
#pragma unroll
        for (int ai = 0; ai < 2; ++ai)
#pragma unroll
            for (int m = 0; m < 4; ++m) { const size_t r = (size_t)u.pm * BM + ai * HALF + wr * 64 + m * 16 + fr;
                *(uint2*)(ACT8 + r * DFF + c0) = make_uint2(w[ai][m][0], w[ai][m][1]); }
    }
};
struct EpiM2 {
    bf16_t* Y; const float* b2l; const float* dq2l;
    struct Pre {};
    __device__ __forceinline__ void prefetch(const Unit&, int, int, Pre&) const {}
    __device__ __forceinline__ void preload(const Unit&, int, int, Pre&) const {}
    __device__ __forceinline__ void init(f32x4 (&acc)[2][2][4][2], const Pre&) const {
#pragma unroll
        for (int a = 0; a < 2; ++a)
#pragma unroll
            for (int b = 0; b < 2; ++b)
#pragma unroll
                for (int m = 0; m < 4; ++m)
#pragma unroll
                    for (int n = 0; n < 2; ++n) acc[a][b][m][n] = (f32x4){0.f, 0.f, 0.f, 0.f};
    }
    __device__ __forceinline__ void operator()(const f32x4 (&acc)[2][2][4][2], const Unit& u, int wr, int wc, int fr, int fq, bool has_next, const Unit& nxt, Pre& pre) const {
        { const int t_ = otid(); fr = t_ & 15; fq = (t_ >> 4) & 3; }
        const int cb = u.pn * BM + 32 * wc + 8 * fq;
        const float* b2 = b2l + (size_t)u.e * D + cb; const float* dq = dq2l + (size_t)u.e * D + cb;
#pragma unroll
        for (int bj = 0; bj < 2; ++bj) { const int c = cb + 128 * bj;
            const f32x4 b0 = *(const f32x4*)(b2 + 128 * bj), b1_ = *(const f32x4*)(b2 + 128 * bj + 4);
            const f32x4 s0 = *(const f32x4*)(dq + 128 * bj) * (1.f / AS8), s1 = *(const f32x4*)(dq + 128 * bj + 4) * (1.f / AS8);
#pragma unroll
            for (int ai = 0; ai < 2; ++ai)
#pragma unroll
                for (int m = 0; m < 4; ++m) { const size_t r = (size_t)u.pm * BM + ai * HALF + wr * 64 + m * 16 + fr;
                    const f32x4 v0 = acc[ai][bj][m][0] * s0 + b0, v1 = acc[ai][bj][m][1] * s1 + b1_;
                    *(uint2*)((unsigned char*)Y + r * D + c) = make_uint2(pk_fp8x4(v0[0] * YS8, v0[1] * YS8, v0[2] * YS8, v0[3] * YS8), pk_fp8x4(v1[0] * YS8, v1[1] * YS8, v1[2] * YS8, v1[3] * YS8)); }
        }
    }
};
}

__device__ __forceinline__ void phase_g1_fast(const Params& p, int l, unsigned char* lds_raw) {
    pg8::ProbDense P{(const bf16_t*)(p.ws + WS_XN), (const bf16_t*)(p.ws + WS_WINT) + (size_t)l * ZBW * D, D, T / 256, ZBW / 256, (int)gridDim.x, (int)blockIdx.x, true};
    pg8::EpiG1F E{(bf16_t*)(p.ws + WS_ZB), (float*)(p.ws + WS_GATE), p.in[7] + l * 64, p.in[8] + l * 64, p.in[12] + l * 64, p.in[13] + l * 64};
    pg8::gemm_phase<pg8::ProbDense, pg8::EpiG1F, true, true>((PG8_LAS unsigned char*)lds_raw, P, E);
}
__device__ __forceinline__ void phase_g2_fast(const Params& p, int l, unsigned char* lds_raw) {
    pg8::ProbDense P{(const bf16_t*)(p.ws + WS_ATTB), (const bf16_t*)(p.ws + WS_WOT) + (size_t)l * D * D, D, T / 256, D / 256, (int)gridDim.x, (int)blockIdx.x, false};
    pg8::EpiG2 E{l == 0 ? p.in[0] : (const float*)nullptr, (bf16_t*)(p.ws + WS_XAB), (const float*)(p.ws + WS_MOD) + (size_t)l * Bn * 6144 + 2 * D};
    pg8::gemm_phase<pg8::ProbDense, pg8::EpiG2, true, true>((PG8_LAS unsigned char*)lds_raw, P, E);
}
constexpr int LDS_PS_OFF = 131072;
__device__ __forceinline__ void phase_ck_fast(const Params& p, int l, unsigned char* lds_raw) {
    pg8::ProbCmp P{(const bf16_t*)(p.ws + WS_ZB), (const bf16_t*)(p.ws + WS_WCT) + (size_t)l * 2 * 128 * 2048, 2048, (int)gridDim.x, (int)blockIdx.x};
    pg8::EpiCmp E{(float*)(p.ws + WS_HIDP)};
    pg8::gemm_phase<pg8::ProbCmp, pg8::EpiCmp, true, true>((PG8_LAS unsigned char*)lds_raw, P, E);
    { const int tid = otid(), lane = tid & 63, wave = tid >> 6, r8 = lane >> 3, c8 = lane & 7;
      const bf16_t* Z = (const bf16_t*)(p.ws + WS_ZB); bf16_t* KMB = (bf16_t*)(p.ws + WS_KMB);
      float* part = (float*)(lds_raw + 131072 + 512);
      for (int it0 = blockIdx.x * 2; it0 < Bn * 8 * 32; it0 += gridDim.x * 2) {
          const int it = it0 + (wave >> 2), q = wave & 3;
          const int b = it / 256, h = (it / 32) & 7, blk = it & 31;
          const bf16_t* base = Z + (size_t)(b * S + blk * 256 + q * 64 + r8) * ZBW + ZB_MK + h * 64 + c8 * 8;
          float s[8] = {0.f, 0.f, 0.f, 0.f, 0.f, 0.f, 0.f, 0.f};
          uint4 v[8];
#pragma unroll
          for (int i = 0; i < 8; ++i) v[i] = *(const uint4*)(base + (size_t)(8 * i) * ZBW);
#pragma unroll
          for (int i = 0; i < 8; ++i) { const unsigned w[4] = {v[i].x, v[i].y, v[i].z, v[i].w};
#pragma unroll
              for (int e = 0; e < 4; ++e) { s[2 * e] += __builtin_bit_cast(float, w[e] << 16); s[2 * e + 1] += __builtin_bit_cast(float, w[e] & 0xffff0000u); } }
#pragma unroll
          for (int e = 0; e < 8; ++e) { s[e] += __shfl_xor(s[e], 8); s[e] += __shfl_xor(s[e], 16); s[e] += __shfl_xor(s[e], 32); }
          if (r8 == 0) {
#pragma unroll
              for (int e = 0; e < 8; ++e) part[wave * 64 + c8 * 8 + e] = s[e]; }
          __syncthreads();
          if (tid < 128) { const int item = tid >> 6, d = tid & 63; const float* pp = part + item * 256 + d;
              KMB[(size_t)(it0 + item) * 64 + d] = (bf16_t)f2bf((((pp[0] + pp[64]) + pp[128]) + pp[192]) * (1.f / 256.f)); }
          __syncthreads();
      } }
}
__device__ __forceinline__ void phase_m1_fast(const Params& p, int l, unsigned char* lds_raw) {
    int* ps = (int*)(lds_raw + LDS_PS_OFF);
    load_pstart(p, l, ps);
    pg8::ProbMoe1 P{(const bf16_t*)(p.ws + WS_XN8), (const bf16_t*)(p.ws + WS_W1T) + (size_t)l * NE * 2048 * 512, (const int*)(p.ws + WS_ROWTOK) + (size_t)l * RMAX, (pg8::lds_ints)ps, 512, ps[32] / 256, (int)gridDim.x, (int)blockIdx.x};
    pg8::EpiM1 E{p.ws + WS_ACT, p.in[18] + (size_t)l * NE * 2048, (const float*)(p.ws + WS_DQ1) + (size_t)l * NE * 2048};
    pg8::gemm_phase<pg8::ProbMoe1, pg8::EpiM1, true, true>((PG8_LAS unsigned char*)lds_raw, P, E);
    __syncthreads();
}
__device__ __forceinline__ void phase_m2_fast(const Params& p, int l, unsigned char* lds_raw) {
    int* ps = (int*)(lds_raw + LDS_PS_OFF);
    load_pstart(p, l, ps);
    pg8::ProbMoe2 P{(const bf16_t*)(p.ws + WS_ACT), (const bf16_t*)(p.ws + WS_W2T) + (size_t)l * NE * D * 512, (pg8::lds_ints)ps, 512, ps[32] / 256, (int)gridDim.x, (int)blockIdx.x};
    pg8::EpiM2 E{(bf16_t*)(p.ws + WS_Y), p.in[20] + (size_t)l * NE * D, (const float*)(p.ws + WS_DQ2) + (size_t)l * NE * D};
    pg8::gemm_phase<pg8::ProbMoe2, pg8::EpiM2, true, true>((PG8_LAS unsigned char*)lds_raw, P, E);
    __syncthreads();
}

namespace at {
#define AT_LAS __attribute__((address_space(3)))
typedef short bf16x8 __attribute__((ext_vector_type(8)));
typedef short s16x4 __attribute__((ext_vector_type(4)));
typedef short v4i16_t __attribute__((ext_vector_type(4)));
typedef float f32x16 __attribute__((ext_vector_type(16)));
typedef unsigned u32x4 __attribute__((ext_vector_type(4)));
typedef float f32x2_t __attribute__((ext_vector_type(2))); typedef __bf16 bf16x2_t __attribute__((ext_vector_type(2)));
typedef AT_LAS unsigned char* lp;
constexpr int L_K = 0  , L_V = 32768  , L_WSF = 65536, L_OST = 67584  , L_SELM = 133120, L_UNI = 134144, L_KMT = 134400, L_END = 142592;
constexpr float NEGS = -1e30f;
constexpr float MAXTHR = 12.f;
__device__ __forceinline__ int crow(int r, int hi) { return (r & 3) + 8 * (r >> 2) + 4 * hi; }
__device__ __forceinline__ unsigned cvtpk(float lo, float hi) { f32x2_t v = {lo, hi}; bf16x2_t b = __builtin_convertvector(v, bf16x2_t); return __builtin_bit_cast(unsigned, b); }
__device__ __forceinline__ float mx3(float a, float b, float c) { return __builtin_fmaxf(__builtin_fmaxf(a, b), c); }
__device__ __forceinline__ void wsync() { asm volatile("s_waitcnt lgkmcnt(0)" ::: "memory"); __builtin_amdgcn_wave_barrier(); }
__device__ __forceinline__ void bar() { __builtin_amdgcn_s_barrier(); }
#define AT_WAITV(n) asm volatile("s_waitcnt vmcnt(" #n ")" ::: "memory")
#define AT_WAITL() asm volatile("s_waitcnt lgkmcnt(0)" ::: "memory")
__device__ __forceinline__ void glds(const void* g, lp dst) { __builtin_amdgcn_global_load_lds((const unsigned*)g, (AT_LAS unsigned*)dst, 16, 0, 0); }
__device__ __forceinline__ s16x4 vtr(const AT_LAS unsigned char* p) { return __builtin_bit_cast(s16x4, __builtin_amdgcn_ds_read_tr16_b64_v4i16((AT_LAS v4i16_t*)p)); }

__device__ __forceinline__ void dma_k(lp slot, const bf16_t* kbase, int pitch, int key0, int wid, int lane) { glds(kbase + (size_t)(key0 + lane) * pitch + wid * 8, slot + wid * 1024); }
__device__ __forceinline__ void dma_v(lp slot, const bf16_t* vbase, int pitch, int key0, int wid, int lane) {
    glds(vbase + (size_t)(key0 + 16 * (wid & 3) + (lane >> 2)) * pitch + (wid >> 2) * 32 + (lane & 3) * 8, slot + wid * 1024); }

__device__ __forceinline__ void qk_tile(f32x16& p0, f32x16& p1, lp kslot, const bf16x8 (&qr)[4], int r32, int hi) {
    const AT_LAS unsigned char* kb = kslot + hi * 1024 + r32 * 16;
    bf16x8 b0[4], b1[4];
#pragma unroll
    for (int d0 = 0; d0 < 4; ++d0) { b0[d0] = *(const AT_LAS bf16x8*)(kb + d0 * 2048); b1[d0] = *(const AT_LAS bf16x8*)(kb + d0 * 2048 + 512); }
#pragma unroll
    for (int d0 = 0; d0 < 4; ++d0) {
        p0 = __builtin_amdgcn_mfma_f32_32x32x16_bf16(b0[d0], qr[d0], p0, 0, 0, 0);
        p1 = __builtin_amdgcn_mfma_f32_32x32x16_bf16(b1[d0], qr[d0], p1, 0, 0, 0);
    }
}
struct VFrag { bf16x8 f[8]; };
__device__ __forceinline__ void pv_load(VFrag& v, lp vslot, int lane, int hi) {
    const AT_LAS unsigned char* vp = vslot + ((lane >> 4) & 1) * 32 + (lane & 3) * 8 + (4 * hi + ((lane & 15) >> 2)) * 64;
#pragma unroll
    for (int d0 = 0; d0 < 2; ++d0)
#pragma unroll
        for (int ks = 0; ks < 4; ++ks) {
            const s16x4 lo = vtr(vp + d0 * 4096 + ks * 1024), hh = vtr(vp + d0 * 4096 + ks * 1024 + 512);
            v.f[d0 * 4 + ks] = (bf16x8){lo[0], lo[1], lo[2], lo[3], hh[0], hh[1], hh[2], hh[3]};
        }
}
__device__ __forceinline__ void pv_mfma(f32x16 (&o)[2], const VFrag& v, u32x4 pw0, u32x4 pw1, u32x4 pw2, u32x4 pw3) {
    const bf16x8 pa[4] = {__builtin_bit_cast(bf16x8, pw0), __builtin_bit_cast(bf16x8, pw1), __builtin_bit_cast(bf16x8, pw2), __builtin_bit_cast(bf16x8, pw3)};
#pragma unroll
    for (int ks = 0; ks < 4; ++ks) {
        o[0] = __builtin_amdgcn_mfma_f32_32x32x16_bf16(pa[ks], v.f[ks], o[0], 0, 0, 0);
        o[1] = __builtin_amdgcn_mfma_f32_32x32x16_bf16(pa[ks], v.f[4 + ks], o[1], 0, 0, 0);
    }
}
__device__ __forceinline__ float rowmax(const f32x16& p0, const f32x16& p1) {
    float a = mx3(p0[0], p0[1], p1[0]), b = mx3(p0[2], p0[3], p1[1]); a = mx3(a, p1[2], p1[3]);
#pragma unroll
    for (int r = 4; r < 16; r += 4) { a = mx3(a, p0[r], p0[r + 1]); b = mx3(b, p0[r + 2], p0[r + 3]); a = mx3(a, p1[r], p1[r + 1]); b = mx3(b, p1[r + 2], p1[r + 3]); }
    const float m = __builtin_fmaxf(a, b);
    auto rr = __builtin_amdgcn_permlane32_swap(__float_as_uint(m), __float_as_uint(m), false, false);
    return __builtin_fmaxf(__uint_as_float(rr[0]), __uint_as_float(rr[1]));
}
__device__ __forceinline__ float halfsum(float v) {
    auto rr = __builtin_amdgcn_permlane32_swap(__float_as_uint(v), __float_as_uint(v), false, false);
    return __uint_as_float(rr[0]) + __uint_as_float(rr[1]);
}
__device__ __forceinline__ void mask_tile(f32x16& p0, f32x16& p1, int lo, int hi_, int hi) {
    const int kb = 4 * hi;
#pragma unroll
    for (int r = 0; r < 16; ++r) { const int kv = kb + (r & 3) + 8 * (r >> 2); if (kv > hi_ || kv < lo) p0[r] = NEGS; if (kv + 32 > hi_ || kv + 32 < lo) p1[r] = NEGS; }
}

__device__ __forceinline__ void mask_init_lo(f32x16& p0, f32x16& p1, int lo, int hi) {
    const int kb = 4 * hi;
#pragma unroll
    for (int r = 0; r < 16; ++r) { const int kv = kb + (r & 3) + 8 * (r >> 2); if (kv < lo) p0[r] = NEGS; if (kv + 32 < lo) p1[r] = NEGS; }
}
__device__ __forceinline__ void mask_init(f32x16& p0, f32x16& p1, int hi_, int hi) {
    const int kb = 4 * hi;
#pragma unroll
    for (int r = 0; r < 16; ++r) { const int kv = kb + (r & 3) + 8 * (r >> 2); if (kv > hi_) p0[r] = NEGS; if (kv + 32 > hi_) p1[r] = NEGS; }
}
__device__ __forceinline__ int next_bit128(unsigned u0, unsigned u1, unsigned u2, unsigned u3, int below) {
    if (below > 96) { unsigned x = u3; if (below < 128) x &= (1u << (below - 96)) - 1u; if (x) return 96 + 31 - __builtin_clz(x); }
    if (below > 64) { unsigned x = u2; if (below < 96) x &= (1u << (below - 64)) - 1u; if (x) return 64 + 31 - __builtin_clz(x); }
    if (below > 32) { unsigned x = u1; if (below < 64) x &= (1u << (below - 32)) - 1u; if (x) return 32 + 31 - __builtin_clz(x); }
    if (below > 0) { unsigned x = u0; if (below < 32) x &= (1u << below) - 1u; if (x) return 31 - __builtin_clz(x); }
    return -1;
}
struct Soft { float m, l; };

template <bool HAS_O>
__device__ __forceinline__ void softmax_step(f32x16& p0, f32x16& p1, Soft& st, f32x16 (&o)[2], float* wsf, int r32, int hi) {
    const float rm = rowmax(p0, p1);
    if (__any(rm > MAXTHR)) {
        const float dl = __builtin_fmaxf(rm, 0.f); st.m += dl;
#pragma unroll
        for (int r = 0; r < 16; ++r) { p0[r] -= dl; p1[r] -= dl; }
        const float al = __builtin_amdgcn_exp2f(-dl); st.l *= al;
        if (HAS_O) {
            if (hi == 0) wsf[r32] = al;
            wsync();
#pragma unroll
            for (int r = 0; r < 16; ++r) { const float f = wsf[crow(r, hi)]; o[0][r] *= f; o[1][r] *= f; }
            wsync();
        }
    }
    float s = 0.f;
#pragma unroll
    for (int r = 0; r < 16; ++r) { p0[r] = __builtin_amdgcn_exp2f(p0[r]); p1[r] = __builtin_amdgcn_exp2f(p1[r]); s += p0[r] + p1[r]; }
    st.l += s;
}
#define AT_PACK(P0, P1) \
    const u32x4 pw0 = {cvtpk(P0[0], P0[1]), cvtpk(P0[2], P0[3]), cvtpk(P0[4], P0[5]), cvtpk(P0[6], P0[7])}, pw1 = {cvtpk(P0[8], P0[9]), cvtpk(P0[10], P0[11]), cvtpk(P0[12], P0[13]), cvtpk(P0[14], P0[15])}, \
                pw2 = {cvtpk(P1[0], P1[1]), cvtpk(P1[2], P1[3]), cvtpk(P1[4], P1[5]), cvtpk(P1[6], P1[7])}, pw3 = {cvtpk(P1[8], P1[9]), cvtpk(P1[10], P1[11]), cvtpk(P1[12], P1[13]), cvtpk(P1[14], P1[15])}
__device__ __forceinline__ float fma_vsv(float a, float k, float x) { float d; asm("v_fma_f32 %0, %1, %2, %3" : "=v"(d) : "v"(a), "s"(k), "v"(x)); return d; }
__device__ __forceinline__ f32x16 cinit(float c2k, int hi, float x) { f32x16 c; const float xb = __builtin_fmaf(c2k, (float)(4 * hi), x);
    c[0] = xb;
#pragma unroll
    for (int r = 1; r < 16; ++r) c[r] = fma_vsv(c2k, (float)((r & 3) + 8 * (r >> 2)), xb);
    return c; }
template <bool FIRST>
__device__ __forceinline__ void acc_scaled(float* stage, const f32x16 (&o)[2], float f, float* wsf, int r32, int hi) {
    if (hi == 0) wsf[r32] = f;
    wsync();
#pragma unroll
    for (int r = 0; r < 16; ++r) { const int orow = crow(r, hi); const float g = wsf[orow]; float* s0 = stage + orow * 64 + r32;
        if (FIRST) { s0[0] = o[0][r] * g; s0[32] = o[1][r] * g; } else { s0[0] += o[0][r] * g; s0[32] += o[1][r] * g; } }
    wsync();
}

#define AT_WAIT_NEWER(newer, per) do { if ((newer) >= 2) { if ((per) == 2) AT_WAITV(4); else AT_WAITV(2); } else if ((newer) == 1) { if ((per) == 2) AT_WAITV(2); else AT_WAITV(1); } else AT_WAITV(0); } while (0)


#define AT_SB() __builtin_amdgcn_sched_barrier(0)
struct PipeOut { float s, rmn; };
__device__ __forceinline__ PipeOut pipe_step(f32x16& c0, f32x16& c1, f32x16& n0, f32x16& n1, f32x16 (&o)[2], lp kslot_next, lp vslot, const bf16x8 (&qr)[4], int lane, int r32, int hi) {
    const AT_LAS unsigned char* kb = kslot_next + hi * 1024 + r32 * 16;
    const AT_LAS unsigned char* vp = vslot + ((lane >> 4) & 1) * 32 + (lane & 3) * 8 + (4 * hi + ((lane & 15) >> 2)) * 64;
    bf16x8 kf[8];
#pragma unroll
    for (int j = 0; j < 4; ++j) kf[j] = *(const AT_LAS bf16x8*)(kb + (j >> 1) * 2048 + (j & 1) * 512);
    AT_SB();
    unsigned w0[8], w1[8]; s16x4 vl[8], vh[8]; float s = 0.f;
#pragma unroll
    for (int j = 0; j < 8; ++j) {
        if (j & 1) n1 = __builtin_amdgcn_mfma_f32_32x32x16_bf16(kf[j], qr[j >> 1], n1, 0, 0, 0);
        else       n0 = __builtin_amdgcn_mfma_f32_32x32x16_bf16(kf[j], qr[j >> 1], n0, 0, 0, 0);
        if (j < 4) kf[j + 4] = *(const AT_LAS bf16x8*)(kb + ((j + 4) >> 1) * 2048 + (j & 1) * 512);
        if (j >= 4) {
#pragma unroll
            for (int q = 0; q < 2; ++q) { const int f = (j - 4) * 2 + q, d0 = f >> 2, ks = f & 3; vl[f] = vtr(vp + d0 * 4096 + ks * 1024); vh[f] = vtr(vp + d0 * 4096 + ks * 1024 + 512); }
        }
        const float e0 = __builtin_amdgcn_exp2f(c0[2 * j]), e1 = __builtin_amdgcn_exp2f(c0[2 * j + 1]), e2 = __builtin_amdgcn_exp2f(c1[2 * j]), e3 = __builtin_amdgcn_exp2f(c1[2 * j + 1]);
        s += (e0 + e1) + (e2 + e3);
        asm volatile("" : "+v"(s));
        w0[j] = cvtpk(e0, e1); w1[j] = cvtpk(e2, e3);
        AT_SB();
    }
    const u32x4 pw0 = {w0[0], w0[1], w0[2], w0[3]}, pw1 = {w0[4], w0[5], w0[6], w0[7]}, pw2 = {w1[0], w1[1], w1[2], w1[3]}, pw3 = {w1[4], w1[5], w1[6], w1[7]};
    const bf16x8 pa[4] = {__builtin_bit_cast(bf16x8, pw0), __builtin_bit_cast(bf16x8, pw1), __builtin_bit_cast(bf16x8, pw2), __builtin_bit_cast(bf16x8, pw3)};
    float a = mx3(n0[0], n0[1], n1[0]), b = mx3(n0[2], n0[3], n1[1]);
#pragma unroll
    for (int f = 0; f < 8; ++f) {
        const int d0 = f >> 2, ks = f & 3;
        const bf16x8 vf = (bf16x8){vl[f][0], vl[f][1], vl[f][2], vl[f][3], vh[f][0], vh[f][1], vh[f][2], vh[f][3]};
        o[d0] = __builtin_amdgcn_mfma_f32_32x32x16_bf16(pa[ks], vf, o[d0], 0, 0, 0);
        if (f == 0) { a = mx3(a, n1[2], n1[3]); }
        else if (f < 4) { const int r = 4 * f; a = mx3(a, n0[r], n0[r + 1]); b = mx3(b, n0[r + 2], n0[r + 3]); a = mx3(a, n1[r], n1[r + 1]); b = mx3(b, n1[r + 2], n1[r + 3]); }
        asm volatile("" : "+v"(a), "+v"(b));
        AT_SB();
    }
    const float m = __builtin_fmaxf(a, b);
    auto rr = __builtin_amdgcn_permlane32_swap(__float_as_uint(m), __float_as_uint(m), false, false);
    PipeOut out; out.s = s; out.rmn = __builtin_fmaxf(__uint_as_float(rr[0]), __uint_as_float(rr[1]));
    return out;
}
__device__ __forceinline__ void nsa_unit(const Params& p, int b, int g, int c, unsigned char* lds_raw) {
    const int tid = otid(), lane = tid & 63, r32 = lane & 31, hi = lane >> 5, wid = __builtin_amdgcn_readfirstlane(tid >> 6);
    lp lds = (lp)lds_raw;
    const bf16_t* ZB = (const bf16_t*)(p.ws + WS_ZB); const float* GT = (const float*)(p.ws + WS_GATE);
    const bf16_t* KCB = (const bf16_t*)(p.ws + WS_KCB) + (size_t)(b * 2 + g) * 512 * 64; const bf16_t* VCB = (const bf16_t*)(p.ws + WS_VCB) + (size_t)(b * 2 + g) * 512 * 64;
    const int t0 = c * 64, hg = r32 >> 3, qq = r32 & 7, qi = 8 * wid + qq, t = t0 + qi, h = 4 * g + hg; const size_t tt = (size_t)b * S + t;
    float* wsf = (float*)(lds_raw + L_WSF) + wid * 64;
    float* ostage = (float*)(lds_raw + L_OST) + wid * 2048;
    float* imp = ostage;
    unsigned* selm = (unsigned*)(lds_raw + L_SELM);
    unsigned* uni = (unsigned*)(lds_raw + L_UNI);
    const float c2 = exp2f(-(float)(h + 1)) * LOG2E;
    bf16x8 qr[4];
#pragma unroll
    for (int d0 = 0; d0 < 4; ++d0) qr[d0] = *(const bf16x8*)(ZB + tt * ZBW + ZB_Q + h * 64 + d0 * 16 + hi * 8);
    const float gt0 = GT[tt * 32 + h * 3 + 0], gt1 = GT[tt * 32 + h * 3 + 1], gt2 = GT[tt * 32 + h * 3 + 2];
    f32x16 o[2];
    const lp sK0 = lds + L_K, sV0 = lds + L_V;
    const int nmax = t >= 31 ? (t - 31) >> 4 : -1;
    const int ntc = ((4 * c + 2) >> 6) + 1;
    for (int i = lane; i < 8 * 129; i += 64) imp[i] = 0.f;
    Soft sc; sc.m = 0.f; sc.l = 0.f;
#pragma unroll
    for (int k = 0; k < 3; ++k) if (k < ntc) dma_k(sK0 + k * 8192, KCB, 64, 64 * k, wid, lane);
    for (int k = 0; k < ntc; ++k) {
        const int newer = ntc - 1 - k; AT_WAIT_NEWER(newer, 1);
        AT_WAITL(); bar();
        if (k + 3 < ntc) dma_k(sK0 + ((k + 3) & 3) * 8192, KCB, 64, 64 * (k + 3), wid, lane);
        const lp sK = sK0 + (k & 3) * 8192;
        const float x0 = c2 * (16.f * (64 * k) + 15.5f - (float)t0) - sc.m;
        f32x16 p0 = cinit(16.f * c2, hi, x0), p1 = cinit(16.f * c2, hi, x0 + c2 * 512.f);
        qk_tile(p0, p1, sK, qr, r32, hi);
        if (__any(nmax - 64 * k < 63)) mask_tile(p0, p1, 0, nmax - 64 * k, hi);
        softmax_step<false>(p0, p1, sc, o, wsf, r32, hi);
    }
    const float lc = halfsum(sc.l), linv = lc > 0.f ? 1.f / lc : 0.f;
    o[0] = f32x16{}; o[1] = f32x16{};
    AT_WAITL(); bar();
#pragma unroll
    for (int k = 0; k < 3; ++k) if (k < ntc) { dma_k(sK0 + k * 8192, KCB, 64, 64 * k, wid, lane); dma_v(sV0 + k * 8192, VCB, 64, 64 * k, wid, lane); }
    for (int k = 0; k < ntc; ++k) {
        const int newer = ntc - 1 - k; AT_WAIT_NEWER(newer, 2);
        AT_WAITL(); bar();
        if (k + 3 < ntc) { dma_k(sK0 + ((k + 3) & 3) * 8192, KCB, 64, 64 * (k + 3), wid, lane); dma_v(sV0 + ((k + 3) & 3) * 8192, VCB, 64, 64 * (k + 3), wid, lane); }
        const lp sK = sK0 + (k & 3) * 8192, sV = sV0 + (k & 3) * 8192;
        const float x0 = c2 * (16.f * (64 * k) + 15.5f - (float)t0) - sc.m;
        f32x16 p0 = cinit(16.f * c2, hi, x0), p1 = cinit(16.f * c2, hi, x0 + c2 * 512.f);
        qk_tile(p0, p1, sK, qr, r32, hi);
        if (__any(nmax - 64 * k < 63)) mask_tile(p0, p1, 0, nmax - 64 * k, hi);
        VFrag vf; pv_load(vf, sV, lane, hi);
#pragma unroll
        for (int r = 0; r < 16; ++r) { p0[r] = __builtin_amdgcn_exp2f(p0[r]); p1[r] = __builtin_amdgcn_exp2f(p1[r]); }
        { AT_PACK(p0, p1); pv_mfma(o, vf, pw0, pw1, pw2, pw3); }
        float gs[8], ls[8];
#pragma unroll
        for (int q4 = 0; q4 < 4; ++q4) { gs[q4] = ((p0[4 * q4] + p0[4 * q4 + 1]) + (p0[4 * q4 + 2] + p0[4 * q4 + 3])) * linv; ls[q4] = p0[4 * q4 + 3] * linv;
                                         gs[4 + q4] = ((p1[4 * q4] + p1[4 * q4 + 1]) + (p1[4 * q4 + 2] + p1[4 * q4 + 3])) * linv; ls[4 + q4] = p1[4 * q4 + 3] * linv; }
#pragma unroll
        for (int q4 = 0; q4 < 8; ++q4) { gs[q4] += __shfl_xor(gs[q4], 8); gs[q4] += __shfl_xor(gs[q4], 16); ls[q4] += __shfl_xor(ls[q4], 8); ls[q4] += __shfl_xor(ls[q4], 16); }
        if (r32 < 8) {
            float* row = imp + qq * 129 + 16 * k + hi;
#pragma unroll
            for (int q4 = 0; q4 < 8; ++q4) row[2 * q4] += gs[q4];
        }
        wsync();
        if (r32 < 8) {
            float* row = imp + qq * 129 + 16 * k + hi + 1;
#pragma unroll
            for (int q4 = 0; q4 < 8; ++q4) row[2 * q4] += ls[q4];
        }
        wsync();
    }
    unsigned mk0 = 0u, mk1 = 0u, mk2 = 0u, mk3 = 0u;
    {
        const int qs = lane >> 3, part = lane & 7;
        float v[16];
#pragma unroll
        for (int i = 0; i < 16; ++i) { const int j = part * 16 + i; float x = imp[qs * 129 + j]; if (j == 0 || j == c || j == c - 1) x = 1e4f; if (j > c) x = NEGS; v[i] = x; }
#pragma unroll 1
        for (int it = 0; it < 16; ++it) {
            float bv = -3e38f; int bi = 0;
#pragma unroll
            for (int i = 0; i < 16; ++i) if (v[i] > bv) { bv = v[i]; bi = part * 16 + i; }
#pragma unroll
            for (int sft = 1; sft < 8; sft <<= 1) { const float ov = __shfl_xor(bv, sft); const int oi = __shfl_xor(bi, sft); if (ov > bv || (ov == bv && oi < bi)) { bv = ov; bi = oi; } }
            if (bv > NEGS) { const unsigned bit = 1u << (bi & 31); const int wq = bi >> 5; if (wq == 0) mk0 |= bit; else if (wq == 1) mk1 |= bit; else if (wq == 2) mk2 |= bit; else mk3 |= bit; }
#pragma unroll
            for (int i = 0; i < 16; ++i) if (part * 16 + i == bi) v[i] = -3.4e38f;
        }
        if (part == 0) { unsigned* sm = selm + (8 * wid + qs) * 4; sm[0] = mk0; sm[1] = mk1; sm[2] = mk2; sm[3] = mk3; }
        unsigned u0 = mk0, u1 = mk1, u2 = mk2, u3 = mk3;
#pragma unroll
        for (int sft = 8; sft < 64; sft <<= 1) { u0 |= __shfl_xor(u0, sft); u1 |= __shfl_xor(u1, sft); u2 |= __shfl_xor(u2, sft); u3 |= __shfl_xor(u3, sft); }
        if (lane == 0) { uni[wid * 4 + 0] = u0; uni[wid * 4 + 1] = u1; uni[wid * 4 + 2] = u2; uni[wid * 4 + 3] = u3; }
    }
    wsync();
    acc_scaled<true>(ostage, o, gt0 * linv, wsf, r32, hi);
    AT_WAITL(); bar();
    unsigned un0 = 0u, un1 = 0u, un2 = 0u, un3 = 0u;
#pragma unroll
    for (int w = 0; w < 8; ++w) { un0 |= uni[w * 4 + 0]; un1 |= uni[w * 4 + 1]; un2 |= uni[w * 4 + 2]; un3 |= uni[w * 4 + 3]; }
    un0 = __builtin_amdgcn_readfirstlane(un0); un1 = __builtin_amdgcn_readfirstlane(un1); un2 = __builtin_amdgcn_readfirstlane(un2); un3 = __builtin_amdgcn_readfirstlane(un3);
    const unsigned my0 = selm[(8 * wid + qq) * 4 + 0], my1 = selm[(8 * wid + qq) * 4 + 1], my2 = selm[(8 * wid + qq) * 4 + 2], my3 = selm[(8 * wid + qq) * 4 + 3];
    {
        const bf16_t* KS = ZB + (size_t)b * S * ZBW + ZB_KS + g * 64; const bf16_t* VS = ZB + (size_t)b * S * ZBW + ZB_VS + g * 64;
        Soft ss; ss.m = 0.f; ss.l = 0.f; o[0] = f32x16{}; o[1] = f32x16{};
        const int nsel = __builtin_popcount(un0) + __builtin_popcount(un1) + __builtin_popcount(un2) + __builtin_popcount(un3);
        int ji = 128;
#pragma unroll
        for (int k = 0; k < 3; ++k) if (k < nsel) { ji = next_bit128(un0, un1, un2, un3, ji); dma_k(sK0 + k * 8192, KS, ZBW, 64 * ji, wid, lane); dma_v(sV0 + k * 8192, VS, ZBW, 64 * ji, wid, lane); }
        int j = 128;
        for (int i = 0; i < nsel; ++i) {
            j = next_bit128(un0, un1, un2, un3, j);
            const int newer = nsel - 1 - i; AT_WAIT_NEWER(newer, 2);
            AT_WAITL(); bar();
            if (i + 3 < nsel) { ji = next_bit128(un0, un1, un2, un3, ji); dma_k(sK0 + ((i + 3) & 3) * 8192, KS, ZBW, 64 * ji, wid, lane); dma_v(sV0 + ((i + 3) & 3) * 8192, VS, ZBW, 64 * ji, wid, lane); }
            const lp sK = sK0 + (i & 3) * 8192, sV = sV0 + (i & 3) * 8192;
            const unsigned mw = (j >> 5) == 0 ? my0 : (j >> 5) == 1 ? my1 : (j >> 5) == 2 ? my2 : my3;
            const bool sel = (mw >> (j & 31)) & 1u;
            const float x0 = sel ? c2 * (float)(64 * j - t0) - ss.m : NEGS;
            f32x16 p0 = cinit(c2, hi, x0), p1 = cinit(c2, hi, sel ? x0 + c2 * 32.f : NEGS);
            qk_tile(p0, p1, sK, qr, r32, hi);
            if (j == c) mask_tile(p0, p1, 0, qi, hi);
            VFrag vf; pv_load(vf, sV, lane, hi);
            softmax_step<true>(p0, p1, ss, o, wsf, r32, hi);
            { AT_PACK(p0, p1); pv_mfma(o, vf, pw0, pw1, pw2, pw3); }
        }
        const float ls_ = halfsum(ss.l);
        acc_scaled<false>(ostage, o, ls_ > 0.f ? gt1 / ls_ : 0.f, wsf, r32, hi);
    }
    {
        const bf16_t* KW = ZB + (size_t)b * S * ZBW + ZB_KW + g * 64; const bf16_t* VW = ZB + (size_t)b * S * ZBW + ZB_VW + g * 64;
        Soft sw; sw.m = 0.f; sw.l = 0.f; o[0] = f32x16{}; o[1] = f32x16{};
        const int k0 = c >= 8 ? 0 : 8 - c, nw = 9 - k0;
        AT_WAITL(); bar();
#pragma unroll
        for (int k = 0; k < 3; ++k) if (k < nw) { dma_k(sK0 + k * 8192, KW, ZBW, t0 - 64 * k, wid, lane); dma_v(sV0 + k * 8192, VW, ZBW, t0 - 64 * k, wid, lane); }
        f32x16 pA0, pA1, pB0, pB1; float rmc;
#define WIN_STEP(C0, C1, N0, N1, I) do { const int i_ = (I); \
            if (i_ + 1 < nw) { if (i_ + 2 < nw) AT_WAITV(2); else AT_WAITV(0); } \
            AT_WAITL(); bar(); \
            if (i_ + 3 < nw) { dma_k(sK0 + ((i_ + 3) & 3) * 8192, KW, ZBW, t0 - 64 * (i_ + 3), wid, lane); dma_v(sV0 + ((i_ + 3) & 3) * 8192, VW, ZBW, t0 - 64 * (i_ + 3), wid, lane); } \
            if (__any(rmc > MAXTHR)) { \
                const float dl = __builtin_fmaxf(rmc, 0.f); sw.m += dl; \
                _Pragma("unroll") for (int r = 0; r < 16; ++r) { C0[r] -= dl; C1[r] -= dl; } \
                const float al = __builtin_amdgcn_exp2f(-dl); sw.l *= al; \
                if (hi == 0) wsf[r32] = al; \
                wsync(); \
                _Pragma("unroll") for (int r = 0; r < 16; ++r) { const float f = wsf[crow(r, hi)]; o[0][r] *= f; o[1][r] *= f; } \
                wsync(); \
            } \
            { const float x0 = c2 * (float)(-64 * (i_ + 1)) - sw.m; \
              N0 = cinit(c2, hi, x0); N1 = cinit(c2, hi, x0 + c2 * 32.f); \
              if (i_ + 1 == 8) mask_init_lo(N0, N1, qi + 1, hi); }        \
            const PipeOut po = pipe_step(C0, C1, N0, N1, o, sK0 + ((i_ + 1) & 3) * 8192, sV0 + (i_ & 3) * 8192, qr, lane, r32, hi); \
            sw.l += po.s; rmc = po.rmn; } while (0)
        { if (nw >= 3) AT_WAITV(4); else if (nw == 2) AT_WAITV(2); else AT_WAITV(0);
          AT_WAITL(); bar(); }
        { pB0 = cinit(c2, hi, 0.f); pB1 = cinit(c2, hi, c2 * 32.f);
          qk_tile(pB0, pB1, sK0, qr, r32, hi);
          mask_tile(pB0, pB1, 0, qi, hi);
          rmc = rowmax(pB0, pB1); }
        int i = 0;
#pragma unroll 1
        for (; i + 1 < nw; i += 2) {
            WIN_STEP(pB0, pB1, pA0, pA1, i);
            WIN_STEP(pA0, pA1, pB0, pB1, i + 1);
        }
        if (i < nw) WIN_STEP(pB0, pB1, pA0, pA1, i);
#undef WIN_STEP
        const float lw = halfsum(sw.l);
        acc_scaled<false>(ostage, o, lw > 0.f ? gt2 / lw : 0.f, wsf, r32, hi);
    }
    {
        bf16_t* AB = (bf16_t*)(p.ws + WS_ATTB);
#pragma unroll
        for (int i = 0; i < 4; ++i) { const int row = i * 8 + (lane >> 3), ch = lane & 7; const float4 a = *(const float4*)(ostage + row * 64 + ch * 8), c4 = *(const float4*)(ostage + row * 64 + ch * 8 + 4);
            const uint4 v = make_uint4(pk2(a.x, a.y), pk2(a.z, a.w), pk2(c4.x, c4.y), pk2(c4.z, c4.w));
            *(uint4*)(AB + ((size_t)b * S + t0 + 8 * wid + (row & 7)) * D + (4 * g + (row >> 3)) * 64 + ch * 8) = v; }
        wsync();
    }
    AT_WAITL(); bar();
}

}

constexpr int MB_CAP = 25600;
namespace at {
__device__ __forceinline__ void moba_route_unit(const Params& p, int b, int h, int qb, unsigned char* lds_raw) {
    const int tid = otid(), lane = tid & 63, r32 = lane & 31, hi = lane >> 5, wid = __builtin_amdgcn_readfirstlane(tid >> 6);
    lp lds = (lp)lds_raw;
    const bf16_t* ZB = (const bf16_t*)(p.ws + WS_ZB);
    const int bh = b * 8 + h;
    const bf16_t* KMB = (const bf16_t*)(p.ws + WS_KMB) + (size_t)bh * 32 * 64;
    const int qi = 32 * wid + r32, t = qb * 256 + qi; const size_t tt = (size_t)b * S + t;
    int* hist = (int*)(lds_raw + L_UNI);
    unsigned* SEL3 = (unsigned*)(p.ws + WS_SEL3); unsigned* LRK = (unsigned*)(p.ws + WS_LRK);
    unsigned char* IL = (unsigned char*)(p.ws + WS_ILIST) + ((size_t)(bh * 32 + qb) * 32) * 256;
    int* BCm = (int*)(p.ws + WS_BCM) + (size_t)(bh * 32 + qb) * 32;
    if (tid < 32) hist[tid] = 0;
    bf16x8 qr[4];
#pragma unroll
    for (int d0 = 0; d0 < 4; ++d0) qr[d0] = *(const bf16x8*)(ZB + tt * ZBW + ZB_MQ + h * 64 + d0 * 16 + hi * 8);
    const lp sKM = lds + L_KMT;
    glds(KMB + (size_t)(lane & 31) * 64 + wid * 8, sKM + wid * 1024);
    AT_WAITV(0); AT_WAITL(); bar();
    f32x16 g0 = f32x16{}, g1 = f32x16{};
    qk_tile(g0, g1, sKM, qr, r32, hi);
    float v1 = NEGS, v2 = NEGS, v3 = NEGS; int i1 = 64, i2 = 64, i3 = 64;
#pragma unroll
    for (int r = 0; r < 16; ++r) { const int n = crow(r, hi); const float s_ = n < qb ? g0[r] : NEGS;
        if (s_ > v1) { v3 = v2; i3 = i2; v2 = v1; i2 = i1; v1 = s_; i1 = n; } else if (s_ > v2) { v3 = v2; i3 = i2; v2 = s_; i2 = n; } else if (s_ > v3) { v3 = s_; i3 = n; } }
    float ov[3]; int oi[3];
    { auto a = __builtin_amdgcn_permlane32_swap(__float_as_uint(v1), __float_as_uint(v1), false, false); ov[0] = __uint_as_float(hi ? a[0] : a[1]); }
    { auto a = __builtin_amdgcn_permlane32_swap(__float_as_uint(v2), __float_as_uint(v2), false, false); ov[1] = __uint_as_float(hi ? a[0] : a[1]); }
    { auto a = __builtin_amdgcn_permlane32_swap(__float_as_uint(v3), __float_as_uint(v3), false, false); ov[2] = __uint_as_float(hi ? a[0] : a[1]); }
    { auto a = __builtin_amdgcn_permlane32_swap((unsigned)i1, (unsigned)i1, false, false); oi[0] = (int)(hi ? a[0] : a[1]); }
    { auto a = __builtin_amdgcn_permlane32_swap((unsigned)i2, (unsigned)i2, false, false); oi[1] = (int)(hi ? a[0] : a[1]); }
    { auto a = __builtin_amdgcn_permlane32_swap((unsigned)i3, (unsigned)i3, false, false); oi[2] = (int)(hi ? a[0] : a[1]); }
#pragma unroll
    for (int k = 0; k < 3; ++k) { const float s_ = ov[k]; const int n = oi[k];
        if (s_ > v1 || (s_ == v1 && n < i1)) { v3 = v2; i3 = i2; v2 = v1; i2 = i1; v1 = s_; i1 = n; }
        else if (s_ > v2 || (s_ == v2 && n < i2)) { v3 = v2; i3 = i2; v2 = s_; i2 = n; }
        else if (s_ > v3 || (s_ == v3 && n < i3)) { v3 = s_; i3 = n; } }
    if (hi == 0) {
        const int j1 = v1 > NEGS ? i1 : 255, j2 = v2 > NEGS ? i2 : 255, j3 = v3 > NEGS ? i3 : 255;
        int l1 = 0, l2 = 0, l3 = 0;
        if (j1 < 32) { l1 = atomicAdd(&hist[j1], 1); IL[j1 * 256 + l1] = (unsigned char)qi; }
        if (j2 < 32) { l2 = atomicAdd(&hist[j2], 1); IL[j2 * 256 + l2] = (unsigned char)qi; }
        if (j3 < 32) { l3 = atomicAdd(&hist[j3], 1); IL[j3 * 256 + l3] = (unsigned char)qi; }
        SEL3[tt * 8 + h] = (unsigned)j1 | ((unsigned)j2 << 8) | ((unsigned)j3 << 16);
        LRK[tt * 8 + h] = (unsigned)l1 | ((unsigned)l2 << 8) | ((unsigned)l3 << 16);
    }
    AT_WAITL(); bar();
    if (tid < 32) BCm[tid] = hist[tid];
    AT_WAITL(); bar();
}
__device__ __forceinline__ void moba_tables(const int* BCmbh, int lane, int& tot, int& seg) {
    int s = 0;
    if (lane < 32) { for (int q = 0; q < 32; ++q) s += BCmbh[q * 32 + lane]; }
    tot = s;
    int pad = (s + 31) & ~31, inc = pad;
#pragma unroll
    for (int sft = 1; sft < 32; sft <<= 1) { const int o_ = __shfl_up(inc, sft); if ((lane & 31) >= sft) inc += o_; }
    seg = inc - pad;
}
__device__ __forceinline__ void moba_gather_unit(const Params& p, int bh, int j, int ch, int segj, bool reload, unsigned char* lds_raw) {
    const int tid = otid(), lane = tid & 63, r32 = lane & 31, hi = lane >> 5, wid = __builtin_amdgcn_readfirstlane(tid >> 6);
    lp lds = (lp)lds_raw;
    const int b = bh >> 3, h = bh & 7;
    const bf16_t* ZB = (const bf16_t*)(p.ws + WS_ZB);
    const int* BCmbh = (const int*)(p.ws + WS_BCM) + (size_t)bh * 32 * 32;
    float* wsf = (float*)(lds_raw + L_WSF) + wid * 64;
    const lp sK0 = lds + L_K, sV0 = lds + L_V;
    const bf16_t* KM_ = ZB + (size_t)b * S * ZBW + ZB_MK + h * 64; const bf16_t* VM_ = ZB + (size_t)b * S * ZBW + ZB_MV + h * 64;
    if (reload) {
#pragma unroll
        for (int k = 3; k >= 0; --k) { dma_k(sK0 + k * 8192, KM_, ZBW, j * 256 + 64 * k, wid, lane); dma_v(sV0 + k * 8192, VM_, ZBW, j * 256 + 64 * k, wid, lane); }
    }
    const int gr = 256 * ch + 32 * wid + r32;
    const int cq = lane < 32 ? BCmbh[lane * 32 + j] : 0;
    int run = 0, qbs = j + 1, lr = 0;
#pragma unroll 4
    for (int q = 0; q < 32; ++q) { const int c_ = __builtin_amdgcn_readlane(cq, q); if (gr >= run && gr < run + c_) { qbs = q; lr = gr - run; } run += c_; }
    const int totj = run;
    const bool valid = gr < totj;
    const unsigned char* IL = (const unsigned char*)(p.ws + WS_ILIST);
    const int qidx = valid ? (int)IL[((size_t)(bh * 32 + qbs) * 32 + j) * 256 + lr] : 0;
    const int t = valid ? qbs * 256 + qidx : (j + 1) * 256; const size_t tt = (size_t)b * S + t;
    const float c2 = exp2f(-(float)(h + 1)) * LOG2E;
    bf16x8 qr[4];
#pragma unroll
    for (int d0 = 0; d0 < 4; ++d0) qr[d0] = *(const bf16x8*)(ZB + tt * ZBW + ZB_MQ + h * 64 + d0 * 16 + hi * 8);
    Soft sm; sm.m = 0.f; sm.l = 0.f; f32x16 o[2]; o[0] = f32x16{}; o[1] = f32x16{};
#pragma unroll 1
    for (int i = 0; i < 4; ++i) {
        if (reload) { const int newer = 3 - i; if (newer >= 3) AT_WAITV(6); else AT_WAIT_NEWER(newer, 2); AT_WAITL(); bar(); }
        const int kt = 3 - i;
        const lp sK = sK0 + kt * 8192, sV = sV0 + kt * 8192;
        const float x0 = c2 * (float)(64 * kt) - sm.m;
        f32x16 p0 = cinit(c2, hi, x0), p1 = cinit(c2, hi, x0 + c2 * 32.f);
        qk_tile(p0, p1, sK, qr, r32, hi);
        VFrag vf; pv_load(vf, sV, lane, hi);
        softmax_step<true>(p0, p1, sm, o, wsf, r32, hi);
        { AT_PACK(p0, p1); pv_mfma(o, vf, pw0, pw1, pw2, pw3); }
    }
    {
        const float lt = halfsum(sm.l);
        float* PM = (float*)(p.ws + WS_PM) + (size_t)bh * MB_CAP; float* PL = (float*)(p.ws + WS_PL) + (size_t)bh * MB_CAP;
        if (hi == 0 && valid) { PM[segj + gr] = sm.m; PL[segj + gr] = lt; }
        bf16_t* stg = (bf16_t*)(lds_raw + L_OST) + wid * 4096;
#pragma unroll
        for (int r = 0; r < 16; ++r) { const int orow = crow(r, hi); stg[orow * 64 + r32] = (bf16_t)f2bf(o[0][r]); stg[orow * 64 + 32 + r32] = (bf16_t)f2bf(o[1][r]); }
        wsync();
        bf16_t* PO = (bf16_t*)(p.ws + WS_PO) + ((size_t)bh * MB_CAP + segj + 256 * ch + 32 * wid) * 64;
        const int nrow = totj - (256 * ch + 32 * wid);
#pragma unroll
        for (int i = 0; i < 4; ++i) { const int row = i * 8 + (lane >> 3), c8 = lane & 7; if (row < nrow) *(uint4*)(PO + (size_t)row * 64 + c8 * 8) = *(const uint4*)(stg + row * 64 + c8 * 8); }
        wsync();
    }
    AT_WAITL(); bar();
}
__device__ __forceinline__ void moba_self_unit(const Params& p, int b, int h, int qb, unsigned char* lds_raw) {
    const int tid = otid(), lane = tid & 63, r32 = lane & 31, hi = lane >> 5, wid = __builtin_amdgcn_readfirstlane(tid >> 6);
    lp lds = (lp)lds_raw;
    const int bh = b * 8 + h;
    const bf16_t* ZB = (const bf16_t*)(p.ws + WS_ZB);
    const int* BCmbh = (const int*)(p.ws + WS_BCM) + (size_t)bh * 32 * 32;
    const int qi = 32 * wid + r32, t = qb * 256 + qi; const size_t tt = (size_t)b * S + t;
    float* wsf = (float*)(lds_raw + L_WSF) + wid * 64;
    float* ostage = (float*)(lds_raw + L_OST) + wid * 2048;
    const float c2 = exp2f(-(float)(h + 1)) * LOG2E;
    bf16x8 qr[4];
#pragma unroll
    for (int d0 = 0; d0 < 4; ++d0) qr[d0] = *(const bf16x8*)(ZB + tt * ZBW + ZB_MQ + h * 64 + d0 * 16 + hi * 8);
    const lp sK0 = lds + L_K, sV0 = lds + L_V;
    const bf16_t* KM_ = ZB + (size_t)b * S * ZBW + ZB_MK + h * 64; const bf16_t* VM_ = ZB + (size_t)b * S * ZBW + ZB_MV + h * 64;
    Soft sm; sm.m = 0.f; sm.l = 0.f; f32x16 o[2]; o[0] = f32x16{}; o[1] = f32x16{};
#pragma unroll
    for (int k = 0; k < 3; ++k) { dma_k(sK0 + k * 8192, KM_, ZBW, qb * 256 + 64 * (3 - k), wid, lane); dma_v(sV0 + k * 8192, VM_, ZBW, qb * 256 + 64 * (3 - k), wid, lane); }
    int tot, seg; moba_tables(BCmbh, lane, tot, seg);
    int before = 0; if (lane < 32) { for (int q = 0; q < qb; ++q) before += BCmbh[q * 32 + lane]; }
    const int base = seg + before;
#pragma unroll 1
    for (int i = 0; i < 4; ++i) {
        const int newer = 3 - i; AT_WAIT_NEWER(newer, 2);
        AT_WAITL(); bar();
        if (i == 0) { dma_k(sK0 + 3 * 8192, KM_, ZBW, qb * 256, wid, lane); dma_v(sV0 + 3 * 8192, VM_, ZBW, qb * 256, wid, lane); }
        const lp sK = sK0 + i * 8192, sV = sV0 + i * 8192;
        const int kt = 3 - i;
        const bool skip = (32 * wid + 31 < 64 * kt);
        if (!skip) {
            const float x0 = c2 * (float)(64 * kt) - sm.m;
            f32x16 p0 = cinit(c2, hi, x0), p1 = cinit(c2, hi, x0 + c2 * 32.f);
            qk_tile(p0, p1, sK, qr, r32, hi);
            if (64 * kt + 63 > 32 * wid) mask_tile(p0, p1, 0, qi - 64 * kt, hi);
            VFrag vf; pv_load(vf, sV, lane, hi);
            softmax_step<true>(p0, p1, sm, o, wsf, r32, hi);
            { AT_PACK(p0, p1); pv_mfma(o, vf, pw0, pw1, pw2, pw3); }
        }
    }
    {
        const float lself = halfsum(sm.l);
        const unsigned s3 = ((const unsigned*)(p.ws + WS_SEL3))[tt * 8 + h], l3 = ((const unsigned*)(p.ws + WS_LRK))[tt * 8 + h];
        const float* PM = (const float*)(p.ws + WS_PM) + (size_t)bh * MB_CAP; const float* PL = (const float*)(p.ws + WS_PL) + (size_t)bh * MB_CAP;
        float mk[3], lk[3]; int pidx[3];
        float M = sm.m + c2 * 256.f * (float)qb;
        const float mself = M;
#pragma unroll
        for (int k = 0; k < 3; ++k) { const int jk = (s3 >> (8 * k)) & 255, lrk = (l3 >> (8 * k)) & 255;
            const int pb = __shfl(base, jk & 31);
            if (jk < 32) { pidx[k] = pb + lrk; mk[k] = PM[pidx[k]] + c2 * 256.f * (float)jk; lk[k] = PL[pidx[k]]; M = __builtin_fmaxf(M, mk[k]); }
            else { pidx[k] = -1; mk[k] = NEGS; lk[k] = 0.f; } }
        const float ws_ = __builtin_amdgcn_exp2f(mself - M);
        float wk[3]; float Lt = lself * ws_;
#pragma unroll
        for (int k = 0; k < 3; ++k) { wk[k] = pidx[k] >= 0 ? __builtin_amdgcn_exp2f(mk[k] - M) : 0.f; Lt += lk[k] * wk[k]; }
        const float inv = Lt > 0.f ? 1.f / Lt : 0.f;
        float* rws = wsf;
        float* rwk = (float*)(lds_raw + L_KMT) + wid * 256;
        int* rpi = (int*)(rwk + 96);
        if (hi == 0) { rws[r32] = ws_ * inv;
#pragma unroll
            for (int k = 0; k < 3; ++k) { rwk[k * 32 + r32] = wk[k] * inv; rpi[k * 32 + r32] = pidx[k]; } }
#pragma unroll
        for (int r = 0; r < 16; ++r) { const int orow = crow(r, hi); ostage[orow * 64 + r32] = o[0][r]; ostage[orow * 64 + 32 + r32] = o[1][r]; }
        wsync();
        const bf16_t* PO = (const bf16_t*)(p.ws + WS_PO) + (size_t)bh * MB_CAP * 64;
        bf16_t* AB = (bf16_t*)(p.ws + WS_ATTB);
#pragma unroll
        for (int i = 0; i < 4; ++i) { const int row = i * 8 + (lane >> 3), c8 = lane & 7;
            const float4 a = *(const float4*)(ostage + row * 64 + c8 * 8), c4 = *(const float4*)(ostage + row * 64 + c8 * 8 + 4);
            const float w0 = rws[row];
            float acc8[8] = {a.x * w0, a.y * w0, a.z * w0, a.w * w0, c4.x * w0, c4.y * w0, c4.z * w0, c4.w * w0};
#pragma unroll
            for (int k = 0; k < 3; ++k) { const int pi = rpi[k * 32 + row]; if (pi >= 0) { const float w = rwk[k * 32 + row]; const uint4 q = *(const uint4*)(PO + (size_t)pi * 64 + c8 * 8);
                const unsigned qq_[4] = {q.x, q.y, q.z, q.w};
#pragma unroll
                for (int e = 0; e < 4; ++e) { acc8[2 * e] += __builtin_bit_cast(float, qq_[e] << 16) * w; acc8[2 * e + 1] += __builtin_bit_cast(float, qq_[e] & 0xffff0000u) * w; } } }
            *(uint4*)(AB + ((size_t)b * S + qb * 256 + 32 * wid + row) * D + 512 + h * 64 + c8 * 8) = make_uint4(pk2(acc8[0], acc8[1]), pk2(acc8[2], acc8[3]), pk2(acc8[4], acc8[5]), pk2(acc8[6], acc8[7])); }
        wsync();
    }
    AT_WAITL(); bar();
}
}

__device__ __forceinline__ void phase_att1(const Params& p, unsigned char* lds_raw) {
    const int tid = otid();
    int* pre = (int*)(lds_raw + at::L_END);
    int* segt = pre + 514;
    { const int* BCm = (const int*)(p.ws + WS_BCM); const int bh = tid >> 5, j = tid & 31; int s = 0;
      for (int q = 0; q < 32; ++q) s += BCm[(size_t)(bh * 32 + q) * 32 + j];
      pre[tid + 1] = (s + 255) >> 8; if (tid == 0) pre[0] = 0;
      segt[tid] = (s + 31) & ~31; }
    __syncthreads();
    for (int sft = 1; sft < 512; sft <<= 1) { int v = 0, w = 0; if (tid >= sft) v = pre[tid + 1 - sft]; if ((tid & 31) >= sft) w = segt[tid - sft]; __syncthreads(); pre[tid + 1] += v; if (sft < 32) segt[tid] += w; __syncthreads(); }
    { const int* BCm = (const int*)(p.ws + WS_BCM); const int bh = tid >> 5, j = tid & 31; int s = 0;
      for (int q = 0; q < 32; ++q) s += BCm[(size_t)(bh * 32 + q) * 32 + j];
      const int excl = segt[tid] - ((s + 31) & ~31); __syncthreads(); segt[tid] = excl; }
    __syncthreads();
    const int nun = pre[512];
    for (int pi = blockIdx.x; pi < 512; pi += gridDim.x) {
        const int rnd = pi >> 8, id = pi & 255;
        const int bg = 2 * rnd + (id >> 7), c = rnd ? 127 - (id & 127) : (id & 127); at::nsa_unit(p, bg >> 1, bg & 1, c, lds_raw);
    }
    {
        const int u0 = (int)(((long)blockIdx.x * nun) / gridDim.x), u1 = (int)(((long)(blockIdx.x + 1) * nun) / gridDim.x);
        int prev = -1;
        for (int u = u0; u < u1; ++u) {
            int lo = 0, hi_ = 511;
            while (lo < hi_) { const int mid = (lo + hi_ + 1) >> 1; if (pre[mid] <= u) lo = mid; else hi_ = mid - 1; }
            at::moba_gather_unit(p, lo >> 5, lo & 31, u - pre[lo], segt[lo], lo != prev, lds_raw);
            prev = lo;
        }
    }
}
__device__ __forceinline__ void phase_att2(const Params& p, unsigned char* lds_raw) {
    for (int pi = blockIdx.x; pi < 512; pi += gridDim.x) {
        const int rnd = pi >> 8, id = pi & 255;
        const int bh = 8 * rnd + (id >> 5), qb = rnd ? 31 - (id & 31) : (id & 31); at::moba_self_unit(p, bh >> 3, bh & 7, qb, lds_raw);
    }
}
__device__ __forceinline__ void phase_route(const Params& p, unsigned char* lds_raw) {
    for (int pi = blockIdx.x; pi < 512; pi += gridDim.x) at::moba_route_unit(p, pi >> 8, (pi >> 5) & 7, pi & 31, lds_raw);
}


__device__ __forceinline__ void phase_r2_fast(const Params& p, int l, unsigned char* lds_raw) {
    using namespace at;
    const int tid = otid(), lane = tid & 63, wave = __builtin_amdgcn_readfirstlane(tid >> 6), r32 = lane & 31, hi = lane >> 5;
    const float* mod = (const float*)(p.ws + WS_MOD);
    const bf16_t* XAB = (const bf16_t*)(p.ws + WS_XAB);
    const float* lng = p.in[5] + (size_t)l * D; const float* rb = p.in[16] + l * NE;
    int* toke = (int*)(p.ws + WS_TOKE); float* tokw = (float*)(p.ws + WS_TOKW); int* BC = (int*)(p.ws + WS_BC);
    const unsigned char* img = p.ws + WS_RWI + (size_t)l * 131072;
    constexpr int PP = 2064;
    unsigned char* pl_hi = lds_raw; unsigned char* pl_lo = lds_raw + 32 * PP;
    int* hist = (int*)(lds_raw + 2 * 32 * PP);
    for (int blk = blockIdx.x; blk < T / 64; blk += gridDim.x) {
        if (tid < 32) hist[tid] = 0;
        const int b = (blk * 64) / S;
        const float* sh = mod + ((size_t)l * Bn + b) * 6144 + 3 * D; const float* sc = mod + ((size_t)l * Bn + b) * 6144 + 4 * D;
        float4 ga[4], s0v[4];
#pragma unroll
        for (int j = 0; j < 4; ++j) { const int col = 4 * lane + 256 * j; const float4 g = *(const float4*)(lng + col), s1 = *(const float4*)(sc + col); s0v[j] = *(const float4*)(sh + col);
            ga[j] = make_float4(g.x * (1.f + s1.x), g.y * (1.f + s1.y), g.z * (1.f + s1.z), g.w * (1.f + s1.w)); }
#pragma unroll 1
        for (int half = 0; half < 2; ++half) {
            const int trow0 = blk * 64 + half * 32;
            {
                uint2 q_[4][4];
#pragma unroll
                for (int i = 0; i < 4; ++i)
#pragma unroll
                    for (int j = 0; j < 4; ++j) q_[i][j] = *(const uint2*)(XAB + (size_t)(trow0 + wave * 4 + i) * D + 4 * lane + 256 * j);
                float ss[4];
#pragma unroll
                for (int i = 0; i < 4; ++i) { float s_ = 0.f;
#pragma unroll
                    for (int j = 0; j < 4; ++j) { const float x0 = __builtin_bit_cast(float, q_[i][j].x << 16), x1 = __builtin_bit_cast(float, q_[i][j].x & 0xffff0000u), x2 = __builtin_bit_cast(float, q_[i][j].y << 16), x3 = __builtin_bit_cast(float, q_[i][j].y & 0xffff0000u);
                        s_ += (x0 * x0 + x1 * x1) + (x2 * x2 + x3 * x3); }
                    ss[i] = s_; }
#pragma unroll
                for (int sft = 32; sft >= 1; sft >>= 1) {
#pragma unroll
                    for (int i = 0; i < 4; ++i) ss[i] += __shfl_xor(ss[i], sft); }
#pragma unroll
                for (int i = 0; i < 4; ++i) {
                    const int rl = wave * 4 + i, t = trow0 + rl;
                    const float r = rsqrtf(ss[i] * (1.f / D) + EPS);
#pragma unroll
                    for (int j = 0; j < 4; ++j) {
                        const int col = 4 * lane + 256 * j;
                        const float x0 = __builtin_bit_cast(float, q_[i][j].x << 16), x1 = __builtin_bit_cast(float, q_[i][j].x & 0xffff0000u), x2 = __builtin_bit_cast(float, q_[i][j].y << 16), x3 = __builtin_bit_cast(float, q_[i][j].y & 0xffff0000u);
                        const float o[4] = {x0 * r * ga[j].x + s0v[j].x, x1 * r * ga[j].y + s0v[j].y, x2 * r * ga[j].z + s0v[j].z, x3 * r * ga[j].w + s0v[j].w};
                        unsigned hh[4], ll[4];
#pragma unroll
                        for (int q = 0; q < 4; ++q) { hh[q] = f2bf(o[q]); ll[q] = f2bf(o[q] - __builtin_bit_cast(float, hh[q] << 16)); }
                        *(uint2*)(pl_hi + rl * PP + col * 2) = make_uint2(hh[0] | (hh[1] << 16), hh[2] | (hh[3] << 16));
                        *(uint2*)(pl_lo + rl * PP + col * 2) = make_uint2(ll[0] | (ll[1] << 16), ll[2] | (ll[3] << 16));
                        *(unsigned*)(p.ws + WS_XN8 + (size_t)t * D + col) = pk_fp8x4(o[0] * XS8, o[1] * XS8, o[2] * XS8, o[3] * XS8);
                    }
                }
            }
            __syncthreads();
            f32x16 acc = f32x16{};
            {
                const AT_LAS unsigned char* xh = (lp)pl_hi + r32 * PP + (128 * wave + 8 * hi) * 2; const AT_LAS unsigned char* xl = (lp)pl_lo + r32 * PP + (128 * wave + 8 * hi) * 2;
                const unsigned char* wh = img + (size_t)((16 * wave + hi) * 32 + r32) * 16; const unsigned char* wl = wh + 65536;
#pragma unroll 1
                for (int k4 = 0; k4 < 8; k4 += 4) {
                    bf16x8 ah[4], al[4];
#pragma unroll
                    for (int ks = 0; ks < 4; ++ks) { ah[ks] = *(const bf16x8*)(wh + (k4 + ks) * 1024); al[ks] = *(const bf16x8*)(wl + (k4 + ks) * 1024); }
#pragma unroll
                    for (int ks = 0; ks < 4; ++ks) {
                        const bf16x8 bh = *(const AT_LAS bf16x8*)(xh + 32 * (k4 + ks)), bl = *(const AT_LAS bf16x8*)(xl + 32 * (k4 + ks));
                        acc = __builtin_amdgcn_mfma_f32_32x32x16_bf16(ah[ks], bh, acc, 0, 0, 0);
                        acc = __builtin_amdgcn_mfma_f32_32x32x16_bf16(al[ks], bh, acc, 0, 0, 0);
                        acc = __builtin_amdgcn_mfma_f32_32x32x16_bf16(ah[ks], bl, acc, 0, 0, 0);
                    }
                }
            }
            __syncthreads();
            { float* part = (float*)lds_raw;
              if (wave >= 1) {
#pragma unroll
                  for (int r = 0; r < 16; ++r) part[(wave * 16 + r) * 64 + lane] = acc[r]; } }
            __syncthreads();
            if (wave == 0) {
                const int t = trow0 + r32;
                { const float* part = (const float*)lds_raw;
#pragma unroll
                  for (int r = 0; r < 16; ++r) { float a = acc[r];
#pragma unroll
                      for (int w = 1; w < 8; ++w) a += part[(w * 16 + r) * 64 + lane];
                      acc[r] = a; } }
                float a0 = -3e38f, a1 = -3e38f, a2 = -3e38f, a3 = -3e38f; int i0 = 99, i1 = 99, i2 = 99, i3 = 99;
#pragma unroll
                for (int r = 0; r < 16; ++r) { const int e = crow(r, hi); const float s_ = acc[r] + rb[e];
                    if (s_ > a0) { a3 = a2; i3 = i2; a2 = a1; i2 = i1; a1 = a0; i1 = i0; a0 = s_; i0 = e; }
                    else if (s_ > a1) { a3 = a2; i3 = i2; a2 = a1; i2 = i1; a1 = s_; i1 = e; }
                    else if (s_ > a2) { a3 = a2; i3 = i2; a2 = s_; i2 = e; }
                    else if (s_ > a3) { a3 = s_; i3 = e; } }
                float ov[4]; int oi[4];
                { const float sv[4] = {a0, a1, a2, a3}; const int si[4] = {i0, i1, i2, i3};
#pragma unroll
                  for (int k = 0; k < 4; ++k) { auto a = __builtin_amdgcn_permlane32_swap(__float_as_uint(sv[k]), __float_as_uint(sv[k]), false, false); ov[k] = __uint_as_float(hi ? a[0] : a[1]);
                                                auto c = __builtin_amdgcn_permlane32_swap((unsigned)si[k], (unsigned)si[k], false, false); oi[k] = (int)(hi ? c[0] : c[1]); } }
#pragma unroll
                for (int k = 0; k < 4; ++k) { const float s_ = ov[k]; const int e = oi[k];
                    if (s_ > a0 || (s_ == a0 && e < i0)) { a3 = a2; i3 = i2; a2 = a1; i2 = i1; a1 = a0; i1 = i0; a0 = s_; i0 = e; }
                    else if (s_ > a1 || (s_ == a1 && e < i1)) { a3 = a2; i3 = i2; a2 = a1; i2 = i1; a1 = s_; i1 = e; }
                    else if (s_ > a2 || (s_ == a2 && e < i2)) { a3 = a2; i3 = i2; a2 = s_; i2 = e; }
                    else if (s_ > a3 || (s_ == a3 && e < i3)) { a3 = s_; i3 = e; } }
                const float e1 = __expf(a1 - a0), e2 = __expf(a2 - a0), e3 = __expf(a3 - a0), inv = 1.f / (((1.f + e1) + e2) + e3);
                if (hi == 0) {
                    *(int4*)(toke + (size_t)t * 4) = make_int4(i0, i1, i2, i3);
                    *(float4*)(tokw + (size_t)t * 4) = make_float4(inv, e1 * inv, e2 * inv, e3 * inv);
                    atomicAdd(&hist[i0], 1); atomicAdd(&hist[i1], 1); atomicAdd(&hist[i2], 1); atomicAdd(&hist[i3], 1);
                }
            }
            __syncthreads();
        }
        if (tid < 32) BC[blk * 32 + tid] = hist[tid];
        __syncthreads();
    }
}
__device__ __forceinline__ void phase_sc_fast(const Params& p, int l, unsigned char* lds_raw) {
    const int tid = otid();
    const int* BC = (const int*)(p.ws + WS_BC);
    int* cnt = (int*)(p.ws + WS_CNT) + l * 32;
    int* tot = (int*)lds_raw; int* base = tot + 32; int* fillc = tot + 64; int* before = tot + 96;
    const int* toke = (const int*)(p.ws + WS_TOKE); const float* tokw = (const float*)(p.ws + WS_TOKW);
    int* rowtok = (int*)(p.ws + WS_ROWTOK) + (size_t)l * RMAX; float* roww = (float*)(p.ws + WS_ROWW) + (size_t)l * RMAX; int* pos = (int*)(p.ws + WS_POS);
    for (int blk = blockIdx.x; blk < T / 64; blk += gridDim.x) {
        { const int e = tid & 31, part = tid >> 5; int s = 0, bf = 0;
#pragma unroll 4
          for (int i = part * 16; i < part * 16 + 16; ++i) { const int c = BC[i * 32 + e]; s += c; if (i < blk) bf += c; }
          int* ptot = tot + 128; int* pbef = ptot + 512;
          ptot[tid] = s; pbef[tid] = bf; }
        __syncthreads();
        if (tid < 32) { const int* ptot = tot + 128; const int* pbef = ptot + 512; int s = 0, bf = 0;
#pragma unroll
            for (int q = 0; q < 16; ++q) { s += ptot[q * 32 + tid]; bf += pbef[q * 32 + tid]; }
            tot[tid] = s; before[tid] = bf; fillc[tid] = 0; if (blk == 0) cnt[tid] = s; }
        __syncthreads();
        if (tid == 0) { int s = 0; for (int e = 0; e < 32; ++e) { base[e] = s + before[e]; s += (tot[e] + 255) & ~255; } }
        __syncthreads();
        if (tid < 256) {
            const int i = blk * 256 + tid, e = toke[i];
            const int slot = base[e] + atomicAdd(&fillc[e], 1);
            rowtok[slot] = i >> 2; roww[slot] = tokw[i]; pos[i] = slot;
        }
        __syncthreads();
    }
}

#define XB_TMO      128
#define XB_XCNT(j)  (256  + 64 * (j))
#define XB_XSUB(j)  (1280 + 64 * (j))
#define XB_XGEN(j)  (2304 + 64 * (j))
#define XB_TOP      3328
#define XB_TOPGEN   3392
#define XCD_BAR_WORDS 3456
#define XB_SPIN_CAP (1u << 18)
#define XLAS __attribute__((address_space(3)))
__device__ __forceinline__ unsigned xb_ld(unsigned* p)              { return __hip_atomic_load(p, __ATOMIC_RELAXED, __HIP_MEMORY_SCOPE_AGENT); }
__device__ __forceinline__ unsigned xb_add(unsigned* p, unsigned v) { return __hip_atomic_fetch_add(p, v, __ATOMIC_RELAXED, __HIP_MEMORY_SCOPE_AGENT); }
__device__ __forceinline__ unsigned xb_xcc_id() { return (unsigned)__builtin_amdgcn_s_getreg((3 << 11) | 20) & 0xFu; }
#define XB_SPIN(cond, bar) do { unsigned _sp = 0; while (cond) { __builtin_amdgcn_s_sleep(1); \
    if ((++_sp & 255u) == 0u) { if (xb_ld(&(bar)[XB_TMO])) break; if (_sp > XB_SPIN_CAP) { atomicAdd(&(bar)[XB_TMO], 1u); break; } } } } while (0)
constexpr int LDS_BARST_OFF = 147200;
struct XcdBarrier { unsigned* bar; unsigned x; volatile XLAS unsigned* st; };
__device__ __forceinline__ XcdBarrier xcd_barrier_post(unsigned* bar, volatile XLAS unsigned* st) {
    XcdBarrier b; b.bar = bar; b.x = xb_xcc_id(); b.st = st;
    if (threadIdx.x == 0) (void)xb_add(&bar[XB_XCNT(b.x)], 1u);
    return b;
}
__device__ __forceinline__ void xcd_barrier_complete(unsigned* bar, unsigned x, unsigned& nloc, unsigned& nx) {
    const unsigned G = gridDim.x * gridDim.y * gridDim.z;
    unsigned sum, cnt, mine, sp = 0u;
    for (;;) {
        sum = 0u; cnt = 0u; mine = 0u;
#pragma unroll
        for (unsigned j = 0; j < 16; ++j) { const unsigned c = xb_ld(&bar[XB_XCNT(j)]); sum += c; cnt += (c > 0u) ? 1u : 0u; mine = (j == x) ? c : mine; }
        if (sum == G) break;
        __builtin_amdgcn_s_sleep(1);
        if ((++sp & 255u) == 0u) { if (xb_ld(&bar[XB_TMO])) break; if (sp > XB_SPIN_CAP) { atomicAdd(&bar[XB_TMO], 1u); break; } }
    }
    nloc = mine > 0u ? mine : 1u; nx = cnt > 0u ? cnt : 1u;
}
__device__ __forceinline__ void xcd_barrier(unsigned char* ws, unsigned char* lds_raw_) {
    XcdBarrier b; b.bar = (unsigned*)(ws + WS_BAR); b.x = xb_xcc_id(); b.st = (volatile XLAS unsigned*)((XLAS unsigned char*)lds_raw_ + LDS_BARST_OFF);
    asm volatile("s_waitcnt vmcnt(0)" ::: "memory");
    __syncthreads();
    if (threadIdx.x == 0) {
        unsigned* bar = b.bar;
        __builtin_amdgcn_s_waitcnt(0);
        unsigned nloc = b.st[0], nx = b.st[1];
        if (nloc == 0u) { xcd_barrier_complete(bar, b.x, nloc, nx); b.st[0] = nloc; b.st[1] = nx; }
        const unsigned old = xb_add(&bar[XB_XSUB(b.x)], 1u);
        const unsigned gen = old / nloc;
        if (old + 1u == (gen + 1u) * nloc) {
            __builtin_amdgcn_fence(__ATOMIC_RELEASE, "agent");
            asm volatile("s_waitcnt vmcnt(0)" ::: "memory");
            const unsigned og = xb_add(&bar[XB_TOP], 1u);
            const unsigned tg = og / nx;
            if (og + 1u == (tg + 1u) * nx) xb_add(&bar[XB_TOPGEN], 1u);
            else XB_SPIN(xb_ld(&bar[XB_TOPGEN]) == tg, bar);
            __builtin_amdgcn_fence(__ATOMIC_ACQUIRE, "agent");
            xb_add(&bar[XB_XGEN(b.x)], 1u);
            asm volatile("s_waitcnt vmcnt(0)" ::: "memory");
        } else {
            XB_SPIN(xb_ld(&bar[XB_XGEN(b.x)]) == gen, bar);
            __builtin_amdgcn_fence(__ATOMIC_ACQUIRE, "agent");
            asm volatile("s_waitcnt vmcnt(0)" ::: "memory");
        }
    }
    __syncthreads();
}

__global__ void __launch_bounds__(NT, 2) mega_fwd(Params p) {
    extern __shared__ __attribute__((aligned(16))) unsigned char lds_raw[];
    float* lds = (float*)lds_raw;
    volatile XLAS unsigned* bst = (volatile XLAS unsigned*)((XLAS unsigned char*)lds_raw + LDS_BARST_OFF);
    if (threadIdx.x < 2) bst[threadIdx.x] = 0u;
    __syncthreads();
    (void)xcd_barrier_post((unsigned*)(p.ws + WS_BAR), bst);
#define GSYNC() xcd_barrier(p.ws, lds_raw)
    phase_p0a(p, lds);
    __syncthreads();
    phase_convert(p, lds);
    GSYNC();
    phase_p0b(p);
    GSYNC();
    _Pragma("unroll 1") for (int l = 0; l < L; ++l) {
        phase_r1(p, l, true);
        GSYNC();
        phase_g1_fast(p, l, lds_raw);
        GSYNC();
        phase_ck_fast(p, l, lds_raw);
        GSYNC();
        phase_c2(p, l, lds);
        __syncthreads();
        phase_route(p, lds_raw);
        GSYNC();
        phase_att1(p, lds_raw);
        GSYNC();
        phase_att2(p, lds_raw);
        GSYNC();
        phase_g2_fast(p, l, lds_raw);
        GSYNC();
        phase_r2_fast(p, l, lds_raw);
        GSYNC();
        phase_sc_fast(p, l, lds_raw);
        GSYNC();
        phase_m1_fast(p, l, lds_raw);
        GSYNC();
        phase_m2_fast(p, l, lds_raw);
        GSYNC();
    }
    phase_r1(p, L, false);
}

extern "C" void kernel_launch(void* const* d_in, const int* in_sizes, int n_in, void* d_out, int out_size, void* d_ws, size_t ws_size, hipStream_t stream) {
    static int grid_blocks = 0;
    if (grid_blocks == 0) {
        if (n_in != 21 || out_size != T * D || ws_size < WS_END) { fprintf(stderr, "kernel_launch: unexpected shapes (n_in %d out %d ws %zu need %zu)\n", n_in, out_size, ws_size, (size_t)WS_END); grid_blocks = -1; return; }
        int dev = 0, cus = 0, per_cu = 0;
        hipGetDevice(&dev);
        hipDeviceGetAttribute(&cus, hipDeviceAttributeMultiprocessorCount, dev);
        hipFuncSetAttribute((const void*)mega_fwd, hipFuncAttributeMaxDynamicSharedMemorySize, LDS_BYTES);
        hipOccupancyMaxActiveBlocksPerMultiprocessor(&per_cu, (const void*)mega_fwd, NT, LDS_BYTES);
        if (per_cu < 1) { fprintf(stderr, "kernel_launch: occupancy query says %d blocks per CU\n", per_cu); per_cu = 1; }
        (void)hipGetLastError();
        grid_blocks = cus * 1;
    }
    if (grid_blocks < 0) return;
    if (hipMemsetAsync((char*)d_ws + WS_BAR, 0, 16384, stream) != hipSuccess) { fprintf(stderr, "kernel_launch: memset failed\n"); return; }
    Params p{};
    for (int i = 0; i < 21; ++i) p.in[i] = (const float*)d_in[i];
    p.out = (float*)d_out; p.ws = (unsigned char*)d_ws;
    hipLaunchKernelGGL(mega_fwd, dim3(grid_blocks), dim3(NT), LDS_BYTES, stream, p);
    hipError_t e = hipPeekAtLastError();
    if (e != hipSuccess) fprintf(stderr, "launch failed: %s (grid %d)\n", hipGetErrorString(e), grid_blocks);
}
```

```cpp
#include <hip/hip_runtime.h>
#include <cstdio>
#include <cstdint>

constexpr int Bn = 2, S = 8192, D = 1024, L = 2, T = Bn * S;
constexpr int INW = 2840;
constexpr int NE = 32, TOPK = 4, DFF = 1024;
constexpr int A_TOT = T * TOPK;
constexpr int RMAX = A_TOT + NE * 256;
constexpr int NCMP = 511;
constexpr int NT = 512;
constexpr int NW = NT / 64;
constexpr int LDS_BYTES = 147456;
constexpr float EPS = 1e-6f;
constexpr float NEGF = -1e30f;

constexpr int ZBW = 3072;
constexpr int ZB_Q = 0, ZB_KC = 512, ZB_VC = 640, ZB_KS = 768, ZB_VS = 896, ZB_KW = 1024, ZB_VW = 1152, ZB_MQ = 1280, ZB_MK = 1792, ZB_MV = 2304, ZB_G = 2816;
constexpr float QSCALE = 0.125f * 1.4426950408889634f;
constexpr float LOG2E = 1.4426950408889634f;

constexpr size_t al256(size_t x) { return (x + 255) & ~(size_t)255; }
constexpr size_t WS_BAR = 0;
constexpr size_t WS_MODP = 16384;
constexpr size_t WS_MOD = al256(WS_MODP + (size_t)8 * L * Bn * 6144 * 4);
constexpr size_t WS_CNT = al256(WS_MOD + (size_t)L * Bn * 6144 * 4);
constexpr size_t WS_ROWTOK = al256(WS_CNT + L * 32 * 4);
constexpr size_t WS_ROWW = al256(WS_ROWTOK + (size_t)L * RMAX * 4);
constexpr size_t WS_TOKE = al256(WS_ROWW + (size_t)L * RMAX * 4);
constexpr size_t WS_TOKW = al256(WS_TOKE + (size_t)T * 4 * 4);
constexpr size_t WS_POS = al256(WS_TOKW + (size_t)T * 4 * 4);
constexpr size_t WS_Y = al256(WS_POS + (size_t)T * 4 * 4);
constexpr size_t WS_WINT = al256(WS_Y + (size_t)RMAX * 1024 * 4);
constexpr size_t WS_WOT = al256(WS_WINT + (size_t)L * 3072 * 1024 * 2);
constexpr size_t WS_W1T = al256(WS_WOT + (size_t)L * 1024 * 1024 * 2);
constexpr size_t WS_W2T = al256(WS_W1T + (size_t)L * NE * 2048 * 1024 * 2);
constexpr size_t WS_XN = al256(WS_W2T + (size_t)L * NE * 1024 * 1024 * 2);
constexpr size_t WS_ATTB = al256(WS_XN + (size_t)(T + 1) * D * 2);
constexpr size_t WS_ACT = al256(WS_ATTB + (size_t)T * D * 2);
constexpr size_t WS_ZB = al256(WS_ACT + (size_t)RMAX * DFF * 2);
constexpr size_t WS_GATE = al256(WS_ZB + (size_t)T * ZBW * 2);
constexpr size_t WS_KCB = al256(WS_GATE + (size_t)T * 32 * 4);
constexpr size_t WS_VCB = al256(WS_KCB + (size_t)Bn * 2 * 512 * 64 * 2);
constexpr size_t WS_KMB = al256(WS_VCB + (size_t)Bn * 2 * 512 * 64 * 2);
constexpr size_t WS_XNLO = al256(WS_KMB + (size_t)Bn * 8 * 32 * 64 * 2);
constexpr size_t WS_BC = al256(WS_XNLO + (size_t)T * D * 2);
constexpr size_t WS_WCT = al256(WS_BC + (size_t)(T / 64) * 32 * 4);
constexpr size_t WS_CBP = al256(WS_WCT + (size_t)L * 2 * 128 * 2048 * 2);
constexpr size_t WS_CB = al256(WS_CBP + (size_t)16 * L * 2 * 128 * 4);
constexpr size_t WS_HIDP = al256(WS_CB + (size_t)L * 2 * 128 * 4);
constexpr size_t WS_XAB = al256(WS_HIDP + (size_t)4 * 2 * 2044 * 128 * 4);
constexpr size_t WS_SEL3 = al256(WS_XAB + (size_t)T * D * 2);
constexpr size_t WS_LRK = al256(WS_SEL3 + (size_t)T * 8 * 4);
constexpr size_t WS_ILIST = al256(WS_LRK + (size_t)T * 8 * 4);
constexpr size_t WS_BCM = al256(WS_ILIST + (size_t)16 * 32 * 32 * 256);
constexpr size_t WS_PM = al256(WS_BCM + (size_t)16 * 32 * 32 * 4);
constexpr size_t WS_PL = al256(WS_PM + (size_t)16 * 25600 * 4);
constexpr size_t WS_PO = al256(WS_PL + (size_t)16 * 25600 * 4);
constexpr size_t WS_XN8 = al256(WS_PO + (size_t)16 * 25600 * 64 * 2);
constexpr size_t WS_DQ1 = al256(WS_XN8 + (size_t)(T + 1) * D);
constexpr size_t WS_DQ2 = al256(WS_DQ1 + (size_t)L * NE * 2048 * 4);
constexpr size_t WS_RWI = al256(WS_DQ2 + (size_t)L * NE * 1024 * 4);
constexpr size_t WS_KI = al256(WS_RWI + (size_t)L * 131072);
constexpr size_t WS_VI = al256(WS_KI + (size_t)Bn * 12 * 128 * 8192);
constexpr size_t WS_DQO = al256(WS_VI + (size_t)Bn * 12 * 128 * 8192);
constexpr size_t WS_END = al256(WS_DQO + (size_t)L * 1024 * 4);
constexpr float XS8 = 16.f, AS8 = 8.f, YS8 = 16.f, OS8 = 16.f;

struct Params {
    const float* in[21];
    float* out;
    unsigned char* ws;
};

__device__ __forceinline__ int otid() { int t = threadIdx.x; asm volatile("" : "+v"(t)); return t; }
typedef unsigned short bf16_t;
__device__ __forceinline__ unsigned f2bf(float f) { unsigned u = __builtin_bit_cast(unsigned, f); return (u + 0x7fffu + ((u >> 16) & 1u)) >> 16; }
__device__ __forceinline__ unsigned pk2(float lo, float hi) { return f2bf(lo) | (f2bf(hi) << 16); }
typedef float f32x2v __attribute__((ext_vector_type(2)));
__device__ __forceinline__ float4 f84(unsigned q) {
    const f32x2v lo = __builtin_amdgcn_cvt_pk_f32_fp8((int)q, false), hi = __builtin_amdgcn_cvt_pk_f32_fp8((int)q, true);
    return make_float4(lo[0] * (1.f / 16.f), lo[1] * (1.f / 16.f), hi[0] * (1.f / 16.f), hi[1] * (1.f / 16.f)); }
__device__ __forceinline__ unsigned pk_fp8x4(float a, float b, float c, float d) {
    a = __builtin_amdgcn_fmed3f(a, -448.f, 448.f); b = __builtin_amdgcn_fmed3f(b, -448.f, 448.f); c = __builtin_amdgcn_fmed3f(c, -448.f, 448.f); d = __builtin_amdgcn_fmed3f(d, -448.f, 448.f);
    int r = __builtin_amdgcn_cvt_pk_fp8_f32(a, b, 0, false);
    r = __builtin_amdgcn_cvt_pk_fp8_f32(c, d, r, true);
    return (unsigned)r; }
__device__ __forceinline__ float bf2f(bf16_t v) { return __builtin_bit_cast(float, (unsigned)v << 16); }
__device__ __forceinline__ float wave_sum(float v) {
#pragma unroll
    for (int o = 1; o < 64; o <<= 1) v += __shfl_xor(v, o);
    return v;
}
__device__ __forceinline__ float sigmoidf_(float x) { return 1.f / (1.f + __expf(-x)); }
__device__ __forceinline__ float gelu_tanh(float x) {
    const float u = 0.7978845608028654f * (x + 0.044715f * x * x * x);
    return 0.5f * x * (1.f + tanhf(u));
}

__device__ __forceinline__ void phase_p0a(const Params& p, float* lds) {
    const int tid = otid(), gtid = blockIdx.x * NT + tid, gsz = gridDim.x * NT;
    int* cnt = (int*)(p.ws + WS_CNT); int* rowtok = (int*)(p.ws + WS_ROWTOK);
    for (int i = gtid; i < L * 32; i += gsz) cnt[i] = 0;
    for (int i = gtid; i < L * RMAX; i += gsz) rowtok[i] = -1;
    const float* c = p.in[1];
    for (int i = tid; i < Bn * D; i += NT) { const float v = c[i]; lds[i] = v / (1.f + __expf(-v)); }
    __syncthreads();
    const float* ada_w = p.in[2];
    float* modp = (float*)(p.ws + WS_MODP);
    for (int idx = gtid; idx < 8 * L * 6144; idx += gsz) {
        const int col = idx % 6144, l = (idx / 6144) % L, kc = idx / (6144 * L);
        const float* w = ada_w + ((size_t)l * D + kc * 128) * 6144 + col;
        float a0 = 0.f, a1 = 0.f, c0 = 0.f, c1 = 0.f;
#pragma unroll 1
        for (int k0 = 0; k0 < 128; k0 += 32) { float wv[32];
#pragma unroll
            for (int k = 0; k < 32; ++k) wv[k] = __builtin_nontemporal_load(w + (size_t)(k0 + k) * 6144);
#pragma unroll
            for (int k = 0; k < 32; k += 2) { a0 += lds[kc * 128 + k0 + k] * wv[k]; a1 += lds[D + kc * 128 + k0 + k] * wv[k]; c0 += lds[kc * 128 + k0 + k + 1] * wv[k + 1]; c1 += lds[D + kc * 128 + k0 + k + 1] * wv[k + 1]; } }
        modp[((size_t)(kc * L + l) * Bn + 0) * 6144 + col] = a0 + c0;
        modp[((size_t)(kc * L + l) * Bn + 1) * 6144 + col] = a1 + c1;
    }
    { const float* posw = p.in[9]; const float* w1c = p.in[10]; float* cbp = (float*)(p.ws + WS_CBP);
      int first = 8 * L * 6144; if (first + 16 * L * 2 * 128 > gsz) first = 0;
      for (int idx = gtid - first; idx < 16 * L * 2 * 128; idx += gsz) { if (idx < 0) continue;
          const int j = idx & 127, li = (idx >> 7) % (L * 2), kc = idx / (L * 2 * 128);
          const float* w = w1c + ((size_t)li * 2048 + kc * 128) * 128 + j; const float* pp = posw + (size_t)li * 2048 + kc * 128;
          float a = 0.f, c_ = 0.f;
#pragma unroll 1
          for (int k0 = 0; k0 < 128; k0 += 32) { float wv[32];
#pragma unroll
              for (int k = 0; k < 32; ++k) wv[k] = w[(size_t)(k0 + k) * 128];
#pragma unroll
              for (int k = 0; k < 32; k += 2) { a += pp[k0 + k] * wv[k]; c_ += pp[k0 + k + 1] * wv[k + 1]; } }
          cbp[idx] = a + c_; } }
}
__device__ __forceinline__ void phase_p0b(const Params& p) {
    const int gtid = blockIdx.x * NT + otid(), gsz = gridDim.x * NT;
    { const float* cbp = (const float*)(p.ws + WS_CBP); float* cb = (float*)(p.ws + WS_CB);
      for (int idx = gtid; idx < L * 2 * 128; idx += gsz) { float s = 0.f;
#pragma unroll
          for (int kc = 0; kc < 16; ++kc) s += cbp[kc * (L * 2 * 128) + idx];
          cb[idx] = s; } }
    const float* modp = (const float*)(p.ws + WS_MODP); float* mod = (float*)(p.ws + WS_MOD); const float* ada_b = p.in[3];
    for (int idx = gtid; idx < L * Bn * 6144; idx += gsz) {
        const int col = idx % 6144, l = idx / (Bn * 6144);
        float s = ada_b[l * 6144 + col];
#pragma unroll
        for (int kc = 0; kc < 8; ++kc) s += modp[(size_t)kc * L * Bn * 6144 + idx];
        mod[idx] = s;
    }
}

__device__ __forceinline__ void phase_r1(const Params& p, int l, bool do_h) {
    const int lane = otid() & 63, wave = otid() >> 6;
    const int gw = blockIdx.x * NW + wave, ngw = gridDim.x * NW;
    const float* mod = (const float*)(p.ws + WS_MOD);
    const float* xin = p.in[0]; float* XA = p.out;
    const unsigned char* Y8 = p.ws + WS_Y; const int* pos = (const int*)(p.ws + WS_POS); const float* tokw = (const float*)(p.ws + WS_TOKW);
    const float* lng = p.in[4] + (size_t)(do_h ? l : 0) * D;
    bf16_t* XN = (bf16_t*)(p.ws + WS_XN); bf16_t* XAB = (bf16_t*)(p.ws + WS_XAB);
#define BF4(q) make_float4(__builtin_bit_cast(float, (q).x << 16), __builtin_bit_cast(float, (q).x & 0xffff0000u), __builtin_bit_cast(float, (q).y << 16), __builtin_bit_cast(float, (q).y & 0xffff0000u))
#define F84(q) f84((q))
    int curb = -1; float4 g2v[4], ga[4], s0v[4];
    for (int t0 = gw; t0 < T; t0 += ngw) {
        const int nr = 1;
        float4 v[2][4];
        if (l == 0) {
#pragma unroll
            for (int i = 0; i < 2; ++i) if (i < nr) {
#pragma unroll
                for (int j = 0; j < 4; ++j) v[i][j] = *(const float4*)(xin + (size_t)(t0 + i * ngw) * D + 4 * lane + 256 * j); }
        } else {
            int4 ps[2]; float4 tw[2]; uint2 xq[2][4];
#pragma unroll
            for (int i = 0; i < 2; ++i) if (i < nr) { const int t = t0 + i * ngw; ps[i] = *(const int4*)(pos + (size_t)t * 4); tw[i] = *(const float4*)(tokw + (size_t)t * 4);
#pragma unroll
                for (int j = 0; j < 4; ++j) xq[i][j] = *(const uint2*)(XAB + (size_t)t * D + 4 * lane + 256 * j); }
            unsigned yq[2][4][4];
#pragma unroll
            for (int i = 0; i < 2; ++i) if (i < nr) {
#pragma unroll
                for (int j = 0; j < 4; ++j) { const int col = 4 * lane + 256 * j;
                    yq[i][j][0] = *(const unsigned*)(Y8 + (size_t)ps[i].x * D + col); yq[i][j][1] = *(const unsigned*)(Y8 + (size_t)ps[i].y * D + col);
                    yq[i][j][2] = *(const unsigned*)(Y8 + (size_t)ps[i].z * D + col); yq[i][j][3] = *(const unsigned*)(Y8 + (size_t)ps[i].w * D + col); } }
#pragma unroll
            for (int i = 0; i < 2; ++i) if (i < nr) {
                const int t = t0 + i * ngw, b = t / S;
                if (b != curb) { curb = b;
                    const float* g2 = mod + ((size_t)(l - 1) * Bn + b) * 6144 + 5 * D;
#pragma unroll
                    for (int j = 0; j < 4; ++j) g2v[j] = *(const float4*)(g2 + 4 * lane + 256 * j);
                    if (do_h) { const float* sh = mod + ((size_t)l * Bn + b) * 6144 + 0 * D; const float* sc = mod + ((size_t)l * Bn + b) * 6144 + 1 * D;
#pragma unroll
                        for (int j = 0; j < 4; ++j) { const int col = 4 * lane + 256 * j; const float4 g = *(const float4*)(lng + col), s1 = *(const float4*)(sc + col); s0v[j] = *(const float4*)(sh + col);
                            ga[j] = make_float4(g.x * (1.f + s1.x), g.y * (1.f + s1.y), g.z * (1.f + s1.z), g.w * (1.f + s1.w)); } } }
#pragma unroll
                for (int j = 0; j < 4; ++j) {
                    const int col = 4 * lane + 256 * j;
                    const float4 x = BF4(xq[i][j]);
                    const float4 y0 = F84(yq[i][j][0]), y1 = F84(yq[i][j][1]), y2 = F84(yq[i][j][2]), y3 = F84(yq[i][j][3]);
                    const float4 g = g2v[j];
                    float4 r;
                    r.x = x.x + g.x * (((tw[i].x * y0.x + tw[i].y * y1.x) + tw[i].z * y2.x) + tw[i].w * y3.x); r.y = x.y + g.y * (((tw[i].x * y0.y + tw[i].y * y1.y) + tw[i].z * y2.y) + tw[i].w * y3.y);
                    r.z = x.z + g.z * (((tw[i].x * y0.z + tw[i].y * y1.z) + tw[i].z * y2.z) + tw[i].w * y3.z); r.w = x.w + g.w * (((tw[i].x * y0.w + tw[i].y * y1.w) + tw[i].z * y2.w) + tw[i].w * y3.w);
                    v[i][j] = r;
                    if (do_h) *(uint2*)(XAB + (size_t)t * D + col) = make_uint2(pk2(r.x, r.y), pk2(r.z, r.w));
                    else *(float4*)(XA + (size_t)t * D + col) = r;
                }
            }
        }
        if (do_h) {
#pragma unroll
            for (int i = 0; i < 2; ++i) if (i < nr) {
                const int t = t0 + i * ngw, b = t / S;
                if (b != curb) { curb = b;
                    const float* sh = mod + ((size_t)l * Bn + b) * 6144 + 0 * D; const float* sc = mod + ((size_t)l * Bn + b) * 6144 + 1 * D;
#pragma unroll
                    for (int j = 0; j < 4; ++j) { const int col = 4 * lane + 256 * j; const float4 g = *(const float4*)(lng + col), s1 = *(const float4*)(sc + col); s0v[j] = *(const float4*)(sh + col);
                        ga[j] = make_float4(g.x * (1.f + s1.x), g.y * (1.f + s1.y), g.z * (1.f + s1.z), g.w * (1.f + s1.w)); } }
                float ss = 0.f;
#pragma unroll
                for (int j = 0; j < 4; ++j) ss += (v[i][j].x * v[i][j].x + v[i][j].y * v[i][j].y) + (v[i][j].z * v[i][j].z + v[i][j].w * v[i][j].w);
                ss = wave_sum(ss);
                const float r = rsqrtf(ss * (1.f / D) + EPS);
#pragma unroll
                for (int j = 0; j < 4; ++j) {
                    const int col = 4 * lane + 256 * j;
                    float4 o;
                    o.x = v[i][j].x * r * ga[j].x + s0v[j].x; o.y = v[i][j].y * r * ga[j].y + s0v[j].y;
                    o.z = v[i][j].z * r * ga[j].z + s0v[j].z; o.w = v[i][j].w * r * ga[j].w + s0v[j].w;
                    *(uint2*)(XN + (size_t)t * D + col) = make_uint2(pk2(o.x, o.y), pk2(o.z, o.w));
                }
            }
        }
    }
#undef BF4
}


__device__ __forceinline__ void phase_c2(const Params& p, int l, float* lds) {
    const int lane = otid() & 63, wave = otid() >> 6;
    const float* HIDP = (const float*)(p.ws + WS_HIDP); const float* cb = (const float*)(p.ws + WS_CB) + l * 2 * 128; const float* w2 = p.in[11] + (size_t)l * 2 * 128 * 64;
    const float gk = p.in[8][l * 64 + lane];
    float* hl = lds + wave * 128;
    for (int r = blockIdx.x * NW + wave; r < 2 * 2044; r += gridDim.x * NW) {
        const int idx = r / 2044, rr = r % 2044;
#pragma unroll
        for (int q = 0; q < 2; ++q) { const int j = lane + 64 * q; float s = cb[idx * 128 + j];
#pragma unroll
            for (int kq = 0; kq < 4; ++kq) s += HIDP[((size_t)(kq * 2 + idx) * 2044 + rr) * 128 + j];
            hl[j] = gelu_tanh(s); }
        asm volatile("s_waitcnt lgkmcnt(0)" ::: "memory"); __builtin_amdgcn_wave_barrier();
        const float* W = w2 + (size_t)idx * 128 * 64;
        float s = 0.f;
#pragma unroll 8
        for (int j = 0; j < 128; ++j) s += hl[j] * W[j * 64 + lane];
        asm volatile("s_waitcnt lgkmcnt(0)" ::: "memory"); __builtin_amdgcn_wave_barrier();
        const int bgi = rr / 511, n = rr % 511;
        if (idx == 0) { const float ss = wave_sum(s * s); const float kv = s * rsqrtf(ss * (1.f / 64.f) + EPS) * gk; ((bf16_t*)(p.ws + WS_KCB))[((size_t)bgi * 512 + n) * 64 + lane] = (bf16_t)f2bf(kv); }
        else { ((bf16_t*)(p.ws + WS_VCB))[((size_t)bgi * 512 + n) * 64 + lane] = (bf16_t)f2bf(s); }
    }
    if (blockIdx.x == 0 && otid() < 2 * 4 * 64) { const int i = otid(); bf16_t* dst = (bf16_t*)(p.ws + (i < 256 ? WS_KCB : WS_VCB)); dst[((size_t)((i & 255) >> 6) * 512 + 511) * 64 + (i & 63)] = 0; }
}

__device__ __forceinline__ void load_pstart(const Params& p, int l, int* ps) {
    const int* cnt = (const int*)(p.ws + WS_CNT) + l * 32;
    if (otid() == 0) { int s = 0; for (int e = 0; e < 32; ++e) { ps[e] = s; s += (cnt[e] + 255) & ~255; } ps[32] = s; }
    __syncthreads();
}


template <int MAP>
__device__ __forceinline__ void tr_tile(const float* W, int Nsrc, bf16_t* WT, int K, int k0, int n0, float* scr, int lane) {
    const int nl = (lane & 15) * 4, kr = lane >> 4;
    int sc = n0 + nl;
    if (MAP == 1) { sc = sc < 1280 ? sc : (sc < 2816 ? sc + 24 : (sc < 2840 ? sc - 2816 + 1280 : -1)); }
    float4 v[16];
#pragma unroll
    for (int it = 0; it < 16; ++it) { if (sc >= 0) { const float* src_ = W + (size_t)(k0 + it * 4 + kr) * Nsrc + sc; typedef float f4v __attribute__((ext_vector_type(4))); const f4v t_ = __builtin_nontemporal_load((const f4v*)src_); v[it] = make_float4(t_[0], t_[1], t_[2], t_[3]); } else v[it] = make_float4(0.f, 0.f, 0.f, 0.f); }
#pragma unroll
    for (int it = 0; it < 16; ++it) { float* s = scr + (it * 4 + kr) * 65 + nl; s[0] = v[it].x; s[1] = v[it].y; s[2] = v[it].z; s[3] = v[it].w; }
    asm volatile("s_waitcnt lgkmcnt(0)" ::: "memory"); __builtin_amdgcn_wave_barrier();
    const int c = lane & 7, nr = lane >> 3;
#pragma unroll
    for (int it = 0; it < 8; ++it) {
        const int n = it * 8 + nr; const float* s = scr + (8 * c) * 65 + n;
        uint4 o; o.x = pk2(s[0], s[65]); o.y = pk2(s[2 * 65], s[3 * 65]); o.z = pk2(s[4 * 65], s[5 * 65]); o.w = pk2(s[6 * 65], s[7 * 65]);
        *(uint4*)(WT + (size_t)(n0 + n) * K + k0 + 8 * c) = o;
    }
    asm volatile("s_waitcnt lgkmcnt(0)" ::: "memory"); __builtin_amdgcn_wave_barrier();
}
__device__ __forceinline__ void phase_convert(const Params& p, float* lds) {
    const int tid = otid(), lane = tid & 63, wave = tid >> 6;
    float* scr = lds + wave * (64 * 65);
    const int gw = blockIdx.x * NW + wave, ngw = gridDim.x * NW;
    bf16_t* WinT = (bf16_t*)(p.ws + WS_WINT); bf16_t* WoT = (bf16_t*)(p.ws + WS_WOT);
    constexpr int I_IN = L * 16 * (ZBW / 64), I_O = 0  , I_C = L * 2 * 32 * 2;
    { float* cm = lds + NW * (64 * 65);
      constexpr int S1 = L * NE * 32, S2 = L * NE * 16, S3 = L * 16;
      const int offs3 = gridDim.x == 256 ? 224 : 0;
      for (int sv = blockIdx.x; sv < S1 + S2 + S3 + offs3; sv += gridDim.x) {
          int s = sv; if (sv >= S1 + S2) { s = sv - offs3; if (s < S1 + S2) break; }
          const bool is1 = s < S1, is3 = s >= S1 + S2; const int q = is1 ? s : (is3 ? s - S1 - S2 : s - S1);
          const int le = is1 ? (q >> 5) : (q >> 4), nb = is1 ? (q & 31) : (q & 15), Nsrc = is1 ? 2048 : 1024;
          const float* W = (is1 ? p.in[17] : (is3 ? p.in[14] : p.in[19])) + (size_t)le * 1024 * Nsrc;
          unsigned char* WT8 = p.ws + (is1 ? WS_W1T : (is3 ? WS_WOT : WS_W2T)) + (size_t)le * Nsrc * 1024;
          float* DQ = (float*)(p.ws + (is1 ? WS_DQ1 : (is3 ? WS_DQO : WS_DQ2))) + (size_t)le * Nsrc;
          const int n0 = nb * 64, nl = (lane & 15) * 4, kr = lane >> 4, k0 = wave * 128;
          typedef float f4v __attribute__((ext_vector_type(4)));
          f4v va[16], vb[16];
#pragma unroll
          for (int it = 0; it < 16; ++it) { va[it] = __builtin_nontemporal_load((const f4v*)(W + (size_t)(k0 + it * 4 + kr) * Nsrc + n0 + nl));
                                            vb[it] = __builtin_nontemporal_load((const f4v*)(W + (size_t)(k0 + 64 + it * 4 + kr) * Nsrc + n0 + nl)); }
          float m[4] = {0.f, 0.f, 0.f, 0.f};
#pragma unroll
          for (int it = 0; it < 16; ++it)
#pragma unroll
              for (int j = 0; j < 4; ++j) m[j] = __builtin_fmaxf(m[j], __builtin_fmaxf(__builtin_fabsf(va[it][j]), __builtin_fabsf(vb[it][j])));
#pragma unroll
          for (int j = 0; j < 4; ++j) { m[j] = __builtin_fmaxf(m[j], __shfl_xor(m[j], 16)); m[j] = __builtin_fmaxf(m[j], __shfl_xor(m[j], 32)); }
          if (kr == 0) {
#pragma unroll
              for (int j = 0; j < 4; ++j) cm[wave * 64 + nl + j] = m[j]; }
          __syncthreads();
          float sc[4];
#pragma unroll
          for (int j = 0; j < 4; ++j) { float a = cm[nl + j];
#pragma unroll
              for (int w = 1; w < NW; ++w) a = __builtin_fmaxf(a, cm[w * 64 + nl + j]);
              sc[j] = a > 0.f ? 448.f / a : 0.f;
              if (wave == 0 && kr == 0) DQ[n0 + nl + j] = a * (1.f / 448.f); }
#pragma unroll
          for (int half = 0; half < 2; ++half) {
#pragma unroll
              for (int it = 0; it < 16; ++it) { const f4v v = half ? vb[it] : va[it]; float* d = scr + (it * 4 + kr) * 65 + nl; d[0] = v[0] * sc[0]; d[1] = v[1] * sc[1]; d[2] = v[2] * sc[2]; d[3] = v[3] * sc[3]; }
              asm volatile("s_waitcnt lgkmcnt(0)" ::: "memory"); __builtin_amdgcn_wave_barrier();
              const int c = lane & 7, nr = lane >> 3;
#pragma unroll
              for (int it = 0; it < 8; ++it) { const int n = it * 8 + nr; const float* sp = scr + (8 * c) * 65 + n;
                  uint2 o; o.x = pk_fp8x4(sp[0], sp[65], sp[2 * 65], sp[3 * 65]); o.y = pk_fp8x4(sp[4 * 65], sp[5 * 65], sp[6 * 65], sp[7 * 65]);
                  *(uint2*)(WT8 + (size_t)(n0 + n) * 1024 + k0 + half * 64 + 8 * c) = o; }
              asm volatile("s_waitcnt lgkmcnt(0)" ::: "memory"); __builtin_amdgcn_wave_barrier();
          }
          __syncthreads();
      } }
    for (int it = gw; it < I_C + I_IN + I_O; it += ngw) {
        int r = it;
        if (r < I_C) { const int li = r / 64, q = r % 64, kb = q / 2, nb = q % 2;
            tr_tile<0>(p.in[10] + (size_t)li * 2048 * 128, 128, (bf16_t*)(p.ws + WS_WCT) + (size_t)li * 128 * 2048, 2048, kb * 64, nb * 64, scr, lane); continue; }
        r -= I_C;
        if (r < I_IN) { const int l = r / (16 * 48), q = r % (16 * 48), kb = q / 48, nb = q % 48;
            tr_tile<1>(p.in[6] + (size_t)l * D * INW, INW, WinT + (size_t)l * ZBW * D, D, kb * 64, nb * 64, scr, lane); continue; }
        r -= I_IN;
        { const int l = r / 256, q = r % 256, kb = q / 16, nb = q % 16;
            tr_tile<0>(p.in[14] + (size_t)l * D * D, D, WoT + (size_t)l * D * D, D, kb * 64, nb * 64, scr, lane); }
    }
    for (int idx = blockIdx.x * NT + tid; idx < L * 128 * 32; idx += gridDim.x * NT) {
        const int l = idx >> 12, kc = (idx >> 5) & 127, e = idx & 31; const float* rw = p.in[15] + (size_t)l * D * NE; float v[8];
#pragma unroll
        for (int j = 0; j < 8; ++j) v[j] = rw[(size_t)(8 * kc + j) * NE + e];
        unsigned hh[8], ll[8];
#pragma unroll
        for (int j = 0; j < 8; ++j) { hh[j] = f2bf(v[j]); ll[j] = f2bf(v[j] - __builtin_bit_cast(float, hh[j] << 16)); }
        unsigned char* img = p.ws + WS_RWI + (size_t)l * 131072;
        *(uint4*)(img + (size_t)(idx & 4095) * 16) = make_uint4(hh[0] | (hh[1] << 16), hh[2] | (hh[3] << 16), hh[4] | (hh[5] << 16), hh[6] | (hh[7] << 16));
        *(uint4*)(img + 65536 + (size_t)(idx & 4095) * 16) = make_uint4(ll[0] | (ll[1] << 16), ll[2] | (ll[3] << 16), ll[4] | (ll[5] << 16), ll[6] | (ll[7] << 16));
    }
    if (blockIdx.x == 0) { bf16_t* XN = (bf16_t*)(p.ws + WS_XN); for (int i = tid; i < D / 2; i += NT) ((unsigned*)(XN + (size_t)T * D))[i] = 0u;
                           for (int i = tid; i < D / 4; i += NT) ((unsigned*)(p.ws + WS_XN8 + (size_t)T * D))[i] = 0u; }
}

namespace pg8 {
#define PG8_LAS __attribute__((address_space(3)))
typedef short bf16x8 __attribute__((ext_vector_type(8)));
typedef float f32x4 __attribute__((ext_vector_type(4)));
typedef unsigned u32x4 __attribute__((ext_vector_type(4)));
typedef long l64x2 __attribute__((ext_vector_type(2)));
typedef int i32x4 __attribute__((ext_vector_type(4)));
typedef int i32x8 __attribute__((ext_vector_type(8)));
constexpr int BM = 256, BK = 64, HALF = 128, HTB = HALF * BK * 2, STAGE_BYTES = 8 * HTB, NXCD = 8, WGM = 8;
__device__ __forceinline__ int lds_byte(int r, int c) { const int st = (r >> 4) * 2 + (c >> 5), rr = r & 15, cc = c & 31, ob = rr * 64 + cc * 2; return st * 1024 + (ob ^ (((ob >> 9) & 1) << 5)); }
__device__ __forceinline__ void stage_rc(int b, int& R, int& C) { const int st = b / 1024, sb = b % 1024, swz = sb ^ (((sb >> 9) & 1) << 5); R = (st >> 1) * 16 + swz / 64; C = (st & 1) * 32 + (swz % 64) / 2; }
__device__ __forceinline__ int perm32(int rho) { const int n = rho >> 4, i = rho & 15; return 8 * (i >> 2) + 4 * n + (i & 3); }
struct Unit { int pm, pn, e; };
__device__ __forceinline__ unsigned cvt_pk_bf16(float lo, float hi) { unsigned r; asm volatile("v_cvt_pk_bf16_f32 %0, %1, %2" : "=v"(r) : "v"(lo), "v"(hi)); return r; }

__device__ __forceinline__ bool static_next(int nM, int nN, int G, int c, int i, Unit& u) {
    const int nwg = nM * nN; const long Lq = (long)i * G + c; if (Lq >= nwg) return false;
    int wgid = (int)Lq; { const int q = nwg / NXCD, r = nwg % NXCD, xcd = wgid % NXCD, off = wgid / NXCD; wgid = (xcd < r ? xcd * (q + 1) : r * (q + 1) + (xcd - r) * q) + off; }
    const int nig = WGM * nN, gid = wgid / nig, fm = gid * WGM, gsz = (nM - fm) < WGM ? (nM - fm) : WGM;
    u.pm = fm + ((wgid % nig) % gsz); u.pn = (wgid % nig) / gsz; u.e = 0; return true;
}

template <class Prob, class Epi, bool ALIGN_EPI, bool SP2>
__device__ __forceinline__ void gemm_phase(PG8_LAS unsigned char* lds, const Prob& P, const Epi& E) {
    const int tid = otid(), wid = __builtin_amdgcn_readfirstlane(tid >> 6), lane = tid & 63, wr = wid >> 2, wc = wid & 3, fr = lane & 15, fq = lane >> 4;
    const int K = P.K, nt = Prob::KT > 0 ? Prob::KT : K / BK;
    int sR[2], sC[2]; unsigned voffB[2];
#pragma unroll
    for (int i = 0; i < 2; ++i) { stage_rc(tid * 16 + i * 8192, sR[i], sC[i]); voffB[i] = (unsigned)(P.b_row(sR[i]) * K + sC[i]) * 2u; }
    const size_t kstep = (size_t)(BK * 2);
    const size_t kstepA = P.a_kstep();
    const size_t hstepB = P.b_hstep();
    const unsigned ldsw = (unsigned)wid * 1024u;
    const int aoff = lds_byte(wr * 64 + fr, fq * 8), boff = lds_byte(wc * 32 + fr, fq * 8);
#define PG8_SA(b, h) (((b) * 2 + (h)) * HTB)
#define PG8_SB(b, h) ((4 + (b) * 2 + (h)) * HTB)
#define PG8_STAGE(bufoff, gbase, voff) do { _Pragma("unroll") for (int _i = 0; _i < 2; ++_i) { unsigned _vo = (voff)[_i]; asm volatile("" : "+v"(_vo));        \
        __builtin_amdgcn_global_load_lds((const unsigned*)((const char*)(gbase) + _vo), (PG8_LAS unsigned*)(lds + (bufoff) + ldsw + _i * 8192), 16, 0, 0); } } while (0)
#define PG8_STAGE_SEL(bufoff, gbase, h) do { _Pragma("unroll") for (int _i = 0; _i < 2; ++_i) { unsigned _vo = vAc[h][_i]; if constexpr (Prob::GATHER) { const unsigned _vn = van[(h) * 2 + _i]; _vo = last ? _vn : _vo; } asm volatile("" : "+v"(_vo)); \
        __builtin_amdgcn_global_load_lds((const unsigned*)((const char*)(gbase) + _vo), (PG8_LAS unsigned*)(lds + (bufoff) + ldsw + _i * 8192), 16, 0, 0); } } while (0)
#define PG8_LDA(dst, b, h) do { if constexpr (Prob::F8) { _Pragma("unroll") for (int m = 0; m < 2; ++m) { \
            const i32x4 lo_ = *(const PG8_LAS i32x4*)(lds + PG8_SA(b, h) + aoff + m * 2048), hi_ = *(const PG8_LAS i32x4*)(lds + PG8_SA(b, h) + aoff + m * 2048 + 1024); \
            dst##8[m] = __builtin_shufflevector(lo_, hi_, 0, 1, 2, 3, 4, 5, 6, 7); } } \
        else { _Pragma("unroll") for (int m = 0; m < 4; ++m) _Pragma("unroll") for (int k = 0; k < 2; ++k) dst[m][k] = *(const PG8_LAS bf16x8*)(lds + PG8_SA(b, h) + aoff + m * 2048 + k * 1024); } } while (0)
#define PG8_LDB(dst, b, h) do { if constexpr (Prob::F8) { _Pragma("unroll") for (int n = 0; n < 2; ++n) { \
            const i32x4 lo_ = *(const PG8_LAS i32x4*)(lds + PG8_SB(b, h) + boff + n * 2048), hi_ = *(const PG8_LAS i32x4*)(lds + PG8_SB(b, h) + boff + n * 2048 + 1024); \
            dst##8[n] = __builtin_shufflevector(lo_, hi_, 0, 1, 2, 3, 4, 5, 6, 7); } } \
        else { _Pragma("unroll") for (int n = 0; n < 2; ++n) _Pragma("unroll") for (int k = 0; k < 2; ++k) dst[n][k] = *(const PG8_LAS bf16x8*)(lds + PG8_SB(b, h) + boff + n * 2048 + k * 1024); } } while (0)
#define PG8_MMA(ai, bj, At, Bt) do { __builtin_amdgcn_s_setprio(1); _Pragma("unroll") for (int m = 0; m < 4; ++m) _Pragma("unroll") for (int n = 0; n < 2; ++n) { \
        if constexpr (Prob::F8)          \
            acc[ai][bj][m][n] = __builtin_amdgcn_mfma_scale_f32_16x16x128_f8f6f4(Bt##8[n], At##8[m], acc[ai][bj][m][n], 0, 0, 0, 0x7f7f7f7f, 0, 0x7f7f7f7f); \
        else { _Pragma("unroll") for (int k = 0; k < 2; ++k) acc[ai][bj][m][n] = __builtin_amdgcn_mfma_f32_16x16x32_bf16(Bt[n][k], At[m][k], acc[ai][bj][m][n], 0, 0, 0); } } __builtin_amdgcn_s_setprio(0); } while (0)
#define PG8_MMA2(ai, At, B0, B1, b, h) do { if constexpr (Prob::F8) { __builtin_amdgcn_s_setprio(1); \
        _Pragma("unroll") for (int m = 0; m < 2; ++m) _Pragma("unroll") for (int n = 0; n < 2; ++n) { \
            acc[ai][0][m][n] = __builtin_amdgcn_mfma_scale_f32_16x16x128_f8f6f4(B0##8[n], At##8[m], acc[ai][0][m][n], 0, 0, 0, 0x7f7f7f7f, 0, 0x7f7f7f7f); \
            acc[ai][1][m][n] = __builtin_amdgcn_mfma_scale_f32_16x16x128_f8f6f4(B1##8[n], At##8[m], acc[ai][1][m][n], 0, 0, 0, 0x7f7f7f7f, 0, 0x7f7f7f7f); } \
        _Pragma("unroll") for (int m = 0; m < 2; ++m) { \
            const i32x4 lo_ = *(const PG8_LAS i32x4*)(lds + PG8_SA(b, h) + aoff + (m + 2) * 2048), hi_ = *(const PG8_LAS i32x4*)(lds + PG8_SA(b, h) + aoff + (m + 2) * 2048 + 1024); \
            At##8[m] = __builtin_shufflevector(lo_, hi_, 0, 1, 2, 3, 4, 5, 6, 7); } \
        _Pragma("unroll") for (int m = 0; m < 2; ++m) _Pragma("unroll") for (int n = 0; n < 2; ++n) { \
            acc[ai][0][m + 2][n] = __builtin_amdgcn_mfma_scale_f32_16x16x128_f8f6f4(B0##8[n], At##8[m], acc[ai][0][m + 2][n], 0, 0, 0, 0x7f7f7f7f, 0, 0x7f7f7f7f); \
            acc[ai][1][m + 2][n] = __builtin_amdgcn_mfma_scale_f32_16x16x128_f8f6f4(B1##8[n], At##8[m], acc[ai][1][m + 2][n], 0, 0, 0, 0x7f7f7f7f, 0, 0x7f7f7f7f); } \
        __builtin_amdgcn_s_setprio(0); } else { PG8_MMA(ai, 0, At, B0); PG8_MMA(ai, 1, At, B1); } } while (0)
#define PG8_WAIT_V(n) asm volatile("s_waitcnt vmcnt(" #n ")" ::: "memory")
#define PG8_WAIT_L(n) asm volatile("s_waitcnt lgkmcnt(" #n ")" ::: "memory")
#define PG8_BAR __builtin_amdgcn_s_barrier()
#define PG8_SCHED __builtin_amdgcn_sched_barrier(0)
    Unit cur, nxt; int ui = 0;
    if (!P.next(0, cur)) return;
    nxt = cur;
    f32x4 acc[2][2][4][2];
    typename Epi::Pre pre;
    E.prefetch(cur, wc, fq, pre); E.init(acc, pre);
    bf16x8 At[4][2], B0[2][2], B1[2][2];
    i32x8 At8[2], B08[2], B18[2];
    unsigned vAc[2][2];
    PG8_LAS unsigned* van = (PG8_LAS unsigned*)(lds + 131072 + 1024) + tid * 4;
    const char* cA = P.a_base(cur); const char* cB = P.b_base(cur);
    P.a_voff(cur, sR, sC, vAc);
    if constexpr (Prob::GATHER) { van[0] = vAc[0][0]; van[1] = vAc[0][1]; van[2] = vAc[1][0]; van[3] = vAc[1][1]; }
    if constexpr (SP2) {
        PG8_STAGE(PG8_SB(0, 0), cB, voffB); PG8_STAGE(PG8_SB(0, 1), cB + hstepB, voffB); PG8_STAGE(PG8_SA(0, 0), cA, vAc[0]); PG8_STAGE(PG8_SA(0, 1), cA, vAc[1]);
        if (wr == 1) PG8_BAR;
        PG8_WAIT_V(2); PG8_BAR;
        PG8_STAGE(PG8_SB(1, 0), cB + kstep, voffB); PG8_STAGE(PG8_SA(1, 0), cA + kstepA, vAc[0]); PG8_STAGE(PG8_SB(1, 1), cB + hstepB + kstep, voffB);
        PG8_WAIT_V(6); PG8_BAR;
    } else {
        PG8_STAGE(PG8_SB(0, 0), cB, voffB); PG8_STAGE(PG8_SA(0, 0), cA, vAc[0]); PG8_STAGE(PG8_SB(0, 1), cB + hstepB, voffB); PG8_STAGE(PG8_SA(0, 1), cA, vAc[1]);
        if (wr == 1) PG8_BAR;
        PG8_WAIT_V(4); PG8_BAR;
        PG8_STAGE(PG8_SB(1, 0), cB + kstep, voffB); PG8_STAGE(PG8_SA(1, 0), cA + kstepA, vAc[0]); PG8_STAGE(PG8_SB(1, 1), cB + hstepB + kstep, voffB);
        PG8_WAIT_V(6); PG8_BAR;
    }
    for (;;) {
        E.preload(cur, wc, fq, pre);
        const bool has_next = P.next(ui + 1, nxt);
        const char* nA = cA; const char* nB = cB;
        if (has_next) { nA = P.a_base(nxt); nB = P.b_base(nxt);
            if constexpr (Prob::GATHER) { int r2[2], c2[2]; const int t2 = otid();
#pragma unroll
                for (int i = 0; i < 2; ++i) stage_rc(t2 * 16 + i * 8192, r2[i], c2[i]);
                unsigned vn[2][2]; P.a_voff(nxt, r2, c2, vn); van[0] = vn[0][0]; van[1] = vn[0][1]; van[2] = vn[1][0]; van[3] = vn[1][1]; } }
        for (int t = 0; t < nt; t += 2) {
            const bool last = (t == nt - 2);
            const char* a1 = cA + (size_t)(t + 1) * kstepA;
            const char* a2 = last ? nA : cA + (size_t)(t + 2) * kstepA; const char* b2 = last ? nB : cB + (size_t)(t + 2) * kstep;
            const char* a3 = a2 + kstepA; const char* b3 = b2 + kstep;
            if constexpr (SP2) {
            PG8_LDB(B0, 0, 0); PG8_LDB(B1, 0, 1); PG8_SCHED; PG8_LDA(At, 0, 0); PG8_STAGE(PG8_SA(1, 1), a1, vAc[1]);
            PG8_WAIT_V(8); PG8_WAIT_L(0); PG8_BAR; PG8_MMA2(0, At, B0, B1, 0, 0); PG8_BAR; PG8_SCHED;
            PG8_LDA(At, 0, 1); PG8_STAGE(PG8_SB(0, 0), b2, voffB); PG8_STAGE(PG8_SB(0, 1), b2 + hstepB, voffB); PG8_STAGE_SEL(PG8_SA(0, 0), a2, 0);
            PG8_WAIT_V(8); PG8_WAIT_L(0); PG8_BAR; PG8_MMA2(1, At, B0, B1, 0, 1); PG8_BAR; PG8_SCHED;
            PG8_LDB(B0, 1, 0); PG8_LDB(B1, 1, 1); PG8_SCHED; PG8_LDA(At, 1, 0); PG8_STAGE_SEL(PG8_SA(0, 1), a2, 1);
            PG8_WAIT_V(8); PG8_WAIT_L(0); PG8_BAR; PG8_MMA2(0, At, B0, B1, 1, 0); PG8_BAR; PG8_SCHED;
            PG8_LDA(At, 1, 1); PG8_STAGE(PG8_SB(1, 0), b3, voffB); PG8_STAGE(PG8_SB(1, 1), b3 + hstepB, voffB); PG8_STAGE_SEL(PG8_SA(1, 0), a3, 0);
            PG8_WAIT_V(8); PG8_WAIT_L(0); PG8_BAR; PG8_MMA2(1, At, B0, B1, 1, 1); PG8_BAR; PG8_SCHED;
            } else {
            PG8_LDB(B0, 0, 0); PG8_SCHED; PG8_LDA(At, 0, 0); PG8_STAGE(PG8_SA(1, 1), a1, vAc[1]);
            PG8_WAIT_L(8); PG8_BAR; PG8_WAIT_L(0); PG8_MMA(0, 0, At, B0); PG8_BAR; PG8_SCHED;
            PG8_LDB(B1, 0, 1); PG8_STAGE(PG8_SB(0, 0), b2, voffB);
            PG8_BAR; PG8_WAIT_L(0); PG8_MMA(0, 1, At, B1); PG8_BAR;
            PG8_LDA(At, 0, 1); PG8_STAGE_SEL(PG8_SA(0, 0), a2, 0);
            PG8_BAR; PG8_WAIT_L(0); PG8_MMA(1, 0, At, B0); PG8_BAR; PG8_SCHED;
            PG8_STAGE(PG8_SB(0, 1), b2 + hstepB, voffB);
            PG8_WAIT_V(6); PG8_BAR; PG8_MMA(1, 1, At, B1); PG8_BAR;
            PG8_LDB(B0, 1, 0); PG8_SCHED; PG8_LDA(At, 1, 0); PG8_STAGE_SEL(PG8_SA(0, 1), a2, 1);
            PG8_WAIT_L(8); PG8_BAR; PG8_WAIT_L(0); PG8_MMA(0, 0, At, B0); PG8_BAR; PG8_SCHED;
            PG8_LDB(B1, 1, 1); PG8_STAGE(PG8_SB(1, 0), b3, voffB);
            PG8_BAR; PG8_WAIT_L(0); PG8_MMA(0, 1, At, B1); PG8_BAR;
            PG8_LDA(At, 1, 1); PG8_STAGE_SEL(PG8_SA(1, 0), a3, 0);
            PG8_BAR; PG8_WAIT_L(0); PG8_MMA(1, 0, At, B0); PG8_BAR; PG8_SCHED;
            PG8_STAGE(PG8_SB(1, 1), b3 + hstepB, voffB);
            PG8_WAIT_V(6); PG8_BAR; PG8_MMA(1, 1, At, B1); PG8_BAR;
            }
        }
        if constexpr (ALIGN_EPI) { if (wr == 0) PG8_BAR; }
        E(acc, cur, wr, wc, fr, fq, has_next, nxt, pre);
        if (!has_next) break;
        E.init(acc, pre);
        cur = nxt; cA = nA; cB = nB; ++ui;
        if constexpr (Prob::GATHER) {
#pragma unroll
            for (int h = 0; h < 2; ++h)
#pragma unroll
                for (int i = 0; i < 2; ++i) vAc[h][i] = van[h * 2 + i];
        }
        if constexpr (ALIGN_EPI) { if (wr == 1) PG8_BAR; }
    }
    PG8_WAIT_V(0);
    if constexpr (!ALIGN_EPI) { if (wr == 0) PG8_BAR; }
    PG8_BAR;
#undef PG8_SA
#undef PG8_SB
#undef PG8_STAGE
#undef PG8_STAGE_SEL
#undef PG8_LDA
#undef PG8_LDB
#undef PG8_MMA
#undef PG8_WAIT_V
#undef PG8_WAIT_L
#undef PG8_BAR
#undef PG8_SCHED
}

template <bool F8_> struct ProbDenseT { static constexpr bool F8 = F8_; static constexpr bool GATHER = false; static constexpr int KT = 0;
    const bf16_t* A; const bf16_t* Bt; int K, nM, nN, G, c; bool headperm;
    __device__ __forceinline__ bool next(int i, Unit& u) const { return static_next(nM, nN, G, c, i, u); }
    __device__ __forceinline__ const char* a_base(const Unit& u) const { return (const char*)(A + (size_t)u.pm * BM * K); }
    __device__ __forceinline__ void a_voff(const Unit&, const int (&R)[2], const int (&C)[2], unsigned (&v)[2][2]) const {
#pragma unroll
        for (int h = 0; h < 2; ++h)
#pragma unroll
            for (int i = 0; i < 2; ++i) v[h][i] = (unsigned)((h * HALF + R[i]) * K + C[i]) * 2u;
    }
    __device__ __forceinline__ const char* b_base(const Unit& u) const { return (const char*)(Bt + (size_t)u.pn * BM * K); }
    __device__ __forceinline__ size_t a_kstep() const { return (size_t)BK * 2; }
    __device__ __forceinline__ size_t b_hstep() const { return headperm ? (size_t)32 * K * 2 : (size_t)HALF * K * 2; }
    __device__ __forceinline__ int b_row(int R) const { return headperm ? ((R >> 5) * 64 + perm32(R & 31)) : ((R & ~31) + perm32(R & 31)); }
};
typedef ProbDenseT<false> ProbDense; typedef ProbDenseT<true> ProbDense8;
typedef const PG8_LAS int* lds_ints;
__device__ __forceinline__ int expert_of(lds_ints ps, int pm) { int e = 0;
#pragma unroll
    for (int i = 1; i < 32; ++i) if (ps[i] <= pm * 256) e = i;
    return __builtin_amdgcn_readfirstlane(e); }
struct ProbMoe1 { static constexpr bool F8 = true; static constexpr bool GATHER = true; static constexpr int KT = 0;
    const bf16_t* XN; const bf16_t* W1T; const int* rowtok; lds_ints ps; int K, ntm, G, c;
    __device__ __forceinline__ bool next(int i, Unit& u) const {
        if (G != 256) { const int q = i * G + c; if (q >= ntm * 8) return false; u.pm = q >> 3; u.pn = q & 7; u.e = expert_of(ps, u.pm); return true; }
        const int x = c & 7, s = c >> 3, ifull = ntm >> 5; int pm;
        if (i < ifull) pm = 4 * (i * 8 + x) + (s >> 3);
        else if (i == ifull) { const int q = (ntm - 32 * ifull + 7) >> 3, lr = s >> 3; if (lr >= q) return false; pm = 32 * ifull + x * q + lr; }
        else return false;
        if (pm >= ntm) return false;
        u.pm = pm; u.pn = s & 7; u.e = expert_of(ps, u.pm); return true; }
    __device__ __forceinline__ const char* a_base(const Unit&) const { return (const char*)XN; }
    __device__ __forceinline__ void a_voff(const Unit& u, const int (&R)[2], const int (&C)[2], unsigned (&v)[2][2]) const {
#pragma unroll
        for (int h = 0; h < 2; ++h)
#pragma unroll
            for (int i = 0; i < 2; ++i) { int tk = rowtok[u.pm * BM + h * HALF + R[i]]; if (tk < 0) tk = T; v[h][i] = (unsigned)(tk * K + C[i]) * 2u; }
    }
    __device__ __forceinline__ const char* b_base(const Unit& u) const { return (const char*)(W1T + ((size_t)u.e * 2048 + u.pn * 128) * K); }
    __device__ __forceinline__ size_t a_kstep() const { return (size_t)BK * 2; }
    __device__ __forceinline__ size_t b_hstep() const { return (size_t)1024 * K * 2; }
    __device__ __forceinline__ int b_row(int R) const { return (R & ~31) + perm32(R & 31); }
};
struct ProbMoe2 { static constexpr bool F8 = true; static constexpr bool GATHER = false; static constexpr int KT = 0;
    const bf16_t* ACT; const bf16_t* W2T; lds_ints ps; int K, ntm, G, c;
    __device__ __forceinline__ bool next(int i, Unit& u) const {
        if (G != 256) { const int q = i * G + c; if (q >= ntm * 4) return false; u.pm = q >> 2; u.pn = q & 3; u.e = expert_of(ps, u.pm); return true; }
        const int x = c & 7, s = c >> 3, ifull = ntm >> 6; int pm;
        if (i < ifull) pm = 8 * (i * 8 + x) + (s >> 2);
        else if (i == ifull) { const int q = (ntm - 64 * ifull + 7) >> 3, lr = s >> 2; if (lr >= q) return false; pm = 64 * ifull + x * q + lr; }
        else return false;
        if (pm >= ntm) return false;
        u.pm = pm; u.pn = s & 3; u.e = expert_of(ps, u.pm); return true; }
    __device__ __forceinline__ const char* a_base(const Unit& u) const { return (const char*)(ACT + (size_t)u.pm * BM * K); }
    __device__ __forceinline__ void a_voff(const Unit&, const int (&R)[2], const int (&C)[2], unsigned (&v)[2][2]) const {
#pragma unroll
        for (int h = 0; h < 2; ++h)
#pragma unroll
            for (int i = 0; i < 2; ++i) v[h][i] = (unsigned)((h * HALF + R[i]) * K + C[i]) * 2u;
    }
    __device__ __forceinline__ const char* b_base(const Unit& u) const { return (const char*)(W2T + ((size_t)u.e * 1024 + u.pn * BM) * K); }
    __device__ __forceinline__ size_t a_kstep() const { return (size_t)BK * 2; }
    __device__ __forceinline__ size_t b_hstep() const { return (size_t)HALF * K * 2; }
    __device__ __forceinline__ int b_row(int R) const { return (R & ~31) + perm32(R & 31); }
};

struct ProbCmp { static constexpr bool F8 = false; static constexpr bool GATHER = false; static constexpr int KT = 8;
    const bf16_t* ZB; const bf16_t* W1T; int K, G, c;
    __device__ __forceinline__ bool next(int i, Unit& u) const { const int q = i * G + c; if (q >= 64) return false; u.pm = q & 15; u.pn = 0; u.e = q >> 4; return true; }
    __device__ __forceinline__ const char* a_base(const Unit& u) const { const int idx = u.pm >> 3, bg = (u.pm >> 1) & 3, half = u.pm & 1;
        return (const char*)(ZB + ((size_t)(bg >> 1) * S + 16 * 256 * half + 8 * u.e) * ZBW + ZB_KC + idx * 128 + (bg & 1) * 64); }
    __device__ __forceinline__ void a_voff(const Unit&, const int (&R)[2], const int (&C)[2], unsigned (&v)[2][2]) const {
#pragma unroll
        for (int h = 0; h < 2; ++h)
#pragma unroll
            for (int i = 0; i < 2; ++i) v[h][i] = (unsigned)(16 * (h * HALF + R[i]) * ZBW + C[i]) * 2u;
    }
    __device__ __forceinline__ size_t a_kstep() const { return (size_t)ZBW * 2; }
    __device__ __forceinline__ const char* b_base(const Unit& u) const { return (const char*)(W1T + (size_t)(u.pm >> 3) * 128 * K + 8 * 64 * u.e); }
    __device__ __forceinline__ size_t b_hstep() const { return 0; }
    __device__ __forceinline__ int b_row(int R) const { return (R & ~31) + perm32(R & 31); }
};
struct EpiCmp {
    float* HIDP;
    struct Pre {};
    __device__ __forceinline__ void prefetch(const Unit&, int, int, Pre&) const {}
    __device__ __forceinline__ void preload(const Unit&, int, int, Pre&) const {}
    __device__ __forceinline__ void init(f32x4 (&acc)[2][2][4][2], const Pre&) const {
#pragma unroll
        for (int a = 0; a < 2; ++a)
#pragma unroll
            for (int b = 0; b < 2; ++b)
#pragma unroll
                for (int m = 0; m < 4; ++m)
#pragma unroll
                    for (int n = 0; n < 2; ++n) acc[a][b][m][n] = (f32x4){0.f, 0.f, 0.f, 0.f};
    }
    __device__ __forceinline__ void operator()(const f32x4 (&acc)[2][2][4][2], const Unit& u, int wr, int wc, int fr, int fq, bool has_next, const Unit& nxt, Pre& pre) const {
        const int idx = u.pm >> 3, bg = (u.pm >> 1) & 3, half = u.pm & 1;
        const int c0 = 32 * wc + 8 * fq;
#pragma unroll
        for (int ai = 0; ai < 2; ++ai)
#pragma unroll
            for (int m = 0; m < 4; ++m) { const int n = 256 * half + ai * HALF + wr * 64 + m * 16 + fr;
                if (n < 511) { float* dst = HIDP + (((size_t)u.e * 2 + idx) * 2044 + bg * 511 + n) * 128 + c0;
                    *(f32x4*)dst = acc[ai][0][m][0]; *(f32x4*)(dst + 4) = acc[ai][0][m][1]; } }
    }
};
struct EpiG1F {
    bf16_t* ZB; float* GATE; const float* gq; const float* gk; const float* gmq; const float* gmk; bf16_t* KI; bf16_t* VI;
    struct Pre {};
    __device__ __forceinline__ void prefetch(const Unit&, int, int, Pre&) const {}
    __device__ __forceinline__ void preload(const Unit&, int, int, Pre&) const {}
    __device__ __forceinline__ void init(f32x4 (&acc)[2][2][4][2], const Pre&) const {
#pragma unroll
        for (int a = 0; a < 2; ++a)
#pragma unroll
            for (int b = 0; b < 2; ++b)
#pragma unroll
                for (int m = 0; m < 4; ++m)
#pragma unroll
                    for (int n = 0; n < 2; ++n) acc[a][b][m][n] = (f32x4){0.f, 0.f, 0.f, 0.f};
    }
    __device__ __forceinline__ void operator()(const f32x4 (&acc)[2][2][4][2], const Unit& u, int wr, int wc, int fr, int fq, bool has_next, const Unit& nxt, Pre& pre) const {
        const int pn = u.pn;
        const float* gain = nullptr; float sc = 1.f;
        if (pn < 2) { gain = gq; sc = QSCALE; }
        else if (pn == 3 || pn == 4) { if (wc < 2) gain = gk; }
        else if (pn == 5 || pn == 6) { gain = gmq; sc = QSCALE; }
        else if (pn == 7 || pn == 8) { gain = gmk; }
        if (pn == 11) {
            if (wc == 0 && fq < 3) {
#pragma unroll
                for (int ai = 0; ai < 2; ++ai)
#pragma unroll
                    for (int m = 0; m < 4; ++m) { const size_t r = (size_t)u.pm * BM + ai * HALF + wr * 64 + m * 16 + fr;
#pragma unroll
                        for (int n = 0; n < 2; ++n) { const f32x4 v = acc[ai][0][m][n]; f32x4 o;
#pragma unroll
                            for (int i = 0; i < 4; ++i) o[i] = __builtin_amdgcn_rcpf(1.f + __builtin_amdgcn_exp2f(-LOG2E * v[i]));
                            *(f32x4*)(GATE + r * 32 + 8 * fq + 4 * n) = o; } }
            }
            return;
        }
        int islot = -1; bool isv = false;
        if (pn == 3 || pn == 4) { isv = wc >= 2; islot = (pn == 4 ? 2 : 0) + (wc & 1); }
        else if (pn == 7 || pn == 8) { islot = 4 + (pn - 7) * 4 + wc; }
        else if (pn == 9 || pn == 10) { isv = true; islot = 4 + (pn - 9) * 4 + wc; }
        f32x4 gv[2][2];
#pragma unroll
        for (int bj = 0; bj < 2; ++bj)
#pragma unroll
            for (int n = 0; n < 2; ++n) gv[bj][n] = gain ? *(const f32x4*)(gain + 32 * bj + 8 * fq + 4 * n) * sc : (f32x4){1.f, 1.f, 1.f, 1.f};
#pragma unroll
        for (int ai = 0; ai < 2; ++ai)
#pragma unroll
            for (int m = 0; m < 4; ++m) { const size_t r = (size_t)u.pm * BM + ai * HALF + wr * 64 + m * 16 + fr;
                float rs = 1.f;
                if (gain) { float ss = 0.f;
#pragma unroll
                    for (int bj = 0; bj < 2; ++bj)
#pragma unroll
                        for (int n = 0; n < 2; ++n) { const f32x4 v = acc[ai][bj][m][n]; ss += (v[0] * v[0] + v[1] * v[1]) + (v[2] * v[2] + v[3] * v[3]); }
                    ss += __shfl_xor(ss, 16); ss += __shfl_xor(ss, 32);
                    rs = rsqrtf(ss * (1.f / 64.f) + EPS); }
#pragma unroll
                for (int bj = 0; bj < 2; ++bj) { const f32x4 a = acc[ai][bj][m][0] * gv[bj][0] * rs, b = acc[ai][bj][m][1] * gv[bj][1] * rs;
                    u32x4 w; w.x = cvt_pk_bf16(a[0], a[1]); w.y = cvt_pk_bf16(a[2], a[3]); w.z = cvt_pk_bf16(b[0], b[1]); w.w = cvt_pk_bf16(b[2], b[3]);
                    if (islot >= 0) {
                        const int bb = (int)(r / S), tt = (int)(r % S); bf16_t* tile = (isv ? VI : KI) + ((size_t)(bb * 12 + islot) * 128 + (tt >> 6)) * 4096;
                        *(u32x4*)(tile + (isv ? bj * 2048 + (tt & 63) * 32 + fq * 8 : (4 * bj + fq) * 512 + (tt & 63) * 8)) = w;
                    } else *(u32x4*)(ZB + r * ZBW + pn * BM + 64 * wc + 32 * bj + 8 * fq) = w; } }
    }
};
struct EpiG2 {
    const float* xin32; bf16_t* XAB; const float* g1; const float* dqo;
    struct Pre {};
    __device__ __forceinline__ void prefetch(const Unit&, int, int, Pre&) const {}
    __device__ __forceinline__ void preload(const Unit&, int, int, Pre&) const {}
    __device__ __forceinline__ void init(f32x4 (&acc)[2][2][4][2], const Pre&) const {
#pragma unroll
        for (int a = 0; a < 2; ++a)
#pragma unroll
            for (int b = 0; b < 2; ++b)
#pragma unroll
                for (int m = 0; m < 4; ++m)
#pragma unroll
                    for (int n = 0; n < 2; ++n) acc[a][b][m][n] = (f32x4){0.f, 0.f, 0.f, 0.f};
    }
    __device__ __forceinline__ void operator()(const f32x4 (&acc)[2][2][4][2], const Unit& u, int wr, int wc, int fr, int fq, bool has_next, const Unit& nxt, Pre& pre) const {
        { const int t_ = otid(); fr = t_ & 15; fq = (t_ >> 4) & 3; }
        const int b = (u.pm * BM) / S;
        f32x4 gg[2][2];
#pragma unroll
        for (int bj = 0; bj < 2; ++bj) { const int c = u.pn * BM + 128 * bj + 32 * wc + 8 * fq;
            gg[bj][0] = *(const f32x4*)(g1 + (size_t)b * 6144 + c) * (*(const f32x4*)(dqo + c) * (1.f / OS8)); gg[bj][1] = *(const f32x4*)(g1 + (size_t)b * 6144 + c + 4) * (*(const f32x4*)(dqo + c + 4) * (1.f / OS8)); }
#pragma unroll
        for (int ai = 0; ai < 2; ++ai)
#pragma unroll
            for (int m = 0; m < 4; ++m) { const size_t r = (size_t)u.pm * BM + ai * HALF + wr * 64 + m * 16 + fr;
#pragma unroll
                for (int bj = 0; bj < 2; ++bj) { const int c = u.pn * BM + 128 * bj + 32 * wc + 8 * fq;
                    f32x4 x0, x1;
                    if (xin32) { x0 = *(const f32x4*)(xin32 + r * D + c); x1 = *(const f32x4*)(xin32 + r * D + c + 4); }
                    else { const u32x4 q = *(const u32x4*)(XAB + r * D + c);
                        x0 = (f32x4){__builtin_bit_cast(float, q.x << 16), __builtin_bit_cast(float, q.x & 0xffff0000u), __builtin_bit_cast(float, q.y << 16), __builtin_bit_cast(float, q.y & 0xffff0000u)};
                        x1 = (f32x4){__builtin_bit_cast(float, q.z << 16), __builtin_bit_cast(float, q.z & 0xffff0000u), __builtin_bit_cast(float, q.w << 16), __builtin_bit_cast(float, q.w & 0xffff0000u)}; }
                    const f32x4 g0 = gg[bj][0], g1v = gg[bj][1];
                    const f32x4 y0 = x0 + g0 * acc[ai][bj][m][0], y1 = x1 + g1v * acc[ai][bj][m][1];
                    u32x4 o; o.x = cvt_pk_bf16(y0[0], y0[1]); o.y = cvt_pk_bf16(y0[2], y0[3]); o.z = cvt_pk_bf16(y1[0], y1[1]); o.w = cvt_pk_bf16(y1[2], y1[3]);
                    *(u32x4*)(XAB + r * D + c) = o; } }
    }
};
struct EpiM1 {
    unsigned char* ACT8; const float* b1l; const float* dq1l;
    struct Pre { f32x4 bg, bl, sg, sl; };
    __device__ __forceinline__ void prefetch(const Unit&, int, int, Pre&) const {}
    __device__ __forceinline__ void preload(const Unit& u, int wc, int fq, Pre& q) const {
        const int c0 = u.pn * 128 + 32 * wc + 8 * fq; const float* b1 = b1l + (size_t)u.e * 2048 + c0; const float* dq = dq1l + (size_t)u.e * 2048 + c0;
        q.bg = *(const f32x4*)(b1); q.bl = *(const f32x4*)(b1 + 1024); q.sg = *(const f32x4*)(dq); q.sl = *(const f32x4*)(dq + 1024); }
    __device__ __forceinline__ void init(f32x4 (&acc)[2][2][4][2], const Pre&) const {
#pragma unroll
        for (int a = 0; a < 2; ++a)
#pragma unroll
            for (int b = 0; b < 2; ++b)
#pragma unroll
                for (int m = 0; m < 4; ++m)
#pragma unroll
                    for (int n = 0; n < 2; ++n) acc[a][b][m][n] = (f32x4){0.f, 0.f, 0.f, 0.f};
    }
    __device__ __forceinline__ void operator()(const f32x4 (&acc)[2][2][4][2], const Unit& u, int wr, int wc, int fr, int fq, bool has_next, const Unit& nxt, Pre& pre) const {
        { const int t_ = otid(); fr = t_ & 15; fq = (t_ >> 4) & 3; }
        const int c0 = u.pn * 128 + 32 * wc + 8 * fq;
        const float* b1 = b1l + (size_t)u.e * 2048 + c0; const float* dq = dq1l + (size_t)u.e * 2048 + c0;
        unsigned w[2][4][2];
        const f32x4 bg1 = *(const f32x4*)(b1 + 4), bl1 = *(const f32x4*)(b1 + 1024 + 4), sg1 = *(const f32x4*)(dq + 4), sl1 = *(const f32x4*)(dq + 1024 + 4);
        typedef float f32x2 __attribute__((ext_vector_type(2)));
        const f32x2 cexp2 = {-1.702f * LOG2E, -1.702f * LOG2E}, one2 = {1.f, 1.f}, as2 = {AS8, AS8};
#pragma unroll
        for (int n = 0; n < 2; ++n) {
            const f32x4 bg = n ? bg1 : pre.bg, bl = n ? bl1 : pre.bl;
            const f32x4 sg = (n ? sg1 : pre.sg) * (1.f / XS8), sl = (n ? sl1 : pre.sl) * (1.f / XS8);
#pragma unroll
            for (int ai = 0; ai < 2; ++ai)
#pragma unroll
                for (int m = 0; m < 4; ++m) { const f32x4 ag = acc[ai][0][m][n], al = acc[ai][1][m][n]; f32x2 o2[2];
#pragma unroll
                    for (int h2 = 0; h2 < 2; ++h2) {
                        const f32x2 g = (f32x2){ag[2 * h2], ag[2 * h2 + 1]} * (f32x2){sg[2 * h2], sg[2 * h2 + 1]} + (f32x2){bg[2 * h2], bg[2 * h2 + 1]};
                        const f32x2 li = (f32x2){al[2 * h2], al[2 * h2 + 1]} * (f32x2){sl[2 * h2], sl[2 * h2 + 1]} + (f32x2){bl[2 * h2], bl[2 * h2 + 1]};
                        const f32x2 gc = {fminf(g[0], 7.f), fminf(g[1], 7.f)};
                        const f32x2 lc = {__builtin_amdgcn_fmed3f(li[0], -7.f, 7.f), __builtin_amdgcn_fmed3f(li[1], -7.f, 7.f)};
                        const f32x2 t = gc * cexp2;
                        const f32x2 d = (f32x2){__builtin_amdgcn_exp2f(t[0]), __builtin_amdgcn_exp2f(t[1])} + one2;
                        const f32x2 sgm = gc * (f32x2){__builtin_amdgcn_rcpf(d[0]), __builtin_amdgcn_rcpf(d[1])};
                        o2[h2] = (lc * as2 + as2) * sgm; }
                    int r_ = __builtin_amdgcn_cvt_pk_fp8_f32(o2[0][0], o2[0][1], 0, false); r_ = __builtin_amdgcn_cvt_pk_fp8_f32(o2[1][0], o2[1][1], r_, true);
                    w[ai][m][n] = (unsigned)r_; }
        }
#pragma unroll
        for (int ai = 0; ai < 2; ++ai)
#pragma unroll
            for (int m = 0; m < 4; ++m) { const size_t r = (size_t)u.pm * BM + ai * HALF + wr * 64 + m * 16 + fr;
                *(uint2*)(ACT8 + r * DFF + c0) = make_uint2(w[ai][m][0], w[ai][m][1]); }
    }
};
struct EpiM2 {
    bf16_t* Y; const float* b2l; const float* dq2l;
    struct Pre {};
    __device__ __forceinline__ void prefetch(const Unit&, int, int, Pre&) const {}
    __device__ __forceinline__ void preload(const Unit&, int, int, Pre&) const {}
    __device__ __forceinline__ void init(f32x4 (&acc)[2][2][4][2], const Pre&) const {
#pragma unroll
        for (int a = 0; a < 2; ++a)
#pragma unroll
            for (int b = 0; b < 2; ++b)
#pragma unroll
                for (int m = 0; m < 4; ++m)
#pragma unroll
                    for (int n = 0; n < 2; ++n) acc[a][b][m][n] = (f32x4){0.f, 0.f, 0.f, 0.f};
    }
    __device__ __forceinline__ void operator()(const f32x4 (&acc)[2][2][4][2], const Unit& u, int wr, int wc, int fr, int fq, bool has_next, const Unit& nxt, Pre& pre) const {
        { const int t_ = otid(); fr = t_ & 15; fq = (t_ >> 4) & 3; }
        const int cb = u.pn * BM + 32 * wc + 8 * fq;
        const float* b2 = b2l + (size_t)u.e * D + cb; const float* dq = dq2l + (size_t)u.e * D + cb;
#pragma unroll
        for (int bj = 0; bj < 2; ++bj) { const int c = cb + 128 * bj;
            const f32x4 b0 = *(const f32x4*)(b2 + 128 * bj), b1_ = *(const f32x4*)(b2 + 128 * bj + 4);
            const f32x4 s0 = *(const f32x4*)(dq + 128 * bj) * (1.f / AS8), s1 = *(const f32x4*)(dq + 128 * bj + 4) * (1.f / AS8);
#pragma unroll
            for (int ai = 0; ai < 2; ++ai)
#pragma unroll
                for (int m = 0; m < 4; ++m) { const size_t r = (size_t)u.pm * BM + ai * HALF + wr * 64 + m * 16 + fr;
                    const f32x4 v0 = acc[ai][bj][m][0] * s0 + b0, v1 = acc[ai][bj][m][1] * s1 + b1_;
                    *(uint2*)((unsigned char*)Y + r * D + c) = make_uint2(pk_fp8x4(v0[0] * YS8, v0[1] * YS8, v0[2] * YS8, v0[3] * YS8), pk_fp8x4(v1[0] * YS8, v1[1] * YS8, v1[2] * YS8, v1[3] * YS8)); }
        }
    }
};
}

__device__ __forceinline__ void phase_g1_fast(const Params& p, int l, unsigned char* lds_raw) {
    pg8::ProbDense P{(const bf16_t*)(p.ws + WS_XN), (const bf16_t*)(p.ws + WS_WINT) + (size_t)l * ZBW * D, D, T / 256, ZBW / 256, (int)gridDim.x, (int)blockIdx.x, true};
    pg8::EpiG1F E{(bf16_t*)(p.ws + WS_ZB), (float*)(p.ws + WS_GATE), p.in[7] + l * 64, p.in[8] + l * 64, p.in[12] + l * 64, p.in[13] + l * 64, (bf16_t*)(p.ws + WS_KI), (bf16_t*)(p.ws + WS_VI)};
    pg8::gemm_phase<pg8::ProbDense, pg8::EpiG1F, true, true>((PG8_LAS unsigned char*)lds_raw, P, E);
}
__device__ __forceinline__ void phase_g2_fast(const Params& p, int l, unsigned char* lds_raw) {
    pg8::ProbDense8 P{(const bf16_t*)(p.ws + WS_ATTB), (const bf16_t*)(p.ws + WS_WOT) + (size_t)l * D * 512, 512, T / 256, D / 256, (int)gridDim.x, (int)blockIdx.x, false};
    pg8::EpiG2 E{l == 0 ? p.in[0] : (const float*)nullptr, (bf16_t*)(p.ws + WS_XAB), (const float*)(p.ws + WS_MOD) + (size_t)l * Bn * 6144 + 2 * D, (const float*)(p.ws + WS_DQO) + (size_t)l * D};
    pg8::gemm_phase<pg8::ProbDense8, pg8::EpiG2, true, true>((PG8_LAS unsigned char*)lds_raw, P, E);
}
constexpr int LDS_PS_OFF = 131072;
__device__ __forceinline__ void phase_ck_fast(const Params& p, int l, unsigned char* lds_raw) {
    pg8::ProbCmp P{(const bf16_t*)(p.ws + WS_ZB), (const bf16_t*)(p.ws + WS_WCT) + (size_t)l * 2 * 128 * 2048, 2048, (int)gridDim.x, (int)blockIdx.x};
    pg8::EpiCmp E{(float*)(p.ws + WS_HIDP)};
    pg8::gemm_phase<pg8::ProbCmp, pg8::EpiCmp, true, true>((PG8_LAS unsigned char*)lds_raw, P, E);
    { const int tid = otid(), lane = tid & 63, wave = tid >> 6, r8 = lane >> 3, c8 = lane & 7;
      const bf16_t* Z = (const bf16_t*)(p.ws + WS_ZB); bf16_t* KMB = (bf16_t*)(p.ws + WS_KMB);
      float* part = (float*)(lds_raw + 131072 + 512);
      for (int it0 = blockIdx.x * 2; it0 < Bn * 8 * 32; it0 += gridDim.x * 2) {
          const int it = it0 + (wave >> 2), q = wave & 3;
          const int b = it / 256, h = (it / 32) & 7, blk = it & 31;
          const bf16_t* base = (const bf16_t*)(p.ws + WS_KI) + ((size_t)(b * 12 + 4 + h) * 128 + blk * 4 + q) * 4096 + c8 * 512 + r8 * 8;
          float s[8] = {0.f, 0.f, 0.f, 0.f, 0.f, 0.f, 0.f, 0.f};
          uint4 v[8];
#pragma unroll
          for (int i = 0; i < 8; ++i) v[i] = *(const uint4*)(base + 64 * i);
#pragma unroll
          for (int i = 0; i < 8; ++i) { const unsigned w[4] = {v[i].x, v[i].y, v[i].z, v[i].w};
#pragma unroll
              for (int e = 0; e < 4; ++e) { s[2 * e] += __builtin_bit_cast(float, w[e] << 16); s[2 * e + 1] += __builtin_bit_cast(float, w[e] & 0xffff0000u); } }
#pragma unroll
          for (int e = 0; e < 8; ++e) { s[e] += __shfl_xor(s[e], 8); s[e] += __shfl_xor(s[e], 16); s[e] += __shfl_xor(s[e], 32); }
          if (r8 == 0) {
#pragma unroll
              for (int e = 0; e < 8; ++e) part[wave * 64 + c8 * 8 + e] = s[e]; }
          __syncthreads();
          if (tid < 128) { const int item = tid >> 6, d = tid & 63; const float* pp = part + item * 256 + d;
              KMB[(size_t)(it0 + item) * 64 + d] = (bf16_t)f2bf((((pp[0] + pp[64]) + pp[128]) + pp[192]) * (1.f / 256.f)); }
          __syncthreads();
      } }
}
__device__ __forceinline__ void phase_m1_fast(const Params& p, int l, unsigned char* lds_raw) {
    int* ps = (int*)(lds_raw + LDS_PS_OFF);
    load_pstart(p, l, ps);
    pg8::ProbMoe1 P{(const bf16_t*)(p.ws + WS_XN8), (const bf16_t*)(p.ws + WS_W1T) + (size_t)l * NE * 2048 * 512, (const int*)(p.ws + WS_ROWTOK) + (size_t)l * RMAX, (pg8::lds_ints)ps, 512, ps[32] / 256, (int)gridDim.x, (int)blockIdx.x};
    pg8::EpiM1 E{p.ws + WS_ACT, p.in[18] + (size_t)l * NE * 2048, (const float*)(p.ws + WS_DQ1) + (size_t)l * NE * 2048};
    pg8::gemm_phase<pg8::ProbMoe1, pg8::EpiM1, true, true>((PG8_LAS unsigned char*)lds_raw, P, E);
    __syncthreads();
}
__device__ __forceinline__ void phase_m2_fast(const Params& p, int l, unsigned char* lds_raw) {
    int* ps = (int*)(lds_raw + LDS_PS_OFF);
    load_pstart(p, l, ps);
    pg8::ProbMoe2 P{(const bf16_t*)(p.ws + WS_ACT), (const bf16_t*)(p.ws + WS_W2T) + (size_t)l * NE * D * 512, (pg8::lds_ints)ps, 512, ps[32] / 256, (int)gridDim.x, (int)blockIdx.x};
    pg8::EpiM2 E{(bf16_t*)(p.ws + WS_Y), p.in[20] + (size_t)l * NE * D, (const float*)(p.ws + WS_DQ2) + (size_t)l * NE * D};
    pg8::gemm_phase<pg8::ProbMoe2, pg8::EpiM2, true, true>((PG8_LAS unsigned char*)lds_raw, P, E);
    __syncthreads();
}

namespace at {
#define AT_LAS __attribute__((address_space(3)))
typedef short bf16x8 __attribute__((ext_vector_type(8)));
typedef short s16x4 __attribute__((ext_vector_type(4)));
typedef short v4i16_t __attribute__((ext_vector_type(4)));
typedef float f32x16 __attribute__((ext_vector_type(16)));
typedef unsigned u32x4 __attribute__((ext_vector_type(4)));
typedef float f32x2_t __attribute__((ext_vector_type(2))); typedef __bf16 bf16x2_t __attribute__((ext_vector_type(2)));
typedef AT_LAS unsigned char* lp;
constexpr int L_K = 0  , L_V = 32768  , L_WSF = 65536, L_OST = 67584  , L_SELM = 133120, L_UNI = 134144, L_KMT = 134400, L_END = 142592;
constexpr float NEGS = -1e30f;
constexpr float MAXTHR = 12.f;
__device__ __forceinline__ int crow(int r, int hi) { return (r & 3) + 8 * (r >> 2) + 4 * hi; }
__device__ __forceinline__ unsigned cvtpk(float lo, float hi) { f32x2_t v = {lo, hi}; bf16x2_t b = __builtin_convertvector(v, bf16x2_t); return __builtin_bit_cast(unsigned, b); }
__device__ __forceinline__ float mx3(float a, float b, float c) { return __builtin_fmaxf(__builtin_fmaxf(a, b), c); }
__device__ __forceinline__ void wsync() { asm volatile("s_waitcnt lgkmcnt(0)" ::: "memory"); __builtin_amdgcn_wave_barrier(); }
__device__ __forceinline__ void bar() { __builtin_amdgcn_s_barrier(); }
#define AT_WAITV(n) asm volatile("s_waitcnt vmcnt(" #n ")" ::: "memory")
#define AT_WAITL() asm volatile("s_waitcnt lgkmcnt(0)" ::: "memory")
__device__ __forceinline__ void glds(const void* g, lp dst) { __builtin_amdgcn_global_load_lds((const unsigned*)g, (AT_LAS unsigned*)dst, 16, 0, 0); }
__device__ __forceinline__ s16x4 vtr(const AT_LAS unsigned char* p) { return __builtin_bit_cast(s16x4, __builtin_amdgcn_ds_read_tr16_b64_v4i16((AT_LAS v4i16_t*)p)); }

__device__ __forceinline__ const bf16_t* kimg(const Params& p, int b, int slot) { return (const bf16_t*)(p.ws + WS_KI) + (size_t)(b * 12 + slot) * 128 * 4096; }
__device__ __forceinline__ const bf16_t* vimg(const Params& p, int b, int slot) { return (const bf16_t*)(p.ws + WS_VI) + (size_t)(b * 12 + slot) * 128 * 4096; }
__device__ __forceinline__ void dma_k(lp slot, const bf16_t* kbase, int pitch, int key0, int wid, int lane) {
    if (pitch == 0) { glds(kbase + (size_t)(key0 >> 6) * 4096 + wid * 512 + lane * 8, slot + wid * 1024); return; }
    glds(kbase + (size_t)(key0 + lane) * pitch + wid * 8, slot + wid * 1024); }
__device__ __forceinline__ void dma_v(lp slot, const bf16_t* vbase, int pitch, int key0, int wid, int lane) {
    if (pitch == 0) { glds(vbase + (size_t)(key0 >> 6) * 4096 + wid * 512 + lane * 8, slot + wid * 1024); return; }
    glds(vbase + (size_t)(key0 + 16 * (wid & 3) + (lane >> 2)) * pitch + (wid >> 2) * 32 + (lane & 3) * 8, slot + wid * 1024); }

__device__ __forceinline__ void qk_tile(f32x16& p0, f32x16& p1, lp kslot, const bf16x8 (&qr)[4], int r32, int hi) {
    const AT_LAS unsigned char* kb = kslot + hi * 1024 + r32 * 16;
    bf16x8 b0[4], b1[4];
#pragma unroll
    for (int d0 = 0; d0 < 4; ++d0) { b0[d0] = *(const AT_LAS bf16x8*)(kb + d0 * 2048); b1[d0] = *(const AT_LAS bf16x8*)(kb + d0 * 2048 + 512); }
#pragma unroll
    for (int d0 = 0; d0 < 4; ++d0) {
        p0 = __builtin_amdgcn_mfma_f32_32x32x16_bf16(b0[d0], qr[d0], p0, 0, 0, 0);
        p1 = __builtin_amdgcn_mfma_f32_32x32x16_bf16(b1[d0], qr[d0], p1, 0, 0, 0);
    }
}
struct VFrag { bf16x8 f[8]; };
__device__ __forceinline__ void pv_load(VFrag& v, lp vslot, int lane, int hi) {
    const AT_LAS unsigned char* vp = vslot + ((lane >> 4) & 1) * 32 + (lane & 3) * 8 + (4 * hi + ((lane & 15) >> 2)) * 64;
#pragma unroll
    for (int d0 = 0; d0 < 2; ++d0)
#pragma unroll
        for (int ks = 0; ks < 4; ++ks) {
            const s16x4 lo = vtr(vp + d0 * 4096 + ks * 1024), hh = vtr(vp + d0 * 4096 + ks * 1024 + 512);
            v.f[d0 * 4 + ks] = (bf16x8){lo[0], lo[1], lo[2], lo[3], hh[0], hh[1], hh[2], hh[3]};
        }
}
__device__ __forceinline__ void pv_mfma(f32x16 (&o)[2], const VFrag& v, u32x4 pw0, u32x4 pw1, u32x4 pw2, u32x4 pw3) {
    const bf16x8 pa[4] = {__builtin_bit_cast(bf16x8, pw0), __builtin_bit_cast(bf16x8, pw1), __builtin_bit_cast(bf16x8, pw2), __builtin_bit_cast(bf16x8, pw3)};
#pragma unroll
    for (int ks = 0; ks < 4; ++ks) {
        o[0] = __builtin_amdgcn_mfma_f32_32x32x16_bf16(pa[ks], v.f[ks], o[0], 0, 0, 0);
        o[1] = __builtin_amdgcn_mfma_f32_32x32x16_bf16(pa[ks], v.f[4 + ks], o[1], 0, 0, 0);
    }
}
__device__ __forceinline__ float rowmax(const f32x16& p0, const f32x16& p1) {
    float a = mx3(p0[0], p0[1], p1[0]), b = mx3(p0[2], p0[3], p1[1]); a = mx3(a, p1[2], p1[3]);
#pragma unroll
    for (int r = 4; r < 16; r += 4) { a = mx3(a, p0[r], p0[r + 1]); b = mx3(b, p0[r + 2], p0[r + 3]); a = mx3(a, p1[r], p1[r + 1]); b = mx3(b, p1[r + 2], p1[r + 3]); }
    const float m = __builtin_fmaxf(a, b);
    auto rr = __builtin_amdgcn_permlane32_swap(__float_as_uint(m), __float_as_uint(m), false, false);
    return __builtin_fmaxf(__uint_as_float(rr[0]), __uint_as_float(rr[1]));
}
__device__ __forceinline__ float halfsum(float v) {
    auto rr = __builtin_amdgcn_permlane32_swap(__float_as_uint(v), __float_as_uint(v), false, false);
    return __uint_as_float(rr[0]) + __uint_as_float(rr[1]);
}
__device__ __forceinline__ void mask_tile(f32x16& p0, f32x16& p1, int lo, int hi_, int hi) {
    const int kb = 4 * hi;
#pragma unroll
    for (int r = 0; r < 16; ++r) { const int kv = kb + (r & 3) + 8 * (r >> 2); if (kv > hi_ || kv < lo) p0[r] = NEGS; if (kv + 32 > hi_ || kv + 32 < lo) p1[r] = NEGS; }
}

__device__ __forceinline__ void mask_init_lo(f32x16& p0, f32x16& p1, int lo, int hi) {
    const int kb = 4 * hi;
#pragma unroll
    for (int r = 0; r < 16; ++r) { const int kv = kb + (r & 3) + 8 * (r >> 2); if (kv < lo) p0[r] = NEGS; if (kv + 32 < lo) p1[r] = NEGS; }
}
__device__ __forceinline__ void mask_init(f32x16& p0, f32x16& p1, int hi_, int hi) {
    const int kb = 4 * hi;
#pragma unroll
    for (int r = 0; r < 16; ++r) { const int kv = kb + (r & 3) + 8 * (r >> 2); if (kv > hi_) p0[r] = NEGS; if (kv + 32 > hi_) p1[r] = NEGS; }
}
__device__ __forceinline__ int next_bit128(unsigned u0, unsigned u1, unsigned u2, unsigned u3, int below) {
    if (below > 96) { unsigned x = u3; if (below < 128) x &= (1u << (below - 96)) - 1u; if (x) return 96 + 31 - __builtin_clz(x); }
    if (below > 64) { unsigned x = u2; if (below < 96) x &= (1u << (below - 64)) - 1u; if (x) return 64 + 31 - __builtin_clz(x); }
    if (below > 32) { unsigned x = u1; if (below < 64) x &= (1u << (below - 32)) - 1u; if (x) return 32 + 31 - __builtin_clz(x); }
    if (below > 0) { unsigned x = u0; if (below < 32) x &= (1u << below) - 1u; if (x) return 31 - __builtin_clz(x); }
    return -1;
}
struct Soft { float m, l; };

template <bool HAS_O>
__device__ __forceinline__ void softmax_step(f32x16& p0, f32x16& p1, Soft& st, f32x16 (&o)[2], float* wsf, int r32, int hi) {
    const float rm = rowmax(p0, p1);
    if (__any(rm > MAXTHR)) {
        const float dl = __builtin_fmaxf(rm, 0.f); st.m += dl;
#pragma unroll
        for (int r = 0; r < 16; ++r) { p0[r] -= dl; p1[r] -= dl; }
        const float al = __builtin_amdgcn_exp2f(-dl); st.l *= al;
        if (HAS_O) {
            if (hi == 0) wsf[r32] = al;
            wsync();
#pragma unroll
            for (int r = 0; r < 16; ++r) { const float f = wsf[crow(r, hi)]; o[0][r] *= f; o[1][r] *= f; }
            wsync();
        }
    }
    float s = 0.f;
#pragma unroll
    for (int r = 0; r < 16; ++r) { p0[r] = __builtin_amdgcn_exp2f(p0[r]); p1[r] = __builtin_amdgcn_exp2f(p1[r]); s += p0[r] + p1[r]; }
    st.l += s;
}
#define AT_PACK(P0, P1) \
    const u32x4 pw0 = {cvtpk(P0[0], P0[1]), cvtpk(P0[2], P0[3]), cvtpk(P0[4], P0[5]), cvtpk(P0[6], P0[7])}, pw1 = {cvtpk(P0[8], P0[9]), cvtpk(P0[10], P0[11]), cvtpk(P0[12], P0[13]), cvtpk(P0[14], P0[15])}, \
                pw2 = {cvtpk(P1[0], P1[1]), cvtpk(P1[2], P1[3]), cvtpk(P1[4], P1[5]), cvtpk(P1[6], P1[7])}, pw3 = {cvtpk(P1[8], P1[9]), cvtpk(P1[10], P1[11]), cvtpk(P1[12], P1[13]), cvtpk(P1[14], P1[15])}
__device__ __forceinline__ float fma_vsv(float a, float k, float x) { float d; asm("v_fma_f32 %0, %1, %2, %3" : "=v"(d) : "v"(a), "s"(k), "v"(x)); return d; }
__device__ __forceinline__ f32x16 cinit(float c2k, int hi, float x) { f32x16 c; const float xb = __builtin_fmaf(c2k, (float)(4 * hi), x);
    c[0] = xb;
#pragma unroll
    for (int r = 1; r < 16; ++r) c[r] = fma_vsv(c2k, (float)((r & 3) + 8 * (r >> 2)), xb);
    return c; }
template <bool FIRST>
__device__ __forceinline__ void acc_scaled(float* stage, const f32x16 (&o)[2], float f, float* wsf, int r32, int hi) {
    if (hi == 0) wsf[r32] = f;
    wsync();
#pragma unroll
    for (int r = 0; r < 16; ++r) { const int orow = crow(r, hi); const float g = wsf[orow]; float* s0 = stage + orow * 64 + r32;
        if (FIRST) { s0[0] = o[0][r] * g; s0[32] = o[1][r] * g; } else { s0[0] += o[0][r] * g; s0[32] += o[1][r] * g; } }
    wsync();
}

#define AT_WAIT_NEWER(newer, per) do { if ((newer) >= 2) { if ((per) == 2) AT_WAITV(4); else AT_WAITV(2); } else if ((newer) == 1) { if ((per) == 2) AT_WAITV(2); else AT_WAITV(1); } else AT_WAITV(0); } while (0)


#define AT_SB() __builtin_amdgcn_sched_barrier(0)
struct PipeOut { float s, rmn; };
__device__ __forceinline__ PipeOut pipe_step(f32x16& c0, f32x16& c1, f32x16& n0, f32x16& n1, f32x16 (&o)[2], lp kslot_next, lp vslot, const bf16x8 (&qr)[4], int lane, int r32, int hi) {
    const AT_LAS unsigned char* kb = kslot_next + hi * 1024 + r32 * 16;
    const AT_LAS unsigned char* vp = vslot + ((lane >> 4) & 1) * 32 + (lane & 3) * 8 + (4 * hi + ((lane & 15) >> 2)) * 64;
    bf16x8 kf[8];
#pragma unroll
    for (int j = 0; j < 4; ++j) kf[j] = *(const AT_LAS bf16x8*)(kb + (j >> 1) * 2048 + (j & 1) * 512);
    AT_SB();
    unsigned w0[8], w1[8]; s16x4 vl[8], vh[8]; float s = 0.f;
#pragma unroll
    for (int j = 0; j < 8; ++j) {
        if (j & 1) n1 = __builtin_amdgcn_mfma_f32_32x32x16_bf16(kf[j], qr[j >> 1], n1, 0, 0, 0);
        else       n0 = __builtin_amdgcn_mfma_f32_32x32x16_bf16(kf[j], qr[j >> 1], n0, 0, 0, 0);
        if (j < 4) kf[j + 4] = *(const AT_LAS bf16x8*)(kb + ((j + 4) >> 1) * 2048 + (j & 1) * 512);
        if (j >= 4) {
#pragma unroll
            for (int q = 0; q < 2; ++q) { const int f = (j - 4) * 2 + q, d0 = f >> 2, ks = f & 3; vl[f] = vtr(vp + d0 * 4096 + ks * 1024); vh[f] = vtr(vp + d0 * 4096 + ks * 1024 + 512); }
        }
        const float e0 = __builtin_amdgcn_exp2f(c0[2 * j]), e1 = __builtin_amdgcn_exp2f(c0[2 * j + 1]), e2 = __builtin_amdgcn_exp2f(c1[2 * j]), e3 = __builtin_amdgcn_exp2f(c1[2 * j + 1]);
        s += (e0 + e1) + (e2 + e3);
        asm volatile("" : "+v"(s));
        w0[j] = cvtpk(e0, e1); w1[j] = cvtpk(e2, e3);
        AT_SB();
    }
    const u32x4 pw0 = {w0[0], w0[1], w0[2], w0[3]}, pw1 = {w0[4], w0[5], w0[6], w0[7]}, pw2 = {w1[0], w1[1], w1[2], w1[3]}, pw3 = {w1[4], w1[5], w1[6], w1[7]};
    const bf16x8 pa[4] = {__builtin_bit_cast(bf16x8, pw0), __builtin_bit_cast(bf16x8, pw1), __builtin_bit_cast(bf16x8, pw2), __builtin_bit_cast(bf16x8, pw3)};
    float a = mx3(n0[0], n0[1], n1[0]), b = mx3(n0[2], n0[3], n1[1]);
#pragma unroll
    for (int f = 0; f < 8; ++f) {
        const int d0 = f >> 2, ks = f & 3;
        const bf16x8 vf = (bf16x8){vl[f][0], vl[f][1], vl[f][2], vl[f][3], vh[f][0], vh[f][1], vh[f][2], vh[f][3]};
        o[d0] = __builtin_amdgcn_mfma_f32_32x32x16_bf16(pa[ks], vf, o[d0], 0, 0, 0);
        if (f == 0) { a = mx3(a, n1[2], n1[3]); }
        else if (f < 4) { const int r = 4 * f; a = mx3(a, n0[r], n0[r + 1]); b = mx3(b, n0[r + 2], n0[r + 3]); a = mx3(a, n1[r], n1[r + 1]); b = mx3(b, n1[r + 2], n1[r + 3]); }
        asm volatile("" : "+v"(a), "+v"(b));
        AT_SB();
    }
    const float m = __builtin_fmaxf(a, b);
    auto rr = __builtin_amdgcn_permlane32_swap(__float_as_uint(m), __float_as_uint(m), false, false);
    PipeOut out; out.s = s; out.rmn = __builtin_fmaxf(__uint_as_float(rr[0]), __uint_as_float(rr[1]));
    return out;
}
__device__ __forceinline__ void nsa_unit(const Params& p, int b, int g, int c, unsigned char* lds_raw) {
    const int tid = otid(), lane = tid & 63, r32 = lane & 31, hi = lane >> 5, wid = __builtin_amdgcn_readfirstlane(tid >> 6);
    lp lds = (lp)lds_raw;
    const bf16_t* ZB = (const bf16_t*)(p.ws + WS_ZB); const float* GT = (const float*)(p.ws + WS_GATE);
    const bf16_t* KCB = (const bf16_t*)(p.ws + WS_KCB) + (size_t)(b * 2 + g) * 512 * 64; const bf16_t* VCB = (const bf16_t*)(p.ws + WS_VCB) + (size_t)(b * 2 + g) * 512 * 64;
    const int t0 = c * 64, hg = r32 >> 3, qq = r32 & 7, qi = 8 * wid + qq, t = t0 + qi, h = 4 * g + hg; const size_t tt = (size_t)b * S + t;
    float* wsf = (float*)(lds_raw + L_WSF) + wid * 64;
    float* ostage = (float*)(lds_raw + L_OST) + wid * 2048;
    float* imp = ostage;
    unsigned* selm = (unsigned*)(lds_raw + L_SELM);
    unsigned* uni = (unsigned*)(lds_raw + L_UNI);
    const float c2 = exp2f(-(float)(h + 1)) * LOG2E;
    bf16x8 qr[4];
#pragma unroll
    for (int d0 = 0; d0 < 4; ++d0) qr[d0] = *(const bf16x8*)(ZB + tt * ZBW + ZB_Q + h * 64 + d0 * 16 + hi * 8);
    const float gt0 = GT[tt * 32 + h * 3 + 0], gt1 = GT[tt * 32 + h * 3 + 1], gt2 = GT[tt * 32 + h * 3 + 2];
    f32x16 o[2];
    const lp sK0 = lds + L_K, sV0 = lds + L_V;
    const int nmax = t >= 31 ? (t - 31) >> 4 : -1;
    const int ntc = ((4 * c + 2) >> 6) + 1;
    for (int i = lane; i < 8 * 129; i += 64) imp[i] = 0.f;
    Soft sc; sc.m = 0.f; sc.l = 0.f;
#pragma unroll
    for (int k = 0; k < 3; ++k) if (k < ntc) dma_k(sK0 + k * 8192, KCB, 64, 64 * k, wid, lane);
    for (int k = 0; k < ntc; ++k) {
        const int newer = ntc - 1 - k; AT_WAIT_NEWER(newer, 1);
        AT_WAITL(); bar();
        if (k + 3 < ntc) dma_k(sK0 + ((k + 3) & 3) * 8192, KCB, 64, 64 * (k + 3), wid, lane);
        const lp sK = sK0 + (k & 3) * 8192;
        const float x0 = c2 * (16.f * (64 * k) + 15.5f - (float)t0) - sc.m;
        f32x16 p0 = cinit(16.f * c2, hi, x0), p1 = cinit(16.f * c2, hi, x0 + c2 * 512.f);
        qk_tile(p0, p1, sK, qr, r32, hi);
        if (__any(nmax - 64 * k < 63)) mask_tile(p0, p1, 0, nmax - 64 * k, hi);
        softmax_step<false>(p0, p1, sc, o, wsf, r32, hi);
    }
    const float lc = halfsum(sc.l), linv = lc > 0.f ? 1.f / lc : 0.f;
    o[0] = f32x16{}; o[1] = f32x16{};
    AT_WAITL(); bar();
#pragma unroll
    for (int k = 0; k < 3; ++k) if (k < ntc) { dma_k(sK0 + k * 8192, KCB, 64, 64 * k, wid, lane); dma_v(sV0 + k * 8192, VCB, 64, 64 * k, wid, lane); }
    for (int k = 0; k < ntc; ++k) {
        const int newer = ntc - 1 - k; AT_WAIT_NEWER(newer, 2);
        AT_WAITL(); bar();
        if (k + 3 < ntc) { dma_k(sK0 + ((k + 3) & 3) * 8192, KCB, 64, 64 * (k + 3), wid, lane); dma_v(sV0 + ((k + 3) & 3) * 8192, VCB, 64, 64 * (k + 3), wid, lane); }
        const lp sK = sK0 + (k & 3) * 8192, sV = sV0 + (k & 3) * 8192;
        const float x0 = c2 * (16.f * (64 * k) + 15.5f - (float)t0) - sc.m;
        f32x16 p0 = cinit(16.f * c2, hi, x0), p1 = cinit(16.f * c2, hi, x0 + c2 * 512.f);
        qk_tile(p0, p1, sK, qr, r32, hi);
        if (__any(nmax - 64 * k < 63)) mask_tile(p0, p1, 0, nmax - 64 * k, hi);
        VFrag vf; pv_load(vf, sV, lane, hi);
#pragma unroll
        for (int r = 0; r < 16; ++r) { p0[r] = __builtin_amdgcn_exp2f(p0[r]); p1[r] = __builtin_amdgcn_exp2f(p1[r]); }
        { AT_PACK(p0, p1); pv_mfma(o, vf, pw0, pw1, pw2, pw3); }
        float gs[8], ls[8];
#pragma unroll
        for (int q4 = 0; q4 < 4; ++q4) { gs[q4] = ((p0[4 * q4] + p0[4 * q4 + 1]) + (p0[4 * q4 + 2] + p0[4 * q4 + 3])) * linv; ls[q4] = p0[4 * q4 + 3] * linv;
                                         gs[4 + q4] = ((p1[4 * q4] + p1[4 * q4 + 1]) + (p1[4 * q4 + 2] + p1[4 * q4 + 3])) * linv; ls[4 + q4] = p1[4 * q4 + 3] * linv; }
#pragma unroll
        for (int q4 = 0; q4 < 8; ++q4) { gs[q4] += __shfl_xor(gs[q4], 8); gs[q4] += __shfl_xor(gs[q4], 16); ls[q4] += __shfl_xor(ls[q4], 8); ls[q4] += __shfl_xor(ls[q4], 16); }
        if (r32 < 8) {
            float* row = imp + qq * 129 + 16 * k + hi;
#pragma unroll
            for (int q4 = 0; q4 < 8; ++q4) row[2 * q4] += gs[q4];
        }
        wsync();
        if (r32 < 8) {
            float* row = imp + qq * 129 + 16 * k + hi + 1;
#pragma unroll
            for (int q4 = 0; q4 < 8; ++q4) row[2 * q4] += ls[q4];
        }
        wsync();
    }
    unsigned mk0 = 0u, mk1 = 0u, mk2 = 0u, mk3 = 0u;
    {
        const int qs = lane >> 3, part = lane & 7;
        unsigned k[16];
#pragma unroll
        for (int i = 0; i < 16; ++i) { const int j = part * 16 + i; float x = imp[qs * 129 + j]; if (j == 0 || j == c || j == c - 1) x = 1e4f;
            const unsigned key = ((__builtin_bit_cast(unsigned, x) & 0xffffff80u) | (unsigned)(127 - j)) + 1u; k[i] = j > c ? 0u : key; }
#define CE(a, b) do { const unsigned hi_ = k[a] > k[b] ? k[a] : k[b], lo_ = k[a] > k[b] ? k[b] : k[a]; k[a] = hi_; k[b] = lo_; } while (0)
        CE(0,1); CE(2,3); CE(0,2); CE(1,3); CE(1,2); CE(4,5); CE(6,7); CE(4,6); CE(5,7); CE(5,6); CE(0,4); CE(2,6); CE(2,4); CE(1,5); CE(3,7); CE(3,5); CE(1,2); CE(3,4); CE(5,6); CE(8,9); CE(10,11); CE(8,10); CE(9,11); CE(9,10); CE(12,13); CE(14,15); CE(12,14); CE(13,15); CE(13,14); CE(8,12); CE(10,14); CE(10,12); CE(9,13); CE(11,15); CE(11,13); CE(9,10); CE(11,12); CE(13,14); CE(0,8); CE(4,12); CE(4,8); CE(2,10); CE(6,14); CE(6,10); CE(2,4); CE(6,8); CE(10,12); CE(1,9); CE(5,13); CE(5,9); CE(3,11); CE(7,15); CE(7,11); CE(3,5); CE(7,9); CE(11,13); CE(1,2); CE(3,4); CE(5,6); CE(7,8); CE(9,10); CE(11,12); CE(13,14);
#undef CE
#pragma unroll 1
        for (int it = 0; it < 16; ++it) {
            unsigned bk = k[0];
#pragma unroll
            for (int sft = 1; sft < 8; sft <<= 1) { const unsigned ok = (unsigned)__shfl_xor((int)bk, sft); bk = ok > bk ? ok : bk; }
            if (bk != 0u) { const int bi = 127 - (int)((bk - 1u) & 127u); const unsigned bit = 1u << (bi & 31); const int wq = bi >> 5; if (wq == 0) mk0 |= bit; else if (wq == 1) mk1 |= bit; else if (wq == 2) mk2 |= bit; else mk3 |= bit; }
            const bool win = k[0] == bk;
#pragma unroll
            for (int i = 0; i < 15; ++i) k[i] = win ? k[i + 1] : k[i];
            k[15] = win ? 0u : k[15];
        }
        if (part == 0) { unsigned* sm = selm + (8 * wid + qs) * 4; sm[0] = mk0; sm[1] = mk1; sm[2] = mk2; sm[3] = mk3; }
        unsigned u0 = mk0, u1 = mk1, u2 = mk2, u3 = mk3;
#pragma unroll
        for (int sft = 8; sft < 64; sft <<= 1) { u0 |= __shfl_xor(u0, sft); u1 |= __shfl_xor(u1, sft); u2 |= __shfl_xor(u2, sft); u3 |= __shfl_xor(u3, sft); }
        if (lane == 0) { uni[wid * 4 + 0] = u0; uni[wid * 4 + 1] = u1; uni[wid * 4 + 2] = u2; uni[wid * 4 + 3] = u3; }
    }
    wsync();
    acc_scaled<true>(ostage, o, gt0 * linv, wsf, r32, hi);
    AT_WAITL(); bar();
    unsigned un0 = 0u, un1 = 0u, un2 = 0u, un3 = 0u;
#pragma unroll
    for (int w = 0; w < 8; ++w) { un0 |= uni[w * 4 + 0]; un1 |= uni[w * 4 + 1]; un2 |= uni[w * 4 + 2]; un3 |= uni[w * 4 + 3]; }
    un0 = __builtin_amdgcn_readfirstlane(un0); un1 = __builtin_amdgcn_readfirstlane(un1); un2 = __builtin_amdgcn_readfirstlane(un2); un3 = __builtin_amdgcn_readfirstlane(un3);
    const unsigned my0 = selm[(8 * wid + qq) * 4 + 0], my1 = selm[(8 * wid + qq) * 4 + 1], my2 = selm[(8 * wid + qq) * 4 + 2], my3 = selm[(8 * wid + qq) * 4 + 3];
    {
        const bf16_t* KS = kimg(p, b, g); const bf16_t* VS = vimg(p, b, g);
        Soft ss; ss.m = 0.f; ss.l = 0.f; o[0] = f32x16{}; o[1] = f32x16{};
        const int nsel = __builtin_popcount(un0) + __builtin_popcount(un1) + __builtin_popcount(un2) + __builtin_popcount(un3);
        int ji = 128;
#pragma unroll
        for (int k = 0; k < 3; ++k) if (k < nsel) { ji = next_bit128(un0, un1, un2, un3, ji); dma_k(sK0 + k * 8192, KS, 0, 64 * ji, wid, lane); dma_v(sV0 + k * 8192, VS, 0, 64 * ji, wid, lane); }
        int j = 128;
        for (int i = 0; i < nsel; ++i) {
            j = next_bit128(un0, un1, un2, un3, j);
            const int newer = nsel - 1 - i; AT_WAIT_NEWER(newer, 2);
            AT_WAITL(); bar();
            if (i + 3 < nsel) { ji = next_bit128(un0, un1, un2, un3, ji); dma_k(sK0 + ((i + 3) & 3) * 8192, KS, 0, 64 * ji, wid, lane); dma_v(sV0 + ((i + 3) & 3) * 8192, VS, 0, 64 * ji, wid, lane); }
            const lp sK = sK0 + (i & 3) * 8192, sV = sV0 + (i & 3) * 8192;
            const unsigned mw = (j >> 5) == 0 ? my0 : (j >> 5) == 1 ? my1 : (j >> 5) == 2 ? my2 : my3;
            const bool sel = (mw >> (j & 31)) & 1u;
            const float x0 = sel ? c2 * (float)(64 * j - t0) - ss.m : NEGS;
            f32x16 p0 = cinit(c2, hi, x0), p1 = cinit(c2, hi, sel ? x0 + c2 * 32.f : NEGS);
            qk_tile(p0, p1, sK, qr, r32, hi);
            if (j == c) mask_tile(p0, p1, 0, qi, hi);
            VFrag vf; pv_load(vf, sV, lane, hi);
            softmax_step<true>(p0, p1, ss, o, wsf, r32, hi);
            { AT_PACK(p0, p1); pv_mfma(o, vf, pw0, pw1, pw2, pw3); }
        }
        const float ls_ = halfsum(ss.l);
        acc_scaled<false>(ostage, o, ls_ > 0.f ? gt1 / ls_ : 0.f, wsf, r32, hi);
    }
    {
        const bf16_t* KW = kimg(p, b, 2 + g); const bf16_t* VW = vimg(p, b, 2 + g);
        Soft sw; sw.m = 0.f; sw.l = 0.f; o[0] = f32x16{}; o[1] = f32x16{};
        const int k0 = c >= 8 ? 0 : 8 - c, nw = 9 - k0;
        AT_WAITL(); bar();
#pragma unroll
        for (int k = 0; k < 3; ++k) if (k < nw) { dma_k(sK0 + k * 8192, KW, 0, t0 - 64 * k, wid, lane); dma_v(sV0 + k * 8192, VW, 0, t0 - 64 * k, wid, lane); }
        f32x16 pA0, pA1, pB0, pB1; float rmc;
#define WIN_STEP(C0, C1, N0, N1, I) do { const int i_ = (I); \
            if (i_ + 1 < nw) { if (i_ + 2 < nw) AT_WAITV(2); else AT_WAITV(0); } \
            AT_WAITL(); bar(); \
            if (i_ + 3 < nw) { dma_k(sK0 + ((i_ + 3) & 3) * 8192, KW, 0, t0 - 64 * (i_ + 3), wid, lane); dma_v(sV0 + ((i_ + 3) & 3) * 8192, VW, 0, t0 - 64 * (i_ + 3), wid, lane); } \
            if (__any(rmc > MAXTHR)) { \
                const float dl = __builtin_fmaxf(rmc, 0.f); sw.m += dl; \
                _Pragma("unroll") for (int r = 0; r < 16; ++r) { C0[r] -= dl; C1[r] -= dl; } \
                const float al = __builtin_amdgcn_exp2f(-dl); sw.l *= al; \
                if (hi == 0) wsf[r32] = al; \
                wsync(); \
                _Pragma("unroll") for (int r = 0; r < 16; ++r) { const float f = wsf[crow(r, hi)]; o[0][r] *= f; o[1][r] *= f; } \
                wsync(); \
            } \
            { const float x0 = c2 * (float)(-64 * (i_ + 1)) - sw.m; \
              N0 = cinit(c2, hi, x0); N1 = cinit(c2, hi, x0 + c2 * 32.f); \
              if (i_ + 1 == 8) mask_init_lo(N0, N1, qi + 1, hi); }        \
            const PipeOut po = pipe_step(C0, C1, N0, N1, o, sK0 + ((i_ + 1) & 3) * 8192, sV0 + (i_ & 3) * 8192, qr, lane, r32, hi); \
            sw.l += po.s; rmc = po.rmn; } while (0)
        { if (nw >= 3) AT_WAITV(4); else if (nw == 2) AT_WAITV(2); else AT_WAITV(0);
          AT_WAITL(); bar(); }
        { pB0 = cinit(c2, hi, 0.f); pB1 = cinit(c2, hi, c2 * 32.f);
          qk_tile(pB0, pB1, sK0, qr, r32, hi);
          mask_tile(pB0, pB1, 0, qi, hi);
          rmc = rowmax(pB0, pB1); }
        int i = 0;
#pragma unroll 1
        for (; i + 1 < nw; i += 2) {
            WIN_STEP(pB0, pB1, pA0, pA1, i);
            WIN_STEP(pA0, pA1, pB0, pB1, i + 1);
        }
        if (i < nw) WIN_STEP(pB0, pB1, pA0, pA1, i);
#undef WIN_STEP
        const float lw = halfsum(sw.l);
        acc_scaled<false>(ostage, o, lw > 0.f ? gt2 / lw : 0.f, wsf, r32, hi);
    }
    {
        unsigned char* AB = p.ws + WS_ATTB;
#pragma unroll
        for (int i = 0; i < 4; ++i) { const int row = i * 8 + (lane >> 3), ch = lane & 7; const float4 a = *(const float4*)(ostage + row * 64 + ch * 8), c4 = *(const float4*)(ostage + row * 64 + ch * 8 + 4);
            const uint2 v = make_uint2(pk_fp8x4(OS8 * a.x, OS8 * a.y, OS8 * a.z, OS8 * a.w), pk_fp8x4(OS8 * c4.x, OS8 * c4.y, OS8 * c4.z, OS8 * c4.w));
            *(uint2*)(AB + ((size_t)b * S + t0 + 8 * wid + (row & 7)) * D + (4 * g + (row >> 3)) * 64 + ch * 8) = v; }
        wsync();
    }
    AT_WAITL(); bar();
}

}

constexpr int MB_CAP = 25600;
namespace at {
__device__ __forceinline__ void moba_route_unit(const Params& p, int b, int h, int qb, unsigned char* lds_raw) {
    const int tid = otid(), lane = tid & 63, r32 = lane & 31, hi = lane >> 5, wid = __builtin_amdgcn_readfirstlane(tid >> 6);
    lp lds = (lp)lds_raw;
    const bf16_t* ZB = (const bf16_t*)(p.ws + WS_ZB);
    const int bh = b * 8 + h;
    const bf16_t* KMB = (const bf16_t*)(p.ws + WS_KMB) + (size_t)bh * 32 * 64;
    const int qi = 32 * wid + r32, t = qb * 256 + qi; const size_t tt = (size_t)b * S + t;
    int* hist = (int*)(lds_raw + L_UNI);
    unsigned* SEL3 = (unsigned*)(p.ws + WS_SEL3); unsigned* LRK = (unsigned*)(p.ws + WS_LRK);
    unsigned char* IL = (unsigned char*)(p.ws + WS_ILIST) + ((size_t)(bh * 32 + qb) * 32) * 256;
    int* BCm = (int*)(p.ws + WS_BCM) + (size_t)(bh * 32 + qb) * 32;
    if (tid < 32) hist[tid] = 0;
    bf16x8 qr[4];
#pragma unroll
    for (int d0 = 0; d0 < 4; ++d0) qr[d0] = *(const bf16x8*)(ZB + tt * ZBW + ZB_MQ + h * 64 + d0 * 16 + hi * 8);
    const lp sKM = lds + L_KMT;
    glds(KMB + (size_t)(lane & 31) * 64 + wid * 8, sKM + wid * 1024);
    AT_WAITV(0); AT_WAITL(); bar();
    f32x16 g0 = f32x16{}, g1 = f32x16{};
    qk_tile(g0, g1, sKM, qr, r32, hi);
    float v1 = NEGS, v2 = NEGS, v3 = NEGS; int i1 = 64, i2 = 64, i3 = 64;
#pragma unroll
    for (int r = 0; r < 16; ++r) { const int n = crow(r, hi); const float s_ = n < qb ? g0[r] : NEGS;
        if (s_ > v1) { v3 = v2; i3 = i2; v2 = v1; i2 = i1; v1 = s_; i1 = n; } else if (s_ > v2) { v3 = v2; i3 = i2; v2 = s_; i2 = n; } else if (s_ > v3) { v3 = s_; i3 = n; } }
    float ov[3]; int oi[3];
    { auto a = __builtin_amdgcn_permlane32_swap(__float_as_uint(v1), __float_as_uint(v1), false, false); ov[0] = __uint_as_float(hi ? a[0] : a[1]); }
    { auto a = __builtin_amdgcn_permlane32_swap(__float_as_uint(v2), __float_as_uint(v2), false, false); ov[1] = __uint_as_float(hi ? a[0] : a[1]); }
    { auto a = __builtin_amdgcn_permlane32_swap(__float_as_uint(v3), __float_as_uint(v3), false, false); ov[2] = __uint_as_float(hi ? a[0] : a[1]); }
    { auto a = __builtin_amdgcn_permlane32_swap((unsigned)i1, (unsigned)i1, false, false); oi[0] = (int)(hi ? a[0] : a[1]); }
    { auto a = __builtin_amdgcn_permlane32_swap((unsigned)i2, (unsigned)i2, false, false); oi[1] = (int)(hi ? a[0] : a[1]); }
    { auto a = __builtin_amdgcn_permlane32_swap((unsigned)i3, (unsigned)i3, false, false); oi[2] = (int)(hi ? a[0] : a[1]); }
#pragma unroll
    for (int k = 0; k < 3; ++k) { const float s_ = ov[k]; const int n = oi[k];
        if (s_ > v1 || (s_ == v1 && n < i1)) { v3 = v2; i3 = i2; v2 = v1; i2 = i1; v1 = s_; i1 = n; }
        else if (s_ > v2 || (s_ == v2 && n < i2)) { v3 = v2; i3 = i2; v2 = s_; i2 = n; }
        else if (s_ > v3 || (s_ == v3 && n < i3)) { v3 = s_; i3 = n; } }
    if (hi == 0) {
        const int j1 = v1 > NEGS ? i1 : 255, j2 = v2 > NEGS ? i2 : 255, j3 = v3 > NEGS ? i3 : 255;
        int l1 = 0, l2 = 0, l3 = 0;
        if (j1 < 32) { l1 = atomicAdd(&hist[j1], 1); IL[j1 * 256 + l1] = (unsigned char)qi; }
        if (j2 < 32) { l2 = atomicAdd(&hist[j2], 1); IL[j2 * 256 + l2] = (unsigned char)qi; }
        if (j3 < 32) { l3 = atomicAdd(&hist[j3], 1); IL[j3 * 256 + l3] = (unsigned char)qi; }
        SEL3[tt * 8 + h] = (unsigned)j1 | ((unsigned)j2 << 8) | ((unsigned)j3 << 16);
        LRK[tt * 8 + h] = (unsigned)l1 | ((unsigned)l2 << 8) | ((unsigned)l3 << 16);
    }
    AT_WAITL(); bar();
    if (tid < 32) BCm[tid] = hist[tid];
    AT_WAITL(); bar();
}
__device__ __forceinline__ void moba_tables(const int* BCmbh, int lane, int& tot, int& seg) {
    int s = 0;
    if (lane < 32) { for (int q = 0; q < 32; ++q) s += BCmbh[q * 32 + lane]; }
    tot = s;
    int pad = (s + 31) & ~31, inc = pad;
#pragma unroll
    for (int sft = 1; sft < 32; sft <<= 1) { const int o_ = __shfl_up(inc, sft); if ((lane & 31) >= sft) inc += o_; }
    seg = inc - pad;
}
__device__ __forceinline__ void gather_lookup(const Params& p, int bh, int j, int gr, int lane, int& t, int& totj) {
    const int* BCmbh = (const int*)(p.ws + WS_BCM) + (size_t)bh * 32 * 32;
    const int cq = lane < 32 ? BCmbh[lane * 32 + j] : 0;
    int run = 0, qbs = j + 1, lr = 0;
#pragma unroll 4
    for (int q = 0; q < 32; ++q) { const int c_ = __builtin_amdgcn_readlane(cq, q); if (gr >= run && gr < run + c_) { qbs = q; lr = gr - run; } run += c_; }
    totj = run;
    const bool valid = gr < run;
    const unsigned char* IL = (const unsigned char*)(p.ws + WS_ILIST);
    const int qidx = valid ? (int)IL[((size_t)(bh * 32 + qbs) * 32 + j) * 256 + lr] : 0;
    t = valid ? qbs * 256 + qidx : (j + 1) * 256;
}
template <bool reload>
__device__ __forceinline__ void moba_gather_unit(const Params& p, int bh, int j, int ch, int segj, int nlo, int nch, bool havecar, bf16x8& qc0, bf16x8& qc1, bf16x8& qc2, bf16x8& qc3, int& totcar, unsigned char* lds_raw) {
    const int tid = otid(), lane = tid & 63, r32 = lane & 31, hi = lane >> 5, wid = __builtin_amdgcn_readfirstlane(tid >> 6);
    lp lds = (lp)lds_raw;
    const int b = bh >> 3, h = bh & 7;
    const bf16_t* ZB = (const bf16_t*)(p.ws + WS_ZB);
    float* wsf = (float*)(lds_raw + L_WSF) + wid * 64;
    const lp sK0 = lds + L_K, sV0 = lds + L_V;
    const bf16_t* KM_ = kimg(p, b, 4 + h); const bf16_t* VM_ = vimg(p, b, 4 + h);
    const int gr = 256 * ch + 32 * wid + r32;
    int totj;
    const float c2 = exp2f(-(float)(h + 1)) * LOG2E;
    bf16x8 qr[4];
    if (!havecar) { int t; gather_lookup(p, bh, j, gr, lane, t, totj); const size_t tt = (size_t)b * S + t;
#pragma unroll
        for (int d0 = 0; d0 < 4; ++d0) qr[d0] = *(const bf16x8*)(ZB + tt * ZBW + ZB_MQ + h * 64 + d0 * 16 + hi * 8); }
    else { totj = totcar; qr[0] = qc0; qr[1] = qc1; qr[2] = qc2; qr[3] = qc3; }
    const bool valid = gr < totj;
    AT_SB();
    if (reload) {
#pragma unroll
        for (int k = 3; k >= 0; --k) { dma_k(sK0 + k * 8192, KM_, 0, j * 256 + 64 * k, wid, lane); dma_v(sV0 + k * 8192, VM_, 0, j * 256 + 64 * k, wid, lane); }
    }
    AT_SB();
    const int nbh = nlo >= 0 ? nlo >> 5 : bh, nj = nlo >= 0 ? nlo & 31 : j;
    int cqn;
    { const int* BCn = (const int*)(p.ws + WS_BCM) + (size_t)nbh * 32 * 32 + nj; const int l31 = lane & 31; cqn = BCn[l31 * 32]; }
    AT_SB();
    int qbsn = nj + 1, totn = 0; unsigned ilv = 0; bool validn = false;
    Soft sm; sm.m = 0.f; sm.l = 0.f; f32x16 o[2]; o[0] = f32x16{}; o[1] = f32x16{};
#pragma unroll
    for (int i = 0; i < 4; ++i) {
        if (reload) { if (i == 0) AT_WAITV(7); else if (i == 1) AT_WAITV(5); else AT_WAITV(1); AT_WAITL(); bar(); }
        const int kt = 3 - i;
        const lp sK = sK0 + kt * 8192, sV = sV0 + kt * 8192;
        const float x0 = c2 * (float)(64 * kt) - sm.m;
        f32x16 p0 = cinit(c2, hi, x0), p1 = cinit(c2, hi, x0 + c2 * 32.f);
        qk_tile(p0, p1, sK, qr, r32, hi);
        VFrag vf; pv_load(vf, sV, lane, hi);
        softmax_step<true>(p0, p1, sm, o, wsf, r32, hi);
        { AT_PACK(p0, p1); pv_mfma(o, vf, pw0, pw1, pw2, pw3); }
        if (i == 1) {
            const int grn = 256 * nch + 32 * wid + r32; int run = 0, lrn = 0;
#pragma unroll 4
            for (int q = 0; q < 32; ++q) { const int c_ = __builtin_amdgcn_readlane(cqn, q); if (grn >= run && grn < run + c_) { qbsn = q; lrn = grn - run; } run += c_; }
            totn = run; validn = grn < run;
            const unsigned char* IL = (const unsigned char*)(p.ws + WS_ILIST);
            if (validn) ilv = IL[((size_t)(nbh * 32 + qbsn) * 32 + nj) * 256 + lrn];
        }
    }
    totcar = totn;
    if (nlo >= 0) { const int tn = validn ? qbsn * 256 + (int)ilv : (nj + 1) * 256; const size_t ttn = (size_t)(nbh >> 3) * S + tn;
        const bf16_t* qp = ZB + ttn * ZBW + ZB_MQ + (nbh & 7) * 64 + hi * 8;
        qc0 = *(const bf16x8*)(qp); qc1 = *(const bf16x8*)(qp + 16); qc2 = *(const bf16x8*)(qp + 32); qc3 = *(const bf16x8*)(qp + 48); }
    {
        const float lt = halfsum(sm.l);
        float* PM = (float*)(p.ws + WS_PM) + (size_t)bh * MB_CAP; float* PL = (float*)(p.ws + WS_PL) + (size_t)bh * MB_CAP;
        if (hi == 0 && valid) { PM[segj + gr] = sm.m; PL[segj + gr] = lt; }
        bf16_t* stg = (bf16_t*)(lds_raw + L_OST) + wid * 4096;
#pragma unroll
        for (int r = 0; r < 16; ++r) { const int orow = crow(r, hi); stg[orow * 64 + r32] = (bf16_t)f2bf(o[0][r]); stg[orow * 64 + 32 + r32] = (bf16_t)f2bf(o[1][r]); }
        wsync();
        bf16_t* PO = (bf16_t*)(p.ws + WS_PO) + ((size_t)bh * MB_CAP + segj + 256 * ch + 32 * wid) * 64;
        const int nrow = totj - (256 * ch + 32 * wid);
#pragma unroll
        for (int i = 0; i < 4; ++i) { const int row = i * 8 + (lane >> 3), c8 = lane & 7; if (row < nrow) *(uint4*)(PO + (size_t)row * 64 + c8 * 8) = *(const uint4*)(stg + row * 64 + c8 * 8); }
        wsync();
    }
    AT_WAITL(); bar();
}
__device__ __forceinline__ void moba_self_unit(const Params& p, int b, int h, int qb, unsigned char* lds_raw) {
    const int tid = otid(), lane = tid & 63, r32 = lane & 31, hi = lane >> 5, wid = __builtin_amdgcn_readfirstlane(tid >> 6);
    lp lds = (lp)lds_raw;
    const int bh = b * 8 + h;
    const bf16_t* ZB = (const bf16_t*)(p.ws + WS_ZB);
    const int* BCmbh = (const int*)(p.ws + WS_BCM) + (size_t)bh * 32 * 32;
    const int qi = 32 * wid + r32, t = qb * 256 + qi; const size_t tt = (size_t)b * S + t;
    float* wsf = (float*)(lds_raw + L_WSF) + wid * 64;
    float* ostage = (float*)(lds_raw + L_OST) + wid * 2048;
    const float c2 = exp2f(-(float)(h + 1)) * LOG2E;
    bf16x8 qr[4];
#pragma unroll
    for (int d0 = 0; d0 < 4; ++d0) qr[d0] = *(const bf16x8*)(ZB + tt * ZBW + ZB_MQ + h * 64 + d0 * 16 + hi * 8);
    const lp sK0 = lds + L_K, sV0 = lds + L_V;
    const bf16_t* KM_ = kimg(p, b, 4 + h); const bf16_t* VM_ = vimg(p, b, 4 + h);
    Soft sm; sm.m = 0.f; sm.l = 0.f; f32x16 o[2]; o[0] = f32x16{}; o[1] = f32x16{};
#pragma unroll
    for (int k = 0; k < 3; ++k) { dma_k(sK0 + k * 8192, KM_, 0, qb * 256 + 64 * (3 - k), wid, lane); dma_v(sV0 + k * 8192, VM_, 0, qb * 256 + 64 * (3 - k), wid, lane); }
    int tot, seg; moba_tables(BCmbh, lane, tot, seg);
    int before = 0; if (lane < 32) { for (int q = 0; q < qb; ++q) before += BCmbh[q * 32 + lane]; }
    const int base = seg + before;
    const unsigned s3 = ((const unsigned*)(p.ws + WS_SEL3))[tt * 8 + h], l3 = ((const unsigned*)(p.ws + WS_LRK))[tt * 8 + h];
    int pidx[3]; float mkr[3], lk[3]; uint4 pq[4][3];
    { const float* PM = (const float*)(p.ws + WS_PM) + (size_t)bh * MB_CAP; const float* PL = (const float*)(p.ws + WS_PL) + (size_t)bh * MB_CAP;
      const bf16_t* PO = (const bf16_t*)(p.ws + WS_PO) + (size_t)bh * MB_CAP * 64;
#pragma unroll
      for (int k = 0; k < 3; ++k) { const int jk = (s3 >> (8 * k)) & 255, lrk = (l3 >> (8 * k)) & 255;
          const int pb = __shfl(base, jk & 31);
          pidx[k] = jk < 32 ? pb + lrk : -1;
          const int pc = pidx[k] < 0 ? 0 : pidx[k];
          mkr[k] = PM[pc]; lk[k] = PL[pc];
#pragma unroll
          for (int i = 0; i < 4; ++i) { const int pi = __shfl(pc, i * 8 + (lane >> 3)); pq[i][k] = *(const uint4*)(PO + (size_t)pi * 64 + (lane & 7) * 8); } } }
#pragma unroll 1
    for (int i = 0; i < 4; ++i) {
        const int newer = 3 - i; AT_WAIT_NEWER(newer, 2);
        AT_WAITL(); bar();
        if (i == 0) { dma_k(sK0 + 3 * 8192, KM_, 0, qb * 256, wid, lane); dma_v(sV0 + 3 * 8192, VM_, 0, qb * 256, wid, lane); }
        const lp sK = sK0 + i * 8192, sV = sV0 + i * 8192;
        const int kt = 3 - i;
        const bool skip = (32 * wid + 31 < 64 * kt);
        if (!skip) {
            const float x0 = c2 * (float)(64 * kt) - sm.m;
            f32x16 p0 = cinit(c2, hi, x0), p1 = cinit(c2, hi, x0 + c2 * 32.f);
            qk_tile(p0, p1, sK, qr, r32, hi);
            if (64 * kt + 63 > 32 * wid) mask_tile(p0, p1, 0, qi - 64 * kt, hi);
            VFrag vf; pv_load(vf, sV, lane, hi);
            softmax_step<true>(p0, p1, sm, o, wsf, r32, hi);
            { AT_PACK(p0, p1); pv_mfma(o, vf, pw0, pw1, pw2, pw3); }
        }
    }
    {
        const float lself = halfsum(sm.l);
        float mk[3];
        float M = sm.m + c2 * 256.f * (float)qb;
        const float mself = M;
#pragma unroll
        for (int k = 0; k < 3; ++k) { const int jk = (s3 >> (8 * k)) & 255;
            if (pidx[k] >= 0) { mk[k] = mkr[k] + c2 * 256.f * (float)jk; M = __builtin_fmaxf(M, mk[k]); }
            else { mk[k] = NEGS; lk[k] = 0.f; } }
        const float ws_ = __builtin_amdgcn_exp2f(mself - M);
        float wk[3]; float Lt = lself * ws_;
#pragma unroll
        for (int k = 0; k < 3; ++k) { wk[k] = pidx[k] >= 0 ? __builtin_amdgcn_exp2f(mk[k] - M) : 0.f; Lt += lk[k] * wk[k]; }
        const float inv = Lt > 0.f ? 1.f / Lt : 0.f;
        float* rws = wsf;
        float* rwk = (float*)(lds_raw + L_KMT) + wid * 256;
        int* rpi = (int*)(rwk + 96);
        if (hi == 0) { rws[r32] = ws_ * inv;
#pragma unroll
            for (int k = 0; k < 3; ++k) { rwk[k * 32 + r32] = wk[k] * inv; rpi[k * 32 + r32] = pidx[k]; } }
#pragma unroll
        for (int r = 0; r < 16; ++r) { const int orow = crow(r, hi); ostage[orow * 64 + r32] = o[0][r]; ostage[orow * 64 + 32 + r32] = o[1][r]; }
        wsync();
        unsigned char* AB = p.ws + WS_ATTB;
#pragma unroll
        for (int i = 0; i < 4; ++i) { const int row = i * 8 + (lane >> 3), c8 = lane & 7;
            const float4 a = *(const float4*)(ostage + row * 64 + c8 * 8), c4 = *(const float4*)(ostage + row * 64 + c8 * 8 + 4);
            const float w0 = rws[row];
            float acc8[8] = {a.x * w0, a.y * w0, a.z * w0, a.w * w0, c4.x * w0, c4.y * w0, c4.z * w0, c4.w * w0};
#pragma unroll
            for (int k = 0; k < 3; ++k) { const int pi = rpi[k * 32 + row]; if (pi >= 0) { const float w = rwk[k * 32 + row]; const uint4 q = pq[i][k];
                const unsigned qq_[4] = {q.x, q.y, q.z, q.w};
#pragma unroll
                for (int e = 0; e < 4; ++e) { acc8[2 * e] += __builtin_bit_cast(float, qq_[e] << 16) * w; acc8[2 * e + 1] += __builtin_bit_cast(float, qq_[e] & 0xffff0000u) * w; } } }
            *(uint2*)(AB + ((size_t)b * S + qb * 256 + 32 * wid + row) * D + 512 + h * 64 + c8 * 8) = make_uint2(pk_fp8x4(OS8 * acc8[0], OS8 * acc8[1], OS8 * acc8[2], OS8 * acc8[3]), pk_fp8x4(OS8 * acc8[4], OS8 * acc8[5], OS8 * acc8[6], OS8 * acc8[7])); }
        wsync();
    }
    AT_WAITL(); bar();
}
}

__device__ __forceinline__ void phase_att1(const Params& p, unsigned char* lds_raw) {
    const int tid = otid();
    int* pre = (int*)(lds_raw + at::L_END);
    int* segt = pre + 514;
    { const int* BCm = (const int*)(p.ws + WS_BCM); const int bh = tid >> 5, j = tid & 31, lane = tid & 63, wave = tid >> 6; int s = 0;
#pragma unroll 8
      for (int q = 0; q < 32; ++q) s += BCm[(size_t)(bh * 32 + q) * 32 + j];
      const int cn = (s + 255) >> 8, pad = (s + 31) & ~31; int ic = cn, ip = pad;
#pragma unroll
      for (int sft = 1; sft < 64; sft <<= 1) { const int oc = __shfl_up(ic, sft), op = __shfl_up(ip, sft); if (lane >= sft) ic += oc; if ((lane & 31) >= sft && sft < 32) ip += op; }
      int* wtot = segt + 512;
      if (lane == 63) wtot[wave] = ic;
      __syncthreads();
      int off = 0;
#pragma unroll
      for (int w = 0; w < 8; ++w) off += (w < wave) ? wtot[w] : 0;
      pre[tid + 1] = ic + off; if (tid == 0) pre[0] = 0;
      segt[tid] = ip - pad; }
    __syncthreads();
    const int nun = pre[512];
    for (int pi = blockIdx.x; pi < 512; pi += gridDim.x) {
        const int rnd = pi >> 8, id = pi & 255;
        const int bg = 2 * rnd + (id >> 7), c = rnd ? 127 - (id & 127) : (id & 127); at::nsa_unit(p, bg >> 1, bg & 1, c, lds_raw);
    }
    {
        const int u0 = (int)(((long)blockIdx.x * nun) / gridDim.x), u1 = (int)(((long)(blockIdx.x + 1) * nun) / gridDim.x);
        int prev = -1, totcar = 0; at::bf16x8 qc0 = {}, qc1 = {}, qc2 = {}, qc3 = {};
        int lo = 0; { int hi_ = 511; while (lo < hi_) { const int mid = (lo + hi_ + 1) >> 1; if (pre[mid] <= u0) lo = mid; else hi_ = mid - 1; } }
        for (int u = u0; u < u1; ++u) {
            int lon = -1, chn = 0;
            if (u + 1 < u1) { lon = lo; while (pre[lon + 1] <= u + 1) ++lon; chn = u + 1 - pre[lon]; }
            if (lo != prev) at::moba_gather_unit<true>(p, lo >> 5, lo & 31, u - pre[lo], segt[lo], lon, chn, u != u0, qc0, qc1, qc2, qc3, totcar, lds_raw);
            else at::moba_gather_unit<false>(p, lo >> 5, lo & 31, u - pre[lo], segt[lo], lon, chn, true, qc0, qc1, qc2, qc3, totcar, lds_raw);
            prev = lo; if (lon >= 0) lo = lon;
        }
    }
}
__device__ __forceinline__ void phase_att2(const Params& p, unsigned char* lds_raw) {
    for (int pi = blockIdx.x; pi < 512; pi += gridDim.x) {
        const int rnd = pi >> 8, id = pi & 255;
        const int bh = 8 * rnd + (id >> 5), qb = rnd ? 31 - (id & 31) : (id & 31); at::moba_self_unit(p, bh >> 3, bh & 7, qb, lds_raw);
    }
}
__device__ __forceinline__ void phase_route(const Params& p, unsigned char* lds_raw) {
    for (int pi = blockIdx.x; pi < 512; pi += gridDim.x) at::moba_route_unit(p, pi >> 8, (pi >> 5) & 7, pi & 31, lds_raw);
}


__device__ __forceinline__ void phase_r2_fast(const Params& p, int l, unsigned char* lds_raw) {
    using namespace at;
    const int tid = otid(), lane = tid & 63, wave = __builtin_amdgcn_readfirstlane(tid >> 6), r32 = lane & 31, hi = lane >> 5;
    const float* mod = (const float*)(p.ws + WS_MOD);
    const bf16_t* XAB = (const bf16_t*)(p.ws + WS_XAB);
    const float* lng = p.in[5] + (size_t)l * D; const float* rb = p.in[16] + l * NE;
    int* toke = (int*)(p.ws + WS_TOKE); float* tokw = (float*)(p.ws + WS_TOKW); int* BC = (int*)(p.ws + WS_BC);
    const unsigned char* img = p.ws + WS_RWI + (size_t)l * 131072;
    constexpr int PP = 2064;
    unsigned char* pl_hi = lds_raw; unsigned char* pl_lo = lds_raw + 32 * PP;
    int* hist = (int*)(lds_raw + 2 * 32 * PP);
    for (int blk = blockIdx.x; blk < T / 64; blk += gridDim.x) {
        if (tid < 32) hist[tid] = 0;
        const int b = (blk * 64) / S;
        const float* sh = mod + ((size_t)l * Bn + b) * 6144 + 3 * D; const float* sc = mod + ((size_t)l * Bn + b) * 6144 + 4 * D;
        float4 ga[4], s0v[4];
#pragma unroll
        for (int j = 0; j < 4; ++j) { const int col = 4 * lane + 256 * j; const float4 g = *(const float4*)(lng + col), s1 = *(const float4*)(sc + col); s0v[j] = *(const float4*)(sh + col);
            ga[j] = make_float4(g.x * (1.f + s1.x), g.y * (1.f + s1.y), g.z * (1.f + s1.z), g.w * (1.f + s1.w)); }
#pragma unroll 1
        for (int half = 0; half < 2; ++half) {
            const int trow0 = blk * 64 + half * 32;
            {
                uint2 q_[4][4];
#pragma unroll
                for (int i = 0; i < 4; ++i)
#pragma unroll
                    for (int j = 0; j < 4; ++j) q_[i][j] = *(const uint2*)(XAB + (size_t)(trow0 + wave * 4 + i) * D + 4 * lane + 256 * j);
                float ss[4];
#pragma unroll
                for (int i = 0; i < 4; ++i) { float s_ = 0.f;
#pragma unroll
                    for (int j = 0; j < 4; ++j) { const float x0 = __builtin_bit_cast(float, q_[i][j].x << 16), x1 = __builtin_bit_cast(float, q_[i][j].x & 0xffff0000u), x2 = __builtin_bit_cast(float, q_[i][j].y << 16), x3 = __builtin_bit_cast(float, q_[i][j].y & 0xffff0000u);
                        s_ += (x0 * x0 + x1 * x1) + (x2 * x2 + x3 * x3); }
                    ss[i] = s_; }
#pragma unroll
                for (int sft = 32; sft >= 1; sft >>= 1) {
#pragma unroll
                    for (int i = 0; i < 4; ++i) ss[i] += __shfl_xor(ss[i], sft); }
#pragma unroll
                for (int i = 0; i < 4; ++i) {
                    const int rl = wave * 4 + i, t = trow0 + rl;
                    const float r = rsqrtf(ss[i] * (1.f / D) + EPS);
#pragma unroll
                    for (int j = 0; j < 4; ++j) {
                        const int col = 4 * lane + 256 * j;
                        const float x0 = __builtin_bit_cast(float, q_[i][j].x << 16), x1 = __builtin_bit_cast(float, q_[i][j].x & 0xffff0000u), x2 = __builtin_bit_cast(float, q_[i][j].y << 16), x3 = __builtin_bit_cast(float, q_[i][j].y & 0xffff0000u);
                        const float o[4] = {x0 * r * ga[j].x + s0v[j].x, x1 * r * ga[j].y + s0v[j].y, x2 * r * ga[j].z + s0v[j].z, x3 * r * ga[j].w + s0v[j].w};
                        unsigned hh[4], ll[4];
#pragma unroll
                        for (int q = 0; q < 4; ++q) { hh[q] = f2bf(o[q]); ll[q] = f2bf(o[q] - __builtin_bit_cast(float, hh[q] << 16)); }
                        *(uint2*)(pl_hi + rl * PP + col * 2) = make_uint2(hh[0] | (hh[1] << 16), hh[2] | (hh[3] << 16));
                        *(uint2*)(pl_lo + rl * PP + col * 2) = make_uint2(ll[0] | (ll[1] << 16), ll[2] | (ll[3] << 16));
                        *(unsigned*)(p.ws + WS_XN8 + (size_t)t * D + col) = pk_fp8x4(o[0] * XS8, o[1] * XS8, o[2] * XS8, o[3] * XS8);
                    }
                }
            }
            __syncthreads();
            f32x16 acc = f32x16{};
            {
                const AT_LAS unsigned char* xh = (lp)pl_hi + r32 * PP + (128 * wave + 8 * hi) * 2; const AT_LAS unsigned char* xl = (lp)pl_lo + r32 * PP + (128 * wave + 8 * hi) * 2;
                const unsigned char* wh = img + (size_t)((16 * wave + hi) * 32 + r32) * 16; const unsigned char* wl = wh + 65536;
#pragma unroll 1
                for (int k4 = 0; k4 < 8; k4 += 4) {
                    bf16x8 ah[4], al[4];
#pragma unroll
                    for (int ks = 0; ks < 4; ++ks) { ah[ks] = *(const bf16x8*)(wh + (k4 + ks) * 1024); al[ks] = *(const bf16x8*)(wl + (k4 + ks) * 1024); }
#pragma unroll
                    for (int ks = 0; ks < 4; ++ks) {
                        const bf16x8 bh = *(const AT_LAS bf16x8*)(xh + 32 * (k4 + ks)), bl = *(const AT_LAS bf16x8*)(xl + 32 * (k4 + ks));
                        acc = __builtin_amdgcn_mfma_f32_32x32x16_bf16(ah[ks], bh, acc, 0, 0, 0);
                        acc = __builtin_amdgcn_mfma_f32_32x32x16_bf16(al[ks], bh, acc, 0, 0, 0);
                        acc = __builtin_amdgcn_mfma_f32_32x32x16_bf16(ah[ks], bl, acc, 0, 0, 0);
                    }
                }
            }
            __syncthreads();
            { float* part = (float*)lds_raw;
              if (wave >= 1) {
#pragma unroll
                  for (int r = 0; r < 16; ++r) part[(wave * 16 + r) * 64 + lane] = acc[r]; } }
            __syncthreads();
            if (wave == 0) {
                const int t = trow0 + r32;
                { const float* part = (const float*)lds_raw;
#pragma unroll
                  for (int r = 0; r < 16; ++r) { float a = acc[r];
#pragma unroll
                      for (int w = 1; w < 8; ++w) a += part[(w * 16 + r) * 64 + lane];
                      acc[r] = a; } }
                float a0 = -3e38f, a1 = -3e38f, a2 = -3e38f, a3 = -3e38f; int i0 = 99, i1 = 99, i2 = 99, i3 = 99;
#pragma unroll
                for (int r = 0; r < 16; ++r) { const int e = crow(r, hi); const float s_ = acc[r] + rb[e];
                    if (s_ > a0) { a3 = a2; i3 = i2; a2 = a1; i2 = i1; a1 = a0; i1 = i0; a0 = s_; i0 = e; }
                    else if (s_ > a1) { a3 = a2; i3 = i2; a2 = a1; i2 = i1; a1 = s_; i1 = e; }
                    else if (s_ > a2) { a3 = a2; i3 = i2; a2 = s_; i2 = e; }
                    else if (s_ > a3) { a3 = s_; i3 = e; } }
                float ov[4]; int oi[4];
                { const float sv[4] = {a0, a1, a2, a3}; const int si[4] = {i0, i1, i2, i3};
#pragma unroll
                  for (int k = 0; k < 4; ++k) { auto a = __builtin_amdgcn_permlane32_swap(__float_as_uint(sv[k]), __float_as_uint(sv[k]), false, false); ov[k] = __uint_as_float(hi ? a[0] : a[1]);
                                                auto c = __builtin_amdgcn_permlane32_swap((unsigned)si[k], (unsigned)si[k], false, false); oi[k] = (int)(hi ? c[0] : c[1]); } }
#pragma unroll
                for (int k = 0; k < 4; ++k) { const float s_ = ov[k]; const int e = oi[k];
                    if (s_ > a0 || (s_ == a0 && e < i0)) { a3 = a2; i3 = i2; a2 = a1; i2 = i1; a1 = a0; i1 = i0; a0 = s_; i0 = e; }
                    else if (s_ > a1 || (s_ == a1 && e < i1)) { a3 = a2; i3 = i2; a2 = a1; i2 = i1; a1 = s_; i1 = e; }
                    else if (s_ > a2 || (s_ == a2 && e < i2)) { a3 = a2; i3 = i2; a2 = s_; i2 = e; }
                    else if (s_ > a3 || (s_ == a3 && e < i3)) { a3 = s_; i3 = e; } }
                const float e1 = __expf(a1 - a0), e2 = __expf(a2 - a0), e3 = __expf(a3 - a0), inv = 1.f / (((1.f + e1) + e2) + e3);
                if (hi == 0) {
                    *(int4*)(toke + (size_t)t * 4) = make_int4(i0, i1, i2, i3);
                    *(float4*)(tokw + (size_t)t * 4) = make_float4(inv, e1 * inv, e2 * inv, e3 * inv);
                    atomicAdd(&hist[i0], 1); atomicAdd(&hist[i1], 1); atomicAdd(&hist[i2], 1); atomicAdd(&hist[i3], 1);
                }
            }
            __syncthreads();
        }
        if (tid < 32) BC[blk * 32 + tid] = hist[tid];
        __syncthreads();
    }
}
__device__ __forceinline__ void phase_sc_fast(const Params& p, int l, unsigned char* lds_raw) {
    const int tid = otid();
    const int* BC = (const int*)(p.ws + WS_BC);
    int* cnt = (int*)(p.ws + WS_CNT) + l * 32;
    int* tot = (int*)lds_raw; int* base = tot + 32; int* fillc = tot + 64; int* before = tot + 96;
    const int* toke = (const int*)(p.ws + WS_TOKE); const float* tokw = (const float*)(p.ws + WS_TOKW);
    int* rowtok = (int*)(p.ws + WS_ROWTOK) + (size_t)l * RMAX; float* roww = (float*)(p.ws + WS_ROWW) + (size_t)l * RMAX; int* pos = (int*)(p.ws + WS_POS);
    for (int blk = blockIdx.x; blk < T / 64; blk += gridDim.x) {
        { const int e = tid & 31, part = tid >> 5; int s = 0, bf = 0;
#pragma unroll 4
          for (int i = part * 16; i < part * 16 + 16; ++i) { const int c = BC[i * 32 + e]; s += c; if (i < blk) bf += c; }
          int* ptot = tot + 128; int* pbef = ptot + 512;
          ptot[tid] = s; pbef[tid] = bf; }
        __syncthreads();
        if (tid < 32) { const int* ptot = tot + 128; const int* pbef = ptot + 512; int s = 0, bf = 0;
#pragma unroll
            for (int q = 0; q < 16; ++q) { s += ptot[q * 32 + tid]; bf += pbef[q * 32 + tid]; }
            tot[tid] = s; before[tid] = bf; fillc[tid] = 0; if (blk == 0) cnt[tid] = s; }
        __syncthreads();
        if (tid == 0) { int s = 0; for (int e = 0; e < 32; ++e) { base[e] = s + before[e]; s += (tot[e] + 255) & ~255; } }
        __syncthreads();
        if (tid < 256) {
            const int i = blk * 256 + tid, e = toke[i];
            const int slot = base[e] + atomicAdd(&fillc[e], 1);
            rowtok[slot] = i >> 2; roww[slot] = tokw[i]; pos[i] = slot;
        }
        __syncthreads();
    }
}

#define XB_TMO      128
#define XB_XCNT(j)  (256  + 64 * (j))
#define XB_XSUB(j)  (1280 + 64 * (j))
#define XB_XGEN(j)  (2304 + 64 * (j))
#define XB_TOP      3328
#define XB_TOPGEN   3392
#define XCD_BAR_WORDS 3456
#define XB_SPIN_CAP (1u << 18)
#define XLAS __attribute__((address_space(3)))
__device__ __forceinline__ unsigned xb_ld(unsigned* p)              { return __hip_atomic_load(p, __ATOMIC_RELAXED, __HIP_MEMORY_SCOPE_AGENT); }
__device__ __forceinline__ unsigned xb_add(unsigned* p, unsigned v) { return __hip_atomic_fetch_add(p, v, __ATOMIC_RELAXED, __HIP_MEMORY_SCOPE_AGENT); }
__device__ __forceinline__ unsigned xb_xcc_id() { return (unsigned)__builtin_amdgcn_s_getreg((3 << 11) | 20) & 0xFu; }
#define XB_SPIN(cond, bar) do { unsigned _sp = 0; while (cond) { __builtin_amdgcn_s_sleep(1); \
    if ((++_sp & 255u) == 0u) { if (xb_ld(&(bar)[XB_TMO])) break; if (_sp > XB_SPIN_CAP) { atomicAdd(&(bar)[XB_TMO], 1u); break; } } } } while (0)
constexpr int LDS_BARST_OFF = 147200;
struct XcdBarrier { unsigned* bar; unsigned x; volatile XLAS unsigned* st; };
__device__ __forceinline__ XcdBarrier xcd_barrier_post(unsigned* bar, volatile XLAS unsigned* st) {
    XcdBarrier b; b.bar = bar; b.x = xb_xcc_id(); b.st = st;
    if (threadIdx.x == 0) (void)xb_add(&bar[XB_XCNT(b.x)], 1u);
    return b;
}
__device__ __forceinline__ void xcd_barrier_complete(unsigned* bar, unsigned x, unsigned& nloc, unsigned& nx) {
    const unsigned G = gridDim.x * gridDim.y * gridDim.z;
    unsigned sum, cnt, mine, sp = 0u;
    for (;;) {
        sum = 0u; cnt = 0u; mine = 0u;
#pragma unroll
        for (unsigned j = 0; j < 16; ++j) { const unsigned c = xb_ld(&bar[XB_XCNT(j)]); sum += c; cnt += (c > 0u) ? 1u : 0u; mine = (j == x) ? c : mine; }
        if (sum == G) break;
        __builtin_amdgcn_s_sleep(1);
        if ((++sp & 255u) == 0u) { if (xb_ld(&bar[XB_TMO])) break; if (sp > XB_SPIN_CAP) { atomicAdd(&bar[XB_TMO], 1u); break; } }
    }
    nloc = mine > 0u ? mine : 1u; nx = cnt > 0u ? cnt : 1u;
}
__device__ __forceinline__ void xcd_barrier(unsigned char* ws, unsigned char* lds_raw_) {
    XcdBarrier b; b.bar = (unsigned*)(ws + WS_BAR); b.x = xb_xcc_id(); b.st = (volatile XLAS unsigned*)((XLAS unsigned char*)lds_raw_ + LDS_BARST_OFF);
    asm volatile("s_waitcnt vmcnt(0)" ::: "memory");
    __syncthreads();
    if (threadIdx.x == 0) {
        unsigned* bar = b.bar;
        __builtin_amdgcn_s_waitcnt(0);
        unsigned nloc = b.st[0], nx = b.st[1];
        if (nloc == 0u) { xcd_barrier_complete(bar, b.x, nloc, nx); b.st[0] = nloc; b.st[1] = nx; }
        const unsigned old = xb_add(&bar[XB_XSUB(b.x)], 1u);
        const unsigned gen = old / nloc;
        if (old + 1u == (gen + 1u) * nloc) {
            __builtin_amdgcn_fence(__ATOMIC_RELEASE, "agent");
            asm volatile("s_waitcnt vmcnt(0)" ::: "memory");
            const unsigned og = xb_add(&bar[XB_TOP], 1u);
            const unsigned tg = og / nx;
            if (og + 1u == (tg + 1u) * nx) xb_add(&bar[XB_TOPGEN], 1u);
            else XB_SPIN(xb_ld(&bar[XB_TOPGEN]) == tg, bar);
            __builtin_amdgcn_fence(__ATOMIC_ACQUIRE, "agent");
            xb_add(&bar[XB_XGEN(b.x)], 1u);
            asm volatile("s_waitcnt vmcnt(0)" ::: "memory");
        } else {
            XB_SPIN(xb_ld(&bar[XB_XGEN(b.x)]) == gen, bar);
            __builtin_amdgcn_fence(__ATOMIC_ACQUIRE, "agent");
            asm volatile("s_waitcnt vmcnt(0)" ::: "memory");
        }
    }
    __syncthreads();
}

__global__ void __launch_bounds__(NT, 2) mega_fwd(Params p) {
    extern __shared__ __attribute__((aligned(16))) unsigned char lds_raw[];
    float* lds = (float*)lds_raw;
    volatile XLAS unsigned* bst = (volatile XLAS unsigned*)((XLAS unsigned char*)lds_raw + LDS_BARST_OFF);
    if (threadIdx.x < 2) bst[threadIdx.x] = 0u;
    __syncthreads();
    (void)xcd_barrier_post((unsigned*)(p.ws + WS_BAR), bst);
#define GSYNC() xcd_barrier(p.ws, lds_raw)
    phase_p0a(p, lds);
    __syncthreads();
    phase_convert(p, lds);
    GSYNC();
    phase_p0b(p);
    GSYNC();
    _Pragma("unroll 1") for (int l = 0; l < L; ++l) {
        phase_r1(p, l, true);
        GSYNC();
        phase_g1_fast(p, l, lds_raw);
        GSYNC();
        phase_ck_fast(p, l, lds_raw);
        GSYNC();
        phase_c2(p, l, lds);
        __syncthreads();
        phase_route(p, lds_raw);
        GSYNC();
        phase_att1(p, lds_raw);
        GSYNC();
        phase_att2(p, lds_raw);
        GSYNC();
        phase_g2_fast(p, l, lds_raw);
        GSYNC();
        phase_r2_fast(p, l, lds_raw);
        GSYNC();
        phase_sc_fast(p, l, lds_raw);
        GSYNC();
        phase_m1_fast(p, l, lds_raw);
        GSYNC();
        phase_m2_fast(p, l, lds_raw);
        GSYNC();
    }
    phase_r1(p, L, false);
}

extern "C" void kernel_launch(void* const* d_in, const int* in_sizes, int n_in, void* d_out, int out_size, void* d_ws, size_t ws_size, hipStream_t stream) {
    static int grid_blocks = 0;
    if (grid_blocks == 0) {
        if (n_in != 21 || out_size != T * D || ws_size < WS_END) { fprintf(stderr, "kernel_launch: unexpected shapes (n_in %d out %d ws %zu need %zu)\n", n_in, out_size, ws_size, (size_t)WS_END); grid_blocks = -1; return; }
        int dev = 0, cus = 0, per_cu = 0;
        hipGetDevice(&dev);
        hipDeviceGetAttribute(&cus, hipDeviceAttributeMultiprocessorCount, dev);
        hipFuncSetAttribute((const void*)mega_fwd, hipFuncAttributeMaxDynamicSharedMemorySize, LDS_BYTES);
        hipOccupancyMaxActiveBlocksPerMultiprocessor(&per_cu, (const void*)mega_fwd, NT, LDS_BYTES);
        if (per_cu < 1) { fprintf(stderr, "kernel_launch: occupancy query says %d blocks per CU\n", per_cu); per_cu = 1; }
        (void)hipGetLastError();
        grid_blocks = cus * 1;
    }
    if (grid_blocks < 0) return;
    if (hipMemsetAsync((char*)d_ws + WS_BAR, 0, 16384, stream) != hipSuccess) { fprintf(stderr, "kernel_launch: memset failed\n"); return; }
    Params p{};
    for (int i = 0; i < 21; ++i) p.in[i] = (const float*)d_in[i];
    p.out = (float*)d_out; p.ws = (unsigned char*)d_ws;
    hipLaunchKernelGGL(mega_fwd, dim3(grid_blocks), dim3(NT), LDS_BYTES, stream, p);
    hipError_t e = hipPeekAtLastError();
    if (e != hipSuccess) fprintf(stderr, "launch failed: %s (grid %d)\n", hipGetErrorString(e), grid_blocks);
}
```
